# Optimizing an MI355X kernel written in HIP

```python
import math
import jax, jax.numpy as jnp
from jax import lax
import numpy as np

D_MODEL = 1024
BATCH = 8
SEQ = 2048
DEPTH = 1

CHUNK = 64
Q_BLOCK = 128
NORM_EPS = 1e-6
ROPE_THETA = 10000.0

DA_WIDTH = 512
DA_HEADS = 4
DA_HALF_DIM = DA_WIDTH // (2 * DA_HEADS)
DA_VDIM = 2 * DA_HALF_DIM
DA_SUBLN_EPS = 1e-5

RW_WIDTH = 512
RW_HEAD = 64
RW_HEADS = RW_WIDTH // RW_HEAD
RW_DECAY_LORA = 64
RW_AAA_LORA = 64
RW_GATE_LORA = 128
RW_GN_EPS = RW_HEAD * 1e-5
RW_IN_WIDTH = 3 * RW_WIDTH + RW_DECAY_LORA + RW_AAA_LORA + RW_GATE_LORA
RW_SPLIT_IDX = [RW_WIDTH, 2 * RW_WIDTH, 3 * RW_WIDTH,
                3 * RW_WIDTH + RW_DECAY_LORA,
                3 * RW_WIDTH + RW_DECAY_LORA + RW_AAA_LORA]

DA_IN_WIDTH = 3 * DA_WIDTH
GATE_WIDTH = 2 * D_MODEL
D_IN = DA_IN_WIDTH + RW_IN_WIDTH + GATE_WIDTH

D_FF = 4 * D_MODEL

kernel_name = "hybrid_diffattn_rwkv7_gated_block"


def rms_norm(x, g, eps=NORM_EPS):
    xf = x.astype(jnp.float32)
    y = xf * lax.rsqrt(jnp.mean(xf * xf, axis=-1, keepdims=True) + eps)
    return (y * g.astype(jnp.float32)).astype(x.dtype)


def rope(x, pos):
    d = x.shape[-1]
    inv_freq = ROPE_THETA ** (-jnp.arange(0, d, 2, dtype=jnp.float32) / d)
    ang = pos[:, None] * inv_freq[None, :]
    cos = jnp.cos(ang)[None, :, None, :].astype(x.dtype)
    sin = jnp.sin(ang)[None, :, None, :].astype(x.dtype)
    x1, x2 = x[..., : d // 2], x[..., d // 2:]
    return jnp.concatenate([x1 * cos - x2 * sin, x2 * cos + x1 * sin], axis=-1)


def diff_attention(q, k, v, lq1, lk1, lq2, lk2, subln_g, lambda_init):
    B, S, _ = q.shape
    pos = jnp.arange(S, dtype=jnp.float32)
    q = rope(q.reshape(B, S, 2 * DA_HEADS, DA_HALF_DIM), pos).reshape(B, S, DA_HEADS, 2, DA_HALF_DIM)
    k = rope(k.reshape(B, S, 2 * DA_HEADS, DA_HALF_DIM), pos).reshape(B, S, DA_HEADS, 2, DA_HALF_DIM)
    v = v.reshape(B, S, DA_HEADS, DA_VDIM)
    lam = (jnp.exp(jnp.sum(lq1.astype(jnp.float32) * lk1.astype(jnp.float32)))
           - jnp.exp(jnp.sum(lq2.astype(jnp.float32) * lk2.astype(jnp.float32)))
           + lambda_init)
    nb = S // Q_BLOCK
    qb = q.reshape(B, nb, Q_BLOCK, DA_HEADS, 2, DA_HALF_DIM).transpose(1, 0, 2, 3, 4, 5)
    k_chunk = jnp.arange(S) // CHUNK
    scale = DA_HALF_DIM ** -0.5

    def attend(args):
        q_blk, bi = args
        s = jnp.einsum('bqhcd,bkhcd->bhcqk', q_blk, k,
                       preferred_element_type=jnp.float32) * scale
        q_chunk = (bi * Q_BLOCK + jnp.arange(Q_BLOCK)) // CHUNK
        allowed = k_chunk[None, :] <= q_chunk[:, None]
        s = jnp.where(allowed, s, -jnp.inf)
        p = jax.nn.softmax(s, axis=-1)
        w = p[:, :, 0] - lam * p[:, :, 1]
        return jnp.einsum('bhqk,bkhv->bqhv', w.astype(v.dtype), v)

    o = lax.map(attend, (qb, jnp.arange(nb)))
    o = o.transpose(1, 0, 2, 3, 4).reshape(B, S, DA_HEADS, DA_VDIM)
    o = rms_norm(o, subln_g, DA_SUBLN_EPS) * (1.0 - lambda_init)
    return o.reshape(B, S, DA_WIDTH)


def rwkv7_time_mix(z, mu, w0, w2, a0, a2, g2, k_k, k_a, r_k, ln_g, ln_b):
    B, S, _ = z.shape
    f32 = jnp.float32
    z_prev = jnp.pad(z, ((0, 0), (1, 0), (0, 0)))[:, :-1]
    z = z + (z_prev - z) * mu
    r, k, v, wd, ad, gd = jnp.split(z, RW_SPLIT_IDX, axis=-1)
    w = -jax.nn.softplus(-(w0 + jnp.tanh(wd) @ w2).astype(f32)) - 0.5
    decay = jnp.exp(-jnp.exp(w))
    a = jax.nn.sigmoid(a0 + ad @ a2)
    g = jax.nn.sigmoid(gd) @ g2
    hd = lambda t: t.reshape(B, S, RW_HEADS, RW_HEAD).astype(f32)
    kk = hd(k * k_k)
    kk = kk / jnp.maximum(jnp.sqrt(jnp.sum(kk * kk, axis=-1, keepdims=True)), 1e-12)
    k = k * (1.0 + (a - 1.0) * k_a)
    r_h, k_h, v_h, a_h, w_h = hd(r), hd(k), hd(v), hd(a), hd(decay)
    a_vec = -kk
    b_vec = kk * a_h

    def step(state, inp):
        r_t, w_t, k_t, v_t, a_t, b_t = inp
        sa = jnp.einsum('bhvk,bhk->bhv', state, a_t)
        state = (state * w_t[:, :, None, :] + sa[..., None] * b_t[:, :, None, :]
                 + v_t[..., None] * k_t[:, :, None, :])
        return state, jnp.einsum('bhvk,bhk->bhv', state, r_t)

    tm = lambda t: jnp.moveaxis(t, 1, 0)
    state0 = jnp.zeros((B, RW_HEADS, RW_HEAD, RW_HEAD), f32)
    _, y = lax.scan(step, state0, (tm(r_h), tm(w_h), tm(k_h), tm(v_h), tm(a_vec), tm(b_vec)))
    y = jnp.moveaxis(y, 0, 1)
    mean = jnp.mean(y, axis=-1, keepdims=True)
    var = jnp.mean(jnp.square(y - mean), axis=-1, keepdims=True)
    y = ((y - mean) * lax.rsqrt(var + RW_GN_EPS)).reshape(B, S, RW_WIDTH)
    y = y * ln_g.astype(f32) + ln_b.astype(f32)
    bonus = jnp.sum(r_h * k_h * r_k.astype(f32), axis=-1, keepdims=True) * v_h
    y = (y + bonus.reshape(B, S, RW_WIDTH)) * g.astype(f32)
    return y.astype(z.dtype)


def setup_inputs(seed: int = 0) -> dict:
    key = jax.random.key(seed)
    ks = jax.random.split(key, 32)
    nrm = lambda k, shape, s: jax.random.normal(k, shape, jnp.float32) * s
    L = DEPTH
    return {
        "x": nrm(ks[0], (BATCH, SEQ, D_MODEL), 1.0),
        "norm_mix_g": 1.0 + nrm(ks[1], (L, D_MODEL), 0.02),
        "w_in": nrm(ks[2], (L, D_MODEL, D_IN), D_MODEL ** -0.5),
        "rw_mu": jax.random.uniform(ks[3], (L, RW_IN_WIDTH), jnp.float32, 0.0, 1.0),
        "rw_w0": jax.random.uniform(ks[4], (L, RW_WIDTH), jnp.float32, -6.5, -1.5),
        "rw_w2": nrm(ks[5], (L, RW_DECAY_LORA, RW_WIDTH), 0.1 * RW_DECAY_LORA ** -0.5),
        "rw_a0": nrm(ks[6], (L, RW_WIDTH), 0.1),
        "rw_a2": nrm(ks[7], (L, RW_AAA_LORA, RW_WIDTH), RW_AAA_LORA ** -0.5),
        "rw_g2": nrm(ks[8], (L, RW_GATE_LORA, RW_WIDTH), RW_GATE_LORA ** -0.5),
        "rw_k_k": 0.85 + nrm(ks[9], (L, RW_WIDTH), 0.02),
        "rw_k_a": 1.0 + nrm(ks[10], (L, RW_WIDTH), 0.02),
        "rw_r_k": nrm(ks[11], (L, RW_HEADS, RW_HEAD), 0.1),
        "rw_ln_g": 1.0 + nrm(ks[12], (L, RW_WIDTH), 0.02),
        "rw_ln_b": nrm(ks[13], (L, RW_WIDTH), 0.02),
        "da_lq1": nrm(ks[14], (L, DA_HALF_DIM), 0.1),
        "da_lk1": nrm(ks[15], (L, DA_HALF_DIM), 0.1),
        "da_lq2": nrm(ks[16], (L, DA_HALF_DIM), 0.1),
        "da_lk2": nrm(ks[17], (L, DA_HALF_DIM), 0.1),
        "da_subln_g": 1.0 + nrm(ks[18], (L, DA_VDIM), 0.02),
        "w_branch_a": nrm(ks[19], (L, DA_WIDTH, D_MODEL), DA_WIDTH ** -0.5),
        "w_branch_b": nrm(ks[20], (L, RW_WIDTH, D_MODEL), RW_WIDTH ** -0.5),
        "w_o": nrm(ks[21], (L, D_MODEL, D_MODEL), D_MODEL ** -0.5),
        "norm_ffn_g": 1.0 + nrm(ks[22], (L, D_MODEL), 0.02),
        "w_ff1": nrm(ks[23], (L, D_MODEL, D_FF), D_MODEL ** -0.5),
        "w_ff2": nrm(ks[24], (L, D_FF, D_MODEL), D_FF ** -0.5),
        "norm_final_g": 1.0 + nrm(ks[25], (D_MODEL,), 0.02),
    }


def reference(x, norm_mix_g, w_in, rw_mu, rw_w0, rw_w2, rw_a0, rw_a2, rw_g2, rw_k_k,
              rw_k_a, rw_r_k, rw_ln_g, rw_ln_b, da_lq1, da_lk1, da_lq2, da_lk2,
              da_subln_g, w_branch_a, w_branch_b, w_o, norm_ffn_g, w_ff1, w_ff2,
              norm_final_g):
    for l in range(DEPTH):
        lambda_init = 0.8 - 0.6 * math.exp(-0.3 * l)
        h = rms_norm(x, norm_mix_g[l])
        proj = h @ w_in[l]
        da_in, rw_in, gates = jnp.split(proj, [DA_IN_WIDTH, DA_IN_WIDTH + RW_IN_WIDTH], axis=-1)
        q, k, v = jnp.split(da_in, 3, axis=-1)
        y_a = diff_attention(q, k, v, da_lq1[l], da_lk1[l], da_lq2[l], da_lk2[l],
                             da_subln_g[l], lambda_init)
        y_b = rwkv7_time_mix(rw_in, rw_mu[l], rw_w0[l], rw_w2[l], rw_a0[l], rw_a2[l],
                             rw_g2[l], rw_k_k[l], rw_k_a[l], rw_r_k[l], rw_ln_g[l], rw_ln_b[l])
        gate_a, gate_b = jnp.split(gates, 2, axis=-1)
        merged = (jax.nn.sigmoid(gate_a) * (y_a @ w_branch_a[l])
                  + jax.nn.sigmoid(gate_b) * (y_b @ w_branch_b[l]))
        x = x + merged @ w_o[l]
        h = rms_norm(x, norm_ffn_g[l])
        x = x + jnp.square(jax.nn.relu(h @ w_ff1[l])) @ w_ff2[l]
    return rms_norm(x, norm_final_g)
```

```cpp
#define MK_ONE_LAUNCH 1
#include <hip/hip_runtime.h>
#include <cstdio>
#include <cstdint>
constexpr int NWAVES = 8;
constexpr int BATCH = 8, SEQ = 2048, D = 1024, M = BATCH * SEQ;
constexpr int D_IN = 5376, FF = 4096, RWW = 512, NLORA = 1536, KLORA = 256;
constexpr float NORM_EPS = 1e-6f, SUBLN_EPS = 1e-5f, GN_EPS = 64e-5f, LAMBDA_INIT = 0.2f;
constexpr size_t MiB = 1u << 20;
constexpr size_t WS_CTL = 0, CTL_ZERO_BYTES = 256 * 1024;
constexpr size_t CTL_SS1 = 65536, CTL_SS2 = 131072, CTL_CNT1 = 196608, CTL_CNT2 = 212992;
constexpr size_t WS_ROPE_C = 512 * 1024, WS_ROPE_S = 768 * 1024;
constexpr size_t WS_BON = 1 * MiB;
constexpr size_t WS_WIN = 2 * MiB;
constexpr size_t WS_WA = WS_WIN + (size_t)D_IN * D * 2;
constexpr size_t WS_WB = WS_WA + 1 * MiB;
constexpr size_t WS_WO = WS_WB + 1 * MiB;
constexpr size_t WS_W1 = WS_WO + 2 * MiB;
constexpr size_t WS_W2 = WS_W1 + 8 * MiB;
constexpr size_t WS_WL = WS_W2 + 8 * MiB;
static_assert(WS_WL + (size_t)NLORA * KLORA * 2 <= 34 * MiB, "weights");
constexpr size_t WS_XN = 34 * MiB;
constexpr size_t WS_DEC = WS_XN;
constexpr size_t WS_Q = 66 * MiB, WS_K = 82 * MiB, WS_V = 98 * MiB;
constexpr size_t WS_RKV = 114 * MiB;
constexpr size_t WS_WAG = 162 * MiB, WS_LIN = 170 * MiB;
constexpr size_t WS_Y = 162 * MiB;
constexpr size_t WS_AA = 178 * MiB, WS_GG = 194 * MiB;
constexpr size_t WS_O = 210 * MiB;
constexpr size_t WS_YA = 66 * MiB, WS_YB = 82 * MiB;
constexpr size_t WS_TMP = 114 * MiB;
constexpr size_t WS_MERGED = 210 * MiB;
constexpr size_t WS_H = 66 * MiB;
constexpr size_t WS_END = 244 * MiB;
constexpr int RING_OFF = 0, RING_BYTES = 131072;
constexpr int LDS_BYTES = 163840;

#include <hip/hip_runtime.h>
#include <cstdio>
#include <cstdint>
namespace pg8 {
#define PG8_LAS __attribute__((address_space(3)))
typedef unsigned short bf16_t;
typedef short bf16x8 __attribute__((ext_vector_type(8)));
typedef float f32x4 __attribute__((ext_vector_type(4)));
typedef unsigned u32x4 __attribute__((ext_vector_type(4)));
constexpr int BM = 256, BK = 64, HALF = 128, HTB = HALF * BK * 2  , STAGE_BYTES = 8 * HTB, NXCD = 8, WGM = 8;

__host__ __device__ __forceinline__ int lds_byte(int r, int c) { const int st = (r >> 4) * 2 + (c >> 5), rr = r & 15, cc = c & 31, ob = rr * 64 + cc * 2; return st * 1024 + (ob ^ (((ob >> 9) & 1) << 5)); }
__host__ __device__ __forceinline__ void stage_rc(int b, int& R, int& C) { const int st = b / 1024, sb = b % 1024, swz = sb ^ (((sb >> 9) & 1) << 5); R = (st >> 1) * 16 + swz / 64; C = (st & 1) * 32 + (swz % 64) / 2; }
__host__ __device__ __forceinline__ int perm32(int rho) { const int n = rho >> 4, i = rho & 15; return 8 * (i >> 2) + 4 * n + (i & 3); }

struct Unit { int pm, pn; };
struct Gemm { const bf16_t* A; const bf16_t* Bt; int M, N, K; };

struct StaticOrder {
    int nM, nN, nwg, G, c;
    __host__ __device__ void init(int M, int N, int G_, int c_) { nM = M / BM; nN = N / BM; nwg = nM * nN; G = G_; c = c_; }
    __host__ __device__ bool next(int i, Unit& u) const {
        const long L = (long)i * G + c; if (L >= nwg) return false;
        int wgid = (int)L; { const int q = nwg / NXCD, r = nwg % NXCD, xcd = wgid % NXCD, off = wgid / NXCD; wgid = (xcd < r ? xcd * (q + 1) : r * (q + 1) + (xcd - r) * q) + off; }
        const int nig = WGM * nN, gid = wgid / nig, fm = gid * WGM, gsz = (nM - fm) < WGM ? (nM - fm) : WGM;
        u.pm = fm + ((wgid % nig) % gsz); u.pn = (wgid % nig) / gsz; return true;
    }
    __device__ __forceinline__ void a_ready(const Unit&) const {}
    __device__ __forceinline__ void done(const Unit&) const {}
};

typedef float f32x2c_t __attribute__((ext_vector_type(2))); typedef __bf16 bf16x2c_t __attribute__((ext_vector_type(2)));
__device__ __forceinline__ unsigned cvt_pk_bf16(float lo, float hi) { f32x2c_t v = {lo, hi}; bf16x2c_t b = __builtin_convertvector(v, bf16x2c_t); return __builtin_bit_cast(unsigned, b); }
typedef float f32x2 __attribute__((ext_vector_type(2)));
__device__ __forceinline__ f32x2 gelu_pk(f32x2 v) {
    const f32x2 av = __builtin_elementwise_abs(v), d = av * 0.2316418882f + 1.0f;
    f32x2 t; t.x = __builtin_amdgcn_rcpf(d.x); t.y = __builtin_amdgcn_rcpf(d.y);
    f32x2 q = t * 0.5307027145f + (-0.7265760135f); q = q * t + 0.7107068705f; q = q * t + (-0.142248368f); q = q * t + 0.127414796f; q = q * t;
    const f32x2 s = (v * v) * (-0.72134752044f);
    f32x2 e; e.x = __builtin_amdgcn_exp2f(s.x); e.y = __builtin_amdgcn_exp2f(s.y);
    const f32x2 m = v * (q * e), r = v - m;
    f32x2 o; o.x = v.x < 0.f ? m.x : r.x; o.y = v.y < 0.f ? m.y : r.y; return o;
}

template <int ACT  > struct EpiBf16 {
    static constexpr int MIDK = 0; static constexpr bool PERM = true, AFTER_DRAIN = false; static_assert(ACT == 0 || ACT == 1, "EpiBf16: ACT is 0 (none) or 1 (gelu_pk)");
    bf16_t* O; int ldc; const float* bias; int split_cols; size_t split_stride; float scale0;
    __device__ __forceinline__ void operator()(const f32x4 (&acc)[2][2][4][2], const Unit& u, int wr, int wc, int fr, int fq) const {
        const int row0 = u.pm * BM + wr * 64 + fr; int colt = u.pn * BM; bf16_t* base = O;
        float sc = 1.f; if (split_cols) { const int t = colt / split_cols; base += (size_t)t * split_stride; colt -= t * split_cols; if (t == 0) sc = scale0; }
        const int col0 = colt + wc * 32 + 8 * fq, bcol0 = u.pn * BM + wc * 32 + 8 * fq;
        f32x4 bv[2][2];
#pragma unroll
        for (int bj = 0; bj < 2; ++bj)
#pragma unroll
            for (int n = 0; n < 2; ++n) bv[bj][n] = bias ? *(const f32x4*)(bias + bcol0 + bj * HALF + 4 * n) : (f32x4){0.f, 0.f, 0.f, 0.f};
#pragma unroll
        for (int ai = 0; ai < 2; ++ai)
#pragma unroll
            for (int m = 0; m < 4; ++m) { bf16_t* rowp = base + (size_t)(row0 + ai * HALF + m * 16) * ldc + col0;
#pragma unroll
                for (int bj = 0; bj < 2; ++bj) { f32x4 v0 = acc[ai][bj][m][0] + bv[bj][0], v1 = acc[ai][bj][m][1] + bv[bj][1];
                    if (ACT == 1) { f32x2 a = gelu_pk((f32x2){v0[0], v0[1]}), b = gelu_pk((f32x2){v0[2], v0[3]}), c = gelu_pk((f32x2){v1[0], v1[1]}), d = gelu_pk((f32x2){v1[2], v1[3]});
                        v0 = (f32x4){a.x, a.y, b.x, b.y}; v1 = (f32x4){c.x, c.y, d.x, d.y}; }
                    v0 = v0 * sc; v1 = v1 * sc; u32x4 w; w.x = cvt_pk_bf16(v0[0], v0[1]); w.y = cvt_pk_bf16(v0[2], v0[3]); w.z = cvt_pk_bf16(v1[0], v1[1]); w.w = cvt_pk_bf16(v1[2], v1[3]);
                    *(u32x4*)(rowp + bj * HALF) = w; } }
    }
};
typedef unsigned u32x2 __attribute__((ext_vector_type(2)));
__device__ __forceinline__ float bf_lo(unsigned w) { return __builtin_bit_cast(float, w << 16); }
__device__ __forceinline__ float bf_hi(unsigned w) { return __builtin_bit_cast(float, w & 0xffff0000u); }
__device__ __forceinline__ u32x4 pack8(f32x4 v0, f32x4 v1) { u32x4 w; w.x = cvt_pk_bf16(v0[0], v0[1]); w.y = cvt_pk_bf16(v0[2], v0[3]); w.z = cvt_pk_bf16(v1[0], v1[1]); w.w = cvt_pk_bf16(v1[2], v1[3]); return w; }
__device__ __forceinline__ float sigmoidf_(float x) { return __builtin_amdgcn_rcpf(1.0f + __expf(-x)); }
template <class F> struct EpiRow8 {
    static constexpr int MIDK = 0; static constexpr bool PERM = true, AFTER_DRAIN = false;
    F f;
    __device__ __forceinline__ void operator()(const f32x4 (&acc)[2][2][4][2], const Unit& u, int wr, int wc, int fr, int fq) const {
        const int row0 = u.pm * BM + wr * 64 + fr, c0 = wc * 32 + 8 * fq;
#pragma unroll
        for (int ai = 0; ai < 2; ++ai)
#pragma unroll
            for (int m = 0; m < 4; ++m) { const int row = row0 + ai * HALF + m * 16;
#pragma unroll
                for (int bj = 0; bj < 2; ++bj) { f(u.pn, row, c0 + bj * HALF, acc[ai][bj][m][0], acc[ai][bj][m][1]); if (F::FENCE) asm volatile("" ::: "memory"); } }
    }
};
constexpr float ATT_C2 = 0.125f * 1.4426950408889634f;
struct FProj {
    static constexpr bool FENCE = false;
    unsigned char* ws; bf16_t* GATES;
    __device__ __forceinline__ void operator()(int pn, int row, int cu, f32x4 v0, f32x4 v1) const {
        if (pn < 4) {
            const int sh = cu >> 6, j = (cu & 63) >> 3, pos = row & 2047;
            const f32x4 c = *(const f32x4*)((const float*)(ws + WS_ROPE_C) + pos * 32 + 4 * j), s = *(const f32x4*)((const float*)(ws + WS_ROPE_S) + pos * 32 + 4 * j);
            const float sc = pn < 2 ? ATT_C2 : 1.0f;
            const f32x4 o1 = (v0 * c - v1 * s) * sc, o2 = (v1 * c + v0 * s) * sc;
            bf16_t* dst = (bf16_t*)(ws + (pn < 2 ? WS_Q : WS_K)) + (size_t)row * 512 + (pn & 1) * 256 + sh * 64 + 4 * j;
            u32x2 w1, w2; w1.x = cvt_pk_bf16(o1[0], o1[1]); w1.y = cvt_pk_bf16(o1[2], o1[3]); w2.x = cvt_pk_bf16(o2[0], o2[1]); w2.y = cvt_pk_bf16(o2[2], o2[3]);
            *(u32x2*)dst = w1; *(u32x2*)(dst + 32) = w2;
        } else if (pn < 13) {
            size_t off; int pitch, col;
            if (pn < 6) { off = WS_V; pitch = 512; col = (pn - 4) * 256; }
            else if (pn < 12) { off = WS_RKV; pitch = 1536; col = (pn - 6) * 256; }
            else { off = WS_WAG; pitch = 256; col = 0; }
            *(u32x4*)((bf16_t*)(ws + off) + (size_t)row * pitch + col + cu) = pack8(v0, v1);
        } else *(u32x4*)(GATES + (size_t)row * 2048 + (pn - 13) * 256 + cu) = pack8(v0, v1);
    }
};
struct FLora {
    static constexpr bool FENCE = false;
    unsigned char* ws; const float *w0, *a0;
    __device__ __forceinline__ void operator()(int pn, int row, int cu, f32x4 v0, f32x4 v1) const {
        const int c = (pn & 1) * 256 + cu;
        if (pn < 2) {
            const f32x4 b0 = *(const f32x4*)(w0 + c), b1 = *(const f32x4*)(w0 + c + 4);
            float* dst = (float*)(ws + WS_DEC) + (size_t)row * 512 + c; *(f32x4*)dst = v0 + b0; *(f32x4*)(dst + 4) = v1 + b1;
        } else if (pn < 4) {
            const f32x4 b0 = *(const f32x4*)(a0 + c), b1 = *(const f32x4*)(a0 + c + 4);
            *(u32x4*)((bf16_t*)(ws + WS_AA) + (size_t)row * 512 + c) = pack8(v0 + b0, v1 + b1);
        } else *(u32x4*)((bf16_t*)(ws + WS_GG) + (size_t)row * 512 + c) = pack8(v0, v1);
    }
};
struct EpiMerge {
    static constexpr int MIDK = 8; static constexpr bool PERM = true, AFTER_DRAIN = false;
    const bf16_t* GATES; bf16_t* MERGED;
    static __device__ __forceinline__ float ratio_(float ga, float gb) { return (1.0f + __expf(-gb)) * __builtin_amdgcn_rcpf(1.0f + __expf(-ga)); }
    __device__ __forceinline__ void mid(f32x4 (&acc)[2][2][4][2], const Unit& u, int wr, int wc, int fr, int fq) const {
        int fr_ = fr; asm volatile("" : "+v"(fr_));
        const bf16_t* gp0 = GATES + (size_t)(u.pm * BM + wr * 64 + fr_) * 2048 + u.pn * BM + wc * 32 + 8 * fq;
#pragma unroll
        for (int ai = 0; ai < 2; ++ai)
#pragma unroll
            for (int m = 0; m < 4; ++m)
#pragma unroll
                for (int bj = 0; bj < 2; ++bj) { const bf16_t* gp = gp0 + (size_t)(ai * HALF + m * 16) * 2048 + bj * HALF;
                    const u32x4 ga = *(const u32x4*)gp, gb = *(const u32x4*)(gp + 1024);
                    f32x4& v0 = acc[ai][bj][m][0]; f32x4& v1 = acc[ai][bj][m][1];
                    v0[0] *= ratio_(bf_lo(ga.x), bf_lo(gb.x)); v0[1] *= ratio_(bf_hi(ga.x), bf_hi(gb.x)); v0[2] *= ratio_(bf_lo(ga.y), bf_lo(gb.y)); v0[3] *= ratio_(bf_hi(ga.y), bf_hi(gb.y));
                    v1[0] *= ratio_(bf_lo(ga.z), bf_lo(gb.z)); v1[1] *= ratio_(bf_hi(ga.z), bf_hi(gb.z)); v1[2] *= ratio_(bf_lo(ga.w), bf_lo(gb.w)); v1[3] *= ratio_(bf_hi(ga.w), bf_hi(gb.w));
                    asm volatile("" ::: "memory"); }
    }
    __device__ __forceinline__ void operator()(const f32x4 (&acc)[2][2][4][2], const Unit& u, int wr, int wc, int fr, int fq) const {
        const int row0 = u.pm * BM + wr * 64 + fr, c0 = u.pn * BM + wc * 32 + 8 * fq;
#pragma unroll
        for (int ai = 0; ai < 2; ++ai)
#pragma unroll
            for (int m = 0; m < 4; ++m) { const int row = row0 + ai * HALF + m * 16;
#pragma unroll
                for (int bj = 0; bj < 2; ++bj) { const u32x4 g = *(const u32x4*)(GATES + (size_t)row * 2048 + 1024 + c0 + bj * HALF);
                    f32x4 v0 = acc[ai][bj][m][0], v1 = acc[ai][bj][m][1];
                    v0[0] *= sigmoidf_(bf_lo(g.x)); v0[1] *= sigmoidf_(bf_hi(g.x)); v0[2] *= sigmoidf_(bf_lo(g.y)); v0[3] *= sigmoidf_(bf_hi(g.y));
                    v1[0] *= sigmoidf_(bf_lo(g.z)); v1[1] *= sigmoidf_(bf_hi(g.z)); v1[2] *= sigmoidf_(bf_lo(g.w)); v1[3] *= sigmoidf_(bf_hi(g.w));
                    *(u32x4*)(MERGED + (size_t)row * 1024 + c0 + bj * HALF) = pack8(v0, v1); } }
    }
};
struct FRes {
    static constexpr bool FENCE = false;
    const float* base; float* out;
    __device__ __forceinline__ void operator()(int pn, int row, int cu, f32x4 v0, f32x4 v1) const {
        const size_t off = (size_t)row * 1024 + pn * 256 + cu; const f32x4 b0 = *(const f32x4*)(base + off), b1 = *(const f32x4*)(base + off + 4);
        *(f32x4*)(out + off) = b0 + v0; *(f32x4*)(out + off + 4) = b1 + v1;
    }
};
struct FRelu2 {
    static constexpr bool FENCE = false;
    bf16_t* H;
    __device__ __forceinline__ void operator()(int pn, int row, int cu, f32x4 v0, f32x4 v1) const {
        f32x4 r0, r1;
#pragma unroll
        for (int e = 0; e < 4; ++e) { const float a = __builtin_fmaxf(v0[e], 0.f), b = __builtin_fmaxf(v1[e], 0.f); r0[e] = a * a; r1[e] = b * b; }
        *(u32x4*)(H + (size_t)row * 4096 + pn * 256 + cu) = pack8(r0, r1);
    }
};

__device__ __forceinline__ float xsum_fq(float x) {
    { auto r = __builtin_amdgcn_permlane16_swap(__builtin_bit_cast(unsigned, x), __builtin_bit_cast(unsigned, x), false, false); const unsigned a = r[0], b = r[1]; x = __builtin_bit_cast(float, a) + __builtin_bit_cast(float, b); }
    { auto r = __builtin_amdgcn_permlane32_swap(__builtin_bit_cast(unsigned, x), __builtin_bit_cast(unsigned, x), false, false); const unsigned a = r[0], b = r[1]; x = __builtin_bit_cast(float, a) + __builtin_bit_cast(float, b); }
    return x;
}
template <int MODE> struct EpiResNorm {
    static constexpr int MIDK = 0; static constexpr bool PERM = true, AFTER_DRAIN = false;
    const float* base; float* out; bf16_t* xn; const float* g; float* ss; unsigned* cnt; float eps;
    __device__ __forceinline__ void operator()(f32x4 (&acc)[2][2][4][2], const Unit& u, int wr, int wc, int fr, int fq) const {
        const int row0 = u.pm * BM + wr * 64 + fr, c0 = u.pn * BM + wc * 32 + 8 * fq;
#pragma unroll
        for (int ai = 0; ai < 2; ++ai)
#pragma unroll
            for (int m = 0; m < 4; ++m) { const int row = row0 + ai * HALF + m * 16; float s = 0.f;
#pragma unroll
                for (int bj = 0; bj < 2; ++bj) { const size_t off = (size_t)row * 1024 + c0 + bj * HALF; const f32x4 b0 = *(const f32x4*)(base + off), b1 = *(const f32x4*)(base + off + 4);
                    f32x4& v0 = acc[ai][bj][m][0]; f32x4& v1 = acc[ai][bj][m][1]; v0 += b0; v1 += b1;
                    if (MODE == 0) { *(f32x4*)(out + off) = v0; *(f32x4*)(out + off + 4) = v1; }
                    s += (v0[0] * v0[0] + v0[1] * v0[1]) + (v0[2] * v0[2] + v0[3] * v0[3]) + (v1[0] * v1[0] + v1[1] * v1[1]) + (v1[2] * v1[2] + v1[3] * v1[3]); }
                s = xsum_fq(s);
                if (fq == 0) __hip_atomic_fetch_add(ss + row, s, __ATOMIC_RELAXED, __HIP_MEMORY_SCOPE_AGENT);
                if (m & 1) asm volatile("" ::: "memory"); }
        asm volatile("s_waitcnt vmcnt(0)" ::: "memory");
        unsigned* c_ = cnt + 64 * u.pm;
        if (fr == 0 && fq == 0) __hip_atomic_fetch_add(c_, 1u, __ATOMIC_RELAXED, __HIP_MEMORY_SCOPE_AGENT);
        { unsigned spins = 0; while ((unsigned)__builtin_amdgcn_readfirstlane(__hip_atomic_load(c_, __ATOMIC_RELAXED, __HIP_MEMORY_SCOPE_AGENT)) < 32u && ++spins < (1u << 22)) __builtin_amdgcn_s_sleep(2); }
        asm volatile("" ::: "memory");
#pragma unroll
        for (int ai = 0; ai < 2; ++ai)
#pragma unroll
            for (int m = 0; m < 4; ++m) { const int row = row0 + ai * HALF + m * 16;
                const float rstd = 1.0f / sqrtf(__hip_atomic_load(ss + row, __ATOMIC_RELAXED, __HIP_MEMORY_SCOPE_AGENT) * (1.0f / 1024.0f) + eps);
#pragma unroll
                for (int bj = 0; bj < 2; ++bj) { const size_t off = (size_t)row * 1024 + c0 + bj * HALF; const f32x4 g0 = *(const f32x4*)(g + c0 + bj * HALF), g1 = *(const f32x4*)(g + c0 + bj * HALF + 4);
                    const f32x4 o0 = acc[ai][bj][m][0] * rstd * g0, o1 = acc[ai][bj][m][1] * rstd * g1;
                    if (MODE == 0) *(u32x4*)(xn + off) = pack8(o0, o1); else { *(f32x4*)(out + off) = o0; *(f32x4*)(out + off + 4) = o1; } }
                if (m & 1) asm volatile("" ::: "memory"); }
    }
};
template <class Epi, class Sched, bool ALIGN_EPI = false, bool SP2 = false>
__device__ __forceinline__ void gemm_phase(PG8_LAS unsigned char* lds, const Gemm g, const Sched& S, const Epi& E) {
    int tid_ = threadIdx.x; asm volatile("" : "+v"(tid_));
    const int tid = tid_, wid = __builtin_amdgcn_readfirstlane(tid >> 6), lane = tid & 63, wr = wid >> 2, wc = wid & 3, fr = lane & 15, fq = lane >> 4;
    const int K = g.K, nt = K / BK;
    unsigned voffA[2], voffB[2];
#pragma unroll
    for (int i = 0; i < 2; ++i) { int R, C; stage_rc(tid * 16 + i * 8192, R, C); const int Rb = Epi::PERM ? ((R & ~31) + perm32(R & 31)) : R;
        voffA[i] = (unsigned)(R * K + C) * 2u; voffB[i] = (unsigned)(Rb * K + C) * 2u; }
    const size_t kstep = (size_t)(BK * 2);
    const size_t hstep = (size_t)HALF * K * 2;
    const size_t tstep = 2 * hstep;
    const unsigned ldsw = (unsigned)wid * 1024u;
    const int aoff = lds_byte(wr * 64 + fr, fq * 8), boff = lds_byte(wc * 32 + fr, fq * 8);
#define PG8_SA(b, h) (((b) * 2 + (h)) * HTB)
#define PG8_SB(b, h) ((4 + (b) * 2 + (h)) * HTB)
#define PG8_STAGE(bufoff, gbase, voff) do { _Pragma("unroll") for (int _i = 0; _i < 2; ++_i) \
        __builtin_amdgcn_global_load_lds((const unsigned*)((const char*)(gbase) + (voff)[_i]), (PG8_LAS unsigned*)(lds + (bufoff) + ldsw + _i * 8192), 16, 0, 0); } while (0)
#define PG8_LDA(dst, b, h) do { _Pragma("unroll") for (int m = 0; m < 4; ++m) _Pragma("unroll") for (int k = 0; k < 2; ++k) dst[m][k] = *(const PG8_LAS bf16x8*)(lds + PG8_SA(b, h) + aoff + m * 2048 + k * 1024); } while (0)
#define PG8_LDB(dst, b, h) do { _Pragma("unroll") for (int n = 0; n < 2; ++n) _Pragma("unroll") for (int k = 0; k < 2; ++k) dst[n][k] = *(const PG8_LAS bf16x8*)(lds + PG8_SB(b, h) + boff + n * 2048 + k * 1024); } while (0)
#define PG8_MMA(ai, bj, At, Bt) do { __builtin_amdgcn_s_setprio(1); _Pragma("unroll") for (int m = 0; m < 4; ++m) _Pragma("unroll") for (int n = 0; n < 2; ++n) _Pragma("unroll") for (int k = 0; k < 2; ++k) \
        acc[ai][bj][m][n] = __builtin_amdgcn_mfma_f32_16x16x32_bf16(Bt[n][k], At[m][k], acc[ai][bj][m][n], 0, 0, 0); __builtin_amdgcn_s_setprio(0); } while (0)
#define PG8_WAIT_V(n) asm volatile("s_waitcnt vmcnt(" #n ")" ::: "memory")
#define PG8_WAIT_L(n) asm volatile("s_waitcnt lgkmcnt(" #n ")" ::: "memory")
#define PG8_BAR __builtin_amdgcn_s_barrier()
#define PG8_SCHED __builtin_amdgcn_sched_barrier(0)
    Unit cur, nxt; int ui = 0;
    if (!S.next(0, cur)) return;
    f32x4 acc[2][2][4][2];
#pragma unroll
    for (int a = 0; a < 2; ++a)
#pragma unroll
        for (int b = 0; b < 2; ++b)
#pragma unroll
            for (int m = 0; m < 4; ++m)
#pragma unroll
                for (int n = 0; n < 2; ++n) acc[a][b][m][n] = (f32x4){0.f, 0.f, 0.f, 0.f};
    bf16x8 At[4][2], B0[2][2], B1[2][2];
    const char* cA = (const char*)g.A + (size_t)cur.pm * tstep; const char* cB = (const char*)g.Bt + (size_t)cur.pn * tstep;
    S.a_ready(cur);
    if constexpr (SP2) {
        PG8_STAGE(PG8_SB(0, 0), cB, voffB); PG8_STAGE(PG8_SB(0, 1), cB + hstep, voffB); PG8_STAGE(PG8_SA(0, 0), cA, voffA); PG8_STAGE(PG8_SA(0, 1), cA + hstep, voffA);
        if (wr == 1) PG8_BAR;
        PG8_WAIT_V(2); PG8_BAR;
        PG8_STAGE(PG8_SB(1, 0), cB + kstep, voffB); PG8_STAGE(PG8_SA(1, 0), cA + kstep, voffA); PG8_STAGE(PG8_SB(1, 1), cB + hstep + kstep, voffB);
        PG8_WAIT_V(6); PG8_BAR;
    } else {
        PG8_STAGE(PG8_SB(0, 0), cB, voffB); PG8_STAGE(PG8_SA(0, 0), cA, voffA); PG8_STAGE(PG8_SB(0, 1), cB + hstep, voffB); PG8_STAGE(PG8_SA(0, 1), cA + hstep, voffA);
        if (wr == 1) PG8_BAR;
        PG8_WAIT_V(4); PG8_BAR;
        PG8_STAGE(PG8_SB(1, 0), cB + kstep, voffB); PG8_STAGE(PG8_SA(1, 0), cA + kstep, voffA); PG8_STAGE(PG8_SB(1, 1), cB + hstep + kstep, voffB);
        PG8_WAIT_V(6); PG8_BAR;
    }
    for (;;) {
        const bool has_next = S.next(ui + 1, nxt);
        const char* nA = has_next ? (const char*)g.A + (size_t)nxt.pm * tstep : cA; const char* nB = has_next ? (const char*)g.Bt + (size_t)nxt.pn * tstep : cB;
        for (int t = 0; t < nt; t += 2) {
            if constexpr (Epi::MIDK > 0) { if (t == Epi::MIDK) E.mid(acc, cur, wr, wc, fr, fq); }
            const bool last = (t == nt - 2);
            const char* a1 = cA + (size_t)(t + 1) * kstep;
            const char* a2 = last ? nA : cA + (size_t)(t + 2) * kstep; const char* b2 = last ? nB : cB + (size_t)(t + 2) * kstep;
            const char* a3 = a2 + kstep; const char* b3 = b2 + kstep;
            if (last && has_next) S.a_ready(nxt);
            if constexpr (SP2) {
            PG8_LDB(B0, 0, 0); PG8_LDB(B1, 0, 1); PG8_SCHED; PG8_LDA(At, 0, 0); PG8_STAGE(PG8_SA(1, 1), a1 + hstep, voffA);
            PG8_WAIT_V(8); PG8_WAIT_L(0); PG8_BAR; PG8_MMA(0, 0, At, B0); PG8_MMA(0, 1, At, B1); PG8_BAR; PG8_SCHED;
            PG8_LDA(At, 0, 1); PG8_STAGE(PG8_SB(0, 0), b2, voffB); PG8_STAGE(PG8_SB(0, 1), b2 + hstep, voffB); PG8_STAGE(PG8_SA(0, 0), a2, voffA);
            PG8_WAIT_V(8); PG8_WAIT_L(0); PG8_BAR; PG8_MMA(1, 0, At, B0); PG8_MMA(1, 1, At, B1); PG8_BAR; PG8_SCHED;
            PG8_LDB(B0, 1, 0); PG8_LDB(B1, 1, 1); PG8_SCHED; PG8_LDA(At, 1, 0); PG8_STAGE(PG8_SA(0, 1), a2 + hstep, voffA);
            PG8_WAIT_V(8); PG8_WAIT_L(0); PG8_BAR; PG8_MMA(0, 0, At, B0); PG8_MMA(0, 1, At, B1); PG8_BAR; PG8_SCHED;
            PG8_LDA(At, 1, 1); PG8_STAGE(PG8_SB(1, 0), b3, voffB); PG8_STAGE(PG8_SB(1, 1), b3 + hstep, voffB); PG8_STAGE(PG8_SA(1, 0), a3, voffA);
            PG8_WAIT_V(8); PG8_WAIT_L(0); PG8_BAR; PG8_MMA(1, 0, At, B0); PG8_MMA(1, 1, At, B1); PG8_BAR; PG8_SCHED;
            } else {
            PG8_LDB(B0, 0, 0); PG8_SCHED; PG8_LDA(At, 0, 0); PG8_STAGE(PG8_SA(1, 1), a1 + hstep, voffA);
            PG8_WAIT_L(8); PG8_BAR; PG8_WAIT_L(0); PG8_MMA(0, 0, At, B0); PG8_BAR; PG8_SCHED;
            PG8_LDB(B1, 0, 1); PG8_STAGE(PG8_SB(0, 0), b2, voffB);
            PG8_BAR; PG8_WAIT_L(0); PG8_MMA(0, 1, At, B1); PG8_BAR;
            PG8_LDA(At, 0, 1); PG8_STAGE(PG8_SA(0, 0), a2, voffA);
            PG8_BAR; PG8_WAIT_L(0); PG8_MMA(1, 0, At, B0); PG8_BAR; PG8_SCHED;
            PG8_STAGE(PG8_SB(0, 1), b2 + hstep, voffB);
            PG8_WAIT_V(6); PG8_BAR; PG8_MMA(1, 1, At, B1); PG8_BAR;
            PG8_LDB(B0, 1, 0); PG8_SCHED; PG8_LDA(At, 1, 0); PG8_STAGE(PG8_SA(0, 1), a2 + hstep, voffA);
            PG8_WAIT_L(8); PG8_BAR; PG8_WAIT_L(0); PG8_MMA(0, 0, At, B0); PG8_BAR; PG8_SCHED;
            PG8_LDB(B1, 1, 1); PG8_STAGE(PG8_SB(1, 0), b3, voffB);
            PG8_BAR; PG8_WAIT_L(0); PG8_MMA(0, 1, At, B1); PG8_BAR;
            PG8_LDA(At, 1, 1); PG8_STAGE(PG8_SA(1, 0), a3, voffA);
            PG8_BAR; PG8_WAIT_L(0); PG8_MMA(1, 0, At, B0); PG8_BAR; PG8_SCHED;
            PG8_STAGE(PG8_SB(1, 1), b3 + hstep, voffB);
            PG8_WAIT_V(6); PG8_BAR; PG8_MMA(1, 1, At, B1); PG8_BAR;
            }
        }
        if constexpr (ALIGN_EPI) { if (wr == 0) PG8_BAR; }
        if constexpr (!Epi::AFTER_DRAIN) { E(acc, cur, wr, wc, fr, fq); S.done(cur); }
        if (!has_next) break;
#pragma unroll
        for (int a = 0; a < 2; ++a)
#pragma unroll
            for (int b = 0; b < 2; ++b)
#pragma unroll
                for (int m = 0; m < 4; ++m)
#pragma unroll
                    for (int n = 0; n < 2; ++n) acc[a][b][m][n] = (f32x4){0.f, 0.f, 0.f, 0.f};
        cur = nxt; cA = nA; cB = nB; ++ui;
        if constexpr (ALIGN_EPI) { if (wr == 1) PG8_BAR; }
    }
    PG8_WAIT_V(0);
    if constexpr (!ALIGN_EPI) { if (wr == 0) PG8_BAR; }
    PG8_BAR;
    if constexpr (Epi::AFTER_DRAIN) { E.fused(acc, cur, wr, wc, fr, fq, lds, wid, lane); S.done(cur); }
#undef PG8_SA
#undef PG8_SB
#undef PG8_STAGE
#undef PG8_LDA
#undef PG8_LDB
#undef PG8_MMA
#undef PG8_WAIT_V
#undef PG8_WAIT_L
#undef PG8_BAR
#undef PG8_SCHED
}
}

#ifndef PG8_SP2
#define PG8_SP2 true
#endif
#ifndef PG8_ALIGN
#define PG8_ALIGN true
#endif
#include <hip/hip_bf16.h>
#include <cmath>
namespace attn_body {
using bf16=__hip_bfloat16;
using bf16x8=__attribute__((ext_vector_type(8)))short;
using s16x4=__attribute__((ext_vector_type(4)))short;
using f32x16=__attribute__((ext_vector_type(16)))float;
using u32x4=__attribute__((ext_vector_type(4)))unsigned;
constexpr int SEQ=2048,D=64,QP=512,KP=512,VP=512,OP=1024;
constexpr int NW=8,QBLK=32,QB=QBLK*NW,KVBLK=64,NQB=SEQ/QB;
constexpr int ATTN_UNIT_ROWS=QB;
__device__ __forceinline__ int crow(int r,int hi){return (r&3)+8*(r>>2)+4*hi;}
#define SBAR() __builtin_amdgcn_sched_barrier(0)
__device__ __forceinline__ void cmask(f32x16&p0,f32x16&p1,int jb,int wchunk,int){
  if(jb>wchunk){ const float NEG=-INFINITY;
    #pragma unroll
    for(int r=0;r<16;++r){p0[r]=NEG;p1[r]=NEG;} }
}

constexpr int NSLOT=3, SLOTB=8192;
constexpr int LDS_K=0, LDS_V=NSLOT*SLOTB, LDS_WS=2*NSLOT*SLOTB, LDS_OST=LDS_WS+NW*64*4, LDS_BYTES=LDS_OST+NW*4096;
constexpr float C2=0.125f*1.4426950408889634f;
__device__ __forceinline__ void glds16(const void*gsrc,unsigned lds_dst){unsigned keep;
  asm volatile("s_mov_b32 %0, m0\n\ts_mov_b32 m0, %2\n\ts_nop 0\n\tglobal_load_lds_dwordx4 %1, off\n\ts_mov_b32 m0, %0":"=&s"(keep):"v"(gsrc),"s"(lds_dst):"memory");}
__device__ __forceinline__ float max3f(float a,float b,float c){float r;asm("v_max3_f32 %0, %1, %2, %3":"=v"(r):"v"(a),"v"(b),"v"(c));return r;}
__device__ __forceinline__ float max2f(float a,float b){float r;asm("v_max_f32_e32 %0, %1, %2":"=v"(r):"v"(a),"v"(b));return r;}
__device__ __forceinline__ float fadd_s(float a,float b){float r;asm("v_add_f32_e32 %0, %1, %2":"=v"(r):"v"(a),"v"(b));return r;}
__device__ __forceinline__ float fsub_s(float a,float b){float r;asm("v_sub_f32_e32 %0, %1, %2":"=v"(r):"v"(a),"v"(b));return r;}
typedef float f32x2_t __attribute__((ext_vector_type(2))); typedef __bf16 bf16x2_t __attribute__((ext_vector_type(2)));
__device__ __forceinline__ unsigned cvtpk_s(float lo,float hi){f32x2_t v={lo,hi};bf16x2_t b=__builtin_convertvector(v,bf16x2_t);return __builtin_bit_cast(unsigned,b);}
#define WAIT_BAR(N) asm volatile("s_waitcnt vmcnt(" #N ") lgkmcnt(0)\n\ts_barrier":::"memory")

__device__ __forceinline__ void qkt(f32x16&p0,f32x16&p1,const char*Kslot,const bf16x8*qr,const f32x16&negm,int r32,int hi){
  const char*kb=Kslot+hi*1024+r32*16;
  #pragma unroll
  for(int d0=0;d0<4;++d0){
    const bf16x8 b0=*reinterpret_cast<const bf16x8*>(kb+d0*2048);
    const bf16x8 b1=*reinterpret_cast<const bf16x8*>(kb+d0*2048+512);
    if(d0==0){p0=__builtin_amdgcn_mfma_f32_32x32x16_bf16(b0,qr[0],negm,0,0,0);p1=__builtin_amdgcn_mfma_f32_32x32x16_bf16(b1,qr[0],negm,0,0,0);}
    else{p0=__builtin_amdgcn_mfma_f32_32x32x16_bf16(b0,qr[d0],p0,0,0,0);p1=__builtin_amdgcn_mfma_f32_32x32x16_bf16(b1,qr[d0],p1,0,0,0);}}
}
typedef __attribute__((address_space(3))) const char* lds_cptr;
typedef short v4i16_t __attribute__((ext_vector_type(4)));
__device__ __forceinline__ void kload8(bf16x8*kf,lds_cptr kp){
  kf[0]=*(const __attribute__((address_space(3))) bf16x8*)(kp);      kf[1]=*(const __attribute__((address_space(3))) bf16x8*)(kp+512);
  kf[2]=*(const __attribute__((address_space(3))) bf16x8*)(kp+2048); kf[3]=*(const __attribute__((address_space(3))) bf16x8*)(kp+2560);
  kf[4]=*(const __attribute__((address_space(3))) bf16x8*)(kp+4096); kf[5]=*(const __attribute__((address_space(3))) bf16x8*)(kp+4608);
  kf[6]=*(const __attribute__((address_space(3))) bf16x8*)(kp+6144); kf[7]=*(const __attribute__((address_space(3))) bf16x8*)(kp+6656);
}
__device__ __forceinline__ void kload2(bf16x8*kf,lds_cptr kp,int j){ kf[2*j]=*(const __attribute__((address_space(3))) bf16x8*)(kp+j*2048); kf[2*j+1]=*(const __attribute__((address_space(3))) bf16x8*)(kp+j*2048+512); }
__device__ __forceinline__ s16x4 vtr(lds_cptr p){ return __builtin_bit_cast(s16x4,__builtin_amdgcn_ds_read_tr16_b64_v4i16((__attribute__((address_space(3))) v4i16_t*)p)); }
__device__ __forceinline__ float rowmax(const f32x16&p0,const f32x16&p1){
  float a=max3f(p0[0],p0[1],p1[0]),b=max3f(p0[2],p0[3],p1[1]);a=max3f(a,p1[2],p1[3]);
  #pragma unroll
  for(int r=4;r<16;r+=4){a=max3f(a,p0[r],p0[r+1]);b=max3f(b,p0[r+2],p0[r+3]);a=max3f(a,p1[r],p1[r+1]);b=max3f(b,p1[r+2],p1[r+3]);}
  const float m=max2f(a,b);
  auto rr=__builtin_amdgcn_permlane32_swap(__float_as_uint(m),__float_as_uint(m),false,false);
  return max2f(__uint_as_float(rr[0]),__uint_as_float(rr[1]));
}
__device__ __forceinline__ void pv(f32x16*o,int vb,bf16x8 pa0,bf16x8 pa1,bf16x8 pa2,bf16x8 pa3){
  #pragma unroll
  for(int d0=0;d0<2;++d0){s16x4 lo[4],hi[4];
    #pragma unroll
    for(int ks=0;ks<4;++ks){
      asm volatile("ds_read_b64_tr_b16 %0,%1 offset:%c2":"=&v"(lo[ks]):"v"(vb),"i"(d0*4096+ks*1024):"memory");
      asm volatile("ds_read_b64_tr_b16 %0,%1 offset:%c2":"=&v"(hi[ks]):"v"(vb),"i"(d0*4096+ks*1024+512):"memory");}
    asm volatile("s_waitcnt lgkmcnt(0)":::"memory");SBAR();
    #define PK(k) (bf16x8){lo[k][0],lo[k][1],lo[k][2],lo[k][3],hi[k][0],hi[k][1],hi[k][2],hi[k][3]}
    o[d0]=__builtin_amdgcn_mfma_f32_32x32x16_bf16(pa0,PK(0),o[d0],0,0,0);
    o[d0]=__builtin_amdgcn_mfma_f32_32x32x16_bf16(pa1,PK(1),o[d0],0,0,0);
    o[d0]=__builtin_amdgcn_mfma_f32_32x32x16_bf16(pa2,PK(2),o[d0],0,0,0);
    o[d0]=__builtin_amdgcn_mfma_f32_32x32x16_bf16(pa3,PK(3),o[d0],0,0,0);
    #undef PK
  }
}

#ifndef ATTN_STORE16
#define ATTN_STORE16(p,v) (*(u32x4*)(p)=(v))
#endif
template<int THRL> __device__ __forceinline__ void attn_unit(int b,int qcol,int kcol,int vcol,int ocol,int qb,const bf16*Q,const bf16*__restrict__ K,const bf16*__restrict__ V,bf16*O,char*shm){
  const int tid=threadIdx.x,lane=tid&63,r32=lane&31,hi=lane>>5; const int wid=__builtin_amdgcn_readfirstlane(tid>>6);
  const long rowbase=(long)b*SEQ; const int q0=qb*QB;
  const bf16*Qw=Q+(rowbase+q0+wid*QBLK)*QP+qcol;
  const bf16*Kh=K+rowbase*KP+kcol,*Vh=V+rowbase*VP+vcol;
  const unsigned lds0=(unsigned)(uintptr_t)shm;
  float*wsf=(float*)(shm+LDS_WS)+wid*64;
  const bf16*ksrc=Kh+(long)lane*KP+wid*8;
  const bf16*vsrc=Vh+(long)(16*(wid&3)+(lane>>2))*VP+(wid>>2)*32+(lane&3)*8;
  const unsigned kdst=lds0+LDS_K+wid*1024, vdst=lds0+LDS_V+wid*1024;
  #define DMA_K(t,slot) glds16(ksrc+(long)(t)*KVBLK*KP,(unsigned)__builtin_amdgcn_readfirstlane(kdst+(slot)))
  #define DMA_V(t,slot) glds16(vsrc+(long)(t)*KVBLK*VP,(unsigned)__builtin_amdgcn_readfirstlane(vdst+(slot)))
  const int vb0=(int)(lds0+LDS_V)+((lane>>4)&1)*32+(lane&3)*8+(4*hi+((lane&15)>>2))*64;
  const char*Kbase=shm+LDS_K; bf16x8 kf[8];
  const lds_cptr shm3=(lds_cptr)shm; const lds_cptr kp0=shm3+LDS_K+hi*1024+r32*16; const lds_cptr vp0=shm3+LDS_V+((lane>>4)&1)*32+(lane&3)*8+(4*hi+((lane&15)>>2))*64;
  const int NT=(q0+QB)/KVBLK;
  DMA_K(0,0);DMA_V(0,0);DMA_K(1,SLOTB);
  bf16x8 qr[4];
  #pragma unroll
  for(int d0=0;d0<4;++d0)qr[d0]=*reinterpret_cast<const bf16x8*>(&Qw[(long)r32*QP+d0*16+hi*8]);
  float mhat=0.f,l_reg=0.f;f32x16 o[2];o[0]=f32x16{};o[1]=f32x16{};f32x16 negm=f32x16{};asm volatile("":"+v"(negm));
  const int qrel=wid>>1;
  #define CMASK(P0,P1,t) do{int jb_=(t)-(NT-4); if(jb_>=0)cmask(P0,P1,jb_,qrel,hi);}while(0)
  bool resc=false;
  #define START(P0,P1) do{ const float rm=rowmax(P0,P1); resc=false; \
    { const float dl=rm; mhat=fadd_s(mhat,dl); \
      _Pragma("unroll") for(int r=0;r<16;++r){P0[r]=fsub_s(P0[r],dl);P1[r]=fsub_s(P1[r],dl);} \
      _Pragma("unroll") for(int r=0;r<16;++r)negm[r]=-mhat; asm volatile("":"+v"(negm)); } \
    _Pragma("unroll") for(int r=0;r<16;++r)P0[r]=__builtin_amdgcn_exp2f(P0[r]); }while(0)
  #define RESC() do{ if(resc){ asm volatile("s_waitcnt lgkmcnt(0)":::"memory"); \
      _Pragma("unroll") for(int d_=0;d_<2;++d_) _Pragma("unroll") for(int r=0;r<16;++r)o[d_][r]*=wsf[crow(r,hi)]; } }while(0)
  f32x16 pA0,pA1,pB0,pB1;
  int sl_prev=0,sl_cur=0,sl_next=SLOTB;
  #define ROT() do{sl_prev=sl_cur;sl_cur=sl_next;sl_next=(sl_next==(NSLOT-1)*SLOTB)?0:sl_next+SLOTB;}while(0)
  DMA_K(2,2*SLOTB);
  WAIT_BAR(3);
  qkt(pA0,pA1,Kbase,qr,negm,r32,hi);asm volatile("s_nop 15\n\ts_nop 7":"+v"(pA0),"+v"(pA1));CMASK(pA0,pA1,0);
  START(pA0,pA1);
  _Pragma("unroll") for(int r=0;r<16;++r)pA1[r]=__builtin_amdgcn_exp2f(pA1[r]);
  WAIT_BAR(0);
  DMA_K(3,0);DMA_V(1,SLOTB);
  ROT();
  kload8(kf,kp0+sl_cur);
  WAIT_BAR(2);
  s16x4 vlo[8],vhi[8]; u32x4 pw0,pw1,pw2,pw3;
  #define PKW(P,B) cvtpk_s(P[B],P[B+1])
  #define PAF(k) __builtin_bit_cast(bf16x8,pw##k)
  #define VFR(i) (bf16x8){vlo[i][0],vlo[i][1],vlo[i][2],vlo[i][3],vhi[i][0],vhi[i][1],vhi[i][2],vhi[i][3]}
  #define PIN(x) asm volatile("":"+v"(x))
  #define MX3(a,b,c) __builtin_fmaxf(__builtin_fmaxf((a),(b)),(c))
  #define GAPA(MF,A0,A1,A2,A3,W0,W1,PW) do{ MF; sacc+=A0; sacc+=A1; sacc+=A2; sacc+=A3; PIN(sacc); W0; W1; PIN(PW); SBAR(); }while(0)
  #define EX(v) __builtin_amdgcn_exp2f(v)
  #define GAPB(MF,X,B) do{ MF; X[B]=EX(X[B]); X[B+1]=EX(X[B+1]); X[B+2]=EX(X[B+2]); X[B+3]=EX(X[B+3]); PIN(X); SBAR(); }while(0)
  #define VRD(i) do{ vlo[i]=vtr(vp_+(((i)>>2)*4096+((i)&3)*1024)); vhi[i]=vtr(vp_+(((i)>>2)*4096+((i)&3)*1024+512)); }while(0)
  #define KRD(G,j) do{ if(G){ kload2(kf,kp0+sl_next,j); SBAR(); } }while(0)
  #define STEP(C0,C1,P0,P1,t,GK,GV,GL) do{ SBAR(); \
    const lds_cptr vp_=vp0+sl_prev; \
    VRD(0); SBAR(); float sacc=(P0[0]+P0[1]); \
    GAPA(C0=__builtin_amdgcn_mfma_f32_32x32x16_bf16(kf[0],qr[0],negm,0,0,0), P0[2],P0[3],P0[4],P0[5],     pw0[0]=PKW(P0,0), pw0[1]=PKW(P0,2), pw0); \
    VRD(4); SBAR(); GAPA(C1=__builtin_amdgcn_mfma_f32_32x32x16_bf16(kf[1],qr[0],negm,0,0,0), P0[6],P0[7],P0[8],P0[9],     pw0[2]=PKW(P0,4), pw0[3]=PKW(P0,6), pw0); \
    VRD(1); SBAR(); GAPA(C0=__builtin_amdgcn_mfma_f32_32x32x16_bf16(kf[2],qr[1],C0,0,0,0),   P0[10],P0[11],P0[12],P0[13], pw1[0]=PKW(P0,8), pw1[1]=PKW(P0,10), pw1); \
    VRD(5); SBAR(); GAPA(C1=__builtin_amdgcn_mfma_f32_32x32x16_bf16(kf[3],qr[1],C1,0,0,0),   P0[14],P0[15],P1[0],P1[1],   pw1[2]=PKW(P0,12),pw1[3]=PKW(P0,14), pw1); \
    VRD(2); SBAR(); GAPA(C0=__builtin_amdgcn_mfma_f32_32x32x16_bf16(kf[4],qr[2],C0,0,0,0),   P1[2],P1[3],P1[4],P1[5],     pw2[0]=PKW(P1,0), pw2[1]=PKW(P1,2), pw2); \
    VRD(6); SBAR(); GAPA(C1=__builtin_amdgcn_mfma_f32_32x32x16_bf16(kf[5],qr[2],C1,0,0,0),   P1[6],P1[7],P1[8],P1[9],     pw2[2]=PKW(P1,4), pw2[3]=PKW(P1,6), pw2); \
    VRD(3); SBAR(); GAPA(C0=__builtin_amdgcn_mfma_f32_32x32x16_bf16(kf[6],qr[3],C0,0,0,0),   P1[10],P1[11],P1[12],P1[13], pw3[0]=PKW(P1,8), pw3[1]=PKW(P1,10), pw3); \
    VRD(7); SBAR(); GAPA(C1=__builtin_amdgcn_mfma_f32_32x32x16_bf16(kf[7],qr[3],C1,0,0,0),   P1[14],P1[15],0.f,0.f,       pw3[2]=PKW(P1,12),pw3[3]=PKW(P1,14), pw3); \
    l_reg+=sacc; \
    if(GK){DMA_K((t)+3,sl_cur);} if(GV){DMA_V((t)+1,sl_next);} \
    CMASK(C0,C1,t); \
    { float a=MX3(C0[0],C0[1],C1[0]),b=MX3(C0[2],C0[3],C1[1]); a=MX3(a,C1[2],C1[3]); \
      _Pragma("unroll") for(int r=4;r<16;r+=4){a=MX3(a,C0[r],C0[r+1]);b=MX3(b,C0[r+2],C0[r+3]);a=MX3(a,C1[r],C1[r+1]);b=MX3(b,C1[r+2],C1[r+3]);} \
      float rm=__builtin_fmaxf(a,b); { auto rr=__builtin_amdgcn_permlane32_swap(__float_as_uint(rm),__float_as_uint(rm),false,false); rm=__builtin_fmaxf(__uint_as_float(rr[0]),__uint_as_float(rr[1])); } \
      resc=false; \
      if(__builtin_expect(__any(rm>(float)THRL),0)){ const float dl=__builtin_fmaxf(rm,0.f); mhat+=dl; \
        _Pragma("unroll") for(int r=0;r<16;++r){C0[r]-=dl;C1[r]-=dl;} \
        _Pragma("unroll") for(int r=0;r<16;++r)negm[r]=-mhat; asm volatile("":"+v"(negm)); \
        const float f=__builtin_amdgcn_exp2f(-dl); l_reg*=f; if(hi==0)wsf[r32]=f; resc=true; } } \
    SBAR(); \
    GAPB(o[0]=__builtin_amdgcn_mfma_f32_32x32x16_bf16(PAF(0),VFR(0),o[0],0,0,0), C0,0); \
    GAPB(o[1]=__builtin_amdgcn_mfma_f32_32x32x16_bf16(PAF(0),VFR(4),o[1],0,0,0), C0,4); \
    KRD(GL,0); GAPB(o[0]=__builtin_amdgcn_mfma_f32_32x32x16_bf16(PAF(1),VFR(1),o[0],0,0,0), C0,8); \
    KRD(GL,1); GAPB(o[1]=__builtin_amdgcn_mfma_f32_32x32x16_bf16(PAF(1),VFR(5),o[1],0,0,0), C0,12); \
    KRD(GL,2); GAPB(o[0]=__builtin_amdgcn_mfma_f32_32x32x16_bf16(PAF(2),VFR(2),o[0],0,0,0), C1,0); \
    KRD(GL,3); GAPB(o[1]=__builtin_amdgcn_mfma_f32_32x32x16_bf16(PAF(2),VFR(6),o[1],0,0,0), C1,4); \
    GAPB(o[0]=__builtin_amdgcn_mfma_f32_32x32x16_bf16(PAF(3),VFR(3),o[0],0,0,0), C1,8); \
    GAPB(o[1]=__builtin_amdgcn_mfma_f32_32x32x16_bf16(PAF(3),VFR(7),o[1],0,0,0), C1,12); \
    }while(0)
  int t=1;
  #undef CMASK
  #define CMASK(P0,P1,t) do{}while(0)
  for(;t+5<NT;t+=2){
    STEP(pB0,pB1,pA0,pA1,t,true,true,true);     WAIT_BAR(2); RESC(); ROT();
    STEP(pA0,pA1,pB0,pB1,t+1,true,true,true);   WAIT_BAR(2); RESC(); ROT();
  }
  #undef CMASK
  #define CMASK(P0,P1,t) do{int jb_=(t)-(NT-4); if(jb_>=0)cmask(P0,P1,jb_,qrel,hi);}while(0)
  #define ENDW(tt) do{ if((tt)+3<NT){WAIT_BAR(2);} else if((tt)+2<NT){WAIT_BAR(1);} else {WAIT_BAR(0);} }while(0)
  for(;t+1<NT;t+=2){
    STEP(pB0,pB1,pA0,pA1,t,(t+3<NT),(t+1<NT),(t+1<NT));       ENDW(t);   RESC(); ROT();
    STEP(pA0,pA1,pB0,pB1,t+1,(t+4<NT),(t+2<NT),(t+2<NT));     ENDW(t+1); RESC(); ROT();
  }
  STEP(pB0,pB1,pA0,pA1,NT-1,false,false,false); RESC();
  { float sacc=pB0[0]+pB0[1]; _Pragma("unroll") for(int r=2;r<16;++r)sacc+=pB0[r]; _Pragma("unroll") for(int r=0;r<16;++r)sacc+=pB1[r]; l_reg+=sacc;
    pw0=(u32x4){PKW(pB0,0),PKW(pB0,2),PKW(pB0,4),PKW(pB0,6)};pw1=(u32x4){PKW(pB0,8),PKW(pB0,10),PKW(pB0,12),PKW(pB0,14)};pw2=(u32x4){PKW(pB1,0),PKW(pB1,2),PKW(pB1,4),PKW(pB1,6)};pw3=(u32x4){PKW(pB1,8),PKW(pB1,10),PKW(pB1,12),PKW(pB1,14)};
    SBAR(); pv(o,vb0+sl_cur,PAF(0),PAF(1),PAF(2),PAF(3)); }
  #undef PKW
  #undef PAF
  #undef VFR
  #undef PIN
  #undef MX3
  #undef GAPA
  #undef GAPB
  #undef EX
  #undef VRD
  #undef KRD
  #undef STEP
  #undef ENDW
  {auto rr=__builtin_amdgcn_permlane32_swap(__float_as_uint(l_reg),__float_as_uint(l_reg),false,false);l_reg=__uint_as_float(rr[0])+__uint_as_float(rr[1]);}
  if(hi==0)wsf[32+r32]=l_reg;asm volatile("s_waitcnt lgkmcnt(0)":::"memory");
  float rli[16];
  #pragma unroll
  for(int r=0;r<16;++r)rli[r]=__builtin_amdgcn_rcpf(wsf[32+crow(r,hi)]);
  bf16*Ow=O+(rowbase+q0+wid*QBLK)*OP+ocol;
  { bf16*stg=(bf16*)(shm+LDS_OST)+wid*2048;
    #pragma unroll
    for(int r=0;r<16;++r){const int orow=crow(r,hi);
      #pragma unroll
      for(int d0=0;d0<2;++d0)stg[orow*64+d0*32+r32]=__float2bfloat16(o[d0][r]*rli[r]);}
    asm volatile("s_waitcnt lgkmcnt(0)":::"memory");
    #pragma unroll
    for(int i=0;i<4;++i){const int row=i*8+(lane>>3),ch=lane&7; const u32x4 v=*(const u32x4*)(stg+row*64+ch*8); ATTN_STORE16(Ow+(long)row*OP+ch*8,v);} }
  asm volatile("s_waitcnt lgkmcnt(0)\n\ts_barrier":::"memory");
  #undef DMA_K
  #undef DMA_V
  #undef CMASK
  #undef START
  #undef RESC
  #undef ROT
}
constexpr int ATTN_LDS_BYTES=LDS_BYTES;
struct AttnTensors { const bf16* Q; const bf16* K; const bf16* V; bf16* O; };
struct AttnUnit { int bvh; int qb; };
struct StaticOrder {
  int ai,nA;
  __device__ __forceinline__ StaticOrder(int ai_,int nA_):ai(ai_),nA(nA_){}
  __device__ __forceinline__ bool next(int i,AttnUnit&u)const{
    if(nA==128){ if(i>=8)return false; u.bvh=ai; u.qb=7-i; return true; }
    if(i>=4)return false; const int s=ai&1; u.bvh=ai>>1; u.qb=(i==0)?7-s:(i==1)?4+s:(i==2)?3-s:s; return true; }
  __device__ __forceinline__ void a_ready(const AttnUnit&)const{}
  __device__ __forceinline__ void done(const AttnUnit&)const{}
};
template<class Sched,int THRL=8> __device__ __forceinline__ void attn_phase(char*lds,const AttnTensors&T,const Sched&S){
  AttnUnit u;
  for(int i=0;S.next(i,u);++i){ S.a_ready(u); const int b=u.bvh>>4,vh=u.bvh&15,s=vh>>1,half=vh&1;
    attn_unit<THRL>(b,s*64,s*64,(s>>1)*128+half*64,s*128+half*64,u.qb,T.Q,T.K,T.V,T.O,lds); S.done(u); }
}
#undef SBAR
#undef WAIT_BAR
}
#include <hip/hip_cooperative_groups.h>
typedef unsigned short bf16;
#define GAS __attribute__((address_space(1)))
#define LAS __attribute__((address_space(3)))
typedef unsigned v4u __attribute__((ext_vector_type(4)));
typedef unsigned v2u __attribute__((ext_vector_type(2)));
typedef float f32x4 __attribute__((ext_vector_type(4)));
#define LDS_WAIT() asm volatile("s_waitcnt lgkmcnt(0)" ::: "memory")
__device__ __forceinline__ unsigned f2bf(float f) { unsigned u = __builtin_bit_cast(unsigned, f); return (u + 0x7fffu + ((u >> 16) & 1u)) >> 16; }
__device__ __forceinline__ unsigned pk2(float lo, float hi) { return f2bf(lo) | (f2bf(hi) << 16); }
__device__ __forceinline__ float bflo(unsigned w) { return __builtin_bit_cast(float, w << 16); }
__device__ __forceinline__ float bfhi(unsigned w) { return __builtin_bit_cast(float, w & 0xffff0000u); }
__device__ __forceinline__ float bf1(unsigned short h) { return __builtin_bit_cast(float, (unsigned)h << 16); }
template <int CTRL> __device__ __forceinline__ float dppf(float x) { return __builtin_bit_cast(float, __builtin_amdgcn_update_dpp(0, __builtin_bit_cast(int, x), CTRL, 0xf, 0xf, false)); }
__device__ __forceinline__ float row16_allsum(float x) { x += dppf<0x128>(x); x += dppf<0x124>(x); x += dppf<0x122>(x); x += dppf<0x121>(x); return x; }
__device__ __forceinline__ float oct_allsum(float x) { x += dppf<0xB1>(x); x += dppf<0x4E>(x); x += dppf<0x141>(x); return x; }
__device__ __forceinline__ float u2f(unsigned u) { return __builtin_bit_cast(float, u); }
__device__ __forceinline__ unsigned f2u(float f) { return __builtin_bit_cast(unsigned, f); }
__device__ __forceinline__ float sw32(float a, float b) { auto r = __builtin_amdgcn_permlane32_swap(f2u(a), f2u(b), false, false); const unsigned r0 = r[0], r1 = r[1]; return u2f(r0) + u2f(r1); }
__device__ __forceinline__ float sw16(float a, float b) { auto r = __builtin_amdgcn_permlane16_swap(f2u(a), f2u(b), false, false); const unsigned r0 = r[0], r1 = r[1]; return u2f(r0) + u2f(r1); }
__device__ __forceinline__ float wave_allsum(float x) { x = row16_allsum(x); x = sw16(x, x); return sw32(x, x); }
__device__ __forceinline__ float red4(float x0, float x1, float x2, float x3) { return row16_allsum(sw16(sw32(x0, x1), sw32(x2, x3))); }

#define XB_TMO      128
#define XB_XCNT(j)  (256  + 64 * (j))
#define XB_XSUB(j)  (1280 + 64 * (j))
#define XB_XGEN(j)  (2304 + 64 * (j))
#define XB_TOP      3328
#define XB_TOPGEN   3392
#define XCD_BAR_WORDS 3456
#define XB_SPIN_CAP (1u << 18)

__device__ __forceinline__ unsigned xb_ld(unsigned* p)              { return __hip_atomic_load(p, __ATOMIC_RELAXED, __HIP_MEMORY_SCOPE_AGENT); }
__device__ __forceinline__ unsigned xb_add(unsigned* p, unsigned v) { return __hip_atomic_fetch_add(p, v, __ATOMIC_RELAXED, __HIP_MEMORY_SCOPE_AGENT); }
__device__ __forceinline__ unsigned xb_xcc_id() { return (unsigned)__builtin_amdgcn_s_getreg((3 << 11) | 20) & 0xFu; }
#define XB_SPIN(cond, bar) do { unsigned _sp = 0; while (cond) { __builtin_amdgcn_s_sleep(1); \
    if ((++_sp & 255u) == 0u) { if (xb_ld(&(bar)[XB_TMO])) break; if (_sp > XB_SPIN_CAP) { atomicAdd(&(bar)[XB_TMO], 1u); break; } } } } while (0)

struct XcdBarrier {
    unsigned* bar; unsigned x;
    volatile LAS unsigned* st;
};

__device__ __forceinline__ XcdBarrier xcd_barrier_post(unsigned* bar, volatile LAS unsigned* st) {
    XcdBarrier b; b.bar = bar; b.x = xb_xcc_id(); b.st = st;
    if (threadIdx.x == 0) (void)xb_add(&bar[XB_XCNT(b.x)], 1u);
    return b;
}
__device__ __forceinline__ void xcd_barrier_complete(unsigned* bar, unsigned x, unsigned& nloc, unsigned& nx) {
    const unsigned G = gridDim.x * gridDim.y * gridDim.z;
    unsigned sum, cnt, mine, sp = 0u;
    for (;;) {
        sum = 0u; cnt = 0u; mine = 0u;
#pragma unroll
        for (unsigned j = 0; j < 16; ++j) { const unsigned c = xb_ld(&bar[XB_XCNT(j)]); sum += c; cnt += (c > 0u) ? 1u : 0u; }
        mine = xb_ld(&bar[XB_XCNT(x)]);
        if (sum == G) break;
        __builtin_amdgcn_s_sleep(1);
        if ((++sp & 255u) == 0u) { if (xb_ld(&bar[XB_TMO])) break; if (sp > XB_SPIN_CAP) { atomicAdd(&bar[XB_TMO], 1u); break; } }
    }
    nloc = mine > 0u ? mine : 1u; nx = cnt > 0u ? cnt : 1u;
}

__device__ __forceinline__ void xcd_barrier(const XcdBarrier& b) {
    asm volatile("s_waitcnt vmcnt(0)" ::: "memory");
    __syncthreads();
    if (threadIdx.x == 0) {
        unsigned* bar = b.bar;
        __builtin_amdgcn_s_waitcnt(0);
        unsigned nloc = b.st[0], nx = b.st[1];
        if (nloc == 0u) { xcd_barrier_complete(bar, b.x, nloc, nx); b.st[0] = nloc; b.st[1] = nx; }
        const unsigned old = xb_add(&bar[XB_XSUB(b.x)], 1u);
        const unsigned gen = old / nloc;
        if (old + 1u == (gen + 1u) * nloc) {
            __builtin_amdgcn_fence(__ATOMIC_RELEASE, "agent");
            asm volatile("s_waitcnt vmcnt(0)" ::: "memory");
            const unsigned og = xb_add(&bar[XB_TOP], 1u);
            const unsigned tg = og / nx;
            if (og + 1u == (tg + 1u) * nx) xb_add(&bar[XB_TOPGEN], 1u);
            else XB_SPIN(xb_ld(&bar[XB_TOPGEN]) == tg, bar);
            __builtin_amdgcn_fence(__ATOMIC_ACQUIRE, "agent");
            xb_add(&bar[XB_XGEN(b.x)], 1u);
            asm volatile("s_waitcnt vmcnt(0)" ::: "memory");
        } else {
            XB_SPIN(xb_ld(&bar[XB_XGEN(b.x)]) == gen, bar);
            __builtin_amdgcn_fence(__ATOMIC_ACQUIRE, "agent");
            asm volatile("s_waitcnt vmcnt(0)" ::: "memory");
        }
    }
    __syncthreads();
}


constexpr int CW_BAR = 4096;
constexpr int MISC_OFF = 162816 + 320;
struct Frame {
    LAS unsigned char* lds;
    int tid, lane, wave, G, bx;
    float* out; unsigned char* ws;
};
struct Args { const float* in[26]; float* out; unsigned char* ws; int ph_lo, ph_hi; };
typedef const float* cfp_t;
typedef __attribute__((address_space(4))) const cfp_t* ktab_t;
struct InTab { ktab_t p; __device__ __forceinline__ const float* operator[](int i) const { return p[i]; } };
enum { I_X = 0, I_NMG, I_WIN, I_MU, I_W0, I_W2, I_A0, I_A2, I_G2, I_KK, I_KA, I_RK, I_LNG, I_LNB, I_LQ1, I_LK1, I_LQ2, I_LK2, I_SUBG, I_WA, I_WB, I_WO, I_NFG, I_FF1, I_FF2, I_NFIN };

template <bool ROPE> __device__ __forceinline__ void p0_transpose_item(const float* W, int K, int N, bf16* WT, LAS float* scr, int item, int lane, int pitch = 0, int koff = 0) {
    if (pitch == 0) pitch = K;
    const int nblk = N / 32, kb = item / nblk, nb = item % nblk, k0 = 64 * kb, n0 = 32 * nb;
#pragma unroll 8
    for (int i = 0; i < 32; ++i) { const int kk = 2 * i + (lane >> 5); scr[kk * 33 + (lane & 31)] = W[(size_t)(k0 + kk) * N + n0 + (lane & 31)]; }
    LDS_WAIT(); asm volatile("" ::: "memory");
    const int c = lane & 7;
#pragma unroll
    for (int j = 0; j < 4; ++j) { const int n = (lane >> 3) + 8 * j; const LAS float* s = scr + (8 * c) * 33 + n;
        v4u o; o.x = pk2(s[0 * 33], s[1 * 33]); o.y = pk2(s[2 * 33], s[3 * 33]); o.z = pk2(s[4 * 33], s[5 * 33]); o.w = pk2(s[6 * 33], s[7 * 33]);
        int col = n0 + n;
        if (ROPE && col < 1024) { const int d = col & 63, dd = d & 31; col = (col & ~63) + 8 * (dd >> 2) + (d >> 5) * 4 + (dd & 3); }
        *(GAS v4u*)(WT + (size_t)col * pitch + koff + k0 + 8 * c) = o; }
    LDS_WAIT(); asm volatile("" ::: "memory");
}
__device__ __forceinline__ void rms_row_to_bf16(const float* xrow, const float* g, bf16* orow, int lane) {
    const GAS f32x4* xr = (const GAS f32x4*)xrow + lane; const f32x4* gr = (const f32x4*)g + lane;
    f32x4 v[4]; float s = 0.f;
#pragma unroll
    for (int j = 0; j < 4; ++j) { v[j] = xr[64 * j]; s += (v[j].x * v[j].x + v[j].y * v[j].y) + (v[j].z * v[j].z + v[j].w * v[j].w); }
    const float rstd = 1.0f / sqrtf(wave_allsum(s) * (1.f / D) + NORM_EPS);
    GAS unsigned long long* o8 = (GAS unsigned long long*)orow + lane;
#pragma unroll
    for (int j = 0; j < 4; ++j) { const f32x4 gg = gr[64 * j];
        o8[64 * j] = (unsigned long long)pk2(v[j].x * rstd * gg.x, v[j].y * rstd * gg.y) | ((unsigned long long)pk2(v[j].z * rstd * gg.z, v[j].w * rstd * gg.w) << 32); }
}
__device__ __forceinline__ void rms_row_to_f32(const float* xrow, const float* g, float* orow, int lane) {
    const GAS f32x4* xr = (const GAS f32x4*)xrow + lane; const f32x4* gr = (const f32x4*)g + lane;
    f32x4 v[4]; float s = 0.f;
#pragma unroll
    for (int j = 0; j < 4; ++j) { v[j] = xr[64 * j]; s += (v[j].x * v[j].x + v[j].y * v[j].y) + (v[j].z * v[j].z + v[j].w * v[j].w); }
    const float rstd = 1.0f / sqrtf(wave_allsum(s) * (1.f / D) + NORM_EPS);
    GAS f32x4* o = (GAS f32x4*)orow + lane;
#pragma unroll
    for (int j = 0; j < 4; ++j) { const f32x4 gg = gr[64 * j]; o[64 * j] = v[j] * rstd * gg; }
}
__device__ __forceinline__ void p0_prologue(Frame& F, const InTab& A) {
    LAS float* scr = (LAS float*)(F.lds + RING_OFF + F.wave * 16384);
    const int gw = F.bx * NWAVES + F.wave, NGW = F.G * NWAVES;
    unsigned char* ws = F.ws;
    constexpr int I_IN = (D / 64) * (D_IN / 32), I_A = (512 / 64) * (D / 32), I_O = (D / 64) * (D / 32), I_1 = (D / 64) * (FF / 32), I_2 = (FF / 64) * (D / 32);
    (void)I_A; (void)I_O; (void)I_1; (void)I_2;
    for (int it = gw; it < I_IN; it += NGW) p0_transpose_item<true>(A[I_WIN], D, D_IN, (bf16*)(ws + WS_WIN), scr, it, F.lane);
    if (false) for (int it = gw; it < 0; it += NGW) {
        int r = it;
        if (r < I_A) { p0_transpose_item<false>(A[I_WA], 512, D, (bf16*)(ws + WS_WA), scr, r, F.lane, 1024, 0); continue; } r -= I_A;
        if (r < I_A) { p0_transpose_item<false>(A[I_WB], 512, D, (bf16*)(ws + WS_WA), scr, r, F.lane, 1024, 512); continue; } r -= I_A;
        if (r < I_O) { p0_transpose_item<false>(A[I_WO], D, D, (bf16*)(ws + WS_WO), scr, r, F.lane); continue; } r -= I_O;
        if (r < I_1) { p0_transpose_item<false>(A[I_FF1], D, FF, (bf16*)(ws + WS_W1), scr, r, F.lane); continue; } r -= I_1;
        p0_transpose_item<false>(A[I_FF2], FF, D, (bf16*)(ws + WS_W2), scr, r, F.lane);
    }
    const int gt = F.bx * (NWAVES * 64) + F.tid, NGT = F.G * NWAVES * 64;
    for (int e = gt; e < NLORA * (KLORA / 8); e += NGT) { const int n = e / (KLORA / 8), k8 = (e % (KLORA / 8)) * 8; float v[8];
#pragma unroll
        for (int i = 0; i < 8; ++i) { const int k = k8 + i; float x = 0.f;
            if (n < 512) { if (k < 64) x = A[I_W2][(size_t)k * 512 + n]; }
            else if (n < 1024) { if (k >= 64 && k < 128) x = A[I_A2][(size_t)(k - 64) * 512 + (n - 512)]; }
            else { if (k >= 128) x = A[I_G2][(size_t)(k - 128) * 512 + (n - 1024)]; }
            v[i] = x; }
        v4u o; o.x = pk2(v[0], v[1]); o.y = pk2(v[2], v[3]); o.z = pk2(v[4], v[5]); o.w = pk2(v[6], v[7]);
        *(GAS v4u*)((bf16*)(ws + WS_WL) + (size_t)n * KLORA + k8) = o; }
    for (int e = gt; e < SEQ * 32; e += NGT) { const int pos = e >> 5, i = e & 31;
        const float inv = (float)pow(10000.0, -(double)i / 32.0); const float ang = (float)pos * inv; double s, c; sincos((double)ang, &s, &c);
        ((float*)(ws + WS_ROPE_C))[e] = (float)c; ((float*)(ws + WS_ROPE_S))[e] = (float)s; }
    for (int m = gw; m < M; m += NGW) rms_row_to_bf16(A[I_X] + (size_t)m * D, A[I_NMG], (bf16*)(ws + WS_XN) + (size_t)m * D, F.lane);
}

__device__ __forceinline__ void late_weights(Frame& F, const InTab& A, int part, int nparts, int cu0) {
    int lane_ = F.lane; asm volatile("" : "+v"(lane_));
    LAS float* scr = (LAS float*)(F.lds + RING_OFF + F.wave * 16384);
    unsigned char* ws = F.ws;
    constexpr int I_A = (512 / 64) * (D / 32), I_O = (D / 64) * (D / 32), I_1 = (D / 64) * (FF / 32), I_2 = (FF / 64) * (D / 32), NIT = 2 * I_A + I_O + I_1 + I_2;
    const int per = NIT / nparts, lo = part * per, hi = lo + per;
    const int gw = (F.bx - cu0) * NWAVES + F.wave, NGW = (F.G - cu0) * NWAVES;
    for (int it = lo + gw; it < hi; it += NGW) {
        int r = it;
        if (r < I_A) { p0_transpose_item<false>(A[I_WA], 512, D, (bf16*)(ws + WS_WA), scr, r, lane_, 1024, 0); continue; } r -= I_A;
        if (r < I_A) { p0_transpose_item<false>(A[I_WB], 512, D, (bf16*)(ws + WS_WA), scr, r, lane_, 1024, 512); continue; } r -= I_A;
        if (r < I_O) { p0_transpose_item<false>(A[I_WO], D, D, (bf16*)(ws + WS_WO), scr, r, lane_); continue; } r -= I_O;
        if (r < I_1) { p0_transpose_item<false>(A[I_FF1], D, FF, (bf16*)(ws + WS_W1), scr, r, lane_); continue; } r -= I_1;
        p0_transpose_item<false>(A[I_FF2], FF, D, (bf16*)(ws + WS_W2), scr, r, lane_);
    }
}
__device__ __forceinline__ void prep1_phase(Frame& F, const InTab& A) {
    const int gw = F.bx * NWAVES + F.wave, NGW = F.G * NWAVES, lane = F.lane;
    const bf16* WAG = (const bf16*)(F.ws + WS_WAG); bf16* LIN = (bf16*)(F.ws + WS_LIN);
    const f32x4 mu = *(const f32x4*)(A[I_MU] + 1536 + 4 * lane);
    for (int m = gw; m < M; m += NGW) {
        const v2u cur = *(const GAS v2u*)(WAG + (size_t)m * 256 + 4 * lane);
        v2u prv = (v2u){0u, 0u}; if ((m & (SEQ - 1)) != 0) prv = *(const GAS v2u*)(WAG + (size_t)(m - 1) * 256 + 4 * lane);
        float z[4] = {bflo(cur.x), bfhi(cur.x), bflo(cur.y), bfhi(cur.y)}; const float p[4] = {bflo(prv.x), bfhi(prv.x), bflo(prv.y), bfhi(prv.y)};
#pragma unroll
        for (int e = 0; e < 4; ++e) { float v = z[e] + (p[e] - z[e]) * mu[e];
            if (lane < 16) v = tanhf(v); else if (lane >= 32) v = 1.0f / (1.0f + __expf(-v));
            z[e] = v; }
        v2u o; o.x = pk2(z[0], z[1]); o.y = pk2(z[2], z[3]);
        *(GAS v2u*)(LIN + (size_t)m * 256 + 4 * lane) = o;
    }
}
struct ScanRaw { unsigned short r[9], k[9], v[9], a[8]; float d[8]; };
__device__ __forceinline__ void scan_load(ScanRaw& R, const bf16* RKV, const float* DEC, const bf16* AA, size_t row0, int t0, int c) {
#pragma unroll
    for (int j = 0; j < 9; ++j) { int t = t0 - 1 + j; if (t < 0) t = 0; const bf16* p = RKV + (row0 + t) * 1536 + c;
        R.r[j] = *(const GAS bf16*)p; R.k[j] = *(const GAS bf16*)(p + 512); R.v[j] = *(const GAS bf16*)(p + 1024); }
#pragma unroll
    for (int j = 0; j < 8; ++j) { R.d[j] = *(const GAS float*)(DEC + (row0 + t0 + j) * 512 + c); R.a[j] = *(const GAS bf16*)(AA + (row0 + t0 + j) * 512 + c); }
}
__device__ __forceinline__ void scan_phase(Frame& F, const InTab& A, int si) {
    const int lane = F.lane, wave = F.wave, tid = F.tid;
    const int bh = si >> 1, half = si & 1, b = bh >> 3, h = bh & 7, c = h * 64 + lane;
    LAS float* IN = (LAS float*)(F.lds + RING_OFF);
    LAS float* VV = IN + 5 * 4096;
    LAS float* YBUF = VV + 2048;
    const bf16* RKV = (const bf16*)(F.ws + WS_RKV); const float* DEC = (const float*)(F.ws + WS_DEC); const bf16* AA = (const bf16*)(F.ws + WS_AA);
    bf16* Y = (bf16*)(F.ws + WS_Y); float* BON = (float*)(F.ws + WS_BON);
    const float mu_r = A[I_MU][c], mu_k = A[I_MU][512 + c], mu_v = A[I_MU][1024 + c], kkc = A[I_KK][c], kac = A[I_KA][c], rkc = A[I_RK][c];
    const size_t row0 = (size_t)b * SEQ;
    const int myv = (int)(red4(0.f, 1.f, 2.f, 3.f) * (1.0f / 64.0f) + 0.5f);
    const int L0 = __builtin_ctzll(__ballot(myv == 0)), L1 = __builtin_ctzll(__ballot(myv == 1)), L2 = __builtin_ctzll(__ballot(myv == 2)), L3 = __builtin_ctzll(__ballot(myv == 3));
    float S0 = 0.f, S1 = 0.f, S2 = 0.f, S3 = 0.f;
    ScanRaw R; scan_load(R, RKV, DEC, AA, row0, wave * 8, c);
    for (int blk = 0; blk < SEQ / 64; ++blk) {
        {
            const int t0 = blk * 64 + wave * 8;
            f32x4 qd[2], qa[2], qb[2], qk[2], qr[2], qv[2];
#pragma unroll
            for (int j = 0; j < 8; ++j) {
                const float pz = (t0 + j == 0) ? 0.f : 1.f;
                const float rt_ = bf1(R.r[j + 1]), kt_ = bf1(R.k[j + 1]), vt_ = bf1(R.v[j + 1]);
                const float rs = rt_ + (bf1(R.r[j]) * pz - rt_) * mu_r, ks = kt_ + (bf1(R.k[j]) * pz - kt_) * mu_k, vs = vt_ + (bf1(R.v[j]) * pz - vt_) * mu_v;
                const float kkr = ks * kkc, n2 = wave_allsum(kkr * kkr), kk = kkr / __builtin_fmaxf(sqrtf(n2), 1e-12f);
                const float a = 1.0f / (1.0f + __expf(-bf1(R.a[j]))), kx = ks * (1.0f + (a - 1.0f) * kac);
                const float bon = wave_allsum(rs * kx * rkc);
                if (half == 0 && lane == 0) BON[(row0 + t0 + j) * 8 + h] = bon;
                qd[j >> 2][j & 3] = __expf(-0.6065306597f / (1.0f + __expf(-R.d[j])));     qa[j >> 2][j & 3] = -kk; qb[j >> 2][j & 3] = kk * a; qk[j >> 2][j & 3] = kx; qr[j >> 2][j & 3] = rs; qv[j >> 2][j & 3] = vs;
            }
#pragma unroll
            for (int q = 0; q < 2; ++q) { const int t4 = wave * 2 + q; LAS f32x4* p = (LAS f32x4*)IN + t4 * 64 + lane;
                p[0 * 1024] = qd[q]; p[1 * 1024] = qa[q]; p[2 * 1024] = qb[q]; p[3 * 1024] = qk[q]; p[4 * 1024] = qr[q];
                if ((lane >> 5) == half) ((LAS f32x4*)VV)[t4 * 32 + (lane & 31)] = qv[q]; }
        }
        __syncthreads();
        if (blk + 1 < SEQ / 64) scan_load(R, RKV, DEC, AA, row0, (blk + 1) * 64 + wave * 8, c);
#pragma unroll 1
        for (int t4 = 0; t4 < 16; ++t4) {
            const LAS f32x4* p = (const LAS f32x4*)IN + t4 * 64 + lane;
            const f32x4 W4 = p[0], A4 = p[1024], B4 = p[2048], K4 = p[3072], R4 = p[4096];
            const LAS f32x4* pv = (const LAS f32x4*)VV + t4 * 32 + wave * 4;
            const f32x4 V0 = pv[0], V1 = pv[1], V2 = pv[2], V3 = pv[3];
            f32x4 yq;
#pragma unroll
            for (int ts = 0; ts < 4; ++ts) {
                const float w = W4[ts], a = A4[ts], bb = B4[ts], kx = K4[ts], r = R4[ts];
                const float t = red4(S0 * a, S1 * a, S2 * a, S3 * a);
                const float sa0 = __builtin_bit_cast(float, __builtin_amdgcn_readlane(__builtin_bit_cast(int, t), L0)), sa1 = __builtin_bit_cast(float, __builtin_amdgcn_readlane(__builtin_bit_cast(int, t), L1));
                const float sa2 = __builtin_bit_cast(float, __builtin_amdgcn_readlane(__builtin_bit_cast(int, t), L2)), sa3 = __builtin_bit_cast(float, __builtin_amdgcn_readlane(__builtin_bit_cast(int, t), L3));
                S0 = S0 * w + (sa0 * bb + V0[ts] * kx); S1 = S1 * w + (sa1 * bb + V1[ts] * kx); S2 = S2 * w + (sa2 * bb + V2[ts] * kx); S3 = S3 * w + (sa3 * bb + V3[ts] * kx);
                yq[ts] = red4(S0 * r, S1 * r, S2 * r, S3 * r);
            }
            if ((lane & 15) == 0) *(LAS f32x4*)(YBUF + (wave * 4 + myv) * 68 + t4 * 4) = yq;
        }
        __syncthreads();
        { const int t = tid >> 3, rg = tid & 7; const LAS float* yb = YBUF + (4 * rg) * 68 + t;
          v2u o; o.x = pk2(yb[0], yb[68]); o.y = pk2(yb[136], yb[204]);
          *(GAS v2u*)(Y + (row0 + blk * 64 + t) * 512 + h * 64 + 32 * half + 4 * rg) = o; }
    }
    __syncthreads();
}
__device__ __forceinline__ void post_phase(Frame& F, const InTab& A) {
    const int gw = F.bx * NWAVES + F.wave, NGW = F.G * NWAVES, lane = F.lane;
    const bf16* O = (const bf16*)(F.ws + WS_O); const bf16* Y = (const bf16*)(F.ws + WS_Y); const bf16* RKV = (const bf16*)(F.ws + WS_RKV); const bf16* GG = (const bf16*)(F.ws + WS_GG);
    const float* BON = (const float*)(F.ws + WS_BON); bf16* YA = (bf16*)(F.ws + WS_YA); bf16* YB = (bf16*)(F.ws + WS_YB);
    const float lam = __expf(wave_allsum(A[I_LQ1][lane] * A[I_LK1][lane])) - __expf(wave_allsum(A[I_LQ2][lane] * A[I_LK2][lane])) + LAMBDA_INIT;
    const int ca = 8 * lane, ha = lane >> 4, ea = ca & 127;
    const int hb = lane >> 3;
    float sg[8], lg[8], lb[8], muv[8];
#pragma unroll
    for (int e = 0; e < 8; ++e) { sg[e] = A[I_SUBG][ea + e] * (1.0f - LAMBDA_INIT); lg[e] = A[I_LNG][ca + e]; lb[e] = A[I_LNB][ca + e]; muv[e] = A[I_MU][1024 + ca + e]; }
    for (int m = gw; m < M; m += NGW) {
        {
            const v4u o0 = *(const GAS v4u*)(O + (size_t)m * 1024 + (2 * ha) * 128 + ea), o1 = *(const GAS v4u*)(O + (size_t)m * 1024 + (2 * ha + 1) * 128 + ea);
            float o[8] = {bflo(o0.x) - lam * bflo(o1.x), bfhi(o0.x) - lam * bfhi(o1.x), bflo(o0.y) - lam * bflo(o1.y), bfhi(o0.y) - lam * bfhi(o1.y),
                          bflo(o0.z) - lam * bflo(o1.z), bfhi(o0.z) - lam * bfhi(o1.z), bflo(o0.w) - lam * bflo(o1.w), bfhi(o0.w) - lam * bfhi(o1.w)};
            float ss = 0.f;
#pragma unroll
            for (int e = 0; e < 8; ++e) ss += o[e] * o[e];
            const float rstd = 1.0f / sqrtf(row16_allsum(ss) * (1.0f / 128.0f) + SUBLN_EPS);
            v4u w; w.x = pk2(o[0] * rstd * sg[0], o[1] * rstd * sg[1]); w.y = pk2(o[2] * rstd * sg[2], o[3] * rstd * sg[3]); w.z = pk2(o[4] * rstd * sg[4], o[5] * rstd * sg[5]); w.w = pk2(o[6] * rstd * sg[6], o[7] * rstd * sg[7]);
#ifdef ABL_YA0
            w = (v4u){0u, 0u, 0u, 0u};
#endif
            *(GAS v4u*)(YA + (size_t)m * 1024 + ca) = w;
        }
        {
            const v4u yr = *(const GAS v4u*)(Y + (size_t)m * 512 + ca), gr = *(const GAS v4u*)(GG + (size_t)m * 512 + ca);
            const v4u vc = *(const GAS v4u*)(RKV + (size_t)m * 1536 + 1024 + ca);
            v4u vp = (v4u){0u, 0u, 0u, 0u}; if ((m & (SEQ - 1)) != 0) vp = *(const GAS v4u*)(RKV + (size_t)(m - 1) * 1536 + 1024 + ca);
            const float y[8] = {bflo(yr.x), bfhi(yr.x), bflo(yr.y), bfhi(yr.y), bflo(yr.z), bfhi(yr.z), bflo(yr.w), bfhi(yr.w)};
#ifdef DBG_GDIRECT
            float g[8] = {0.f, 0.f, 0.f, 0.f, 0.f, 0.f, 0.f, 0.f};
            { const bf16* LINr = (const bf16*)(F.ws + WS_LIN) + (size_t)m * 256 + 128; (void)gr;
              for (int k = 0; k < 128; ++k) { const float s = bf1(*(const GAS bf16*)(LINr + k)); const float* g2r = A[I_G2] + (size_t)k * 512 + ca;
#pragma unroll
                for (int e = 0; e < 8; ++e) g[e] += s * g2r[e]; } }
#else
            const float g[8] = {bflo(gr.x), bfhi(gr.x), bflo(gr.y), bfhi(gr.y), bflo(gr.z), bfhi(gr.z), bflo(gr.w), bfhi(gr.w)};
#endif
            const float v[8] = {bflo(vc.x), bfhi(vc.x), bflo(vc.y), bfhi(vc.y), bflo(vc.z), bfhi(vc.z), bflo(vc.w), bfhi(vc.w)};
            const float p[8] = {bflo(vp.x), bfhi(vp.x), bflo(vp.y), bfhi(vp.y), bflo(vp.z), bfhi(vp.z), bflo(vp.w), bfhi(vp.w)};
            float s = 0.f;
#pragma unroll
            for (int e = 0; e < 8; ++e) s += y[e];
            const float mean = oct_allsum(s) * (1.0f / 64.0f); float q = 0.f;
#pragma unroll
            for (int e = 0; e < 8; ++e) { const float d = y[e] - mean; q += d * d; }
            const float rstd = 1.0f / sqrtf(oct_allsum(q) * (1.0f / 64.0f) + GN_EPS);
#ifdef DBG_BONDIRECT
            float bon;
            { const v4u rc = *(const GAS v4u*)(RKV + (size_t)m * 1536 + ca), kc = *(const GAS v4u*)(RKV + (size_t)m * 1536 + 512 + ca), ac = *(const GAS v4u*)((const bf16*)(F.ws + WS_AA) + (size_t)m * 512 + ca);
              v4u rp = (v4u){0u, 0u, 0u, 0u}, kp = (v4u){0u, 0u, 0u, 0u};
              if ((m & (SEQ - 1)) != 0) { rp = *(const GAS v4u*)(RKV + (size_t)(m - 1) * 1536 + ca); kp = *(const GAS v4u*)(RKV + (size_t)(m - 1) * 1536 + 512 + ca); }
              const float rcf[8] = {bflo(rc.x), bfhi(rc.x), bflo(rc.y), bfhi(rc.y), bflo(rc.z), bfhi(rc.z), bflo(rc.w), bfhi(rc.w)}, rpf[8] = {bflo(rp.x), bfhi(rp.x), bflo(rp.y), bfhi(rp.y), bflo(rp.z), bfhi(rp.z), bflo(rp.w), bfhi(rp.w)};
              const float kcf[8] = {bflo(kc.x), bfhi(kc.x), bflo(kc.y), bfhi(kc.y), bflo(kc.z), bfhi(kc.z), bflo(kc.w), bfhi(kc.w)}, kpf[8] = {bflo(kp.x), bfhi(kp.x), bflo(kp.y), bfhi(kp.y), bflo(kp.z), bfhi(kp.z), bflo(kp.w), bfhi(kp.w)};
              const float af[8] = {bflo(ac.x), bfhi(ac.x), bflo(ac.y), bfhi(ac.y), bflo(ac.z), bfhi(ac.z), bflo(ac.w), bfhi(ac.w)};
              float s_ = 0.f;
#pragma unroll
              for (int e = 0; e < 8; ++e) { const float rs = rcf[e] + (rpf[e] - rcf[e]) * A[I_MU][ca + e], ks = kcf[e] + (kpf[e] - kcf[e]) * A[I_MU][512 + ca + e];
                  s_ += rs * (ks * (1.0f + (af[e] - 1.0f) * A[I_KA][ca + e])) * A[I_RK][ca + e]; }
              bon = oct_allsum(s_); (void)BON; }
#else
            const float bon = BON[(size_t)m * 8 + hb];
#endif
            float r[8];
#pragma unroll
            for (int e = 0; e < 8; ++e) { const float vs = v[e] + (p[e] - v[e]) * muv[e];
#if defined(ABL_NOGN)
                r[e] = (bon * vs) * g[e]; }
#elif defined(ABL_NOBON)
                r[e] = (((y[e] - mean) * rstd) * lg[e] + lb[e]) * g[e]; }
#else
                r[e] = (((y[e] - mean) * rstd) * lg[e] + lb[e] + bon * vs) * g[e]; }
#endif

            v4u w; w.x = pk2(r[0], r[1]); w.y = pk2(r[2], r[3]); w.z = pk2(r[4], r[5]); w.w = pk2(r[6], r[7]);
#ifdef ABL_YB0
            w = (v4u){0u, 0u, 0u, 0u};
#endif
            *(GAS v4u*)(YA + (size_t)m * 1024 + 512 + ca) = w;
        }
    }
}

typedef short rk_bf16x8 __attribute__((ext_vector_type(8)));
typedef float rk_f32x16 __attribute__((ext_vector_type(16)));
constexpr int RKA_RS_K = 144, RKA_RS_J = 80;
constexpr int RKA_A = 0, RKA_B = 5120, RKA_K = 10240, RKA_R = 15360, RKA_AT = 19968, RKA_BH = 25088, RKA_KH = 30208, RKA_VT = 35328, RKA_GC = 40448, RKA_BYTES = 40704;
constexpr int RKA_N = 0, RKA_X = 0, RKA_T = 5120, RKA_MAK = 7680, RKA_MRB = 10240, RKA_MRK = 12800;
constexpr int RKA_WAVES = 4;
static_assert(RKA_WAVES * RKA_BYTES <= 162816, "phase A LDS");
constexpr size_t WS_PQ = 66 * MiB;
constexpr size_t WS_RY = 98 * MiB;
constexpr size_t WS_GC = 242 * MiB;
constexpr size_t WS_SST = 243 * MiB;

__device__ __forceinline__ rk_bf16x8 rk_frag(const LAS unsigned char* base, int rs, int row, int s, int h) { return *(const LAS rk_bf16x8*)(base + row * rs + (16 * s + 8 * h) * 2); }
__device__ __forceinline__ rk_f32x16 rk_mfma(rk_bf16x8 a, rk_bf16x8 b, rk_f32x16 c) { return __builtin_amdgcn_mfma_f32_32x32x16_bf16(a, b, c, 0, 0, 0); }
__device__ __forceinline__ unsigned rk_pk(float lo, float hi) { typedef float f2_ __attribute__((ext_vector_type(2))); typedef __bf16 b2_ __attribute__((ext_vector_type(2))); f2_ v = {lo, hi}; b2_ b = __builtin_convertvector(v, b2_); return __builtin_bit_cast(unsigned, b); }
__device__ __forceinline__ void rk_store_tile_lds(LAS unsigned char* base, int rs, int nrow, int mbase, int h, const rk_f32x16& acc) {
#pragma unroll
    for (int g = 0; g < 4; ++g) { v2u w; w.x = rk_pk(acc[4 * g], acc[4 * g + 1]); w.y = rk_pk(acc[4 * g + 2], acc[4 * g + 3]); *(LAS v2u*)(base + nrow * rs + (mbase + 8 * g + 4 * h) * 2) = w; }
}
__device__ __forceinline__ void rk_store_tile_glb(bf16* base, int pitch, int nrow, int mbase, int h, const rk_f32x16& acc) {
#pragma unroll
    for (int g = 0; g < 4; ++g) { v2u w; w.x = rk_pk(acc[4 * g], acc[4 * g + 1]); w.y = rk_pk(acc[4 * g + 2], acc[4 * g + 3]); *(GAS v2u*)(base + (size_t)nrow * pitch + mbase + 8 * g + 4 * h) = w; }
}
__device__ __forceinline__ void rk_store_blob(unsigned* blob, int lane, const rk_f32x16& acc) {
    v4u w0, w1; w0.x = rk_pk(acc[0], acc[1]); w0.y = rk_pk(acc[2], acc[3]); w0.z = rk_pk(acc[4], acc[5]); w0.w = rk_pk(acc[6], acc[7]);
    w1.x = rk_pk(acc[8], acc[9]); w1.y = rk_pk(acc[10], acc[11]); w1.z = rk_pk(acc[12], acc[13]); w1.w = rk_pk(acc[14], acc[15]);
    *(GAS v4u*)(blob + lane * 8) = w0; *(GAS v4u*)(blob + lane * 8 + 4) = w1;
}
struct RkBlob { v4u w0, w1; };
__device__ __forceinline__ RkBlob rk_load_blob(const unsigned* blob, int lane) { RkBlob b; b.w0 = *(const GAS v4u*)(blob + lane * 8); b.w1 = *(const GAS v4u*)(blob + lane * 8 + 4); return b; }
__device__ __forceinline__ rk_f32x16 rk_blob_f32(const RkBlob& b) {
    rk_f32x16 a; const unsigned w[8] = {b.w0.x, b.w0.y, b.w0.z, b.w0.w, b.w1.x, b.w1.y, b.w1.z, b.w1.w};
#pragma unroll
    for (int i = 0; i < 8; ++i) { a[2 * i] = bflo(w[i]); a[2 * i + 1] = bfhi(w[i]); }
    return a;
}

struct RkRaw { unsigned short r[8], k[8], v[8], a[8]; float d[8]; };
__device__ __forceinline__ void rk_load8(RkRaw& R, const bf16* prkv, const float* pdec, const bf16* paa) {
#pragma unroll
    for (int j = 0; j < 8; ++j) { R.r[j] = *(const GAS bf16*)(prkv + j * 1536); R.k[j] = *(const GAS bf16*)(prkv + j * 1536 + 512); R.v[j] = *(const GAS bf16*)(prkv + j * 1536 + 1024);
        R.d[j] = *(const GAS float*)(pdec + j * 512); R.a[j] = *(const GAS bf16*)(paa + j * 512); }
}
__device__ __forceinline__ void rwkvA_unit(LAS unsigned char* L, const InTab& A, unsigned char* ws, int bh, int chunk, int lane_in) {
    int lane = lane_in; asm volatile("" : "+v"(lane));
    const int b = bh >> 3, hd = bh & 7, cg = hd * 64 + lane, r32 = lane & 31, h = lane >> 5;
    const size_t row0 = (size_t)b * SEQ + (size_t)chunk * 32;
    const int uh = bh * 32 + (chunk & 31);
    const bf16* prkv = (const bf16*)(ws + WS_RKV) + row0 * 1536 + cg; const float* pdec = (const float*)(ws + WS_DEC) + row0 * 512 + cg; const bf16* paa = (const bf16*)(ws + WS_AA) + row0 * 512 + cg;
    float* pbon = (float*)(ws + WS_BON) + row0 * 8 + hd;
    const float mu_r = A[I_MU][cg], mu_k = A[I_MU][512 + cg], mu_v = A[I_MU][1024 + cg], kkc = A[I_KK][cg], kac = A[I_KA][cg], rkc = A[I_RK][cg];
    float rp = 0.f, kp = 0.f, vp = 0.f;
    if (chunk != 0) { rp = bf1(*(const GAS bf16*)(prkv - 1536)); kp = bf1(*(const GAS bf16*)(prkv - 1536 + 512)); vp = bf1(*(const GAS bf16*)(prkv - 1536 + 1024)); }
    float G = 1.0f;
    RkRaw Rc, Rn; rk_load8(Rc, prkv, pdec, paa);
#pragma unroll 1
    for (int q = 0; q < 4; ++q) {
        prkv += 8 * 1536; pdec += 8 * 512; paa += 8 * 512;
        if (q < 3) rk_load8(Rn, prkv, pdec, paa);
        LAS unsigned char* Lr = L + (8 * q) * RKA_RS_K + lane * 2;
        LAS unsigned char* Lt = L + lane * RKA_RS_J + (8 * q) * 2;
        unsigned tA[4], tB[4], tK[4], tV[4], pA = 0, pB = 0, pK = 0, pV = 0;
#pragma unroll
        for (int j = 0; j < 8; ++j) {
            const float rc = bf1(Rc.r[j]), kc = bf1(Rc.k[j]), vc = bf1(Rc.v[j]);
            const float rs = rc + (rp - rc) * mu_r, ks = kc + (kp - kc) * mu_k, vs = vc + (vp - vc) * mu_v; rp = rc; kp = kc; vp = vc;
            const float kkr = ks * kkc, n2 = wave_allsum(kkr * kkr), kk = kkr * __builtin_amdgcn_rsqf(__builtin_fmaxf(n2, 1e-24f));
            const float a_ = __builtin_amdgcn_rcpf(1.0f + __expf(-bf1(Rc.a[j]))), kx = ks * (1.0f + (a_ - 1.0f) * kac);
            const float bon = wave_allsum(rs * kx * rkc);
            if (lane == 0) *(GAS float*)(pbon + (8 * q + j) * 8) = bon;
            const float w = __expf(-0.6065306597f * __builtin_amdgcn_rcpf(1.0f + __expf(-Rc.d[j])));
            const float Gprev = G; G *= w; const float iG = __builtin_amdgcn_rcpf(G);
            const bf16 at = (bf16)f2bf(-kk * Gprev), rt = (bf16)f2bf(rs * G), bt = (bf16)f2bf(kk * a_ * iG), kt = (bf16)f2bf(kx * iG), vb = (bf16)f2bf(vs);
            *(LAS bf16*)(Lr + RKA_A + j * RKA_RS_K) = at; *(LAS bf16*)(Lr + RKA_R + j * RKA_RS_K) = rt; *(LAS bf16*)(Lr + RKA_B + j * RKA_RS_K) = bt; *(LAS bf16*)(Lr + RKA_K + j * RKA_RS_K) = kt;
            if (j & 1) { tA[j >> 1] = pA | ((unsigned)at << 16); tB[j >> 1] = pB | ((unsigned)bt << 16); tK[j >> 1] = pK | ((unsigned)kt << 16); tV[j >> 1] = pV | ((unsigned)vb << 16); } else { pA = at; pB = bt; pK = kt; pV = vb; }
        }
        *(LAS v4u*)(Lt + RKA_AT) = (v4u){tA[0], tA[1], tA[2], tA[3]}; *(LAS v4u*)(Lt + RKA_BH) = (v4u){tB[0], tB[1], tB[2], tB[3]}; *(LAS v4u*)(Lt + RKA_KH) = (v4u){tK[0], tK[1], tK[2], tK[3]}; *(LAS v4u*)(Lt + RKA_VT) = (v4u){tV[0], tV[1], tV[2], tV[3]};
        Rc = Rn;
    }
    const float GC = G;
    *(GAS float*)((float*)(ws + WS_GC) + (size_t)uh * 64 + lane) = GC;
    *(LAS float*)(L + RKA_GC + lane * 4) = GC;
    LDS_WAIT(); asm volatile("" ::: "memory");
    {
        rk_f32x16 aN = {}, aAK = {}, aRB = {}, aRK = {};
#pragma unroll
        for (int s = 0; s < 4; ++s) {
            const rk_bf16x8 fA = rk_frag(L + RKA_A, RKA_RS_K, r32, s, h), fR = rk_frag(L + RKA_R, RKA_RS_K, r32, s, h), fB = rk_frag(L + RKA_B, RKA_RS_K, r32, s, h), fK = rk_frag(L + RKA_K, RKA_RS_K, r32, s, h);
            aN = rk_mfma(fB, fA, aN); aAK = rk_mfma(fK, fA, aAK); aRB = rk_mfma(fB, fR, aRB); aRK = rk_mfma(fK, fR, aRK);
        }
        LDS_WAIT(); asm volatile("" ::: "memory");
#pragma unroll
        for (int i = 0; i < 16; ++i) { const int j = (i & 3) + 8 * (i >> 2) + 4 * h;
            if (!(j < r32)) { aN[i] = 0.f; aAK[i] = 0.f; }
            if (!(j <= r32)) { aRB[i] = 0.f; aRK[i] = 0.f; } }
#pragma unroll
        for (int g = 0; g < 4; ++g) *(LAS f32x4*)(L + RKA_N + r32 * 144 + (8 * g + 4 * h) * 4) = (f32x4){aN[4 * g], aN[4 * g + 1], aN[4 * g + 2], aN[4 * g + 3]};
        rk_store_tile_lds(L + RKA_MAK, RKA_RS_J, r32, 0, h, aAK); rk_store_tile_lds(L + RKA_MRB, RKA_RS_J, r32, 0, h, aRB); rk_store_tile_lds(L + RKA_MRK, RKA_RS_J, r32, 0, h, aRK);
    }
    LDS_WAIT(); asm volatile("" ::: "memory");
    {
        float T[32];
#pragma unroll
        for (int t = 0; t < 32; ++t) { float acc = (r32 == t) ? 1.0f : 0.0f;
#pragma unroll
            for (int j4 = 0; j4 < (t + 3) / 4; ++j4) { const f32x4 n4 = *(const LAS f32x4*)(L + RKA_N + t * 144 + j4 * 16);
#pragma unroll
                for (int e = 0; e < 4; ++e) if (4 * j4 + e < t) acc += n4[e] * T[4 * j4 + e]; }
            T[t] = acc; }
        LDS_WAIT(); asm volatile("" ::: "memory");
#pragma unroll
        for (int t = 0; t < 32; ++t) *(LAS bf16*)(L + RKA_T + t * RKA_RS_J + r32 * 2) = (bf16)f2bf(T[t]);
    }
    LDS_WAIT(); asm volatile("" ::: "memory");
    rk_bf16x8 fT[2];
#pragma unroll
    for (int s = 0; s < 2; ++s) fT[s] = rk_frag(L + RKA_T, RKA_RS_J, r32, s, h);
    {
        rk_f32x16 x0[2] = {{}, {}}, ap[2] = {{}, {}};
#pragma unroll
        for (int s = 0; s < 2; ++s) { const rk_bf16x8 fM = rk_frag(L + RKA_MAK, RKA_RS_J, r32, s, h);
#pragma unroll
            for (int nt = 0; nt < 2; ++nt) { x0[nt] = rk_mfma(fM, rk_frag(L + RKA_VT, RKA_RS_J, nt * 32 + r32, s, h), x0[nt]); ap[nt] = rk_mfma(fT[s], rk_frag(L + RKA_AT, RKA_RS_J, nt * 32 + r32, s, h), ap[nt]); } }
        LDS_WAIT(); asm volatile("" ::: "memory");
#pragma unroll
        for (int nt = 0; nt < 2; ++nt) { rk_store_tile_lds(L + RKA_X, RKA_RS_J, nt * 32 + r32, 0, h, x0[nt]); rk_store_tile_lds(L + RKA_AT, RKA_RS_J, nt * 32 + r32, 0, h, ap[nt]); }
    }
    LDS_WAIT(); asm volatile("" ::: "memory");
    {
        rk_f32x16 u0[2] = {{}, {}};
#pragma unroll
        for (int s = 0; s < 2; ++s)
#pragma unroll
            for (int nt = 0; nt < 2; ++nt) u0[nt] = rk_mfma(fT[s], rk_frag(L + RKA_X, RKA_RS_J, nt * 32 + r32, s, h), u0[nt]);
        LDS_WAIT(); asm volatile("" ::: "memory");
#pragma unroll
        for (int nt = 0; nt < 2; ++nt) rk_store_tile_lds(L + RKA_X, RKA_RS_J, nt * 32 + r32, 0, h, u0[nt]);
    }
    LDS_WAIT(); asm volatile("" ::: "memory");
    unsigned char* pq = ws + WS_PQ + (size_t)uh * 16384; unsigned char* ry = ws + WS_RY + (size_t)uh * 8192;
    rk_bf16x8 fRB[2], fRK[2], fAp[2][2], fBh[2][2], fKh[2][2], fU[2][2], fV[2][2];
#pragma unroll
    for (int s = 0; s < 2; ++s) { fRB[s] = rk_frag(L + RKA_MRB, RKA_RS_J, r32, s, h); fRK[s] = rk_frag(L + RKA_MRK, RKA_RS_J, r32, s, h);
#pragma unroll
        for (int nt = 0; nt < 2; ++nt) { fAp[nt][s] = rk_frag(L + RKA_AT, RKA_RS_J, nt * 32 + r32, s, h); fBh[nt][s] = rk_frag(L + RKA_BH, RKA_RS_J, nt * 32 + r32, s, h);
            fKh[nt][s] = rk_frag(L + RKA_KH, RKA_RS_J, nt * 32 + r32, s, h); fU[nt][s] = rk_frag(L + RKA_X, RKA_RS_J, nt * 32 + r32, s, h); fV[nt][s] = rk_frag(L + RKA_VT, RKA_RS_J, nt * 32 + r32, s, h); } }
#pragma unroll
    for (int kt = 0; kt < 2; ++kt) {
        rk_f32x16 acc;
#pragma unroll
        for (int g = 0; g < 4; ++g) { const v2u w = *(const LAS v2u*)(L + RKA_R + r32 * RKA_RS_K + (kt * 32 + 8 * g + 4 * h) * 2); acc[4 * g] = bflo(w.x); acc[4 * g + 1] = bfhi(w.x); acc[4 * g + 2] = bflo(w.y); acc[4 * g + 3] = bfhi(w.y); }
#pragma unroll
        for (int s = 0; s < 2; ++s) acc = rk_mfma(fAp[kt][s], fRB[s], acc);
        rk_store_tile_glb((bf16*)ry, 64, r32, kt * 32, h, acc);
    }
#pragma unroll
    for (int kt = 0; kt < 2; ++kt)
#pragma unroll
        for (int kq = 0; kq < 2; ++kq) { rk_f32x16 acc = {};
#pragma unroll
            for (int s = 0; s < 2; ++s) acc = rk_mfma(fAp[kq][s], fBh[kt][s], acc);
            acc = acc * *(const LAS float*)(L + RKA_GC + (kt * 32 + r32) * 4);
            rk_store_tile_glb((bf16*)pq, 64, kt * 32 + r32, kq * 32, h, acc); }
#pragma unroll
    for (int vt = 0; vt < 2; ++vt) {
        rk_f32x16 acc = {};
#pragma unroll
        for (int s = 0; s < 2; ++s) { acc = rk_mfma(fU[vt][s], fRB[s], acc); acc = rk_mfma(fV[vt][s], fRK[s], acc); }
        rk_store_blob((unsigned*)(ry + 4096) + vt * 512, lane, acc);
    }
#pragma unroll
    for (int kt = 0; kt < 2; ++kt)
#pragma unroll
        for (int vt = 0; vt < 2; ++vt) { rk_f32x16 acc = {};
#pragma unroll
            for (int s = 0; s < 2; ++s) { acc = rk_mfma(fBh[kt][s], fU[vt][s], acc); acc = rk_mfma(fKh[kt][s], fV[vt][s], acc); }
#pragma unroll
            for (int g = 0; g < 4; ++g) { const f32x4 gq = *(const LAS f32x4*)(L + RKA_GC + (kt * 32 + 8 * g + 4 * h) * 4); acc[4 * g] *= gq[0]; acc[4 * g + 1] *= gq[1]; acc[4 * g + 2] *= gq[2]; acc[4 * g + 3] *= gq[3]; }
            rk_store_blob((unsigned*)(pq + 8192) + (kt * 2 + vt) * 512, lane, acc); }
    LDS_WAIT(); asm volatile("" ::: "memory");
}
__device__ __forceinline__ void rwkvA_phase(Frame& F, const InTab& A, int half) {
    if (F.wave >= RKA_WAVES) return;
    LAS unsigned char* L = F.lds + RING_OFF + F.wave * RKA_BYTES;
    const int gw = F.bx * RKA_WAVES + F.wave, NGW = F.G * RKA_WAVES;
    for (int u = gw; u < 64 * 32; u += NGW) rwkvA_unit(L, A, F.ws, u >> 5, half * 32 + (u & 31), F.lane);
}
constexpr int RKB_RS = 144, RKB_SBUF = 64 * RKB_RS;
__device__ __forceinline__ void rwkvB_phase(Frame& F, int bh, int half) {
    int lane = F.lane; asm volatile("" : "+v"(lane));
    const int wave = F.wave, r32 = lane & 31, h = lane >> 5;
    LAS unsigned char* SB = F.lds + RING_OFF;
    unsigned char* ws = F.ws;
    const int b = bh >> 3, hd = bh & 7;
    bf16* Y = (bf16*)(ws + WS_Y);
    const int kt = (wave >> 1) & 1, vt = wave & 1;
    float* sst = (float*)(ws + WS_SST) + (size_t)bh * 4096 + (size_t)(wave & 3) * 1024;
    rk_f32x16 st = {};
    if (wave < 4) {
        if (half != 0) {
#pragma unroll
            for (int i = 0; i < 16; ++i) st[i] = *(const GAS float*)(sst + i * 64 + lane);
        }
        rk_store_tile_lds(SB, RKB_RS, vt * 32 + r32, kt * 32, h, st);
    }
    const int uh0 = bh * 32; const bool isS = wave < 4, isY = !isS && wave < 6;
    const unsigned char* fptr = isS ? ws + WS_PQ + (size_t)uh0 * 16384 + (kt * 32 + r32) * 128 + 16 * h : ws + WS_RY + (size_t)uh0 * 8192 + r32 * 128 + 16 * h;
    const unsigned char* bptr = isS ? ws + WS_PQ + (size_t)uh0 * 16384 + 8192 + (kt * 2 + vt) * 2048 + lane * 32 : ws + WS_RY + (size_t)uh0 * 8192 + 4096 + vt * 2048 + lane * 32;
    const LAS unsigned char* gl = SB + 2 * RKB_SBUF + (kt * 32 + 4 * h) * 4;
    const int fstride = isS ? 16384 : 8192;
    struct Op { v4u f[4]; v4u b0, b1; };
    { const int tid_ = wave * 64 + lane; *(LAS f32x4*)(SB + 2 * RKB_SBUF + tid_ * 16) = *(const GAS f32x4*)(ws + WS_GC + (size_t)uh0 * 256 + tid_ * 16); }
    Op o0, o1, o2;
#define RKB_LOAD(O_, c) do { const unsigned char* fp_ = fptr + (size_t)(c) * fstride; const unsigned char* bp_ = bptr + (size_t)(c) * fstride; \
        _Pragma("unroll") for (int s = 0; s < 4; ++s) O_.f[s] = *(const GAS v4u*)(fp_ + 32 * s); \
        O_.b0 = *(const GAS v4u*)bp_; O_.b1 = *(const GAS v4u*)(bp_ + 16); } while (0)
#define RKB_BAR() do { asm volatile("s_waitcnt lgkmcnt(0)" ::: "memory"); __builtin_amdgcn_s_barrier(); asm volatile("" ::: "memory"); } while (0)
#define RKB_NEXT(O_, c) RKB_LOAD(O_, ((c) + 3 < 32 ? (c) + 3 : 31))
#define RKB_STEP_S(O_, c) do { \
        const LAS unsigned char* cur = SB + ((c) & 1) * RKB_SBUF; LAS unsigned char* nxt = SB + (((c) & 1) ^ 1) * RKB_SBUF; \
        rk_bf16x8 fS[4]; _Pragma("unroll") for (int s = 0; s < 4; ++s) fS[s] = rk_frag(cur, RKB_RS, vt * 32 + r32, s, h); \
        RkBlob bb_; bb_.w0 = O_.b0; bb_.w1 = O_.b1; const rk_f32x16 q = rk_blob_f32(bb_); \
        _Pragma("unroll") for (int g = 0; g < 4; ++g) { const f32x4 gq = *(const LAS f32x4*)(gl + (c) * 256 + 32 * g); \
            st[4 * g] = st[4 * g] * gq[0] + q[4 * g]; st[4 * g + 1] = st[4 * g + 1] * gq[1] + q[4 * g + 1]; st[4 * g + 2] = st[4 * g + 2] * gq[2] + q[4 * g + 2]; st[4 * g + 3] = st[4 * g + 3] * gq[3] + q[4 * g + 3]; } \
        _Pragma("unroll") for (int s = 0; s < 4; ++s) st = rk_mfma(__builtin_bit_cast(rk_bf16x8, O_.f[s]), fS[s], st); \
        RKB_NEXT(O_, c); \
        rk_store_tile_lds(nxt, RKB_RS, vt * 32 + r32, kt * 32, h, st); \
        RKB_BAR(); } while (0)
#define RKB_STEP_Y(O_, c) do { \
        const LAS unsigned char* cur = SB + ((c) & 1) * RKB_SBUF; \
        rk_bf16x8 fS[4]; _Pragma("unroll") for (int s = 0; s < 4; ++s) fS[s] = rk_frag(cur, RKB_RS, vt * 32 + r32, s, h); \
        RkBlob bb_; bb_.w0 = O_.b0; bb_.w1 = O_.b1; rk_f32x16 acc = rk_blob_f32(bb_); \
        _Pragma("unroll") for (int s = 0; s < 4; ++s) acc = rk_mfma(fS[s], __builtin_bit_cast(rk_bf16x8, O_.f[s]), acc);       \
        RKB_NEXT(O_, c); \
        rk_store_tile_glb(Y + ((size_t)b * SEQ + (size_t)(half * 32 + (c)) * 32) * 512 + hd * 64, 512, r32, vt * 32, h, acc); \
        RKB_BAR(); } while (0)
    if (wave < 6) { RKB_LOAD(o0, 0); RKB_LOAD(o1, 1); RKB_LOAD(o2, 2); }
    __syncthreads();
    if (isS) {
#define R3S(c) RKB_STEP_S(o0, c); RKB_STEP_S(o1, (c) + 1); RKB_STEP_S(o2, (c) + 2);
        R3S(0) R3S(3) R3S(6) R3S(9) R3S(12) R3S(15) R3S(18) R3S(21) R3S(24) R3S(27)
        RKB_STEP_S(o0, 30); RKB_STEP_S(o1, 31);
#undef R3S
    } else if (isY) {
#define R3Y(c) RKB_STEP_Y(o0, c); RKB_STEP_Y(o1, (c) + 1); RKB_STEP_Y(o2, (c) + 2);
        R3Y(0) R3Y(3) R3Y(6) R3Y(9) R3Y(12) R3Y(15) R3Y(18) R3Y(21) R3Y(24) R3Y(27)
        RKB_STEP_Y(o0, 30); RKB_STEP_Y(o1, 31);
#undef R3Y
    } else {
#pragma unroll 1
        for (int c = 0; c < 32; ++c) RKB_BAR();
    }
#undef RKB_STEP_S
#undef RKB_STEP_Y
#undef RKB_NEXT
#undef RKB_BAR
#undef RKB_LOAD
    if (wave < 4 && half == 0) {
#pragma unroll
        for (int i = 0; i < 16; ++i) *(GAS float*)(sst + i * 64 + lane) = st[i];
    }
}

constexpr int NPHASE = 11;
template <int PHM> __global__ void __launch_bounds__(NWAVES * 64, 2) fwd_kernel(Args args) {
    extern __shared__ __attribute__((aligned(16))) unsigned char lds[];
    namespace cg = cooperative_groups;
    Frame F;
    F.lds = (LAS unsigned char*)lds;
    F.tid = threadIdx.x; F.lane = F.tid & 63; F.wave = __builtin_amdgcn_readfirstlane(F.tid >> 6);
    F.G = gridDim.x; F.bx = blockIdx.x;
    F.out = args.out; F.ws = args.ws;
#define PH_BEGIN InTab TAB; { ktab_t kp_ = (ktab_t)__builtin_amdgcn_kernarg_segment_ptr(); asm volatile("" : "+s"(kp_)); TAB.p = kp_; } { int t_ = threadIdx.x; asm volatile("" : "+v"(t_)); F.tid = t_; F.lane = t_ & 63; F.wave = __builtin_amdgcn_readfirstlane(t_ >> 6); } GAS unsigned char* wsg_ = (GAS unsigned char*)args.ws; asm volatile("" : "+s"(wsg_)); unsigned char* ws = (unsigned char*)wsg_; F.ws = ws; GAS bf16_t* gtg_ = (GAS bf16_t*)args.out; asm volatile("" : "+s"(gtg_)); bf16_t* GATES = (bf16_t*)gtg_; F.out = (float*)GATES; (void)GATES;
    const int lo = args.ph_lo, hi = args.ph_hi;
    XcdBarrier bar; bar.bar = nullptr; bar.x = 0; bar.st = nullptr;
    if (hi - lo > 1) {
        for (int u = threadIdx.x; u < (LDS_BYTES - 162816) / 4; u += NWAVES * 64) ((LAS unsigned*)(F.lds + 162816))[u] = 0u;
        __syncthreads();
        bar = xcd_barrier_post((unsigned*)(args.ws + WS_CTL) + CW_BAR, (volatile LAS unsigned*)(F.lds + MISC_OFF) + 8);
    }
#define IN(k) (((PHM >> (k)) & 1) && lo <= (k) && (k) < hi)
#ifdef PROBE_DUP
#define REPS(k) (((k) == PROBE_DUP) ? 2 : 1)
#else
#define REPS(k) 1
#endif
#define SEAM(k) do { if (IN(k) && IN((k) + 1)) { if ((k) == 0) cg::this_grid().sync(); else xcd_barrier(bar); } } while (0)
    using pg8::Gemm; using pg8::StaticOrder; using pg8::EpiRow8; using pg8::bf16_t;

    if (IN(0)) for (int rep_ = 0; rep_ < REPS(0); ++rep_) { if (rep_) xcd_barrier(bar); PH_BEGIN p0_prologue(F, TAB); } SEAM(0);
    if (IN(1)) for (int rep_ = 0; rep_ < REPS(1); ++rep_) { if (rep_) xcd_barrier(bar); PH_BEGIN
        Gemm g{(const bf16_t*)(ws + WS_XN), (const bf16_t*)(ws + WS_WIN), M, D_IN, D}; StaticOrder S; S.init(M, D_IN, F.G, F.bx);
        EpiRow8<pg8::FProj> E{{ws, GATES}};
        pg8::gemm_phase<EpiRow8<pg8::FProj>, StaticOrder, PG8_ALIGN, PG8_SP2>(F.lds + RING_OFF, g, S, E);
    } SEAM(1);
    if (IN(2)) for (int rep_ = 0; rep_ < REPS(2); ++rep_) { if (rep_) xcd_barrier(bar); PH_BEGIN prep1_phase(F, TAB); } SEAM(2);
    if (IN(3)) for (int rep_ = 0; rep_ < REPS(3); ++rep_) { if (rep_) xcd_barrier(bar); PH_BEGIN
        int klora = KLORA; asm volatile("" : "+s"(klora));
        Gemm g{(const bf16_t*)(ws + WS_LIN), (const bf16_t*)(ws + WS_WL), M, NLORA, klora}; StaticOrder S; S.init(M, NLORA, F.G, F.bx);
        EpiRow8<pg8::FLora> E{{ws, TAB[I_W0], TAB[I_A0]}};
        pg8::gemm_phase<EpiRow8<pg8::FLora>, StaticOrder, PG8_ALIGN, PG8_SP2>(F.lds + RING_OFF, g, S, E);
    } SEAM(3);
    if (IN(4)) for (int rep_ = 0; rep_ < REPS(4); ++rep_) { if (rep_) xcd_barrier(bar); PH_BEGIN
        const attn_body::AttnTensors AT{(const attn_body::bf16*)(ws + WS_Q), (const attn_body::bf16*)(ws + WS_K), (const attn_body::bf16*)(ws + WS_V), (attn_body::bf16*)(ws + WS_O)};
        const attn_body::StaticOrder S(F.bx, F.G);
        attn_body::attn_phase<attn_body::StaticOrder>((char*)lds + RING_OFF, AT, S);
    } SEAM(4);
    if (IN(5)) for (int rep_ = 0; rep_ < REPS(5); ++rep_) { if (rep_) xcd_barrier(bar); PH_BEGIN
#pragma unroll 1
        for (int half = 0; half < 2; ++half) {
            { GAS unsigned char* w_ = (GAS unsigned char*)args.ws; asm volatile("" : "+s"(w_)); F.ws = (unsigned char*)w_; }
            rwkvA_phase(F, TAB, half);
#ifdef PROBE_DUP_RKA
            rwkvA_phase(F, TAB, half);
#endif
            xcd_barrier(bar);
            { GAS unsigned char* w_ = (GAS unsigned char*)args.ws; asm volatile("" : "+s"(w_)); F.ws = (unsigned char*)w_; }
            if (F.bx < 64) rwkvB_phase(F, F.bx, half); else late_weights(F, TAB, half, 2, 64);
#ifdef PROBE_DUP_RKB
            if (F.bx < 64) rwkvB_phase(F, F.bx, half);
#endif
            if (half == 0) xcd_barrier(bar);
        }
    } SEAM(5);
#ifdef PROBE_BARS
    for (int pb_ = 0; pb_ < PROBE_BARS; ++pb_) xcd_barrier(bar);
#endif
    if (IN(6)) for (int rep_ = 0; rep_ < REPS(6); ++rep_) { if (rep_) xcd_barrier(bar); PH_BEGIN post_phase(F, TAB); } SEAM(6);
    if (IN(7)) for (int rep_ = 0; rep_ < REPS(7); ++rep_) { if (rep_) xcd_barrier(bar); PH_BEGIN
        Gemm g{(const bf16_t*)(ws + WS_YA), (const bf16_t*)(ws + WS_WA), M, D, 1024}; StaticOrder S; S.init(M, D, F.G, F.bx);
        pg8::EpiMerge E{GATES, (bf16_t*)(ws + WS_MERGED)};
        pg8::gemm_phase<pg8::EpiMerge, StaticOrder, PG8_ALIGN, PG8_SP2>(F.lds + RING_OFF, g, S, E);
    } SEAM(7);
    if (IN(8)) for (int rep_ = 0; rep_ < REPS(8); ++rep_) { if (rep_) xcd_barrier(bar); PH_BEGIN
        Gemm g{(const bf16_t*)(ws + WS_MERGED), (const bf16_t*)(ws + WS_WO), M, D, D}; StaticOrder S; S.init(M, D, F.G, F.bx);
        pg8::EpiResNorm<0> E{TAB[I_X], F.out, (bf16_t*)(ws + WS_XN), TAB[I_NFG], (float*)(ws + WS_CTL + CTL_SS1), (unsigned*)(ws + WS_CTL + CTL_CNT1), NORM_EPS};
        pg8::gemm_phase<pg8::EpiResNorm<0>, StaticOrder, PG8_ALIGN, PG8_SP2>(F.lds + RING_OFF, g, S, E);
    } SEAM(8);
    if (IN(9)) for (int rep_ = 0; rep_ < REPS(9); ++rep_) { if (rep_) xcd_barrier(bar); PH_BEGIN
        Gemm g{(const bf16_t*)(ws + WS_XN), (const bf16_t*)(ws + WS_W1), M, FF, D}; StaticOrder S; S.init(M, FF, F.G, F.bx);
        EpiRow8<pg8::FRelu2> E{{(bf16_t*)(ws + WS_H)}};
        pg8::gemm_phase<EpiRow8<pg8::FRelu2>, StaticOrder, PG8_ALIGN, PG8_SP2>(F.lds + RING_OFF, g, S, E);
    } SEAM(9);
    if (IN(10)) for (int rep_ = 0; rep_ < REPS(10); ++rep_) { if (rep_) xcd_barrier(bar); PH_BEGIN
        Gemm g{(const bf16_t*)(ws + WS_H), (const bf16_t*)(ws + WS_W2), M, D, FF}; StaticOrder S; S.init(M, D, F.G, F.bx);
        pg8::EpiResNorm<1> E{F.out, F.out, nullptr, TAB[I_NFIN], (float*)(ws + WS_CTL + CTL_SS2), (unsigned*)(ws + WS_CTL + CTL_CNT2), NORM_EPS};
        pg8::gemm_phase<pg8::EpiResNorm<1>, StaticOrder, PG8_ALIGN, PG8_SP2>(F.lds + RING_OFF, g, S, E);
    }
#undef IN
#undef SEAM
#undef PH_BEGIN
}


#ifdef DBG_DUMP
__global__ void dbg_dump(float* out, const unsigned char* ws) {
    const size_t i = (size_t)blockIdx.x * blockDim.x + threadIdx.x; if (i >= (size_t)M * 1024) return;
    const size_t m = i >> 10; const int c = (int)(i & 1023); float v = 0.f;
#if DBG_DUMP == 1
    v = bf1(((const bf16*)(ws + WS_O))[m * 1024 + c]);
#elif DBG_DUMP == 2
    v = c < 512 ? bf1(((const bf16*)(ws + WS_Y))[m * 512 + c]) : (c < 520 ? ((const float*)(ws + WS_BON))[m * 8 + (c - 512)] : 0.f);
#elif DBG_DUMP == 3
    v = c < 512 ? bf1(((const bf16*)(ws + WS_Q))[m * 512 + c]) : bf1(((const bf16*)(ws + WS_K))[m * 512 + c - 512]);
#elif DBG_DUMP == 4
    v = c < 512 ? ((const float*)(ws + WS_DEC))[m * 512 + c] : bf1(((const bf16*)(ws + WS_AA))[m * 512 + c - 512]);
#elif DBG_DUMP == 6
    v = c < 256 ? bf1(((const bf16*)(ws + WS_WAG))[m * 256 + c]) : (c < 512 ? bf1(((const bf16*)(ws + WS_LIN))[m * 256 + c - 256]) : 0.f);
#elif DBG_DUMP == 7
    { const bf16* wl = (const bf16*)(ws + WS_WL); const size_t j = (m * 1024 + c); v = j < (size_t)NLORA * KLORA ? bf1(wl[j]) : 0.f; }
#elif DBG_DUMP == 8
    v = c < 512 ? bf1(((const bf16*)(ws + WS_GG))[m * 512 + c]) : 0.f;
#elif DBG_DUMP == 5
    v = bf1(((const bf16*)(ws + WS_RKV))[m * 1536 + c]);
#endif
    out[i] = v;
}
#endif

#ifdef DBG_FIXLORA
__global__ void dbg_fixlora(Args A) {
    const size_t i = (size_t)blockIdx.x * blockDim.x + threadIdx.x; if (i >= (size_t)M * 512) return;
    const size_t m = i >> 9; const int c = (int)(i & 511);
    const bf16* LINr = (const bf16*)(A.ws + WS_LIN) + m * 256;
#if DBG_FIXLORA & 1
    { float g = 0.f; for (int k = 0; k < 128; ++k) g += bf1(LINr[128 + k]) * A[I_G2][(size_t)k * 512 + c]; ((bf16*)(A.ws + WS_GG))[m * 512 + c] = (bf16)f2bf(g); }
#endif
#if DBG_FIXLORA & 2
    { float s = A[I_A0][c]; for (int k = 0; k < 64; ++k) s += bf1(LINr[64 + k]) * A[I_A2][(size_t)k * 512 + c]; ((bf16*)(A.ws + WS_AA))[m * 512 + c] = (bf16)f2bf(1.0f / (1.0f + expf(-s))); }
#endif
#if DBG_FIXLORA & 4
    { float s = A[I_W0][c]; for (int k = 0; k < 64; ++k) s += bf1(LINr[k]) * A[I_W2][(size_t)k * 512 + c]; const float w = -log1pf(expf(-s)) - 0.5f; ((float*)(A.ws + WS_DEC))[m * 512 + c] = expf(-expf(w)); }
#endif
}
#endif
#ifndef MK_ONE_LAUNCH
#define MK_ONE_LAUNCH 0
#endif
#ifndef MK_MASK
#define MK_MASK ((1 << NPHASE) - 1)
#endif
typedef void (*kern_t)(Args);
template <int P> struct KTab { static void fill(kern_t* t) { t[P] = fwd_kernel<(1 << P)>; KTab<P - 1>::fill(t); } };
template <> struct KTab<-1> { static void fill(kern_t*) {} };
extern "C" void kernel_launch(void* const* d_in, const int* in_sizes, int n_in, void* d_out, int out_size, void* d_ws, size_t ws_size, hipStream_t stream) {
    static int grid = 0; static kern_t ktab[NPHASE];
    if (grid == 0) {
        if (n_in != 26 || in_sizes[0] != M * D || out_size != M * D || ws_size < WS_END) { fprintf(stderr, "kernel_launch: unexpected shapes (n_in %d, in0 %d, out %d, ws %zu); nothing launched\n", n_in, n_in > 0 ? in_sizes[0] : -1, out_size, ws_size); grid = -1; return; }
        int dev = 0, cus = 0;
        if (hipGetDevice(&dev) != hipSuccess || hipDeviceGetAttribute(&cus, hipDeviceAttributeMultiprocessorCount, dev) != hipSuccess) { grid = -1; return; }
#if MK_ONE_LAUNCH
        int per_cu = 0;
        if (hipFuncSetAttribute((const void*)fwd_kernel<MK_MASK>, hipFuncAttributeMaxDynamicSharedMemorySize, LDS_BYTES) != hipSuccess) { fprintf(stderr, "kernel_launch: hipFuncSetAttribute failed\n"); grid = -1; return; }
        if (hipOccupancyMaxActiveBlocksPerMultiprocessor(&per_cu, (const void*)fwd_kernel<MK_MASK>, NWAVES * 64, LDS_BYTES) != hipSuccess || per_cu < 1) { fprintf(stderr, "kernel_launch: occupancy query says %d blocks per CU\n", per_cu); (void)hipGetLastError(); grid = -1; return; }
#else
        KTab<NPHASE - 1>::fill(ktab);
        for (int p = 0; p < NPHASE; ++p) if (hipFuncSetAttribute((const void*)ktab[p], hipFuncAttributeMaxDynamicSharedMemorySize, LDS_BYTES) != hipSuccess) { fprintf(stderr, "kernel_launch: hipFuncSetAttribute failed\n"); grid = -1; return; }
#endif
        grid = cus;
        if (grid != 256) fprintf(stderr, "kernel_launch: note: %d CUs (built for 256)\n", grid);
    }
    if (grid < 0) return;
    Args a{};
    for (int i = 0; i < 26; ++i) a.in[i] = (const float*)d_in[i];
    a.out = (float*)d_out; a.ws = (unsigned char*)d_ws;
#if MK_ONE_LAUNCH
    a.ph_lo = 0; a.ph_hi = NPHASE;
    if (hipMemsetAsync((char*)d_ws + WS_CTL, 0, CTL_ZERO_BYTES, stream) != hipSuccess) { fprintf(stderr, "kernel_launch: hipMemsetAsync failed\n"); return; }
    void* kargs[] = {&a};
    hipError_t e = hipLaunchCooperativeKernel((const void*)fwd_kernel<MK_MASK>, dim3(grid), dim3(NWAVES * 64), kargs, LDS_BYTES, stream);
    if (e != hipSuccess) fprintf(stderr, "kernel_launch: cooperative launch failed: %s\n", hipGetErrorString(e));
#else
#ifdef DBG_DUMP
    for (int p = 0; p <= DBG_STOP; ++p) { a.ph_lo = p; a.ph_hi = p + 1; hipLaunchKernelGGL(ktab[p], dim3(grid), dim3(NWAVES * 64), LDS_BYTES, stream, a); }
    hipLaunchKernelGGL(dbg_dump, dim3((M * 1024) / 256), dim3(256), 0, stream, (float*)d_out, (const unsigned char*)d_ws);
#else
    for (int p = 0; p < NPHASE; ++p) { a.ph_lo = p; a.ph_hi = p + 1; hipLaunchKernelGGL(ktab[p], dim3(grid), dim3(NWAVES * 64), LDS_BYTES, stream, a);
#ifdef DBG_FIXLORA
        if (p == 3) hipLaunchKernelGGL(dbg_fixlora, dim3((M * 512) / 256), dim3(256), 0, stream, a);
#endif
    }
#endif
#endif
}
```

```cpp
#define MK_ONE_LAUNCH 1
#include <hip/hip_runtime.h>
#include <cstdio>
#include <cstdint>
constexpr int NWAVES = 8;
constexpr int BATCH = 8, SEQ = 2048, D = 1024, M = BATCH * SEQ;
constexpr int D_IN = 5376, FF = 4096, RWW = 512, NLORA = 1536, KLORA = 256;
constexpr float NORM_EPS = 1e-6f, SUBLN_EPS = 1e-5f, GN_EPS = 64e-5f, LAMBDA_INIT = 0.2f;
constexpr size_t MiB = 1u << 20;
constexpr size_t WS_CTL = 0, CTL_ZERO_BYTES = 256 * 1024;
constexpr size_t CTL_SS1 = 65536, CTL_SS2 = 131072, CTL_CNT1 = 196608, CTL_CNT2 = 212992;
constexpr size_t WS_ROPE_C = 512 * 1024, WS_ROPE_S = 768 * 1024;
constexpr size_t WS_BON = 1 * MiB;
constexpr size_t WS_WIN = 2 * MiB;
constexpr size_t WS_WA = WS_WIN + (size_t)D_IN * D * 2;
constexpr size_t WS_WB = WS_WA + 1 * MiB;
constexpr size_t WS_WO = WS_WB + 1 * MiB;
constexpr size_t WS_W1 = WS_WO + 2 * MiB;
constexpr size_t WS_W2 = WS_W1 + 8 * MiB;
constexpr size_t WS_WL = WS_W2 + 8 * MiB;
static_assert(WS_WL + (size_t)NLORA * KLORA * 2 <= 34 * MiB, "weights");
constexpr size_t WS_XN = 34 * MiB;
constexpr size_t WS_DEC = WS_XN;
constexpr size_t WS_Q = 66 * MiB, WS_K = 82 * MiB, WS_V = 98 * MiB;
constexpr size_t WS_RKV = 114 * MiB;
constexpr size_t WS_WAG = 162 * MiB, WS_LIN = 170 * MiB;
constexpr size_t WS_Y = 162 * MiB;
constexpr size_t WS_AA = 178 * MiB, WS_GG = 194 * MiB;
constexpr size_t WS_O = 210 * MiB;
constexpr size_t WS_YA = 66 * MiB, WS_YB = 82 * MiB;
constexpr size_t WS_TMP = 114 * MiB;
constexpr size_t WS_MERGED = 210 * MiB;
constexpr size_t WS_H = 66 * MiB;
constexpr size_t WS_END = 244 * MiB;
constexpr int RING_OFF = 0, RING_BYTES = 131072;
constexpr int LDS_BYTES = 163840;

#include <hip/hip_runtime.h>
#include <cstdio>
#include <cstdint>
namespace pg8 {
#define PG8_LAS __attribute__((address_space(3)))
typedef unsigned short bf16_t;
typedef short bf16x8 __attribute__((ext_vector_type(8)));
typedef float f32x4 __attribute__((ext_vector_type(4)));
typedef unsigned u32x4 __attribute__((ext_vector_type(4)));
constexpr int BM = 256, BK = 64, HALF = 128, HTB = HALF * BK * 2  , STAGE_BYTES = 8 * HTB, NXCD = 8, WGM = 8;

__host__ __device__ __forceinline__ int lds_byte(int r, int c) { const int st = (r >> 4) * 2 + (c >> 5), rr = r & 15, cc = c & 31, ob = rr * 64 + cc * 2; return st * 1024 + (ob ^ (((ob >> 9) & 1) << 5)); }
__host__ __device__ __forceinline__ void stage_rc(int b, int& R, int& C) { const int st = b / 1024, sb = b % 1024, swz = sb ^ (((sb >> 9) & 1) << 5); R = (st >> 1) * 16 + swz / 64; C = (st & 1) * 32 + (swz % 64) / 2; }
__host__ __device__ __forceinline__ int perm32(int rho) { const int n = rho >> 4, i = rho & 15; return 8 * (i >> 2) + 4 * n + (i & 3); }

struct Unit { int pm, pn; };
struct Gemm { const bf16_t* A; const bf16_t* Bt; int M, N, K; };

struct StaticOrder {
    int nM, nN, nwg, G, c;
    __host__ __device__ void init(int M, int N, int G_, int c_) { nM = M / BM; nN = N / BM; nwg = nM * nN; G = G_; c = c_; }
    __host__ __device__ bool next(int i, Unit& u) const {
        const long L = (long)i * G + c; if (L >= nwg) return false;
        int wgid = (int)L; { const int q = nwg / NXCD, r = nwg % NXCD, xcd = wgid % NXCD, off = wgid / NXCD; wgid = (xcd < r ? xcd * (q + 1) : r * (q + 1) + (xcd - r) * q) + off; }
        const int nig = WGM * nN, gid = wgid / nig, fm = gid * WGM, gsz = (nM - fm) < WGM ? (nM - fm) : WGM;
        u.pm = fm + ((wgid % nig) % gsz); u.pn = (wgid % nig) / gsz; return true;
    }
    __device__ __forceinline__ void a_ready(const Unit&) const {}
    __device__ __forceinline__ void done(const Unit&) const {}
};

typedef float f32x2c_t __attribute__((ext_vector_type(2))); typedef __bf16 bf16x2c_t __attribute__((ext_vector_type(2)));
__device__ __forceinline__ unsigned cvt_pk_bf16(float lo, float hi) { f32x2c_t v = {lo, hi}; bf16x2c_t b = __builtin_convertvector(v, bf16x2c_t); return __builtin_bit_cast(unsigned, b); }
typedef float f32x2 __attribute__((ext_vector_type(2)));
__device__ __forceinline__ f32x2 gelu_pk(f32x2 v) {
    const f32x2 av = __builtin_elementwise_abs(v), d = av * 0.2316418882f + 1.0f;
    f32x2 t; t.x = __builtin_amdgcn_rcpf(d.x); t.y = __builtin_amdgcn_rcpf(d.y);
    f32x2 q = t * 0.5307027145f + (-0.7265760135f); q = q * t + 0.7107068705f; q = q * t + (-0.142248368f); q = q * t + 0.127414796f; q = q * t;
    const f32x2 s = (v * v) * (-0.72134752044f);
    f32x2 e; e.x = __builtin_amdgcn_exp2f(s.x); e.y = __builtin_amdgcn_exp2f(s.y);
    const f32x2 m = v * (q * e), r = v - m;
    f32x2 o; o.x = v.x < 0.f ? m.x : r.x; o.y = v.y < 0.f ? m.y : r.y; return o;
}

template <int ACT  > struct EpiBf16 {
    static constexpr int MIDK = 0; static constexpr bool PERM = true, AFTER_DRAIN = false; static_assert(ACT == 0 || ACT == 1, "EpiBf16: ACT is 0 (none) or 1 (gelu_pk)");
    bf16_t* O; int ldc; const float* bias; int split_cols; size_t split_stride; float scale0;
    __device__ __forceinline__ void operator()(const f32x4 (&acc)[2][2][4][2], const Unit& u, int wr, int wc, int fr, int fq) const {
        const int row0 = u.pm * BM + wr * 64 + fr; int colt = u.pn * BM; bf16_t* base = O;
        float sc = 1.f; if (split_cols) { const int t = colt / split_cols; base += (size_t)t * split_stride; colt -= t * split_cols; if (t == 0) sc = scale0; }
        const int col0 = colt + wc * 32 + 8 * fq, bcol0 = u.pn * BM + wc * 32 + 8 * fq;
        f32x4 bv[2][2];
#pragma unroll
        for (int bj = 0; bj < 2; ++bj)
#pragma unroll
            for (int n = 0; n < 2; ++n) bv[bj][n] = bias ? *(const f32x4*)(bias + bcol0 + bj * HALF + 4 * n) : (f32x4){0.f, 0.f, 0.f, 0.f};
#pragma unroll
        for (int ai = 0; ai < 2; ++ai)
#pragma unroll
            for (int m = 0; m < 4; ++m) { bf16_t* rowp = base + (size_t)(row0 + ai * HALF + m * 16) * ldc + col0;
#pragma unroll
                for (int bj = 0; bj < 2; ++bj) { f32x4 v0 = acc[ai][bj][m][0] + bv[bj][0], v1 = acc[ai][bj][m][1] + bv[bj][1];
                    if (ACT == 1) { f32x2 a = gelu_pk((f32x2){v0[0], v0[1]}), b = gelu_pk((f32x2){v0[2], v0[3]}), c = gelu_pk((f32x2){v1[0], v1[1]}), d = gelu_pk((f32x2){v1[2], v1[3]});
                        v0 = (f32x4){a.x, a.y, b.x, b.y}; v1 = (f32x4){c.x, c.y, d.x, d.y}; }
                    v0 = v0 * sc; v1 = v1 * sc; u32x4 w; w.x = cvt_pk_bf16(v0[0], v0[1]); w.y = cvt_pk_bf16(v0[2], v0[3]); w.z = cvt_pk_bf16(v1[0], v1[1]); w.w = cvt_pk_bf16(v1[2], v1[3]);
                    *(u32x4*)(rowp + bj * HALF) = w; } }
    }
};
typedef unsigned u32x2 __attribute__((ext_vector_type(2)));
__device__ __forceinline__ float bf_lo(unsigned w) { return __builtin_bit_cast(float, w << 16); }
__device__ __forceinline__ float bf_hi(unsigned w) { return __builtin_bit_cast(float, w & 0xffff0000u); }
__device__ __forceinline__ u32x4 pack8(f32x4 v0, f32x4 v1) { u32x4 w; w.x = cvt_pk_bf16(v0[0], v0[1]); w.y = cvt_pk_bf16(v0[2], v0[3]); w.z = cvt_pk_bf16(v1[0], v1[1]); w.w = cvt_pk_bf16(v1[2], v1[3]); return w; }
__device__ __forceinline__ float sigmoidf_(float x) { return __builtin_amdgcn_rcpf(1.0f + __expf(-x)); }
template <class F> struct EpiRow8 {
    static constexpr int MIDK = 0; static constexpr bool PERM = true, AFTER_DRAIN = false;
    F f;
    __device__ __forceinline__ void operator()(const f32x4 (&acc)[2][2][4][2], const Unit& u, int wr, int wc, int fr, int fq) const {
        const int row0 = u.pm * BM + wr * 64 + fr, c0 = wc * 32 + 8 * fq;
#pragma unroll
        for (int ai = 0; ai < 2; ++ai)
#pragma unroll
            for (int m = 0; m < 4; ++m) { const int row = row0 + ai * HALF + m * 16;
#pragma unroll
                for (int bj = 0; bj < 2; ++bj) { f(u.pn, row, c0 + bj * HALF, acc[ai][bj][m][0], acc[ai][bj][m][1]); if (F::FENCE) asm volatile("" ::: "memory"); } }
    }
};
constexpr float ATT_C2 = 0.125f * 1.4426950408889634f;
struct FProj {
    static constexpr bool FENCE = false;
    unsigned char* ws; bf16_t* GATES;
    __device__ __forceinline__ void operator()(int pn, int row, int cu, f32x4 v0, f32x4 v1) const {
        if (pn < 4) {
            const int sh = cu >> 6, j = (cu & 63) >> 3, pos = row & 2047;
            const f32x4 c = *(const f32x4*)((const float*)(ws + WS_ROPE_C) + pos * 32 + 4 * j), s = *(const f32x4*)((const float*)(ws + WS_ROPE_S) + pos * 32 + 4 * j);
            const float sc = pn < 2 ? ATT_C2 : 1.0f;
            const f32x4 o1 = (v0 * c - v1 * s) * sc, o2 = (v1 * c + v0 * s) * sc;
            bf16_t* dst = (bf16_t*)(ws + (pn < 2 ? WS_Q : WS_K)) + (size_t)row * 512 + (pn & 1) * 256 + sh * 64 + 4 * j;
            u32x2 w1, w2; w1.x = cvt_pk_bf16(o1[0], o1[1]); w1.y = cvt_pk_bf16(o1[2], o1[3]); w2.x = cvt_pk_bf16(o2[0], o2[1]); w2.y = cvt_pk_bf16(o2[2], o2[3]);
            *(u32x2*)dst = w1; *(u32x2*)(dst + 32) = w2;
        } else if (pn < 13) {
            size_t off; int pitch, col;
            if (pn < 6) { off = WS_V; pitch = 512; col = (pn - 4) * 256; }
            else if (pn < 12) { off = WS_RKV; pitch = 1536; col = (pn - 6) * 256; }
            else { off = WS_WAG; pitch = 256; col = 0; }
            *(u32x4*)((bf16_t*)(ws + off) + (size_t)row * pitch + col + cu) = pack8(v0, v1);
        } else *(u32x4*)(GATES + (size_t)row * 2048 + (pn - 13) * 256 + cu) = pack8(v0, v1);
    }
};
struct FLora {
    static constexpr bool FENCE = false;
    unsigned char* ws; const float *w0, *a0;
    __device__ __forceinline__ void operator()(int pn, int row, int cu, f32x4 v0, f32x4 v1) const {
        const int c = (pn & 1) * 256 + cu;
        if (pn < 2) {
            const f32x4 b0 = *(const f32x4*)(w0 + c), b1 = *(const f32x4*)(w0 + c + 4);
            float* dst = (float*)(ws + WS_DEC) + (size_t)row * 512 + c; *(f32x4*)dst = v0 + b0; *(f32x4*)(dst + 4) = v1 + b1;
        } else if (pn < 4) {
            const f32x4 b0 = *(const f32x4*)(a0 + c), b1 = *(const f32x4*)(a0 + c + 4);
            *(u32x4*)((bf16_t*)(ws + WS_AA) + (size_t)row * 512 + c) = pack8(v0 + b0, v1 + b1);
        } else *(u32x4*)((bf16_t*)(ws + WS_GG) + (size_t)row * 512 + c) = pack8(v0, v1);
    }
};
struct EpiMerge {
    static constexpr int MIDK = 8; static constexpr bool PERM = true, AFTER_DRAIN = false;
    const bf16_t* GATES; bf16_t* MERGED;
    static __device__ __forceinline__ float ratio_(float ga, float gb) { return (1.0f + __expf(-gb)) * __builtin_amdgcn_rcpf(1.0f + __expf(-ga)); }
    __device__ __forceinline__ void mid(f32x4 (&acc)[2][2][4][2], const Unit& u, int wr, int wc, int fr, int fq) const {
        int fr_ = fr; asm volatile("" : "+v"(fr_));
        const bf16_t* gp0 = GATES + (size_t)(u.pm * BM + wr * 64 + fr_) * 2048 + u.pn * BM + wc * 32 + 8 * fq;
#pragma unroll
        for (int ai = 0; ai < 2; ++ai)
#pragma unroll
            for (int m = 0; m < 4; ++m)
#pragma unroll
                for (int bj = 0; bj < 2; ++bj) { const bf16_t* gp = gp0 + (size_t)(ai * HALF + m * 16) * 2048 + bj * HALF;
                    const u32x4 ga = *(const u32x4*)gp, gb = *(const u32x4*)(gp + 1024);
                    f32x4& v0 = acc[ai][bj][m][0]; f32x4& v1 = acc[ai][bj][m][1];
                    v0[0] *= ratio_(bf_lo(ga.x), bf_lo(gb.x)); v0[1] *= ratio_(bf_hi(ga.x), bf_hi(gb.x)); v0[2] *= ratio_(bf_lo(ga.y), bf_lo(gb.y)); v0[3] *= ratio_(bf_hi(ga.y), bf_hi(gb.y));
                    v1[0] *= ratio_(bf_lo(ga.z), bf_lo(gb.z)); v1[1] *= ratio_(bf_hi(ga.z), bf_hi(gb.z)); v1[2] *= ratio_(bf_lo(ga.w), bf_lo(gb.w)); v1[3] *= ratio_(bf_hi(ga.w), bf_hi(gb.w));
                    asm volatile("" ::: "memory"); }
    }
    __device__ __forceinline__ void operator()(const f32x4 (&acc)[2][2][4][2], const Unit& u, int wr, int wc, int fr, int fq) const {
        const int row0 = u.pm * BM + wr * 64 + fr, c0 = u.pn * BM + wc * 32 + 8 * fq;
#pragma unroll
        for (int ai = 0; ai < 2; ++ai)
#pragma unroll
            for (int m = 0; m < 4; ++m) { const int row = row0 + ai * HALF + m * 16;
#pragma unroll
                for (int bj = 0; bj < 2; ++bj) { const u32x4 g = *(const u32x4*)(GATES + (size_t)row * 2048 + 1024 + c0 + bj * HALF);
                    f32x4 v0 = acc[ai][bj][m][0], v1 = acc[ai][bj][m][1];
                    v0[0] *= sigmoidf_(bf_lo(g.x)); v0[1] *= sigmoidf_(bf_hi(g.x)); v0[2] *= sigmoidf_(bf_lo(g.y)); v0[3] *= sigmoidf_(bf_hi(g.y));
                    v1[0] *= sigmoidf_(bf_lo(g.z)); v1[1] *= sigmoidf_(bf_hi(g.z)); v1[2] *= sigmoidf_(bf_lo(g.w)); v1[3] *= sigmoidf_(bf_hi(g.w));
                    *(u32x4*)(MERGED + (size_t)row * 1024 + c0 + bj * HALF) = pack8(v0, v1); } }
    }
};
struct FRes {
    static constexpr bool FENCE = false;
    const float* base; float* out;
    __device__ __forceinline__ void operator()(int pn, int row, int cu, f32x4 v0, f32x4 v1) const {
        const size_t off = (size_t)row * 1024 + pn * 256 + cu; const f32x4 b0 = *(const f32x4*)(base + off), b1 = *(const f32x4*)(base + off + 4);
        *(f32x4*)(out + off) = b0 + v0; *(f32x4*)(out + off + 4) = b1 + v1;
    }
};
struct FRelu2 {
    static constexpr bool FENCE = false;
    bf16_t* H;
    __device__ __forceinline__ void operator()(int pn, int row, int cu, f32x4 v0, f32x4 v1) const {
        f32x4 r0, r1;
#pragma unroll
        for (int e = 0; e < 4; ++e) { const float a = __builtin_fmaxf(v0[e], 0.f), b = __builtin_fmaxf(v1[e], 0.f); r0[e] = a * a; r1[e] = b * b; }
        *(u32x4*)(H + (size_t)row * 4096 + pn * 256 + cu) = pack8(r0, r1);
    }
};

__device__ __forceinline__ float xsum_fq(float x) {
    { auto r = __builtin_amdgcn_permlane16_swap(__builtin_bit_cast(unsigned, x), __builtin_bit_cast(unsigned, x), false, false); const unsigned a = r[0], b = r[1]; x = __builtin_bit_cast(float, a) + __builtin_bit_cast(float, b); }
    { auto r = __builtin_amdgcn_permlane32_swap(__builtin_bit_cast(unsigned, x), __builtin_bit_cast(unsigned, x), false, false); const unsigned a = r[0], b = r[1]; x = __builtin_bit_cast(float, a) + __builtin_bit_cast(float, b); }
    return x;
}
template <int MODE> struct EpiResNorm {
    static constexpr int MIDK = 0; static constexpr bool PERM = true, AFTER_DRAIN = false;
    const float* base; float* out; bf16_t* xn; const float* g; float* ss; unsigned* cnt; float eps;
    __device__ __forceinline__ void operator()(f32x4 (&acc)[2][2][4][2], const Unit& u, int wr, int wc, int fr, int fq) const {
        const int row0 = u.pm * BM + wr * 64 + fr, c0 = u.pn * BM + wc * 32 + 8 * fq;
#pragma unroll
        for (int ai = 0; ai < 2; ++ai)
#pragma unroll
            for (int m = 0; m < 4; ++m) { const int row = row0 + ai * HALF + m * 16; float s = 0.f;
#pragma unroll
                for (int bj = 0; bj < 2; ++bj) { const size_t off = (size_t)row * 1024 + c0 + bj * HALF; const f32x4 b0 = *(const f32x4*)(base + off), b1 = *(const f32x4*)(base + off + 4);
                    f32x4& v0 = acc[ai][bj][m][0]; f32x4& v1 = acc[ai][bj][m][1]; v0 += b0; v1 += b1;
                    if (MODE == 0) { *(f32x4*)(out + off) = v0; *(f32x4*)(out + off + 4) = v1; }
                    s += (v0[0] * v0[0] + v0[1] * v0[1]) + (v0[2] * v0[2] + v0[3] * v0[3]) + (v1[0] * v1[0] + v1[1] * v1[1]) + (v1[2] * v1[2] + v1[3] * v1[3]); }
                s = xsum_fq(s);
                if (fq == 0) __hip_atomic_fetch_add(ss + row, s, __ATOMIC_RELAXED, __HIP_MEMORY_SCOPE_AGENT);
                if (m & 1) asm volatile("" ::: "memory"); }
        asm volatile("s_waitcnt vmcnt(0)" ::: "memory");
        unsigned* c_ = cnt + 64 * u.pm;
        if (fr == 0 && fq == 0) __hip_atomic_fetch_add(c_, 1u, __ATOMIC_RELAXED, __HIP_MEMORY_SCOPE_AGENT);
        { unsigned spins = 0; while ((unsigned)__builtin_amdgcn_readfirstlane(__hip_atomic_load(c_, __ATOMIC_RELAXED, __HIP_MEMORY_SCOPE_AGENT)) < 32u && ++spins < (1u << 22)) __builtin_amdgcn_s_sleep(2); }
        asm volatile("" ::: "memory");
#pragma unroll
        for (int ai = 0; ai < 2; ++ai)
#pragma unroll
            for (int m = 0; m < 4; ++m) { const int row = row0 + ai * HALF + m * 16;
                const float rstd = 1.0f / sqrtf(__hip_atomic_load(ss + row, __ATOMIC_RELAXED, __HIP_MEMORY_SCOPE_AGENT) * (1.0f / 1024.0f) + eps);
#pragma unroll
                for (int bj = 0; bj < 2; ++bj) { const size_t off = (size_t)row * 1024 + c0 + bj * HALF; const f32x4 g0 = *(const f32x4*)(g + c0 + bj * HALF), g1 = *(const f32x4*)(g + c0 + bj * HALF + 4);
                    const f32x4 o0 = acc[ai][bj][m][0] * rstd * g0, o1 = acc[ai][bj][m][1] * rstd * g1;
                    if (MODE == 0) *(u32x4*)(xn + off) = pack8(o0, o1); else { *(f32x4*)(out + off) = o0; *(f32x4*)(out + off + 4) = o1; } }
                if (m & 1) asm volatile("" ::: "memory"); }
    }
};
template <class Epi, class Sched, bool ALIGN_EPI = false, bool SP2 = false>
__device__ __forceinline__ void gemm_phase(PG8_LAS unsigned char* lds, const Gemm g, const Sched& S, const Epi& E) {
    int tid_ = threadIdx.x; asm volatile("" : "+v"(tid_));
    const int tid = tid_, wid = __builtin_amdgcn_readfirstlane(tid >> 6), lane = tid & 63, wr = wid >> 2, wc = wid & 3, fr = lane & 15, fq = lane >> 4;
    const int K = g.K, nt = K / BK;
    unsigned voffA[2], voffB[2];
#pragma unroll
    for (int i = 0; i < 2; ++i) { int R, C; stage_rc(tid * 16 + i * 8192, R, C); const int Rb = Epi::PERM ? ((R & ~31) + perm32(R & 31)) : R;
        voffA[i] = (unsigned)(R * K + C) * 2u; voffB[i] = (unsigned)(Rb * K + C) * 2u; }
    const size_t kstep = (size_t)(BK * 2);
    const size_t hstep = (size_t)HALF * K * 2;
    const size_t tstep = 2 * hstep;
    const unsigned ldsw = (unsigned)wid * 1024u;
    const int aoff = lds_byte(wr * 64 + fr, fq * 8), boff = lds_byte(wc * 32 + fr, fq * 8);
#define PG8_SA(b, h) (((b) * 2 + (h)) * HTB)
#define PG8_SB(b, h) ((4 + (b) * 2 + (h)) * HTB)
#define PG8_STAGE(bufoff, gbase, voff) do { _Pragma("unroll") for (int _i = 0; _i < 2; ++_i) \
        __builtin_amdgcn_global_load_lds((const unsigned*)((const char*)(gbase) + (voff)[_i]), (PG8_LAS unsigned*)(lds + (bufoff) + ldsw + _i * 8192), 16, 0, 0); } while (0)
#define PG8_LDA(dst, b, h) do { _Pragma("unroll") for (int m = 0; m < 4; ++m) _Pragma("unroll") for (int k = 0; k < 2; ++k) dst[m][k] = *(const PG8_LAS bf16x8*)(lds + PG8_SA(b, h) + aoff + m * 2048 + k * 1024); } while (0)
#define PG8_LDB(dst, b, h) do { _Pragma("unroll") for (int n = 0; n < 2; ++n) _Pragma("unroll") for (int k = 0; k < 2; ++k) dst[n][k] = *(const PG8_LAS bf16x8*)(lds + PG8_SB(b, h) + boff + n * 2048 + k * 1024); } while (0)
#define PG8_MMA(ai, bj, At, Bt) do { __builtin_amdgcn_s_setprio(1); _Pragma("unroll") for (int m = 0; m < 4; ++m) _Pragma("unroll") for (int n = 0; n < 2; ++n) _Pragma("unroll") for (int k = 0; k < 2; ++k) \
        acc[ai][bj][m][n] = __builtin_amdgcn_mfma_f32_16x16x32_bf16(Bt[n][k], At[m][k], acc[ai][bj][m][n], 0, 0, 0); __builtin_amdgcn_s_setprio(0); } while (0)
#define PG8_WAIT_V(n) asm volatile("s_waitcnt vmcnt(" #n ")" ::: "memory")
#define PG8_WAIT_L(n) asm volatile("s_waitcnt lgkmcnt(" #n ")" ::: "memory")
#define PG8_BAR __builtin_amdgcn_s_barrier()
#define PG8_SCHED __builtin_amdgcn_sched_barrier(0)
    Unit cur, nxt; int ui = 0;
    if (!S.next(0, cur)) return;
    f32x4 acc[2][2][4][2];
#pragma unroll
    for (int a = 0; a < 2; ++a)
#pragma unroll
        for (int b = 0; b < 2; ++b)
#pragma unroll
            for (int m = 0; m < 4; ++m)
#pragma unroll
                for (int n = 0; n < 2; ++n) acc[a][b][m][n] = (f32x4){0.f, 0.f, 0.f, 0.f};
    bf16x8 At[4][2], B0[2][2], B1[2][2];
    const char* cA = (const char*)g.A + (size_t)cur.pm * tstep; const char* cB = (const char*)g.Bt + (size_t)cur.pn * tstep;
    S.a_ready(cur);
    if constexpr (SP2) {
        PG8_STAGE(PG8_SB(0, 0), cB, voffB); PG8_STAGE(PG8_SB(0, 1), cB + hstep, voffB); PG8_STAGE(PG8_SA(0, 0), cA, voffA); PG8_STAGE(PG8_SA(0, 1), cA + hstep, voffA);
        if (wr == 1) PG8_BAR;
        PG8_WAIT_V(2); PG8_BAR;
        PG8_STAGE(PG8_SB(1, 0), cB + kstep, voffB); PG8_STAGE(PG8_SA(1, 0), cA + kstep, voffA); PG8_STAGE(PG8_SB(1, 1), cB + hstep + kstep, voffB);
        PG8_WAIT_V(6); PG8_BAR;
    } else {
        PG8_STAGE(PG8_SB(0, 0), cB, voffB); PG8_STAGE(PG8_SA(0, 0), cA, voffA); PG8_STAGE(PG8_SB(0, 1), cB + hstep, voffB); PG8_STAGE(PG8_SA(0, 1), cA + hstep, voffA);
        if (wr == 1) PG8_BAR;
        PG8_WAIT_V(4); PG8_BAR;
        PG8_STAGE(PG8_SB(1, 0), cB + kstep, voffB); PG8_STAGE(PG8_SA(1, 0), cA + kstep, voffA); PG8_STAGE(PG8_SB(1, 1), cB + hstep + kstep, voffB);
        PG8_WAIT_V(6); PG8_BAR;
    }
    for (;;) {
        const bool has_next = S.next(ui + 1, nxt);
        const char* nA = has_next ? (const char*)g.A + (size_t)nxt.pm * tstep : cA; const char* nB = has_next ? (const char*)g.Bt + (size_t)nxt.pn * tstep : cB;
        for (int t = 0; t < nt; t += 2) {
            if constexpr (Epi::MIDK > 0) { if (t == Epi::MIDK) E.mid(acc, cur, wr, wc, fr, fq); }
            const bool last = (t == nt - 2);
            const char* a1 = cA + (size_t)(t + 1) * kstep;
            const char* a2 = last ? nA : cA + (size_t)(t + 2) * kstep; const char* b2 = last ? nB : cB + (size_t)(t + 2) * kstep;
            const char* a3 = a2 + kstep; const char* b3 = b2 + kstep;
            if (last && has_next) S.a_ready(nxt);
            if constexpr (SP2) {
            PG8_LDB(B0, 0, 0); PG8_LDB(B1, 0, 1); PG8_SCHED; PG8_LDA(At, 0, 0); PG8_STAGE(PG8_SA(1, 1), a1 + hstep, voffA);
            PG8_WAIT_V(8); PG8_WAIT_L(0); PG8_BAR; PG8_MMA(0, 0, At, B0); PG8_MMA(0, 1, At, B1); PG8_BAR; PG8_SCHED;
            PG8_LDA(At, 0, 1); PG8_STAGE(PG8_SB(0, 0), b2, voffB); PG8_STAGE(PG8_SB(0, 1), b2 + hstep, voffB); PG8_STAGE(PG8_SA(0, 0), a2, voffA);
            PG8_WAIT_V(8); PG8_WAIT_L(0); PG8_BAR; PG8_MMA(1, 0, At, B0); PG8_MMA(1, 1, At, B1); PG8_BAR; PG8_SCHED;
            PG8_LDB(B0, 1, 0); PG8_LDB(B1, 1, 1); PG8_SCHED; PG8_LDA(At, 1, 0); PG8_STAGE(PG8_SA(0, 1), a2 + hstep, voffA);
            PG8_WAIT_V(8); PG8_WAIT_L(0); PG8_BAR; PG8_MMA(0, 0, At, B0); PG8_MMA(0, 1, At, B1); PG8_BAR; PG8_SCHED;
            PG8_LDA(At, 1, 1); PG8_STAGE(PG8_SB(1, 0), b3, voffB); PG8_STAGE(PG8_SB(1, 1), b3 + hstep, voffB); PG8_STAGE(PG8_SA(1, 0), a3, voffA);
            PG8_WAIT_V(8); PG8_WAIT_L(0); PG8_BAR; PG8_MMA(1, 0, At, B0); PG8_MMA(1, 1, At, B1); PG8_BAR; PG8_SCHED;
            } else {
            PG8_LDB(B0, 0, 0); PG8_SCHED; PG8_LDA(At, 0, 0); PG8_STAGE(PG8_SA(1, 1), a1 + hstep, voffA);
            PG8_WAIT_L(8); PG8_BAR; PG8_WAIT_L(0); PG8_MMA(0, 0, At, B0); PG8_BAR; PG8_SCHED;
            PG8_LDB(B1, 0, 1); PG8_STAGE(PG8_SB(0, 0), b2, voffB);
            PG8_BAR; PG8_WAIT_L(0); PG8_MMA(0, 1, At, B1); PG8_BAR;
            PG8_LDA(At, 0, 1); PG8_STAGE(PG8_SA(0, 0), a2, voffA);
            PG8_BAR; PG8_WAIT_L(0); PG8_MMA(1, 0, At, B0); PG8_BAR; PG8_SCHED;
            PG8_STAGE(PG8_SB(0, 1), b2 + hstep, voffB);
            PG8_WAIT_V(6); PG8_BAR; PG8_MMA(1, 1, At, B1); PG8_BAR;
            PG8_LDB(B0, 1, 0); PG8_SCHED; PG8_LDA(At, 1, 0); PG8_STAGE(PG8_SA(0, 1), a2 + hstep, voffA);
            PG8_WAIT_L(8); PG8_BAR; PG8_WAIT_L(0); PG8_MMA(0, 0, At, B0); PG8_BAR; PG8_SCHED;
            PG8_LDB(B1, 1, 1); PG8_STAGE(PG8_SB(1, 0), b3, voffB);
            PG8_BAR; PG8_WAIT_L(0); PG8_MMA(0, 1, At, B1); PG8_BAR;
            PG8_LDA(At, 1, 1); PG8_STAGE(PG8_SA(1, 0), a3, voffA);
            PG8_BAR; PG8_WAIT_L(0); PG8_MMA(1, 0, At, B0); PG8_BAR; PG8_SCHED;
            PG8_STAGE(PG8_SB(1, 1), b3 + hstep, voffB);
            PG8_WAIT_V(6); PG8_BAR; PG8_MMA(1, 1, At, B1); PG8_BAR;
            }
        }
        if constexpr (ALIGN_EPI) { if (wr == 0) PG8_BAR; }
        if constexpr (!Epi::AFTER_DRAIN) { E(acc, cur, wr, wc, fr, fq); S.done(cur); }
        if (!has_next) break;
#pragma unroll
        for (int a = 0; a < 2; ++a)
#pragma unroll
            for (int b = 0; b < 2; ++b)
#pragma unroll
                for (int m = 0; m < 4; ++m)
#pragma unroll
                    for (int n = 0; n < 2; ++n) acc[a][b][m][n] = (f32x4){0.f, 0.f, 0.f, 0.f};
        cur = nxt; cA = nA; cB = nB; ++ui;
        if constexpr (ALIGN_EPI) { if (wr == 1) PG8_BAR; }
    }
    PG8_WAIT_V(0);
    if constexpr (!ALIGN_EPI) { if (wr == 0) PG8_BAR; }
    PG8_BAR;
    if constexpr (Epi::AFTER_DRAIN) { E.fused(acc, cur, wr, wc, fr, fq, lds, wid, lane); S.done(cur); }
#undef PG8_SA
#undef PG8_SB
#undef PG8_STAGE
#undef PG8_LDA
#undef PG8_LDB
#undef PG8_MMA
#undef PG8_WAIT_V
#undef PG8_WAIT_L
#undef PG8_BAR
#undef PG8_SCHED
}
}

#ifndef PG8_SP2
#define PG8_SP2 true
#endif
#ifndef PG8_ALIGN
#define PG8_ALIGN true
#endif
#include <hip/hip_bf16.h>
#include <cmath>
namespace attn_body {
using bf16=__hip_bfloat16;
using bf16x8=__attribute__((ext_vector_type(8)))short;
using s16x4=__attribute__((ext_vector_type(4)))short;
using f32x16=__attribute__((ext_vector_type(16)))float;
using u32x4=__attribute__((ext_vector_type(4)))unsigned;
constexpr int SEQ=2048,D=64,QP=512,KP=512,VP=512,OP=1024;
constexpr int NW=8,QBLK=32,QB=QBLK*NW,KVBLK=64,NQB=SEQ/QB;
constexpr int ATTN_UNIT_ROWS=QB;
__device__ __forceinline__ int crow(int r,int hi){return (r&3)+8*(r>>2)+4*hi;}
#define SBAR() __builtin_amdgcn_sched_barrier(0)
__device__ __forceinline__ void cmask(f32x16&p0,f32x16&p1,int jb,int wchunk,int){
  if(jb>wchunk){ const float NEG=-INFINITY;
    #pragma unroll
    for(int r=0;r<16;++r){p0[r]=NEG;p1[r]=NEG;} }
}

constexpr int NSLOT=3, SLOTB=8192;
constexpr int LDS_K=0, LDS_V=NSLOT*SLOTB, LDS_WS=2*NSLOT*SLOTB, LDS_OST=LDS_WS+NW*64*4, LDS_BYTES=LDS_OST+NW*4096;
constexpr float C2=0.125f*1.4426950408889634f;
__device__ __forceinline__ void glds16(const void*gsrc,unsigned lds_dst){unsigned keep;
  asm volatile("s_mov_b32 %0, m0\n\ts_mov_b32 m0, %2\n\ts_nop 0\n\tglobal_load_lds_dwordx4 %1, off\n\ts_mov_b32 m0, %0":"=&s"(keep):"v"(gsrc),"s"(lds_dst):"memory");}
__device__ __forceinline__ float max3f(float a,float b,float c){float r;asm("v_max3_f32 %0, %1, %2, %3":"=v"(r):"v"(a),"v"(b),"v"(c));return r;}
__device__ __forceinline__ float max2f(float a,float b){float r;asm("v_max_f32_e32 %0, %1, %2":"=v"(r):"v"(a),"v"(b));return r;}
__device__ __forceinline__ float fadd_s(float a,float b){float r;asm("v_add_f32_e32 %0, %1, %2":"=v"(r):"v"(a),"v"(b));return r;}
__device__ __forceinline__ float fsub_s(float a,float b){float r;asm("v_sub_f32_e32 %0, %1, %2":"=v"(r):"v"(a),"v"(b));return r;}
typedef float f32x2_t __attribute__((ext_vector_type(2))); typedef __bf16 bf16x2_t __attribute__((ext_vector_type(2)));
__device__ __forceinline__ unsigned cvtpk_s(float lo,float hi){f32x2_t v={lo,hi};bf16x2_t b=__builtin_convertvector(v,bf16x2_t);return __builtin_bit_cast(unsigned,b);}
#define WAIT_BAR(N) asm volatile("s_waitcnt vmcnt(" #N ") lgkmcnt(0)\n\ts_barrier":::"memory")

__device__ __forceinline__ void qkt(f32x16&p0,f32x16&p1,const char*Kslot,const bf16x8*qr,const f32x16&negm,int r32,int hi){
  const char*kb=Kslot+hi*1024+r32*16;
  #pragma unroll
  for(int d0=0;d0<4;++d0){
    const bf16x8 b0=*reinterpret_cast<const bf16x8*>(kb+d0*2048);
    const bf16x8 b1=*reinterpret_cast<const bf16x8*>(kb+d0*2048+512);
    if(d0==0){p0=__builtin_amdgcn_mfma_f32_32x32x16_bf16(b0,qr[0],negm,0,0,0);p1=__builtin_amdgcn_mfma_f32_32x32x16_bf16(b1,qr[0],negm,0,0,0);}
    else{p0=__builtin_amdgcn_mfma_f32_32x32x16_bf16(b0,qr[d0],p0,0,0,0);p1=__builtin_amdgcn_mfma_f32_32x32x16_bf16(b1,qr[d0],p1,0,0,0);}}
}
typedef __attribute__((address_space(3))) const char* lds_cptr;
typedef short v4i16_t __attribute__((ext_vector_type(4)));
__device__ __forceinline__ void kload8(bf16x8*kf,lds_cptr kp){
  kf[0]=*(const __attribute__((address_space(3))) bf16x8*)(kp);      kf[1]=*(const __attribute__((address_space(3))) bf16x8*)(kp+512);
  kf[2]=*(const __attribute__((address_space(3))) bf16x8*)(kp+2048); kf[3]=*(const __attribute__((address_space(3))) bf16x8*)(kp+2560);
  kf[4]=*(const __attribute__((address_space(3))) bf16x8*)(kp+4096); kf[5]=*(const __attribute__((address_space(3))) bf16x8*)(kp+4608);
  kf[6]=*(const __attribute__((address_space(3))) bf16x8*)(kp+6144); kf[7]=*(const __attribute__((address_space(3))) bf16x8*)(kp+6656);
}
__device__ __forceinline__ void kload2(bf16x8*kf,lds_cptr kp,int j){ kf[2*j]=*(const __attribute__((address_space(3))) bf16x8*)(kp+j*2048); kf[2*j+1]=*(const __attribute__((address_space(3))) bf16x8*)(kp+j*2048+512); }
__device__ __forceinline__ s16x4 vtr(lds_cptr p){ return __builtin_bit_cast(s16x4,__builtin_amdgcn_ds_read_tr16_b64_v4i16((__attribute__((address_space(3))) v4i16_t*)p)); }
__device__ __forceinline__ float rowmax(const f32x16&p0,const f32x16&p1){
  float a=max3f(p0[0],p0[1],p1[0]),b=max3f(p0[2],p0[3],p1[1]);a=max3f(a,p1[2],p1[3]);
  #pragma unroll
  for(int r=4;r<16;r+=4){a=max3f(a,p0[r],p0[r+1]);b=max3f(b,p0[r+2],p0[r+3]);a=max3f(a,p1[r],p1[r+1]);b=max3f(b,p1[r+2],p1[r+3]);}
  const float m=max2f(a,b);
  auto rr=__builtin_amdgcn_permlane32_swap(__float_as_uint(m),__float_as_uint(m),false,false);
  return max2f(__uint_as_float(rr[0]),__uint_as_float(rr[1]));
}
__device__ __forceinline__ void pv(f32x16*o,int vb,bf16x8 pa0,bf16x8 pa1,bf16x8 pa2,bf16x8 pa3){
  #pragma unroll
  for(int d0=0;d0<2;++d0){s16x4 lo[4],hi[4];
    #pragma unroll
    for(int ks=0;ks<4;++ks){
      asm volatile("ds_read_b64_tr_b16 %0,%1 offset:%c2":"=&v"(lo[ks]):"v"(vb),"i"(d0*4096+ks*1024):"memory");
      asm volatile("ds_read_b64_tr_b16 %0,%1 offset:%c2":"=&v"(hi[ks]):"v"(vb),"i"(d0*4096+ks*1024+512):"memory");}
    asm volatile("s_waitcnt lgkmcnt(0)":::"memory");SBAR();
    #define PK(k) (bf16x8){lo[k][0],lo[k][1],lo[k][2],lo[k][3],hi[k][0],hi[k][1],hi[k][2],hi[k][3]}
    o[d0]=__builtin_amdgcn_mfma_f32_32x32x16_bf16(pa0,PK(0),o[d0],0,0,0);
    o[d0]=__builtin_amdgcn_mfma_f32_32x32x16_bf16(pa1,PK(1),o[d0],0,0,0);
    o[d0]=__builtin_amdgcn_mfma_f32_32x32x16_bf16(pa2,PK(2),o[d0],0,0,0);
    o[d0]=__builtin_amdgcn_mfma_f32_32x32x16_bf16(pa3,PK(3),o[d0],0,0,0);
    #undef PK
  }
}

#ifndef ATTN_STORE16
#define ATTN_STORE16(p,v) (*(u32x4*)(p)=(v))
#endif
template<int THRL> __device__ __forceinline__ void attn_unit(int b,int qcol,int kcol,int vcol,int ocol,int qb,const bf16*Q,const bf16*__restrict__ K,const bf16*__restrict__ V,bf16*O,char*shm){
  const int tid=threadIdx.x,lane=tid&63,r32=lane&31,hi=lane>>5; const int wid=__builtin_amdgcn_readfirstlane(tid>>6);
  const long rowbase=(long)b*SEQ; const int q0=qb*QB;
  const bf16*Qw=Q+(rowbase+q0+wid*QBLK)*QP+qcol;
  const bf16*Kh=K+rowbase*KP+kcol,*Vh=V+rowbase*VP+vcol;
  const unsigned lds0=(unsigned)(uintptr_t)shm;
  float*wsf=(float*)(shm+LDS_WS)+wid*64;
  const bf16*ksrc=Kh+(long)lane*KP+wid*8;
  const bf16*vsrc=Vh+(long)(16*(wid&3)+(lane>>2))*VP+(wid>>2)*32+(lane&3)*8;
  const unsigned kdst=lds0+LDS_K+wid*1024, vdst=lds0+LDS_V+wid*1024;
  #define DMA_K(t,slot) glds16(ksrc+(long)(t)*KVBLK*KP,(unsigned)__builtin_amdgcn_readfirstlane(kdst+(slot)))
  #define DMA_V(t,slot) glds16(vsrc+(long)(t)*KVBLK*VP,(unsigned)__builtin_amdgcn_readfirstlane(vdst+(slot)))
  const int vb0=(int)(lds0+LDS_V)+((lane>>4)&1)*32+(lane&3)*8+(4*hi+((lane&15)>>2))*64;
  const char*Kbase=shm+LDS_K; bf16x8 kf[8];
  const lds_cptr shm3=(lds_cptr)shm; const lds_cptr kp0=shm3+LDS_K+hi*1024+r32*16; const lds_cptr vp0=shm3+LDS_V+((lane>>4)&1)*32+(lane&3)*8+(4*hi+((lane&15)>>2))*64;
  const int NT=(q0+QB)/KVBLK;
  DMA_K(0,0);DMA_V(0,0);DMA_K(1,SLOTB);
  bf16x8 qr[4];
  #pragma unroll
  for(int d0=0;d0<4;++d0)qr[d0]=*reinterpret_cast<const bf16x8*>(&Qw[(long)r32*QP+d0*16+hi*8]);
  float mhat=0.f,l_reg=0.f;f32x16 o[2];o[0]=f32x16{};o[1]=f32x16{};f32x16 negm=f32x16{};asm volatile("":"+v"(negm));
  const int qrel=wid>>1;
  #define CMASK(P0,P1,t) do{int jb_=(t)-(NT-4); if(jb_>=0)cmask(P0,P1,jb_,qrel,hi);}while(0)
  bool resc=false;
  #define START(P0,P1) do{ const float rm=rowmax(P0,P1); resc=false; \
    { const float dl=rm; mhat=fadd_s(mhat,dl); \
      _Pragma("unroll") for(int r=0;r<16;++r){P0[r]=fsub_s(P0[r],dl);P1[r]=fsub_s(P1[r],dl);} \
      _Pragma("unroll") for(int r=0;r<16;++r)negm[r]=-mhat; asm volatile("":"+v"(negm)); } \
    _Pragma("unroll") for(int r=0;r<16;++r)P0[r]=__builtin_amdgcn_exp2f(P0[r]); }while(0)
  #define RESC() do{ if(resc){ asm volatile("s_waitcnt lgkmcnt(0)":::"memory"); \
      _Pragma("unroll") for(int d_=0;d_<2;++d_) _Pragma("unroll") for(int r=0;r<16;++r)o[d_][r]*=wsf[crow(r,hi)]; } }while(0)
  f32x16 pA0,pA1,pB0,pB1;
  int sl_prev=0,sl_cur=0,sl_next=SLOTB;
  #define ROT() do{sl_prev=sl_cur;sl_cur=sl_next;sl_next=(sl_next==(NSLOT-1)*SLOTB)?0:sl_next+SLOTB;}while(0)
  DMA_K(2,2*SLOTB);
  WAIT_BAR(3);
  qkt(pA0,pA1,Kbase,qr,negm,r32,hi);asm volatile("s_nop 15\n\ts_nop 7":"+v"(pA0),"+v"(pA1));CMASK(pA0,pA1,0);
  START(pA0,pA1);
  _Pragma("unroll") for(int r=0;r<16;++r)pA1[r]=__builtin_amdgcn_exp2f(pA1[r]);
  WAIT_BAR(0);
  DMA_K(3,0);DMA_V(1,SLOTB);
  ROT();
  kload8(kf,kp0+sl_cur);
  WAIT_BAR(2);
  s16x4 vlo[8],vhi[8]; u32x4 pw0,pw1,pw2,pw3;
  #define PKW(P,B) cvtpk_s(P[B],P[B+1])
  #define PAF(k) __builtin_bit_cast(bf16x8,pw##k)
  #define VFR(i) (bf16x8){vlo[i][0],vlo[i][1],vlo[i][2],vlo[i][3],vhi[i][0],vhi[i][1],vhi[i][2],vhi[i][3]}
  #define PIN(x) asm volatile("":"+v"(x))
  #define MX3(a,b,c) __builtin_fmaxf(__builtin_fmaxf((a),(b)),(c))
  #define GAPA(MF,A0,A1,A2,A3,W0,W1,PW) do{ MF; sacc+=A0; sacc+=A1; sacc+=A2; sacc+=A3; PIN(sacc); W0; W1; PIN(PW); SBAR(); }while(0)
  #define EX(v) __builtin_amdgcn_exp2f(v)
  #define GAPB(MF,X,B) do{ MF; X[B]=EX(X[B]); X[B+1]=EX(X[B+1]); X[B+2]=EX(X[B+2]); X[B+3]=EX(X[B+3]); PIN(X); SBAR(); }while(0)
  #define VRD(i) do{ vlo[i]=vtr(vp_+(((i)>>2)*4096+((i)&3)*1024)); vhi[i]=vtr(vp_+(((i)>>2)*4096+((i)&3)*1024+512)); }while(0)
  #define KRD(G,j) do{ if(G){ kload2(kf,kp0+sl_next,j); SBAR(); } }while(0)
  #define STEP(C0,C1,P0,P1,t,GK,GV,GL) do{ SBAR(); \
    const lds_cptr vp_=vp0+sl_prev; \
    VRD(0); SBAR(); float sacc=(P0[0]+P0[1]); \
    GAPA(C0=__builtin_amdgcn_mfma_f32_32x32x16_bf16(kf[0],qr[0],negm,0,0,0), P0[2],P0[3],P0[4],P0[5],     pw0[0]=PKW(P0,0), pw0[1]=PKW(P0,2), pw0); \
    VRD(4); SBAR(); GAPA(C1=__builtin_amdgcn_mfma_f32_32x32x16_bf16(kf[1],qr[0],negm,0,0,0), P0[6],P0[7],P0[8],P0[9],     pw0[2]=PKW(P0,4), pw0[3]=PKW(P0,6), pw0); \
    VRD(1); SBAR(); GAPA(C0=__builtin_amdgcn_mfma_f32_32x32x16_bf16(kf[2],qr[1],C0,0,0,0),   P0[10],P0[11],P0[12],P0[13], pw1[0]=PKW(P0,8), pw1[1]=PKW(P0,10), pw1); \
    VRD(5); SBAR(); GAPA(C1=__builtin_amdgcn_mfma_f32_32x32x16_bf16(kf[3],qr[1],C1,0,0,0),   P0[14],P0[15],P1[0],P1[1],   pw1[2]=PKW(P0,12),pw1[3]=PKW(P0,14), pw1); \
    VRD(2); SBAR(); GAPA(C0=__builtin_amdgcn_mfma_f32_32x32x16_bf16(kf[4],qr[2],C0,0,0,0),   P1[2],P1[3],P1[4],P1[5],     pw2[0]=PKW(P1,0), pw2[1]=PKW(P1,2), pw2); \
    VRD(6); SBAR(); GAPA(C1=__builtin_amdgcn_mfma_f32_32x32x16_bf16(kf[5],qr[2],C1,0,0,0),   P1[6],P1[7],P1[8],P1[9],     pw2[2]=PKW(P1,4), pw2[3]=PKW(P1,6), pw2); \
    VRD(3); SBAR(); GAPA(C0=__builtin_amdgcn_mfma_f32_32x32x16_bf16(kf[6],qr[3],C0,0,0,0),   P1[10],P1[11],P1[12],P1[13], pw3[0]=PKW(P1,8), pw3[1]=PKW(P1,10), pw3); \
    VRD(7); SBAR(); GAPA(C1=__builtin_amdgcn_mfma_f32_32x32x16_bf16(kf[7],qr[3],C1,0,0,0),   P1[14],P1[15],0.f,0.f,       pw3[2]=PKW(P1,12),pw3[3]=PKW(P1,14), pw3); \
    l_reg+=sacc; \
    if(GK){DMA_K((t)+3,sl_cur);} if(GV){DMA_V((t)+1,sl_next);} \
    CMASK(C0,C1,t); \
    { float a=MX3(C0[0],C0[1],C1[0]),b=MX3(C0[2],C0[3],C1[1]); a=MX3(a,C1[2],C1[3]); \
      _Pragma("unroll") for(int r=4;r<16;r+=4){a=MX3(a,C0[r],C0[r+1]);b=MX3(b,C0[r+2],C0[r+3]);a=MX3(a,C1[r],C1[r+1]);b=MX3(b,C1[r+2],C1[r+3]);} \
      float rm=__builtin_fmaxf(a,b); { auto rr=__builtin_amdgcn_permlane32_swap(__float_as_uint(rm),__float_as_uint(rm),false,false); rm=__builtin_fmaxf(__uint_as_float(rr[0]),__uint_as_float(rr[1])); } \
      resc=false; \
      if(__builtin_expect(__any(rm>(float)THRL),0)){ const float dl=__builtin_fmaxf(rm,0.f); mhat+=dl; \
        _Pragma("unroll") for(int r=0;r<16;++r){C0[r]-=dl;C1[r]-=dl;} \
        _Pragma("unroll") for(int r=0;r<16;++r)negm[r]=-mhat; asm volatile("":"+v"(negm)); \
        const float f=__builtin_amdgcn_exp2f(-dl); l_reg*=f; if(hi==0)wsf[r32]=f; resc=true; } } \
    SBAR(); \
    GAPB(o[0]=__builtin_amdgcn_mfma_f32_32x32x16_bf16(PAF(0),VFR(0),o[0],0,0,0), C0,0); \
    GAPB(o[1]=__builtin_amdgcn_mfma_f32_32x32x16_bf16(PAF(0),VFR(4),o[1],0,0,0), C0,4); \
    KRD(GL,0); GAPB(o[0]=__builtin_amdgcn_mfma_f32_32x32x16_bf16(PAF(1),VFR(1),o[0],0,0,0), C0,8); \
    KRD(GL,1); GAPB(o[1]=__builtin_amdgcn_mfma_f32_32x32x16_bf16(PAF(1),VFR(5),o[1],0,0,0), C0,12); \
    KRD(GL,2); GAPB(o[0]=__builtin_amdgcn_mfma_f32_32x32x16_bf16(PAF(2),VFR(2),o[0],0,0,0), C1,0); \
    KRD(GL,3); GAPB(o[1]=__builtin_amdgcn_mfma_f32_32x32x16_bf16(PAF(2),VFR(6),o[1],0,0,0), C1,4); \
    GAPB(o[0]=__builtin_amdgcn_mfma_f32_32x32x16_bf16(PAF(3),VFR(3),o[0],0,0,0), C1,8); \
    GAPB(o[1]=__builtin_amdgcn_mfma_f32_32x32x16_bf16(PAF(3),VFR(7),o[1],0,0,0), C1,12); \
    }while(0)
  int t=1;
  #undef CMASK
  #define CMASK(P0,P1,t) do{}while(0)
  for(;t+5<NT;t+=2){
    STEP(pB0,pB1,pA0,pA1,t,true,true,true);     WAIT_BAR(2); RESC(); ROT();
    STEP(pA0,pA1,pB0,pB1,t+1,true,true,true);   WAIT_BAR(2); RESC(); ROT();
  }
  #undef CMASK
  #define CMASK(P0,P1,t) do{int jb_=(t)-(NT-4); if(jb_>=0)cmask(P0,P1,jb_,qrel,hi);}while(0)
  #define ENDW(tt) do{ if((tt)+3<NT){WAIT_BAR(2);} else if((tt)+2<NT){WAIT_BAR(1);} else {WAIT_BAR(0);} }while(0)
  for(;t+1<NT;t+=2){
    STEP(pB0,pB1,pA0,pA1,t,(t+3<NT),(t+1<NT),(t+1<NT));       ENDW(t);   RESC(); ROT();
    STEP(pA0,pA1,pB0,pB1,t+1,(t+4<NT),(t+2<NT),(t+2<NT));     ENDW(t+1); RESC(); ROT();
  }
  STEP(pB0,pB1,pA0,pA1,NT-1,false,false,false); RESC();
  { float sacc=pB0[0]+pB0[1]; _Pragma("unroll") for(int r=2;r<16;++r)sacc+=pB0[r]; _Pragma("unroll") for(int r=0;r<16;++r)sacc+=pB1[r]; l_reg+=sacc;
    pw0=(u32x4){PKW(pB0,0),PKW(pB0,2),PKW(pB0,4),PKW(pB0,6)};pw1=(u32x4){PKW(pB0,8),PKW(pB0,10),PKW(pB0,12),PKW(pB0,14)};pw2=(u32x4){PKW(pB1,0),PKW(pB1,2),PKW(pB1,4),PKW(pB1,6)};pw3=(u32x4){PKW(pB1,8),PKW(pB1,10),PKW(pB1,12),PKW(pB1,14)};
    SBAR(); pv(o,vb0+sl_cur,PAF(0),PAF(1),PAF(2),PAF(3)); }
  #undef PKW
  #undef PAF
  #undef VFR
  #undef PIN
  #undef MX3
  #undef GAPA
  #undef GAPB
  #undef EX
  #undef VRD
  #undef KRD
  #undef STEP
  #undef ENDW
  {auto rr=__builtin_amdgcn_permlane32_swap(__float_as_uint(l_reg),__float_as_uint(l_reg),false,false);l_reg=__uint_as_float(rr[0])+__uint_as_float(rr[1]);}
  if(hi==0)wsf[32+r32]=l_reg;asm volatile("s_waitcnt lgkmcnt(0)":::"memory");
  float rli[16];
  #pragma unroll
  for(int r=0;r<16;++r)rli[r]=__builtin_amdgcn_rcpf(wsf[32+crow(r,hi)]);
  bf16*Ow=O+(rowbase+q0+wid*QBLK)*OP+ocol;
  { bf16*stg=(bf16*)(shm+LDS_OST)+wid*2048;
    #pragma unroll
    for(int r=0;r<16;++r){const int orow=crow(r,hi);
      #pragma unroll
      for(int d0=0;d0<2;++d0)stg[orow*64+d0*32+r32]=__float2bfloat16(o[d0][r]*rli[r]);}
    asm volatile("s_waitcnt lgkmcnt(0)":::"memory");
    #pragma unroll
    for(int i=0;i<4;++i){const int row=i*8+(lane>>3),ch=lane&7; const u32x4 v=*(const u32x4*)(stg+row*64+ch*8); ATTN_STORE16(Ow+(long)row*OP+ch*8,v);} }
  asm volatile("s_waitcnt lgkmcnt(0)\n\ts_barrier":::"memory");
  #undef DMA_K
  #undef DMA_V
  #undef CMASK
  #undef START
  #undef RESC
  #undef ROT
}
constexpr int ATTN_LDS_BYTES=LDS_BYTES;
struct AttnTensors { const bf16* Q; const bf16* K; const bf16* V; bf16* O; };
struct AttnUnit { int bvh; int qb; };
struct StaticOrder {
  int ai,nA;
  __device__ __forceinline__ StaticOrder(int ai_,int nA_):ai(ai_),nA(nA_){}
  __device__ __forceinline__ bool next(int i,AttnUnit&u)const{
    if(nA==128){ if(i>=8)return false; u.bvh=ai; u.qb=7-i; return true; }
    if(i>=4)return false; const int s=ai&1; u.bvh=ai>>1; u.qb=(i==0)?7-s:(i==1)?4+s:(i==2)?3-s:s; return true; }
  __device__ __forceinline__ void a_ready(const AttnUnit&)const{}
  __device__ __forceinline__ void done(const AttnUnit&)const{}
};
template<class Sched,int THRL=8> __device__ __forceinline__ void attn_phase(char*lds,const AttnTensors&T,const Sched&S){
  AttnUnit u;
  for(int i=0;S.next(i,u);++i){ S.a_ready(u); const int b=u.bvh>>4,vh=u.bvh&15,s=vh>>1,half=vh&1;
    attn_unit<THRL>(b,s*64,s*64,(s>>1)*128+half*64,s*128+half*64,u.qb,T.Q,T.K,T.V,T.O,lds); S.done(u); }
}
#undef SBAR
#undef WAIT_BAR
}
#include <hip/hip_cooperative_groups.h>
typedef unsigned short bf16;
#define GAS __attribute__((address_space(1)))
#define LAS __attribute__((address_space(3)))
typedef unsigned v4u __attribute__((ext_vector_type(4)));
typedef unsigned v2u __attribute__((ext_vector_type(2)));
typedef float f32x4 __attribute__((ext_vector_type(4)));
#define LDS_WAIT() asm volatile("s_waitcnt lgkmcnt(0)" ::: "memory")
__device__ __forceinline__ unsigned f2bf(float f) { unsigned u = __builtin_bit_cast(unsigned, f); return (u + 0x7fffu + ((u >> 16) & 1u)) >> 16; }
__device__ __forceinline__ unsigned pk2(float lo, float hi) { return f2bf(lo) | (f2bf(hi) << 16); }
__device__ __forceinline__ float bflo(unsigned w) { return __builtin_bit_cast(float, w << 16); }
__device__ __forceinline__ float bfhi(unsigned w) { return __builtin_bit_cast(float, w & 0xffff0000u); }
__device__ __forceinline__ float bf1(unsigned short h) { return __builtin_bit_cast(float, (unsigned)h << 16); }
template <int CTRL> __device__ __forceinline__ float dppf(float x) { return __builtin_bit_cast(float, __builtin_amdgcn_update_dpp(0, __builtin_bit_cast(int, x), CTRL, 0xf, 0xf, false)); }
__device__ __forceinline__ float row16_allsum(float x) { x += dppf<0x128>(x); x += dppf<0x124>(x); x += dppf<0x122>(x); x += dppf<0x121>(x); return x; }
__device__ __forceinline__ float oct_allsum(float x) { x += dppf<0xB1>(x); x += dppf<0x4E>(x); x += dppf<0x141>(x); return x; }
__device__ __forceinline__ float u2f(unsigned u) { return __builtin_bit_cast(float, u); }
__device__ __forceinline__ unsigned f2u(float f) { return __builtin_bit_cast(unsigned, f); }
__device__ __forceinline__ float sw32(float a, float b) { auto r = __builtin_amdgcn_permlane32_swap(f2u(a), f2u(b), false, false); const unsigned r0 = r[0], r1 = r[1]; return u2f(r0) + u2f(r1); }
__device__ __forceinline__ float sw16(float a, float b) { auto r = __builtin_amdgcn_permlane16_swap(f2u(a), f2u(b), false, false); const unsigned r0 = r[0], r1 = r[1]; return u2f(r0) + u2f(r1); }
__device__ __forceinline__ float wave_allsum(float x) { x = row16_allsum(x); x = sw16(x, x); return sw32(x, x); }
__device__ __forceinline__ float red4(float x0, float x1, float x2, float x3) { return row16_allsum(sw16(sw32(x0, x1), sw32(x2, x3))); }

#define XB_TMO      128
#define XB_XCNT(j)  (256  + 64 * (j))
#define XB_XSUB(j)  (1280 + 64 * (j))
#define XB_XGEN(j)  (2304 + 64 * (j))
#define XB_TOP      3328
#define XB_TOPGEN   3392
#define XCD_BAR_WORDS 3456
#define XB_SPIN_CAP (1u << 18)

__device__ __forceinline__ unsigned xb_ld(unsigned* p)              { return __hip_atomic_load(p, __ATOMIC_RELAXED, __HIP_MEMORY_SCOPE_AGENT); }
__device__ __forceinline__ unsigned xb_add(unsigned* p, unsigned v) { return __hip_atomic_fetch_add(p, v, __ATOMIC_RELAXED, __HIP_MEMORY_SCOPE_AGENT); }
__device__ __forceinline__ unsigned xb_xcc_id() { return (unsigned)__builtin_amdgcn_s_getreg((3 << 11) | 20) & 0xFu; }
#define XB_SPIN(cond, bar) do { unsigned _sp = 0; while (cond) { __builtin_amdgcn_s_sleep(1); \
    if ((++_sp & 255u) == 0u) { if (xb_ld(&(bar)[XB_TMO])) break; if (_sp > XB_SPIN_CAP) { atomicAdd(&(bar)[XB_TMO], 1u); break; } } } } while (0)

struct XcdBarrier {
    unsigned* bar; unsigned x;
    volatile LAS unsigned* st;
};

__device__ __forceinline__ XcdBarrier xcd_barrier_post(unsigned* bar, volatile LAS unsigned* st) {
    XcdBarrier b; b.bar = bar; b.x = xb_xcc_id(); b.st = st;
    if (threadIdx.x == 0) (void)xb_add(&bar[XB_XCNT(b.x)], 1u);
    return b;
}
__device__ __forceinline__ void xcd_barrier_complete(unsigned* bar, unsigned x, unsigned& nloc, unsigned& nx) {
    const unsigned G = gridDim.x * gridDim.y * gridDim.z;
    unsigned sum, cnt, mine, sp = 0u;
    for (;;) {
        sum = 0u; cnt = 0u; mine = 0u;
#pragma unroll
        for (unsigned j = 0; j < 16; ++j) { const unsigned c = xb_ld(&bar[XB_XCNT(j)]); sum += c; cnt += (c > 0u) ? 1u : 0u; }
        mine = xb_ld(&bar[XB_XCNT(x)]);
        if (sum == G) break;
        __builtin_amdgcn_s_sleep(1);
        if ((++sp & 255u) == 0u) { if (xb_ld(&bar[XB_TMO])) break; if (sp > XB_SPIN_CAP) { atomicAdd(&bar[XB_TMO], 1u); break; } }
    }
    nloc = mine > 0u ? mine : 1u; nx = cnt > 0u ? cnt : 1u;
}

__device__ __forceinline__ void xcd_barrier(const XcdBarrier& b) {
    asm volatile("s_waitcnt vmcnt(0)" ::: "memory");
    __syncthreads();
    if (threadIdx.x == 0) {
        unsigned* bar = b.bar;
        __builtin_amdgcn_s_waitcnt(0);
        unsigned nloc = b.st[0], nx = b.st[1];
        if (nloc == 0u) { xcd_barrier_complete(bar, b.x, nloc, nx); b.st[0] = nloc; b.st[1] = nx; }
        const unsigned old = xb_add(&bar[XB_XSUB(b.x)], 1u);
        const unsigned gen = old / nloc;
        if (old + 1u == (gen + 1u) * nloc) {
            __builtin_amdgcn_fence(__ATOMIC_RELEASE, "agent");
            asm volatile("s_waitcnt vmcnt(0)" ::: "memory");
            const unsigned og = xb_add(&bar[XB_TOP], 1u);
            const unsigned tg = og / nx;
            if (og + 1u == (tg + 1u) * nx) xb_add(&bar[XB_TOPGEN], 1u);
            else XB_SPIN(xb_ld(&bar[XB_TOPGEN]) == tg, bar);
            __builtin_amdgcn_fence(__ATOMIC_ACQUIRE, "agent");
            xb_add(&bar[XB_XGEN(b.x)], 1u);
            asm volatile("s_waitcnt vmcnt(0)" ::: "memory");
        } else {
            XB_SPIN(xb_ld(&bar[XB_XGEN(b.x)]) == gen, bar);
            __builtin_amdgcn_fence(__ATOMIC_ACQUIRE, "agent");
            asm volatile("s_waitcnt vmcnt(0)" ::: "memory");
        }
    }
    __syncthreads();
}


constexpr int CW_BAR = 4096;
constexpr int MISC_OFF = 162816 + 320;
struct Frame {
    LAS unsigned char* lds;
    int tid, lane, wave, G, bx;
    float* out; unsigned char* ws;
};
struct Args { const float* in[26]; float* out; unsigned char* ws; int ph_lo, ph_hi; };
typedef const float* cfp_t;
typedef __attribute__((address_space(4))) const cfp_t* ktab_t;
struct InTab { ktab_t p; __device__ __forceinline__ const float* operator[](int i) const { return p[i]; } };
enum { I_X = 0, I_NMG, I_WIN, I_MU, I_W0, I_W2, I_A0, I_A2, I_G2, I_KK, I_KA, I_RK, I_LNG, I_LNB, I_LQ1, I_LK1, I_LQ2, I_LK2, I_SUBG, I_WA, I_WB, I_WO, I_NFG, I_FF1, I_FF2, I_NFIN };

template <bool ROPE> __device__ __forceinline__ void p0_transpose_item(const float* W, int K, int N, bf16* WT, LAS float* scr, int item, int lane, int pitch = 0, int koff = 0) {
    if (pitch == 0) pitch = K;
    const int nblk = N / 32, kb = item / nblk, nb = item % nblk, k0 = 64 * kb, n0 = 32 * nb;
#pragma unroll 8
    for (int i = 0; i < 32; ++i) { const int kk = 2 * i + (lane >> 5); scr[kk * 33 + (lane & 31)] = W[(size_t)(k0 + kk) * N + n0 + (lane & 31)]; }
    LDS_WAIT(); asm volatile("" ::: "memory");
    const int c = lane & 7;
#pragma unroll
    for (int j = 0; j < 4; ++j) { const int n = (lane >> 3) + 8 * j; const LAS float* s = scr + (8 * c) * 33 + n;
        v4u o; o.x = pk2(s[0 * 33], s[1 * 33]); o.y = pk2(s[2 * 33], s[3 * 33]); o.z = pk2(s[4 * 33], s[5 * 33]); o.w = pk2(s[6 * 33], s[7 * 33]);
        int col = n0 + n;
        if (ROPE && col < 1024) { const int d = col & 63, dd = d & 31; col = (col & ~63) + 8 * (dd >> 2) + (d >> 5) * 4 + (dd & 3); }
        *(GAS v4u*)(WT + (size_t)col * pitch + koff + k0 + 8 * c) = o; }
    LDS_WAIT(); asm volatile("" ::: "memory");
}
__device__ __forceinline__ void rms_row_to_bf16(const float* xrow, const float* g, bf16* orow, int lane) {
    const GAS f32x4* xr = (const GAS f32x4*)xrow + lane; const f32x4* gr = (const f32x4*)g + lane;
    f32x4 v[4]; float s = 0.f;
#pragma unroll
    for (int j = 0; j < 4; ++j) { v[j] = xr[64 * j]; s += (v[j].x * v[j].x + v[j].y * v[j].y) + (v[j].z * v[j].z + v[j].w * v[j].w); }
    const float rstd = 1.0f / sqrtf(wave_allsum(s) * (1.f / D) + NORM_EPS);
    GAS unsigned long long* o8 = (GAS unsigned long long*)orow + lane;
#pragma unroll
    for (int j = 0; j < 4; ++j) { const f32x4 gg = gr[64 * j];
        o8[64 * j] = (unsigned long long)pk2(v[j].x * rstd * gg.x, v[j].y * rstd * gg.y) | ((unsigned long long)pk2(v[j].z * rstd * gg.z, v[j].w * rstd * gg.w) << 32); }
}
__device__ __forceinline__ void rms_row_to_f32(const float* xrow, const float* g, float* orow, int lane) {
    const GAS f32x4* xr = (const GAS f32x4*)xrow + lane; const f32x4* gr = (const f32x4*)g + lane;
    f32x4 v[4]; float s = 0.f;
#pragma unroll
    for (int j = 0; j < 4; ++j) { v[j] = xr[64 * j]; s += (v[j].x * v[j].x + v[j].y * v[j].y) + (v[j].z * v[j].z + v[j].w * v[j].w); }
    const float rstd = 1.0f / sqrtf(wave_allsum(s) * (1.f / D) + NORM_EPS);
    GAS f32x4* o = (GAS f32x4*)orow + lane;
#pragma unroll
    for (int j = 0; j < 4; ++j) { const f32x4 gg = gr[64 * j]; o[64 * j] = v[j] * rstd * gg; }
}
__device__ __forceinline__ void p0_prologue(Frame& F, const InTab& A) {
    LAS float* scr = (LAS float*)(F.lds + RING_OFF + F.wave * 16384);
    const int gw = F.bx * NWAVES + F.wave, NGW = F.G * NWAVES;
    unsigned char* ws = F.ws;
    constexpr int I_IN = (D / 64) * (D_IN / 32), I_A = (512 / 64) * (D / 32), I_O = (D / 64) * (D / 32), I_1 = (D / 64) * (FF / 32), I_2 = (FF / 64) * (D / 32);
    (void)I_A; (void)I_O; (void)I_1; (void)I_2;
    for (int it = gw; it < I_IN; it += NGW) p0_transpose_item<true>(A[I_WIN], D, D_IN, (bf16*)(ws + WS_WIN), scr, it, F.lane);
    if (false) for (int it = gw; it < 0; it += NGW) {
        int r = it;
        if (r < I_A) { p0_transpose_item<false>(A[I_WA], 512, D, (bf16*)(ws + WS_WA), scr, r, F.lane, 1024, 0); continue; } r -= I_A;
        if (r < I_A) { p0_transpose_item<false>(A[I_WB], 512, D, (bf16*)(ws + WS_WA), scr, r, F.lane, 1024, 512); continue; } r -= I_A;
        if (r < I_O) { p0_transpose_item<false>(A[I_WO], D, D, (bf16*)(ws + WS_WO), scr, r, F.lane); continue; } r -= I_O;
        if (r < I_1) { p0_transpose_item<false>(A[I_FF1], D, FF, (bf16*)(ws + WS_W1), scr, r, F.lane); continue; } r -= I_1;
        p0_transpose_item<false>(A[I_FF2], FF, D, (bf16*)(ws + WS_W2), scr, r, F.lane);
    }
    const int gt = F.bx * (NWAVES * 64) + F.tid, NGT = F.G * NWAVES * 64;
    for (int e = gt; e < NLORA * (KLORA / 8); e += NGT) { const int n = e / (KLORA / 8), k8 = (e % (KLORA / 8)) * 8; float v[8];
#pragma unroll
        for (int i = 0; i < 8; ++i) { const int k = k8 + i; float x = 0.f;
            if (n < 512) { if (k < 64) x = A[I_W2][(size_t)k * 512 + n]; }
            else if (n < 1024) { if (k >= 64 && k < 128) x = A[I_A2][(size_t)(k - 64) * 512 + (n - 512)]; }
            else { if (k >= 128) x = A[I_G2][(size_t)(k - 128) * 512 + (n - 1024)]; }
            v[i] = x; }
        v4u o; o.x = pk2(v[0], v[1]); o.y = pk2(v[2], v[3]); o.z = pk2(v[4], v[5]); o.w = pk2(v[6], v[7]);
        *(GAS v4u*)((bf16*)(ws + WS_WL) + (size_t)n * KLORA + k8) = o; }
    for (int e = gt; e < SEQ * 32; e += NGT) { const int pos = e >> 5, i = e & 31;
        const float inv = (float)pow(10000.0, -(double)i / 32.0); const float ang = (float)pos * inv; double s, c; sincos((double)ang, &s, &c);
        ((float*)(ws + WS_ROPE_C))[e] = (float)c; ((float*)(ws + WS_ROPE_S))[e] = (float)s; }
    for (int m = gw; m < M; m += NGW) rms_row_to_bf16(A[I_X] + (size_t)m * D, A[I_NMG], (bf16*)(ws + WS_XN) + (size_t)m * D, F.lane);
}

__device__ __forceinline__ void late_weights(Frame& F, const InTab& A, int part, int nparts, int cu0) {
    int lane_ = F.lane; asm volatile("" : "+v"(lane_));
    LAS float* scr = (LAS float*)(F.lds + RING_OFF + F.wave * 16384);
    unsigned char* ws = F.ws;
    constexpr int I_A = (512 / 64) * (D / 32), I_O = (D / 64) * (D / 32), I_1 = (D / 64) * (FF / 32), I_2 = (FF / 64) * (D / 32), NIT = 2 * I_A + I_O + I_1 + I_2;
    const int per = NIT / nparts, lo = part * per, hi = lo + per;
    const int gw = (F.bx - cu0) * NWAVES + F.wave, NGW = (F.G - cu0) * NWAVES;
    for (int it = lo + gw; it < hi; it += NGW) {
        int r = it;
        if (r < I_A) { p0_transpose_item<false>(A[I_WA], 512, D, (bf16*)(ws + WS_WA), scr, r, lane_, 1024, 0); continue; } r -= I_A;
        if (r < I_A) { p0_transpose_item<false>(A[I_WB], 512, D, (bf16*)(ws + WS_WA), scr, r, lane_, 1024, 512); continue; } r -= I_A;
        if (r < I_O) { p0_transpose_item<false>(A[I_WO], D, D, (bf16*)(ws + WS_WO), scr, r, lane_); continue; } r -= I_O;
        if (r < I_1) { p0_transpose_item<false>(A[I_FF1], D, FF, (bf16*)(ws + WS_W1), scr, r, lane_); continue; } r -= I_1;
        p0_transpose_item<false>(A[I_FF2], FF, D, (bf16*)(ws + WS_W2), scr, r, lane_);
    }
}
__device__ __forceinline__ void prep1_phase(Frame& F, const InTab& A) {
    const int gw = F.bx * NWAVES + F.wave, NGW = F.G * NWAVES, lane = F.lane;
    const bf16* WAG = (const bf16*)(F.ws + WS_WAG); bf16* LIN = (bf16*)(F.ws + WS_LIN);
    const f32x4 mu = *(const f32x4*)(A[I_MU] + 1536 + 4 * lane);
    for (int m = gw; m < M; m += NGW) {
        const v2u cur = *(const GAS v2u*)(WAG + (size_t)m * 256 + 4 * lane);
        v2u prv = (v2u){0u, 0u}; if ((m & (SEQ - 1)) != 0) prv = *(const GAS v2u*)(WAG + (size_t)(m - 1) * 256 + 4 * lane);
        float z[4] = {bflo(cur.x), bfhi(cur.x), bflo(cur.y), bfhi(cur.y)}; const float p[4] = {bflo(prv.x), bfhi(prv.x), bflo(prv.y), bfhi(prv.y)};
#pragma unroll
        for (int e = 0; e < 4; ++e) { float v = z[e] + (p[e] - z[e]) * mu[e];
            if (lane < 16) v = tanhf(v); else if (lane >= 32) v = 1.0f / (1.0f + __expf(-v));
            z[e] = v; }
        v2u o; o.x = pk2(z[0], z[1]); o.y = pk2(z[2], z[3]);
        *(GAS v2u*)(LIN + (size_t)m * 256 + 4 * lane) = o;
    }
}
struct ScanRaw { unsigned short r[9], k[9], v[9], a[8]; float d[8]; };
__device__ __forceinline__ void scan_load(ScanRaw& R, const bf16* RKV, const float* DEC, const bf16* AA, size_t row0, int t0, int c) {
#pragma unroll
    for (int j = 0; j < 9; ++j) { int t = t0 - 1 + j; if (t < 0) t = 0; const bf16* p = RKV + (row0 + t) * 1536 + c;
        R.r[j] = *(const GAS bf16*)p; R.k[j] = *(const GAS bf16*)(p + 512); R.v[j] = *(const GAS bf16*)(p + 1024); }
#pragma unroll
    for (int j = 0; j < 8; ++j) { R.d[j] = *(const GAS float*)(DEC + (row0 + t0 + j) * 512 + c); R.a[j] = *(const GAS bf16*)(AA + (row0 + t0 + j) * 512 + c); }
}
__device__ __forceinline__ void scan_phase(Frame& F, const InTab& A, int si) {
    const int lane = F.lane, wave = F.wave, tid = F.tid;
    const int bh = si >> 1, half = si & 1, b = bh >> 3, h = bh & 7, c = h * 64 + lane;
    LAS float* IN = (LAS float*)(F.lds + RING_OFF);
    LAS float* VV = IN + 5 * 4096;
    LAS float* YBUF = VV + 2048;
    const bf16* RKV = (const bf16*)(F.ws + WS_RKV); const float* DEC = (const float*)(F.ws + WS_DEC); const bf16* AA = (const bf16*)(F.ws + WS_AA);
    bf16* Y = (bf16*)(F.ws + WS_Y); float* BON = (float*)(F.ws + WS_BON);
    const float mu_r = A[I_MU][c], mu_k = A[I_MU][512 + c], mu_v = A[I_MU][1024 + c], kkc = A[I_KK][c], kac = A[I_KA][c], rkc = A[I_RK][c];
    const size_t row0 = (size_t)b * SEQ;
    const int myv = (int)(red4(0.f, 1.f, 2.f, 3.f) * (1.0f / 64.0f) + 0.5f);
    const int L0 = __builtin_ctzll(__ballot(myv == 0)), L1 = __builtin_ctzll(__ballot(myv == 1)), L2 = __builtin_ctzll(__ballot(myv == 2)), L3 = __builtin_ctzll(__ballot(myv == 3));
    float S0 = 0.f, S1 = 0.f, S2 = 0.f, S3 = 0.f;
    ScanRaw R; scan_load(R, RKV, DEC, AA, row0, wave * 8, c);
    for (int blk = 0; blk < SEQ / 64; ++blk) {
        {
            const int t0 = blk * 64 + wave * 8;
            f32x4 qd[2], qa[2], qb[2], qk[2], qr[2], qv[2];
#pragma unroll
            for (int j = 0; j < 8; ++j) {
                const float pz = (t0 + j == 0) ? 0.f : 1.f;
                const float rt_ = bf1(R.r[j + 1]), kt_ = bf1(R.k[j + 1]), vt_ = bf1(R.v[j + 1]);
                const float rs = rt_ + (bf1(R.r[j]) * pz - rt_) * mu_r, ks = kt_ + (bf1(R.k[j]) * pz - kt_) * mu_k, vs = vt_ + (bf1(R.v[j]) * pz - vt_) * mu_v;
                const float kkr = ks * kkc, n2 = wave_allsum(kkr * kkr), kk = kkr / __builtin_fmaxf(sqrtf(n2), 1e-12f);
                const float a = 1.0f / (1.0f + __expf(-bf1(R.a[j]))), kx = ks * (1.0f + (a - 1.0f) * kac);
                const float bon = wave_allsum(rs * kx * rkc);
                if (half == 0 && lane == 0) BON[(row0 + t0 + j) * 8 + h] = bon;
                qd[j >> 2][j & 3] = __expf(-0.6065306597f / (1.0f + __expf(-R.d[j])));     qa[j >> 2][j & 3] = -kk; qb[j >> 2][j & 3] = kk * a; qk[j >> 2][j & 3] = kx; qr[j >> 2][j & 3] = rs; qv[j >> 2][j & 3] = vs;
            }
#pragma unroll
            for (int q = 0; q < 2; ++q) { const int t4 = wave * 2 + q; LAS f32x4* p = (LAS f32x4*)IN + t4 * 64 + lane;
                p[0 * 1024] = qd[q]; p[1 * 1024] = qa[q]; p[2 * 1024] = qb[q]; p[3 * 1024] = qk[q]; p[4 * 1024] = qr[q];
                if ((lane >> 5) == half) ((LAS f32x4*)VV)[t4 * 32 + (lane & 31)] = qv[q]; }
        }
        __syncthreads();
        if (blk + 1 < SEQ / 64) scan_load(R, RKV, DEC, AA, row0, (blk + 1) * 64 + wave * 8, c);
#pragma unroll 1
        for (int t4 = 0; t4 < 16; ++t4) {
            const LAS f32x4* p = (const LAS f32x4*)IN + t4 * 64 + lane;
            const f32x4 W4 = p[0], A4 = p[1024], B4 = p[2048], K4 = p[3072], R4 = p[4096];
            const LAS f32x4* pv = (const LAS f32x4*)VV + t4 * 32 + wave * 4;
            const f32x4 V0 = pv[0], V1 = pv[1], V2 = pv[2], V3 = pv[3];
            f32x4 yq;
#pragma unroll
            for (int ts = 0; ts < 4; ++ts) {
                const float w = W4[ts], a = A4[ts], bb = B4[ts], kx = K4[ts], r = R4[ts];
                const float t = red4(S0 * a, S1 * a, S2 * a, S3 * a);
                const float sa0 = __builtin_bit_cast(float, __builtin_amdgcn_readlane(__builtin_bit_cast(int, t), L0)), sa1 = __builtin_bit_cast(float, __builtin_amdgcn_readlane(__builtin_bit_cast(int, t), L1));
                const float sa2 = __builtin_bit_cast(float, __builtin_amdgcn_readlane(__builtin_bit_cast(int, t), L2)), sa3 = __builtin_bit_cast(float, __builtin_amdgcn_readlane(__builtin_bit_cast(int, t), L3));
                S0 = S0 * w + (sa0 * bb + V0[ts] * kx); S1 = S1 * w + (sa1 * bb + V1[ts] * kx); S2 = S2 * w + (sa2 * bb + V2[ts] * kx); S3 = S3 * w + (sa3 * bb + V3[ts] * kx);
                yq[ts] = red4(S0 * r, S1 * r, S2 * r, S3 * r);
            }
            if ((lane & 15) == 0) *(LAS f32x4*)(YBUF + (wave * 4 + myv) * 68 + t4 * 4) = yq;
        }
        __syncthreads();
        { const int t = tid >> 3, rg = tid & 7; const LAS float* yb = YBUF + (4 * rg) * 68 + t;
          v2u o; o.x = pk2(yb[0], yb[68]); o.y = pk2(yb[136], yb[204]);
          *(GAS v2u*)(Y + (row0 + blk * 64 + t) * 512 + h * 64 + 32 * half + 4 * rg) = o; }
    }
    __syncthreads();
}
__device__ __forceinline__ void post_phase(Frame& F, const InTab& A) {
    const int gw = F.bx * NWAVES + F.wave, NGW = F.G * NWAVES, lane = F.lane;
    const bf16* O = (const bf16*)(F.ws + WS_O); const bf16* Y = (const bf16*)(F.ws + WS_Y); const bf16* RKV = (const bf16*)(F.ws + WS_RKV); const bf16* GG = (const bf16*)(F.ws + WS_GG);
    const float* BON = (const float*)(F.ws + WS_BON); bf16* YA = (bf16*)(F.ws + WS_YA); bf16* YB = (bf16*)(F.ws + WS_YB);
    const float lam = __expf(wave_allsum(A[I_LQ1][lane] * A[I_LK1][lane])) - __expf(wave_allsum(A[I_LQ2][lane] * A[I_LK2][lane])) + LAMBDA_INIT;
    const int ca = 8 * lane, ha = lane >> 4, ea = ca & 127;
    const int hb = lane >> 3;
    float sg[8], lg[8], lb[8], muv[8];
#pragma unroll
    for (int e = 0; e < 8; ++e) { sg[e] = A[I_SUBG][ea + e] * (1.0f - LAMBDA_INIT); lg[e] = A[I_LNG][ca + e]; lb[e] = A[I_LNB][ca + e]; muv[e] = A[I_MU][1024 + ca + e]; }
    for (int m = gw; m < M; m += NGW) {
        {
            const v4u o0 = *(const GAS v4u*)(O + (size_t)m * 1024 + (2 * ha) * 128 + ea), o1 = *(const GAS v4u*)(O + (size_t)m * 1024 + (2 * ha + 1) * 128 + ea);
            float o[8] = {bflo(o0.x) - lam * bflo(o1.x), bfhi(o0.x) - lam * bfhi(o1.x), bflo(o0.y) - lam * bflo(o1.y), bfhi(o0.y) - lam * bfhi(o1.y),
                          bflo(o0.z) - lam * bflo(o1.z), bfhi(o0.z) - lam * bfhi(o1.z), bflo(o0.w) - lam * bflo(o1.w), bfhi(o0.w) - lam * bfhi(o1.w)};
            float ss = 0.f;
#pragma unroll
            for (int e = 0; e < 8; ++e) ss += o[e] * o[e];
            const float rstd = 1.0f / sqrtf(row16_allsum(ss) * (1.0f / 128.0f) + SUBLN_EPS);
            v4u w; w.x = pk2(o[0] * rstd * sg[0], o[1] * rstd * sg[1]); w.y = pk2(o[2] * rstd * sg[2], o[3] * rstd * sg[3]); w.z = pk2(o[4] * rstd * sg[4], o[5] * rstd * sg[5]); w.w = pk2(o[6] * rstd * sg[6], o[7] * rstd * sg[7]);
#ifdef ABL_YA0
            w = (v4u){0u, 0u, 0u, 0u};
#endif
            *(GAS v4u*)(YA + (size_t)m * 1024 + ca) = w;
        }
        {
            const v4u yr = *(const GAS v4u*)(Y + (size_t)m * 512 + ca), gr = *(const GAS v4u*)(GG + (size_t)m * 512 + ca);
            const v4u vc = *(const GAS v4u*)(RKV + (size_t)m * 1536 + 1024 + ca);
            v4u vp = (v4u){0u, 0u, 0u, 0u}; if ((m & (SEQ - 1)) != 0) vp = *(const GAS v4u*)(RKV + (size_t)(m - 1) * 1536 + 1024 + ca);
            const float y[8] = {bflo(yr.x), bfhi(yr.x), bflo(yr.y), bfhi(yr.y), bflo(yr.z), bfhi(yr.z), bflo(yr.w), bfhi(yr.w)};
#ifdef DBG_GDIRECT
            float g[8] = {0.f, 0.f, 0.f, 0.f, 0.f, 0.f, 0.f, 0.f};
            { const bf16* LINr = (const bf16*)(F.ws + WS_LIN) + (size_t)m * 256 + 128; (void)gr;
              for (int k = 0; k < 128; ++k) { const float s = bf1(*(const GAS bf16*)(LINr + k)); const float* g2r = A[I_G2] + (size_t)k * 512 + ca;
#pragma unroll
                for (int e = 0; e < 8; ++e) g[e] += s * g2r[e]; } }
#else
            const float g[8] = {bflo(gr.x), bfhi(gr.x), bflo(gr.y), bfhi(gr.y), bflo(gr.z), bfhi(gr.z), bflo(gr.w), bfhi(gr.w)};
#endif
            const float v[8] = {bflo(vc.x), bfhi(vc.x), bflo(vc.y), bfhi(vc.y), bflo(vc.z), bfhi(vc.z), bflo(vc.w), bfhi(vc.w)};
            const float p[8] = {bflo(vp.x), bfhi(vp.x), bflo(vp.y), bfhi(vp.y), bflo(vp.z), bfhi(vp.z), bflo(vp.w), bfhi(vp.w)};
            float s = 0.f;
#pragma unroll
            for (int e = 0; e < 8; ++e) s += y[e];
            const float mean = oct_allsum(s) * (1.0f / 64.0f); float q = 0.f;
#pragma unroll
            for (int e = 0; e < 8; ++e) { const float d = y[e] - mean; q += d * d; }
            const float rstd = 1.0f / sqrtf(oct_allsum(q) * (1.0f / 64.0f) + GN_EPS);
#ifdef DBG_BONDIRECT
            float bon;
            { const v4u rc = *(const GAS v4u*)(RKV + (size_t)m * 1536 + ca), kc = *(const GAS v4u*)(RKV + (size_t)m * 1536 + 512 + ca), ac = *(const GAS v4u*)((const bf16*)(F.ws + WS_AA) + (size_t)m * 512 + ca);
              v4u rp = (v4u){0u, 0u, 0u, 0u}, kp = (v4u){0u, 0u, 0u, 0u};
              if ((m & (SEQ - 1)) != 0) { rp = *(const GAS v4u*)(RKV + (size_t)(m - 1) * 1536 + ca); kp = *(const GAS v4u*)(RKV + (size_t)(m - 1) * 1536 + 512 + ca); }
              const float rcf[8] = {bflo(rc.x), bfhi(rc.x), bflo(rc.y), bfhi(rc.y), bflo(rc.z), bfhi(rc.z), bflo(rc.w), bfhi(rc.w)}, rpf[8] = {bflo(rp.x), bfhi(rp.x), bflo(rp.y), bfhi(rp.y), bflo(rp.z), bfhi(rp.z), bflo(rp.w), bfhi(rp.w)};
              const float kcf[8] = {bflo(kc.x), bfhi(kc.x), bflo(kc.y), bfhi(kc.y), bflo(kc.z), bfhi(kc.z), bflo(kc.w), bfhi(kc.w)}, kpf[8] = {bflo(kp.x), bfhi(kp.x), bflo(kp.y), bfhi(kp.y), bflo(kp.z), bfhi(kp.z), bflo(kp.w), bfhi(kp.w)};
              const float af[8] = {bflo(ac.x), bfhi(ac.x), bflo(ac.y), bfhi(ac.y), bflo(ac.z), bfhi(ac.z), bflo(ac.w), bfhi(ac.w)};
              float s_ = 0.f;
#pragma unroll
              for (int e = 0; e < 8; ++e) { const float rs = rcf[e] + (rpf[e] - rcf[e]) * A[I_MU][ca + e], ks = kcf[e] + (kpf[e] - kcf[e]) * A[I_MU][512 + ca + e];
                  s_ += rs * (ks * (1.0f + (af[e] - 1.0f) * A[I_KA][ca + e])) * A[I_RK][ca + e]; }
              bon = oct_allsum(s_); (void)BON; }
#else
            const float bon = BON[(size_t)m * 8 + hb];
#endif
            float r[8];
#pragma unroll
            for (int e = 0; e < 8; ++e) { const float vs = v[e] + (p[e] - v[e]) * muv[e];
#if defined(ABL_NOGN)
                r[e] = (bon * vs) * g[e]; }
#elif defined(ABL_NOBON)
                r[e] = (((y[e] - mean) * rstd) * lg[e] + lb[e]) * g[e]; }
#else
                r[e] = (((y[e] - mean) * rstd) * lg[e] + lb[e] + bon * vs) * g[e]; }
#endif

            v4u w; w.x = pk2(r[0], r[1]); w.y = pk2(r[2], r[3]); w.z = pk2(r[4], r[5]); w.w = pk2(r[6], r[7]);
#ifdef ABL_YB0
            w = (v4u){0u, 0u, 0u, 0u};
#endif
            *(GAS v4u*)(YA + (size_t)m * 1024 + 512 + ca) = w;
        }
    }
}

typedef short rk_bf16x8 __attribute__((ext_vector_type(8)));
typedef float rk_f32x16 __attribute__((ext_vector_type(16)));
constexpr int RKA_RS_K = 144, RKA_RS_J = 80;
constexpr int RKA_A = 0, RKA_B = 5120, RKA_K = 10240, RKA_R = 15360, RKA_AT = 19968, RKA_BH = 25088, RKA_KH = 30208, RKA_VT = 35328, RKA_GC = 40448, RKA_BYTES = 40704;
constexpr int RKA_N = 0, RKA_X = 0, RKA_T = 5120, RKA_MAK = 7680, RKA_MRB = 10240, RKA_MRK = 12800;
constexpr int RKA_WAVES = 4;
static_assert(RKA_WAVES * RKA_BYTES <= 162816, "phase A LDS");
constexpr size_t WS_PQ = 66 * MiB;
constexpr size_t WS_RY = 98 * MiB;
constexpr size_t WS_GC = 242 * MiB;
constexpr size_t WS_SST = 243 * MiB;

__device__ __forceinline__ rk_bf16x8 rk_frag(const LAS unsigned char* base, int rs, int row, int s, int h) { return *(const LAS rk_bf16x8*)(base + row * rs + (16 * s + 8 * h) * 2); }
__device__ __forceinline__ rk_f32x16 rk_mfma(rk_bf16x8 a, rk_bf16x8 b, rk_f32x16 c) { return __builtin_amdgcn_mfma_f32_32x32x16_bf16(a, b, c, 0, 0, 0); }
__device__ __forceinline__ unsigned rk_pk(float lo, float hi) { typedef float f2_ __attribute__((ext_vector_type(2))); typedef __bf16 b2_ __attribute__((ext_vector_type(2))); f2_ v = {lo, hi}; b2_ b = __builtin_convertvector(v, b2_); return __builtin_bit_cast(unsigned, b); }
__device__ __forceinline__ void rk_store_tile_lds(LAS unsigned char* base, int rs, int nrow, int mbase, int h, const rk_f32x16& acc) {
#pragma unroll
    for (int g = 0; g < 4; ++g) { v2u w; w.x = rk_pk(acc[4 * g], acc[4 * g + 1]); w.y = rk_pk(acc[4 * g + 2], acc[4 * g + 3]); *(LAS v2u*)(base + nrow * rs + (mbase + 8 * g + 4 * h) * 2) = w; }
}
__device__ __forceinline__ void rk_store_tile_glb(bf16* base, int pitch, int nrow, int mbase, int h, const rk_f32x16& acc) {
#pragma unroll
    for (int g = 0; g < 4; ++g) { v2u w; w.x = rk_pk(acc[4 * g], acc[4 * g + 1]); w.y = rk_pk(acc[4 * g + 2], acc[4 * g + 3]); *(GAS v2u*)(base + (size_t)nrow * pitch + mbase + 8 * g + 4 * h) = w; }
}
__device__ __forceinline__ void rk_store_tile_frag(unsigned char* base, int nt, int r32, int mt, int h, const rk_f32x16& acc) {
#pragma unroll
    for (int g = 0; g < 4; ++g) { v2u w; w.x = rk_pk(acc[4 * g], acc[4 * g + 1]); w.y = rk_pk(acc[4 * g + 2], acc[4 * g + 3]);
        *(GAS v2u*)(base + ((size_t)((nt * 4 + 2 * mt + (g >> 1)) * 64 + r32 + 32 * (g & 1))) * 16 + 8 * h) = w; }
}
__device__ __forceinline__ void rk_store_blob(unsigned* blob, int lane, const rk_f32x16& acc) {
    v4u w0, w1; w0.x = rk_pk(acc[0], acc[1]); w0.y = rk_pk(acc[2], acc[3]); w0.z = rk_pk(acc[4], acc[5]); w0.w = rk_pk(acc[6], acc[7]);
    w1.x = rk_pk(acc[8], acc[9]); w1.y = rk_pk(acc[10], acc[11]); w1.z = rk_pk(acc[12], acc[13]); w1.w = rk_pk(acc[14], acc[15]);
    *(GAS v4u*)(blob + lane * 8) = w0; *(GAS v4u*)(blob + lane * 8 + 4) = w1;
}
struct RkBlob { v4u w0, w1; };
__device__ __forceinline__ RkBlob rk_load_blob(const unsigned* blob, int lane) { RkBlob b; b.w0 = *(const GAS v4u*)(blob + lane * 8); b.w1 = *(const GAS v4u*)(blob + lane * 8 + 4); return b; }
__device__ __forceinline__ rk_f32x16 rk_blob_f32(const RkBlob& b) {
    rk_f32x16 a; const unsigned w[8] = {b.w0.x, b.w0.y, b.w0.z, b.w0.w, b.w1.x, b.w1.y, b.w1.z, b.w1.w};
#pragma unroll
    for (int i = 0; i < 8; ++i) { a[2 * i] = bflo(w[i]); a[2 * i + 1] = bfhi(w[i]); }
    return a;
}

struct RkRaw { unsigned short r[8], k[8], v[8], a[8]; float d[8]; };
__device__ __forceinline__ void rk_load8(RkRaw& R, const bf16* prkv, const float* pdec, const bf16* paa) {
#pragma unroll
    for (int j = 0; j < 8; ++j) { R.r[j] = *(const GAS bf16*)(prkv + j * 1536); R.k[j] = *(const GAS bf16*)(prkv + j * 1536 + 512); R.v[j] = *(const GAS bf16*)(prkv + j * 1536 + 1024);
        R.d[j] = *(const GAS float*)(pdec + j * 512); R.a[j] = *(const GAS bf16*)(paa + j * 512); }
}
__device__ __forceinline__ void rwkvA_unit(LAS unsigned char* L, const InTab& A, unsigned char* ws, int bh, int chunk, int lane_in) {
    int lane = lane_in; asm volatile("" : "+v"(lane));
    const int b = bh >> 3, hd = bh & 7, cg = hd * 64 + lane, r32 = lane & 31, h = lane >> 5;
    const size_t row0 = (size_t)b * SEQ + (size_t)chunk * 32;
    const int uh = bh * 32 + (chunk & 31);
    const bf16* prkv = (const bf16*)(ws + WS_RKV) + row0 * 1536 + cg; const float* pdec = (const float*)(ws + WS_DEC) + row0 * 512 + cg; const bf16* paa = (const bf16*)(ws + WS_AA) + row0 * 512 + cg;
    float* pbon = (float*)(ws + WS_BON) + row0 * 8 + hd;
    const float mu_r = A[I_MU][cg], mu_k = A[I_MU][512 + cg], mu_v = A[I_MU][1024 + cg], kkc = A[I_KK][cg], kac = A[I_KA][cg], rkc = A[I_RK][cg];
    float rp = 0.f, kp = 0.f, vp = 0.f;
    if (chunk != 0) { rp = bf1(*(const GAS bf16*)(prkv - 1536)); kp = bf1(*(const GAS bf16*)(prkv - 1536 + 512)); vp = bf1(*(const GAS bf16*)(prkv - 1536 + 1024)); }
    float G = 1.0f;
    RkRaw Rc, Rn; rk_load8(Rc, prkv, pdec, paa);
#pragma unroll 1
    for (int q = 0; q < 4; ++q) {
        prkv += 8 * 1536; pdec += 8 * 512; paa += 8 * 512;
        if (q < 3) rk_load8(Rn, prkv, pdec, paa);
        LAS unsigned char* Lr = L + (8 * q) * RKA_RS_K + lane * 2;
        LAS unsigned char* Lt = L + lane * RKA_RS_J + (8 * q) * 2;
        unsigned tA[4], tB[4], tK[4], tV[4], pA = 0, pB = 0, pK = 0, pV = 0;
#pragma unroll
        for (int j = 0; j < 8; ++j) {
            const float rc = bf1(Rc.r[j]), kc = bf1(Rc.k[j]), vc = bf1(Rc.v[j]);
            const float rs = rc + (rp - rc) * mu_r, ks = kc + (kp - kc) * mu_k, vs = vc + (vp - vc) * mu_v; rp = rc; kp = kc; vp = vc;
            const float kkr = ks * kkc, n2 = wave_allsum(kkr * kkr), kk = kkr * __builtin_amdgcn_rsqf(__builtin_fmaxf(n2, 1e-24f));
            const float a_ = __builtin_amdgcn_rcpf(1.0f + __expf(-bf1(Rc.a[j]))), kx = ks * (1.0f + (a_ - 1.0f) * kac);
            const float bon = wave_allsum(rs * kx * rkc);
            if (lane == 0) *(GAS float*)(pbon + (8 * q + j) * 8) = bon;
            const float w = __expf(-0.6065306597f * __builtin_amdgcn_rcpf(1.0f + __expf(-Rc.d[j])));
            const float Gprev = G; G *= w; const float iG = __builtin_amdgcn_rcpf(G);
            const bf16 at = (bf16)f2bf(-kk * Gprev), rt = (bf16)f2bf(rs * G), bt = (bf16)f2bf(kk * a_ * iG), kt = (bf16)f2bf(kx * iG), vb = (bf16)f2bf(vs);
            *(LAS bf16*)(Lr + RKA_A + j * RKA_RS_K) = at; *(LAS bf16*)(Lr + RKA_R + j * RKA_RS_K) = rt; *(LAS bf16*)(Lr + RKA_B + j * RKA_RS_K) = bt; *(LAS bf16*)(Lr + RKA_K + j * RKA_RS_K) = kt;
            if (j & 1) { tA[j >> 1] = pA | ((unsigned)at << 16); tB[j >> 1] = pB | ((unsigned)bt << 16); tK[j >> 1] = pK | ((unsigned)kt << 16); tV[j >> 1] = pV | ((unsigned)vb << 16); } else { pA = at; pB = bt; pK = kt; pV = vb; }
        }
        *(LAS v4u*)(Lt + RKA_AT) = (v4u){tA[0], tA[1], tA[2], tA[3]}; *(LAS v4u*)(Lt + RKA_BH) = (v4u){tB[0], tB[1], tB[2], tB[3]}; *(LAS v4u*)(Lt + RKA_KH) = (v4u){tK[0], tK[1], tK[2], tK[3]}; *(LAS v4u*)(Lt + RKA_VT) = (v4u){tV[0], tV[1], tV[2], tV[3]};
        Rc = Rn;
    }
    const float GC = G;
    *(GAS float*)((float*)(ws + WS_GC) + (size_t)uh * 64 + lane) = GC;
    *(LAS float*)(L + RKA_GC + lane * 4) = GC;
    LDS_WAIT(); asm volatile("" ::: "memory");
    {
        rk_f32x16 aN = {}, aAK = {}, aRB = {}, aRK = {};
#pragma unroll
        for (int s = 0; s < 4; ++s) {
            const rk_bf16x8 fA = rk_frag(L + RKA_A, RKA_RS_K, r32, s, h), fR = rk_frag(L + RKA_R, RKA_RS_K, r32, s, h), fB = rk_frag(L + RKA_B, RKA_RS_K, r32, s, h), fK = rk_frag(L + RKA_K, RKA_RS_K, r32, s, h);
            aN = rk_mfma(fB, fA, aN); aAK = rk_mfma(fK, fA, aAK); aRB = rk_mfma(fB, fR, aRB); aRK = rk_mfma(fK, fR, aRK);
        }
        LDS_WAIT(); asm volatile("" ::: "memory");
#pragma unroll
        for (int i = 0; i < 16; ++i) { const int j = (i & 3) + 8 * (i >> 2) + 4 * h;
            if (!(j < r32)) { aN[i] = 0.f; aAK[i] = 0.f; }
            if (!(j <= r32)) { aRB[i] = 0.f; aRK[i] = 0.f; } }
#pragma unroll
        for (int g = 0; g < 4; ++g) *(LAS f32x4*)(L + RKA_N + r32 * 144 + (8 * g + 4 * h) * 4) = (f32x4){aN[4 * g], aN[4 * g + 1], aN[4 * g + 2], aN[4 * g + 3]};
        rk_store_tile_lds(L + RKA_MAK, RKA_RS_J, r32, 0, h, aAK); rk_store_tile_lds(L + RKA_MRB, RKA_RS_J, r32, 0, h, aRB); rk_store_tile_lds(L + RKA_MRK, RKA_RS_J, r32, 0, h, aRK);
    }
    LDS_WAIT(); asm volatile("" ::: "memory");
    {
        float T[32];
#pragma unroll
        for (int t = 0; t < 32; ++t) { float acc = (r32 == t) ? 1.0f : 0.0f;
#pragma unroll
            for (int j4 = 0; j4 < (t + 3) / 4; ++j4) { const f32x4 n4 = *(const LAS f32x4*)(L + RKA_N + t * 144 + j4 * 16);
#pragma unroll
                for (int e = 0; e < 4; ++e) if (4 * j4 + e < t) acc += n4[e] * T[4 * j4 + e]; }
            T[t] = acc; }
        LDS_WAIT(); asm volatile("" ::: "memory");
#pragma unroll
        for (int t = 0; t < 32; ++t) *(LAS bf16*)(L + RKA_T + t * RKA_RS_J + r32 * 2) = (bf16)f2bf(T[t]);
    }
    LDS_WAIT(); asm volatile("" ::: "memory");
    rk_bf16x8 fT[2];
#pragma unroll
    for (int s = 0; s < 2; ++s) fT[s] = rk_frag(L + RKA_T, RKA_RS_J, r32, s, h);
    {
        rk_f32x16 x0[2] = {{}, {}}, ap[2] = {{}, {}};
#pragma unroll
        for (int s = 0; s < 2; ++s) { const rk_bf16x8 fM = rk_frag(L + RKA_MAK, RKA_RS_J, r32, s, h);
#pragma unroll
            for (int nt = 0; nt < 2; ++nt) { x0[nt] = rk_mfma(fM, rk_frag(L + RKA_VT, RKA_RS_J, nt * 32 + r32, s, h), x0[nt]); ap[nt] = rk_mfma(fT[s], rk_frag(L + RKA_AT, RKA_RS_J, nt * 32 + r32, s, h), ap[nt]); } }
        LDS_WAIT(); asm volatile("" ::: "memory");
#pragma unroll
        for (int nt = 0; nt < 2; ++nt) { rk_store_tile_lds(L + RKA_X, RKA_RS_J, nt * 32 + r32, 0, h, x0[nt]); rk_store_tile_lds(L + RKA_AT, RKA_RS_J, nt * 32 + r32, 0, h, ap[nt]); }
    }
    LDS_WAIT(); asm volatile("" ::: "memory");
    {
        rk_f32x16 u0[2] = {{}, {}};
#pragma unroll
        for (int s = 0; s < 2; ++s)
#pragma unroll
            for (int nt = 0; nt < 2; ++nt) u0[nt] = rk_mfma(fT[s], rk_frag(L + RKA_X, RKA_RS_J, nt * 32 + r32, s, h), u0[nt]);
        LDS_WAIT(); asm volatile("" ::: "memory");
#pragma unroll
        for (int nt = 0; nt < 2; ++nt) rk_store_tile_lds(L + RKA_X, RKA_RS_J, nt * 32 + r32, 0, h, u0[nt]);
    }
    LDS_WAIT(); asm volatile("" ::: "memory");
    unsigned char* pq = ws + WS_PQ + (size_t)uh * 16384; unsigned char* ry = ws + WS_RY + (size_t)uh * 8192;
    rk_bf16x8 fRB[2], fRK[2], fAp[2][2], fBh[2][2], fKh[2][2], fU[2][2], fV[2][2];
#pragma unroll
    for (int s = 0; s < 2; ++s) { fRB[s] = rk_frag(L + RKA_MRB, RKA_RS_J, r32, s, h); fRK[s] = rk_frag(L + RKA_MRK, RKA_RS_J, r32, s, h);
#pragma unroll
        for (int nt = 0; nt < 2; ++nt) { fAp[nt][s] = rk_frag(L + RKA_AT, RKA_RS_J, nt * 32 + r32, s, h); fBh[nt][s] = rk_frag(L + RKA_BH, RKA_RS_J, nt * 32 + r32, s, h);
            fKh[nt][s] = rk_frag(L + RKA_KH, RKA_RS_J, nt * 32 + r32, s, h); fU[nt][s] = rk_frag(L + RKA_X, RKA_RS_J, nt * 32 + r32, s, h); fV[nt][s] = rk_frag(L + RKA_VT, RKA_RS_J, nt * 32 + r32, s, h); } }
#pragma unroll
    for (int kt = 0; kt < 2; ++kt) {
        rk_f32x16 acc;
#pragma unroll
        for (int g = 0; g < 4; ++g) { const v2u w = *(const LAS v2u*)(L + RKA_R + r32 * RKA_RS_K + (kt * 32 + 8 * g + 4 * h) * 2); acc[4 * g] = bflo(w.x); acc[4 * g + 1] = bfhi(w.x); acc[4 * g + 2] = bflo(w.y); acc[4 * g + 3] = bfhi(w.y); }
#pragma unroll
        for (int s = 0; s < 2; ++s) acc = rk_mfma(fAp[kt][s], fRB[s], acc);
        rk_store_tile_frag(ry, 0, r32, kt, h, acc);
    }
#pragma unroll
    for (int kt = 0; kt < 2; ++kt)
#pragma unroll
        for (int kq = 0; kq < 2; ++kq) { rk_f32x16 acc = {};
#pragma unroll
            for (int s = 0; s < 2; ++s) acc = rk_mfma(fAp[kq][s], fBh[kt][s], acc);
            acc = acc * *(const LAS float*)(L + RKA_GC + (kt * 32 + r32) * 4);
            rk_store_tile_frag(pq, kt, r32, kq, h, acc); }
#pragma unroll
    for (int vt = 0; vt < 2; ++vt) {
        rk_f32x16 acc = {};
#pragma unroll
        for (int s = 0; s < 2; ++s) { acc = rk_mfma(fU[vt][s], fRB[s], acc); acc = rk_mfma(fV[vt][s], fRK[s], acc); }
        rk_store_blob((unsigned*)(ry + 4096) + vt * 512, lane, acc);
    }
#pragma unroll
    for (int kt = 0; kt < 2; ++kt)
#pragma unroll
        for (int vt = 0; vt < 2; ++vt) { rk_f32x16 acc = {};
#pragma unroll
            for (int s = 0; s < 2; ++s) { acc = rk_mfma(fBh[kt][s], fU[vt][s], acc); acc = rk_mfma(fKh[kt][s], fV[vt][s], acc); }
#pragma unroll
            for (int g = 0; g < 4; ++g) { const f32x4 gq = *(const LAS f32x4*)(L + RKA_GC + (kt * 32 + 8 * g + 4 * h) * 4); acc[4 * g] *= gq[0]; acc[4 * g + 1] *= gq[1]; acc[4 * g + 2] *= gq[2]; acc[4 * g + 3] *= gq[3]; }
            rk_store_blob((unsigned*)(pq + 8192) + (kt * 2 + vt) * 512, lane, acc); }
    LDS_WAIT(); asm volatile("" ::: "memory");
}
__device__ __forceinline__ void rwkvA_phase(Frame& F, const InTab& A, int half) {
    if (F.wave >= RKA_WAVES) return;
    LAS unsigned char* L = F.lds + RING_OFF + F.wave * RKA_BYTES;
    const int gw = F.bx * RKA_WAVES + F.wave, NGW = F.G * RKA_WAVES;
    for (int u = gw; u < 64 * 32; u += NGW) rwkvA_unit(L, A, F.ws, u >> 5, half * 32 + (u & 31), F.lane);
}
constexpr int RKB_RS = 144, RKB_SBUF = 64 * RKB_RS;
__device__ __forceinline__ void rwkvB_phase(Frame& F, int bh, int half) {
    int lane = F.lane; asm volatile("" : "+v"(lane));
    const int wave = F.wave, r32 = lane & 31, h = lane >> 5;
    LAS unsigned char* SB = F.lds + RING_OFF;
    unsigned char* ws = F.ws;
    const int b = bh >> 3, hd = bh & 7;
    bf16* Y = (bf16*)(ws + WS_Y);
    const int kt = (wave >> 1) & 1, vt = wave & 1;
    float* sst = (float*)(ws + WS_SST) + (size_t)bh * 4096 + (size_t)(wave & 3) * 1024;
    rk_f32x16 st = {};
    if (wave < 4) {
        if (half != 0) {
#pragma unroll
            for (int i = 0; i < 16; ++i) st[i] = *(const GAS float*)(sst + i * 64 + lane);
        }
        rk_store_tile_lds(SB, RKB_RS, vt * 32 + r32, kt * 32, h, st);
    }
    const int uh0 = bh * 32; const bool isS = wave < 4, isY = !isS && wave < 6;
    const unsigned char* fptr = isS ? ws + WS_PQ + (size_t)uh0 * 16384 + (kt * 256 + lane) * 16 : ws + WS_RY + (size_t)uh0 * 8192 + lane * 16;
    const unsigned char* bptr = isS ? ws + WS_PQ + (size_t)uh0 * 16384 + 8192 + (kt * 2 + vt) * 2048 + lane * 32 : ws + WS_RY + (size_t)uh0 * 8192 + 4096 + vt * 2048 + lane * 32;
    const LAS unsigned char* gl = SB + 2 * RKB_SBUF + (kt * 32 + 4 * h) * 4;
    const int fstride = isS ? 16384 : 8192;
    struct Op { v4u f[4]; v4u b0, b1; };
    { const int tid_ = wave * 64 + lane; *(LAS f32x4*)(SB + 2 * RKB_SBUF + tid_ * 16) = *(const GAS f32x4*)(ws + WS_GC + (size_t)uh0 * 256 + tid_ * 16); }
    Op o0, o1, o2;
#define RKB_LOAD(O_, c) do { const unsigned char* fp_ = fptr + (size_t)(c) * fstride; const unsigned char* bp_ = bptr + (size_t)(c) * fstride; \
        _Pragma("unroll") for (int s = 0; s < 4; ++s) O_.f[s] = *(const GAS v4u*)(fp_ + 1024 * s); \
        O_.b0 = *(const GAS v4u*)bp_; O_.b1 = *(const GAS v4u*)(bp_ + 16); } while (0)
#define RKB_BAR() do { asm volatile("s_waitcnt lgkmcnt(0)" ::: "memory"); __builtin_amdgcn_s_barrier(); asm volatile("" ::: "memory"); } while (0)
#define RKB_NEXT(O_, c, AH_) RKB_LOAD(O_, ((c) + (AH_) < 32 ? (c) + (AH_) : 31))
#define RKB_STEP_S(O_, c) do { \
        const LAS unsigned char* cur = SB + ((c) & 1) * RKB_SBUF; LAS unsigned char* nxt = SB + (((c) & 1) ^ 1) * RKB_SBUF; \
        rk_bf16x8 fS[4]; _Pragma("unroll") for (int s = 0; s < 4; ++s) fS[s] = rk_frag(cur, RKB_RS, vt * 32 + r32, s, h); \
        RkBlob bb_; bb_.w0 = O_.b0; bb_.w1 = O_.b1; const rk_f32x16 q = rk_blob_f32(bb_); \
        _Pragma("unroll") for (int g = 0; g < 4; ++g) { const f32x4 gq = *(const LAS f32x4*)(gl + (c) * 256 + 32 * g); \
            st[4 * g] = st[4 * g] * gq[0] + q[4 * g]; st[4 * g + 1] = st[4 * g + 1] * gq[1] + q[4 * g + 1]; st[4 * g + 2] = st[4 * g + 2] * gq[2] + q[4 * g + 2]; st[4 * g + 3] = st[4 * g + 3] * gq[3] + q[4 * g + 3]; } \
        _Pragma("unroll") for (int s = 0; s < 4; ++s) st = rk_mfma(__builtin_bit_cast(rk_bf16x8, O_.f[s]), fS[s], st); \
        RKB_NEXT(O_, c, 5); \
        rk_store_tile_lds(nxt, RKB_RS, vt * 32 + r32, kt * 32, h, st); \
        RKB_BAR(); } while (0)
#define RKB_STEP_Y(O_, c) do { \
        const LAS unsigned char* cur = SB + ((c) & 1) * RKB_SBUF; \
        rk_bf16x8 fS[4]; _Pragma("unroll") for (int s = 0; s < 4; ++s) fS[s] = rk_frag(cur, RKB_RS, vt * 32 + r32, s, h); \
        RkBlob bb_; bb_.w0 = O_.b0; bb_.w1 = O_.b1; rk_f32x16 acc = rk_blob_f32(bb_); \
        _Pragma("unroll") for (int s = 0; s < 4; ++s) acc = rk_mfma(fS[s], __builtin_bit_cast(rk_bf16x8, O_.f[s]), acc);       \
        RKB_NEXT(O_, c, 3); \
        rk_store_tile_glb(Y + ((size_t)b * SEQ + (size_t)(half * 32 + (c)) * 32) * 512 + hd * 64, 512, r32, vt * 32, h, acc); \
        RKB_BAR(); } while (0)
    if (isY) { RKB_LOAD(o0, 0); RKB_LOAD(o1, 1); RKB_LOAD(o2, 2); }
    __syncthreads();
    if (isS) {
        Op o3, o4; RKB_LOAD(o0, 0); RKB_LOAD(o1, 1); RKB_LOAD(o2, 2); RKB_LOAD(o3, 3); RKB_LOAD(o4, 4);
#define R5S(c) RKB_STEP_S(o0, c); RKB_STEP_S(o1, (c) + 1); RKB_STEP_S(o2, (c) + 2); RKB_STEP_S(o3, (c) + 3); RKB_STEP_S(o4, (c) + 4);
        R5S(0) R5S(5) R5S(10) R5S(15) R5S(20) R5S(25)
        RKB_STEP_S(o0, 30); RKB_STEP_S(o1, 31);
#undef R5S
    } else if (isY) {
#define R3Y(c) RKB_STEP_Y(o0, c); RKB_STEP_Y(o1, (c) + 1); RKB_STEP_Y(o2, (c) + 2);
        R3Y(0) R3Y(3) R3Y(6) R3Y(9) R3Y(12) R3Y(15) R3Y(18) R3Y(21) R3Y(24) R3Y(27)
        RKB_STEP_Y(o0, 30); RKB_STEP_Y(o1, 31);
#undef R3Y
    } else {
#pragma unroll 1
        for (int c = 0; c < 32; ++c) RKB_BAR();
    }
#undef RKB_STEP_S
#undef RKB_STEP_Y
#undef RKB_NEXT
#undef RKB_BAR
#undef RKB_LOAD
    if (wave < 4 && half == 0) {
#pragma unroll
        for (int i = 0; i < 16; ++i) *(GAS float*)(sst + i * 64 + lane) = st[i];
    }
}

constexpr int NPHASE = 11;
template <int PHM> __global__ void __launch_bounds__(NWAVES * 64, 2) fwd_kernel(Args args) {
    extern __shared__ __attribute__((aligned(16))) unsigned char lds[];
    namespace cg = cooperative_groups;
    Frame F;
    F.lds = (LAS unsigned char*)lds;
    F.tid = threadIdx.x; F.lane = F.tid & 63; F.wave = __builtin_amdgcn_readfirstlane(F.tid >> 6);
    F.G = gridDim.x; F.bx = blockIdx.x;
    F.out = args.out; F.ws = args.ws;
#define PH_BEGIN InTab TAB; { ktab_t kp_ = (ktab_t)__builtin_amdgcn_kernarg_segment_ptr(); asm volatile("" : "+s"(kp_)); TAB.p = kp_; } { int t_ = threadIdx.x; asm volatile("" : "+v"(t_)); F.tid = t_; F.lane = t_ & 63; F.wave = __builtin_amdgcn_readfirstlane(t_ >> 6); } GAS unsigned char* wsg_ = (GAS unsigned char*)args.ws; asm volatile("" : "+s"(wsg_)); unsigned char* ws = (unsigned char*)wsg_; F.ws = ws; GAS bf16_t* gtg_ = (GAS bf16_t*)args.out; asm volatile("" : "+s"(gtg_)); bf16_t* GATES = (bf16_t*)gtg_; F.out = (float*)GATES; (void)GATES;
    const int lo = args.ph_lo, hi = args.ph_hi;
    XcdBarrier bar; bar.bar = nullptr; bar.x = 0; bar.st = nullptr;
    if (hi - lo > 1) {
        for (int u = threadIdx.x; u < (LDS_BYTES - 162816) / 4; u += NWAVES * 64) ((LAS unsigned*)(F.lds + 162816))[u] = 0u;
        __syncthreads();
        bar = xcd_barrier_post((unsigned*)(args.ws + WS_CTL) + CW_BAR, (volatile LAS unsigned*)(F.lds + MISC_OFF) + 8);
        cg::this_grid().sync();
    }
#define IN(k) (((PHM >> (k)) & 1) && lo <= (k) && (k) < hi)
#ifdef PROBE_DUP
#define REPS(k) (((k) == PROBE_DUP) ? 2 : 1)
#else
#define REPS(k) 1
#endif
#define SEAM(k) do { if (IN(k) && IN((k) + 1)) { xcd_barrier(bar); } } while (0)
    using pg8::Gemm; using pg8::StaticOrder; using pg8::EpiRow8; using pg8::bf16_t;

    if (IN(0)) for (int rep_ = 0; rep_ < REPS(0); ++rep_) { if (rep_) xcd_barrier(bar); PH_BEGIN p0_prologue(F, TAB); } SEAM(0);
    if (IN(1)) for (int rep_ = 0; rep_ < REPS(1); ++rep_) { if (rep_) xcd_barrier(bar); PH_BEGIN
        Gemm g{(const bf16_t*)(ws + WS_XN), (const bf16_t*)(ws + WS_WIN), M, D_IN, D}; StaticOrder S; S.init(M, D_IN, F.G, F.bx);
        EpiRow8<pg8::FProj> E{{ws, GATES}};
        pg8::gemm_phase<EpiRow8<pg8::FProj>, StaticOrder, PG8_ALIGN, PG8_SP2>(F.lds + RING_OFF, g, S, E);
    } SEAM(1);
    if (IN(2)) for (int rep_ = 0; rep_ < REPS(2); ++rep_) { if (rep_) xcd_barrier(bar); PH_BEGIN prep1_phase(F, TAB); } SEAM(2);
    if (IN(3)) for (int rep_ = 0; rep_ < REPS(3); ++rep_) { if (rep_) xcd_barrier(bar); PH_BEGIN
        int klora = KLORA; asm volatile("" : "+s"(klora));
        Gemm g{(const bf16_t*)(ws + WS_LIN), (const bf16_t*)(ws + WS_WL), M, NLORA, klora}; StaticOrder S; S.init(M, NLORA, F.G, F.bx);
        EpiRow8<pg8::FLora> E{{ws, TAB[I_W0], TAB[I_A0]}};
        pg8::gemm_phase<EpiRow8<pg8::FLora>, StaticOrder, PG8_ALIGN, PG8_SP2>(F.lds + RING_OFF, g, S, E);
    } SEAM(3);
    if (IN(4)) for (int rep_ = 0; rep_ < REPS(4); ++rep_) { if (rep_) xcd_barrier(bar); PH_BEGIN
        const attn_body::AttnTensors AT{(const attn_body::bf16*)(ws + WS_Q), (const attn_body::bf16*)(ws + WS_K), (const attn_body::bf16*)(ws + WS_V), (attn_body::bf16*)(ws + WS_O)};
        const attn_body::StaticOrder S(F.bx, F.G);
        attn_body::attn_phase<attn_body::StaticOrder>((char*)lds + RING_OFF, AT, S);
    } SEAM(4);
    if (IN(5)) for (int rep_ = 0; rep_ < REPS(5); ++rep_) { if (rep_) xcd_barrier(bar); PH_BEGIN
#pragma unroll 1
        for (int half = 0; half < 2; ++half) {
            { GAS unsigned char* w_ = (GAS unsigned char*)args.ws; asm volatile("" : "+s"(w_)); F.ws = (unsigned char*)w_; }
            rwkvA_phase(F, TAB, half);
#ifdef PROBE_DUP_RKA
            rwkvA_phase(F, TAB, half);
#endif
            xcd_barrier(bar);
            { GAS unsigned char* w_ = (GAS unsigned char*)args.ws; asm volatile("" : "+s"(w_)); F.ws = (unsigned char*)w_; }
            if (F.bx < 64) rwkvB_phase(F, F.bx, half); else late_weights(F, TAB, half, 2, 64);
#ifdef PROBE_DUP_RKB
            if (F.bx < 64) rwkvB_phase(F, F.bx, half);
#endif
            if (half == 0) xcd_barrier(bar);
        }
    } SEAM(5);
#ifdef PROBE_BARS
    for (int pb_ = 0; pb_ < PROBE_BARS; ++pb_) xcd_barrier(bar);
#endif
    if (IN(6)) for (int rep_ = 0; rep_ < REPS(6); ++rep_) { if (rep_) xcd_barrier(bar); PH_BEGIN post_phase(F, TAB); } SEAM(6);
    if (IN(7)) for (int rep_ = 0; rep_ < REPS(7); ++rep_) { if (rep_) xcd_barrier(bar); PH_BEGIN
        Gemm g{(const bf16_t*)(ws + WS_YA), (const bf16_t*)(ws + WS_WA), M, D, 1024}; StaticOrder S; S.init(M, D, F.G, F.bx);
        pg8::EpiMerge E{GATES, (bf16_t*)(ws + WS_MERGED)};
        pg8::gemm_phase<pg8::EpiMerge, StaticOrder, PG8_ALIGN, PG8_SP2>(F.lds + RING_OFF, g, S, E);
    } SEAM(7);
    if (IN(8)) for (int rep_ = 0; rep_ < REPS(8); ++rep_) { if (rep_) xcd_barrier(bar); PH_BEGIN
        Gemm g{(const bf16_t*)(ws + WS_MERGED), (const bf16_t*)(ws + WS_WO), M, D, D}; StaticOrder S; S.init(M, D, F.G, F.bx);
        pg8::EpiResNorm<0> E{TAB[I_X], F.out, (bf16_t*)(ws + WS_XN), TAB[I_NFG], (float*)(ws + WS_CTL + CTL_SS1), (unsigned*)(ws + WS_CTL + CTL_CNT1), NORM_EPS};
        pg8::gemm_phase<pg8::EpiResNorm<0>, StaticOrder, PG8_ALIGN, PG8_SP2>(F.lds + RING_OFF, g, S, E);
    } SEAM(8);
    if (IN(9)) for (int rep_ = 0; rep_ < REPS(9); ++rep_) { if (rep_) xcd_barrier(bar); PH_BEGIN
        Gemm g{(const bf16_t*)(ws + WS_XN), (const bf16_t*)(ws + WS_W1), M, FF, D}; StaticOrder S; S.init(M, FF, F.G, F.bx);
        EpiRow8<pg8::FRelu2> E{{(bf16_t*)(ws + WS_H)}};
        pg8::gemm_phase<EpiRow8<pg8::FRelu2>, StaticOrder, PG8_ALIGN, PG8_SP2>(F.lds + RING_OFF, g, S, E);
    } SEAM(9);
    if (IN(10)) for (int rep_ = 0; rep_ < REPS(10); ++rep_) { if (rep_) xcd_barrier(bar); PH_BEGIN
        Gemm g{(const bf16_t*)(ws + WS_H), (const bf16_t*)(ws + WS_W2), M, D, FF}; StaticOrder S; S.init(M, D, F.G, F.bx);
        pg8::EpiResNorm<1> E{F.out, F.out, nullptr, TAB[I_NFIN], (float*)(ws + WS_CTL + CTL_SS2), (unsigned*)(ws + WS_CTL + CTL_CNT2), NORM_EPS};
        pg8::gemm_phase<pg8::EpiResNorm<1>, StaticOrder, PG8_ALIGN, PG8_SP2>(F.lds + RING_OFF, g, S, E);
    }
#undef IN
#undef SEAM
#undef PH_BEGIN
}


#ifdef DBG_DUMP
__global__ void dbg_dump(float* out, const unsigned char* ws) {
    const size_t i = (size_t)blockIdx.x * blockDim.x + threadIdx.x; if (i >= (size_t)M * 1024) return;
    const size_t m = i >> 10; const int c = (int)(i & 1023); float v = 0.f;
#if DBG_DUMP == 1
    v = bf1(((const bf16*)(ws + WS_O))[m * 1024 + c]);
#elif DBG_DUMP == 2
    v = c < 512 ? bf1(((const bf16*)(ws + WS_Y))[m * 512 + c]) : (c < 520 ? ((const float*)(ws + WS_BON))[m * 8 + (c - 512)] : 0.f);
#elif DBG_DUMP == 3
    v = c < 512 ? bf1(((const bf16*)(ws + WS_Q))[m * 512 + c]) : bf1(((const bf16*)(ws + WS_K))[m * 512 + c - 512]);
#elif DBG_DUMP == 4
    v = c < 512 ? ((const float*)(ws + WS_DEC))[m * 512 + c] : bf1(((const bf16*)(ws + WS_AA))[m * 512 + c - 512]);
#elif DBG_DUMP == 6
    v = c < 256 ? bf1(((const bf16*)(ws + WS_WAG))[m * 256 + c]) : (c < 512 ? bf1(((const bf16*)(ws + WS_LIN))[m * 256 + c - 256]) : 0.f);
#elif DBG_DUMP == 7
    { const bf16* wl = (const bf16*)(ws + WS_WL); const size_t j = (m * 1024 + c); v = j < (size_t)NLORA * KLORA ? bf1(wl[j]) : 0.f; }
#elif DBG_DUMP == 8
    v = c < 512 ? bf1(((const bf16*)(ws + WS_GG))[m * 512 + c]) : 0.f;
#elif DBG_DUMP == 5
    v = bf1(((const bf16*)(ws + WS_RKV))[m * 1536 + c]);
#endif
    out[i] = v;
}
#endif

#ifdef DBG_FIXLORA
__global__ void dbg_fixlora(Args A) {
    const size_t i = (size_t)blockIdx.x * blockDim.x + threadIdx.x; if (i >= (size_t)M * 512) return;
    const size_t m = i >> 9; const int c = (int)(i & 511);
    const bf16* LINr = (const bf16*)(A.ws + WS_LIN) + m * 256;
#if DBG_FIXLORA & 1
    { float g = 0.f; for (int k = 0; k < 128; ++k) g += bf1(LINr[128 + k]) * A[I_G2][(size_t)k * 512 + c]; ((bf16*)(A.ws + WS_GG))[m * 512 + c] = (bf16)f2bf(g); }
#endif
#if DBG_FIXLORA & 2
    { float s = A[I_A0][c]; for (int k = 0; k < 64; ++k) s += bf1(LINr[64 + k]) * A[I_A2][(size_t)k * 512 + c]; ((bf16*)(A.ws + WS_AA))[m * 512 + c] = (bf16)f2bf(1.0f / (1.0f + expf(-s))); }
#endif
#if DBG_FIXLORA & 4
    { float s = A[I_W0][c]; for (int k = 0; k < 64; ++k) s += bf1(LINr[k]) * A[I_W2][(size_t)k * 512 + c]; const float w = -log1pf(expf(-s)) - 0.5f; ((float*)(A.ws + WS_DEC))[m * 512 + c] = expf(-expf(w)); }
#endif
}
#endif
#ifndef MK_ONE_LAUNCH
#define MK_ONE_LAUNCH 0
#endif
#ifndef MK_MASK
#define MK_MASK ((1 << NPHASE) - 1)
#endif
typedef void (*kern_t)(Args);
template <int P> struct KTab { static void fill(kern_t* t) { t[P] = fwd_kernel<(1 << P)>; KTab<P - 1>::fill(t); } };
template <> struct KTab<-1> { static void fill(kern_t*) {} };
extern "C" void kernel_launch(void* const* d_in, const int* in_sizes, int n_in, void* d_out, int out_size, void* d_ws, size_t ws_size, hipStream_t stream) {
    static int grid = 0; static kern_t ktab[NPHASE];
    if (grid == 0) {
        if (n_in != 26 || in_sizes[0] != M * D || out_size != M * D || ws_size < WS_END) { fprintf(stderr, "kernel_launch: unexpected shapes (n_in %d, in0 %d, out %d, ws %zu); nothing launched\n", n_in, n_in > 0 ? in_sizes[0] : -1, out_size, ws_size); grid = -1; return; }
        int dev = 0, cus = 0;
        if (hipGetDevice(&dev) != hipSuccess || hipDeviceGetAttribute(&cus, hipDeviceAttributeMultiprocessorCount, dev) != hipSuccess) { grid = -1; return; }
#if MK_ONE_LAUNCH
        int per_cu = 0;
        if (hipFuncSetAttribute((const void*)fwd_kernel<MK_MASK>, hipFuncAttributeMaxDynamicSharedMemorySize, LDS_BYTES) != hipSuccess) { fprintf(stderr, "kernel_launch: hipFuncSetAttribute failed\n"); grid = -1; return; }
        if (hipOccupancyMaxActiveBlocksPerMultiprocessor(&per_cu, (const void*)fwd_kernel<MK_MASK>, NWAVES * 64, LDS_BYTES) != hipSuccess || per_cu < 1) { fprintf(stderr, "kernel_launch: occupancy query says %d blocks per CU\n", per_cu); (void)hipGetLastError(); grid = -1; return; }
#else
        KTab<NPHASE - 1>::fill(ktab);
        for (int p = 0; p < NPHASE; ++p) if (hipFuncSetAttribute((const void*)ktab[p], hipFuncAttributeMaxDynamicSharedMemorySize, LDS_BYTES) != hipSuccess) { fprintf(stderr, "kernel_launch: hipFuncSetAttribute failed\n"); grid = -1; return; }
#endif
        grid = cus;
        if (grid != 256) fprintf(stderr, "kernel_launch: note: %d CUs (built for 256)\n", grid);
    }
    if (grid < 0) return;
    Args a{};
    for (int i = 0; i < 26; ++i) a.in[i] = (const float*)d_in[i];
    a.out = (float*)d_out; a.ws = (unsigned char*)d_ws;
#if MK_ONE_LAUNCH
    a.ph_lo = 0; a.ph_hi = NPHASE;
    if (hipMemsetAsync((char*)d_ws + WS_CTL, 0, CTL_ZERO_BYTES, stream) != hipSuccess) { fprintf(stderr, "kernel_launch: hipMemsetAsync failed\n"); return; }
    void* kargs[] = {&a};
    hipError_t e = hipLaunchCooperativeKernel((const void*)fwd_kernel<MK_MASK>, dim3(grid), dim3(NWAVES * 64), kargs, LDS_BYTES, stream);
    if (e != hipSuccess) fprintf(stderr, "kernel_launch: cooperative launch failed: %s\n", hipGetErrorString(e));
#else
#ifdef DBG_DUMP
    for (int p = 0; p <= DBG_STOP; ++p) { a.ph_lo = p; a.ph_hi = p + 1; hipLaunchKernelGGL(ktab[p], dim3(grid), dim3(NWAVES * 64), LDS_BYTES, stream, a); }
    hipLaunchKernelGGL(dbg_dump, dim3((M * 1024) / 256), dim3(256), 0, stream, (float*)d_out, (const unsigned char*)d_ws);
#else
    for (int p = 0; p < NPHASE; ++p) { a.ph_lo = p; a.ph_hi = p + 1; hipLaunchKernelGGL(ktab[p], dim3(grid), dim3(NWAVES * 64), LDS_BYTES, stream, a);
#ifdef DBG_FIXLORA
        if (p == 3) hipLaunchKernelGGL(dbg_fixlora, dim3((M * 512) / 256), dim3(256), 0, stream, a);
#endif
    }
#endif
#endif
}
```

```cpp
#define MK_ONE_LAUNCH 1
#include <hip/hip_runtime.h>
#include <cstdio>
#include <cstdint>
constexpr int NWAVES = 8;
constexpr int BATCH = 8, SEQ = 2048, D = 1024, M = BATCH * SEQ;
constexpr int D_IN = 5376, FF = 4096, RWW = 512, NLORA = 1536, KLORA = 256;
constexpr float NORM_EPS = 1e-6f, SUBLN_EPS = 1e-5f, GN_EPS = 64e-5f, LAMBDA_INIT = 0.2f;
constexpr size_t MiB = 1u << 20;
constexpr size_t WS_CTL = 0, CTL_ZERO_BYTES = 256 * 1024;
constexpr size_t CTL_SS1 = 65536, CTL_SS2 = 131072, CTL_CNT1 = 196608, CTL_CNT2 = 212992;
constexpr size_t WS_ROPE_C = 512 * 1024, WS_ROPE_S = 768 * 1024;
constexpr size_t WS_BON = 1 * MiB;
constexpr size_t WS_WIN = 2 * MiB;
constexpr size_t WS_WA = WS_WIN + (size_t)D_IN * D * 2;
constexpr size_t WS_WB = WS_WA + 1 * MiB;
constexpr size_t WS_WO = WS_WB + 1 * MiB;
constexpr size_t WS_W1 = WS_WO + 2 * MiB;
constexpr size_t WS_W2 = WS_W1 + 8 * MiB;
constexpr size_t WS_WL = WS_W2 + 8 * MiB;
static_assert(WS_WL + (size_t)NLORA * KLORA * 2 <= 34 * MiB, "weights");
constexpr size_t WS_XN = 34 * MiB;
constexpr size_t WS_DEC = WS_XN;
constexpr size_t WS_Q = 66 * MiB, WS_K = 82 * MiB, WS_V = 98 * MiB;
constexpr size_t WS_RKV = 114 * MiB;
constexpr size_t WS_WAG = 162 * MiB, WS_LIN = 170 * MiB;
constexpr size_t WS_Y = 162 * MiB;
constexpr size_t WS_AA = 178 * MiB, WS_GG = 194 * MiB;
constexpr size_t WS_O = 210 * MiB;
constexpr size_t WS_YA = 66 * MiB, WS_YB = 82 * MiB;
constexpr size_t WS_TMP = 114 * MiB;
constexpr size_t WS_MERGED = 210 * MiB;
constexpr size_t WS_H = 66 * MiB;
constexpr size_t WS_END = 244 * MiB;
constexpr int RING_OFF = 0, RING_BYTES = 131072;
constexpr int LDS_BYTES = 163840;

#include <hip/hip_runtime.h>
#include <cstdio>
#include <cstdint>
namespace pg8 {
#define PG8_LAS __attribute__((address_space(3)))
typedef unsigned short bf16_t;
typedef short bf16x8 __attribute__((ext_vector_type(8)));
typedef float f32x4 __attribute__((ext_vector_type(4)));
typedef unsigned u32x4 __attribute__((ext_vector_type(4)));
constexpr int BM = 256, BK = 64, HALF = 128, HTB = HALF * BK * 2  , STAGE_BYTES = 8 * HTB, NXCD = 8, WGM = 8;

__host__ __device__ __forceinline__ int lds_byte(int r, int c) { const int st = (r >> 4) * 2 + (c >> 5), rr = r & 15, cc = c & 31, ob = rr * 64 + cc * 2; return st * 1024 + (ob ^ (((ob >> 9) & 1) << 5)); }
__host__ __device__ __forceinline__ void stage_rc(int b, int& R, int& C) { const int st = b / 1024, sb = b % 1024, swz = sb ^ (((sb >> 9) & 1) << 5); R = (st >> 1) * 16 + swz / 64; C = (st & 1) * 32 + (swz % 64) / 2; }
__host__ __device__ __forceinline__ int perm32(int rho) { const int n = rho >> 4, i = rho & 15; return 8 * (i >> 2) + 4 * n + (i & 3); }

struct Unit { int pm, pn; };
struct Gemm { const bf16_t* A; const bf16_t* Bt; int M, N, K; };

struct StaticOrder {
    int nM, nN, nwg, G, c;
    __host__ __device__ void init(int M, int N, int G_, int c_) { nM = M / BM; nN = N / BM; nwg = nM * nN; G = G_; c = c_; }
    __host__ __device__ bool next(int i, Unit& u) const {
        const long L = (long)i * G + c; if (L >= nwg) return false;
        int wgid = (int)L; { const int q = nwg / NXCD, r = nwg % NXCD, xcd = wgid % NXCD, off = wgid / NXCD; wgid = (xcd < r ? xcd * (q + 1) : r * (q + 1) + (xcd - r) * q) + off; }
        const int nig = WGM * nN, gid = wgid / nig, fm = gid * WGM, gsz = (nM - fm) < WGM ? (nM - fm) : WGM;
        u.pm = fm + ((wgid % nig) % gsz); u.pn = (wgid % nig) / gsz; return true;
    }
    __device__ __forceinline__ void a_ready(const Unit&) const {}
    __device__ __forceinline__ void done(const Unit&) const {}
};

typedef float f32x2c_t __attribute__((ext_vector_type(2))); typedef __bf16 bf16x2c_t __attribute__((ext_vector_type(2)));
__device__ __forceinline__ unsigned cvt_pk_bf16(float lo, float hi) { f32x2c_t v = {lo, hi}; bf16x2c_t b = __builtin_convertvector(v, bf16x2c_t); return __builtin_bit_cast(unsigned, b); }
typedef float f32x2 __attribute__((ext_vector_type(2)));
__device__ __forceinline__ f32x2 gelu_pk(f32x2 v) {
    const f32x2 av = __builtin_elementwise_abs(v), d = av * 0.2316418882f + 1.0f;
    f32x2 t; t.x = __builtin_amdgcn_rcpf(d.x); t.y = __builtin_amdgcn_rcpf(d.y);
    f32x2 q = t * 0.5307027145f + (-0.7265760135f); q = q * t + 0.7107068705f; q = q * t + (-0.142248368f); q = q * t + 0.127414796f; q = q * t;
    const f32x2 s = (v * v) * (-0.72134752044f);
    f32x2 e; e.x = __builtin_amdgcn_exp2f(s.x); e.y = __builtin_amdgcn_exp2f(s.y);
    const f32x2 m = v * (q * e), r = v - m;
    f32x2 o; o.x = v.x < 0.f ? m.x : r.x; o.y = v.y < 0.f ? m.y : r.y; return o;
}

template <int ACT  > struct EpiBf16 {
    static constexpr int MIDK = 0; static constexpr bool PERM = true, AFTER_DRAIN = false; static_assert(ACT == 0 || ACT == 1, "EpiBf16: ACT is 0 (none) or 1 (gelu_pk)");
    bf16_t* O; int ldc; const float* bias; int split_cols; size_t split_stride; float scale0;
    __device__ __forceinline__ void operator()(const f32x4 (&acc)[2][2][4][2], const Unit& u, int wr, int wc, int fr, int fq) const {
        const int row0 = u.pm * BM + wr * 64 + fr; int colt = u.pn * BM; bf16_t* base = O;
        float sc = 1.f; if (split_cols) { const int t = colt / split_cols; base += (size_t)t * split_stride; colt -= t * split_cols; if (t == 0) sc = scale0; }
        const int col0 = colt + wc * 32 + 8 * fq, bcol0 = u.pn * BM + wc * 32 + 8 * fq;
        f32x4 bv[2][2];
#pragma unroll
        for (int bj = 0; bj < 2; ++bj)
#pragma unroll
            for (int n = 0; n < 2; ++n) bv[bj][n] = bias ? *(const f32x4*)(bias + bcol0 + bj * HALF + 4 * n) : (f32x4){0.f, 0.f, 0.f, 0.f};
#pragma unroll
        for (int ai = 0; ai < 2; ++ai)
#pragma unroll
            for (int m = 0; m < 4; ++m) { bf16_t* rowp = base + (size_t)(row0 + ai * HALF + m * 16) * ldc + col0;
#pragma unroll
                for (int bj = 0; bj < 2; ++bj) { f32x4 v0 = acc[ai][bj][m][0] + bv[bj][0], v1 = acc[ai][bj][m][1] + bv[bj][1];
                    if (ACT == 1) { f32x2 a = gelu_pk((f32x2){v0[0], v0[1]}), b = gelu_pk((f32x2){v0[2], v0[3]}), c = gelu_pk((f32x2){v1[0], v1[1]}), d = gelu_pk((f32x2){v1[2], v1[3]});
                        v0 = (f32x4){a.x, a.y, b.x, b.y}; v1 = (f32x4){c.x, c.y, d.x, d.y}; }
                    v0 = v0 * sc; v1 = v1 * sc; u32x4 w; w.x = cvt_pk_bf16(v0[0], v0[1]); w.y = cvt_pk_bf16(v0[2], v0[3]); w.z = cvt_pk_bf16(v1[0], v1[1]); w.w = cvt_pk_bf16(v1[2], v1[3]);
                    *(u32x4*)(rowp + bj * HALF) = w; } }
    }
};
typedef unsigned u32x2 __attribute__((ext_vector_type(2)));
__device__ __forceinline__ float bf_lo(unsigned w) { return __builtin_bit_cast(float, w << 16); }
__device__ __forceinline__ float bf_hi(unsigned w) { return __builtin_bit_cast(float, w & 0xffff0000u); }
__device__ __forceinline__ u32x4 pack8(f32x4 v0, f32x4 v1) { u32x4 w; w.x = cvt_pk_bf16(v0[0], v0[1]); w.y = cvt_pk_bf16(v0[2], v0[3]); w.z = cvt_pk_bf16(v1[0], v1[1]); w.w = cvt_pk_bf16(v1[2], v1[3]); return w; }
__device__ __forceinline__ float sigmoidf_(float x) { return __builtin_amdgcn_rcpf(1.0f + __expf(-x)); }
template <class F> struct EpiRow8 {
    static constexpr int MIDK = 0; static constexpr bool PERM = true, AFTER_DRAIN = false;
    F f;
    __device__ __forceinline__ void operator()(const f32x4 (&acc)[2][2][4][2], const Unit& u, int wr, int wc, int fr, int fq) const {
        const int row0 = u.pm * BM + wr * 64 + fr, c0 = wc * 32 + 8 * fq;
#pragma unroll
        for (int ai = 0; ai < 2; ++ai)
#pragma unroll
            for (int m = 0; m < 4; ++m) { const int row = row0 + ai * HALF + m * 16;
#pragma unroll
                for (int bj = 0; bj < 2; ++bj) { f(u.pn, row, c0 + bj * HALF, acc[ai][bj][m][0], acc[ai][bj][m][1]); if (F::FENCE) asm volatile("" ::: "memory"); } }
    }
};
constexpr float ATT_C2 = 0.125f * 1.4426950408889634f;
struct FProj {
    static constexpr bool FENCE = false;
    unsigned char* ws; bf16_t* GATES;
    __device__ __forceinline__ void operator()(int pn, int row, int cu, f32x4 v0, f32x4 v1) const {
        if (pn < 4) {
            const int sh = cu >> 6, j = (cu & 63) >> 3, pos = row & 2047;
            const f32x4 c = *(const f32x4*)((const float*)(ws + WS_ROPE_C) + pos * 32 + 4 * j), s = *(const f32x4*)((const float*)(ws + WS_ROPE_S) + pos * 32 + 4 * j);
            const float sc = pn < 2 ? ATT_C2 : 1.0f;
            const f32x4 o1 = (v0 * c - v1 * s) * sc, o2 = (v1 * c + v0 * s) * sc;
            bf16_t* dst = (bf16_t*)(ws + (pn < 2 ? WS_Q : WS_K)) + (size_t)row * 512 + (pn & 1) * 256 + sh * 64 + 4 * j;
            u32x2 w1, w2; w1.x = cvt_pk_bf16(o1[0], o1[1]); w1.y = cvt_pk_bf16(o1[2], o1[3]); w2.x = cvt_pk_bf16(o2[0], o2[1]); w2.y = cvt_pk_bf16(o2[2], o2[3]);
            *(u32x2*)dst = w1; *(u32x2*)(dst + 32) = w2;
        } else if (pn < 13) {
            size_t off; int pitch, col;
            if (pn < 6) { off = WS_V; pitch = 512; col = (pn - 4) * 256; }
            else if (pn < 12) { off = WS_RKV; pitch = 1536; col = (pn - 6) * 256; }
            else { off = WS_WAG; pitch = 256; col = 0; }
            *(u32x4*)((bf16_t*)(ws + off) + (size_t)row * pitch + col + cu) = pack8(v0, v1);
        } else *(u32x4*)(GATES + (size_t)row * 2048 + (pn - 13) * 256 + cu) = pack8(v0, v1);
    }
};
struct FLora {
    static constexpr bool FENCE = false;
    unsigned char* ws; const float *w0, *a0;
    __device__ __forceinline__ void operator()(int pn, int row, int cu, f32x4 v0, f32x4 v1) const {
        const int c = (pn & 1) * 256 + cu;
        if (pn < 2) {
            const f32x4 b0 = *(const f32x4*)(w0 + c), b1 = *(const f32x4*)(w0 + c + 4);
            float* dst = (float*)(ws + WS_DEC) + (size_t)row * 512 + c; *(f32x4*)dst = v0 + b0; *(f32x4*)(dst + 4) = v1 + b1;
        } else if (pn < 4) {
            const f32x4 b0 = *(const f32x4*)(a0 + c), b1 = *(const f32x4*)(a0 + c + 4);
            *(u32x4*)((bf16_t*)(ws + WS_AA) + (size_t)row * 512 + c) = pack8(v0 + b0, v1 + b1);
        } else *(u32x4*)((bf16_t*)(ws + WS_GG) + (size_t)row * 512 + c) = pack8(v0, v1);
    }
};
struct EpiMerge {
    static constexpr int MIDK = 8; static constexpr bool PERM = true, AFTER_DRAIN = false;
    const bf16_t* GATES; bf16_t* MERGED;
    static __device__ __forceinline__ float ratio_(float ga, float gb) { return (1.0f + __expf(-gb)) * __builtin_amdgcn_rcpf(1.0f + __expf(-ga)); }
    __device__ __forceinline__ void mid(f32x4 (&acc)[2][2][4][2], const Unit& u, int wr, int wc, int fr, int fq) const {
        int fr_ = fr; asm volatile("" : "+v"(fr_));
        const bf16_t* gp0 = GATES + (size_t)(u.pm * BM + wr * 64 + fr_) * 2048 + u.pn * BM + wc * 32 + 8 * fq;
#pragma unroll
        for (int ai = 0; ai < 2; ++ai)
#pragma unroll
            for (int m = 0; m < 4; ++m)
#pragma unroll
                for (int bj = 0; bj < 2; ++bj) { const bf16_t* gp = gp0 + (size_t)(ai * HALF + m * 16) * 2048 + bj * HALF;
                    const u32x4 ga = *(const u32x4*)gp, gb = *(const u32x4*)(gp + 1024);
                    f32x4& v0 = acc[ai][bj][m][0]; f32x4& v1 = acc[ai][bj][m][1];
                    v0[0] *= ratio_(bf_lo(ga.x), bf_lo(gb.x)); v0[1] *= ratio_(bf_hi(ga.x), bf_hi(gb.x)); v0[2] *= ratio_(bf_lo(ga.y), bf_lo(gb.y)); v0[3] *= ratio_(bf_hi(ga.y), bf_hi(gb.y));
                    v1[0] *= ratio_(bf_lo(ga.z), bf_lo(gb.z)); v1[1] *= ratio_(bf_hi(ga.z), bf_hi(gb.z)); v1[2] *= ratio_(bf_lo(ga.w), bf_lo(gb.w)); v1[3] *= ratio_(bf_hi(ga.w), bf_hi(gb.w));
                    asm volatile("" ::: "memory"); }
    }
    __device__ __forceinline__ void operator()(const f32x4 (&acc)[2][2][4][2], const Unit& u, int wr, int wc, int fr, int fq) const {
        const int row0 = u.pm * BM + wr * 64 + fr, c0 = u.pn * BM + wc * 32 + 8 * fq;
#pragma unroll
        for (int ai = 0; ai < 2; ++ai)
#pragma unroll
            for (int m = 0; m < 4; ++m) { const int row = row0 + ai * HALF + m * 16;
#pragma unroll
                for (int bj = 0; bj < 2; ++bj) { const u32x4 g = *(const u32x4*)(GATES + (size_t)row * 2048 + 1024 + c0 + bj * HALF);
                    f32x4 v0 = acc[ai][bj][m][0], v1 = acc[ai][bj][m][1];
                    v0[0] *= sigmoidf_(bf_lo(g.x)); v0[1] *= sigmoidf_(bf_hi(g.x)); v0[2] *= sigmoidf_(bf_lo(g.y)); v0[3] *= sigmoidf_(bf_hi(g.y));
                    v1[0] *= sigmoidf_(bf_lo(g.z)); v1[1] *= sigmoidf_(bf_hi(g.z)); v1[2] *= sigmoidf_(bf_lo(g.w)); v1[3] *= sigmoidf_(bf_hi(g.w));
                    *(u32x4*)(MERGED + (size_t)row * 1024 + c0 + bj * HALF) = pack8(v0, v1); } }
    }
};
struct FRes {
    static constexpr bool FENCE = false;
    const float* base; float* out;
    __device__ __forceinline__ void operator()(int pn, int row, int cu, f32x4 v0, f32x4 v1) const {
        const size_t off = (size_t)row * 1024 + pn * 256 + cu; const f32x4 b0 = *(const f32x4*)(base + off), b1 = *(const f32x4*)(base + off + 4);
        *(f32x4*)(out + off) = b0 + v0; *(f32x4*)(out + off + 4) = b1 + v1;
    }
};
struct FRelu2 {
    static constexpr bool FENCE = false;
    bf16_t* H;
    __device__ __forceinline__ void operator()(int pn, int row, int cu, f32x4 v0, f32x4 v1) const {
        f32x4 r0, r1;
#pragma unroll
        for (int e = 0; e < 4; ++e) { const float a = __builtin_fmaxf(v0[e], 0.f), b = __builtin_fmaxf(v1[e], 0.f); r0[e] = a * a; r1[e] = b * b; }
        *(u32x4*)(H + (size_t)row * 4096 + pn * 256 + cu) = pack8(r0, r1);
    }
};

__device__ __forceinline__ float xsum_fq(float x) {
    { auto r = __builtin_amdgcn_permlane16_swap(__builtin_bit_cast(unsigned, x), __builtin_bit_cast(unsigned, x), false, false); const unsigned a = r[0], b = r[1]; x = __builtin_bit_cast(float, a) + __builtin_bit_cast(float, b); }
    { auto r = __builtin_amdgcn_permlane32_swap(__builtin_bit_cast(unsigned, x), __builtin_bit_cast(unsigned, x), false, false); const unsigned a = r[0], b = r[1]; x = __builtin_bit_cast(float, a) + __builtin_bit_cast(float, b); }
    return x;
}
template <int MODE> struct EpiResNorm {
    static constexpr int MIDK = 0; static constexpr bool PERM = true, AFTER_DRAIN = false;
    const float* base; float* out; bf16_t* xn; const float* g; float* ss; unsigned* cnt; float eps;
    __device__ __forceinline__ void operator()(f32x4 (&acc)[2][2][4][2], const Unit& u, int wr, int wc, int fr, int fq) const {
        const int row0 = u.pm * BM + wr * 64 + fr, c0 = u.pn * BM + wc * 32 + 8 * fq;
#pragma unroll
        for (int ai = 0; ai < 2; ++ai)
#pragma unroll
            for (int m = 0; m < 4; ++m) { const int row = row0 + ai * HALF + m * 16; float s = 0.f;
#pragma unroll
                for (int bj = 0; bj < 2; ++bj) { const size_t off = (size_t)row * 1024 + c0 + bj * HALF; const f32x4 b0 = *(const f32x4*)(base + off), b1 = *(const f32x4*)(base + off + 4);
                    f32x4& v0 = acc[ai][bj][m][0]; f32x4& v1 = acc[ai][bj][m][1]; v0 += b0; v1 += b1;
                    if (MODE == 0) { *(f32x4*)(out + off) = v0; *(f32x4*)(out + off + 4) = v1; }
                    s += (v0[0] * v0[0] + v0[1] * v0[1]) + (v0[2] * v0[2] + v0[3] * v0[3]) + (v1[0] * v1[0] + v1[1] * v1[1]) + (v1[2] * v1[2] + v1[3] * v1[3]); }
                s = xsum_fq(s);
                if (fq == 0) __hip_atomic_fetch_add(ss + row, s, __ATOMIC_RELAXED, __HIP_MEMORY_SCOPE_AGENT);
                if (m & 1) asm volatile("" ::: "memory"); }
        asm volatile("s_waitcnt vmcnt(0)" ::: "memory");
        unsigned* c_ = cnt + 64 * u.pm;
        if (fr == 0 && fq == 0) __hip_atomic_fetch_add(c_, 1u, __ATOMIC_RELAXED, __HIP_MEMORY_SCOPE_AGENT);
        { unsigned spins = 0; while ((unsigned)__builtin_amdgcn_readfirstlane(__hip_atomic_load(c_, __ATOMIC_RELAXED, __HIP_MEMORY_SCOPE_AGENT)) < 32u && ++spins < (1u << 22)) __builtin_amdgcn_s_sleep(2); }
        asm volatile("" ::: "memory");
#pragma unroll
        for (int ai = 0; ai < 2; ++ai)
#pragma unroll
            for (int m = 0; m < 4; ++m) { const int row = row0 + ai * HALF + m * 16;
                const float rstd = 1.0f / sqrtf(__hip_atomic_load(ss + row, __ATOMIC_RELAXED, __HIP_MEMORY_SCOPE_AGENT) * (1.0f / 1024.0f) + eps);
#pragma unroll
                for (int bj = 0; bj < 2; ++bj) { const size_t off = (size_t)row * 1024 + c0 + bj * HALF; const f32x4 g0 = *(const f32x4*)(g + c0 + bj * HALF), g1 = *(const f32x4*)(g + c0 + bj * HALF + 4);
                    const f32x4 o0 = acc[ai][bj][m][0] * rstd * g0, o1 = acc[ai][bj][m][1] * rstd * g1;
                    if (MODE == 0) *(u32x4*)(xn + off) = pack8(o0, o1); else { *(f32x4*)(out + off) = o0; *(f32x4*)(out + off + 4) = o1; } }
                if (m & 1) asm volatile("" ::: "memory"); }
    }
};
template <class Epi, class Sched, bool ALIGN_EPI = false, bool SP2 = false>
__device__ __forceinline__ void gemm_phase(PG8_LAS unsigned char* lds, const Gemm g, const Sched& S, const Epi& E) {
    int tid_ = threadIdx.x; asm volatile("" : "+v"(tid_));
    const int tid = tid_, wid = __builtin_amdgcn_readfirstlane(tid >> 6), lane = tid & 63, wr = wid >> 2, wc = wid & 3, fr = lane & 15, fq = lane >> 4;
    const int K = g.K, nt = K / BK;
    unsigned voffA[2], voffB[2];
#pragma unroll
    for (int i = 0; i < 2; ++i) { int R, C; stage_rc(tid * 16 + i * 8192, R, C); const int Rb = Epi::PERM ? ((R & ~31) + perm32(R & 31)) : R;
        voffA[i] = (unsigned)(R * K + C) * 2u; voffB[i] = (unsigned)(Rb * K + C) * 2u; }
    const size_t kstep = (size_t)(BK * 2);
    const size_t hstep = (size_t)HALF * K * 2;
    const size_t tstep = 2 * hstep;
    const unsigned ldsw = (unsigned)wid * 1024u;
    const int aoff = lds_byte(wr * 64 + fr, fq * 8), boff = lds_byte(wc * 32 + fr, fq * 8);
#define PG8_SA(b, h) (((b) * 2 + (h)) * HTB)
#define PG8_SB(b, h) ((4 + (b) * 2 + (h)) * HTB)
#define PG8_STAGE(bufoff, gbase, voff) do { _Pragma("unroll") for (int _i = 0; _i < 2; ++_i) \
        __builtin_amdgcn_global_load_lds((const unsigned*)((const char*)(gbase) + (voff)[_i]), (PG8_LAS unsigned*)(lds + (bufoff) + ldsw + _i * 8192), 16, 0, 0); } while (0)
#define PG8_LDA(dst, b, h) do { _Pragma("unroll") for (int m = 0; m < 4; ++m) _Pragma("unroll") for (int k = 0; k < 2; ++k) dst[m][k] = *(const PG8_LAS bf16x8*)(lds + PG8_SA(b, h) + aoff + m * 2048 + k * 1024); } while (0)
#define PG8_LDB(dst, b, h) do { _Pragma("unroll") for (int n = 0; n < 2; ++n) _Pragma("unroll") for (int k = 0; k < 2; ++k) dst[n][k] = *(const PG8_LAS bf16x8*)(lds + PG8_SB(b, h) + boff + n * 2048 + k * 1024); } while (0)
#define PG8_MMA(ai, bj, At, Bt) do { __builtin_amdgcn_s_setprio(1); _Pragma("unroll") for (int m = 0; m < 4; ++m) _Pragma("unroll") for (int n = 0; n < 2; ++n) _Pragma("unroll") for (int k = 0; k < 2; ++k) \
        acc[ai][bj][m][n] = __builtin_amdgcn_mfma_f32_16x16x32_bf16(Bt[n][k], At[m][k], acc[ai][bj][m][n], 0, 0, 0); __builtin_amdgcn_s_setprio(0); } while (0)
#define PG8_WAIT_V(n) asm volatile("s_waitcnt vmcnt(" #n ")" ::: "memory")
#define PG8_WAIT_L(n) asm volatile("s_waitcnt lgkmcnt(" #n ")" ::: "memory")
#define PG8_BAR __builtin_amdgcn_s_barrier()
#define PG8_SCHED __builtin_amdgcn_sched_barrier(0)
    Unit cur, nxt; int ui = 0;
    if (!S.next(0, cur)) return;
    f32x4 acc[2][2][4][2];
#pragma unroll
    for (int a = 0; a < 2; ++a)
#pragma unroll
        for (int b = 0; b < 2; ++b)
#pragma unroll
            for (int m = 0; m < 4; ++m)
#pragma unroll
                for (int n = 0; n < 2; ++n) acc[a][b][m][n] = (f32x4){0.f, 0.f, 0.f, 0.f};
    bf16x8 At[4][2], B0[2][2], B1[2][2];
    const char* cA = (const char*)g.A + (size_t)cur.pm * tstep; const char* cB = (const char*)g.Bt + (size_t)cur.pn * tstep;
    S.a_ready(cur);
    if constexpr (SP2) {
        PG8_STAGE(PG8_SB(0, 0), cB, voffB); PG8_STAGE(PG8_SB(0, 1), cB + hstep, voffB); PG8_STAGE(PG8_SA(0, 0), cA, voffA); PG8_STAGE(PG8_SA(0, 1), cA + hstep, voffA);
        if (wr == 1) PG8_BAR;
        PG8_WAIT_V(2); PG8_BAR;
        PG8_STAGE(PG8_SB(1, 0), cB + kstep, voffB); PG8_STAGE(PG8_SA(1, 0), cA + kstep, voffA); PG8_STAGE(PG8_SB(1, 1), cB + hstep + kstep, voffB);
        PG8_WAIT_V(6); PG8_BAR;
    } else {
        PG8_STAGE(PG8_SB(0, 0), cB, voffB); PG8_STAGE(PG8_SA(0, 0), cA, voffA); PG8_STAGE(PG8_SB(0, 1), cB + hstep, voffB); PG8_STAGE(PG8_SA(0, 1), cA + hstep, voffA);
        if (wr == 1) PG8_BAR;
        PG8_WAIT_V(4); PG8_BAR;
        PG8_STAGE(PG8_SB(1, 0), cB + kstep, voffB); PG8_STAGE(PG8_SA(1, 0), cA + kstep, voffA); PG8_STAGE(PG8_SB(1, 1), cB + hstep + kstep, voffB);
        PG8_WAIT_V(6); PG8_BAR;
    }
    for (;;) {
        const bool has_next = S.next(ui + 1, nxt);
        const char* nA = has_next ? (const char*)g.A + (size_t)nxt.pm * tstep : cA; const char* nB = has_next ? (const char*)g.Bt + (size_t)nxt.pn * tstep : cB;
        for (int t = 0; t < nt; t += 2) {
            if constexpr (Epi::MIDK > 0) { if (t == Epi::MIDK) E.mid(acc, cur, wr, wc, fr, fq); }
            const bool last = (t == nt - 2);
            const char* a1 = cA + (size_t)(t + 1) * kstep;
            const char* a2 = last ? nA : cA + (size_t)(t + 2) * kstep; const char* b2 = last ? nB : cB + (size_t)(t + 2) * kstep;
            const char* a3 = a2 + kstep; const char* b3 = b2 + kstep;
            if (last && has_next) S.a_ready(nxt);
            if constexpr (SP2) {
            PG8_LDB(B0, 0, 0); PG8_LDB(B1, 0, 1); PG8_SCHED; PG8_LDA(At, 0, 0); PG8_STAGE(PG8_SA(1, 1), a1 + hstep, voffA);
            PG8_WAIT_V(8); PG8_WAIT_L(0); PG8_BAR; PG8_MMA(0, 0, At, B0); PG8_MMA(0, 1, At, B1); PG8_BAR; PG8_SCHED;
            PG8_LDA(At, 0, 1); PG8_STAGE(PG8_SB(0, 0), b2, voffB); PG8_STAGE(PG8_SB(0, 1), b2 + hstep, voffB); PG8_STAGE(PG8_SA(0, 0), a2, voffA);
            PG8_WAIT_V(8); PG8_WAIT_L(0); PG8_BAR; PG8_MMA(1, 0, At, B0); PG8_MMA(1, 1, At, B1); PG8_BAR; PG8_SCHED;
            PG8_LDB(B0, 1, 0); PG8_LDB(B1, 1, 1); PG8_SCHED; PG8_LDA(At, 1, 0); PG8_STAGE(PG8_SA(0, 1), a2 + hstep, voffA);
            PG8_WAIT_V(8); PG8_WAIT_L(0); PG8_BAR; PG8_MMA(0, 0, At, B0); PG8_MMA(0, 1, At, B1); PG8_BAR; PG8_SCHED;
            PG8_LDA(At, 1, 1); PG8_STAGE(PG8_SB(1, 0), b3, voffB); PG8_STAGE(PG8_SB(1, 1), b3 + hstep, voffB); PG8_STAGE(PG8_SA(1, 0), a3, voffA);
            PG8_WAIT_V(8); PG8_WAIT_L(0); PG8_BAR; PG8_MMA(1, 0, At, B0); PG8_MMA(1, 1, At, B1); PG8_BAR; PG8_SCHED;
            } else {
            PG8_LDB(B0, 0, 0); PG8_SCHED; PG8_LDA(At, 0, 0); PG8_STAGE(PG8_SA(1, 1), a1 + hstep, voffA);
            PG8_WAIT_L(8); PG8_BAR; PG8_WAIT_L(0); PG8_MMA(0, 0, At, B0); PG8_BAR; PG8_SCHED;
            PG8_LDB(B1, 0, 1); PG8_STAGE(PG8_SB(0, 0), b2, voffB);
            PG8_BAR; PG8_WAIT_L(0); PG8_MMA(0, 1, At, B1); PG8_BAR;
            PG8_LDA(At, 0, 1); PG8_STAGE(PG8_SA(0, 0), a2, voffA);
            PG8_BAR; PG8_WAIT_L(0); PG8_MMA(1, 0, At, B0); PG8_BAR; PG8_SCHED;
            PG8_STAGE(PG8_SB(0, 1), b2 + hstep, voffB);
            PG8_WAIT_V(6); PG8_BAR; PG8_MMA(1, 1, At, B1); PG8_BAR;
            PG8_LDB(B0, 1, 0); PG8_SCHED; PG8_LDA(At, 1, 0); PG8_STAGE(PG8_SA(0, 1), a2 + hstep, voffA);
            PG8_WAIT_L(8); PG8_BAR; PG8_WAIT_L(0); PG8_MMA(0, 0, At, B0); PG8_BAR; PG8_SCHED;
            PG8_LDB(B1, 1, 1); PG8_STAGE(PG8_SB(1, 0), b3, voffB);
            PG8_BAR; PG8_WAIT_L(0); PG8_MMA(0, 1, At, B1); PG8_BAR;
            PG8_LDA(At, 1, 1); PG8_STAGE(PG8_SA(1, 0), a3, voffA);
            PG8_BAR; PG8_WAIT_L(0); PG8_MMA(1, 0, At, B0); PG8_BAR; PG8_SCHED;
            PG8_STAGE(PG8_SB(1, 1), b3 + hstep, voffB);
            PG8_WAIT_V(6); PG8_BAR; PG8_MMA(1, 1, At, B1); PG8_BAR;
            }
        }
        if constexpr (ALIGN_EPI) { if (wr == 0) PG8_BAR; }
        if constexpr (!Epi::AFTER_DRAIN) { E(acc, cur, wr, wc, fr, fq); S.done(cur); }
        if (!has_next) break;
#pragma unroll
        for (int a = 0; a < 2; ++a)
#pragma unroll
            for (int b = 0; b < 2; ++b)
#pragma unroll
                for (int m = 0; m < 4; ++m)
#pragma unroll
                    for (int n = 0; n < 2; ++n) acc[a][b][m][n] = (f32x4){0.f, 0.f, 0.f, 0.f};
        cur = nxt; cA = nA; cB = nB; ++ui;
        if constexpr (ALIGN_EPI) { if (wr == 1) PG8_BAR; }
    }
    PG8_WAIT_V(0);
    if constexpr (!ALIGN_EPI) { if (wr == 0) PG8_BAR; }
    PG8_BAR;
    if constexpr (Epi::AFTER_DRAIN) { E.fused(acc, cur, wr, wc, fr, fq, lds, wid, lane); S.done(cur); }
#undef PG8_SA
#undef PG8_SB
#undef PG8_STAGE
#undef PG8_LDA
#undef PG8_LDB
#undef PG8_MMA
#undef PG8_WAIT_V
#undef PG8_WAIT_L
#undef PG8_BAR
#undef PG8_SCHED
}
}

#ifndef PG8_SP2
#define PG8_SP2 true
#endif
#ifndef PG8_ALIGN
#define PG8_ALIGN true
#endif
#include <hip/hip_bf16.h>
#include <cmath>
namespace attn_body {
using bf16=__hip_bfloat16;
using bf16x8=__attribute__((ext_vector_type(8)))short;
using s16x4=__attribute__((ext_vector_type(4)))short;
using f32x16=__attribute__((ext_vector_type(16)))float;
using u32x4=__attribute__((ext_vector_type(4)))unsigned;
constexpr int SEQ=2048,D=64,QP=512,KP=512,VP=512,OP=1024;
constexpr int NW=8,QBLK=32,QB=QBLK*NW,KVBLK=64,NQB=SEQ/QB;
constexpr int ATTN_UNIT_ROWS=QB;
__device__ __forceinline__ int crow(int r,int hi){return (r&3)+8*(r>>2)+4*hi;}
#define SBAR() __builtin_amdgcn_sched_barrier(0)
__device__ __forceinline__ void cmask(f32x16&p0,f32x16&p1,int jb,int wchunk,int){
  if(jb>wchunk){ const float NEG=-INFINITY;
    #pragma unroll
    for(int r=0;r<16;++r){p0[r]=NEG;p1[r]=NEG;} }
}

constexpr int NSLOT=3, SLOTB=8192;
constexpr int LDS_K=0, LDS_V=NSLOT*SLOTB, LDS_WS=2*NSLOT*SLOTB, LDS_OST=LDS_WS+NW*64*4, LDS_BYTES=LDS_OST+NW*4096;
constexpr float C2=0.125f*1.4426950408889634f;
__device__ __forceinline__ void glds16(const void*gsrc,unsigned lds_dst){unsigned keep;
  asm volatile("s_mov_b32 %0, m0\n\ts_mov_b32 m0, %2\n\ts_nop 0\n\tglobal_load_lds_dwordx4 %1, off\n\ts_mov_b32 m0, %0":"=&s"(keep):"v"(gsrc),"s"(lds_dst):"memory");}
__device__ __forceinline__ float max3f(float a,float b,float c){float r;asm("v_max3_f32 %0, %1, %2, %3":"=v"(r):"v"(a),"v"(b),"v"(c));return r;}
__device__ __forceinline__ float max2f(float a,float b){float r;asm("v_max_f32_e32 %0, %1, %2":"=v"(r):"v"(a),"v"(b));return r;}
__device__ __forceinline__ float fadd_s(float a,float b){float r;asm("v_add_f32_e32 %0, %1, %2":"=v"(r):"v"(a),"v"(b));return r;}
__device__ __forceinline__ float fsub_s(float a,float b){float r;asm("v_sub_f32_e32 %0, %1, %2":"=v"(r):"v"(a),"v"(b));return r;}
typedef float f32x2_t __attribute__((ext_vector_type(2))); typedef __bf16 bf16x2_t __attribute__((ext_vector_type(2)));
__device__ __forceinline__ unsigned cvtpk_s(float lo,float hi){f32x2_t v={lo,hi};bf16x2_t b=__builtin_convertvector(v,bf16x2_t);return __builtin_bit_cast(unsigned,b);}
#define WAIT_BAR(N) asm volatile("s_waitcnt vmcnt(" #N ") lgkmcnt(0)\n\ts_barrier":::"memory")

__device__ __forceinline__ void qkt(f32x16&p0,f32x16&p1,const char*Kslot,const bf16x8*qr,const f32x16&negm,int r32,int hi){
  const char*kb=Kslot+hi*1024+r32*16;
  #pragma unroll
  for(int d0=0;d0<4;++d0){
    const bf16x8 b0=*reinterpret_cast<const bf16x8*>(kb+d0*2048);
    const bf16x8 b1=*reinterpret_cast<const bf16x8*>(kb+d0*2048+512);
    if(d0==0){p0=__builtin_amdgcn_mfma_f32_32x32x16_bf16(b0,qr[0],negm,0,0,0);p1=__builtin_amdgcn_mfma_f32_32x32x16_bf16(b1,qr[0],negm,0,0,0);}
    else{p0=__builtin_amdgcn_mfma_f32_32x32x16_bf16(b0,qr[d0],p0,0,0,0);p1=__builtin_amdgcn_mfma_f32_32x32x16_bf16(b1,qr[d0],p1,0,0,0);}}
}
typedef __attribute__((address_space(3))) const char* lds_cptr;
typedef short v4i16_t __attribute__((ext_vector_type(4)));
__device__ __forceinline__ void kload8(bf16x8*kf,lds_cptr kp){
  kf[0]=*(const __attribute__((address_space(3))) bf16x8*)(kp);      kf[1]=*(const __attribute__((address_space(3))) bf16x8*)(kp+512);
  kf[2]=*(const __attribute__((address_space(3))) bf16x8*)(kp+2048); kf[3]=*(const __attribute__((address_space(3))) bf16x8*)(kp+2560);
  kf[4]=*(const __attribute__((address_space(3))) bf16x8*)(kp+4096); kf[5]=*(const __attribute__((address_space(3))) bf16x8*)(kp+4608);
  kf[6]=*(const __attribute__((address_space(3))) bf16x8*)(kp+6144); kf[7]=*(const __attribute__((address_space(3))) bf16x8*)(kp+6656);
}
__device__ __forceinline__ void kload2(bf16x8*kf,lds_cptr kp,int j){ kf[2*j]=*(const __attribute__((address_space(3))) bf16x8*)(kp+j*2048); kf[2*j+1]=*(const __attribute__((address_space(3))) bf16x8*)(kp+j*2048+512); }
__device__ __forceinline__ s16x4 vtr(lds_cptr p){ return __builtin_bit_cast(s16x4,__builtin_amdgcn_ds_read_tr16_b64_v4i16((__attribute__((address_space(3))) v4i16_t*)p)); }
__device__ __forceinline__ float rowmax(const f32x16&p0,const f32x16&p1){
  float a=max3f(p0[0],p0[1],p1[0]),b=max3f(p0[2],p0[3],p1[1]);a=max3f(a,p1[2],p1[3]);
  #pragma unroll
  for(int r=4;r<16;r+=4){a=max3f(a,p0[r],p0[r+1]);b=max3f(b,p0[r+2],p0[r+3]);a=max3f(a,p1[r],p1[r+1]);b=max3f(b,p1[r+2],p1[r+3]);}
  const float m=max2f(a,b);
  auto rr=__builtin_amdgcn_permlane32_swap(__float_as_uint(m),__float_as_uint(m),false,false);
  return max2f(__uint_as_float(rr[0]),__uint_as_float(rr[1]));
}
__device__ __forceinline__ void pv(f32x16*o,int vb,bf16x8 pa0,bf16x8 pa1,bf16x8 pa2,bf16x8 pa3){
  #pragma unroll
  for(int d0=0;d0<2;++d0){s16x4 lo[4],hi[4];
    #pragma unroll
    for(int ks=0;ks<4;++ks){
      asm volatile("ds_read_b64_tr_b16 %0,%1 offset:%c2":"=&v"(lo[ks]):"v"(vb),"i"(d0*4096+ks*1024):"memory");
      asm volatile("ds_read_b64_tr_b16 %0,%1 offset:%c2":"=&v"(hi[ks]):"v"(vb),"i"(d0*4096+ks*1024+512):"memory");}
    asm volatile("s_waitcnt lgkmcnt(0)":::"memory");SBAR();
    #define PK(k) (bf16x8){lo[k][0],lo[k][1],lo[k][2],lo[k][3],hi[k][0],hi[k][1],hi[k][2],hi[k][3]}
    o[d0]=__builtin_amdgcn_mfma_f32_32x32x16_bf16(pa0,PK(0),o[d0],0,0,0);
    o[d0]=__builtin_amdgcn_mfma_f32_32x32x16_bf16(pa1,PK(1),o[d0],0,0,0);
    o[d0]=__builtin_amdgcn_mfma_f32_32x32x16_bf16(pa2,PK(2),o[d0],0,0,0);
    o[d0]=__builtin_amdgcn_mfma_f32_32x32x16_bf16(pa3,PK(3),o[d0],0,0,0);
    #undef PK
  }
}

#ifndef ATTN_STORE16
#define ATTN_STORE16(p,v) (*(u32x4*)(p)=(v))
#endif
template<int THRL> __device__ __forceinline__ void attn_unit(int b,int qcol,int kcol,int vcol,int ocol,int qb,const bf16*Q,const bf16*__restrict__ K,const bf16*__restrict__ V,bf16*O,char*shm){
  const int tid=threadIdx.x,lane=tid&63,r32=lane&31,hi=lane>>5; const int wid=__builtin_amdgcn_readfirstlane(tid>>6);
  const long rowbase=(long)b*SEQ; const int q0=qb*QB;
  const bf16*Qw=Q+(rowbase+q0+wid*QBLK)*QP+qcol;
  const bf16*Kh=K+rowbase*KP+kcol,*Vh=V+rowbase*VP+vcol;
  const unsigned lds0=(unsigned)(uintptr_t)shm;
  float*wsf=(float*)(shm+LDS_WS)+wid*64;
  const bf16*ksrc=Kh+(long)lane*KP+wid*8;
  const bf16*vsrc=Vh+(long)(16*(wid&3)+(lane>>2))*VP+(wid>>2)*32+(lane&3)*8;
  const unsigned kdst=lds0+LDS_K+wid*1024, vdst=lds0+LDS_V+wid*1024;
  #define DMA_K(t,slot) glds16(ksrc+(long)(t)*KVBLK*KP,(unsigned)__builtin_amdgcn_readfirstlane(kdst+(slot)))
  #define DMA_V(t,slot) glds16(vsrc+(long)(t)*KVBLK*VP,(unsigned)__builtin_amdgcn_readfirstlane(vdst+(slot)))
  const int vb0=(int)(lds0+LDS_V)+((lane>>4)&1)*32+(lane&3)*8+(4*hi+((lane&15)>>2))*64;
  const char*Kbase=shm+LDS_K; bf16x8 kf[8];
  const lds_cptr shm3=(lds_cptr)shm; const lds_cptr kp0=shm3+LDS_K+hi*1024+r32*16; const lds_cptr vp0=shm3+LDS_V+((lane>>4)&1)*32+(lane&3)*8+(4*hi+((lane&15)>>2))*64;
  const int NT=(q0+QB)/KVBLK;
  DMA_K(0,0);DMA_V(0,0);DMA_K(1,SLOTB);
  bf16x8 qr[4];
  #pragma unroll
  for(int d0=0;d0<4;++d0)qr[d0]=*reinterpret_cast<const bf16x8*>(&Qw[(long)r32*QP+d0*16+hi*8]);
  float mhat=0.f,l_reg=0.f;f32x16 o[2];o[0]=f32x16{};o[1]=f32x16{};f32x16 negm=f32x16{};asm volatile("":"+v"(negm));
  const int qrel=wid>>1;
  #define CMASK(P0,P1,t) do{int jb_=(t)-(NT-4); if(jb_>=0)cmask(P0,P1,jb_,qrel,hi);}while(0)
  bool resc=false;
  #define START(P0,P1) do{ const float rm=rowmax(P0,P1); resc=false; \
    { const float dl=rm; mhat=fadd_s(mhat,dl); \
      _Pragma("unroll") for(int r=0;r<16;++r){P0[r]=fsub_s(P0[r],dl);P1[r]=fsub_s(P1[r],dl);} \
      _Pragma("unroll") for(int r=0;r<16;++r)negm[r]=-mhat; asm volatile("":"+v"(negm)); } \
    _Pragma("unroll") for(int r=0;r<16;++r)P0[r]=__builtin_amdgcn_exp2f(P0[r]); }while(0)
  #define RESC() do{ if(resc){ asm volatile("s_waitcnt lgkmcnt(0)":::"memory"); \
      _Pragma("unroll") for(int d_=0;d_<2;++d_) _Pragma("unroll") for(int r=0;r<16;++r)o[d_][r]*=wsf[crow(r,hi)]; } }while(0)
  f32x16 pA0,pA1,pB0,pB1;
  int sl_prev=0,sl_cur=0,sl_next=SLOTB;
  #define ROT() do{sl_prev=sl_cur;sl_cur=sl_next;sl_next=(sl_next==(NSLOT-1)*SLOTB)?0:sl_next+SLOTB;}while(0)
  DMA_K(2,2*SLOTB);
  WAIT_BAR(3);
  qkt(pA0,pA1,Kbase,qr,negm,r32,hi);asm volatile("s_nop 15\n\ts_nop 7":"+v"(pA0),"+v"(pA1));CMASK(pA0,pA1,0);
  START(pA0,pA1);
  _Pragma("unroll") for(int r=0;r<16;++r)pA1[r]=__builtin_amdgcn_exp2f(pA1[r]);
  WAIT_BAR(0);
  DMA_K(3,0);DMA_V(1,SLOTB);
  ROT();
  kload8(kf,kp0+sl_cur);
  WAIT_BAR(2);
  s16x4 vlo[8],vhi[8]; u32x4 pw0,pw1,pw2,pw3;
  #define PKW(P,B) cvtpk_s(P[B],P[B+1])
  #define PAF(k) __builtin_bit_cast(bf16x8,pw##k)
  #define VFR(i) (bf16x8){vlo[i][0],vlo[i][1],vlo[i][2],vlo[i][3],vhi[i][0],vhi[i][1],vhi[i][2],vhi[i][3]}
  #define PIN(x) asm volatile("":"+v"(x))
  #define MX3(a,b,c) __builtin_fmaxf(__builtin_fmaxf((a),(b)),(c))
  #define GAPA(MF,A0,A1,A2,A3,W0,W1,PW) do{ MF; sacc+=A0; sacc+=A1; sacc+=A2; sacc+=A3; PIN(sacc); W0; W1; PIN(PW); SBAR(); }while(0)
  #define EX(v) __builtin_amdgcn_exp2f(v)
  #define GAPB(MF,X,B) do{ MF; X[B]=EX(X[B]); X[B+1]=EX(X[B+1]); X[B+2]=EX(X[B+2]); X[B+3]=EX(X[B+3]); PIN(X); SBAR(); }while(0)
  #define VRD(i) do{ vlo[i]=vtr(vp_+(((i)>>2)*4096+((i)&3)*1024)); vhi[i]=vtr(vp_+(((i)>>2)*4096+((i)&3)*1024+512)); }while(0)
  #define KRD(G,j) do{ if(G){ kload2(kf,kp0+sl_next,j); SBAR(); } }while(0)
  #define STEP(C0,C1,P0,P1,t,GK,GV,GL) do{ SBAR(); \
    const lds_cptr vp_=vp0+sl_prev; \
    VRD(0); SBAR(); float sacc=(P0[0]+P0[1]); \
    GAPA(C0=__builtin_amdgcn_mfma_f32_32x32x16_bf16(kf[0],qr[0],negm,0,0,0), P0[2],P0[3],P0[4],P0[5],     pw0[0]=PKW(P0,0), pw0[1]=PKW(P0,2), pw0); \
    VRD(4); SBAR(); GAPA(C1=__builtin_amdgcn_mfma_f32_32x32x16_bf16(kf[1],qr[0],negm,0,0,0), P0[6],P0[7],P0[8],P0[9],     pw0[2]=PKW(P0,4), pw0[3]=PKW(P0,6), pw0); \
    VRD(1); SBAR(); GAPA(C0=__builtin_amdgcn_mfma_f32_32x32x16_bf16(kf[2],qr[1],C0,0,0,0),   P0[10],P0[11],P0[12],P0[13], pw1[0]=PKW(P0,8), pw1[1]=PKW(P0,10), pw1); \
    VRD(5); SBAR(); GAPA(C1=__builtin_amdgcn_mfma_f32_32x32x16_bf16(kf[3],qr[1],C1,0,0,0),   P0[14],P0[15],P1[0],P1[1],   pw1[2]=PKW(P0,12),pw1[3]=PKW(P0,14), pw1); \
    VRD(2); SBAR(); GAPA(C0=__builtin_amdgcn_mfma_f32_32x32x16_bf16(kf[4],qr[2],C0,0,0,0),   P1[2],P1[3],P1[4],P1[5],     pw2[0]=PKW(P1,0), pw2[1]=PKW(P1,2), pw2); \
    VRD(6); SBAR(); GAPA(C1=__builtin_amdgcn_mfma_f32_32x32x16_bf16(kf[5],qr[2],C1,0,0,0),   P1[6],P1[7],P1[8],P1[9],     pw2[2]=PKW(P1,4), pw2[3]=PKW(P1,6), pw2); \
    VRD(3); SBAR(); GAPA(C0=__builtin_amdgcn_mfma_f32_32x32x16_bf16(kf[6],qr[3],C0,0,0,0),   P1[10],P1[11],P1[12],P1[13], pw3[0]=PKW(P1,8), pw3[1]=PKW(P1,10), pw3); \
    VRD(7); SBAR(); GAPA(C1=__builtin_amdgcn_mfma_f32_32x32x16_bf16(kf[7],qr[3],C1,0,0,0),   P1[14],P1[15],0.f,0.f,       pw3[2]=PKW(P1,12),pw3[3]=PKW(P1,14), pw3); \
    l_reg+=sacc; \
    if(GK){DMA_K((t)+3,sl_cur);} if(GV){DMA_V((t)+1,sl_next);} \
    CMASK(C0,C1,t); \
    { float a=MX3(C0[0],C0[1],C1[0]),b=MX3(C0[2],C0[3],C1[1]); a=MX3(a,C1[2],C1[3]); \
      _Pragma("unroll") for(int r=4;r<16;r+=4){a=MX3(a,C0[r],C0[r+1]);b=MX3(b,C0[r+2],C0[r+3]);a=MX3(a,C1[r],C1[r+1]);b=MX3(b,C1[r+2],C1[r+3]);} \
      float rm=__builtin_fmaxf(a,b); { auto rr=__builtin_amdgcn_permlane32_swap(__float_as_uint(rm),__float_as_uint(rm),false,false); rm=__builtin_fmaxf(__uint_as_float(rr[0]),__uint_as_float(rr[1])); } \
      resc=false; \
      if(__builtin_expect(__any(rm>(float)THRL),0)){ const float dl=__builtin_fmaxf(rm,0.f); mhat+=dl; \
        _Pragma("unroll") for(int r=0;r<16;++r){C0[r]-=dl;C1[r]-=dl;} \
        _Pragma("unroll") for(int r=0;r<16;++r)negm[r]=-mhat; asm volatile("":"+v"(negm)); \
        const float f=__builtin_amdgcn_exp2f(-dl); l_reg*=f; if(hi==0)wsf[r32]=f; resc=true; } } \
    SBAR(); \
    GAPB(o[0]=__builtin_amdgcn_mfma_f32_32x32x16_bf16(PAF(0),VFR(0),o[0],0,0,0), C0,0); \
    GAPB(o[1]=__builtin_amdgcn_mfma_f32_32x32x16_bf16(PAF(0),VFR(4),o[1],0,0,0), C0,4); \
    KRD(GL,0); GAPB(o[0]=__builtin_amdgcn_mfma_f32_32x32x16_bf16(PAF(1),VFR(1),o[0],0,0,0), C0,8); \
    KRD(GL,1); GAPB(o[1]=__builtin_amdgcn_mfma_f32_32x32x16_bf16(PAF(1),VFR(5),o[1],0,0,0), C0,12); \
    KRD(GL,2); GAPB(o[0]=__builtin_amdgcn_mfma_f32_32x32x16_bf16(PAF(2),VFR(2),o[0],0,0,0), C1,0); \
    KRD(GL,3); GAPB(o[1]=__builtin_amdgcn_mfma_f32_32x32x16_bf16(PAF(2),VFR(6),o[1],0,0,0), C1,4); \
    GAPB(o[0]=__builtin_amdgcn_mfma_f32_32x32x16_bf16(PAF(3),VFR(3),o[0],0,0,0), C1,8); \
    GAPB(o[1]=__builtin_amdgcn_mfma_f32_32x32x16_bf16(PAF(3),VFR(7),o[1],0,0,0), C1,12); \
    }while(0)
  int t=1;
  #undef CMASK
  #define CMASK(P0,P1,t) do{}while(0)
  for(;t+5<NT;t+=2){
    STEP(pB0,pB1,pA0,pA1,t,true,true,true);     WAIT_BAR(2); RESC(); ROT();
    STEP(pA0,pA1,pB0,pB1,t+1,true,true,true);   WAIT_BAR(2); RESC(); ROT();
  }
  #undef CMASK
  #define CMASK(P0,P1,t) do{int jb_=(t)-(NT-4); if(jb_>=0)cmask(P0,P1,jb_,qrel,hi);}while(0)
  #define ENDW(tt) do{ if((tt)+3<NT){WAIT_BAR(2);} else if((tt)+2<NT){WAIT_BAR(1);} else {WAIT_BAR(0);} }while(0)
  for(;t+1<NT;t+=2){
    STEP(pB0,pB1,pA0,pA1,t,(t+3<NT),(t+1<NT),(t+1<NT));       ENDW(t);   RESC(); ROT();
    STEP(pA0,pA1,pB0,pB1,t+1,(t+4<NT),(t+2<NT),(t+2<NT));     ENDW(t+1); RESC(); ROT();
  }
  STEP(pB0,pB1,pA0,pA1,NT-1,false,false,false); RESC();
  { float sacc=pB0[0]+pB0[1]; _Pragma("unroll") for(int r=2;r<16;++r)sacc+=pB0[r]; _Pragma("unroll") for(int r=0;r<16;++r)sacc+=pB1[r]; l_reg+=sacc;
    pw0=(u32x4){PKW(pB0,0),PKW(pB0,2),PKW(pB0,4),PKW(pB0,6)};pw1=(u32x4){PKW(pB0,8),PKW(pB0,10),PKW(pB0,12),PKW(pB0,14)};pw2=(u32x4){PKW(pB1,0),PKW(pB1,2),PKW(pB1,4),PKW(pB1,6)};pw3=(u32x4){PKW(pB1,8),PKW(pB1,10),PKW(pB1,12),PKW(pB1,14)};
    SBAR(); pv(o,vb0+sl_cur,PAF(0),PAF(1),PAF(2),PAF(3)); }
  #undef PKW
  #undef PAF
  #undef VFR
  #undef PIN
  #undef MX3
  #undef GAPA
  #undef GAPB
  #undef EX
  #undef VRD
  #undef KRD
  #undef STEP
  #undef ENDW
  {auto rr=__builtin_amdgcn_permlane32_swap(__float_as_uint(l_reg),__float_as_uint(l_reg),false,false);l_reg=__uint_as_float(rr[0])+__uint_as_float(rr[1]);}
  if(hi==0)wsf[32+r32]=l_reg;asm volatile("s_waitcnt lgkmcnt(0)":::"memory");
  float rli[16];
  #pragma unroll
  for(int r=0;r<16;++r)rli[r]=__builtin_amdgcn_rcpf(wsf[32+crow(r,hi)]);
  bf16*Ow=O+(rowbase+q0+wid*QBLK)*OP+ocol;
  { bf16*stg=(bf16*)(shm+LDS_OST)+wid*2048;
    #pragma unroll
    for(int r=0;r<16;++r){const int orow=crow(r,hi);
      #pragma unroll
      for(int d0=0;d0<2;++d0)stg[orow*64+d0*32+r32]=__float2bfloat16(o[d0][r]*rli[r]);}
    asm volatile("s_waitcnt lgkmcnt(0)":::"memory");
    #pragma unroll
    for(int i=0;i<4;++i){const int row=i*8+(lane>>3),ch=lane&7; const u32x4 v=*(const u32x4*)(stg+row*64+ch*8); ATTN_STORE16(Ow+(long)row*OP+ch*8,v);} }
  asm volatile("s_waitcnt lgkmcnt(0)\n\ts_barrier":::"memory");
  #undef DMA_K
  #undef DMA_V
  #undef CMASK
  #undef START
  #undef RESC
  #undef ROT
}
constexpr int ATTN_LDS_BYTES=LDS_BYTES;
struct AttnTensors { const bf16* Q; const bf16* K; const bf16* V; bf16* O; };
struct AttnUnit { int bvh; int qb; };
struct StaticOrder {
  int ai,nA;
  __device__ __forceinline__ StaticOrder(int ai_,int nA_):ai(ai_),nA(nA_){}
  __device__ __forceinline__ bool next(int i,AttnUnit&u)const{
    if(nA==128){ if(i>=8)return false; u.bvh=ai; u.qb=7-i; return true; }
    if(i>=4)return false; const int s=ai&1; u.bvh=ai>>1; u.qb=(i==0)?7-s:(i==1)?4+s:(i==2)?3-s:s; return true; }
  __device__ __forceinline__ void a_ready(const AttnUnit&)const{}
  __device__ __forceinline__ void done(const AttnUnit&)const{}
};
template<class Sched,int THRL=8> __device__ __forceinline__ void attn_phase(char*lds,const AttnTensors&T,const Sched&S){
  AttnUnit u;
  for(int i=0;S.next(i,u);++i){ S.a_ready(u); const int b=u.bvh>>4,vh=u.bvh&15,s=vh>>1,half=vh&1;
    attn_unit<THRL>(b,s*64,s*64,(s>>1)*128+half*64,s*128+half*64,u.qb,T.Q,T.K,T.V,T.O,lds); S.done(u); }
}
#undef SBAR
#undef WAIT_BAR
}
#include <hip/hip_cooperative_groups.h>
typedef unsigned short bf16;
#define GAS __attribute__((address_space(1)))
#define LAS __attribute__((address_space(3)))
typedef unsigned v4u __attribute__((ext_vector_type(4)));
typedef unsigned v2u __attribute__((ext_vector_type(2)));
typedef float f32x4 __attribute__((ext_vector_type(4)));
#define LDS_WAIT() asm volatile("s_waitcnt lgkmcnt(0)" ::: "memory")
__device__ __forceinline__ unsigned f2bf(float f) { unsigned u = __builtin_bit_cast(unsigned, f); return (u + 0x7fffu + ((u >> 16) & 1u)) >> 16; }
__device__ __forceinline__ unsigned pk2(float lo, float hi) { return f2bf(lo) | (f2bf(hi) << 16); }
__device__ __forceinline__ float bflo(unsigned w) { return __builtin_bit_cast(float, w << 16); }
__device__ __forceinline__ float bfhi(unsigned w) { return __builtin_bit_cast(float, w & 0xffff0000u); }
__device__ __forceinline__ float bf1(unsigned short h) { return __builtin_bit_cast(float, (unsigned)h << 16); }
template <int CTRL> __device__ __forceinline__ float dppf(float x) { return __builtin_bit_cast(float, __builtin_amdgcn_update_dpp(0, __builtin_bit_cast(int, x), CTRL, 0xf, 0xf, false)); }
__device__ __forceinline__ float row16_allsum(float x) { x += dppf<0x128>(x); x += dppf<0x124>(x); x += dppf<0x122>(x); x += dppf<0x121>(x); return x; }
__device__ __forceinline__ float oct_allsum(float x) { x += dppf<0xB1>(x); x += dppf<0x4E>(x); x += dppf<0x141>(x); return x; }
__device__ __forceinline__ float u2f(unsigned u) { return __builtin_bit_cast(float, u); }
__device__ __forceinline__ unsigned f2u(float f) { return __builtin_bit_cast(unsigned, f); }
__device__ __forceinline__ float sw32(float a, float b) { auto r = __builtin_amdgcn_permlane32_swap(f2u(a), f2u(b), false, false); const unsigned r0 = r[0], r1 = r[1]; return u2f(r0) + u2f(r1); }
__device__ __forceinline__ float sw16(float a, float b) { auto r = __builtin_amdgcn_permlane16_swap(f2u(a), f2u(b), false, false); const unsigned r0 = r[0], r1 = r[1]; return u2f(r0) + u2f(r1); }
__device__ __forceinline__ float wave_allsum(float x) { x = row16_allsum(x); x = sw16(x, x); return sw32(x, x); }
__device__ __forceinline__ float red4(float x0, float x1, float x2, float x3) { return row16_allsum(sw16(sw32(x0, x1), sw32(x2, x3))); }

#define XB_TMO      128
#define XB_XCNT(j)  (256  + 64 * (j))
#define XB_XSUB(j)  (1280 + 64 * (j))
#define XB_XGEN(j)  (2304 + 64 * (j))
#define XB_TOP      3328
#define XB_TOPGEN   3392
#define XCD_BAR_WORDS 3456
#define XB_SPIN_CAP (1u << 18)

__device__ __forceinline__ unsigned xb_ld(unsigned* p)              { return __hip_atomic_load(p, __ATOMIC_RELAXED, __HIP_MEMORY_SCOPE_AGENT); }
__device__ __forceinline__ unsigned xb_add(unsigned* p, unsigned v) { return __hip_atomic_fetch_add(p, v, __ATOMIC_RELAXED, __HIP_MEMORY_SCOPE_AGENT); }
__device__ __forceinline__ unsigned xb_xcc_id() { return (unsigned)__builtin_amdgcn_s_getreg((3 << 11) | 20) & 0xFu; }
#define XB_SPIN(cond, bar) do { unsigned _sp = 0; while (cond) { __builtin_amdgcn_s_sleep(1); \
    if ((++_sp & 255u) == 0u) { if (xb_ld(&(bar)[XB_TMO])) break; if (_sp > XB_SPIN_CAP) { atomicAdd(&(bar)[XB_TMO], 1u); break; } } } } while (0)

struct XcdBarrier {
    unsigned* bar; unsigned x;
    volatile LAS unsigned* st;
};

__device__ __forceinline__ XcdBarrier xcd_barrier_post(unsigned* bar, volatile LAS unsigned* st) {
    XcdBarrier b; b.bar = bar; b.x = xb_xcc_id(); b.st = st;
    if (threadIdx.x == 0) (void)xb_add(&bar[XB_XCNT(b.x)], 1u);
    return b;
}
__device__ __forceinline__ void xcd_barrier_complete(unsigned* bar, unsigned x, unsigned& nloc, unsigned& nx) {
    const unsigned G = gridDim.x * gridDim.y * gridDim.z;
    unsigned sum, cnt, mine, sp = 0u;
    for (;;) {
        sum = 0u; cnt = 0u; mine = 0u;
#pragma unroll
        for (unsigned j = 0; j < 16; ++j) { const unsigned c = xb_ld(&bar[XB_XCNT(j)]); sum += c; cnt += (c > 0u) ? 1u : 0u; }
        mine = xb_ld(&bar[XB_XCNT(x)]);
        if (sum == G) break;
        __builtin_amdgcn_s_sleep(1);
        if ((++sp & 255u) == 0u) { if (xb_ld(&bar[XB_TMO])) break; if (sp > XB_SPIN_CAP) { atomicAdd(&bar[XB_TMO], 1u); break; } }
    }
    nloc = mine > 0u ? mine : 1u; nx = cnt > 0u ? cnt : 1u;
}

__device__ __forceinline__ void xcd_barrier(const XcdBarrier& b) {
    asm volatile("s_waitcnt vmcnt(0)" ::: "memory");
    __syncthreads();
    if (threadIdx.x == 0) {
        unsigned* bar = b.bar;
        __builtin_amdgcn_s_waitcnt(0);
        unsigned nloc = b.st[0], nx = b.st[1];
        if (nloc == 0u) { xcd_barrier_complete(bar, b.x, nloc, nx); b.st[0] = nloc; b.st[1] = nx; }
        const unsigned old = xb_add(&bar[XB_XSUB(b.x)], 1u);
        const unsigned gen = old / nloc;
        if (old + 1u == (gen + 1u) * nloc) {
            __builtin_amdgcn_fence(__ATOMIC_RELEASE, "agent");
            asm volatile("s_waitcnt vmcnt(0)" ::: "memory");
            const unsigned og = xb_add(&bar[XB_TOP], 1u);
            const unsigned tg = og / nx;
            if (og + 1u == (tg + 1u) * nx) xb_add(&bar[XB_TOPGEN], 1u);
            else XB_SPIN(xb_ld(&bar[XB_TOPGEN]) == tg, bar);
            __builtin_amdgcn_fence(__ATOMIC_ACQUIRE, "agent");
            xb_add(&bar[XB_XGEN(b.x)], 1u);
            asm volatile("s_waitcnt vmcnt(0)" ::: "memory");
        } else {
            XB_SPIN(xb_ld(&bar[XB_XGEN(b.x)]) == gen, bar);
            __builtin_amdgcn_fence(__ATOMIC_ACQUIRE, "agent");
            asm volatile("s_waitcnt vmcnt(0)" ::: "memory");
        }
    }
    __syncthreads();
}


constexpr int CW_BAR = 4096;
constexpr int MISC_OFF = 162816 + 320;
struct Frame {
    LAS unsigned char* lds;
    int tid, lane, wave, G, bx;
    float* out; unsigned char* ws;
};
struct Args { const float* in[26]; float* out; unsigned char* ws; int ph_lo, ph_hi; };
typedef const float* cfp_t;
typedef __attribute__((address_space(4))) const cfp_t* ktab_t;
struct InTab { ktab_t p; __device__ __forceinline__ const float* operator[](int i) const { return p[i]; } };
enum { I_X = 0, I_NMG, I_WIN, I_MU, I_W0, I_W2, I_A0, I_A2, I_G2, I_KK, I_KA, I_RK, I_LNG, I_LNB, I_LQ1, I_LK1, I_LQ2, I_LK2, I_SUBG, I_WA, I_WB, I_WO, I_NFG, I_FF1, I_FF2, I_NFIN };

template <bool ROPE> __device__ __forceinline__ void p0_transpose_item(const float* W, int K, int N, bf16* WT, LAS float* scr, int item, int lane, int pitch = 0, int koff = 0) {
    if (pitch == 0) pitch = K;
    const int nblk = N / 32, kb = item / nblk, nb = item % nblk, k0 = 64 * kb, n0 = 32 * nb;
#pragma unroll 8
    for (int i = 0; i < 32; ++i) { const int kk = 2 * i + (lane >> 5); scr[kk * 33 + (lane & 31)] = W[(size_t)(k0 + kk) * N + n0 + (lane & 31)]; }
    LDS_WAIT(); asm volatile("" ::: "memory");
    const int c = lane & 7;
#pragma unroll
    for (int j = 0; j < 4; ++j) { const int n = (lane >> 3) + 8 * j; const LAS float* s = scr + (8 * c) * 33 + n;
        v4u o; o.x = pk2(s[0 * 33], s[1 * 33]); o.y = pk2(s[2 * 33], s[3 * 33]); o.z = pk2(s[4 * 33], s[5 * 33]); o.w = pk2(s[6 * 33], s[7 * 33]);
        int col = n0 + n;
        if (ROPE && col < 1024) { const int d = col & 63, dd = d & 31; col = (col & ~63) + 8 * (dd >> 2) + (d >> 5) * 4 + (dd & 3); }
        *(GAS v4u*)(WT + (size_t)col * pitch + koff + k0 + 8 * c) = o; }
    LDS_WAIT(); asm volatile("" ::: "memory");
}
__device__ __forceinline__ void rms_row_to_bf16(const float* xrow, const float* g, bf16* orow, int lane) {
    const GAS f32x4* xr = (const GAS f32x4*)xrow + lane; const f32x4* gr = (const f32x4*)g + lane;
    f32x4 v[4]; float s = 0.f;
#pragma unroll
    for (int j = 0; j < 4; ++j) { v[j] = xr[64 * j]; s += (v[j].x * v[j].x + v[j].y * v[j].y) + (v[j].z * v[j].z + v[j].w * v[j].w); }
    const float rstd = 1.0f / sqrtf(wave_allsum(s) * (1.f / D) + NORM_EPS);
    GAS unsigned long long* o8 = (GAS unsigned long long*)orow + lane;
#pragma unroll
    for (int j = 0; j < 4; ++j) { const f32x4 gg = gr[64 * j];
        o8[64 * j] = (unsigned long long)pk2(v[j].x * rstd * gg.x, v[j].y * rstd * gg.y) | ((unsigned long long)pk2(v[j].z * rstd * gg.z, v[j].w * rstd * gg.w) << 32); }
}
__device__ __forceinline__ void rms_row_to_f32(const float* xrow, const float* g, float* orow, int lane) {
    const GAS f32x4* xr = (const GAS f32x4*)xrow + lane; const f32x4* gr = (const f32x4*)g + lane;
    f32x4 v[4]; float s = 0.f;
#pragma unroll
    for (int j = 0; j < 4; ++j) { v[j] = xr[64 * j]; s += (v[j].x * v[j].x + v[j].y * v[j].y) + (v[j].z * v[j].z + v[j].w * v[j].w); }
    const float rstd = 1.0f / sqrtf(wave_allsum(s) * (1.f / D) + NORM_EPS);
    GAS f32x4* o = (GAS f32x4*)orow + lane;
#pragma unroll
    for (int j = 0; j < 4; ++j) { const f32x4 gg = gr[64 * j]; o[64 * j] = v[j] * rstd * gg; }
}
__device__ __forceinline__ void p0_prologue(Frame& F, const InTab& A) {
    LAS float* scr = (LAS float*)(F.lds + RING_OFF + F.wave * 16384);
    const int gw = F.bx * NWAVES + F.wave, NGW = F.G * NWAVES;
    unsigned char* ws = F.ws;
    constexpr int I_IN = (D / 64) * (D_IN / 32), I_A = (512 / 64) * (D / 32), I_O = (D / 64) * (D / 32), I_1 = (D / 64) * (FF / 32), I_2 = (FF / 64) * (D / 32);
    (void)I_A; (void)I_O; (void)I_1; (void)I_2;
    for (int it = gw; it < I_IN; it += NGW) p0_transpose_item<true>(A[I_WIN], D, D_IN, (bf16*)(ws + WS_WIN), scr, it, F.lane);
    if (false) for (int it = gw; it < 0; it += NGW) {
        int r = it;
        if (r < I_A) { p0_transpose_item<false>(A[I_WA], 512, D, (bf16*)(ws + WS_WA), scr, r, F.lane, 1024, 0); continue; } r -= I_A;
        if (r < I_A) { p0_transpose_item<false>(A[I_WB], 512, D, (bf16*)(ws + WS_WA), scr, r, F.lane, 1024, 512); continue; } r -= I_A;
        if (r < I_O) { p0_transpose_item<false>(A[I_WO], D, D, (bf16*)(ws + WS_WO), scr, r, F.lane); continue; } r -= I_O;
        if (r < I_1) { p0_transpose_item<false>(A[I_FF1], D, FF, (bf16*)(ws + WS_W1), scr, r, F.lane); continue; } r -= I_1;
        p0_transpose_item<false>(A[I_FF2], FF, D, (bf16*)(ws + WS_W2), scr, r, F.lane);
    }
    const int gt = F.bx * (NWAVES * 64) + F.tid, NGT = F.G * NWAVES * 64;
    for (int e = gt; e < NLORA * (KLORA / 8); e += NGT) { const int n = e / (KLORA / 8), k8 = (e % (KLORA / 8)) * 8; float v[8];
#pragma unroll
        for (int i = 0; i < 8; ++i) { const int k = k8 + i; float x = 0.f;
            if (n < 512) { if (k < 64) x = A[I_W2][(size_t)k * 512 + n]; }
            else if (n < 1024) { if (k >= 64 && k < 128) x = A[I_A2][(size_t)(k - 64) * 512 + (n - 512)]; }
            else { if (k >= 128) x = A[I_G2][(size_t)(k - 128) * 512 + (n - 1024)]; }
            v[i] = x; }
        v4u o; o.x = pk2(v[0], v[1]); o.y = pk2(v[2], v[3]); o.z = pk2(v[4], v[5]); o.w = pk2(v[6], v[7]);
        *(GAS v4u*)((bf16*)(ws + WS_WL) + (size_t)n * KLORA + k8) = o; }
    for (int e = gt; e < SEQ * 32; e += NGT) { const int pos = e >> 5, i = e & 31;
        const float inv = (float)pow(10000.0, -(double)i / 32.0); const float ang = (float)pos * inv; double s, c; sincos((double)ang, &s, &c);
        ((float*)(ws + WS_ROPE_C))[e] = (float)c; ((float*)(ws + WS_ROPE_S))[e] = (float)s; }
    for (int m = gw; m < M; m += NGW) rms_row_to_bf16(A[I_X] + (size_t)m * D, A[I_NMG], (bf16*)(ws + WS_XN) + (size_t)m * D, F.lane);
}

__device__ __forceinline__ void late_weights(Frame& F, const InTab& A, int part, int nparts, int cu0) {
    int lane_ = F.lane; asm volatile("" : "+v"(lane_));
    LAS float* scr = (LAS float*)(F.lds + RING_OFF + F.wave * 16384);
    unsigned char* ws = F.ws;
    constexpr int I_A = (512 / 64) * (D / 32), I_O = (D / 64) * (D / 32), I_1 = (D / 64) * (FF / 32), I_2 = (FF / 64) * (D / 32), NIT = 2 * I_A + I_O + I_1 + I_2;
    const int per = NIT / nparts, lo = part * per, hi = lo + per;
    const int gw = (F.bx - cu0) * NWAVES + F.wave, NGW = (F.G - cu0) * NWAVES;
    for (int it = lo + gw; it < hi; it += NGW) {
        int r = it;
        if (r < I_A) { p0_transpose_item<false>(A[I_WA], 512, D, (bf16*)(ws + WS_WA), scr, r, lane_, 1024, 0); continue; } r -= I_A;
        if (r < I_A) { p0_transpose_item<false>(A[I_WB], 512, D, (bf16*)(ws + WS_WA), scr, r, lane_, 1024, 512); continue; } r -= I_A;
        if (r < I_O) { p0_transpose_item<false>(A[I_WO], D, D, (bf16*)(ws + WS_WO), scr, r, lane_); continue; } r -= I_O;
        if (r < I_1) { p0_transpose_item<false>(A[I_FF1], D, FF, (bf16*)(ws + WS_W1), scr, r, lane_); continue; } r -= I_1;
        p0_transpose_item<false>(A[I_FF2], FF, D, (bf16*)(ws + WS_W2), scr, r, lane_);
    }
}
__device__ __forceinline__ void prep1_phase(Frame& F, const InTab& A) {
    const int gw = F.bx * NWAVES + F.wave, NGW = F.G * NWAVES, lane = F.lane;
    const bf16* WAG = (const bf16*)(F.ws + WS_WAG); bf16* LIN = (bf16*)(F.ws + WS_LIN);
    const f32x4 mu = *(const f32x4*)(A[I_MU] + 1536 + 4 * lane);
    for (int m = gw; m < M; m += NGW) {
        const v2u cur = *(const GAS v2u*)(WAG + (size_t)m * 256 + 4 * lane);
        v2u prv = (v2u){0u, 0u}; if ((m & (SEQ - 1)) != 0) prv = *(const GAS v2u*)(WAG + (size_t)(m - 1) * 256 + 4 * lane);
        float z[4] = {bflo(cur.x), bfhi(cur.x), bflo(cur.y), bfhi(cur.y)}; const float p[4] = {bflo(prv.x), bfhi(prv.x), bflo(prv.y), bfhi(prv.y)};
#pragma unroll
        for (int e = 0; e < 4; ++e) { float v = z[e] + (p[e] - z[e]) * mu[e];
            if (lane < 16) v = tanhf(v); else if (lane >= 32) v = 1.0f / (1.0f + __expf(-v));
            z[e] = v; }
        v2u o; o.x = pk2(z[0], z[1]); o.y = pk2(z[2], z[3]);
        *(GAS v2u*)(LIN + (size_t)m * 256 + 4 * lane) = o;
    }
}
struct ScanRaw { unsigned short r[9], k[9], v[9], a[8]; float d[8]; };
__device__ __forceinline__ void scan_load(ScanRaw& R, const bf16* RKV, const float* DEC, const bf16* AA, size_t row0, int t0, int c) {
#pragma unroll
    for (int j = 0; j < 9; ++j) { int t = t0 - 1 + j; if (t < 0) t = 0; const bf16* p = RKV + (row0 + t) * 1536 + c;
        R.r[j] = *(const GAS bf16*)p; R.k[j] = *(const GAS bf16*)(p + 512); R.v[j] = *(const GAS bf16*)(p + 1024); }
#pragma unroll
    for (int j = 0; j < 8; ++j) { R.d[j] = *(const GAS float*)(DEC + (row0 + t0 + j) * 512 + c); R.a[j] = *(const GAS bf16*)(AA + (row0 + t0 + j) * 512 + c); }
}
__device__ __forceinline__ void scan_phase(Frame& F, const InTab& A, int si) {
    const int lane = F.lane, wave = F.wave, tid = F.tid;
    const int bh = si >> 1, half = si & 1, b = bh >> 3, h = bh & 7, c = h * 64 + lane;
    LAS float* IN = (LAS float*)(F.lds + RING_OFF);
    LAS float* VV = IN + 5 * 4096;
    LAS float* YBUF = VV + 2048;
    const bf16* RKV = (const bf16*)(F.ws + WS_RKV); const float* DEC = (const float*)(F.ws + WS_DEC); const bf16* AA = (const bf16*)(F.ws + WS_AA);
    bf16* Y = (bf16*)(F.ws + WS_Y); float* BON = (float*)(F.ws + WS_BON);
    const float mu_r = A[I_MU][c], mu_k = A[I_MU][512 + c], mu_v = A[I_MU][1024 + c], kkc = A[I_KK][c], kac = A[I_KA][c], rkc = A[I_RK][c];
    const size_t row0 = (size_t)b * SEQ;
    const int myv = (int)(red4(0.f, 1.f, 2.f, 3.f) * (1.0f / 64.0f) + 0.5f);
    const int L0 = __builtin_ctzll(__ballot(myv == 0)), L1 = __builtin_ctzll(__ballot(myv == 1)), L2 = __builtin_ctzll(__ballot(myv == 2)), L3 = __builtin_ctzll(__ballot(myv == 3));
    float S0 = 0.f, S1 = 0.f, S2 = 0.f, S3 = 0.f;
    ScanRaw R; scan_load(R, RKV, DEC, AA, row0, wave * 8, c);
    for (int blk = 0; blk < SEQ / 64; ++blk) {
        {
            const int t0 = blk * 64 + wave * 8;
            f32x4 qd[2], qa[2], qb[2], qk[2], qr[2], qv[2];
#pragma unroll
            for (int j = 0; j < 8; ++j) {
                const float pz = (t0 + j == 0) ? 0.f : 1.f;
                const float rt_ = bf1(R.r[j + 1]), kt_ = bf1(R.k[j + 1]), vt_ = bf1(R.v[j + 1]);
                const float rs = rt_ + (bf1(R.r[j]) * pz - rt_) * mu_r, ks = kt_ + (bf1(R.k[j]) * pz - kt_) * mu_k, vs = vt_ + (bf1(R.v[j]) * pz - vt_) * mu_v;
                const float kkr = ks * kkc, n2 = wave_allsum(kkr * kkr), kk = kkr / __builtin_fmaxf(sqrtf(n2), 1e-12f);
                const float a = 1.0f / (1.0f + __expf(-bf1(R.a[j]))), kx = ks * (1.0f + (a - 1.0f) * kac);
                const float bon = wave_allsum(rs * kx * rkc);
                if (half == 0 && lane == 0) BON[(row0 + t0 + j) * 8 + h] = bon;
                qd[j >> 2][j & 3] = __expf(-0.6065306597f / (1.0f + __expf(-R.d[j])));     qa[j >> 2][j & 3] = -kk; qb[j >> 2][j & 3] = kk * a; qk[j >> 2][j & 3] = kx; qr[j >> 2][j & 3] = rs; qv[j >> 2][j & 3] = vs;
            }
#pragma unroll
            for (int q = 0; q < 2; ++q) { const int t4 = wave * 2 + q; LAS f32x4* p = (LAS f32x4*)IN + t4 * 64 + lane;
                p[0 * 1024] = qd[q]; p[1 * 1024] = qa[q]; p[2 * 1024] = qb[q]; p[3 * 1024] = qk[q]; p[4 * 1024] = qr[q];
                if ((lane >> 5) == half) ((LAS f32x4*)VV)[t4 * 32 + (lane & 31)] = qv[q]; }
        }
        __syncthreads();
        if (blk + 1 < SEQ / 64) scan_load(R, RKV, DEC, AA, row0, (blk + 1) * 64 + wave * 8, c);
#pragma unroll 1
        for (int t4 = 0; t4 < 16; ++t4) {
            const LAS f32x4* p = (const LAS f32x4*)IN + t4 * 64 + lane;
            const f32x4 W4 = p[0], A4 = p[1024], B4 = p[2048], K4 = p[3072], R4 = p[4096];
            const LAS f32x4* pv = (const LAS f32x4*)VV + t4 * 32 + wave * 4;
            const f32x4 V0 = pv[0], V1 = pv[1], V2 = pv[2], V3 = pv[3];
            f32x4 yq;
#pragma unroll
            for (int ts = 0; ts < 4; ++ts) {
                const float w = W4[ts], a = A4[ts], bb = B4[ts], kx = K4[ts], r = R4[ts];
                const float t = red4(S0 * a, S1 * a, S2 * a, S3 * a);
                const float sa0 = __builtin_bit_cast(float, __builtin_amdgcn_readlane(__builtin_bit_cast(int, t), L0)), sa1 = __builtin_bit_cast(float, __builtin_amdgcn_readlane(__builtin_bit_cast(int, t), L1));
                const float sa2 = __builtin_bit_cast(float, __builtin_amdgcn_readlane(__builtin_bit_cast(int, t), L2)), sa3 = __builtin_bit_cast(float, __builtin_amdgcn_readlane(__builtin_bit_cast(int, t), L3));
                S0 = S0 * w + (sa0 * bb + V0[ts] * kx); S1 = S1 * w + (sa1 * bb + V1[ts] * kx); S2 = S2 * w + (sa2 * bb + V2[ts] * kx); S3 = S3 * w + (sa3 * bb + V3[ts] * kx);
                yq[ts] = red4(S0 * r, S1 * r, S2 * r, S3 * r);
            }
            if ((lane & 15) == 0) *(LAS f32x4*)(YBUF + (wave * 4 + myv) * 68 + t4 * 4) = yq;
        }
        __syncthreads();
        { const int t = tid >> 3, rg = tid & 7; const LAS float* yb = YBUF + (4 * rg) * 68 + t;
          v2u o; o.x = pk2(yb[0], yb[68]); o.y = pk2(yb[136], yb[204]);
          *(GAS v2u*)(Y + (row0 + blk * 64 + t) * 512 + h * 64 + 32 * half + 4 * rg) = o; }
    }
    __syncthreads();
}
__device__ __forceinline__ void post_phase(Frame& F, const InTab& A) {
    const int gw = F.bx * NWAVES + F.wave, NGW = F.G * NWAVES, lane = F.lane;
    const bf16* O = (const bf16*)(F.ws + WS_O); const bf16* Y = (const bf16*)(F.ws + WS_Y); const bf16* RKV = (const bf16*)(F.ws + WS_RKV); const bf16* GG = (const bf16*)(F.ws + WS_GG);
    const float* BON = (const float*)(F.ws + WS_BON); bf16* YA = (bf16*)(F.ws + WS_YA); bf16* YB = (bf16*)(F.ws + WS_YB);
    const float lam = __expf(wave_allsum(A[I_LQ1][lane] * A[I_LK1][lane])) - __expf(wave_allsum(A[I_LQ2][lane] * A[I_LK2][lane])) + LAMBDA_INIT;
    const int ca = 8 * lane, ha = lane >> 4, ea = ca & 127;
    const int hb = lane >> 3;
    float sg[8], lg[8], lb[8], muv[8];
#pragma unroll
    for (int e = 0; e < 8; ++e) { sg[e] = A[I_SUBG][ea + e] * (1.0f - LAMBDA_INIT); lg[e] = A[I_LNG][ca + e]; lb[e] = A[I_LNB][ca + e]; muv[e] = A[I_MU][1024 + ca + e]; }
    for (int m = gw; m < M; m += NGW) {
        {
            const v4u o0 = *(const GAS v4u*)(O + (size_t)m * 1024 + (2 * ha) * 128 + ea), o1 = *(const GAS v4u*)(O + (size_t)m * 1024 + (2 * ha + 1) * 128 + ea);
            float o[8] = {bflo(o0.x) - lam * bflo(o1.x), bfhi(o0.x) - lam * bfhi(o1.x), bflo(o0.y) - lam * bflo(o1.y), bfhi(o0.y) - lam * bfhi(o1.y),
                          bflo(o0.z) - lam * bflo(o1.z), bfhi(o0.z) - lam * bfhi(o1.z), bflo(o0.w) - lam * bflo(o1.w), bfhi(o0.w) - lam * bfhi(o1.w)};
            float ss = 0.f;
#pragma unroll
            for (int e = 0; e < 8; ++e) ss += o[e] * o[e];
            const float rstd = 1.0f / sqrtf(row16_allsum(ss) * (1.0f / 128.0f) + SUBLN_EPS);
            v4u w; w.x = pk2(o[0] * rstd * sg[0], o[1] * rstd * sg[1]); w.y = pk2(o[2] * rstd * sg[2], o[3] * rstd * sg[3]); w.z = pk2(o[4] * rstd * sg[4], o[5] * rstd * sg[5]); w.w = pk2(o[6] * rstd * sg[6], o[7] * rstd * sg[7]);
#ifdef ABL_YA0
            w = (v4u){0u, 0u, 0u, 0u};
#endif
            *(GAS v4u*)(YA + (size_t)m * 1024 + ca) = w;
        }
        {
            const v4u yr = *(const GAS v4u*)(Y + (size_t)m * 512 + ca), gr = *(const GAS v4u*)(GG + (size_t)m * 512 + ca);
            const v4u vc = *(const GAS v4u*)(RKV + (size_t)m * 1536 + 1024 + ca);
            v4u vp = (v4u){0u, 0u, 0u, 0u}; if ((m & (SEQ - 1)) != 0) vp = *(const GAS v4u*)(RKV + (size_t)(m - 1) * 1536 + 1024 + ca);
            const float y[8] = {bflo(yr.x), bfhi(yr.x), bflo(yr.y), bfhi(yr.y), bflo(yr.z), bfhi(yr.z), bflo(yr.w), bfhi(yr.w)};
#ifdef DBG_GDIRECT
            float g[8] = {0.f, 0.f, 0.f, 0.f, 0.f, 0.f, 0.f, 0.f};
            { const bf16* LINr = (const bf16*)(F.ws + WS_LIN) + (size_t)m * 256 + 128; (void)gr;
              for (int k = 0; k < 128; ++k) { const float s = bf1(*(const GAS bf16*)(LINr + k)); const float* g2r = A[I_G2] + (size_t)k * 512 + ca;
#pragma unroll
                for (int e = 0; e < 8; ++e) g[e] += s * g2r[e]; } }
#else
            const float g[8] = {bflo(gr.x), bfhi(gr.x), bflo(gr.y), bfhi(gr.y), bflo(gr.z), bfhi(gr.z), bflo(gr.w), bfhi(gr.w)};
#endif
            const float v[8] = {bflo(vc.x), bfhi(vc.x), bflo(vc.y), bfhi(vc.y), bflo(vc.z), bfhi(vc.z), bflo(vc.w), bfhi(vc.w)};
            const float p[8] = {bflo(vp.x), bfhi(vp.x), bflo(vp.y), bfhi(vp.y), bflo(vp.z), bfhi(vp.z), bflo(vp.w), bfhi(vp.w)};
            float s = 0.f;
#pragma unroll
            for (int e = 0; e < 8; ++e) s += y[e];
            const float mean = oct_allsum(s) * (1.0f / 64.0f); float q = 0.f;
#pragma unroll
            for (int e = 0; e < 8; ++e) { const float d = y[e] - mean; q += d * d; }
            const float rstd = 1.0f / sqrtf(oct_allsum(q) * (1.0f / 64.0f) + GN_EPS);
#ifdef DBG_BONDIRECT
            float bon;
            { const v4u rc = *(const GAS v4u*)(RKV + (size_t)m * 1536 + ca), kc = *(const GAS v4u*)(RKV + (size_t)m * 1536 + 512 + ca), ac = *(const GAS v4u*)((const bf16*)(F.ws + WS_AA) + (size_t)m * 512 + ca);
              v4u rp = (v4u){0u, 0u, 0u, 0u}, kp = (v4u){0u, 0u, 0u, 0u};
              if ((m & (SEQ - 1)) != 0) { rp = *(const GAS v4u*)(RKV + (size_t)(m - 1) * 1536 + ca); kp = *(const GAS v4u*)(RKV + (size_t)(m - 1) * 1536 + 512 + ca); }
              const float rcf[8] = {bflo(rc.x), bfhi(rc.x), bflo(rc.y), bfhi(rc.y), bflo(rc.z), bfhi(rc.z), bflo(rc.w), bfhi(rc.w)}, rpf[8] = {bflo(rp.x), bfhi(rp.x), bflo(rp.y), bfhi(rp.y), bflo(rp.z), bfhi(rp.z), bflo(rp.w), bfhi(rp.w)};
              const float kcf[8] = {bflo(kc.x), bfhi(kc.x), bflo(kc.y), bfhi(kc.y), bflo(kc.z), bfhi(kc.z), bflo(kc.w), bfhi(kc.w)}, kpf[8] = {bflo(kp.x), bfhi(kp.x), bflo(kp.y), bfhi(kp.y), bflo(kp.z), bfhi(kp.z), bflo(kp.w), bfhi(kp.w)};
              const float af[8] = {bflo(ac.x), bfhi(ac.x), bflo(ac.y), bfhi(ac.y), bflo(ac.z), bfhi(ac.z), bflo(ac.w), bfhi(ac.w)};
              float s_ = 0.f;
#pragma unroll
              for (int e = 0; e < 8; ++e) { const float rs = rcf[e] + (rpf[e] - rcf[e]) * A[I_MU][ca + e], ks = kcf[e] + (kpf[e] - kcf[e]) * A[I_MU][512 + ca + e];
                  s_ += rs * (ks * (1.0f + (af[e] - 1.0f) * A[I_KA][ca + e])) * A[I_RK][ca + e]; }
              bon = oct_allsum(s_); (void)BON; }
#else
            const float bon = BON[(size_t)m * 8 + hb];
#endif
            float r[8];
#pragma unroll
            for (int e = 0; e < 8; ++e) { const float vs = v[e] + (p[e] - v[e]) * muv[e];
#if defined(ABL_NOGN)
                r[e] = (bon * vs) * g[e]; }
#elif defined(ABL_NOBON)
                r[e] = (((y[e] - mean) * rstd) * lg[e] + lb[e]) * g[e]; }
#else
                r[e] = (((y[e] - mean) * rstd) * lg[e] + lb[e] + bon * vs) * g[e]; }
#endif

            v4u w; w.x = pk2(r[0], r[1]); w.y = pk2(r[2], r[3]); w.z = pk2(r[4], r[5]); w.w = pk2(r[6], r[7]);
#ifdef ABL_YB0
            w = (v4u){0u, 0u, 0u, 0u};
#endif
            *(GAS v4u*)(YA + (size_t)m * 1024 + 512 + ca) = w;
        }
    }
}

typedef short rk_bf16x8 __attribute__((ext_vector_type(8)));
typedef float rk_f32x16 __attribute__((ext_vector_type(16)));
constexpr int RKA_RS_K = 144, RKA_RS_J = 80;
constexpr int RKA_A = 0, RKA_B = 5120, RKA_K = 10240, RKA_R = 15360, RKA_AT = 19968, RKA_BH = 25088, RKA_KH = 30208, RKA_VT = 35328, RKA_GC = 40448, RKA_BYTES = 40704;
constexpr int RKA_N = 0, RKA_X = 0, RKA_T = 5120, RKA_MAK = 7680, RKA_MRB = 10240, RKA_MRK = 12800;
constexpr int RKA_WAVES = 4;
static_assert(RKA_WAVES * RKA_BYTES <= 162816, "phase A LDS");
constexpr size_t WS_PQ = 66 * MiB;
constexpr size_t WS_RY = 98 * MiB;
constexpr size_t WS_GC = 242 * MiB;
constexpr size_t WS_SST = 243 * MiB;

__device__ __forceinline__ rk_bf16x8 rk_frag(const LAS unsigned char* base, int rs, int row, int s, int h) { return *(const LAS rk_bf16x8*)(base + row * rs + (16 * s + 8 * h) * 2); }
__device__ __forceinline__ rk_f32x16 rk_mfma(rk_bf16x8 a, rk_bf16x8 b, rk_f32x16 c) { return __builtin_amdgcn_mfma_f32_32x32x16_bf16(a, b, c, 0, 0, 0); }
__device__ __forceinline__ unsigned rk_pk(float lo, float hi) { typedef float f2_ __attribute__((ext_vector_type(2))); typedef __bf16 b2_ __attribute__((ext_vector_type(2))); f2_ v = {lo, hi}; b2_ b = __builtin_convertvector(v, b2_); return __builtin_bit_cast(unsigned, b); }
__device__ __forceinline__ void rk_store_tile_lds(LAS unsigned char* base, int rs, int nrow, int mbase, int h, const rk_f32x16& acc) {
#pragma unroll
    for (int g = 0; g < 4; ++g) { v2u w; w.x = rk_pk(acc[4 * g], acc[4 * g + 1]); w.y = rk_pk(acc[4 * g + 2], acc[4 * g + 3]); *(LAS v2u*)(base + nrow * rs + (mbase + 8 * g + 4 * h) * 2) = w; }
}
__device__ __forceinline__ void rk_store_tile_glb(bf16* base, int pitch, int nrow, int mbase, int h, const rk_f32x16& acc) {
#pragma unroll
    for (int g = 0; g < 4; ++g) { v2u w; w.x = rk_pk(acc[4 * g], acc[4 * g + 1]); w.y = rk_pk(acc[4 * g + 2], acc[4 * g + 3]); *(GAS v2u*)(base + (size_t)nrow * pitch + mbase + 8 * g + 4 * h) = w; }
}
__device__ __forceinline__ void rk_store_tile_frag(unsigned char* base, int nt, int r32, int mt, int h, const rk_f32x16& acc) {
#pragma unroll
    for (int g = 0; g < 4; ++g) { v2u w; w.x = rk_pk(acc[4 * g], acc[4 * g + 1]); w.y = rk_pk(acc[4 * g + 2], acc[4 * g + 3]);
        *(GAS v2u*)(base + ((size_t)((nt * 4 + 2 * mt + (g >> 1)) * 64 + r32 + 32 * (g & 1))) * 16 + 8 * h) = w; }
}
__device__ __forceinline__ void rk_store_blob(unsigned* blob, int lane, const rk_f32x16& acc) {
    v4u w0, w1; w0.x = rk_pk(acc[0], acc[1]); w0.y = rk_pk(acc[2], acc[3]); w0.z = rk_pk(acc[4], acc[5]); w0.w = rk_pk(acc[6], acc[7]);
    w1.x = rk_pk(acc[8], acc[9]); w1.y = rk_pk(acc[10], acc[11]); w1.z = rk_pk(acc[12], acc[13]); w1.w = rk_pk(acc[14], acc[15]);
    *(GAS v4u*)(blob + lane * 8) = w0; *(GAS v4u*)(blob + lane * 8 + 4) = w1;
}
struct RkBlob { v4u w0, w1; };
__device__ __forceinline__ RkBlob rk_load_blob(const unsigned* blob, int lane) { RkBlob b; b.w0 = *(const GAS v4u*)(blob + lane * 8); b.w1 = *(const GAS v4u*)(blob + lane * 8 + 4); return b; }
__device__ __forceinline__ rk_f32x16 rk_blob_f32(const RkBlob& b) {
    rk_f32x16 a; const unsigned w[8] = {b.w0.x, b.w0.y, b.w0.z, b.w0.w, b.w1.x, b.w1.y, b.w1.z, b.w1.w};
#pragma unroll
    for (int i = 0; i < 8; ++i) { a[2 * i] = bflo(w[i]); a[2 * i + 1] = bfhi(w[i]); }
    return a;
}

struct RkRaw { unsigned short r[8], k[8], v[8], a[8]; float d[8]; };
__device__ __forceinline__ void rk_load8(RkRaw& R, const bf16* prkv, const float* pdec, const bf16* paa) {
#pragma unroll
    for (int j = 0; j < 8; ++j) { R.r[j] = *(const GAS bf16*)(prkv + j * 1536); R.k[j] = *(const GAS bf16*)(prkv + j * 1536 + 512); R.v[j] = *(const GAS bf16*)(prkv + j * 1536 + 1024);
        R.d[j] = *(const GAS float*)(pdec + j * 512); R.a[j] = *(const GAS bf16*)(paa + j * 512); }
}
__device__ __forceinline__ void rwkvA_unit(LAS unsigned char* L, const InTab& A, unsigned char* ws, int bh, int chunk, int lane_in) {
    int lane = lane_in; asm volatile("" : "+v"(lane));
    const int b = bh >> 3, hd = bh & 7, cg = hd * 64 + lane, r32 = lane & 31, h = lane >> 5;
    const size_t row0 = (size_t)b * SEQ + (size_t)chunk * 32;
    const int uh = bh * 32 + (chunk & 31);
    const bf16* prkv = (const bf16*)(ws + WS_RKV) + row0 * 1536 + cg; const float* pdec = (const float*)(ws + WS_DEC) + row0 * 512 + cg; const bf16* paa = (const bf16*)(ws + WS_AA) + row0 * 512 + cg;
    float* pbon = (float*)(ws + WS_BON) + row0 * 8 + hd;
    const float mu_r = A[I_MU][cg], mu_k = A[I_MU][512 + cg], mu_v = A[I_MU][1024 + cg], kkc = A[I_KK][cg], kac = A[I_KA][cg], rkc = A[I_RK][cg];
    const int myv = (int)(red4(0.f, 1.f, 2.f, 3.f) * (1.0f / 64.0f) + 0.5f);
    const int L0 = __builtin_ctzll(__ballot(myv == 0)), L1 = __builtin_ctzll(__ballot(myv == 1)), L2 = __builtin_ctzll(__ballot(myv == 2)), L3 = __builtin_ctzll(__ballot(myv == 3));
    float rp = 0.f, kp = 0.f, vp = 0.f;
    if (chunk != 0) { rp = bf1(*(const GAS bf16*)(prkv - 1536)); kp = bf1(*(const GAS bf16*)(prkv - 1536 + 512)); vp = bf1(*(const GAS bf16*)(prkv - 1536 + 1024)); }
    float G = 1.0f;
    RkRaw Rc, Rn; rk_load8(Rc, prkv, pdec, paa);
#pragma unroll 1
    for (int q = 0; q < 4; ++q) {
        prkv += 8 * 1536; pdec += 8 * 512; paa += 8 * 512;
        if (q < 3) rk_load8(Rn, prkv, pdec, paa);
        LAS unsigned char* Lr = L + (8 * q) * RKA_RS_K + lane * 2;
        LAS unsigned char* Lt = L + lane * RKA_RS_J + (8 * q) * 2;
        unsigned tA[4], tB[4], tK[4], tV[4], pA = 0, pB = 0, pK = 0, pV = 0;
        float rs_[8], kx_[8], kkr_[8], a8_[8], w8_[8], vs_[8];
#pragma unroll
        for (int j = 0; j < 8; ++j) {
            const float rc = bf1(Rc.r[j]), kc = bf1(Rc.k[j]), vc = bf1(Rc.v[j]);
            const float ks = kc + (kp - kc) * mu_k; rs_[j] = rc + (rp - rc) * mu_r; vs_[j] = vc + (vp - vc) * mu_v; rp = rc; kp = kc; vp = vc;
            kkr_[j] = ks * kkc; a8_[j] = __builtin_amdgcn_rcpf(1.0f + __expf(-bf1(Rc.a[j]))); kx_[j] = ks * (1.0f + (a8_[j] - 1.0f) * kac);
            w8_[j] = __expf(-0.6065306597f * __builtin_amdgcn_rcpf(1.0f + __expf(-Rc.d[j])));
        }
        float n2_[8], bon_[8];
#pragma unroll
        for (int j = 0; j < 8; j += 2) {
            const float t = red4(kkr_[j] * kkr_[j], kkr_[j + 1] * kkr_[j + 1], rs_[j] * kx_[j] * rkc, rs_[j + 1] * kx_[j + 1] * rkc);
            n2_[j] = __builtin_bit_cast(float, __builtin_amdgcn_readlane(__builtin_bit_cast(int, t), L0)); n2_[j + 1] = __builtin_bit_cast(float, __builtin_amdgcn_readlane(__builtin_bit_cast(int, t), L1));
            bon_[j] = __builtin_bit_cast(float, __builtin_amdgcn_readlane(__builtin_bit_cast(int, t), L2)); bon_[j + 1] = __builtin_bit_cast(float, __builtin_amdgcn_readlane(__builtin_bit_cast(int, t), L3));
        }
        if (lane < 8) { float bv = bon_[0];
#pragma unroll
            for (int j = 1; j < 8; ++j) bv = (lane == j) ? bon_[j] : bv;
            *(GAS float*)(pbon + (8 * q + lane) * 8) = bv; }
#pragma unroll
        for (int j = 0; j < 8; ++j) {
            const float kk = kkr_[j] * __builtin_amdgcn_rsqf(__builtin_fmaxf(n2_[j], 1e-24f));
            const float Gprev = G; G *= w8_[j]; const float iG = __builtin_amdgcn_rcpf(G);
            const bf16 at = (bf16)f2bf(-kk * Gprev), rt = (bf16)f2bf(rs_[j] * G), bt = (bf16)f2bf(kk * a8_[j] * iG), kt = (bf16)f2bf(kx_[j] * iG), vb = (bf16)f2bf(vs_[j]);
            *(LAS bf16*)(Lr + RKA_A + j * RKA_RS_K) = at; *(LAS bf16*)(Lr + RKA_R + j * RKA_RS_K) = rt; *(LAS bf16*)(Lr + RKA_B + j * RKA_RS_K) = bt; *(LAS bf16*)(Lr + RKA_K + j * RKA_RS_K) = kt;
            if (j & 1) { tA[j >> 1] = pA | ((unsigned)at << 16); tB[j >> 1] = pB | ((unsigned)bt << 16); tK[j >> 1] = pK | ((unsigned)kt << 16); tV[j >> 1] = pV | ((unsigned)vb << 16); } else { pA = at; pB = bt; pK = kt; pV = vb; }
        }
        *(LAS v4u*)(Lt + RKA_AT) = (v4u){tA[0], tA[1], tA[2], tA[3]}; *(LAS v4u*)(Lt + RKA_BH) = (v4u){tB[0], tB[1], tB[2], tB[3]}; *(LAS v4u*)(Lt + RKA_KH) = (v4u){tK[0], tK[1], tK[2], tK[3]}; *(LAS v4u*)(Lt + RKA_VT) = (v4u){tV[0], tV[1], tV[2], tV[3]};
        Rc = Rn;
    }
    const float GC = G;
    *(GAS float*)((float*)(ws + WS_GC) + (size_t)uh * 64 + lane) = GC;
    *(LAS float*)(L + RKA_GC + lane * 4) = GC;
    LDS_WAIT(); asm volatile("" ::: "memory");
    {
        rk_f32x16 aN = {}, aAK = {}, aRB = {}, aRK = {};
#pragma unroll
        for (int s = 0; s < 4; ++s) {
            const rk_bf16x8 fA = rk_frag(L + RKA_A, RKA_RS_K, r32, s, h), fR = rk_frag(L + RKA_R, RKA_RS_K, r32, s, h), fB = rk_frag(L + RKA_B, RKA_RS_K, r32, s, h), fK = rk_frag(L + RKA_K, RKA_RS_K, r32, s, h);
            aN = rk_mfma(fB, fA, aN); aAK = rk_mfma(fK, fA, aAK); aRB = rk_mfma(fB, fR, aRB); aRK = rk_mfma(fK, fR, aRK);
        }
        LDS_WAIT(); asm volatile("" ::: "memory");
#pragma unroll
        for (int i = 0; i < 16; ++i) { const int j = (i & 3) + 8 * (i >> 2) + 4 * h;
            if (!(j < r32)) { aN[i] = 0.f; aAK[i] = 0.f; }
            if (!(j <= r32)) { aRB[i] = 0.f; aRK[i] = 0.f; } }
#pragma unroll
        for (int g = 0; g < 4; ++g) *(LAS f32x4*)(L + RKA_N + r32 * 144 + (8 * g + 4 * h) * 4) = (f32x4){aN[4 * g], aN[4 * g + 1], aN[4 * g + 2], aN[4 * g + 3]};
        rk_store_tile_lds(L + RKA_MAK, RKA_RS_J, r32, 0, h, aAK); rk_store_tile_lds(L + RKA_MRB, RKA_RS_J, r32, 0, h, aRB); rk_store_tile_lds(L + RKA_MRK, RKA_RS_J, r32, 0, h, aRK);
    }
    LDS_WAIT(); asm volatile("" ::: "memory");
    {
        float T[32];
#pragma unroll
        for (int t = 0; t < 32; ++t) { float acc = (r32 == t) ? 1.0f : 0.0f;
#pragma unroll
            for (int j4 = 0; j4 < (t + 3) / 4; ++j4) { const f32x4 n4 = *(const LAS f32x4*)(L + RKA_N + t * 144 + j4 * 16);
#pragma unroll
                for (int e = 0; e < 4; ++e) if (4 * j4 + e < t) acc += n4[e] * T[4 * j4 + e]; }
            T[t] = acc; }
        LDS_WAIT(); asm volatile("" ::: "memory");
#pragma unroll
        for (int t = 0; t < 32; ++t) *(LAS bf16*)(L + RKA_T + t * RKA_RS_J + r32 * 2) = (bf16)f2bf(T[t]);
    }
    LDS_WAIT(); asm volatile("" ::: "memory");
    rk_bf16x8 fT[2];
#pragma unroll
    for (int s = 0; s < 2; ++s) fT[s] = rk_frag(L + RKA_T, RKA_RS_J, r32, s, h);
    {
        rk_f32x16 x0[2] = {{}, {}}, ap[2] = {{}, {}};
#pragma unroll
        for (int s = 0; s < 2; ++s) { const rk_bf16x8 fM = rk_frag(L + RKA_MAK, RKA_RS_J, r32, s, h);
#pragma unroll
            for (int nt = 0; nt < 2; ++nt) { x0[nt] = rk_mfma(fM, rk_frag(L + RKA_VT, RKA_RS_J, nt * 32 + r32, s, h), x0[nt]); ap[nt] = rk_mfma(fT[s], rk_frag(L + RKA_AT, RKA_RS_J, nt * 32 + r32, s, h), ap[nt]); } }
        LDS_WAIT(); asm volatile("" ::: "memory");
#pragma unroll
        for (int nt = 0; nt < 2; ++nt) { rk_store_tile_lds(L + RKA_X, RKA_RS_J, nt * 32 + r32, 0, h, x0[nt]); rk_store_tile_lds(L + RKA_AT, RKA_RS_J, nt * 32 + r32, 0, h, ap[nt]); }
    }
    LDS_WAIT(); asm volatile("" ::: "memory");
    {
        rk_f32x16 u0[2] = {{}, {}};
#pragma unroll
        for (int s = 0; s < 2; ++s)
#pragma unroll
            for (int nt = 0; nt < 2; ++nt) u0[nt] = rk_mfma(fT[s], rk_frag(L + RKA_X, RKA_RS_J, nt * 32 + r32, s, h), u0[nt]);
        LDS_WAIT(); asm volatile("" ::: "memory");
#pragma unroll
        for (int nt = 0; nt < 2; ++nt) rk_store_tile_lds(L + RKA_X, RKA_RS_J, nt * 32 + r32, 0, h, u0[nt]);
    }
    LDS_WAIT(); asm volatile("" ::: "memory");
    unsigned char* pq = ws + WS_PQ + (size_t)uh * 16384; unsigned char* ry = ws + WS_RY + (size_t)uh * 8192;
    rk_bf16x8 fRB[2], fRK[2], fAp[2][2], fBh[2][2], fKh[2][2], fU[2][2], fV[2][2];
#pragma unroll
    for (int s = 0; s < 2; ++s) { fRB[s] = rk_frag(L + RKA_MRB, RKA_RS_J, r32, s, h); fRK[s] = rk_frag(L + RKA_MRK, RKA_RS_J, r32, s, h);
#pragma unroll
        for (int nt = 0; nt < 2; ++nt) { fAp[nt][s] = rk_frag(L + RKA_AT, RKA_RS_J, nt * 32 + r32, s, h); fBh[nt][s] = rk_frag(L + RKA_BH, RKA_RS_J, nt * 32 + r32, s, h);
            fKh[nt][s] = rk_frag(L + RKA_KH, RKA_RS_J, nt * 32 + r32, s, h); fU[nt][s] = rk_frag(L + RKA_X, RKA_RS_J, nt * 32 + r32, s, h); fV[nt][s] = rk_frag(L + RKA_VT, RKA_RS_J, nt * 32 + r32, s, h); } }
#pragma unroll
    for (int kt = 0; kt < 2; ++kt) {
        rk_f32x16 acc;
#pragma unroll
        for (int g = 0; g < 4; ++g) { const v2u w = *(const LAS v2u*)(L + RKA_R + r32 * RKA_RS_K + (kt * 32 + 8 * g + 4 * h) * 2); acc[4 * g] = bflo(w.x); acc[4 * g + 1] = bfhi(w.x); acc[4 * g + 2] = bflo(w.y); acc[4 * g + 3] = bfhi(w.y); }
#pragma unroll
        for (int s = 0; s < 2; ++s) acc = rk_mfma(fAp[kt][s], fRB[s], acc);
        rk_store_tile_frag(ry, 0, r32, kt, h, acc);
    }
#pragma unroll
    for (int kt = 0; kt < 2; ++kt)
#pragma unroll
        for (int kq = 0; kq < 2; ++kq) { rk_f32x16 acc = {};
#pragma unroll
            for (int s = 0; s < 2; ++s) acc = rk_mfma(fAp[kq][s], fBh[kt][s], acc);
            acc = acc * *(const LAS float*)(L + RKA_GC + (kt * 32 + r32) * 4);
            rk_store_tile_frag(pq, kt, r32, kq, h, acc); }
#pragma unroll
    for (int vt = 0; vt < 2; ++vt) {
        rk_f32x16 acc = {};
#pragma unroll
        for (int s = 0; s < 2; ++s) { acc = rk_mfma(fU[vt][s], fRB[s], acc); acc = rk_mfma(fV[vt][s], fRK[s], acc); }
        rk_store_blob((unsigned*)(ry + 4096) + vt * 512, lane, acc);
    }
#pragma unroll
    for (int kt = 0; kt < 2; ++kt)
#pragma unroll
        for (int vt = 0; vt < 2; ++vt) { rk_f32x16 acc = {};
#pragma unroll
            for (int s = 0; s < 2; ++s) { acc = rk_mfma(fBh[kt][s], fU[vt][s], acc); acc = rk_mfma(fKh[kt][s], fV[vt][s], acc); }
#pragma unroll
            for (int g = 0; g < 4; ++g) { const f32x4 gq = *(const LAS f32x4*)(L + RKA_GC + (kt * 32 + 8 * g + 4 * h) * 4); acc[4 * g] *= gq[0]; acc[4 * g + 1] *= gq[1]; acc[4 * g + 2] *= gq[2]; acc[4 * g + 3] *= gq[3]; }
            rk_store_blob((unsigned*)(pq + 8192) + (kt * 2 + vt) * 512, lane, acc); }
    LDS_WAIT(); asm volatile("" ::: "memory");
}
__device__ __forceinline__ void rwkvA_phase(Frame& F, const InTab& A, int half) {
    if (F.wave >= RKA_WAVES) return;
    LAS unsigned char* L = F.lds + RING_OFF + F.wave * RKA_BYTES;
    const int gw = F.bx * RKA_WAVES + F.wave, NGW = F.G * RKA_WAVES;
    for (int u = gw; u < 64 * 32; u += NGW) rwkvA_unit(L, A, F.ws, u >> 5, half * 32 + (u & 31), F.lane);
}
constexpr int RKB_RS = 144, RKB_SBUF = 64 * RKB_RS;
__device__ __forceinline__ void rwkvB_phase(Frame& F, int bh, int half) {
    int lane = F.lane; asm volatile("" : "+v"(lane));
    const int wave = F.wave, r32 = lane & 31, h = lane >> 5;
    LAS unsigned char* SB = F.lds + RING_OFF;
    unsigned char* ws = F.ws;
    const int b = bh >> 3, hd = bh & 7;
    bf16* Y = (bf16*)(ws + WS_Y);
    const int kt = (wave >> 1) & 1, vt = wave & 1;
    float* sst = (float*)(ws + WS_SST) + (size_t)bh * 4096 + (size_t)(wave & 3) * 1024;
    rk_f32x16 st = {};
    if (wave < 4) {
        if (half != 0) {
#pragma unroll
            for (int i = 0; i < 16; ++i) st[i] = *(const GAS float*)(sst + i * 64 + lane);
        }
        rk_store_tile_lds(SB, RKB_RS, vt * 32 + r32, kt * 32, h, st);
    }
    const int uh0 = bh * 32; const bool isS = wave < 4, isY = !isS && wave < 6;
    const unsigned char* fptr = isS ? ws + WS_PQ + (size_t)uh0 * 16384 + (kt * 256 + lane) * 16 : ws + WS_RY + (size_t)uh0 * 8192 + lane * 16;
    const unsigned char* bptr = isS ? ws + WS_PQ + (size_t)uh0 * 16384 + 8192 + (kt * 2 + vt) * 2048 + lane * 32 : ws + WS_RY + (size_t)uh0 * 8192 + 4096 + vt * 2048 + lane * 32;
    const LAS unsigned char* gl = SB + 2 * RKB_SBUF + (kt * 32 + 4 * h) * 4;
    const int fstride = isS ? 16384 : 8192;
    struct Op { v4u f[4]; v4u b0, b1; };
    { const int tid_ = wave * 64 + lane; *(LAS f32x4*)(SB + 2 * RKB_SBUF + tid_ * 16) = *(const GAS f32x4*)(ws + WS_GC + (size_t)uh0 * 256 + tid_ * 16); }
    Op o0, o1, o2;
#define RKB_LOAD(O_, c) do { const unsigned char* fp_ = fptr + (size_t)(c) * fstride; const unsigned char* bp_ = bptr + (size_t)(c) * fstride; \
        _Pragma("unroll") for (int s = 0; s < 4; ++s) O_.f[s] = *(const GAS v4u*)(fp_ + 1024 * s); \
        O_.b0 = *(const GAS v4u*)bp_; O_.b1 = *(const GAS v4u*)(bp_ + 16); } while (0)
#define RKB_BAR() do { asm volatile("s_waitcnt lgkmcnt(0)" ::: "memory"); __builtin_amdgcn_s_barrier(); asm volatile("" ::: "memory"); } while (0)
#define RKB_NEXT(O_, c, AH_) RKB_LOAD(O_, ((c) + (AH_) < 32 ? (c) + (AH_) : 31))
#define RKB_STEP_S(O_, c) do { \
        const LAS unsigned char* cur = SB + ((c) & 1) * RKB_SBUF; LAS unsigned char* nxt = SB + (((c) & 1) ^ 1) * RKB_SBUF; \
        rk_bf16x8 fS[4]; _Pragma("unroll") for (int s = 0; s < 4; ++s) fS[s] = rk_frag(cur, RKB_RS, vt * 32 + r32, s, h); \
        RkBlob bb_; bb_.w0 = O_.b0; bb_.w1 = O_.b1; const rk_f32x16 q = rk_blob_f32(bb_); \
        _Pragma("unroll") for (int g = 0; g < 4; ++g) { const f32x4 gq = *(const LAS f32x4*)(gl + (c) * 256 + 32 * g); \
            st[4 * g] = st[4 * g] * gq[0] + q[4 * g]; st[4 * g + 1] = st[4 * g + 1] * gq[1] + q[4 * g + 1]; st[4 * g + 2] = st[4 * g + 2] * gq[2] + q[4 * g + 2]; st[4 * g + 3] = st[4 * g + 3] * gq[3] + q[4 * g + 3]; } \
        _Pragma("unroll") for (int s = 0; s < 4; ++s) st = rk_mfma(__builtin_bit_cast(rk_bf16x8, O_.f[s]), fS[s], st); \
        RKB_NEXT(O_, c, 5); \
        rk_store_tile_lds(nxt, RKB_RS, vt * 32 + r32, kt * 32, h, st); \
        RKB_BAR(); } while (0)
#define RKB_STEP_Y(O_, c) do { \
        const LAS unsigned char* cur = SB + ((c) & 1) * RKB_SBUF; \
        rk_bf16x8 fS[4]; _Pragma("unroll") for (int s = 0; s < 4; ++s) fS[s] = rk_frag(cur, RKB_RS, vt * 32 + r32, s, h); \
        RkBlob bb_; bb_.w0 = O_.b0; bb_.w1 = O_.b1; rk_f32x16 acc = rk_blob_f32(bb_); \
        _Pragma("unroll") for (int s = 0; s < 4; ++s) acc = rk_mfma(fS[s], __builtin_bit_cast(rk_bf16x8, O_.f[s]), acc);       \
        RKB_NEXT(O_, c, 3); \
        rk_store_tile_glb(Y + ((size_t)b * SEQ + (size_t)(half * 32 + (c)) * 32) * 512 + hd * 64, 512, r32, vt * 32, h, acc); \
        RKB_BAR(); } while (0)
    if (isY) { RKB_LOAD(o0, 0); RKB_LOAD(o1, 1); RKB_LOAD(o2, 2); }
    __syncthreads();
    if (isS) {
        Op o3, o4; RKB_LOAD(o0, 0); RKB_LOAD(o1, 1); RKB_LOAD(o2, 2); RKB_LOAD(o3, 3); RKB_LOAD(o4, 4);
#define R5S(c) RKB_STEP_S(o0, c); RKB_STEP_S(o1, (c) + 1); RKB_STEP_S(o2, (c) + 2); RKB_STEP_S(o3, (c) + 3); RKB_STEP_S(o4, (c) + 4);
        R5S(0) R5S(5) R5S(10) R5S(15) R5S(20) R5S(25)
        RKB_STEP_S(o0, 30); RKB_STEP_S(o1, 31);
#undef R5S
    } else if (isY) {
#define R3Y(c) RKB_STEP_Y(o0, c); RKB_STEP_Y(o1, (c) + 1); RKB_STEP_Y(o2, (c) + 2);
        R3Y(0) R3Y(3) R3Y(6) R3Y(9) R3Y(12) R3Y(15) R3Y(18) R3Y(21) R3Y(24) R3Y(27)
        RKB_STEP_Y(o0, 30); RKB_STEP_Y(o1, 31);
#undef R3Y
    } else {
#pragma unroll 1
        for (int c = 0; c < 32; ++c) RKB_BAR();
    }
#undef RKB_STEP_S
#undef RKB_STEP_Y
#undef RKB_NEXT
#undef RKB_BAR
#undef RKB_LOAD
    if (wave < 4 && half == 0) {
#pragma unroll
        for (int i = 0; i < 16; ++i) *(GAS float*)(sst + i * 64 + lane) = st[i];
    }
}

constexpr int NPHASE = 11;
template <int PHM> __global__ void __launch_bounds__(NWAVES * 64, 2) fwd_kernel(Args args) {
    extern __shared__ __attribute__((aligned(16))) unsigned char lds[];
    namespace cg = cooperative_groups;
    Frame F;
    F.lds = (LAS unsigned char*)lds;
    F.tid = threadIdx.x; F.lane = F.tid & 63; F.wave = __builtin_amdgcn_readfirstlane(F.tid >> 6);
    F.G = gridDim.x; F.bx = blockIdx.x;
    F.out = args.out; F.ws = args.ws;
#define PH_BEGIN InTab TAB; { ktab_t kp_ = (ktab_t)__builtin_amdgcn_kernarg_segment_ptr(); asm volatile("" : "+s"(kp_)); TAB.p = kp_; } { int t_ = threadIdx.x; asm volatile("" : "+v"(t_)); F.tid = t_; F.lane = t_ & 63; F.wave = __builtin_amdgcn_readfirstlane(t_ >> 6); } GAS unsigned char* wsg_ = (GAS unsigned char*)args.ws; asm volatile("" : "+s"(wsg_)); unsigned char* ws = (unsigned char*)wsg_; F.ws = ws; GAS bf16_t* gtg_ = (GAS bf16_t*)args.out; asm volatile("" : "+s"(gtg_)); bf16_t* GATES = (bf16_t*)gtg_; F.out = (float*)GATES; (void)GATES;
    const int lo = args.ph_lo, hi = args.ph_hi;
    XcdBarrier bar; bar.bar = nullptr; bar.x = 0; bar.st = nullptr;
    if (hi - lo > 1) {
        for (int u = threadIdx.x; u < (LDS_BYTES - 162816) / 4; u += NWAVES * 64) ((LAS unsigned*)(F.lds + 162816))[u] = 0u;
        { GAS v4u* z_ = (GAS v4u*)(args.ws + WS_CTL) + (size_t)blockIdx.x * (CTL_ZERO_BYTES / 16 / 256); for (int u = threadIdx.x; u < (int)(CTL_ZERO_BYTES / 16 / 256); u += NWAVES * 64) z_[u] = (v4u){0u, 0u, 0u, 0u}; }
        asm volatile("s_waitcnt vmcnt(0)" ::: "memory");
        __syncthreads();
        cg::this_grid().sync();
        bar = xcd_barrier_post((unsigned*)(args.ws + WS_CTL) + CW_BAR, (volatile LAS unsigned*)(F.lds + MISC_OFF) + 8);
    }
#define IN(k) (((PHM >> (k)) & 1) && lo <= (k) && (k) < hi)
#ifdef PROBE_DUP
#define REPS(k) (((k) == PROBE_DUP) ? 2 : 1)
#else
#define REPS(k) 1
#endif
#define SEAM(k) do { if (IN(k) && IN((k) + 1)) { xcd_barrier(bar); } } while (0)
    using pg8::Gemm; using pg8::StaticOrder; using pg8::EpiRow8; using pg8::bf16_t;

    if (IN(0)) for (int rep_ = 0; rep_ < REPS(0); ++rep_) { if (rep_) xcd_barrier(bar); PH_BEGIN p0_prologue(F, TAB); } SEAM(0);
    if (IN(1)) for (int rep_ = 0; rep_ < REPS(1); ++rep_) { if (rep_) xcd_barrier(bar); PH_BEGIN
        Gemm g{(const bf16_t*)(ws + WS_XN), (const bf16_t*)(ws + WS_WIN), M, D_IN, D}; StaticOrder S; S.init(M, D_IN, F.G, F.bx);
        EpiRow8<pg8::FProj> E{{ws, GATES}};
        pg8::gemm_phase<EpiRow8<pg8::FProj>, StaticOrder, PG8_ALIGN, PG8_SP2>(F.lds + RING_OFF, g, S, E);
    } SEAM(1);
    if (IN(2)) for (int rep_ = 0; rep_ < REPS(2); ++rep_) { if (rep_) xcd_barrier(bar); PH_BEGIN prep1_phase(F, TAB); } SEAM(2);
    if (IN(3)) for (int rep_ = 0; rep_ < REPS(3); ++rep_) { if (rep_) xcd_barrier(bar); PH_BEGIN
        int klora = KLORA; asm volatile("" : "+s"(klora));
        Gemm g{(const bf16_t*)(ws + WS_LIN), (const bf16_t*)(ws + WS_WL), M, NLORA, klora}; StaticOrder S; S.init(M, NLORA, F.G, F.bx);
        EpiRow8<pg8::FLora> E{{ws, TAB[I_W0], TAB[I_A0]}};
        pg8::gemm_phase<EpiRow8<pg8::FLora>, StaticOrder, PG8_ALIGN, PG8_SP2>(F.lds + RING_OFF, g, S, E);
    } SEAM(3);
    if (IN(4)) for (int rep_ = 0; rep_ < REPS(4); ++rep_) { if (rep_) xcd_barrier(bar); PH_BEGIN
        const attn_body::AttnTensors AT{(const attn_body::bf16*)(ws + WS_Q), (const attn_body::bf16*)(ws + WS_K), (const attn_body::bf16*)(ws + WS_V), (attn_body::bf16*)(ws + WS_O)};
        const attn_body::StaticOrder S(F.bx, F.G);
        attn_body::attn_phase<attn_body::StaticOrder>((char*)lds + RING_OFF, AT, S);
    } SEAM(4);
    if (IN(5)) for (int rep_ = 0; rep_ < REPS(5); ++rep_) { if (rep_) xcd_barrier(bar); PH_BEGIN
#pragma unroll 1
        for (int half = 0; half < 2; ++half) {
            { GAS unsigned char* w_ = (GAS unsigned char*)args.ws; asm volatile("" : "+s"(w_)); F.ws = (unsigned char*)w_; }
            rwkvA_phase(F, TAB, half);
#ifdef PROBE_DUP_RKA
            rwkvA_phase(F, TAB, half);
#endif
            xcd_barrier(bar);
            { GAS unsigned char* w_ = (GAS unsigned char*)args.ws; asm volatile("" : "+s"(w_)); F.ws = (unsigned char*)w_; }
            if (F.bx < 64) rwkvB_phase(F, F.bx, half); else late_weights(F, TAB, half, 2, 64);
#ifdef PROBE_DUP_RKB
            if (F.bx < 64) rwkvB_phase(F, F.bx, half);
#endif
            if (half == 0) xcd_barrier(bar);
        }
    } SEAM(5);
#ifdef PROBE_BARS
    for (int pb_ = 0; pb_ < PROBE_BARS; ++pb_) xcd_barrier(bar);
#endif
    if (IN(6)) for (int rep_ = 0; rep_ < REPS(6); ++rep_) { if (rep_) xcd_barrier(bar); PH_BEGIN post_phase(F, TAB); } SEAM(6);
    if (IN(7)) for (int rep_ = 0; rep_ < REPS(7); ++rep_) { if (rep_) xcd_barrier(bar); PH_BEGIN
        Gemm g{(const bf16_t*)(ws + WS_YA), (const bf16_t*)(ws + WS_WA), M, D, 1024}; StaticOrder S; S.init(M, D, F.G, F.bx);
        pg8::EpiMerge E{GATES, (bf16_t*)(ws + WS_MERGED)};
        pg8::gemm_phase<pg8::EpiMerge, StaticOrder, PG8_ALIGN, PG8_SP2>(F.lds + RING_OFF, g, S, E);
    } SEAM(7);
    if (IN(8)) for (int rep_ = 0; rep_ < REPS(8); ++rep_) { if (rep_) xcd_barrier(bar); PH_BEGIN
        Gemm g{(const bf16_t*)(ws + WS_MERGED), (const bf16_t*)(ws + WS_WO), M, D, D}; StaticOrder S; S.init(M, D, F.G, F.bx);
        pg8::EpiResNorm<0> E{TAB[I_X], F.out, (bf16_t*)(ws + WS_XN), TAB[I_NFG], (float*)(ws + WS_CTL + CTL_SS1), (unsigned*)(ws + WS_CTL + CTL_CNT1), NORM_EPS};
        pg8::gemm_phase<pg8::EpiResNorm<0>, StaticOrder, PG8_ALIGN, PG8_SP2>(F.lds + RING_OFF, g, S, E);
    } SEAM(8);
    if (IN(9)) for (int rep_ = 0; rep_ < REPS(9); ++rep_) { if (rep_) xcd_barrier(bar); PH_BEGIN
        Gemm g{(const bf16_t*)(ws + WS_XN), (const bf16_t*)(ws + WS_W1), M, FF, D}; StaticOrder S; S.init(M, FF, F.G, F.bx);
        EpiRow8<pg8::FRelu2> E{{(bf16_t*)(ws + WS_H)}};
        pg8::gemm_phase<EpiRow8<pg8::FRelu2>, StaticOrder, PG8_ALIGN, PG8_SP2>(F.lds + RING_OFF, g, S, E);
    } SEAM(9);
    if (IN(10)) for (int rep_ = 0; rep_ < REPS(10); ++rep_) { if (rep_) xcd_barrier(bar); PH_BEGIN
        Gemm g{(const bf16_t*)(ws + WS_H), (const bf16_t*)(ws + WS_W2), M, D, FF}; StaticOrder S; S.init(M, D, F.G, F.bx);
        pg8::EpiResNorm<1> E{F.out, F.out, nullptr, TAB[I_NFIN], (float*)(ws + WS_CTL + CTL_SS2), (unsigned*)(ws + WS_CTL + CTL_CNT2), NORM_EPS};
        pg8::gemm_phase<pg8::EpiResNorm<1>, StaticOrder, PG8_ALIGN, PG8_SP2>(F.lds + RING_OFF, g, S, E);
    }
#undef IN
#undef SEAM
#undef PH_BEGIN
}


#ifdef DBG_DUMP
__global__ void dbg_dump(float* out, const unsigned char* ws) {
    const size_t i = (size_t)blockIdx.x * blockDim.x + threadIdx.x; if (i >= (size_t)M * 1024) return;
    const size_t m = i >> 10; const int c = (int)(i & 1023); float v = 0.f;
#if DBG_DUMP == 1
    v = bf1(((const bf16*)(ws + WS_O))[m * 1024 + c]);
#elif DBG_DUMP == 2
    v = c < 512 ? bf1(((const bf16*)(ws + WS_Y))[m * 512 + c]) : (c < 520 ? ((const float*)(ws + WS_BON))[m * 8 + (c - 512)] : 0.f);
#elif DBG_DUMP == 3
    v = c < 512 ? bf1(((const bf16*)(ws + WS_Q))[m * 512 + c]) : bf1(((const bf16*)(ws + WS_K))[m * 512 + c - 512]);
#elif DBG_DUMP == 4
    v = c < 512 ? ((const float*)(ws + WS_DEC))[m * 512 + c] : bf1(((const bf16*)(ws + WS_AA))[m * 512 + c - 512]);
#elif DBG_DUMP == 6
    v = c < 256 ? bf1(((const bf16*)(ws + WS_WAG))[m * 256 + c]) : (c < 512 ? bf1(((const bf16*)(ws + WS_LIN))[m * 256 + c - 256]) : 0.f);
#elif DBG_DUMP == 7
    { const bf16* wl = (const bf16*)(ws + WS_WL); const size_t j = (m * 1024 + c); v = j < (size_t)NLORA * KLORA ? bf1(wl[j]) : 0.f; }
#elif DBG_DUMP == 8
    v = c < 512 ? bf1(((const bf16*)(ws + WS_GG))[m * 512 + c]) : 0.f;
#elif DBG_DUMP == 5
    v = bf1(((const bf16*)(ws + WS_RKV))[m * 1536 + c]);
#endif
    out[i] = v;
}
#endif

#ifdef DBG_FIXLORA
__global__ void dbg_fixlora(Args A) {
    const size_t i = (size_t)blockIdx.x * blockDim.x + threadIdx.x; if (i >= (size_t)M * 512) return;
    const size_t m = i >> 9; const int c = (int)(i & 511);
    const bf16* LINr = (const bf16*)(A.ws + WS_LIN) + m * 256;
#if DBG_FIXLORA & 1
    { float g = 0.f; for (int k = 0; k < 128; ++k) g += bf1(LINr[128 + k]) * A[I_G2][(size_t)k * 512 + c]; ((bf16*)(A.ws + WS_GG))[m * 512 + c] = (bf16)f2bf(g); }
#endif
#if DBG_FIXLORA & 2
    { float s = A[I_A0][c]; for (int k = 0; k < 64; ++k) s += bf1(LINr[64 + k]) * A[I_A2][(size_t)k * 512 + c]; ((bf16*)(A.ws + WS_AA))[m * 512 + c] = (bf16)f2bf(1.0f / (1.0f + expf(-s))); }
#endif
#if DBG_FIXLORA & 4
    { float s = A[I_W0][c]; for (int k = 0; k < 64; ++k) s += bf1(LINr[k]) * A[I_W2][(size_t)k * 512 + c]; const float w = -log1pf(expf(-s)) - 0.5f; ((float*)(A.ws + WS_DEC))[m * 512 + c] = expf(-expf(w)); }
#endif
}
#endif
#ifndef MK_ONE_LAUNCH
#define MK_ONE_LAUNCH 0
#endif
#ifndef MK_MASK
#define MK_MASK ((1 << NPHASE) - 1)
#endif
typedef void (*kern_t)(Args);
template <int P> struct KTab { static void fill(kern_t* t) { t[P] = fwd_kernel<(1 << P)>; KTab<P - 1>::fill(t); } };
template <> struct KTab<-1> { static void fill(kern_t*) {} };
extern "C" void kernel_launch(void* const* d_in, const int* in_sizes, int n_in, void* d_out, int out_size, void* d_ws, size_t ws_size, hipStream_t stream) {
    static int grid = 0; static kern_t ktab[NPHASE];
    if (grid == 0) {
        if (n_in != 26 || in_sizes[0] != M * D || out_size != M * D || ws_size < WS_END) { fprintf(stderr, "kernel_launch: unexpected shapes (n_in %d, in0 %d, out %d, ws %zu); nothing launched\n", n_in, n_in > 0 ? in_sizes[0] : -1, out_size, ws_size); grid = -1; return; }
        int dev = 0, cus = 0;
        if (hipGetDevice(&dev) != hipSuccess || hipDeviceGetAttribute(&cus, hipDeviceAttributeMultiprocessorCount, dev) != hipSuccess) { grid = -1; return; }
#if MK_ONE_LAUNCH
        int per_cu = 0;
        if (hipFuncSetAttribute((const void*)fwd_kernel<MK_MASK>, hipFuncAttributeMaxDynamicSharedMemorySize, LDS_BYTES) != hipSuccess) { fprintf(stderr, "kernel_launch: hipFuncSetAttribute failed\n"); grid = -1; return; }
        if (hipOccupancyMaxActiveBlocksPerMultiprocessor(&per_cu, (const void*)fwd_kernel<MK_MASK>, NWAVES * 64, LDS_BYTES) != hipSuccess || per_cu < 1) { fprintf(stderr, "kernel_launch: occupancy query says %d blocks per CU\n", per_cu); (void)hipGetLastError(); grid = -1; return; }
#else
        KTab<NPHASE - 1>::fill(ktab);
        for (int p = 0; p < NPHASE; ++p) if (hipFuncSetAttribute((const void*)ktab[p], hipFuncAttributeMaxDynamicSharedMemorySize, LDS_BYTES) != hipSuccess) { fprintf(stderr, "kernel_launch: hipFuncSetAttribute failed\n"); grid = -1; return; }
#endif
        grid = cus;
        if (grid != 256) fprintf(stderr, "kernel_launch: note: %d CUs (built for 256)\n", grid);
    }
    if (grid < 0) return;
    Args a{};
    for (int i = 0; i < 26; ++i) a.in[i] = (const float*)d_in[i];
    a.out = (float*)d_out; a.ws = (unsigned char*)d_ws;
#if MK_ONE_LAUNCH
    a.ph_lo = 0; a.ph_hi = NPHASE;
    void* kargs[] = {&a};
    hipError_t e = hipLaunchCooperativeKernel((const void*)fwd_kernel<MK_MASK>, dim3(grid), dim3(NWAVES * 64), kargs, LDS_BYTES, stream);
    if (e != hipSuccess) fprintf(stderr, "kernel_launch: cooperative launch failed: %s\n", hipGetErrorString(e));
#else
#ifdef DBG_DUMP
    for (int p = 0; p <= DBG_STOP; ++p) { a.ph_lo = p; a.ph_hi = p + 1; hipLaunchKernelGGL(ktab[p], dim3(grid), dim3(NWAVES * 64), LDS_BYTES, stream, a); }
    hipLaunchKernelGGL(dbg_dump, dim3((M * 1024) / 256), dim3(256), 0, stream, (float*)d_out, (const unsigned char*)d_ws);
#else
    for (int p = 0; p < NPHASE; ++p) { a.ph_lo = p; a.ph_hi = p + 1; hipLaunchKernelGGL(ktab[p], dim3(grid), dim3(NWAVES * 64), LDS_BYTES, stream, a);
#ifdef DBG_FIXLORA
        if (p == 3) hipLaunchKernelGGL(dbg_fixlora, dim3((M * 512) / 256), dim3(256), 0, stream, a);
#endif
    }
#endif
#endif
}
```

```cpp
#define MK_ONE_LAUNCH 1
#include <hip/hip_runtime.h>
#include <cstdio>
#include <cstdint>
constexpr int NWAVES = 8;
constexpr int BATCH = 8, SEQ = 2048, D = 1024, M = BATCH * SEQ;
constexpr int D_IN = 5376, FF = 4096, RWW = 512, NLORA = 1536, KLORA = 256;
constexpr float NORM_EPS = 1e-6f, SUBLN_EPS = 1e-5f, GN_EPS = 64e-5f, LAMBDA_INIT = 0.2f;
constexpr size_t MiB = 1u << 20;
constexpr size_t WS_CTL = 0, CTL_ZERO_BYTES = 256 * 1024;
constexpr size_t CTL_SS1 = 65536, CTL_SS2 = 131072, CTL_CNT1 = 196608, CTL_CNT2 = 212992;
constexpr size_t WS_ROPE_C = 512 * 1024, WS_ROPE_S = 768 * 1024;
constexpr size_t WS_BON = 1 * MiB;
constexpr size_t WS_WIN = 2 * MiB;
constexpr size_t WS_WA = WS_WIN + (size_t)D_IN * D * 2;
constexpr size_t WS_WB = WS_WA + 1 * MiB;
constexpr size_t WS_WO = WS_WB + 1 * MiB;
constexpr size_t WS_W1 = WS_WO + 2 * MiB;
constexpr size_t WS_W2 = WS_W1 + 8 * MiB;
constexpr size_t WS_WL = WS_W2 + 8 * MiB;
static_assert(WS_WL + (size_t)NLORA * KLORA * 2 <= 34 * MiB, "weights");
constexpr size_t WS_XN = 34 * MiB;
constexpr size_t WS_DEC = WS_XN;
constexpr size_t WS_Q = 66 * MiB, WS_K = 82 * MiB, WS_V = 98 * MiB;
constexpr size_t WS_RKV = 114 * MiB;
constexpr size_t WS_WAG = 162 * MiB, WS_LIN = 170 * MiB;
constexpr size_t WS_Y = 162 * MiB;
constexpr size_t WS_AA = 178 * MiB, WS_GG = 194 * MiB;
constexpr size_t WS_O = 210 * MiB;
constexpr size_t WS_YA = 66 * MiB, WS_YB = 82 * MiB;
constexpr size_t WS_TMP = 114 * MiB;
constexpr size_t WS_MERGED = 114 * MiB;
constexpr size_t WS_X1B = 194 * MiB;
constexpr size_t WS_H = 66 * MiB;
constexpr size_t WS_END = 244 * MiB;
constexpr int RING_OFF = 0, RING_BYTES = 131072;
constexpr int LDS_BYTES = 163840;

#include <hip/hip_runtime.h>
#include <cstdio>
#include <cstdint>
namespace pg8 {
#define PG8_LAS __attribute__((address_space(3)))
typedef unsigned short bf16_t;
typedef short bf16x8 __attribute__((ext_vector_type(8)));
typedef float f32x4 __attribute__((ext_vector_type(4)));
typedef unsigned u32x4 __attribute__((ext_vector_type(4)));
constexpr int BM = 256, BK = 64, HALF = 128, HTB = HALF * BK * 2  , STAGE_BYTES = 8 * HTB, NXCD = 8, WGM = 8;

__host__ __device__ __forceinline__ int lds_byte(int r, int c) { const int st = (r >> 4) * 2 + (c >> 5), rr = r & 15, cc = c & 31, ob = rr * 64 + cc * 2; return st * 1024 + (ob ^ (((ob >> 9) & 1) << 5)); }
__host__ __device__ __forceinline__ void stage_rc(int b, int& R, int& C) { const int st = b / 1024, sb = b % 1024, swz = sb ^ (((sb >> 9) & 1) << 5); R = (st >> 1) * 16 + swz / 64; C = (st & 1) * 32 + (swz % 64) / 2; }
__host__ __device__ __forceinline__ int perm32(int rho) { const int n = rho >> 4, i = rho & 15; return 8 * (i >> 2) + 4 * n + (i & 3); }

struct Unit { int pm, pn; };
struct Gemm { const bf16_t* A; const bf16_t* Bt; int M, N, K; };

struct StaticOrder {
    int nM, nN, nwg, G, c;
    __host__ __device__ void init(int M, int N, int G_, int c_) { nM = M / BM; nN = N / BM; nwg = nM * nN; G = G_; c = c_; }
    __host__ __device__ bool next(int i, Unit& u) const {
        const long L = (long)i * G + c; if (L >= nwg) return false;
        int wgid = (int)L; { const int q = nwg / NXCD, r = nwg % NXCD, xcd = wgid % NXCD, off = wgid / NXCD; wgid = (xcd < r ? xcd * (q + 1) : r * (q + 1) + (xcd - r) * q) + off; }
        const int nig = WGM * nN, gid = wgid / nig, fm = gid * WGM, gsz = (nM - fm) < WGM ? (nM - fm) : WGM;
        u.pm = fm + ((wgid % nig) % gsz); u.pn = (wgid % nig) / gsz; return true;
    }
    __device__ __forceinline__ void a_ready(const Unit&) const {}
    __device__ __forceinline__ void done(const Unit&) const {}
};

typedef float f32x2c_t __attribute__((ext_vector_type(2))); typedef __bf16 bf16x2c_t __attribute__((ext_vector_type(2)));
__device__ __forceinline__ unsigned cvt_pk_bf16(float lo, float hi) { f32x2c_t v = {lo, hi}; bf16x2c_t b = __builtin_convertvector(v, bf16x2c_t); return __builtin_bit_cast(unsigned, b); }
typedef float f32x2 __attribute__((ext_vector_type(2)));
__device__ __forceinline__ f32x2 gelu_pk(f32x2 v) {
    const f32x2 av = __builtin_elementwise_abs(v), d = av * 0.2316418882f + 1.0f;
    f32x2 t; t.x = __builtin_amdgcn_rcpf(d.x); t.y = __builtin_amdgcn_rcpf(d.y);
    f32x2 q = t * 0.5307027145f + (-0.7265760135f); q = q * t + 0.7107068705f; q = q * t + (-0.142248368f); q = q * t + 0.127414796f; q = q * t;
    const f32x2 s = (v * v) * (-0.72134752044f);
    f32x2 e; e.x = __builtin_amdgcn_exp2f(s.x); e.y = __builtin_amdgcn_exp2f(s.y);
    const f32x2 m = v * (q * e), r = v - m;
    f32x2 o; o.x = v.x < 0.f ? m.x : r.x; o.y = v.y < 0.f ? m.y : r.y; return o;
}

template <int ACT  > struct EpiBf16 {
    static constexpr int MIDK = 0; static constexpr bool PERM = true, AFTER_DRAIN = false; static_assert(ACT == 0 || ACT == 1, "EpiBf16: ACT is 0 (none) or 1 (gelu_pk)");
    bf16_t* O; int ldc; const float* bias; int split_cols; size_t split_stride; float scale0;
    __device__ __forceinline__ void operator()(const f32x4 (&acc)[2][2][4][2], const Unit& u, int wr, int wc, int fr, int fq) const {
        const int row0 = u.pm * BM + wr * 64 + fr; int colt = u.pn * BM; bf16_t* base = O;
        float sc = 1.f; if (split_cols) { const int t = colt / split_cols; base += (size_t)t * split_stride; colt -= t * split_cols; if (t == 0) sc = scale0; }
        const int col0 = colt + wc * 32 + 8 * fq, bcol0 = u.pn * BM + wc * 32 + 8 * fq;
        f32x4 bv[2][2];
#pragma unroll
        for (int bj = 0; bj < 2; ++bj)
#pragma unroll
            for (int n = 0; n < 2; ++n) bv[bj][n] = bias ? *(const f32x4*)(bias + bcol0 + bj * HALF + 4 * n) : (f32x4){0.f, 0.f, 0.f, 0.f};
#pragma unroll
        for (int ai = 0; ai < 2; ++ai)
#pragma unroll
            for (int m = 0; m < 4; ++m) { bf16_t* rowp = base + (size_t)(row0 + ai * HALF + m * 16) * ldc + col0;
#pragma unroll
                for (int bj = 0; bj < 2; ++bj) { f32x4 v0 = acc[ai][bj][m][0] + bv[bj][0], v1 = acc[ai][bj][m][1] + bv[bj][1];
                    if (ACT == 1) { f32x2 a = gelu_pk((f32x2){v0[0], v0[1]}), b = gelu_pk((f32x2){v0[2], v0[3]}), c = gelu_pk((f32x2){v1[0], v1[1]}), d = gelu_pk((f32x2){v1[2], v1[3]});
                        v0 = (f32x4){a.x, a.y, b.x, b.y}; v1 = (f32x4){c.x, c.y, d.x, d.y}; }
                    v0 = v0 * sc; v1 = v1 * sc; u32x4 w; w.x = cvt_pk_bf16(v0[0], v0[1]); w.y = cvt_pk_bf16(v0[2], v0[3]); w.z = cvt_pk_bf16(v1[0], v1[1]); w.w = cvt_pk_bf16(v1[2], v1[3]);
                    *(u32x4*)(rowp + bj * HALF) = w; } }
    }
};
typedef unsigned u32x2 __attribute__((ext_vector_type(2)));
__device__ __forceinline__ float bf_lo(unsigned w) { return __builtin_bit_cast(float, w << 16); }
__device__ __forceinline__ float bf_hi(unsigned w) { return __builtin_bit_cast(float, w & 0xffff0000u); }
__device__ __forceinline__ u32x4 pack8(f32x4 v0, f32x4 v1) { u32x4 w; w.x = cvt_pk_bf16(v0[0], v0[1]); w.y = cvt_pk_bf16(v0[2], v0[3]); w.z = cvt_pk_bf16(v1[0], v1[1]); w.w = cvt_pk_bf16(v1[2], v1[3]); return w; }
__device__ __forceinline__ float sigmoidf_(float x) { return __builtin_amdgcn_rcpf(1.0f + __expf(-x)); }
template <class F> struct EpiRow8 {
    static constexpr int MIDK = 0; static constexpr bool PERM = true, AFTER_DRAIN = false;
    F f;
    __device__ __forceinline__ void operator()(const f32x4 (&acc)[2][2][4][2], const Unit& u, int wr, int wc, int fr, int fq) const {
        const int row0 = u.pm * BM + wr * 64 + fr, c0 = wc * 32 + 8 * fq;
#pragma unroll
        for (int ai = 0; ai < 2; ++ai)
#pragma unroll
            for (int m = 0; m < 4; ++m) { const int row = row0 + ai * HALF + m * 16;
#pragma unroll
                for (int bj = 0; bj < 2; ++bj) { f(u.pn, row, c0 + bj * HALF, acc[ai][bj][m][0], acc[ai][bj][m][1]); if (F::FENCE) asm volatile("" ::: "memory"); } }
    }
};
constexpr float ATT_C2 = 0.125f * 1.4426950408889634f;
struct FProj {
    static constexpr bool FENCE = false;
    unsigned char* ws; bf16_t* GATES;
    __device__ __forceinline__ void operator()(int pn, int row, int cu, f32x4 v0, f32x4 v1) const {
        if (pn < 4) {
            const int sh = cu >> 6, j = (cu & 63) >> 3, pos = row & 2047;
            const f32x4 c = *(const f32x4*)((const float*)(ws + WS_ROPE_C) + pos * 32 + 4 * j), s = *(const f32x4*)((const float*)(ws + WS_ROPE_S) + pos * 32 + 4 * j);
            const float sc = pn < 2 ? ATT_C2 : 1.0f;
            const f32x4 o1 = (v0 * c - v1 * s) * sc, o2 = (v1 * c + v0 * s) * sc;
            bf16_t* dst = (bf16_t*)(ws + (pn < 2 ? WS_Q : WS_K)) + (size_t)row * 512 + (pn & 1) * 256 + sh * 64 + 4 * j;
            u32x2 w1, w2; w1.x = cvt_pk_bf16(o1[0], o1[1]); w1.y = cvt_pk_bf16(o1[2], o1[3]); w2.x = cvt_pk_bf16(o2[0], o2[1]); w2.y = cvt_pk_bf16(o2[2], o2[3]);
            *(u32x2*)dst = w1; *(u32x2*)(dst + 32) = w2;
        } else if (pn < 13) {
            size_t off; int pitch, col;
            if (pn < 6) { off = WS_V; pitch = 512; col = (pn - 4) * 256; }
            else if (pn < 12) { off = WS_RKV; pitch = 1536; col = (pn - 6) * 256; }
            else { off = WS_WAG; pitch = 256; col = 0; }
            *(u32x4*)((bf16_t*)(ws + off) + (size_t)row * pitch + col + cu) = pack8(v0, v1);
        } else *(u32x4*)(GATES + (size_t)row * 2048 + (pn - 13) * 256 + cu) = pack8(v0, v1);
    }
};
struct FLora {
    static constexpr bool FENCE = false;
    unsigned char* ws; const float *w0, *a0;
    __device__ __forceinline__ void operator()(int pn, int row, int cu, f32x4 v0, f32x4 v1) const {
        const int c = (pn & 1) * 256 + cu;
        if (pn < 2) {
            const f32x4 b0 = *(const f32x4*)(w0 + c), b1 = *(const f32x4*)(w0 + c + 4);
            float* dst = (float*)(ws + WS_DEC) + (size_t)row * 512 + c; *(f32x4*)dst = v0 + b0; *(f32x4*)(dst + 4) = v1 + b1;
        } else if (pn < 4) {
            const f32x4 b0 = *(const f32x4*)(a0 + c), b1 = *(const f32x4*)(a0 + c + 4);
            *(u32x4*)((bf16_t*)(ws + WS_AA) + (size_t)row * 512 + c) = pack8(v0 + b0, v1 + b1);
        } else *(u32x4*)((bf16_t*)(ws + WS_GG) + (size_t)row * 512 + c) = pack8(v0, v1);
    }
};
struct EpiMerge {
    static constexpr int MIDK = 8; static constexpr bool PERM = true, AFTER_DRAIN = false;
    const bf16_t* GATES; bf16_t* MERGED;
    static __device__ __forceinline__ float ratio_(float ga, float gb) { return (1.0f + __expf(-gb)) * __builtin_amdgcn_rcpf(1.0f + __expf(-ga)); }
    __device__ __forceinline__ void mid(f32x4 (&acc)[2][2][4][2], const Unit& u, int wr, int wc, int fr, int fq) const {
        int fr_ = fr; asm volatile("" : "+v"(fr_));
        const bf16_t* gp0 = GATES + (size_t)(u.pm * BM + wr * 64 + fr_) * 2048 + u.pn * BM + wc * 32 + 8 * fq;
#pragma unroll
        for (int ai = 0; ai < 2; ++ai)
#pragma unroll
            for (int m = 0; m < 4; ++m)
#pragma unroll
                for (int bj = 0; bj < 2; ++bj) { const bf16_t* gp = gp0 + (size_t)(ai * HALF + m * 16) * 2048 + bj * HALF;
                    const u32x4 ga = *(const u32x4*)gp, gb = *(const u32x4*)(gp + 1024);
                    f32x4& v0 = acc[ai][bj][m][0]; f32x4& v1 = acc[ai][bj][m][1];
                    v0[0] *= ratio_(bf_lo(ga.x), bf_lo(gb.x)); v0[1] *= ratio_(bf_hi(ga.x), bf_hi(gb.x)); v0[2] *= ratio_(bf_lo(ga.y), bf_lo(gb.y)); v0[3] *= ratio_(bf_hi(ga.y), bf_hi(gb.y));
                    v1[0] *= ratio_(bf_lo(ga.z), bf_lo(gb.z)); v1[1] *= ratio_(bf_hi(ga.z), bf_hi(gb.z)); v1[2] *= ratio_(bf_lo(ga.w), bf_lo(gb.w)); v1[3] *= ratio_(bf_hi(ga.w), bf_hi(gb.w));
                    asm volatile("" ::: "memory"); }
    }
    __device__ __forceinline__ void operator()(const f32x4 (&acc)[2][2][4][2], const Unit& u, int wr, int wc, int fr, int fq) const {
        const int row0 = u.pm * BM + wr * 64 + fr, c0 = u.pn * BM + wc * 32 + 8 * fq;
#pragma unroll
        for (int ai = 0; ai < 2; ++ai)
#pragma unroll
            for (int m = 0; m < 4; ++m) { const int row = row0 + ai * HALF + m * 16;
#pragma unroll
                for (int bj = 0; bj < 2; ++bj) { const u32x4 g = *(const u32x4*)(GATES + (size_t)row * 2048 + 1024 + c0 + bj * HALF);
                    f32x4 v0 = acc[ai][bj][m][0], v1 = acc[ai][bj][m][1];
                    v0[0] *= sigmoidf_(bf_lo(g.x)); v0[1] *= sigmoidf_(bf_hi(g.x)); v0[2] *= sigmoidf_(bf_lo(g.y)); v0[3] *= sigmoidf_(bf_hi(g.y));
                    v1[0] *= sigmoidf_(bf_lo(g.z)); v1[1] *= sigmoidf_(bf_hi(g.z)); v1[2] *= sigmoidf_(bf_lo(g.w)); v1[3] *= sigmoidf_(bf_hi(g.w));
                    *(u32x4*)(MERGED + (size_t)row * 1024 + c0 + bj * HALF) = pack8(v0, v1); } }
    }
};
struct FRes {
    static constexpr bool FENCE = false;
    const float* base; float* out;
    __device__ __forceinline__ void operator()(int pn, int row, int cu, f32x4 v0, f32x4 v1) const {
        const size_t off = (size_t)row * 1024 + pn * 256 + cu; const f32x4 b0 = *(const f32x4*)(base + off), b1 = *(const f32x4*)(base + off + 4);
        *(f32x4*)(out + off) = b0 + v0; *(f32x4*)(out + off + 4) = b1 + v1;
    }
};
struct FRelu2 {
    static constexpr bool FENCE = false;
    bf16_t* H;
    __device__ __forceinline__ void operator()(int pn, int row, int cu, f32x4 v0, f32x4 v1) const {
        f32x4 r0, r1;
#pragma unroll
        for (int e = 0; e < 4; ++e) { const float a = __builtin_fmaxf(v0[e], 0.f), b = __builtin_fmaxf(v1[e], 0.f); r0[e] = a * a; r1[e] = b * b; }
        *(u32x4*)(H + (size_t)row * 4096 + pn * 256 + cu) = pack8(r0, r1);
    }
};

__device__ __forceinline__ float xsum_fq(float x) {
    { auto r = __builtin_amdgcn_permlane16_swap(__builtin_bit_cast(unsigned, x), __builtin_bit_cast(unsigned, x), false, false); const unsigned a = r[0], b = r[1]; x = __builtin_bit_cast(float, a) + __builtin_bit_cast(float, b); }
    { auto r = __builtin_amdgcn_permlane32_swap(__builtin_bit_cast(unsigned, x), __builtin_bit_cast(unsigned, x), false, false); const unsigned a = r[0], b = r[1]; x = __builtin_bit_cast(float, a) + __builtin_bit_cast(float, b); }
    return x;
}
template <int MODE> struct EpiResNorm {
    static constexpr int MIDK = 0; static constexpr bool PERM = true, AFTER_DRAIN = false;
    const float* base; float* out; bf16_t* xn; const float* g; float* ss; unsigned* cnt; float eps; bf16_t* x1b;
    __device__ __forceinline__ void operator()(f32x4 (&acc)[2][2][4][2], const Unit& u, int wr, int wc, int fr, int fq) const {
        const int row0 = u.pm * BM + wr * 64 + fr, c0 = u.pn * BM + wc * 32 + 8 * fq;
#pragma unroll
        for (int ai = 0; ai < 2; ++ai)
#pragma unroll
            for (int m = 0; m < 4; ++m) { const int row = row0 + ai * HALF + m * 16; float s = 0.f;
#pragma unroll
                for (int bj = 0; bj < 2; ++bj) { const size_t off = (size_t)row * 1024 + c0 + bj * HALF; f32x4 b0, b1;
                    if (MODE == 0) { b0 = *(const f32x4*)(base + off); b1 = *(const f32x4*)(base + off + 4); }
                    else { const u32x4 w = *(const u32x4*)(x1b + off); b0 = (f32x4){bf_lo(w.x), bf_hi(w.x), bf_lo(w.y), bf_hi(w.y)}; b1 = (f32x4){bf_lo(w.z), bf_hi(w.z), bf_lo(w.w), bf_hi(w.w)}; }
                    f32x4& v0 = acc[ai][bj][m][0]; f32x4& v1 = acc[ai][bj][m][1]; v0 += b0; v1 += b1;
                    if (MODE == 0) *(u32x4*)(x1b + off) = pack8(v0, v1);
                    s += (v0[0] * v0[0] + v0[1] * v0[1]) + (v0[2] * v0[2] + v0[3] * v0[3]) + (v1[0] * v1[0] + v1[1] * v1[1]) + (v1[2] * v1[2] + v1[3] * v1[3]); }
                s = xsum_fq(s);
                if (fq == 0) __hip_atomic_fetch_add(ss + row, s, __ATOMIC_RELAXED, __HIP_MEMORY_SCOPE_AGENT);
                if (m & 1) asm volatile("" ::: "memory"); }
        asm volatile("s_waitcnt vmcnt(0)" ::: "memory");
        unsigned* c_ = cnt + 64 * u.pm;
        if (fr == 0 && fq == 0) __hip_atomic_fetch_add(c_, 1u, __ATOMIC_RELAXED, __HIP_MEMORY_SCOPE_AGENT);
        { unsigned spins = 0; while ((unsigned)__builtin_amdgcn_readfirstlane(__hip_atomic_load(c_, __ATOMIC_RELAXED, __HIP_MEMORY_SCOPE_AGENT)) < 32u && ++spins < (1u << 22)) __builtin_amdgcn_s_sleep(2); }
        asm volatile("" ::: "memory");
#pragma unroll
        for (int ai = 0; ai < 2; ++ai)
#pragma unroll
            for (int m = 0; m < 4; ++m) { const int row = row0 + ai * HALF + m * 16;
                const float rstd = 1.0f / sqrtf(__hip_atomic_load(ss + row, __ATOMIC_RELAXED, __HIP_MEMORY_SCOPE_AGENT) * (1.0f / 1024.0f) + eps);
#pragma unroll
                for (int bj = 0; bj < 2; ++bj) { const size_t off = (size_t)row * 1024 + c0 + bj * HALF; const f32x4 g0 = *(const f32x4*)(g + c0 + bj * HALF), g1 = *(const f32x4*)(g + c0 + bj * HALF + 4);
                    const f32x4 o0 = acc[ai][bj][m][0] * rstd * g0, o1 = acc[ai][bj][m][1] * rstd * g1;
                    if (MODE == 0) *(u32x4*)(xn + off) = pack8(o0, o1); else { *(f32x4*)(out + off) = o0; *(f32x4*)(out + off + 4) = o1; } }
                if (m & 1) asm volatile("" ::: "memory"); }
    }
};
template <class Epi, class Sched, bool ALIGN_EPI = false, bool SP2 = false>
__device__ __forceinline__ void gemm_phase(PG8_LAS unsigned char* lds, const Gemm g, const Sched& S, const Epi& E) {
    int tid_ = threadIdx.x; asm volatile("" : "+v"(tid_));
    const int tid = tid_, wid = __builtin_amdgcn_readfirstlane(tid >> 6), lane = tid & 63, wr = wid >> 2, wc = wid & 3, fr = lane & 15, fq = lane >> 4;
    const int K = g.K, nt = K / BK;
    unsigned voffA[2], voffB[2];
#pragma unroll
    for (int i = 0; i < 2; ++i) { int R, C; stage_rc(tid * 16 + i * 8192, R, C); const int Rb = Epi::PERM ? ((R & ~31) + perm32(R & 31)) : R;
        voffA[i] = (unsigned)(R * K + C) * 2u; voffB[i] = (unsigned)(Rb * K + C) * 2u; }
    const size_t kstep = (size_t)(BK * 2);
    const size_t hstep = (size_t)HALF * K * 2;
    const size_t tstep = 2 * hstep;
    const unsigned ldsw = (unsigned)wid * 1024u;
    const int aoff = lds_byte(wr * 64 + fr, fq * 8), boff = lds_byte(wc * 32 + fr, fq * 8);
#define PG8_SA(b, h) (((b) * 2 + (h)) * HTB)
#define PG8_SB(b, h) ((4 + (b) * 2 + (h)) * HTB)
#define PG8_STAGE(bufoff, gbase, voff) do { _Pragma("unroll") for (int _i = 0; _i < 2; ++_i) \
        __builtin_amdgcn_global_load_lds((const unsigned*)((const char*)(gbase) + (voff)[_i]), (PG8_LAS unsigned*)(lds + (bufoff) + ldsw + _i * 8192), 16, 0, 0); } while (0)
#define PG8_LDA(dst, b, h) do { _Pragma("unroll") for (int m = 0; m < 4; ++m) _Pragma("unroll") for (int k = 0; k < 2; ++k) dst[m][k] = *(const PG8_LAS bf16x8*)(lds + PG8_SA(b, h) + aoff + m * 2048 + k * 1024); } while (0)
#define PG8_LDB(dst, b, h) do { _Pragma("unroll") for (int n = 0; n < 2; ++n) _Pragma("unroll") for (int k = 0; k < 2; ++k) dst[n][k] = *(const PG8_LAS bf16x8*)(lds + PG8_SB(b, h) + boff + n * 2048 + k * 1024); } while (0)
#define PG8_MMA(ai, bj, At, Bt) do { __builtin_amdgcn_s_setprio(1); _Pragma("unroll") for (int m = 0; m < 4; ++m) _Pragma("unroll") for (int n = 0; n < 2; ++n) _Pragma("unroll") for (int k = 0; k < 2; ++k) \
        acc[ai][bj][m][n] = __builtin_amdgcn_mfma_f32_16x16x32_bf16(Bt[n][k], At[m][k], acc[ai][bj][m][n], 0, 0, 0); __builtin_amdgcn_s_setprio(0); } while (0)
#define PG8_WAIT_V(n) asm volatile("s_waitcnt vmcnt(" #n ")" ::: "memory")
#define PG8_WAIT_L(n) asm volatile("s_waitcnt lgkmcnt(" #n ")" ::: "memory")
#define PG8_BAR __builtin_amdgcn_s_barrier()
#define PG8_SCHED __builtin_amdgcn_sched_barrier(0)
    Unit cur, nxt; int ui = 0;
    if (!S.next(0, cur)) return;
    f32x4 acc[2][2][4][2];
#pragma unroll
    for (int a = 0; a < 2; ++a)
#pragma unroll
        for (int b = 0; b < 2; ++b)
#pragma unroll
            for (int m = 0; m < 4; ++m)
#pragma unroll
                for (int n = 0; n < 2; ++n) acc[a][b][m][n] = (f32x4){0.f, 0.f, 0.f, 0.f};
    bf16x8 At[4][2], B0[2][2], B1[2][2];
    const char* cA = (const char*)g.A + (size_t)cur.pm * tstep; const char* cB = (const char*)g.Bt + (size_t)cur.pn * tstep;
    S.a_ready(cur);
    if constexpr (SP2) {
        PG8_STAGE(PG8_SB(0, 0), cB, voffB); PG8_STAGE(PG8_SB(0, 1), cB + hstep, voffB); PG8_STAGE(PG8_SA(0, 0), cA, voffA); PG8_STAGE(PG8_SA(0, 1), cA + hstep, voffA);
        if (wr == 1) PG8_BAR;
        PG8_WAIT_V(2); PG8_BAR;
        PG8_STAGE(PG8_SB(1, 0), cB + kstep, voffB); PG8_STAGE(PG8_SA(1, 0), cA + kstep, voffA); PG8_STAGE(PG8_SB(1, 1), cB + hstep + kstep, voffB);
        PG8_WAIT_V(6); PG8_BAR;
    } else {
        PG8_STAGE(PG8_SB(0, 0), cB, voffB); PG8_STAGE(PG8_SA(0, 0), cA, voffA); PG8_STAGE(PG8_SB(0, 1), cB + hstep, voffB); PG8_STAGE(PG8_SA(0, 1), cA + hstep, voffA);
        if (wr == 1) PG8_BAR;
        PG8_WAIT_V(4); PG8_BAR;
        PG8_STAGE(PG8_SB(1, 0), cB + kstep, voffB); PG8_STAGE(PG8_SA(1, 0), cA + kstep, voffA); PG8_STAGE(PG8_SB(1, 1), cB + hstep + kstep, voffB);
        PG8_WAIT_V(6); PG8_BAR;
    }
    for (;;) {
        const bool has_next = S.next(ui + 1, nxt);
        const char* nA = has_next ? (const char*)g.A + (size_t)nxt.pm * tstep : cA; const char* nB = has_next ? (const char*)g.Bt + (size_t)nxt.pn * tstep : cB;
        for (int t = 0; t < nt; t += 2) {
            if constexpr (Epi::MIDK > 0) { if (t == Epi::MIDK) E.mid(acc, cur, wr, wc, fr, fq); }
            const bool last = (t == nt - 2);
            const char* a1 = cA + (size_t)(t + 1) * kstep;
            const char* a2 = last ? nA : cA + (size_t)(t + 2) * kstep; const char* b2 = last ? nB : cB + (size_t)(t + 2) * kstep;
            const char* a3 = a2 + kstep; const char* b3 = b2 + kstep;
            if (last && has_next) S.a_ready(nxt);
            if constexpr (SP2) {
            PG8_LDB(B0, 0, 0); PG8_LDB(B1, 0, 1); PG8_SCHED; PG8_LDA(At, 0, 0); PG8_STAGE(PG8_SA(1, 1), a1 + hstep, voffA);
            PG8_WAIT_V(8); PG8_WAIT_L(0); PG8_BAR; PG8_MMA(0, 0, At, B0); PG8_MMA(0, 1, At, B1); PG8_BAR; PG8_SCHED;
            PG8_LDA(At, 0, 1); PG8_STAGE(PG8_SB(0, 0), b2, voffB); PG8_STAGE(PG8_SB(0, 1), b2 + hstep, voffB); PG8_STAGE(PG8_SA(0, 0), a2, voffA);
            PG8_WAIT_V(8); PG8_WAIT_L(0); PG8_BAR; PG8_MMA(1, 0, At, B0); PG8_MMA(1, 1, At, B1); PG8_BAR; PG8_SCHED;
            PG8_LDB(B0, 1, 0); PG8_LDB(B1, 1, 1); PG8_SCHED; PG8_LDA(At, 1, 0); PG8_STAGE(PG8_SA(0, 1), a2 + hstep, voffA);
            PG8_WAIT_V(8); PG8_WAIT_L(0); PG8_BAR; PG8_MMA(0, 0, At, B0); PG8_MMA(0, 1, At, B1); PG8_BAR; PG8_SCHED;
            PG8_LDA(At, 1, 1); PG8_STAGE(PG8_SB(1, 0), b3, voffB); PG8_STAGE(PG8_SB(1, 1), b3 + hstep, voffB); PG8_STAGE(PG8_SA(1, 0), a3, voffA);
            PG8_WAIT_V(8); PG8_WAIT_L(0); PG8_BAR; PG8_MMA(1, 0, At, B0); PG8_MMA(1, 1, At, B1); PG8_BAR; PG8_SCHED;
            } else {
            PG8_LDB(B0, 0, 0); PG8_SCHED; PG8_LDA(At, 0, 0); PG8_STAGE(PG8_SA(1, 1), a1 + hstep, voffA);
            PG8_WAIT_L(8); PG8_BAR; PG8_WAIT_L(0); PG8_MMA(0, 0, At, B0); PG8_BAR; PG8_SCHED;
            PG8_LDB(B1, 0, 1); PG8_STAGE(PG8_SB(0, 0), b2, voffB);
            PG8_BAR; PG8_WAIT_L(0); PG8_MMA(0, 1, At, B1); PG8_BAR;
            PG8_LDA(At, 0, 1); PG8_STAGE(PG8_SA(0, 0), a2, voffA);
            PG8_BAR; PG8_WAIT_L(0); PG8_MMA(1, 0, At, B0); PG8_BAR; PG8_SCHED;
            PG8_STAGE(PG8_SB(0, 1), b2 + hstep, voffB);
            PG8_WAIT_V(6); PG8_BAR; PG8_MMA(1, 1, At, B1); PG8_BAR;
            PG8_LDB(B0, 1, 0); PG8_SCHED; PG8_LDA(At, 1, 0); PG8_STAGE(PG8_SA(0, 1), a2 + hstep, voffA);
            PG8_WAIT_L(8); PG8_BAR; PG8_WAIT_L(0); PG8_MMA(0, 0, At, B0); PG8_BAR; PG8_SCHED;
            PG8_LDB(B1, 1, 1); PG8_STAGE(PG8_SB(1, 0), b3, voffB);
            PG8_BAR; PG8_WAIT_L(0); PG8_MMA(0, 1, At, B1); PG8_BAR;
            PG8_LDA(At, 1, 1); PG8_STAGE(PG8_SA(1, 0), a3, voffA);
            PG8_BAR; PG8_WAIT_L(0); PG8_MMA(1, 0, At, B0); PG8_BAR; PG8_SCHED;
            PG8_STAGE(PG8_SB(1, 1), b3 + hstep, voffB);
            PG8_WAIT_V(6); PG8_BAR; PG8_MMA(1, 1, At, B1); PG8_BAR;
            }
        }
        if constexpr (ALIGN_EPI) { if (wr == 0) PG8_BAR; }
        if constexpr (!Epi::AFTER_DRAIN) { E(acc, cur, wr, wc, fr, fq); S.done(cur); }
        if (!has_next) break;
#pragma unroll
        for (int a = 0; a < 2; ++a)
#pragma unroll
            for (int b = 0; b < 2; ++b)
#pragma unroll
                for (int m = 0; m < 4; ++m)
#pragma unroll
                    for (int n = 0; n < 2; ++n) acc[a][b][m][n] = (f32x4){0.f, 0.f, 0.f, 0.f};
        cur = nxt; cA = nA; cB = nB; ++ui;
        if constexpr (ALIGN_EPI) { if (wr == 1) PG8_BAR; }
    }
    PG8_WAIT_V(0);
    if constexpr (!ALIGN_EPI) { if (wr == 0) PG8_BAR; }
    PG8_BAR;
    if constexpr (Epi::AFTER_DRAIN) { E.fused(acc, cur, wr, wc, fr, fq, lds, wid, lane); S.done(cur); }
#undef PG8_SA
#undef PG8_SB
#undef PG8_STAGE
#undef PG8_LDA
#undef PG8_LDB
#undef PG8_MMA
#undef PG8_WAIT_V
#undef PG8_WAIT_L
#undef PG8_BAR
#undef PG8_SCHED
}
}

#ifndef PG8_SP2
#define PG8_SP2 true
#endif
#ifndef PG8_ALIGN
#define PG8_ALIGN true
#endif
#include <hip/hip_bf16.h>
#include <cmath>
namespace attn_body {
using bf16=__hip_bfloat16;
using bf16x8=__attribute__((ext_vector_type(8)))short;
using s16x4=__attribute__((ext_vector_type(4)))short;
using f32x16=__attribute__((ext_vector_type(16)))float;
using u32x4=__attribute__((ext_vector_type(4)))unsigned;
constexpr int SEQ=2048,D=64,QP=512,KP=512,VP=512,OP=1024;
constexpr int NW=8,QBLK=32,QB=QBLK*NW,KVBLK=64,NQB=SEQ/QB;
constexpr int ATTN_UNIT_ROWS=QB;
__device__ __forceinline__ int crow(int r,int hi){return (r&3)+8*(r>>2)+4*hi;}
#define SBAR() __builtin_amdgcn_sched_barrier(0)
__device__ __forceinline__ void cmask(f32x16&p0,f32x16&p1,int jb,int wchunk,int){
  if(jb>wchunk){ const float NEG=-INFINITY;
    #pragma unroll
    for(int r=0;r<16;++r){p0[r]=NEG;p1[r]=NEG;} }
}

constexpr int NSLOT=3, SLOTB=8192;
constexpr int LDS_K=0, LDS_V=NSLOT*SLOTB, LDS_WS=2*NSLOT*SLOTB, LDS_OST=LDS_WS+NW*64*4, LDS_BYTES=LDS_OST+NW*4096;
constexpr float C2=0.125f*1.4426950408889634f;
__device__ __forceinline__ void glds16(const void*gsrc,unsigned lds_dst){unsigned keep;
  asm volatile("s_mov_b32 %0, m0\n\ts_mov_b32 m0, %2\n\ts_nop 0\n\tglobal_load_lds_dwordx4 %1, off\n\ts_mov_b32 m0, %0":"=&s"(keep):"v"(gsrc),"s"(lds_dst):"memory");}
__device__ __forceinline__ float max3f(float a,float b,float c){float r;asm("v_max3_f32 %0, %1, %2, %3":"=v"(r):"v"(a),"v"(b),"v"(c));return r;}
__device__ __forceinline__ float max2f(float a,float b){float r;asm("v_max_f32_e32 %0, %1, %2":"=v"(r):"v"(a),"v"(b));return r;}
__device__ __forceinline__ float fadd_s(float a,float b){float r;asm("v_add_f32_e32 %0, %1, %2":"=v"(r):"v"(a),"v"(b));return r;}
__device__ __forceinline__ float fsub_s(float a,float b){float r;asm("v_sub_f32_e32 %0, %1, %2":"=v"(r):"v"(a),"v"(b));return r;}
typedef float f32x2_t __attribute__((ext_vector_type(2))); typedef __bf16 bf16x2_t __attribute__((ext_vector_type(2)));
__device__ __forceinline__ unsigned cvtpk_s(float lo,float hi){f32x2_t v={lo,hi};bf16x2_t b=__builtin_convertvector(v,bf16x2_t);return __builtin_bit_cast(unsigned,b);}
#define WAIT_BAR(N) asm volatile("s_waitcnt vmcnt(" #N ") lgkmcnt(0)\n\ts_barrier":::"memory")

__device__ __forceinline__ void qkt(f32x16&p0,f32x16&p1,const char*Kslot,const bf16x8*qr,const f32x16&negm,int r32,int hi){
  const char*kb=Kslot+hi*1024+r32*16;
  #pragma unroll
  for(int d0=0;d0<4;++d0){
    const bf16x8 b0=*reinterpret_cast<const bf16x8*>(kb+d0*2048);
    const bf16x8 b1=*reinterpret_cast<const bf16x8*>(kb+d0*2048+512);
    if(d0==0){p0=__builtin_amdgcn_mfma_f32_32x32x16_bf16(b0,qr[0],negm,0,0,0);p1=__builtin_amdgcn_mfma_f32_32x32x16_bf16(b1,qr[0],negm,0,0,0);}
    else{p0=__builtin_amdgcn_mfma_f32_32x32x16_bf16(b0,qr[d0],p0,0,0,0);p1=__builtin_amdgcn_mfma_f32_32x32x16_bf16(b1,qr[d0],p1,0,0,0);}}
}
typedef __attribute__((address_space(3))) const char* lds_cptr;
typedef short v4i16_t __attribute__((ext_vector_type(4)));
__device__ __forceinline__ void kload8(bf16x8*kf,lds_cptr kp){
  kf[0]=*(const __attribute__((address_space(3))) bf16x8*)(kp);      kf[1]=*(const __attribute__((address_space(3))) bf16x8*)(kp+512);
  kf[2]=*(const __attribute__((address_space(3))) bf16x8*)(kp+2048); kf[3]=*(const __attribute__((address_space(3))) bf16x8*)(kp+2560);
  kf[4]=*(const __attribute__((address_space(3))) bf16x8*)(kp+4096); kf[5]=*(const __attribute__((address_space(3))) bf16x8*)(kp+4608);
  kf[6]=*(const __attribute__((address_space(3))) bf16x8*)(kp+6144); kf[7]=*(const __attribute__((address_space(3))) bf16x8*)(kp+6656);
}
__device__ __forceinline__ void kload2(bf16x8*kf,lds_cptr kp,int j){ kf[2*j]=*(const __attribute__((address_space(3))) bf16x8*)(kp+j*2048); kf[2*j+1]=*(const __attribute__((address_space(3))) bf16x8*)(kp+j*2048+512); }
__device__ __forceinline__ s16x4 vtr(lds_cptr p){ return __builtin_bit_cast(s16x4,__builtin_amdgcn_ds_read_tr16_b64_v4i16((__attribute__((address_space(3))) v4i16_t*)p)); }
__device__ __forceinline__ float rowmax(const f32x16&p0,const f32x16&p1){
  float a=max3f(p0[0],p0[1],p1[0]),b=max3f(p0[2],p0[3],p1[1]);a=max3f(a,p1[2],p1[3]);
  #pragma unroll
  for(int r=4;r<16;r+=4){a=max3f(a,p0[r],p0[r+1]);b=max3f(b,p0[r+2],p0[r+3]);a=max3f(a,p1[r],p1[r+1]);b=max3f(b,p1[r+2],p1[r+3]);}
  const float m=max2f(a,b);
  auto rr=__builtin_amdgcn_permlane32_swap(__float_as_uint(m),__float_as_uint(m),false,false);
  return max2f(__uint_as_float(rr[0]),__uint_as_float(rr[1]));
}
__device__ __forceinline__ void pv(f32x16*o,int vb,bf16x8 pa0,bf16x8 pa1,bf16x8 pa2,bf16x8 pa3){
  #pragma unroll
  for(int d0=0;d0<2;++d0){s16x4 lo[4],hi[4];
    #pragma unroll
    for(int ks=0;ks<4;++ks){
      asm volatile("ds_read_b64_tr_b16 %0,%1 offset:%c2":"=&v"(lo[ks]):"v"(vb),"i"(d0*4096+ks*1024):"memory");
      asm volatile("ds_read_b64_tr_b16 %0,%1 offset:%c2":"=&v"(hi[ks]):"v"(vb),"i"(d0*4096+ks*1024+512):"memory");}
    asm volatile("s_waitcnt lgkmcnt(0)":::"memory");SBAR();
    #define PK(k) (bf16x8){lo[k][0],lo[k][1],lo[k][2],lo[k][3],hi[k][0],hi[k][1],hi[k][2],hi[k][3]}
    o[d0]=__builtin_amdgcn_mfma_f32_32x32x16_bf16(pa0,PK(0),o[d0],0,0,0);
    o[d0]=__builtin_amdgcn_mfma_f32_32x32x16_bf16(pa1,PK(1),o[d0],0,0,0);
    o[d0]=__builtin_amdgcn_mfma_f32_32x32x16_bf16(pa2,PK(2),o[d0],0,0,0);
    o[d0]=__builtin_amdgcn_mfma_f32_32x32x16_bf16(pa3,PK(3),o[d0],0,0,0);
    #undef PK
  }
}

#ifndef ATTN_STORE16
#define ATTN_STORE16(p,v) (*(u32x4*)(p)=(v))
#endif
template<int THRL> __device__ __forceinline__ void attn_unit(int b,int qcol,int kcol,int vcol,int ocol,int qb,const bf16*Q,const bf16*__restrict__ K,const bf16*__restrict__ V,bf16*O,char*shm){
  const int tid=threadIdx.x,lane=tid&63,r32=lane&31,hi=lane>>5; const int wid=__builtin_amdgcn_readfirstlane(tid>>6);
  const long rowbase=(long)b*SEQ; const int q0=qb*QB;
  const bf16*Qw=Q+(rowbase+q0+wid*QBLK)*QP+qcol;
  const bf16*Kh=K+rowbase*KP+kcol,*Vh=V+rowbase*VP+vcol;
  const unsigned lds0=(unsigned)(uintptr_t)shm;
  float*wsf=(float*)(shm+LDS_WS)+wid*64;
  const bf16*ksrc=Kh+(long)lane*KP+wid*8;
  const bf16*vsrc=Vh+(long)(16*(wid&3)+(lane>>2))*VP+(wid>>2)*32+(lane&3)*8;
  const unsigned kdst=lds0+LDS_K+wid*1024, vdst=lds0+LDS_V+wid*1024;
  #define DMA_K(t,slot) glds16(ksrc+(long)(t)*KVBLK*KP,(unsigned)__builtin_amdgcn_readfirstlane(kdst+(slot)))
  #define DMA_V(t,slot) glds16(vsrc+(long)(t)*KVBLK*VP,(unsigned)__builtin_amdgcn_readfirstlane(vdst+(slot)))
  const int vb0=(int)(lds0+LDS_V)+((lane>>4)&1)*32+(lane&3)*8+(4*hi+((lane&15)>>2))*64;
  const char*Kbase=shm+LDS_K; bf16x8 kf[8];
  const lds_cptr shm3=(lds_cptr)shm; const lds_cptr kp0=shm3+LDS_K+hi*1024+r32*16; const lds_cptr vp0=shm3+LDS_V+((lane>>4)&1)*32+(lane&3)*8+(4*hi+((lane&15)>>2))*64;
  const int NT=(q0+QB)/KVBLK;
  DMA_K(0,0);DMA_V(0,0);DMA_K(1,SLOTB);
  bf16x8 qr[4];
  #pragma unroll
  for(int d0=0;d0<4;++d0)qr[d0]=*reinterpret_cast<const bf16x8*>(&Qw[(long)r32*QP+d0*16+hi*8]);
  float mhat=0.f,l_reg=0.f;f32x16 o[2];o[0]=f32x16{};o[1]=f32x16{};f32x16 negm=f32x16{};asm volatile("":"+v"(negm));
  const int qrel=wid>>1;
  #define CMASK(P0,P1,t) do{int jb_=(t)-(NT-4); if(jb_>=0)cmask(P0,P1,jb_,qrel,hi);}while(0)
  bool resc=false;
  #define START(P0,P1) do{ const float rm=rowmax(P0,P1); resc=false; \
    { const float dl=rm; mhat=fadd_s(mhat,dl); \
      _Pragma("unroll") for(int r=0;r<16;++r){P0[r]=fsub_s(P0[r],dl);P1[r]=fsub_s(P1[r],dl);} \
      _Pragma("unroll") for(int r=0;r<16;++r)negm[r]=-mhat; asm volatile("":"+v"(negm)); } \
    _Pragma("unroll") for(int r=0;r<16;++r)P0[r]=__builtin_amdgcn_exp2f(P0[r]); }while(0)
  #define RESC() do{ if(resc){ asm volatile("s_waitcnt lgkmcnt(0)":::"memory"); \
      _Pragma("unroll") for(int d_=0;d_<2;++d_) _Pragma("unroll") for(int r=0;r<16;++r)o[d_][r]*=wsf[crow(r,hi)]; } }while(0)
  f32x16 pA0,pA1,pB0,pB1;
  int sl_prev=0,sl_cur=0,sl_next=SLOTB;
  #define ROT() do{sl_prev=sl_cur;sl_cur=sl_next;sl_next=(sl_next==(NSLOT-1)*SLOTB)?0:sl_next+SLOTB;}while(0)
  DMA_K(2,2*SLOTB);
  WAIT_BAR(3);
  qkt(pA0,pA1,Kbase,qr,negm,r32,hi);asm volatile("s_nop 15\n\ts_nop 7":"+v"(pA0),"+v"(pA1));CMASK(pA0,pA1,0);
  START(pA0,pA1);
  _Pragma("unroll") for(int r=0;r<16;++r)pA1[r]=__builtin_amdgcn_exp2f(pA1[r]);
  WAIT_BAR(0);
  DMA_K(3,0);DMA_V(1,SLOTB);
  ROT();
  kload8(kf,kp0+sl_cur);
  WAIT_BAR(2);
  s16x4 vlo[8],vhi[8]; u32x4 pw0,pw1,pw2,pw3;
  #define PKW(P,B) cvtpk_s(P[B],P[B+1])
  #define PAF(k) __builtin_bit_cast(bf16x8,pw##k)
  #define VFR(i) (bf16x8){vlo[i][0],vlo[i][1],vlo[i][2],vlo[i][3],vhi[i][0],vhi[i][1],vhi[i][2],vhi[i][3]}
  #define PIN(x) asm volatile("":"+v"(x))
  #define MX3(a,b,c) __builtin_fmaxf(__builtin_fmaxf((a),(b)),(c))
  #define GAPA(MF,A0,A1,A2,A3,W0,W1,PW) do{ MF; sacc+=A0; sacc+=A1; sacc+=A2; sacc+=A3; PIN(sacc); W0; W1; PIN(PW); SBAR(); }while(0)
  #define EX(v) __builtin_amdgcn_exp2f(v)
  #define GAPB(MF,X,B) do{ MF; X[B]=EX(X[B]); X[B+1]=EX(X[B+1]); X[B+2]=EX(X[B+2]); X[B+3]=EX(X[B+3]); PIN(X); SBAR(); }while(0)
  #define VRD(i) do{ vlo[i]=vtr(vp_+(((i)>>2)*4096+((i)&3)*1024)); vhi[i]=vtr(vp_+(((i)>>2)*4096+((i)&3)*1024+512)); }while(0)
  #define KRD(G,j) do{ if(G){ kload2(kf,kp0+sl_next,j); SBAR(); } }while(0)
  #define STEP(C0,C1,P0,P1,t,GK,GV,GL) do{ SBAR(); \
    const lds_cptr vp_=vp0+sl_prev; \
    VRD(0); SBAR(); float sacc=(P0[0]+P0[1]); \
    GAPA(C0=__builtin_amdgcn_mfma_f32_32x32x16_bf16(kf[0],qr[0],negm,0,0,0), P0[2],P0[3],P0[4],P0[5],     pw0[0]=PKW(P0,0), pw0[1]=PKW(P0,2), pw0); \
    VRD(4); SBAR(); GAPA(C1=__builtin_amdgcn_mfma_f32_32x32x16_bf16(kf[1],qr[0],negm,0,0,0), P0[6],P0[7],P0[8],P0[9],     pw0[2]=PKW(P0,4), pw0[3]=PKW(P0,6), pw0); \
    VRD(1); SBAR(); GAPA(C0=__builtin_amdgcn_mfma_f32_32x32x16_bf16(kf[2],qr[1],C0,0,0,0),   P0[10],P0[11],P0[12],P0[13], pw1[0]=PKW(P0,8), pw1[1]=PKW(P0,10), pw1); \
    VRD(5); SBAR(); GAPA(C1=__builtin_amdgcn_mfma_f32_32x32x16_bf16(kf[3],qr[1],C1,0,0,0),   P0[14],P0[15],P1[0],P1[1],   pw1[2]=PKW(P0,12),pw1[3]=PKW(P0,14), pw1); \
    VRD(2); SBAR(); GAPA(C0=__builtin_amdgcn_mfma_f32_32x32x16_bf16(kf[4],qr[2],C0,0,0,0),   P1[2],P1[3],P1[4],P1[5],     pw2[0]=PKW(P1,0), pw2[1]=PKW(P1,2), pw2); \
    VRD(6); SBAR(); GAPA(C1=__builtin_amdgcn_mfma_f32_32x32x16_bf16(kf[5],qr[2],C1,0,0,0),   P1[6],P1[7],P1[8],P1[9],     pw2[2]=PKW(P1,4), pw2[3]=PKW(P1,6), pw2); \
    VRD(3); SBAR(); GAPA(C0=__builtin_amdgcn_mfma_f32_32x32x16_bf16(kf[6],qr[3],C0,0,0,0),   P1[10],P1[11],P1[12],P1[13], pw3[0]=PKW(P1,8), pw3[1]=PKW(P1,10), pw3); \
    VRD(7); SBAR(); GAPA(C1=__builtin_amdgcn_mfma_f32_32x32x16_bf16(kf[7],qr[3],C1,0,0,0),   P1[14],P1[15],0.f,0.f,       pw3[2]=PKW(P1,12),pw3[3]=PKW(P1,14), pw3); \
    l_reg+=sacc; \
    if(GK){DMA_K((t)+3,sl_cur);} if(GV){DMA_V((t)+1,sl_next);} \
    CMASK(C0,C1,t); \
    { float a=MX3(C0[0],C0[1],C1[0]),b=MX3(C0[2],C0[3],C1[1]); a=MX3(a,C1[2],C1[3]); \
      _Pragma("unroll") for(int r=4;r<16;r+=4){a=MX3(a,C0[r],C0[r+1]);b=MX3(b,C0[r+2],C0[r+3]);a=MX3(a,C1[r],C1[r+1]);b=MX3(b,C1[r+2],C1[r+3]);} \
      float rm=__builtin_fmaxf(a,b); { auto rr=__builtin_amdgcn_permlane32_swap(__float_as_uint(rm),__float_as_uint(rm),false,false); rm=__builtin_fmaxf(__uint_as_float(rr[0]),__uint_as_float(rr[1])); } \
      resc=false; \
      if(__builtin_expect(__any(rm>(float)THRL),0)){ const float dl=__builtin_fmaxf(rm,0.f); mhat+=dl; \
        _Pragma("unroll") for(int r=0;r<16;++r){C0[r]-=dl;C1[r]-=dl;} \
        _Pragma("unroll") for(int r=0;r<16;++r)negm[r]=-mhat; asm volatile("":"+v"(negm)); \
        const float f=__builtin_amdgcn_exp2f(-dl); l_reg*=f; if(hi==0)wsf[r32]=f; resc=true; } } \
    SBAR(); \
    GAPB(o[0]=__builtin_amdgcn_mfma_f32_32x32x16_bf16(PAF(0),VFR(0),o[0],0,0,0), C0,0); \
    GAPB(o[1]=__builtin_amdgcn_mfma_f32_32x32x16_bf16(PAF(0),VFR(4),o[1],0,0,0), C0,4); \
    KRD(GL,0); GAPB(o[0]=__builtin_amdgcn_mfma_f32_32x32x16_bf16(PAF(1),VFR(1),o[0],0,0,0), C0,8); \
    KRD(GL,1); GAPB(o[1]=__builtin_amdgcn_mfma_f32_32x32x16_bf16(PAF(1),VFR(5),o[1],0,0,0), C0,12); \
    KRD(GL,2); GAPB(o[0]=__builtin_amdgcn_mfma_f32_32x32x16_bf16(PAF(2),VFR(2),o[0],0,0,0), C1,0); \
    KRD(GL,3); GAPB(o[1]=__builtin_amdgcn_mfma_f32_32x32x16_bf16(PAF(2),VFR(6),o[1],0,0,0), C1,4); \
    GAPB(o[0]=__builtin_amdgcn_mfma_f32_32x32x16_bf16(PAF(3),VFR(3),o[0],0,0,0), C1,8); \
    GAPB(o[1]=__builtin_amdgcn_mfma_f32_32x32x16_bf16(PAF(3),VFR(7),o[1],0,0,0), C1,12); \
    }while(0)
  int t=1;
  #undef CMASK
  #define CMASK(P0,P1,t) do{}while(0)
  for(;t+5<NT;t+=2){
    STEP(pB0,pB1,pA0,pA1,t,true,true,true);     WAIT_BAR(2); RESC(); ROT();
    STEP(pA0,pA1,pB0,pB1,t+1,true,true,true);   WAIT_BAR(2); RESC(); ROT();
  }
  #undef CMASK
  #define CMASK(P0,P1,t) do{int jb_=(t)-(NT-4); if(jb_>=0)cmask(P0,P1,jb_,qrel,hi);}while(0)
  #define ENDW(tt) do{ if((tt)+3<NT){WAIT_BAR(2);} else if((tt)+2<NT){WAIT_BAR(1);} else {WAIT_BAR(0);} }while(0)
  for(;t+1<NT;t+=2){
    STEP(pB0,pB1,pA0,pA1,t,(t+3<NT),(t+1<NT),(t+1<NT));       ENDW(t);   RESC(); ROT();
    STEP(pA0,pA1,pB0,pB1,t+1,(t+4<NT),(t+2<NT),(t+2<NT));     ENDW(t+1); RESC(); ROT();
  }
  STEP(pB0,pB1,pA0,pA1,NT-1,false,false,false); RESC();
  { float sacc=pB0[0]+pB0[1]; _Pragma("unroll") for(int r=2;r<16;++r)sacc+=pB0[r]; _Pragma("unroll") for(int r=0;r<16;++r)sacc+=pB1[r]; l_reg+=sacc;
    pw0=(u32x4){PKW(pB0,0),PKW(pB0,2),PKW(pB0,4),PKW(pB0,6)};pw1=(u32x4){PKW(pB0,8),PKW(pB0,10),PKW(pB0,12),PKW(pB0,14)};pw2=(u32x4){PKW(pB1,0),PKW(pB1,2),PKW(pB1,4),PKW(pB1,6)};pw3=(u32x4){PKW(pB1,8),PKW(pB1,10),PKW(pB1,12),PKW(pB1,14)};
    SBAR(); pv(o,vb0+sl_cur,PAF(0),PAF(1),PAF(2),PAF(3)); }
  #undef PKW
  #undef PAF
  #undef VFR
  #undef PIN
  #undef MX3
  #undef GAPA
  #undef GAPB
  #undef EX
  #undef VRD
  #undef KRD
  #undef STEP
  #undef ENDW
  {auto rr=__builtin_amdgcn_permlane32_swap(__float_as_uint(l_reg),__float_as_uint(l_reg),false,false);l_reg=__uint_as_float(rr[0])+__uint_as_float(rr[1]);}
  if(hi==0)wsf[32+r32]=l_reg;asm volatile("s_waitcnt lgkmcnt(0)":::"memory");
  float rli[16];
  #pragma unroll
  for(int r=0;r<16;++r)rli[r]=__builtin_amdgcn_rcpf(wsf[32+crow(r,hi)]);
  bf16*Ow=O+(rowbase+q0+wid*QBLK)*OP+ocol;
  { bf16*stg=(bf16*)(shm+LDS_OST)+wid*2048;
    #pragma unroll
    for(int r=0;r<16;++r){const int orow=crow(r,hi);
      #pragma unroll
      for(int d0=0;d0<2;++d0)stg[orow*64+d0*32+r32]=__float2bfloat16(o[d0][r]*rli[r]);}
    asm volatile("s_waitcnt lgkmcnt(0)":::"memory");
    #pragma unroll
    for(int i=0;i<4;++i){const int row=i*8+(lane>>3),ch=lane&7; const u32x4 v=*(const u32x4*)(stg+row*64+ch*8); ATTN_STORE16(Ow+(long)row*OP+ch*8,v);} }
  asm volatile("s_waitcnt lgkmcnt(0)\n\ts_barrier":::"memory");
  #undef DMA_K
  #undef DMA_V
  #undef CMASK
  #undef START
  #undef RESC
  #undef ROT
}
constexpr int ATTN_LDS_BYTES=LDS_BYTES;
struct AttnTensors { const bf16* Q; const bf16* K; const bf16* V; bf16* O; };
struct AttnUnit { int bvh; int qb; };
struct StaticOrder {
  int ai,nA;
  __device__ __forceinline__ StaticOrder(int ai_,int nA_):ai(ai_),nA(nA_){}
  __device__ __forceinline__ bool next(int i,AttnUnit&u)const{
    if(nA==128){ if(i>=8)return false; u.bvh=ai; u.qb=7-i; return true; }
    if(i>=4)return false; const int s=ai&1; u.bvh=ai>>1; u.qb=(i==0)?7-s:(i==1)?4+s:(i==2)?3-s:s; return true; }
  __device__ __forceinline__ void a_ready(const AttnUnit&)const{}
  __device__ __forceinline__ void done(const AttnUnit&)const{}
};
template<class Sched,int THRL=8> __device__ __forceinline__ void attn_phase(char*lds,const AttnTensors&T,const Sched&S){
  AttnUnit u;
  for(int i=0;S.next(i,u);++i){ S.a_ready(u); const int b=u.bvh>>4,vh=u.bvh&15,s=vh>>1,half=vh&1;
    attn_unit<THRL>(b,s*64,s*64,(s>>1)*128+half*64,s*128+half*64,u.qb,T.Q,T.K,T.V,T.O,lds); S.done(u); }
}
#undef SBAR
#undef WAIT_BAR
}
#include <hip/hip_cooperative_groups.h>
typedef unsigned short bf16;
#define GAS __attribute__((address_space(1)))
#define LAS __attribute__((address_space(3)))
typedef unsigned v4u __attribute__((ext_vector_type(4)));
typedef unsigned v2u __attribute__((ext_vector_type(2)));
typedef float f32x4 __attribute__((ext_vector_type(4)));
#define LDS_WAIT() asm volatile("s_waitcnt lgkmcnt(0)" ::: "memory")
__device__ __forceinline__ unsigned f2bf(float f) { unsigned u = __builtin_bit_cast(unsigned, f); return (u + 0x7fffu + ((u >> 16) & 1u)) >> 16; }
__device__ __forceinline__ unsigned pk2(float lo, float hi) { return f2bf(lo) | (f2bf(hi) << 16); }
__device__ __forceinline__ float bflo(unsigned w) { return __builtin_bit_cast(float, w << 16); }
__device__ __forceinline__ float bfhi(unsigned w) { return __builtin_bit_cast(float, w & 0xffff0000u); }
__device__ __forceinline__ float bf1(unsigned short h) { return __builtin_bit_cast(float, (unsigned)h << 16); }
template <int CTRL> __device__ __forceinline__ float dppf(float x) { return __builtin_bit_cast(float, __builtin_amdgcn_update_dpp(0, __builtin_bit_cast(int, x), CTRL, 0xf, 0xf, false)); }
__device__ __forceinline__ float row16_allsum(float x) { x += dppf<0x128>(x); x += dppf<0x124>(x); x += dppf<0x122>(x); x += dppf<0x121>(x); return x; }
__device__ __forceinline__ float oct_allsum(float x) { x += dppf<0xB1>(x); x += dppf<0x4E>(x); x += dppf<0x141>(x); return x; }
__device__ __forceinline__ float u2f(unsigned u) { return __builtin_bit_cast(float, u); }
__device__ __forceinline__ unsigned f2u(float f) { return __builtin_bit_cast(unsigned, f); }
__device__ __forceinline__ float sw32(float a, float b) { auto r = __builtin_amdgcn_permlane32_swap(f2u(a), f2u(b), false, false); const unsigned r0 = r[0], r1 = r[1]; return u2f(r0) + u2f(r1); }
__device__ __forceinline__ float sw16(float a, float b) { auto r = __builtin_amdgcn_permlane16_swap(f2u(a), f2u(b), false, false); const unsigned r0 = r[0], r1 = r[1]; return u2f(r0) + u2f(r1); }
__device__ __forceinline__ float wave_allsum(float x) { x = row16_allsum(x); x = sw16(x, x); return sw32(x, x); }
__device__ __forceinline__ float red4(float x0, float x1, float x2, float x3) { return row16_allsum(sw16(sw32(x0, x1), sw32(x2, x3))); }

#define XB_TMO      128
#define XB_XCNT(j)  (256  + 64 * (j))
#define XB_XSUB(j)  (1280 + 64 * (j))
#define XB_XGEN(j)  (2304 + 64 * (j))
#define XB_TOP      3328
#define XB_TOPGEN   3392
#define XCD_BAR_WORDS 3456
#define XB_SPIN_CAP (1u << 18)

__device__ __forceinline__ unsigned xb_ld(unsigned* p)              { return __hip_atomic_load(p, __ATOMIC_RELAXED, __HIP_MEMORY_SCOPE_AGENT); }
__device__ __forceinline__ unsigned xb_add(unsigned* p, unsigned v) { return __hip_atomic_fetch_add(p, v, __ATOMIC_RELAXED, __HIP_MEMORY_SCOPE_AGENT); }
__device__ __forceinline__ unsigned xb_xcc_id() { return (unsigned)__builtin_amdgcn_s_getreg((3 << 11) | 20) & 0xFu; }
#define XB_SPIN(cond, bar) do { unsigned _sp = 0; while (cond) { __builtin_amdgcn_s_sleep(1); \
    if ((++_sp & 255u) == 0u) { if (xb_ld(&(bar)[XB_TMO])) break; if (_sp > XB_SPIN_CAP) { atomicAdd(&(bar)[XB_TMO], 1u); break; } } } } while (0)

struct XcdBarrier {
    unsigned* bar; unsigned x;
    volatile LAS unsigned* st;
};

__device__ __forceinline__ XcdBarrier xcd_barrier_post(unsigned* bar, volatile LAS unsigned* st) {
    XcdBarrier b; b.bar = bar; b.x = xb_xcc_id(); b.st = st;
    if (threadIdx.x == 0) (void)xb_add(&bar[XB_XCNT(b.x)], 1u);
    return b;
}
__device__ __forceinline__ void xcd_barrier_complete(unsigned* bar, unsigned x, unsigned& nloc, unsigned& nx) {
    const unsigned G = gridDim.x * gridDim.y * gridDim.z;
    unsigned sum, cnt, mine, sp = 0u;
    for (;;) {
        sum = 0u; cnt = 0u; mine = 0u;
#pragma unroll
        for (unsigned j = 0; j < 16; ++j) { const unsigned c = xb_ld(&bar[XB_XCNT(j)]); sum += c; cnt += (c > 0u) ? 1u : 0u; }
        mine = xb_ld(&bar[XB_XCNT(x)]);
        if (sum == G) break;
        __builtin_amdgcn_s_sleep(1);
        if ((++sp & 255u) == 0u) { if (xb_ld(&bar[XB_TMO])) break; if (sp > XB_SPIN_CAP) { atomicAdd(&bar[XB_TMO], 1u); break; } }
    }
    nloc = mine > 0u ? mine : 1u; nx = cnt > 0u ? cnt : 1u;
}

__device__ __forceinline__ void xcd_barrier(const XcdBarrier& b) {
    asm volatile("s_waitcnt vmcnt(0)" ::: "memory");
    __syncthreads();
    if (threadIdx.x == 0) {
        unsigned* bar = b.bar;
        __builtin_amdgcn_s_waitcnt(0);
        unsigned nloc = b.st[0], nx = b.st[1];
        if (nloc == 0u) { xcd_barrier_complete(bar, b.x, nloc, nx); b.st[0] = nloc; b.st[1] = nx; }
        const unsigned old = xb_add(&bar[XB_XSUB(b.x)], 1u);
        const unsigned gen = old / nloc;
        if (old + 1u == (gen + 1u) * nloc) {
            __builtin_amdgcn_fence(__ATOMIC_RELEASE, "agent");
            asm volatile("s_waitcnt vmcnt(0)" ::: "memory");
            const unsigned og = xb_add(&bar[XB_TOP], 1u);
            const unsigned tg = og / nx;
            if (og + 1u == (tg + 1u) * nx) xb_add(&bar[XB_TOPGEN], 1u);
            else XB_SPIN(xb_ld(&bar[XB_TOPGEN]) == tg, bar);
            __builtin_amdgcn_fence(__ATOMIC_ACQUIRE, "agent");
            xb_add(&bar[XB_XGEN(b.x)], 1u);
            asm volatile("s_waitcnt vmcnt(0)" ::: "memory");
        } else {
            XB_SPIN(xb_ld(&bar[XB_XGEN(b.x)]) == gen, bar);
            __builtin_amdgcn_fence(__ATOMIC_ACQUIRE, "agent");
            asm volatile("s_waitcnt vmcnt(0)" ::: "memory");
        }
    }
    __syncthreads();
}


constexpr int CW_BAR = 4096;
constexpr int MISC_OFF = 162816 + 320;
struct Frame {
    LAS unsigned char* lds;
    int tid, lane, wave, G, bx;
    float* out; unsigned char* ws;
};
struct Args { const float* in[26]; float* out; unsigned char* ws; int ph_lo, ph_hi; };
typedef const float* cfp_t;
typedef __attribute__((address_space(4))) const cfp_t* ktab_t;
struct InTab { ktab_t p; __device__ __forceinline__ const float* operator[](int i) const { return p[i]; } };
enum { I_X = 0, I_NMG, I_WIN, I_MU, I_W0, I_W2, I_A0, I_A2, I_G2, I_KK, I_KA, I_RK, I_LNG, I_LNB, I_LQ1, I_LK1, I_LQ2, I_LK2, I_SUBG, I_WA, I_WB, I_WO, I_NFG, I_FF1, I_FF2, I_NFIN };

template <bool ROPE> __device__ __forceinline__ void p0_transpose_item(const float* W, int K, int N, bf16* WT, LAS float* scr, int item, int lane, int pitch = 0, int koff = 0) {
    if (pitch == 0) pitch = K;
    const int nblk = N / 32, kb = item / nblk, nb = item % nblk, k0 = 64 * kb, n0 = 32 * nb;
#pragma unroll
    for (int i = 0; i < 8; ++i) { const int kk = 8 * i + (lane >> 3), c4 = 4 * (lane & 7); const f32x4 w4 = *(const GAS f32x4*)(W + (size_t)(k0 + kk) * N + n0 + c4);
        scr[kk * 33 + c4] = w4.x; scr[kk * 33 + c4 + 1] = w4.y; scr[kk * 33 + c4 + 2] = w4.z; scr[kk * 33 + c4 + 3] = w4.w; }
    LDS_WAIT(); asm volatile("" ::: "memory");
    const int c = lane & 7;
#pragma unroll
    for (int j = 0; j < 4; ++j) { const int n = (lane >> 3) + 8 * j; const LAS float* s = scr + (8 * c) * 33 + n;
        v4u o; o.x = pk2(s[0 * 33], s[1 * 33]); o.y = pk2(s[2 * 33], s[3 * 33]); o.z = pk2(s[4 * 33], s[5 * 33]); o.w = pk2(s[6 * 33], s[7 * 33]);
        int col = n0 + n;
        if (ROPE && col < 1024) { const int d = col & 63, dd = d & 31; col = (col & ~63) + 8 * (dd >> 2) + (d >> 5) * 4 + (dd & 3); }
        *(GAS v4u*)(WT + (size_t)col * pitch + koff + k0 + 8 * c) = o; }
    LDS_WAIT(); asm volatile("" ::: "memory");
}
__device__ __forceinline__ void rms_row_to_bf16(const float* xrow, const float* g, bf16* orow, int lane) {
    const GAS f32x4* xr = (const GAS f32x4*)xrow + lane; const f32x4* gr = (const f32x4*)g + lane;
    f32x4 v[4]; float s = 0.f;
#pragma unroll
    for (int j = 0; j < 4; ++j) { v[j] = xr[64 * j]; s += (v[j].x * v[j].x + v[j].y * v[j].y) + (v[j].z * v[j].z + v[j].w * v[j].w); }
    const float rstd = 1.0f / sqrtf(wave_allsum(s) * (1.f / D) + NORM_EPS);
    GAS unsigned long long* o8 = (GAS unsigned long long*)orow + lane;
#pragma unroll
    for (int j = 0; j < 4; ++j) { const f32x4 gg = gr[64 * j];
        o8[64 * j] = (unsigned long long)pk2(v[j].x * rstd * gg.x, v[j].y * rstd * gg.y) | ((unsigned long long)pk2(v[j].z * rstd * gg.z, v[j].w * rstd * gg.w) << 32); }
}
__device__ __forceinline__ void rms_row_to_f32(const float* xrow, const float* g, float* orow, int lane) {
    const GAS f32x4* xr = (const GAS f32x4*)xrow + lane; const f32x4* gr = (const f32x4*)g + lane;
    f32x4 v[4]; float s = 0.f;
#pragma unroll
    for (int j = 0; j < 4; ++j) { v[j] = xr[64 * j]; s += (v[j].x * v[j].x + v[j].y * v[j].y) + (v[j].z * v[j].z + v[j].w * v[j].w); }
    const float rstd = 1.0f / sqrtf(wave_allsum(s) * (1.f / D) + NORM_EPS);
    GAS f32x4* o = (GAS f32x4*)orow + lane;
#pragma unroll
    for (int j = 0; j < 4; ++j) { const f32x4 gg = gr[64 * j]; o[64 * j] = v[j] * rstd * gg; }
}
__device__ __forceinline__ void p0_prologue(Frame& F, const InTab& A) {
    LAS float* scr = (LAS float*)(F.lds + RING_OFF + F.wave * 16384);
    const int gw = F.bx * NWAVES + F.wave, NGW = F.G * NWAVES;
    unsigned char* ws = F.ws;
    constexpr int I_IN = (D / 64) * (D_IN / 32), I_A = (512 / 64) * (D / 32), I_O = (D / 64) * (D / 32), I_1 = (D / 64) * (FF / 32), I_2 = (FF / 64) * (D / 32);
    (void)I_A; (void)I_O; (void)I_1; (void)I_2;
    for (int it = gw; it < I_IN; it += NGW) p0_transpose_item<true>(A[I_WIN], D, D_IN, (bf16*)(ws + WS_WIN), scr, it, F.lane);
    if (false) for (int it = gw; it < 0; it += NGW) {
        int r = it;
        if (r < I_A) { p0_transpose_item<false>(A[I_WA], 512, D, (bf16*)(ws + WS_WA), scr, r, F.lane, 1024, 0); continue; } r -= I_A;
        if (r < I_A) { p0_transpose_item<false>(A[I_WB], 512, D, (bf16*)(ws + WS_WA), scr, r, F.lane, 1024, 512); continue; } r -= I_A;
        if (r < I_O) { p0_transpose_item<false>(A[I_WO], D, D, (bf16*)(ws + WS_WO), scr, r, F.lane); continue; } r -= I_O;
        if (r < I_1) { p0_transpose_item<false>(A[I_FF1], D, FF, (bf16*)(ws + WS_W1), scr, r, F.lane); continue; } r -= I_1;
        p0_transpose_item<false>(A[I_FF2], FF, D, (bf16*)(ws + WS_W2), scr, r, F.lane);
    }
    const int gt = F.bx * (NWAVES * 64) + F.tid, NGT = F.G * NWAVES * 64;
    for (int e = gt; e < NLORA * (KLORA / 8); e += NGT) { const int n = e % NLORA, k8 = (e / NLORA) * 8; float v[8];
#pragma unroll
        for (int i = 0; i < 8; ++i) { const int k = k8 + i; float x = 0.f;
            if (n < 512) { if (k < 64) x = A[I_W2][(size_t)k * 512 + n]; }
            else if (n < 1024) { if (k >= 64 && k < 128) x = A[I_A2][(size_t)(k - 64) * 512 + (n - 512)]; }
            else { if (k >= 128) x = A[I_G2][(size_t)(k - 128) * 512 + (n - 1024)]; }
            v[i] = x; }
        v4u o; o.x = pk2(v[0], v[1]); o.y = pk2(v[2], v[3]); o.z = pk2(v[4], v[5]); o.w = pk2(v[6], v[7]);
        *(GAS v4u*)((bf16*)(ws + WS_WL) + (size_t)n * KLORA + k8) = o; }
    for (int e = gt; e < SEQ * 32; e += NGT) { const int pos = e >> 5, i = e & 31;
        const float inv = exp2f(-(float)i * 0.41524101186092029f);
        const float ang = (float)pos * inv; float s, c; sincosf(ang, &s, &c);
        ((float*)(ws + WS_ROPE_C))[e] = c; ((float*)(ws + WS_ROPE_S))[e] = s; }
    for (int m = gw; m < M; m += NGW) rms_row_to_bf16(A[I_X] + (size_t)m * D, A[I_NMG], (bf16*)(ws + WS_XN) + (size_t)m * D, F.lane);
}

__device__ __forceinline__ void late_weights(Frame& F, const InTab& A, int part, int nparts, int cu0) {
    int lane_ = F.lane; asm volatile("" : "+v"(lane_));
    LAS float* scr = (LAS float*)(F.lds + RING_OFF + F.wave * 16384);
    unsigned char* ws = F.ws;
    constexpr int I_A = (512 / 64) * (D / 32), I_O = (D / 64) * (D / 32), I_1 = (D / 64) * (FF / 32), I_2 = (FF / 64) * (D / 32), NIT = 2 * I_A + I_O + I_1 + I_2;
    const int per = NIT / nparts, lo = part * per, hi = lo + per;
    const int gw = (F.bx - cu0) * NWAVES + F.wave, NGW = (F.G - cu0) * NWAVES;
    for (int it = lo + gw; it < hi; it += NGW) {
        int r = it;
        if (r < I_A) { p0_transpose_item<false>(A[I_WA], 512, D, (bf16*)(ws + WS_WA), scr, r, lane_, 1024, 0); continue; } r -= I_A;
        if (r < I_A) { p0_transpose_item<false>(A[I_WB], 512, D, (bf16*)(ws + WS_WA), scr, r, lane_, 1024, 512); continue; } r -= I_A;
        if (r < I_O) { p0_transpose_item<false>(A[I_WO], D, D, (bf16*)(ws + WS_WO), scr, r, lane_); continue; } r -= I_O;
        if (r < I_1) { p0_transpose_item<false>(A[I_FF1], D, FF, (bf16*)(ws + WS_W1), scr, r, lane_); continue; } r -= I_1;
        p0_transpose_item<false>(A[I_FF2], FF, D, (bf16*)(ws + WS_W2), scr, r, lane_);
    }
}
__device__ __forceinline__ void prep1_phase(Frame& F, const InTab& A) {
    const int gw = F.bx * NWAVES + F.wave, NGW = F.G * NWAVES, lane = F.lane;
    const bf16* WAG = (const bf16*)(F.ws + WS_WAG); bf16* LIN = (bf16*)(F.ws + WS_LIN);
    const f32x4 mu = *(const f32x4*)(A[I_MU] + 1536 + 4 * lane);
    for (int g = gw; g < M / 8; g += NGW) {
        const int m0 = g * 8; v2u row[9];
        row[0] = (v2u){0u, 0u}; if ((m0 & (SEQ - 1)) != 0) row[0] = *(const GAS v2u*)(WAG + (size_t)(m0 - 1) * 256 + 4 * lane);
#pragma unroll
        for (int j = 0; j < 8; ++j) row[j + 1] = *(const GAS v2u*)(WAG + (size_t)(m0 + j) * 256 + 4 * lane);
#pragma unroll
        for (int j = 0; j < 8; ++j) {
            float z[4] = {bflo(row[j + 1].x), bfhi(row[j + 1].x), bflo(row[j + 1].y), bfhi(row[j + 1].y)}; const float p[4] = {bflo(row[j].x), bfhi(row[j].x), bflo(row[j].y), bfhi(row[j].y)};
#pragma unroll
            for (int e = 0; e < 4; ++e) { float v = z[e] + (p[e] - z[e]) * mu[e];
                if (lane < 16) v = 1.0f - 2.0f * __builtin_amdgcn_rcpf(1.0f + __expf(2.0f * v));
                else if (lane >= 32) v = __builtin_amdgcn_rcpf(1.0f + __expf(-v));
                z[e] = v; }
            v2u o; o.x = pk2(z[0], z[1]); o.y = pk2(z[2], z[3]);
            *(GAS v2u*)(LIN + (size_t)(m0 + j) * 256 + 4 * lane) = o;
        }
    }
}
struct ScanRaw { unsigned short r[9], k[9], v[9], a[8]; float d[8]; };
__device__ __forceinline__ void scan_load(ScanRaw& R, const bf16* RKV, const float* DEC, const bf16* AA, size_t row0, int t0, int c) {
#pragma unroll
    for (int j = 0; j < 9; ++j) { int t = t0 - 1 + j; if (t < 0) t = 0; const bf16* p = RKV + (row0 + t) * 1536 + c;
        R.r[j] = *(const GAS bf16*)p; R.k[j] = *(const GAS bf16*)(p + 512); R.v[j] = *(const GAS bf16*)(p + 1024); }
#pragma unroll
    for (int j = 0; j < 8; ++j) { R.d[j] = *(const GAS float*)(DEC + (row0 + t0 + j) * 512 + c); R.a[j] = *(const GAS bf16*)(AA + (row0 + t0 + j) * 512 + c); }
}
__device__ __forceinline__ void scan_phase(Frame& F, const InTab& A, int si) {
    const int lane = F.lane, wave = F.wave, tid = F.tid;
    const int bh = si >> 1, half = si & 1, b = bh >> 3, h = bh & 7, c = h * 64 + lane;
    LAS float* IN = (LAS float*)(F.lds + RING_OFF);
    LAS float* VV = IN + 5 * 4096;
    LAS float* YBUF = VV + 2048;
    const bf16* RKV = (const bf16*)(F.ws + WS_RKV); const float* DEC = (const float*)(F.ws + WS_DEC); const bf16* AA = (const bf16*)(F.ws + WS_AA);
    bf16* Y = (bf16*)(F.ws + WS_Y); float* BON = (float*)(F.ws + WS_BON);
    const float mu_r = A[I_MU][c], mu_k = A[I_MU][512 + c], mu_v = A[I_MU][1024 + c], kkc = A[I_KK][c], kac = A[I_KA][c], rkc = A[I_RK][c];
    const size_t row0 = (size_t)b * SEQ;
    const int myv = (int)(red4(0.f, 1.f, 2.f, 3.f) * (1.0f / 64.0f) + 0.5f);
    const int L0 = __builtin_ctzll(__ballot(myv == 0)), L1 = __builtin_ctzll(__ballot(myv == 1)), L2 = __builtin_ctzll(__ballot(myv == 2)), L3 = __builtin_ctzll(__ballot(myv == 3));
    float S0 = 0.f, S1 = 0.f, S2 = 0.f, S3 = 0.f;
    ScanRaw R; scan_load(R, RKV, DEC, AA, row0, wave * 8, c);
    for (int blk = 0; blk < SEQ / 64; ++blk) {
        {
            const int t0 = blk * 64 + wave * 8;
            f32x4 qd[2], qa[2], qb[2], qk[2], qr[2], qv[2];
#pragma unroll
            for (int j = 0; j < 8; ++j) {
                const float pz = (t0 + j == 0) ? 0.f : 1.f;
                const float rt_ = bf1(R.r[j + 1]), kt_ = bf1(R.k[j + 1]), vt_ = bf1(R.v[j + 1]);
                const float rs = rt_ + (bf1(R.r[j]) * pz - rt_) * mu_r, ks = kt_ + (bf1(R.k[j]) * pz - kt_) * mu_k, vs = vt_ + (bf1(R.v[j]) * pz - vt_) * mu_v;
                const float kkr = ks * kkc, n2 = wave_allsum(kkr * kkr), kk = kkr / __builtin_fmaxf(sqrtf(n2), 1e-12f);
                const float a = 1.0f / (1.0f + __expf(-bf1(R.a[j]))), kx = ks * (1.0f + (a - 1.0f) * kac);
                const float bon = wave_allsum(rs * kx * rkc);
                if (half == 0 && lane == 0) BON[(row0 + t0 + j) * 8 + h] = bon;
                qd[j >> 2][j & 3] = __expf(-0.6065306597f / (1.0f + __expf(-R.d[j])));     qa[j >> 2][j & 3] = -kk; qb[j >> 2][j & 3] = kk * a; qk[j >> 2][j & 3] = kx; qr[j >> 2][j & 3] = rs; qv[j >> 2][j & 3] = vs;
            }
#pragma unroll
            for (int q = 0; q < 2; ++q) { const int t4 = wave * 2 + q; LAS f32x4* p = (LAS f32x4*)IN + t4 * 64 + lane;
                p[0 * 1024] = qd[q]; p[1 * 1024] = qa[q]; p[2 * 1024] = qb[q]; p[3 * 1024] = qk[q]; p[4 * 1024] = qr[q];
                if ((lane >> 5) == half) ((LAS f32x4*)VV)[t4 * 32 + (lane & 31)] = qv[q]; }
        }
        __syncthreads();
        if (blk + 1 < SEQ / 64) scan_load(R, RKV, DEC, AA, row0, (blk + 1) * 64 + wave * 8, c);
#pragma unroll 1
        for (int t4 = 0; t4 < 16; ++t4) {
            const LAS f32x4* p = (const LAS f32x4*)IN + t4 * 64 + lane;
            const f32x4 W4 = p[0], A4 = p[1024], B4 = p[2048], K4 = p[3072], R4 = p[4096];
            const LAS f32x4* pv = (const LAS f32x4*)VV + t4 * 32 + wave * 4;
            const f32x4 V0 = pv[0], V1 = pv[1], V2 = pv[2], V3 = pv[3];
            f32x4 yq;
#pragma unroll
            for (int ts = 0; ts < 4; ++ts) {
                const float w = W4[ts], a = A4[ts], bb = B4[ts], kx = K4[ts], r = R4[ts];
                const float t = red4(S0 * a, S1 * a, S2 * a, S3 * a);
                const float sa0 = __builtin_bit_cast(float, __builtin_amdgcn_readlane(__builtin_bit_cast(int, t), L0)), sa1 = __builtin_bit_cast(float, __builtin_amdgcn_readlane(__builtin_bit_cast(int, t), L1));
                const float sa2 = __builtin_bit_cast(float, __builtin_amdgcn_readlane(__builtin_bit_cast(int, t), L2)), sa3 = __builtin_bit_cast(float, __builtin_amdgcn_readlane(__builtin_bit_cast(int, t), L3));
                S0 = S0 * w + (sa0 * bb + V0[ts] * kx); S1 = S1 * w + (sa1 * bb + V1[ts] * kx); S2 = S2 * w + (sa2 * bb + V2[ts] * kx); S3 = S3 * w + (sa3 * bb + V3[ts] * kx);
                yq[ts] = red4(S0 * r, S1 * r, S2 * r, S3 * r);
            }
            if ((lane & 15) == 0) *(LAS f32x4*)(YBUF + (wave * 4 + myv) * 68 + t4 * 4) = yq;
        }
        __syncthreads();
        { const int t = tid >> 3, rg = tid & 7; const LAS float* yb = YBUF + (4 * rg) * 68 + t;
          v2u o; o.x = pk2(yb[0], yb[68]); o.y = pk2(yb[136], yb[204]);
          *(GAS v2u*)(Y + (row0 + blk * 64 + t) * 512 + h * 64 + 32 * half + 4 * rg) = o; }
    }
    __syncthreads();
}
__device__ __forceinline__ void post_phase(Frame& F, const InTab& A) {
    const int gw = F.bx * NWAVES + F.wave, NGW = F.G * NWAVES, lane = F.lane;
    const bf16* O = (const bf16*)(F.ws + WS_O); const bf16* Y = (const bf16*)(F.ws + WS_Y); const bf16* RKV = (const bf16*)(F.ws + WS_RKV); const bf16* GG = (const bf16*)(F.ws + WS_GG);
    const float* BON = (const float*)(F.ws + WS_BON); bf16* YA = (bf16*)(F.ws + WS_YA);
    const float lam = __expf(wave_allsum(A[I_LQ1][lane] * A[I_LK1][lane])) - __expf(wave_allsum(A[I_LQ2][lane] * A[I_LK2][lane])) + LAMBDA_INIT;
    const int ca = 8 * lane, ha = lane >> 4, ea = ca & 127;
    const int hb = lane >> 3;
    float sg[8], lg[8], lb[8], muv[8];
#pragma unroll
    for (int e = 0; e < 8; ++e) { sg[e] = A[I_SUBG][ea + e] * (1.0f - LAMBDA_INIT); lg[e] = A[I_LNG][ca + e]; lb[e] = A[I_LNB][ca + e]; muv[e] = A[I_MU][1024 + ca + e]; }
#define UNPK8(w_) {bflo(w_.x), bfhi(w_.x), bflo(w_.y), bfhi(w_.y), bflo(w_.z), bfhi(w_.z), bflo(w_.w), bfhi(w_.w)}
    for (int g = gw; g < M / 4; g += NGW) {
        const int m0 = g * 4;
        v4u o0[4], o1[4], yr[4], gr[4], vr[5]; float bon[4];
        vr[0] = (v4u){0u, 0u, 0u, 0u}; if ((m0 & (SEQ - 1)) != 0) vr[0] = *(const GAS v4u*)(RKV + (size_t)(m0 - 1) * 1536 + 1024 + ca);
#pragma unroll
        for (int j = 0; j < 4; ++j) { const size_t mm = (size_t)(m0 + j);
            o0[j] = *(const GAS v4u*)(O + mm * 1024 + (2 * ha) * 128 + ea); o1[j] = *(const GAS v4u*)(O + mm * 1024 + (2 * ha + 1) * 128 + ea);
            yr[j] = *(const GAS v4u*)(Y + mm * 512 + ca); gr[j] = *(const GAS v4u*)(GG + mm * 512 + ca); vr[j + 1] = *(const GAS v4u*)(RKV + mm * 1536 + 1024 + ca);
            bon[j] = *(const GAS float*)(BON + mm * 8 + hb); }
#pragma unroll
        for (int j = 0; j < 4; ++j) { const size_t mm = (size_t)(m0 + j);
            {
                const float a0[8] = UNPK8(o0[j]), a1[8] = UNPK8(o1[j]); float o[8], ss = 0.f;
#pragma unroll
                for (int e = 0; e < 8; ++e) { o[e] = a0[e] - lam * a1[e]; ss += o[e] * o[e]; }
                const float rstd = __builtin_amdgcn_rsqf(row16_allsum(ss) * (1.0f / 128.0f) + SUBLN_EPS);
                v4u w; w.x = pk2(o[0] * rstd * sg[0], o[1] * rstd * sg[1]); w.y = pk2(o[2] * rstd * sg[2], o[3] * rstd * sg[3]); w.z = pk2(o[4] * rstd * sg[4], o[5] * rstd * sg[5]); w.w = pk2(o[6] * rstd * sg[6], o[7] * rstd * sg[7]);
                *(GAS v4u*)(YA + mm * 1024 + ca) = w;
            }
            {
                const float y[8] = UNPK8(yr[j]), gq[8] = UNPK8(gr[j]), v[8] = UNPK8(vr[j + 1]), p[8] = UNPK8(vr[j]);
                float s = 0.f;
#pragma unroll
                for (int e = 0; e < 8; ++e) s += y[e];
                const float mean = oct_allsum(s) * (1.0f / 64.0f); float q = 0.f;
#pragma unroll
                for (int e = 0; e < 8; ++e) { const float d = y[e] - mean; q += d * d; }
                const float rstd = __builtin_amdgcn_rsqf(oct_allsum(q) * (1.0f / 64.0f) + GN_EPS);
                float r[8];
#pragma unroll
                for (int e = 0; e < 8; ++e) { const float vs = v[e] + (p[e] - v[e]) * muv[e]; r[e] = (((y[e] - mean) * rstd) * lg[e] + lb[e] + bon[j] * vs) * gq[e]; }
                v4u w; w.x = pk2(r[0], r[1]); w.y = pk2(r[2], r[3]); w.z = pk2(r[4], r[5]); w.w = pk2(r[6], r[7]);
                *(GAS v4u*)(YA + mm * 1024 + 512 + ca) = w;
            }
        }
    }
#undef UNPK8
}

typedef short rk_bf16x8 __attribute__((ext_vector_type(8)));
typedef float rk_f32x16 __attribute__((ext_vector_type(16)));
constexpr int RKA_RS_K = 144, RKA_RS_J = 80;
constexpr int RKA_A = 0, RKA_B = 5120, RKA_K = 10240, RKA_R = 15360, RKA_AT = 19968, RKA_BH = 25088, RKA_KH = 30208, RKA_VT = 35328, RKA_GC = 40448, RKA_BYTES = 40704;
constexpr int RKA_N = 0, RKA_X = 0, RKA_T = 5120, RKA_MAK = 7680, RKA_MRB = 10240, RKA_MRK = 12800;
constexpr int RKA_WAVES = 4;
static_assert(RKA_WAVES * RKA_BYTES <= 162816, "phase A LDS");
constexpr size_t WS_PQ = 66 * MiB;
constexpr size_t WS_RY = 98 * MiB;
constexpr size_t WS_GC = 242 * MiB;
constexpr size_t WS_SST = 243 * MiB;

__device__ __forceinline__ rk_bf16x8 rk_frag(const LAS unsigned char* base, int rs, int row, int s, int h) { return *(const LAS rk_bf16x8*)(base + row * rs + (16 * s + 8 * h) * 2); }
__device__ __forceinline__ rk_f32x16 rk_mfma(rk_bf16x8 a, rk_bf16x8 b, rk_f32x16 c) { return __builtin_amdgcn_mfma_f32_32x32x16_bf16(a, b, c, 0, 0, 0); }
__device__ __forceinline__ unsigned rk_pk(float lo, float hi) { typedef float f2_ __attribute__((ext_vector_type(2))); typedef __bf16 b2_ __attribute__((ext_vector_type(2))); f2_ v = {lo, hi}; b2_ b = __builtin_convertvector(v, b2_); return __builtin_bit_cast(unsigned, b); }
__device__ __forceinline__ void rk_store_tile_lds(LAS unsigned char* base, int rs, int nrow, int mbase, int h, const rk_f32x16& acc) {
#pragma unroll
    for (int g = 0; g < 4; ++g) { v2u w; w.x = rk_pk(acc[4 * g], acc[4 * g + 1]); w.y = rk_pk(acc[4 * g + 2], acc[4 * g + 3]); *(LAS v2u*)(base + nrow * rs + (mbase + 8 * g + 4 * h) * 2) = w; }
}
__device__ __forceinline__ void rk_store_tile_glb(bf16* base, int pitch, int nrow, int mbase, int h, const rk_f32x16& acc) {
#pragma unroll
    for (int g = 0; g < 4; ++g) { v2u w; w.x = rk_pk(acc[4 * g], acc[4 * g + 1]); w.y = rk_pk(acc[4 * g + 2], acc[4 * g + 3]); *(GAS v2u*)(base + (size_t)nrow * pitch + mbase + 8 * g + 4 * h) = w; }
}
__device__ __forceinline__ void rk_store_tile_frag(unsigned char* base, int nt, int r32, int mt, int h, const rk_f32x16& acc) {
#pragma unroll
    for (int g = 0; g < 4; ++g) { v2u w; w.x = rk_pk(acc[4 * g], acc[4 * g + 1]); w.y = rk_pk(acc[4 * g + 2], acc[4 * g + 3]);
        *(GAS v2u*)(base + ((size_t)((nt * 4 + 2 * mt + (g >> 1)) * 64 + r32 + 32 * (g & 1))) * 16 + 8 * h) = w; }
}
__device__ __forceinline__ void rk_store_blob(unsigned* blob, int lane, const rk_f32x16& acc) {
    v4u w0, w1; w0.x = rk_pk(acc[0], acc[1]); w0.y = rk_pk(acc[2], acc[3]); w0.z = rk_pk(acc[4], acc[5]); w0.w = rk_pk(acc[6], acc[7]);
    w1.x = rk_pk(acc[8], acc[9]); w1.y = rk_pk(acc[10], acc[11]); w1.z = rk_pk(acc[12], acc[13]); w1.w = rk_pk(acc[14], acc[15]);
    *(GAS v4u*)(blob + lane * 8) = w0; *(GAS v4u*)(blob + lane * 8 + 4) = w1;
}
struct RkBlob { v4u w0, w1; };
__device__ __forceinline__ RkBlob rk_load_blob(const unsigned* blob, int lane) { RkBlob b; b.w0 = *(const GAS v4u*)(blob + lane * 8); b.w1 = *(const GAS v4u*)(blob + lane * 8 + 4); return b; }
__device__ __forceinline__ rk_f32x16 rk_blob_f32(const RkBlob& b) {
    rk_f32x16 a; const unsigned w[8] = {b.w0.x, b.w0.y, b.w0.z, b.w0.w, b.w1.x, b.w1.y, b.w1.z, b.w1.w};
#pragma unroll
    for (int i = 0; i < 8; ++i) { a[2 * i] = bflo(w[i]); a[2 * i + 1] = bfhi(w[i]); }
    return a;
}

struct RkRaw { unsigned short r[8], k[8], v[8], a[8]; float d[8]; };
__device__ __forceinline__ void rk_load8(RkRaw& R, const bf16* prkv, const float* pdec, const bf16* paa) {
#pragma unroll
    for (int j = 0; j < 8; ++j) { R.r[j] = *(const GAS bf16*)(prkv + j * 1536); R.k[j] = *(const GAS bf16*)(prkv + j * 1536 + 512); R.v[j] = *(const GAS bf16*)(prkv + j * 1536 + 1024);
        R.d[j] = *(const GAS float*)(pdec + j * 512); R.a[j] = *(const GAS bf16*)(paa + j * 512); }
}
__device__ __forceinline__ void rwkvA_unit(LAS unsigned char* L, const InTab& A, unsigned char* ws, int bh, int chunk, int lane_in) {
    int lane = lane_in; asm volatile("" : "+v"(lane));
    const int b = bh >> 3, hd = bh & 7, cg = hd * 64 + lane, r32 = lane & 31, h = lane >> 5;
    const size_t row0 = (size_t)b * SEQ + (size_t)chunk * 32;
    const int uh = bh * 32 + (chunk & 31);
    const bf16* prkv = (const bf16*)(ws + WS_RKV) + row0 * 1536 + cg; const float* pdec = (const float*)(ws + WS_DEC) + row0 * 512 + cg; const bf16* paa = (const bf16*)(ws + WS_AA) + row0 * 512 + cg;
    float* pbon = (float*)(ws + WS_BON) + row0 * 8 + hd;
    const float mu_r = A[I_MU][cg], mu_k = A[I_MU][512 + cg], mu_v = A[I_MU][1024 + cg], kkc = A[I_KK][cg], kac = A[I_KA][cg], rkc = A[I_RK][cg];
    const int myv = (int)(red4(0.f, 1.f, 2.f, 3.f) * (1.0f / 64.0f) + 0.5f);
    const int L0 = __builtin_ctzll(__ballot(myv == 0)), L1 = __builtin_ctzll(__ballot(myv == 1)), L2 = __builtin_ctzll(__ballot(myv == 2)), L3 = __builtin_ctzll(__ballot(myv == 3));
    float rp = 0.f, kp = 0.f, vp = 0.f;
    if (chunk != 0) { rp = bf1(*(const GAS bf16*)(prkv - 1536)); kp = bf1(*(const GAS bf16*)(prkv - 1536 + 512)); vp = bf1(*(const GAS bf16*)(prkv - 1536 + 1024)); }
    float G = 1.0f;
    RkRaw Rc, Rn; rk_load8(Rc, prkv, pdec, paa);
#pragma unroll 1
    for (int q = 0; q < 4; ++q) {
        prkv += 8 * 1536; pdec += 8 * 512; paa += 8 * 512;
        if (q < 3) rk_load8(Rn, prkv, pdec, paa);
        LAS unsigned char* Lr = L + (8 * q) * RKA_RS_K + lane * 2;
        LAS unsigned char* Lt = L + lane * RKA_RS_J + (8 * q) * 2;
        unsigned tA[4], tB[4], tK[4], tV[4], pA = 0, pB = 0, pK = 0, pV = 0;
        float rs_[8], kx_[8], kkr_[8], a8_[8], w8_[8], vs_[8];
#pragma unroll
        for (int j = 0; j < 8; ++j) {
            const float rc = bf1(Rc.r[j]), kc = bf1(Rc.k[j]), vc = bf1(Rc.v[j]);
            const float ks = kc + (kp - kc) * mu_k; rs_[j] = rc + (rp - rc) * mu_r; vs_[j] = vc + (vp - vc) * mu_v; rp = rc; kp = kc; vp = vc;
            kkr_[j] = ks * kkc; a8_[j] = __builtin_amdgcn_rcpf(1.0f + __expf(-bf1(Rc.a[j]))); kx_[j] = ks * (1.0f + (a8_[j] - 1.0f) * kac);
            w8_[j] = __expf(-0.6065306597f * __builtin_amdgcn_rcpf(1.0f + __expf(-Rc.d[j])));
        }
        float n2_[8], bon_[8];
#pragma unroll
        for (int j = 0; j < 8; j += 2) {
            const float t = red4(kkr_[j] * kkr_[j], kkr_[j + 1] * kkr_[j + 1], rs_[j] * kx_[j] * rkc, rs_[j + 1] * kx_[j + 1] * rkc);
            n2_[j] = __builtin_bit_cast(float, __builtin_amdgcn_readlane(__builtin_bit_cast(int, t), L0)); n2_[j + 1] = __builtin_bit_cast(float, __builtin_amdgcn_readlane(__builtin_bit_cast(int, t), L1));
            bon_[j] = __builtin_bit_cast(float, __builtin_amdgcn_readlane(__builtin_bit_cast(int, t), L2)); bon_[j + 1] = __builtin_bit_cast(float, __builtin_amdgcn_readlane(__builtin_bit_cast(int, t), L3));
        }
        if (lane < 8) { float bv = bon_[0];
#pragma unroll
            for (int j = 1; j < 8; ++j) bv = (lane == j) ? bon_[j] : bv;
            *(GAS float*)(pbon + (8 * q + lane) * 8) = bv; }
#pragma unroll
        for (int j = 0; j < 8; ++j) {
            const float kk = kkr_[j] * __builtin_amdgcn_rsqf(__builtin_fmaxf(n2_[j], 1e-24f));
            const float Gprev = G; G *= w8_[j]; const float iG = __builtin_amdgcn_rcpf(G);
            const bf16 at = (bf16)f2bf(-kk * Gprev), rt = (bf16)f2bf(rs_[j] * G), bt = (bf16)f2bf(kk * a8_[j] * iG), kt = (bf16)f2bf(kx_[j] * iG), vb = (bf16)f2bf(vs_[j]);
            *(LAS bf16*)(Lr + RKA_A + j * RKA_RS_K) = at; *(LAS bf16*)(Lr + RKA_R + j * RKA_RS_K) = rt; *(LAS bf16*)(Lr + RKA_B + j * RKA_RS_K) = bt; *(LAS bf16*)(Lr + RKA_K + j * RKA_RS_K) = kt;
            if (j & 1) { tA[j >> 1] = pA | ((unsigned)at << 16); tB[j >> 1] = pB | ((unsigned)bt << 16); tK[j >> 1] = pK | ((unsigned)kt << 16); tV[j >> 1] = pV | ((unsigned)vb << 16); } else { pA = at; pB = bt; pK = kt; pV = vb; }
        }
        *(LAS v4u*)(Lt + RKA_AT) = (v4u){tA[0], tA[1], tA[2], tA[3]}; *(LAS v4u*)(Lt + RKA_BH) = (v4u){tB[0], tB[1], tB[2], tB[3]}; *(LAS v4u*)(Lt + RKA_KH) = (v4u){tK[0], tK[1], tK[2], tK[3]}; *(LAS v4u*)(Lt + RKA_VT) = (v4u){tV[0], tV[1], tV[2], tV[3]};
        Rc = Rn;
    }
    const float GC = G;
    *(GAS float*)((float*)(ws + WS_GC) + (size_t)uh * 64 + lane) = GC;
    *(LAS float*)(L + RKA_GC + lane * 4) = GC;
    LDS_WAIT(); asm volatile("" ::: "memory");
    {
        rk_f32x16 aN = {}, aAK = {}, aRB = {}, aRK = {};
#pragma unroll
        for (int s = 0; s < 4; ++s) {
            const rk_bf16x8 fA = rk_frag(L + RKA_A, RKA_RS_K, r32, s, h), fR = rk_frag(L + RKA_R, RKA_RS_K, r32, s, h), fB = rk_frag(L + RKA_B, RKA_RS_K, r32, s, h), fK = rk_frag(L + RKA_K, RKA_RS_K, r32, s, h);
            aN = rk_mfma(fB, fA, aN); aAK = rk_mfma(fK, fA, aAK); aRB = rk_mfma(fB, fR, aRB); aRK = rk_mfma(fK, fR, aRK);
        }
        LDS_WAIT(); asm volatile("" ::: "memory");
#pragma unroll
        for (int i = 0; i < 16; ++i) { const int j = (i & 3) + 8 * (i >> 2) + 4 * h;
            if (!(j < r32)) { aN[i] = 0.f; aAK[i] = 0.f; }
            if (!(j <= r32)) { aRB[i] = 0.f; aRK[i] = 0.f; } }
#pragma unroll
        for (int g = 0; g < 4; ++g) *(LAS f32x4*)(L + RKA_N + r32 * 144 + (8 * g + 4 * h) * 4) = (f32x4){aN[4 * g], aN[4 * g + 1], aN[4 * g + 2], aN[4 * g + 3]};
        rk_store_tile_lds(L + RKA_MAK, RKA_RS_J, r32, 0, h, aAK); rk_store_tile_lds(L + RKA_MRB, RKA_RS_J, r32, 0, h, aRB); rk_store_tile_lds(L + RKA_MRK, RKA_RS_J, r32, 0, h, aRK);
    }
    LDS_WAIT(); asm volatile("" ::: "memory");
    {
        float T[32];
#pragma unroll
        for (int t = 0; t < 32; ++t) { float acc = (r32 == t) ? 1.0f : 0.0f;
#pragma unroll
            for (int j4 = 0; j4 < (t + 3) / 4; ++j4) { const f32x4 n4 = *(const LAS f32x4*)(L + RKA_N + t * 144 + j4 * 16);
#pragma unroll
                for (int e = 0; e < 4; ++e) if (4 * j4 + e < t) acc += n4[e] * T[4 * j4 + e]; }
            T[t] = acc; }
        LDS_WAIT(); asm volatile("" ::: "memory");
#pragma unroll
        for (int t = 0; t < 32; ++t) *(LAS bf16*)(L + RKA_T + t * RKA_RS_J + r32 * 2) = (bf16)f2bf(T[t]);
    }
    LDS_WAIT(); asm volatile("" ::: "memory");
    rk_bf16x8 fT[2];
#pragma unroll
    for (int s = 0; s < 2; ++s) fT[s] = rk_frag(L + RKA_T, RKA_RS_J, r32, s, h);
    {
        rk_f32x16 x0[2] = {{}, {}}, ap[2] = {{}, {}};
#pragma unroll
        for (int s = 0; s < 2; ++s) { const rk_bf16x8 fM = rk_frag(L + RKA_MAK, RKA_RS_J, r32, s, h);
#pragma unroll
            for (int nt = 0; nt < 2; ++nt) { x0[nt] = rk_mfma(fM, rk_frag(L + RKA_VT, RKA_RS_J, nt * 32 + r32, s, h), x0[nt]); ap[nt] = rk_mfma(fT[s], rk_frag(L + RKA_AT, RKA_RS_J, nt * 32 + r32, s, h), ap[nt]); } }
        LDS_WAIT(); asm volatile("" ::: "memory");
#pragma unroll
        for (int nt = 0; nt < 2; ++nt) { rk_store_tile_lds(L + RKA_X, RKA_RS_J, nt * 32 + r32, 0, h, x0[nt]); rk_store_tile_lds(L + RKA_AT, RKA_RS_J, nt * 32 + r32, 0, h, ap[nt]); }
    }
    LDS_WAIT(); asm volatile("" ::: "memory");
    {
        rk_f32x16 u0[2] = {{}, {}};
#pragma unroll
        for (int s = 0; s < 2; ++s)
#pragma unroll
            for (int nt = 0; nt < 2; ++nt) u0[nt] = rk_mfma(fT[s], rk_frag(L + RKA_X, RKA_RS_J, nt * 32 + r32, s, h), u0[nt]);
        LDS_WAIT(); asm volatile("" ::: "memory");
#pragma unroll
        for (int nt = 0; nt < 2; ++nt) rk_store_tile_lds(L + RKA_X, RKA_RS_J, nt * 32 + r32, 0, h, u0[nt]);
    }
    LDS_WAIT(); asm volatile("" ::: "memory");
    unsigned char* pq = ws + WS_PQ + (size_t)uh * 16384; unsigned char* ry = ws + WS_RY + (size_t)uh * 8192;
    rk_bf16x8 fRB[2], fRK[2], fAp[2][2], fBh[2][2], fKh[2][2], fU[2][2], fV[2][2];
#pragma unroll
    for (int s = 0; s < 2; ++s) { fRB[s] = rk_frag(L + RKA_MRB, RKA_RS_J, r32, s, h); fRK[s] = rk_frag(L + RKA_MRK, RKA_RS_J, r32, s, h);
#pragma unroll
        for (int nt = 0; nt < 2; ++nt) { fAp[nt][s] = rk_frag(L + RKA_AT, RKA_RS_J, nt * 32 + r32, s, h); fBh[nt][s] = rk_frag(L + RKA_BH, RKA_RS_J, nt * 32 + r32, s, h);
            fKh[nt][s] = rk_frag(L + RKA_KH, RKA_RS_J, nt * 32 + r32, s, h); fU[nt][s] = rk_frag(L + RKA_X, RKA_RS_J, nt * 32 + r32, s, h); fV[nt][s] = rk_frag(L + RKA_VT, RKA_RS_J, nt * 32 + r32, s, h); } }
#pragma unroll
    for (int kt = 0; kt < 2; ++kt) {
        rk_f32x16 acc;
#pragma unroll
        for (int g = 0; g < 4; ++g) { const v2u w = *(const LAS v2u*)(L + RKA_R + r32 * RKA_RS_K + (kt * 32 + 8 * g + 4 * h) * 2); acc[4 * g] = bflo(w.x); acc[4 * g + 1] = bfhi(w.x); acc[4 * g + 2] = bflo(w.y); acc[4 * g + 3] = bfhi(w.y); }
#pragma unroll
        for (int s = 0; s < 2; ++s) acc = rk_mfma(fAp[kt][s], fRB[s], acc);
        rk_store_tile_frag(ry, 0, r32, kt, h, acc);
    }
#pragma unroll
    for (int kt = 0; kt < 2; ++kt)
#pragma unroll
        for (int kq = 0; kq < 2; ++kq) { rk_f32x16 acc = {};
#pragma unroll
            for (int s = 0; s < 2; ++s) acc = rk_mfma(fAp[kq][s], fBh[kt][s], acc);
            acc = acc * *(const LAS float*)(L + RKA_GC + (kt * 32 + r32) * 4);
            rk_store_tile_frag(pq, kt, r32, kq, h, acc); }
#pragma unroll
    for (int vt = 0; vt < 2; ++vt) {
        rk_f32x16 acc = {};
#pragma unroll
        for (int s = 0; s < 2; ++s) { acc = rk_mfma(fU[vt][s], fRB[s], acc); acc = rk_mfma(fV[vt][s], fRK[s], acc); }
        rk_store_blob((unsigned*)(ry + 4096) + vt * 512, lane, acc);
    }
#pragma unroll
    for (int kt = 0; kt < 2; ++kt)
#pragma unroll
        for (int vt = 0; vt < 2; ++vt) { rk_f32x16 acc = {};
#pragma unroll
            for (int s = 0; s < 2; ++s) { acc = rk_mfma(fBh[kt][s], fU[vt][s], acc); acc = rk_mfma(fKh[kt][s], fV[vt][s], acc); }
#pragma unroll
            for (int g = 0; g < 4; ++g) { const f32x4 gq = *(const LAS f32x4*)(L + RKA_GC + (kt * 32 + 8 * g + 4 * h) * 4); acc[4 * g] *= gq[0]; acc[4 * g + 1] *= gq[1]; acc[4 * g + 2] *= gq[2]; acc[4 * g + 3] *= gq[3]; }
            rk_store_blob((unsigned*)(pq + 8192) + (kt * 2 + vt) * 512, lane, acc); }
    LDS_WAIT(); asm volatile("" ::: "memory");
}
__device__ __forceinline__ void rwkvA_phase(Frame& F, const InTab& A, int half) {
    if (F.wave >= RKA_WAVES) return;
    LAS unsigned char* L = F.lds + RING_OFF + F.wave * RKA_BYTES;
    const int gw = F.bx * RKA_WAVES + F.wave, NGW = F.G * RKA_WAVES;
    for (int u = gw; u < 64 * 32; u += NGW) rwkvA_unit(L, A, F.ws, u >> 5, half * 32 + (u & 31), F.lane);
}
constexpr int RKB_RS = 144, RKB_SBUF = 64 * RKB_RS;
__device__ __forceinline__ void rwkvB_phase(Frame& F, int bh, int half) {
    int lane = F.lane; asm volatile("" : "+v"(lane));
    const int wave = F.wave, r32 = lane & 31, h = lane >> 5;
    LAS unsigned char* SB = F.lds + RING_OFF;
    unsigned char* ws = F.ws;
    const int b = bh >> 3, hd = bh & 7;
    bf16* Y = (bf16*)(ws + WS_Y);
    const int kt = (wave >> 1) & 1, vt = wave & 1;
    float* sst = (float*)(ws + WS_SST) + (size_t)bh * 4096 + (size_t)(wave & 3) * 1024;
    rk_f32x16 st = {};
    if (wave < 4) {
        if (half != 0) {
#pragma unroll
            for (int i = 0; i < 16; ++i) st[i] = *(const GAS float*)(sst + i * 64 + lane);
        }
        rk_store_tile_lds(SB, RKB_RS, vt * 32 + r32, kt * 32, h, st);
    }
    const int uh0 = bh * 32; const bool isS = wave < 4, isY = !isS && wave < 6;
    const unsigned char* fptr = isS ? ws + WS_PQ + (size_t)uh0 * 16384 + (kt * 256 + lane) * 16 : ws + WS_RY + (size_t)uh0 * 8192 + lane * 16;
    const unsigned char* bptr = isS ? ws + WS_PQ + (size_t)uh0 * 16384 + 8192 + (kt * 2 + vt) * 2048 + lane * 32 : ws + WS_RY + (size_t)uh0 * 8192 + 4096 + vt * 2048 + lane * 32;
    const LAS unsigned char* gl = SB + 2 * RKB_SBUF + (kt * 32 + 4 * h) * 4;
    const int fstride = isS ? 16384 : 8192;
    struct Op { v4u f[4]; v4u b0, b1; };
    { const int tid_ = wave * 64 + lane; *(LAS f32x4*)(SB + 2 * RKB_SBUF + tid_ * 16) = *(const GAS f32x4*)(ws + WS_GC + (size_t)uh0 * 256 + tid_ * 16); }
    Op o0, o1, o2;
#define RKB_LOAD(O_, c) do { const unsigned char* fp_ = fptr + (size_t)(c) * fstride; const unsigned char* bp_ = bptr + (size_t)(c) * fstride; \
        _Pragma("unroll") for (int s = 0; s < 4; ++s) O_.f[s] = *(const GAS v4u*)(fp_ + 1024 * s); \
        O_.b0 = *(const GAS v4u*)bp_; O_.b1 = *(const GAS v4u*)(bp_ + 16); } while (0)
#define RKB_BAR() do { asm volatile("s_waitcnt lgkmcnt(0)" ::: "memory"); __builtin_amdgcn_s_barrier(); asm volatile("" ::: "memory"); } while (0)
#define RKB_NEXT(O_, c, AH_) RKB_LOAD(O_, ((c) + (AH_) < 32 ? (c) + (AH_) : 31))
#define RKB_STEP_S(O_, c) do { \
        const LAS unsigned char* cur = SB + ((c) & 1) * RKB_SBUF; LAS unsigned char* nxt = SB + (((c) & 1) ^ 1) * RKB_SBUF; \
        rk_bf16x8 fS[4]; _Pragma("unroll") for (int s = 0; s < 4; ++s) fS[s] = rk_frag(cur, RKB_RS, vt * 32 + r32, s, h); \
        RkBlob bb_; bb_.w0 = O_.b0; bb_.w1 = O_.b1; const rk_f32x16 q = rk_blob_f32(bb_); \
        _Pragma("unroll") for (int g = 0; g < 4; ++g) { const f32x4 gq = *(const LAS f32x4*)(gl + (c) * 256 + 32 * g); \
            st[4 * g] = st[4 * g] * gq[0] + q[4 * g]; st[4 * g + 1] = st[4 * g + 1] * gq[1] + q[4 * g + 1]; st[4 * g + 2] = st[4 * g + 2] * gq[2] + q[4 * g + 2]; st[4 * g + 3] = st[4 * g + 3] * gq[3] + q[4 * g + 3]; } \
        _Pragma("unroll") for (int s = 0; s < 4; ++s) st = rk_mfma(__builtin_bit_cast(rk_bf16x8, O_.f[s]), fS[s], st); \
        RKB_NEXT(O_, c, 5); \
        rk_store_tile_lds(nxt, RKB_RS, vt * 32 + r32, kt * 32, h, st); \
        RKB_BAR(); } while (0)
#define RKB_STEP_Y(O_, c) do { \
        const LAS unsigned char* cur = SB + ((c) & 1) * RKB_SBUF; \
        rk_bf16x8 fS[4]; _Pragma("unroll") for (int s = 0; s < 4; ++s) fS[s] = rk_frag(cur, RKB_RS, vt * 32 + r32, s, h); \
        RkBlob bb_; bb_.w0 = O_.b0; bb_.w1 = O_.b1; rk_f32x16 acc = rk_blob_f32(bb_); \
        _Pragma("unroll") for (int s = 0; s < 4; ++s) acc = rk_mfma(fS[s], __builtin_bit_cast(rk_bf16x8, O_.f[s]), acc);       \
        RKB_NEXT(O_, c, 3); \
        rk_store_tile_glb(Y + ((size_t)b * SEQ + (size_t)(half * 32 + (c)) * 32) * 512 + hd * 64, 512, r32, vt * 32, h, acc); \
        RKB_BAR(); } while (0)
    if (isY) { RKB_LOAD(o0, 0); RKB_LOAD(o1, 1); RKB_LOAD(o2, 2); }
    __syncthreads();
    if (isS) {
        Op o3, o4; RKB_LOAD(o0, 0); RKB_LOAD(o1, 1); RKB_LOAD(o2, 2); RKB_LOAD(o3, 3); RKB_LOAD(o4, 4);
#define R5S(c) RKB_STEP_S(o0, c); RKB_STEP_S(o1, (c) + 1); RKB_STEP_S(o2, (c) + 2); RKB_STEP_S(o3, (c) + 3); RKB_STEP_S(o4, (c) + 4);
        R5S(0) R5S(5) R5S(10) R5S(15) R5S(20) R5S(25)
        RKB_STEP_S(o0, 30); RKB_STEP_S(o1, 31);
#undef R5S
    } else if (isY) {
#define R3Y(c) RKB_STEP_Y(o0, c); RKB_STEP_Y(o1, (c) + 1); RKB_STEP_Y(o2, (c) + 2);
        R3Y(0) R3Y(3) R3Y(6) R3Y(9) R3Y(12) R3Y(15) R3Y(18) R3Y(21) R3Y(24) R3Y(27)
        RKB_STEP_Y(o0, 30); RKB_STEP_Y(o1, 31);
#undef R3Y
    } else {
#pragma unroll 1
        for (int c = 0; c < 32; ++c) RKB_BAR();
    }
#undef RKB_STEP_S
#undef RKB_STEP_Y
#undef RKB_NEXT
#undef RKB_BAR
#undef RKB_LOAD
    if (wave < 4 && half == 0) {
#pragma unroll
        for (int i = 0; i < 16; ++i) *(GAS float*)(sst + i * 64 + lane) = st[i];
    }
}

constexpr int NPHASE = 11;
template <int PHM> __global__ void __launch_bounds__(NWAVES * 64, 2) fwd_kernel(Args args) {
    extern __shared__ __attribute__((aligned(16))) unsigned char lds[];
    namespace cg = cooperative_groups;
    Frame F;
    F.lds = (LAS unsigned char*)lds;
    F.tid = threadIdx.x; F.lane = F.tid & 63; F.wave = __builtin_amdgcn_readfirstlane(F.tid >> 6);
    F.G = gridDim.x; F.bx = blockIdx.x;
    F.out = args.out; F.ws = args.ws;
#define PH_BEGIN InTab TAB; { ktab_t kp_ = (ktab_t)__builtin_amdgcn_kernarg_segment_ptr(); asm volatile("" : "+s"(kp_)); TAB.p = kp_; } { int t_ = threadIdx.x; asm volatile("" : "+v"(t_)); F.tid = t_; F.lane = t_ & 63; F.wave = __builtin_amdgcn_readfirstlane(t_ >> 6); } GAS unsigned char* wsg_ = (GAS unsigned char*)args.ws; asm volatile("" : "+s"(wsg_)); unsigned char* ws = (unsigned char*)wsg_; F.ws = ws; GAS bf16_t* gtg_ = (GAS bf16_t*)args.out; asm volatile("" : "+s"(gtg_)); bf16_t* GATES = (bf16_t*)gtg_; F.out = (float*)GATES; (void)GATES;
    const int lo = args.ph_lo, hi = args.ph_hi;
    XcdBarrier bar; bar.bar = nullptr; bar.x = 0; bar.st = nullptr;
    if (hi - lo > 1) {
        for (int u = threadIdx.x; u < (LDS_BYTES - 162816) / 4; u += NWAVES * 64) ((LAS unsigned*)(F.lds + 162816))[u] = 0u;
        { GAS v4u* z_ = (GAS v4u*)(args.ws + WS_CTL) + (size_t)blockIdx.x * (CTL_ZERO_BYTES / 16 / 256); for (int u = threadIdx.x; u < (int)(CTL_ZERO_BYTES / 16 / 256); u += NWAVES * 64) z_[u] = (v4u){0u, 0u, 0u, 0u}; }
        asm volatile("s_waitcnt vmcnt(0)" ::: "memory");
        __syncthreads();
        cg::this_grid().sync();
        bar = xcd_barrier_post((unsigned*)(args.ws + WS_CTL) + CW_BAR, (volatile LAS unsigned*)(F.lds + MISC_OFF) + 8);
    }
#define IN(k) (((PHM >> (k)) & 1) && lo <= (k) && (k) < hi)
#ifdef PROBE_DUP
#define REPS(k) (((k) == PROBE_DUP) ? 2 : 1)
#else
#define REPS(k) 1
#endif
#define SEAM(k) do { if (IN(k) && IN((k) + 1)) { xcd_barrier(bar); } } while (0)
    using pg8::Gemm; using pg8::StaticOrder; using pg8::EpiRow8; using pg8::bf16_t;

    if (IN(0)) for (int rep_ = 0; rep_ < REPS(0); ++rep_) { if (rep_) xcd_barrier(bar); PH_BEGIN p0_prologue(F, TAB); } SEAM(0);
    if (IN(1)) for (int rep_ = 0; rep_ < REPS(1); ++rep_) { if (rep_) xcd_barrier(bar); PH_BEGIN
        Gemm g{(const bf16_t*)(ws + WS_XN), (const bf16_t*)(ws + WS_WIN), M, D_IN, D}; StaticOrder S; S.init(M, D_IN, F.G, F.bx);
        EpiRow8<pg8::FProj> E{{ws, GATES}};
        pg8::gemm_phase<EpiRow8<pg8::FProj>, StaticOrder, PG8_ALIGN, PG8_SP2>(F.lds + RING_OFF, g, S, E);
    } SEAM(1);
    if (IN(2)) for (int rep_ = 0; rep_ < REPS(2); ++rep_) { if (rep_) xcd_barrier(bar); PH_BEGIN prep1_phase(F, TAB); } SEAM(2);
    if (IN(3)) for (int rep_ = 0; rep_ < REPS(3); ++rep_) { if (rep_) xcd_barrier(bar); PH_BEGIN
        int klora = KLORA; asm volatile("" : "+s"(klora));
        Gemm g{(const bf16_t*)(ws + WS_LIN), (const bf16_t*)(ws + WS_WL), M, NLORA, klora}; StaticOrder S; S.init(M, NLORA, F.G, F.bx);
        EpiRow8<pg8::FLora> E{{ws, TAB[I_W0], TAB[I_A0]}};
        pg8::gemm_phase<EpiRow8<pg8::FLora>, StaticOrder, PG8_ALIGN, PG8_SP2>(F.lds + RING_OFF, g, S, E);
    } SEAM(3);
    if (IN(4)) for (int rep_ = 0; rep_ < REPS(4); ++rep_) { if (rep_) xcd_barrier(bar); PH_BEGIN
        const attn_body::AttnTensors AT{(const attn_body::bf16*)(ws + WS_Q), (const attn_body::bf16*)(ws + WS_K), (const attn_body::bf16*)(ws + WS_V), (attn_body::bf16*)(ws + WS_O)};
        const attn_body::StaticOrder S(F.bx, F.G);
        attn_body::attn_phase<attn_body::StaticOrder>((char*)lds + RING_OFF, AT, S);
    } SEAM(4);
    if (IN(5)) for (int rep_ = 0; rep_ < REPS(5); ++rep_) { if (rep_) xcd_barrier(bar); PH_BEGIN
#pragma unroll 1
        for (int half = 0; half < 2; ++half) {
            { GAS unsigned char* w_ = (GAS unsigned char*)args.ws; asm volatile("" : "+s"(w_)); F.ws = (unsigned char*)w_; }
            rwkvA_phase(F, TAB, half);
#ifdef PROBE_DUP_RKA
            rwkvA_phase(F, TAB, half);
#endif
            xcd_barrier(bar);
            { GAS unsigned char* w_ = (GAS unsigned char*)args.ws; asm volatile("" : "+s"(w_)); F.ws = (unsigned char*)w_; }
            if (F.bx < 64) rwkvB_phase(F, F.bx, half); else late_weights(F, TAB, half, 2, 64);
#ifdef PROBE_DUP_RKB
            if (F.bx < 64) rwkvB_phase(F, F.bx, half);
#endif
            if (half == 0) xcd_barrier(bar);
        }
    } SEAM(5);
#ifdef PROBE_BARS
    for (int pb_ = 0; pb_ < PROBE_BARS; ++pb_) xcd_barrier(bar);
#endif
    if (IN(6)) for (int rep_ = 0; rep_ < REPS(6); ++rep_) { if (rep_) xcd_barrier(bar); PH_BEGIN post_phase(F, TAB); } SEAM(6);
    if (IN(7)) for (int rep_ = 0; rep_ < REPS(7); ++rep_) { if (rep_) xcd_barrier(bar); PH_BEGIN
        Gemm g{(const bf16_t*)(ws + WS_YA), (const bf16_t*)(ws + WS_WA), M, D, 1024}; StaticOrder S; S.init(M, D, F.G, F.bx);
        pg8::EpiMerge E{GATES, (bf16_t*)(ws + WS_MERGED)};
        pg8::gemm_phase<pg8::EpiMerge, StaticOrder, PG8_ALIGN, PG8_SP2>(F.lds + RING_OFF, g, S, E);
    } SEAM(7);
    if (IN(8)) for (int rep_ = 0; rep_ < REPS(8); ++rep_) { if (rep_) xcd_barrier(bar); PH_BEGIN
        Gemm g{(const bf16_t*)(ws + WS_MERGED), (const bf16_t*)(ws + WS_WO), M, D, D}; StaticOrder S; S.init(M, D, F.G, F.bx);
        pg8::EpiResNorm<0> E{TAB[I_X], F.out, (bf16_t*)(ws + WS_XN), TAB[I_NFG], (float*)(ws + WS_CTL + CTL_SS1), (unsigned*)(ws + WS_CTL + CTL_CNT1), NORM_EPS, (bf16_t*)(ws + WS_X1B)};
        pg8::gemm_phase<pg8::EpiResNorm<0>, StaticOrder, PG8_ALIGN, PG8_SP2>(F.lds + RING_OFF, g, S, E);
    } SEAM(8);
    if (IN(9)) for (int rep_ = 0; rep_ < REPS(9); ++rep_) { if (rep_) xcd_barrier(bar); PH_BEGIN
        Gemm g{(const bf16_t*)(ws + WS_XN), (const bf16_t*)(ws + WS_W1), M, FF, D}; StaticOrder S; S.init(M, FF, F.G, F.bx);
        EpiRow8<pg8::FRelu2> E{{(bf16_t*)(ws + WS_H)}};
        pg8::gemm_phase<EpiRow8<pg8::FRelu2>, StaticOrder, PG8_ALIGN, PG8_SP2>(F.lds + RING_OFF, g, S, E);
    } SEAM(9);
    if (IN(10)) for (int rep_ = 0; rep_ < REPS(10); ++rep_) { if (rep_) xcd_barrier(bar); PH_BEGIN
        Gemm g{(const bf16_t*)(ws + WS_H), (const bf16_t*)(ws + WS_W2), M, D, FF}; StaticOrder S; S.init(M, D, F.G, F.bx);
        pg8::EpiResNorm<1> E{nullptr, F.out, nullptr, TAB[I_NFIN], (float*)(ws + WS_CTL + CTL_SS2), (unsigned*)(ws + WS_CTL + CTL_CNT2), NORM_EPS, (bf16_t*)(ws + WS_X1B)};
        pg8::gemm_phase<pg8::EpiResNorm<1>, StaticOrder, PG8_ALIGN, PG8_SP2>(F.lds + RING_OFF, g, S, E);
    }
#undef IN
#undef SEAM
#undef PH_BEGIN
}


#ifdef DBG_DUMP
__global__ void dbg_dump(float* out, const unsigned char* ws) {
    const size_t i = (size_t)blockIdx.x * blockDim.x + threadIdx.x; if (i >= (size_t)M * 1024) return;
    const size_t m = i >> 10; const int c = (int)(i & 1023); float v = 0.f;
#if DBG_DUMP == 1
    v = bf1(((const bf16*)(ws + WS_O))[m * 1024 + c]);
#elif DBG_DUMP == 2
    v = c < 512 ? bf1(((const bf16*)(ws + WS_Y))[m * 512 + c]) : (c < 520 ? ((const float*)(ws + WS_BON))[m * 8 + (c - 512)] : 0.f);
#elif DBG_DUMP == 3
    v = c < 512 ? bf1(((const bf16*)(ws + WS_Q))[m * 512 + c]) : bf1(((const bf16*)(ws + WS_K))[m * 512 + c - 512]);
#elif DBG_DUMP == 4
    v = c < 512 ? ((const float*)(ws + WS_DEC))[m * 512 + c] : bf1(((const bf16*)(ws + WS_AA))[m * 512 + c - 512]);
#elif DBG_DUMP == 6
    v = c < 256 ? bf1(((const bf16*)(ws + WS_WAG))[m * 256 + c]) : (c < 512 ? bf1(((const bf16*)(ws + WS_LIN))[m * 256 + c - 256]) : 0.f);
#elif DBG_DUMP == 7
    { const bf16* wl = (const bf16*)(ws + WS_WL); const size_t j = (m * 1024 + c); v = j < (size_t)NLORA * KLORA ? bf1(wl[j]) : 0.f; }
#elif DBG_DUMP == 8
    v = c < 512 ? bf1(((const bf16*)(ws + WS_GG))[m * 512 + c]) : 0.f;
#elif DBG_DUMP == 5
    v = bf1(((const bf16*)(ws + WS_RKV))[m * 1536 + c]);
#endif
    out[i] = v;
}
#endif

#ifdef DBG_FIXLORA
__global__ void dbg_fixlora(Args A) {
    const size_t i = (size_t)blockIdx.x * blockDim.x + threadIdx.x; if (i >= (size_t)M * 512) return;
    const size_t m = i >> 9; const int c = (int)(i & 511);
    const bf16* LINr = (const bf16*)(A.ws + WS_LIN) + m * 256;
#if DBG_FIXLORA & 1
    { float g = 0.f; for (int k = 0; k < 128; ++k) g += bf1(LINr[128 + k]) * A[I_G2][(size_t)k * 512 + c]; ((bf16*)(A.ws + WS_GG))[m * 512 + c] = (bf16)f2bf(g); }
#endif
#if DBG_FIXLORA & 2
    { float s = A[I_A0][c]; for (int k = 0; k < 64; ++k) s += bf1(LINr[64 + k]) * A[I_A2][(size_t)k * 512 + c]; ((bf16*)(A.ws + WS_AA))[m * 512 + c] = (bf16)f2bf(1.0f / (1.0f + expf(-s))); }
#endif
#if DBG_FIXLORA & 4
    { float s = A[I_W0][c]; for (int k = 0; k < 64; ++k) s += bf1(LINr[k]) * A[I_W2][(size_t)k * 512 + c]; const float w = -log1pf(expf(-s)) - 0.5f; ((float*)(A.ws + WS_DEC))[m * 512 + c] = expf(-expf(w)); }
#endif
}
#endif
#ifndef MK_ONE_LAUNCH
#define MK_ONE_LAUNCH 0
#endif
#ifndef MK_MASK
#define MK_MASK ((1 << NPHASE) - 1)
#endif
typedef void (*kern_t)(Args);
template <int P> struct KTab { static void fill(kern_t* t) { t[P] = fwd_kernel<(1 << P)>; KTab<P - 1>::fill(t); } };
template <> struct KTab<-1> { static void fill(kern_t*) {} };
extern "C" void kernel_launch(void* const* d_in, const int* in_sizes, int n_in, void* d_out, int out_size, void* d_ws, size_t ws_size, hipStream_t stream) {
    static int grid = 0; static kern_t ktab[NPHASE];
    if (grid == 0) {
        if (n_in != 26 || in_sizes[0] != M * D || out_size != M * D || ws_size < WS_END) { fprintf(stderr, "kernel_launch: unexpected shapes (n_in %d, in0 %d, out %d, ws %zu); nothing launched\n", n_in, n_in > 0 ? in_sizes[0] : -1, out_size, ws_size); grid = -1; return; }
        int dev = 0, cus = 0;
        if (hipGetDevice(&dev) != hipSuccess || hipDeviceGetAttribute(&cus, hipDeviceAttributeMultiprocessorCount, dev) != hipSuccess) { grid = -1; return; }
#if MK_ONE_LAUNCH
        int per_cu = 0;
        if (hipFuncSetAttribute((const void*)fwd_kernel<MK_MASK>, hipFuncAttributeMaxDynamicSharedMemorySize, LDS_BYTES) != hipSuccess) { fprintf(stderr, "kernel_launch: hipFuncSetAttribute failed\n"); grid = -1; return; }
        if (hipOccupancyMaxActiveBlocksPerMultiprocessor(&per_cu, (const void*)fwd_kernel<MK_MASK>, NWAVES * 64, LDS_BYTES) != hipSuccess || per_cu < 1) { fprintf(stderr, "kernel_launch: occupancy query says %d blocks per CU\n", per_cu); (void)hipGetLastError(); grid = -1; return; }
#else
        KTab<NPHASE - 1>::fill(ktab);
        for (int p = 0; p < NPHASE; ++p) if (hipFuncSetAttribute((const void*)ktab[p], hipFuncAttributeMaxDynamicSharedMemorySize, LDS_BYTES) != hipSuccess) { fprintf(stderr, "kernel_launch: hipFuncSetAttribute failed\n"); grid = -1; return; }
#endif
        grid = cus;
        if (grid != 256) fprintf(stderr, "kernel_launch: note: %d CUs (built for 256)\n", grid);
    }
    if (grid < 0) return;
    Args a{};
    for (int i = 0; i < 26; ++i) a.in[i] = (const float*)d_in[i];
    a.out = (float*)d_out; a.ws = (unsigned char*)d_ws;
#if MK_ONE_LAUNCH
    a.ph_lo = 0; a.ph_hi = NPHASE;
    void* kargs[] = {&a};
    hipError_t e = hipLaunchCooperativeKernel((const void*)fwd_kernel<MK_MASK>, dim3(grid), dim3(NWAVES * 64), kargs, LDS_BYTES, stream);
    if (e != hipSuccess) fprintf(stderr, "kernel_launch: cooperative launch failed: %s\n", hipGetErrorString(e));
#else
#ifdef DBG_DUMP
    for (int p = 0; p <= DBG_STOP; ++p) { a.ph_lo = p; a.ph_hi = p + 1; hipLaunchKernelGGL(ktab[p], dim3(grid), dim3(NWAVES * 64), LDS_BYTES, stream, a); }
    hipLaunchKernelGGL(dbg_dump, dim3((M * 1024) / 256), dim3(256), 0, stream, (float*)d_out, (const unsigned char*)d_ws);
#else
    for (int p = 0; p < NPHASE; ++p) { a.ph_lo = p; a.ph_hi = p + 1; hipLaunchKernelGGL(ktab[p], dim3(grid), dim3(NWAVES * 64), LDS_BYTES, stream, a);
#ifdef DBG_FIXLORA
        if (p == 3) hipLaunchKernelGGL(dbg_fixlora, dim3((M * 512) / 256), dim3(256), 0, stream, a);
#endif
    }
#endif
#endif
}
```

```cpp
#define MK_ONE_LAUNCH 1
#include <hip/hip_runtime.h>
#include <cstdio>
#include <cstdint>
constexpr int NWAVES = 8;
constexpr int BATCH = 8, SEQ = 2048, D = 1024, M = BATCH * SEQ;
constexpr int D_IN = 5376, FF = 4096, RWW = 512, NLORA = 1536, KLORA = 256;
constexpr float NORM_EPS = 1e-6f, SUBLN_EPS = 1e-5f, GN_EPS = 64e-5f, LAMBDA_INIT = 0.2f;
constexpr size_t MiB = 1u << 20;
constexpr size_t WS_CTL = 0, CTL_ZERO_BYTES = 256 * 1024;
constexpr size_t CTL_SS1 = 65536, CTL_SS2 = 131072, CTL_CNT1 = 196608, CTL_CNT2 = 212992;
constexpr size_t WS_ROPE_C = 512 * 1024, WS_ROPE_S = 768 * 1024;
constexpr size_t WS_BON = 1 * MiB;
constexpr size_t WS_WIN = 2 * MiB;
constexpr size_t WS_WA = WS_WIN + (size_t)D_IN * D * 2;
constexpr size_t WS_WB = WS_WA + 1 * MiB;
constexpr size_t WS_WO = WS_WB + 1 * MiB;
constexpr size_t WS_W1 = WS_WO + 2 * MiB;
constexpr size_t WS_W2 = WS_W1 + 8 * MiB;
constexpr size_t WS_WL = WS_W2 + 8 * MiB;
static_assert(WS_WL + (size_t)NLORA * KLORA * 2 <= 34 * MiB, "weights");
constexpr size_t WS_XN = 34 * MiB;
constexpr size_t WS_DEC = WS_XN;
constexpr size_t WS_Q = 66 * MiB, WS_K = 82 * MiB, WS_V = 98 * MiB;
constexpr size_t WS_RKV = 114 * MiB;
constexpr size_t WS_WAG = 162 * MiB, WS_LIN = 170 * MiB;
constexpr size_t WS_Y = 162 * MiB;
constexpr size_t WS_AA = 178 * MiB, WS_GG = 194 * MiB;
constexpr size_t WS_O = 210 * MiB;
constexpr size_t WS_YA = 66 * MiB, WS_YB = 82 * MiB;
constexpr size_t WS_TMP = 114 * MiB;
constexpr size_t WS_MERGED = 114 * MiB;
constexpr size_t WS_X1B = 194 * MiB;
constexpr size_t WS_H = 66 * MiB;
constexpr size_t WS_END = 244 * MiB;
constexpr int RING_OFF = 0, RING_BYTES = 131072;
constexpr int LDS_BYTES = 163840;

#include <hip/hip_runtime.h>
#include <cstdio>
#include <cstdint>
namespace pg8 {
#define PG8_LAS __attribute__((address_space(3)))
typedef unsigned short bf16_t;
typedef short bf16x8 __attribute__((ext_vector_type(8)));
typedef float f32x4 __attribute__((ext_vector_type(4)));
typedef unsigned u32x4 __attribute__((ext_vector_type(4)));
constexpr int BM = 256, BK = 64, HALF = 128, HTB = HALF * BK * 2  , STAGE_BYTES = 8 * HTB, NXCD = 8, WGM = 8;

__host__ __device__ __forceinline__ int lds_byte(int r, int c) { const int st = (r >> 4) * 2 + (c >> 5), rr = r & 15, cc = c & 31, ob = rr * 64 + cc * 2; return st * 1024 + (ob ^ (((ob >> 9) & 1) << 5)); }
__host__ __device__ __forceinline__ void stage_rc(int b, int& R, int& C) { const int st = b / 1024, sb = b % 1024, swz = sb ^ (((sb >> 9) & 1) << 5); R = (st >> 1) * 16 + swz / 64; C = (st & 1) * 32 + (swz % 64) / 2; }
__host__ __device__ __forceinline__ int perm32(int rho) { const int n = rho >> 4, i = rho & 15; return 8 * (i >> 2) + 4 * n + (i & 3); }

struct Unit { int pm, pn; };
struct Gemm { const bf16_t* A; const bf16_t* Bt; int M, N, K; };

struct StaticOrder {
    int nM, nN, nwg, G, c;
    __host__ __device__ void init(int M, int N, int G_, int c_) { nM = M / BM; nN = N / BM; nwg = nM * nN; G = G_; c = c_; }
    __host__ __device__ bool next(int i, Unit& u) const {
        const long L = (long)i * G + c; if (L >= nwg) return false;
        int wgid = (int)L; { const int q = nwg / NXCD, r = nwg % NXCD, xcd = wgid % NXCD, off = wgid / NXCD; wgid = (xcd < r ? xcd * (q + 1) : r * (q + 1) + (xcd - r) * q) + off; }
        const int nig = WGM * nN, gid = wgid / nig, fm = gid * WGM, gsz = (nM - fm) < WGM ? (nM - fm) : WGM;
        u.pm = fm + ((wgid % nig) % gsz); u.pn = (wgid % nig) / gsz; return true;
    }
    __device__ __forceinline__ void a_ready(const Unit&) const {}
    __device__ __forceinline__ void done(const Unit&) const {}
};

typedef float f32x2c_t __attribute__((ext_vector_type(2))); typedef __bf16 bf16x2c_t __attribute__((ext_vector_type(2)));
__device__ __forceinline__ unsigned cvt_pk_bf16(float lo, float hi) { f32x2c_t v = {lo, hi}; bf16x2c_t b = __builtin_convertvector(v, bf16x2c_t); return __builtin_bit_cast(unsigned, b); }
typedef float f32x2 __attribute__((ext_vector_type(2)));
__device__ __forceinline__ f32x2 gelu_pk(f32x2 v) {
    const f32x2 av = __builtin_elementwise_abs(v), d = av * 0.2316418882f + 1.0f;
    f32x2 t; t.x = __builtin_amdgcn_rcpf(d.x); t.y = __builtin_amdgcn_rcpf(d.y);
    f32x2 q = t * 0.5307027145f + (-0.7265760135f); q = q * t + 0.7107068705f; q = q * t + (-0.142248368f); q = q * t + 0.127414796f; q = q * t;
    const f32x2 s = (v * v) * (-0.72134752044f);
    f32x2 e; e.x = __builtin_amdgcn_exp2f(s.x); e.y = __builtin_amdgcn_exp2f(s.y);
    const f32x2 m = v * (q * e), r = v - m;
    f32x2 o; o.x = v.x < 0.f ? m.x : r.x; o.y = v.y < 0.f ? m.y : r.y; return o;
}

template <int ACT  > struct EpiBf16 {
    static constexpr int MIDK = 0; static constexpr bool PERM = true, AFTER_DRAIN = false; static_assert(ACT == 0 || ACT == 1, "EpiBf16: ACT is 0 (none) or 1 (gelu_pk)");
    bf16_t* O; int ldc; const float* bias; int split_cols; size_t split_stride; float scale0;
    __device__ __forceinline__ void operator()(const f32x4 (&acc)[2][2][4][2], const Unit& u, int wr, int wc, int fr, int fq) const {
        const int row0 = u.pm * BM + wr * 64 + fr; int colt = u.pn * BM; bf16_t* base = O;
        float sc = 1.f; if (split_cols) { const int t = colt / split_cols; base += (size_t)t * split_stride; colt -= t * split_cols; if (t == 0) sc = scale0; }
        const int col0 = colt + wc * 32 + 8 * fq, bcol0 = u.pn * BM + wc * 32 + 8 * fq;
        f32x4 bv[2][2];
#pragma unroll
        for (int bj = 0; bj < 2; ++bj)
#pragma unroll
            for (int n = 0; n < 2; ++n) bv[bj][n] = bias ? *(const f32x4*)(bias + bcol0 + bj * HALF + 4 * n) : (f32x4){0.f, 0.f, 0.f, 0.f};
#pragma unroll
        for (int ai = 0; ai < 2; ++ai)
#pragma unroll
            for (int m = 0; m < 4; ++m) { bf16_t* rowp = base + (size_t)(row0 + ai * HALF + m * 16) * ldc + col0;
#pragma unroll
                for (int bj = 0; bj < 2; ++bj) { f32x4 v0 = acc[ai][bj][m][0] + bv[bj][0], v1 = acc[ai][bj][m][1] + bv[bj][1];
                    if (ACT == 1) { f32x2 a = gelu_pk((f32x2){v0[0], v0[1]}), b = gelu_pk((f32x2){v0[2], v0[3]}), c = gelu_pk((f32x2){v1[0], v1[1]}), d = gelu_pk((f32x2){v1[2], v1[3]});
                        v0 = (f32x4){a.x, a.y, b.x, b.y}; v1 = (f32x4){c.x, c.y, d.x, d.y}; }
                    v0 = v0 * sc; v1 = v1 * sc; u32x4 w; w.x = cvt_pk_bf16(v0[0], v0[1]); w.y = cvt_pk_bf16(v0[2], v0[3]); w.z = cvt_pk_bf16(v1[0], v1[1]); w.w = cvt_pk_bf16(v1[2], v1[3]);
                    *(u32x4*)(rowp + bj * HALF) = w; } }
    }
};
typedef unsigned u32x2 __attribute__((ext_vector_type(2)));
__device__ __forceinline__ float bf_lo(unsigned w) { return __builtin_bit_cast(float, w << 16); }
__device__ __forceinline__ float bf_hi(unsigned w) { return __builtin_bit_cast(float, w & 0xffff0000u); }
__device__ __forceinline__ u32x4 pack8(f32x4 v0, f32x4 v1) { u32x4 w; w.x = cvt_pk_bf16(v0[0], v0[1]); w.y = cvt_pk_bf16(v0[2], v0[3]); w.z = cvt_pk_bf16(v1[0], v1[1]); w.w = cvt_pk_bf16(v1[2], v1[3]); return w; }
__device__ __forceinline__ float sigmoidf_(float x) { return __builtin_amdgcn_rcpf(1.0f + __expf(-x)); }
template <class F> struct EpiRow8 {
    static constexpr int MIDK = 0; static constexpr bool PERM = true, AFTER_DRAIN = false;
    F f;
    __device__ __forceinline__ void operator()(const f32x4 (&acc)[2][2][4][2], const Unit& u, int wr, int wc, int fr, int fq) const {
        const int row0 = u.pm * BM + wr * 64 + fr, c0 = wc * 32 + 8 * fq;
#pragma unroll
        for (int ai = 0; ai < 2; ++ai)
#pragma unroll
            for (int m = 0; m < 4; ++m) { const int row = row0 + ai * HALF + m * 16;
#pragma unroll
                for (int bj = 0; bj < 2; ++bj) { f(u.pn, row, c0 + bj * HALF, acc[ai][bj][m][0], acc[ai][bj][m][1]); if (F::FENCE) asm volatile("" ::: "memory"); } }
    }
};
constexpr float ATT_C2 = 0.125f * 1.4426950408889634f;
struct FProj {
    static constexpr bool FENCE = false;
    unsigned char* ws; bf16_t* GATES;
    __device__ __forceinline__ void operator()(int pn, int row, int cu, f32x4 v0, f32x4 v1) const {
        if (pn < 4) {
            const int sh = cu >> 6, j = (cu & 63) >> 3, pos = row & 2047;
            const f32x4 c = *(const f32x4*)((const float*)(ws + WS_ROPE_C) + pos * 32 + 4 * j), s = *(const f32x4*)((const float*)(ws + WS_ROPE_S) + pos * 32 + 4 * j);
            const float sc = pn < 2 ? ATT_C2 : 1.0f;
            const f32x4 o1 = (v0 * c - v1 * s) * sc, o2 = (v1 * c + v0 * s) * sc;
            bf16_t* dst = (bf16_t*)(ws + (pn < 2 ? WS_Q : WS_K)) + (size_t)row * 512 + (pn & 1) * 256 + sh * 64 + 4 * j;
            u32x2 w1, w2; w1.x = cvt_pk_bf16(o1[0], o1[1]); w1.y = cvt_pk_bf16(o1[2], o1[3]); w2.x = cvt_pk_bf16(o2[0], o2[1]); w2.y = cvt_pk_bf16(o2[2], o2[3]);
            *(u32x2*)dst = w1; *(u32x2*)(dst + 32) = w2;
        } else if (pn < 13) {
            size_t off; int pitch, col;
            if (pn < 6) { off = WS_V; pitch = 512; col = (pn - 4) * 256; }
            else if (pn < 12) { off = WS_RKV; pitch = 1536; col = (pn - 6) * 256; }
            else { off = WS_WAG; pitch = 256; col = 0; }
            *(u32x4*)((bf16_t*)(ws + off) + (size_t)row * pitch + col + cu) = pack8(v0, v1);
        } else *(u32x4*)(GATES + (size_t)row * 2048 + (pn - 13) * 256 + cu) = pack8(v0, v1);
    }
};
struct FLora {
    static constexpr bool FENCE = false;
    unsigned char* ws; const float *w0, *a0;
    __device__ __forceinline__ void operator()(int pn, int row, int cu, f32x4 v0, f32x4 v1) const {
        const int c = (pn & 1) * 256 + cu;
        if (pn < 2) {
            const f32x4 b0 = *(const f32x4*)(w0 + c), b1 = *(const f32x4*)(w0 + c + 4);
            float* dst = (float*)(ws + WS_DEC) + (size_t)row * 512 + c; *(f32x4*)dst = v0 + b0; *(f32x4*)(dst + 4) = v1 + b1;
        } else if (pn < 4) {
            const f32x4 b0 = *(const f32x4*)(a0 + c), b1 = *(const f32x4*)(a0 + c + 4);
            *(u32x4*)((bf16_t*)(ws + WS_AA) + (size_t)row * 512 + c) = pack8(v0 + b0, v1 + b1);
        } else *(u32x4*)((bf16_t*)(ws + WS_GG) + (size_t)row * 512 + c) = pack8(v0, v1);
    }
};
struct EpiMerge {
    static constexpr int MIDK = 8; static constexpr bool PERM = true, AFTER_DRAIN = false;
    const bf16_t* GATES; bf16_t* MERGED;
    static __device__ __forceinline__ float ratio_(float ga, float gb) { return (1.0f + __expf(-gb)) * __builtin_amdgcn_rcpf(1.0f + __expf(-ga)); }
    __device__ __forceinline__ void mid(f32x4 (&acc)[2][2][4][2], const Unit& u, int wr, int wc, int fr, int fq) const {
        int fr_ = fr; asm volatile("" : "+v"(fr_));
        const bf16_t* gp0 = GATES + (size_t)(u.pm * BM + wr * 64 + fr_) * 2048 + u.pn * BM + wc * 32 + 8 * fq;
#pragma unroll
        for (int ai = 0; ai < 2; ++ai)
#pragma unroll
            for (int m = 0; m < 4; ++m)
#pragma unroll
                for (int bj = 0; bj < 2; ++bj) { const bf16_t* gp = gp0 + (size_t)(ai * HALF + m * 16) * 2048 + bj * HALF;
                    const u32x4 ga = *(const u32x4*)gp, gb = *(const u32x4*)(gp + 1024);
                    f32x4& v0 = acc[ai][bj][m][0]; f32x4& v1 = acc[ai][bj][m][1];
                    v0[0] *= ratio_(bf_lo(ga.x), bf_lo(gb.x)); v0[1] *= ratio_(bf_hi(ga.x), bf_hi(gb.x)); v0[2] *= ratio_(bf_lo(ga.y), bf_lo(gb.y)); v0[3] *= ratio_(bf_hi(ga.y), bf_hi(gb.y));
                    v1[0] *= ratio_(bf_lo(ga.z), bf_lo(gb.z)); v1[1] *= ratio_(bf_hi(ga.z), bf_hi(gb.z)); v1[2] *= ratio_(bf_lo(ga.w), bf_lo(gb.w)); v1[3] *= ratio_(bf_hi(ga.w), bf_hi(gb.w));
                    asm volatile("" ::: "memory"); }
    }
    __device__ __forceinline__ void operator()(const f32x4 (&acc)[2][2][4][2], const Unit& u, int wr, int wc, int fr, int fq) const {
        const int row0 = u.pm * BM + wr * 64 + fr, c0 = u.pn * BM + wc * 32 + 8 * fq;
#pragma unroll
        for (int ai = 0; ai < 2; ++ai)
#pragma unroll
            for (int m = 0; m < 4; ++m) { const int row = row0 + ai * HALF + m * 16;
#pragma unroll
                for (int bj = 0; bj < 2; ++bj) { const u32x4 g = *(const u32x4*)(GATES + (size_t)row * 2048 + 1024 + c0 + bj * HALF);
                    f32x4 v0 = acc[ai][bj][m][0], v1 = acc[ai][bj][m][1];
                    v0[0] *= sigmoidf_(bf_lo(g.x)); v0[1] *= sigmoidf_(bf_hi(g.x)); v0[2] *= sigmoidf_(bf_lo(g.y)); v0[3] *= sigmoidf_(bf_hi(g.y));
                    v1[0] *= sigmoidf_(bf_lo(g.z)); v1[1] *= sigmoidf_(bf_hi(g.z)); v1[2] *= sigmoidf_(bf_lo(g.w)); v1[3] *= sigmoidf_(bf_hi(g.w));
                    *(u32x4*)(MERGED + (size_t)row * 1024 + c0 + bj * HALF) = pack8(v0, v1); } }
    }
};
struct FRes {
    static constexpr bool FENCE = false;
    const float* base; float* out;
    __device__ __forceinline__ void operator()(int pn, int row, int cu, f32x4 v0, f32x4 v1) const {
        const size_t off = (size_t)row * 1024 + pn * 256 + cu; const f32x4 b0 = *(const f32x4*)(base + off), b1 = *(const f32x4*)(base + off + 4);
        *(f32x4*)(out + off) = b0 + v0; *(f32x4*)(out + off + 4) = b1 + v1;
    }
};
struct FRelu2 {
    static constexpr bool FENCE = false;
    bf16_t* H;
    __device__ __forceinline__ void operator()(int pn, int row, int cu, f32x4 v0, f32x4 v1) const {
        f32x4 r0, r1;
#pragma unroll
        for (int e = 0; e < 4; ++e) { const float a = __builtin_fmaxf(v0[e], 0.f), b = __builtin_fmaxf(v1[e], 0.f); r0[e] = a * a; r1[e] = b * b; }
        *(u32x4*)(H + (size_t)row * 4096 + pn * 256 + cu) = pack8(r0, r1);
    }
};

__device__ __forceinline__ float xsum_fq(float x) {
    { auto r = __builtin_amdgcn_permlane16_swap(__builtin_bit_cast(unsigned, x), __builtin_bit_cast(unsigned, x), false, false); const unsigned a = r[0], b = r[1]; x = __builtin_bit_cast(float, a) + __builtin_bit_cast(float, b); }
    { auto r = __builtin_amdgcn_permlane32_swap(__builtin_bit_cast(unsigned, x), __builtin_bit_cast(unsigned, x), false, false); const unsigned a = r[0], b = r[1]; x = __builtin_bit_cast(float, a) + __builtin_bit_cast(float, b); }
    return x;
}
template <int MODE> struct EpiResNorm {
    static constexpr int MIDK = 0; static constexpr bool PERM = true, AFTER_DRAIN = false;
    const float* base; float* out; bf16_t* xn; const float* g; float* ss; unsigned* cnt; float eps; bf16_t* x1b;
    __device__ __forceinline__ void operator()(f32x4 (&acc)[2][2][4][2], const Unit& u, int wr, int wc, int fr, int fq) const {
        const int row0 = u.pm * BM + wr * 64 + fr, c0 = u.pn * BM + wc * 32 + 8 * fq;
#pragma unroll
        for (int ai = 0; ai < 2; ++ai)
#pragma unroll
            for (int m = 0; m < 4; ++m) { const int row = row0 + ai * HALF + m * 16; float s = 0.f;
#pragma unroll
                for (int bj = 0; bj < 2; ++bj) { const size_t off = (size_t)row * 1024 + c0 + bj * HALF; f32x4 b0, b1;
                    if (MODE == 0) { b0 = *(const f32x4*)(base + off); b1 = *(const f32x4*)(base + off + 4); }
                    else { const u32x4 w = *(const u32x4*)(x1b + off); b0 = (f32x4){bf_lo(w.x), bf_hi(w.x), bf_lo(w.y), bf_hi(w.y)}; b1 = (f32x4){bf_lo(w.z), bf_hi(w.z), bf_lo(w.w), bf_hi(w.w)}; }
                    f32x4& v0 = acc[ai][bj][m][0]; f32x4& v1 = acc[ai][bj][m][1]; v0 += b0; v1 += b1;
                    if (MODE == 0) *(u32x4*)(x1b + off) = pack8(v0, v1);
                    s += (v0[0] * v0[0] + v0[1] * v0[1]) + (v0[2] * v0[2] + v0[3] * v0[3]) + (v1[0] * v1[0] + v1[1] * v1[1]) + (v1[2] * v1[2] + v1[3] * v1[3]); }
                s = xsum_fq(s);
                if (fq == 0) __hip_atomic_fetch_add(ss + row, s, __ATOMIC_RELAXED, __HIP_MEMORY_SCOPE_AGENT);
                if (m & 1) asm volatile("" ::: "memory"); }
        asm volatile("s_waitcnt vmcnt(0)" ::: "memory");
        unsigned* c_ = cnt + 64 * u.pm;
        if (fr == 0 && fq == 0) __hip_atomic_fetch_add(c_, 1u, __ATOMIC_RELAXED, __HIP_MEMORY_SCOPE_AGENT);
        { unsigned spins = 0; while ((unsigned)__builtin_amdgcn_readfirstlane(__hip_atomic_load(c_, __ATOMIC_RELAXED, __HIP_MEMORY_SCOPE_AGENT)) < 32u && ++spins < (1u << 22)) __builtin_amdgcn_s_sleep(2); }
        asm volatile("" ::: "memory");
#pragma unroll
        for (int ai = 0; ai < 2; ++ai)
#pragma unroll
            for (int m = 0; m < 4; ++m) { const int row = row0 + ai * HALF + m * 16;
                const float rstd = 1.0f / sqrtf(__hip_atomic_load(ss + row, __ATOMIC_RELAXED, __HIP_MEMORY_SCOPE_AGENT) * (1.0f / 1024.0f) + eps);
#pragma unroll
                for (int bj = 0; bj < 2; ++bj) { const size_t off = (size_t)row * 1024 + c0 + bj * HALF; const f32x4 g0 = *(const f32x4*)(g + c0 + bj * HALF), g1 = *(const f32x4*)(g + c0 + bj * HALF + 4);
                    const f32x4 o0 = acc[ai][bj][m][0] * rstd * g0, o1 = acc[ai][bj][m][1] * rstd * g1;
                    if (MODE == 0) *(u32x4*)(xn + off) = pack8(o0, o1); else { *(f32x4*)(out + off) = o0; *(f32x4*)(out + off + 4) = o1; } }
                if (m & 1) asm volatile("" ::: "memory"); }
    }
};
template <class Epi, class Sched, bool ALIGN_EPI = false, bool SP2 = false>
__device__ __forceinline__ void gemm_phase(PG8_LAS unsigned char* lds, const Gemm g, const Sched& S, const Epi& E) {
    int tid_ = threadIdx.x; asm volatile("" : "+v"(tid_));
    const int tid = tid_, wid = __builtin_amdgcn_readfirstlane(tid >> 6), lane = tid & 63, wr = wid >> 2, wc = wid & 3, fr = lane & 15, fq = lane >> 4;
    const int K = g.K, nt = K / BK;
    unsigned voffA[2], voffB[2];
#pragma unroll
    for (int i = 0; i < 2; ++i) { int R, C; stage_rc(tid * 16 + i * 8192, R, C); const int Rb = Epi::PERM ? ((R & ~31) + perm32(R & 31)) : R;
        voffA[i] = (unsigned)(R * K + C) * 2u; voffB[i] = (unsigned)(Rb * K + C) * 2u; }
    const size_t kstep = (size_t)(BK * 2);
    const size_t hstep = (size_t)HALF * K * 2;
    const size_t tstep = 2 * hstep;
    const unsigned ldsw = (unsigned)wid * 1024u;
    const int aoff = lds_byte(wr * 64 + fr, fq * 8), boff = lds_byte(wc * 32 + fr, fq * 8);
#define PG8_SA(b, h) (((b) * 2 + (h)) * HTB)
#define PG8_SB(b, h) ((4 + (b) * 2 + (h)) * HTB)
#define PG8_STAGE(bufoff, gbase, voff) do { _Pragma("unroll") for (int _i = 0; _i < 2; ++_i) \
        __builtin_amdgcn_global_load_lds((const unsigned*)((const char*)(gbase) + (voff)[_i]), (PG8_LAS unsigned*)(lds + (bufoff) + ldsw + _i * 8192), 16, 0, 0); } while (0)
#define PG8_LDA(dst, b, h) do { _Pragma("unroll") for (int m = 0; m < 4; ++m) _Pragma("unroll") for (int k = 0; k < 2; ++k) dst[m][k] = *(const PG8_LAS bf16x8*)(lds + PG8_SA(b, h) + aoff + m * 2048 + k * 1024); } while (0)
#define PG8_LDB(dst, b, h) do { _Pragma("unroll") for (int n = 0; n < 2; ++n) _Pragma("unroll") for (int k = 0; k < 2; ++k) dst[n][k] = *(const PG8_LAS bf16x8*)(lds + PG8_SB(b, h) + boff + n * 2048 + k * 1024); } while (0)
#define PG8_MMA(ai, bj, At, Bt) do { __builtin_amdgcn_s_setprio(1); _Pragma("unroll") for (int m = 0; m < 4; ++m) _Pragma("unroll") for (int n = 0; n < 2; ++n) _Pragma("unroll") for (int k = 0; k < 2; ++k) \
        acc[ai][bj][m][n] = __builtin_amdgcn_mfma_f32_16x16x32_bf16(Bt[n][k], At[m][k], acc[ai][bj][m][n], 0, 0, 0); __builtin_amdgcn_s_setprio(0); } while (0)
#define PG8_WAIT_V(n) asm volatile("s_waitcnt vmcnt(" #n ")" ::: "memory")
#define PG8_WAIT_L(n) asm volatile("s_waitcnt lgkmcnt(" #n ")" ::: "memory")
#define PG8_BAR __builtin_amdgcn_s_barrier()
#define PG8_SCHED __builtin_amdgcn_sched_barrier(0)
    Unit cur, nxt; int ui = 0;
    if (!S.next(0, cur)) return;
    f32x4 acc[2][2][4][2];
#pragma unroll
    for (int a = 0; a < 2; ++a)
#pragma unroll
        for (int b = 0; b < 2; ++b)
#pragma unroll
            for (int m = 0; m < 4; ++m)
#pragma unroll
                for (int n = 0; n < 2; ++n) acc[a][b][m][n] = (f32x4){0.f, 0.f, 0.f, 0.f};
    bf16x8 At[4][2], B0[2][2], B1[2][2];
    const char* cA = (const char*)g.A + (size_t)cur.pm * tstep; const char* cB = (const char*)g.Bt + (size_t)cur.pn * tstep;
    S.a_ready(cur);
    if constexpr (SP2) {
        PG8_STAGE(PG8_SB(0, 0), cB, voffB); PG8_STAGE(PG8_SB(0, 1), cB + hstep, voffB); PG8_STAGE(PG8_SA(0, 0), cA, voffA); PG8_STAGE(PG8_SA(0, 1), cA + hstep, voffA);
        if (wr == 1) PG8_BAR;
        PG8_WAIT_V(2); PG8_BAR;
        PG8_STAGE(PG8_SB(1, 0), cB + kstep, voffB); PG8_STAGE(PG8_SA(1, 0), cA + kstep, voffA); PG8_STAGE(PG8_SB(1, 1), cB + hstep + kstep, voffB);
        PG8_WAIT_V(6); PG8_BAR;
    } else {
        PG8_STAGE(PG8_SB(0, 0), cB, voffB); PG8_STAGE(PG8_SA(0, 0), cA, voffA); PG8_STAGE(PG8_SB(0, 1), cB + hstep, voffB); PG8_STAGE(PG8_SA(0, 1), cA + hstep, voffA);
        if (wr == 1) PG8_BAR;
        PG8_WAIT_V(4); PG8_BAR;
        PG8_STAGE(PG8_SB(1, 0), cB + kstep, voffB); PG8_STAGE(PG8_SA(1, 0), cA + kstep, voffA); PG8_STAGE(PG8_SB(1, 1), cB + hstep + kstep, voffB);
        PG8_WAIT_V(6); PG8_BAR;
    }
    for (;;) {
        const bool has_next = S.next(ui + 1, nxt);
        const char* nA = has_next ? (const char*)g.A + (size_t)nxt.pm * tstep : cA; const char* nB = has_next ? (const char*)g.Bt + (size_t)nxt.pn * tstep : cB;
        for (int t = 0; t < nt; t += 2) {
            if constexpr (Epi::MIDK > 0) { if (t == Epi::MIDK) E.mid(acc, cur, wr, wc, fr, fq); }
            const bool last = (t == nt - 2);
            const char* a1 = cA + (size_t)(t + 1) * kstep;
            const char* a2 = last ? nA : cA + (size_t)(t + 2) * kstep; const char* b2 = last ? nB : cB + (size_t)(t + 2) * kstep;
            const char* a3 = a2 + kstep; const char* b3 = b2 + kstep;
            if (last && has_next) S.a_ready(nxt);
            if constexpr (SP2) {
            PG8_LDB(B0, 0, 0); PG8_LDB(B1, 0, 1); PG8_SCHED; PG8_LDA(At, 0, 0); PG8_STAGE(PG8_SA(1, 1), a1 + hstep, voffA);
            PG8_WAIT_V(8); PG8_WAIT_L(0); PG8_BAR; PG8_MMA(0, 0, At, B0); PG8_MMA(0, 1, At, B1); PG8_BAR; PG8_SCHED;
            PG8_LDA(At, 0, 1); PG8_STAGE(PG8_SB(0, 0), b2, voffB); PG8_STAGE(PG8_SB(0, 1), b2 + hstep, voffB); PG8_STAGE(PG8_SA(0, 0), a2, voffA);
            PG8_WAIT_V(8); PG8_WAIT_L(0); PG8_BAR; PG8_MMA(1, 0, At, B0); PG8_MMA(1, 1, At, B1); PG8_BAR; PG8_SCHED;
            PG8_LDB(B0, 1, 0); PG8_LDB(B1, 1, 1); PG8_SCHED; PG8_LDA(At, 1, 0); PG8_STAGE(PG8_SA(0, 1), a2 + hstep, voffA);
            PG8_WAIT_V(8); PG8_WAIT_L(0); PG8_BAR; PG8_MMA(0, 0, At, B0); PG8_MMA(0, 1, At, B1); PG8_BAR; PG8_SCHED;
            PG8_LDA(At, 1, 1); PG8_STAGE(PG8_SB(1, 0), b3, voffB); PG8_STAGE(PG8_SB(1, 1), b3 + hstep, voffB); PG8_STAGE(PG8_SA(1, 0), a3, voffA);
            PG8_WAIT_V(8); PG8_WAIT_L(0); PG8_BAR; PG8_MMA(1, 0, At, B0); PG8_MMA(1, 1, At, B1); PG8_BAR; PG8_SCHED;
            } else {
            PG8_LDB(B0, 0, 0); PG8_SCHED; PG8_LDA(At, 0, 0); PG8_STAGE(PG8_SA(1, 1), a1 + hstep, voffA);
            PG8_WAIT_L(8); PG8_BAR; PG8_WAIT_L(0); PG8_MMA(0, 0, At, B0); PG8_BAR; PG8_SCHED;
            PG8_LDB(B1, 0, 1); PG8_STAGE(PG8_SB(0, 0), b2, voffB);
            PG8_BAR; PG8_WAIT_L(0); PG8_MMA(0, 1, At, B1); PG8_BAR;
            PG8_LDA(At, 0, 1); PG8_STAGE(PG8_SA(0, 0), a2, voffA);
            PG8_BAR; PG8_WAIT_L(0); PG8_MMA(1, 0, At, B0); PG8_BAR; PG8_SCHED;
            PG8_STAGE(PG8_SB(0, 1), b2 + hstep, voffB);
            PG8_WAIT_V(6); PG8_BAR; PG8_MMA(1, 1, At, B1); PG8_BAR;
            PG8_LDB(B0, 1, 0); PG8_SCHED; PG8_LDA(At, 1, 0); PG8_STAGE(PG8_SA(0, 1), a2 + hstep, voffA);
            PG8_WAIT_L(8); PG8_BAR; PG8_WAIT_L(0); PG8_MMA(0, 0, At, B0); PG8_BAR; PG8_SCHED;
            PG8_LDB(B1, 1, 1); PG8_STAGE(PG8_SB(1, 0), b3, voffB);
            PG8_BAR; PG8_WAIT_L(0); PG8_MMA(0, 1, At, B1); PG8_BAR;
            PG8_LDA(At, 1, 1); PG8_STAGE(PG8_SA(1, 0), a3, voffA);
            PG8_BAR; PG8_WAIT_L(0); PG8_MMA(1, 0, At, B0); PG8_BAR; PG8_SCHED;
            PG8_STAGE(PG8_SB(1, 1), b3 + hstep, voffB);
            PG8_WAIT_V(6); PG8_BAR; PG8_MMA(1, 1, At, B1); PG8_BAR;
            }
        }
        if constexpr (ALIGN_EPI) { if (wr == 0) PG8_BAR; }
        if constexpr (!Epi::AFTER_DRAIN) { E(acc, cur, wr, wc, fr, fq); S.done(cur); }
        if (!has_next) break;
#pragma unroll
        for (int a = 0; a < 2; ++a)
#pragma unroll
            for (int b = 0; b < 2; ++b)
#pragma unroll
                for (int m = 0; m < 4; ++m)
#pragma unroll
                    for (int n = 0; n < 2; ++n) acc[a][b][m][n] = (f32x4){0.f, 0.f, 0.f, 0.f};
        cur = nxt; cA = nA; cB = nB; ++ui;
        if constexpr (ALIGN_EPI) { if (wr == 1) PG8_BAR; }
    }
    PG8_WAIT_V(0);
    if constexpr (!ALIGN_EPI) { if (wr == 0) PG8_BAR; }
    PG8_BAR;
    if constexpr (Epi::AFTER_DRAIN) { E.fused(acc, cur, wr, wc, fr, fq, lds, wid, lane); S.done(cur); }
#undef PG8_SA
#undef PG8_SB
#undef PG8_STAGE
#undef PG8_LDA
#undef PG8_LDB
#undef PG8_MMA
#undef PG8_WAIT_V
#undef PG8_WAIT_L
#undef PG8_BAR
#undef PG8_SCHED
}
}

#ifndef PG8_SP2
#define PG8_SP2 true
#endif
#ifndef PG8_ALIGN
#define PG8_ALIGN true
#endif
#include <hip/hip_bf16.h>
#include <cmath>
namespace attn_body {
using bf16=__hip_bfloat16;
using bf16x8=__attribute__((ext_vector_type(8)))short;
using s16x4=__attribute__((ext_vector_type(4)))short;
using f32x16=__attribute__((ext_vector_type(16)))float;
using u32x4=__attribute__((ext_vector_type(4)))unsigned;
constexpr int SEQ=2048,D=64,QP=512,KP=512,VP=512,OP=1024;
constexpr int NW=8,QBLK=32,QB=QBLK*NW,KVBLK=64,NQB=SEQ/QB;
constexpr int ATTN_UNIT_ROWS=QB;
__device__ __forceinline__ int crow(int r,int hi){return (r&3)+8*(r>>2)+4*hi;}
#define SBAR() __builtin_amdgcn_sched_barrier(0)
__device__ __forceinline__ void cmask(f32x16&p0,f32x16&p1,int jb,int wchunk,int){
  if(jb>wchunk){ const float NEG=-INFINITY;
    #pragma unroll
    for(int r=0;r<16;++r){p0[r]=NEG;p1[r]=NEG;} }
}

constexpr int NSLOT=3, SLOTB=8192;
constexpr int LDS_K=0, LDS_V=NSLOT*SLOTB, LDS_WS=2*NSLOT*SLOTB, LDS_OST=LDS_WS+NW*64*4, LDS_BYTES=LDS_OST+NW*4096;
constexpr float C2=0.125f*1.4426950408889634f;
__device__ __forceinline__ void glds16(const void*gsrc,unsigned lds_dst){unsigned keep;
  asm volatile("s_mov_b32 %0, m0\n\ts_mov_b32 m0, %2\n\ts_nop 0\n\tglobal_load_lds_dwordx4 %1, off\n\ts_mov_b32 m0, %0":"=&s"(keep):"v"(gsrc),"s"(lds_dst):"memory");}
__device__ __forceinline__ float max3f(float a,float b,float c){float r;asm("v_max3_f32 %0, %1, %2, %3":"=v"(r):"v"(a),"v"(b),"v"(c));return r;}
__device__ __forceinline__ float max2f(float a,float b){float r;asm("v_max_f32_e32 %0, %1, %2":"=v"(r):"v"(a),"v"(b));return r;}
__device__ __forceinline__ float fadd_s(float a,float b){float r;asm("v_add_f32_e32 %0, %1, %2":"=v"(r):"v"(a),"v"(b));return r;}
__device__ __forceinline__ float fsub_s(float a,float b){float r;asm("v_sub_f32_e32 %0, %1, %2":"=v"(r):"v"(a),"v"(b));return r;}
typedef float f32x2_t __attribute__((ext_vector_type(2))); typedef __bf16 bf16x2_t __attribute__((ext_vector_type(2)));
__device__ __forceinline__ unsigned cvtpk_s(float lo,float hi){f32x2_t v={lo,hi};bf16x2_t b=__builtin_convertvector(v,bf16x2_t);return __builtin_bit_cast(unsigned,b);}
#define WAIT_BAR(N) asm volatile("s_waitcnt vmcnt(" #N ") lgkmcnt(0)\n\ts_barrier":::"memory")

__device__ __forceinline__ void qkt(f32x16&p0,f32x16&p1,const char*Kslot,const bf16x8*qr,const f32x16&negm,int r32,int hi){
  const char*kb=Kslot+hi*1024+r32*16;
  #pragma unroll
  for(int d0=0;d0<4;++d0){
    const bf16x8 b0=*reinterpret_cast<const bf16x8*>(kb+d0*2048);
    const bf16x8 b1=*reinterpret_cast<const bf16x8*>(kb+d0*2048+512);
    if(d0==0){p0=__builtin_amdgcn_mfma_f32_32x32x16_bf16(b0,qr[0],negm,0,0,0);p1=__builtin_amdgcn_mfma_f32_32x32x16_bf16(b1,qr[0],negm,0,0,0);}
    else{p0=__builtin_amdgcn_mfma_f32_32x32x16_bf16(b0,qr[d0],p0,0,0,0);p1=__builtin_amdgcn_mfma_f32_32x32x16_bf16(b1,qr[d0],p1,0,0,0);}}
}
typedef __attribute__((address_space(3))) const char* lds_cptr;
typedef short v4i16_t __attribute__((ext_vector_type(4)));
__device__ __forceinline__ void kload8(bf16x8*kf,lds_cptr kp){
  kf[0]=*(const __attribute__((address_space(3))) bf16x8*)(kp);      kf[1]=*(const __attribute__((address_space(3))) bf16x8*)(kp+512);
  kf[2]=*(const __attribute__((address_space(3))) bf16x8*)(kp+2048); kf[3]=*(const __attribute__((address_space(3))) bf16x8*)(kp+2560);
  kf[4]=*(const __attribute__((address_space(3))) bf16x8*)(kp+4096); kf[5]=*(const __attribute__((address_space(3))) bf16x8*)(kp+4608);
  kf[6]=*(const __attribute__((address_space(3))) bf16x8*)(kp+6144); kf[7]=*(const __attribute__((address_space(3))) bf16x8*)(kp+6656);
}
__device__ __forceinline__ void kload2(bf16x8*kf,lds_cptr kp,int j){ kf[2*j]=*(const __attribute__((address_space(3))) bf16x8*)(kp+j*2048); kf[2*j+1]=*(const __attribute__((address_space(3))) bf16x8*)(kp+j*2048+512); }
__device__ __forceinline__ s16x4 vtr(lds_cptr p){ return __builtin_bit_cast(s16x4,__builtin_amdgcn_ds_read_tr16_b64_v4i16((__attribute__((address_space(3))) v4i16_t*)p)); }
__device__ __forceinline__ float rowmax(const f32x16&p0,const f32x16&p1){
  float a=max3f(p0[0],p0[1],p1[0]),b=max3f(p0[2],p0[3],p1[1]);a=max3f(a,p1[2],p1[3]);
  #pragma unroll
  for(int r=4;r<16;r+=4){a=max3f(a,p0[r],p0[r+1]);b=max3f(b,p0[r+2],p0[r+3]);a=max3f(a,p1[r],p1[r+1]);b=max3f(b,p1[r+2],p1[r+3]);}
  const float m=max2f(a,b);
  auto rr=__builtin_amdgcn_permlane32_swap(__float_as_uint(m),__float_as_uint(m),false,false);
  return max2f(__uint_as_float(rr[0]),__uint_as_float(rr[1]));
}
__device__ __forceinline__ void pv(f32x16*o,int vb,bf16x8 pa0,bf16x8 pa1,bf16x8 pa2,bf16x8 pa3){
  #pragma unroll
  for(int d0=0;d0<2;++d0){s16x4 lo[4],hi[4];
    #pragma unroll
    for(int ks=0;ks<4;++ks){
      asm volatile("ds_read_b64_tr_b16 %0,%1 offset:%c2":"=&v"(lo[ks]):"v"(vb),"i"(d0*4096+ks*1024):"memory");
      asm volatile("ds_read_b64_tr_b16 %0,%1 offset:%c2":"=&v"(hi[ks]):"v"(vb),"i"(d0*4096+ks*1024+512):"memory");}
    asm volatile("s_waitcnt lgkmcnt(0)":::"memory");SBAR();
    #define PK(k) (bf16x8){lo[k][0],lo[k][1],lo[k][2],lo[k][3],hi[k][0],hi[k][1],hi[k][2],hi[k][3]}
    o[d0]=__builtin_amdgcn_mfma_f32_32x32x16_bf16(pa0,PK(0),o[d0],0,0,0);
    o[d0]=__builtin_amdgcn_mfma_f32_32x32x16_bf16(pa1,PK(1),o[d0],0,0,0);
    o[d0]=__builtin_amdgcn_mfma_f32_32x32x16_bf16(pa2,PK(2),o[d0],0,0,0);
    o[d0]=__builtin_amdgcn_mfma_f32_32x32x16_bf16(pa3,PK(3),o[d0],0,0,0);
    #undef PK
  }
}

#ifndef ATTN_STORE16
#define ATTN_STORE16(p,v) (*(u32x4*)(p)=(v))
#endif
template<int THRL> __device__ __forceinline__ void attn_unit(int b,int qcol,int kcol,int vcol,int ocol,int qb,const bf16*Q,const bf16*__restrict__ K,const bf16*__restrict__ V,bf16*O,char*shm){
  const int tid=threadIdx.x,lane=tid&63,r32=lane&31,hi=lane>>5; const int wid=__builtin_amdgcn_readfirstlane(tid>>6);
  const long rowbase=(long)b*SEQ; const int q0=qb*QB;
  const bf16*Qw=Q+(rowbase+q0+wid*QBLK)*QP+qcol;
  const bf16*Kh=K+rowbase*KP+kcol,*Vh=V+rowbase*VP+vcol;
  const unsigned lds0=(unsigned)(uintptr_t)shm;
  float*wsf=(float*)(shm+LDS_WS)+wid*64;
  const bf16*ksrc=Kh+(long)lane*KP+wid*8;
  const bf16*vsrc=Vh+(long)(16*(wid&3)+(lane>>2))*VP+(wid>>2)*32+(lane&3)*8;
  const unsigned kdst=lds0+LDS_K+wid*1024, vdst=lds0+LDS_V+wid*1024;
  #define DMA_K(t,slot) glds16(ksrc+(long)(t)*KVBLK*KP,(unsigned)__builtin_amdgcn_readfirstlane(kdst+(slot)))
  #define DMA_V(t,slot) glds16(vsrc+(long)(t)*KVBLK*VP,(unsigned)__builtin_amdgcn_readfirstlane(vdst+(slot)))
  const int vb0=(int)(lds0+LDS_V)+((lane>>4)&1)*32+(lane&3)*8+(4*hi+((lane&15)>>2))*64;
  const char*Kbase=shm+LDS_K; bf16x8 kf[8];
  const lds_cptr shm3=(lds_cptr)shm; const lds_cptr kp0=shm3+LDS_K+hi*1024+r32*16; const lds_cptr vp0=shm3+LDS_V+((lane>>4)&1)*32+(lane&3)*8+(4*hi+((lane&15)>>2))*64;
  const int NT=(q0+QB)/KVBLK;
  DMA_K(0,0);DMA_V(0,0);DMA_K(1,SLOTB);
  bf16x8 qr[4];
  #pragma unroll
  for(int d0=0;d0<4;++d0)qr[d0]=*reinterpret_cast<const bf16x8*>(&Qw[(long)r32*QP+d0*16+hi*8]);
  float mhat=0.f,l_reg=0.f;f32x16 o[2];o[0]=f32x16{};o[1]=f32x16{};f32x16 negm=f32x16{};asm volatile("":"+v"(negm));
  const int qrel=wid>>1;
  #define CMASK(P0,P1,t) do{int jb_=(t)-(NT-4); if(jb_>=0)cmask(P0,P1,jb_,qrel,hi);}while(0)
  bool resc=false;
  #define START(P0,P1) do{ const float rm=rowmax(P0,P1); resc=false; \
    { const float dl=rm; mhat=fadd_s(mhat,dl); \
      _Pragma("unroll") for(int r=0;r<16;++r){P0[r]=fsub_s(P0[r],dl);P1[r]=fsub_s(P1[r],dl);} \
      _Pragma("unroll") for(int r=0;r<16;++r)negm[r]=-mhat; asm volatile("":"+v"(negm)); } \
    _Pragma("unroll") for(int r=0;r<16;++r)P0[r]=__builtin_amdgcn_exp2f(P0[r]); }while(0)
  #define RESC() do{ if(resc){ asm volatile("s_waitcnt lgkmcnt(0)":::"memory"); \
      _Pragma("unroll") for(int d_=0;d_<2;++d_) _Pragma("unroll") for(int r=0;r<16;++r)o[d_][r]*=wsf[crow(r,hi)]; } }while(0)
  f32x16 pA0,pA1,pB0,pB1;
  int sl_prev=0,sl_cur=0,sl_next=SLOTB;
  #define ROT() do{sl_prev=sl_cur;sl_cur=sl_next;sl_next=(sl_next==(NSLOT-1)*SLOTB)?0:sl_next+SLOTB;}while(0)
  DMA_K(2,2*SLOTB);
  WAIT_BAR(3);
  qkt(pA0,pA1,Kbase,qr,negm,r32,hi);asm volatile("s_nop 15\n\ts_nop 7":"+v"(pA0),"+v"(pA1));CMASK(pA0,pA1,0);
  START(pA0,pA1);
  _Pragma("unroll") for(int r=0;r<16;++r)pA1[r]=__builtin_amdgcn_exp2f(pA1[r]);
  WAIT_BAR(0);
  DMA_K(3,0);DMA_V(1,SLOTB);
  ROT();
  kload8(kf,kp0+sl_cur);
  WAIT_BAR(2);
  s16x4 vlo[8],vhi[8]; u32x4 pw0,pw1,pw2,pw3;
  #define PKW(P,B) cvtpk_s(P[B],P[B+1])
  #define PAF(k) __builtin_bit_cast(bf16x8,pw##k)
  #define VFR(i) (bf16x8){vlo[i][0],vlo[i][1],vlo[i][2],vlo[i][3],vhi[i][0],vhi[i][1],vhi[i][2],vhi[i][3]}
  #define PIN(x) asm volatile("":"+v"(x))
  #define MX3(a,b,c) __builtin_fmaxf(__builtin_fmaxf((a),(b)),(c))
  #define GAPA(MF,A0,A1,A2,A3,W0,W1,PW) do{ MF; sacc+=A0; sacc+=A1; sacc+=A2; sacc+=A3; PIN(sacc); W0; W1; PIN(PW); SBAR(); }while(0)
  #define EX(v) __builtin_amdgcn_exp2f(v)
  #define GAPB(MF,X,B) do{ MF; X[B]=EX(X[B]); X[B+1]=EX(X[B+1]); X[B+2]=EX(X[B+2]); X[B+3]=EX(X[B+3]); PIN(X); SBAR(); }while(0)
  #define VRD(i) do{ vlo[i]=vtr(vp_+(((i)>>2)*4096+((i)&3)*1024)); vhi[i]=vtr(vp_+(((i)>>2)*4096+((i)&3)*1024+512)); }while(0)
  #define KRD(G,j) do{ if(G){ kload2(kf,kp0+sl_next,j); SBAR(); } }while(0)
  #define STEP(C0,C1,P0,P1,t,GK,GV,GL) do{ SBAR(); \
    const lds_cptr vp_=vp0+sl_prev; \
    VRD(0); SBAR(); float sacc=(P0[0]+P0[1]); \
    GAPA(C0=__builtin_amdgcn_mfma_f32_32x32x16_bf16(kf[0],qr[0],negm,0,0,0), P0[2],P0[3],P0[4],P0[5],     pw0[0]=PKW(P0,0), pw0[1]=PKW(P0,2), pw0); \
    VRD(4); SBAR(); GAPA(C1=__builtin_amdgcn_mfma_f32_32x32x16_bf16(kf[1],qr[0],negm,0,0,0), P0[6],P0[7],P0[8],P0[9],     pw0[2]=PKW(P0,4), pw0[3]=PKW(P0,6), pw0); \
    VRD(1); SBAR(); GAPA(C0=__builtin_amdgcn_mfma_f32_32x32x16_bf16(kf[2],qr[1],C0,0,0,0),   P0[10],P0[11],P0[12],P0[13], pw1[0]=PKW(P0,8), pw1[1]=PKW(P0,10), pw1); \
    VRD(5); SBAR(); GAPA(C1=__builtin_amdgcn_mfma_f32_32x32x16_bf16(kf[3],qr[1],C1,0,0,0),   P0[14],P0[15],P1[0],P1[1],   pw1[2]=PKW(P0,12),pw1[3]=PKW(P0,14), pw1); \
    VRD(2); SBAR(); GAPA(C0=__builtin_amdgcn_mfma_f32_32x32x16_bf16(kf[4],qr[2],C0,0,0,0),   P1[2],P1[3],P1[4],P1[5],     pw2[0]=PKW(P1,0), pw2[1]=PKW(P1,2), pw2); \
    VRD(6); SBAR(); GAPA(C1=__builtin_amdgcn_mfma_f32_32x32x16_bf16(kf[5],qr[2],C1,0,0,0),   P1[6],P1[7],P1[8],P1[9],     pw2[2]=PKW(P1,4), pw2[3]=PKW(P1,6), pw2); \
    VRD(3); SBAR(); GAPA(C0=__builtin_amdgcn_mfma_f32_32x32x16_bf16(kf[6],qr[3],C0,0,0,0),   P1[10],P1[11],P1[12],P1[13], pw3[0]=PKW(P1,8), pw3[1]=PKW(P1,10), pw3); \
    VRD(7); SBAR(); GAPA(C1=__builtin_amdgcn_mfma_f32_32x32x16_bf16(kf[7],qr[3],C1,0,0,0),   P1[14],P1[15],0.f,0.f,       pw3[2]=PKW(P1,12),pw3[3]=PKW(P1,14), pw3); \
    l_reg+=sacc; \
    if(GK){DMA_K((t)+3,sl_cur);} if(GV){DMA_V((t)+1,sl_next);} \
    CMASK(C0,C1,t); \
    { float a=MX3(C0[0],C0[1],C1[0]),b=MX3(C0[2],C0[3],C1[1]); a=MX3(a,C1[2],C1[3]); \
      _Pragma("unroll") for(int r=4;r<16;r+=4){a=MX3(a,C0[r],C0[r+1]);b=MX3(b,C0[r+2],C0[r+3]);a=MX3(a,C1[r],C1[r+1]);b=MX3(b,C1[r+2],C1[r+3]);} \
      float rm=__builtin_fmaxf(a,b); { auto rr=__builtin_amdgcn_permlane32_swap(__float_as_uint(rm),__float_as_uint(rm),false,false); rm=__builtin_fmaxf(__uint_as_float(rr[0]),__uint_as_float(rr[1])); } \
      resc=false; \
      if(__builtin_expect(__any(rm>(float)THRL),0)){ const float dl=__builtin_fmaxf(rm,0.f); mhat+=dl; \
        _Pragma("unroll") for(int r=0;r<16;++r){C0[r]-=dl;C1[r]-=dl;} \
        _Pragma("unroll") for(int r=0;r<16;++r)negm[r]=-mhat; asm volatile("":"+v"(negm)); \
        const float f=__builtin_amdgcn_exp2f(-dl); l_reg*=f; if(hi==0)wsf[r32]=f; resc=true; } } \
    SBAR(); \
    GAPB(o[0]=__builtin_amdgcn_mfma_f32_32x32x16_bf16(PAF(0),VFR(0),o[0],0,0,0), C0,0); \
    GAPB(o[1]=__builtin_amdgcn_mfma_f32_32x32x16_bf16(PAF(0),VFR(4),o[1],0,0,0), C0,4); \
    KRD(GL,0); GAPB(o[0]=__builtin_amdgcn_mfma_f32_32x32x16_bf16(PAF(1),VFR(1),o[0],0,0,0), C0,8); \
    KRD(GL,1); GAPB(o[1]=__builtin_amdgcn_mfma_f32_32x32x16_bf16(PAF(1),VFR(5),o[1],0,0,0), C0,12); \
    KRD(GL,2); GAPB(o[0]=__builtin_amdgcn_mfma_f32_32x32x16_bf16(PAF(2),VFR(2),o[0],0,0,0), C1,0); \
    KRD(GL,3); GAPB(o[1]=__builtin_amdgcn_mfma_f32_32x32x16_bf16(PAF(2),VFR(6),o[1],0,0,0), C1,4); \
    GAPB(o[0]=__builtin_amdgcn_mfma_f32_32x32x16_bf16(PAF(3),VFR(3),o[0],0,0,0), C1,8); \
    GAPB(o[1]=__builtin_amdgcn_mfma_f32_32x32x16_bf16(PAF(3),VFR(7),o[1],0,0,0), C1,12); \
    }while(0)
  int t=1;
  #undef CMASK
  #define CMASK(P0,P1,t) do{}while(0)
  for(;t+5<NT;t+=2){
    STEP(pB0,pB1,pA0,pA1,t,true,true,true);     WAIT_BAR(2); RESC(); ROT();
    STEP(pA0,pA1,pB0,pB1,t+1,true,true,true);   WAIT_BAR(2); RESC(); ROT();
  }
  #undef CMASK
  #define CMASK(P0,P1,t) do{int jb_=(t)-(NT-4); if(jb_>=0)cmask(P0,P1,jb_,qrel,hi);}while(0)
  #define ENDW(tt) do{ if((tt)+3<NT){WAIT_BAR(2);} else if((tt)+2<NT){WAIT_BAR(1);} else {WAIT_BAR(0);} }while(0)
  for(;t+1<NT;t+=2){
    STEP(pB0,pB1,pA0,pA1,t,(t+3<NT),(t+1<NT),(t+1<NT));       ENDW(t);   RESC(); ROT();
    STEP(pA0,pA1,pB0,pB1,t+1,(t+4<NT),(t+2<NT),(t+2<NT));     ENDW(t+1); RESC(); ROT();
  }
  STEP(pB0,pB1,pA0,pA1,NT-1,false,false,false); RESC();
  { float sacc=pB0[0]+pB0[1]; _Pragma("unroll") for(int r=2;r<16;++r)sacc+=pB0[r]; _Pragma("unroll") for(int r=0;r<16;++r)sacc+=pB1[r]; l_reg+=sacc;
    pw0=(u32x4){PKW(pB0,0),PKW(pB0,2),PKW(pB0,4),PKW(pB0,6)};pw1=(u32x4){PKW(pB0,8),PKW(pB0,10),PKW(pB0,12),PKW(pB0,14)};pw2=(u32x4){PKW(pB1,0),PKW(pB1,2),PKW(pB1,4),PKW(pB1,6)};pw3=(u32x4){PKW(pB1,8),PKW(pB1,10),PKW(pB1,12),PKW(pB1,14)};
    SBAR(); pv(o,vb0+sl_cur,PAF(0),PAF(1),PAF(2),PAF(3)); }
  #undef PKW
  #undef PAF
  #undef VFR
  #undef PIN
  #undef MX3
  #undef GAPA
  #undef GAPB
  #undef EX
  #undef VRD
  #undef KRD
  #undef STEP
  #undef ENDW
  {auto rr=__builtin_amdgcn_permlane32_swap(__float_as_uint(l_reg),__float_as_uint(l_reg),false,false);l_reg=__uint_as_float(rr[0])+__uint_as_float(rr[1]);}
  if(hi==0)wsf[32+r32]=l_reg;asm volatile("s_waitcnt lgkmcnt(0)":::"memory");
  float rli[16];
  #pragma unroll
  for(int r=0;r<16;++r)rli[r]=__builtin_amdgcn_rcpf(wsf[32+crow(r,hi)]);
  bf16*Ow=O+(rowbase+q0+wid*QBLK)*OP+ocol;
  { bf16*stg=(bf16*)(shm+LDS_OST)+wid*2048;
    #pragma unroll
    for(int r=0;r<16;++r){const int orow=crow(r,hi);
      #pragma unroll
      for(int d0=0;d0<2;++d0)stg[orow*64+d0*32+r32]=__float2bfloat16(o[d0][r]*rli[r]);}
    asm volatile("s_waitcnt lgkmcnt(0)":::"memory");
    #pragma unroll
    for(int i=0;i<4;++i){const int row=i*8+(lane>>3),ch=lane&7; const u32x4 v=*(const u32x4*)(stg+row*64+ch*8); ATTN_STORE16(Ow+(long)row*OP+ch*8,v);} }
  asm volatile("s_waitcnt lgkmcnt(0)\n\ts_barrier":::"memory");
  #undef DMA_K
  #undef DMA_V
  #undef CMASK
  #undef START
  #undef RESC
  #undef ROT
}
constexpr int ATTN_LDS_BYTES=LDS_BYTES;
struct AttnTensors { const bf16* Q; const bf16* K; const bf16* V; bf16* O; };
struct AttnUnit { int bvh; int qb; };
struct StaticOrder {
  int ai,nA;
  __device__ __forceinline__ StaticOrder(int ai_,int nA_):ai(ai_),nA(nA_){}
  __device__ __forceinline__ bool next(int i,AttnUnit&u)const{
    if(nA==128){ if(i>=8)return false; u.bvh=ai; u.qb=7-i; return true; }
    if(i>=4)return false; const int s=ai&1; u.bvh=ai>>1; u.qb=(i==0)?7-s:(i==1)?4+s:(i==2)?3-s:s; return true; }
  __device__ __forceinline__ void a_ready(const AttnUnit&)const{}
  __device__ __forceinline__ void done(const AttnUnit&)const{}
};
template<class Sched,int THRL=8> __device__ __forceinline__ void attn_phase(char*lds,const AttnTensors&T,const Sched&S){
  AttnUnit u;
  for(int i=0;S.next(i,u);++i){ S.a_ready(u); const int b=u.bvh>>4,vh=u.bvh&15,s=vh>>1,half=vh&1;
    attn_unit<THRL>(b,s*64,s*64,(s>>1)*128+half*64,s*128+half*64,u.qb,T.Q,T.K,T.V,T.O,lds); S.done(u); }
}
#undef SBAR
#undef WAIT_BAR
}
#include <hip/hip_cooperative_groups.h>
typedef unsigned short bf16;
#define GAS __attribute__((address_space(1)))
#define LAS __attribute__((address_space(3)))
typedef unsigned v4u __attribute__((ext_vector_type(4)));
typedef unsigned v2u __attribute__((ext_vector_type(2)));
typedef float f32x4 __attribute__((ext_vector_type(4)));
#define LDS_WAIT() asm volatile("s_waitcnt lgkmcnt(0)" ::: "memory")
__device__ __forceinline__ unsigned f2bf(float f) { unsigned u = __builtin_bit_cast(unsigned, f); return (u + 0x7fffu + ((u >> 16) & 1u)) >> 16; }
__device__ __forceinline__ unsigned pk2(float lo, float hi) { return f2bf(lo) | (f2bf(hi) << 16); }
__device__ __forceinline__ float bflo(unsigned w) { return __builtin_bit_cast(float, w << 16); }
__device__ __forceinline__ float bfhi(unsigned w) { return __builtin_bit_cast(float, w & 0xffff0000u); }
__device__ __forceinline__ float bf1(unsigned short h) { return __builtin_bit_cast(float, (unsigned)h << 16); }
template <int CTRL> __device__ __forceinline__ float dppf(float x) { return __builtin_bit_cast(float, __builtin_amdgcn_update_dpp(0, __builtin_bit_cast(int, x), CTRL, 0xf, 0xf, false)); }
__device__ __forceinline__ float row16_allsum(float x) { x += dppf<0x128>(x); x += dppf<0x124>(x); x += dppf<0x122>(x); x += dppf<0x121>(x); return x; }
__device__ __forceinline__ float oct_allsum(float x) { x += dppf<0xB1>(x); x += dppf<0x4E>(x); x += dppf<0x141>(x); return x; }
__device__ __forceinline__ float u2f(unsigned u) { return __builtin_bit_cast(float, u); }
__device__ __forceinline__ unsigned f2u(float f) { return __builtin_bit_cast(unsigned, f); }
__device__ __forceinline__ float sw32(float a, float b) { auto r = __builtin_amdgcn_permlane32_swap(f2u(a), f2u(b), false, false); const unsigned r0 = r[0], r1 = r[1]; return u2f(r0) + u2f(r1); }
__device__ __forceinline__ float sw16(float a, float b) { auto r = __builtin_amdgcn_permlane16_swap(f2u(a), f2u(b), false, false); const unsigned r0 = r[0], r1 = r[1]; return u2f(r0) + u2f(r1); }
__device__ __forceinline__ float wave_allsum(float x) { x = row16_allsum(x); x = sw16(x, x); return sw32(x, x); }
__device__ __forceinline__ float red4(float x0, float x1, float x2, float x3) { return row16_allsum(sw16(sw32(x0, x1), sw32(x2, x3))); }

#define XB_TMO      128
#define XB_XCNT(j)  (256  + 64 * (j))
#define XB_XSUB(j)  (1280 + 64 * (j))
#define XB_XGEN(j)  (2304 + 64 * (j))
#define XB_TOP      3328
#define XB_TOPGEN   3392
#define XCD_BAR_WORDS 3456
#define XB_SPIN_CAP (1u << 18)

__device__ __forceinline__ unsigned xb_ld(unsigned* p)              { return __hip_atomic_load(p, __ATOMIC_RELAXED, __HIP_MEMORY_SCOPE_AGENT); }
__device__ __forceinline__ unsigned xb_add(unsigned* p, unsigned v) { return __hip_atomic_fetch_add(p, v, __ATOMIC_RELAXED, __HIP_MEMORY_SCOPE_AGENT); }
__device__ __forceinline__ unsigned xb_xcc_id() { return (unsigned)__builtin_amdgcn_s_getreg((3 << 11) | 20) & 0xFu; }
#define XB_SPIN(cond, bar) do { unsigned _sp = 0; while (cond) { __builtin_amdgcn_s_sleep(1); \
    if ((++_sp & 255u) == 0u) { if (xb_ld(&(bar)[XB_TMO])) break; if (_sp > XB_SPIN_CAP) { atomicAdd(&(bar)[XB_TMO], 1u); break; } } } } while (0)

struct XcdBarrier {
    unsigned* bar; unsigned x;
    volatile LAS unsigned* st;
};

__device__ __forceinline__ XcdBarrier xcd_barrier_post(unsigned* bar, volatile LAS unsigned* st) {
    XcdBarrier b; b.bar = bar; b.x = xb_xcc_id(); b.st = st;
    if (threadIdx.x == 0) (void)xb_add(&bar[XB_XCNT(b.x)], 1u);
    return b;
}
__device__ __forceinline__ void xcd_barrier_complete(unsigned* bar, unsigned x, unsigned& nloc, unsigned& nx) {
    const unsigned G = gridDim.x * gridDim.y * gridDim.z;
    unsigned sum, cnt, mine, sp = 0u;
    for (;;) {
        sum = 0u; cnt = 0u; mine = 0u;
#pragma unroll
        for (unsigned j = 0; j < 16; ++j) { const unsigned c = xb_ld(&bar[XB_XCNT(j)]); sum += c; cnt += (c > 0u) ? 1u : 0u; }
        mine = xb_ld(&bar[XB_XCNT(x)]);
        if (sum == G) break;
        __builtin_amdgcn_s_sleep(1);
        if ((++sp & 255u) == 0u) { if (xb_ld(&bar[XB_TMO])) break; if (sp > XB_SPIN_CAP) { atomicAdd(&bar[XB_TMO], 1u); break; } }
    }
    nloc = mine > 0u ? mine : 1u; nx = cnt > 0u ? cnt : 1u;
}

__device__ __forceinline__ void xcd_barrier(const XcdBarrier& b) {
    asm volatile("s_waitcnt vmcnt(0)" ::: "memory");
    __syncthreads();
    if (threadIdx.x == 0) {
        unsigned* bar = b.bar;
        __builtin_amdgcn_s_waitcnt(0);
        unsigned nloc = b.st[0], nx = b.st[1];
        if (nloc == 0u) { xcd_barrier_complete(bar, b.x, nloc, nx); b.st[0] = nloc; b.st[1] = nx; }
        const unsigned old = xb_add(&bar[XB_XSUB(b.x)], 1u);
        const unsigned gen = old / nloc;
        if (old + 1u == (gen + 1u) * nloc) {
            __builtin_amdgcn_fence(__ATOMIC_RELEASE, "agent");
            asm volatile("s_waitcnt vmcnt(0)" ::: "memory");
            const unsigned og = xb_add(&bar[XB_TOP], 1u);
            const unsigned tg = og / nx;
            if (og + 1u == (tg + 1u) * nx) xb_add(&bar[XB_TOPGEN], 1u);
            else XB_SPIN(xb_ld(&bar[XB_TOPGEN]) == tg, bar);
            __builtin_amdgcn_fence(__ATOMIC_ACQUIRE, "agent");
            xb_add(&bar[XB_XGEN(b.x)], 1u);
            asm volatile("s_waitcnt vmcnt(0)" ::: "memory");
        } else {
            XB_SPIN(xb_ld(&bar[XB_XGEN(b.x)]) == gen, bar);
            __builtin_amdgcn_fence(__ATOMIC_ACQUIRE, "agent");
            asm volatile("s_waitcnt vmcnt(0)" ::: "memory");
        }
    }
    __syncthreads();
}


constexpr int CW_BAR = 4096;
constexpr int MISC_OFF = 162816 + 320;
struct Frame {
    LAS unsigned char* lds;
    int tid, lane, wave, G, bx;
    float* out; unsigned char* ws;
};
struct Args { const float* in[26]; float* out; unsigned char* ws; int ph_lo, ph_hi; };
typedef const float* cfp_t;
typedef __attribute__((address_space(4))) const cfp_t* ktab_t;
struct InTab { ktab_t p; __device__ __forceinline__ const float* operator[](int i) const { return p[i]; } };
enum { I_X = 0, I_NMG, I_WIN, I_MU, I_W0, I_W2, I_A0, I_A2, I_G2, I_KK, I_KA, I_RK, I_LNG, I_LNB, I_LQ1, I_LK1, I_LQ2, I_LK2, I_SUBG, I_WA, I_WB, I_WO, I_NFG, I_FF1, I_FF2, I_NFIN };

template <bool ROPE> __device__ __forceinline__ void p0_transpose_item(const float* W, int K, int N, bf16* WT, LAS float* scr, int item, int lane, int pitch = 0, int koff = 0) {
    if (pitch == 0) pitch = K;
    const int nblk = N / 32, kb = item / nblk, nb = item % nblk, k0 = 64 * kb, n0 = 32 * nb;
#pragma unroll
    for (int i = 0; i < 8; ++i) { const int kk = 8 * i + (lane >> 3), c4 = 4 * (lane & 7); const f32x4 w4 = *(const GAS f32x4*)(W + (size_t)(k0 + kk) * N + n0 + c4);
        scr[kk * 33 + c4] = w4.x; scr[kk * 33 + c4 + 1] = w4.y; scr[kk * 33 + c4 + 2] = w4.z; scr[kk * 33 + c4 + 3] = w4.w; }
    LDS_WAIT(); asm volatile("" ::: "memory");
    const int c = lane & 7;
#pragma unroll
    for (int j = 0; j < 4; ++j) { const int n = (lane >> 3) + 8 * j; const LAS float* s = scr + (8 * c) * 33 + n;
        v4u o; o.x = pk2(s[0 * 33], s[1 * 33]); o.y = pk2(s[2 * 33], s[3 * 33]); o.z = pk2(s[4 * 33], s[5 * 33]); o.w = pk2(s[6 * 33], s[7 * 33]);
        int col = n0 + n;
        if (ROPE && col < 1024) { const int d = col & 63, dd = d & 31; col = (col & ~63) + 8 * (dd >> 2) + (d >> 5) * 4 + (dd & 3); }
        *(GAS v4u*)(WT + (size_t)col * pitch + koff + k0 + 8 * c) = o; }
    LDS_WAIT(); asm volatile("" ::: "memory");
}
__device__ __forceinline__ void rms_row_to_bf16(const float* xrow, const float* g, bf16* orow, int lane) {
    const GAS f32x4* xr = (const GAS f32x4*)xrow + lane; const f32x4* gr = (const f32x4*)g + lane;
    f32x4 v[4]; float s = 0.f;
#pragma unroll
    for (int j = 0; j < 4; ++j) { v[j] = xr[64 * j]; s += (v[j].x * v[j].x + v[j].y * v[j].y) + (v[j].z * v[j].z + v[j].w * v[j].w); }
    const float rstd = 1.0f / sqrtf(wave_allsum(s) * (1.f / D) + NORM_EPS);
    GAS unsigned long long* o8 = (GAS unsigned long long*)orow + lane;
#pragma unroll
    for (int j = 0; j < 4; ++j) { const f32x4 gg = gr[64 * j];
        o8[64 * j] = (unsigned long long)pk2(v[j].x * rstd * gg.x, v[j].y * rstd * gg.y) | ((unsigned long long)pk2(v[j].z * rstd * gg.z, v[j].w * rstd * gg.w) << 32); }
}
__device__ __forceinline__ void rms_row_to_f32(const float* xrow, const float* g, float* orow, int lane) {
    const GAS f32x4* xr = (const GAS f32x4*)xrow + lane; const f32x4* gr = (const f32x4*)g + lane;
    f32x4 v[4]; float s = 0.f;
#pragma unroll
    for (int j = 0; j < 4; ++j) { v[j] = xr[64 * j]; s += (v[j].x * v[j].x + v[j].y * v[j].y) + (v[j].z * v[j].z + v[j].w * v[j].w); }
    const float rstd = 1.0f / sqrtf(wave_allsum(s) * (1.f / D) + NORM_EPS);
    GAS f32x4* o = (GAS f32x4*)orow + lane;
#pragma unroll
    for (int j = 0; j < 4; ++j) { const f32x4 gg = gr[64 * j]; o[64 * j] = v[j] * rstd * gg; }
}
__device__ __forceinline__ void p0_prologue(Frame& F, const InTab& A) {
    LAS float* scr = (LAS float*)(F.lds + RING_OFF + F.wave * 16384);
    const int gw = F.bx * NWAVES + F.wave, NGW = F.G * NWAVES;
    unsigned char* ws = F.ws;
    constexpr int I_IN = (D / 64) * (D_IN / 32), I_A = (512 / 64) * (D / 32), I_O = (D / 64) * (D / 32), I_1 = (D / 64) * (FF / 32), I_2 = (FF / 64) * (D / 32);
    (void)I_A; (void)I_O; (void)I_1; (void)I_2;
    for (int it = gw; it < I_IN; it += NGW) p0_transpose_item<true>(A[I_WIN], D, D_IN, (bf16*)(ws + WS_WIN), scr, it, F.lane);
    if (false) for (int it = gw; it < 0; it += NGW) {
        int r = it;
        if (r < I_A) { p0_transpose_item<false>(A[I_WA], 512, D, (bf16*)(ws + WS_WA), scr, r, F.lane, 1024, 0); continue; } r -= I_A;
        if (r < I_A) { p0_transpose_item<false>(A[I_WB], 512, D, (bf16*)(ws + WS_WA), scr, r, F.lane, 1024, 512); continue; } r -= I_A;
        if (r < I_O) { p0_transpose_item<false>(A[I_WO], D, D, (bf16*)(ws + WS_WO), scr, r, F.lane); continue; } r -= I_O;
        if (r < I_1) { p0_transpose_item<false>(A[I_FF1], D, FF, (bf16*)(ws + WS_W1), scr, r, F.lane); continue; } r -= I_1;
        p0_transpose_item<false>(A[I_FF2], FF, D, (bf16*)(ws + WS_W2), scr, r, F.lane);
    }
    const int gt = F.bx * (NWAVES * 64) + F.tid, NGT = F.G * NWAVES * 64;
    for (int e = gt; e < NLORA * (KLORA / 8); e += NGT) { const int n = e % NLORA, k8 = (e / NLORA) * 8; float v[8];
#pragma unroll
        for (int i = 0; i < 8; ++i) { const int k = k8 + i; float x = 0.f;
            if (n < 512) { if (k < 64) x = A[I_W2][(size_t)k * 512 + n]; }
            else if (n < 1024) { if (k >= 64 && k < 128) x = A[I_A2][(size_t)(k - 64) * 512 + (n - 512)]; }
            else { if (k >= 128) x = A[I_G2][(size_t)(k - 128) * 512 + (n - 1024)]; }
            v[i] = x; }
        v4u o; o.x = pk2(v[0], v[1]); o.y = pk2(v[2], v[3]); o.z = pk2(v[4], v[5]); o.w = pk2(v[6], v[7]);
        *(GAS v4u*)((bf16*)(ws + WS_WL) + (size_t)n * KLORA + k8) = o; }
    for (int e = gt; e < SEQ * 32; e += NGT) { const int pos = e >> 5, i = e & 31;
        const float inv = exp2f(-(float)i * 0.41524101186092029f);
        const float ang = (float)pos * inv; float s, c; sincosf(ang, &s, &c);
        ((float*)(ws + WS_ROPE_C))[e] = c; ((float*)(ws + WS_ROPE_S))[e] = s; }
    for (int m = gw; m < M; m += NGW) rms_row_to_bf16(A[I_X] + (size_t)m * D, A[I_NMG], (bf16*)(ws + WS_XN) + (size_t)m * D, F.lane);
}

__device__ __forceinline__ void late_weights(Frame& F, const InTab& A, int part, int nparts, int cu0) {
    int lane_ = F.lane; asm volatile("" : "+v"(lane_));
    LAS float* scr = (LAS float*)(F.lds + RING_OFF + F.wave * 16384);
    unsigned char* ws = F.ws;
    constexpr int I_A = (512 / 64) * (D / 32), I_O = (D / 64) * (D / 32), I_1 = (D / 64) * (FF / 32), I_2 = (FF / 64) * (D / 32), NIT = 2 * I_A + I_O + I_1 + I_2;
    const int per = NIT / nparts, lo = part * per, hi = lo + per;
    const int gw = (F.bx - cu0) * NWAVES + F.wave, NGW = (F.G - cu0) * NWAVES;
    for (int it = lo + gw; it < hi; it += NGW) {
        int r = it;
        if (r < I_A) { p0_transpose_item<false>(A[I_WA], 512, D, (bf16*)(ws + WS_WA), scr, r, lane_, 1024, 0); continue; } r -= I_A;
        if (r < I_A) { p0_transpose_item<false>(A[I_WB], 512, D, (bf16*)(ws + WS_WA), scr, r, lane_, 1024, 512); continue; } r -= I_A;
        if (r < I_O) { p0_transpose_item<false>(A[I_WO], D, D, (bf16*)(ws + WS_WO), scr, r, lane_); continue; } r -= I_O;
        if (r < I_1) { p0_transpose_item<false>(A[I_FF1], D, FF, (bf16*)(ws + WS_W1), scr, r, lane_); continue; } r -= I_1;
        p0_transpose_item<false>(A[I_FF2], FF, D, (bf16*)(ws + WS_W2), scr, r, lane_);
    }
}
__device__ __forceinline__ void prep1_phase(Frame& F, const InTab& A) {
    const int gw = F.bx * NWAVES + F.wave, NGW = F.G * NWAVES, lane = F.lane;
    const bf16* WAG = (const bf16*)(F.ws + WS_WAG); bf16* LIN = (bf16*)(F.ws + WS_LIN);
    const f32x4 mu = *(const f32x4*)(A[I_MU] + 1536 + 4 * lane);
    for (int g = gw; g < M / 8; g += NGW) {
        const int m0 = g * 8; v2u row[9];
        row[0] = (v2u){0u, 0u}; if ((m0 & (SEQ - 1)) != 0) row[0] = *(const GAS v2u*)(WAG + (size_t)(m0 - 1) * 256 + 4 * lane);
#pragma unroll
        for (int j = 0; j < 8; ++j) row[j + 1] = *(const GAS v2u*)(WAG + (size_t)(m0 + j) * 256 + 4 * lane);
#pragma unroll
        for (int j = 0; j < 8; ++j) {
            float z[4] = {bflo(row[j + 1].x), bfhi(row[j + 1].x), bflo(row[j + 1].y), bfhi(row[j + 1].y)}; const float p[4] = {bflo(row[j].x), bfhi(row[j].x), bflo(row[j].y), bfhi(row[j].y)};
#pragma unroll
            for (int e = 0; e < 4; ++e) { float v = z[e] + (p[e] - z[e]) * mu[e];
                if (lane < 16) v = 1.0f - 2.0f * __builtin_amdgcn_rcpf(1.0f + __expf(2.0f * v));
                else if (lane >= 32) v = __builtin_amdgcn_rcpf(1.0f + __expf(-v));
                z[e] = v; }
            v2u o; o.x = pk2(z[0], z[1]); o.y = pk2(z[2], z[3]);
            *(GAS v2u*)(LIN + (size_t)(m0 + j) * 256 + 4 * lane) = o;
        }
    }
}
struct ScanRaw { unsigned short r[9], k[9], v[9], a[8]; float d[8]; };
__device__ __forceinline__ void scan_load(ScanRaw& R, const bf16* RKV, const float* DEC, const bf16* AA, size_t row0, int t0, int c) {
#pragma unroll
    for (int j = 0; j < 9; ++j) { int t = t0 - 1 + j; if (t < 0) t = 0; const bf16* p = RKV + (row0 + t) * 1536 + c;
        R.r[j] = *(const GAS bf16*)p; R.k[j] = *(const GAS bf16*)(p + 512); R.v[j] = *(const GAS bf16*)(p + 1024); }
#pragma unroll
    for (int j = 0; j < 8; ++j) { R.d[j] = *(const GAS float*)(DEC + (row0 + t0 + j) * 512 + c); R.a[j] = *(const GAS bf16*)(AA + (row0 + t0 + j) * 512 + c); }
}
__device__ __forceinline__ void scan_phase(Frame& F, const InTab& A, int si) {
    const int lane = F.lane, wave = F.wave, tid = F.tid;
    const int bh = si >> 1, half = si & 1, b = bh >> 3, h = bh & 7, c = h * 64 + lane;
    LAS float* IN = (LAS float*)(F.lds + RING_OFF);
    LAS float* VV = IN + 5 * 4096;
    LAS float* YBUF = VV + 2048;
    const bf16* RKV = (const bf16*)(F.ws + WS_RKV); const float* DEC = (const float*)(F.ws + WS_DEC); const bf16* AA = (const bf16*)(F.ws + WS_AA);
    bf16* Y = (bf16*)(F.ws + WS_Y); float* BON = (float*)(F.ws + WS_BON);
    const float mu_r = A[I_MU][c], mu_k = A[I_MU][512 + c], mu_v = A[I_MU][1024 + c], kkc = A[I_KK][c], kac = A[I_KA][c], rkc = A[I_RK][c];
    const size_t row0 = (size_t)b * SEQ;
    const int myv = (int)(red4(0.f, 1.f, 2.f, 3.f) * (1.0f / 64.0f) + 0.5f);
    const int L0 = __builtin_ctzll(__ballot(myv == 0)), L1 = __builtin_ctzll(__ballot(myv == 1)), L2 = __builtin_ctzll(__ballot(myv == 2)), L3 = __builtin_ctzll(__ballot(myv == 3));
    float S0 = 0.f, S1 = 0.f, S2 = 0.f, S3 = 0.f;
    ScanRaw R; scan_load(R, RKV, DEC, AA, row0, wave * 8, c);
    for (int blk = 0; blk < SEQ / 64; ++blk) {
        {
            const int t0 = blk * 64 + wave * 8;
            f32x4 qd[2], qa[2], qb[2], qk[2], qr[2], qv[2];
#pragma unroll
            for (int j = 0; j < 8; ++j) {
                const float pz = (t0 + j == 0) ? 0.f : 1.f;
                const float rt_ = bf1(R.r[j + 1]), kt_ = bf1(R.k[j + 1]), vt_ = bf1(R.v[j + 1]);
                const float rs = rt_ + (bf1(R.r[j]) * pz - rt_) * mu_r, ks = kt_ + (bf1(R.k[j]) * pz - kt_) * mu_k, vs = vt_ + (bf1(R.v[j]) * pz - vt_) * mu_v;
                const float kkr = ks * kkc, n2 = wave_allsum(kkr * kkr), kk = kkr / __builtin_fmaxf(sqrtf(n2), 1e-12f);
                const float a = 1.0f / (1.0f + __expf(-bf1(R.a[j]))), kx = ks * (1.0f + (a - 1.0f) * kac);
                const float bon = wave_allsum(rs * kx * rkc);
                if (half == 0 && lane == 0) BON[(row0 + t0 + j) * 8 + h] = bon;
                qd[j >> 2][j & 3] = __expf(-0.6065306597f / (1.0f + __expf(-R.d[j])));     qa[j >> 2][j & 3] = -kk; qb[j >> 2][j & 3] = kk * a; qk[j >> 2][j & 3] = kx; qr[j >> 2][j & 3] = rs; qv[j >> 2][j & 3] = vs;
            }
#pragma unroll
            for (int q = 0; q < 2; ++q) { const int t4 = wave * 2 + q; LAS f32x4* p = (LAS f32x4*)IN + t4 * 64 + lane;
                p[0 * 1024] = qd[q]; p[1 * 1024] = qa[q]; p[2 * 1024] = qb[q]; p[3 * 1024] = qk[q]; p[4 * 1024] = qr[q];
                if ((lane >> 5) == half) ((LAS f32x4*)VV)[t4 * 32 + (lane & 31)] = qv[q]; }
        }
        __syncthreads();
        if (blk + 1 < SEQ / 64) scan_load(R, RKV, DEC, AA, row0, (blk + 1) * 64 + wave * 8, c);
#pragma unroll 1
        for (int t4 = 0; t4 < 16; ++t4) {
            const LAS f32x4* p = (const LAS f32x4*)IN + t4 * 64 + lane;
            const f32x4 W4 = p[0], A4 = p[1024], B4 = p[2048], K4 = p[3072], R4 = p[4096];
            const LAS f32x4* pv = (const LAS f32x4*)VV + t4 * 32 + wave * 4;
            const f32x4 V0 = pv[0], V1 = pv[1], V2 = pv[2], V3 = pv[3];
            f32x4 yq;
#pragma unroll
            for (int ts = 0; ts < 4; ++ts) {
                const float w = W4[ts], a = A4[ts], bb = B4[ts], kx = K4[ts], r = R4[ts];
                const float t = red4(S0 * a, S1 * a, S2 * a, S3 * a);
                const float sa0 = __builtin_bit_cast(float, __builtin_amdgcn_readlane(__builtin_bit_cast(int, t), L0)), sa1 = __builtin_bit_cast(float, __builtin_amdgcn_readlane(__builtin_bit_cast(int, t), L1));
                const float sa2 = __builtin_bit_cast(float, __builtin_amdgcn_readlane(__builtin_bit_cast(int, t), L2)), sa3 = __builtin_bit_cast(float, __builtin_amdgcn_readlane(__builtin_bit_cast(int, t), L3));
                S0 = S0 * w + (sa0 * bb + V0[ts] * kx); S1 = S1 * w + (sa1 * bb + V1[ts] * kx); S2 = S2 * w + (sa2 * bb + V2[ts] * kx); S3 = S3 * w + (sa3 * bb + V3[ts] * kx);
                yq[ts] = red4(S0 * r, S1 * r, S2 * r, S3 * r);
            }
            if ((lane & 15) == 0) *(LAS f32x4*)(YBUF + (wave * 4 + myv) * 68 + t4 * 4) = yq;
        }
        __syncthreads();
        { const int t = tid >> 3, rg = tid & 7; const LAS float* yb = YBUF + (4 * rg) * 68 + t;
          v2u o; o.x = pk2(yb[0], yb[68]); o.y = pk2(yb[136], yb[204]);
          *(GAS v2u*)(Y + (row0 + blk * 64 + t) * 512 + h * 64 + 32 * half + 4 * rg) = o; }
    }
    __syncthreads();
}
__device__ __forceinline__ void post_phase(Frame& F, const InTab& A) {
    const int gw = F.bx * NWAVES + F.wave, NGW = F.G * NWAVES, lane = F.lane;
    const bf16* O = (const bf16*)(F.ws + WS_O); const bf16* Y = (const bf16*)(F.ws + WS_Y); const bf16* RKV = (const bf16*)(F.ws + WS_RKV); const bf16* GG = (const bf16*)(F.ws + WS_GG);
    const float* BON = (const float*)(F.ws + WS_BON); bf16* YA = (bf16*)(F.ws + WS_YA);
    const float lam = __expf(wave_allsum(A[I_LQ1][lane] * A[I_LK1][lane])) - __expf(wave_allsum(A[I_LQ2][lane] * A[I_LK2][lane])) + LAMBDA_INIT;
    const int ca = 8 * lane, ha = lane >> 4, ea = ca & 127;
    const int hb = lane >> 3;
    float sg[8], lg[8], lb[8], muv[8];
#pragma unroll
    for (int e = 0; e < 8; ++e) { sg[e] = A[I_SUBG][ea + e] * (1.0f - LAMBDA_INIT); lg[e] = A[I_LNG][ca + e]; lb[e] = A[I_LNB][ca + e]; muv[e] = A[I_MU][1024 + ca + e]; }
#define UNPK8(w_) {bflo(w_.x), bfhi(w_.x), bflo(w_.y), bfhi(w_.y), bflo(w_.z), bfhi(w_.z), bflo(w_.w), bfhi(w_.w)}
    for (int g = gw; g < M / 4; g += NGW) {
        const int m0 = g * 4;
        v4u o0[4], o1[4], yr[4], gr[4], vr[5]; float bon[4];
        vr[0] = (v4u){0u, 0u, 0u, 0u}; if ((m0 & (SEQ - 1)) != 0) vr[0] = *(const GAS v4u*)(RKV + (size_t)(m0 - 1) * 1536 + 1024 + ca);
#pragma unroll
        for (int j = 0; j < 4; ++j) { const size_t mm = (size_t)(m0 + j);
            o0[j] = *(const GAS v4u*)(O + mm * 1024 + (2 * ha) * 128 + ea); o1[j] = *(const GAS v4u*)(O + mm * 1024 + (2 * ha + 1) * 128 + ea);
            yr[j] = *(const GAS v4u*)(Y + mm * 512 + ca); gr[j] = *(const GAS v4u*)(GG + mm * 512 + ca); vr[j + 1] = *(const GAS v4u*)(RKV + mm * 1536 + 1024 + ca);
            bon[j] = *(const GAS float*)(BON + mm * 8 + hb); }
#pragma unroll
        for (int j = 0; j < 4; ++j) { const size_t mm = (size_t)(m0 + j);
            {
                const float a0[8] = UNPK8(o0[j]), a1[8] = UNPK8(o1[j]); float o[8], ss = 0.f;
#pragma unroll
                for (int e = 0; e < 8; ++e) { o[e] = a0[e] - lam * a1[e]; ss += o[e] * o[e]; }
                const float rstd = __builtin_amdgcn_rsqf(row16_allsum(ss) * (1.0f / 128.0f) + SUBLN_EPS);
                v4u w; w.x = pk2(o[0] * rstd * sg[0], o[1] * rstd * sg[1]); w.y = pk2(o[2] * rstd * sg[2], o[3] * rstd * sg[3]); w.z = pk2(o[4] * rstd * sg[4], o[5] * rstd * sg[5]); w.w = pk2(o[6] * rstd * sg[6], o[7] * rstd * sg[7]);
                *(GAS v4u*)(YA + mm * 1024 + ca) = w;
            }
            {
                const float y[8] = UNPK8(yr[j]), gq[8] = UNPK8(gr[j]), v[8] = UNPK8(vr[j + 1]), p[8] = UNPK8(vr[j]);
                float s = 0.f;
#pragma unroll
                for (int e = 0; e < 8; ++e) s += y[e];
                const float mean = oct_allsum(s) * (1.0f / 64.0f); float q = 0.f;
#pragma unroll
                for (int e = 0; e < 8; ++e) { const float d = y[e] - mean; q += d * d; }
                const float rstd = __builtin_amdgcn_rsqf(oct_allsum(q) * (1.0f / 64.0f) + GN_EPS);
                float r[8];
#pragma unroll
                for (int e = 0; e < 8; ++e) { const float vs = v[e] + (p[e] - v[e]) * muv[e]; r[e] = (((y[e] - mean) * rstd) * lg[e] + lb[e] + bon[j] * vs) * gq[e]; }
                v4u w; w.x = pk2(r[0], r[1]); w.y = pk2(r[2], r[3]); w.z = pk2(r[4], r[5]); w.w = pk2(r[6], r[7]);
                *(GAS v4u*)(YA + mm * 1024 + 512 + ca) = w;
            }
        }
    }
#undef UNPK8
}

typedef short rk_bf16x8 __attribute__((ext_vector_type(8)));
typedef float rk_f32x16 __attribute__((ext_vector_type(16)));
constexpr int RKA_RS_K = 144, RKA_RS_J = 80;
constexpr int RKA_A = 0, RKA_B = 5120, RKA_K = 10240, RKA_R = 15360, RKA_AT = 19968, RKA_BH = 25088, RKA_KH = 30208, RKA_VT = 35328, RKA_GC = 40448, RKA_BYTES = 40704;
constexpr int RKA_N = 0, RKA_X = 0, RKA_T = 5120, RKA_MAK = 7680, RKA_MRB = 10240, RKA_MRK = 12800;
constexpr int RKA_WAVES = 4;
static_assert(RKA_WAVES * RKA_BYTES <= 162816, "phase A LDS");
constexpr size_t WS_PQ = 66 * MiB;
constexpr size_t WS_RY = 98 * MiB;
constexpr size_t WS_GC = 242 * MiB;
constexpr size_t WS_SST = 243 * MiB;

__device__ __forceinline__ rk_bf16x8 rk_frag(const LAS unsigned char* base, int rs, int row, int s, int h) { return *(const LAS rk_bf16x8*)(base + row * rs + (16 * s + 8 * h) * 2); }
__device__ __forceinline__ rk_f32x16 rk_mfma(rk_bf16x8 a, rk_bf16x8 b, rk_f32x16 c) { return __builtin_amdgcn_mfma_f32_32x32x16_bf16(a, b, c, 0, 0, 0); }
__device__ __forceinline__ unsigned rk_pk(float lo, float hi) { typedef float f2_ __attribute__((ext_vector_type(2))); typedef __bf16 b2_ __attribute__((ext_vector_type(2))); f2_ v = {lo, hi}; b2_ b = __builtin_convertvector(v, b2_); return __builtin_bit_cast(unsigned, b); }
__device__ __forceinline__ void rk_store_tile_lds(LAS unsigned char* base, int rs, int nrow, int mbase, int h, const rk_f32x16& acc) {
#pragma unroll
    for (int g = 0; g < 4; ++g) { v2u w; w.x = rk_pk(acc[4 * g], acc[4 * g + 1]); w.y = rk_pk(acc[4 * g + 2], acc[4 * g + 3]); *(LAS v2u*)(base + nrow * rs + (mbase + 8 * g + 4 * h) * 2) = w; }
}
__device__ __forceinline__ void rk_store_tile_glb(bf16* base, int pitch, int nrow, int mbase, int h, const rk_f32x16& acc) {
#pragma unroll
    for (int g = 0; g < 4; ++g) { v2u w; w.x = rk_pk(acc[4 * g], acc[4 * g + 1]); w.y = rk_pk(acc[4 * g + 2], acc[4 * g + 3]); *(GAS v2u*)(base + (size_t)nrow * pitch + mbase + 8 * g + 4 * h) = w; }
}
__device__ __forceinline__ void rk_store_tile_frag(unsigned char* base, int nt, int r32, int mt, int h, const rk_f32x16& acc) {
#pragma unroll
    for (int g = 0; g < 4; ++g) { v2u w; w.x = rk_pk(acc[4 * g], acc[4 * g + 1]); w.y = rk_pk(acc[4 * g + 2], acc[4 * g + 3]);
        *(GAS v2u*)(base + ((size_t)((nt * 4 + 2 * mt + (g >> 1)) * 64 + r32 + 32 * (g & 1))) * 16 + 8 * h) = w; }
}
__device__ __forceinline__ void rk_store_blob(unsigned* blob, int lane, const rk_f32x16& acc) {
    v4u w0, w1; w0.x = rk_pk(acc[0], acc[1]); w0.y = rk_pk(acc[2], acc[3]); w0.z = rk_pk(acc[4], acc[5]); w0.w = rk_pk(acc[6], acc[7]);
    w1.x = rk_pk(acc[8], acc[9]); w1.y = rk_pk(acc[10], acc[11]); w1.z = rk_pk(acc[12], acc[13]); w1.w = rk_pk(acc[14], acc[15]);
    *(GAS v4u*)(blob + lane * 8) = w0; *(GAS v4u*)(blob + lane * 8 + 4) = w1;
}
struct RkBlob { v4u w0, w1; };
__device__ __forceinline__ RkBlob rk_load_blob(const unsigned* blob, int lane) { RkBlob b; b.w0 = *(const GAS v4u*)(blob + lane * 8); b.w1 = *(const GAS v4u*)(blob + lane * 8 + 4); return b; }
__device__ __forceinline__ rk_f32x16 rk_blob_f32(const RkBlob& b) {
    rk_f32x16 a; const unsigned w[8] = {b.w0.x, b.w0.y, b.w0.z, b.w0.w, b.w1.x, b.w1.y, b.w1.z, b.w1.w};
#pragma unroll
    for (int i = 0; i < 8; ++i) { a[2 * i] = bflo(w[i]); a[2 * i + 1] = bfhi(w[i]); }
    return a;
}

struct RkRaw { unsigned short r[8], k[8], v[8], a[8]; float d[8]; };
__device__ __forceinline__ void rk_load8(RkRaw& R, const bf16* prkv, const float* pdec, const bf16* paa) {
#pragma unroll
    for (int j = 0; j < 8; ++j) { R.r[j] = *(const GAS bf16*)(prkv + j * 1536); R.k[j] = *(const GAS bf16*)(prkv + j * 1536 + 512); R.v[j] = *(const GAS bf16*)(prkv + j * 1536 + 1024);
        R.d[j] = *(const GAS float*)(pdec + j * 512); R.a[j] = *(const GAS bf16*)(paa + j * 512); }
}
__device__ __forceinline__ void rwkvA_unit(LAS unsigned char* L, const InTab& A, unsigned char* ws, int bh, int chunk, int lane_in) {
    int lane = lane_in; asm volatile("" : "+v"(lane));
    const int b = bh >> 3, hd = bh & 7, cg = hd * 64 + lane, r32 = lane & 31, h = lane >> 5;
    const size_t row0 = (size_t)b * SEQ + (size_t)chunk * 32;
    const int uh = bh * 32 + (chunk & 31);
    const bf16* prkv = (const bf16*)(ws + WS_RKV) + row0 * 1536 + cg; const float* pdec = (const float*)(ws + WS_DEC) + row0 * 512 + cg; const bf16* paa = (const bf16*)(ws + WS_AA) + row0 * 512 + cg;
    float* pbon = (float*)(ws + WS_BON) + row0 * 8 + hd;
    const float mu_r = A[I_MU][cg], mu_k = A[I_MU][512 + cg], mu_v = A[I_MU][1024 + cg], kkc = A[I_KK][cg], kac = A[I_KA][cg], rkc = A[I_RK][cg];
    const int myv = (int)(red4(0.f, 1.f, 2.f, 3.f) * (1.0f / 64.0f) + 0.5f);
    const int L0 = __builtin_ctzll(__ballot(myv == 0)), L1 = __builtin_ctzll(__ballot(myv == 1)), L2 = __builtin_ctzll(__ballot(myv == 2)), L3 = __builtin_ctzll(__ballot(myv == 3));
    float rp = 0.f, kp = 0.f, vp = 0.f;
    if (chunk != 0) { rp = bf1(*(const GAS bf16*)(prkv - 1536)); kp = bf1(*(const GAS bf16*)(prkv - 1536 + 512)); vp = bf1(*(const GAS bf16*)(prkv - 1536 + 1024)); }
    float G = 1.0f;
    RkRaw Rc, Rn; rk_load8(Rc, prkv, pdec, paa);
#pragma unroll 1
    for (int q = 0; q < 4; ++q) {
        prkv += 8 * 1536; pdec += 8 * 512; paa += 8 * 512;
        if (q < 3) rk_load8(Rn, prkv, pdec, paa);
        LAS unsigned char* Lr = L + (8 * q) * RKA_RS_K + lane * 2;
        LAS unsigned char* Lt = L + lane * RKA_RS_J + (8 * q) * 2;
        unsigned tA[4], tB[4], tK[4], tV[4], pA = 0, pB = 0, pK = 0, pV = 0;
        float rs_[8], kx_[8], kkr_[8], a8_[8], w8_[8], vs_[8];
#pragma unroll
        for (int j = 0; j < 8; ++j) {
            const float rc = bf1(Rc.r[j]), kc = bf1(Rc.k[j]), vc = bf1(Rc.v[j]);
            const float ks = kc + (kp - kc) * mu_k; rs_[j] = rc + (rp - rc) * mu_r; vs_[j] = vc + (vp - vc) * mu_v; rp = rc; kp = kc; vp = vc;
            kkr_[j] = ks * kkc; a8_[j] = __builtin_amdgcn_rcpf(1.0f + __expf(-bf1(Rc.a[j]))); kx_[j] = ks * (1.0f + (a8_[j] - 1.0f) * kac);
            w8_[j] = __expf(-0.6065306597f * __builtin_amdgcn_rcpf(1.0f + __expf(-Rc.d[j])));
        }
        float n2_[8], bon_[8];
#pragma unroll
        for (int j = 0; j < 8; j += 2) {
            const float t = red4(kkr_[j] * kkr_[j], kkr_[j + 1] * kkr_[j + 1], rs_[j] * kx_[j] * rkc, rs_[j + 1] * kx_[j + 1] * rkc);
            n2_[j] = __builtin_bit_cast(float, __builtin_amdgcn_readlane(__builtin_bit_cast(int, t), L0)); n2_[j + 1] = __builtin_bit_cast(float, __builtin_amdgcn_readlane(__builtin_bit_cast(int, t), L1));
            bon_[j] = __builtin_bit_cast(float, __builtin_amdgcn_readlane(__builtin_bit_cast(int, t), L2)); bon_[j + 1] = __builtin_bit_cast(float, __builtin_amdgcn_readlane(__builtin_bit_cast(int, t), L3));
        }
        if (lane < 8) { float bv = bon_[0];
#pragma unroll
            for (int j = 1; j < 8; ++j) bv = (lane == j) ? bon_[j] : bv;
            *(GAS float*)(pbon + (8 * q + lane) * 8) = bv; }
#pragma unroll
        for (int j = 0; j < 8; ++j) {
            const float kk = kkr_[j] * __builtin_amdgcn_rsqf(__builtin_fmaxf(n2_[j], 1e-24f));
            const float Gprev = G; G *= w8_[j]; const float iG = __builtin_amdgcn_rcpf(G);
            const bf16 at = (bf16)f2bf(-kk * Gprev), rt = (bf16)f2bf(rs_[j] * G), bt = (bf16)f2bf(kk * a8_[j] * iG), kt = (bf16)f2bf(kx_[j] * iG), vb = (bf16)f2bf(vs_[j]);
            *(LAS bf16*)(Lr + RKA_A + j * RKA_RS_K) = at; *(LAS bf16*)(Lr + RKA_R + j * RKA_RS_K) = rt; *(LAS bf16*)(Lr + RKA_B + j * RKA_RS_K) = bt; *(LAS bf16*)(Lr + RKA_K + j * RKA_RS_K) = kt;
            if (j & 1) { tA[j >> 1] = pA | ((unsigned)at << 16); tB[j >> 1] = pB | ((unsigned)bt << 16); tK[j >> 1] = pK | ((unsigned)kt << 16); tV[j >> 1] = pV | ((unsigned)vb << 16); } else { pA = at; pB = bt; pK = kt; pV = vb; }
        }
        *(LAS v4u*)(Lt + RKA_AT) = (v4u){tA[0], tA[1], tA[2], tA[3]}; *(LAS v4u*)(Lt + RKA_BH) = (v4u){tB[0], tB[1], tB[2], tB[3]}; *(LAS v4u*)(Lt + RKA_KH) = (v4u){tK[0], tK[1], tK[2], tK[3]}; *(LAS v4u*)(Lt + RKA_VT) = (v4u){tV[0], tV[1], tV[2], tV[3]};
        Rc = Rn;
    }
    const float GC = G;
    *(GAS float*)((float*)(ws + WS_GC) + (size_t)uh * 64 + lane) = GC;
    *(LAS float*)(L + RKA_GC + lane * 4) = GC;
    LDS_WAIT(); asm volatile("" ::: "memory");
    {
        rk_f32x16 aN = {}, aAK = {}, aRB = {}, aRK = {};
#pragma unroll
        for (int s = 0; s < 4; ++s) {
            const rk_bf16x8 fA = rk_frag(L + RKA_A, RKA_RS_K, r32, s, h), fR = rk_frag(L + RKA_R, RKA_RS_K, r32, s, h), fB = rk_frag(L + RKA_B, RKA_RS_K, r32, s, h), fK = rk_frag(L + RKA_K, RKA_RS_K, r32, s, h);
            aN = rk_mfma(fB, fA, aN); aAK = rk_mfma(fK, fA, aAK); aRB = rk_mfma(fB, fR, aRB); aRK = rk_mfma(fK, fR, aRK);
        }
        LDS_WAIT(); asm volatile("" ::: "memory");
#pragma unroll
        for (int i = 0; i < 16; ++i) { const int j = (i & 3) + 8 * (i >> 2) + 4 * h;
            if (!(j < r32)) { aN[i] = 0.f; aAK[i] = 0.f; }
            if (!(j <= r32)) { aRB[i] = 0.f; aRK[i] = 0.f; } }
#pragma unroll
        for (int g = 0; g < 4; ++g) *(LAS f32x4*)(L + RKA_N + r32 * 144 + (8 * g + 4 * h) * 4) = (f32x4){aN[4 * g], aN[4 * g + 1], aN[4 * g + 2], aN[4 * g + 3]};
        rk_store_tile_lds(L + RKA_MAK, RKA_RS_J, r32, 0, h, aAK); rk_store_tile_lds(L + RKA_MRB, RKA_RS_J, r32, 0, h, aRB); rk_store_tile_lds(L + RKA_MRK, RKA_RS_J, r32, 0, h, aRK);
        rk_store_tile_lds(L + RKA_T, RKA_RS_J, r32, 0, h, aN);
    }
    LDS_WAIT(); asm volatile("" ::: "memory");
    {
        const int blk = (r32 >> 4) & 1, cc = r32 & 15;
        const LAS unsigned char* Nb = L + RKA_N + (16 * blk) * 144 + (16 * blk) * 4;
        float T[16];
#pragma unroll
        for (int t = 0; t < 16; ++t) { float ac[4] = {(cc == t) ? 1.0f : 0.0f, 0.f, 0.f, 0.f};
#pragma unroll
            for (int j4 = 0; j4 < (t + 3) / 4; ++j4) { const f32x4 n4 = *(const LAS f32x4*)(Nb + t * 144 + j4 * 16);
#pragma unroll
                for (int e = 0; e < 4; ++e) if (4 * j4 + e < t) ac[e] += n4[e] * T[4 * j4 + e]; }
            T[t] = (ac[0] + ac[1]) + (ac[2] + ac[3]); }
        LDS_WAIT(); asm volatile("" ::: "memory");
#pragma unroll
        for (int t = 0; t < 16; ++t) *(LAS bf16*)(L + RKA_T + (16 * blk + t) * RKA_RS_J + r32 * 2) = (bf16)f2bf(T[t]);
        if (blk == 0) { LAS v4u* p = (LAS v4u*)(L + RKA_N + cc * RKA_RS_J);
            p[0] = (v4u){pk2(T[0], T[1]), pk2(T[2], T[3]), pk2(T[4], T[5]), pk2(T[6], T[7])}; p[1] = (v4u){pk2(T[8], T[9]), pk2(T[10], T[11]), pk2(T[12], T[13]), pk2(T[14], T[15])}; }
        LDS_WAIT(); asm volatile("" ::: "memory");
        rk_f32x16 xa = {};
        xa = rk_mfma(*(const LAS rk_bf16x8*)(L + RKA_T + (16 + r32) * RKA_RS_J + 16 * h), *(const LAS rk_bf16x8*)(L + RKA_N + r32 * RKA_RS_J + 16 * h), xa);
        if (r32 < 16) {
#pragma unroll
            for (int g = 0; g < 2; ++g) { v2u w; w.x = rk_pk(xa[4 * g], xa[4 * g + 1]); w.y = rk_pk(xa[4 * g + 2], xa[4 * g + 3]); *(LAS v2u*)(L + RKA_N + 1280 + r32 * RKA_RS_J + (8 * g + 4 * h) * 2) = w; } }
        LDS_WAIT(); asm volatile("" ::: "memory");
        rk_f32x16 ta = {};
        ta = rk_mfma(*(const LAS rk_bf16x8*)(L + RKA_N + 1280 + r32 * RKA_RS_J + 16 * h), *(const LAS rk_bf16x8*)(L + RKA_T + (16 + r32) * RKA_RS_J + (16 + 8 * h) * 2), ta);
        LDS_WAIT(); asm volatile("" ::: "memory");
        if (r32 < 16) {
#pragma unroll
            for (int g = 0; g < 2; ++g) { v2u w; w.x = rk_pk(ta[4 * g], ta[4 * g + 1]); w.y = rk_pk(ta[4 * g + 2], ta[4 * g + 3]); *(LAS v2u*)(L + RKA_T + (16 + r32) * RKA_RS_J + (8 * g + 4 * h) * 2) = w; } }
    }
    LDS_WAIT(); asm volatile("" ::: "memory");
    rk_bf16x8 fT[2];
#pragma unroll
    for (int s = 0; s < 2; ++s) fT[s] = rk_frag(L + RKA_T, RKA_RS_J, r32, s, h);
    {
        rk_f32x16 x0[2] = {{}, {}}, ap[2] = {{}, {}};
#pragma unroll
        for (int s = 0; s < 2; ++s) { const rk_bf16x8 fM = rk_frag(L + RKA_MAK, RKA_RS_J, r32, s, h);
#pragma unroll
            for (int nt = 0; nt < 2; ++nt) { x0[nt] = rk_mfma(fM, rk_frag(L + RKA_VT, RKA_RS_J, nt * 32 + r32, s, h), x0[nt]); ap[nt] = rk_mfma(fT[s], rk_frag(L + RKA_AT, RKA_RS_J, nt * 32 + r32, s, h), ap[nt]); } }
        LDS_WAIT(); asm volatile("" ::: "memory");
#pragma unroll
        for (int nt = 0; nt < 2; ++nt) { rk_store_tile_lds(L + RKA_X, RKA_RS_J, nt * 32 + r32, 0, h, x0[nt]); rk_store_tile_lds(L + RKA_AT, RKA_RS_J, nt * 32 + r32, 0, h, ap[nt]); }
    }
    LDS_WAIT(); asm volatile("" ::: "memory");
    {
        rk_f32x16 u0[2] = {{}, {}};
#pragma unroll
        for (int s = 0; s < 2; ++s)
#pragma unroll
            for (int nt = 0; nt < 2; ++nt) u0[nt] = rk_mfma(fT[s], rk_frag(L + RKA_X, RKA_RS_J, nt * 32 + r32, s, h), u0[nt]);
        LDS_WAIT(); asm volatile("" ::: "memory");
#pragma unroll
        for (int nt = 0; nt < 2; ++nt) rk_store_tile_lds(L + RKA_X, RKA_RS_J, nt * 32 + r32, 0, h, u0[nt]);
    }
    LDS_WAIT(); asm volatile("" ::: "memory");
    unsigned char* pq = ws + WS_PQ + (size_t)uh * 16384; unsigned char* ry = ws + WS_RY + (size_t)uh * 8192;
    rk_bf16x8 fRB[2], fRK[2], fAp[2][2], fBh[2][2], fKh[2][2], fU[2][2], fV[2][2];
#pragma unroll
    for (int s = 0; s < 2; ++s) { fRB[s] = rk_frag(L + RKA_MRB, RKA_RS_J, r32, s, h); fRK[s] = rk_frag(L + RKA_MRK, RKA_RS_J, r32, s, h);
#pragma unroll
        for (int nt = 0; nt < 2; ++nt) { fAp[nt][s] = rk_frag(L + RKA_AT, RKA_RS_J, nt * 32 + r32, s, h); fBh[nt][s] = rk_frag(L + RKA_BH, RKA_RS_J, nt * 32 + r32, s, h);
            fKh[nt][s] = rk_frag(L + RKA_KH, RKA_RS_J, nt * 32 + r32, s, h); fU[nt][s] = rk_frag(L + RKA_X, RKA_RS_J, nt * 32 + r32, s, h); fV[nt][s] = rk_frag(L + RKA_VT, RKA_RS_J, nt * 32 + r32, s, h); } }
#pragma unroll
    for (int kt = 0; kt < 2; ++kt) {
        rk_f32x16 acc;
#pragma unroll
        for (int g = 0; g < 4; ++g) { const v2u w = *(const LAS v2u*)(L + RKA_R + r32 * RKA_RS_K + (kt * 32 + 8 * g + 4 * h) * 2); acc[4 * g] = bflo(w.x); acc[4 * g + 1] = bfhi(w.x); acc[4 * g + 2] = bflo(w.y); acc[4 * g + 3] = bfhi(w.y); }
#pragma unroll
        for (int s = 0; s < 2; ++s) acc = rk_mfma(fAp[kt][s], fRB[s], acc);
        rk_store_tile_frag(ry, 0, r32, kt, h, acc);
    }
#pragma unroll
    for (int kt = 0; kt < 2; ++kt)
#pragma unroll
        for (int kq = 0; kq < 2; ++kq) { rk_f32x16 acc = {};
#pragma unroll
            for (int s = 0; s < 2; ++s) acc = rk_mfma(fAp[kq][s], fBh[kt][s], acc);
            acc = acc * *(const LAS float*)(L + RKA_GC + (kt * 32 + r32) * 4);
            rk_store_tile_frag(pq, kt, r32, kq, h, acc); }
#pragma unroll
    for (int vt = 0; vt < 2; ++vt) {
        rk_f32x16 acc = {};
#pragma unroll
        for (int s = 0; s < 2; ++s) { acc = rk_mfma(fU[vt][s], fRB[s], acc); acc = rk_mfma(fV[vt][s], fRK[s], acc); }
        rk_store_blob((unsigned*)(ry + 4096) + vt * 512, lane, acc);
    }
#pragma unroll
    for (int kt = 0; kt < 2; ++kt)
#pragma unroll
        for (int vt = 0; vt < 2; ++vt) { rk_f32x16 acc = {};
#pragma unroll
            for (int s = 0; s < 2; ++s) { acc = rk_mfma(fBh[kt][s], fU[vt][s], acc); acc = rk_mfma(fKh[kt][s], fV[vt][s], acc); }
#pragma unroll
            for (int g = 0; g < 4; ++g) { const f32x4 gq = *(const LAS f32x4*)(L + RKA_GC + (kt * 32 + 8 * g + 4 * h) * 4); acc[4 * g] *= gq[0]; acc[4 * g + 1] *= gq[1]; acc[4 * g + 2] *= gq[2]; acc[4 * g + 3] *= gq[3]; }
            rk_store_blob((unsigned*)(pq + 8192) + (kt * 2 + vt) * 512, lane, acc); }
    LDS_WAIT(); asm volatile("" ::: "memory");
}
__device__ __forceinline__ void rwkvA_phase(Frame& F, const InTab& A, int half) {
    if (F.wave >= RKA_WAVES) return;
    LAS unsigned char* L = F.lds + RING_OFF + F.wave * RKA_BYTES;
    const int gw = F.bx * RKA_WAVES + F.wave, NGW = F.G * RKA_WAVES;
    for (int u = gw; u < 64 * 32; u += NGW) rwkvA_unit(L, A, F.ws, u >> 5, half * 32 + (u & 31), F.lane);
}
constexpr int RKB_RS = 144, RKB_SBUF = 64 * RKB_RS;
__device__ __forceinline__ void rwkvB_phase(Frame& F, int bh, int half) {
    int lane = F.lane; asm volatile("" : "+v"(lane));
    const int wave = F.wave, r32 = lane & 31, h = lane >> 5;
    LAS unsigned char* SB = F.lds + RING_OFF;
    unsigned char* ws = F.ws;
    const int b = bh >> 3, hd = bh & 7;
    bf16* Y = (bf16*)(ws + WS_Y);
    const int kt = (wave >> 1) & 1, vt = wave & 1;
    float* sst = (float*)(ws + WS_SST) + (size_t)bh * 4096 + (size_t)(wave & 3) * 1024;
    rk_f32x16 st = {};
    if (wave < 4) {
        if (half != 0) {
#pragma unroll
            for (int i = 0; i < 16; ++i) st[i] = *(const GAS float*)(sst + i * 64 + lane);
        }
        rk_store_tile_lds(SB, RKB_RS, vt * 32 + r32, kt * 32, h, st);
    }
    const int uh0 = bh * 32; const bool isS = wave < 4, isY = !isS && wave < 6;
    const unsigned char* fptr = isS ? ws + WS_PQ + (size_t)uh0 * 16384 + (kt * 256 + lane) * 16 : ws + WS_RY + (size_t)uh0 * 8192 + lane * 16;
    const unsigned char* bptr = isS ? ws + WS_PQ + (size_t)uh0 * 16384 + 8192 + (kt * 2 + vt) * 2048 + lane * 32 : ws + WS_RY + (size_t)uh0 * 8192 + 4096 + vt * 2048 + lane * 32;
    const LAS unsigned char* gl = SB + 2 * RKB_SBUF + (kt * 32 + 4 * h) * 4;
    const int fstride = isS ? 16384 : 8192;
    struct Op { v4u f[4]; v4u b0, b1; };
    { const int tid_ = wave * 64 + lane; *(LAS f32x4*)(SB + 2 * RKB_SBUF + tid_ * 16) = *(const GAS f32x4*)(ws + WS_GC + (size_t)uh0 * 256 + tid_ * 16); }
    Op o0, o1, o2;
#define RKB_LOAD(O_, c) do { const unsigned char* fp_ = fptr + (size_t)(c) * fstride; const unsigned char* bp_ = bptr + (size_t)(c) * fstride; \
        _Pragma("unroll") for (int s = 0; s < 4; ++s) O_.f[s] = *(const GAS v4u*)(fp_ + 1024 * s); \
        O_.b0 = *(const GAS v4u*)bp_; O_.b1 = *(const GAS v4u*)(bp_ + 16); } while (0)
#define RKB_BAR() do { asm volatile("s_waitcnt lgkmcnt(0)" ::: "memory"); __builtin_amdgcn_s_barrier(); asm volatile("" ::: "memory"); } while (0)
#define RKB_NEXT(O_, c, AH_) RKB_LOAD(O_, ((c) + (AH_) < 32 ? (c) + (AH_) : 31))
#define RKB_STEP_S(O_, c) do { \
        const LAS unsigned char* cur = SB + ((c) & 1) * RKB_SBUF; LAS unsigned char* nxt = SB + (((c) & 1) ^ 1) * RKB_SBUF; \
        rk_bf16x8 fS[4]; _Pragma("unroll") for (int s = 0; s < 4; ++s) fS[s] = rk_frag(cur, RKB_RS, vt * 32 + r32, s, h); \
        RkBlob bb_; bb_.w0 = O_.b0; bb_.w1 = O_.b1; const rk_f32x16 q = rk_blob_f32(bb_); \
        _Pragma("unroll") for (int g = 0; g < 4; ++g) { const f32x4 gq = *(const LAS f32x4*)(gl + (c) * 256 + 32 * g); \
            st[4 * g] = st[4 * g] * gq[0] + q[4 * g]; st[4 * g + 1] = st[4 * g + 1] * gq[1] + q[4 * g + 1]; st[4 * g + 2] = st[4 * g + 2] * gq[2] + q[4 * g + 2]; st[4 * g + 3] = st[4 * g + 3] * gq[3] + q[4 * g + 3]; } \
        _Pragma("unroll") for (int s = 0; s < 4; ++s) st = rk_mfma(__builtin_bit_cast(rk_bf16x8, O_.f[s]), fS[s], st); \
        RKB_NEXT(O_, c, 5); \
        rk_store_tile_lds(nxt, RKB_RS, vt * 32 + r32, kt * 32, h, st); \
        RKB_BAR(); } while (0)
#define RKB_STEP_Y(O_, c) do { \
        const LAS unsigned char* cur = SB + ((c) & 1) * RKB_SBUF; \
        rk_bf16x8 fS[4]; _Pragma("unroll") for (int s = 0; s < 4; ++s) fS[s] = rk_frag(cur, RKB_RS, vt * 32 + r32, s, h); \
        RkBlob bb_; bb_.w0 = O_.b0; bb_.w1 = O_.b1; rk_f32x16 acc = rk_blob_f32(bb_); \
        _Pragma("unroll") for (int s = 0; s < 4; ++s) acc = rk_mfma(fS[s], __builtin_bit_cast(rk_bf16x8, O_.f[s]), acc);       \
        RKB_NEXT(O_, c, 3); \
        rk_store_tile_glb(Y + ((size_t)b * SEQ + (size_t)(half * 32 + (c)) * 32) * 512 + hd * 64, 512, r32, vt * 32, h, acc); \
        RKB_BAR(); } while (0)
    if (isY) { RKB_LOAD(o0, 0); RKB_LOAD(o1, 1); RKB_LOAD(o2, 2); }
    __syncthreads();
    if (isS) {
        Op o3, o4; RKB_LOAD(o0, 0); RKB_LOAD(o1, 1); RKB_LOAD(o2, 2); RKB_LOAD(o3, 3); RKB_LOAD(o4, 4);
#define R5S(c) RKB_STEP_S(o0, c); RKB_STEP_S(o1, (c) + 1); RKB_STEP_S(o2, (c) + 2); RKB_STEP_S(o3, (c) + 3); RKB_STEP_S(o4, (c) + 4);
        R5S(0) R5S(5) R5S(10) R5S(15) R5S(20) R5S(25)
        RKB_STEP_S(o0, 30); RKB_STEP_S(o1, 31);
#undef R5S
    } else if (isY) {
#define R3Y(c) RKB_STEP_Y(o0, c); RKB_STEP_Y(o1, (c) + 1); RKB_STEP_Y(o2, (c) + 2);
        R3Y(0) R3Y(3) R3Y(6) R3Y(9) R3Y(12) R3Y(15) R3Y(18) R3Y(21) R3Y(24) R3Y(27)
        RKB_STEP_Y(o0, 30); RKB_STEP_Y(o1, 31);
#undef R3Y
    } else {
#pragma unroll 1
        for (int c = 0; c < 32; ++c) RKB_BAR();
    }
#undef RKB_STEP_S
#undef RKB_STEP_Y
#undef RKB_NEXT
#undef RKB_BAR
#undef RKB_LOAD
    if (wave < 4 && half == 0) {
#pragma unroll
        for (int i = 0; i < 16; ++i) *(GAS float*)(sst + i * 64 + lane) = st[i];
    }
}

constexpr int NPHASE = 11;
template <int PHM> __global__ void __launch_bounds__(NWAVES * 64, 2) fwd_kernel(Args args) {
    extern __shared__ __attribute__((aligned(16))) unsigned char lds[];
    namespace cg = cooperative_groups;
    Frame F;
    F.lds = (LAS unsigned char*)lds;
    F.tid = threadIdx.x; F.lane = F.tid & 63; F.wave = __builtin_amdgcn_readfirstlane(F.tid >> 6);
    F.G = gridDim.x; F.bx = blockIdx.x;
    F.out = args.out; F.ws = args.ws;
#define PH_BEGIN InTab TAB; { ktab_t kp_ = (ktab_t)__builtin_amdgcn_kernarg_segment_ptr(); asm volatile("" : "+s"(kp_)); TAB.p = kp_; } { int t_ = threadIdx.x; asm volatile("" : "+v"(t_)); F.tid = t_; F.lane = t_ & 63; F.wave = __builtin_amdgcn_readfirstlane(t_ >> 6); } GAS unsigned char* wsg_ = (GAS unsigned char*)args.ws; asm volatile("" : "+s"(wsg_)); unsigned char* ws = (unsigned char*)wsg_; F.ws = ws; GAS bf16_t* gtg_ = (GAS bf16_t*)args.out; asm volatile("" : "+s"(gtg_)); bf16_t* GATES = (bf16_t*)gtg_; F.out = (float*)GATES; (void)GATES;
    const int lo = args.ph_lo, hi = args.ph_hi;
    XcdBarrier bar; bar.bar = nullptr; bar.x = 0; bar.st = nullptr;
    if (hi - lo > 1) {
        for (int u = threadIdx.x; u < (LDS_BYTES - 162816) / 4; u += NWAVES * 64) ((LAS unsigned*)(F.lds + 162816))[u] = 0u;
        { GAS v4u* z_ = (GAS v4u*)(args.ws + WS_CTL) + (size_t)blockIdx.x * (CTL_ZERO_BYTES / 16 / 256); for (int u = threadIdx.x; u < (int)(CTL_ZERO_BYTES / 16 / 256); u += NWAVES * 64) z_[u] = (v4u){0u, 0u, 0u, 0u}; }
        asm volatile("s_waitcnt vmcnt(0)" ::: "memory");
        __syncthreads();
        cg::this_grid().sync();
        bar = xcd_barrier_post((unsigned*)(args.ws + WS_CTL) + CW_BAR, (volatile LAS unsigned*)(F.lds + MISC_OFF) + 8);
    }
#define IN(k) (((PHM >> (k)) & 1) && lo <= (k) && (k) < hi)
#ifdef PROBE_DUP
#define REPS(k) (((k) == PROBE_DUP) ? 2 : 1)
#else
#define REPS(k) 1
#endif
#define SEAM(k) do { if (IN(k) && IN((k) + 1)) { xcd_barrier(bar); } } while (0)
    using pg8::Gemm; using pg8::StaticOrder; using pg8::EpiRow8; using pg8::bf16_t;

    if (IN(0)) for (int rep_ = 0; rep_ < REPS(0); ++rep_) { if (rep_) xcd_barrier(bar); PH_BEGIN p0_prologue(F, TAB); } SEAM(0);
    if (IN(1)) for (int rep_ = 0; rep_ < REPS(1); ++rep_) { if (rep_) xcd_barrier(bar); PH_BEGIN
        Gemm g{(const bf16_t*)(ws + WS_XN), (const bf16_t*)(ws + WS_WIN), M, D_IN, D}; StaticOrder S; S.init(M, D_IN, F.G, F.bx);
        EpiRow8<pg8::FProj> E{{ws, GATES}};
        pg8::gemm_phase<EpiRow8<pg8::FProj>, StaticOrder, PG8_ALIGN, PG8_SP2>(F.lds + RING_OFF, g, S, E);
    } SEAM(1);
    if (IN(2)) for (int rep_ = 0; rep_ < REPS(2); ++rep_) { if (rep_) xcd_barrier(bar); PH_BEGIN prep1_phase(F, TAB); } SEAM(2);
    if (IN(3)) for (int rep_ = 0; rep_ < REPS(3); ++rep_) { if (rep_) xcd_barrier(bar); PH_BEGIN
        int klora = KLORA; asm volatile("" : "+s"(klora));
        Gemm g{(const bf16_t*)(ws + WS_LIN), (const bf16_t*)(ws + WS_WL), M, NLORA, klora}; StaticOrder S; S.init(M, NLORA, F.G, F.bx);
        EpiRow8<pg8::FLora> E{{ws, TAB[I_W0], TAB[I_A0]}};
        pg8::gemm_phase<EpiRow8<pg8::FLora>, StaticOrder, PG8_ALIGN, PG8_SP2>(F.lds + RING_OFF, g, S, E);
    } SEAM(3);
    if (IN(4)) for (int rep_ = 0; rep_ < REPS(4); ++rep_) { if (rep_) xcd_barrier(bar); PH_BEGIN
        const attn_body::AttnTensors AT{(const attn_body::bf16*)(ws + WS_Q), (const attn_body::bf16*)(ws + WS_K), (const attn_body::bf16*)(ws + WS_V), (attn_body::bf16*)(ws + WS_O)};
        const attn_body::StaticOrder S(F.bx, F.G);
        attn_body::attn_phase<attn_body::StaticOrder>((char*)lds + RING_OFF, AT, S);
    } SEAM(4);
    if (IN(5)) for (int rep_ = 0; rep_ < REPS(5); ++rep_) { if (rep_) xcd_barrier(bar); PH_BEGIN
#pragma unroll 1
        for (int half = 0; half < 2; ++half) {
            { GAS unsigned char* w_ = (GAS unsigned char*)args.ws; asm volatile("" : "+s"(w_)); F.ws = (unsigned char*)w_; }
            rwkvA_phase(F, TAB, half);
#ifdef PROBE_DUP_RKA
            rwkvA_phase(F, TAB, half);
#endif
            xcd_barrier(bar);
            { GAS unsigned char* w_ = (GAS unsigned char*)args.ws; asm volatile("" : "+s"(w_)); F.ws = (unsigned char*)w_; }
            if (F.bx < 64) rwkvB_phase(F, F.bx, half); else late_weights(F, TAB, half, 2, 64);
#ifdef PROBE_DUP_RKB
            if (F.bx < 64) rwkvB_phase(F, F.bx, half);
#endif
            if (half == 0) xcd_barrier(bar);
        }
    } SEAM(5);
#ifdef PROBE_BARS
    for (int pb_ = 0; pb_ < PROBE_BARS; ++pb_) xcd_barrier(bar);
#endif
    if (IN(6)) for (int rep_ = 0; rep_ < REPS(6); ++rep_) { if (rep_) xcd_barrier(bar); PH_BEGIN post_phase(F, TAB); } SEAM(6);
    if (IN(7)) for (int rep_ = 0; rep_ < REPS(7); ++rep_) { if (rep_) xcd_barrier(bar); PH_BEGIN
        Gemm g{(const bf16_t*)(ws + WS_YA), (const bf16_t*)(ws + WS_WA), M, D, 1024}; StaticOrder S; S.init(M, D, F.G, F.bx);
        pg8::EpiMerge E{GATES, (bf16_t*)(ws + WS_MERGED)};
        pg8::gemm_phase<pg8::EpiMerge, StaticOrder, PG8_ALIGN, PG8_SP2>(F.lds + RING_OFF, g, S, E);
    } SEAM(7);
    if (IN(8)) for (int rep_ = 0; rep_ < REPS(8); ++rep_) { if (rep_) xcd_barrier(bar); PH_BEGIN
        Gemm g{(const bf16_t*)(ws + WS_MERGED), (const bf16_t*)(ws + WS_WO), M, D, D}; StaticOrder S; S.init(M, D, F.G, F.bx);
        pg8::EpiResNorm<0> E{TAB[I_X], F.out, (bf16_t*)(ws + WS_XN), TAB[I_NFG], (float*)(ws + WS_CTL + CTL_SS1), (unsigned*)(ws + WS_CTL + CTL_CNT1), NORM_EPS, (bf16_t*)(ws + WS_X1B)};
        pg8::gemm_phase<pg8::EpiResNorm<0>, StaticOrder, PG8_ALIGN, PG8_SP2>(F.lds + RING_OFF, g, S, E);
    } SEAM(8);
    if (IN(9)) for (int rep_ = 0; rep_ < REPS(9); ++rep_) { if (rep_) xcd_barrier(bar); PH_BEGIN
        Gemm g{(const bf16_t*)(ws + WS_XN), (const bf16_t*)(ws + WS_W1), M, FF, D}; StaticOrder S; S.init(M, FF, F.G, F.bx);
        EpiRow8<pg8::FRelu2> E{{(bf16_t*)(ws + WS_H)}};
        pg8::gemm_phase<EpiRow8<pg8::FRelu2>, StaticOrder, PG8_ALIGN, PG8_SP2>(F.lds + RING_OFF, g, S, E);
    } SEAM(9);
    if (IN(10)) for (int rep_ = 0; rep_ < REPS(10); ++rep_) { if (rep_) xcd_barrier(bar); PH_BEGIN
        Gemm g{(const bf16_t*)(ws + WS_H), (const bf16_t*)(ws + WS_W2), M, D, FF}; StaticOrder S; S.init(M, D, F.G, F.bx);
        pg8::EpiResNorm<1> E{nullptr, F.out, nullptr, TAB[I_NFIN], (float*)(ws + WS_CTL + CTL_SS2), (unsigned*)(ws + WS_CTL + CTL_CNT2), NORM_EPS, (bf16_t*)(ws + WS_X1B)};
        pg8::gemm_phase<pg8::EpiResNorm<1>, StaticOrder, PG8_ALIGN, PG8_SP2>(F.lds + RING_OFF, g, S, E);
    }
#undef IN
#undef SEAM
#undef PH_BEGIN
}


#ifdef DBG_DUMP
__global__ void dbg_dump(float* out, const unsigned char* ws) {
    const size_t i = (size_t)blockIdx.x * blockDim.x + threadIdx.x; if (i >= (size_t)M * 1024) return;
    const size_t m = i >> 10; const int c = (int)(i & 1023); float v = 0.f;
#if DBG_DUMP == 1
    v = bf1(((const bf16*)(ws + WS_O))[m * 1024 + c]);
#elif DBG_DUMP == 2
    v = c < 512 ? bf1(((const bf16*)(ws + WS_Y))[m * 512 + c]) : (c < 520 ? ((const float*)(ws + WS_BON))[m * 8 + (c - 512)] : 0.f);
#elif DBG_DUMP == 3
    v = c < 512 ? bf1(((const bf16*)(ws + WS_Q))[m * 512 + c]) : bf1(((const bf16*)(ws + WS_K))[m * 512 + c - 512]);
#elif DBG_DUMP == 4
    v = c < 512 ? ((const float*)(ws + WS_DEC))[m * 512 + c] : bf1(((const bf16*)(ws + WS_AA))[m * 512 + c - 512]);
#elif DBG_DUMP == 6
    v = c < 256 ? bf1(((const bf16*)(ws + WS_WAG))[m * 256 + c]) : (c < 512 ? bf1(((const bf16*)(ws + WS_LIN))[m * 256 + c - 256]) : 0.f);
#elif DBG_DUMP == 7
    { const bf16* wl = (const bf16*)(ws + WS_WL); const size_t j = (m * 1024 + c); v = j < (size_t)NLORA * KLORA ? bf1(wl[j]) : 0.f; }
#elif DBG_DUMP == 8
    v = c < 512 ? bf1(((const bf16*)(ws + WS_GG))[m * 512 + c]) : 0.f;
#elif DBG_DUMP == 5
    v = bf1(((const bf16*)(ws + WS_RKV))[m * 1536 + c]);
#endif
    out[i] = v;
}
#endif

#ifdef DBG_FIXLORA
__global__ void dbg_fixlora(Args A) {
    const size_t i = (size_t)blockIdx.x * blockDim.x + threadIdx.x; if (i >= (size_t)M * 512) return;
    const size_t m = i >> 9; const int c = (int)(i & 511);
    const bf16* LINr = (const bf16*)(A.ws + WS_LIN) + m * 256;
#if DBG_FIXLORA & 1
    { float g = 0.f; for (int k = 0; k < 128; ++k) g += bf1(LINr[128 + k]) * A[I_G2][(size_t)k * 512 + c]; ((bf16*)(A.ws + WS_GG))[m * 512 + c] = (bf16)f2bf(g); }
#endif
#if DBG_FIXLORA & 2
    { float s = A[I_A0][c]; for (int k = 0; k < 64; ++k) s += bf1(LINr[64 + k]) * A[I_A2][(size_t)k * 512 + c]; ((bf16*)(A.ws + WS_AA))[m * 512 + c] = (bf16)f2bf(1.0f / (1.0f + expf(-s))); }
#endif
#if DBG_FIXLORA & 4
    { float s = A[I_W0][c]; for (int k = 0; k < 64; ++k) s += bf1(LINr[k]) * A[I_W2][(size_t)k * 512 + c]; const float w = -log1pf(expf(-s)) - 0.5f; ((float*)(A.ws + WS_DEC))[m * 512 + c] = expf(-expf(w)); }
#endif
}
#endif
#ifndef MK_ONE_LAUNCH
#define MK_ONE_LAUNCH 0
#endif
#ifndef MK_MASK
#define MK_MASK ((1 << NPHASE) - 1)
#endif
typedef void (*kern_t)(Args);
template <int P> struct KTab { static void fill(kern_t* t) { t[P] = fwd_kernel<(1 << P)>; KTab<P - 1>::fill(t); } };
template <> struct KTab<-1> { static void fill(kern_t*) {} };
extern "C" void kernel_launch(void* const* d_in, const int* in_sizes, int n_in, void* d_out, int out_size, void* d_ws, size_t ws_size, hipStream_t stream) {
    static int grid = 0; static kern_t ktab[NPHASE];
    if (grid == 0) {
        if (n_in != 26 || in_sizes[0] != M * D || out_size != M * D || ws_size < WS_END) { fprintf(stderr, "kernel_launch: unexpected shapes (n_in %d, in0 %d, out %d, ws %zu); nothing launched\n", n_in, n_in > 0 ? in_sizes[0] : -1, out_size, ws_size); grid = -1; return; }
        int dev = 0, cus = 0;
        if (hipGetDevice(&dev) != hipSuccess || hipDeviceGetAttribute(&cus, hipDeviceAttributeMultiprocessorCount, dev) != hipSuccess) { grid = -1; return; }
#if MK_ONE_LAUNCH
        int per_cu = 0;
        if (hipFuncSetAttribute((const void*)fwd_kernel<MK_MASK>, hipFuncAttributeMaxDynamicSharedMemorySize, LDS_BYTES) != hipSuccess) { fprintf(stderr, "kernel_launch: hipFuncSetAttribute failed\n"); grid = -1; return; }
        if (hipOccupancyMaxActiveBlocksPerMultiprocessor(&per_cu, (const void*)fwd_kernel<MK_MASK>, NWAVES * 64, LDS_BYTES) != hipSuccess || per_cu < 1) { fprintf(stderr, "kernel_launch: occupancy query says %d blocks per CU\n", per_cu); (void)hipGetLastError(); grid = -1; return; }
#else
        KTab<NPHASE - 1>::fill(ktab);
        for (int p = 0; p < NPHASE; ++p) if (hipFuncSetAttribute((const void*)ktab[p], hipFuncAttributeMaxDynamicSharedMemorySize, LDS_BYTES) != hipSuccess) { fprintf(stderr, "kernel_launch: hipFuncSetAttribute failed\n"); grid = -1; return; }
#endif
        grid = cus;
        if (grid != 256) fprintf(stderr, "kernel_launch: note: %d CUs (built for 256)\n", grid);
    }
    if (grid < 0) return;
    Args a{};
    for (int i = 0; i < 26; ++i) a.in[i] = (const float*)d_in[i];
    a.out = (float*)d_out; a.ws = (unsigned char*)d_ws;
#if MK_ONE_LAUNCH
    a.ph_lo = 0; a.ph_hi = NPHASE;
    void* kargs[] = {&a};
    hipError_t e = hipLaunchCooperativeKernel((const void*)fwd_kernel<MK_MASK>, dim3(grid), dim3(NWAVES * 64), kargs, LDS_BYTES, stream);
    if (e != hipSuccess) fprintf(stderr, "kernel_launch: cooperative launch failed: %s\n", hipGetErrorString(e));
#else
#ifdef DBG_DUMP
    for (int p = 0; p <= DBG_STOP; ++p) { a.ph_lo = p; a.ph_hi = p + 1; hipLaunchKernelGGL(ktab[p], dim3(grid), dim3(NWAVES * 64), LDS_BYTES, stream, a); }
    hipLaunchKernelGGL(dbg_dump, dim3((M * 1024) / 256), dim3(256), 0, stream, (float*)d_out, (const unsigned char*)d_ws);
#else
    for (int p = 0; p < NPHASE; ++p) { a.ph_lo = p; a.ph_hi = p + 1; hipLaunchKernelGGL(ktab[p], dim3(grid), dim3(NWAVES * 64), LDS_BYTES, stream, a);
#ifdef DBG_FIXLORA
        if (p == 3) hipLaunchKernelGGL(dbg_fixlora, dim3((M * 512) / 256), dim3(256), 0, stream, a);
#endif
    }
#endif
#endif
}
```

```cpp
#define MK_ONE_LAUNCH 1
#include <hip/hip_runtime.h>
#include <cstdio>
#include <cstdint>
constexpr int NWAVES = 8;
constexpr int BATCH = 8, SEQ = 2048, D = 1024, M = BATCH * SEQ;
constexpr int D_IN = 5376, FF = 4096, RWW = 512, NLORA = 1536, KLORA = 256;
constexpr float NORM_EPS = 1e-6f, SUBLN_EPS = 1e-5f, GN_EPS = 64e-5f, LAMBDA_INIT = 0.2f;
constexpr size_t MiB = 1u << 20;
constexpr size_t WS_CTL = 0, CTL_ZERO_BYTES = 256 * 1024;
constexpr size_t CTL_SS1 = 65536, CTL_SS2 = 131072, CTL_CNT1 = 196608, CTL_CNT2 = 212992, CTL_ATTQ = 229376;
constexpr size_t WS_ROPE_C = 512 * 1024, WS_ROPE_S = 768 * 1024;
constexpr size_t WS_BON = 1 * MiB;
constexpr size_t WS_WIN = 2 * MiB;
constexpr size_t WS_WA = WS_WIN + (size_t)D_IN * D * 2;
constexpr size_t WS_WB = WS_WA + 1 * MiB;
constexpr size_t WS_WO = WS_WB + 1 * MiB;
constexpr size_t WS_W1 = WS_WO + 2 * MiB;
constexpr size_t WS_W2 = WS_W1 + 8 * MiB;
constexpr size_t WS_WL = WS_W2 + 8 * MiB;
static_assert(WS_WL + (size_t)NLORA * KLORA * 2 <= 34 * MiB, "weights");
constexpr size_t WS_XN = 34 * MiB;
constexpr size_t WS_DEC = WS_XN;
constexpr size_t WS_Q = 66 * MiB, WS_K = 82 * MiB, WS_V = 98 * MiB;
constexpr size_t WS_RKV = 114 * MiB;
constexpr size_t WS_WAG = 162 * MiB, WS_LIN = 170 * MiB;
constexpr size_t WS_Y = 162 * MiB;
constexpr size_t WS_AA = 178 * MiB, WS_GG = 194 * MiB;
constexpr size_t WS_O = 210 * MiB;
constexpr size_t WS_YA = 66 * MiB, WS_YB = 82 * MiB;
constexpr size_t WS_TMP = 114 * MiB;
constexpr size_t WS_MERGED = 114 * MiB;
constexpr size_t WS_X1B = 194 * MiB;
constexpr size_t WS_H = 66 * MiB;
constexpr size_t WS_END = 244 * MiB;
constexpr int RING_OFF = 0, RING_BYTES = 131072;
constexpr int LDS_BYTES = 163840;

#include <hip/hip_runtime.h>
#include <cstdio>
#include <cstdint>
namespace pg8 {
#define PG8_LAS __attribute__((address_space(3)))
typedef unsigned short bf16_t;
typedef short bf16x8 __attribute__((ext_vector_type(8)));
typedef float f32x4 __attribute__((ext_vector_type(4)));
typedef unsigned u32x4 __attribute__((ext_vector_type(4)));
constexpr int BM = 256, BK = 64, HALF = 128, HTB = HALF * BK * 2  , STAGE_BYTES = 8 * HTB, NXCD = 8, WGM = 8;

__host__ __device__ __forceinline__ int lds_byte(int r, int c) { const int st = (r >> 4) * 2 + (c >> 5), rr = r & 15, cc = c & 31, ob = rr * 64 + cc * 2; return st * 1024 + (ob ^ (((ob >> 9) & 1) << 5)); }
__host__ __device__ __forceinline__ void stage_rc(int b, int& R, int& C) { const int st = b / 1024, sb = b % 1024, swz = sb ^ (((sb >> 9) & 1) << 5); R = (st >> 1) * 16 + swz / 64; C = (st & 1) * 32 + (swz % 64) / 2; }
__host__ __device__ __forceinline__ int perm32(int rho) { const int n = rho >> 4, i = rho & 15; return 8 * (i >> 2) + 4 * n + (i & 3); }

struct Unit { int pm, pn; };
struct Gemm { const bf16_t* A; const bf16_t* Bt; int M, N, K; };

struct StaticOrder {
    int nM, nN, nwg, G, c;
    __host__ __device__ void init(int M, int N, int G_, int c_) { nM = M / BM; nN = N / BM; nwg = nM * nN; G = G_; c = c_; }
    __host__ __device__ bool next(int i, Unit& u) const {
        const long L = (long)i * G + c; if (L >= nwg) return false;
        int wgid = (int)L; { const int q = nwg / NXCD, r = nwg % NXCD, xcd = wgid % NXCD, off = wgid / NXCD; wgid = (xcd < r ? xcd * (q + 1) : r * (q + 1) + (xcd - r) * q) + off; }
        const int nig = WGM * nN, gid = wgid / nig, fm = gid * WGM, gsz = (nM - fm) < WGM ? (nM - fm) : WGM;
        u.pm = fm + ((wgid % nig) % gsz); u.pn = (wgid % nig) / gsz; return true;
    }
    __device__ __forceinline__ void a_ready(const Unit&) const {}
    __device__ __forceinline__ void done(const Unit&) const {}
};

typedef float f32x2c_t __attribute__((ext_vector_type(2))); typedef __bf16 bf16x2c_t __attribute__((ext_vector_type(2)));
__device__ __forceinline__ unsigned cvt_pk_bf16(float lo, float hi) { f32x2c_t v = {lo, hi}; bf16x2c_t b = __builtin_convertvector(v, bf16x2c_t); return __builtin_bit_cast(unsigned, b); }
typedef float f32x2 __attribute__((ext_vector_type(2)));
__device__ __forceinline__ f32x2 gelu_pk(f32x2 v) {
    const f32x2 av = __builtin_elementwise_abs(v), d = av * 0.2316418882f + 1.0f;
    f32x2 t; t.x = __builtin_amdgcn_rcpf(d.x); t.y = __builtin_amdgcn_rcpf(d.y);
    f32x2 q = t * 0.5307027145f + (-0.7265760135f); q = q * t + 0.7107068705f; q = q * t + (-0.142248368f); q = q * t + 0.127414796f; q = q * t;
    const f32x2 s = (v * v) * (-0.72134752044f);
    f32x2 e; e.x = __builtin_amdgcn_exp2f(s.x); e.y = __builtin_amdgcn_exp2f(s.y);
    const f32x2 m = v * (q * e), r = v - m;
    f32x2 o; o.x = v.x < 0.f ? m.x : r.x; o.y = v.y < 0.f ? m.y : r.y; return o;
}

template <int ACT  > struct EpiBf16 {
    static constexpr int MIDK = 0; static constexpr bool PERM = true, AFTER_DRAIN = false; static_assert(ACT == 0 || ACT == 1, "EpiBf16: ACT is 0 (none) or 1 (gelu_pk)");
    bf16_t* O; int ldc; const float* bias; int split_cols; size_t split_stride; float scale0;
    __device__ __forceinline__ void operator()(const f32x4 (&acc)[2][2][4][2], const Unit& u, int wr, int wc, int fr, int fq) const {
        const int row0 = u.pm * BM + wr * 64 + fr; int colt = u.pn * BM; bf16_t* base = O;
        float sc = 1.f; if (split_cols) { const int t = colt / split_cols; base += (size_t)t * split_stride; colt -= t * split_cols; if (t == 0) sc = scale0; }
        const int col0 = colt + wc * 32 + 8 * fq, bcol0 = u.pn * BM + wc * 32 + 8 * fq;
        f32x4 bv[2][2];
#pragma unroll
        for (int bj = 0; bj < 2; ++bj)
#pragma unroll
            for (int n = 0; n < 2; ++n) bv[bj][n] = bias ? *(const f32x4*)(bias + bcol0 + bj * HALF + 4 * n) : (f32x4){0.f, 0.f, 0.f, 0.f};
#pragma unroll
        for (int ai = 0; ai < 2; ++ai)
#pragma unroll
            for (int m = 0; m < 4; ++m) { bf16_t* rowp = base + (size_t)(row0 + ai * HALF + m * 16) * ldc + col0;
#pragma unroll
                for (int bj = 0; bj < 2; ++bj) { f32x4 v0 = acc[ai][bj][m][0] + bv[bj][0], v1 = acc[ai][bj][m][1] + bv[bj][1];
                    if (ACT == 1) { f32x2 a = gelu_pk((f32x2){v0[0], v0[1]}), b = gelu_pk((f32x2){v0[2], v0[3]}), c = gelu_pk((f32x2){v1[0], v1[1]}), d = gelu_pk((f32x2){v1[2], v1[3]});
                        v0 = (f32x4){a.x, a.y, b.x, b.y}; v1 = (f32x4){c.x, c.y, d.x, d.y}; }
                    v0 = v0 * sc; v1 = v1 * sc; u32x4 w; w.x = cvt_pk_bf16(v0[0], v0[1]); w.y = cvt_pk_bf16(v0[2], v0[3]); w.z = cvt_pk_bf16(v1[0], v1[1]); w.w = cvt_pk_bf16(v1[2], v1[3]);
                    *(u32x4*)(rowp + bj * HALF) = w; } }
    }
};
typedef unsigned u32x2 __attribute__((ext_vector_type(2)));
__device__ __forceinline__ float bf_lo(unsigned w) { return __builtin_bit_cast(float, w << 16); }
__device__ __forceinline__ float bf_hi(unsigned w) { return __builtin_bit_cast(float, w & 0xffff0000u); }
__device__ __forceinline__ u32x4 pack8(f32x4 v0, f32x4 v1) { u32x4 w; w.x = cvt_pk_bf16(v0[0], v0[1]); w.y = cvt_pk_bf16(v0[2], v0[3]); w.z = cvt_pk_bf16(v1[0], v1[1]); w.w = cvt_pk_bf16(v1[2], v1[3]); return w; }
__device__ __forceinline__ float sigmoidf_(float x) { return __builtin_amdgcn_rcpf(1.0f + __expf(-x)); }
template <class F> struct EpiRow8 {
    static constexpr int MIDK = 0; static constexpr bool PERM = true, AFTER_DRAIN = false;
    F f;
    __device__ __forceinline__ void operator()(const f32x4 (&acc)[2][2][4][2], const Unit& u, int wr, int wc, int fr, int fq) const {
        const int row0 = u.pm * BM + wr * 64 + fr, c0 = wc * 32 + 8 * fq;
#pragma unroll
        for (int ai = 0; ai < 2; ++ai)
#pragma unroll
            for (int m = 0; m < 4; ++m) { const int row = row0 + ai * HALF + m * 16;
#pragma unroll
                for (int bj = 0; bj < 2; ++bj) { f(u.pn, row, c0 + bj * HALF, acc[ai][bj][m][0], acc[ai][bj][m][1]); if (F::FENCE) asm volatile("" ::: "memory"); } }
    }
};
constexpr float ATT_C2 = 0.125f * 1.4426950408889634f;
struct FProj {
    static constexpr bool FENCE = false;
    unsigned char* ws; bf16_t* GATES;
    __device__ __forceinline__ void operator()(int pn, int row, int cu, f32x4 v0, f32x4 v1) const {
        if (pn < 4) {
            const int sh = cu >> 6, j = (cu & 63) >> 3, pos = row & 2047;
            const f32x4 c = *(const f32x4*)((const float*)(ws + WS_ROPE_C) + pos * 32 + 4 * j), s = *(const f32x4*)((const float*)(ws + WS_ROPE_S) + pos * 32 + 4 * j);
            const float sc = pn < 2 ? ATT_C2 : 1.0f;
            const f32x4 o1 = (v0 * c - v1 * s) * sc, o2 = (v1 * c + v0 * s) * sc;
            bf16_t* dst = (bf16_t*)(ws + (pn < 2 ? WS_Q : WS_K)) + (size_t)row * 512 + (pn & 1) * 256 + sh * 64 + 4 * j;
            u32x2 w1, w2; w1.x = cvt_pk_bf16(o1[0], o1[1]); w1.y = cvt_pk_bf16(o1[2], o1[3]); w2.x = cvt_pk_bf16(o2[0], o2[1]); w2.y = cvt_pk_bf16(o2[2], o2[3]);
            *(u32x2*)dst = w1; *(u32x2*)(dst + 32) = w2;
        } else if (pn < 13) {
            size_t off; int pitch, col;
            if (pn < 6) { off = WS_V; pitch = 512; col = (pn - 4) * 256; }
            else if (pn < 12) { off = WS_RKV; pitch = 1536; col = (pn - 6) * 256; }
            else { off = WS_WAG; pitch = 256; col = 0; }
            *(u32x4*)((bf16_t*)(ws + off) + (size_t)row * pitch + col + cu) = pack8(v0, v1);
        } else *(u32x4*)(GATES + (size_t)row * 2048 + (pn - 13) * 256 + cu) = pack8(v0, v1);
    }
};
struct FLora {
    static constexpr bool FENCE = false;
    unsigned char* ws; const float *w0, *a0;
    __device__ __forceinline__ void operator()(int pn, int row, int cu, f32x4 v0, f32x4 v1) const {
        const int c = (pn & 1) * 256 + cu;
        if (pn < 2) {
            const f32x4 b0 = *(const f32x4*)(w0 + c), b1 = *(const f32x4*)(w0 + c + 4);
            float* dst = (float*)(ws + WS_DEC) + (size_t)row * 512 + c; *(f32x4*)dst = v0 + b0; *(f32x4*)(dst + 4) = v1 + b1;
        } else if (pn < 4) {
            const f32x4 b0 = *(const f32x4*)(a0 + c), b1 = *(const f32x4*)(a0 + c + 4);
            *(u32x4*)((bf16_t*)(ws + WS_AA) + (size_t)row * 512 + c) = pack8(v0 + b0, v1 + b1);
        } else *(u32x4*)((bf16_t*)(ws + WS_GG) + (size_t)row * 512 + c) = pack8(v0, v1);
    }
};
struct EpiMerge {
    static constexpr int MIDK = 8; static constexpr bool PERM = true, AFTER_DRAIN = false;
    const bf16_t* GATES; bf16_t* MERGED;
    static __device__ __forceinline__ float ratio_(float ga, float gb) { return (1.0f + __expf(-gb)) * __builtin_amdgcn_rcpf(1.0f + __expf(-ga)); }
    __device__ __forceinline__ void mid(f32x4 (&acc)[2][2][4][2], const Unit& u, int wr, int wc, int fr, int fq) const {
        int fr_ = fr; asm volatile("" : "+v"(fr_));
        const bf16_t* gp0 = GATES + (size_t)(u.pm * BM + wr * 64 + fr_) * 2048 + u.pn * BM + wc * 32 + 8 * fq;
#pragma unroll
        for (int ai = 0; ai < 2; ++ai)
#pragma unroll
            for (int m = 0; m < 4; ++m)
#pragma unroll
                for (int bj = 0; bj < 2; ++bj) { const bf16_t* gp = gp0 + (size_t)(ai * HALF + m * 16) * 2048 + bj * HALF;
                    const u32x4 ga = *(const u32x4*)gp, gb = *(const u32x4*)(gp + 1024);
                    f32x4& v0 = acc[ai][bj][m][0]; f32x4& v1 = acc[ai][bj][m][1];
                    v0[0] *= ratio_(bf_lo(ga.x), bf_lo(gb.x)); v0[1] *= ratio_(bf_hi(ga.x), bf_hi(gb.x)); v0[2] *= ratio_(bf_lo(ga.y), bf_lo(gb.y)); v0[3] *= ratio_(bf_hi(ga.y), bf_hi(gb.y));
                    v1[0] *= ratio_(bf_lo(ga.z), bf_lo(gb.z)); v1[1] *= ratio_(bf_hi(ga.z), bf_hi(gb.z)); v1[2] *= ratio_(bf_lo(ga.w), bf_lo(gb.w)); v1[3] *= ratio_(bf_hi(ga.w), bf_hi(gb.w));
                    asm volatile("" ::: "memory"); }
    }
    __device__ __forceinline__ void operator()(const f32x4 (&acc)[2][2][4][2], const Unit& u, int wr, int wc, int fr, int fq) const {
        const int row0 = u.pm * BM + wr * 64 + fr, c0 = u.pn * BM + wc * 32 + 8 * fq;
#pragma unroll
        for (int ai = 0; ai < 2; ++ai)
#pragma unroll
            for (int m = 0; m < 4; ++m) { const int row = row0 + ai * HALF + m * 16;
#pragma unroll
                for (int bj = 0; bj < 2; ++bj) { const u32x4 g = *(const u32x4*)(GATES + (size_t)row * 2048 + 1024 + c0 + bj * HALF);
                    f32x4 v0 = acc[ai][bj][m][0], v1 = acc[ai][bj][m][1];
                    v0[0] *= sigmoidf_(bf_lo(g.x)); v0[1] *= sigmoidf_(bf_hi(g.x)); v0[2] *= sigmoidf_(bf_lo(g.y)); v0[3] *= sigmoidf_(bf_hi(g.y));
                    v1[0] *= sigmoidf_(bf_lo(g.z)); v1[1] *= sigmoidf_(bf_hi(g.z)); v1[2] *= sigmoidf_(bf_lo(g.w)); v1[3] *= sigmoidf_(bf_hi(g.w));
                    *(u32x4*)(MERGED + (size_t)row * 1024 + c0 + bj * HALF) = pack8(v0, v1); } }
    }
};
struct FRes {
    static constexpr bool FENCE = false;
    const float* base; float* out;
    __device__ __forceinline__ void operator()(int pn, int row, int cu, f32x4 v0, f32x4 v1) const {
        const size_t off = (size_t)row * 1024 + pn * 256 + cu; const f32x4 b0 = *(const f32x4*)(base + off), b1 = *(const f32x4*)(base + off + 4);
        *(f32x4*)(out + off) = b0 + v0; *(f32x4*)(out + off + 4) = b1 + v1;
    }
};
struct FRelu2 {
    static constexpr bool FENCE = false;
    bf16_t* H;
    __device__ __forceinline__ void operator()(int pn, int row, int cu, f32x4 v0, f32x4 v1) const {
        f32x4 r0, r1;
#pragma unroll
        for (int e = 0; e < 4; ++e) { const float a = __builtin_fmaxf(v0[e], 0.f), b = __builtin_fmaxf(v1[e], 0.f); r0[e] = a * a; r1[e] = b * b; }
        *(u32x4*)(H + (size_t)row * 4096 + pn * 256 + cu) = pack8(r0, r1);
    }
};

__device__ __forceinline__ float xsum_fq(float x) {
    { auto r = __builtin_amdgcn_permlane16_swap(__builtin_bit_cast(unsigned, x), __builtin_bit_cast(unsigned, x), false, false); const unsigned a = r[0], b = r[1]; x = __builtin_bit_cast(float, a) + __builtin_bit_cast(float, b); }
    { auto r = __builtin_amdgcn_permlane32_swap(__builtin_bit_cast(unsigned, x), __builtin_bit_cast(unsigned, x), false, false); const unsigned a = r[0], b = r[1]; x = __builtin_bit_cast(float, a) + __builtin_bit_cast(float, b); }
    return x;
}
template <int MODE> struct EpiResNorm {
    static constexpr int MIDK = 0; static constexpr bool PERM = true, AFTER_DRAIN = false;
    const float* base; float* out; bf16_t* xn; const float* g; float* ss; unsigned* cnt; float eps; bf16_t* x1b;
    __device__ __forceinline__ void operator()(f32x4 (&acc)[2][2][4][2], const Unit& u, int wr, int wc, int fr, int fq) const {
        const int row0 = u.pm * BM + wr * 64 + fr, c0 = u.pn * BM + wc * 32 + 8 * fq;
#pragma unroll
        for (int ai = 0; ai < 2; ++ai)
#pragma unroll
            for (int m = 0; m < 4; ++m) { const int row = row0 + ai * HALF + m * 16; float s = 0.f;
#pragma unroll
                for (int bj = 0; bj < 2; ++bj) { const size_t off = (size_t)row * 1024 + c0 + bj * HALF; f32x4 b0, b1;
                    if (MODE == 0) { b0 = *(const f32x4*)(base + off); b1 = *(const f32x4*)(base + off + 4); }
                    else { const u32x4 w = *(const u32x4*)(x1b + off); b0 = (f32x4){bf_lo(w.x), bf_hi(w.x), bf_lo(w.y), bf_hi(w.y)}; b1 = (f32x4){bf_lo(w.z), bf_hi(w.z), bf_lo(w.w), bf_hi(w.w)}; }
                    f32x4& v0 = acc[ai][bj][m][0]; f32x4& v1 = acc[ai][bj][m][1]; v0 += b0; v1 += b1;
                    if (MODE == 0) *(u32x4*)(x1b + off) = pack8(v0, v1);
                    s += (v0[0] * v0[0] + v0[1] * v0[1]) + (v0[2] * v0[2] + v0[3] * v0[3]) + (v1[0] * v1[0] + v1[1] * v1[1]) + (v1[2] * v1[2] + v1[3] * v1[3]); }
                s = xsum_fq(s);
                if (fq == 0) __hip_atomic_fetch_add(ss + row, s, __ATOMIC_RELAXED, __HIP_MEMORY_SCOPE_AGENT);
                if (m & 1) asm volatile("" ::: "memory"); }
        asm volatile("s_waitcnt vmcnt(0)" ::: "memory");
        unsigned* c_ = cnt + 64 * u.pm;
        if (fr == 0 && fq == 0) __hip_atomic_fetch_add(c_, 1u, __ATOMIC_RELAXED, __HIP_MEMORY_SCOPE_AGENT);
        { unsigned spins = 0; while ((unsigned)__builtin_amdgcn_readfirstlane(__hip_atomic_load(c_, __ATOMIC_RELAXED, __HIP_MEMORY_SCOPE_AGENT)) < 32u && ++spins < (1u << 22)) __builtin_amdgcn_s_sleep(2); }
        asm volatile("" ::: "memory");
#pragma unroll
        for (int ai = 0; ai < 2; ++ai)
#pragma unroll
            for (int m = 0; m < 4; ++m) { const int row = row0 + ai * HALF + m * 16;
                const float rstd = 1.0f / sqrtf(__hip_atomic_load(ss + row, __ATOMIC_RELAXED, __HIP_MEMORY_SCOPE_AGENT) * (1.0f / 1024.0f) + eps);
#pragma unroll
                for (int bj = 0; bj < 2; ++bj) { const size_t off = (size_t)row * 1024 + c0 + bj * HALF; const f32x4 g0 = *(const f32x4*)(g + c0 + bj * HALF), g1 = *(const f32x4*)(g + c0 + bj * HALF + 4);
                    const f32x4 o0 = acc[ai][bj][m][0] * rstd * g0, o1 = acc[ai][bj][m][1] * rstd * g1;
                    if (MODE == 0) *(u32x4*)(xn + off) = pack8(o0, o1); else { *(f32x4*)(out + off) = o0; *(f32x4*)(out + off + 4) = o1; } }
                if (m & 1) asm volatile("" ::: "memory"); }
    }
};

struct PanelOrder {
    int pm, ntiles;
    __device__ __forceinline__ bool next(int i, Unit& u) const { if (i >= ntiles) return false; int p = pm; asm volatile("" : "+s"(p)); u.pm = p; u.pn = i; return true; }
    __device__ __forceinline__ void a_ready(const Unit&) const {}
    __device__ __forceinline__ void done(const Unit&) const {}
};
template <class Epi, class Sched, bool ALIGN_EPI = false, bool SP2 = false>
__device__ __forceinline__ void gemm_phase(PG8_LAS unsigned char* lds, const Gemm g, const Sched& S, const Epi& E) {
    int tid_ = threadIdx.x; asm volatile("" : "+v"(tid_));
    const int tid = tid_, wid = __builtin_amdgcn_readfirstlane(tid >> 6), lane = tid & 63, wr = wid >> 2, wc = wid & 3, fr = lane & 15, fq = lane >> 4;
    const int K = g.K, nt = K / BK;
    unsigned voffA[2], voffB[2];
#pragma unroll
    for (int i = 0; i < 2; ++i) { int R, C; stage_rc(tid * 16 + i * 8192, R, C); const int Rb = Epi::PERM ? ((R & ~31) + perm32(R & 31)) : R;
        voffA[i] = (unsigned)(R * K + C) * 2u; voffB[i] = (unsigned)(Rb * K + C) * 2u; }
    const size_t kstep = (size_t)(BK * 2);
    const size_t hstep = (size_t)HALF * K * 2;
    const size_t tstep = 2 * hstep;
    const unsigned ldsw = (unsigned)wid * 1024u;
    const int aoff = lds_byte(wr * 64 + fr, fq * 8), boff = lds_byte(wc * 32 + fr, fq * 8);
#define PG8_SA(b, h) (((b) * 2 + (h)) * HTB)
#define PG8_SB(b, h) ((4 + (b) * 2 + (h)) * HTB)
#define PG8_STAGE(bufoff, gbase, voff) do { _Pragma("unroll") for (int _i = 0; _i < 2; ++_i) \
        __builtin_amdgcn_global_load_lds((const unsigned*)((const char*)(gbase) + (voff)[_i]), (PG8_LAS unsigned*)(lds + (bufoff) + ldsw + _i * 8192), 16, 0, 0); } while (0)
#define PG8_LDA(dst, b, h) do { _Pragma("unroll") for (int m = 0; m < 4; ++m) _Pragma("unroll") for (int k = 0; k < 2; ++k) dst[m][k] = *(const PG8_LAS bf16x8*)(lds + PG8_SA(b, h) + aoff + m * 2048 + k * 1024); } while (0)
#define PG8_LDB(dst, b, h) do { _Pragma("unroll") for (int n = 0; n < 2; ++n) _Pragma("unroll") for (int k = 0; k < 2; ++k) dst[n][k] = *(const PG8_LAS bf16x8*)(lds + PG8_SB(b, h) + boff + n * 2048 + k * 1024); } while (0)
#define PG8_MMA(ai, bj, At, Bt) do { __builtin_amdgcn_s_setprio(1); _Pragma("unroll") for (int m = 0; m < 4; ++m) _Pragma("unroll") for (int n = 0; n < 2; ++n) _Pragma("unroll") for (int k = 0; k < 2; ++k) \
        acc[ai][bj][m][n] = __builtin_amdgcn_mfma_f32_16x16x32_bf16(Bt[n][k], At[m][k], acc[ai][bj][m][n], 0, 0, 0); __builtin_amdgcn_s_setprio(0); } while (0)
#define PG8_WAIT_V(n) asm volatile("s_waitcnt vmcnt(" #n ")" ::: "memory")
#define PG8_WAIT_L(n) asm volatile("s_waitcnt lgkmcnt(" #n ")" ::: "memory")
#define PG8_BAR __builtin_amdgcn_s_barrier()
#define PG8_SCHED __builtin_amdgcn_sched_barrier(0)
    Unit cur, nxt; int ui = 0;
    if (!S.next(0, cur)) return;
    f32x4 acc[2][2][4][2];
#pragma unroll
    for (int a = 0; a < 2; ++a)
#pragma unroll
        for (int b = 0; b < 2; ++b)
#pragma unroll
            for (int m = 0; m < 4; ++m)
#pragma unroll
                for (int n = 0; n < 2; ++n) acc[a][b][m][n] = (f32x4){0.f, 0.f, 0.f, 0.f};
    bf16x8 At[4][2], B0[2][2], B1[2][2];
    const char* cA = (const char*)g.A + (size_t)cur.pm * tstep; const char* cB = (const char*)g.Bt + (size_t)cur.pn * tstep;
    S.a_ready(cur);
    if constexpr (SP2) {
        PG8_STAGE(PG8_SB(0, 0), cB, voffB); PG8_STAGE(PG8_SB(0, 1), cB + hstep, voffB); PG8_STAGE(PG8_SA(0, 0), cA, voffA); PG8_STAGE(PG8_SA(0, 1), cA + hstep, voffA);
        if (wr == 1) PG8_BAR;
        PG8_WAIT_V(2); PG8_BAR;
        PG8_STAGE(PG8_SB(1, 0), cB + kstep, voffB); PG8_STAGE(PG8_SA(1, 0), cA + kstep, voffA); PG8_STAGE(PG8_SB(1, 1), cB + hstep + kstep, voffB);
        PG8_WAIT_V(6); PG8_BAR;
    } else {
        PG8_STAGE(PG8_SB(0, 0), cB, voffB); PG8_STAGE(PG8_SA(0, 0), cA, voffA); PG8_STAGE(PG8_SB(0, 1), cB + hstep, voffB); PG8_STAGE(PG8_SA(0, 1), cA + hstep, voffA);
        if (wr == 1) PG8_BAR;
        PG8_WAIT_V(4); PG8_BAR;
        PG8_STAGE(PG8_SB(1, 0), cB + kstep, voffB); PG8_STAGE(PG8_SA(1, 0), cA + kstep, voffA); PG8_STAGE(PG8_SB(1, 1), cB + hstep + kstep, voffB);
        PG8_WAIT_V(6); PG8_BAR;
    }
    for (;;) {
        const bool has_next = S.next(ui + 1, nxt);
        const char* nA = has_next ? (const char*)g.A + (size_t)nxt.pm * tstep : cA; const char* nB = has_next ? (const char*)g.Bt + (size_t)nxt.pn * tstep : cB;
        for (int t = 0; t < nt; t += 2) {
            if constexpr (Epi::MIDK > 0) { if (t == Epi::MIDK) E.mid(acc, cur, wr, wc, fr, fq); }
            const bool last = (t == nt - 2);
            const char* a1 = cA + (size_t)(t + 1) * kstep;
            const char* a2 = last ? nA : cA + (size_t)(t + 2) * kstep; const char* b2 = last ? nB : cB + (size_t)(t + 2) * kstep;
            const char* a3 = a2 + kstep; const char* b3 = b2 + kstep;
            if (last && has_next) S.a_ready(nxt);
            if constexpr (SP2) {
            PG8_LDB(B0, 0, 0); PG8_LDB(B1, 0, 1); PG8_SCHED; PG8_LDA(At, 0, 0); PG8_STAGE(PG8_SA(1, 1), a1 + hstep, voffA);
            PG8_WAIT_V(8); PG8_WAIT_L(0); PG8_BAR; PG8_MMA(0, 0, At, B0); PG8_MMA(0, 1, At, B1); PG8_BAR; PG8_SCHED;
            PG8_LDA(At, 0, 1); PG8_STAGE(PG8_SB(0, 0), b2, voffB); PG8_STAGE(PG8_SB(0, 1), b2 + hstep, voffB); PG8_STAGE(PG8_SA(0, 0), a2, voffA);
            PG8_WAIT_V(8); PG8_WAIT_L(0); PG8_BAR; PG8_MMA(1, 0, At, B0); PG8_MMA(1, 1, At, B1); PG8_BAR; PG8_SCHED;
            PG8_LDB(B0, 1, 0); PG8_LDB(B1, 1, 1); PG8_SCHED; PG8_LDA(At, 1, 0); PG8_STAGE(PG8_SA(0, 1), a2 + hstep, voffA);
            PG8_WAIT_V(8); PG8_WAIT_L(0); PG8_BAR; PG8_MMA(0, 0, At, B0); PG8_MMA(0, 1, At, B1); PG8_BAR; PG8_SCHED;
            PG8_LDA(At, 1, 1); PG8_STAGE(PG8_SB(1, 0), b3, voffB); PG8_STAGE(PG8_SB(1, 1), b3 + hstep, voffB); PG8_STAGE(PG8_SA(1, 0), a3, voffA);
            PG8_WAIT_V(8); PG8_WAIT_L(0); PG8_BAR; PG8_MMA(1, 0, At, B0); PG8_MMA(1, 1, At, B1); PG8_BAR; PG8_SCHED;
            } else {
            PG8_LDB(B0, 0, 0); PG8_SCHED; PG8_LDA(At, 0, 0); PG8_STAGE(PG8_SA(1, 1), a1 + hstep, voffA);
            PG8_WAIT_L(8); PG8_BAR; PG8_WAIT_L(0); PG8_MMA(0, 0, At, B0); PG8_BAR; PG8_SCHED;
            PG8_LDB(B1, 0, 1); PG8_STAGE(PG8_SB(0, 0), b2, voffB);
            PG8_BAR; PG8_WAIT_L(0); PG8_MMA(0, 1, At, B1); PG8_BAR;
            PG8_LDA(At, 0, 1); PG8_STAGE(PG8_SA(0, 0), a2, voffA);
            PG8_BAR; PG8_WAIT_L(0); PG8_MMA(1, 0, At, B0); PG8_BAR; PG8_SCHED;
            PG8_STAGE(PG8_SB(0, 1), b2 + hstep, voffB);
            PG8_WAIT_V(6); PG8_BAR; PG8_MMA(1, 1, At, B1); PG8_BAR;
            PG8_LDB(B0, 1, 0); PG8_SCHED; PG8_LDA(At, 1, 0); PG8_STAGE(PG8_SA(0, 1), a2 + hstep, voffA);
            PG8_WAIT_L(8); PG8_BAR; PG8_WAIT_L(0); PG8_MMA(0, 0, At, B0); PG8_BAR; PG8_SCHED;
            PG8_LDB(B1, 1, 1); PG8_STAGE(PG8_SB(1, 0), b3, voffB);
            PG8_BAR; PG8_WAIT_L(0); PG8_MMA(0, 1, At, B1); PG8_BAR;
            PG8_LDA(At, 1, 1); PG8_STAGE(PG8_SA(1, 0), a3, voffA);
            PG8_BAR; PG8_WAIT_L(0); PG8_MMA(1, 0, At, B0); PG8_BAR; PG8_SCHED;
            PG8_STAGE(PG8_SB(1, 1), b3 + hstep, voffB);
            PG8_WAIT_V(6); PG8_BAR; PG8_MMA(1, 1, At, B1); PG8_BAR;
            }
        }
        if constexpr (ALIGN_EPI) { if (wr == 0) PG8_BAR; }
        if constexpr (!Epi::AFTER_DRAIN) { E(acc, cur, wr, wc, fr, fq); S.done(cur); }
        if (!has_next) break;
#pragma unroll
        for (int a = 0; a < 2; ++a)
#pragma unroll
            for (int b = 0; b < 2; ++b)
#pragma unroll
                for (int m = 0; m < 4; ++m)
#pragma unroll
                    for (int n = 0; n < 2; ++n) acc[a][b][m][n] = (f32x4){0.f, 0.f, 0.f, 0.f};
        cur = nxt; cA = nA; cB = nB; ++ui;
        if constexpr (ALIGN_EPI) { if (wr == 1) PG8_BAR; }
    }
    PG8_WAIT_V(0);
    if constexpr (!ALIGN_EPI) { if (wr == 0) PG8_BAR; }
    PG8_BAR;
    if constexpr (Epi::AFTER_DRAIN) { E.fused(acc, cur, wr, wc, fr, fq, lds, wid, lane); S.done(cur); }
#undef PG8_SA
#undef PG8_SB
#undef PG8_STAGE
#undef PG8_LDA
#undef PG8_LDB
#undef PG8_MMA
#undef PG8_WAIT_V
#undef PG8_WAIT_L
#undef PG8_BAR
#undef PG8_SCHED
}
}

#ifndef PG8_SP2
#define PG8_SP2 true
#endif
#ifndef PG8_ALIGN
#define PG8_ALIGN true
#endif
#include <hip/hip_bf16.h>
#include <cmath>
namespace attn_body {
using bf16=__hip_bfloat16;
using bf16x8=__attribute__((ext_vector_type(8)))short;
using s16x4=__attribute__((ext_vector_type(4)))short;
using f32x16=__attribute__((ext_vector_type(16)))float;
using u32x4=__attribute__((ext_vector_type(4)))unsigned;
constexpr int SEQ=2048,D=64,QP=512,KP=512,VP=512,OP=1024;
constexpr int NW=8,QBLK=32,QB=QBLK*NW,KVBLK=64,NQB=SEQ/QB;
constexpr int ATTN_UNIT_ROWS=QB;
__device__ __forceinline__ int crow(int r,int hi){return (r&3)+8*(r>>2)+4*hi;}
#define SBAR() __builtin_amdgcn_sched_barrier(0)
__device__ __forceinline__ void cmask(f32x16&p0,f32x16&p1,int jb,int wchunk,int){
  if(jb>wchunk){ const float NEG=-INFINITY;
    #pragma unroll
    for(int r=0;r<16;++r){p0[r]=NEG;p1[r]=NEG;} }
}

constexpr int NSLOT=3, SLOTB=8192;
constexpr int LDS_K=0, LDS_V=NSLOT*SLOTB, LDS_WS=2*NSLOT*SLOTB, LDS_OST=LDS_WS+NW*64*4, LDS_BYTES=LDS_OST+NW*4096;
constexpr float C2=0.125f*1.4426950408889634f;
__device__ __forceinline__ void glds16(const void*gsrc,unsigned lds_dst){unsigned keep;
  asm volatile("s_mov_b32 %0, m0\n\ts_mov_b32 m0, %2\n\ts_nop 0\n\tglobal_load_lds_dwordx4 %1, off\n\ts_mov_b32 m0, %0":"=&s"(keep):"v"(gsrc),"s"(lds_dst):"memory");}
__device__ __forceinline__ float max3f(float a,float b,float c){float r;asm("v_max3_f32 %0, %1, %2, %3":"=v"(r):"v"(a),"v"(b),"v"(c));return r;}
__device__ __forceinline__ float max2f(float a,float b){float r;asm("v_max_f32_e32 %0, %1, %2":"=v"(r):"v"(a),"v"(b));return r;}
__device__ __forceinline__ float fadd_s(float a,float b){float r;asm("v_add_f32_e32 %0, %1, %2":"=v"(r):"v"(a),"v"(b));return r;}
__device__ __forceinline__ float fsub_s(float a,float b){float r;asm("v_sub_f32_e32 %0, %1, %2":"=v"(r):"v"(a),"v"(b));return r;}
typedef float f32x2_t __attribute__((ext_vector_type(2))); typedef __bf16 bf16x2_t __attribute__((ext_vector_type(2)));
__device__ __forceinline__ unsigned cvtpk_s(float lo,float hi){f32x2_t v={lo,hi};bf16x2_t b=__builtin_convertvector(v,bf16x2_t);return __builtin_bit_cast(unsigned,b);}
#define WAIT_BAR(N) asm volatile("s_waitcnt vmcnt(" #N ") lgkmcnt(0)\n\ts_barrier":::"memory")

__device__ __forceinline__ void qkt(f32x16&p0,f32x16&p1,const char*Kslot,const bf16x8*qr,const f32x16&negm,int r32,int hi){
  const char*kb=Kslot+hi*1024+r32*16;
  #pragma unroll
  for(int d0=0;d0<4;++d0){
    const bf16x8 b0=*reinterpret_cast<const bf16x8*>(kb+d0*2048);
    const bf16x8 b1=*reinterpret_cast<const bf16x8*>(kb+d0*2048+512);
    if(d0==0){p0=__builtin_amdgcn_mfma_f32_32x32x16_bf16(b0,qr[0],negm,0,0,0);p1=__builtin_amdgcn_mfma_f32_32x32x16_bf16(b1,qr[0],negm,0,0,0);}
    else{p0=__builtin_amdgcn_mfma_f32_32x32x16_bf16(b0,qr[d0],p0,0,0,0);p1=__builtin_amdgcn_mfma_f32_32x32x16_bf16(b1,qr[d0],p1,0,0,0);}}
}
typedef __attribute__((address_space(3))) const char* lds_cptr;
typedef short v4i16_t __attribute__((ext_vector_type(4)));
__device__ __forceinline__ void kload8(bf16x8*kf,lds_cptr kp){
  kf[0]=*(const __attribute__((address_space(3))) bf16x8*)(kp);      kf[1]=*(const __attribute__((address_space(3))) bf16x8*)(kp+512);
  kf[2]=*(const __attribute__((address_space(3))) bf16x8*)(kp+2048); kf[3]=*(const __attribute__((address_space(3))) bf16x8*)(kp+2560);
  kf[4]=*(const __attribute__((address_space(3))) bf16x8*)(kp+4096); kf[5]=*(const __attribute__((address_space(3))) bf16x8*)(kp+4608);
  kf[6]=*(const __attribute__((address_space(3))) bf16x8*)(kp+6144); kf[7]=*(const __attribute__((address_space(3))) bf16x8*)(kp+6656);
}
__device__ __forceinline__ void kload2(bf16x8*kf,lds_cptr kp,int j){ kf[2*j]=*(const __attribute__((address_space(3))) bf16x8*)(kp+j*2048); kf[2*j+1]=*(const __attribute__((address_space(3))) bf16x8*)(kp+j*2048+512); }
__device__ __forceinline__ s16x4 vtr(lds_cptr p){ return __builtin_bit_cast(s16x4,__builtin_amdgcn_ds_read_tr16_b64_v4i16((__attribute__((address_space(3))) v4i16_t*)p)); }
__device__ __forceinline__ float rowmax(const f32x16&p0,const f32x16&p1){
  float a=max3f(p0[0],p0[1],p1[0]),b=max3f(p0[2],p0[3],p1[1]);a=max3f(a,p1[2],p1[3]);
  #pragma unroll
  for(int r=4;r<16;r+=4){a=max3f(a,p0[r],p0[r+1]);b=max3f(b,p0[r+2],p0[r+3]);a=max3f(a,p1[r],p1[r+1]);b=max3f(b,p1[r+2],p1[r+3]);}
  const float m=max2f(a,b);
  auto rr=__builtin_amdgcn_permlane32_swap(__float_as_uint(m),__float_as_uint(m),false,false);
  return max2f(__uint_as_float(rr[0]),__uint_as_float(rr[1]));
}
__device__ __forceinline__ void pv(f32x16*o,int vb,bf16x8 pa0,bf16x8 pa1,bf16x8 pa2,bf16x8 pa3){
  #pragma unroll
  for(int d0=0;d0<2;++d0){s16x4 lo[4],hi[4];
    #pragma unroll
    for(int ks=0;ks<4;++ks){
      asm volatile("ds_read_b64_tr_b16 %0,%1 offset:%c2":"=&v"(lo[ks]):"v"(vb),"i"(d0*4096+ks*1024):"memory");
      asm volatile("ds_read_b64_tr_b16 %0,%1 offset:%c2":"=&v"(hi[ks]):"v"(vb),"i"(d0*4096+ks*1024+512):"memory");}
    asm volatile("s_waitcnt lgkmcnt(0)":::"memory");SBAR();
    #define PK(k) (bf16x8){lo[k][0],lo[k][1],lo[k][2],lo[k][3],hi[k][0],hi[k][1],hi[k][2],hi[k][3]}
    o[d0]=__builtin_amdgcn_mfma_f32_32x32x16_bf16(pa0,PK(0),o[d0],0,0,0);
    o[d0]=__builtin_amdgcn_mfma_f32_32x32x16_bf16(pa1,PK(1),o[d0],0,0,0);
    o[d0]=__builtin_amdgcn_mfma_f32_32x32x16_bf16(pa2,PK(2),o[d0],0,0,0);
    o[d0]=__builtin_amdgcn_mfma_f32_32x32x16_bf16(pa3,PK(3),o[d0],0,0,0);
    #undef PK
  }
}

#ifndef ATTN_STORE16
#define ATTN_STORE16(p,v) (*(u32x4*)(p)=(v))
#endif
template<int THRL> __device__ __forceinline__ void attn_unit(int b,int qcol,int kcol,int vcol,int ocol,int qb,const bf16*Q,const bf16*__restrict__ K,const bf16*__restrict__ V,bf16*O,char*shm){
  int tid_=threadIdx.x; asm volatile("":"+v"(tid_));
  const int tid=tid_,lane=tid&63,r32=lane&31,hi=lane>>5; const int wid=__builtin_amdgcn_readfirstlane(tid>>6);
  const long rowbase=(long)b*SEQ; const int q0=qb*QB;
  const bf16*Qw=Q+(rowbase+q0+wid*QBLK)*QP+qcol;
  const bf16*Kh=K+rowbase*KP+kcol,*Vh=V+rowbase*VP+vcol;
  const unsigned lds0=(unsigned)(uintptr_t)shm;
  float*wsf=(float*)(shm+LDS_WS)+wid*64;
  const bf16*ksrc=Kh+(long)lane*KP+wid*8;
  const bf16*vsrc=Vh+(long)(16*(wid&3)+(lane>>2))*VP+(wid>>2)*32+(lane&3)*8;
  const unsigned kdst=lds0+LDS_K+wid*1024, vdst=lds0+LDS_V+wid*1024;
  #define DMA_K(t,slot) glds16(ksrc+(long)(t)*KVBLK*KP,(unsigned)__builtin_amdgcn_readfirstlane(kdst+(slot)))
  #define DMA_V(t,slot) glds16(vsrc+(long)(t)*KVBLK*VP,(unsigned)__builtin_amdgcn_readfirstlane(vdst+(slot)))
  const int vb0=(int)(lds0+LDS_V)+((lane>>4)&1)*32+(lane&3)*8+(4*hi+((lane&15)>>2))*64;
  const char*Kbase=shm+LDS_K; bf16x8 kf[8];
  const lds_cptr shm3=(lds_cptr)shm; const lds_cptr kp0=shm3+LDS_K+hi*1024+r32*16; const lds_cptr vp0=shm3+LDS_V+((lane>>4)&1)*32+(lane&3)*8+(4*hi+((lane&15)>>2))*64;
  const int NT=(q0+QB)/KVBLK;
  DMA_K(0,0);DMA_V(0,0);DMA_K(1,SLOTB);
  bf16x8 qr[4];
  #pragma unroll
  for(int d0=0;d0<4;++d0)qr[d0]=*reinterpret_cast<const bf16x8*>(&Qw[(long)r32*QP+d0*16+hi*8]);
  float mhat=0.f,l_reg=0.f;f32x16 o[2];o[0]=f32x16{};o[1]=f32x16{};f32x16 negm=f32x16{};asm volatile("":"+v"(negm));
  const int qrel=wid>>1;
  #define CMASK(P0,P1,t) do{int jb_=(t)-(NT-4); if(jb_>=0)cmask(P0,P1,jb_,qrel,hi);}while(0)
  bool resc=false;
  #define START(P0,P1) do{ const float rm=rowmax(P0,P1); resc=false; \
    { const float dl=rm; mhat=fadd_s(mhat,dl); \
      _Pragma("unroll") for(int r=0;r<16;++r){P0[r]=fsub_s(P0[r],dl);P1[r]=fsub_s(P1[r],dl);} \
      _Pragma("unroll") for(int r=0;r<16;++r)negm[r]=-mhat; asm volatile("":"+v"(negm)); } \
    _Pragma("unroll") for(int r=0;r<16;++r)P0[r]=__builtin_amdgcn_exp2f(P0[r]); }while(0)
  #define RESC() do{ if(resc){ asm volatile("s_waitcnt lgkmcnt(0)":::"memory"); \
      _Pragma("unroll") for(int d_=0;d_<2;++d_) _Pragma("unroll") for(int r=0;r<16;++r)o[d_][r]*=wsf[crow(r,hi)]; } }while(0)
  f32x16 pA0,pA1,pB0,pB1;
  int sl_prev=0,sl_cur=0,sl_next=SLOTB;
  #define ROT() do{sl_prev=sl_cur;sl_cur=sl_next;sl_next=(sl_next==(NSLOT-1)*SLOTB)?0:sl_next+SLOTB;}while(0)
  DMA_K(2,2*SLOTB);
  WAIT_BAR(3);
  qkt(pA0,pA1,Kbase,qr,negm,r32,hi);asm volatile("s_nop 15\n\ts_nop 7":"+v"(pA0),"+v"(pA1));CMASK(pA0,pA1,0);
  START(pA0,pA1);
  _Pragma("unroll") for(int r=0;r<16;++r)pA1[r]=__builtin_amdgcn_exp2f(pA1[r]);
  WAIT_BAR(0);
  DMA_K(3,0);DMA_V(1,SLOTB);
  ROT();
  kload8(kf,kp0+sl_cur);
  WAIT_BAR(2);
  s16x4 vlo[8],vhi[8]; u32x4 pw0,pw1,pw2,pw3;
  #define PKW(P,B) cvtpk_s(P[B],P[B+1])
  #define PAF(k) __builtin_bit_cast(bf16x8,pw##k)
  #define VFR(i) (bf16x8){vlo[i][0],vlo[i][1],vlo[i][2],vlo[i][3],vhi[i][0],vhi[i][1],vhi[i][2],vhi[i][3]}
  #define PIN(x) asm volatile("":"+v"(x))
  #define MX3(a,b,c) __builtin_fmaxf(__builtin_fmaxf((a),(b)),(c))
  #define GAPA(MF,A0,A1,A2,A3,W0,W1,PW) do{ MF; sacc+=A0; sacc+=A1; sacc+=A2; sacc+=A3; PIN(sacc); W0; W1; PIN(PW); SBAR(); }while(0)
  #define EX(v) __builtin_amdgcn_exp2f(v)
  #define GAPB(MF,X,B) do{ MF; X[B]=EX(X[B]); X[B+1]=EX(X[B+1]); X[B+2]=EX(X[B+2]); X[B+3]=EX(X[B+3]); PIN(X); SBAR(); }while(0)
  #define VRD(i) do{ vlo[i]=vtr(vp_+(((i)>>2)*4096+((i)&3)*1024)); vhi[i]=vtr(vp_+(((i)>>2)*4096+((i)&3)*1024+512)); }while(0)
  #define KRD(G,j) do{ if(G){ kload2(kf,kp0+sl_next,j); SBAR(); } }while(0)
  #define STEP(C0,C1,P0,P1,t,GK,GV,GL) do{ SBAR(); \
    const lds_cptr vp_=vp0+sl_prev; \
    VRD(0); SBAR(); float sacc=(P0[0]+P0[1]); \
    GAPA(C0=__builtin_amdgcn_mfma_f32_32x32x16_bf16(kf[0],qr[0],negm,0,0,0), P0[2],P0[3],P0[4],P0[5],     pw0[0]=PKW(P0,0), pw0[1]=PKW(P0,2), pw0); \
    VRD(4); SBAR(); GAPA(C1=__builtin_amdgcn_mfma_f32_32x32x16_bf16(kf[1],qr[0],negm,0,0,0), P0[6],P0[7],P0[8],P0[9],     pw0[2]=PKW(P0,4), pw0[3]=PKW(P0,6), pw0); \
    VRD(1); SBAR(); GAPA(C0=__builtin_amdgcn_mfma_f32_32x32x16_bf16(kf[2],qr[1],C0,0,0,0),   P0[10],P0[11],P0[12],P0[13], pw1[0]=PKW(P0,8), pw1[1]=PKW(P0,10), pw1); \
    VRD(5); SBAR(); GAPA(C1=__builtin_amdgcn_mfma_f32_32x32x16_bf16(kf[3],qr[1],C1,0,0,0),   P0[14],P0[15],P1[0],P1[1],   pw1[2]=PKW(P0,12),pw1[3]=PKW(P0,14), pw1); \
    VRD(2); SBAR(); GAPA(C0=__builtin_amdgcn_mfma_f32_32x32x16_bf16(kf[4],qr[2],C0,0,0,0),   P1[2],P1[3],P1[4],P1[5],     pw2[0]=PKW(P1,0), pw2[1]=PKW(P1,2), pw2); \
    VRD(6); SBAR(); GAPA(C1=__builtin_amdgcn_mfma_f32_32x32x16_bf16(kf[5],qr[2],C1,0,0,0),   P1[6],P1[7],P1[8],P1[9],     pw2[2]=PKW(P1,4), pw2[3]=PKW(P1,6), pw2); \
    VRD(3); SBAR(); GAPA(C0=__builtin_amdgcn_mfma_f32_32x32x16_bf16(kf[6],qr[3],C0,0,0,0),   P1[10],P1[11],P1[12],P1[13], pw3[0]=PKW(P1,8), pw3[1]=PKW(P1,10), pw3); \
    VRD(7); SBAR(); GAPA(C1=__builtin_amdgcn_mfma_f32_32x32x16_bf16(kf[7],qr[3],C1,0,0,0),   P1[14],P1[15],0.f,0.f,       pw3[2]=PKW(P1,12),pw3[3]=PKW(P1,14), pw3); \
    l_reg+=sacc; \
    if(GK){DMA_K((t)+3,sl_cur);} if(GV){DMA_V((t)+1,sl_next);} \
    CMASK(C0,C1,t); \
    { float a=MX3(C0[0],C0[1],C1[0]),b=MX3(C0[2],C0[3],C1[1]); a=MX3(a,C1[2],C1[3]); \
      _Pragma("unroll") for(int r=4;r<16;r+=4){a=MX3(a,C0[r],C0[r+1]);b=MX3(b,C0[r+2],C0[r+3]);a=MX3(a,C1[r],C1[r+1]);b=MX3(b,C1[r+2],C1[r+3]);} \
      float rm=__builtin_fmaxf(a,b); { auto rr=__builtin_amdgcn_permlane32_swap(__float_as_uint(rm),__float_as_uint(rm),false,false); rm=__builtin_fmaxf(__uint_as_float(rr[0]),__uint_as_float(rr[1])); } \
      resc=false; \
      if(__builtin_expect(__any(rm>(float)THRL),0)){ const float dl=__builtin_fmaxf(rm,0.f); mhat+=dl; \
        _Pragma("unroll") for(int r=0;r<16;++r){C0[r]-=dl;C1[r]-=dl;} \
        _Pragma("unroll") for(int r=0;r<16;++r)negm[r]=-mhat; asm volatile("":"+v"(negm)); \
        const float f=__builtin_amdgcn_exp2f(-dl); l_reg*=f; if(hi==0)wsf[r32]=f; resc=true; } } \
    SBAR(); \
    GAPB(o[0]=__builtin_amdgcn_mfma_f32_32x32x16_bf16(PAF(0),VFR(0),o[0],0,0,0), C0,0); \
    GAPB(o[1]=__builtin_amdgcn_mfma_f32_32x32x16_bf16(PAF(0),VFR(4),o[1],0,0,0), C0,4); \
    KRD(GL,0); GAPB(o[0]=__builtin_amdgcn_mfma_f32_32x32x16_bf16(PAF(1),VFR(1),o[0],0,0,0), C0,8); \
    KRD(GL,1); GAPB(o[1]=__builtin_amdgcn_mfma_f32_32x32x16_bf16(PAF(1),VFR(5),o[1],0,0,0), C0,12); \
    KRD(GL,2); GAPB(o[0]=__builtin_amdgcn_mfma_f32_32x32x16_bf16(PAF(2),VFR(2),o[0],0,0,0), C1,0); \
    KRD(GL,3); GAPB(o[1]=__builtin_amdgcn_mfma_f32_32x32x16_bf16(PAF(2),VFR(6),o[1],0,0,0), C1,4); \
    GAPB(o[0]=__builtin_amdgcn_mfma_f32_32x32x16_bf16(PAF(3),VFR(3),o[0],0,0,0), C1,8); \
    GAPB(o[1]=__builtin_amdgcn_mfma_f32_32x32x16_bf16(PAF(3),VFR(7),o[1],0,0,0), C1,12); \
    }while(0)
  int t=1;
  #undef CMASK
  #define CMASK(P0,P1,t) do{}while(0)
  for(;t+5<NT;t+=2){
    STEP(pB0,pB1,pA0,pA1,t,true,true,true);     WAIT_BAR(2); RESC(); ROT();
    STEP(pA0,pA1,pB0,pB1,t+1,true,true,true);   WAIT_BAR(2); RESC(); ROT();
  }
  #undef CMASK
  #define CMASK(P0,P1,t) do{int jb_=(t)-(NT-4); if(jb_>=0)cmask(P0,P1,jb_,qrel,hi);}while(0)
  #define ENDW(tt) do{ if((tt)+3<NT){WAIT_BAR(2);} else if((tt)+2<NT){WAIT_BAR(1);} else {WAIT_BAR(0);} }while(0)
  for(;t+1<NT;t+=2){
    STEP(pB0,pB1,pA0,pA1,t,(t+3<NT),(t+1<NT),(t+1<NT));       ENDW(t);   RESC(); ROT();
    STEP(pA0,pA1,pB0,pB1,t+1,(t+4<NT),(t+2<NT),(t+2<NT));     ENDW(t+1); RESC(); ROT();
  }
  STEP(pB0,pB1,pA0,pA1,NT-1,false,false,false); RESC();
  { float sacc=pB0[0]+pB0[1]; _Pragma("unroll") for(int r=2;r<16;++r)sacc+=pB0[r]; _Pragma("unroll") for(int r=0;r<16;++r)sacc+=pB1[r]; l_reg+=sacc;
    pw0=(u32x4){PKW(pB0,0),PKW(pB0,2),PKW(pB0,4),PKW(pB0,6)};pw1=(u32x4){PKW(pB0,8),PKW(pB0,10),PKW(pB0,12),PKW(pB0,14)};pw2=(u32x4){PKW(pB1,0),PKW(pB1,2),PKW(pB1,4),PKW(pB1,6)};pw3=(u32x4){PKW(pB1,8),PKW(pB1,10),PKW(pB1,12),PKW(pB1,14)};
    SBAR(); pv(o,vb0+sl_cur,PAF(0),PAF(1),PAF(2),PAF(3)); }
  #undef PKW
  #undef PAF
  #undef VFR
  #undef PIN
  #undef MX3
  #undef GAPA
  #undef GAPB
  #undef EX
  #undef VRD
  #undef KRD
  #undef STEP
  #undef ENDW
  {auto rr=__builtin_amdgcn_permlane32_swap(__float_as_uint(l_reg),__float_as_uint(l_reg),false,false);l_reg=__uint_as_float(rr[0])+__uint_as_float(rr[1]);}
  if(hi==0)wsf[32+r32]=l_reg;asm volatile("s_waitcnt lgkmcnt(0)":::"memory");
  float rli[16];
  #pragma unroll
  for(int r=0;r<16;++r)rli[r]=__builtin_amdgcn_rcpf(wsf[32+crow(r,hi)]);
  bf16*Ow=O+(rowbase+q0+wid*QBLK)*OP+ocol;
  { bf16*stg=(bf16*)(shm+LDS_OST)+wid*2048;
    #pragma unroll
    for(int r=0;r<16;++r){const int orow=crow(r,hi);
      #pragma unroll
      for(int d0=0;d0<2;++d0)stg[orow*64+d0*32+r32]=__float2bfloat16(o[d0][r]*rli[r]);}
    asm volatile("s_waitcnt lgkmcnt(0)":::"memory");
    #pragma unroll
    for(int i=0;i<4;++i){const int row=i*8+(lane>>3),ch=lane&7; const u32x4 v=*(const u32x4*)(stg+row*64+ch*8); ATTN_STORE16(Ow+(long)row*OP+ch*8,v);} }
  asm volatile("s_waitcnt lgkmcnt(0)\n\ts_barrier":::"memory");
  #undef DMA_K
  #undef DMA_V
  #undef CMASK
  #undef START
  #undef RESC
  #undef ROT
}
constexpr int ATTN_LDS_BYTES=LDS_BYTES;
struct AttnTensors { const bf16* Q; const bf16* K; const bf16* V; bf16* O; };
struct AttnUnit { int bvh; int qb; };
struct StaticOrder {
  int ai,nA;
  __device__ __forceinline__ StaticOrder(int ai_,int nA_):ai(ai_),nA(nA_){}
  __device__ __forceinline__ bool next(int i,AttnUnit&u)const{
    if(nA==128){ if(i>=8)return false; u.bvh=ai; u.qb=7-i; return true; }
    if(i>=4)return false; const int s=ai&1; u.bvh=ai>>1; u.qb=(i==0)?7-s:(i==1)?4+s:(i==2)?3-s:s; return true; }
  __device__ __forceinline__ void a_ready(const AttnUnit&)const{}
  __device__ __forceinline__ void done(const AttnUnit&)const{}
};
template<class Sched,int THRL=8> __device__ __forceinline__ void attn_phase(char*lds,const AttnTensors&T,const Sched&S){
  AttnUnit u;
  for(int i=0;S.next(i,u);++i){ S.a_ready(u); const int b=u.bvh>>4,vh=u.bvh&15,s=vh>>1,half=vh&1;
    attn_unit<THRL>(b,s*64,s*64,(s>>1)*128+half*64,s*128+half*64,u.qb,T.Q,T.K,T.V,T.O,lds); S.done(u); }
}
template<int THRL=8> __device__ __forceinline__ void attn_phase_queue(char*lds,const AttnTensors&T,unsigned*counter,volatile __attribute__((address_space(3))) unsigned*slot){
  for(;;){
    if(threadIdx.x==0)*slot=__hip_atomic_fetch_add(counter,1u,__ATOMIC_RELAXED,__HIP_MEMORY_SCOPE_AGENT);
    __syncthreads();
    const unsigned u=__builtin_amdgcn_readfirstlane(*slot);
    __syncthreads();
    if(u>=1024u)break;
    const int qb=7-(int)(u>>7),bvh=(int)(u&127u),b=bvh>>4,vh=bvh&15,s=vh>>1,half=vh&1;
    attn_unit<THRL>(b,s*64,s*64,(s>>1)*128+half*64,s*128+half*64,qb,T.Q,T.K,T.V,T.O,lds);
  }
}
#undef SBAR
#undef WAIT_BAR
}
#include <hip/hip_cooperative_groups.h>
typedef unsigned short bf16;
#define GAS __attribute__((address_space(1)))
#define LAS __attribute__((address_space(3)))
typedef unsigned v4u __attribute__((ext_vector_type(4)));
typedef unsigned v2u __attribute__((ext_vector_type(2)));
typedef float f32x4 __attribute__((ext_vector_type(4)));
#define LDS_WAIT() asm volatile("s_waitcnt lgkmcnt(0)" ::: "memory")
__device__ __forceinline__ unsigned f2bf(float f) { unsigned u = __builtin_bit_cast(unsigned, f); return (u + 0x7fffu + ((u >> 16) & 1u)) >> 16; }
__device__ __forceinline__ unsigned pk2(float lo, float hi) { return f2bf(lo) | (f2bf(hi) << 16); }
__device__ __forceinline__ float bflo(unsigned w) { return __builtin_bit_cast(float, w << 16); }
__device__ __forceinline__ float bfhi(unsigned w) { return __builtin_bit_cast(float, w & 0xffff0000u); }
__device__ __forceinline__ float bf1(unsigned short h) { return __builtin_bit_cast(float, (unsigned)h << 16); }
template <int CTRL> __device__ __forceinline__ float dppf(float x) { return __builtin_bit_cast(float, __builtin_amdgcn_update_dpp(0, __builtin_bit_cast(int, x), CTRL, 0xf, 0xf, false)); }
__device__ __forceinline__ float row16_allsum(float x) { x += dppf<0x128>(x); x += dppf<0x124>(x); x += dppf<0x122>(x); x += dppf<0x121>(x); return x; }
__device__ __forceinline__ float oct_allsum(float x) { x += dppf<0xB1>(x); x += dppf<0x4E>(x); x += dppf<0x141>(x); return x; }
__device__ __forceinline__ float u2f(unsigned u) { return __builtin_bit_cast(float, u); }
__device__ __forceinline__ unsigned f2u(float f) { return __builtin_bit_cast(unsigned, f); }
__device__ __forceinline__ float sw32(float a, float b) { auto r = __builtin_amdgcn_permlane32_swap(f2u(a), f2u(b), false, false); const unsigned r0 = r[0], r1 = r[1]; return u2f(r0) + u2f(r1); }
__device__ __forceinline__ float sw16(float a, float b) { auto r = __builtin_amdgcn_permlane16_swap(f2u(a), f2u(b), false, false); const unsigned r0 = r[0], r1 = r[1]; return u2f(r0) + u2f(r1); }
__device__ __forceinline__ float wave_allsum(float x) { x = row16_allsum(x); x = sw16(x, x); return sw32(x, x); }
__device__ __forceinline__ float red4(float x0, float x1, float x2, float x3) { return row16_allsum(sw16(sw32(x0, x1), sw32(x2, x3))); }

#define XB_TMO      128
#define XB_XCNT(j)  (256  + 64 * (j))
#define XB_XSUB(j)  (1280 + 64 * (j))
#define XB_XGEN(j)  (2304 + 64 * (j))
#define XB_TOP      3328
#define XB_TOPGEN   3392
#define XCD_BAR_WORDS 3456
#define XB_SPIN_CAP (1u << 18)

__device__ __forceinline__ unsigned xb_ld(unsigned* p)              { return __hip_atomic_load(p, __ATOMIC_RELAXED, __HIP_MEMORY_SCOPE_AGENT); }
__device__ __forceinline__ unsigned xb_add(unsigned* p, unsigned v) { return __hip_atomic_fetch_add(p, v, __ATOMIC_RELAXED, __HIP_MEMORY_SCOPE_AGENT); }
__device__ __forceinline__ unsigned xb_xcc_id() { return (unsigned)__builtin_amdgcn_s_getreg((3 << 11) | 20) & 0xFu; }
#define XB_SPIN(cond, bar) do { unsigned _sp = 0; while (cond) { __builtin_amdgcn_s_sleep(1); \
    if ((++_sp & 255u) == 0u) { if (xb_ld(&(bar)[XB_TMO])) break; if (_sp > XB_SPIN_CAP) { atomicAdd(&(bar)[XB_TMO], 1u); break; } } } } while (0)

struct XcdBarrier {
    unsigned* bar; unsigned x;
    volatile LAS unsigned* st;
};

__device__ __forceinline__ XcdBarrier xcd_barrier_post(unsigned* bar, volatile LAS unsigned* st) {
    XcdBarrier b; b.bar = bar; b.x = xb_xcc_id(); b.st = st;
    if (threadIdx.x == 0) (void)xb_add(&bar[XB_XCNT(b.x)], 1u);
    return b;
}
__device__ __forceinline__ void xcd_barrier_complete(unsigned* bar, unsigned x, unsigned& nloc, unsigned& nx) {
    const unsigned G = gridDim.x * gridDim.y * gridDim.z;
    unsigned sum, cnt, mine, sp = 0u;
    for (;;) {
        sum = 0u; cnt = 0u; mine = 0u;
#pragma unroll
        for (unsigned j = 0; j < 16; ++j) { const unsigned c = xb_ld(&bar[XB_XCNT(j)]); sum += c; cnt += (c > 0u) ? 1u : 0u; }
        mine = xb_ld(&bar[XB_XCNT(x)]);
        if (sum == G) break;
        __builtin_amdgcn_s_sleep(1);
        if ((++sp & 255u) == 0u) { if (xb_ld(&bar[XB_TMO])) break; if (sp > XB_SPIN_CAP) { atomicAdd(&bar[XB_TMO], 1u); break; } }
    }
    nloc = mine > 0u ? mine : 1u; nx = cnt > 0u ? cnt : 1u;
}

__device__ __forceinline__ void xcd_barrier(const XcdBarrier& b) {
    asm volatile("s_waitcnt vmcnt(0)" ::: "memory");
    __syncthreads();
    if (threadIdx.x == 0) {
        unsigned* bar = b.bar;
        __builtin_amdgcn_s_waitcnt(0);
        unsigned nloc = b.st[0], nx = b.st[1];
        if (nloc == 0u) { xcd_barrier_complete(bar, b.x, nloc, nx); b.st[0] = nloc; b.st[1] = nx; }
        const unsigned old = xb_add(&bar[XB_XSUB(b.x)], 1u);
        const unsigned gen = old / nloc;
        if (old + 1u == (gen + 1u) * nloc) {
            __builtin_amdgcn_fence(__ATOMIC_RELEASE, "agent");
            asm volatile("s_waitcnt vmcnt(0)" ::: "memory");
            const unsigned og = xb_add(&bar[XB_TOP], 1u);
            const unsigned tg = og / nx;
            if (og + 1u == (tg + 1u) * nx) xb_add(&bar[XB_TOPGEN], 1u);
            else XB_SPIN(xb_ld(&bar[XB_TOPGEN]) == tg, bar);
            __builtin_amdgcn_fence(__ATOMIC_ACQUIRE, "agent");
            xb_add(&bar[XB_XGEN(b.x)], 1u);
            asm volatile("s_waitcnt vmcnt(0)" ::: "memory");
        } else {
            XB_SPIN(xb_ld(&bar[XB_XGEN(b.x)]) == gen, bar);
            __builtin_amdgcn_fence(__ATOMIC_ACQUIRE, "agent");
            asm volatile("s_waitcnt vmcnt(0)" ::: "memory");
        }
    }
    __syncthreads();
}


constexpr int CW_BAR = 4096;
constexpr int MISC_OFF = 162816 + 320;
struct Frame {
    LAS unsigned char* lds;
    int tid, lane, wave, G, bx;
    float* out; unsigned char* ws;
};
struct Args { const float* in[26]; float* out; unsigned char* ws; int ph_lo, ph_hi; };
typedef const float* cfp_t;
typedef __attribute__((address_space(4))) const cfp_t* ktab_t;
struct InTab { ktab_t p; __device__ __forceinline__ const float* operator[](int i) const { return p[i]; } };
enum { I_X = 0, I_NMG, I_WIN, I_MU, I_W0, I_W2, I_A0, I_A2, I_G2, I_KK, I_KA, I_RK, I_LNG, I_LNB, I_LQ1, I_LK1, I_LQ2, I_LK2, I_SUBG, I_WA, I_WB, I_WO, I_NFG, I_FF1, I_FF2, I_NFIN };

template <bool ROPE> __device__ __forceinline__ void p0_transpose_item(const float* W, int K, int N, bf16* WT, LAS float* scr, int item, int lane, int pitch = 0, int koff = 0) {
    if (pitch == 0) pitch = K;
    const int nblk = N / 32, kb = item / nblk, nb = item % nblk, k0 = 64 * kb, n0 = 32 * nb;
#pragma unroll
    for (int i = 0; i < 8; ++i) { const int kk = 8 * i + (lane >> 3), c4 = 4 * (lane & 7); const f32x4 w4 = *(const GAS f32x4*)(W + (size_t)(k0 + kk) * N + n0 + c4);
        scr[kk * 33 + c4] = w4.x; scr[kk * 33 + c4 + 1] = w4.y; scr[kk * 33 + c4 + 2] = w4.z; scr[kk * 33 + c4 + 3] = w4.w; }
    LDS_WAIT(); asm volatile("" ::: "memory");
    const int c = lane & 7;
#pragma unroll
    for (int j = 0; j < 4; ++j) { const int n = (lane >> 3) + 8 * j; const LAS float* s = scr + (8 * c) * 33 + n;
        v4u o; o.x = pk2(s[0 * 33], s[1 * 33]); o.y = pk2(s[2 * 33], s[3 * 33]); o.z = pk2(s[4 * 33], s[5 * 33]); o.w = pk2(s[6 * 33], s[7 * 33]);
        int col = n0 + n;
        if (ROPE && col < 1024) { const int d = col & 63, dd = d & 31; col = (col & ~63) + 8 * (dd >> 2) + (d >> 5) * 4 + (dd & 3); }
        *(GAS v4u*)(WT + (size_t)col * pitch + koff + k0 + 8 * c) = o; }
    LDS_WAIT(); asm volatile("" ::: "memory");
}
__device__ __forceinline__ void rms_row_to_bf16(const float* xrow, const float* g, bf16* orow, int lane) {
    const GAS f32x4* xr = (const GAS f32x4*)xrow + lane; const f32x4* gr = (const f32x4*)g + lane;
    f32x4 v[4]; float s = 0.f;
#pragma unroll
    for (int j = 0; j < 4; ++j) { v[j] = xr[64 * j]; s += (v[j].x * v[j].x + v[j].y * v[j].y) + (v[j].z * v[j].z + v[j].w * v[j].w); }
    const float rstd = 1.0f / sqrtf(wave_allsum(s) * (1.f / D) + NORM_EPS);
    GAS unsigned long long* o8 = (GAS unsigned long long*)orow + lane;
#pragma unroll
    for (int j = 0; j < 4; ++j) { const f32x4 gg = gr[64 * j];
        o8[64 * j] = (unsigned long long)pk2(v[j].x * rstd * gg.x, v[j].y * rstd * gg.y) | ((unsigned long long)pk2(v[j].z * rstd * gg.z, v[j].w * rstd * gg.w) << 32); }
}
__device__ __forceinline__ void rms_row_to_f32(const float* xrow, const float* g, float* orow, int lane) {
    const GAS f32x4* xr = (const GAS f32x4*)xrow + lane; const f32x4* gr = (const f32x4*)g + lane;
    f32x4 v[4]; float s = 0.f;
#pragma unroll
    for (int j = 0; j < 4; ++j) { v[j] = xr[64 * j]; s += (v[j].x * v[j].x + v[j].y * v[j].y) + (v[j].z * v[j].z + v[j].w * v[j].w); }
    const float rstd = 1.0f / sqrtf(wave_allsum(s) * (1.f / D) + NORM_EPS);
    GAS f32x4* o = (GAS f32x4*)orow + lane;
#pragma unroll
    for (int j = 0; j < 4; ++j) { const f32x4 gg = gr[64 * j]; o[64 * j] = v[j] * rstd * gg; }
}
__device__ __forceinline__ void p0_prologue(Frame& F, const InTab& A) {
    LAS float* scr = (LAS float*)(F.lds + RING_OFF + F.wave * 16384);
    const int gw = F.bx * NWAVES + F.wave, NGW = F.G * NWAVES;
    unsigned char* ws = F.ws;
    constexpr int I_IN = (D / 64) * (D_IN / 32), I_A = (512 / 64) * (D / 32), I_O = (D / 64) * (D / 32), I_1 = (D / 64) * (FF / 32), I_2 = (FF / 64) * (D / 32);
    (void)I_A; (void)I_O; (void)I_1; (void)I_2;
    for (int it = gw; it < I_IN; it += NGW) p0_transpose_item<true>(A[I_WIN], D, D_IN, (bf16*)(ws + WS_WIN), scr, it, F.lane);
    if (false) for (int it = gw; it < 0; it += NGW) {
        int r = it;
        if (r < I_A) { p0_transpose_item<false>(A[I_WA], 512, D, (bf16*)(ws + WS_WA), scr, r, F.lane, 1024, 0); continue; } r -= I_A;
        if (r < I_A) { p0_transpose_item<false>(A[I_WB], 512, D, (bf16*)(ws + WS_WA), scr, r, F.lane, 1024, 512); continue; } r -= I_A;
        if (r < I_O) { p0_transpose_item<false>(A[I_WO], D, D, (bf16*)(ws + WS_WO), scr, r, F.lane); continue; } r -= I_O;
        if (r < I_1) { p0_transpose_item<false>(A[I_FF1], D, FF, (bf16*)(ws + WS_W1), scr, r, F.lane); continue; } r -= I_1;
        p0_transpose_item<false>(A[I_FF2], FF, D, (bf16*)(ws + WS_W2), scr, r, F.lane);
    }
    const int gt = F.bx * (NWAVES * 64) + F.tid, NGT = F.G * NWAVES * 64;
    for (int e = gt; e < NLORA * (KLORA / 8); e += NGT) { const int n = e % NLORA, k8 = (e / NLORA) * 8; float v[8];
#pragma unroll
        for (int i = 0; i < 8; ++i) { const int k = k8 + i; float x = 0.f;
            if (n < 512) { if (k < 64) x = A[I_W2][(size_t)k * 512 + n]; }
            else if (n < 1024) { if (k >= 64 && k < 128) x = A[I_A2][(size_t)(k - 64) * 512 + (n - 512)]; }
            else { if (k >= 128) x = A[I_G2][(size_t)(k - 128) * 512 + (n - 1024)]; }
            v[i] = x; }
        v4u o; o.x = pk2(v[0], v[1]); o.y = pk2(v[2], v[3]); o.z = pk2(v[4], v[5]); o.w = pk2(v[6], v[7]);
        *(GAS v4u*)((bf16*)(ws + WS_WL) + (size_t)n * KLORA + k8) = o; }
    for (int e = gt; e < SEQ * 32; e += NGT) { const int pos = e >> 5, i = e & 31;
        const float inv = exp2f(-(float)i * 0.41524101186092029f);
        const float ang = (float)pos * inv; float s, c; sincosf(ang, &s, &c);
        ((float*)(ws + WS_ROPE_C))[e] = c; ((float*)(ws + WS_ROPE_S))[e] = s; }
    for (int m = gw; m < M; m += NGW) rms_row_to_bf16(A[I_X] + (size_t)m * D, A[I_NMG], (bf16*)(ws + WS_XN) + (size_t)m * D, F.lane);
}

__device__ __forceinline__ void late_weights(Frame& F, const InTab& A, int part, int nparts, int cu0) {
    int lane_ = F.lane; asm volatile("" : "+v"(lane_));
    LAS float* scr = (LAS float*)(F.lds + RING_OFF + F.wave * 16384);
    unsigned char* ws = F.ws;
    constexpr int I_A = (512 / 64) * (D / 32), I_O = (D / 64) * (D / 32), I_1 = (D / 64) * (FF / 32), I_2 = (FF / 64) * (D / 32), NIT = 2 * I_A + I_O + I_1 + I_2;
    const int per = NIT / nparts, lo = part * per, hi = lo + per;
    const int gw = (F.bx - cu0) * NWAVES + F.wave, NGW = (F.G - cu0) * NWAVES;
    for (int it = lo + gw; it < hi; it += NGW) {
        int r = it;
        if (r < I_A) { p0_transpose_item<false>(A[I_WA], 512, D, (bf16*)(ws + WS_WA), scr, r, lane_, 1024, 0); continue; } r -= I_A;
        if (r < I_A) { p0_transpose_item<false>(A[I_WB], 512, D, (bf16*)(ws + WS_WA), scr, r, lane_, 1024, 512); continue; } r -= I_A;
        if (r < I_O) { p0_transpose_item<false>(A[I_WO], D, D, (bf16*)(ws + WS_WO), scr, r, lane_); continue; } r -= I_O;
        if (r < I_1) { p0_transpose_item<false>(A[I_FF1], D, FF, (bf16*)(ws + WS_W1), scr, r, lane_); continue; } r -= I_1;
        p0_transpose_item<false>(A[I_FF2], FF, D, (bf16*)(ws + WS_W2), scr, r, lane_);
    }
}
__device__ __forceinline__ void prep1_rows(Frame& F, const InTab& A, int g0, int g1, int w, int nw) {
    const int lane = F.lane;
    const bf16* WAG = (const bf16*)(F.ws + WS_WAG); bf16* LIN = (bf16*)(F.ws + WS_LIN);
    const f32x4 mu = *(const f32x4*)(A[I_MU] + 1536 + 4 * lane);
    for (int g = g0 + w; g < g1; g += nw) {
        const int m0 = g * 8; v2u row[9];
        row[0] = (v2u){0u, 0u}; if ((m0 & (SEQ - 1)) != 0) row[0] = *(const GAS v2u*)(WAG + (size_t)(m0 - 1) * 256 + 4 * lane);
#pragma unroll
        for (int j = 0; j < 8; ++j) row[j + 1] = *(const GAS v2u*)(WAG + (size_t)(m0 + j) * 256 + 4 * lane);
#pragma unroll
        for (int j = 0; j < 8; ++j) {
            float z[4] = {bflo(row[j + 1].x), bfhi(row[j + 1].x), bflo(row[j + 1].y), bfhi(row[j + 1].y)}; const float p[4] = {bflo(row[j].x), bfhi(row[j].x), bflo(row[j].y), bfhi(row[j].y)};
#pragma unroll
            for (int e = 0; e < 4; ++e) { float v = z[e] + (p[e] - z[e]) * mu[e];
                if (lane < 16) v = 1.0f - 2.0f * __builtin_amdgcn_rcpf(1.0f + __expf(2.0f * v));
                else if (lane >= 32) v = __builtin_amdgcn_rcpf(1.0f + __expf(-v));
                z[e] = v; }
            v2u o; o.x = pk2(z[0], z[1]); o.y = pk2(z[2], z[3]);
            *(GAS v2u*)(LIN + (size_t)(m0 + j) * 256 + 4 * lane) = o;
        }
    }
}
struct ScanRaw { unsigned short r[9], k[9], v[9], a[8]; float d[8]; };
__device__ __forceinline__ void scan_load(ScanRaw& R, const bf16* RKV, const float* DEC, const bf16* AA, size_t row0, int t0, int c) {
#pragma unroll
    for (int j = 0; j < 9; ++j) { int t = t0 - 1 + j; if (t < 0) t = 0; const bf16* p = RKV + (row0 + t) * 1536 + c;
        R.r[j] = *(const GAS bf16*)p; R.k[j] = *(const GAS bf16*)(p + 512); R.v[j] = *(const GAS bf16*)(p + 1024); }
#pragma unroll
    for (int j = 0; j < 8; ++j) { R.d[j] = *(const GAS float*)(DEC + (row0 + t0 + j) * 512 + c); R.a[j] = *(const GAS bf16*)(AA + (row0 + t0 + j) * 512 + c); }
}
__device__ __forceinline__ void scan_phase(Frame& F, const InTab& A, int si) {
    const int lane = F.lane, wave = F.wave, tid = F.tid;
    const int bh = si >> 1, half = si & 1, b = bh >> 3, h = bh & 7, c = h * 64 + lane;
    LAS float* IN = (LAS float*)(F.lds + RING_OFF);
    LAS float* VV = IN + 5 * 4096;
    LAS float* YBUF = VV + 2048;
    const bf16* RKV = (const bf16*)(F.ws + WS_RKV); const float* DEC = (const float*)(F.ws + WS_DEC); const bf16* AA = (const bf16*)(F.ws + WS_AA);
    bf16* Y = (bf16*)(F.ws + WS_Y); float* BON = (float*)(F.ws + WS_BON);
    const float mu_r = A[I_MU][c], mu_k = A[I_MU][512 + c], mu_v = A[I_MU][1024 + c], kkc = A[I_KK][c], kac = A[I_KA][c], rkc = A[I_RK][c];
    const size_t row0 = (size_t)b * SEQ;
    const int myv = (int)(red4(0.f, 1.f, 2.f, 3.f) * (1.0f / 64.0f) + 0.5f);
    const int L0 = __builtin_ctzll(__ballot(myv == 0)), L1 = __builtin_ctzll(__ballot(myv == 1)), L2 = __builtin_ctzll(__ballot(myv == 2)), L3 = __builtin_ctzll(__ballot(myv == 3));
    float S0 = 0.f, S1 = 0.f, S2 = 0.f, S3 = 0.f;
    ScanRaw R; scan_load(R, RKV, DEC, AA, row0, wave * 8, c);
    for (int blk = 0; blk < SEQ / 64; ++blk) {
        {
            const int t0 = blk * 64 + wave * 8;
            f32x4 qd[2], qa[2], qb[2], qk[2], qr[2], qv[2];
#pragma unroll
            for (int j = 0; j < 8; ++j) {
                const float pz = (t0 + j == 0) ? 0.f : 1.f;
                const float rt_ = bf1(R.r[j + 1]), kt_ = bf1(R.k[j + 1]), vt_ = bf1(R.v[j + 1]);
                const float rs = rt_ + (bf1(R.r[j]) * pz - rt_) * mu_r, ks = kt_ + (bf1(R.k[j]) * pz - kt_) * mu_k, vs = vt_ + (bf1(R.v[j]) * pz - vt_) * mu_v;
                const float kkr = ks * kkc, n2 = wave_allsum(kkr * kkr), kk = kkr / __builtin_fmaxf(sqrtf(n2), 1e-12f);
                const float a = 1.0f / (1.0f + __expf(-bf1(R.a[j]))), kx = ks * (1.0f + (a - 1.0f) * kac);
                const float bon = wave_allsum(rs * kx * rkc);
                if (half == 0 && lane == 0) BON[(row0 + t0 + j) * 8 + h] = bon;
                qd[j >> 2][j & 3] = __expf(-0.6065306597f / (1.0f + __expf(-R.d[j])));     qa[j >> 2][j & 3] = -kk; qb[j >> 2][j & 3] = kk * a; qk[j >> 2][j & 3] = kx; qr[j >> 2][j & 3] = rs; qv[j >> 2][j & 3] = vs;
            }
#pragma unroll
            for (int q = 0; q < 2; ++q) { const int t4 = wave * 2 + q; LAS f32x4* p = (LAS f32x4*)IN + t4 * 64 + lane;
                p[0 * 1024] = qd[q]; p[1 * 1024] = qa[q]; p[2 * 1024] = qb[q]; p[3 * 1024] = qk[q]; p[4 * 1024] = qr[q];
                if ((lane >> 5) == half) ((LAS f32x4*)VV)[t4 * 32 + (lane & 31)] = qv[q]; }
        }
        __syncthreads();
        if (blk + 1 < SEQ / 64) scan_load(R, RKV, DEC, AA, row0, (blk + 1) * 64 + wave * 8, c);
#pragma unroll 1
        for (int t4 = 0; t4 < 16; ++t4) {
            const LAS f32x4* p = (const LAS f32x4*)IN + t4 * 64 + lane;
            const f32x4 W4 = p[0], A4 = p[1024], B4 = p[2048], K4 = p[3072], R4 = p[4096];
            const LAS f32x4* pv = (const LAS f32x4*)VV + t4 * 32 + wave * 4;
            const f32x4 V0 = pv[0], V1 = pv[1], V2 = pv[2], V3 = pv[3];
            f32x4 yq;
#pragma unroll
            for (int ts = 0; ts < 4; ++ts) {
                const float w = W4[ts], a = A4[ts], bb = B4[ts], kx = K4[ts], r = R4[ts];
                const float t = red4(S0 * a, S1 * a, S2 * a, S3 * a);
                const float sa0 = __builtin_bit_cast(float, __builtin_amdgcn_readlane(__builtin_bit_cast(int, t), L0)), sa1 = __builtin_bit_cast(float, __builtin_amdgcn_readlane(__builtin_bit_cast(int, t), L1));
                const float sa2 = __builtin_bit_cast(float, __builtin_amdgcn_readlane(__builtin_bit_cast(int, t), L2)), sa3 = __builtin_bit_cast(float, __builtin_amdgcn_readlane(__builtin_bit_cast(int, t), L3));
                S0 = S0 * w + (sa0 * bb + V0[ts] * kx); S1 = S1 * w + (sa1 * bb + V1[ts] * kx); S2 = S2 * w + (sa2 * bb + V2[ts] * kx); S3 = S3 * w + (sa3 * bb + V3[ts] * kx);
                yq[ts] = red4(S0 * r, S1 * r, S2 * r, S3 * r);
            }
            if ((lane & 15) == 0) *(LAS f32x4*)(YBUF + (wave * 4 + myv) * 68 + t4 * 4) = yq;
        }
        __syncthreads();
        { const int t = tid >> 3, rg = tid & 7; const LAS float* yb = YBUF + (4 * rg) * 68 + t;
          v2u o; o.x = pk2(yb[0], yb[68]); o.y = pk2(yb[136], yb[204]);
          *(GAS v2u*)(Y + (row0 + blk * 64 + t) * 512 + h * 64 + 32 * half + 4 * rg) = o; }
    }
    __syncthreads();
}
__device__ __forceinline__ void post_phase(Frame& F, const InTab& A) {
    const int gw = F.bx * NWAVES + F.wave, NGW = F.G * NWAVES, lane = F.lane;
    const bf16* O = (const bf16*)(F.ws + WS_O); const bf16* Y = (const bf16*)(F.ws + WS_Y); const bf16* RKV = (const bf16*)(F.ws + WS_RKV); const bf16* GG = (const bf16*)(F.ws + WS_GG);
    const float* BON = (const float*)(F.ws + WS_BON); bf16* YA = (bf16*)(F.ws + WS_YA);
    const float lam = __expf(wave_allsum(A[I_LQ1][lane] * A[I_LK1][lane])) - __expf(wave_allsum(A[I_LQ2][lane] * A[I_LK2][lane])) + LAMBDA_INIT;
    const int ca = 8 * lane, ha = lane >> 4, ea = ca & 127;
    const int hb = lane >> 3;
    float sg[8], lg[8], lb[8], muv[8];
#pragma unroll
    for (int e = 0; e < 8; ++e) { sg[e] = A[I_SUBG][ea + e] * (1.0f - LAMBDA_INIT); lg[e] = A[I_LNG][ca + e]; lb[e] = A[I_LNB][ca + e]; muv[e] = A[I_MU][1024 + ca + e]; }
#define UNPK8(w_) {bflo(w_.x), bfhi(w_.x), bflo(w_.y), bfhi(w_.y), bflo(w_.z), bfhi(w_.z), bflo(w_.w), bfhi(w_.w)}
    for (int g = gw; g < M / 4; g += NGW) {
        const int m0 = g * 4;
        v4u o0[4], o1[4], yr[4], gr[4], vr[5]; float bon[4];
        vr[0] = (v4u){0u, 0u, 0u, 0u}; if ((m0 & (SEQ - 1)) != 0) vr[0] = *(const GAS v4u*)(RKV + (size_t)(m0 - 1) * 1536 + 1024 + ca);
#pragma unroll
        for (int j = 0; j < 4; ++j) { const size_t mm = (size_t)(m0 + j);
            o0[j] = *(const GAS v4u*)(O + mm * 1024 + (2 * ha) * 128 + ea); o1[j] = *(const GAS v4u*)(O + mm * 1024 + (2 * ha + 1) * 128 + ea);
            yr[j] = *(const GAS v4u*)(Y + mm * 512 + ca); gr[j] = *(const GAS v4u*)(GG + mm * 512 + ca); vr[j + 1] = *(const GAS v4u*)(RKV + mm * 1536 + 1024 + ca);
            bon[j] = *(const GAS float*)(BON + mm * 8 + hb); }
#pragma unroll
        for (int j = 0; j < 4; ++j) { const size_t mm = (size_t)(m0 + j);
            {
                const float a0[8] = UNPK8(o0[j]), a1[8] = UNPK8(o1[j]); float o[8], ss = 0.f;
#pragma unroll
                for (int e = 0; e < 8; ++e) { o[e] = a0[e] - lam * a1[e]; ss += o[e] * o[e]; }
                const float rstd = __builtin_amdgcn_rsqf(row16_allsum(ss) * (1.0f / 128.0f) + SUBLN_EPS);
                v4u w; w.x = pk2(o[0] * rstd * sg[0], o[1] * rstd * sg[1]); w.y = pk2(o[2] * rstd * sg[2], o[3] * rstd * sg[3]); w.z = pk2(o[4] * rstd * sg[4], o[5] * rstd * sg[5]); w.w = pk2(o[6] * rstd * sg[6], o[7] * rstd * sg[7]);
                *(GAS v4u*)(YA + mm * 1024 + ca) = w;
            }
            {
                const float y[8] = UNPK8(yr[j]), gq[8] = UNPK8(gr[j]), v[8] = UNPK8(vr[j + 1]), p[8] = UNPK8(vr[j]);
                float s = 0.f;
#pragma unroll
                for (int e = 0; e < 8; ++e) s += y[e];
                const float mean = oct_allsum(s) * (1.0f / 64.0f); float q = 0.f;
#pragma unroll
                for (int e = 0; e < 8; ++e) { const float d = y[e] - mean; q += d * d; }
                const float rstd = __builtin_amdgcn_rsqf(oct_allsum(q) * (1.0f / 64.0f) + GN_EPS);
                float r[8];
#pragma unroll
                for (int e = 0; e < 8; ++e) { const float vs = v[e] + (p[e] - v[e]) * muv[e]; r[e] = (((y[e] - mean) * rstd) * lg[e] + lb[e] + bon[j] * vs) * gq[e]; }
                v4u w; w.x = pk2(r[0], r[1]); w.y = pk2(r[2], r[3]); w.z = pk2(r[4], r[5]); w.w = pk2(r[6], r[7]);
                *(GAS v4u*)(YA + mm * 1024 + 512 + ca) = w;
            }
        }
    }
#undef UNPK8
}

typedef short rk_bf16x8 __attribute__((ext_vector_type(8)));
typedef float rk_f32x16 __attribute__((ext_vector_type(16)));
constexpr int RKA_RS_K = 144, RKA_RS_J = 80;
constexpr int RKA_A = 0, RKA_B = 5120, RKA_K = 10240, RKA_R = 15360, RKA_AT = 19968, RKA_BH = 25088, RKA_KH = 30208, RKA_VT = 35328, RKA_GC = 40448, RKA_BYTES = 40704;
constexpr int RKA_N = 0, RKA_X = 0, RKA_T = 5120, RKA_MAK = 7680, RKA_MRB = 10240, RKA_MRK = 12800;
constexpr int RKA_WAVES = 4;
static_assert(RKA_WAVES * RKA_BYTES <= 162816, "phase A LDS");
constexpr size_t WS_PQ = 66 * MiB;
constexpr size_t WS_RY = 98 * MiB;
constexpr size_t WS_GC = 242 * MiB;
constexpr size_t WS_SST = 243 * MiB;

__device__ __forceinline__ rk_bf16x8 rk_frag(const LAS unsigned char* base, int rs, int row, int s, int h) { return *(const LAS rk_bf16x8*)(base + row * rs + (16 * s + 8 * h) * 2); }
__device__ __forceinline__ rk_f32x16 rk_mfma(rk_bf16x8 a, rk_bf16x8 b, rk_f32x16 c) { return __builtin_amdgcn_mfma_f32_32x32x16_bf16(a, b, c, 0, 0, 0); }
__device__ __forceinline__ unsigned rk_pk(float lo, float hi) { typedef float f2_ __attribute__((ext_vector_type(2))); typedef __bf16 b2_ __attribute__((ext_vector_type(2))); f2_ v = {lo, hi}; b2_ b = __builtin_convertvector(v, b2_); return __builtin_bit_cast(unsigned, b); }
__device__ __forceinline__ void rk_store_tile_lds(LAS unsigned char* base, int rs, int nrow, int mbase, int h, const rk_f32x16& acc) {
#pragma unroll
    for (int g = 0; g < 4; ++g) { v2u w; w.x = rk_pk(acc[4 * g], acc[4 * g + 1]); w.y = rk_pk(acc[4 * g + 2], acc[4 * g + 3]); *(LAS v2u*)(base + nrow * rs + (mbase + 8 * g + 4 * h) * 2) = w; }
}
__device__ __forceinline__ void rk_store_tile_glb(bf16* base, int pitch, int nrow, int mbase, int h, const rk_f32x16& acc) {
#pragma unroll
    for (int g = 0; g < 4; ++g) { v2u w; w.x = rk_pk(acc[4 * g], acc[4 * g + 1]); w.y = rk_pk(acc[4 * g + 2], acc[4 * g + 3]); *(GAS v2u*)(base + (size_t)nrow * pitch + mbase + 8 * g + 4 * h) = w; }
}
__device__ __forceinline__ void rk_store_tile_frag(unsigned char* base, int nt, int r32, int mt, int h, const rk_f32x16& acc) {
#pragma unroll
    for (int g = 0; g < 4; ++g) { v2u w; w.x = rk_pk(acc[4 * g], acc[4 * g + 1]); w.y = rk_pk(acc[4 * g + 2], acc[4 * g + 3]);
        *(GAS v2u*)(base + ((size_t)((nt * 4 + 2 * mt + (g >> 1)) * 64 + r32 + 32 * (g & 1))) * 16 + 8 * h) = w; }
}
__device__ __forceinline__ void rk_store_blob(unsigned* blob, int lane, const rk_f32x16& acc) {
    v4u w0, w1; w0.x = rk_pk(acc[0], acc[1]); w0.y = rk_pk(acc[2], acc[3]); w0.z = rk_pk(acc[4], acc[5]); w0.w = rk_pk(acc[6], acc[7]);
    w1.x = rk_pk(acc[8], acc[9]); w1.y = rk_pk(acc[10], acc[11]); w1.z = rk_pk(acc[12], acc[13]); w1.w = rk_pk(acc[14], acc[15]);
    *(GAS v4u*)(blob + lane * 8) = w0; *(GAS v4u*)(blob + lane * 8 + 4) = w1;
}
struct RkBlob { v4u w0, w1; };
__device__ __forceinline__ RkBlob rk_load_blob(const unsigned* blob, int lane) { RkBlob b; b.w0 = *(const GAS v4u*)(blob + lane * 8); b.w1 = *(const GAS v4u*)(blob + lane * 8 + 4); return b; }
__device__ __forceinline__ rk_f32x16 rk_blob_f32(const RkBlob& b) {
    rk_f32x16 a; const unsigned w[8] = {b.w0.x, b.w0.y, b.w0.z, b.w0.w, b.w1.x, b.w1.y, b.w1.z, b.w1.w};
#pragma unroll
    for (int i = 0; i < 8; ++i) { a[2 * i] = bflo(w[i]); a[2 * i + 1] = bfhi(w[i]); }
    return a;
}

struct RkRaw { unsigned short r[8], k[8], v[8], a[8]; float d[8]; };
__device__ __forceinline__ void rk_load8(RkRaw& R, const bf16* prkv, const float* pdec, const bf16* paa) {
#pragma unroll
    for (int j = 0; j < 8; ++j) { R.r[j] = *(const GAS bf16*)(prkv + j * 1536); R.k[j] = *(const GAS bf16*)(prkv + j * 1536 + 512); R.v[j] = *(const GAS bf16*)(prkv + j * 1536 + 1024);
        R.d[j] = *(const GAS float*)(pdec + j * 512); R.a[j] = *(const GAS bf16*)(paa + j * 512); }
}
__device__ __forceinline__ void rwkvA_unit(LAS unsigned char* L, const InTab& A, unsigned char* ws, int bh, int chunk, int lane_in) {
    int lane = lane_in; asm volatile("" : "+v"(lane));
    const int b = bh >> 3, hd = bh & 7, cg = hd * 64 + lane, r32 = lane & 31, h = lane >> 5;
    const size_t row0 = (size_t)b * SEQ + (size_t)chunk * 32;
    const int uh = bh * 32 + (chunk & 31);
    const bf16* prkv = (const bf16*)(ws + WS_RKV) + row0 * 1536 + cg; const float* pdec = (const float*)(ws + WS_DEC) + row0 * 512 + cg; const bf16* paa = (const bf16*)(ws + WS_AA) + row0 * 512 + cg;
    float* pbon = (float*)(ws + WS_BON) + row0 * 8 + hd;
    const float mu_r = A[I_MU][cg], mu_k = A[I_MU][512 + cg], mu_v = A[I_MU][1024 + cg], kkc = A[I_KK][cg], kac = A[I_KA][cg], rkc = A[I_RK][cg];
    const int myv = (int)(red4(0.f, 1.f, 2.f, 3.f) * (1.0f / 64.0f) + 0.5f);
    const int L0 = __builtin_ctzll(__ballot(myv == 0)), L1 = __builtin_ctzll(__ballot(myv == 1)), L2 = __builtin_ctzll(__ballot(myv == 2)), L3 = __builtin_ctzll(__ballot(myv == 3));
    float rp = 0.f, kp = 0.f, vp = 0.f;
    if (chunk != 0) { rp = bf1(*(const GAS bf16*)(prkv - 1536)); kp = bf1(*(const GAS bf16*)(prkv - 1536 + 512)); vp = bf1(*(const GAS bf16*)(prkv - 1536 + 1024)); }
    float G = 1.0f;
    RkRaw Rc, Rn; rk_load8(Rc, prkv, pdec, paa);
#pragma unroll 1
    for (int q = 0; q < 4; ++q) {
        prkv += 8 * 1536; pdec += 8 * 512; paa += 8 * 512;
        if (q < 3) rk_load8(Rn, prkv, pdec, paa);
        LAS unsigned char* Lr = L + (8 * q) * RKA_RS_K + lane * 2;
        LAS unsigned char* Lt = L + lane * RKA_RS_J + (8 * q) * 2;
        unsigned tA[4], tB[4], tK[4], tV[4], pA = 0, pB = 0, pK = 0, pV = 0;
        float rs_[8], kx_[8], kkr_[8], a8_[8], w8_[8], vs_[8];
#pragma unroll
        for (int j = 0; j < 8; ++j) {
            const float rc = bf1(Rc.r[j]), kc = bf1(Rc.k[j]), vc = bf1(Rc.v[j]);
            const float ks = kc + (kp - kc) * mu_k; rs_[j] = rc + (rp - rc) * mu_r; vs_[j] = vc + (vp - vc) * mu_v; rp = rc; kp = kc; vp = vc;
            kkr_[j] = ks * kkc; a8_[j] = __builtin_amdgcn_rcpf(1.0f + __expf(-bf1(Rc.a[j]))); kx_[j] = ks * (1.0f + (a8_[j] - 1.0f) * kac);
            w8_[j] = __expf(-0.6065306597f * __builtin_amdgcn_rcpf(1.0f + __expf(-Rc.d[j])));
        }
        float n2_[8], bon_[8];
#pragma unroll
        for (int j = 0; j < 8; j += 2) {
            const float t = red4(kkr_[j] * kkr_[j], kkr_[j + 1] * kkr_[j + 1], rs_[j] * kx_[j] * rkc, rs_[j + 1] * kx_[j + 1] * rkc);
            n2_[j] = __builtin_bit_cast(float, __builtin_amdgcn_readlane(__builtin_bit_cast(int, t), L0)); n2_[j + 1] = __builtin_bit_cast(float, __builtin_amdgcn_readlane(__builtin_bit_cast(int, t), L1));
            bon_[j] = __builtin_bit_cast(float, __builtin_amdgcn_readlane(__builtin_bit_cast(int, t), L2)); bon_[j + 1] = __builtin_bit_cast(float, __builtin_amdgcn_readlane(__builtin_bit_cast(int, t), L3));
        }
        if (lane < 8) { float bv = bon_[0];
#pragma unroll
            for (int j = 1; j < 8; ++j) bv = (lane == j) ? bon_[j] : bv;
            *(GAS float*)(pbon + (8 * q + lane) * 8) = bv; }
#pragma unroll
        for (int j = 0; j < 8; ++j) {
            const float kk = kkr_[j] * __builtin_amdgcn_rsqf(__builtin_fmaxf(n2_[j], 1e-24f));
            const float Gprev = G; G *= w8_[j]; const float iG = __builtin_amdgcn_rcpf(G);
            const bf16 at = (bf16)f2bf(-kk * Gprev), rt = (bf16)f2bf(rs_[j] * G), bt = (bf16)f2bf(kk * a8_[j] * iG), kt = (bf16)f2bf(kx_[j] * iG), vb = (bf16)f2bf(vs_[j]);
            *(LAS bf16*)(Lr + RKA_A + j * RKA_RS_K) = at; *(LAS bf16*)(Lr + RKA_R + j * RKA_RS_K) = rt; *(LAS bf16*)(Lr + RKA_B + j * RKA_RS_K) = bt; *(LAS bf16*)(Lr + RKA_K + j * RKA_RS_K) = kt;
            if (j & 1) { tA[j >> 1] = pA | ((unsigned)at << 16); tB[j >> 1] = pB | ((unsigned)bt << 16); tK[j >> 1] = pK | ((unsigned)kt << 16); tV[j >> 1] = pV | ((unsigned)vb << 16); } else { pA = at; pB = bt; pK = kt; pV = vb; }
        }
        *(LAS v4u*)(Lt + RKA_AT) = (v4u){tA[0], tA[1], tA[2], tA[3]}; *(LAS v4u*)(Lt + RKA_BH) = (v4u){tB[0], tB[1], tB[2], tB[3]}; *(LAS v4u*)(Lt + RKA_KH) = (v4u){tK[0], tK[1], tK[2], tK[3]}; *(LAS v4u*)(Lt + RKA_VT) = (v4u){tV[0], tV[1], tV[2], tV[3]};
        Rc = Rn;
    }
    const float GC = G;
    *(GAS float*)((float*)(ws + WS_GC) + (size_t)uh * 64 + lane) = GC;
    *(LAS float*)(L + RKA_GC + lane * 4) = GC;
    LDS_WAIT(); asm volatile("" ::: "memory");
    {
        rk_f32x16 aN = {}, aAK = {}, aRB = {}, aRK = {};
#pragma unroll
        for (int s = 0; s < 4; ++s) {
            const rk_bf16x8 fA = rk_frag(L + RKA_A, RKA_RS_K, r32, s, h), fR = rk_frag(L + RKA_R, RKA_RS_K, r32, s, h), fB = rk_frag(L + RKA_B, RKA_RS_K, r32, s, h), fK = rk_frag(L + RKA_K, RKA_RS_K, r32, s, h);
            aN = rk_mfma(fB, fA, aN); aAK = rk_mfma(fK, fA, aAK); aRB = rk_mfma(fB, fR, aRB); aRK = rk_mfma(fK, fR, aRK);
        }
        LDS_WAIT(); asm volatile("" ::: "memory");
#pragma unroll
        for (int i = 0; i < 16; ++i) { const int j = (i & 3) + 8 * (i >> 2) + 4 * h;
            if (!(j < r32)) { aN[i] = 0.f; aAK[i] = 0.f; }
            if (!(j <= r32)) { aRB[i] = 0.f; aRK[i] = 0.f; } }
#pragma unroll
        for (int g = 0; g < 4; ++g) *(LAS f32x4*)(L + RKA_N + r32 * 144 + (8 * g + 4 * h) * 4) = (f32x4){aN[4 * g], aN[4 * g + 1], aN[4 * g + 2], aN[4 * g + 3]};
        rk_store_tile_lds(L + RKA_MAK, RKA_RS_J, r32, 0, h, aAK); rk_store_tile_lds(L + RKA_MRB, RKA_RS_J, r32, 0, h, aRB); rk_store_tile_lds(L + RKA_MRK, RKA_RS_J, r32, 0, h, aRK);
        rk_store_tile_lds(L + RKA_T, RKA_RS_J, r32, 0, h, aN);
    }
    LDS_WAIT(); asm volatile("" ::: "memory");
    {
        const int blk = (r32 >> 4) & 1, cc = r32 & 15;
        const LAS unsigned char* Nb = L + RKA_N + (16 * blk) * 144 + (16 * blk) * 4;
        float T[16];
#pragma unroll
        for (int t = 0; t < 16; ++t) { float ac[4] = {(cc == t) ? 1.0f : 0.0f, 0.f, 0.f, 0.f};
#pragma unroll
            for (int j4 = 0; j4 < (t + 3) / 4; ++j4) { const f32x4 n4 = *(const LAS f32x4*)(Nb + t * 144 + j4 * 16);
#pragma unroll
                for (int e = 0; e < 4; ++e) if (4 * j4 + e < t) ac[e] += n4[e] * T[4 * j4 + e]; }
            T[t] = (ac[0] + ac[1]) + (ac[2] + ac[3]); }
        LDS_WAIT(); asm volatile("" ::: "memory");
#pragma unroll
        for (int t = 0; t < 16; ++t) *(LAS bf16*)(L + RKA_T + (16 * blk + t) * RKA_RS_J + r32 * 2) = (bf16)f2bf(T[t]);
        if (blk == 0) { LAS v4u* p = (LAS v4u*)(L + RKA_N + cc * RKA_RS_J);
            p[0] = (v4u){pk2(T[0], T[1]), pk2(T[2], T[3]), pk2(T[4], T[5]), pk2(T[6], T[7])}; p[1] = (v4u){pk2(T[8], T[9]), pk2(T[10], T[11]), pk2(T[12], T[13]), pk2(T[14], T[15])}; }
        LDS_WAIT(); asm volatile("" ::: "memory");
        rk_f32x16 xa = {};
        xa = rk_mfma(*(const LAS rk_bf16x8*)(L + RKA_T + (16 + r32) * RKA_RS_J + 16 * h), *(const LAS rk_bf16x8*)(L + RKA_N + r32 * RKA_RS_J + 16 * h), xa);
        if (r32 < 16) {
#pragma unroll
            for (int g = 0; g < 2; ++g) { v2u w; w.x = rk_pk(xa[4 * g], xa[4 * g + 1]); w.y = rk_pk(xa[4 * g + 2], xa[4 * g + 3]); *(LAS v2u*)(L + RKA_N + 1280 + r32 * RKA_RS_J + (8 * g + 4 * h) * 2) = w; } }
        LDS_WAIT(); asm volatile("" ::: "memory");
        rk_f32x16 ta = {};
        ta = rk_mfma(*(const LAS rk_bf16x8*)(L + RKA_N + 1280 + r32 * RKA_RS_J + 16 * h), *(const LAS rk_bf16x8*)(L + RKA_T + (16 + r32) * RKA_RS_J + (16 + 8 * h) * 2), ta);
        LDS_WAIT(); asm volatile("" ::: "memory");
        if (r32 < 16) {
#pragma unroll
            for (int g = 0; g < 2; ++g) { v2u w; w.x = rk_pk(ta[4 * g], ta[4 * g + 1]); w.y = rk_pk(ta[4 * g + 2], ta[4 * g + 3]); *(LAS v2u*)(L + RKA_T + (16 + r32) * RKA_RS_J + (8 * g + 4 * h) * 2) = w; } }
    }
    LDS_WAIT(); asm volatile("" ::: "memory");
    rk_bf16x8 fT[2];
#pragma unroll
    for (int s = 0; s < 2; ++s) fT[s] = rk_frag(L + RKA_T, RKA_RS_J, r32, s, h);
    {
        rk_f32x16 x0[2] = {{}, {}}, ap[2] = {{}, {}};
#pragma unroll
        for (int s = 0; s < 2; ++s) { const rk_bf16x8 fM = rk_frag(L + RKA_MAK, RKA_RS_J, r32, s, h);
#pragma unroll
            for (int nt = 0; nt < 2; ++nt) { x0[nt] = rk_mfma(fM, rk_frag(L + RKA_VT, RKA_RS_J, nt * 32 + r32, s, h), x0[nt]); ap[nt] = rk_mfma(fT[s], rk_frag(L + RKA_AT, RKA_RS_J, nt * 32 + r32, s, h), ap[nt]); } }
        LDS_WAIT(); asm volatile("" ::: "memory");
#pragma unroll
        for (int nt = 0; nt < 2; ++nt) { rk_store_tile_lds(L + RKA_X, RKA_RS_J, nt * 32 + r32, 0, h, x0[nt]); rk_store_tile_lds(L + RKA_AT, RKA_RS_J, nt * 32 + r32, 0, h, ap[nt]); }
    }
    LDS_WAIT(); asm volatile("" ::: "memory");
    {
        rk_f32x16 u0[2] = {{}, {}};
#pragma unroll
        for (int s = 0; s < 2; ++s)
#pragma unroll
            for (int nt = 0; nt < 2; ++nt) u0[nt] = rk_mfma(fT[s], rk_frag(L + RKA_X, RKA_RS_J, nt * 32 + r32, s, h), u0[nt]);
        LDS_WAIT(); asm volatile("" ::: "memory");
#pragma unroll
        for (int nt = 0; nt < 2; ++nt) rk_store_tile_lds(L + RKA_X, RKA_RS_J, nt * 32 + r32, 0, h, u0[nt]);
    }
    LDS_WAIT(); asm volatile("" ::: "memory");
    unsigned char* pq = ws + WS_PQ + (size_t)uh * 16384; unsigned char* ry = ws + WS_RY + (size_t)uh * 8192;
    rk_bf16x8 fRB[2], fRK[2], fAp[2][2], fBh[2][2], fKh[2][2], fU[2][2], fV[2][2];
#pragma unroll
    for (int s = 0; s < 2; ++s) { fRB[s] = rk_frag(L + RKA_MRB, RKA_RS_J, r32, s, h); fRK[s] = rk_frag(L + RKA_MRK, RKA_RS_J, r32, s, h);
#pragma unroll
        for (int nt = 0; nt < 2; ++nt) { fAp[nt][s] = rk_frag(L + RKA_AT, RKA_RS_J, nt * 32 + r32, s, h); fBh[nt][s] = rk_frag(L + RKA_BH, RKA_RS_J, nt * 32 + r32, s, h);
            fKh[nt][s] = rk_frag(L + RKA_KH, RKA_RS_J, nt * 32 + r32, s, h); fU[nt][s] = rk_frag(L + RKA_X, RKA_RS_J, nt * 32 + r32, s, h); fV[nt][s] = rk_frag(L + RKA_VT, RKA_RS_J, nt * 32 + r32, s, h); } }
#pragma unroll
    for (int kt = 0; kt < 2; ++kt) {
        rk_f32x16 acc;
#pragma unroll
        for (int g = 0; g < 4; ++g) { const v2u w = *(const LAS v2u*)(L + RKA_R + r32 * RKA_RS_K + (kt * 32 + 8 * g + 4 * h) * 2); acc[4 * g] = bflo(w.x); acc[4 * g + 1] = bfhi(w.x); acc[4 * g + 2] = bflo(w.y); acc[4 * g + 3] = bfhi(w.y); }
#pragma unroll
        for (int s = 0; s < 2; ++s) acc = rk_mfma(fAp[kt][s], fRB[s], acc);
        rk_store_tile_frag(ry, 0, r32, kt, h, acc);
    }
#pragma unroll
    for (int kt = 0; kt < 2; ++kt)
#pragma unroll
        for (int kq = 0; kq < 2; ++kq) { rk_f32x16 acc = {};
#pragma unroll
            for (int s = 0; s < 2; ++s) acc = rk_mfma(fAp[kq][s], fBh[kt][s], acc);
            acc = acc * *(const LAS float*)(L + RKA_GC + (kt * 32 + r32) * 4);
            rk_store_tile_frag(pq, kt, r32, kq, h, acc); }
#pragma unroll
    for (int vt = 0; vt < 2; ++vt) {
        rk_f32x16 acc = {};
#pragma unroll
        for (int s = 0; s < 2; ++s) { acc = rk_mfma(fU[vt][s], fRB[s], acc); acc = rk_mfma(fV[vt][s], fRK[s], acc); }
        rk_store_blob((unsigned*)(ry + 4096) + vt * 512, lane, acc);
    }
#pragma unroll
    for (int kt = 0; kt < 2; ++kt)
#pragma unroll
        for (int vt = 0; vt < 2; ++vt) { rk_f32x16 acc = {};
#pragma unroll
            for (int s = 0; s < 2; ++s) { acc = rk_mfma(fBh[kt][s], fU[vt][s], acc); acc = rk_mfma(fKh[kt][s], fV[vt][s], acc); }
#pragma unroll
            for (int g = 0; g < 4; ++g) { const f32x4 gq = *(const LAS f32x4*)(L + RKA_GC + (kt * 32 + 8 * g + 4 * h) * 4); acc[4 * g] *= gq[0]; acc[4 * g + 1] *= gq[1]; acc[4 * g + 2] *= gq[2]; acc[4 * g + 3] *= gq[3]; }
            rk_store_blob((unsigned*)(pq + 8192) + (kt * 2 + vt) * 512, lane, acc); }
    LDS_WAIT(); asm volatile("" ::: "memory");
}
__device__ __forceinline__ void rwkvA_phase(Frame& F, const InTab& A, int half) {
    if (F.wave >= RKA_WAVES) return;
    LAS unsigned char* L = F.lds + RING_OFF + F.wave * RKA_BYTES;
    const int gw = F.bx * RKA_WAVES + F.wave, NGW = F.G * RKA_WAVES;
    for (int u = gw; u < 64 * 32; u += NGW) rwkvA_unit(L, A, F.ws, u >> 5, half * 32 + (u & 31), F.lane);
}
constexpr int RKB_RS = 144, RKB_SBUF = 64 * RKB_RS;
__device__ __forceinline__ void rwkvB_phase(Frame& F, int bh, int half) {
    int lane = F.lane; asm volatile("" : "+v"(lane));
    const int wave = F.wave, r32 = lane & 31, h = lane >> 5;
    LAS unsigned char* SB = F.lds + RING_OFF;
    unsigned char* ws = F.ws;
    const int b = bh >> 3, hd = bh & 7;
    bf16* Y = (bf16*)(ws + WS_Y);
    const int kt = (wave >> 1) & 1, vt = wave & 1;
    float* sst = (float*)(ws + WS_SST) + (size_t)bh * 4096 + (size_t)(wave & 3) * 1024;
    rk_f32x16 st = {};
    if (wave < 4) {
        if (half != 0) {
#pragma unroll
            for (int i = 0; i < 16; ++i) st[i] = *(const GAS float*)(sst + i * 64 + lane);
        }
        rk_store_tile_lds(SB, RKB_RS, vt * 32 + r32, kt * 32, h, st);
    }
    const int uh0 = bh * 32; const bool isS = wave < 4, isY = !isS && wave < 6;
    const unsigned char* fptr = isS ? ws + WS_PQ + (size_t)uh0 * 16384 + (kt * 256 + lane) * 16 : ws + WS_RY + (size_t)uh0 * 8192 + lane * 16;
    const unsigned char* bptr = isS ? ws + WS_PQ + (size_t)uh0 * 16384 + 8192 + (kt * 2 + vt) * 2048 + lane * 32 : ws + WS_RY + (size_t)uh0 * 8192 + 4096 + vt * 2048 + lane * 32;
    const LAS unsigned char* gl = SB + 2 * RKB_SBUF + (kt * 32 + 4 * h) * 4;
    const int fstride = isS ? 16384 : 8192;
    struct Op { v4u f[4]; v4u b0, b1; };
    { const int tid_ = wave * 64 + lane; *(LAS f32x4*)(SB + 2 * RKB_SBUF + tid_ * 16) = *(const GAS f32x4*)(ws + WS_GC + (size_t)uh0 * 256 + tid_ * 16); }
    Op o0, o1, o2;
#define RKB_LOAD(O_, c) do { const unsigned char* fp_ = fptr + (size_t)(c) * fstride; const unsigned char* bp_ = bptr + (size_t)(c) * fstride; \
        _Pragma("unroll") for (int s = 0; s < 4; ++s) O_.f[s] = *(const GAS v4u*)(fp_ + 1024 * s); \
        O_.b0 = *(const GAS v4u*)bp_; O_.b1 = *(const GAS v4u*)(bp_ + 16); } while (0)
#define RKB_BAR() do { asm volatile("s_waitcnt lgkmcnt(0)" ::: "memory"); __builtin_amdgcn_s_barrier(); asm volatile("" ::: "memory"); } while (0)
#define RKB_NEXT(O_, c, AH_) RKB_LOAD(O_, ((c) + (AH_) < 32 ? (c) + (AH_) : 31))
#define RKB_STEP_S(O_, c) do { \
        const LAS unsigned char* cur = SB + ((c) & 1) * RKB_SBUF; LAS unsigned char* nxt = SB + (((c) & 1) ^ 1) * RKB_SBUF; \
        rk_bf16x8 fS[4]; _Pragma("unroll") for (int s = 0; s < 4; ++s) fS[s] = rk_frag(cur, RKB_RS, vt * 32 + r32, s, h); \
        RkBlob bb_; bb_.w0 = O_.b0; bb_.w1 = O_.b1; const rk_f32x16 q = rk_blob_f32(bb_); \
        _Pragma("unroll") for (int g = 0; g < 4; ++g) { const f32x4 gq = *(const LAS f32x4*)(gl + (c) * 256 + 32 * g); \
            st[4 * g] = st[4 * g] * gq[0] + q[4 * g]; st[4 * g + 1] = st[4 * g + 1] * gq[1] + q[4 * g + 1]; st[4 * g + 2] = st[4 * g + 2] * gq[2] + q[4 * g + 2]; st[4 * g + 3] = st[4 * g + 3] * gq[3] + q[4 * g + 3]; } \
        _Pragma("unroll") for (int s = 0; s < 4; ++s) st = rk_mfma(__builtin_bit_cast(rk_bf16x8, O_.f[s]), fS[s], st); \
        RKB_NEXT(O_, c, 5); \
        rk_store_tile_lds(nxt, RKB_RS, vt * 32 + r32, kt * 32, h, st); \
        RKB_BAR(); } while (0)
#define RKB_STEP_Y(O_, c) do { \
        const LAS unsigned char* cur = SB + ((c) & 1) * RKB_SBUF; \
        rk_bf16x8 fS[4]; _Pragma("unroll") for (int s = 0; s < 4; ++s) fS[s] = rk_frag(cur, RKB_RS, vt * 32 + r32, s, h); \
        RkBlob bb_; bb_.w0 = O_.b0; bb_.w1 = O_.b1; rk_f32x16 acc = rk_blob_f32(bb_); \
        _Pragma("unroll") for (int s = 0; s < 4; ++s) acc = rk_mfma(fS[s], __builtin_bit_cast(rk_bf16x8, O_.f[s]), acc);       \
        RKB_NEXT(O_, c, 3); \
        rk_store_tile_glb(Y + ((size_t)b * SEQ + (size_t)(half * 32 + (c)) * 32) * 512 + hd * 64, 512, r32, vt * 32, h, acc); \
        RKB_BAR(); } while (0)
    if (isY) { RKB_LOAD(o0, 0); RKB_LOAD(o1, 1); RKB_LOAD(o2, 2); }
    __syncthreads();
    if (isS) {
        Op o3, o4; RKB_LOAD(o0, 0); RKB_LOAD(o1, 1); RKB_LOAD(o2, 2); RKB_LOAD(o3, 3); RKB_LOAD(o4, 4);
#define R5S(c) RKB_STEP_S(o0, c); RKB_STEP_S(o1, (c) + 1); RKB_STEP_S(o2, (c) + 2); RKB_STEP_S(o3, (c) + 3); RKB_STEP_S(o4, (c) + 4);
        R5S(0) R5S(5) R5S(10) R5S(15) R5S(20) R5S(25)
        RKB_STEP_S(o0, 30); RKB_STEP_S(o1, 31);
#undef R5S
    } else if (isY) {
#define R3Y(c) RKB_STEP_Y(o0, c); RKB_STEP_Y(o1, (c) + 1); RKB_STEP_Y(o2, (c) + 2);
        R3Y(0) R3Y(3) R3Y(6) R3Y(9) R3Y(12) R3Y(15) R3Y(18) R3Y(21) R3Y(24) R3Y(27)
        RKB_STEP_Y(o0, 30); RKB_STEP_Y(o1, 31);
#undef R3Y
    } else {
#pragma unroll 1
        for (int c = 0; c < 32; ++c) RKB_BAR();
    }
#undef RKB_STEP_S
#undef RKB_STEP_Y
#undef RKB_NEXT
#undef RKB_BAR
#undef RKB_LOAD
    if (wave < 4 && half == 0) {
#pragma unroll
        for (int i = 0; i < 16; ++i) *(GAS float*)(sst + i * 64 + lane) = st[i];
    }
}

constexpr int NPHASE = 9;
template <int PHM> __global__ void __launch_bounds__(NWAVES * 64, 2) fwd_kernel(Args args) {
    extern __shared__ __attribute__((aligned(16))) unsigned char lds[];
    namespace cg = cooperative_groups;
    Frame F;
    F.lds = (LAS unsigned char*)lds;
    F.tid = threadIdx.x; F.lane = F.tid & 63; F.wave = __builtin_amdgcn_readfirstlane(F.tid >> 6);
    F.G = gridDim.x; F.bx = blockIdx.x;
    F.out = args.out; F.ws = args.ws;
#define PH_BEGIN InTab TAB; { ktab_t kp_ = (ktab_t)__builtin_amdgcn_kernarg_segment_ptr(); asm volatile("" : "+s"(kp_)); TAB.p = kp_; } { int t_ = threadIdx.x; asm volatile("" : "+v"(t_)); F.tid = t_; F.lane = t_ & 63; F.wave = __builtin_amdgcn_readfirstlane(t_ >> 6); } GAS unsigned char* wsg_ = (GAS unsigned char*)args.ws; asm volatile("" : "+s"(wsg_)); unsigned char* ws = (unsigned char*)wsg_; F.ws = ws; GAS bf16_t* gtg_ = (GAS bf16_t*)args.out; asm volatile("" : "+s"(gtg_)); bf16_t* GATES = (bf16_t*)gtg_; F.out = (float*)GATES; (void)GATES;
    const int lo = args.ph_lo, hi = args.ph_hi;
    XcdBarrier bar; bar.bar = nullptr; bar.x = 0; bar.st = nullptr;
    if (hi - lo > 1) {
        for (int u = threadIdx.x; u < (LDS_BYTES - 162816) / 4; u += NWAVES * 64) ((LAS unsigned*)(F.lds + 162816))[u] = 0u;
        { GAS v4u* z_ = (GAS v4u*)(args.ws + WS_CTL) + (size_t)blockIdx.x * (CTL_ZERO_BYTES / 16 / 256); for (int u = threadIdx.x; u < (int)(CTL_ZERO_BYTES / 16 / 256); u += NWAVES * 64) z_[u] = (v4u){0u, 0u, 0u, 0u}; }
        asm volatile("s_waitcnt vmcnt(0)" ::: "memory");
        __syncthreads();
        cg::this_grid().sync();
        bar = xcd_barrier_post((unsigned*)(args.ws + WS_CTL) + CW_BAR, (volatile LAS unsigned*)(F.lds + MISC_OFF) + 8);
    }
#define IN(k) (((PHM >> (k)) & 1) && lo <= (k) && (k) < hi)
#ifdef PROBE_DUP
#define REPS(k) (((k) == PROBE_DUP) ? 2 : 1)
#else
#define REPS(k) 1
#endif
#define SEAM(k) do { if (IN(k) && IN((k) + 1)) { xcd_barrier(bar); } } while (0)
    using pg8::Gemm; using pg8::StaticOrder; using pg8::EpiRow8; using pg8::bf16_t;

    if (IN(0)) for (int rep_ = 0; rep_ < REPS(0); ++rep_) { if (rep_) xcd_barrier(bar); PH_BEGIN p0_prologue(F, TAB); } SEAM(0);
    if (IN(1)) for (int rep_ = 0; rep_ < REPS(1); ++rep_) { if (rep_) xcd_barrier(bar); PH_BEGIN
        Gemm g{(const bf16_t*)(ws + WS_XN), (const bf16_t*)(ws + WS_WIN), M, D_IN, D}; StaticOrder S; S.init(M, D_IN, F.G, F.bx);
        EpiRow8<pg8::FProj> E{{ws, GATES}};
        pg8::gemm_phase<EpiRow8<pg8::FProj>, StaticOrder, PG8_ALIGN, PG8_SP2>(F.lds + RING_OFF, g, S, E);
    } SEAM(1);
    if (IN(2)) { PH_BEGIN
        constexpr int NLW = 64;
        if (F.bx >= F.G - NLW) {
            const int pm = F.bx - (F.G - NLW);
            prep1_rows(F, TAB, pm * 32, pm * 32 + 32, F.wave, NWAVES);
            asm volatile("s_waitcnt vmcnt(0)" ::: "memory"); __syncthreads();
            if (threadIdx.x == 0) { __builtin_amdgcn_fence(__ATOMIC_ACQUIRE, "agent"); asm volatile("s_waitcnt vmcnt(0)" ::: "memory"); }
            __syncthreads();
            int klora = KLORA; asm volatile("" : "+s"(klora));
            Gemm g{(const bf16_t*)(ws + WS_LIN), (const bf16_t*)(ws + WS_WL), M, NLORA, klora}; pg8::PanelOrder S{pm, NLORA / 256};
            EpiRow8<pg8::FLora> E{{ws, TAB[I_W0], TAB[I_A0]}};
            pg8::gemm_phase<EpiRow8<pg8::FLora>, pg8::PanelOrder, PG8_ALIGN, PG8_SP2>(F.lds + RING_OFF, g, S, E);
            __syncthreads();
        }
        const attn_body::AttnTensors AT{(const attn_body::bf16*)(ws + WS_Q), (const attn_body::bf16*)(ws + WS_K), (const attn_body::bf16*)(ws + WS_V), (attn_body::bf16*)(ws + WS_O)};
        attn_body::attn_phase_queue<8>((char*)lds + RING_OFF, AT, (unsigned*)(ws + WS_CTL + CTL_ATTQ), (volatile LAS unsigned*)(F.lds + MISC_OFF) + 24);
    } SEAM(2);
    if (IN(3)) for (int rep_ = 0; rep_ < REPS(3); ++rep_) { if (rep_) xcd_barrier(bar); PH_BEGIN
#pragma unroll 1
        for (int half = 0; half < 2; ++half) {
            { GAS unsigned char* w_ = (GAS unsigned char*)args.ws; asm volatile("" : "+s"(w_)); F.ws = (unsigned char*)w_; }
            rwkvA_phase(F, TAB, half);
#ifdef PROBE_DUP_RKA
            rwkvA_phase(F, TAB, half);
#endif
            xcd_barrier(bar);
            { GAS unsigned char* w_ = (GAS unsigned char*)args.ws; asm volatile("" : "+s"(w_)); F.ws = (unsigned char*)w_; }
            if (F.bx < 64) rwkvB_phase(F, F.bx, half); else late_weights(F, TAB, half, 2, 64);
#ifdef PROBE_DUP_RKB
            if (F.bx < 64) rwkvB_phase(F, F.bx, half);
#endif
            if (half == 0) xcd_barrier(bar);
        }
    } SEAM(3);
#ifdef PROBE_BARS
    for (int pb_ = 0; pb_ < PROBE_BARS; ++pb_) xcd_barrier(bar);
#endif
    if (IN(4)) for (int rep_ = 0; rep_ < REPS(4); ++rep_) { if (rep_) xcd_barrier(bar); PH_BEGIN post_phase(F, TAB); } SEAM(4);
    if (IN(5)) for (int rep_ = 0; rep_ < REPS(5); ++rep_) { if (rep_) xcd_barrier(bar); PH_BEGIN
        Gemm g{(const bf16_t*)(ws + WS_YA), (const bf16_t*)(ws + WS_WA), M, D, 1024}; StaticOrder S; S.init(M, D, F.G, F.bx);
        pg8::EpiMerge E{GATES, (bf16_t*)(ws + WS_MERGED)};
        pg8::gemm_phase<pg8::EpiMerge, StaticOrder, PG8_ALIGN, PG8_SP2>(F.lds + RING_OFF, g, S, E);
    } SEAM(5);
    if (IN(6)) for (int rep_ = 0; rep_ < REPS(6); ++rep_) { if (rep_) xcd_barrier(bar); PH_BEGIN
        Gemm g{(const bf16_t*)(ws + WS_MERGED), (const bf16_t*)(ws + WS_WO), M, D, D}; StaticOrder S; S.init(M, D, F.G, F.bx);
        pg8::EpiResNorm<0> E{TAB[I_X], F.out, (bf16_t*)(ws + WS_XN), TAB[I_NFG], (float*)(ws + WS_CTL + CTL_SS1), (unsigned*)(ws + WS_CTL + CTL_CNT1), NORM_EPS, (bf16_t*)(ws + WS_X1B)};
        pg8::gemm_phase<pg8::EpiResNorm<0>, StaticOrder, PG8_ALIGN, PG8_SP2>(F.lds + RING_OFF, g, S, E);
    } SEAM(6);
    if (IN(7)) for (int rep_ = 0; rep_ < REPS(7); ++rep_) { if (rep_) xcd_barrier(bar); PH_BEGIN
        Gemm g{(const bf16_t*)(ws + WS_XN), (const bf16_t*)(ws + WS_W1), M, FF, D}; StaticOrder S; S.init(M, FF, F.G, F.bx);
        EpiRow8<pg8::FRelu2> E{{(bf16_t*)(ws + WS_H)}};
        pg8::gemm_phase<EpiRow8<pg8::FRelu2>, StaticOrder, PG8_ALIGN, PG8_SP2>(F.lds + RING_OFF, g, S, E);
    } SEAM(7);
    if (IN(8)) for (int rep_ = 0; rep_ < REPS(8); ++rep_) { if (rep_) xcd_barrier(bar); PH_BEGIN
        Gemm g{(const bf16_t*)(ws + WS_H), (const bf16_t*)(ws + WS_W2), M, D, FF}; StaticOrder S; S.init(M, D, F.G, F.bx);
        pg8::EpiResNorm<1> E{nullptr, F.out, nullptr, TAB[I_NFIN], (float*)(ws + WS_CTL + CTL_SS2), (unsigned*)(ws + WS_CTL + CTL_CNT2), NORM_EPS, (bf16_t*)(ws + WS_X1B)};
        pg8::gemm_phase<pg8::EpiResNorm<1>, StaticOrder, PG8_ALIGN, PG8_SP2>(F.lds + RING_OFF, g, S, E);
    }
#undef IN
#undef SEAM
#undef PH_BEGIN
}


#ifdef DBG_DUMP
__global__ void dbg_dump(float* out, const unsigned char* ws) {
    const size_t i = (size_t)blockIdx.x * blockDim.x + threadIdx.x; if (i >= (size_t)M * 1024) return;
    const size_t m = i >> 10; const int c = (int)(i & 1023); float v = 0.f;
#if DBG_DUMP == 1
    v = bf1(((const bf16*)(ws + WS_O))[m * 1024 + c]);
#elif DBG_DUMP == 2
    v = c < 512 ? bf1(((const bf16*)(ws + WS_Y))[m * 512 + c]) : (c < 520 ? ((const float*)(ws + WS_BON))[m * 8 + (c - 512)] : 0.f);
#elif DBG_DUMP == 3
    v = c < 512 ? bf1(((const bf16*)(ws + WS_Q))[m * 512 + c]) : bf1(((const bf16*)(ws + WS_K))[m * 512 + c - 512]);
#elif DBG_DUMP == 4
    v = c < 512 ? ((const float*)(ws + WS_DEC))[m * 512 + c] : bf1(((const bf16*)(ws + WS_AA))[m * 512 + c - 512]);
#elif DBG_DUMP == 6
    v = c < 256 ? bf1(((const bf16*)(ws + WS_WAG))[m * 256 + c]) : (c < 512 ? bf1(((const bf16*)(ws + WS_LIN))[m * 256 + c - 256]) : 0.f);
#elif DBG_DUMP == 7
    { const bf16* wl = (const bf16*)(ws + WS_WL); const size_t j = (m * 1024 + c); v = j < (size_t)NLORA * KLORA ? bf1(wl[j]) : 0.f; }
#elif DBG_DUMP == 8
    v = c < 512 ? bf1(((const bf16*)(ws + WS_GG))[m * 512 + c]) : 0.f;
#elif DBG_DUMP == 5
    v = bf1(((const bf16*)(ws + WS_RKV))[m * 1536 + c]);
#endif
    out[i] = v;
}
#endif

#ifdef DBG_FIXLORA
__global__ void dbg_fixlora(Args A) {
    const size_t i = (size_t)blockIdx.x * blockDim.x + threadIdx.x; if (i >= (size_t)M * 512) return;
    const size_t m = i >> 9; const int c = (int)(i & 511);
    const bf16* LINr = (const bf16*)(A.ws + WS_LIN) + m * 256;
#if DBG_FIXLORA & 1
    { float g = 0.f; for (int k = 0; k < 128; ++k) g += bf1(LINr[128 + k]) * A[I_G2][(size_t)k * 512 + c]; ((bf16*)(A.ws + WS_GG))[m * 512 + c] = (bf16)f2bf(g); }
#endif
#if DBG_FIXLORA & 2
    { float s = A[I_A0][c]; for (int k = 0; k < 64; ++k) s += bf1(LINr[64 + k]) * A[I_A2][(size_t)k * 512 + c]; ((bf16*)(A.ws + WS_AA))[m * 512 + c] = (bf16)f2bf(1.0f / (1.0f + expf(-s))); }
#endif
#if DBG_FIXLORA & 4
    { float s = A[I_W0][c]; for (int k = 0; k < 64; ++k) s += bf1(LINr[k]) * A[I_W2][(size_t)k * 512 + c]; const float w = -log1pf(expf(-s)) - 0.5f; ((float*)(A.ws + WS_DEC))[m * 512 + c] = expf(-expf(w)); }
#endif
}
#endif
#ifndef MK_ONE_LAUNCH
#define MK_ONE_LAUNCH 0
#endif
#ifndef MK_MASK
#define MK_MASK ((1 << NPHASE) - 1)
#endif
typedef void (*kern_t)(Args);
template <int P> struct KTab { static void fill(kern_t* t) { t[P] = fwd_kernel<(1 << P)>; KTab<P - 1>::fill(t); } };
template <> struct KTab<-1> { static void fill(kern_t*) {} };
extern "C" void kernel_launch(void* const* d_in, const int* in_sizes, int n_in, void* d_out, int out_size, void* d_ws, size_t ws_size, hipStream_t stream) {
    static int grid = 0; static kern_t ktab[NPHASE];
    if (grid == 0) {
        if (n_in != 26 || in_sizes[0] != M * D || out_size != M * D || ws_size < WS_END) { fprintf(stderr, "kernel_launch: unexpected shapes (n_in %d, in0 %d, out %d, ws %zu); nothing launched\n", n_in, n_in > 0 ? in_sizes[0] : -1, out_size, ws_size); grid = -1; return; }
        int dev = 0, cus = 0;
        if (hipGetDevice(&dev) != hipSuccess || hipDeviceGetAttribute(&cus, hipDeviceAttributeMultiprocessorCount, dev) != hipSuccess) { grid = -1; return; }
#if MK_ONE_LAUNCH
        int per_cu = 0;
        if (hipFuncSetAttribute((const void*)fwd_kernel<MK_MASK>, hipFuncAttributeMaxDynamicSharedMemorySize, LDS_BYTES) != hipSuccess) { fprintf(stderr, "kernel_launch: hipFuncSetAttribute failed\n"); grid = -1; return; }
        if (hipOccupancyMaxActiveBlocksPerMultiprocessor(&per_cu, (const void*)fwd_kernel<MK_MASK>, NWAVES * 64, LDS_BYTES) != hipSuccess || per_cu < 1) { fprintf(stderr, "kernel_launch: occupancy query says %d blocks per CU\n", per_cu); (void)hipGetLastError(); grid = -1; return; }
#else
        KTab<NPHASE - 1>::fill(ktab);
        for (int p = 0; p < NPHASE; ++p) if (hipFuncSetAttribute((const void*)ktab[p], hipFuncAttributeMaxDynamicSharedMemorySize, LDS_BYTES) != hipSuccess) { fprintf(stderr, "kernel_launch: hipFuncSetAttribute failed\n"); grid = -1; return; }
#endif
        grid = cus;
        if (grid != 256) fprintf(stderr, "kernel_launch: note: %d CUs (built for 256)\n", grid);
    }
    if (grid < 0) return;
    Args a{};
    for (int i = 0; i < 26; ++i) a.in[i] = (const float*)d_in[i];
    a.out = (float*)d_out; a.ws = (unsigned char*)d_ws;
#if MK_ONE_LAUNCH
    a.ph_lo = 0; a.ph_hi = NPHASE;
    void* kargs[] = {&a};
    hipError_t e = hipLaunchCooperativeKernel((const void*)fwd_kernel<MK_MASK>, dim3(grid), dim3(NWAVES * 64), kargs, LDS_BYTES, stream);
    if (e != hipSuccess) fprintf(stderr, "kernel_launch: cooperative launch failed: %s\n", hipGetErrorString(e));
#else
#ifdef DBG_DUMP
    for (int p = 0; p <= DBG_STOP; ++p) { a.ph_lo = p; a.ph_hi = p + 1; hipLaunchKernelGGL(ktab[p], dim3(grid), dim3(NWAVES * 64), LDS_BYTES, stream, a); }
    hipLaunchKernelGGL(dbg_dump, dim3((M * 1024) / 256), dim3(256), 0, stream, (float*)d_out, (const unsigned char*)d_ws);
#else
    for (int p = 0; p < NPHASE; ++p) { a.ph_lo = p; a.ph_hi = p + 1; hipLaunchKernelGGL(ktab[p], dim3(grid), dim3(NWAVES * 64), LDS_BYTES, stream, a);
#ifdef DBG_FIXLORA
        if (p == 3) hipLaunchKernelGGL(dbg_fixlora, dim3((M * 512) / 256), dim3(256), 0, stream, a);
#endif
    }
#endif
#endif
}
```

```cpp
#define MK_ONE_LAUNCH 1
#include <hip/hip_runtime.h>
#include <cstdio>
#include <cstdint>
constexpr int NWAVES = 8;
constexpr int BATCH = 8, SEQ = 2048, D = 1024, M = BATCH * SEQ;
constexpr int D_IN = 5376, FF = 4096, RWW = 512, NLORA = 1536, KLORA = 256;
constexpr float NORM_EPS = 1e-6f, SUBLN_EPS = 1e-5f, GN_EPS = 64e-5f, LAMBDA_INIT = 0.2f;
constexpr size_t MiB = 1u << 20;
constexpr size_t WS_CTL = 0, CTL_ZERO_BYTES = 256 * 1024;
constexpr size_t CTL_SS1 = 65536, CTL_SS2 = 131072, CTL_CNT1 = 196608, CTL_CNT2 = 212992, CTL_ATTQ = 229376, CTL_RKAQ = 229380;
constexpr size_t WS_ROPE_C = 512 * 1024, WS_ROPE_S = 768 * 1024;
constexpr size_t WS_BON = 1 * MiB;
constexpr size_t WS_WIN = 2 * MiB;
constexpr size_t WS_WA = WS_WIN + (size_t)D_IN * D * 2;
constexpr size_t WS_WB = WS_WA + 1 * MiB;
constexpr size_t WS_WO = WS_WB + 1 * MiB;
constexpr size_t WS_W1 = WS_WO + 2 * MiB;
constexpr size_t WS_W2 = WS_W1 + 8 * MiB;
constexpr size_t WS_WL = WS_W2 + 8 * MiB;
static_assert(WS_WL + (size_t)NLORA * KLORA * 2 <= 34 * MiB, "weights");
constexpr size_t WS_XN = 34 * MiB;
constexpr size_t WS_DEC = WS_XN;
constexpr size_t WS_Q = 66 * MiB, WS_K = 82 * MiB, WS_V = 98 * MiB;
constexpr size_t WS_RKV = 114 * MiB;
constexpr size_t WS_WAG = 162 * MiB, WS_LIN = 242 * MiB;
constexpr size_t WS_Y = 162 * MiB;
constexpr size_t WS_AA = 178 * MiB, WS_GG = 194 * MiB;
constexpr size_t WS_O = 210 * MiB;
constexpr size_t WS_YA = 66 * MiB, WS_YB = 82 * MiB;
constexpr size_t WS_TMP = 114 * MiB;
constexpr size_t WS_MERGED = 114 * MiB;
constexpr size_t WS_X1B = 194 * MiB;
constexpr size_t WS_H = 66 * MiB;
constexpr size_t WS_END = 252 * MiB;
constexpr int RING_OFF = 0, RING_BYTES = 131072;
constexpr int LDS_BYTES = 163840;

#include <hip/hip_runtime.h>
#include <cstdio>
#include <cstdint>
namespace pg8 {
#define PG8_LAS __attribute__((address_space(3)))
typedef unsigned short bf16_t;
typedef short bf16x8 __attribute__((ext_vector_type(8)));
typedef float f32x4 __attribute__((ext_vector_type(4)));
typedef unsigned u32x4 __attribute__((ext_vector_type(4)));
constexpr int BM = 256, BK = 64, HALF = 128, HTB = HALF * BK * 2  , STAGE_BYTES = 8 * HTB, NXCD = 8, WGM = 8;

__host__ __device__ __forceinline__ int lds_byte(int r, int c) { const int st = (r >> 4) * 2 + (c >> 5), rr = r & 15, cc = c & 31, ob = rr * 64 + cc * 2; return st * 1024 + (ob ^ (((ob >> 9) & 1) << 5)); }
__host__ __device__ __forceinline__ void stage_rc(int b, int& R, int& C) { const int st = b / 1024, sb = b % 1024, swz = sb ^ (((sb >> 9) & 1) << 5); R = (st >> 1) * 16 + swz / 64; C = (st & 1) * 32 + (swz % 64) / 2; }
__host__ __device__ __forceinline__ int perm32(int rho) { const int n = rho >> 4, i = rho & 15; return 8 * (i >> 2) + 4 * n + (i & 3); }

struct Unit { int pm, pn; };
struct Gemm { const bf16_t* A; const bf16_t* Bt; int M, N, K; };

struct StaticOrder {
    int nM, nN, nwg, G, c;
    __host__ __device__ void init(int M, int N, int G_, int c_) { nM = M / BM; nN = N / BM; nwg = nM * nN; G = G_; c = c_; }
    __host__ __device__ bool next(int i, Unit& u) const {
        const long L = (long)i * G + c; if (L >= nwg) return false;
        int wgid = (int)L; { const int q = nwg / NXCD, r = nwg % NXCD, xcd = wgid % NXCD, off = wgid / NXCD; wgid = (xcd < r ? xcd * (q + 1) : r * (q + 1) + (xcd - r) * q) + off; }
        const int nig = WGM * nN, gid = wgid / nig, fm = gid * WGM, gsz = (nM - fm) < WGM ? (nM - fm) : WGM;
        u.pm = fm + ((wgid % nig) % gsz); u.pn = (wgid % nig) / gsz; return true;
    }
    __device__ __forceinline__ void a_ready(const Unit&) const {}
    __device__ __forceinline__ void done(const Unit&) const {}
};

typedef float f32x2c_t __attribute__((ext_vector_type(2))); typedef __bf16 bf16x2c_t __attribute__((ext_vector_type(2)));
__device__ __forceinline__ unsigned cvt_pk_bf16(float lo, float hi) { f32x2c_t v = {lo, hi}; bf16x2c_t b = __builtin_convertvector(v, bf16x2c_t); return __builtin_bit_cast(unsigned, b); }
typedef float f32x2 __attribute__((ext_vector_type(2)));
__device__ __forceinline__ f32x2 gelu_pk(f32x2 v) {
    const f32x2 av = __builtin_elementwise_abs(v), d = av * 0.2316418882f + 1.0f;
    f32x2 t; t.x = __builtin_amdgcn_rcpf(d.x); t.y = __builtin_amdgcn_rcpf(d.y);
    f32x2 q = t * 0.5307027145f + (-0.7265760135f); q = q * t + 0.7107068705f; q = q * t + (-0.142248368f); q = q * t + 0.127414796f; q = q * t;
    const f32x2 s = (v * v) * (-0.72134752044f);
    f32x2 e; e.x = __builtin_amdgcn_exp2f(s.x); e.y = __builtin_amdgcn_exp2f(s.y);
    const f32x2 m = v * (q * e), r = v - m;
    f32x2 o; o.x = v.x < 0.f ? m.x : r.x; o.y = v.y < 0.f ? m.y : r.y; return o;
}

template <int ACT  > struct EpiBf16 {
    static constexpr int MIDK = 0; static constexpr bool PERM = true, AFTER_DRAIN = false; static_assert(ACT == 0 || ACT == 1, "EpiBf16: ACT is 0 (none) or 1 (gelu_pk)");
    bf16_t* O; int ldc; const float* bias; int split_cols; size_t split_stride; float scale0;
    __device__ __forceinline__ void operator()(const f32x4 (&acc)[2][2][4][2], const Unit& u, int wr, int wc, int fr, int fq) const {
        const int row0 = u.pm * BM + wr * 64 + fr; int colt = u.pn * BM; bf16_t* base = O;
        float sc = 1.f; if (split_cols) { const int t = colt / split_cols; base += (size_t)t * split_stride; colt -= t * split_cols; if (t == 0) sc = scale0; }
        const int col0 = colt + wc * 32 + 8 * fq, bcol0 = u.pn * BM + wc * 32 + 8 * fq;
        f32x4 bv[2][2];
#pragma unroll
        for (int bj = 0; bj < 2; ++bj)
#pragma unroll
            for (int n = 0; n < 2; ++n) bv[bj][n] = bias ? *(const f32x4*)(bias + bcol0 + bj * HALF + 4 * n) : (f32x4){0.f, 0.f, 0.f, 0.f};
#pragma unroll
        for (int ai = 0; ai < 2; ++ai)
#pragma unroll
            for (int m = 0; m < 4; ++m) { bf16_t* rowp = base + (size_t)(row0 + ai * HALF + m * 16) * ldc + col0;
#pragma unroll
                for (int bj = 0; bj < 2; ++bj) { f32x4 v0 = acc[ai][bj][m][0] + bv[bj][0], v1 = acc[ai][bj][m][1] + bv[bj][1];
                    if (ACT == 1) { f32x2 a = gelu_pk((f32x2){v0[0], v0[1]}), b = gelu_pk((f32x2){v0[2], v0[3]}), c = gelu_pk((f32x2){v1[0], v1[1]}), d = gelu_pk((f32x2){v1[2], v1[3]});
                        v0 = (f32x4){a.x, a.y, b.x, b.y}; v1 = (f32x4){c.x, c.y, d.x, d.y}; }
                    v0 = v0 * sc; v1 = v1 * sc; u32x4 w; w.x = cvt_pk_bf16(v0[0], v0[1]); w.y = cvt_pk_bf16(v0[2], v0[3]); w.z = cvt_pk_bf16(v1[0], v1[1]); w.w = cvt_pk_bf16(v1[2], v1[3]);
                    *(u32x4*)(rowp + bj * HALF) = w; } }
    }
};
typedef unsigned u32x2 __attribute__((ext_vector_type(2)));
__device__ __forceinline__ float bf_lo(unsigned w) { return __builtin_bit_cast(float, w << 16); }
__device__ __forceinline__ float bf_hi(unsigned w) { return __builtin_bit_cast(float, w & 0xffff0000u); }
__device__ __forceinline__ u32x4 pack8(f32x4 v0, f32x4 v1) { u32x4 w; w.x = cvt_pk_bf16(v0[0], v0[1]); w.y = cvt_pk_bf16(v0[2], v0[3]); w.z = cvt_pk_bf16(v1[0], v1[1]); w.w = cvt_pk_bf16(v1[2], v1[3]); return w; }
__device__ __forceinline__ float sigmoidf_(float x) { return __builtin_amdgcn_rcpf(1.0f + __expf(-x)); }
template <class F> struct EpiRow8 {
    static constexpr int MIDK = 0; static constexpr bool PERM = true, AFTER_DRAIN = false;
    F f;
    __device__ __forceinline__ void operator()(const f32x4 (&acc)[2][2][4][2], const Unit& u, int wr, int wc, int fr, int fq) const {
        const int row0 = u.pm * BM + wr * 64 + fr, c0 = wc * 32 + 8 * fq;
#pragma unroll
        for (int ai = 0; ai < 2; ++ai)
#pragma unroll
            for (int m = 0; m < 4; ++m) { const int row = row0 + ai * HALF + m * 16;
#pragma unroll
                for (int bj = 0; bj < 2; ++bj) { f(u.pn, row, c0 + bj * HALF, acc[ai][bj][m][0], acc[ai][bj][m][1]); if (F::FENCE) asm volatile("" ::: "memory"); } }
    }
};
constexpr float ATT_C2 = 0.125f * 1.4426950408889634f;
struct FProj {
    static constexpr bool FENCE = false;
    unsigned char* ws; bf16_t* GATES;
    __device__ __forceinline__ void operator()(int pn, int row, int cu, f32x4 v0, f32x4 v1) const {
        if (pn < 4) {
            const int sh = cu >> 6, j = (cu & 63) >> 3, pos = row & 2047;
            const f32x4 c = *(const f32x4*)((const float*)(ws + WS_ROPE_C) + pos * 32 + 4 * j), s = *(const f32x4*)((const float*)(ws + WS_ROPE_S) + pos * 32 + 4 * j);
            const float sc = pn < 2 ? ATT_C2 : 1.0f;
            const f32x4 o1 = (v0 * c - v1 * s) * sc, o2 = (v1 * c + v0 * s) * sc;
            bf16_t* dst = (bf16_t*)(ws + (pn < 2 ? WS_Q : WS_K)) + (size_t)row * 512 + (pn & 1) * 256 + sh * 64 + 4 * j;
            u32x2 w1, w2; w1.x = cvt_pk_bf16(o1[0], o1[1]); w1.y = cvt_pk_bf16(o1[2], o1[3]); w2.x = cvt_pk_bf16(o2[0], o2[1]); w2.y = cvt_pk_bf16(o2[2], o2[3]);
            *(u32x2*)dst = w1; *(u32x2*)(dst + 32) = w2;
        } else if (pn < 13) {
            size_t off; int pitch, col;
            if (pn < 6) { off = WS_V; pitch = 512; col = (pn - 4) * 256; }
            else if (pn < 12) { off = WS_RKV; pitch = 1536; col = (pn - 6) * 256; }
            else { off = WS_WAG; pitch = 256; col = 0; }
            *(u32x4*)((bf16_t*)(ws + off) + (size_t)row * pitch + col + cu) = pack8(v0, v1);
        } else *(u32x4*)(GATES + (size_t)row * 2048 + (pn - 13) * 256 + cu) = pack8(v0, v1);
    }
};
struct FLora {
    static constexpr bool FENCE = false;
    unsigned char* ws; const float *w0, *a0;
    __device__ __forceinline__ void operator()(int pn, int row, int cu, f32x4 v0, f32x4 v1) const {
        const int c = (pn & 1) * 256 + cu;
        if (pn < 2) {
            const f32x4 b0 = *(const f32x4*)(w0 + c), b1 = *(const f32x4*)(w0 + c + 4);
            float* dst = (float*)(ws + WS_DEC) + (size_t)row * 512 + c; *(f32x4*)dst = v0 + b0; *(f32x4*)(dst + 4) = v1 + b1;
        } else if (pn < 4) {
            const f32x4 b0 = *(const f32x4*)(a0 + c), b1 = *(const f32x4*)(a0 + c + 4);
            *(u32x4*)((bf16_t*)(ws + WS_AA) + (size_t)row * 512 + c) = pack8(v0 + b0, v1 + b1);
        } else *(u32x4*)((bf16_t*)(ws + WS_GG) + (size_t)row * 512 + c) = pack8(v0, v1);
    }
};
struct FLoraG {
    static constexpr bool FENCE = false;
    unsigned char* ws;
    __device__ __forceinline__ void operator()(int pn, int row, int cu, f32x4 v0, f32x4 v1) const { *(u32x4*)((bf16_t*)(ws + WS_GG) + (size_t)row * 512 + pn * 256 + cu) = pack8(v0, v1); }
};
struct EpiMerge {
    static constexpr int MIDK = 8; static constexpr bool PERM = true, AFTER_DRAIN = false;
    const bf16_t* GATES; bf16_t* MERGED;
    static __device__ __forceinline__ float ratio_(float ga, float gb) { return (1.0f + __expf(-gb)) * __builtin_amdgcn_rcpf(1.0f + __expf(-ga)); }
    __device__ __forceinline__ void mid(f32x4 (&acc)[2][2][4][2], const Unit& u, int wr, int wc, int fr, int fq) const {
        int fr_ = fr; asm volatile("" : "+v"(fr_));
        const bf16_t* gp0 = GATES + (size_t)(u.pm * BM + wr * 64 + fr_) * 2048 + u.pn * BM + wc * 32 + 8 * fq;
#pragma unroll
        for (int ai = 0; ai < 2; ++ai)
#pragma unroll
            for (int m = 0; m < 4; ++m)
#pragma unroll
                for (int bj = 0; bj < 2; ++bj) { const bf16_t* gp = gp0 + (size_t)(ai * HALF + m * 16) * 2048 + bj * HALF;
                    const u32x4 ga = *(const u32x4*)gp, gb = *(const u32x4*)(gp + 1024);
                    f32x4& v0 = acc[ai][bj][m][0]; f32x4& v1 = acc[ai][bj][m][1];
                    v0[0] *= ratio_(bf_lo(ga.x), bf_lo(gb.x)); v0[1] *= ratio_(bf_hi(ga.x), bf_hi(gb.x)); v0[2] *= ratio_(bf_lo(ga.y), bf_lo(gb.y)); v0[3] *= ratio_(bf_hi(ga.y), bf_hi(gb.y));
                    v1[0] *= ratio_(bf_lo(ga.z), bf_lo(gb.z)); v1[1] *= ratio_(bf_hi(ga.z), bf_hi(gb.z)); v1[2] *= ratio_(bf_lo(ga.w), bf_lo(gb.w)); v1[3] *= ratio_(bf_hi(ga.w), bf_hi(gb.w));
                    asm volatile("" ::: "memory"); }
    }
    __device__ __forceinline__ void operator()(const f32x4 (&acc)[2][2][4][2], const Unit& u, int wr, int wc, int fr, int fq) const {
        const int row0 = u.pm * BM + wr * 64 + fr, c0 = u.pn * BM + wc * 32 + 8 * fq;
#pragma unroll
        for (int ai = 0; ai < 2; ++ai)
#pragma unroll
            for (int m = 0; m < 4; ++m) { const int row = row0 + ai * HALF + m * 16;
#pragma unroll
                for (int bj = 0; bj < 2; ++bj) { const u32x4 g = *(const u32x4*)(GATES + (size_t)row * 2048 + 1024 + c0 + bj * HALF);
                    f32x4 v0 = acc[ai][bj][m][0], v1 = acc[ai][bj][m][1];
                    v0[0] *= sigmoidf_(bf_lo(g.x)); v0[1] *= sigmoidf_(bf_hi(g.x)); v0[2] *= sigmoidf_(bf_lo(g.y)); v0[3] *= sigmoidf_(bf_hi(g.y));
                    v1[0] *= sigmoidf_(bf_lo(g.z)); v1[1] *= sigmoidf_(bf_hi(g.z)); v1[2] *= sigmoidf_(bf_lo(g.w)); v1[3] *= sigmoidf_(bf_hi(g.w));
                    *(u32x4*)(MERGED + (size_t)row * 1024 + c0 + bj * HALF) = pack8(v0, v1); } }
    }
};
struct FRes {
    static constexpr bool FENCE = false;
    const float* base; float* out;
    __device__ __forceinline__ void operator()(int pn, int row, int cu, f32x4 v0, f32x4 v1) const {
        const size_t off = (size_t)row * 1024 + pn * 256 + cu; const f32x4 b0 = *(const f32x4*)(base + off), b1 = *(const f32x4*)(base + off + 4);
        *(f32x4*)(out + off) = b0 + v0; *(f32x4*)(out + off + 4) = b1 + v1;
    }
};
struct FRelu2 {
    static constexpr bool FENCE = false;
    bf16_t* H;
    __device__ __forceinline__ void operator()(int pn, int row, int cu, f32x4 v0, f32x4 v1) const {
        f32x4 r0, r1;
#pragma unroll
        for (int e = 0; e < 4; ++e) { const float a = __builtin_fmaxf(v0[e], 0.f), b = __builtin_fmaxf(v1[e], 0.f); r0[e] = a * a; r1[e] = b * b; }
        *(u32x4*)(H + (size_t)row * 4096 + pn * 256 + cu) = pack8(r0, r1);
    }
};

__device__ __forceinline__ float xsum_fq(float x) {
    { auto r = __builtin_amdgcn_permlane16_swap(__builtin_bit_cast(unsigned, x), __builtin_bit_cast(unsigned, x), false, false); const unsigned a = r[0], b = r[1]; x = __builtin_bit_cast(float, a) + __builtin_bit_cast(float, b); }
    { auto r = __builtin_amdgcn_permlane32_swap(__builtin_bit_cast(unsigned, x), __builtin_bit_cast(unsigned, x), false, false); const unsigned a = r[0], b = r[1]; x = __builtin_bit_cast(float, a) + __builtin_bit_cast(float, b); }
    return x;
}
template <int MODE> struct EpiResNorm {
    static constexpr int MIDK = 0; static constexpr bool PERM = true, AFTER_DRAIN = false;
    const float* base; float* out; bf16_t* xn; const float* g; float* ss; unsigned* cnt; float eps; bf16_t* x1b;
    __device__ __forceinline__ void operator()(f32x4 (&acc)[2][2][4][2], const Unit& u, int wr, int wc, int fr, int fq) const {
        const int row0 = u.pm * BM + wr * 64 + fr, c0 = u.pn * BM + wc * 32 + 8 * fq;
#pragma unroll
        for (int ai = 0; ai < 2; ++ai)
#pragma unroll
            for (int m = 0; m < 4; ++m) { const int row = row0 + ai * HALF + m * 16; float s = 0.f;
#pragma unroll
                for (int bj = 0; bj < 2; ++bj) { const size_t off = (size_t)row * 1024 + c0 + bj * HALF; f32x4 b0, b1;
                    if (MODE == 0) { b0 = *(const f32x4*)(base + off); b1 = *(const f32x4*)(base + off + 4); }
                    else { const u32x4 w = *(const u32x4*)(x1b + off); b0 = (f32x4){bf_lo(w.x), bf_hi(w.x), bf_lo(w.y), bf_hi(w.y)}; b1 = (f32x4){bf_lo(w.z), bf_hi(w.z), bf_lo(w.w), bf_hi(w.w)}; }
                    f32x4& v0 = acc[ai][bj][m][0]; f32x4& v1 = acc[ai][bj][m][1]; v0 += b0; v1 += b1;
                    if (MODE == 0) *(u32x4*)(x1b + off) = pack8(v0, v1);
                    s += (v0[0] * v0[0] + v0[1] * v0[1]) + (v0[2] * v0[2] + v0[3] * v0[3]) + (v1[0] * v1[0] + v1[1] * v1[1]) + (v1[2] * v1[2] + v1[3] * v1[3]); }
                s = xsum_fq(s);
                if (fq == 0) __hip_atomic_fetch_add(ss + row, s, __ATOMIC_RELAXED, __HIP_MEMORY_SCOPE_AGENT);
                if (m & 1) asm volatile("" ::: "memory"); }
        asm volatile("s_waitcnt vmcnt(0)" ::: "memory");
        unsigned* c_ = cnt + 64 * u.pm;
        if (fr == 0 && fq == 0) __hip_atomic_fetch_add(c_, 1u, __ATOMIC_RELAXED, __HIP_MEMORY_SCOPE_AGENT);
        { unsigned spins = 0; while ((unsigned)__builtin_amdgcn_readfirstlane(__hip_atomic_load(c_, __ATOMIC_RELAXED, __HIP_MEMORY_SCOPE_AGENT)) < 32u && ++spins < (1u << 22)) __builtin_amdgcn_s_sleep(2); }
        asm volatile("" ::: "memory");
#pragma unroll
        for (int ai = 0; ai < 2; ++ai)
#pragma unroll
            for (int m = 0; m < 4; ++m) { const int row = row0 + ai * HALF + m * 16;
                const float rstd = 1.0f / sqrtf(__hip_atomic_load(ss + row, __ATOMIC_RELAXED, __HIP_MEMORY_SCOPE_AGENT) * (1.0f / 1024.0f) + eps);
#pragma unroll
                for (int bj = 0; bj < 2; ++bj) { const size_t off = (size_t)row * 1024 + c0 + bj * HALF; const f32x4 g0 = *(const f32x4*)(g + c0 + bj * HALF), g1 = *(const f32x4*)(g + c0 + bj * HALF + 4);
                    const f32x4 o0 = acc[ai][bj][m][0] * rstd * g0, o1 = acc[ai][bj][m][1] * rstd * g1;
                    if (MODE == 0) *(u32x4*)(xn + off) = pack8(o0, o1); else { *(f32x4*)(out + off) = o0; *(f32x4*)(out + off + 4) = o1; } }
                if (m & 1) asm volatile("" ::: "memory"); }
    }
};

struct PanelOrder {
    int pm, ntiles;
    __device__ __forceinline__ bool next(int i, Unit& u) const { if (i >= ntiles) return false; int p = pm; asm volatile("" : "+s"(p)); u.pm = p; u.pn = i; return true; }
    __device__ __forceinline__ void a_ready(const Unit&) const {}
    __device__ __forceinline__ void done(const Unit&) const {}
};
template <class Epi, class Sched, bool ALIGN_EPI = false, bool SP2 = false>
__device__ __forceinline__ void gemm_phase(PG8_LAS unsigned char* lds, const Gemm g, const Sched& S, const Epi& E) {
    int tid_ = threadIdx.x; asm volatile("" : "+v"(tid_));
    const int tid = tid_, wid = __builtin_amdgcn_readfirstlane(tid >> 6), lane = tid & 63, wr = wid >> 2, wc = wid & 3, fr = lane & 15, fq = lane >> 4;
    const int K = g.K, nt = K / BK;
    unsigned voffA[2], voffB[2];
#pragma unroll
    for (int i = 0; i < 2; ++i) { int R, C; stage_rc(tid * 16 + i * 8192, R, C); const int Rb = Epi::PERM ? ((R & ~31) + perm32(R & 31)) : R;
        voffA[i] = (unsigned)(R * K + C) * 2u; voffB[i] = (unsigned)(Rb * K + C) * 2u; }
    const size_t kstep = (size_t)(BK * 2);
    const size_t hstep = (size_t)HALF * K * 2;
    const size_t tstep = 2 * hstep;
    const unsigned ldsw = (unsigned)wid * 1024u;
    const int aoff = lds_byte(wr * 64 + fr, fq * 8), boff = lds_byte(wc * 32 + fr, fq * 8);
#define PG8_SA(b, h) (((b) * 2 + (h)) * HTB)
#define PG8_SB(b, h) ((4 + (b) * 2 + (h)) * HTB)
#define PG8_STAGE(bufoff, gbase, voff) do { _Pragma("unroll") for (int _i = 0; _i < 2; ++_i) \
        __builtin_amdgcn_global_load_lds((const unsigned*)((const char*)(gbase) + (voff)[_i]), (PG8_LAS unsigned*)(lds + (bufoff) + ldsw + _i * 8192), 16, 0, 0); } while (0)
#define PG8_LDA(dst, b, h) do { _Pragma("unroll") for (int m = 0; m < 4; ++m) _Pragma("unroll") for (int k = 0; k < 2; ++k) dst[m][k] = *(const PG8_LAS bf16x8*)(lds + PG8_SA(b, h) + aoff + m * 2048 + k * 1024); } while (0)
#define PG8_LDB(dst, b, h) do { _Pragma("unroll") for (int n = 0; n < 2; ++n) _Pragma("unroll") for (int k = 0; k < 2; ++k) dst[n][k] = *(const PG8_LAS bf16x8*)(lds + PG8_SB(b, h) + boff + n * 2048 + k * 1024); } while (0)
#define PG8_MMA(ai, bj, At, Bt) do { __builtin_amdgcn_s_setprio(1); _Pragma("unroll") for (int m = 0; m < 4; ++m) _Pragma("unroll") for (int n = 0; n < 2; ++n) _Pragma("unroll") for (int k = 0; k < 2; ++k) \
        acc[ai][bj][m][n] = __builtin_amdgcn_mfma_f32_16x16x32_bf16(Bt[n][k], At[m][k], acc[ai][bj][m][n], 0, 0, 0); __builtin_amdgcn_s_setprio(0); } while (0)
#define PG8_WAIT_V(n) asm volatile("s_waitcnt vmcnt(" #n ")" ::: "memory")
#define PG8_WAIT_L(n) asm volatile("s_waitcnt lgkmcnt(" #n ")" ::: "memory")
#define PG8_BAR __builtin_amdgcn_s_barrier()
#define PG8_SCHED __builtin_amdgcn_sched_barrier(0)
    Unit cur, nxt; int ui = 0;
    if (!S.next(0, cur)) return;
    f32x4 acc[2][2][4][2];
#pragma unroll
    for (int a = 0; a < 2; ++a)
#pragma unroll
        for (int b = 0; b < 2; ++b)
#pragma unroll
            for (int m = 0; m < 4; ++m)
#pragma unroll
                for (int n = 0; n < 2; ++n) acc[a][b][m][n] = (f32x4){0.f, 0.f, 0.f, 0.f};
    bf16x8 At[4][2], B0[2][2], B1[2][2];
    const char* cA = (const char*)g.A + (size_t)cur.pm * tstep; const char* cB = (const char*)g.Bt + (size_t)cur.pn * tstep;
    S.a_ready(cur);
    if constexpr (SP2) {
        PG8_STAGE(PG8_SB(0, 0), cB, voffB); PG8_STAGE(PG8_SB(0, 1), cB + hstep, voffB); PG8_STAGE(PG8_SA(0, 0), cA, voffA); PG8_STAGE(PG8_SA(0, 1), cA + hstep, voffA);
        if (wr == 1) PG8_BAR;
        PG8_WAIT_V(2); PG8_BAR;
        PG8_STAGE(PG8_SB(1, 0), cB + kstep, voffB); PG8_STAGE(PG8_SA(1, 0), cA + kstep, voffA); PG8_STAGE(PG8_SB(1, 1), cB + hstep + kstep, voffB);
        PG8_WAIT_V(6); PG8_BAR;
    } else {
        PG8_STAGE(PG8_SB(0, 0), cB, voffB); PG8_STAGE(PG8_SA(0, 0), cA, voffA); PG8_STAGE(PG8_SB(0, 1), cB + hstep, voffB); PG8_STAGE(PG8_SA(0, 1), cA + hstep, voffA);
        if (wr == 1) PG8_BAR;
        PG8_WAIT_V(4); PG8_BAR;
        PG8_STAGE(PG8_SB(1, 0), cB + kstep, voffB); PG8_STAGE(PG8_SA(1, 0), cA + kstep, voffA); PG8_STAGE(PG8_SB(1, 1), cB + hstep + kstep, voffB);
        PG8_WAIT_V(6); PG8_BAR;
    }
    for (;;) {
        const bool has_next = S.next(ui + 1, nxt);
        const char* nA = has_next ? (const char*)g.A + (size_t)nxt.pm * tstep : cA; const char* nB = has_next ? (const char*)g.Bt + (size_t)nxt.pn * tstep : cB;
        for (int t = 0; t < nt; t += 2) {
            if constexpr (Epi::MIDK > 0) { if (t == Epi::MIDK) E.mid(acc, cur, wr, wc, fr, fq); }
            const bool last = (t == nt - 2);
            const char* a1 = cA + (size_t)(t + 1) * kstep;
            const char* a2 = last ? nA : cA + (size_t)(t + 2) * kstep; const char* b2 = last ? nB : cB + (size_t)(t + 2) * kstep;
            const char* a3 = a2 + kstep; const char* b3 = b2 + kstep;
            if (last && has_next) S.a_ready(nxt);
            if constexpr (SP2) {
            PG8_LDB(B0, 0, 0); PG8_LDB(B1, 0, 1); PG8_SCHED; PG8_LDA(At, 0, 0); PG8_STAGE(PG8_SA(1, 1), a1 + hstep, voffA);
            PG8_WAIT_V(8); PG8_WAIT_L(0); PG8_BAR; PG8_MMA(0, 0, At, B0); PG8_MMA(0, 1, At, B1); PG8_BAR; PG8_SCHED;
            PG8_LDA(At, 0, 1); PG8_STAGE(PG8_SB(0, 0), b2, voffB); PG8_STAGE(PG8_SB(0, 1), b2 + hstep, voffB); PG8_STAGE(PG8_SA(0, 0), a2, voffA);
            PG8_WAIT_V(8); PG8_WAIT_L(0); PG8_BAR; PG8_MMA(1, 0, At, B0); PG8_MMA(1, 1, At, B1); PG8_BAR; PG8_SCHED;
            PG8_LDB(B0, 1, 0); PG8_LDB(B1, 1, 1); PG8_SCHED; PG8_LDA(At, 1, 0); PG8_STAGE(PG8_SA(0, 1), a2 + hstep, voffA);
            PG8_WAIT_V(8); PG8_WAIT_L(0); PG8_BAR; PG8_MMA(0, 0, At, B0); PG8_MMA(0, 1, At, B1); PG8_BAR; PG8_SCHED;
            PG8_LDA(At, 1, 1); PG8_STAGE(PG8_SB(1, 0), b3, voffB); PG8_STAGE(PG8_SB(1, 1), b3 + hstep, voffB); PG8_STAGE(PG8_SA(1, 0), a3, voffA);
            PG8_WAIT_V(8); PG8_WAIT_L(0); PG8_BAR; PG8_MMA(1, 0, At, B0); PG8_MMA(1, 1, At, B1); PG8_BAR; PG8_SCHED;
            } else {
            PG8_LDB(B0, 0, 0); PG8_SCHED; PG8_LDA(At, 0, 0); PG8_STAGE(PG8_SA(1, 1), a1 + hstep, voffA);
            PG8_WAIT_L(8); PG8_BAR; PG8_WAIT_L(0); PG8_MMA(0, 0, At, B0); PG8_BAR; PG8_SCHED;
            PG8_LDB(B1, 0, 1); PG8_STAGE(PG8_SB(0, 0), b2, voffB);
            PG8_BAR; PG8_WAIT_L(0); PG8_MMA(0, 1, At, B1); PG8_BAR;
            PG8_LDA(At, 0, 1); PG8_STAGE(PG8_SA(0, 0), a2, voffA);
            PG8_BAR; PG8_WAIT_L(0); PG8_MMA(1, 0, At, B0); PG8_BAR; PG8_SCHED;
            PG8_STAGE(PG8_SB(0, 1), b2 + hstep, voffB);
            PG8_WAIT_V(6); PG8_BAR; PG8_MMA(1, 1, At, B1); PG8_BAR;
            PG8_LDB(B0, 1, 0); PG8_SCHED; PG8_LDA(At, 1, 0); PG8_STAGE(PG8_SA(0, 1), a2 + hstep, voffA);
            PG8_WAIT_L(8); PG8_BAR; PG8_WAIT_L(0); PG8_MMA(0, 0, At, B0); PG8_BAR; PG8_SCHED;
            PG8_LDB(B1, 1, 1); PG8_STAGE(PG8_SB(1, 0), b3, voffB);
            PG8_BAR; PG8_WAIT_L(0); PG8_MMA(0, 1, At, B1); PG8_BAR;
            PG8_LDA(At, 1, 1); PG8_STAGE(PG8_SA(1, 0), a3, voffA);
            PG8_BAR; PG8_WAIT_L(0); PG8_MMA(1, 0, At, B0); PG8_BAR; PG8_SCHED;
            PG8_STAGE(PG8_SB(1, 1), b3 + hstep, voffB);
            PG8_WAIT_V(6); PG8_BAR; PG8_MMA(1, 1, At, B1); PG8_BAR;
            }
        }
        if constexpr (ALIGN_EPI) { if (wr == 0) PG8_BAR; }
        if constexpr (!Epi::AFTER_DRAIN) { E(acc, cur, wr, wc, fr, fq); S.done(cur); }
        if (!has_next) break;
#pragma unroll
        for (int a = 0; a < 2; ++a)
#pragma unroll
            for (int b = 0; b < 2; ++b)
#pragma unroll
                for (int m = 0; m < 4; ++m)
#pragma unroll
                    for (int n = 0; n < 2; ++n) acc[a][b][m][n] = (f32x4){0.f, 0.f, 0.f, 0.f};
        cur = nxt; cA = nA; cB = nB; ++ui;
        if constexpr (ALIGN_EPI) { if (wr == 1) PG8_BAR; }
    }
    PG8_WAIT_V(0);
    if constexpr (!ALIGN_EPI) { if (wr == 0) PG8_BAR; }
    PG8_BAR;
    if constexpr (Epi::AFTER_DRAIN) { E.fused(acc, cur, wr, wc, fr, fq, lds, wid, lane); S.done(cur); }
#undef PG8_SA
#undef PG8_SB
#undef PG8_STAGE
#undef PG8_LDA
#undef PG8_LDB
#undef PG8_MMA
#undef PG8_WAIT_V
#undef PG8_WAIT_L
#undef PG8_BAR
#undef PG8_SCHED
}
}

#ifndef PG8_SP2
#define PG8_SP2 true
#endif
#ifndef PG8_ALIGN
#define PG8_ALIGN true
#endif
#include <hip/hip_bf16.h>
#include <cmath>
namespace attn_body {
using bf16=__hip_bfloat16;
using bf16x8=__attribute__((ext_vector_type(8)))short;
using s16x4=__attribute__((ext_vector_type(4)))short;
using f32x16=__attribute__((ext_vector_type(16)))float;
using u32x4=__attribute__((ext_vector_type(4)))unsigned;
constexpr int SEQ=2048,D=64,QP=512,KP=512,VP=512,OP=1024;
constexpr int NW=8,QBLK=32,QB=QBLK*NW,KVBLK=64,NQB=SEQ/QB;
constexpr int ATTN_UNIT_ROWS=QB;
__device__ __forceinline__ int crow(int r,int hi){return (r&3)+8*(r>>2)+4*hi;}
#define SBAR() __builtin_amdgcn_sched_barrier(0)
__device__ __forceinline__ void cmask(f32x16&p0,f32x16&p1,int jb,int wchunk,int){
  if(jb>wchunk){ const float NEG=-INFINITY;
    #pragma unroll
    for(int r=0;r<16;++r){p0[r]=NEG;p1[r]=NEG;} }
}

constexpr int NSLOT=3, SLOTB=8192;
constexpr int LDS_K=0, LDS_V=NSLOT*SLOTB, LDS_WS=2*NSLOT*SLOTB, LDS_OST=LDS_WS+NW*64*4, LDS_BYTES=LDS_OST+NW*4096;
constexpr float C2=0.125f*1.4426950408889634f;
__device__ __forceinline__ void glds16(const void*gsrc,unsigned lds_dst){unsigned keep;
  asm volatile("s_mov_b32 %0, m0\n\ts_mov_b32 m0, %2\n\ts_nop 0\n\tglobal_load_lds_dwordx4 %1, off\n\ts_mov_b32 m0, %0":"=&s"(keep):"v"(gsrc),"s"(lds_dst):"memory");}
__device__ __forceinline__ float max3f(float a,float b,float c){float r;asm("v_max3_f32 %0, %1, %2, %3":"=v"(r):"v"(a),"v"(b),"v"(c));return r;}
__device__ __forceinline__ float max2f(float a,float b){float r;asm("v_max_f32_e32 %0, %1, %2":"=v"(r):"v"(a),"v"(b));return r;}
__device__ __forceinline__ float fadd_s(float a,float b){float r;asm("v_add_f32_e32 %0, %1, %2":"=v"(r):"v"(a),"v"(b));return r;}
__device__ __forceinline__ float fsub_s(float a,float b){float r;asm("v_sub_f32_e32 %0, %1, %2":"=v"(r):"v"(a),"v"(b));return r;}
typedef float f32x2_t __attribute__((ext_vector_type(2))); typedef __bf16 bf16x2_t __attribute__((ext_vector_type(2)));
__device__ __forceinline__ unsigned cvtpk_s(float lo,float hi){f32x2_t v={lo,hi};bf16x2_t b=__builtin_convertvector(v,bf16x2_t);return __builtin_bit_cast(unsigned,b);}
#define WAIT_BAR(N) asm volatile("s_waitcnt vmcnt(" #N ") lgkmcnt(0)\n\ts_barrier":::"memory")

__device__ __forceinline__ void qkt(f32x16&p0,f32x16&p1,const char*Kslot,const bf16x8*qr,const f32x16&negm,int r32,int hi){
  const char*kb=Kslot+hi*1024+r32*16;
  #pragma unroll
  for(int d0=0;d0<4;++d0){
    const bf16x8 b0=*reinterpret_cast<const bf16x8*>(kb+d0*2048);
    const bf16x8 b1=*reinterpret_cast<const bf16x8*>(kb+d0*2048+512);
    if(d0==0){p0=__builtin_amdgcn_mfma_f32_32x32x16_bf16(b0,qr[0],negm,0,0,0);p1=__builtin_amdgcn_mfma_f32_32x32x16_bf16(b1,qr[0],negm,0,0,0);}
    else{p0=__builtin_amdgcn_mfma_f32_32x32x16_bf16(b0,qr[d0],p0,0,0,0);p1=__builtin_amdgcn_mfma_f32_32x32x16_bf16(b1,qr[d0],p1,0,0,0);}}
}
typedef __attribute__((address_space(3))) const char* lds_cptr;
typedef short v4i16_t __attribute__((ext_vector_type(4)));
__device__ __forceinline__ void kload8(bf16x8*kf,lds_cptr kp){
  kf[0]=*(const __attribute__((address_space(3))) bf16x8*)(kp);      kf[1]=*(const __attribute__((address_space(3))) bf16x8*)(kp+512);
  kf[2]=*(const __attribute__((address_space(3))) bf16x8*)(kp+2048); kf[3]=*(const __attribute__((address_space(3))) bf16x8*)(kp+2560);
  kf[4]=*(const __attribute__((address_space(3))) bf16x8*)(kp+4096); kf[5]=*(const __attribute__((address_space(3))) bf16x8*)(kp+4608);
  kf[6]=*(const __attribute__((address_space(3))) bf16x8*)(kp+6144); kf[7]=*(const __attribute__((address_space(3))) bf16x8*)(kp+6656);
}
__device__ __forceinline__ void kload2(bf16x8*kf,lds_cptr kp,int j){ kf[2*j]=*(const __attribute__((address_space(3))) bf16x8*)(kp+j*2048); kf[2*j+1]=*(const __attribute__((address_space(3))) bf16x8*)(kp+j*2048+512); }
__device__ __forceinline__ s16x4 vtr(lds_cptr p){ return __builtin_bit_cast(s16x4,__builtin_amdgcn_ds_read_tr16_b64_v4i16((__attribute__((address_space(3))) v4i16_t*)p)); }
__device__ __forceinline__ float rowmax(const f32x16&p0,const f32x16&p1){
  float a=max3f(p0[0],p0[1],p1[0]),b=max3f(p0[2],p0[3],p1[1]);a=max3f(a,p1[2],p1[3]);
  #pragma unroll
  for(int r=4;r<16;r+=4){a=max3f(a,p0[r],p0[r+1]);b=max3f(b,p0[r+2],p0[r+3]);a=max3f(a,p1[r],p1[r+1]);b=max3f(b,p1[r+2],p1[r+3]);}
  const float m=max2f(a,b);
  auto rr=__builtin_amdgcn_permlane32_swap(__float_as_uint(m),__float_as_uint(m),false,false);
  return max2f(__uint_as_float(rr[0]),__uint_as_float(rr[1]));
}
__device__ __forceinline__ void pv(f32x16*o,int vb,bf16x8 pa0,bf16x8 pa1,bf16x8 pa2,bf16x8 pa3){
  #pragma unroll
  for(int d0=0;d0<2;++d0){s16x4 lo[4],hi[4];
    #pragma unroll
    for(int ks=0;ks<4;++ks){
      asm volatile("ds_read_b64_tr_b16 %0,%1 offset:%c2":"=&v"(lo[ks]):"v"(vb),"i"(d0*4096+ks*1024):"memory");
      asm volatile("ds_read_b64_tr_b16 %0,%1 offset:%c2":"=&v"(hi[ks]):"v"(vb),"i"(d0*4096+ks*1024+512):"memory");}
    asm volatile("s_waitcnt lgkmcnt(0)":::"memory");SBAR();
    #define PK(k) (bf16x8){lo[k][0],lo[k][1],lo[k][2],lo[k][3],hi[k][0],hi[k][1],hi[k][2],hi[k][3]}
    o[d0]=__builtin_amdgcn_mfma_f32_32x32x16_bf16(pa0,PK(0),o[d0],0,0,0);
    o[d0]=__builtin_amdgcn_mfma_f32_32x32x16_bf16(pa1,PK(1),o[d0],0,0,0);
    o[d0]=__builtin_amdgcn_mfma_f32_32x32x16_bf16(pa2,PK(2),o[d0],0,0,0);
    o[d0]=__builtin_amdgcn_mfma_f32_32x32x16_bf16(pa3,PK(3),o[d0],0,0,0);
    #undef PK
  }
}

#ifndef ATTN_STORE16
#define ATTN_STORE16(p,v) (*(u32x4*)(p)=(v))
#endif
template<int THRL> __device__ __forceinline__ void attn_unit(int b,int qcol,int kcol,int vcol,int ocol,int qb,const bf16*Q,const bf16*__restrict__ K,const bf16*__restrict__ V,bf16*O,char*shm){
  int tid_=threadIdx.x; asm volatile("":"+v"(tid_));
  const int tid=tid_,lane=tid&63,r32=lane&31,hi=lane>>5; const int wid=__builtin_amdgcn_readfirstlane(tid>>6);
  const long rowbase=(long)b*SEQ; const int q0=qb*QB;
  const bf16*Qw=Q+(rowbase+q0+wid*QBLK)*QP+qcol;
  const bf16*Kh=K+rowbase*KP+kcol,*Vh=V+rowbase*VP+vcol;
  const unsigned lds0=(unsigned)(uintptr_t)shm;
  float*wsf=(float*)(shm+LDS_WS)+wid*64;
  const bf16*ksrc=Kh+(long)lane*KP+wid*8;
  const bf16*vsrc=Vh+(long)(16*(wid&3)+(lane>>2))*VP+(wid>>2)*32+(lane&3)*8;
  const unsigned kdst=lds0+LDS_K+wid*1024, vdst=lds0+LDS_V+wid*1024;
  #define DMA_K(t,slot) glds16(ksrc+(long)(t)*KVBLK*KP,(unsigned)__builtin_amdgcn_readfirstlane(kdst+(slot)))
  #define DMA_V(t,slot) glds16(vsrc+(long)(t)*KVBLK*VP,(unsigned)__builtin_amdgcn_readfirstlane(vdst+(slot)))
  const int vb0=(int)(lds0+LDS_V)+((lane>>4)&1)*32+(lane&3)*8+(4*hi+((lane&15)>>2))*64;
  const char*Kbase=shm+LDS_K; bf16x8 kf[8];
  const lds_cptr shm3=(lds_cptr)shm; const lds_cptr kp0=shm3+LDS_K+hi*1024+r32*16; const lds_cptr vp0=shm3+LDS_V+((lane>>4)&1)*32+(lane&3)*8+(4*hi+((lane&15)>>2))*64;
  const int NT=(q0+QB)/KVBLK;
  DMA_K(0,0);DMA_V(0,0);DMA_K(1,SLOTB);
  bf16x8 qr[4];
  #pragma unroll
  for(int d0=0;d0<4;++d0)qr[d0]=*reinterpret_cast<const bf16x8*>(&Qw[(long)r32*QP+d0*16+hi*8]);
  float mhat=0.f,l_reg=0.f;f32x16 o[2];o[0]=f32x16{};o[1]=f32x16{};f32x16 negm=f32x16{};asm volatile("":"+v"(negm));
  const int qrel=wid>>1;
  #define CMASK(P0,P1,t) do{int jb_=(t)-(NT-4); if(jb_>=0)cmask(P0,P1,jb_,qrel,hi);}while(0)
  bool resc=false;
  #define START(P0,P1) do{ const float rm=rowmax(P0,P1); resc=false; \
    { const float dl=rm; mhat=fadd_s(mhat,dl); \
      _Pragma("unroll") for(int r=0;r<16;++r){P0[r]=fsub_s(P0[r],dl);P1[r]=fsub_s(P1[r],dl);} \
      _Pragma("unroll") for(int r=0;r<16;++r)negm[r]=-mhat; asm volatile("":"+v"(negm)); } \
    _Pragma("unroll") for(int r=0;r<16;++r)P0[r]=__builtin_amdgcn_exp2f(P0[r]); }while(0)
  #define RESC() do{ if(resc){ asm volatile("s_waitcnt lgkmcnt(0)":::"memory"); \
      _Pragma("unroll") for(int d_=0;d_<2;++d_) _Pragma("unroll") for(int r=0;r<16;++r)o[d_][r]*=wsf[crow(r,hi)]; } }while(0)
  f32x16 pA0,pA1,pB0,pB1;
  int sl_prev=0,sl_cur=0,sl_next=SLOTB;
  #define ROT() do{sl_prev=sl_cur;sl_cur=sl_next;sl_next=(sl_next==(NSLOT-1)*SLOTB)?0:sl_next+SLOTB;}while(0)
  DMA_K(2,2*SLOTB);
  WAIT_BAR(3);
  qkt(pA0,pA1,Kbase,qr,negm,r32,hi);asm volatile("s_nop 15\n\ts_nop 7":"+v"(pA0),"+v"(pA1));CMASK(pA0,pA1,0);
  START(pA0,pA1);
  _Pragma("unroll") for(int r=0;r<16;++r)pA1[r]=__builtin_amdgcn_exp2f(pA1[r]);
  WAIT_BAR(0);
  DMA_K(3,0);DMA_V(1,SLOTB);
  ROT();
  kload8(kf,kp0+sl_cur);
  WAIT_BAR(2);
  s16x4 vlo[8],vhi[8]; u32x4 pw0,pw1,pw2,pw3;
  #define PKW(P,B) cvtpk_s(P[B],P[B+1])
  #define PAF(k) __builtin_bit_cast(bf16x8,pw##k)
  #define VFR(i) (bf16x8){vlo[i][0],vlo[i][1],vlo[i][2],vlo[i][3],vhi[i][0],vhi[i][1],vhi[i][2],vhi[i][3]}
  #define PIN(x) asm volatile("":"+v"(x))
  #define MX3(a,b,c) __builtin_fmaxf(__builtin_fmaxf((a),(b)),(c))
  #define GAPA(MF,A0,A1,A2,A3,W0,W1,PW) do{ MF; sacc+=A0; sacc+=A1; sacc+=A2; sacc+=A3; PIN(sacc); W0; W1; PIN(PW); SBAR(); }while(0)
  #define EX(v) __builtin_amdgcn_exp2f(v)
  #define GAPB(MF,X,B) do{ MF; X[B]=EX(X[B]); X[B+1]=EX(X[B+1]); X[B+2]=EX(X[B+2]); X[B+3]=EX(X[B+3]); PIN(X); SBAR(); }while(0)
  #define VRD(i) do{ vlo[i]=vtr(vp_+(((i)>>2)*4096+((i)&3)*1024)); vhi[i]=vtr(vp_+(((i)>>2)*4096+((i)&3)*1024+512)); }while(0)
  #define KRD(G,j) do{ if(G){ kload2(kf,kp0+sl_next,j); SBAR(); } }while(0)
  #define STEP(C0,C1,P0,P1,t,GK,GV,GL) do{ SBAR(); \
    const lds_cptr vp_=vp0+sl_prev; \
    VRD(0); SBAR(); float sacc=(P0[0]+P0[1]); \
    GAPA(C0=__builtin_amdgcn_mfma_f32_32x32x16_bf16(kf[0],qr[0],negm,0,0,0), P0[2],P0[3],P0[4],P0[5],     pw0[0]=PKW(P0,0), pw0[1]=PKW(P0,2), pw0); \
    VRD(4); SBAR(); GAPA(C1=__builtin_amdgcn_mfma_f32_32x32x16_bf16(kf[1],qr[0],negm,0,0,0), P0[6],P0[7],P0[8],P0[9],     pw0[2]=PKW(P0,4), pw0[3]=PKW(P0,6), pw0); \
    VRD(1); SBAR(); GAPA(C0=__builtin_amdgcn_mfma_f32_32x32x16_bf16(kf[2],qr[1],C0,0,0,0),   P0[10],P0[11],P0[12],P0[13], pw1[0]=PKW(P0,8), pw1[1]=PKW(P0,10), pw1); \
    VRD(5); SBAR(); GAPA(C1=__builtin_amdgcn_mfma_f32_32x32x16_bf16(kf[3],qr[1],C1,0,0,0),   P0[14],P0[15],P1[0],P1[1],   pw1[2]=PKW(P0,12),pw1[3]=PKW(P0,14), pw1); \
    VRD(2); SBAR(); GAPA(C0=__builtin_amdgcn_mfma_f32_32x32x16_bf16(kf[4],qr[2],C0,0,0,0),   P1[2],P1[3],P1[4],P1[5],     pw2[0]=PKW(P1,0), pw2[1]=PKW(P1,2), pw2); \
    VRD(6); SBAR(); GAPA(C1=__builtin_amdgcn_mfma_f32_32x32x16_bf16(kf[5],qr[2],C1,0,0,0),   P1[6],P1[7],P1[8],P1[9],     pw2[2]=PKW(P1,4), pw2[3]=PKW(P1,6), pw2); \
    VRD(3); SBAR(); GAPA(C0=__builtin_amdgcn_mfma_f32_32x32x16_bf16(kf[6],qr[3],C0,0,0,0),   P1[10],P1[11],P1[12],P1[13], pw3[0]=PKW(P1,8), pw3[1]=PKW(P1,10), pw3); \
    VRD(7); SBAR(); GAPA(C1=__builtin_amdgcn_mfma_f32_32x32x16_bf16(kf[7],qr[3],C1,0,0,0),   P1[14],P1[15],0.f,0.f,       pw3[2]=PKW(P1,12),pw3[3]=PKW(P1,14), pw3); \
    l_reg+=sacc; \
    if(GK){DMA_K((t)+3,sl_cur);} if(GV){DMA_V((t)+1,sl_next);} \
    CMASK(C0,C1,t); \
    { float a=MX3(C0[0],C0[1],C1[0]),b=MX3(C0[2],C0[3],C1[1]); a=MX3(a,C1[2],C1[3]); \
      _Pragma("unroll") for(int r=4;r<16;r+=4){a=MX3(a,C0[r],C0[r+1]);b=MX3(b,C0[r+2],C0[r+3]);a=MX3(a,C1[r],C1[r+1]);b=MX3(b,C1[r+2],C1[r+3]);} \
      float rm=__builtin_fmaxf(a,b); { auto rr=__builtin_amdgcn_permlane32_swap(__float_as_uint(rm),__float_as_uint(rm),false,false); rm=__builtin_fmaxf(__uint_as_float(rr[0]),__uint_as_float(rr[1])); } \
      resc=false; \
      if(__builtin_expect(__any(rm>(float)THRL),0)){ const float dl=__builtin_fmaxf(rm,0.f); mhat+=dl; \
        _Pragma("unroll") for(int r=0;r<16;++r){C0[r]-=dl;C1[r]-=dl;} \
        _Pragma("unroll") for(int r=0;r<16;++r)negm[r]=-mhat; asm volatile("":"+v"(negm)); \
        const float f=__builtin_amdgcn_exp2f(-dl); l_reg*=f; if(hi==0)wsf[r32]=f; resc=true; } } \
    SBAR(); \
    GAPB(o[0]=__builtin_amdgcn_mfma_f32_32x32x16_bf16(PAF(0),VFR(0),o[0],0,0,0), C0,0); \
    GAPB(o[1]=__builtin_amdgcn_mfma_f32_32x32x16_bf16(PAF(0),VFR(4),o[1],0,0,0), C0,4); \
    KRD(GL,0); GAPB(o[0]=__builtin_amdgcn_mfma_f32_32x32x16_bf16(PAF(1),VFR(1),o[0],0,0,0), C0,8); \
    KRD(GL,1); GAPB(o[1]=__builtin_amdgcn_mfma_f32_32x32x16_bf16(PAF(1),VFR(5),o[1],0,0,0), C0,12); \
    KRD(GL,2); GAPB(o[0]=__builtin_amdgcn_mfma_f32_32x32x16_bf16(PAF(2),VFR(2),o[0],0,0,0), C1,0); \
    KRD(GL,3); GAPB(o[1]=__builtin_amdgcn_mfma_f32_32x32x16_bf16(PAF(2),VFR(6),o[1],0,0,0), C1,4); \
    GAPB(o[0]=__builtin_amdgcn_mfma_f32_32x32x16_bf16(PAF(3),VFR(3),o[0],0,0,0), C1,8); \
    GAPB(o[1]=__builtin_amdgcn_mfma_f32_32x32x16_bf16(PAF(3),VFR(7),o[1],0,0,0), C1,12); \
    }while(0)
  int t=1;
  #undef CMASK
  #define CMASK(P0,P1,t) do{}while(0)
  for(;t+5<NT;t+=2){
    STEP(pB0,pB1,pA0,pA1,t,true,true,true);     WAIT_BAR(2); RESC(); ROT();
    STEP(pA0,pA1,pB0,pB1,t+1,true,true,true);   WAIT_BAR(2); RESC(); ROT();
  }
  #undef CMASK
  #define CMASK(P0,P1,t) do{int jb_=(t)-(NT-4); if(jb_>=0)cmask(P0,P1,jb_,qrel,hi);}while(0)
  #define ENDW(tt) do{ if((tt)+3<NT){WAIT_BAR(2);} else if((tt)+2<NT){WAIT_BAR(1);} else {WAIT_BAR(0);} }while(0)
  for(;t+1<NT;t+=2){
    STEP(pB0,pB1,pA0,pA1,t,(t+3<NT),(t+1<NT),(t+1<NT));       ENDW(t);   RESC(); ROT();
    STEP(pA0,pA1,pB0,pB1,t+1,(t+4<NT),(t+2<NT),(t+2<NT));     ENDW(t+1); RESC(); ROT();
  }
  STEP(pB0,pB1,pA0,pA1,NT-1,false,false,false); RESC();
  { float sacc=pB0[0]+pB0[1]; _Pragma("unroll") for(int r=2;r<16;++r)sacc+=pB0[r]; _Pragma("unroll") for(int r=0;r<16;++r)sacc+=pB1[r]; l_reg+=sacc;
    pw0=(u32x4){PKW(pB0,0),PKW(pB0,2),PKW(pB0,4),PKW(pB0,6)};pw1=(u32x4){PKW(pB0,8),PKW(pB0,10),PKW(pB0,12),PKW(pB0,14)};pw2=(u32x4){PKW(pB1,0),PKW(pB1,2),PKW(pB1,4),PKW(pB1,6)};pw3=(u32x4){PKW(pB1,8),PKW(pB1,10),PKW(pB1,12),PKW(pB1,14)};
    SBAR(); pv(o,vb0+sl_cur,PAF(0),PAF(1),PAF(2),PAF(3)); }
  #undef PKW
  #undef PAF
  #undef VFR
  #undef PIN
  #undef MX3
  #undef GAPA
  #undef GAPB
  #undef EX
  #undef VRD
  #undef KRD
  #undef STEP
  #undef ENDW
  {auto rr=__builtin_amdgcn_permlane32_swap(__float_as_uint(l_reg),__float_as_uint(l_reg),false,false);l_reg=__uint_as_float(rr[0])+__uint_as_float(rr[1]);}
  if(hi==0)wsf[32+r32]=l_reg;asm volatile("s_waitcnt lgkmcnt(0)":::"memory");
  float rli[16];
  #pragma unroll
  for(int r=0;r<16;++r)rli[r]=__builtin_amdgcn_rcpf(wsf[32+crow(r,hi)]);
  bf16*Ow=O+(rowbase+q0+wid*QBLK)*OP+ocol;
  { bf16*stg=(bf16*)(shm+LDS_OST)+wid*2048;
    #pragma unroll
    for(int r=0;r<16;++r){const int orow=crow(r,hi);
      #pragma unroll
      for(int d0=0;d0<2;++d0)stg[orow*64+d0*32+r32]=__float2bfloat16(o[d0][r]*rli[r]);}
    asm volatile("s_waitcnt lgkmcnt(0)":::"memory");
    #pragma unroll
    for(int i=0;i<4;++i){const int row=i*8+(lane>>3),ch=lane&7; const u32x4 v=*(const u32x4*)(stg+row*64+ch*8); ATTN_STORE16(Ow+(long)row*OP+ch*8,v);} }
  asm volatile("s_waitcnt lgkmcnt(0)\n\ts_barrier":::"memory");
  #undef DMA_K
  #undef DMA_V
  #undef CMASK
  #undef START
  #undef RESC
  #undef ROT
}
constexpr int ATTN_LDS_BYTES=LDS_BYTES;
struct AttnTensors { const bf16* Q; const bf16* K; const bf16* V; bf16* O; };
struct AttnUnit { int bvh; int qb; };
struct StaticOrder {
  int ai,nA;
  __device__ __forceinline__ StaticOrder(int ai_,int nA_):ai(ai_),nA(nA_){}
  __device__ __forceinline__ bool next(int i,AttnUnit&u)const{
    if(nA==128){ if(i>=8)return false; u.bvh=ai; u.qb=7-i; return true; }
    if(i>=4)return false; const int s=ai&1; u.bvh=ai>>1; u.qb=(i==0)?7-s:(i==1)?4+s:(i==2)?3-s:s; return true; }
  __device__ __forceinline__ void a_ready(const AttnUnit&)const{}
  __device__ __forceinline__ void done(const AttnUnit&)const{}
};
template<class Sched,int THRL=8> __device__ __forceinline__ void attn_phase(char*lds,const AttnTensors&T,const Sched&S){
  AttnUnit u;
  for(int i=0;S.next(i,u);++i){ S.a_ready(u); const int b=u.bvh>>4,vh=u.bvh&15,s=vh>>1,half=vh&1;
    attn_unit<THRL>(b,s*64,s*64,(s>>1)*128+half*64,s*128+half*64,u.qb,T.Q,T.K,T.V,T.O,lds); S.done(u); }
}
template<int THRL=8> __device__ __forceinline__ void attn_phase_queue(char*lds,const AttnTensors&T,unsigned*counter,volatile __attribute__((address_space(3))) unsigned*slot){
  for(;;){
    if(threadIdx.x==0)*slot=__hip_atomic_fetch_add(counter,1u,__ATOMIC_RELAXED,__HIP_MEMORY_SCOPE_AGENT);
    __syncthreads();
    const unsigned u=__builtin_amdgcn_readfirstlane(*slot);
    __syncthreads();
    if(u>=1024u)break;
    const int qb=7-(int)(u>>7),bvh=(int)(u&127u),b=bvh>>4,vh=bvh&15,s=vh>>1,half=vh&1;
    attn_unit<THRL>(b,s*64,s*64,(s>>1)*128+half*64,s*128+half*64,qb,T.Q,T.K,T.V,T.O,lds);
  }
}
#undef SBAR
#undef WAIT_BAR
}
#include <hip/hip_cooperative_groups.h>
typedef unsigned short bf16;
#define GAS __attribute__((address_space(1)))
#define LAS __attribute__((address_space(3)))
typedef unsigned v4u __attribute__((ext_vector_type(4)));
typedef unsigned v2u __attribute__((ext_vector_type(2)));
typedef float f32x4 __attribute__((ext_vector_type(4)));
#define LDS_WAIT() asm volatile("s_waitcnt lgkmcnt(0)" ::: "memory")
__device__ __forceinline__ unsigned f2bf(float f) { unsigned u = __builtin_bit_cast(unsigned, f); return (u + 0x7fffu + ((u >> 16) & 1u)) >> 16; }
__device__ __forceinline__ unsigned pk2(float lo, float hi) { return f2bf(lo) | (f2bf(hi) << 16); }
__device__ __forceinline__ float bflo(unsigned w) { return __builtin_bit_cast(float, w << 16); }
__device__ __forceinline__ float bfhi(unsigned w) { return __builtin_bit_cast(float, w & 0xffff0000u); }
__device__ __forceinline__ float bf1(unsigned short h) { return __builtin_bit_cast(float, (unsigned)h << 16); }
template <int CTRL> __device__ __forceinline__ float dppf(float x) { return __builtin_bit_cast(float, __builtin_amdgcn_update_dpp(0, __builtin_bit_cast(int, x), CTRL, 0xf, 0xf, false)); }
__device__ __forceinline__ float row16_allsum(float x) { x += dppf<0x128>(x); x += dppf<0x124>(x); x += dppf<0x122>(x); x += dppf<0x121>(x); return x; }
__device__ __forceinline__ float oct_allsum(float x) { x += dppf<0xB1>(x); x += dppf<0x4E>(x); x += dppf<0x141>(x); return x; }
__device__ __forceinline__ float u2f(unsigned u) { return __builtin_bit_cast(float, u); }
__device__ __forceinline__ unsigned f2u(float f) { return __builtin_bit_cast(unsigned, f); }
__device__ __forceinline__ float sw32(float a, float b) { auto r = __builtin_amdgcn_permlane32_swap(f2u(a), f2u(b), false, false); const unsigned r0 = r[0], r1 = r[1]; return u2f(r0) + u2f(r1); }
__device__ __forceinline__ float sw16(float a, float b) { auto r = __builtin_amdgcn_permlane16_swap(f2u(a), f2u(b), false, false); const unsigned r0 = r[0], r1 = r[1]; return u2f(r0) + u2f(r1); }
__device__ __forceinline__ float wave_allsum(float x) { x = row16_allsum(x); x = sw16(x, x); return sw32(x, x); }
__device__ __forceinline__ float red4(float x0, float x1, float x2, float x3) { return row16_allsum(sw16(sw32(x0, x1), sw32(x2, x3))); }

#define XB_TMO      128
#define XB_XCNT(j)  (256  + 64 * (j))
#define XB_XSUB(j)  (1280 + 64 * (j))
#define XB_XGEN(j)  (2304 + 64 * (j))
#define XB_TOP      3328
#define XB_TOPGEN   3392
#define XCD_BAR_WORDS 3456
#define XB_SPIN_CAP (1u << 18)

__device__ __forceinline__ unsigned xb_ld(unsigned* p)              { return __hip_atomic_load(p, __ATOMIC_RELAXED, __HIP_MEMORY_SCOPE_AGENT); }
__device__ __forceinline__ unsigned xb_add(unsigned* p, unsigned v) { return __hip_atomic_fetch_add(p, v, __ATOMIC_RELAXED, __HIP_MEMORY_SCOPE_AGENT); }
__device__ __forceinline__ unsigned xb_xcc_id() { return (unsigned)__builtin_amdgcn_s_getreg((3 << 11) | 20) & 0xFu; }
#define XB_SPIN(cond, bar) do { unsigned _sp = 0; while (cond) { __builtin_amdgcn_s_sleep(1); \
    if ((++_sp & 255u) == 0u) { if (xb_ld(&(bar)[XB_TMO])) break; if (_sp > XB_SPIN_CAP) { atomicAdd(&(bar)[XB_TMO], 1u); break; } } } } while (0)

struct XcdBarrier {
    unsigned* bar; unsigned x;
    volatile LAS unsigned* st;
};

__device__ __forceinline__ XcdBarrier xcd_barrier_post(unsigned* bar, volatile LAS unsigned* st) {
    XcdBarrier b; b.bar = bar; b.x = xb_xcc_id(); b.st = st;
    if (threadIdx.x == 0) (void)xb_add(&bar[XB_XCNT(b.x)], 1u);
    return b;
}
__device__ __forceinline__ void xcd_barrier_complete(unsigned* bar, unsigned x, unsigned& nloc, unsigned& nx) {
    const unsigned G = gridDim.x * gridDim.y * gridDim.z;
    unsigned sum, cnt, mine, sp = 0u;
    for (;;) {
        sum = 0u; cnt = 0u; mine = 0u;
#pragma unroll
        for (unsigned j = 0; j < 16; ++j) { const unsigned c = xb_ld(&bar[XB_XCNT(j)]); sum += c; cnt += (c > 0u) ? 1u : 0u; }
        mine = xb_ld(&bar[XB_XCNT(x)]);
        if (sum == G) break;
        __builtin_amdgcn_s_sleep(1);
        if ((++sp & 255u) == 0u) { if (xb_ld(&bar[XB_TMO])) break; if (sp > XB_SPIN_CAP) { atomicAdd(&bar[XB_TMO], 1u); break; } }
    }
    nloc = mine > 0u ? mine : 1u; nx = cnt > 0u ? cnt : 1u;
}

__device__ __forceinline__ void xcd_barrier(const XcdBarrier& b) {
    asm volatile("s_waitcnt vmcnt(0)" ::: "memory");
    __syncthreads();
    if (threadIdx.x == 0) {
        unsigned* bar = b.bar;
        __builtin_amdgcn_s_waitcnt(0);
        unsigned nloc = b.st[0], nx = b.st[1];
        if (nloc == 0u) { xcd_barrier_complete(bar, b.x, nloc, nx); b.st[0] = nloc; b.st[1] = nx; }
        const unsigned old = xb_add(&bar[XB_XSUB(b.x)], 1u);
        const unsigned gen = old / nloc;
        if (old + 1u == (gen + 1u) * nloc) {
            __builtin_amdgcn_fence(__ATOMIC_RELEASE, "agent");
            asm volatile("s_waitcnt vmcnt(0)" ::: "memory");
            const unsigned og = xb_add(&bar[XB_TOP], 1u);
            const unsigned tg = og / nx;
            if (og + 1u == (tg + 1u) * nx) xb_add(&bar[XB_TOPGEN], 1u);
            else XB_SPIN(xb_ld(&bar[XB_TOPGEN]) == tg, bar);
            __builtin_amdgcn_fence(__ATOMIC_ACQUIRE, "agent");
            xb_add(&bar[XB_XGEN(b.x)], 1u);
            asm volatile("s_waitcnt vmcnt(0)" ::: "memory");
        } else {
            XB_SPIN(xb_ld(&bar[XB_XGEN(b.x)]) == gen, bar);
            __builtin_amdgcn_fence(__ATOMIC_ACQUIRE, "agent");
            asm volatile("s_waitcnt vmcnt(0)" ::: "memory");
        }
    }
    __syncthreads();
}


constexpr int CW_BAR = 4096;
constexpr int MISC_OFF = 162816 + 320;
struct Frame {
    LAS unsigned char* lds;
    int tid, lane, wave, G, bx;
    float* out; unsigned char* ws;
};
struct Args { const float* in[26]; float* out; unsigned char* ws; int ph_lo, ph_hi; };
typedef const float* cfp_t;
typedef __attribute__((address_space(4))) const cfp_t* ktab_t;
struct InTab { ktab_t p; __device__ __forceinline__ const float* operator[](int i) const { return p[i]; } };
enum { I_X = 0, I_NMG, I_WIN, I_MU, I_W0, I_W2, I_A0, I_A2, I_G2, I_KK, I_KA, I_RK, I_LNG, I_LNB, I_LQ1, I_LK1, I_LQ2, I_LK2, I_SUBG, I_WA, I_WB, I_WO, I_NFG, I_FF1, I_FF2, I_NFIN };

template <bool ROPE> __device__ __forceinline__ void p0_transpose_item(const float* W, int K, int N, bf16* WT, LAS float* scr, int item, int lane, int pitch = 0, int koff = 0) {
    if (pitch == 0) pitch = K;
    const int nblk = N / 32, kb = item / nblk, nb = item % nblk, k0 = 64 * kb, n0 = 32 * nb;
#pragma unroll
    for (int i = 0; i < 8; ++i) { const int kk = 8 * i + (lane >> 3), c4 = 4 * (lane & 7); const f32x4 w4 = *(const GAS f32x4*)(W + (size_t)(k0 + kk) * N + n0 + c4);
        scr[kk * 33 + c4] = w4.x; scr[kk * 33 + c4 + 1] = w4.y; scr[kk * 33 + c4 + 2] = w4.z; scr[kk * 33 + c4 + 3] = w4.w; }
    LDS_WAIT(); asm volatile("" ::: "memory");
    const int c = lane & 7;
#pragma unroll
    for (int j = 0; j < 4; ++j) { const int n = (lane >> 3) + 8 * j; const LAS float* s = scr + (8 * c) * 33 + n;
        v4u o; o.x = pk2(s[0 * 33], s[1 * 33]); o.y = pk2(s[2 * 33], s[3 * 33]); o.z = pk2(s[4 * 33], s[5 * 33]); o.w = pk2(s[6 * 33], s[7 * 33]);
        int col = n0 + n;
        if (ROPE && col < 1024) { const int d = col & 63, dd = d & 31; col = (col & ~63) + 8 * (dd >> 2) + (d >> 5) * 4 + (dd & 3); }
        *(GAS v4u*)(WT + (size_t)col * pitch + koff + k0 + 8 * c) = o; }
    LDS_WAIT(); asm volatile("" ::: "memory");
}
__device__ __forceinline__ void rms_row_to_bf16(const float* xrow, const float* g, bf16* orow, int lane) {
    const GAS f32x4* xr = (const GAS f32x4*)xrow + lane; const f32x4* gr = (const f32x4*)g + lane;
    f32x4 v[4]; float s = 0.f;
#pragma unroll
    for (int j = 0; j < 4; ++j) { v[j] = xr[64 * j]; s += (v[j].x * v[j].x + v[j].y * v[j].y) + (v[j].z * v[j].z + v[j].w * v[j].w); }
    const float rstd = 1.0f / sqrtf(wave_allsum(s) * (1.f / D) + NORM_EPS);
    GAS unsigned long long* o8 = (GAS unsigned long long*)orow + lane;
#pragma unroll
    for (int j = 0; j < 4; ++j) { const f32x4 gg = gr[64 * j];
        o8[64 * j] = (unsigned long long)pk2(v[j].x * rstd * gg.x, v[j].y * rstd * gg.y) | ((unsigned long long)pk2(v[j].z * rstd * gg.z, v[j].w * rstd * gg.w) << 32); }
}
__device__ __forceinline__ void rms_row_to_f32(const float* xrow, const float* g, float* orow, int lane) {
    const GAS f32x4* xr = (const GAS f32x4*)xrow + lane; const f32x4* gr = (const f32x4*)g + lane;
    f32x4 v[4]; float s = 0.f;
#pragma unroll
    for (int j = 0; j < 4; ++j) { v[j] = xr[64 * j]; s += (v[j].x * v[j].x + v[j].y * v[j].y) + (v[j].z * v[j].z + v[j].w * v[j].w); }
    const float rstd = 1.0f / sqrtf(wave_allsum(s) * (1.f / D) + NORM_EPS);
    GAS f32x4* o = (GAS f32x4*)orow + lane;
#pragma unroll
    for (int j = 0; j < 4; ++j) { const f32x4 gg = gr[64 * j]; o[64 * j] = v[j] * rstd * gg; }
}
__device__ __forceinline__ void p0_prologue(Frame& F, const InTab& A) {
    LAS float* scr = (LAS float*)(F.lds + RING_OFF + F.wave * 16384);
    const int gw = F.bx * NWAVES + F.wave, NGW = F.G * NWAVES;
    unsigned char* ws = F.ws;
    constexpr int I_IN = (D / 64) * (D_IN / 32), I_A = (512 / 64) * (D / 32), I_O = (D / 64) * (D / 32), I_1 = (D / 64) * (FF / 32), I_2 = (FF / 64) * (D / 32);
    (void)I_A; (void)I_O; (void)I_1; (void)I_2;
    for (int it = gw; it < I_IN; it += NGW) p0_transpose_item<true>(A[I_WIN], D, D_IN, (bf16*)(ws + WS_WIN), scr, it, F.lane);
    if (false) for (int it = gw; it < 0; it += NGW) {
        int r = it;
        if (r < I_A) { p0_transpose_item<false>(A[I_WA], 512, D, (bf16*)(ws + WS_WA), scr, r, F.lane, 1024, 0); continue; } r -= I_A;
        if (r < I_A) { p0_transpose_item<false>(A[I_WB], 512, D, (bf16*)(ws + WS_WA), scr, r, F.lane, 1024, 512); continue; } r -= I_A;
        if (r < I_O) { p0_transpose_item<false>(A[I_WO], D, D, (bf16*)(ws + WS_WO), scr, r, F.lane); continue; } r -= I_O;
        if (r < I_1) { p0_transpose_item<false>(A[I_FF1], D, FF, (bf16*)(ws + WS_W1), scr, r, F.lane); continue; } r -= I_1;
        p0_transpose_item<false>(A[I_FF2], FF, D, (bf16*)(ws + WS_W2), scr, r, F.lane);
    }
    const int gt = F.bx * (NWAVES * 64) + F.tid, NGT = F.G * NWAVES * 64;
    for (int e = gt; e < NLORA * (KLORA / 8); e += NGT) { const int n = e % NLORA, k8 = (e / NLORA) * 8; float v[8];
#pragma unroll
        for (int i = 0; i < 8; ++i) { const int k = k8 + i; float x = 0.f;
            if (n < 512) { if (k < 64) x = A[I_W2][(size_t)k * 512 + n]; }
            else if (n < 1024) { if (k >= 64 && k < 128) x = A[I_A2][(size_t)(k - 64) * 512 + (n - 512)]; }
            else { if (k >= 128) x = A[I_G2][(size_t)(k - 128) * 512 + (n - 1024)]; }
            v[i] = x; }
        v4u o; o.x = pk2(v[0], v[1]); o.y = pk2(v[2], v[3]); o.z = pk2(v[4], v[5]); o.w = pk2(v[6], v[7]);
        *(GAS v4u*)((bf16*)(ws + WS_WL) + (size_t)n * KLORA + k8) = o; }
    for (int e = gt; e < SEQ * 32; e += NGT) { const int pos = e >> 5, i = e & 31;
        const float inv = exp2f(-(float)i * 0.41524101186092029f);
        const float ang = (float)pos * inv; float s, c; sincosf(ang, &s, &c);
        ((float*)(ws + WS_ROPE_C))[e] = c; ((float*)(ws + WS_ROPE_S))[e] = s; }
    for (int m = gw; m < M; m += NGW) rms_row_to_bf16(A[I_X] + (size_t)m * D, A[I_NMG], (bf16*)(ws + WS_XN) + (size_t)m * D, F.lane);
}

__device__ __forceinline__ void late_weights(Frame& F, const InTab& A, int part, int nparts, int cu0) {
    int lane_ = F.lane; asm volatile("" : "+v"(lane_));
    LAS float* scr = (LAS float*)(F.lds + RING_OFF + F.wave * 16384);
    unsigned char* ws = F.ws;
    constexpr int I_A = (512 / 64) * (D / 32), I_O = (D / 64) * (D / 32), I_1 = (D / 64) * (FF / 32), I_2 = (FF / 64) * (D / 32), NIT = 2 * I_A + I_O + I_1 + I_2;
    const int per = NIT / nparts, lo = part * per, hi = lo + per;
    const int gw = (F.bx - cu0) * NWAVES + F.wave, NGW = (F.G - cu0) * NWAVES;
    for (int it = lo + gw; it < hi; it += NGW) {
        int r = it;
        if (r < I_A) { p0_transpose_item<false>(A[I_WA], 512, D, (bf16*)(ws + WS_WA), scr, r, lane_, 1024, 0); continue; } r -= I_A;
        if (r < I_A) { p0_transpose_item<false>(A[I_WB], 512, D, (bf16*)(ws + WS_WA), scr, r, lane_, 1024, 512); continue; } r -= I_A;
        if (r < I_O) { p0_transpose_item<false>(A[I_WO], D, D, (bf16*)(ws + WS_WO), scr, r, lane_); continue; } r -= I_O;
        if (r < I_1) { p0_transpose_item<false>(A[I_FF1], D, FF, (bf16*)(ws + WS_W1), scr, r, lane_); continue; } r -= I_1;
        p0_transpose_item<false>(A[I_FF2], FF, D, (bf16*)(ws + WS_W2), scr, r, lane_);
    }
}
__device__ __forceinline__ void prep1_rows(Frame& F, const InTab& A, int g0, int g1, int w, int nw) {
    const int lane = F.lane;
    const bf16* WAG = (const bf16*)(F.ws + WS_WAG); bf16* LIN = (bf16*)(F.ws + WS_LIN);
    const f32x4 mu = *(const f32x4*)(A[I_MU] + 1536 + 4 * lane);
    for (int g = g0 + w; g < g1; g += nw) {
        const int m0 = g * 8; v2u row[9];
        row[0] = (v2u){0u, 0u}; if ((m0 & (SEQ - 1)) != 0) row[0] = *(const GAS v2u*)(WAG + (size_t)(m0 - 1) * 256 + 4 * lane);
#pragma unroll
        for (int j = 0; j < 8; ++j) row[j + 1] = *(const GAS v2u*)(WAG + (size_t)(m0 + j) * 256 + 4 * lane);
#pragma unroll
        for (int j = 0; j < 8; ++j) {
            float z[4] = {bflo(row[j + 1].x), bfhi(row[j + 1].x), bflo(row[j + 1].y), bfhi(row[j + 1].y)}; const float p[4] = {bflo(row[j].x), bfhi(row[j].x), bflo(row[j].y), bfhi(row[j].y)};
#pragma unroll
            for (int e = 0; e < 4; ++e) { float v = z[e] + (p[e] - z[e]) * mu[e];
                if (lane < 16) v = 1.0f - 2.0f * __builtin_amdgcn_rcpf(1.0f + __expf(2.0f * v));
                else if (lane >= 32) v = __builtin_amdgcn_rcpf(1.0f + __expf(-v));
                z[e] = v; }
            v2u o; o.x = pk2(z[0], z[1]); o.y = pk2(z[2], z[3]);
            *(GAS v2u*)(LIN + (size_t)(m0 + j) * 256 + 4 * lane) = o;
        }
    }
}
struct ScanRaw { unsigned short r[9], k[9], v[9], a[8]; float d[8]; };
__device__ __forceinline__ void scan_load(ScanRaw& R, const bf16* RKV, const float* DEC, const bf16* AA, size_t row0, int t0, int c) {
#pragma unroll
    for (int j = 0; j < 9; ++j) { int t = t0 - 1 + j; if (t < 0) t = 0; const bf16* p = RKV + (row0 + t) * 1536 + c;
        R.r[j] = *(const GAS bf16*)p; R.k[j] = *(const GAS bf16*)(p + 512); R.v[j] = *(const GAS bf16*)(p + 1024); }
#pragma unroll
    for (int j = 0; j < 8; ++j) { R.d[j] = *(const GAS float*)(DEC + (row0 + t0 + j) * 512 + c); R.a[j] = *(const GAS bf16*)(AA + (row0 + t0 + j) * 512 + c); }
}
__device__ __forceinline__ void scan_phase(Frame& F, const InTab& A, int si) {
    const int lane = F.lane, wave = F.wave, tid = F.tid;
    const int bh = si >> 1, half = si & 1, b = bh >> 3, h = bh & 7, c = h * 64 + lane;
    LAS float* IN = (LAS float*)(F.lds + RING_OFF);
    LAS float* VV = IN + 5 * 4096;
    LAS float* YBUF = VV + 2048;
    const bf16* RKV = (const bf16*)(F.ws + WS_RKV); const float* DEC = (const float*)(F.ws + WS_DEC); const bf16* AA = (const bf16*)(F.ws + WS_AA);
    bf16* Y = (bf16*)(F.ws + WS_Y); float* BON = (float*)(F.ws + WS_BON);
    const float mu_r = A[I_MU][c], mu_k = A[I_MU][512 + c], mu_v = A[I_MU][1024 + c], kkc = A[I_KK][c], kac = A[I_KA][c], rkc = A[I_RK][c];
    const size_t row0 = (size_t)b * SEQ;
    const int myv = (int)(red4(0.f, 1.f, 2.f, 3.f) * (1.0f / 64.0f) + 0.5f);
    const int L0 = __builtin_ctzll(__ballot(myv == 0)), L1 = __builtin_ctzll(__ballot(myv == 1)), L2 = __builtin_ctzll(__ballot(myv == 2)), L3 = __builtin_ctzll(__ballot(myv == 3));
    float S0 = 0.f, S1 = 0.f, S2 = 0.f, S3 = 0.f;
    ScanRaw R; scan_load(R, RKV, DEC, AA, row0, wave * 8, c);
    for (int blk = 0; blk < SEQ / 64; ++blk) {
        {
            const int t0 = blk * 64 + wave * 8;
            f32x4 qd[2], qa[2], qb[2], qk[2], qr[2], qv[2];
#pragma unroll
            for (int j = 0; j < 8; ++j) {
                const float pz = (t0 + j == 0) ? 0.f : 1.f;
                const float rt_ = bf1(R.r[j + 1]), kt_ = bf1(R.k[j + 1]), vt_ = bf1(R.v[j + 1]);
                const float rs = rt_ + (bf1(R.r[j]) * pz - rt_) * mu_r, ks = kt_ + (bf1(R.k[j]) * pz - kt_) * mu_k, vs = vt_ + (bf1(R.v[j]) * pz - vt_) * mu_v;
                const float kkr = ks * kkc, n2 = wave_allsum(kkr * kkr), kk = kkr / __builtin_fmaxf(sqrtf(n2), 1e-12f);
                const float a = 1.0f / (1.0f + __expf(-bf1(R.a[j]))), kx = ks * (1.0f + (a - 1.0f) * kac);
                const float bon = wave_allsum(rs * kx * rkc);
                if (half == 0 && lane == 0) BON[(row0 + t0 + j) * 8 + h] = bon;
                qd[j >> 2][j & 3] = __expf(-0.6065306597f / (1.0f + __expf(-R.d[j])));     qa[j >> 2][j & 3] = -kk; qb[j >> 2][j & 3] = kk * a; qk[j >> 2][j & 3] = kx; qr[j >> 2][j & 3] = rs; qv[j >> 2][j & 3] = vs;
            }
#pragma unroll
            for (int q = 0; q < 2; ++q) { const int t4 = wave * 2 + q; LAS f32x4* p = (LAS f32x4*)IN + t4 * 64 + lane;
                p[0 * 1024] = qd[q]; p[1 * 1024] = qa[q]; p[2 * 1024] = qb[q]; p[3 * 1024] = qk[q]; p[4 * 1024] = qr[q];
                if ((lane >> 5) == half) ((LAS f32x4*)VV)[t4 * 32 + (lane & 31)] = qv[q]; }
        }
        __syncthreads();
        if (blk + 1 < SEQ / 64) scan_load(R, RKV, DEC, AA, row0, (blk + 1) * 64 + wave * 8, c);
#pragma unroll 1
        for (int t4 = 0; t4 < 16; ++t4) {
            const LAS f32x4* p = (const LAS f32x4*)IN + t4 * 64 + lane;
            const f32x4 W4 = p[0], A4 = p[1024], B4 = p[2048], K4 = p[3072], R4 = p[4096];
            const LAS f32x4* pv = (const LAS f32x4*)VV + t4 * 32 + wave * 4;
            const f32x4 V0 = pv[0], V1 = pv[1], V2 = pv[2], V3 = pv[3];
            f32x4 yq;
#pragma unroll
            for (int ts = 0; ts < 4; ++ts) {
                const float w = W4[ts], a = A4[ts], bb = B4[ts], kx = K4[ts], r = R4[ts];
                const float t = red4(S0 * a, S1 * a, S2 * a, S3 * a);
                const float sa0 = __builtin_bit_cast(float, __builtin_amdgcn_readlane(__builtin_bit_cast(int, t), L0)), sa1 = __builtin_bit_cast(float, __builtin_amdgcn_readlane(__builtin_bit_cast(int, t), L1));
                const float sa2 = __builtin_bit_cast(float, __builtin_amdgcn_readlane(__builtin_bit_cast(int, t), L2)), sa3 = __builtin_bit_cast(float, __builtin_amdgcn_readlane(__builtin_bit_cast(int, t), L3));
                S0 = S0 * w + (sa0 * bb + V0[ts] * kx); S1 = S1 * w + (sa1 * bb + V1[ts] * kx); S2 = S2 * w + (sa2 * bb + V2[ts] * kx); S3 = S3 * w + (sa3 * bb + V3[ts] * kx);
                yq[ts] = red4(S0 * r, S1 * r, S2 * r, S3 * r);
            }
            if ((lane & 15) == 0) *(LAS f32x4*)(YBUF + (wave * 4 + myv) * 68 + t4 * 4) = yq;
        }
        __syncthreads();
        { const int t = tid >> 3, rg = tid & 7; const LAS float* yb = YBUF + (4 * rg) * 68 + t;
          v2u o; o.x = pk2(yb[0], yb[68]); o.y = pk2(yb[136], yb[204]);
          *(GAS v2u*)(Y + (row0 + blk * 64 + t) * 512 + h * 64 + 32 * half + 4 * rg) = o; }
    }
    __syncthreads();
}
__device__ __forceinline__ void post_phase(Frame& F, const InTab& A) {
    const int gw = F.bx * NWAVES + F.wave, NGW = F.G * NWAVES, lane = F.lane;
    const bf16* O = (const bf16*)(F.ws + WS_O); const bf16* Y = (const bf16*)(F.ws + WS_Y); const bf16* RKV = (const bf16*)(F.ws + WS_RKV); const bf16* GG = (const bf16*)(F.ws + WS_GG);
    const float* BON = (const float*)(F.ws + WS_BON); bf16* YA = (bf16*)(F.ws + WS_YA);
    const float lam = __expf(wave_allsum(A[I_LQ1][lane] * A[I_LK1][lane])) - __expf(wave_allsum(A[I_LQ2][lane] * A[I_LK2][lane])) + LAMBDA_INIT;
    const int ca = 8 * lane, ha = lane >> 4, ea = ca & 127;
    const int hb = lane >> 3;
    float sg[8], lg[8], lb[8], muv[8];
#pragma unroll
    for (int e = 0; e < 8; ++e) { sg[e] = A[I_SUBG][ea + e] * (1.0f - LAMBDA_INIT); lg[e] = A[I_LNG][ca + e]; lb[e] = A[I_LNB][ca + e]; muv[e] = A[I_MU][1024 + ca + e]; }
#define UNPK8(w_) {bflo(w_.x), bfhi(w_.x), bflo(w_.y), bfhi(w_.y), bflo(w_.z), bfhi(w_.z), bflo(w_.w), bfhi(w_.w)}
    for (int g = gw; g < M / 4; g += NGW) {
        const int m0 = g * 4;
        v4u o0[4], o1[4], yr[4], gr[4], vr[5]; float bon[4];
        vr[0] = (v4u){0u, 0u, 0u, 0u}; if ((m0 & (SEQ - 1)) != 0) vr[0] = *(const GAS v4u*)(RKV + (size_t)(m0 - 1) * 1536 + 1024 + ca);
#pragma unroll
        for (int j = 0; j < 4; ++j) { const size_t mm = (size_t)(m0 + j);
            o0[j] = *(const GAS v4u*)(O + mm * 1024 + (2 * ha) * 128 + ea); o1[j] = *(const GAS v4u*)(O + mm * 1024 + (2 * ha + 1) * 128 + ea);
            yr[j] = *(const GAS v4u*)(Y + mm * 512 + ca); gr[j] = *(const GAS v4u*)(GG + mm * 512 + ca); vr[j + 1] = *(const GAS v4u*)(RKV + mm * 1536 + 1024 + ca);
            bon[j] = *(const GAS float*)(BON + mm * 8 + hb); }
#pragma unroll
        for (int j = 0; j < 4; ++j) { const size_t mm = (size_t)(m0 + j);
            {
                const float a0[8] = UNPK8(o0[j]), a1[8] = UNPK8(o1[j]); float o[8], ss = 0.f;
#pragma unroll
                for (int e = 0; e < 8; ++e) { o[e] = a0[e] - lam * a1[e]; ss += o[e] * o[e]; }
                const float rstd = __builtin_amdgcn_rsqf(row16_allsum(ss) * (1.0f / 128.0f) + SUBLN_EPS);
                v4u w; w.x = pk2(o[0] * rstd * sg[0], o[1] * rstd * sg[1]); w.y = pk2(o[2] * rstd * sg[2], o[3] * rstd * sg[3]); w.z = pk2(o[4] * rstd * sg[4], o[5] * rstd * sg[5]); w.w = pk2(o[6] * rstd * sg[6], o[7] * rstd * sg[7]);
                *(GAS v4u*)(YA + mm * 1024 + ca) = w;
            }
            {
                const float y[8] = UNPK8(yr[j]), gq[8] = UNPK8(gr[j]), v[8] = UNPK8(vr[j + 1]), p[8] = UNPK8(vr[j]);
                float s = 0.f;
#pragma unroll
                for (int e = 0; e < 8; ++e) s += y[e];
                const float mean = oct_allsum(s) * (1.0f / 64.0f); float q = 0.f;
#pragma unroll
                for (int e = 0; e < 8; ++e) { const float d = y[e] - mean; q += d * d; }
                const float rstd = __builtin_amdgcn_rsqf(oct_allsum(q) * (1.0f / 64.0f) + GN_EPS);
                float r[8];
#pragma unroll
                for (int e = 0; e < 8; ++e) { const float vs = v[e] + (p[e] - v[e]) * muv[e]; r[e] = (((y[e] - mean) * rstd) * lg[e] + lb[e] + bon[j] * vs) * gq[e]; }
                v4u w; w.x = pk2(r[0], r[1]); w.y = pk2(r[2], r[3]); w.z = pk2(r[4], r[5]); w.w = pk2(r[6], r[7]);
                *(GAS v4u*)(YA + mm * 1024 + 512 + ca) = w;
            }
        }
    }
#undef UNPK8
}

typedef short rk_bf16x8 __attribute__((ext_vector_type(8)));
typedef float rk_f32x16 __attribute__((ext_vector_type(16)));
constexpr int RKA_RS_K = 144, RKA_RS_J = 80;
constexpr int RKA_A = 0, RKA_B = 5120, RKA_K = 10240, RKA_R = 15360, RKA_AT = 19968, RKA_BH = 25088, RKA_KH = 30208, RKA_VT = 35328, RKA_GC = 40448, RKA_BYTES = 40704;
constexpr int RKA_N = 0, RKA_X = 0, RKA_T = 5120, RKA_MAK = 7680, RKA_MRB = 10240, RKA_MRK = 12800;
constexpr int RKA_WAVES = 4;
static_assert(RKA_WAVES * RKA_BYTES <= 162816, "phase A LDS");
constexpr size_t WS_PQ0 = 66 * MiB, WS_PQ1 = 34 * MiB;
constexpr size_t WS_RY0 = 98 * MiB, WS_RY1 = 178 * MiB;
constexpr size_t WS_GC = 250 * MiB;
__device__ __forceinline__ unsigned char* rk_pq(unsigned char* ws, int half) { return ws + (half ? WS_PQ1 : WS_PQ0); }
__device__ __forceinline__ unsigned char* rk_ry(unsigned char* ws, int half) { return ws + (half ? WS_RY1 : WS_RY0); }
__device__ __forceinline__ unsigned char* rk_gc(unsigned char* ws, int half) { return ws + WS_GC + (size_t)half * (2048 * 256); }
constexpr size_t WS_SST = 251 * MiB;

__device__ __forceinline__ rk_bf16x8 rk_frag(const LAS unsigned char* base, int rs, int row, int s, int h) { return *(const LAS rk_bf16x8*)(base + row * rs + (16 * s + 8 * h) * 2); }
__device__ __forceinline__ rk_f32x16 rk_mfma(rk_bf16x8 a, rk_bf16x8 b, rk_f32x16 c) { return __builtin_amdgcn_mfma_f32_32x32x16_bf16(a, b, c, 0, 0, 0); }
__device__ __forceinline__ unsigned rk_pk(float lo, float hi) { typedef float f2_ __attribute__((ext_vector_type(2))); typedef __bf16 b2_ __attribute__((ext_vector_type(2))); f2_ v = {lo, hi}; b2_ b = __builtin_convertvector(v, b2_); return __builtin_bit_cast(unsigned, b); }
__device__ __forceinline__ void rk_store_tile_lds(LAS unsigned char* base, int rs, int nrow, int mbase, int h, const rk_f32x16& acc) {
#pragma unroll
    for (int g = 0; g < 4; ++g) { v2u w; w.x = rk_pk(acc[4 * g], acc[4 * g + 1]); w.y = rk_pk(acc[4 * g + 2], acc[4 * g + 3]); *(LAS v2u*)(base + nrow * rs + (mbase + 8 * g + 4 * h) * 2) = w; }
}
__device__ __forceinline__ void rk_store_tile_glb(bf16* base, int pitch, int nrow, int mbase, int h, const rk_f32x16& acc) {
#pragma unroll
    for (int g = 0; g < 4; ++g) { v2u w; w.x = rk_pk(acc[4 * g], acc[4 * g + 1]); w.y = rk_pk(acc[4 * g + 2], acc[4 * g + 3]); *(GAS v2u*)(base + (size_t)nrow * pitch + mbase + 8 * g + 4 * h) = w; }
}
__device__ __forceinline__ void rk_store_tile_frag(unsigned char* base, int nt, int r32, int mt, int h, const rk_f32x16& acc) {
#pragma unroll
    for (int g = 0; g < 4; ++g) { v2u w; w.x = rk_pk(acc[4 * g], acc[4 * g + 1]); w.y = rk_pk(acc[4 * g + 2], acc[4 * g + 3]);
        *(GAS v2u*)(base + ((size_t)((nt * 4 + 2 * mt + (g >> 1)) * 64 + r32 + 32 * (g & 1))) * 16 + 8 * h) = w; }
}
__device__ __forceinline__ void rk_store_blob(unsigned* blob, int lane, const rk_f32x16& acc) {
    v4u w0, w1; w0.x = rk_pk(acc[0], acc[1]); w0.y = rk_pk(acc[2], acc[3]); w0.z = rk_pk(acc[4], acc[5]); w0.w = rk_pk(acc[6], acc[7]);
    w1.x = rk_pk(acc[8], acc[9]); w1.y = rk_pk(acc[10], acc[11]); w1.z = rk_pk(acc[12], acc[13]); w1.w = rk_pk(acc[14], acc[15]);
    *(GAS v4u*)(blob + lane * 8) = w0; *(GAS v4u*)(blob + lane * 8 + 4) = w1;
}
struct RkBlob { v4u w0, w1; };
__device__ __forceinline__ RkBlob rk_load_blob(const unsigned* blob, int lane) { RkBlob b; b.w0 = *(const GAS v4u*)(blob + lane * 8); b.w1 = *(const GAS v4u*)(blob + lane * 8 + 4); return b; }
__device__ __forceinline__ rk_f32x16 rk_blob_f32(const RkBlob& b) {
    rk_f32x16 a; const unsigned w[8] = {b.w0.x, b.w0.y, b.w0.z, b.w0.w, b.w1.x, b.w1.y, b.w1.z, b.w1.w};
#pragma unroll
    for (int i = 0; i < 8; ++i) { a[2 * i] = bflo(w[i]); a[2 * i + 1] = bfhi(w[i]); }
    return a;
}

struct RkRaw { unsigned short r[8], k[8], v[8]; };
__device__ __forceinline__ void rk_load8(RkRaw& R, const bf16* prkv) {
#pragma unroll
    for (int j = 0; j < 8; ++j) { R.r[j] = *(const GAS bf16*)(prkv + j * 1536); R.k[j] = *(const GAS bf16*)(prkv + j * 1536 + 512); R.v[j] = *(const GAS bf16*)(prkv + j * 1536 + 1024); }
}
__device__ __forceinline__ void rwkvA_unit(LAS unsigned char* L, const InTab& A, unsigned char* ws, int bh, int chunk, int lane_in) {
    int lane = lane_in; asm volatile("" : "+v"(lane));
    const int b = bh >> 3, hd = bh & 7, cg = hd * 64 + lane, r32 = lane & 31, h = lane >> 5;
    const size_t row0 = (size_t)b * SEQ + (size_t)chunk * 32;
    const int uh = bh * 32 + (chunk & 31);
    const bf16* prkv = (const bf16*)(ws + WS_RKV) + row0 * 1536 + cg;
    float* pbon = (float*)(ws + WS_BON) + row0 * 8 + hd;
    const float mu_r = A[I_MU][cg], mu_k = A[I_MU][512 + cg], mu_v = A[I_MU][1024 + cg], kkc = A[I_KK][cg], kac = A[I_KA][cg], rkc = A[I_RK][cg], w0c = A[I_W0][cg], a0c = A[I_A0][cg];
    float dW[32], dA[32];
    {
        rk_f32x16 lw[2] = {{}, {}}, la[2] = {{}, {}};
        const bf16* lp = (const bf16*)(ws + WS_LIN) + (row0 + r32) * 256 + 8 * h;
        const bf16* wp = (const bf16*)(ws + WS_WL) + (size_t)(hd * 64 + r32) * 256 + 8 * h;
#pragma unroll
        for (int s2 = 0; s2 < 4; ++s2) { const rk_bf16x8 fw = __builtin_bit_cast(rk_bf16x8, *(const GAS v4u*)(lp + 16 * s2)), fa = __builtin_bit_cast(rk_bf16x8, *(const GAS v4u*)(lp + 64 + 16 * s2));
#pragma unroll
            for (int ct = 0; ct < 2; ++ct) { lw[ct] = rk_mfma(fw, __builtin_bit_cast(rk_bf16x8, *(const GAS v4u*)(wp + (size_t)ct * 32 * 256 + 16 * s2)), lw[ct]);
                la[ct] = rk_mfma(fa, __builtin_bit_cast(rk_bf16x8, *(const GAS v4u*)(wp + (size_t)(512 + ct * 32) * 256 + 64 + 16 * s2)), la[ct]); } }
#pragma unroll
        for (int i = 0; i < 16; ++i) { const int tb = (i & 3) + 8 * (i >> 2);
            { auto r = __builtin_amdgcn_permlane32_swap(f2u(lw[0][i]), f2u(lw[1][i]), false, false); const unsigned r0 = r[0], r1 = r[1]; dW[tb] = u2f(r0); dW[tb + 4] = u2f(r1); }
            { auto r = __builtin_amdgcn_permlane32_swap(f2u(la[0][i]), f2u(la[1][i]), false, false); const unsigned r0 = r[0], r1 = r[1]; dA[tb] = u2f(r0); dA[tb + 4] = u2f(r1); } }
    }
    const int myv = (int)(red4(0.f, 1.f, 2.f, 3.f) * (1.0f / 64.0f) + 0.5f);
    const int L0 = __builtin_ctzll(__ballot(myv == 0)), L1 = __builtin_ctzll(__ballot(myv == 1)), L2 = __builtin_ctzll(__ballot(myv == 2)), L3 = __builtin_ctzll(__ballot(myv == 3));
    float rp = 0.f, kp = 0.f, vp = 0.f;
    if (chunk != 0) { rp = bf1(*(const GAS bf16*)(prkv - 1536)); kp = bf1(*(const GAS bf16*)(prkv - 1536 + 512)); vp = bf1(*(const GAS bf16*)(prkv - 1536 + 1024)); }
    float G = 1.0f;
    RkRaw Rc, Rn; rk_load8(Rc, prkv);
#pragma unroll
    for (int q = 0; q < 4; ++q) {
        prkv += 8 * 1536;
        if (q < 3) rk_load8(Rn, prkv);
        LAS unsigned char* Lr = L + (8 * q) * RKA_RS_K + lane * 2;
        LAS unsigned char* Lt = L + lane * RKA_RS_J + (8 * q) * 2;
        unsigned tA[4], tB[4], tK[4], tV[4], pA = 0, pB = 0, pK = 0, pV = 0;
        float rs_[8], kx_[8], kkr_[8], a8_[8], w8_[8], vs_[8];
#pragma unroll
        for (int j = 0; j < 8; ++j) {
            const float rc = bf1(Rc.r[j]), kc = bf1(Rc.k[j]), vc = bf1(Rc.v[j]);
            const float ks = kc + (kp - kc) * mu_k; rs_[j] = rc + (rp - rc) * mu_r; vs_[j] = vc + (vp - vc) * mu_v; rp = rc; kp = kc; vp = vc;
            kkr_[j] = ks * kkc; a8_[j] = __builtin_amdgcn_rcpf(1.0f + __expf(-(a0c + dA[8 * q + j]))); kx_[j] = ks * (1.0f + (a8_[j] - 1.0f) * kac);
            w8_[j] = __expf(-0.6065306597f * __builtin_amdgcn_rcpf(1.0f + __expf(-(w0c + dW[8 * q + j]))));
        }
        float n2_[8], bon_[8];
#pragma unroll
        for (int j = 0; j < 8; j += 2) {
            const float t = red4(kkr_[j] * kkr_[j], kkr_[j + 1] * kkr_[j + 1], rs_[j] * kx_[j] * rkc, rs_[j + 1] * kx_[j + 1] * rkc);
            n2_[j] = __builtin_bit_cast(float, __builtin_amdgcn_readlane(__builtin_bit_cast(int, t), L0)); n2_[j + 1] = __builtin_bit_cast(float, __builtin_amdgcn_readlane(__builtin_bit_cast(int, t), L1));
            bon_[j] = __builtin_bit_cast(float, __builtin_amdgcn_readlane(__builtin_bit_cast(int, t), L2)); bon_[j + 1] = __builtin_bit_cast(float, __builtin_amdgcn_readlane(__builtin_bit_cast(int, t), L3));
        }
        if (lane < 8) { float bv = bon_[0];
#pragma unroll
            for (int j = 1; j < 8; ++j) bv = (lane == j) ? bon_[j] : bv;
            *(GAS float*)(pbon + (8 * q + lane) * 8) = bv; }
#pragma unroll
        for (int j = 0; j < 8; ++j) {
            const float kk = kkr_[j] * __builtin_amdgcn_rsqf(__builtin_fmaxf(n2_[j], 1e-24f));
            const float Gprev = G; G *= w8_[j]; const float iG = __builtin_amdgcn_rcpf(G);
            const bf16 at = (bf16)f2bf(-kk * Gprev), rt = (bf16)f2bf(rs_[j] * G), bt = (bf16)f2bf(kk * a8_[j] * iG), kt = (bf16)f2bf(kx_[j] * iG), vb = (bf16)f2bf(vs_[j]);
            *(LAS bf16*)(Lr + RKA_A + j * RKA_RS_K) = at; *(LAS bf16*)(Lr + RKA_R + j * RKA_RS_K) = rt; *(LAS bf16*)(Lr + RKA_B + j * RKA_RS_K) = bt; *(LAS bf16*)(Lr + RKA_K + j * RKA_RS_K) = kt;
            if (j & 1) { tA[j >> 1] = pA | ((unsigned)at << 16); tB[j >> 1] = pB | ((unsigned)bt << 16); tK[j >> 1] = pK | ((unsigned)kt << 16); tV[j >> 1] = pV | ((unsigned)vb << 16); } else { pA = at; pB = bt; pK = kt; pV = vb; }
        }
        *(LAS v4u*)(Lt + RKA_AT) = (v4u){tA[0], tA[1], tA[2], tA[3]}; *(LAS v4u*)(Lt + RKA_BH) = (v4u){tB[0], tB[1], tB[2], tB[3]}; *(LAS v4u*)(Lt + RKA_KH) = (v4u){tK[0], tK[1], tK[2], tK[3]}; *(LAS v4u*)(Lt + RKA_VT) = (v4u){tV[0], tV[1], tV[2], tV[3]};
        Rc = Rn;
    }
    const float GC = G;
    *(GAS float*)((float*)rk_gc(ws, chunk >> 5) + (size_t)uh * 64 + lane) = GC;
    *(LAS float*)(L + RKA_GC + lane * 4) = GC;
    LDS_WAIT(); asm volatile("" ::: "memory");
    {
        rk_f32x16 aN = {}, aAK = {}, aRB = {}, aRK = {};
#pragma unroll
        for (int s = 0; s < 4; ++s) {
            const rk_bf16x8 fA = rk_frag(L + RKA_A, RKA_RS_K, r32, s, h), fR = rk_frag(L + RKA_R, RKA_RS_K, r32, s, h), fB = rk_frag(L + RKA_B, RKA_RS_K, r32, s, h), fK = rk_frag(L + RKA_K, RKA_RS_K, r32, s, h);
            aN = rk_mfma(fB, fA, aN); aAK = rk_mfma(fK, fA, aAK); aRB = rk_mfma(fB, fR, aRB); aRK = rk_mfma(fK, fR, aRK);
        }
        LDS_WAIT(); asm volatile("" ::: "memory");
#pragma unroll
        for (int i = 0; i < 16; ++i) { const int j = (i & 3) + 8 * (i >> 2) + 4 * h;
            if (!(j < r32)) { aN[i] = 0.f; aAK[i] = 0.f; }
            if (!(j <= r32)) { aRB[i] = 0.f; aRK[i] = 0.f; } }
#pragma unroll
        for (int g = 0; g < 4; ++g) *(LAS f32x4*)(L + RKA_N + r32 * 144 + (8 * g + 4 * h) * 4) = (f32x4){aN[4 * g], aN[4 * g + 1], aN[4 * g + 2], aN[4 * g + 3]};
        rk_store_tile_lds(L + RKA_MAK, RKA_RS_J, r32, 0, h, aAK); rk_store_tile_lds(L + RKA_MRB, RKA_RS_J, r32, 0, h, aRB); rk_store_tile_lds(L + RKA_MRK, RKA_RS_J, r32, 0, h, aRK);
        rk_store_tile_lds(L + RKA_T, RKA_RS_J, r32, 0, h, aN);
    }
    LDS_WAIT(); asm volatile("" ::: "memory");
    {
        const int blk = (r32 >> 4) & 1, cc = r32 & 15;
        const LAS unsigned char* Nb = L + RKA_N + (16 * blk) * 144 + (16 * blk) * 4;
        float T[16];
#pragma unroll
        for (int t = 0; t < 16; ++t) { float ac[4] = {(cc == t) ? 1.0f : 0.0f, 0.f, 0.f, 0.f};
#pragma unroll
            for (int j4 = 0; j4 < (t + 3) / 4; ++j4) { const f32x4 n4 = *(const LAS f32x4*)(Nb + t * 144 + j4 * 16);
#pragma unroll
                for (int e = 0; e < 4; ++e) if (4 * j4 + e < t) ac[e] += n4[e] * T[4 * j4 + e]; }
            T[t] = (ac[0] + ac[1]) + (ac[2] + ac[3]); }
        LDS_WAIT(); asm volatile("" ::: "memory");
#pragma unroll
        for (int t = 0; t < 16; ++t) *(LAS bf16*)(L + RKA_T + (16 * blk + t) * RKA_RS_J + r32 * 2) = (bf16)f2bf(T[t]);
        if (blk == 0) { LAS v4u* p = (LAS v4u*)(L + RKA_N + cc * RKA_RS_J);
            p[0] = (v4u){pk2(T[0], T[1]), pk2(T[2], T[3]), pk2(T[4], T[5]), pk2(T[6], T[7])}; p[1] = (v4u){pk2(T[8], T[9]), pk2(T[10], T[11]), pk2(T[12], T[13]), pk2(T[14], T[15])}; }
        LDS_WAIT(); asm volatile("" ::: "memory");
        rk_f32x16 xa = {};
        xa = rk_mfma(*(const LAS rk_bf16x8*)(L + RKA_T + (16 + r32) * RKA_RS_J + 16 * h), *(const LAS rk_bf16x8*)(L + RKA_N + r32 * RKA_RS_J + 16 * h), xa);
        if (r32 < 16) {
#pragma unroll
            for (int g = 0; g < 2; ++g) { v2u w; w.x = rk_pk(xa[4 * g], xa[4 * g + 1]); w.y = rk_pk(xa[4 * g + 2], xa[4 * g + 3]); *(LAS v2u*)(L + RKA_N + 1280 + r32 * RKA_RS_J + (8 * g + 4 * h) * 2) = w; } }
        LDS_WAIT(); asm volatile("" ::: "memory");
        rk_f32x16 ta = {};
        ta = rk_mfma(*(const LAS rk_bf16x8*)(L + RKA_N + 1280 + r32 * RKA_RS_J + 16 * h), *(const LAS rk_bf16x8*)(L + RKA_T + (16 + r32) * RKA_RS_J + (16 + 8 * h) * 2), ta);
        LDS_WAIT(); asm volatile("" ::: "memory");
        if (r32 < 16) {
#pragma unroll
            for (int g = 0; g < 2; ++g) { v2u w; w.x = rk_pk(ta[4 * g], ta[4 * g + 1]); w.y = rk_pk(ta[4 * g + 2], ta[4 * g + 3]); *(LAS v2u*)(L + RKA_T + (16 + r32) * RKA_RS_J + (8 * g + 4 * h) * 2) = w; } }
    }
    LDS_WAIT(); asm volatile("" ::: "memory");
    rk_bf16x8 fT[2];
#pragma unroll
    for (int s = 0; s < 2; ++s) fT[s] = rk_frag(L + RKA_T, RKA_RS_J, r32, s, h);
    {
        rk_f32x16 x0[2] = {{}, {}}, ap[2] = {{}, {}};
#pragma unroll
        for (int s = 0; s < 2; ++s) { const rk_bf16x8 fM = rk_frag(L + RKA_MAK, RKA_RS_J, r32, s, h);
#pragma unroll
            for (int nt = 0; nt < 2; ++nt) { x0[nt] = rk_mfma(fM, rk_frag(L + RKA_VT, RKA_RS_J, nt * 32 + r32, s, h), x0[nt]); ap[nt] = rk_mfma(fT[s], rk_frag(L + RKA_AT, RKA_RS_J, nt * 32 + r32, s, h), ap[nt]); } }
        LDS_WAIT(); asm volatile("" ::: "memory");
#pragma unroll
        for (int nt = 0; nt < 2; ++nt) { rk_store_tile_lds(L + RKA_X, RKA_RS_J, nt * 32 + r32, 0, h, x0[nt]); rk_store_tile_lds(L + RKA_AT, RKA_RS_J, nt * 32 + r32, 0, h, ap[nt]); }
    }
    LDS_WAIT(); asm volatile("" ::: "memory");
    {
        rk_f32x16 u0[2] = {{}, {}};
#pragma unroll
        for (int s = 0; s < 2; ++s)
#pragma unroll
            for (int nt = 0; nt < 2; ++nt) u0[nt] = rk_mfma(fT[s], rk_frag(L + RKA_X, RKA_RS_J, nt * 32 + r32, s, h), u0[nt]);
        LDS_WAIT(); asm volatile("" ::: "memory");
#pragma unroll
        for (int nt = 0; nt < 2; ++nt) rk_store_tile_lds(L + RKA_X, RKA_RS_J, nt * 32 + r32, 0, h, u0[nt]);
    }
    LDS_WAIT(); asm volatile("" ::: "memory");
    unsigned char* pq = rk_pq(ws, chunk >> 5) + (size_t)uh * 16384; unsigned char* ry = rk_ry(ws, chunk >> 5) + (size_t)uh * 8192;
    rk_bf16x8 fRB[2], fRK[2], fAp[2][2], fBh[2][2], fKh[2][2], fU[2][2], fV[2][2];
#pragma unroll
    for (int s = 0; s < 2; ++s) { fRB[s] = rk_frag(L + RKA_MRB, RKA_RS_J, r32, s, h); fRK[s] = rk_frag(L + RKA_MRK, RKA_RS_J, r32, s, h);
#pragma unroll
        for (int nt = 0; nt < 2; ++nt) { fAp[nt][s] = rk_frag(L + RKA_AT, RKA_RS_J, nt * 32 + r32, s, h); fBh[nt][s] = rk_frag(L + RKA_BH, RKA_RS_J, nt * 32 + r32, s, h);
            fKh[nt][s] = rk_frag(L + RKA_KH, RKA_RS_J, nt * 32 + r32, s, h); fU[nt][s] = rk_frag(L + RKA_X, RKA_RS_J, nt * 32 + r32, s, h); fV[nt][s] = rk_frag(L + RKA_VT, RKA_RS_J, nt * 32 + r32, s, h); } }
#pragma unroll
    for (int kt = 0; kt < 2; ++kt) {
        rk_f32x16 acc;
#pragma unroll
        for (int g = 0; g < 4; ++g) { const v2u w = *(const LAS v2u*)(L + RKA_R + r32 * RKA_RS_K + (kt * 32 + 8 * g + 4 * h) * 2); acc[4 * g] = bflo(w.x); acc[4 * g + 1] = bfhi(w.x); acc[4 * g + 2] = bflo(w.y); acc[4 * g + 3] = bfhi(w.y); }
#pragma unroll
        for (int s = 0; s < 2; ++s) acc = rk_mfma(fAp[kt][s], fRB[s], acc);
        rk_store_tile_frag(ry, 0, r32, kt, h, acc);
    }
#pragma unroll
    for (int kt = 0; kt < 2; ++kt)
#pragma unroll
        for (int kq = 0; kq < 2; ++kq) { rk_f32x16 acc = {};
#pragma unroll
            for (int s = 0; s < 2; ++s) acc = rk_mfma(fAp[kq][s], fBh[kt][s], acc);
            acc = acc * *(const LAS float*)(L + RKA_GC + (kt * 32 + r32) * 4);
            rk_store_tile_frag(pq, kt, r32, kq, h, acc); }
#pragma unroll
    for (int vt = 0; vt < 2; ++vt) {
        rk_f32x16 acc = {};
#pragma unroll
        for (int s = 0; s < 2; ++s) { acc = rk_mfma(fU[vt][s], fRB[s], acc); acc = rk_mfma(fV[vt][s], fRK[s], acc); }
        rk_store_blob((unsigned*)(ry + 4096) + vt * 512, lane, acc);
    }
#pragma unroll
    for (int kt = 0; kt < 2; ++kt)
#pragma unroll
        for (int vt = 0; vt < 2; ++vt) { rk_f32x16 acc = {};
#pragma unroll
            for (int s = 0; s < 2; ++s) { acc = rk_mfma(fBh[kt][s], fU[vt][s], acc); acc = rk_mfma(fKh[kt][s], fV[vt][s], acc); }
#pragma unroll
            for (int g = 0; g < 4; ++g) { const f32x4 gq = *(const LAS f32x4*)(L + RKA_GC + (kt * 32 + 8 * g + 4 * h) * 4); acc[4 * g] *= gq[0]; acc[4 * g + 1] *= gq[1]; acc[4 * g + 2] *= gq[2]; acc[4 * g + 3] *= gq[3]; }
            rk_store_blob((unsigned*)(pq + 8192) + (kt * 2 + vt) * 512, lane, acc); }
    LDS_WAIT(); asm volatile("" ::: "memory");
}
__device__ __forceinline__ void rwkvA_phase(Frame& F, const InTab& A, int half) {
    if (F.wave >= RKA_WAVES) return;
    LAS unsigned char* L = F.lds + RING_OFF + F.wave * RKA_BYTES;
    const int gw = F.bx * RKA_WAVES + F.wave, NGW = F.G * RKA_WAVES;
    for (int u = gw; u < 64 * 32; u += NGW) rwkvA_unit(L, A, F.ws, u >> 5, half * 32 + (u & 31), F.lane);
}
__device__ __forceinline__ void rwkvA_queue(Frame& F, const InTab& A, int half, unsigned* counter) {
    if (F.wave >= RKA_WAVES) return;
    LAS unsigned char* L = F.lds + RING_OFF + F.wave * RKA_BYTES;
    for (;;) {
        unsigned u = 0; if (F.lane == 0) u = __hip_atomic_fetch_add(counter, 1u, __ATOMIC_RELAXED, __HIP_MEMORY_SCOPE_AGENT);
        u = __builtin_amdgcn_readfirstlane(u);
        if (u >= 64u * 32u) break;
        rwkvA_unit(L, A, F.ws, (int)(u >> 5), half * 32 + (int)(u & 31), F.lane);
    }
}
constexpr int RKB_RS = 144, RKB_SBUF = 64 * RKB_RS;
__device__ __forceinline__ void rwkvB_phase(Frame& F, int bh, int half) {
    int lane = F.lane; asm volatile("" : "+v"(lane));
    const int wave = F.wave, r32 = lane & 31, h = lane >> 5;
    LAS unsigned char* SB = F.lds + RING_OFF;
    unsigned char* ws = F.ws;
    const int b = bh >> 3, hd = bh & 7;
    bf16* Y = (bf16*)(ws + WS_Y);
    const int kt = (wave >> 1) & 1, vt = wave & 1;
    float* sst = (float*)(ws + WS_SST) + (size_t)bh * 4096 + (size_t)(wave & 3) * 1024;
    rk_f32x16 st = {};
    if (wave < 4) {
        if (half != 0) {
#pragma unroll
            for (int i = 0; i < 16; ++i) st[i] = *(const GAS float*)(sst + i * 64 + lane);
        }
        rk_store_tile_lds(SB, RKB_RS, vt * 32 + r32, kt * 32, h, st);
    }
    const int uh0 = bh * 32; const bool isS = wave < 4, isY = !isS && wave < 6;
    const unsigned char* fptr = isS ? rk_pq(ws, half) + (size_t)uh0 * 16384 + (kt * 256 + lane) * 16 : rk_ry(ws, half) + (size_t)uh0 * 8192 + lane * 16;
    const unsigned char* bptr = isS ? rk_pq(ws, half) + (size_t)uh0 * 16384 + 8192 + (kt * 2 + vt) * 2048 + lane * 32 : rk_ry(ws, half) + (size_t)uh0 * 8192 + 4096 + vt * 2048 + lane * 32;
    const LAS unsigned char* gl = SB + 2 * RKB_SBUF + (kt * 32 + 4 * h) * 4;
    const int fstride = isS ? 16384 : 8192;
    struct Op { v4u f[4]; v4u b0, b1; };
    { const int tid_ = wave * 64 + lane; *(LAS f32x4*)(SB + 2 * RKB_SBUF + tid_ * 16) = *(const GAS f32x4*)(rk_gc(ws, half) + (size_t)uh0 * 256 + tid_ * 16); }
    Op o0, o1, o2;
#define RKB_LOAD(O_, c) do { const unsigned char* fp_ = fptr + (size_t)(c) * fstride; const unsigned char* bp_ = bptr + (size_t)(c) * fstride; \
        _Pragma("unroll") for (int s = 0; s < 4; ++s) O_.f[s] = *(const GAS v4u*)(fp_ + 1024 * s); \
        O_.b0 = *(const GAS v4u*)bp_; O_.b1 = *(const GAS v4u*)(bp_ + 16); } while (0)
#define RKB_BAR() do { asm volatile("s_waitcnt lgkmcnt(0)" ::: "memory"); __builtin_amdgcn_s_barrier(); asm volatile("" ::: "memory"); } while (0)
#define RKB_NEXT(O_, c, AH_) RKB_LOAD(O_, ((c) + (AH_) < 32 ? (c) + (AH_) : 31))
#define RKB_STEP_S(O_, c) do { \
        const LAS unsigned char* cur = SB + ((c) & 1) * RKB_SBUF; LAS unsigned char* nxt = SB + (((c) & 1) ^ 1) * RKB_SBUF; \
        rk_bf16x8 fS[4]; _Pragma("unroll") for (int s = 0; s < 4; ++s) fS[s] = rk_frag(cur, RKB_RS, vt * 32 + r32, s, h); \
        RkBlob bb_; bb_.w0 = O_.b0; bb_.w1 = O_.b1; const rk_f32x16 q = rk_blob_f32(bb_); \
        _Pragma("unroll") for (int g = 0; g < 4; ++g) { const f32x4 gq = *(const LAS f32x4*)(gl + (c) * 256 + 32 * g); \
            st[4 * g] = st[4 * g] * gq[0] + q[4 * g]; st[4 * g + 1] = st[4 * g + 1] * gq[1] + q[4 * g + 1]; st[4 * g + 2] = st[4 * g + 2] * gq[2] + q[4 * g + 2]; st[4 * g + 3] = st[4 * g + 3] * gq[3] + q[4 * g + 3]; } \
        _Pragma("unroll") for (int s = 0; s < 4; ++s) st = rk_mfma(__builtin_bit_cast(rk_bf16x8, O_.f[s]), fS[s], st); \
        RKB_NEXT(O_, c, 5); \
        rk_store_tile_lds(nxt, RKB_RS, vt * 32 + r32, kt * 32, h, st); \
        RKB_BAR(); } while (0)
#define RKB_STEP_Y(O_, c) do { \
        const LAS unsigned char* cur = SB + ((c) & 1) * RKB_SBUF; \
        rk_bf16x8 fS[4]; _Pragma("unroll") for (int s = 0; s < 4; ++s) fS[s] = rk_frag(cur, RKB_RS, vt * 32 + r32, s, h); \
        RkBlob bb_; bb_.w0 = O_.b0; bb_.w1 = O_.b1; rk_f32x16 acc = rk_blob_f32(bb_); \
        _Pragma("unroll") for (int s = 0; s < 4; ++s) acc = rk_mfma(fS[s], __builtin_bit_cast(rk_bf16x8, O_.f[s]), acc);       \
        RKB_NEXT(O_, c, 3); \
        rk_store_tile_glb(Y + ((size_t)b * SEQ + (size_t)(half * 32 + (c)) * 32) * 512 + hd * 64, 512, r32, vt * 32, h, acc); \
        RKB_BAR(); } while (0)
    if (isY) { RKB_LOAD(o0, 0); RKB_LOAD(o1, 1); RKB_LOAD(o2, 2); }
    __syncthreads();
    if (isS) {
        Op o3, o4; RKB_LOAD(o0, 0); RKB_LOAD(o1, 1); RKB_LOAD(o2, 2); RKB_LOAD(o3, 3); RKB_LOAD(o4, 4);
#define R5S(c) RKB_STEP_S(o0, c); RKB_STEP_S(o1, (c) + 1); RKB_STEP_S(o2, (c) + 2); RKB_STEP_S(o3, (c) + 3); RKB_STEP_S(o4, (c) + 4);
        R5S(0) R5S(5) R5S(10) R5S(15) R5S(20) R5S(25)
        RKB_STEP_S(o0, 30); RKB_STEP_S(o1, 31);
#undef R5S
    } else if (isY) {
#define R3Y(c) RKB_STEP_Y(o0, c); RKB_STEP_Y(o1, (c) + 1); RKB_STEP_Y(o2, (c) + 2);
        R3Y(0) R3Y(3) R3Y(6) R3Y(9) R3Y(12) R3Y(15) R3Y(18) R3Y(21) R3Y(24) R3Y(27)
        RKB_STEP_Y(o0, 30); RKB_STEP_Y(o1, 31);
#undef R3Y
    } else {
#pragma unroll 1
        for (int c = 0; c < 32; ++c) RKB_BAR();
    }
#undef RKB_STEP_S
#undef RKB_STEP_Y
#undef RKB_NEXT
#undef RKB_BAR
#undef RKB_LOAD
    if (wave < 4 && half == 0) {
#pragma unroll
        for (int i = 0; i < 16; ++i) *(GAS float*)(sst + i * 64 + lane) = st[i];
    }
}

constexpr int NPHASE = 9;
template <int PHM> __global__ void __launch_bounds__(NWAVES * 64, 2) fwd_kernel(Args args) {
    extern __shared__ __attribute__((aligned(16))) unsigned char lds[];
    namespace cg = cooperative_groups;
    Frame F;
    F.lds = (LAS unsigned char*)lds;
    F.tid = threadIdx.x; F.lane = F.tid & 63; F.wave = __builtin_amdgcn_readfirstlane(F.tid >> 6);
    F.G = gridDim.x; F.bx = blockIdx.x;
    F.out = args.out; F.ws = args.ws;
#define PH_BEGIN InTab TAB; { ktab_t kp_ = (ktab_t)__builtin_amdgcn_kernarg_segment_ptr(); asm volatile("" : "+s"(kp_)); TAB.p = kp_; } { int t_ = threadIdx.x; asm volatile("" : "+v"(t_)); F.tid = t_; F.lane = t_ & 63; F.wave = __builtin_amdgcn_readfirstlane(t_ >> 6); } GAS unsigned char* wsg_ = (GAS unsigned char*)args.ws; asm volatile("" : "+s"(wsg_)); unsigned char* ws = (unsigned char*)wsg_; F.ws = ws; GAS bf16_t* gtg_ = (GAS bf16_t*)args.out; asm volatile("" : "+s"(gtg_)); bf16_t* GATES = (bf16_t*)gtg_; F.out = (float*)GATES; (void)GATES;
    const int lo = args.ph_lo, hi = args.ph_hi;
    XcdBarrier bar; bar.bar = nullptr; bar.x = 0; bar.st = nullptr;
    if (hi - lo > 1) {
        for (int u = threadIdx.x; u < (LDS_BYTES - 162816) / 4; u += NWAVES * 64) ((LAS unsigned*)(F.lds + 162816))[u] = 0u;
        { GAS v4u* z_ = (GAS v4u*)(args.ws + WS_CTL) + (size_t)blockIdx.x * (CTL_ZERO_BYTES / 16 / 256); for (int u = threadIdx.x; u < (int)(CTL_ZERO_BYTES / 16 / 256); u += NWAVES * 64) z_[u] = (v4u){0u, 0u, 0u, 0u}; }
        asm volatile("s_waitcnt vmcnt(0)" ::: "memory");
        __syncthreads();
        cg::this_grid().sync();
        bar = xcd_barrier_post((unsigned*)(args.ws + WS_CTL) + CW_BAR, (volatile LAS unsigned*)(F.lds + MISC_OFF) + 8);
    }
#define IN(k) (((PHM >> (k)) & 1) && lo <= (k) && (k) < hi)
#ifdef PROBE_DUP
#define REPS(k) (((k) == PROBE_DUP) ? 2 : 1)
#else
#define REPS(k) 1
#endif
#define SEAM(k) do { if (IN(k) && IN((k) + 1)) { xcd_barrier(bar); } } while (0)
    using pg8::Gemm; using pg8::StaticOrder; using pg8::EpiRow8; using pg8::bf16_t;

    if (IN(0)) for (int rep_ = 0; rep_ < REPS(0); ++rep_) { if (rep_) xcd_barrier(bar); PH_BEGIN p0_prologue(F, TAB); } SEAM(0);
    if (IN(1)) for (int rep_ = 0; rep_ < REPS(1); ++rep_) { if (rep_) xcd_barrier(bar); PH_BEGIN
        Gemm g{(const bf16_t*)(ws + WS_XN), (const bf16_t*)(ws + WS_WIN), M, D_IN, D}; StaticOrder S; S.init(M, D_IN, F.G, F.bx);
        EpiRow8<pg8::FProj> E{{ws, GATES}};
        pg8::gemm_phase<EpiRow8<pg8::FProj>, StaticOrder, PG8_ALIGN, PG8_SP2>(F.lds + RING_OFF, g, S, E);
    } SEAM(1);
    if (IN(2)) { PH_BEGIN
        constexpr int NLW = 64;
        if (F.bx >= F.G - NLW) {
            const int pm = F.bx - (F.G - NLW);
            prep1_rows(F, TAB, pm * 32, pm * 32 + 32, F.wave, NWAVES);
            asm volatile("s_waitcnt vmcnt(0)" ::: "memory"); __syncthreads();
            if (threadIdx.x == 0) { __builtin_amdgcn_fence(__ATOMIC_ACQUIRE, "agent"); asm volatile("s_waitcnt vmcnt(0)" ::: "memory"); }
            __syncthreads();
            int klora = KLORA; asm volatile("" : "+s"(klora));
            Gemm g{(const bf16_t*)(ws + WS_LIN), (const bf16_t*)(ws + WS_WL) + (size_t)1024 * KLORA, M, 512, klora}; pg8::PanelOrder S{pm, 2};
            EpiRow8<pg8::FLoraG> E{{ws}};
            pg8::gemm_phase<EpiRow8<pg8::FLoraG>, pg8::PanelOrder, PG8_ALIGN, PG8_SP2>(F.lds + RING_OFF, g, S, E);
            __syncthreads();
        }
        const attn_body::AttnTensors AT{(const attn_body::bf16*)(ws + WS_Q), (const attn_body::bf16*)(ws + WS_K), (const attn_body::bf16*)(ws + WS_V), (attn_body::bf16*)(ws + WS_O)};
        attn_body::attn_phase_queue<8>((char*)lds + RING_OFF, AT, (unsigned*)(ws + WS_CTL + CTL_ATTQ), (volatile LAS unsigned*)(F.lds + MISC_OFF) + 24);
    } SEAM(2);
    if (IN(3)) { PH_BEGIN
        { GAS unsigned char* w_ = (GAS unsigned char*)args.ws; asm volatile("" : "+s"(w_)); F.ws = (unsigned char*)w_; }
        rwkvA_phase(F, TAB, 0);
        xcd_barrier(bar);
        { GAS unsigned char* w_ = (GAS unsigned char*)args.ws; asm volatile("" : "+s"(w_)); F.ws = (unsigned char*)w_; }
        if (F.bx < 64) rwkvB_phase(F, F.bx, 0); else { late_weights(F, TAB, 0, 2, 64); late_weights(F, TAB, 1, 2, 64); }
        __syncthreads();
        { GAS unsigned char* w_ = (GAS unsigned char*)args.ws; asm volatile("" : "+s"(w_)); F.ws = (unsigned char*)w_; }
        rwkvA_queue(F, TAB, 1, (unsigned*)(F.ws + WS_CTL + CTL_RKAQ));
        xcd_barrier(bar);
        { GAS unsigned char* w_ = (GAS unsigned char*)args.ws; asm volatile("" : "+s"(w_)); F.ws = (unsigned char*)w_; }
        if (F.bx < 64) rwkvB_phase(F, F.bx, 1);
    } SEAM(3);
    if (IN(4)) for (int rep_ = 0; rep_ < REPS(4); ++rep_) { if (rep_) xcd_barrier(bar); PH_BEGIN post_phase(F, TAB); } SEAM(4);
    if (IN(5)) for (int rep_ = 0; rep_ < REPS(5); ++rep_) { if (rep_) xcd_barrier(bar); PH_BEGIN
        Gemm g{(const bf16_t*)(ws + WS_YA), (const bf16_t*)(ws + WS_WA), M, D, 1024}; StaticOrder S; S.init(M, D, F.G, F.bx);
        pg8::EpiMerge E{GATES, (bf16_t*)(ws + WS_MERGED)};
        pg8::gemm_phase<pg8::EpiMerge, StaticOrder, PG8_ALIGN, PG8_SP2>(F.lds + RING_OFF, g, S, E);
    } SEAM(5);
    if (IN(6)) for (int rep_ = 0; rep_ < REPS(6); ++rep_) { if (rep_) xcd_barrier(bar); PH_BEGIN
        Gemm g{(const bf16_t*)(ws + WS_MERGED), (const bf16_t*)(ws + WS_WO), M, D, D}; StaticOrder S; S.init(M, D, F.G, F.bx);
        pg8::EpiResNorm<0> E{TAB[I_X], F.out, (bf16_t*)(ws + WS_XN), TAB[I_NFG], (float*)(ws + WS_CTL + CTL_SS1), (unsigned*)(ws + WS_CTL + CTL_CNT1), NORM_EPS, (bf16_t*)(ws + WS_X1B)};
        pg8::gemm_phase<pg8::EpiResNorm<0>, StaticOrder, PG8_ALIGN, PG8_SP2>(F.lds + RING_OFF, g, S, E);
    } SEAM(6);
    if (IN(7)) for (int rep_ = 0; rep_ < REPS(7); ++rep_) { if (rep_) xcd_barrier(bar); PH_BEGIN
        Gemm g{(const bf16_t*)(ws + WS_XN), (const bf16_t*)(ws + WS_W1), M, FF, D}; StaticOrder S; S.init(M, FF, F.G, F.bx);
        EpiRow8<pg8::FRelu2> E{{(bf16_t*)(ws + WS_H)}};
        pg8::gemm_phase<EpiRow8<pg8::FRelu2>, StaticOrder, PG8_ALIGN, PG8_SP2>(F.lds + RING_OFF, g, S, E);
    } SEAM(7);
    if (IN(8)) for (int rep_ = 0; rep_ < REPS(8); ++rep_) { if (rep_) xcd_barrier(bar); PH_BEGIN
        Gemm g{(const bf16_t*)(ws + WS_H), (const bf16_t*)(ws + WS_W2), M, D, FF}; StaticOrder S; S.init(M, D, F.G, F.bx);
        pg8::EpiResNorm<1> E{nullptr, F.out, nullptr, TAB[I_NFIN], (float*)(ws + WS_CTL + CTL_SS2), (unsigned*)(ws + WS_CTL + CTL_CNT2), NORM_EPS, (bf16_t*)(ws + WS_X1B)};
        pg8::gemm_phase<pg8::EpiResNorm<1>, StaticOrder, PG8_ALIGN, PG8_SP2>(F.lds + RING_OFF, g, S, E);
    }
#undef IN
#undef SEAM
#undef PH_BEGIN
}


#ifdef DBG_DUMP
__global__ void dbg_dump(float* out, const unsigned char* ws) {
    const size_t i = (size_t)blockIdx.x * blockDim.x + threadIdx.x; if (i >= (size_t)M * 1024) return;
    const size_t m = i >> 10; const int c = (int)(i & 1023); float v = 0.f;
#if DBG_DUMP == 1
    v = bf1(((const bf16*)(ws + WS_O))[m * 1024 + c]);
#elif DBG_DUMP == 2
    v = c < 512 ? bf1(((const bf16*)(ws + WS_Y))[m * 512 + c]) : (c < 520 ? ((const float*)(ws + WS_BON))[m * 8 + (c - 512)] : 0.f);
#elif DBG_DUMP == 3
    v = c < 512 ? bf1(((const bf16*)(ws + WS_Q))[m * 512 + c]) : bf1(((const bf16*)(ws + WS_K))[m * 512 + c - 512]);
#elif DBG_DUMP == 4
    v = c < 512 ? ((const float*)(ws + WS_DEC))[m * 512 + c] : bf1(((const bf16*)(ws + WS_AA))[m * 512 + c - 512]);
#elif DBG_DUMP == 6
    v = c < 256 ? bf1(((const bf16*)(ws + WS_WAG))[m * 256 + c]) : (c < 512 ? bf1(((const bf16*)(ws + WS_LIN))[m * 256 + c - 256]) : 0.f);
#elif DBG_DUMP == 7
    { const bf16* wl = (const bf16*)(ws + WS_WL); const size_t j = (m * 1024 + c); v = j < (size_t)NLORA * KLORA ? bf1(wl[j]) : 0.f; }
#elif DBG_DUMP == 8
    v = c < 512 ? bf1(((const bf16*)(ws + WS_GG))[m * 512 + c]) : 0.f;
#elif DBG_DUMP == 5
    v = bf1(((const bf16*)(ws + WS_RKV))[m * 1536 + c]);
#endif
    out[i] = v;
}
#endif

#ifdef DBG_FIXLORA
__global__ void dbg_fixlora(Args A) {
    const size_t i = (size_t)blockIdx.x * blockDim.x + threadIdx.x; if (i >= (size_t)M * 512) return;
    const size_t m = i >> 9; const int c = (int)(i & 511);
    const bf16* LINr = (const bf16*)(A.ws + WS_LIN) + m * 256;
#if DBG_FIXLORA & 1
    { float g = 0.f; for (int k = 0; k < 128; ++k) g += bf1(LINr[128 + k]) * A[I_G2][(size_t)k * 512 + c]; ((bf16*)(A.ws + WS_GG))[m * 512 + c] = (bf16)f2bf(g); }
#endif
#if DBG_FIXLORA & 2
    { float s = A[I_A0][c]; for (int k = 0; k < 64; ++k) s += bf1(LINr[64 + k]) * A[I_A2][(size_t)k * 512 + c]; ((bf16*)(A.ws + WS_AA))[m * 512 + c] = (bf16)f2bf(1.0f / (1.0f + expf(-s))); }
#endif
#if DBG_FIXLORA & 4
    { float s = A[I_W0][c]; for (int k = 0; k < 64; ++k) s += bf1(LINr[k]) * A[I_W2][(size_t)k * 512 + c]; const float w = -log1pf(expf(-s)) - 0.5f; ((float*)(A.ws + WS_DEC))[m * 512 + c] = expf(-expf(w)); }
#endif
}
#endif
#ifndef MK_ONE_LAUNCH
#define MK_ONE_LAUNCH 0
#endif
#ifndef MK_MASK
#define MK_MASK ((1 << NPHASE) - 1)
#endif
typedef void (*kern_t)(Args);
template <int P> struct KTab { static void fill(kern_t* t) { t[P] = fwd_kernel<(1 << P)>; KTab<P - 1>::fill(t); } };
template <> struct KTab<-1> { static void fill(kern_t*) {} };
extern "C" void kernel_launch(void* const* d_in, const int* in_sizes, int n_in, void* d_out, int out_size, void* d_ws, size_t ws_size, hipStream_t stream) {
    static int grid = 0; static kern_t ktab[NPHASE];
    if (grid == 0) {
        if (n_in != 26 || in_sizes[0] != M * D || out_size != M * D || ws_size < WS_END) { fprintf(stderr, "kernel_launch: unexpected shapes (n_in %d, in0 %d, out %d, ws %zu); nothing launched\n", n_in, n_in > 0 ? in_sizes[0] : -1, out_size, ws_size); grid = -1; return; }
        int dev = 0, cus = 0;
        if (hipGetDevice(&dev) != hipSuccess || hipDeviceGetAttribute(&cus, hipDeviceAttributeMultiprocessorCount, dev) != hipSuccess) { grid = -1; return; }
#if MK_ONE_LAUNCH
        int per_cu = 0;
        if (hipFuncSetAttribute((const void*)fwd_kernel<MK_MASK>, hipFuncAttributeMaxDynamicSharedMemorySize, LDS_BYTES) != hipSuccess) { fprintf(stderr, "kernel_launch: hipFuncSetAttribute failed\n"); grid = -1; return; }
        if (hipOccupancyMaxActiveBlocksPerMultiprocessor(&per_cu, (const void*)fwd_kernel<MK_MASK>, NWAVES * 64, LDS_BYTES) != hipSuccess || per_cu < 1) { fprintf(stderr, "kernel_launch: occupancy query says %d blocks per CU\n", per_cu); (void)hipGetLastError(); grid = -1; return; }
#else
        KTab<NPHASE - 1>::fill(ktab);
        for (int p = 0; p < NPHASE; ++p) if (hipFuncSetAttribute((const void*)ktab[p], hipFuncAttributeMaxDynamicSharedMemorySize, LDS_BYTES) != hipSuccess) { fprintf(stderr, "kernel_launch: hipFuncSetAttribute failed\n"); grid = -1; return; }
#endif
        grid = cus;
        if (grid != 256) fprintf(stderr, "kernel_launch: note: %d CUs (built for 256)\n", grid);
    }
    if (grid < 0) return;
    Args a{};
    for (int i = 0; i < 26; ++i) a.in[i] = (const float*)d_in[i];
    a.out = (float*)d_out; a.ws = (unsigned char*)d_ws;
#if MK_ONE_LAUNCH
    a.ph_lo = 0; a.ph_hi = NPHASE;
    void* kargs[] = {&a};
    hipError_t e = hipLaunchCooperativeKernel((const void*)fwd_kernel<MK_MASK>, dim3(grid), dim3(NWAVES * 64), kargs, LDS_BYTES, stream);
    if (e != hipSuccess) fprintf(stderr, "kernel_launch: cooperative launch failed: %s\n", hipGetErrorString(e));
#else
#ifdef DBG_DUMP
    for (int p = 0; p <= DBG_STOP; ++p) { a.ph_lo = p; a.ph_hi = p + 1; hipLaunchKernelGGL(ktab[p], dim3(grid), dim3(NWAVES * 64), LDS_BYTES, stream, a); }
    hipLaunchKernelGGL(dbg_dump, dim3((M * 1024) / 256), dim3(256), 0, stream, (float*)d_out, (const unsigned char*)d_ws);
#else
    for (int p = 0; p < NPHASE; ++p) { a.ph_lo = p; a.ph_hi = p + 1; hipLaunchKernelGGL(ktab[p], dim3(grid), dim3(NWAVES * 64), LDS_BYTES, stream, a);
#ifdef DBG_FIXLORA
        if (p == 3) hipLaunchKernelGGL(dbg_fixlora, dim3((M * 512) / 256), dim3(256), 0, stream, a);
#endif
    }
#endif
#endif
}
```

```cpp
#define MK_ONE_LAUNCH 1
#include <hip/hip_runtime.h>
#include <cstdio>
#include <cstdint>
constexpr int NWAVES = 8;
constexpr int BATCH = 8, SEQ = 2048, D = 1024, M = BATCH * SEQ;
constexpr int D_IN = 5376, FF = 4096, RWW = 512, NLORA = 1536, KLORA = 256;
constexpr float NORM_EPS = 1e-6f, SUBLN_EPS = 1e-5f, GN_EPS = 64e-5f, LAMBDA_INIT = 0.2f;
constexpr size_t MiB = 1u << 20;
constexpr size_t WS_CTL = 0, CTL_ZERO_BYTES = 256 * 1024;
constexpr size_t CTL_SS1 = 65536, CTL_SS2 = 131072, CTL_CNT1 = 196608, CTL_CNT2 = 212992, CTL_ATTQ = 229376, CTL_RKAQ = 229380;
constexpr size_t WS_ROPE_C = 512 * 1024, WS_ROPE_S = 768 * 1024;
constexpr size_t WS_BON = 1 * MiB;
constexpr size_t WS_WIN = 2 * MiB;
constexpr size_t WS_WA = WS_WIN + (size_t)D_IN * D * 2;
constexpr size_t WS_WB = WS_WA + 1 * MiB;
constexpr size_t WS_WO = WS_WB + 1 * MiB;
constexpr size_t WS_W1 = WS_WO + 2 * MiB;
constexpr size_t WS_W2 = WS_W1 + 8 * MiB;
constexpr size_t WS_WL = WS_W2 + 8 * MiB;
static_assert(WS_WL + (size_t)NLORA * KLORA * 2 <= 34 * MiB, "weights");
constexpr size_t WS_XN = 34 * MiB;
constexpr size_t WS_DEC = WS_XN;
constexpr size_t WS_Q = 66 * MiB, WS_K = 82 * MiB, WS_V = 98 * MiB;
constexpr size_t WS_RKV = 114 * MiB;
constexpr size_t WS_WAG = 162 * MiB, WS_LIN = 242 * MiB;
constexpr size_t WS_Y = 162 * MiB;
constexpr size_t WS_AA = 178 * MiB, WS_GG = 194 * MiB;
constexpr size_t WS_O = 210 * MiB;
constexpr size_t WS_YA = 66 * MiB, WS_YB = 82 * MiB;
constexpr size_t WS_TMP = 114 * MiB;
constexpr size_t WS_MERGED = 114 * MiB;
constexpr size_t WS_X1B = 194 * MiB;
constexpr size_t WS_H = 66 * MiB;
constexpr size_t WS_END = 252 * MiB;
constexpr int RING_OFF = 0, RING_BYTES = 131072;
constexpr int LDS_BYTES = 163840;

#include <hip/hip_runtime.h>
#include <cstdio>
#include <cstdint>
namespace pg8 {
#define PG8_LAS __attribute__((address_space(3)))
typedef unsigned short bf16_t;
typedef short bf16x8 __attribute__((ext_vector_type(8)));
typedef float f32x4 __attribute__((ext_vector_type(4)));
typedef unsigned u32x4 __attribute__((ext_vector_type(4)));
constexpr int BM = 256, BK = 64, HALF = 128, HTB = HALF * BK * 2  , STAGE_BYTES = 8 * HTB, NXCD = 8, WGM = 8;

__host__ __device__ __forceinline__ int lds_byte(int r, int c) { const int st = (r >> 4) * 2 + (c >> 5), rr = r & 15, cc = c & 31, ob = rr * 64 + cc * 2; return st * 1024 + (ob ^ (((ob >> 9) & 1) << 5)); }
__host__ __device__ __forceinline__ void stage_rc(int b, int& R, int& C) { const int st = b / 1024, sb = b % 1024, swz = sb ^ (((sb >> 9) & 1) << 5); R = (st >> 1) * 16 + swz / 64; C = (st & 1) * 32 + (swz % 64) / 2; }
__host__ __device__ __forceinline__ int perm32(int rho) { const int n = rho >> 4, i = rho & 15; return 8 * (i >> 2) + 4 * n + (i & 3); }

struct Unit { int pm, pn; };
struct Gemm { const bf16_t* A; const bf16_t* Bt; int M, N, K; };

struct StaticOrder {
    int nM, nN, nwg, G, c;
    __host__ __device__ void init(int M, int N, int G_, int c_) { nM = M / BM; nN = N / BM; nwg = nM * nN; G = G_; c = c_; }
    __host__ __device__ bool next(int i, Unit& u) const {
        const long L = (long)i * G + c; if (L >= nwg) return false;
        int wgid = (int)L; { const int q = nwg / NXCD, r = nwg % NXCD, xcd = wgid % NXCD, off = wgid / NXCD; wgid = (xcd < r ? xcd * (q + 1) : r * (q + 1) + (xcd - r) * q) + off; }
        const int nig = WGM * nN, gid = wgid / nig, fm = gid * WGM, gsz = (nM - fm) < WGM ? (nM - fm) : WGM;
        u.pm = fm + ((wgid % nig) % gsz); u.pn = (wgid % nig) / gsz; return true;
    }
    __device__ __forceinline__ void a_ready(const Unit&) const {}
    __device__ __forceinline__ void done(const Unit&) const {}
};

typedef float f32x2c_t __attribute__((ext_vector_type(2))); typedef __bf16 bf16x2c_t __attribute__((ext_vector_type(2)));
__device__ __forceinline__ unsigned cvt_pk_bf16(float lo, float hi) { f32x2c_t v = {lo, hi}; bf16x2c_t b = __builtin_convertvector(v, bf16x2c_t); return __builtin_bit_cast(unsigned, b); }
typedef float f32x2 __attribute__((ext_vector_type(2)));
__device__ __forceinline__ f32x2 gelu_pk(f32x2 v) {
    const f32x2 av = __builtin_elementwise_abs(v), d = av * 0.2316418882f + 1.0f;
    f32x2 t; t.x = __builtin_amdgcn_rcpf(d.x); t.y = __builtin_amdgcn_rcpf(d.y);
    f32x2 q = t * 0.5307027145f + (-0.7265760135f); q = q * t + 0.7107068705f; q = q * t + (-0.142248368f); q = q * t + 0.127414796f; q = q * t;
    const f32x2 s = (v * v) * (-0.72134752044f);
    f32x2 e; e.x = __builtin_amdgcn_exp2f(s.x); e.y = __builtin_amdgcn_exp2f(s.y);
    const f32x2 m = v * (q * e), r = v - m;
    f32x2 o; o.x = v.x < 0.f ? m.x : r.x; o.y = v.y < 0.f ? m.y : r.y; return o;
}

template <int ACT  > struct EpiBf16 {
    static constexpr int MIDK = 0; static constexpr bool PERM = true, AFTER_DRAIN = false; static_assert(ACT == 0 || ACT == 1, "EpiBf16: ACT is 0 (none) or 1 (gelu_pk)");
    bf16_t* O; int ldc; const float* bias; int split_cols; size_t split_stride; float scale0;
    __device__ __forceinline__ void operator()(const f32x4 (&acc)[2][2][4][2], const Unit& u, int wr, int wc, int fr, int fq) const {
        const int row0 = u.pm * BM + wr * 64 + fr; int colt = u.pn * BM; bf16_t* base = O;
        float sc = 1.f; if (split_cols) { const int t = colt / split_cols; base += (size_t)t * split_stride; colt -= t * split_cols; if (t == 0) sc = scale0; }
        const int col0 = colt + wc * 32 + 8 * fq, bcol0 = u.pn * BM + wc * 32 + 8 * fq;
        f32x4 bv[2][2];
#pragma unroll
        for (int bj = 0; bj < 2; ++bj)
#pragma unroll
            for (int n = 0; n < 2; ++n) bv[bj][n] = bias ? *(const f32x4*)(bias + bcol0 + bj * HALF + 4 * n) : (f32x4){0.f, 0.f, 0.f, 0.f};
#pragma unroll
        for (int ai = 0; ai < 2; ++ai)
#pragma unroll
            for (int m = 0; m < 4; ++m) { bf16_t* rowp = base + (size_t)(row0 + ai * HALF + m * 16) * ldc + col0;
#pragma unroll
                for (int bj = 0; bj < 2; ++bj) { f32x4 v0 = acc[ai][bj][m][0] + bv[bj][0], v1 = acc[ai][bj][m][1] + bv[bj][1];
                    if (ACT == 1) { f32x2 a = gelu_pk((f32x2){v0[0], v0[1]}), b = gelu_pk((f32x2){v0[2], v0[3]}), c = gelu_pk((f32x2){v1[0], v1[1]}), d = gelu_pk((f32x2){v1[2], v1[3]});
                        v0 = (f32x4){a.x, a.y, b.x, b.y}; v1 = (f32x4){c.x, c.y, d.x, d.y}; }
                    v0 = v0 * sc; v1 = v1 * sc; u32x4 w; w.x = cvt_pk_bf16(v0[0], v0[1]); w.y = cvt_pk_bf16(v0[2], v0[3]); w.z = cvt_pk_bf16(v1[0], v1[1]); w.w = cvt_pk_bf16(v1[2], v1[3]);
                    *(u32x4*)(rowp + bj * HALF) = w; } }
    }
};
typedef unsigned u32x2 __attribute__((ext_vector_type(2)));
__device__ __forceinline__ float bf_lo(unsigned w) { return __builtin_bit_cast(float, w << 16); }
__device__ __forceinline__ float bf_hi(unsigned w) { return __builtin_bit_cast(float, w & 0xffff0000u); }
__device__ __forceinline__ u32x4 pack8(f32x4 v0, f32x4 v1) { u32x4 w; w.x = cvt_pk_bf16(v0[0], v0[1]); w.y = cvt_pk_bf16(v0[2], v0[3]); w.z = cvt_pk_bf16(v1[0], v1[1]); w.w = cvt_pk_bf16(v1[2], v1[3]); return w; }
__device__ __forceinline__ float sigmoidf_(float x) { return __builtin_amdgcn_rcpf(1.0f + __expf(-x)); }
template <class F> struct EpiRow8 {
    static constexpr int MIDK = 0; static constexpr bool PERM = true, AFTER_DRAIN = false;
    F f;
    __device__ __forceinline__ void operator()(const f32x4 (&acc)[2][2][4][2], const Unit& u, int wr, int wc, int fr, int fq) const {
        const int row0 = u.pm * BM + wr * 64 + fr, c0 = wc * 32 + 8 * fq;
#pragma unroll
        for (int ai = 0; ai < 2; ++ai)
#pragma unroll
            for (int m = 0; m < 4; ++m) { const int row = row0 + ai * HALF + m * 16;
#pragma unroll
                for (int bj = 0; bj < 2; ++bj) { f(u.pn, row, c0 + bj * HALF, acc[ai][bj][m][0], acc[ai][bj][m][1]); if (F::FENCE) asm volatile("" ::: "memory"); } }
    }
};
constexpr float ATT_C2 = 0.125f * 1.4426950408889634f;
struct FProj {
    static constexpr bool FENCE = false;
    unsigned char* ws; bf16_t* GATES;
    __device__ __forceinline__ void operator()(int pn, int row, int cu, f32x4 v0, f32x4 v1) const {
        if (pn < 4) {
            const int sh = cu >> 6, j = (cu & 63) >> 3, pos = row & 2047;
            const f32x4 c = *(const f32x4*)((const float*)(ws + WS_ROPE_C) + pos * 32 + 4 * j), s = *(const f32x4*)((const float*)(ws + WS_ROPE_S) + pos * 32 + 4 * j);
            const float sc = pn < 2 ? ATT_C2 : 1.0f;
            const f32x4 o1 = (v0 * c - v1 * s) * sc, o2 = (v1 * c + v0 * s) * sc;
            bf16_t* dst = (bf16_t*)(ws + (pn < 2 ? WS_Q : WS_K)) + (size_t)row * 512 + (pn & 1) * 256 + sh * 64 + 4 * j;
            u32x2 w1, w2; w1.x = cvt_pk_bf16(o1[0], o1[1]); w1.y = cvt_pk_bf16(o1[2], o1[3]); w2.x = cvt_pk_bf16(o2[0], o2[1]); w2.y = cvt_pk_bf16(o2[2], o2[3]);
            *(u32x2*)dst = w1; *(u32x2*)(dst + 32) = w2;
        } else if (pn < 13) {
            size_t off; int pitch, col;
            if (pn < 6) { off = WS_V; pitch = 512; col = (pn - 4) * 256; }
            else if (pn < 12) { off = WS_RKV; pitch = 1536; col = (pn - 6) * 256; }
            else { off = WS_WAG; pitch = 256; col = 0; }
            *(u32x4*)((bf16_t*)(ws + off) + (size_t)row * pitch + col + cu) = pack8(v0, v1);
        } else *(u32x4*)(GATES + (size_t)row * 2048 + (pn - 13) * 256 + cu) = pack8(v0, v1);
    }
};
struct FLora {
    static constexpr bool FENCE = false;
    unsigned char* ws; const float *w0, *a0;
    __device__ __forceinline__ void operator()(int pn, int row, int cu, f32x4 v0, f32x4 v1) const {
        const int c = (pn & 1) * 256 + cu;
        if (pn < 2) {
            const f32x4 b0 = *(const f32x4*)(w0 + c), b1 = *(const f32x4*)(w0 + c + 4);
            float* dst = (float*)(ws + WS_DEC) + (size_t)row * 512 + c; *(f32x4*)dst = v0 + b0; *(f32x4*)(dst + 4) = v1 + b1;
        } else if (pn < 4) {
            const f32x4 b0 = *(const f32x4*)(a0 + c), b1 = *(const f32x4*)(a0 + c + 4);
            *(u32x4*)((bf16_t*)(ws + WS_AA) + (size_t)row * 512 + c) = pack8(v0 + b0, v1 + b1);
        } else *(u32x4*)((bf16_t*)(ws + WS_GG) + (size_t)row * 512 + c) = pack8(v0, v1);
    }
};
struct FProjOff {
    static constexpr bool FENCE = false;
    FProj f; int off;
    __device__ __forceinline__ void operator()(int pn, int row, int cu, f32x4 v0, f32x4 v1) const { f(pn + off, row, cu, v0, v1); }
};
struct FLoraG {
    static constexpr bool FENCE = false;
    unsigned char* ws;
    __device__ __forceinline__ void operator()(int pn, int row, int cu, f32x4 v0, f32x4 v1) const { *(u32x4*)((bf16_t*)(ws + WS_GG) + (size_t)row * 512 + pn * 256 + cu) = pack8(v0, v1); }
};
struct EpiMerge {
    static constexpr int MIDK = 8; static constexpr bool PERM = true, AFTER_DRAIN = false;
    const bf16_t* GATES; bf16_t* MERGED;
    static __device__ __forceinline__ float ratio_(float ga, float gb) { return (1.0f + __expf(-gb)) * __builtin_amdgcn_rcpf(1.0f + __expf(-ga)); }
    __device__ __forceinline__ void mid(f32x4 (&acc)[2][2][4][2], const Unit& u, int wr, int wc, int fr, int fq) const {
        int fr_ = fr; asm volatile("" : "+v"(fr_));
        const bf16_t* gp0 = GATES + (size_t)(u.pm * BM + wr * 64 + fr_) * 2048 + u.pn * BM + wc * 32 + 8 * fq;
#pragma unroll
        for (int ai = 0; ai < 2; ++ai)
#pragma unroll
            for (int m = 0; m < 4; ++m)
#pragma unroll
                for (int bj = 0; bj < 2; ++bj) { const bf16_t* gp = gp0 + (size_t)(ai * HALF + m * 16) * 2048 + bj * HALF;
                    const u32x4 ga = *(const u32x4*)gp, gb = *(const u32x4*)(gp + 1024);
                    f32x4& v0 = acc[ai][bj][m][0]; f32x4& v1 = acc[ai][bj][m][1];
                    v0[0] *= ratio_(bf_lo(ga.x), bf_lo(gb.x)); v0[1] *= ratio_(bf_hi(ga.x), bf_hi(gb.x)); v0[2] *= ratio_(bf_lo(ga.y), bf_lo(gb.y)); v0[3] *= ratio_(bf_hi(ga.y), bf_hi(gb.y));
                    v1[0] *= ratio_(bf_lo(ga.z), bf_lo(gb.z)); v1[1] *= ratio_(bf_hi(ga.z), bf_hi(gb.z)); v1[2] *= ratio_(bf_lo(ga.w), bf_lo(gb.w)); v1[3] *= ratio_(bf_hi(ga.w), bf_hi(gb.w));
                    asm volatile("" ::: "memory"); }
    }
    __device__ __forceinline__ void operator()(const f32x4 (&acc)[2][2][4][2], const Unit& u, int wr, int wc, int fr, int fq) const {
        const int row0 = u.pm * BM + wr * 64 + fr, c0 = u.pn * BM + wc * 32 + 8 * fq;
#pragma unroll
        for (int ai = 0; ai < 2; ++ai)
#pragma unroll
            for (int m = 0; m < 4; ++m) { const int row = row0 + ai * HALF + m * 16;
#pragma unroll
                for (int bj = 0; bj < 2; ++bj) { const u32x4 g = *(const u32x4*)(GATES + (size_t)row * 2048 + 1024 + c0 + bj * HALF);
                    f32x4 v0 = acc[ai][bj][m][0], v1 = acc[ai][bj][m][1];
                    v0[0] *= sigmoidf_(bf_lo(g.x)); v0[1] *= sigmoidf_(bf_hi(g.x)); v0[2] *= sigmoidf_(bf_lo(g.y)); v0[3] *= sigmoidf_(bf_hi(g.y));
                    v1[0] *= sigmoidf_(bf_lo(g.z)); v1[1] *= sigmoidf_(bf_hi(g.z)); v1[2] *= sigmoidf_(bf_lo(g.w)); v1[3] *= sigmoidf_(bf_hi(g.w));
                    *(u32x4*)(MERGED + (size_t)row * 1024 + c0 + bj * HALF) = pack8(v0, v1); } }
    }
};
struct FRes {
    static constexpr bool FENCE = false;
    const float* base; float* out;
    __device__ __forceinline__ void operator()(int pn, int row, int cu, f32x4 v0, f32x4 v1) const {
        const size_t off = (size_t)row * 1024 + pn * 256 + cu; const f32x4 b0 = *(const f32x4*)(base + off), b1 = *(const f32x4*)(base + off + 4);
        *(f32x4*)(out + off) = b0 + v0; *(f32x4*)(out + off + 4) = b1 + v1;
    }
};
struct FRelu2 {
    static constexpr bool FENCE = false;
    bf16_t* H;
    __device__ __forceinline__ void operator()(int pn, int row, int cu, f32x4 v0, f32x4 v1) const {
        f32x4 r0, r1;
#pragma unroll
        for (int e = 0; e < 4; ++e) { const float a = __builtin_fmaxf(v0[e], 0.f), b = __builtin_fmaxf(v1[e], 0.f); r0[e] = a * a; r1[e] = b * b; }
        *(u32x4*)(H + (size_t)row * 4096 + pn * 256 + cu) = pack8(r0, r1);
    }
};

__device__ __forceinline__ float xsum_fq(float x) {
    { auto r = __builtin_amdgcn_permlane16_swap(__builtin_bit_cast(unsigned, x), __builtin_bit_cast(unsigned, x), false, false); const unsigned a = r[0], b = r[1]; x = __builtin_bit_cast(float, a) + __builtin_bit_cast(float, b); }
    { auto r = __builtin_amdgcn_permlane32_swap(__builtin_bit_cast(unsigned, x), __builtin_bit_cast(unsigned, x), false, false); const unsigned a = r[0], b = r[1]; x = __builtin_bit_cast(float, a) + __builtin_bit_cast(float, b); }
    return x;
}
template <int MODE> struct EpiResNorm {
    static constexpr int MIDK = 0; static constexpr bool PERM = true, AFTER_DRAIN = false;
    const float* base; float* out; bf16_t* xn; const float* g; float* ss; unsigned* cnt; float eps; bf16_t* x1b;
    __device__ __forceinline__ void operator()(f32x4 (&acc)[2][2][4][2], const Unit& u, int wr, int wc, int fr, int fq) const {
        const int row0 = u.pm * BM + wr * 64 + fr, c0 = u.pn * BM + wc * 32 + 8 * fq;
#pragma unroll
        for (int ai = 0; ai < 2; ++ai)
#pragma unroll
            for (int m = 0; m < 4; ++m) { const int row = row0 + ai * HALF + m * 16; float s = 0.f;
#pragma unroll
                for (int bj = 0; bj < 2; ++bj) { const size_t off = (size_t)row * 1024 + c0 + bj * HALF; f32x4 b0, b1;
                    if (MODE == 0) { b0 = *(const f32x4*)(base + off); b1 = *(const f32x4*)(base + off + 4); }
                    else { const u32x4 w = *(const u32x4*)(x1b + off); b0 = (f32x4){bf_lo(w.x), bf_hi(w.x), bf_lo(w.y), bf_hi(w.y)}; b1 = (f32x4){bf_lo(w.z), bf_hi(w.z), bf_lo(w.w), bf_hi(w.w)}; }
                    f32x4& v0 = acc[ai][bj][m][0]; f32x4& v1 = acc[ai][bj][m][1]; v0 += b0; v1 += b1;
                    if (MODE == 0) *(u32x4*)(x1b + off) = pack8(v0, v1);
                    s += (v0[0] * v0[0] + v0[1] * v0[1]) + (v0[2] * v0[2] + v0[3] * v0[3]) + (v1[0] * v1[0] + v1[1] * v1[1]) + (v1[2] * v1[2] + v1[3] * v1[3]); }
                s = xsum_fq(s);
                if (fq == 0) __hip_atomic_fetch_add(ss + row, s, __ATOMIC_RELAXED, __HIP_MEMORY_SCOPE_AGENT);
                if (m & 1) asm volatile("" ::: "memory"); }
        asm volatile("s_waitcnt vmcnt(0)" ::: "memory");
        unsigned* c_ = cnt + 64 * u.pm;
        if (fr == 0 && fq == 0) __hip_atomic_fetch_add(c_, 1u, __ATOMIC_RELAXED, __HIP_MEMORY_SCOPE_AGENT);
        { unsigned spins = 0; while ((unsigned)__builtin_amdgcn_readfirstlane(__hip_atomic_load(c_, __ATOMIC_RELAXED, __HIP_MEMORY_SCOPE_AGENT)) < 32u && ++spins < (1u << 22)) __builtin_amdgcn_s_sleep(2); }
        asm volatile("" ::: "memory");
#pragma unroll
        for (int ai = 0; ai < 2; ++ai)
#pragma unroll
            for (int m = 0; m < 4; ++m) { const int row = row0 + ai * HALF + m * 16;
                const float rstd = 1.0f / sqrtf(__hip_atomic_load(ss + row, __ATOMIC_RELAXED, __HIP_MEMORY_SCOPE_AGENT) * (1.0f / 1024.0f) + eps);
#pragma unroll
                for (int bj = 0; bj < 2; ++bj) { const size_t off = (size_t)row * 1024 + c0 + bj * HALF; const f32x4 g0 = *(const f32x4*)(g + c0 + bj * HALF), g1 = *(const f32x4*)(g + c0 + bj * HALF + 4);
                    const f32x4 o0 = acc[ai][bj][m][0] * rstd * g0, o1 = acc[ai][bj][m][1] * rstd * g1;
                    if (MODE == 0) *(u32x4*)(xn + off) = pack8(o0, o1); else { *(f32x4*)(out + off) = o0; *(f32x4*)(out + off + 4) = o1; } }
                if (m & 1) asm volatile("" ::: "memory"); }
    }
};

struct PanelOrder {
    int pm, ntiles;
    __device__ __forceinline__ bool next(int i, Unit& u) const { if (i >= ntiles) return false; int p = pm; asm volatile("" : "+s"(p)); u.pm = p; u.pn = i; return true; }
    __device__ __forceinline__ void a_ready(const Unit&) const {}
    __device__ __forceinline__ void done(const Unit&) const {}
};
template <class Epi, class Sched, bool ALIGN_EPI = false, bool SP2 = false>
__device__ __forceinline__ void gemm_phase(PG8_LAS unsigned char* lds, const Gemm g, const Sched& S, const Epi& E) {
    int tid_ = threadIdx.x; asm volatile("" : "+v"(tid_));
    const int tid = tid_, wid = __builtin_amdgcn_readfirstlane(tid >> 6), lane = tid & 63, wr = wid >> 2, wc = wid & 3, fr = lane & 15, fq = lane >> 4;
    const int K = g.K, nt = K / BK;
    unsigned voffA[2], voffB[2];
#pragma unroll
    for (int i = 0; i < 2; ++i) { int R, C; stage_rc(tid * 16 + i * 8192, R, C); const int Rb = Epi::PERM ? ((R & ~31) + perm32(R & 31)) : R;
        voffA[i] = (unsigned)(R * K + C) * 2u; voffB[i] = (unsigned)(Rb * K + C) * 2u; }
    const size_t kstep = (size_t)(BK * 2);
    const size_t hstep = (size_t)HALF * K * 2;
    const size_t tstep = 2 * hstep;
    const unsigned ldsw = (unsigned)wid * 1024u;
    const int aoff = lds_byte(wr * 64 + fr, fq * 8), boff = lds_byte(wc * 32 + fr, fq * 8);
#define PG8_SA(b, h) (((b) * 2 + (h)) * HTB)
#define PG8_SB(b, h) ((4 + (b) * 2 + (h)) * HTB)
#define PG8_STAGE(bufoff, gbase, voff) do { _Pragma("unroll") for (int _i = 0; _i < 2; ++_i) \
        __builtin_amdgcn_global_load_lds((const unsigned*)((const char*)(gbase) + (voff)[_i]), (PG8_LAS unsigned*)(lds + (bufoff) + ldsw + _i * 8192), 16, 0, 0); } while (0)
#define PG8_LDA(dst, b, h) do { _Pragma("unroll") for (int m = 0; m < 4; ++m) _Pragma("unroll") for (int k = 0; k < 2; ++k) dst[m][k] = *(const PG8_LAS bf16x8*)(lds + PG8_SA(b, h) + aoff + m * 2048 + k * 1024); } while (0)
#define PG8_LDB(dst, b, h) do { _Pragma("unroll") for (int n = 0; n < 2; ++n) _Pragma("unroll") for (int k = 0; k < 2; ++k) dst[n][k] = *(const PG8_LAS bf16x8*)(lds + PG8_SB(b, h) + boff + n * 2048 + k * 1024); } while (0)
#define PG8_MMA(ai, bj, At, Bt) do { __builtin_amdgcn_s_setprio(1); _Pragma("unroll") for (int m = 0; m < 4; ++m) _Pragma("unroll") for (int n = 0; n < 2; ++n) _Pragma("unroll") for (int k = 0; k < 2; ++k) \
        acc[ai][bj][m][n] = __builtin_amdgcn_mfma_f32_16x16x32_bf16(Bt[n][k], At[m][k], acc[ai][bj][m][n], 0, 0, 0); __builtin_amdgcn_s_setprio(0); } while (0)
#define PG8_WAIT_V(n) asm volatile("s_waitcnt vmcnt(" #n ")" ::: "memory")
#define PG8_WAIT_L(n) asm volatile("s_waitcnt lgkmcnt(" #n ")" ::: "memory")
#define PG8_BAR __builtin_amdgcn_s_barrier()
#define PG8_SCHED __builtin_amdgcn_sched_barrier(0)
    Unit cur, nxt; int ui = 0;
    if (!S.next(0, cur)) return;
    f32x4 acc[2][2][4][2];
#pragma unroll
    for (int a = 0; a < 2; ++a)
#pragma unroll
        for (int b = 0; b < 2; ++b)
#pragma unroll
            for (int m = 0; m < 4; ++m)
#pragma unroll
                for (int n = 0; n < 2; ++n) acc[a][b][m][n] = (f32x4){0.f, 0.f, 0.f, 0.f};
    bf16x8 At[4][2], B0[2][2], B1[2][2];
    const char* cA = (const char*)g.A + (size_t)cur.pm * tstep; const char* cB = (const char*)g.Bt + (size_t)cur.pn * tstep;
    S.a_ready(cur);
    if constexpr (SP2) {
        PG8_STAGE(PG8_SB(0, 0), cB, voffB); PG8_STAGE(PG8_SB(0, 1), cB + hstep, voffB); PG8_STAGE(PG8_SA(0, 0), cA, voffA); PG8_STAGE(PG8_SA(0, 1), cA + hstep, voffA);
        if (wr == 1) PG8_BAR;
        PG8_WAIT_V(2); PG8_BAR;
        PG8_STAGE(PG8_SB(1, 0), cB + kstep, voffB); PG8_STAGE(PG8_SA(1, 0), cA + kstep, voffA); PG8_STAGE(PG8_SB(1, 1), cB + hstep + kstep, voffB);
        PG8_WAIT_V(6); PG8_BAR;
    } else {
        PG8_STAGE(PG8_SB(0, 0), cB, voffB); PG8_STAGE(PG8_SA(0, 0), cA, voffA); PG8_STAGE(PG8_SB(0, 1), cB + hstep, voffB); PG8_STAGE(PG8_SA(0, 1), cA + hstep, voffA);
        if (wr == 1) PG8_BAR;
        PG8_WAIT_V(4); PG8_BAR;
        PG8_STAGE(PG8_SB(1, 0), cB + kstep, voffB); PG8_STAGE(PG8_SA(1, 0), cA + kstep, voffA); PG8_STAGE(PG8_SB(1, 1), cB + hstep + kstep, voffB);
        PG8_WAIT_V(6); PG8_BAR;
    }
    for (;;) {
        const bool has_next = S.next(ui + 1, nxt);
        const char* nA = has_next ? (const char*)g.A + (size_t)nxt.pm * tstep : cA; const char* nB = has_next ? (const char*)g.Bt + (size_t)nxt.pn * tstep : cB;
        for (int t = 0; t < nt; t += 2) {
            if constexpr (Epi::MIDK > 0) { if (t == Epi::MIDK) E.mid(acc, cur, wr, wc, fr, fq); }
            const bool last = (t == nt - 2);
            const char* a1 = cA + (size_t)(t + 1) * kstep;
            const char* a2 = last ? nA : cA + (size_t)(t + 2) * kstep; const char* b2 = last ? nB : cB + (size_t)(t + 2) * kstep;
            const char* a3 = a2 + kstep; const char* b3 = b2 + kstep;
            if (last && has_next) S.a_ready(nxt);
            if constexpr (SP2) {
            PG8_LDB(B0, 0, 0); PG8_LDB(B1, 0, 1); PG8_SCHED; PG8_LDA(At, 0, 0); PG8_STAGE(PG8_SA(1, 1), a1 + hstep, voffA);
            PG8_WAIT_V(8); PG8_WAIT_L(0); PG8_BAR; PG8_MMA(0, 0, At, B0); PG8_MMA(0, 1, At, B1); PG8_BAR; PG8_SCHED;
            PG8_LDA(At, 0, 1); PG8_STAGE(PG8_SB(0, 0), b2, voffB); PG8_STAGE(PG8_SB(0, 1), b2 + hstep, voffB); PG8_STAGE(PG8_SA(0, 0), a2, voffA);
            PG8_WAIT_V(8); PG8_WAIT_L(0); PG8_BAR; PG8_MMA(1, 0, At, B0); PG8_MMA(1, 1, At, B1); PG8_BAR; PG8_SCHED;
            PG8_LDB(B0, 1, 0); PG8_LDB(B1, 1, 1); PG8_SCHED; PG8_LDA(At, 1, 0); PG8_STAGE(PG8_SA(0, 1), a2 + hstep, voffA);
            PG8_WAIT_V(8); PG8_WAIT_L(0); PG8_BAR; PG8_MMA(0, 0, At, B0); PG8_MMA(0, 1, At, B1); PG8_BAR; PG8_SCHED;
            PG8_LDA(At, 1, 1); PG8_STAGE(PG8_SB(1, 0), b3, voffB); PG8_STAGE(PG8_SB(1, 1), b3 + hstep, voffB); PG8_STAGE(PG8_SA(1, 0), a3, voffA);
            PG8_WAIT_V(8); PG8_WAIT_L(0); PG8_BAR; PG8_MMA(1, 0, At, B0); PG8_MMA(1, 1, At, B1); PG8_BAR; PG8_SCHED;
            } else {
            PG8_LDB(B0, 0, 0); PG8_SCHED; PG8_LDA(At, 0, 0); PG8_STAGE(PG8_SA(1, 1), a1 + hstep, voffA);
            PG8_WAIT_L(8); PG8_BAR; PG8_WAIT_L(0); PG8_MMA(0, 0, At, B0); PG8_BAR; PG8_SCHED;
            PG8_LDB(B1, 0, 1); PG8_STAGE(PG8_SB(0, 0), b2, voffB);
            PG8_BAR; PG8_WAIT_L(0); PG8_MMA(0, 1, At, B1); PG8_BAR;
            PG8_LDA(At, 0, 1); PG8_STAGE(PG8_SA(0, 0), a2, voffA);
            PG8_BAR; PG8_WAIT_L(0); PG8_MMA(1, 0, At, B0); PG8_BAR; PG8_SCHED;
            PG8_STAGE(PG8_SB(0, 1), b2 + hstep, voffB);
            PG8_WAIT_V(6); PG8_BAR; PG8_MMA(1, 1, At, B1); PG8_BAR;
            PG8_LDB(B0, 1, 0); PG8_SCHED; PG8_LDA(At, 1, 0); PG8_STAGE(PG8_SA(0, 1), a2 + hstep, voffA);
            PG8_WAIT_L(8); PG8_BAR; PG8_WAIT_L(0); PG8_MMA(0, 0, At, B0); PG8_BAR; PG8_SCHED;
            PG8_LDB(B1, 1, 1); PG8_STAGE(PG8_SB(1, 0), b3, voffB);
            PG8_BAR; PG8_WAIT_L(0); PG8_MMA(0, 1, At, B1); PG8_BAR;
            PG8_LDA(At, 1, 1); PG8_STAGE(PG8_SA(1, 0), a3, voffA);
            PG8_BAR; PG8_WAIT_L(0); PG8_MMA(1, 0, At, B0); PG8_BAR; PG8_SCHED;
            PG8_STAGE(PG8_SB(1, 1), b3 + hstep, voffB);
            PG8_WAIT_V(6); PG8_BAR; PG8_MMA(1, 1, At, B1); PG8_BAR;
            }
        }
        if constexpr (ALIGN_EPI) { if (wr == 0) PG8_BAR; }
        if constexpr (!Epi::AFTER_DRAIN) { E(acc, cur, wr, wc, fr, fq); S.done(cur); }
        if (!has_next) break;
#pragma unroll
        for (int a = 0; a < 2; ++a)
#pragma unroll
            for (int b = 0; b < 2; ++b)
#pragma unroll
                for (int m = 0; m < 4; ++m)
#pragma unroll
                    for (int n = 0; n < 2; ++n) acc[a][b][m][n] = (f32x4){0.f, 0.f, 0.f, 0.f};
        cur = nxt; cA = nA; cB = nB; ++ui;
        if constexpr (ALIGN_EPI) { if (wr == 1) PG8_BAR; }
    }
    PG8_WAIT_V(0);
    if constexpr (!ALIGN_EPI) { if (wr == 0) PG8_BAR; }
    PG8_BAR;
    if constexpr (Epi::AFTER_DRAIN) { E.fused(acc, cur, wr, wc, fr, fq, lds, wid, lane); S.done(cur); }
#undef PG8_SA
#undef PG8_SB
#undef PG8_STAGE
#undef PG8_LDA
#undef PG8_LDB
#undef PG8_MMA
#undef PG8_WAIT_V
#undef PG8_WAIT_L
#undef PG8_BAR
#undef PG8_SCHED
}
}

#ifndef PG8_SP2
#define PG8_SP2 true
#endif
#ifndef PG8_ALIGN
#define PG8_ALIGN true
#endif
#include <hip/hip_bf16.h>
#include <cmath>
namespace attn_body {
using bf16=__hip_bfloat16;
using bf16x8=__attribute__((ext_vector_type(8)))short;
using s16x4=__attribute__((ext_vector_type(4)))short;
using f32x16=__attribute__((ext_vector_type(16)))float;
using u32x4=__attribute__((ext_vector_type(4)))unsigned;
constexpr int SEQ=2048,D=64,QP=512,KP=512,VP=512,OP=1024;
constexpr int NW=8,QBLK=32,QB=QBLK*NW,KVBLK=64,NQB=SEQ/QB;
constexpr int ATTN_UNIT_ROWS=QB;
__device__ __forceinline__ int crow(int r,int hi){return (r&3)+8*(r>>2)+4*hi;}
#define SBAR() __builtin_amdgcn_sched_barrier(0)
__device__ __forceinline__ void cmask(f32x16&p0,f32x16&p1,int jb,int wchunk,int){
  if(jb>wchunk){ const float NEG=-INFINITY;
    #pragma unroll
    for(int r=0;r<16;++r){p0[r]=NEG;p1[r]=NEG;} }
}

constexpr int NSLOT=3, SLOTB=8192;
constexpr int LDS_K=0, LDS_V=NSLOT*SLOTB, LDS_WS=2*NSLOT*SLOTB, LDS_OST=LDS_WS+NW*64*4, LDS_BYTES=LDS_OST+NW*4096;
constexpr float C2=0.125f*1.4426950408889634f;
__device__ __forceinline__ void glds16(const void*gsrc,unsigned lds_dst){unsigned keep;
  asm volatile("s_mov_b32 %0, m0\n\ts_mov_b32 m0, %2\n\ts_nop 0\n\tglobal_load_lds_dwordx4 %1, off\n\ts_mov_b32 m0, %0":"=&s"(keep):"v"(gsrc),"s"(lds_dst):"memory");}
__device__ __forceinline__ float max3f(float a,float b,float c){float r;asm("v_max3_f32 %0, %1, %2, %3":"=v"(r):"v"(a),"v"(b),"v"(c));return r;}
__device__ __forceinline__ float max2f(float a,float b){float r;asm("v_max_f32_e32 %0, %1, %2":"=v"(r):"v"(a),"v"(b));return r;}
__device__ __forceinline__ float fadd_s(float a,float b){float r;asm("v_add_f32_e32 %0, %1, %2":"=v"(r):"v"(a),"v"(b));return r;}
__device__ __forceinline__ float fsub_s(float a,float b){float r;asm("v_sub_f32_e32 %0, %1, %2":"=v"(r):"v"(a),"v"(b));return r;}
typedef float f32x2_t __attribute__((ext_vector_type(2))); typedef __bf16 bf16x2_t __attribute__((ext_vector_type(2)));
__device__ __forceinline__ unsigned cvtpk_s(float lo,float hi){f32x2_t v={lo,hi};bf16x2_t b=__builtin_convertvector(v,bf16x2_t);return __builtin_bit_cast(unsigned,b);}
#define WAIT_BAR(N) asm volatile("s_waitcnt vmcnt(" #N ") lgkmcnt(0)\n\ts_barrier":::"memory")

__device__ __forceinline__ void qkt(f32x16&p0,f32x16&p1,const char*Kslot,const bf16x8*qr,const f32x16&negm,int r32,int hi){
  const char*kb=Kslot+hi*1024+r32*16;
  #pragma unroll
  for(int d0=0;d0<4;++d0){
    const bf16x8 b0=*reinterpret_cast<const bf16x8*>(kb+d0*2048);
    const bf16x8 b1=*reinterpret_cast<const bf16x8*>(kb+d0*2048+512);
    if(d0==0){p0=__builtin_amdgcn_mfma_f32_32x32x16_bf16(b0,qr[0],negm,0,0,0);p1=__builtin_amdgcn_mfma_f32_32x32x16_bf16(b1,qr[0],negm,0,0,0);}
    else{p0=__builtin_amdgcn_mfma_f32_32x32x16_bf16(b0,qr[d0],p0,0,0,0);p1=__builtin_amdgcn_mfma_f32_32x32x16_bf16(b1,qr[d0],p1,0,0,0);}}
}
typedef __attribute__((address_space(3))) const char* lds_cptr;
typedef short v4i16_t __attribute__((ext_vector_type(4)));
__device__ __forceinline__ void kload8(bf16x8*kf,lds_cptr kp){
  kf[0]=*(const __attribute__((address_space(3))) bf16x8*)(kp);      kf[1]=*(const __attribute__((address_space(3))) bf16x8*)(kp+512);
  kf[2]=*(const __attribute__((address_space(3))) bf16x8*)(kp+2048); kf[3]=*(const __attribute__((address_space(3))) bf16x8*)(kp+2560);
  kf[4]=*(const __attribute__((address_space(3))) bf16x8*)(kp+4096); kf[5]=*(const __attribute__((address_space(3))) bf16x8*)(kp+4608);
  kf[6]=*(const __attribute__((address_space(3))) bf16x8*)(kp+6144); kf[7]=*(const __attribute__((address_space(3))) bf16x8*)(kp+6656);
}
__device__ __forceinline__ void kload2(bf16x8*kf,lds_cptr kp,int j){ kf[2*j]=*(const __attribute__((address_space(3))) bf16x8*)(kp+j*2048); kf[2*j+1]=*(const __attribute__((address_space(3))) bf16x8*)(kp+j*2048+512); }
__device__ __forceinline__ s16x4 vtr(lds_cptr p){ return __builtin_bit_cast(s16x4,__builtin_amdgcn_ds_read_tr16_b64_v4i16((__attribute__((address_space(3))) v4i16_t*)p)); }
__device__ __forceinline__ float rowmax(const f32x16&p0,const f32x16&p1){
  float a=max3f(p0[0],p0[1],p1[0]),b=max3f(p0[2],p0[3],p1[1]);a=max3f(a,p1[2],p1[3]);
  #pragma unroll
  for(int r=4;r<16;r+=4){a=max3f(a,p0[r],p0[r+1]);b=max3f(b,p0[r+2],p0[r+3]);a=max3f(a,p1[r],p1[r+1]);b=max3f(b,p1[r+2],p1[r+3]);}
  const float m=max2f(a,b);
  auto rr=__builtin_amdgcn_permlane32_swap(__float_as_uint(m),__float_as_uint(m),false,false);
  return max2f(__uint_as_float(rr[0]),__uint_as_float(rr[1]));
}
__device__ __forceinline__ void pv(f32x16*o,int vb,bf16x8 pa0,bf16x8 pa1,bf16x8 pa2,bf16x8 pa3){
  #pragma unroll
  for(int d0=0;d0<2;++d0){s16x4 lo[4],hi[4];
    #pragma unroll
    for(int ks=0;ks<4;++ks){
      asm volatile("ds_read_b64_tr_b16 %0,%1 offset:%c2":"=&v"(lo[ks]):"v"(vb),"i"(d0*4096+ks*1024):"memory");
      asm volatile("ds_read_b64_tr_b16 %0,%1 offset:%c2":"=&v"(hi[ks]):"v"(vb),"i"(d0*4096+ks*1024+512):"memory");}
    asm volatile("s_waitcnt lgkmcnt(0)":::"memory");SBAR();
    #define PK(k) (bf16x8){lo[k][0],lo[k][1],lo[k][2],lo[k][3],hi[k][0],hi[k][1],hi[k][2],hi[k][3]}
    o[d0]=__builtin_amdgcn_mfma_f32_32x32x16_bf16(pa0,PK(0),o[d0],0,0,0);
    o[d0]=__builtin_amdgcn_mfma_f32_32x32x16_bf16(pa1,PK(1),o[d0],0,0,0);
    o[d0]=__builtin_amdgcn_mfma_f32_32x32x16_bf16(pa2,PK(2),o[d0],0,0,0);
    o[d0]=__builtin_amdgcn_mfma_f32_32x32x16_bf16(pa3,PK(3),o[d0],0,0,0);
    #undef PK
  }
}

#ifndef ATTN_STORE16
#define ATTN_STORE16(p,v) (*(u32x4*)(p)=(v))
#endif
template<int THRL> __device__ __forceinline__ void attn_unit(int b,int qcol,int kcol,int vcol,int ocol,int qb,const bf16*Q,const bf16*__restrict__ K,const bf16*__restrict__ V,bf16*O,char*shm){
  int tid_=threadIdx.x; asm volatile("":"+v"(tid_));
  const int tid=tid_,lane=tid&63,r32=lane&31,hi=lane>>5; const int wid=__builtin_amdgcn_readfirstlane(tid>>6);
  const long rowbase=(long)b*SEQ; const int q0=qb*QB;
  const bf16*Qw=Q+(rowbase+q0+wid*QBLK)*QP+qcol;
  const bf16*Kh=K+rowbase*KP+kcol,*Vh=V+rowbase*VP+vcol;
  const unsigned lds0=(unsigned)(uintptr_t)shm;
  float*wsf=(float*)(shm+LDS_WS)+wid*64;
  const bf16*ksrc=Kh+(long)lane*KP+wid*8;
  const bf16*vsrc=Vh+(long)(16*(wid&3)+(lane>>2))*VP+(wid>>2)*32+(lane&3)*8;
  const unsigned kdst=lds0+LDS_K+wid*1024, vdst=lds0+LDS_V+wid*1024;
  #define DMA_K(t,slot) glds16(ksrc+(long)(t)*KVBLK*KP,(unsigned)__builtin_amdgcn_readfirstlane(kdst+(slot)))
  #define DMA_V(t,slot) glds16(vsrc+(long)(t)*KVBLK*VP,(unsigned)__builtin_amdgcn_readfirstlane(vdst+(slot)))
  const int vb0=(int)(lds0+LDS_V)+((lane>>4)&1)*32+(lane&3)*8+(4*hi+((lane&15)>>2))*64;
  const char*Kbase=shm+LDS_K; bf16x8 kf[8];
  const lds_cptr shm3=(lds_cptr)shm; const lds_cptr kp0=shm3+LDS_K+hi*1024+r32*16; const lds_cptr vp0=shm3+LDS_V+((lane>>4)&1)*32+(lane&3)*8+(4*hi+((lane&15)>>2))*64;
  const int NT=(q0+QB)/KVBLK;
  DMA_K(0,0);DMA_V(0,0);DMA_K(1,SLOTB);
  bf16x8 qr[4];
  #pragma unroll
  for(int d0=0;d0<4;++d0)qr[d0]=*reinterpret_cast<const bf16x8*>(&Qw[(long)r32*QP+d0*16+hi*8]);
  float mhat=0.f,l_reg=0.f;f32x16 o[2];o[0]=f32x16{};o[1]=f32x16{};f32x16 negm=f32x16{};asm volatile("":"+v"(negm));
  const int qrel=wid>>1;
  #define CMASK(P0,P1,t) do{int jb_=(t)-(NT-4); if(jb_>=0)cmask(P0,P1,jb_,qrel,hi);}while(0)
  bool resc=false;
  #define START(P0,P1) do{ const float rm=rowmax(P0,P1); resc=false; \
    { const float dl=rm; mhat=fadd_s(mhat,dl); \
      _Pragma("unroll") for(int r=0;r<16;++r){P0[r]=fsub_s(P0[r],dl);P1[r]=fsub_s(P1[r],dl);} \
      _Pragma("unroll") for(int r=0;r<16;++r)negm[r]=-mhat; asm volatile("":"+v"(negm)); } \
    _Pragma("unroll") for(int r=0;r<16;++r)P0[r]=__builtin_amdgcn_exp2f(P0[r]); }while(0)
  #define RESC() do{ if(resc){ asm volatile("s_waitcnt lgkmcnt(0)":::"memory"); \
      _Pragma("unroll") for(int d_=0;d_<2;++d_) _Pragma("unroll") for(int r=0;r<16;++r)o[d_][r]*=wsf[crow(r,hi)]; } }while(0)
  f32x16 pA0,pA1,pB0,pB1;
  int sl_prev=0,sl_cur=0,sl_next=SLOTB;
  #define ROT() do{sl_prev=sl_cur;sl_cur=sl_next;sl_next=(sl_next==(NSLOT-1)*SLOTB)?0:sl_next+SLOTB;}while(0)
  DMA_K(2,2*SLOTB);
  WAIT_BAR(3);
  qkt(pA0,pA1,Kbase,qr,negm,r32,hi);asm volatile("s_nop 15\n\ts_nop 7":"+v"(pA0),"+v"(pA1));CMASK(pA0,pA1,0);
  START(pA0,pA1);
  _Pragma("unroll") for(int r=0;r<16;++r)pA1[r]=__builtin_amdgcn_exp2f(pA1[r]);
  WAIT_BAR(0);
  DMA_K(3,0);DMA_V(1,SLOTB);
  ROT();
  kload8(kf,kp0+sl_cur);
  WAIT_BAR(2);
  s16x4 vlo[8],vhi[8]; u32x4 pw0,pw1,pw2,pw3;
  #define PKW(P,B) cvtpk_s(P[B],P[B+1])
  #define PAF(k) __builtin_bit_cast(bf16x8,pw##k)
  #define VFR(i) (bf16x8){vlo[i][0],vlo[i][1],vlo[i][2],vlo[i][3],vhi[i][0],vhi[i][1],vhi[i][2],vhi[i][3]}
  #define PIN(x) asm volatile("":"+v"(x))
  #define MX3(a,b,c) __builtin_fmaxf(__builtin_fmaxf((a),(b)),(c))
  #define GAPA(MF,A0,A1,A2,A3,W0,W1,PW) do{ MF; sacc+=A0; sacc+=A1; sacc+=A2; sacc+=A3; PIN(sacc); W0; W1; PIN(PW); SBAR(); }while(0)
  #define EX(v) __builtin_amdgcn_exp2f(v)
  #define GAPB(MF,X,B) do{ MF; X[B]=EX(X[B]); X[B+1]=EX(X[B+1]); X[B+2]=EX(X[B+2]); X[B+3]=EX(X[B+3]); PIN(X); SBAR(); }while(0)
  #define VRD(i) do{ vlo[i]=vtr(vp_+(((i)>>2)*4096+((i)&3)*1024)); vhi[i]=vtr(vp_+(((i)>>2)*4096+((i)&3)*1024+512)); }while(0)
  #define KRD(G,j) do{ if(G){ kload2(kf,kp0+sl_next,j); SBAR(); } }while(0)
  #define STEP(C0,C1,P0,P1,t,GK,GV,GL) do{ SBAR(); \
    const lds_cptr vp_=vp0+sl_prev; \
    VRD(0); SBAR(); float sacc=(P0[0]+P0[1]); \
    GAPA(C0=__builtin_amdgcn_mfma_f32_32x32x16_bf16(kf[0],qr[0],negm,0,0,0), P0[2],P0[3],P0[4],P0[5],     pw0[0]=PKW(P0,0), pw0[1]=PKW(P0,2), pw0); \
    VRD(4); SBAR(); GAPA(C1=__builtin_amdgcn_mfma_f32_32x32x16_bf16(kf[1],qr[0],negm,0,0,0), P0[6],P0[7],P0[8],P0[9],     pw0[2]=PKW(P0,4), pw0[3]=PKW(P0,6), pw0); \
    VRD(1); SBAR(); GAPA(C0=__builtin_amdgcn_mfma_f32_32x32x16_bf16(kf[2],qr[1],C0,0,0,0),   P0[10],P0[11],P0[12],P0[13], pw1[0]=PKW(P0,8), pw1[1]=PKW(P0,10), pw1); \
    VRD(5); SBAR(); GAPA(C1=__builtin_amdgcn_mfma_f32_32x32x16_bf16(kf[3],qr[1],C1,0,0,0),   P0[14],P0[15],P1[0],P1[1],   pw1[2]=PKW(P0,12),pw1[3]=PKW(P0,14), pw1); \
    VRD(2); SBAR(); GAPA(C0=__builtin_amdgcn_mfma_f32_32x32x16_bf16(kf[4],qr[2],C0,0,0,0),   P1[2],P1[3],P1[4],P1[5],     pw2[0]=PKW(P1,0), pw2[1]=PKW(P1,2), pw2); \
    VRD(6); SBAR(); GAPA(C1=__builtin_amdgcn_mfma_f32_32x32x16_bf16(kf[5],qr[2],C1,0,0,0),   P1[6],P1[7],P1[8],P1[9],     pw2[2]=PKW(P1,4), pw2[3]=PKW(P1,6), pw2); \
    VRD(3); SBAR(); GAPA(C0=__builtin_amdgcn_mfma_f32_32x32x16_bf16(kf[6],qr[3],C0,0,0,0),   P1[10],P1[11],P1[12],P1[13], pw3[0]=PKW(P1,8), pw3[1]=PKW(P1,10), pw3); \
    VRD(7); SBAR(); GAPA(C1=__builtin_amdgcn_mfma_f32_32x32x16_bf16(kf[7],qr[3],C1,0,0,0),   P1[14],P1[15],0.f,0.f,       pw3[2]=PKW(P1,12),pw3[3]=PKW(P1,14), pw3); \
    l_reg+=sacc; \
    if(GK){DMA_K((t)+3,sl_cur);} if(GV){DMA_V((t)+1,sl_next);} \
    CMASK(C0,C1,t); \
    { float a=MX3(C0[0],C0[1],C1[0]),b=MX3(C0[2],C0[3],C1[1]); a=MX3(a,C1[2],C1[3]); \
      _Pragma("unroll") for(int r=4;r<16;r+=4){a=MX3(a,C0[r],C0[r+1]);b=MX3(b,C0[r+2],C0[r+3]);a=MX3(a,C1[r],C1[r+1]);b=MX3(b,C1[r+2],C1[r+3]);} \
      float rm=__builtin_fmaxf(a,b); { auto rr=__builtin_amdgcn_permlane32_swap(__float_as_uint(rm),__float_as_uint(rm),false,false); rm=__builtin_fmaxf(__uint_as_float(rr[0]),__uint_as_float(rr[1])); } \
      resc=false; \
      if(__builtin_expect(__any(rm>(float)THRL),0)){ const float dl=__builtin_fmaxf(rm,0.f); mhat+=dl; \
        _Pragma("unroll") for(int r=0;r<16;++r){C0[r]-=dl;C1[r]-=dl;} \
        _Pragma("unroll") for(int r=0;r<16;++r)negm[r]=-mhat; asm volatile("":"+v"(negm)); \
        const float f=__builtin_amdgcn_exp2f(-dl); l_reg*=f; if(hi==0)wsf[r32]=f; resc=true; } } \
    SBAR(); \
    GAPB(o[0]=__builtin_amdgcn_mfma_f32_32x32x16_bf16(PAF(0),VFR(0),o[0],0,0,0), C0,0); \
    GAPB(o[1]=__builtin_amdgcn_mfma_f32_32x32x16_bf16(PAF(0),VFR(4),o[1],0,0,0), C0,4); \
    KRD(GL,0); GAPB(o[0]=__builtin_amdgcn_mfma_f32_32x32x16_bf16(PAF(1),VFR(1),o[0],0,0,0), C0,8); \
    KRD(GL,1); GAPB(o[1]=__builtin_amdgcn_mfma_f32_32x32x16_bf16(PAF(1),VFR(5),o[1],0,0,0), C0,12); \
    KRD(GL,2); GAPB(o[0]=__builtin_amdgcn_mfma_f32_32x32x16_bf16(PAF(2),VFR(2),o[0],0,0,0), C1,0); \
    KRD(GL,3); GAPB(o[1]=__builtin_amdgcn_mfma_f32_32x32x16_bf16(PAF(2),VFR(6),o[1],0,0,0), C1,4); \
    GAPB(o[0]=__builtin_amdgcn_mfma_f32_32x32x16_bf16(PAF(3),VFR(3),o[0],0,0,0), C1,8); \
    GAPB(o[1]=__builtin_amdgcn_mfma_f32_32x32x16_bf16(PAF(3),VFR(7),o[1],0,0,0), C1,12); \
    }while(0)
  int t=1;
  #undef CMASK
  #define CMASK(P0,P1,t) do{}while(0)
  for(;t+5<NT;t+=2){
    STEP(pB0,pB1,pA0,pA1,t,true,true,true);     WAIT_BAR(2); RESC(); ROT();
    STEP(pA0,pA1,pB0,pB1,t+1,true,true,true);   WAIT_BAR(2); RESC(); ROT();
  }
  #undef CMASK
  #define CMASK(P0,P1,t) do{int jb_=(t)-(NT-4); if(jb_>=0)cmask(P0,P1,jb_,qrel,hi);}while(0)
  #define ENDW(tt) do{ if((tt)+3<NT){WAIT_BAR(2);} else if((tt)+2<NT){WAIT_BAR(1);} else {WAIT_BAR(0);} }while(0)
  for(;t+1<NT;t+=2){
    STEP(pB0,pB1,pA0,pA1,t,(t+3<NT),(t+1<NT),(t+1<NT));       ENDW(t);   RESC(); ROT();
    STEP(pA0,pA1,pB0,pB1,t+1,(t+4<NT),(t+2<NT),(t+2<NT));     ENDW(t+1); RESC(); ROT();
  }
  STEP(pB0,pB1,pA0,pA1,NT-1,false,false,false); RESC();
  { float sacc=pB0[0]+pB0[1]; _Pragma("unroll") for(int r=2;r<16;++r)sacc+=pB0[r]; _Pragma("unroll") for(int r=0;r<16;++r)sacc+=pB1[r]; l_reg+=sacc;
    pw0=(u32x4){PKW(pB0,0),PKW(pB0,2),PKW(pB0,4),PKW(pB0,6)};pw1=(u32x4){PKW(pB0,8),PKW(pB0,10),PKW(pB0,12),PKW(pB0,14)};pw2=(u32x4){PKW(pB1,0),PKW(pB1,2),PKW(pB1,4),PKW(pB1,6)};pw3=(u32x4){PKW(pB1,8),PKW(pB1,10),PKW(pB1,12),PKW(pB1,14)};
    SBAR(); pv(o,vb0+sl_cur,PAF(0),PAF(1),PAF(2),PAF(3)); }
  #undef PKW
  #undef PAF
  #undef VFR
  #undef PIN
  #undef MX3
  #undef GAPA
  #undef GAPB
  #undef EX
  #undef VRD
  #undef KRD
  #undef STEP
  #undef ENDW
  {auto rr=__builtin_amdgcn_permlane32_swap(__float_as_uint(l_reg),__float_as_uint(l_reg),false,false);l_reg=__uint_as_float(rr[0])+__uint_as_float(rr[1]);}
  if(hi==0)wsf[32+r32]=l_reg;asm volatile("s_waitcnt lgkmcnt(0)":::"memory");
  float rli[16];
  #pragma unroll
  for(int r=0;r<16;++r)rli[r]=__builtin_amdgcn_rcpf(wsf[32+crow(r,hi)]);
  bf16*Ow=O+(rowbase+q0+wid*QBLK)*OP+ocol;
  { bf16*stg=(bf16*)(shm+LDS_OST)+wid*2048;
    #pragma unroll
    for(int r=0;r<16;++r){const int orow=crow(r,hi);
      #pragma unroll
      for(int d0=0;d0<2;++d0)stg[orow*64+d0*32+r32]=__float2bfloat16(o[d0][r]*rli[r]);}
    asm volatile("s_waitcnt lgkmcnt(0)":::"memory");
    #pragma unroll
    for(int i=0;i<4;++i){const int row=i*8+(lane>>3),ch=lane&7; const u32x4 v=*(const u32x4*)(stg+row*64+ch*8); ATTN_STORE16(Ow+(long)row*OP+ch*8,v);} }
  asm volatile("s_waitcnt lgkmcnt(0)\n\ts_barrier":::"memory");
  #undef DMA_K
  #undef DMA_V
  #undef CMASK
  #undef START
  #undef RESC
  #undef ROT
}
constexpr int ATTN_LDS_BYTES=LDS_BYTES;
struct AttnTensors { const bf16* Q; const bf16* K; const bf16* V; bf16* O; };
struct AttnUnit { int bvh; int qb; };
struct StaticOrder {
  int ai,nA;
  __device__ __forceinline__ StaticOrder(int ai_,int nA_):ai(ai_),nA(nA_){}
  __device__ __forceinline__ bool next(int i,AttnUnit&u)const{
    if(nA==128){ if(i>=8)return false; u.bvh=ai; u.qb=7-i; return true; }
    if(i>=4)return false; const int s=ai&1; u.bvh=ai>>1; u.qb=(i==0)?7-s:(i==1)?4+s:(i==2)?3-s:s; return true; }
  __device__ __forceinline__ void a_ready(const AttnUnit&)const{}
  __device__ __forceinline__ void done(const AttnUnit&)const{}
};
template<class Sched,int THRL=8> __device__ __forceinline__ void attn_phase(char*lds,const AttnTensors&T,const Sched&S){
  AttnUnit u;
  for(int i=0;S.next(i,u);++i){ S.a_ready(u); const int b=u.bvh>>4,vh=u.bvh&15,s=vh>>1,half=vh&1;
    attn_unit<THRL>(b,s*64,s*64,(s>>1)*128+half*64,s*128+half*64,u.qb,T.Q,T.K,T.V,T.O,lds); S.done(u); }
}
template<int THRL=8> __device__ __forceinline__ void attn_phase_queue(char*lds,const AttnTensors&T,unsigned*counter,volatile __attribute__((address_space(3))) unsigned*slot){
  for(;;){
    if(threadIdx.x==0)*slot=__hip_atomic_fetch_add(counter,1u,__ATOMIC_RELAXED,__HIP_MEMORY_SCOPE_AGENT);
    __syncthreads();
    const unsigned u=__builtin_amdgcn_readfirstlane(*slot);
    __syncthreads();
    if(u>=1024u)break;
    const int qb=7-(int)(u>>7),bvh=(int)(u&127u),b=bvh>>4,vh=bvh&15,s=vh>>1,half=vh&1;
    attn_unit<THRL>(b,s*64,s*64,(s>>1)*128+half*64,s*128+half*64,qb,T.Q,T.K,T.V,T.O,lds);
  }
}
#undef SBAR
#undef WAIT_BAR
}
#include <hip/hip_cooperative_groups.h>
typedef unsigned short bf16;
#define GAS __attribute__((address_space(1)))
#define LAS __attribute__((address_space(3)))
typedef unsigned v4u __attribute__((ext_vector_type(4)));
typedef unsigned v2u __attribute__((ext_vector_type(2)));
typedef float f32x4 __attribute__((ext_vector_type(4)));
#define LDS_WAIT() asm volatile("s_waitcnt lgkmcnt(0)" ::: "memory")
__device__ __forceinline__ unsigned f2bf(float f) { unsigned u = __builtin_bit_cast(unsigned, f); return (u + 0x7fffu + ((u >> 16) & 1u)) >> 16; }
__device__ __forceinline__ unsigned pk2(float lo, float hi) { return f2bf(lo) | (f2bf(hi) << 16); }
__device__ __forceinline__ float bflo(unsigned w) { return __builtin_bit_cast(float, w << 16); }
__device__ __forceinline__ float bfhi(unsigned w) { return __builtin_bit_cast(float, w & 0xffff0000u); }
__device__ __forceinline__ float bf1(unsigned short h) { return __builtin_bit_cast(float, (unsigned)h << 16); }
template <int CTRL> __device__ __forceinline__ float dppf(float x) { return __builtin_bit_cast(float, __builtin_amdgcn_update_dpp(0, __builtin_bit_cast(int, x), CTRL, 0xf, 0xf, false)); }
__device__ __forceinline__ float row16_allsum(float x) { x += dppf<0x128>(x); x += dppf<0x124>(x); x += dppf<0x122>(x); x += dppf<0x121>(x); return x; }
__device__ __forceinline__ float oct_allsum(float x) { x += dppf<0xB1>(x); x += dppf<0x4E>(x); x += dppf<0x141>(x); return x; }
__device__ __forceinline__ float u2f(unsigned u) { return __builtin_bit_cast(float, u); }
__device__ __forceinline__ unsigned f2u(float f) { return __builtin_bit_cast(unsigned, f); }
__device__ __forceinline__ float sw32(float a, float b) { auto r = __builtin_amdgcn_permlane32_swap(f2u(a), f2u(b), false, false); const unsigned r0 = r[0], r1 = r[1]; return u2f(r0) + u2f(r1); }
__device__ __forceinline__ float sw16(float a, float b) { auto r = __builtin_amdgcn_permlane16_swap(f2u(a), f2u(b), false, false); const unsigned r0 = r[0], r1 = r[1]; return u2f(r0) + u2f(r1); }
__device__ __forceinline__ float wave_allsum(float x) { x = row16_allsum(x); x = sw16(x, x); return sw32(x, x); }
__device__ __forceinline__ float red4(float x0, float x1, float x2, float x3) { return row16_allsum(sw16(sw32(x0, x1), sw32(x2, x3))); }

#define XB_TMO      128
#define XB_XCNT(j)  (256  + 64 * (j))
#define XB_XSUB(j)  (1280 + 64 * (j))
#define XB_XGEN(j)  (2304 + 64 * (j))
#define XB_TOP      3328
#define XB_TOPGEN   3392
#define XCD_BAR_WORDS 3456
#define XB_SPIN_CAP (1u << 18)

__device__ __forceinline__ unsigned xb_ld(unsigned* p)              { return __hip_atomic_load(p, __ATOMIC_RELAXED, __HIP_MEMORY_SCOPE_AGENT); }
__device__ __forceinline__ unsigned xb_add(unsigned* p, unsigned v) { return __hip_atomic_fetch_add(p, v, __ATOMIC_RELAXED, __HIP_MEMORY_SCOPE_AGENT); }
__device__ __forceinline__ unsigned xb_xcc_id() { return (unsigned)__builtin_amdgcn_s_getreg((3 << 11) | 20) & 0xFu; }
#define XB_SPIN(cond, bar) do { unsigned _sp = 0; while (cond) { __builtin_amdgcn_s_sleep(1); \
    if ((++_sp & 255u) == 0u) { if (xb_ld(&(bar)[XB_TMO])) break; if (_sp > XB_SPIN_CAP) { atomicAdd(&(bar)[XB_TMO], 1u); break; } } } } while (0)

struct XcdBarrier {
    unsigned* bar; unsigned x;
    volatile LAS unsigned* st;
};

__device__ __forceinline__ XcdBarrier xcd_barrier_post(unsigned* bar, volatile LAS unsigned* st) {
    XcdBarrier b; b.bar = bar; b.x = xb_xcc_id(); b.st = st;
    if (threadIdx.x == 0) (void)xb_add(&bar[XB_XCNT(b.x)], 1u);
    return b;
}
__device__ __forceinline__ void xcd_barrier_complete(unsigned* bar, unsigned x, unsigned& nloc, unsigned& nx) {
    const unsigned G = gridDim.x * gridDim.y * gridDim.z;
    unsigned sum, cnt, mine, sp = 0u;
    for (;;) {
        sum = 0u; cnt = 0u; mine = 0u;
#pragma unroll
        for (unsigned j = 0; j < 16; ++j) { const unsigned c = xb_ld(&bar[XB_XCNT(j)]); sum += c; cnt += (c > 0u) ? 1u : 0u; }
        mine = xb_ld(&bar[XB_XCNT(x)]);
        if (sum == G) break;
        __builtin_amdgcn_s_sleep(1);
        if ((++sp & 255u) == 0u) { if (xb_ld(&bar[XB_TMO])) break; if (sp > XB_SPIN_CAP) { atomicAdd(&bar[XB_TMO], 1u); break; } }
    }
    nloc = mine > 0u ? mine : 1u; nx = cnt > 0u ? cnt : 1u;
}

__device__ __forceinline__ void xcd_barrier(const XcdBarrier& b) {
    asm volatile("s_waitcnt vmcnt(0)" ::: "memory");
    __syncthreads();
    if (threadIdx.x == 0) {
        unsigned* bar = b.bar;
        __builtin_amdgcn_s_waitcnt(0);
        unsigned nloc = b.st[0], nx = b.st[1];
        if (nloc == 0u) { xcd_barrier_complete(bar, b.x, nloc, nx); b.st[0] = nloc; b.st[1] = nx; }
        const unsigned old = xb_add(&bar[XB_XSUB(b.x)], 1u);
        const unsigned gen = old / nloc;
        if (old + 1u == (gen + 1u) * nloc) {
            __builtin_amdgcn_fence(__ATOMIC_RELEASE, "agent");
            asm volatile("s_waitcnt vmcnt(0)" ::: "memory");
            const unsigned og = xb_add(&bar[XB_TOP], 1u);
            const unsigned tg = og / nx;
            if (og + 1u == (tg + 1u) * nx) xb_add(&bar[XB_TOPGEN], 1u);
            else XB_SPIN(xb_ld(&bar[XB_TOPGEN]) == tg, bar);
            __builtin_amdgcn_fence(__ATOMIC_ACQUIRE, "agent");
            xb_add(&bar[XB_XGEN(b.x)], 1u);
            asm volatile("s_waitcnt vmcnt(0)" ::: "memory");
        } else {
            XB_SPIN(xb_ld(&bar[XB_XGEN(b.x)]) == gen, bar);
            __builtin_amdgcn_fence(__ATOMIC_ACQUIRE, "agent");
            asm volatile("s_waitcnt vmcnt(0)" ::: "memory");
        }
    }
    __syncthreads();
}


constexpr int CW_BAR = 4096;
constexpr int MISC_OFF = 162816 + 320;
struct Frame {
    LAS unsigned char* lds;
    int tid, lane, wave, G, bx;
    float* out; unsigned char* ws;
};
struct Args { const float* in[26]; float* out; unsigned char* ws; int ph_lo, ph_hi; };
typedef const float* cfp_t;
typedef __attribute__((address_space(4))) const cfp_t* ktab_t;
struct InTab { ktab_t p; __device__ __forceinline__ const float* operator[](int i) const { return p[i]; } };
enum { I_X = 0, I_NMG, I_WIN, I_MU, I_W0, I_W2, I_A0, I_A2, I_G2, I_KK, I_KA, I_RK, I_LNG, I_LNB, I_LQ1, I_LK1, I_LQ2, I_LK2, I_SUBG, I_WA, I_WB, I_WO, I_NFG, I_FF1, I_FF2, I_NFIN };

template <bool ROPE> __device__ __forceinline__ void p0_transpose_item(const float* W, int K, int N, bf16* WT, LAS float* scr, int item, int lane, int pitch = 0, int koff = 0) {
    if (pitch == 0) pitch = K;
    const int nblk = N / 32, kb = item / nblk, nb = item % nblk, k0 = 64 * kb, n0 = 32 * nb;
#pragma unroll
    for (int i = 0; i < 8; ++i) { const int kk = 8 * i + (lane >> 3), c4 = 4 * (lane & 7); const f32x4 w4 = *(const GAS f32x4*)(W + (size_t)(k0 + kk) * N + n0 + c4);
        scr[kk * 33 + c4] = w4.x; scr[kk * 33 + c4 + 1] = w4.y; scr[kk * 33 + c4 + 2] = w4.z; scr[kk * 33 + c4 + 3] = w4.w; }
    LDS_WAIT(); asm volatile("" ::: "memory");
    const int c = lane & 7;
#pragma unroll
    for (int j = 0; j < 4; ++j) { const int n = (lane >> 3) + 8 * j; const LAS float* s = scr + (8 * c) * 33 + n;
        v4u o; o.x = pk2(s[0 * 33], s[1 * 33]); o.y = pk2(s[2 * 33], s[3 * 33]); o.z = pk2(s[4 * 33], s[5 * 33]); o.w = pk2(s[6 * 33], s[7 * 33]);
        int col = n0 + n;
        if (ROPE && col < 1024) { const int d = col & 63, dd = d & 31; col = (col & ~63) + 8 * (dd >> 2) + (d >> 5) * 4 + (dd & 3); }
        *(GAS v4u*)(WT + (size_t)col * pitch + koff + k0 + 8 * c) = o; }
    LDS_WAIT(); asm volatile("" ::: "memory");
}
__device__ __forceinline__ void rms_row_to_bf16(const float* xrow, const float* g, bf16* orow, int lane) {
    const GAS f32x4* xr = (const GAS f32x4*)xrow + lane; const f32x4* gr = (const f32x4*)g + lane;
    f32x4 v[4]; float s = 0.f;
#pragma unroll
    for (int j = 0; j < 4; ++j) { v[j] = xr[64 * j]; s += (v[j].x * v[j].x + v[j].y * v[j].y) + (v[j].z * v[j].z + v[j].w * v[j].w); }
    const float rstd = 1.0f / sqrtf(wave_allsum(s) * (1.f / D) + NORM_EPS);
    GAS unsigned long long* o8 = (GAS unsigned long long*)orow + lane;
#pragma unroll
    for (int j = 0; j < 4; ++j) { const f32x4 gg = gr[64 * j];
        o8[64 * j] = (unsigned long long)pk2(v[j].x * rstd * gg.x, v[j].y * rstd * gg.y) | ((unsigned long long)pk2(v[j].z * rstd * gg.z, v[j].w * rstd * gg.w) << 32); }
}
__device__ __forceinline__ void rms_row_to_f32(const float* xrow, const float* g, float* orow, int lane) {
    const GAS f32x4* xr = (const GAS f32x4*)xrow + lane; const f32x4* gr = (const f32x4*)g + lane;
    f32x4 v[4]; float s = 0.f;
#pragma unroll
    for (int j = 0; j < 4; ++j) { v[j] = xr[64 * j]; s += (v[j].x * v[j].x + v[j].y * v[j].y) + (v[j].z * v[j].z + v[j].w * v[j].w); }
    const float rstd = 1.0f / sqrtf(wave_allsum(s) * (1.f / D) + NORM_EPS);
    GAS f32x4* o = (GAS f32x4*)orow + lane;
#pragma unroll
    for (int j = 0; j < 4; ++j) { const f32x4 gg = gr[64 * j]; o[64 * j] = v[j] * rstd * gg; }
}
__device__ __forceinline__ void p0_prologue(Frame& F, const InTab& A) {
    LAS float* scr = (LAS float*)(F.lds + RING_OFF + F.wave * 16384);
    const int gw = F.bx * NWAVES + F.wave, NGW = F.G * NWAVES;
    unsigned char* ws = F.ws;
    constexpr int I_IN = (D / 64) * (D_IN / 32), I_A = (512 / 64) * (D / 32), I_O = (D / 64) * (D / 32), I_1 = (D / 64) * (FF / 32), I_2 = (FF / 64) * (D / 32);
    (void)I_A; (void)I_O; (void)I_1; (void)I_2;
    for (int it = gw; it < I_IN; it += NGW) p0_transpose_item<true>(A[I_WIN], D, D_IN, (bf16*)(ws + WS_WIN), scr, it, F.lane);
    if (false) for (int it = gw; it < 0; it += NGW) {
        int r = it;
        if (r < I_A) { p0_transpose_item<false>(A[I_WA], 512, D, (bf16*)(ws + WS_WA), scr, r, F.lane, 1024, 0); continue; } r -= I_A;
        if (r < I_A) { p0_transpose_item<false>(A[I_WB], 512, D, (bf16*)(ws + WS_WA), scr, r, F.lane, 1024, 512); continue; } r -= I_A;
        if (r < I_O) { p0_transpose_item<false>(A[I_WO], D, D, (bf16*)(ws + WS_WO), scr, r, F.lane); continue; } r -= I_O;
        if (r < I_1) { p0_transpose_item<false>(A[I_FF1], D, FF, (bf16*)(ws + WS_W1), scr, r, F.lane); continue; } r -= I_1;
        p0_transpose_item<false>(A[I_FF2], FF, D, (bf16*)(ws + WS_W2), scr, r, F.lane);
    }
    const int gt = F.bx * (NWAVES * 64) + F.tid, NGT = F.G * NWAVES * 64;
    for (int e = gt; e < NLORA * (KLORA / 8); e += NGT) { const int n = e % NLORA, k8 = (e / NLORA) * 8; float v[8];
#pragma unroll
        for (int i = 0; i < 8; ++i) { const int k = k8 + i; float x = 0.f;
            if (n < 512) { if (k < 64) x = A[I_W2][(size_t)k * 512 + n]; }
            else if (n < 1024) { if (k >= 64 && k < 128) x = A[I_A2][(size_t)(k - 64) * 512 + (n - 512)]; }
            else { if (k >= 128) x = A[I_G2][(size_t)(k - 128) * 512 + (n - 1024)]; }
            v[i] = x; }
        v4u o; o.x = pk2(v[0], v[1]); o.y = pk2(v[2], v[3]); o.z = pk2(v[4], v[5]); o.w = pk2(v[6], v[7]);
        *(GAS v4u*)((bf16*)(ws + WS_WL) + (size_t)n * KLORA + k8) = o; }
    for (int e = gt; e < SEQ * 32; e += NGT) { const int pos = e >> 5, i = e & 31;
        const float inv = exp2f(-(float)i * 0.41524101186092029f);
        const float ang = (float)pos * inv; float s, c; sincosf(ang, &s, &c);
        ((float*)(ws + WS_ROPE_C))[e] = c; ((float*)(ws + WS_ROPE_S))[e] = s; }
    for (int m = gw; m < M; m += 2 * NGW) {
        const int m2 = m + NGW;
        const GAS f32x4* xa = (const GAS f32x4*)(A[I_X] + (size_t)m * D) + F.lane; const GAS f32x4* xb = (const GAS f32x4*)(A[I_X] + (size_t)m2 * D) + F.lane; const f32x4* gr = (const f32x4*)A[I_NMG] + F.lane;
        f32x4 va[4], vb[4]; float sa = 0.f, sb = 0.f;
#pragma unroll
        for (int j = 0; j < 4; ++j) { va[j] = xa[64 * j]; vb[j] = xb[64 * j]; }
#pragma unroll
        for (int j = 0; j < 4; ++j) { sa += (va[j].x * va[j].x + va[j].y * va[j].y) + (va[j].z * va[j].z + va[j].w * va[j].w); sb += (vb[j].x * vb[j].x + vb[j].y * vb[j].y) + (vb[j].z * vb[j].z + vb[j].w * vb[j].w); }
        const float ra = __builtin_amdgcn_rsqf(wave_allsum(sa) * (1.f / D) + NORM_EPS), rb = __builtin_amdgcn_rsqf(wave_allsum(sb) * (1.f / D) + NORM_EPS);
        GAS unsigned long long* oa = (GAS unsigned long long*)((bf16*)(ws + WS_XN) + (size_t)m * D) + F.lane; GAS unsigned long long* ob = (GAS unsigned long long*)((bf16*)(ws + WS_XN) + (size_t)m2 * D) + F.lane;
#pragma unroll
        for (int j = 0; j < 4; ++j) { const f32x4 gg = gr[64 * j];
            oa[64 * j] = (unsigned long long)pk2(va[j].x * ra * gg.x, va[j].y * ra * gg.y) | ((unsigned long long)pk2(va[j].z * ra * gg.z, va[j].w * ra * gg.w) << 32);
            ob[64 * j] = (unsigned long long)pk2(vb[j].x * rb * gg.x, vb[j].y * rb * gg.y) | ((unsigned long long)pk2(vb[j].z * rb * gg.z, vb[j].w * rb * gg.w) << 32); }
    }
}

__device__ __forceinline__ void late_weights(Frame& F, const InTab& A, int part, int nparts, int cu0) {
    int lane_ = F.lane; asm volatile("" : "+v"(lane_));
    LAS float* scr = (LAS float*)(F.lds + RING_OFF + F.wave * 16384);
    unsigned char* ws = F.ws;
    constexpr int I_A = (512 / 64) * (D / 32), I_O = (D / 64) * (D / 32), I_1 = (D / 64) * (FF / 32), I_2 = (FF / 64) * (D / 32), NIT = 2 * I_A + I_O + I_1 + I_2;
    const int per = NIT / nparts, lo = part * per, hi = lo + per;
    const int gw = (F.bx - cu0) * NWAVES + F.wave, NGW = (F.G - cu0) * NWAVES;
    for (int it = lo + gw; it < hi; it += NGW) {
        int r = it;
        if (r < I_A) { p0_transpose_item<false>(A[I_WA], 512, D, (bf16*)(ws + WS_WA), scr, r, lane_, 1024, 0); continue; } r -= I_A;
        if (r < I_A) { p0_transpose_item<false>(A[I_WB], 512, D, (bf16*)(ws + WS_WA), scr, r, lane_, 1024, 512); continue; } r -= I_A;
        if (r < I_O) { p0_transpose_item<false>(A[I_WO], D, D, (bf16*)(ws + WS_WO), scr, r, lane_); continue; } r -= I_O;
        if (r < I_1) { p0_transpose_item<false>(A[I_FF1], D, FF, (bf16*)(ws + WS_W1), scr, r, lane_); continue; } r -= I_1;
        p0_transpose_item<false>(A[I_FF2], FF, D, (bf16*)(ws + WS_W2), scr, r, lane_);
    }
}
__device__ __forceinline__ void prep1_rows(Frame& F, const InTab& A, int g0, int g1, int w, int nw) {
    const int lane = F.lane;
    const bf16* WAG = (const bf16*)(F.ws + WS_WAG); bf16* LIN = (bf16*)(F.ws + WS_LIN);
    const f32x4 mu = *(const f32x4*)(A[I_MU] + 1536 + 4 * lane);
    for (int g = g0 + w; g < g1; g += nw) {
        const int m0 = g * 8; v2u row[9];
        row[0] = (v2u){0u, 0u}; if ((m0 & (SEQ - 1)) != 0) row[0] = *(const GAS v2u*)(WAG + (size_t)(m0 - 1) * 256 + 4 * lane);
#pragma unroll
        for (int j = 0; j < 8; ++j) row[j + 1] = *(const GAS v2u*)(WAG + (size_t)(m0 + j) * 256 + 4 * lane);
#pragma unroll
        for (int j = 0; j < 8; ++j) {
            float z[4] = {bflo(row[j + 1].x), bfhi(row[j + 1].x), bflo(row[j + 1].y), bfhi(row[j + 1].y)}; const float p[4] = {bflo(row[j].x), bfhi(row[j].x), bflo(row[j].y), bfhi(row[j].y)};
#pragma unroll
            for (int e = 0; e < 4; ++e) { float v = z[e] + (p[e] - z[e]) * mu[e];
                if (lane < 16) v = 1.0f - 2.0f * __builtin_amdgcn_rcpf(1.0f + __expf(2.0f * v));
                else if (lane >= 32) v = __builtin_amdgcn_rcpf(1.0f + __expf(-v));
                z[e] = v; }
            v2u o; o.x = pk2(z[0], z[1]); o.y = pk2(z[2], z[3]);
            *(GAS v2u*)(LIN + (size_t)(m0 + j) * 256 + 4 * lane) = o;
        }
    }
}
struct ScanRaw { unsigned short r[9], k[9], v[9], a[8]; float d[8]; };
__device__ __forceinline__ void scan_load(ScanRaw& R, const bf16* RKV, const float* DEC, const bf16* AA, size_t row0, int t0, int c) {
#pragma unroll
    for (int j = 0; j < 9; ++j) { int t = t0 - 1 + j; if (t < 0) t = 0; const bf16* p = RKV + (row0 + t) * 1536 + c;
        R.r[j] = *(const GAS bf16*)p; R.k[j] = *(const GAS bf16*)(p + 512); R.v[j] = *(const GAS bf16*)(p + 1024); }
#pragma unroll
    for (int j = 0; j < 8; ++j) { R.d[j] = *(const GAS float*)(DEC + (row0 + t0 + j) * 512 + c); R.a[j] = *(const GAS bf16*)(AA + (row0 + t0 + j) * 512 + c); }
}
__device__ __forceinline__ void scan_phase(Frame& F, const InTab& A, int si) {
    const int lane = F.lane, wave = F.wave, tid = F.tid;
    const int bh = si >> 1, half = si & 1, b = bh >> 3, h = bh & 7, c = h * 64 + lane;
    LAS float* IN = (LAS float*)(F.lds + RING_OFF);
    LAS float* VV = IN + 5 * 4096;
    LAS float* YBUF = VV + 2048;
    const bf16* RKV = (const bf16*)(F.ws + WS_RKV); const float* DEC = (const float*)(F.ws + WS_DEC); const bf16* AA = (const bf16*)(F.ws + WS_AA);
    bf16* Y = (bf16*)(F.ws + WS_Y); float* BON = (float*)(F.ws + WS_BON);
    const float mu_r = A[I_MU][c], mu_k = A[I_MU][512 + c], mu_v = A[I_MU][1024 + c], kkc = A[I_KK][c], kac = A[I_KA][c], rkc = A[I_RK][c];
    const size_t row0 = (size_t)b * SEQ;
    const int myv = (int)(red4(0.f, 1.f, 2.f, 3.f) * (1.0f / 64.0f) + 0.5f);
    const int L0 = __builtin_ctzll(__ballot(myv == 0)), L1 = __builtin_ctzll(__ballot(myv == 1)), L2 = __builtin_ctzll(__ballot(myv == 2)), L3 = __builtin_ctzll(__ballot(myv == 3));
    float S0 = 0.f, S1 = 0.f, S2 = 0.f, S3 = 0.f;
    ScanRaw R; scan_load(R, RKV, DEC, AA, row0, wave * 8, c);
    for (int blk = 0; blk < SEQ / 64; ++blk) {
        {
            const int t0 = blk * 64 + wave * 8;
            f32x4 qd[2], qa[2], qb[2], qk[2], qr[2], qv[2];
#pragma unroll
            for (int j = 0; j < 8; ++j) {
                const float pz = (t0 + j == 0) ? 0.f : 1.f;
                const float rt_ = bf1(R.r[j + 1]), kt_ = bf1(R.k[j + 1]), vt_ = bf1(R.v[j + 1]);
                const float rs = rt_ + (bf1(R.r[j]) * pz - rt_) * mu_r, ks = kt_ + (bf1(R.k[j]) * pz - kt_) * mu_k, vs = vt_ + (bf1(R.v[j]) * pz - vt_) * mu_v;
                const float kkr = ks * kkc, n2 = wave_allsum(kkr * kkr), kk = kkr / __builtin_fmaxf(sqrtf(n2), 1e-12f);
                const float a = 1.0f / (1.0f + __expf(-bf1(R.a[j]))), kx = ks * (1.0f + (a - 1.0f) * kac);
                const float bon = wave_allsum(rs * kx * rkc);
                if (half == 0 && lane == 0) BON[(row0 + t0 + j) * 8 + h] = bon;
                qd[j >> 2][j & 3] = __expf(-0.6065306597f / (1.0f + __expf(-R.d[j])));     qa[j >> 2][j & 3] = -kk; qb[j >> 2][j & 3] = kk * a; qk[j >> 2][j & 3] = kx; qr[j >> 2][j & 3] = rs; qv[j >> 2][j & 3] = vs;
            }
#pragma unroll
            for (int q = 0; q < 2; ++q) { const int t4 = wave * 2 + q; LAS f32x4* p = (LAS f32x4*)IN + t4 * 64 + lane;
                p[0 * 1024] = qd[q]; p[1 * 1024] = qa[q]; p[2 * 1024] = qb[q]; p[3 * 1024] = qk[q]; p[4 * 1024] = qr[q];
                if ((lane >> 5) == half) ((LAS f32x4*)VV)[t4 * 32 + (lane & 31)] = qv[q]; }
        }
        __syncthreads();
        if (blk + 1 < SEQ / 64) scan_load(R, RKV, DEC, AA, row0, (blk + 1) * 64 + wave * 8, c);
#pragma unroll 1
        for (int t4 = 0; t4 < 16; ++t4) {
            const LAS f32x4* p = (const LAS f32x4*)IN + t4 * 64 + lane;
            const f32x4 W4 = p[0], A4 = p[1024], B4 = p[2048], K4 = p[3072], R4 = p[4096];
            const LAS f32x4* pv = (const LAS f32x4*)VV + t4 * 32 + wave * 4;
            const f32x4 V0 = pv[0], V1 = pv[1], V2 = pv[2], V3 = pv[3];
            f32x4 yq;
#pragma unroll
            for (int ts = 0; ts < 4; ++ts) {
                const float w = W4[ts], a = A4[ts], bb = B4[ts], kx = K4[ts], r = R4[ts];
                const float t = red4(S0 * a, S1 * a, S2 * a, S3 * a);
                const float sa0 = __builtin_bit_cast(float, __builtin_amdgcn_readlane(__builtin_bit_cast(int, t), L0)), sa1 = __builtin_bit_cast(float, __builtin_amdgcn_readlane(__builtin_bit_cast(int, t), L1));
                const float sa2 = __builtin_bit_cast(float, __builtin_amdgcn_readlane(__builtin_bit_cast(int, t), L2)), sa3 = __builtin_bit_cast(float, __builtin_amdgcn_readlane(__builtin_bit_cast(int, t), L3));
                S0 = S0 * w + (sa0 * bb + V0[ts] * kx); S1 = S1 * w + (sa1 * bb + V1[ts] * kx); S2 = S2 * w + (sa2 * bb + V2[ts] * kx); S3 = S3 * w + (sa3 * bb + V3[ts] * kx);
                yq[ts] = red4(S0 * r, S1 * r, S2 * r, S3 * r);
            }
            if ((lane & 15) == 0) *(LAS f32x4*)(YBUF + (wave * 4 + myv) * 68 + t4 * 4) = yq;
        }
        __syncthreads();
        { const int t = tid >> 3, rg = tid & 7; const LAS float* yb = YBUF + (4 * rg) * 68 + t;
          v2u o; o.x = pk2(yb[0], yb[68]); o.y = pk2(yb[136], yb[204]);
          *(GAS v2u*)(Y + (row0 + blk * 64 + t) * 512 + h * 64 + 32 * half + 4 * rg) = o; }
    }
    __syncthreads();
}
__device__ __forceinline__ void post_phase(Frame& F, const InTab& A) {
    const int gw = F.bx * NWAVES + F.wave, NGW = F.G * NWAVES, lane = F.lane;
    const bf16* O = (const bf16*)(F.ws + WS_O); const bf16* Y = (const bf16*)(F.ws + WS_Y); const bf16* RKV = (const bf16*)(F.ws + WS_RKV); const bf16* GG = (const bf16*)(F.ws + WS_GG);
    const float* BON = (const float*)(F.ws + WS_BON); bf16* YA = (bf16*)(F.ws + WS_YA);
    const float lam = __expf(wave_allsum(A[I_LQ1][lane] * A[I_LK1][lane])) - __expf(wave_allsum(A[I_LQ2][lane] * A[I_LK2][lane])) + LAMBDA_INIT;
    const int ca = 8 * lane, ha = lane >> 4, ea = ca & 127;
    const int hb = lane >> 3;
    float sg[8], lg[8], lb[8], muv[8];
#pragma unroll
    for (int e = 0; e < 8; ++e) { sg[e] = A[I_SUBG][ea + e] * (1.0f - LAMBDA_INIT); lg[e] = A[I_LNG][ca + e]; lb[e] = A[I_LNB][ca + e]; muv[e] = A[I_MU][1024 + ca + e]; }
#define UNPK8(w_) {bflo(w_.x), bfhi(w_.x), bflo(w_.y), bfhi(w_.y), bflo(w_.z), bfhi(w_.z), bflo(w_.w), bfhi(w_.w)}
    for (int g = gw; g < M / 4; g += NGW) {
        const int m0 = g * 4;
        v4u o0[4], o1[4], yr[4], gr[4], vr[5]; float bon[4];
        vr[0] = (v4u){0u, 0u, 0u, 0u}; if ((m0 & (SEQ - 1)) != 0) vr[0] = *(const GAS v4u*)(RKV + (size_t)(m0 - 1) * 1536 + 1024 + ca);
#pragma unroll
        for (int j = 0; j < 4; ++j) { const size_t mm = (size_t)(m0 + j);
            o0[j] = *(const GAS v4u*)(O + mm * 1024 + (2 * ha) * 128 + ea); o1[j] = *(const GAS v4u*)(O + mm * 1024 + (2 * ha + 1) * 128 + ea);
            yr[j] = *(const GAS v4u*)(Y + mm * 512 + ca); gr[j] = *(const GAS v4u*)(GG + mm * 512 + ca); vr[j + 1] = *(const GAS v4u*)(RKV + mm * 1536 + 1024 + ca);
            bon[j] = *(const GAS float*)(BON + mm * 8 + hb); }
#pragma unroll
        for (int j = 0; j < 4; ++j) { const size_t mm = (size_t)(m0 + j);
            {
                const float a0[8] = UNPK8(o0[j]), a1[8] = UNPK8(o1[j]); float o[8], ss = 0.f;
#pragma unroll
                for (int e = 0; e < 8; ++e) { o[e] = a0[e] - lam * a1[e]; ss += o[e] * o[e]; }
                const float rstd = __builtin_amdgcn_rsqf(row16_allsum(ss) * (1.0f / 128.0f) + SUBLN_EPS);
                v4u w; w.x = pk2(o[0] * rstd * sg[0], o[1] * rstd * sg[1]); w.y = pk2(o[2] * rstd * sg[2], o[3] * rstd * sg[3]); w.z = pk2(o[4] * rstd * sg[4], o[5] * rstd * sg[5]); w.w = pk2(o[6] * rstd * sg[6], o[7] * rstd * sg[7]);
                *(GAS v4u*)(YA + mm * 1024 + ca) = w;
            }
            {
                const float y[8] = UNPK8(yr[j]), gq[8] = UNPK8(gr[j]), v[8] = UNPK8(vr[j + 1]), p[8] = UNPK8(vr[j]);
                float s = 0.f;
#pragma unroll
                for (int e = 0; e < 8; ++e) s += y[e];
                const float mean = oct_allsum(s) * (1.0f / 64.0f); float q = 0.f;
#pragma unroll
                for (int e = 0; e < 8; ++e) { const float d = y[e] - mean; q += d * d; }
                const float rstd = __builtin_amdgcn_rsqf(oct_allsum(q) * (1.0f / 64.0f) + GN_EPS);
                float r[8];
#pragma unroll
                for (int e = 0; e < 8; ++e) { const float vs = v[e] + (p[e] - v[e]) * muv[e]; r[e] = (((y[e] - mean) * rstd) * lg[e] + lb[e] + bon[j] * vs) * gq[e]; }
                v4u w; w.x = pk2(r[0], r[1]); w.y = pk2(r[2], r[3]); w.z = pk2(r[4], r[5]); w.w = pk2(r[6], r[7]);
                *(GAS v4u*)(YA + mm * 1024 + 512 + ca) = w;
            }
        }
    }
#undef UNPK8
}

typedef short rk_bf16x8 __attribute__((ext_vector_type(8)));
typedef float rk_f32x16 __attribute__((ext_vector_type(16)));
constexpr int RKA_RS_K = 144, RKA_RS_J = 80;
constexpr int RKA_A = 0, RKA_B = 5120, RKA_K = 10240, RKA_R = 15360, RKA_AT = 19968, RKA_BH = 25088, RKA_KH = 30208, RKA_VT = 35328, RKA_GC = 40448, RKA_BYTES = 40704;
constexpr int RKA_N = 0, RKA_X = 0, RKA_T = 5120, RKA_MAK = 7680, RKA_MRB = 10240, RKA_MRK = 12800;
constexpr int RKA_WAVES = 4;
static_assert(RKA_WAVES * RKA_BYTES <= 162816, "phase A LDS");
constexpr size_t WS_PQ0 = 66 * MiB, WS_PQ1 = 34 * MiB;
constexpr size_t WS_RY0 = 98 * MiB, WS_RY1 = 178 * MiB;
constexpr size_t WS_GC = 250 * MiB;
__device__ __forceinline__ unsigned char* rk_pq(unsigned char* ws, int half) { return ws + (half ? WS_PQ1 : WS_PQ0); }
__device__ __forceinline__ unsigned char* rk_ry(unsigned char* ws, int half) { return ws + (half ? WS_RY1 : WS_RY0); }
__device__ __forceinline__ unsigned char* rk_gc(unsigned char* ws, int half) { return ws + WS_GC + (size_t)half * (2048 * 256); }
constexpr size_t WS_SST = 251 * MiB;

__device__ __forceinline__ rk_bf16x8 rk_frag(const LAS unsigned char* base, int rs, int row, int s, int h) { return *(const LAS rk_bf16x8*)(base + row * rs + (16 * s + 8 * h) * 2); }
__device__ __forceinline__ rk_f32x16 rk_mfma(rk_bf16x8 a, rk_bf16x8 b, rk_f32x16 c) { return __builtin_amdgcn_mfma_f32_32x32x16_bf16(a, b, c, 0, 0, 0); }
__device__ __forceinline__ unsigned rk_pk(float lo, float hi) { typedef float f2_ __attribute__((ext_vector_type(2))); typedef __bf16 b2_ __attribute__((ext_vector_type(2))); f2_ v = {lo, hi}; b2_ b = __builtin_convertvector(v, b2_); return __builtin_bit_cast(unsigned, b); }
__device__ __forceinline__ void rk_store_tile_lds(LAS unsigned char* base, int rs, int nrow, int mbase, int h, const rk_f32x16& acc) {
#pragma unroll
    for (int g = 0; g < 4; ++g) { v2u w; w.x = rk_pk(acc[4 * g], acc[4 * g + 1]); w.y = rk_pk(acc[4 * g + 2], acc[4 * g + 3]); *(LAS v2u*)(base + nrow * rs + (mbase + 8 * g + 4 * h) * 2) = w; }
}
__device__ __forceinline__ void rk_store_tile_glb(bf16* base, int pitch, int nrow, int mbase, int h, const rk_f32x16& acc) {
#pragma unroll
    for (int g = 0; g < 4; ++g) { v2u w; w.x = rk_pk(acc[4 * g], acc[4 * g + 1]); w.y = rk_pk(acc[4 * g + 2], acc[4 * g + 3]); *(GAS v2u*)(base + (size_t)nrow * pitch + mbase + 8 * g + 4 * h) = w; }
}
__device__ __forceinline__ void rk_store_tile_frag(unsigned char* base, int nt, int r32, int mt, int h, const rk_f32x16& acc) {
#pragma unroll
    for (int g = 0; g < 4; ++g) { v2u w; w.x = rk_pk(acc[4 * g], acc[4 * g + 1]); w.y = rk_pk(acc[4 * g + 2], acc[4 * g + 3]);
        *(GAS v2u*)(base + ((size_t)((nt * 4 + 2 * mt + (g >> 1)) * 64 + r32 + 32 * (g & 1))) * 16 + 8 * h) = w; }
}
__device__ __forceinline__ void rk_store_blob(unsigned* blob, int lane, const rk_f32x16& acc) {
    v4u w0, w1; w0.x = rk_pk(acc[0], acc[1]); w0.y = rk_pk(acc[2], acc[3]); w0.z = rk_pk(acc[4], acc[5]); w0.w = rk_pk(acc[6], acc[7]);
    w1.x = rk_pk(acc[8], acc[9]); w1.y = rk_pk(acc[10], acc[11]); w1.z = rk_pk(acc[12], acc[13]); w1.w = rk_pk(acc[14], acc[15]);
    *(GAS v4u*)(blob + lane * 8) = w0; *(GAS v4u*)(blob + lane * 8 + 4) = w1;
}
struct RkBlob { v4u w0, w1; };
__device__ __forceinline__ RkBlob rk_load_blob(const unsigned* blob, int lane) { RkBlob b; b.w0 = *(const GAS v4u*)(blob + lane * 8); b.w1 = *(const GAS v4u*)(blob + lane * 8 + 4); return b; }
__device__ __forceinline__ rk_f32x16 rk_blob_f32(const RkBlob& b) {
    rk_f32x16 a; const unsigned w[8] = {b.w0.x, b.w0.y, b.w0.z, b.w0.w, b.w1.x, b.w1.y, b.w1.z, b.w1.w};
#pragma unroll
    for (int i = 0; i < 8; ++i) { a[2 * i] = bflo(w[i]); a[2 * i + 1] = bfhi(w[i]); }
    return a;
}

struct RkRaw { unsigned short r[8], k[8], v[8]; };
__device__ __forceinline__ void rk_load8(RkRaw& R, const bf16* prkv) {
#pragma unroll
    for (int j = 0; j < 8; ++j) { R.r[j] = *(const GAS bf16*)(prkv + j * 1536); R.k[j] = *(const GAS bf16*)(prkv + j * 1536 + 512); R.v[j] = *(const GAS bf16*)(prkv + j * 1536 + 1024); }
}
__device__ __forceinline__ void rwkvA_unit(LAS unsigned char* L, const InTab& A, unsigned char* ws, int bh, int chunk, int lane_in) {
    int lane = lane_in; asm volatile("" : "+v"(lane));
    const int b = bh >> 3, hd = bh & 7, cg = hd * 64 + lane, r32 = lane & 31, h = lane >> 5;
    const size_t row0 = (size_t)b * SEQ + (size_t)chunk * 32;
    const int uh = bh * 32 + (chunk & 31);
    const bf16* prkv = (const bf16*)(ws + WS_RKV) + row0 * 1536 + cg;
    float* pbon = (float*)(ws + WS_BON) + row0 * 8 + hd;
    const float mu_r = A[I_MU][cg], mu_k = A[I_MU][512 + cg], mu_v = A[I_MU][1024 + cg], kkc = A[I_KK][cg], kac = A[I_KA][cg], rkc = A[I_RK][cg], w0c = A[I_W0][cg], a0c = A[I_A0][cg];
    float dW[32], dA[32];
    {
        rk_f32x16 lw[2] = {{}, {}}, la[2] = {{}, {}};
        const bf16* lp = (const bf16*)(ws + WS_LIN) + (row0 + r32) * 256 + 8 * h;
        const bf16* wp = (const bf16*)(ws + WS_WL) + (size_t)(hd * 64 + r32) * 256 + 8 * h;
#pragma unroll
        for (int s2 = 0; s2 < 4; ++s2) { const rk_bf16x8 fw = __builtin_bit_cast(rk_bf16x8, *(const GAS v4u*)(lp + 16 * s2)), fa = __builtin_bit_cast(rk_bf16x8, *(const GAS v4u*)(lp + 64 + 16 * s2));
#pragma unroll
            for (int ct = 0; ct < 2; ++ct) { lw[ct] = rk_mfma(fw, __builtin_bit_cast(rk_bf16x8, *(const GAS v4u*)(wp + (size_t)ct * 32 * 256 + 16 * s2)), lw[ct]);
                la[ct] = rk_mfma(fa, __builtin_bit_cast(rk_bf16x8, *(const GAS v4u*)(wp + (size_t)(512 + ct * 32) * 256 + 64 + 16 * s2)), la[ct]); } }
#pragma unroll
        for (int i = 0; i < 16; ++i) { const int tb = (i & 3) + 8 * (i >> 2);
            { auto r = __builtin_amdgcn_permlane32_swap(f2u(lw[0][i]), f2u(lw[1][i]), false, false); const unsigned r0 = r[0], r1 = r[1]; dW[tb] = u2f(r0); dW[tb + 4] = u2f(r1); }
            { auto r = __builtin_amdgcn_permlane32_swap(f2u(la[0][i]), f2u(la[1][i]), false, false); const unsigned r0 = r[0], r1 = r[1]; dA[tb] = u2f(r0); dA[tb + 4] = u2f(r1); } }
    }
    const int myv = (int)(red4(0.f, 1.f, 2.f, 3.f) * (1.0f / 64.0f) + 0.5f);
    const int L0 = __builtin_ctzll(__ballot(myv == 0)), L1 = __builtin_ctzll(__ballot(myv == 1)), L2 = __builtin_ctzll(__ballot(myv == 2)), L3 = __builtin_ctzll(__ballot(myv == 3));
    float rp = 0.f, kp = 0.f, vp = 0.f;
    if (chunk != 0) { rp = bf1(*(const GAS bf16*)(prkv - 1536)); kp = bf1(*(const GAS bf16*)(prkv - 1536 + 512)); vp = bf1(*(const GAS bf16*)(prkv - 1536 + 1024)); }
    float G = 1.0f;
    RkRaw Rc, Rn; rk_load8(Rc, prkv);
#pragma unroll
    for (int q = 0; q < 4; ++q) {
        prkv += 8 * 1536;
        if (q < 3) rk_load8(Rn, prkv);
        LAS unsigned char* Lr = L + (8 * q) * RKA_RS_K + lane * 2;
        LAS unsigned char* Lt = L + lane * RKA_RS_J + (8 * q) * 2;
        unsigned tA[4], tB[4], tK[4], tV[4], pA = 0, pB = 0, pK = 0, pV = 0;
        float rs_[8], kx_[8], kkr_[8], a8_[8], w8_[8], vs_[8];
#pragma unroll
        for (int j = 0; j < 8; ++j) {
            const float rc = bf1(Rc.r[j]), kc = bf1(Rc.k[j]), vc = bf1(Rc.v[j]);
            const float ks = kc + (kp - kc) * mu_k; rs_[j] = rc + (rp - rc) * mu_r; vs_[j] = vc + (vp - vc) * mu_v; rp = rc; kp = kc; vp = vc;
            kkr_[j] = ks * kkc; a8_[j] = __builtin_amdgcn_rcpf(1.0f + __expf(-(a0c + dA[8 * q + j]))); kx_[j] = ks * (1.0f + (a8_[j] - 1.0f) * kac);
            w8_[j] = __expf(-0.6065306597f * __builtin_amdgcn_rcpf(1.0f + __expf(-(w0c + dW[8 * q + j]))));
        }
        float n2_[8], bon_[8];
#pragma unroll
        for (int j = 0; j < 8; j += 2) {
            const float t = red4(kkr_[j] * kkr_[j], kkr_[j + 1] * kkr_[j + 1], rs_[j] * kx_[j] * rkc, rs_[j + 1] * kx_[j + 1] * rkc);
            n2_[j] = __builtin_bit_cast(float, __builtin_amdgcn_readlane(__builtin_bit_cast(int, t), L0)); n2_[j + 1] = __builtin_bit_cast(float, __builtin_amdgcn_readlane(__builtin_bit_cast(int, t), L1));
            bon_[j] = __builtin_bit_cast(float, __builtin_amdgcn_readlane(__builtin_bit_cast(int, t), L2)); bon_[j + 1] = __builtin_bit_cast(float, __builtin_amdgcn_readlane(__builtin_bit_cast(int, t), L3));
        }
        if (lane < 8) { float bv = bon_[0];
#pragma unroll
            for (int j = 1; j < 8; ++j) bv = (lane == j) ? bon_[j] : bv;
            *(GAS float*)(pbon + (8 * q + lane) * 8) = bv; }
        unsigned tR[4];
#pragma unroll
        for (int j = 0; j < 8; j += 2) {
            const float kk0 = kkr_[j] * __builtin_amdgcn_rsqf(__builtin_fmaxf(n2_[j], 1e-24f)), kk1 = kkr_[j + 1] * __builtin_amdgcn_rsqf(__builtin_fmaxf(n2_[j + 1], 1e-24f));
            const float G0 = G; const float G1 = G0 * w8_[j]; G = G1 * w8_[j + 1]; const float i1 = __builtin_amdgcn_rcpf(G1), i2 = __builtin_amdgcn_rcpf(G);
            tA[j >> 1] = rk_pk(-kk0 * G0, -kk1 * G1); tR[j >> 1] = rk_pk(rs_[j] * G1, rs_[j + 1] * G); tB[j >> 1] = rk_pk(kk0 * a8_[j] * i1, kk1 * a8_[j + 1] * i2); tK[j >> 1] = rk_pk(kx_[j] * i1, kx_[j + 1] * i2); tV[j >> 1] = rk_pk(vs_[j], vs_[j + 1]);
            *(LAS bf16*)(Lr + RKA_A + j * RKA_RS_K) = (bf16)(tA[j >> 1] & 0xffffu); *(LAS bf16*)(Lr + RKA_A + (j + 1) * RKA_RS_K) = (bf16)(tA[j >> 1] >> 16);
            *(LAS bf16*)(Lr + RKA_R + j * RKA_RS_K) = (bf16)(tR[j >> 1] & 0xffffu); *(LAS bf16*)(Lr + RKA_R + (j + 1) * RKA_RS_K) = (bf16)(tR[j >> 1] >> 16);
            *(LAS bf16*)(Lr + RKA_B + j * RKA_RS_K) = (bf16)(tB[j >> 1] & 0xffffu); *(LAS bf16*)(Lr + RKA_B + (j + 1) * RKA_RS_K) = (bf16)(tB[j >> 1] >> 16);
            *(LAS bf16*)(Lr + RKA_K + j * RKA_RS_K) = (bf16)(tK[j >> 1] & 0xffffu); *(LAS bf16*)(Lr + RKA_K + (j + 1) * RKA_RS_K) = (bf16)(tK[j >> 1] >> 16);
        }
        (void)pA; (void)pB; (void)pK; (void)pV;
        *(LAS v4u*)(Lt + RKA_AT) = (v4u){tA[0], tA[1], tA[2], tA[3]}; *(LAS v4u*)(Lt + RKA_BH) = (v4u){tB[0], tB[1], tB[2], tB[3]}; *(LAS v4u*)(Lt + RKA_KH) = (v4u){tK[0], tK[1], tK[2], tK[3]}; *(LAS v4u*)(Lt + RKA_VT) = (v4u){tV[0], tV[1], tV[2], tV[3]};
        Rc = Rn;
    }
    const float GC = G;
    *(GAS float*)((float*)rk_gc(ws, chunk >> 5) + (size_t)uh * 64 + lane) = GC;
    *(LAS float*)(L + RKA_GC + lane * 4) = GC;
    LDS_WAIT(); asm volatile("" ::: "memory");
    {
        rk_f32x16 aN = {}, aAK = {}, aRB = {}, aRK = {};
#pragma unroll
        for (int s = 0; s < 4; ++s) {
            const rk_bf16x8 fA = rk_frag(L + RKA_A, RKA_RS_K, r32, s, h), fR = rk_frag(L + RKA_R, RKA_RS_K, r32, s, h), fB = rk_frag(L + RKA_B, RKA_RS_K, r32, s, h), fK = rk_frag(L + RKA_K, RKA_RS_K, r32, s, h);
            aN = rk_mfma(fB, fA, aN); aAK = rk_mfma(fK, fA, aAK); aRB = rk_mfma(fB, fR, aRB); aRK = rk_mfma(fK, fR, aRK);
        }
        LDS_WAIT(); asm volatile("" ::: "memory");
#pragma unroll
        for (int i = 0; i < 16; ++i) { const int j = (i & 3) + 8 * (i >> 2) + 4 * h;
            if (!(j < r32)) { aN[i] = 0.f; aAK[i] = 0.f; }
            if (!(j <= r32)) { aRB[i] = 0.f; aRK[i] = 0.f; } }
#pragma unroll
        for (int g = 0; g < 4; ++g) *(LAS f32x4*)(L + RKA_N + r32 * 144 + (8 * g + 4 * h) * 4) = (f32x4){aN[4 * g], aN[4 * g + 1], aN[4 * g + 2], aN[4 * g + 3]};
        rk_store_tile_lds(L + RKA_MAK, RKA_RS_J, r32, 0, h, aAK); rk_store_tile_lds(L + RKA_MRB, RKA_RS_J, r32, 0, h, aRB); rk_store_tile_lds(L + RKA_MRK, RKA_RS_J, r32, 0, h, aRK);
        rk_store_tile_lds(L + RKA_T, RKA_RS_J, r32, 0, h, aN);
    }
    LDS_WAIT(); asm volatile("" ::: "memory");
    {
        const int blk = (r32 >> 4) & 1, cc = r32 & 15;
        const LAS unsigned char* Nb = L + RKA_N + (16 * blk) * 144 + (16 * blk) * 4;
        float T[16];
#pragma unroll
        for (int t = 0; t < 16; ++t) { float ac[4] = {(cc == t) ? 1.0f : 0.0f, 0.f, 0.f, 0.f};
#pragma unroll
            for (int j4 = 0; j4 < (t + 3) / 4; ++j4) { const f32x4 n4 = *(const LAS f32x4*)(Nb + t * 144 + j4 * 16);
#pragma unroll
                for (int e = 0; e < 4; ++e) if (4 * j4 + e < t) ac[e] += n4[e] * T[4 * j4 + e]; }
            T[t] = (ac[0] + ac[1]) + (ac[2] + ac[3]); }
        LDS_WAIT(); asm volatile("" ::: "memory");
#pragma unroll
        for (int t = 0; t < 16; ++t) *(LAS bf16*)(L + RKA_T + (16 * blk + t) * RKA_RS_J + r32 * 2) = (bf16)f2bf(T[t]);
        if (blk == 0) { LAS v4u* p = (LAS v4u*)(L + RKA_N + cc * RKA_RS_J);
            p[0] = (v4u){pk2(T[0], T[1]), pk2(T[2], T[3]), pk2(T[4], T[5]), pk2(T[6], T[7])}; p[1] = (v4u){pk2(T[8], T[9]), pk2(T[10], T[11]), pk2(T[12], T[13]), pk2(T[14], T[15])}; }
        LDS_WAIT(); asm volatile("" ::: "memory");
        rk_f32x16 xa = {};
        xa = rk_mfma(*(const LAS rk_bf16x8*)(L + RKA_T + (16 + r32) * RKA_RS_J + 16 * h), *(const LAS rk_bf16x8*)(L + RKA_N + r32 * RKA_RS_J + 16 * h), xa);
        if (r32 < 16) {
#pragma unroll
            for (int g = 0; g < 2; ++g) { v2u w; w.x = rk_pk(xa[4 * g], xa[4 * g + 1]); w.y = rk_pk(xa[4 * g + 2], xa[4 * g + 3]); *(LAS v2u*)(L + RKA_N + 1280 + r32 * RKA_RS_J + (8 * g + 4 * h) * 2) = w; } }
        LDS_WAIT(); asm volatile("" ::: "memory");
        rk_f32x16 ta = {};
        ta = rk_mfma(*(const LAS rk_bf16x8*)(L + RKA_N + 1280 + r32 * RKA_RS_J + 16 * h), *(const LAS rk_bf16x8*)(L + RKA_T + (16 + r32) * RKA_RS_J + (16 + 8 * h) * 2), ta);
        LDS_WAIT(); asm volatile("" ::: "memory");
        if (r32 < 16) {
#pragma unroll
            for (int g = 0; g < 2; ++g) { v2u w; w.x = rk_pk(ta[4 * g], ta[4 * g + 1]); w.y = rk_pk(ta[4 * g + 2], ta[4 * g + 3]); *(LAS v2u*)(L + RKA_T + (16 + r32) * RKA_RS_J + (8 * g + 4 * h) * 2) = w; } }
    }
    LDS_WAIT(); asm volatile("" ::: "memory");
    rk_bf16x8 fT[2];
#pragma unroll
    for (int s = 0; s < 2; ++s) fT[s] = rk_frag(L + RKA_T, RKA_RS_J, r32, s, h);
    {
        rk_f32x16 x0[2] = {{}, {}}, ap[2] = {{}, {}};
#pragma unroll
        for (int s = 0; s < 2; ++s) { const rk_bf16x8 fM = rk_frag(L + RKA_MAK, RKA_RS_J, r32, s, h);
#pragma unroll
            for (int nt = 0; nt < 2; ++nt) { x0[nt] = rk_mfma(fM, rk_frag(L + RKA_VT, RKA_RS_J, nt * 32 + r32, s, h), x0[nt]); ap[nt] = rk_mfma(fT[s], rk_frag(L + RKA_AT, RKA_RS_J, nt * 32 + r32, s, h), ap[nt]); } }
        LDS_WAIT(); asm volatile("" ::: "memory");
#pragma unroll
        for (int nt = 0; nt < 2; ++nt) { rk_store_tile_lds(L + RKA_X, RKA_RS_J, nt * 32 + r32, 0, h, x0[nt]); rk_store_tile_lds(L + RKA_AT, RKA_RS_J, nt * 32 + r32, 0, h, ap[nt]); }
    }
    LDS_WAIT(); asm volatile("" ::: "memory");
    {
        rk_f32x16 u0[2] = {{}, {}};
#pragma unroll
        for (int s = 0; s < 2; ++s)
#pragma unroll
            for (int nt = 0; nt < 2; ++nt) u0[nt] = rk_mfma(fT[s], rk_frag(L + RKA_X, RKA_RS_J, nt * 32 + r32, s, h), u0[nt]);
        LDS_WAIT(); asm volatile("" ::: "memory");
#pragma unroll
        for (int nt = 0; nt < 2; ++nt) rk_store_tile_lds(L + RKA_X, RKA_RS_J, nt * 32 + r32, 0, h, u0[nt]);
    }
    LDS_WAIT(); asm volatile("" ::: "memory");
    unsigned char* pq = rk_pq(ws, chunk >> 5) + (size_t)uh * 16384; unsigned char* ry = rk_ry(ws, chunk >> 5) + (size_t)uh * 8192;
    rk_bf16x8 fRB[2], fRK[2], fAp[2][2], fBh[2][2], fKh[2][2], fU[2][2], fV[2][2];
#pragma unroll
    for (int s = 0; s < 2; ++s) { fRB[s] = rk_frag(L + RKA_MRB, RKA_RS_J, r32, s, h); fRK[s] = rk_frag(L + RKA_MRK, RKA_RS_J, r32, s, h);
#pragma unroll
        for (int nt = 0; nt < 2; ++nt) { fAp[nt][s] = rk_frag(L + RKA_AT, RKA_RS_J, nt * 32 + r32, s, h); fBh[nt][s] = rk_frag(L + RKA_BH, RKA_RS_J, nt * 32 + r32, s, h);
            fKh[nt][s] = rk_frag(L + RKA_KH, RKA_RS_J, nt * 32 + r32, s, h); fU[nt][s] = rk_frag(L + RKA_X, RKA_RS_J, nt * 32 + r32, s, h); fV[nt][s] = rk_frag(L + RKA_VT, RKA_RS_J, nt * 32 + r32, s, h); } }
#pragma unroll
    for (int kt = 0; kt < 2; ++kt) {
        rk_f32x16 acc;
#pragma unroll
        for (int g = 0; g < 4; ++g) { const v2u w = *(const LAS v2u*)(L + RKA_R + r32 * RKA_RS_K + (kt * 32 + 8 * g + 4 * h) * 2); acc[4 * g] = bflo(w.x); acc[4 * g + 1] = bfhi(w.x); acc[4 * g + 2] = bflo(w.y); acc[4 * g + 3] = bfhi(w.y); }
#pragma unroll
        for (int s = 0; s < 2; ++s) acc = rk_mfma(fAp[kt][s], fRB[s], acc);
        rk_store_tile_frag(ry, 0, r32, kt, h, acc);
    }
#pragma unroll
    for (int kt = 0; kt < 2; ++kt)
#pragma unroll
        for (int kq = 0; kq < 2; ++kq) { rk_f32x16 acc = {};
#pragma unroll
            for (int s = 0; s < 2; ++s) acc = rk_mfma(fAp[kq][s], fBh[kt][s], acc);
            acc = acc * *(const LAS float*)(L + RKA_GC + (kt * 32 + r32) * 4);
            rk_store_tile_frag(pq, kt, r32, kq, h, acc); }
#pragma unroll
    for (int vt = 0; vt < 2; ++vt) {
        rk_f32x16 acc = {};
#pragma unroll
        for (int s = 0; s < 2; ++s) { acc = rk_mfma(fU[vt][s], fRB[s], acc); acc = rk_mfma(fV[vt][s], fRK[s], acc); }
        rk_store_blob((unsigned*)(ry + 4096) + vt * 512, lane, acc);
    }
#pragma unroll
    for (int kt = 0; kt < 2; ++kt)
#pragma unroll
        for (int vt = 0; vt < 2; ++vt) { rk_f32x16 acc = {};
#pragma unroll
            for (int s = 0; s < 2; ++s) { acc = rk_mfma(fBh[kt][s], fU[vt][s], acc); acc = rk_mfma(fKh[kt][s], fV[vt][s], acc); }
#pragma unroll
            for (int g = 0; g < 4; ++g) { const f32x4 gq = *(const LAS f32x4*)(L + RKA_GC + (kt * 32 + 8 * g + 4 * h) * 4); acc[4 * g] *= gq[0]; acc[4 * g + 1] *= gq[1]; acc[4 * g + 2] *= gq[2]; acc[4 * g + 3] *= gq[3]; }
            rk_store_blob((unsigned*)(pq + 8192) + (kt * 2 + vt) * 512, lane, acc); }
    LDS_WAIT(); asm volatile("" ::: "memory");
}
__device__ __forceinline__ void rwkvA_phase(Frame& F, const InTab& A, int half) {
    if (F.wave >= RKA_WAVES) return;
    LAS unsigned char* L = F.lds + RING_OFF + F.wave * RKA_BYTES;
    const int gw = F.bx * RKA_WAVES + F.wave, NGW = F.G * RKA_WAVES;
    for (int u = gw; u < 64 * 32; u += NGW) rwkvA_unit(L, A, F.ws, u >> 5, half * 32 + (u & 31), F.lane);
}
__device__ __forceinline__ void rwkvA_queue(Frame& F, const InTab& A, int half, unsigned* counter) {
    if (F.wave >= RKA_WAVES) return;
    LAS unsigned char* L = F.lds + RING_OFF + F.wave * RKA_BYTES;
    for (;;) {
        unsigned u = 0; if (F.lane == 0) u = __hip_atomic_fetch_add(counter, 1u, __ATOMIC_RELAXED, __HIP_MEMORY_SCOPE_AGENT);
        u = __builtin_amdgcn_readfirstlane(u);
        if (u >= 64u * 32u) break;
        rwkvA_unit(L, A, F.ws, (int)(u >> 5), half * 32 + (int)(u & 31), F.lane);
    }
}
constexpr int RKB_RS = 144, RKB_SBUF = 64 * RKB_RS;
__device__ __forceinline__ void rwkvB_phase(Frame& F, int bh, int half) {
    int lane = F.lane; asm volatile("" : "+v"(lane));
    const int wave = F.wave, r32 = lane & 31, h = lane >> 5;
    LAS unsigned char* SB = F.lds + RING_OFF;
    unsigned char* ws = F.ws;
    const int b = bh >> 3, hd = bh & 7;
    bf16* Y = (bf16*)(ws + WS_Y);
    const int kt = (wave >> 1) & 1, vt = wave & 1;
    float* sst = (float*)(ws + WS_SST) + (size_t)bh * 4096 + (size_t)(wave & 3) * 1024;
    rk_f32x16 st = {};
    if (wave < 4) {
        if (half != 0) {
#pragma unroll
            for (int i = 0; i < 16; ++i) st[i] = *(const GAS float*)(sst + i * 64 + lane);
        }
        rk_store_tile_lds(SB, RKB_RS, vt * 32 + r32, kt * 32, h, st);
    }
    const int uh0 = bh * 32; const bool isS = wave < 4, isY = !isS && wave < 6;
    const unsigned char* fptr = isS ? rk_pq(ws, half) + (size_t)uh0 * 16384 + (kt * 256 + lane) * 16 : rk_ry(ws, half) + (size_t)uh0 * 8192 + lane * 16;
    const unsigned char* bptr = isS ? rk_pq(ws, half) + (size_t)uh0 * 16384 + 8192 + (kt * 2 + vt) * 2048 + lane * 32 : rk_ry(ws, half) + (size_t)uh0 * 8192 + 4096 + vt * 2048 + lane * 32;
    const LAS unsigned char* gl = SB + 2 * RKB_SBUF + (kt * 32 + 4 * h) * 4;
    const int fstride = isS ? 16384 : 8192;
    struct Op { v4u f[4]; v4u b0, b1; };
    { const int tid_ = wave * 64 + lane; *(LAS f32x4*)(SB + 2 * RKB_SBUF + tid_ * 16) = *(const GAS f32x4*)(rk_gc(ws, half) + (size_t)uh0 * 256 + tid_ * 16); }
    Op o0, o1, o2;
#define RKB_LOAD(O_, c) do { const unsigned char* fp_ = fptr + (size_t)(c) * fstride; const unsigned char* bp_ = bptr + (size_t)(c) * fstride; \
        _Pragma("unroll") for (int s = 0; s < 4; ++s) O_.f[s] = *(const GAS v4u*)(fp_ + 1024 * s); \
        O_.b0 = *(const GAS v4u*)bp_; O_.b1 = *(const GAS v4u*)(bp_ + 16); } while (0)
#define RKB_BAR() do { asm volatile("s_waitcnt lgkmcnt(0)" ::: "memory"); __builtin_amdgcn_s_barrier(); asm volatile("" ::: "memory"); } while (0)
#define RKB_NEXT(O_, c, AH_) RKB_LOAD(O_, ((c) + (AH_) < 32 ? (c) + (AH_) : 31))
#define RKB_STEP_S(O_, c) do { \
        const LAS unsigned char* cur = SB + ((c) & 1) * RKB_SBUF; LAS unsigned char* nxt = SB + (((c) & 1) ^ 1) * RKB_SBUF; \
        rk_bf16x8 fS[4]; _Pragma("unroll") for (int s = 0; s < 4; ++s) fS[s] = rk_frag(cur, RKB_RS, vt * 32 + r32, s, h); \
        RkBlob bb_; bb_.w0 = O_.b0; bb_.w1 = O_.b1; const rk_f32x16 q = rk_blob_f32(bb_); \
        _Pragma("unroll") for (int g = 0; g < 4; ++g) { const f32x4 gq = *(const LAS f32x4*)(gl + (c) * 256 + 32 * g); \
            st[4 * g] = st[4 * g] * gq[0] + q[4 * g]; st[4 * g + 1] = st[4 * g + 1] * gq[1] + q[4 * g + 1]; st[4 * g + 2] = st[4 * g + 2] * gq[2] + q[4 * g + 2]; st[4 * g + 3] = st[4 * g + 3] * gq[3] + q[4 * g + 3]; } \
        _Pragma("unroll") for (int s = 0; s < 4; ++s) st = rk_mfma(__builtin_bit_cast(rk_bf16x8, O_.f[s]), fS[s], st); \
        RKB_NEXT(O_, c, 5); \
        rk_store_tile_lds(nxt, RKB_RS, vt * 32 + r32, kt * 32, h, st); \
        RKB_BAR(); } while (0)
#define RKB_STEP_Y(O_, c) do { \
        const LAS unsigned char* cur = SB + ((c) & 1) * RKB_SBUF; \
        rk_bf16x8 fS[4]; _Pragma("unroll") for (int s = 0; s < 4; ++s) fS[s] = rk_frag(cur, RKB_RS, vt * 32 + r32, s, h); \
        RkBlob bb_; bb_.w0 = O_.b0; bb_.w1 = O_.b1; rk_f32x16 acc = rk_blob_f32(bb_); \
        _Pragma("unroll") for (int s = 0; s < 4; ++s) acc = rk_mfma(fS[s], __builtin_bit_cast(rk_bf16x8, O_.f[s]), acc);       \
        RKB_NEXT(O_, c, 3); \
        rk_store_tile_glb(Y + ((size_t)b * SEQ + (size_t)(half * 32 + (c)) * 32) * 512 + hd * 64, 512, r32, vt * 32, h, acc); \
        RKB_BAR(); } while (0)
    if (isY) { RKB_LOAD(o0, 0); RKB_LOAD(o1, 1); RKB_LOAD(o2, 2); }
    __syncthreads();
    if (isS) {
        Op o3, o4; RKB_LOAD(o0, 0); RKB_LOAD(o1, 1); RKB_LOAD(o2, 2); RKB_LOAD(o3, 3); RKB_LOAD(o4, 4);
#define R5S(c) RKB_STEP_S(o0, c); RKB_STEP_S(o1, (c) + 1); RKB_STEP_S(o2, (c) + 2); RKB_STEP_S(o3, (c) + 3); RKB_STEP_S(o4, (c) + 4);
        R5S(0) R5S(5) R5S(10) R5S(15) R5S(20) R5S(25)
        RKB_STEP_S(o0, 30); RKB_STEP_S(o1, 31);
#undef R5S
    } else if (isY) {
#define R3Y(c) RKB_STEP_Y(o0, c); RKB_STEP_Y(o1, (c) + 1); RKB_STEP_Y(o2, (c) + 2);
        R3Y(0) R3Y(3) R3Y(6) R3Y(9) R3Y(12) R3Y(15) R3Y(18) R3Y(21) R3Y(24) R3Y(27)
        RKB_STEP_Y(o0, 30); RKB_STEP_Y(o1, 31);
#undef R3Y
    } else {
#pragma unroll 1
        for (int c = 0; c < 32; ++c) RKB_BAR();
    }
#undef RKB_STEP_S
#undef RKB_STEP_Y
#undef RKB_NEXT
#undef RKB_BAR
#undef RKB_LOAD
    if (wave < 4 && half == 0) {
#pragma unroll
        for (int i = 0; i < 16; ++i) *(GAS float*)(sst + i * 64 + lane) = st[i];
    }
}

constexpr int NPHASE = 9;
template <int PHM> __global__ void __launch_bounds__(NWAVES * 64, 2) fwd_kernel(Args args) {
    extern __shared__ __attribute__((aligned(16))) unsigned char lds[];
    namespace cg = cooperative_groups;
    Frame F;
    F.lds = (LAS unsigned char*)lds;
    F.tid = threadIdx.x; F.lane = F.tid & 63; F.wave = __builtin_amdgcn_readfirstlane(F.tid >> 6);
    F.G = gridDim.x; F.bx = blockIdx.x;
    F.out = args.out; F.ws = args.ws;
#define PH_BEGIN InTab TAB; { ktab_t kp_ = (ktab_t)__builtin_amdgcn_kernarg_segment_ptr(); asm volatile("" : "+s"(kp_)); TAB.p = kp_; } { int t_ = threadIdx.x; asm volatile("" : "+v"(t_)); F.tid = t_; F.lane = t_ & 63; F.wave = __builtin_amdgcn_readfirstlane(t_ >> 6); } GAS unsigned char* wsg_ = (GAS unsigned char*)args.ws; asm volatile("" : "+s"(wsg_)); unsigned char* ws = (unsigned char*)wsg_; F.ws = ws; GAS bf16_t* gtg_ = (GAS bf16_t*)args.out; asm volatile("" : "+s"(gtg_)); bf16_t* GATES = (bf16_t*)gtg_; F.out = (float*)GATES; (void)GATES;
    const int lo = args.ph_lo, hi = args.ph_hi;
    XcdBarrier bar; bar.bar = nullptr; bar.x = 0; bar.st = nullptr;
    if (hi - lo > 1) {
        for (int u = threadIdx.x; u < (LDS_BYTES - 162816) / 4; u += NWAVES * 64) ((LAS unsigned*)(F.lds + 162816))[u] = 0u;
        { GAS v4u* z_ = (GAS v4u*)(args.ws + WS_CTL) + (size_t)blockIdx.x * (CTL_ZERO_BYTES / 16 / 256); for (int u = threadIdx.x; u < (int)(CTL_ZERO_BYTES / 16 / 256); u += NWAVES * 64) z_[u] = (v4u){0u, 0u, 0u, 0u}; }
        asm volatile("s_waitcnt vmcnt(0)" ::: "memory");
        __syncthreads();
        cg::this_grid().sync();
        bar = xcd_barrier_post((unsigned*)(args.ws + WS_CTL) + CW_BAR, (volatile LAS unsigned*)(F.lds + MISC_OFF) + 8);
    }
#define IN(k) (((PHM >> (k)) & 1) && lo <= (k) && (k) < hi)
#ifdef PROBE_DUP
#define REPS(k) (((k) == PROBE_DUP) ? 2 : 1)
#else
#define REPS(k) 1
#endif
#define SEAM(k) do { if (IN(k) && IN((k) + 1)) { xcd_barrier(bar); } } while (0)
    using pg8::Gemm; using pg8::StaticOrder; using pg8::EpiRow8; using pg8::bf16_t;

    if (IN(0)) for (int rep_ = 0; rep_ < REPS(0); ++rep_) { if (rep_) xcd_barrier(bar); PH_BEGIN p0_prologue(F, TAB); } SEAM(0);
    if (IN(1)) for (int rep_ = 0; rep_ < REPS(1); ++rep_) { if (rep_) xcd_barrier(bar); PH_BEGIN
        Gemm g{(const bf16_t*)(ws + WS_XN), (const bf16_t*)(ws + WS_WIN), M, D_IN - 256, D}; StaticOrder S; S.init(M, D_IN - 256, F.G, F.bx);
        EpiRow8<pg8::FProj> E{{ws, GATES}};
        pg8::gemm_phase<EpiRow8<pg8::FProj>, StaticOrder, PG8_ALIGN, PG8_SP2>(F.lds + RING_OFF, g, S, E);
    } SEAM(1);
    if (IN(2)) { PH_BEGIN
        constexpr int NLW = 64;
        if (F.bx >= F.G - NLW) {
            const int pm = F.bx - (F.G - NLW);
            prep1_rows(F, TAB, pm * 32, pm * 32 + 32, F.wave, NWAVES);
            asm volatile("s_waitcnt vmcnt(0)" ::: "memory"); __syncthreads();
            if (threadIdx.x == 0) { __builtin_amdgcn_fence(__ATOMIC_ACQUIRE, "agent"); asm volatile("s_waitcnt vmcnt(0)" ::: "memory"); }
            __syncthreads();
            int klora = KLORA; asm volatile("" : "+s"(klora));
            Gemm g{(const bf16_t*)(ws + WS_LIN), (const bf16_t*)(ws + WS_WL) + (size_t)1024 * KLORA, M, 512, klora}; pg8::PanelOrder S{pm, 2};
            EpiRow8<pg8::FLoraG> E{{ws}};
            pg8::gemm_phase<EpiRow8<pg8::FLoraG>, pg8::PanelOrder, PG8_ALIGN, PG8_SP2>(F.lds + RING_OFF, g, S, E);
            __syncthreads();
            {
                Gemm g2{(const bf16_t*)(ws + WS_XN), (const bf16_t*)(ws + WS_WIN) + (size_t)(D_IN - 256) * D, M, 256, D}; pg8::PanelOrder S2{pm, 1};
                EpiRow8<pg8::FProjOff> E2{{{ws, GATES}, (D_IN - 256) / 256}};
                pg8::gemm_phase<EpiRow8<pg8::FProjOff>, pg8::PanelOrder, PG8_ALIGN, PG8_SP2>(F.lds + RING_OFF, g2, S2, E2);
                __syncthreads();
            }
        }
        const attn_body::AttnTensors AT{(const attn_body::bf16*)(ws + WS_Q), (const attn_body::bf16*)(ws + WS_K), (const attn_body::bf16*)(ws + WS_V), (attn_body::bf16*)(ws + WS_O)};
        attn_body::attn_phase_queue<8>((char*)lds + RING_OFF, AT, (unsigned*)(ws + WS_CTL + CTL_ATTQ), (volatile LAS unsigned*)(F.lds + MISC_OFF) + 24);
    } SEAM(2);
    if (IN(3)) { PH_BEGIN
        { GAS unsigned char* w_ = (GAS unsigned char*)args.ws; asm volatile("" : "+s"(w_)); F.ws = (unsigned char*)w_; }
        rwkvA_phase(F, TAB, 0);
        xcd_barrier(bar);
        { GAS unsigned char* w_ = (GAS unsigned char*)args.ws; asm volatile("" : "+s"(w_)); F.ws = (unsigned char*)w_; }
        if (F.bx < 64) rwkvB_phase(F, F.bx, 0); else { late_weights(F, TAB, 0, 2, 64); late_weights(F, TAB, 1, 2, 64); }
        __syncthreads();
        { GAS unsigned char* w_ = (GAS unsigned char*)args.ws; asm volatile("" : "+s"(w_)); F.ws = (unsigned char*)w_; }
        rwkvA_queue(F, TAB, 1, (unsigned*)(F.ws + WS_CTL + CTL_RKAQ));
        xcd_barrier(bar);
        { GAS unsigned char* w_ = (GAS unsigned char*)args.ws; asm volatile("" : "+s"(w_)); F.ws = (unsigned char*)w_; }
        if (F.bx < 64) rwkvB_phase(F, F.bx, 1);
    } SEAM(3);
    if (IN(4)) for (int rep_ = 0; rep_ < REPS(4); ++rep_) { if (rep_) xcd_barrier(bar); PH_BEGIN post_phase(F, TAB); } SEAM(4);
    if (IN(5)) for (int rep_ = 0; rep_ < REPS(5); ++rep_) { if (rep_) xcd_barrier(bar); PH_BEGIN
        Gemm g{(const bf16_t*)(ws + WS_YA), (const bf16_t*)(ws + WS_WA), M, D, 1024}; StaticOrder S; S.init(M, D, F.G, F.bx);
        pg8::EpiMerge E{GATES, (bf16_t*)(ws + WS_MERGED)};
        pg8::gemm_phase<pg8::EpiMerge, StaticOrder, PG8_ALIGN, PG8_SP2>(F.lds + RING_OFF, g, S, E);
    } SEAM(5);
    if (IN(6)) for (int rep_ = 0; rep_ < REPS(6); ++rep_) { if (rep_) xcd_barrier(bar); PH_BEGIN
        Gemm g{(const bf16_t*)(ws + WS_MERGED), (const bf16_t*)(ws + WS_WO), M, D, D}; StaticOrder S; S.init(M, D, F.G, F.bx);
        pg8::EpiResNorm<0> E{TAB[I_X], F.out, (bf16_t*)(ws + WS_XN), TAB[I_NFG], (float*)(ws + WS_CTL + CTL_SS1), (unsigned*)(ws + WS_CTL + CTL_CNT1), NORM_EPS, (bf16_t*)(ws + WS_X1B)};
        pg8::gemm_phase<pg8::EpiResNorm<0>, StaticOrder, PG8_ALIGN, PG8_SP2>(F.lds + RING_OFF, g, S, E);
    } SEAM(6);
    if (IN(7)) for (int rep_ = 0; rep_ < REPS(7); ++rep_) { if (rep_) xcd_barrier(bar); PH_BEGIN
        Gemm g{(const bf16_t*)(ws + WS_XN), (const bf16_t*)(ws + WS_W1), M, FF, D}; StaticOrder S; S.init(M, FF, F.G, F.bx);
        EpiRow8<pg8::FRelu2> E{{(bf16_t*)(ws + WS_H)}};
        pg8::gemm_phase<EpiRow8<pg8::FRelu2>, StaticOrder, PG8_ALIGN, PG8_SP2>(F.lds + RING_OFF, g, S, E);
    } SEAM(7);
    if (IN(8)) for (int rep_ = 0; rep_ < REPS(8); ++rep_) { if (rep_) xcd_barrier(bar); PH_BEGIN
        Gemm g{(const bf16_t*)(ws + WS_H), (const bf16_t*)(ws + WS_W2), M, D, FF}; StaticOrder S; S.init(M, D, F.G, F.bx);
        pg8::EpiResNorm<1> E{nullptr, F.out, nullptr, TAB[I_NFIN], (float*)(ws + WS_CTL + CTL_SS2), (unsigned*)(ws + WS_CTL + CTL_CNT2), NORM_EPS, (bf16_t*)(ws + WS_X1B)};
        pg8::gemm_phase<pg8::EpiResNorm<1>, StaticOrder, PG8_ALIGN, PG8_SP2>(F.lds + RING_OFF, g, S, E);
    }
#undef IN
#undef SEAM
#undef PH_BEGIN
}


#ifdef DBG_DUMP
__global__ void dbg_dump(float* out, const unsigned char* ws) {
    const size_t i = (size_t)blockIdx.x * blockDim.x + threadIdx.x; if (i >= (size_t)M * 1024) return;
    const size_t m = i >> 10; const int c = (int)(i & 1023); float v = 0.f;
#if DBG_DUMP == 1
    v = bf1(((const bf16*)(ws + WS_O))[m * 1024 + c]);
#elif DBG_DUMP == 2
    v = c < 512 ? bf1(((const bf16*)(ws + WS_Y))[m * 512 + c]) : (c < 520 ? ((const float*)(ws + WS_BON))[m * 8 + (c - 512)] : 0.f);
#elif DBG_DUMP == 3
    v = c < 512 ? bf1(((const bf16*)(ws + WS_Q))[m * 512 + c]) : bf1(((const bf16*)(ws + WS_K))[m * 512 + c - 512]);
#elif DBG_DUMP == 4
    v = c < 512 ? ((const float*)(ws + WS_DEC))[m * 512 + c] : bf1(((const bf16*)(ws + WS_AA))[m * 512 + c - 512]);
#elif DBG_DUMP == 6
    v = c < 256 ? bf1(((const bf16*)(ws + WS_WAG))[m * 256 + c]) : (c < 512 ? bf1(((const bf16*)(ws + WS_LIN))[m * 256 + c - 256]) : 0.f);
#elif DBG_DUMP == 7
    { const bf16* wl = (const bf16*)(ws + WS_WL); const size_t j = (m * 1024 + c); v = j < (size_t)NLORA * KLORA ? bf1(wl[j]) : 0.f; }
#elif DBG_DUMP == 8
    v = c < 512 ? bf1(((const bf16*)(ws + WS_GG))[m * 512 + c]) : 0.f;
#elif DBG_DUMP == 5
    v = bf1(((const bf16*)(ws + WS_RKV))[m * 1536 + c]);
#endif
    out[i] = v;
}
#endif

#ifdef DBG_FIXLORA
__global__ void dbg_fixlora(Args A) {
    const size_t i = (size_t)blockIdx.x * blockDim.x + threadIdx.x; if (i >= (size_t)M * 512) return;
    const size_t m = i >> 9; const int c = (int)(i & 511);
    const bf16* LINr = (const bf16*)(A.ws + WS_LIN) + m * 256;
#if DBG_FIXLORA & 1
    { float g = 0.f; for (int k = 0; k < 128; ++k) g += bf1(LINr[128 + k]) * A[I_G2][(size_t)k * 512 + c]; ((bf16*)(A.ws + WS_GG))[m * 512 + c] = (bf16)f2bf(g); }
#endif
#if DBG_FIXLORA & 2
    { float s = A[I_A0][c]; for (int k = 0; k < 64; ++k) s += bf1(LINr[64 + k]) * A[I_A2][(size_t)k * 512 + c]; ((bf16*)(A.ws + WS_AA))[m * 512 + c] = (bf16)f2bf(1.0f / (1.0f + expf(-s))); }
#endif
#if DBG_FIXLORA & 4
    { float s = A[I_W0][c]; for (int k = 0; k < 64; ++k) s += bf1(LINr[k]) * A[I_W2][(size_t)k * 512 + c]; const float w = -log1pf(expf(-s)) - 0.5f; ((float*)(A.ws + WS_DEC))[m * 512 + c] = expf(-expf(w)); }
#endif
}
#endif
#ifndef MK_ONE_LAUNCH
#define MK_ONE_LAUNCH 0
#endif
#ifndef MK_MASK
#define MK_MASK ((1 << NPHASE) - 1)
#endif
typedef void (*kern_t)(Args);
template <int P> struct KTab { static void fill(kern_t* t) { t[P] = fwd_kernel<(1 << P)>; KTab<P - 1>::fill(t); } };
template <> struct KTab<-1> { static void fill(kern_t*) {} };
extern "C" void kernel_launch(void* const* d_in, const int* in_sizes, int n_in, void* d_out, int out_size, void* d_ws, size_t ws_size, hipStream_t stream) {
    static int grid = 0; static kern_t ktab[NPHASE];
    if (grid == 0) {
        if (n_in != 26 || in_sizes[0] != M * D || out_size != M * D || ws_size < WS_END) { fprintf(stderr, "kernel_launch: unexpected shapes (n_in %d, in0 %d, out %d, ws %zu); nothing launched\n", n_in, n_in > 0 ? in_sizes[0] : -1, out_size, ws_size); grid = -1; return; }
        int dev = 0, cus = 0;
        if (hipGetDevice(&dev) != hipSuccess || hipDeviceGetAttribute(&cus, hipDeviceAttributeMultiprocessorCount, dev) != hipSuccess) { grid = -1; return; }
#if MK_ONE_LAUNCH
        int per_cu = 0;
        if (hipFuncSetAttribute((const void*)fwd_kernel<MK_MASK>, hipFuncAttributeMaxDynamicSharedMemorySize, LDS_BYTES) != hipSuccess) { fprintf(stderr, "kernel_launch: hipFuncSetAttribute failed\n"); grid = -1; return; }
        if (hipOccupancyMaxActiveBlocksPerMultiprocessor(&per_cu, (const void*)fwd_kernel<MK_MASK>, NWAVES * 64, LDS_BYTES) != hipSuccess || per_cu < 1) { fprintf(stderr, "kernel_launch: occupancy query says %d blocks per CU\n", per_cu); (void)hipGetLastError(); grid = -1; return; }
#else
        KTab<NPHASE - 1>::fill(ktab);
        for (int p = 0; p < NPHASE; ++p) if (hipFuncSetAttribute((const void*)ktab[p], hipFuncAttributeMaxDynamicSharedMemorySize, LDS_BYTES) != hipSuccess) { fprintf(stderr, "kernel_launch: hipFuncSetAttribute failed\n"); grid = -1; return; }
#endif
        grid = cus;
        if (grid != 256) fprintf(stderr, "kernel_launch: note: %d CUs (built for 256)\n", grid);
    }
    if (grid < 0) return;
    Args a{};
    for (int i = 0; i < 26; ++i) a.in[i] = (const float*)d_in[i];
    a.out = (float*)d_out; a.ws = (unsigned char*)d_ws;
#if MK_ONE_LAUNCH
    a.ph_lo = 0; a.ph_hi = NPHASE;
    void* kargs[] = {&a};
    hipError_t e = hipLaunchCooperativeKernel((const void*)fwd_kernel<MK_MASK>, dim3(grid), dim3(NWAVES * 64), kargs, LDS_BYTES, stream);
    if (e != hipSuccess) fprintf(stderr, "kernel_launch: cooperative launch failed: %s\n", hipGetErrorString(e));
#else
#ifdef DBG_DUMP
    for (int p = 0; p <= DBG_STOP; ++p) { a.ph_lo = p; a.ph_hi = p + 1; hipLaunchKernelGGL(ktab[p], dim3(grid), dim3(NWAVES * 64), LDS_BYTES, stream, a); }
    hipLaunchKernelGGL(dbg_dump, dim3((M * 1024) / 256), dim3(256), 0, stream, (float*)d_out, (const unsigned char*)d_ws);
#else
    for (int p = 0; p < NPHASE; ++p) { a.ph_lo = p; a.ph_hi = p + 1; hipLaunchKernelGGL(ktab[p], dim3(grid), dim3(NWAVES * 64), LDS_BYTES, stream, a);
#ifdef DBG_FIXLORA
        if (p == 3) hipLaunchKernelGGL(dbg_fixlora, dim3((M * 512) / 256), dim3(256), 0, stream, a);
#endif
    }
#endif
#endif
}
```

```cpp
#define MK_ONE_LAUNCH 1
#include <hip/hip_runtime.h>
#include <cstdio>
#include <cstdint>
constexpr int NWAVES = 8;
constexpr int BATCH = 8, SEQ = 2048, D = 1024, M = BATCH * SEQ;
constexpr int D_IN = 5376, FF = 4096, RWW = 512, NLORA = 1536, KLORA = 256;
constexpr float NORM_EPS = 1e-6f, SUBLN_EPS = 1e-5f, GN_EPS = 64e-5f, LAMBDA_INIT = 0.2f;
constexpr size_t MiB = 1u << 20;
constexpr size_t WS_CTL = 0, CTL_ZERO_BYTES = 256 * 1024;
constexpr size_t CTL_SS1 = 65536, CTL_SS2 = 131072, CTL_CNT1 = 196608, CTL_CNT2 = 212992, CTL_ATTQ = 229376, CTL_RKAQ = 229380;
constexpr size_t WS_ROPE_C = 512 * 1024, WS_ROPE_S = 768 * 1024;
constexpr size_t WS_BON = 1 * MiB;
constexpr size_t WS_WIN = 2 * MiB;
constexpr size_t WS_WA = WS_WIN + (size_t)D_IN * D * 2;
constexpr size_t WS_WB = WS_WA + 1 * MiB;
constexpr size_t WS_WO = WS_WB + 1 * MiB;
constexpr size_t WS_W1 = WS_WO + 2 * MiB;
constexpr size_t WS_W2 = WS_W1 + 8 * MiB;
constexpr size_t WS_WL = WS_W2 + 8 * MiB;
static_assert(WS_WL + (size_t)NLORA * KLORA * 2 <= 34 * MiB, "weights");
constexpr size_t WS_XN = 34 * MiB;
constexpr size_t WS_DEC = WS_XN;
constexpr size_t WS_Q = 66 * MiB, WS_K = 82 * MiB, WS_V = 98 * MiB;
constexpr size_t WS_RKV = 114 * MiB;
constexpr size_t WS_WAG = 162 * MiB, WS_LIN = 242 * MiB;
constexpr size_t WS_Y = 162 * MiB;
constexpr size_t WS_AA = 178 * MiB, WS_GG = 194 * MiB;
constexpr size_t WS_O = 210 * MiB;
constexpr size_t WS_YA = 66 * MiB, WS_YB = 82 * MiB;
constexpr size_t WS_TMP = 114 * MiB;
constexpr size_t WS_MERGED = 114 * MiB;
constexpr size_t WS_X1B = 194 * MiB;
constexpr size_t WS_H = 66 * MiB;
constexpr size_t WS_END = 252 * MiB;
constexpr int RING_OFF = 0, RING_BYTES = 131072;
constexpr int LDS_BYTES = 163840;

#include <hip/hip_runtime.h>
#include <cstdio>
#include <cstdint>
namespace pg8 {
#define PG8_LAS __attribute__((address_space(3)))
typedef unsigned short bf16_t;
typedef short bf16x8 __attribute__((ext_vector_type(8)));
typedef float f32x4 __attribute__((ext_vector_type(4)));
typedef unsigned u32x4 __attribute__((ext_vector_type(4)));
constexpr int BM = 256, BK = 64, HALF = 128, HTB = HALF * BK * 2  , STAGE_BYTES = 8 * HTB, NXCD = 8, WGM = 8;

__host__ __device__ __forceinline__ int lds_byte(int r, int c) { const int st = (r >> 4) * 2 + (c >> 5), rr = r & 15, cc = c & 31, ob = rr * 64 + cc * 2; return st * 1024 + (ob ^ (((ob >> 9) & 1) << 5)); }
__host__ __device__ __forceinline__ void stage_rc(int b, int& R, int& C) { const int st = b / 1024, sb = b % 1024, swz = sb ^ (((sb >> 9) & 1) << 5); R = (st >> 1) * 16 + swz / 64; C = (st & 1) * 32 + (swz % 64) / 2; }
__host__ __device__ __forceinline__ int perm32(int rho) { const int n = rho >> 4, i = rho & 15; return 8 * (i >> 2) + 4 * n + (i & 3); }

struct Unit { int pm, pn; };
struct Gemm { const bf16_t* A; const bf16_t* Bt; int M, N, K; };

struct StaticOrder {
    int nM, nN, nwg, G, c;
    __host__ __device__ void init(int M, int N, int G_, int c_) { nM = M / BM; nN = N / BM; nwg = nM * nN; G = G_; c = c_; }
    __host__ __device__ bool next(int i, Unit& u) const {
        const long L = (long)i * G + c; if (L >= nwg) return false;
        int wgid = (int)L; { const int q = nwg / NXCD, r = nwg % NXCD, xcd = wgid % NXCD, off = wgid / NXCD; wgid = (xcd < r ? xcd * (q + 1) : r * (q + 1) + (xcd - r) * q) + off; }
        const int nig = WGM * nN, gid = wgid / nig, fm = gid * WGM, gsz = (nM - fm) < WGM ? (nM - fm) : WGM;
        u.pm = fm + ((wgid % nig) % gsz); u.pn = (wgid % nig) / gsz; return true;
    }
    __device__ __forceinline__ void a_ready(const Unit&) const {}
    __device__ __forceinline__ void done(const Unit&) const {}
};

typedef float f32x2c_t __attribute__((ext_vector_type(2))); typedef __bf16 bf16x2c_t __attribute__((ext_vector_type(2)));
__device__ __forceinline__ unsigned cvt_pk_bf16(float lo, float hi) { f32x2c_t v = {lo, hi}; bf16x2c_t b = __builtin_convertvector(v, bf16x2c_t); return __builtin_bit_cast(unsigned, b); }
typedef float f32x2 __attribute__((ext_vector_type(2)));
__device__ __forceinline__ f32x2 gelu_pk(f32x2 v) {
    const f32x2 av = __builtin_elementwise_abs(v), d = av * 0.2316418882f + 1.0f;
    f32x2 t; t.x = __builtin_amdgcn_rcpf(d.x); t.y = __builtin_amdgcn_rcpf(d.y);
    f32x2 q = t * 0.5307027145f + (-0.7265760135f); q = q * t + 0.7107068705f; q = q * t + (-0.142248368f); q = q * t + 0.127414796f; q = q * t;
    const f32x2 s = (v * v) * (-0.72134752044f);
    f32x2 e; e.x = __builtin_amdgcn_exp2f(s.x); e.y = __builtin_amdgcn_exp2f(s.y);
    const f32x2 m = v * (q * e), r = v - m;
    f32x2 o; o.x = v.x < 0.f ? m.x : r.x; o.y = v.y < 0.f ? m.y : r.y; return o;
}

template <int ACT  > struct EpiBf16 {
    static constexpr int MIDK = 0; static constexpr bool PERM = true, AFTER_DRAIN = false; static_assert(ACT == 0 || ACT == 1, "EpiBf16: ACT is 0 (none) or 1 (gelu_pk)");
    bf16_t* O; int ldc; const float* bias; int split_cols; size_t split_stride; float scale0;
    __device__ __forceinline__ void operator()(const f32x4 (&acc)[2][2][4][2], const Unit& u, int wr, int wc, int fr, int fq) const {
        const int row0 = u.pm * BM + wr * 64 + fr; int colt = u.pn * BM; bf16_t* base = O;
        float sc = 1.f; if (split_cols) { const int t = colt / split_cols; base += (size_t)t * split_stride; colt -= t * split_cols; if (t == 0) sc = scale0; }
        const int col0 = colt + wc * 32 + 8 * fq, bcol0 = u.pn * BM + wc * 32 + 8 * fq;
        f32x4 bv[2][2];
#pragma unroll
        for (int bj = 0; bj < 2; ++bj)
#pragma unroll
            for (int n = 0; n < 2; ++n) bv[bj][n] = bias ? *(const f32x4*)(bias + bcol0 + bj * HALF + 4 * n) : (f32x4){0.f, 0.f, 0.f, 0.f};
#pragma unroll
        for (int ai = 0; ai < 2; ++ai)
#pragma unroll
            for (int m = 0; m < 4; ++m) { bf16_t* rowp = base + (size_t)(row0 + ai * HALF + m * 16) * ldc + col0;
#pragma unroll
                for (int bj = 0; bj < 2; ++bj) { f32x4 v0 = acc[ai][bj][m][0] + bv[bj][0], v1 = acc[ai][bj][m][1] + bv[bj][1];
                    if (ACT == 1) { f32x2 a = gelu_pk((f32x2){v0[0], v0[1]}), b = gelu_pk((f32x2){v0[2], v0[3]}), c = gelu_pk((f32x2){v1[0], v1[1]}), d = gelu_pk((f32x2){v1[2], v1[3]});
                        v0 = (f32x4){a.x, a.y, b.x, b.y}; v1 = (f32x4){c.x, c.y, d.x, d.y}; }
                    v0 = v0 * sc; v1 = v1 * sc; u32x4 w; w.x = cvt_pk_bf16(v0[0], v0[1]); w.y = cvt_pk_bf16(v0[2], v0[3]); w.z = cvt_pk_bf16(v1[0], v1[1]); w.w = cvt_pk_bf16(v1[2], v1[3]);
                    *(u32x4*)(rowp + bj * HALF) = w; } }
    }
};
typedef unsigned u32x2 __attribute__((ext_vector_type(2)));
__device__ __forceinline__ float bf_lo(unsigned w) { return __builtin_bit_cast(float, w << 16); }
__device__ __forceinline__ float bf_hi(unsigned w) { return __builtin_bit_cast(float, w & 0xffff0000u); }
__device__ __forceinline__ u32x4 pack8(f32x4 v0, f32x4 v1) { u32x4 w; w.x = cvt_pk_bf16(v0[0], v0[1]); w.y = cvt_pk_bf16(v0[2], v0[3]); w.z = cvt_pk_bf16(v1[0], v1[1]); w.w = cvt_pk_bf16(v1[2], v1[3]); return w; }
__device__ __forceinline__ float sigmoidf_(float x) { return __builtin_amdgcn_rcpf(1.0f + __expf(-x)); }
template <class F> struct EpiRow8 {
    static constexpr int MIDK = 0; static constexpr bool PERM = true, AFTER_DRAIN = false;
    F f;
    __device__ __forceinline__ void operator()(const f32x4 (&acc)[2][2][4][2], const Unit& u, int wr, int wc, int fr, int fq) const {
        const int row0 = u.pm * BM + wr * 64 + fr, c0 = wc * 32 + 8 * fq;
#pragma unroll
        for (int ai = 0; ai < 2; ++ai)
#pragma unroll
            for (int m = 0; m < 4; ++m) { const int row = row0 + ai * HALF + m * 16;
#pragma unroll
                for (int bj = 0; bj < 2; ++bj) { f(u.pn, row, c0 + bj * HALF, acc[ai][bj][m][0], acc[ai][bj][m][1]); if (F::FENCE) asm volatile("" ::: "memory"); } }
    }
};
constexpr float ATT_C2 = 0.125f * 1.4426950408889634f;
struct FProj {
    static constexpr bool FENCE = false;
    unsigned char* ws; bf16_t* GATES;
    __device__ __forceinline__ void operator()(int pn, int row, int cu, f32x4 v0, f32x4 v1) const {
        if (pn < 4) {
            const int sh = cu >> 6, j = (cu & 63) >> 3, pos = row & 2047;
            const f32x4 c = *(const f32x4*)((const float*)(ws + WS_ROPE_C) + pos * 32 + 4 * j), s = *(const f32x4*)((const float*)(ws + WS_ROPE_S) + pos * 32 + 4 * j);
            const float sc = pn < 2 ? ATT_C2 : 1.0f;
            const f32x4 o1 = (v0 * c - v1 * s) * sc, o2 = (v1 * c + v0 * s) * sc;
            bf16_t* dst = (bf16_t*)(ws + (pn < 2 ? WS_Q : WS_K)) + (size_t)row * 512 + (pn & 1) * 256 + sh * 64 + 4 * j;
            u32x2 w1, w2; w1.x = cvt_pk_bf16(o1[0], o1[1]); w1.y = cvt_pk_bf16(o1[2], o1[3]); w2.x = cvt_pk_bf16(o2[0], o2[1]); w2.y = cvt_pk_bf16(o2[2], o2[3]);
            *(u32x2*)dst = w1; *(u32x2*)(dst + 32) = w2;
        } else if (pn < 13) {
            size_t off; int pitch, col;
            if (pn < 6) { off = WS_V; pitch = 512; col = (pn - 4) * 256; }
            else if (pn < 12) { off = WS_RKV; pitch = 1536; col = (pn - 6) * 256; }
            else { off = WS_WAG; pitch = 256; col = 0; }
            *(u32x4*)((bf16_t*)(ws + off) + (size_t)row * pitch + col + cu) = pack8(v0, v1);
        } else *(u32x4*)(GATES + (size_t)row * 2048 + (pn - 13) * 256 + cu) = pack8(v0, v1);
    }
};
struct FLora {
    static constexpr bool FENCE = false;
    unsigned char* ws; const float *w0, *a0;
    __device__ __forceinline__ void operator()(int pn, int row, int cu, f32x4 v0, f32x4 v1) const {
        const int c = (pn & 1) * 256 + cu;
        if (pn < 2) {
            const f32x4 b0 = *(const f32x4*)(w0 + c), b1 = *(const f32x4*)(w0 + c + 4);
            float* dst = (float*)(ws + WS_DEC) + (size_t)row * 512 + c; *(f32x4*)dst = v0 + b0; *(f32x4*)(dst + 4) = v1 + b1;
        } else if (pn < 4) {
            const f32x4 b0 = *(const f32x4*)(a0 + c), b1 = *(const f32x4*)(a0 + c + 4);
            *(u32x4*)((bf16_t*)(ws + WS_AA) + (size_t)row * 512 + c) = pack8(v0 + b0, v1 + b1);
        } else *(u32x4*)((bf16_t*)(ws + WS_GG) + (size_t)row * 512 + c) = pack8(v0, v1);
    }
};
struct FProjOff {
    static constexpr bool FENCE = false;
    FProj f; int off;
    __device__ __forceinline__ void operator()(int pn, int row, int cu, f32x4 v0, f32x4 v1) const { f(pn + off, row, cu, v0, v1); }
};
struct FLoraG {
    static constexpr bool FENCE = false;
    unsigned char* ws;
    __device__ __forceinline__ void operator()(int pn, int row, int cu, f32x4 v0, f32x4 v1) const { *(u32x4*)((bf16_t*)(ws + WS_GG) + (size_t)row * 512 + pn * 256 + cu) = pack8(v0, v1); }
};
struct EpiMerge {
    static constexpr int MIDK = 8; static constexpr bool PERM = true, AFTER_DRAIN = false;
    const bf16_t* GATES; bf16_t* MERGED;
    static __device__ __forceinline__ float ratio_(float ga, float gb) { return (1.0f + __expf(-gb)) * __builtin_amdgcn_rcpf(1.0f + __expf(-ga)); }
    __device__ __forceinline__ void mid(f32x4 (&acc)[2][2][4][2], const Unit& u, int wr, int wc, int fr, int fq) const {
        int fr_ = fr; asm volatile("" : "+v"(fr_));
        const bf16_t* gp0 = GATES + (size_t)(u.pm * BM + wr * 64 + fr_) * 2048 + u.pn * BM + wc * 32 + 8 * fq;
#pragma unroll
        for (int ai = 0; ai < 2; ++ai)
#pragma unroll
            for (int m = 0; m < 4; ++m)
#pragma unroll
                for (int bj = 0; bj < 2; ++bj) { const bf16_t* gp = gp0 + (size_t)(ai * HALF + m * 16) * 2048 + bj * HALF;
                    const u32x4 ga = *(const u32x4*)gp, gb = *(const u32x4*)(gp + 1024);
                    f32x4& v0 = acc[ai][bj][m][0]; f32x4& v1 = acc[ai][bj][m][1];
                    v0[0] *= ratio_(bf_lo(ga.x), bf_lo(gb.x)); v0[1] *= ratio_(bf_hi(ga.x), bf_hi(gb.x)); v0[2] *= ratio_(bf_lo(ga.y), bf_lo(gb.y)); v0[3] *= ratio_(bf_hi(ga.y), bf_hi(gb.y));
                    v1[0] *= ratio_(bf_lo(ga.z), bf_lo(gb.z)); v1[1] *= ratio_(bf_hi(ga.z), bf_hi(gb.z)); v1[2] *= ratio_(bf_lo(ga.w), bf_lo(gb.w)); v1[3] *= ratio_(bf_hi(ga.w), bf_hi(gb.w));
                    asm volatile("" ::: "memory"); }
    }
    __device__ __forceinline__ void operator()(const f32x4 (&acc)[2][2][4][2], const Unit& u, int wr, int wc, int fr, int fq) const {
        const int row0 = u.pm * BM + wr * 64 + fr, c0 = u.pn * BM + wc * 32 + 8 * fq;
#pragma unroll
        for (int ai = 0; ai < 2; ++ai)
#pragma unroll
            for (int m = 0; m < 4; ++m) { const int row = row0 + ai * HALF + m * 16;
#pragma unroll
                for (int bj = 0; bj < 2; ++bj) { const u32x4 g = *(const u32x4*)(GATES + (size_t)row * 2048 + 1024 + c0 + bj * HALF);
                    f32x4 v0 = acc[ai][bj][m][0], v1 = acc[ai][bj][m][1];
                    v0[0] *= sigmoidf_(bf_lo(g.x)); v0[1] *= sigmoidf_(bf_hi(g.x)); v0[2] *= sigmoidf_(bf_lo(g.y)); v0[3] *= sigmoidf_(bf_hi(g.y));
                    v1[0] *= sigmoidf_(bf_lo(g.z)); v1[1] *= sigmoidf_(bf_hi(g.z)); v1[2] *= sigmoidf_(bf_lo(g.w)); v1[3] *= sigmoidf_(bf_hi(g.w));
                    *(u32x4*)(MERGED + (size_t)row * 1024 + c0 + bj * HALF) = pack8(v0, v1); } }
    }
};
struct FRes {
    static constexpr bool FENCE = false;
    const float* base; float* out;
    __device__ __forceinline__ void operator()(int pn, int row, int cu, f32x4 v0, f32x4 v1) const {
        const size_t off = (size_t)row * 1024 + pn * 256 + cu; const f32x4 b0 = *(const f32x4*)(base + off), b1 = *(const f32x4*)(base + off + 4);
        *(f32x4*)(out + off) = b0 + v0; *(f32x4*)(out + off + 4) = b1 + v1;
    }
};
struct FRelu2 {
    static constexpr bool FENCE = false;
    bf16_t* H;
    __device__ __forceinline__ void operator()(int pn, int row, int cu, f32x4 v0, f32x4 v1) const {
        f32x4 r0, r1;
#pragma unroll
        for (int e = 0; e < 4; ++e) { const float a = __builtin_fmaxf(v0[e], 0.f), b = __builtin_fmaxf(v1[e], 0.f); r0[e] = a * a; r1[e] = b * b; }
        *(u32x4*)(H + (size_t)row * 4096 + pn * 256 + cu) = pack8(r0, r1);
    }
};

__device__ __forceinline__ float xsum_fq(float x) {
    { auto r = __builtin_amdgcn_permlane16_swap(__builtin_bit_cast(unsigned, x), __builtin_bit_cast(unsigned, x), false, false); const unsigned a = r[0], b = r[1]; x = __builtin_bit_cast(float, a) + __builtin_bit_cast(float, b); }
    { auto r = __builtin_amdgcn_permlane32_swap(__builtin_bit_cast(unsigned, x), __builtin_bit_cast(unsigned, x), false, false); const unsigned a = r[0], b = r[1]; x = __builtin_bit_cast(float, a) + __builtin_bit_cast(float, b); }
    return x;
}
template <int MODE> struct EpiResNorm {
    static constexpr int MIDK = 0; static constexpr bool PERM = true, AFTER_DRAIN = false;
    const float* base; float* out; bf16_t* xn; const float* g; float* ss; unsigned* cnt; float eps; bf16_t* x1b;
    __device__ __forceinline__ void operator()(f32x4 (&acc)[2][2][4][2], const Unit& u, int wr, int wc, int fr, int fq) const {
        const int row0 = u.pm * BM + wr * 64 + fr, c0 = u.pn * BM + wc * 32 + 8 * fq;
#pragma unroll
        for (int ai = 0; ai < 2; ++ai)
#pragma unroll
            for (int m = 0; m < 4; ++m) { const int row = row0 + ai * HALF + m * 16; float s = 0.f;
#pragma unroll
                for (int bj = 0; bj < 2; ++bj) { const size_t off = (size_t)row * 1024 + c0 + bj * HALF; f32x4 b0, b1;
                    if (MODE == 0) { b0 = *(const f32x4*)(base + off); b1 = *(const f32x4*)(base + off + 4); }
                    else { const u32x4 w = *(const u32x4*)(x1b + off); b0 = (f32x4){bf_lo(w.x), bf_hi(w.x), bf_lo(w.y), bf_hi(w.y)}; b1 = (f32x4){bf_lo(w.z), bf_hi(w.z), bf_lo(w.w), bf_hi(w.w)}; }
                    f32x4& v0 = acc[ai][bj][m][0]; f32x4& v1 = acc[ai][bj][m][1]; v0 += b0; v1 += b1;
                    if (MODE == 0) *(u32x4*)(x1b + off) = pack8(v0, v1);
                    s += (v0[0] * v0[0] + v0[1] * v0[1]) + (v0[2] * v0[2] + v0[3] * v0[3]) + (v1[0] * v1[0] + v1[1] * v1[1]) + (v1[2] * v1[2] + v1[3] * v1[3]); }
                s = xsum_fq(s);
                if (fq == 0) __hip_atomic_fetch_add(ss + row, s, __ATOMIC_RELAXED, __HIP_MEMORY_SCOPE_AGENT);
                if (m & 1) asm volatile("" ::: "memory"); }
        asm volatile("s_waitcnt vmcnt(0)" ::: "memory");
        unsigned* c_ = cnt + 64 * u.pm;
        if (fr == 0 && fq == 0) __hip_atomic_fetch_add(c_, 1u, __ATOMIC_RELAXED, __HIP_MEMORY_SCOPE_AGENT);
        { unsigned spins = 0; while ((unsigned)__builtin_amdgcn_readfirstlane(__hip_atomic_load(c_, __ATOMIC_RELAXED, __HIP_MEMORY_SCOPE_AGENT)) < 32u && ++spins < (1u << 22)) __builtin_amdgcn_s_sleep(2); }
        asm volatile("" ::: "memory");
#pragma unroll
        for (int ai = 0; ai < 2; ++ai)
#pragma unroll
            for (int m = 0; m < 4; ++m) { const int row = row0 + ai * HALF + m * 16;
                const float rstd = 1.0f / sqrtf(__hip_atomic_load(ss + row, __ATOMIC_RELAXED, __HIP_MEMORY_SCOPE_AGENT) * (1.0f / 1024.0f) + eps);
#pragma unroll
                for (int bj = 0; bj < 2; ++bj) { const size_t off = (size_t)row * 1024 + c0 + bj * HALF; const f32x4 g0 = *(const f32x4*)(g + c0 + bj * HALF), g1 = *(const f32x4*)(g + c0 + bj * HALF + 4);
                    const f32x4 o0 = acc[ai][bj][m][0] * rstd * g0, o1 = acc[ai][bj][m][1] * rstd * g1;
                    if (MODE == 0) *(u32x4*)(xn + off) = pack8(o0, o1); else { *(f32x4*)(out + off) = o0; *(f32x4*)(out + off + 4) = o1; } }
                if (m & 1) asm volatile("" ::: "memory"); }
    }
};

struct PanelOrder {
    int pm, ntiles;
    __device__ __forceinline__ bool next(int i, Unit& u) const { if (i >= ntiles) return false; int p = pm; asm volatile("" : "+s"(p)); u.pm = p; u.pn = i; return true; }
    __device__ __forceinline__ void a_ready(const Unit&) const {}
    __device__ __forceinline__ void done(const Unit&) const {}
};
template <class Epi, class Sched, bool ALIGN_EPI = false, bool SP2 = false>
__device__ __forceinline__ void gemm_phase(PG8_LAS unsigned char* lds, const Gemm g, const Sched& S, const Epi& E) {
    int tid_ = threadIdx.x; asm volatile("" : "+v"(tid_));
    const int tid = tid_, wid = __builtin_amdgcn_readfirstlane(tid >> 6), lane = tid & 63, wr = wid >> 2, wc = wid & 3, fr = lane & 15, fq = lane >> 4;
    const int K = g.K, nt = K / BK;
    unsigned voffA[2], voffB[2];
#pragma unroll
    for (int i = 0; i < 2; ++i) { int R, C; stage_rc(tid * 16 + i * 8192, R, C); const int Rb = Epi::PERM ? ((R & ~31) + perm32(R & 31)) : R;
        voffA[i] = (unsigned)(R * K + C) * 2u; voffB[i] = (unsigned)(Rb * K + C) * 2u; }
    const size_t kstep = (size_t)(BK * 2);
    const size_t hstep = (size_t)HALF * K * 2;
    const size_t tstep = 2 * hstep;
    const unsigned ldsw = (unsigned)wid * 1024u;
    const int aoff = lds_byte(wr * 64 + fr, fq * 8), boff = lds_byte(wc * 32 + fr, fq * 8);
#define PG8_SA(b, h) (((b) * 2 + (h)) * HTB)
#define PG8_SB(b, h) ((4 + (b) * 2 + (h)) * HTB)
#define PG8_STAGE(bufoff, gbase, voff) do { _Pragma("unroll") for (int _i = 0; _i < 2; ++_i) \
        __builtin_amdgcn_global_load_lds((const unsigned*)((const char*)(gbase) + (voff)[_i]), (PG8_LAS unsigned*)(lds + (bufoff) + ldsw + _i * 8192), 16, 0, 0); } while (0)
#define PG8_LDA(dst, b, h) do { _Pragma("unroll") for (int m = 0; m < 4; ++m) _Pragma("unroll") for (int k = 0; k < 2; ++k) dst[m][k] = *(const PG8_LAS bf16x8*)(lds + PG8_SA(b, h) + aoff + m * 2048 + k * 1024); } while (0)
#define PG8_LDB(dst, b, h) do { _Pragma("unroll") for (int n = 0; n < 2; ++n) _Pragma("unroll") for (int k = 0; k < 2; ++k) dst[n][k] = *(const PG8_LAS bf16x8*)(lds + PG8_SB(b, h) + boff + n * 2048 + k * 1024); } while (0)
#define PG8_MMA(ai, bj, At, Bt) do { __builtin_amdgcn_s_setprio(1); _Pragma("unroll") for (int m = 0; m < 4; ++m) _Pragma("unroll") for (int n = 0; n < 2; ++n) _Pragma("unroll") for (int k = 0; k < 2; ++k) \
        acc[ai][bj][m][n] = __builtin_amdgcn_mfma_f32_16x16x32_bf16(Bt[n][k], At[m][k], acc[ai][bj][m][n], 0, 0, 0); __builtin_amdgcn_s_setprio(0); } while (0)
#define PG8_WAIT_V(n) asm volatile("s_waitcnt vmcnt(" #n ")" ::: "memory")
#define PG8_WAIT_L(n) asm volatile("s_waitcnt lgkmcnt(" #n ")" ::: "memory")
#define PG8_BAR __builtin_amdgcn_s_barrier()
#define PG8_SCHED __builtin_amdgcn_sched_barrier(0)
    Unit cur, nxt; int ui = 0;
    if (!S.next(0, cur)) return;
    f32x4 acc[2][2][4][2];
#pragma unroll
    for (int a = 0; a < 2; ++a)
#pragma unroll
        for (int b = 0; b < 2; ++b)
#pragma unroll
            for (int m = 0; m < 4; ++m)
#pragma unroll
                for (int n = 0; n < 2; ++n) acc[a][b][m][n] = (f32x4){0.f, 0.f, 0.f, 0.f};
    bf16x8 At[4][2], B0[2][2], B1[2][2];
    const char* cA = (const char*)g.A + (size_t)cur.pm * tstep; const char* cB = (const char*)g.Bt + (size_t)cur.pn * tstep;
    S.a_ready(cur);
    if constexpr (SP2) {
        PG8_STAGE(PG8_SB(0, 0), cB, voffB); PG8_STAGE(PG8_SB(0, 1), cB + hstep, voffB); PG8_STAGE(PG8_SA(0, 0), cA, voffA); PG8_STAGE(PG8_SA(0, 1), cA + hstep, voffA);
        if (wr == 1) PG8_BAR;
        PG8_WAIT_V(2); PG8_BAR;
        PG8_STAGE(PG8_SB(1, 0), cB + kstep, voffB); PG8_STAGE(PG8_SA(1, 0), cA + kstep, voffA); PG8_STAGE(PG8_SB(1, 1), cB + hstep + kstep, voffB);
        PG8_WAIT_V(6); PG8_BAR;
    } else {
        PG8_STAGE(PG8_SB(0, 0), cB, voffB); PG8_STAGE(PG8_SA(0, 0), cA, voffA); PG8_STAGE(PG8_SB(0, 1), cB + hstep, voffB); PG8_STAGE(PG8_SA(0, 1), cA + hstep, voffA);
        if (wr == 1) PG8_BAR;
        PG8_WAIT_V(4); PG8_BAR;
        PG8_STAGE(PG8_SB(1, 0), cB + kstep, voffB); PG8_STAGE(PG8_SA(1, 0), cA + kstep, voffA); PG8_STAGE(PG8_SB(1, 1), cB + hstep + kstep, voffB);
        PG8_WAIT_V(6); PG8_BAR;
    }
    for (;;) {
        const bool has_next = S.next(ui + 1, nxt);
        const char* nA = has_next ? (const char*)g.A + (size_t)nxt.pm * tstep : cA; const char* nB = has_next ? (const char*)g.Bt + (size_t)nxt.pn * tstep : cB;
        for (int t = 0; t < nt; t += 2) {
            if constexpr (Epi::MIDK > 0) { if (t == Epi::MIDK) E.mid(acc, cur, wr, wc, fr, fq); }
            const bool last = (t == nt - 2);
            const char* a1 = cA + (size_t)(t + 1) * kstep;
            const char* a2 = last ? nA : cA + (size_t)(t + 2) * kstep; const char* b2 = last ? nB : cB + (size_t)(t + 2) * kstep;
            const char* a3 = a2 + kstep; const char* b3 = b2 + kstep;
            if (last && has_next) S.a_ready(nxt);
            if constexpr (SP2) {
            PG8_LDB(B0, 0, 0); PG8_LDB(B1, 0, 1); PG8_SCHED; PG8_LDA(At, 0, 0); PG8_STAGE(PG8_SA(1, 1), a1 + hstep, voffA);
            PG8_WAIT_V(8); PG8_WAIT_L(0); PG8_BAR; PG8_MMA(0, 0, At, B0); PG8_MMA(0, 1, At, B1); PG8_BAR; PG8_SCHED;
            PG8_LDA(At, 0, 1); PG8_STAGE(PG8_SB(0, 0), b2, voffB); PG8_STAGE(PG8_SB(0, 1), b2 + hstep, voffB); PG8_STAGE(PG8_SA(0, 0), a2, voffA);
            PG8_WAIT_V(8); PG8_WAIT_L(0); PG8_BAR; PG8_MMA(1, 0, At, B0); PG8_MMA(1, 1, At, B1); PG8_BAR; PG8_SCHED;
            PG8_LDB(B0, 1, 0); PG8_LDB(B1, 1, 1); PG8_SCHED; PG8_LDA(At, 1, 0); PG8_STAGE(PG8_SA(0, 1), a2 + hstep, voffA);
            PG8_WAIT_V(8); PG8_WAIT_L(0); PG8_BAR; PG8_MMA(0, 0, At, B0); PG8_MMA(0, 1, At, B1); PG8_BAR; PG8_SCHED;
            PG8_LDA(At, 1, 1); PG8_STAGE(PG8_SB(1, 0), b3, voffB); PG8_STAGE(PG8_SB(1, 1), b3 + hstep, voffB); PG8_STAGE(PG8_SA(1, 0), a3, voffA);
            PG8_WAIT_V(8); PG8_WAIT_L(0); PG8_BAR; PG8_MMA(1, 0, At, B0); PG8_MMA(1, 1, At, B1); PG8_BAR; PG8_SCHED;
            } else {
            PG8_LDB(B0, 0, 0); PG8_SCHED; PG8_LDA(At, 0, 0); PG8_STAGE(PG8_SA(1, 1), a1 + hstep, voffA);
            PG8_WAIT_L(8); PG8_BAR; PG8_WAIT_L(0); PG8_MMA(0, 0, At, B0); PG8_BAR; PG8_SCHED;
            PG8_LDB(B1, 0, 1); PG8_STAGE(PG8_SB(0, 0), b2, voffB);
            PG8_BAR; PG8_WAIT_L(0); PG8_MMA(0, 1, At, B1); PG8_BAR;
            PG8_LDA(At, 0, 1); PG8_STAGE(PG8_SA(0, 0), a2, voffA);
            PG8_BAR; PG8_WAIT_L(0); PG8_MMA(1, 0, At, B0); PG8_BAR; PG8_SCHED;
            PG8_STAGE(PG8_SB(0, 1), b2 + hstep, voffB);
            PG8_WAIT_V(6); PG8_BAR; PG8_MMA(1, 1, At, B1); PG8_BAR;
            PG8_LDB(B0, 1, 0); PG8_SCHED; PG8_LDA(At, 1, 0); PG8_STAGE(PG8_SA(0, 1), a2 + hstep, voffA);
            PG8_WAIT_L(8); PG8_BAR; PG8_WAIT_L(0); PG8_MMA(0, 0, At, B0); PG8_BAR; PG8_SCHED;
            PG8_LDB(B1, 1, 1); PG8_STAGE(PG8_SB(1, 0), b3, voffB);
            PG8_BAR; PG8_WAIT_L(0); PG8_MMA(0, 1, At, B1); PG8_BAR;
            PG8_LDA(At, 1, 1); PG8_STAGE(PG8_SA(1, 0), a3, voffA);
            PG8_BAR; PG8_WAIT_L(0); PG8_MMA(1, 0, At, B0); PG8_BAR; PG8_SCHED;
            PG8_STAGE(PG8_SB(1, 1), b3 + hstep, voffB);
            PG8_WAIT_V(6); PG8_BAR; PG8_MMA(1, 1, At, B1); PG8_BAR;
            }
        }
        if constexpr (ALIGN_EPI) { if (wr == 0) PG8_BAR; }
        if constexpr (!Epi::AFTER_DRAIN) { E(acc, cur, wr, wc, fr, fq); S.done(cur); }
        if (!has_next) break;
#pragma unroll
        for (int a = 0; a < 2; ++a)
#pragma unroll
            for (int b = 0; b < 2; ++b)
#pragma unroll
                for (int m = 0; m < 4; ++m)
#pragma unroll
                    for (int n = 0; n < 2; ++n) acc[a][b][m][n] = (f32x4){0.f, 0.f, 0.f, 0.f};
        cur = nxt; cA = nA; cB = nB; ++ui;
        if constexpr (ALIGN_EPI) { if (wr == 1) PG8_BAR; }
    }
    PG8_WAIT_V(0);
    if constexpr (!ALIGN_EPI) { if (wr == 0) PG8_BAR; }
    PG8_BAR;
    if constexpr (Epi::AFTER_DRAIN) { E.fused(acc, cur, wr, wc, fr, fq, lds, wid, lane); S.done(cur); }
#undef PG8_SA
#undef PG8_SB
#undef PG8_STAGE
#undef PG8_LDA
#undef PG8_LDB
#undef PG8_MMA
#undef PG8_WAIT_V
#undef PG8_WAIT_L
#undef PG8_BAR
#undef PG8_SCHED
}
}

#ifndef PG8_SP2
#define PG8_SP2 true
#endif
#ifndef PG8_ALIGN
#define PG8_ALIGN true
#endif
#include <hip/hip_bf16.h>
#include <cmath>
namespace attn_body {
using bf16=__hip_bfloat16;
using bf16x8=__attribute__((ext_vector_type(8)))short;
using s16x4=__attribute__((ext_vector_type(4)))short;
using f32x16=__attribute__((ext_vector_type(16)))float;
using u32x4=__attribute__((ext_vector_type(4)))unsigned;
constexpr int SEQ=2048,D=64,QP=512,KP=512,VP=512,OP=1024;
constexpr int NW=8,QBLK=32,QB=QBLK*NW,KVBLK=64,NQB=SEQ/QB;
constexpr int ATTN_UNIT_ROWS=QB;
__device__ __forceinline__ int crow(int r,int hi){return (r&3)+8*(r>>2)+4*hi;}
#define SBAR() __builtin_amdgcn_sched_barrier(0)
__device__ __forceinline__ void cmask(f32x16&p0,f32x16&p1,int jb,int wchunk,int){
  if(jb>wchunk){ const float NEG=-INFINITY;
    #pragma unroll
    for(int r=0;r<16;++r){p0[r]=NEG;p1[r]=NEG;} }
}

constexpr int NSLOT=3, SLOTB=8192;
constexpr int LDS_K=0, LDS_V=NSLOT*SLOTB, LDS_WS=2*NSLOT*SLOTB, LDS_OST=LDS_WS+NW*64*4, LDS_BYTES=LDS_OST+NW*4096;
constexpr float C2=0.125f*1.4426950408889634f;
__device__ __forceinline__ void glds16(const void*gsrc,unsigned lds_dst){unsigned keep;
  asm volatile("s_mov_b32 %0, m0\n\ts_mov_b32 m0, %2\n\ts_nop 0\n\tglobal_load_lds_dwordx4 %1, off\n\ts_mov_b32 m0, %0":"=&s"(keep):"v"(gsrc),"s"(lds_dst):"memory");}
__device__ __forceinline__ float max3f(float a,float b,float c){float r;asm("v_max3_f32 %0, %1, %2, %3":"=v"(r):"v"(a),"v"(b),"v"(c));return r;}
__device__ __forceinline__ float max2f(float a,float b){float r;asm("v_max_f32_e32 %0, %1, %2":"=v"(r):"v"(a),"v"(b));return r;}
__device__ __forceinline__ float fadd_s(float a,float b){float r;asm("v_add_f32_e32 %0, %1, %2":"=v"(r):"v"(a),"v"(b));return r;}
__device__ __forceinline__ float fsub_s(float a,float b){float r;asm("v_sub_f32_e32 %0, %1, %2":"=v"(r):"v"(a),"v"(b));return r;}
typedef float f32x2_t __attribute__((ext_vector_type(2))); typedef __bf16 bf16x2_t __attribute__((ext_vector_type(2)));
__device__ __forceinline__ unsigned cvtpk_s(float lo,float hi){f32x2_t v={lo,hi};bf16x2_t b=__builtin_convertvector(v,bf16x2_t);return __builtin_bit_cast(unsigned,b);}
#define WAIT_BAR(N) asm volatile("s_waitcnt vmcnt(" #N ") lgkmcnt(0)\n\ts_barrier":::"memory")

__device__ __forceinline__ void qkt(f32x16&p0,f32x16&p1,const char*Kslot,const bf16x8*qr,const f32x16&negm,int r32,int hi){
  const char*kb=Kslot+hi*1024+r32*16;
  #pragma unroll
  for(int d0=0;d0<4;++d0){
    const bf16x8 b0=*reinterpret_cast<const bf16x8*>(kb+d0*2048);
    const bf16x8 b1=*reinterpret_cast<const bf16x8*>(kb+d0*2048+512);
    if(d0==0){p0=__builtin_amdgcn_mfma_f32_32x32x16_bf16(b0,qr[0],negm,0,0,0);p1=__builtin_amdgcn_mfma_f32_32x32x16_bf16(b1,qr[0],negm,0,0,0);}
    else{p0=__builtin_amdgcn_mfma_f32_32x32x16_bf16(b0,qr[d0],p0,0,0,0);p1=__builtin_amdgcn_mfma_f32_32x32x16_bf16(b1,qr[d0],p1,0,0,0);}}
}
typedef __attribute__((address_space(3))) const char* lds_cptr;
typedef short v4i16_t __attribute__((ext_vector_type(4)));
__device__ __forceinline__ void kload8(bf16x8*kf,lds_cptr kp){
  kf[0]=*(const __attribute__((address_space(3))) bf16x8*)(kp);      kf[1]=*(const __attribute__((address_space(3))) bf16x8*)(kp+512);
  kf[2]=*(const __attribute__((address_space(3))) bf16x8*)(kp+2048); kf[3]=*(const __attribute__((address_space(3))) bf16x8*)(kp+2560);
  kf[4]=*(const __attribute__((address_space(3))) bf16x8*)(kp+4096); kf[5]=*(const __attribute__((address_space(3))) bf16x8*)(kp+4608);
  kf[6]=*(const __attribute__((address_space(3))) bf16x8*)(kp+6144); kf[7]=*(const __attribute__((address_space(3))) bf16x8*)(kp+6656);
}
__device__ __forceinline__ void kload2(bf16x8*kf,lds_cptr kp,int j){ kf[2*j]=*(const __attribute__((address_space(3))) bf16x8*)(kp+j*2048); kf[2*j+1]=*(const __attribute__((address_space(3))) bf16x8*)(kp+j*2048+512); }
__device__ __forceinline__ s16x4 vtr(lds_cptr p){ return __builtin_bit_cast(s16x4,__builtin_amdgcn_ds_read_tr16_b64_v4i16((__attribute__((address_space(3))) v4i16_t*)p)); }
__device__ __forceinline__ float rowmax(const f32x16&p0,const f32x16&p1){
  float a=max3f(p0[0],p0[1],p1[0]),b=max3f(p0[2],p0[3],p1[1]);a=max3f(a,p1[2],p1[3]);
  #pragma unroll
  for(int r=4;r<16;r+=4){a=max3f(a,p0[r],p0[r+1]);b=max3f(b,p0[r+2],p0[r+3]);a=max3f(a,p1[r],p1[r+1]);b=max3f(b,p1[r+2],p1[r+3]);}
  const float m=max2f(a,b);
  auto rr=__builtin_amdgcn_permlane32_swap(__float_as_uint(m),__float_as_uint(m),false,false);
  return max2f(__uint_as_float(rr[0]),__uint_as_float(rr[1]));
}
__device__ __forceinline__ void pv(f32x16*o,int vb,bf16x8 pa0,bf16x8 pa1,bf16x8 pa2,bf16x8 pa3){
  #pragma unroll
  for(int d0=0;d0<2;++d0){s16x4 lo[4],hi[4];
    #pragma unroll
    for(int ks=0;ks<4;++ks){
      asm volatile("ds_read_b64_tr_b16 %0,%1 offset:%c2":"=&v"(lo[ks]):"v"(vb),"i"(d0*4096+ks*1024):"memory");
      asm volatile("ds_read_b64_tr_b16 %0,%1 offset:%c2":"=&v"(hi[ks]):"v"(vb),"i"(d0*4096+ks*1024+512):"memory");}
    asm volatile("s_waitcnt lgkmcnt(0)":::"memory");SBAR();
    #define PK(k) (bf16x8){lo[k][0],lo[k][1],lo[k][2],lo[k][3],hi[k][0],hi[k][1],hi[k][2],hi[k][3]}
    o[d0]=__builtin_amdgcn_mfma_f32_32x32x16_bf16(pa0,PK(0),o[d0],0,0,0);
    o[d0]=__builtin_amdgcn_mfma_f32_32x32x16_bf16(pa1,PK(1),o[d0],0,0,0);
    o[d0]=__builtin_amdgcn_mfma_f32_32x32x16_bf16(pa2,PK(2),o[d0],0,0,0);
    o[d0]=__builtin_amdgcn_mfma_f32_32x32x16_bf16(pa3,PK(3),o[d0],0,0,0);
    #undef PK
  }
}

#ifndef ATTN_STORE16
#define ATTN_STORE16(p,v) (*(u32x4*)(p)=(v))
#endif
template<int THRL> __device__ __forceinline__ void attn_unit(int b,int qcol,int kcol,int vcol,int ocol,int qb,const bf16*Q,const bf16*__restrict__ K,const bf16*__restrict__ V,bf16*O,char*shm){
  int tid_=threadIdx.x; asm volatile("":"+v"(tid_));
  const int tid=tid_,lane=tid&63,r32=lane&31,hi=lane>>5; const int wid=__builtin_amdgcn_readfirstlane(tid>>6);
  const long rowbase=(long)b*SEQ; const int q0=qb*QB;
  const bf16*Qw=Q+(rowbase+q0+wid*QBLK)*QP+qcol;
  const bf16*Kh=K+rowbase*KP+kcol,*Vh=V+rowbase*VP+vcol;
  const unsigned lds0=(unsigned)(uintptr_t)shm;
  float*wsf=(float*)(shm+LDS_WS)+wid*64;
  const bf16*ksrc=Kh+(long)lane*KP+wid*8;
  const bf16*vsrc=Vh+(long)(16*(wid&3)+(lane>>2))*VP+(wid>>2)*32+(lane&3)*8;
  const unsigned kdst=lds0+LDS_K+wid*1024, vdst=lds0+LDS_V+wid*1024;
  #define DMA_K(t,slot) glds16(ksrc+(long)(t)*KVBLK*KP,(unsigned)__builtin_amdgcn_readfirstlane(kdst+(slot)))
  #define DMA_V(t,slot) glds16(vsrc+(long)(t)*KVBLK*VP,(unsigned)__builtin_amdgcn_readfirstlane(vdst+(slot)))
  const int vb0=(int)(lds0+LDS_V)+((lane>>4)&1)*32+(lane&3)*8+(4*hi+((lane&15)>>2))*64;
  const char*Kbase=shm+LDS_K; bf16x8 kf[8];
  const lds_cptr shm3=(lds_cptr)shm; const lds_cptr kp0=shm3+LDS_K+hi*1024+r32*16; const lds_cptr vp0=shm3+LDS_V+((lane>>4)&1)*32+(lane&3)*8+(4*hi+((lane&15)>>2))*64;
  const int NT=(q0+QB)/KVBLK;
  DMA_K(0,0);DMA_V(0,0);DMA_K(1,SLOTB);
  bf16x8 qr[4];
  #pragma unroll
  for(int d0=0;d0<4;++d0)qr[d0]=*reinterpret_cast<const bf16x8*>(&Qw[(long)r32*QP+d0*16+hi*8]);
  float mhat=0.f,l_reg=0.f;f32x16 o[2];o[0]=f32x16{};o[1]=f32x16{};f32x16 negm=f32x16{};asm volatile("":"+v"(negm));
  const int qrel=wid>>1;
  #define CMASK(P0,P1,t) do{int jb_=(t)-(NT-4); if(jb_>=0)cmask(P0,P1,jb_,qrel,hi);}while(0)
  bool resc=false;
  #define START(P0,P1) do{ const float rm=rowmax(P0,P1); resc=false; \
    { const float dl=rm; mhat=fadd_s(mhat,dl); \
      _Pragma("unroll") for(int r=0;r<16;++r){P0[r]=fsub_s(P0[r],dl);P1[r]=fsub_s(P1[r],dl);} \
      _Pragma("unroll") for(int r=0;r<16;++r)negm[r]=-mhat; asm volatile("":"+v"(negm)); } \
    _Pragma("unroll") for(int r=0;r<16;++r)P0[r]=__builtin_amdgcn_exp2f(P0[r]); }while(0)
  #define RESC() do{ if(resc){ asm volatile("s_waitcnt lgkmcnt(0)":::"memory"); \
      _Pragma("unroll") for(int d_=0;d_<2;++d_) _Pragma("unroll") for(int r=0;r<16;++r)o[d_][r]*=wsf[crow(r,hi)]; } }while(0)
  f32x16 pA0,pA1,pB0,pB1;
  int sl_prev=0,sl_cur=0,sl_next=SLOTB;
  #define ROT() do{sl_prev=sl_cur;sl_cur=sl_next;sl_next=(sl_next==(NSLOT-1)*SLOTB)?0:sl_next+SLOTB;}while(0)
  DMA_K(2,2*SLOTB);
  WAIT_BAR(3);
  qkt(pA0,pA1,Kbase,qr,negm,r32,hi);asm volatile("s_nop 15\n\ts_nop 7":"+v"(pA0),"+v"(pA1));CMASK(pA0,pA1,0);
  START(pA0,pA1);
  _Pragma("unroll") for(int r=0;r<16;++r)pA1[r]=__builtin_amdgcn_exp2f(pA1[r]);
  WAIT_BAR(0);
  DMA_K(3,0);DMA_V(1,SLOTB);
  ROT();
  kload8(kf,kp0+sl_cur);
  WAIT_BAR(2);
  s16x4 vlo[8],vhi[8]; u32x4 pw0,pw1,pw2,pw3;
  #define PKW(P,B) cvtpk_s(P[B],P[B+1])
  #define PAF(k) __builtin_bit_cast(bf16x8,pw##k)
  #define VFR(i) (bf16x8){vlo[i][0],vlo[i][1],vlo[i][2],vlo[i][3],vhi[i][0],vhi[i][1],vhi[i][2],vhi[i][3]}
  #define PIN(x) asm volatile("":"+v"(x))
  #define MX3(a,b,c) __builtin_fmaxf(__builtin_fmaxf((a),(b)),(c))
  #define GAPA(MF,A0,A1,A2,A3,W0,W1,PW) do{ MF; sacc+=A0; sacc+=A1; sacc+=A2; sacc+=A3; PIN(sacc); W0; W1; PIN(PW); SBAR(); }while(0)
  #define EX(v) __builtin_amdgcn_exp2f(v)
  #define GAPB(MF,X,B) do{ MF; X[B]=EX(X[B]); X[B+1]=EX(X[B+1]); X[B+2]=EX(X[B+2]); X[B+3]=EX(X[B+3]); PIN(X); SBAR(); }while(0)
  #define VRD(i) do{ vlo[i]=vtr(vp_+(((i)>>2)*4096+((i)&3)*1024)); vhi[i]=vtr(vp_+(((i)>>2)*4096+((i)&3)*1024+512)); }while(0)
  #define KRD(G,j) do{ if(G){ kload2(kf,kp0+sl_next,j); SBAR(); } }while(0)
  #define STEP(C0,C1,P0,P1,t,GK,GV,GL) do{ SBAR(); \
    const lds_cptr vp_=vp0+sl_prev; \
    VRD(0); SBAR(); float sacc=(P0[0]+P0[1]); \
    GAPA(C0=__builtin_amdgcn_mfma_f32_32x32x16_bf16(kf[0],qr[0],negm,0,0,0), P0[2],P0[3],P0[4],P0[5],     pw0[0]=PKW(P0,0), pw0[1]=PKW(P0,2), pw0); \
    VRD(4); SBAR(); GAPA(C1=__builtin_amdgcn_mfma_f32_32x32x16_bf16(kf[1],qr[0],negm,0,0,0), P0[6],P0[7],P0[8],P0[9],     pw0[2]=PKW(P0,4), pw0[3]=PKW(P0,6), pw0); \
    VRD(1); SBAR(); GAPA(C0=__builtin_amdgcn_mfma_f32_32x32x16_bf16(kf[2],qr[1],C0,0,0,0),   P0[10],P0[11],P0[12],P0[13], pw1[0]=PKW(P0,8), pw1[1]=PKW(P0,10), pw1); \
    VRD(5); SBAR(); GAPA(C1=__builtin_amdgcn_mfma_f32_32x32x16_bf16(kf[3],qr[1],C1,0,0,0),   P0[14],P0[15],P1[0],P1[1],   pw1[2]=PKW(P0,12),pw1[3]=PKW(P0,14), pw1); \
    VRD(2); SBAR(); GAPA(C0=__builtin_amdgcn_mfma_f32_32x32x16_bf16(kf[4],qr[2],C0,0,0,0),   P1[2],P1[3],P1[4],P1[5],     pw2[0]=PKW(P1,0), pw2[1]=PKW(P1,2), pw2); \
    VRD(6); SBAR(); GAPA(C1=__builtin_amdgcn_mfma_f32_32x32x16_bf16(kf[5],qr[2],C1,0,0,0),   P1[6],P1[7],P1[8],P1[9],     pw2[2]=PKW(P1,4), pw2[3]=PKW(P1,6), pw2); \
    VRD(3); SBAR(); GAPA(C0=__builtin_amdgcn_mfma_f32_32x32x16_bf16(kf[6],qr[3],C0,0,0,0),   P1[10],P1[11],P1[12],P1[13], pw3[0]=PKW(P1,8), pw3[1]=PKW(P1,10), pw3); \
    VRD(7); SBAR(); GAPA(C1=__builtin_amdgcn_mfma_f32_32x32x16_bf16(kf[7],qr[3],C1,0,0,0),   P1[14],P1[15],0.f,0.f,       pw3[2]=PKW(P1,12),pw3[3]=PKW(P1,14), pw3); \
    l_reg+=sacc; \
    if(GK){DMA_K((t)+3,sl_cur);} if(GV){DMA_V((t)+1,sl_next);} \
    CMASK(C0,C1,t); \
    { float a=MX3(C0[0],C0[1],C1[0]),b=MX3(C0[2],C0[3],C1[1]); a=MX3(a,C1[2],C1[3]); \
      _Pragma("unroll") for(int r=4;r<16;r+=4){a=MX3(a,C0[r],C0[r+1]);b=MX3(b,C0[r+2],C0[r+3]);a=MX3(a,C1[r],C1[r+1]);b=MX3(b,C1[r+2],C1[r+3]);} \
      float rm=__builtin_fmaxf(a,b); { auto rr=__builtin_amdgcn_permlane32_swap(__float_as_uint(rm),__float_as_uint(rm),false,false); rm=__builtin_fmaxf(__uint_as_float(rr[0]),__uint_as_float(rr[1])); } \
      resc=false; \
      if(__builtin_expect(__any(rm>(float)THRL),0)){ const float dl=__builtin_fmaxf(rm,0.f); mhat+=dl; \
        _Pragma("unroll") for(int r=0;r<16;++r){C0[r]-=dl;C1[r]-=dl;} \
        _Pragma("unroll") for(int r=0;r<16;++r)negm[r]=-mhat; asm volatile("":"+v"(negm)); \
        const float f=__builtin_amdgcn_exp2f(-dl); l_reg*=f; if(hi==0)wsf[r32]=f; resc=true; } } \
    SBAR(); \
    GAPB(o[0]=__builtin_amdgcn_mfma_f32_32x32x16_bf16(PAF(0),VFR(0),o[0],0,0,0), C0,0); \
    GAPB(o[1]=__builtin_amdgcn_mfma_f32_32x32x16_bf16(PAF(0),VFR(4),o[1],0,0,0), C0,4); \
    KRD(GL,0); GAPB(o[0]=__builtin_amdgcn_mfma_f32_32x32x16_bf16(PAF(1),VFR(1),o[0],0,0,0), C0,8); \
    KRD(GL,1); GAPB(o[1]=__builtin_amdgcn_mfma_f32_32x32x16_bf16(PAF(1),VFR(5),o[1],0,0,0), C0,12); \
    KRD(GL,2); GAPB(o[0]=__builtin_amdgcn_mfma_f32_32x32x16_bf16(PAF(2),VFR(2),o[0],0,0,0), C1,0); \
    KRD(GL,3); GAPB(o[1]=__builtin_amdgcn_mfma_f32_32x32x16_bf16(PAF(2),VFR(6),o[1],0,0,0), C1,4); \
    GAPB(o[0]=__builtin_amdgcn_mfma_f32_32x32x16_bf16(PAF(3),VFR(3),o[0],0,0,0), C1,8); \
    GAPB(o[1]=__builtin_amdgcn_mfma_f32_32x32x16_bf16(PAF(3),VFR(7),o[1],0,0,0), C1,12); \
    }while(0)
  int t=1;
  #undef CMASK
  #define CMASK(P0,P1,t) do{}while(0)
  for(;t+5<NT;t+=2){
    STEP(pB0,pB1,pA0,pA1,t,true,true,true);     WAIT_BAR(2); RESC(); ROT();
    STEP(pA0,pA1,pB0,pB1,t+1,true,true,true);   WAIT_BAR(2); RESC(); ROT();
  }
  #undef CMASK
  #define CMASK(P0,P1,t) do{int jb_=(t)-(NT-4); if(jb_>=0)cmask(P0,P1,jb_,qrel,hi);}while(0)
  #define ENDW(tt) do{ if((tt)+3<NT){WAIT_BAR(2);} else if((tt)+2<NT){WAIT_BAR(1);} else {WAIT_BAR(0);} }while(0)
  for(;t+1<NT;t+=2){
    STEP(pB0,pB1,pA0,pA1,t,(t+3<NT),(t+1<NT),(t+1<NT));       ENDW(t);   RESC(); ROT();
    STEP(pA0,pA1,pB0,pB1,t+1,(t+4<NT),(t+2<NT),(t+2<NT));     ENDW(t+1); RESC(); ROT();
  }
  STEP(pB0,pB1,pA0,pA1,NT-1,false,false,false); RESC();
  { float sacc=pB0[0]+pB0[1]; _Pragma("unroll") for(int r=2;r<16;++r)sacc+=pB0[r]; _Pragma("unroll") for(int r=0;r<16;++r)sacc+=pB1[r]; l_reg+=sacc;
    pw0=(u32x4){PKW(pB0,0),PKW(pB0,2),PKW(pB0,4),PKW(pB0,6)};pw1=(u32x4){PKW(pB0,8),PKW(pB0,10),PKW(pB0,12),PKW(pB0,14)};pw2=(u32x4){PKW(pB1,0),PKW(pB1,2),PKW(pB1,4),PKW(pB1,6)};pw3=(u32x4){PKW(pB1,8),PKW(pB1,10),PKW(pB1,12),PKW(pB1,14)};
    SBAR(); pv(o,vb0+sl_cur,PAF(0),PAF(1),PAF(2),PAF(3)); }
  #undef PKW
  #undef PAF
  #undef VFR
  #undef PIN
  #undef MX3
  #undef GAPA
  #undef GAPB
  #undef EX
  #undef VRD
  #undef KRD
  #undef STEP
  #undef ENDW
  {auto rr=__builtin_amdgcn_permlane32_swap(__float_as_uint(l_reg),__float_as_uint(l_reg),false,false);l_reg=__uint_as_float(rr[0])+__uint_as_float(rr[1]);}
  if(hi==0)wsf[32+r32]=l_reg;asm volatile("s_waitcnt lgkmcnt(0)":::"memory");
  float rli[16];
  #pragma unroll
  for(int r=0;r<16;++r)rli[r]=__builtin_amdgcn_rcpf(wsf[32+crow(r,hi)]);
  bf16*Ow=O+(rowbase+q0+wid*QBLK)*OP+ocol;
  { bf16*stg=(bf16*)(shm+LDS_OST)+wid*2048;
    #pragma unroll
    for(int r=0;r<16;++r){const int orow=crow(r,hi);
      #pragma unroll
      for(int d0=0;d0<2;++d0)stg[orow*64+d0*32+r32]=__float2bfloat16(o[d0][r]*rli[r]);}
    asm volatile("s_waitcnt lgkmcnt(0)":::"memory");
    #pragma unroll
    for(int i=0;i<4;++i){const int row=i*8+(lane>>3),ch=lane&7; const u32x4 v=*(const u32x4*)(stg+row*64+ch*8); ATTN_STORE16(Ow+(long)row*OP+ch*8,v);} }
  asm volatile("s_waitcnt lgkmcnt(0)\n\ts_barrier":::"memory");
  #undef DMA_K
  #undef DMA_V
  #undef CMASK
  #undef START
  #undef RESC
  #undef ROT
}
constexpr int LDS2_V=NSLOT*SLOTB, LDS2_WS=LDS2_V+NSLOT*2*SLOTB, LDS2_OST=LDS2_WS+NW*64*4, LDS2_BYTES=LDS2_OST+NW*8192;
#ifndef ATTN_STORE16
#define ATTN_STORE16(p,v) (*(u32x4*)(p)=(v))
#endif
template<int THRL> __device__ __forceinline__ void attn_unit128(int b,int qcol,int kcol,int vcol,int ocol,int qb,const bf16*Q,const bf16*__restrict__ K,const bf16*__restrict__ V,bf16*O,char*shm){
  int tid_=threadIdx.x; asm volatile("":"+v"(tid_));
  const int tid=tid_,lane=tid&63,r32=lane&31,hi=lane>>5; const int wid=__builtin_amdgcn_readfirstlane(tid>>6);
  const long rowbase=(long)b*SEQ; const int q0=qb*QB;
  const bf16*Qw=Q+(rowbase+q0+wid*QBLK)*QP+qcol;
  const bf16*Kh=K+rowbase*KP+kcol,*Vh=V+rowbase*VP+vcol;
  const unsigned lds0=(unsigned)(uintptr_t)shm;
  float*wsf=(float*)(shm+LDS2_WS)+wid*64;
  const bf16*ksrc=Kh+(long)lane*KP+wid*8;
  const bf16*vsrc=Vh+(long)(16*(wid&3)+(lane>>2))*VP+(wid>>2)*32+(lane&3)*8;
  const unsigned kdst=lds0+LDS_K+wid*1024, vdst=lds0+LDS2_V+wid*1024;
  #define DMA_K(t,slot) glds16(ksrc+(long)(t)*KVBLK*KP,(unsigned)__builtin_amdgcn_readfirstlane(kdst+(slot)))
  #define DMA_V(t,slot) do{ glds16(vsrc+(long)(t)*KVBLK*VP,(unsigned)__builtin_amdgcn_readfirstlane(vdst+2*(slot))); glds16(vsrc+(long)(t)*KVBLK*VP+64,(unsigned)__builtin_amdgcn_readfirstlane(vdst+2*(slot)+8192)); }while(0)
  const int vb0=(int)(lds0+LDS2_V)+((lane>>4)&1)*32+(lane&3)*8+(4*hi+((lane&15)>>2))*64;
  const char*Kbase=shm+LDS_K; bf16x8 kf[8];
  const lds_cptr shm3=(lds_cptr)shm; const lds_cptr kp0=shm3+LDS_K+hi*1024+r32*16; const lds_cptr vp0=shm3+LDS2_V+((lane>>4)&1)*32+(lane&3)*8+(4*hi+((lane&15)>>2))*64;
  const int NT=(q0+QB)/KVBLK;
  DMA_K(0,0);DMA_V(0,0);DMA_K(1,SLOTB);
  bf16x8 qr[4];
  #pragma unroll
  for(int d0=0;d0<4;++d0)qr[d0]=*reinterpret_cast<const bf16x8*>(&Qw[(long)r32*QP+d0*16+hi*8]);
  float mhat=0.f,l_reg=0.f;f32x16 o[4];o[0]=f32x16{};o[1]=f32x16{};o[2]=f32x16{};o[3]=f32x16{};f32x16 negm=f32x16{};asm volatile("":"+v"(negm));
  const int qrel=wid>>1;
  #define CMASK(P0,P1,t) do{int jb_=(t)-(NT-4); if(jb_>=0)cmask(P0,P1,jb_,qrel,hi);}while(0)
  bool resc=false;
  #define START(P0,P1) do{ const float rm=rowmax(P0,P1); resc=false; \
    { const float dl=rm; mhat=fadd_s(mhat,dl); \
      _Pragma("unroll") for(int r=0;r<16;++r){P0[r]=fsub_s(P0[r],dl);P1[r]=fsub_s(P1[r],dl);} \
      _Pragma("unroll") for(int r=0;r<16;++r)negm[r]=-mhat; asm volatile("":"+v"(negm)); } \
    _Pragma("unroll") for(int r=0;r<16;++r)P0[r]=__builtin_amdgcn_exp2f(P0[r]); }while(0)
  #define RESC() do{ if(resc){ asm volatile("s_waitcnt lgkmcnt(0)":::"memory"); \
      _Pragma("unroll") for(int d_=0;d_<4;++d_) _Pragma("unroll") for(int r=0;r<16;++r)o[d_][r]*=wsf[crow(r,hi)]; } }while(0)
  f32x16 pA0,pA1,pB0,pB1;
  int sl_prev=0,sl_cur=0,sl_next=SLOTB;
  #define ROT() do{sl_prev=sl_cur;sl_cur=sl_next;sl_next=(sl_next==(NSLOT-1)*SLOTB)?0:sl_next+SLOTB;}while(0)
  DMA_K(2,2*SLOTB);
  WAIT_BAR(4);
  qkt(pA0,pA1,Kbase,qr,negm,r32,hi);asm volatile("s_nop 15\n\ts_nop 7":"+v"(pA0),"+v"(pA1));CMASK(pA0,pA1,0);
  START(pA0,pA1);
  _Pragma("unroll") for(int r=0;r<16;++r)pA1[r]=__builtin_amdgcn_exp2f(pA1[r]);
  WAIT_BAR(0);
  DMA_K(3,0);DMA_V(1,SLOTB);
  ROT();
  kload8(kf,kp0+sl_cur);
  WAIT_BAR(3);
  s16x4 vlo[4],vhi[4]; u32x4 pw0,pw1,pw2,pw3;
  #define PKW(P,B) cvtpk_s(P[B],P[B+1])
  #define PAF(k) __builtin_bit_cast(bf16x8,pw##k)
  #define VFR(i) (bf16x8){vlo[i][0],vlo[i][1],vlo[i][2],vlo[i][3],vhi[i][0],vhi[i][1],vhi[i][2],vhi[i][3]}
  #define PIN(x) asm volatile("":"+v"(x))
  #define MX3(a,b,c) __builtin_fmaxf(__builtin_fmaxf((a),(b)),(c))
  #define GAPA(MF,A0,A1,A2,A3,W0,W1,PW) do{ MF; sacc+=A0; sacc+=A1; sacc+=A2; sacc+=A3; PIN(sacc); W0; W1; PIN(PW); SBAR(); }while(0)
  #define EX(v) __builtin_amdgcn_exp2f(v)
  #define GAPB(MF,X,B) do{ MF; X[B]=EX(X[B]); X[B+1]=EX(X[B+1]); PIN(X); SBAR(); }while(0)
  #define VRD(j,d,k) do{ vlo[(j)&3]=vtr(vp_+((d)*4096+(k)*1024)); vhi[(j)&3]=vtr(vp_+((d)*4096+(k)*1024+512)); }while(0)
  #define KRD(G,j) do{ if(G){ kload2(kf,kp0+sl_next,j); SBAR(); } }while(0)
  #define STEP(C0,C1,P0,P1,t,GK,GV,GL) do{ SBAR(); \
    const lds_cptr vp_=vp0+2*sl_prev; \
    float sacc=(P0[0]+P0[1]); \
    GAPA(C0=__builtin_amdgcn_mfma_f32_32x32x16_bf16(kf[0],qr[0],negm,0,0,0), P0[2],P0[3],P0[4],P0[5],     pw0[0]=PKW(P0,0), pw0[1]=PKW(P0,2), pw0); \
    GAPA(C1=__builtin_amdgcn_mfma_f32_32x32x16_bf16(kf[1],qr[0],negm,0,0,0), P0[6],P0[7],P0[8],P0[9],     pw0[2]=PKW(P0,4), pw0[3]=PKW(P0,6), pw0); \
    GAPA(C0=__builtin_amdgcn_mfma_f32_32x32x16_bf16(kf[2],qr[1],C0,0,0,0),   P0[10],P0[11],P0[12],P0[13], pw1[0]=PKW(P0,8), pw1[1]=PKW(P0,10), pw1); \
    GAPA(C1=__builtin_amdgcn_mfma_f32_32x32x16_bf16(kf[3],qr[1],C1,0,0,0),   P0[14],P0[15],P1[0],P1[1],   pw1[2]=PKW(P0,12),pw1[3]=PKW(P0,14), pw1); \
    VRD(0,0,0); SBAR(); GAPA(C0=__builtin_amdgcn_mfma_f32_32x32x16_bf16(kf[4],qr[2],C0,0,0,0),   P1[2],P1[3],P1[4],P1[5],     pw2[0]=PKW(P1,0), pw2[1]=PKW(P1,2), pw2); \
    VRD(1,1,0); SBAR(); GAPA(C1=__builtin_amdgcn_mfma_f32_32x32x16_bf16(kf[5],qr[2],C1,0,0,0),   P1[6],P1[7],P1[8],P1[9],     pw2[2]=PKW(P1,4), pw2[3]=PKW(P1,6), pw2); \
    VRD(2,0,1); SBAR(); GAPA(C0=__builtin_amdgcn_mfma_f32_32x32x16_bf16(kf[6],qr[3],C0,0,0,0),   P1[10],P1[11],P1[12],P1[13], pw3[0]=PKW(P1,8), pw3[1]=PKW(P1,10), pw3); \
    VRD(3,1,1); SBAR(); GAPA(C1=__builtin_amdgcn_mfma_f32_32x32x16_bf16(kf[7],qr[3],C1,0,0,0),   P1[14],P1[15],0.f,0.f,       pw3[2]=PKW(P1,12),pw3[3]=PKW(P1,14), pw3); \
    l_reg+=sacc; \
    if(GK){DMA_K((t)+3,sl_cur);} if(GV){DMA_V((t)+1,sl_next);} \
    CMASK(C0,C1,t); \
    { float a=MX3(C0[0],C0[1],C1[0]),b=MX3(C0[2],C0[3],C1[1]); a=MX3(a,C1[2],C1[3]); \
      _Pragma("unroll") for(int r=4;r<16;r+=4){a=MX3(a,C0[r],C0[r+1]);b=MX3(b,C0[r+2],C0[r+3]);a=MX3(a,C1[r],C1[r+1]);b=MX3(b,C1[r+2],C1[r+3]);} \
      float rm=__builtin_fmaxf(a,b); { auto rr=__builtin_amdgcn_permlane32_swap(__float_as_uint(rm),__float_as_uint(rm),false,false); rm=__builtin_fmaxf(__uint_as_float(rr[0]),__uint_as_float(rr[1])); } \
      resc=false; \
      if(__builtin_expect(__any(rm>(float)THRL),0)){ const float dl=__builtin_fmaxf(rm,0.f); mhat+=dl; \
        _Pragma("unroll") for(int r=0;r<16;++r){C0[r]-=dl;C1[r]-=dl;} \
        _Pragma("unroll") for(int r=0;r<16;++r)negm[r]=-mhat; asm volatile("":"+v"(negm)); \
        const float f=__builtin_amdgcn_exp2f(-dl); l_reg*=f; if(hi==0)wsf[r32]=f; resc=true; } } \
    SBAR(); \
    GAPB(o[0]=__builtin_amdgcn_mfma_f32_32x32x16_bf16(PAF(0),VFR(0),o[0],0,0,0), C0,0); \
    VRD(4,0,2); SBAR(); GAPB(o[1]=__builtin_amdgcn_mfma_f32_32x32x16_bf16(PAF(0),VFR(1),o[1],0,0,0), C0,2); \
    VRD(5,1,2); SBAR(); KRD(GL,0); GAPB(o[0]=__builtin_amdgcn_mfma_f32_32x32x16_bf16(PAF(1),VFR(2),o[0],0,0,0), C0,4); \
    VRD(6,0,3); SBAR(); KRD(GL,1); GAPB(o[1]=__builtin_amdgcn_mfma_f32_32x32x16_bf16(PAF(1),VFR(3),o[1],0,0,0), C0,6); \
    VRD(7,1,3); SBAR(); KRD(GL,2); GAPB(o[0]=__builtin_amdgcn_mfma_f32_32x32x16_bf16(PAF(2),VFR(0),o[0],0,0,0), C0,8); \
    VRD(8,2,0); SBAR(); KRD(GL,3); GAPB(o[1]=__builtin_amdgcn_mfma_f32_32x32x16_bf16(PAF(2),VFR(1),o[1],0,0,0), C0,10); \
    VRD(9,3,0); SBAR(); GAPB(o[0]=__builtin_amdgcn_mfma_f32_32x32x16_bf16(PAF(3),VFR(2),o[0],0,0,0), C0,12); \
    VRD(10,2,1); SBAR(); GAPB(o[1]=__builtin_amdgcn_mfma_f32_32x32x16_bf16(PAF(3),VFR(3),o[1],0,0,0), C0,14); \
    VRD(11,3,1); SBAR(); GAPB(o[2]=__builtin_amdgcn_mfma_f32_32x32x16_bf16(PAF(0),VFR(0),o[2],0,0,0), C1,0); \
    VRD(12,2,2); SBAR(); GAPB(o[3]=__builtin_amdgcn_mfma_f32_32x32x16_bf16(PAF(0),VFR(1),o[3],0,0,0), C1,2); \
    VRD(13,3,2); SBAR(); GAPB(o[2]=__builtin_amdgcn_mfma_f32_32x32x16_bf16(PAF(1),VFR(2),o[2],0,0,0), C1,4); \
    VRD(14,2,3); SBAR(); GAPB(o[3]=__builtin_amdgcn_mfma_f32_32x32x16_bf16(PAF(1),VFR(3),o[3],0,0,0), C1,6); \
    VRD(15,3,3); SBAR(); GAPB(o[2]=__builtin_amdgcn_mfma_f32_32x32x16_bf16(PAF(2),VFR(0),o[2],0,0,0), C1,8); \
    GAPB(o[3]=__builtin_amdgcn_mfma_f32_32x32x16_bf16(PAF(2),VFR(1),o[3],0,0,0), C1,10); \
    GAPB(o[2]=__builtin_amdgcn_mfma_f32_32x32x16_bf16(PAF(3),VFR(2),o[2],0,0,0), C1,12); \
    GAPB(o[3]=__builtin_amdgcn_mfma_f32_32x32x16_bf16(PAF(3),VFR(3),o[3],0,0,0), C1,14); \
    }while(0)
  int t=1;
  #undef CMASK
  #define CMASK(P0,P1,t) do{}while(0)
  for(;t+5<NT;t+=2){
    STEP(pB0,pB1,pA0,pA1,t,true,true,true);     WAIT_BAR(3); RESC(); ROT();
    STEP(pA0,pA1,pB0,pB1,t+1,true,true,true);   WAIT_BAR(3); RESC(); ROT();
  }
  #undef CMASK
  #define CMASK(P0,P1,t) do{int jb_=(t)-(NT-4); if(jb_>=0)cmask(P0,P1,jb_,qrel,hi);}while(0)
  #define ENDW(tt) do{ if((tt)+3<NT){WAIT_BAR(3);} else if((tt)+2<NT){WAIT_BAR(2);} else {WAIT_BAR(0);} }while(0)
  for(;t+1<NT;t+=2){
    STEP(pB0,pB1,pA0,pA1,t,(t+3<NT),(t+1<NT),(t+1<NT));       ENDW(t);   RESC(); ROT();
    STEP(pA0,pA1,pB0,pB1,t+1,(t+4<NT),(t+2<NT),(t+2<NT));     ENDW(t+1); RESC(); ROT();
  }
  STEP(pB0,pB1,pA0,pA1,NT-1,false,false,false); RESC();
  { float sacc=pB0[0]+pB0[1]; _Pragma("unroll") for(int r=2;r<16;++r)sacc+=pB0[r]; _Pragma("unroll") for(int r=0;r<16;++r)sacc+=pB1[r]; l_reg+=sacc;
    pw0=(u32x4){PKW(pB0,0),PKW(pB0,2),PKW(pB0,4),PKW(pB0,6)};pw1=(u32x4){PKW(pB0,8),PKW(pB0,10),PKW(pB0,12),PKW(pB0,14)};pw2=(u32x4){PKW(pB1,0),PKW(pB1,2),PKW(pB1,4),PKW(pB1,6)};pw3=(u32x4){PKW(pB1,8),PKW(pB1,10),PKW(pB1,12),PKW(pB1,14)};
    SBAR(); pv(o,vb0+2*sl_cur,PAF(0),PAF(1),PAF(2),PAF(3)); pv(o+2,vb0+2*sl_cur+8192,PAF(0),PAF(1),PAF(2),PAF(3)); }
  #undef PKW
  #undef PAF
  #undef VFR
  #undef PIN
  #undef MX3
  #undef GAPA
  #undef GAPB
  #undef EX
  #undef VRD
  #undef KRD
  #undef STEP
  #undef ENDW
  {auto rr=__builtin_amdgcn_permlane32_swap(__float_as_uint(l_reg),__float_as_uint(l_reg),false,false);l_reg=__uint_as_float(rr[0])+__uint_as_float(rr[1]);}
  if(hi==0)wsf[32+r32]=l_reg;asm volatile("s_waitcnt lgkmcnt(0)":::"memory");
  float rli[16];
  #pragma unroll
  for(int r=0;r<16;++r)rli[r]=__builtin_amdgcn_rcpf(wsf[32+crow(r,hi)]);
  bf16*Ow=O+(rowbase+q0+wid*QBLK)*OP+ocol;
  { bf16*stg=(bf16*)(shm+LDS2_OST)+wid*4096;
    #pragma unroll
    for(int r=0;r<16;++r){const int orow=crow(r,hi);
      #pragma unroll
      for(int d0=0;d0<4;++d0)stg[orow*128+d0*32+r32]=__float2bfloat16(o[d0][r]*rli[r]);}
    asm volatile("s_waitcnt lgkmcnt(0)":::"memory");
    #pragma unroll
    for(int i=0;i<8;++i){const int row=i*4+(lane>>4),ch=lane&15; const u32x4 v=*(const u32x4*)(stg+row*128+ch*8); ATTN_STORE16(Ow+(long)row*OP+ch*8,v);} }
  asm volatile("s_waitcnt lgkmcnt(0)\n\ts_barrier":::"memory");
  #undef DMA_K
  #undef DMA_V
  #undef CMASK
  #undef START
  #undef RESC
  #undef ROT
}
constexpr int ATTN_LDS_BYTES=LDS_BYTES;
struct AttnTensors { const bf16* Q; const bf16* K; const bf16* V; bf16* O; };
struct AttnUnit { int bvh; int qb; };
struct StaticOrder {
  int ai,nA;
  __device__ __forceinline__ StaticOrder(int ai_,int nA_):ai(ai_),nA(nA_){}
  __device__ __forceinline__ bool next(int i,AttnUnit&u)const{
    if(nA==128){ if(i>=8)return false; u.bvh=ai; u.qb=7-i; return true; }
    if(i>=4)return false; const int s=ai&1; u.bvh=ai>>1; u.qb=(i==0)?7-s:(i==1)?4+s:(i==2)?3-s:s; return true; }
  __device__ __forceinline__ void a_ready(const AttnUnit&)const{}
  __device__ __forceinline__ void done(const AttnUnit&)const{}
};
template<class Sched,int THRL=8> __device__ __forceinline__ void attn_phase(char*lds,const AttnTensors&T,const Sched&S){
  AttnUnit u;
  for(int i=0;S.next(i,u);++i){ S.a_ready(u); const int b=u.bvh>>4,vh=u.bvh&15,s=vh>>1,half=vh&1;
    attn_unit<THRL>(b,s*64,s*64,(s>>1)*128+half*64,s*128+half*64,u.qb,T.Q,T.K,T.V,T.O,lds); S.done(u); }
}
template<int THRL=8> __device__ __forceinline__ void attn_phase_queue(char*lds,const AttnTensors&T,unsigned*counter,volatile __attribute__((address_space(3))) unsigned*slot){
  for(;;){
    if(threadIdx.x==0)*slot=__hip_atomic_fetch_add(counter,1u,__ATOMIC_RELAXED,__HIP_MEMORY_SCOPE_AGENT);
    __syncthreads();
    const unsigned u=__builtin_amdgcn_readfirstlane(*slot);
    __syncthreads();
    if(u>=1024u)break;
    const int qb=7-(int)(u>>7),bvh=(int)(u&127u),b=bvh>>4,vh=bvh&15,s=vh>>1,half=vh&1;
    attn_unit<THRL>(b,s*64,s*64,(s>>1)*128+half*64,s*128+half*64,qb,T.Q,T.K,T.V,T.O,lds);
  }
}
template<int THRL=8> __device__ __forceinline__ void attn_phase_queue128(char*lds,const AttnTensors&T,unsigned*counter,volatile __attribute__((address_space(3))) unsigned*slot){
  for(;;){
    if(threadIdx.x==0)*slot=__hip_atomic_fetch_add(counter,1u,__ATOMIC_RELAXED,__HIP_MEMORY_SCOPE_AGENT);
    __syncthreads();
    const unsigned u=__builtin_amdgcn_readfirstlane(*slot);
    __syncthreads();
    if(u>=512u)break;
    const int qb=7-(int)(u>>6),bs=(int)(u&63u),b=bs>>3,s=bs&7;
    attn_unit128<THRL>(b,s*64,s*64,(s>>1)*128,s*128,qb,T.Q,T.K,T.V,T.O,lds);
  }
}
#undef SBAR
#undef WAIT_BAR
}
#include <hip/hip_cooperative_groups.h>
typedef unsigned short bf16;
#define GAS __attribute__((address_space(1)))
#define LAS __attribute__((address_space(3)))
typedef unsigned v4u __attribute__((ext_vector_type(4)));
typedef unsigned v2u __attribute__((ext_vector_type(2)));
typedef float f32x4 __attribute__((ext_vector_type(4)));
#define LDS_WAIT() asm volatile("s_waitcnt lgkmcnt(0)" ::: "memory")
__device__ __forceinline__ unsigned f2bf(float f) { unsigned u = __builtin_bit_cast(unsigned, f); return (u + 0x7fffu + ((u >> 16) & 1u)) >> 16; }
__device__ __forceinline__ unsigned pk2(float lo, float hi) { return f2bf(lo) | (f2bf(hi) << 16); }
__device__ __forceinline__ float bflo(unsigned w) { return __builtin_bit_cast(float, w << 16); }
__device__ __forceinline__ float bfhi(unsigned w) { return __builtin_bit_cast(float, w & 0xffff0000u); }
__device__ __forceinline__ float bf1(unsigned short h) { return __builtin_bit_cast(float, (unsigned)h << 16); }
template <int CTRL> __device__ __forceinline__ float dppf(float x) { return __builtin_bit_cast(float, __builtin_amdgcn_update_dpp(0, __builtin_bit_cast(int, x), CTRL, 0xf, 0xf, false)); }
__device__ __forceinline__ float row16_allsum(float x) { x += dppf<0x128>(x); x += dppf<0x124>(x); x += dppf<0x122>(x); x += dppf<0x121>(x); return x; }
__device__ __forceinline__ float oct_allsum(float x) { x += dppf<0xB1>(x); x += dppf<0x4E>(x); x += dppf<0x141>(x); return x; }
__device__ __forceinline__ float u2f(unsigned u) { return __builtin_bit_cast(float, u); }
__device__ __forceinline__ unsigned f2u(float f) { return __builtin_bit_cast(unsigned, f); }
__device__ __forceinline__ float sw32(float a, float b) { auto r = __builtin_amdgcn_permlane32_swap(f2u(a), f2u(b), false, false); const unsigned r0 = r[0], r1 = r[1]; return u2f(r0) + u2f(r1); }
__device__ __forceinline__ float sw16(float a, float b) { auto r = __builtin_amdgcn_permlane16_swap(f2u(a), f2u(b), false, false); const unsigned r0 = r[0], r1 = r[1]; return u2f(r0) + u2f(r1); }
__device__ __forceinline__ float wave_allsum(float x) { x = row16_allsum(x); x = sw16(x, x); return sw32(x, x); }
__device__ __forceinline__ float red4(float x0, float x1, float x2, float x3) { return row16_allsum(sw16(sw32(x0, x1), sw32(x2, x3))); }

#define XB_TMO      128
#define XB_XCNT(j)  (256  + 64 * (j))
#define XB_XSUB(j)  (1280 + 64 * (j))
#define XB_XGEN(j)  (2304 + 64 * (j))
#define XB_TOP      3328
#define XB_TOPGEN   3392
#define XCD_BAR_WORDS 3456
#define XB_SPIN_CAP (1u << 18)

__device__ __forceinline__ unsigned xb_ld(unsigned* p)              { return __hip_atomic_load(p, __ATOMIC_RELAXED, __HIP_MEMORY_SCOPE_AGENT); }
__device__ __forceinline__ unsigned xb_add(unsigned* p, unsigned v) { return __hip_atomic_fetch_add(p, v, __ATOMIC_RELAXED, __HIP_MEMORY_SCOPE_AGENT); }
__device__ __forceinline__ unsigned xb_xcc_id() { return (unsigned)__builtin_amdgcn_s_getreg((3 << 11) | 20) & 0xFu; }
#define XB_SPIN(cond, bar) do { unsigned _sp = 0; while (cond) { __builtin_amdgcn_s_sleep(1); \
    if ((++_sp & 255u) == 0u) { if (xb_ld(&(bar)[XB_TMO])) break; if (_sp > XB_SPIN_CAP) { atomicAdd(&(bar)[XB_TMO], 1u); break; } } } } while (0)

struct XcdBarrier {
    unsigned* bar; unsigned x;
    volatile LAS unsigned* st;
};

__device__ __forceinline__ XcdBarrier xcd_barrier_post(unsigned* bar, volatile LAS unsigned* st) {
    XcdBarrier b; b.bar = bar; b.x = xb_xcc_id(); b.st = st;
    if (threadIdx.x == 0) (void)xb_add(&bar[XB_XCNT(b.x)], 1u);
    return b;
}
__device__ __forceinline__ void xcd_barrier_complete(unsigned* bar, unsigned x, unsigned& nloc, unsigned& nx) {
    const unsigned G = gridDim.x * gridDim.y * gridDim.z;
    unsigned sum, cnt, mine, sp = 0u;
    for (;;) {
        sum = 0u; cnt = 0u; mine = 0u;
#pragma unroll
        for (unsigned j = 0; j < 16; ++j) { const unsigned c = xb_ld(&bar[XB_XCNT(j)]); sum += c; cnt += (c > 0u) ? 1u : 0u; }
        mine = xb_ld(&bar[XB_XCNT(x)]);
        if (sum == G) break;
        __builtin_amdgcn_s_sleep(1);
        if ((++sp & 255u) == 0u) { if (xb_ld(&bar[XB_TMO])) break; if (sp > XB_SPIN_CAP) { atomicAdd(&bar[XB_TMO], 1u); break; } }
    }
    nloc = mine > 0u ? mine : 1u; nx = cnt > 0u ? cnt : 1u;
}

__device__ __forceinline__ void xcd_barrier(const XcdBarrier& b) {
    asm volatile("s_waitcnt vmcnt(0)" ::: "memory");
    __syncthreads();
    if (threadIdx.x == 0) {
        unsigned* bar = b.bar;
        __builtin_amdgcn_s_waitcnt(0);
        unsigned nloc = b.st[0], nx = b.st[1];
        if (nloc == 0u) { xcd_barrier_complete(bar, b.x, nloc, nx); b.st[0] = nloc; b.st[1] = nx; }
        const unsigned old = xb_add(&bar[XB_XSUB(b.x)], 1u);
        const unsigned gen = old / nloc;
        if (old + 1u == (gen + 1u) * nloc) {
            __builtin_amdgcn_fence(__ATOMIC_RELEASE, "agent");
            asm volatile("s_waitcnt vmcnt(0)" ::: "memory");
            const unsigned og = xb_add(&bar[XB_TOP], 1u);
            const unsigned tg = og / nx;
            if (og + 1u == (tg + 1u) * nx) xb_add(&bar[XB_TOPGEN], 1u);
            else XB_SPIN(xb_ld(&bar[XB_TOPGEN]) == tg, bar);
            __builtin_amdgcn_fence(__ATOMIC_ACQUIRE, "agent");
            xb_add(&bar[XB_XGEN(b.x)], 1u);
            asm volatile("s_waitcnt vmcnt(0)" ::: "memory");
        } else {
            XB_SPIN(xb_ld(&bar[XB_XGEN(b.x)]) == gen, bar);
            __builtin_amdgcn_fence(__ATOMIC_ACQUIRE, "agent");
            asm volatile("s_waitcnt vmcnt(0)" ::: "memory");
        }
    }
    __syncthreads();
}


constexpr int CW_BAR = 4096;
constexpr int MISC_OFF = 162816 + 320;
struct Frame {
    LAS unsigned char* lds;
    int tid, lane, wave, G, bx;
    float* out; unsigned char* ws;
};
struct Args { const float* in[26]; float* out; unsigned char* ws; int ph_lo, ph_hi; };
typedef const float* cfp_t;
typedef __attribute__((address_space(4))) const cfp_t* ktab_t;
struct InTab { ktab_t p; __device__ __forceinline__ const float* operator[](int i) const { return p[i]; } };
enum { I_X = 0, I_NMG, I_WIN, I_MU, I_W0, I_W2, I_A0, I_A2, I_G2, I_KK, I_KA, I_RK, I_LNG, I_LNB, I_LQ1, I_LK1, I_LQ2, I_LK2, I_SUBG, I_WA, I_WB, I_WO, I_NFG, I_FF1, I_FF2, I_NFIN };

template <bool ROPE> __device__ __forceinline__ void p0_transpose_item(const float* W, int K, int N, bf16* WT, LAS float* scr, int item, int lane, int pitch = 0, int koff = 0) {
    if (pitch == 0) pitch = K;
    const int nblk = N / 32, kb = item / nblk, nb = item % nblk, k0 = 64 * kb, n0 = 32 * nb;
#pragma unroll
    for (int i = 0; i < 8; ++i) { const int kk = 8 * i + (lane >> 3), c4 = 4 * (lane & 7); const f32x4 w4 = *(const GAS f32x4*)(W + (size_t)(k0 + kk) * N + n0 + c4);
        scr[kk * 33 + c4] = w4.x; scr[kk * 33 + c4 + 1] = w4.y; scr[kk * 33 + c4 + 2] = w4.z; scr[kk * 33 + c4 + 3] = w4.w; }
    LDS_WAIT(); asm volatile("" ::: "memory");
    const int c = lane & 7;
#pragma unroll
    for (int j = 0; j < 4; ++j) { const int n = (lane >> 3) + 8 * j; const LAS float* s = scr + (8 * c) * 33 + n;
        v4u o; o.x = pk2(s[0 * 33], s[1 * 33]); o.y = pk2(s[2 * 33], s[3 * 33]); o.z = pk2(s[4 * 33], s[5 * 33]); o.w = pk2(s[6 * 33], s[7 * 33]);
        int col = n0 + n;
        if (ROPE && col < 1024) { const int d = col & 63, dd = d & 31; col = (col & ~63) + 8 * (dd >> 2) + (d >> 5) * 4 + (dd & 3); }
        *(GAS v4u*)(WT + (size_t)col * pitch + koff + k0 + 8 * c) = o; }
    LDS_WAIT(); asm volatile("" ::: "memory");
}
__device__ __forceinline__ void rms_row_to_bf16(const float* xrow, const float* g, bf16* orow, int lane) {
    const GAS f32x4* xr = (const GAS f32x4*)xrow + lane; const f32x4* gr = (const f32x4*)g + lane;
    f32x4 v[4]; float s = 0.f;
#pragma unroll
    for (int j = 0; j < 4; ++j) { v[j] = xr[64 * j]; s += (v[j].x * v[j].x + v[j].y * v[j].y) + (v[j].z * v[j].z + v[j].w * v[j].w); }
    const float rstd = 1.0f / sqrtf(wave_allsum(s) * (1.f / D) + NORM_EPS);
    GAS unsigned long long* o8 = (GAS unsigned long long*)orow + lane;
#pragma unroll
    for (int j = 0; j < 4; ++j) { const f32x4 gg = gr[64 * j];
        o8[64 * j] = (unsigned long long)pk2(v[j].x * rstd * gg.x, v[j].y * rstd * gg.y) | ((unsigned long long)pk2(v[j].z * rstd * gg.z, v[j].w * rstd * gg.w) << 32); }
}
__device__ __forceinline__ void rms_row_to_f32(const float* xrow, const float* g, float* orow, int lane) {
    const GAS f32x4* xr = (const GAS f32x4*)xrow + lane; const f32x4* gr = (const f32x4*)g + lane;
    f32x4 v[4]; float s = 0.f;
#pragma unroll
    for (int j = 0; j < 4; ++j) { v[j] = xr[64 * j]; s += (v[j].x * v[j].x + v[j].y * v[j].y) + (v[j].z * v[j].z + v[j].w * v[j].w); }
    const float rstd = 1.0f / sqrtf(wave_allsum(s) * (1.f / D) + NORM_EPS);
    GAS f32x4* o = (GAS f32x4*)orow + lane;
#pragma unroll
    for (int j = 0; j < 4; ++j) { const f32x4 gg = gr[64 * j]; o[64 * j] = v[j] * rstd * gg; }
}
__device__ __forceinline__ void p0_prologue(Frame& F, const InTab& A) {
    LAS float* scr = (LAS float*)(F.lds + RING_OFF + F.wave * 16384);
    const int gw = F.bx * NWAVES + F.wave, NGW = F.G * NWAVES;
    unsigned char* ws = F.ws;
    constexpr int I_IN = (D / 64) * (D_IN / 32), I_A = (512 / 64) * (D / 32), I_O = (D / 64) * (D / 32), I_1 = (D / 64) * (FF / 32), I_2 = (FF / 64) * (D / 32);
    (void)I_A; (void)I_O; (void)I_1; (void)I_2;
    for (int it = gw; it < I_IN; it += NGW) p0_transpose_item<true>(A[I_WIN], D, D_IN, (bf16*)(ws + WS_WIN), scr, it, F.lane);
    if (false) for (int it = gw; it < 0; it += NGW) {
        int r = it;
        if (r < I_A) { p0_transpose_item<false>(A[I_WA], 512, D, (bf16*)(ws + WS_WA), scr, r, F.lane, 1024, 0); continue; } r -= I_A;
        if (r < I_A) { p0_transpose_item<false>(A[I_WB], 512, D, (bf16*)(ws + WS_WA), scr, r, F.lane, 1024, 512); continue; } r -= I_A;
        if (r < I_O) { p0_transpose_item<false>(A[I_WO], D, D, (bf16*)(ws + WS_WO), scr, r, F.lane); continue; } r -= I_O;
        if (r < I_1) { p0_transpose_item<false>(A[I_FF1], D, FF, (bf16*)(ws + WS_W1), scr, r, F.lane); continue; } r -= I_1;
        p0_transpose_item<false>(A[I_FF2], FF, D, (bf16*)(ws + WS_W2), scr, r, F.lane);
    }
    const int gt = F.bx * (NWAVES * 64) + F.tid, NGT = F.G * NWAVES * 64;
    for (int e = gt; e < NLORA * (KLORA / 8); e += NGT) { const int n = e % NLORA, k8 = (e / NLORA) * 8; float v[8];
#pragma unroll
        for (int i = 0; i < 8; ++i) { const int k = k8 + i; float x = 0.f;
            if (n < 512) { if (k < 64) x = A[I_W2][(size_t)k * 512 + n]; }
            else if (n < 1024) { if (k >= 64 && k < 128) x = A[I_A2][(size_t)(k - 64) * 512 + (n - 512)]; }
            else { if (k >= 128) x = A[I_G2][(size_t)(k - 128) * 512 + (n - 1024)]; }
            v[i] = x; }
        v4u o; o.x = pk2(v[0], v[1]); o.y = pk2(v[2], v[3]); o.z = pk2(v[4], v[5]); o.w = pk2(v[6], v[7]);
        *(GAS v4u*)((bf16*)(ws + WS_WL) + (size_t)n * KLORA + k8) = o; }
    for (int e = gt; e < SEQ * 32; e += NGT) { const int pos = e >> 5, i = e & 31;
        const float inv = exp2f(-(float)i * 0.41524101186092029f);
        const float ang = (float)pos * inv; float s, c; sincosf(ang, &s, &c);
        ((float*)(ws + WS_ROPE_C))[e] = c; ((float*)(ws + WS_ROPE_S))[e] = s; }
    for (int m = gw; m < M; m += 2 * NGW) {
        const int m2 = m + NGW;
        const GAS f32x4* xa = (const GAS f32x4*)(A[I_X] + (size_t)m * D) + F.lane; const GAS f32x4* xb = (const GAS f32x4*)(A[I_X] + (size_t)m2 * D) + F.lane; const f32x4* gr = (const f32x4*)A[I_NMG] + F.lane;
        f32x4 va[4], vb[4]; float sa = 0.f, sb = 0.f;
#pragma unroll
        for (int j = 0; j < 4; ++j) { va[j] = xa[64 * j]; vb[j] = xb[64 * j]; }
#pragma unroll
        for (int j = 0; j < 4; ++j) { sa += (va[j].x * va[j].x + va[j].y * va[j].y) + (va[j].z * va[j].z + va[j].w * va[j].w); sb += (vb[j].x * vb[j].x + vb[j].y * vb[j].y) + (vb[j].z * vb[j].z + vb[j].w * vb[j].w); }
        const float ra = __builtin_amdgcn_rsqf(wave_allsum(sa) * (1.f / D) + NORM_EPS), rb = __builtin_amdgcn_rsqf(wave_allsum(sb) * (1.f / D) + NORM_EPS);
        GAS unsigned long long* oa = (GAS unsigned long long*)((bf16*)(ws + WS_XN) + (size_t)m * D) + F.lane; GAS unsigned long long* ob = (GAS unsigned long long*)((bf16*)(ws + WS_XN) + (size_t)m2 * D) + F.lane;
#pragma unroll
        for (int j = 0; j < 4; ++j) { const f32x4 gg = gr[64 * j];
            oa[64 * j] = (unsigned long long)pk2(va[j].x * ra * gg.x, va[j].y * ra * gg.y) | ((unsigned long long)pk2(va[j].z * ra * gg.z, va[j].w * ra * gg.w) << 32);
            ob[64 * j] = (unsigned long long)pk2(vb[j].x * rb * gg.x, vb[j].y * rb * gg.y) | ((unsigned long long)pk2(vb[j].z * rb * gg.z, vb[j].w * rb * gg.w) << 32); }
    }
}

__device__ __forceinline__ void late_weights(Frame& F, const InTab& A, int part, int nparts, int cu0) {
    int lane_ = F.lane; asm volatile("" : "+v"(lane_));
    LAS float* scr = (LAS float*)(F.lds + RING_OFF + F.wave * 16384);
    unsigned char* ws = F.ws;
    constexpr int I_A = (512 / 64) * (D / 32), I_O = (D / 64) * (D / 32), I_1 = (D / 64) * (FF / 32), I_2 = (FF / 64) * (D / 32), NIT = 2 * I_A + I_O + I_1 + I_2;
    const int per = NIT / nparts, lo = part * per, hi = lo + per;
    const int gw = (F.bx - cu0) * NWAVES + F.wave, NGW = (F.G - cu0) * NWAVES;
    for (int it = lo + gw; it < hi; it += NGW) {
        int r = it;
        if (r < I_A) { p0_transpose_item<false>(A[I_WA], 512, D, (bf16*)(ws + WS_WA), scr, r, lane_, 1024, 0); continue; } r -= I_A;
        if (r < I_A) { p0_transpose_item<false>(A[I_WB], 512, D, (bf16*)(ws + WS_WA), scr, r, lane_, 1024, 512); continue; } r -= I_A;
        if (r < I_O) { p0_transpose_item<false>(A[I_WO], D, D, (bf16*)(ws + WS_WO), scr, r, lane_); continue; } r -= I_O;
        if (r < I_1) { p0_transpose_item<false>(A[I_FF1], D, FF, (bf16*)(ws + WS_W1), scr, r, lane_); continue; } r -= I_1;
        p0_transpose_item<false>(A[I_FF2], FF, D, (bf16*)(ws + WS_W2), scr, r, lane_);
    }
}
__device__ __forceinline__ void prep1_rows(Frame& F, const InTab& A, int g0, int g1, int w, int nw) {
    const int lane = F.lane;
    const bf16* WAG = (const bf16*)(F.ws + WS_WAG); bf16* LIN = (bf16*)(F.ws + WS_LIN);
    const f32x4 mu = *(const f32x4*)(A[I_MU] + 1536 + 4 * lane);
    for (int g = g0 + w; g < g1; g += nw) {
        const int m0 = g * 8; v2u row[9];
        row[0] = (v2u){0u, 0u}; if ((m0 & (SEQ - 1)) != 0) row[0] = *(const GAS v2u*)(WAG + (size_t)(m0 - 1) * 256 + 4 * lane);
#pragma unroll
        for (int j = 0; j < 8; ++j) row[j + 1] = *(const GAS v2u*)(WAG + (size_t)(m0 + j) * 256 + 4 * lane);
#pragma unroll
        for (int j = 0; j < 8; ++j) {
            float z[4] = {bflo(row[j + 1].x), bfhi(row[j + 1].x), bflo(row[j + 1].y), bfhi(row[j + 1].y)}; const float p[4] = {bflo(row[j].x), bfhi(row[j].x), bflo(row[j].y), bfhi(row[j].y)};
#pragma unroll
            for (int e = 0; e < 4; ++e) { float v = z[e] + (p[e] - z[e]) * mu[e];
                if (lane < 16) v = 1.0f - 2.0f * __builtin_amdgcn_rcpf(1.0f + __expf(2.0f * v));
                else if (lane >= 32) v = __builtin_amdgcn_rcpf(1.0f + __expf(-v));
                z[e] = v; }
            v2u o; o.x = pk2(z[0], z[1]); o.y = pk2(z[2], z[3]);
            *(GAS v2u*)(LIN + (size_t)(m0 + j) * 256 + 4 * lane) = o;
        }
    }
}
struct ScanRaw { unsigned short r[9], k[9], v[9], a[8]; float d[8]; };
__device__ __forceinline__ void scan_load(ScanRaw& R, const bf16* RKV, const float* DEC, const bf16* AA, size_t row0, int t0, int c) {
#pragma unroll
    for (int j = 0; j < 9; ++j) { int t = t0 - 1 + j; if (t < 0) t = 0; const bf16* p = RKV + (row0 + t) * 1536 + c;
        R.r[j] = *(const GAS bf16*)p; R.k[j] = *(const GAS bf16*)(p + 512); R.v[j] = *(const GAS bf16*)(p + 1024); }
#pragma unroll
    for (int j = 0; j < 8; ++j) { R.d[j] = *(const GAS float*)(DEC + (row0 + t0 + j) * 512 + c); R.a[j] = *(const GAS bf16*)(AA + (row0 + t0 + j) * 512 + c); }
}
__device__ __forceinline__ void scan_phase(Frame& F, const InTab& A, int si) {
    const int lane = F.lane, wave = F.wave, tid = F.tid;
    const int bh = si >> 1, half = si & 1, b = bh >> 3, h = bh & 7, c = h * 64 + lane;
    LAS float* IN = (LAS float*)(F.lds + RING_OFF);
    LAS float* VV = IN + 5 * 4096;
    LAS float* YBUF = VV + 2048;
    const bf16* RKV = (const bf16*)(F.ws + WS_RKV); const float* DEC = (const float*)(F.ws + WS_DEC); const bf16* AA = (const bf16*)(F.ws + WS_AA);
    bf16* Y = (bf16*)(F.ws + WS_Y); float* BON = (float*)(F.ws + WS_BON);
    const float mu_r = A[I_MU][c], mu_k = A[I_MU][512 + c], mu_v = A[I_MU][1024 + c], kkc = A[I_KK][c], kac = A[I_KA][c], rkc = A[I_RK][c];
    const size_t row0 = (size_t)b * SEQ;
    const int myv = (int)(red4(0.f, 1.f, 2.f, 3.f) * (1.0f / 64.0f) + 0.5f);
    const int L0 = __builtin_ctzll(__ballot(myv == 0)), L1 = __builtin_ctzll(__ballot(myv == 1)), L2 = __builtin_ctzll(__ballot(myv == 2)), L3 = __builtin_ctzll(__ballot(myv == 3));
    float S0 = 0.f, S1 = 0.f, S2 = 0.f, S3 = 0.f;
    ScanRaw R; scan_load(R, RKV, DEC, AA, row0, wave * 8, c);
    for (int blk = 0; blk < SEQ / 64; ++blk) {
        {
            const int t0 = blk * 64 + wave * 8;
            f32x4 qd[2], qa[2], qb[2], qk[2], qr[2], qv[2];
#pragma unroll
            for (int j = 0; j < 8; ++j) {
                const float pz = (t0 + j == 0) ? 0.f : 1.f;
                const float rt_ = bf1(R.r[j + 1]), kt_ = bf1(R.k[j + 1]), vt_ = bf1(R.v[j + 1]);
                const float rs = rt_ + (bf1(R.r[j]) * pz - rt_) * mu_r, ks = kt_ + (bf1(R.k[j]) * pz - kt_) * mu_k, vs = vt_ + (bf1(R.v[j]) * pz - vt_) * mu_v;
                const float kkr = ks * kkc, n2 = wave_allsum(kkr * kkr), kk = kkr / __builtin_fmaxf(sqrtf(n2), 1e-12f);
                const float a = 1.0f / (1.0f + __expf(-bf1(R.a[j]))), kx = ks * (1.0f + (a - 1.0f) * kac);
                const float bon = wave_allsum(rs * kx * rkc);
                if (half == 0 && lane == 0) BON[(row0 + t0 + j) * 8 + h] = bon;
                qd[j >> 2][j & 3] = __expf(-0.6065306597f / (1.0f + __expf(-R.d[j])));     qa[j >> 2][j & 3] = -kk; qb[j >> 2][j & 3] = kk * a; qk[j >> 2][j & 3] = kx; qr[j >> 2][j & 3] = rs; qv[j >> 2][j & 3] = vs;
            }
#pragma unroll
            for (int q = 0; q < 2; ++q) { const int t4 = wave * 2 + q; LAS f32x4* p = (LAS f32x4*)IN + t4 * 64 + lane;
                p[0 * 1024] = qd[q]; p[1 * 1024] = qa[q]; p[2 * 1024] = qb[q]; p[3 * 1024] = qk[q]; p[4 * 1024] = qr[q];
                if ((lane >> 5) == half) ((LAS f32x4*)VV)[t4 * 32 + (lane & 31)] = qv[q]; }
        }
        __syncthreads();
        if (blk + 1 < SEQ / 64) scan_load(R, RKV, DEC, AA, row0, (blk + 1) * 64 + wave * 8, c);
#pragma unroll 1
        for (int t4 = 0; t4 < 16; ++t4) {
            const LAS f32x4* p = (const LAS f32x4*)IN + t4 * 64 + lane;
            const f32x4 W4 = p[0], A4 = p[1024], B4 = p[2048], K4 = p[3072], R4 = p[4096];
            const LAS f32x4* pv = (const LAS f32x4*)VV + t4 * 32 + wave * 4;
            const f32x4 V0 = pv[0], V1 = pv[1], V2 = pv[2], V3 = pv[3];
            f32x4 yq;
#pragma unroll
            for (int ts = 0; ts < 4; ++ts) {
                const float w = W4[ts], a = A4[ts], bb = B4[ts], kx = K4[ts], r = R4[ts];
                const float t = red4(S0 * a, S1 * a, S2 * a, S3 * a);
                const float sa0 = __builtin_bit_cast(float, __builtin_amdgcn_readlane(__builtin_bit_cast(int, t), L0)), sa1 = __builtin_bit_cast(float, __builtin_amdgcn_readlane(__builtin_bit_cast(int, t), L1));
                const float sa2 = __builtin_bit_cast(float, __builtin_amdgcn_readlane(__builtin_bit_cast(int, t), L2)), sa3 = __builtin_bit_cast(float, __builtin_amdgcn_readlane(__builtin_bit_cast(int, t), L3));
                S0 = S0 * w + (sa0 * bb + V0[ts] * kx); S1 = S1 * w + (sa1 * bb + V1[ts] * kx); S2 = S2 * w + (sa2 * bb + V2[ts] * kx); S3 = S3 * w + (sa3 * bb + V3[ts] * kx);
                yq[ts] = red4(S0 * r, S1 * r, S2 * r, S3 * r);
            }
            if ((lane & 15) == 0) *(LAS f32x4*)(YBUF + (wave * 4 + myv) * 68 + t4 * 4) = yq;
        }
        __syncthreads();
        { const int t = tid >> 3, rg = tid & 7; const LAS float* yb = YBUF + (4 * rg) * 68 + t;
          v2u o; o.x = pk2(yb[0], yb[68]); o.y = pk2(yb[136], yb[204]);
          *(GAS v2u*)(Y + (row0 + blk * 64 + t) * 512 + h * 64 + 32 * half + 4 * rg) = o; }
    }
    __syncthreads();
}
__device__ __forceinline__ void post_phase(Frame& F, const InTab& A) {
    const int gw = F.bx * NWAVES + F.wave, NGW = F.G * NWAVES, lane = F.lane;
    const bf16* O = (const bf16*)(F.ws + WS_O); const bf16* Y = (const bf16*)(F.ws + WS_Y); const bf16* RKV = (const bf16*)(F.ws + WS_RKV); const bf16* GG = (const bf16*)(F.ws + WS_GG);
    const float* BON = (const float*)(F.ws + WS_BON); bf16* YA = (bf16*)(F.ws + WS_YA);
    const float lam = __expf(wave_allsum(A[I_LQ1][lane] * A[I_LK1][lane])) - __expf(wave_allsum(A[I_LQ2][lane] * A[I_LK2][lane])) + LAMBDA_INIT;
    const int ca = 8 * lane, ha = lane >> 4, ea = ca & 127;
    const int hb = lane >> 3;
    float sg[8], lg[8], lb[8], muv[8];
#pragma unroll
    for (int e = 0; e < 8; ++e) { sg[e] = A[I_SUBG][ea + e] * (1.0f - LAMBDA_INIT); lg[e] = A[I_LNG][ca + e]; lb[e] = A[I_LNB][ca + e]; muv[e] = A[I_MU][1024 + ca + e]; }
#define UNPK8(w_) {bflo(w_.x), bfhi(w_.x), bflo(w_.y), bfhi(w_.y), bflo(w_.z), bfhi(w_.z), bflo(w_.w), bfhi(w_.w)}
    for (int g = gw; g < M / 4; g += NGW) {
        const int m0 = g * 4;
        v4u o0[4], o1[4], yr[4], gr[4], vr[5]; float bon[4];
        vr[0] = (v4u){0u, 0u, 0u, 0u}; if ((m0 & (SEQ - 1)) != 0) vr[0] = *(const GAS v4u*)(RKV + (size_t)(m0 - 1) * 1536 + 1024 + ca);
#pragma unroll
        for (int j = 0; j < 4; ++j) { const size_t mm = (size_t)(m0 + j);
            o0[j] = *(const GAS v4u*)(O + mm * 1024 + (2 * ha) * 128 + ea); o1[j] = *(const GAS v4u*)(O + mm * 1024 + (2 * ha + 1) * 128 + ea);
            yr[j] = *(const GAS v4u*)(Y + mm * 512 + ca); gr[j] = *(const GAS v4u*)(GG + mm * 512 + ca); vr[j + 1] = *(const GAS v4u*)(RKV + mm * 1536 + 1024 + ca);
            bon[j] = *(const GAS float*)(BON + mm * 8 + hb); }
#pragma unroll
        for (int j = 0; j < 4; ++j) { const size_t mm = (size_t)(m0 + j);
            {
                const float a0[8] = UNPK8(o0[j]), a1[8] = UNPK8(o1[j]); float o[8], ss = 0.f;
#pragma unroll
                for (int e = 0; e < 8; ++e) { o[e] = a0[e] - lam * a1[e]; ss += o[e] * o[e]; }
                const float rstd = __builtin_amdgcn_rsqf(row16_allsum(ss) * (1.0f / 128.0f) + SUBLN_EPS);
                v4u w; w.x = pk2(o[0] * rstd * sg[0], o[1] * rstd * sg[1]); w.y = pk2(o[2] * rstd * sg[2], o[3] * rstd * sg[3]); w.z = pk2(o[4] * rstd * sg[4], o[5] * rstd * sg[5]); w.w = pk2(o[6] * rstd * sg[6], o[7] * rstd * sg[7]);
                *(GAS v4u*)(YA + mm * 1024 + ca) = w;
            }
            {
                const float y[8] = UNPK8(yr[j]), gq[8] = UNPK8(gr[j]), v[8] = UNPK8(vr[j + 1]), p[8] = UNPK8(vr[j]);
                float s = 0.f;
#pragma unroll
                for (int e = 0; e < 8; ++e) s += y[e];
                const float mean = oct_allsum(s) * (1.0f / 64.0f); float q = 0.f;
#pragma unroll
                for (int e = 0; e < 8; ++e) { const float d = y[e] - mean; q += d * d; }
                const float rstd = __builtin_amdgcn_rsqf(oct_allsum(q) * (1.0f / 64.0f) + GN_EPS);
                float r[8];
#pragma unroll
                for (int e = 0; e < 8; ++e) { const float vs = v[e] + (p[e] - v[e]) * muv[e]; r[e] = (((y[e] - mean) * rstd) * lg[e] + lb[e] + bon[j] * vs) * gq[e]; }
                v4u w; w.x = pk2(r[0], r[1]); w.y = pk2(r[2], r[3]); w.z = pk2(r[4], r[5]); w.w = pk2(r[6], r[7]);
                *(GAS v4u*)(YA + mm * 1024 + 512 + ca) = w;
            }
        }
    }
#undef UNPK8
}

typedef short rk_bf16x8 __attribute__((ext_vector_type(8)));
typedef float rk_f32x16 __attribute__((ext_vector_type(16)));
constexpr int RKA_RS_K = 144, RKA_RS_J = 80;
constexpr int RKA_A = 0, RKA_B = 5120, RKA_K = 10240, RKA_R = 15360, RKA_AT = 19968, RKA_BH = 25088, RKA_KH = 30208, RKA_VT = 35328, RKA_GC = 40448, RKA_BYTES = 40704;
constexpr int RKA_N = 0, RKA_X = 0, RKA_T = 5120, RKA_MAK = 7680, RKA_MRB = 10240, RKA_MRK = 12800;
constexpr int RKA_WAVES = 4;
static_assert(RKA_WAVES * RKA_BYTES <= 162816, "phase A LDS");
constexpr size_t WS_PQ0 = 66 * MiB, WS_PQ1 = 34 * MiB;
constexpr size_t WS_RY0 = 98 * MiB, WS_RY1 = 178 * MiB;
constexpr size_t WS_GC = 250 * MiB;
__device__ __forceinline__ unsigned char* rk_pq(unsigned char* ws, int half) { return ws + (half ? WS_PQ1 : WS_PQ0); }
__device__ __forceinline__ unsigned char* rk_ry(unsigned char* ws, int half) { return ws + (half ? WS_RY1 : WS_RY0); }
__device__ __forceinline__ unsigned char* rk_gc(unsigned char* ws, int half) { return ws + WS_GC + (size_t)half * (2048 * 256); }
constexpr size_t WS_SST = 251 * MiB;

__device__ __forceinline__ rk_bf16x8 rk_frag(const LAS unsigned char* base, int rs, int row, int s, int h) { return *(const LAS rk_bf16x8*)(base + row * rs + (16 * s + 8 * h) * 2); }
__device__ __forceinline__ rk_f32x16 rk_mfma(rk_bf16x8 a, rk_bf16x8 b, rk_f32x16 c) { return __builtin_amdgcn_mfma_f32_32x32x16_bf16(a, b, c, 0, 0, 0); }
__device__ __forceinline__ unsigned rk_pk(float lo, float hi) { typedef float f2_ __attribute__((ext_vector_type(2))); typedef __bf16 b2_ __attribute__((ext_vector_type(2))); f2_ v = {lo, hi}; b2_ b = __builtin_convertvector(v, b2_); return __builtin_bit_cast(unsigned, b); }
__device__ __forceinline__ void rk_store_tile_lds(LAS unsigned char* base, int rs, int nrow, int mbase, int h, const rk_f32x16& acc) {
#pragma unroll
    for (int g = 0; g < 4; ++g) { v2u w; w.x = rk_pk(acc[4 * g], acc[4 * g + 1]); w.y = rk_pk(acc[4 * g + 2], acc[4 * g + 3]); *(LAS v2u*)(base + nrow * rs + (mbase + 8 * g + 4 * h) * 2) = w; }
}
__device__ __forceinline__ void rk_store_tile_glb(bf16* base, int pitch, int nrow, int mbase, int h, const rk_f32x16& acc) {
#pragma unroll
    for (int g = 0; g < 4; ++g) { v2u w; w.x = rk_pk(acc[4 * g], acc[4 * g + 1]); w.y = rk_pk(acc[4 * g + 2], acc[4 * g + 3]); *(GAS v2u*)(base + (size_t)nrow * pitch + mbase + 8 * g + 4 * h) = w; }
}
__device__ __forceinline__ void rk_store_tile_frag(unsigned char* base, int nt, int r32, int mt, int h, const rk_f32x16& acc) {
#pragma unroll
    for (int g = 0; g < 4; ++g) { v2u w; w.x = rk_pk(acc[4 * g], acc[4 * g + 1]); w.y = rk_pk(acc[4 * g + 2], acc[4 * g + 3]);
        *(GAS v2u*)(base + ((size_t)((nt * 4 + 2 * mt + (g >> 1)) * 64 + r32 + 32 * (g & 1))) * 16 + 8 * h) = w; }
}
__device__ __forceinline__ void rk_store_blob(unsigned* blob, int lane, const rk_f32x16& acc) {
    v4u w0, w1; w0.x = rk_pk(acc[0], acc[1]); w0.y = rk_pk(acc[2], acc[3]); w0.z = rk_pk(acc[4], acc[5]); w0.w = rk_pk(acc[6], acc[7]);
    w1.x = rk_pk(acc[8], acc[9]); w1.y = rk_pk(acc[10], acc[11]); w1.z = rk_pk(acc[12], acc[13]); w1.w = rk_pk(acc[14], acc[15]);
    *(GAS v4u*)(blob + lane * 8) = w0; *(GAS v4u*)(blob + lane * 8 + 4) = w1;
}
struct RkBlob { v4u w0, w1; };
__device__ __forceinline__ RkBlob rk_load_blob(const unsigned* blob, int lane) { RkBlob b; b.w0 = *(const GAS v4u*)(blob + lane * 8); b.w1 = *(const GAS v4u*)(blob + lane * 8 + 4); return b; }
__device__ __forceinline__ rk_f32x16 rk_blob_f32(const RkBlob& b) {
    rk_f32x16 a; const unsigned w[8] = {b.w0.x, b.w0.y, b.w0.z, b.w0.w, b.w1.x, b.w1.y, b.w1.z, b.w1.w};
#pragma unroll
    for (int i = 0; i < 8; ++i) { a[2 * i] = bflo(w[i]); a[2 * i + 1] = bfhi(w[i]); }
    return a;
}

struct RkRaw { unsigned short r[8], k[8], v[8]; };
__device__ __forceinline__ void rk_load8(RkRaw& R, const bf16* prkv) {
#pragma unroll
    for (int j = 0; j < 8; ++j) { R.r[j] = *(const GAS bf16*)(prkv + j * 1536); R.k[j] = *(const GAS bf16*)(prkv + j * 1536 + 512); R.v[j] = *(const GAS bf16*)(prkv + j * 1536 + 1024); }
}
__device__ __forceinline__ void rwkvA_unit(LAS unsigned char* L, const InTab& A, unsigned char* ws, int bh, int chunk, int lane_in) {
    int lane = lane_in; asm volatile("" : "+v"(lane));
    const int b = bh >> 3, hd = bh & 7, cg = hd * 64 + lane, r32 = lane & 31, h = lane >> 5;
    const size_t row0 = (size_t)b * SEQ + (size_t)chunk * 32;
    const int uh = bh * 32 + (chunk & 31);
    const bf16* prkv = (const bf16*)(ws + WS_RKV) + row0 * 1536 + cg;
    float* pbon = (float*)(ws + WS_BON) + row0 * 8 + hd;
    const float mu_r = A[I_MU][cg], mu_k = A[I_MU][512 + cg], mu_v = A[I_MU][1024 + cg], kkc = A[I_KK][cg], kac = A[I_KA][cg], rkc = A[I_RK][cg], w0c = A[I_W0][cg], a0c = A[I_A0][cg];
    float dW[32], dA[32];
    {
        rk_f32x16 lw[2] = {{}, {}}, la[2] = {{}, {}};
        const bf16* lp = (const bf16*)(ws + WS_LIN) + (row0 + r32) * 256 + 8 * h;
        const bf16* wp = (const bf16*)(ws + WS_WL) + (size_t)(hd * 64 + r32) * 256 + 8 * h;
#pragma unroll
        for (int s2 = 0; s2 < 4; ++s2) { const rk_bf16x8 fw = __builtin_bit_cast(rk_bf16x8, *(const GAS v4u*)(lp + 16 * s2)), fa = __builtin_bit_cast(rk_bf16x8, *(const GAS v4u*)(lp + 64 + 16 * s2));
#pragma unroll
            for (int ct = 0; ct < 2; ++ct) { lw[ct] = rk_mfma(fw, __builtin_bit_cast(rk_bf16x8, *(const GAS v4u*)(wp + (size_t)ct * 32 * 256 + 16 * s2)), lw[ct]);
                la[ct] = rk_mfma(fa, __builtin_bit_cast(rk_bf16x8, *(const GAS v4u*)(wp + (size_t)(512 + ct * 32) * 256 + 64 + 16 * s2)), la[ct]); } }
#pragma unroll
        for (int i = 0; i < 16; ++i) { const int tb = (i & 3) + 8 * (i >> 2);
            { auto r = __builtin_amdgcn_permlane32_swap(f2u(lw[0][i]), f2u(lw[1][i]), false, false); const unsigned r0 = r[0], r1 = r[1]; dW[tb] = u2f(r0); dW[tb + 4] = u2f(r1); }
            { auto r = __builtin_amdgcn_permlane32_swap(f2u(la[0][i]), f2u(la[1][i]), false, false); const unsigned r0 = r[0], r1 = r[1]; dA[tb] = u2f(r0); dA[tb + 4] = u2f(r1); } }
    }
    const int myv = (int)(red4(0.f, 1.f, 2.f, 3.f) * (1.0f / 64.0f) + 0.5f);
    const int L0 = __builtin_ctzll(__ballot(myv == 0)), L1 = __builtin_ctzll(__ballot(myv == 1)), L2 = __builtin_ctzll(__ballot(myv == 2)), L3 = __builtin_ctzll(__ballot(myv == 3));
    float rp = 0.f, kp = 0.f, vp = 0.f;
    if (chunk != 0) { rp = bf1(*(const GAS bf16*)(prkv - 1536)); kp = bf1(*(const GAS bf16*)(prkv - 1536 + 512)); vp = bf1(*(const GAS bf16*)(prkv - 1536 + 1024)); }
    float G = 1.0f;
    RkRaw Rc, Rn; rk_load8(Rc, prkv);
#pragma unroll
    for (int q = 0; q < 4; ++q) {
        prkv += 8 * 1536;
        if (q < 3) rk_load8(Rn, prkv);
        LAS unsigned char* Lr = L + (8 * q) * RKA_RS_K + lane * 2;
        LAS unsigned char* Lt = L + lane * RKA_RS_J + (8 * q) * 2;
        unsigned tA[4], tB[4], tK[4], tV[4], pA = 0, pB = 0, pK = 0, pV = 0;
        float rs_[8], kx_[8], kkr_[8], a8_[8], w8_[8], vs_[8];
#pragma unroll
        for (int j = 0; j < 8; ++j) {
            const float rc = bf1(Rc.r[j]), kc = bf1(Rc.k[j]), vc = bf1(Rc.v[j]);
            const float ks = kc + (kp - kc) * mu_k; rs_[j] = rc + (rp - rc) * mu_r; vs_[j] = vc + (vp - vc) * mu_v; rp = rc; kp = kc; vp = vc;
            kkr_[j] = ks * kkc; a8_[j] = __builtin_amdgcn_rcpf(1.0f + __expf(-(a0c + dA[8 * q + j]))); kx_[j] = ks * (1.0f + (a8_[j] - 1.0f) * kac);
            w8_[j] = __expf(-0.6065306597f * __builtin_amdgcn_rcpf(1.0f + __expf(-(w0c + dW[8 * q + j]))));
        }
        float n2_[8], bon_[8];
#pragma unroll
        for (int j = 0; j < 8; j += 2) {
            const float t = red4(kkr_[j] * kkr_[j], kkr_[j + 1] * kkr_[j + 1], rs_[j] * kx_[j] * rkc, rs_[j + 1] * kx_[j + 1] * rkc);
            n2_[j] = __builtin_bit_cast(float, __builtin_amdgcn_readlane(__builtin_bit_cast(int, t), L0)); n2_[j + 1] = __builtin_bit_cast(float, __builtin_amdgcn_readlane(__builtin_bit_cast(int, t), L1));
            bon_[j] = __builtin_bit_cast(float, __builtin_amdgcn_readlane(__builtin_bit_cast(int, t), L2)); bon_[j + 1] = __builtin_bit_cast(float, __builtin_amdgcn_readlane(__builtin_bit_cast(int, t), L3));
        }
        if (lane < 8) { float bv = bon_[0];
#pragma unroll
            for (int j = 1; j < 8; ++j) bv = (lane == j) ? bon_[j] : bv;
            *(GAS float*)(pbon + (8 * q + lane) * 8) = bv; }
        unsigned tR[4];
#pragma unroll
        for (int j = 0; j < 8; j += 2) {
            const float kk0 = kkr_[j] * __builtin_amdgcn_rsqf(__builtin_fmaxf(n2_[j], 1e-24f)), kk1 = kkr_[j + 1] * __builtin_amdgcn_rsqf(__builtin_fmaxf(n2_[j + 1], 1e-24f));
            const float G0 = G; const float G1 = G0 * w8_[j]; G = G1 * w8_[j + 1]; const float i1 = __builtin_amdgcn_rcpf(G1), i2 = __builtin_amdgcn_rcpf(G);
            tA[j >> 1] = rk_pk(-kk0 * G0, -kk1 * G1); tR[j >> 1] = rk_pk(rs_[j] * G1, rs_[j + 1] * G); tB[j >> 1] = rk_pk(kk0 * a8_[j] * i1, kk1 * a8_[j + 1] * i2); tK[j >> 1] = rk_pk(kx_[j] * i1, kx_[j + 1] * i2); tV[j >> 1] = rk_pk(vs_[j], vs_[j + 1]);
            *(LAS bf16*)(Lr + RKA_A + j * RKA_RS_K) = (bf16)(tA[j >> 1] & 0xffffu); *(LAS bf16*)(Lr + RKA_A + (j + 1) * RKA_RS_K) = (bf16)(tA[j >> 1] >> 16);
            *(LAS bf16*)(Lr + RKA_R + j * RKA_RS_K) = (bf16)(tR[j >> 1] & 0xffffu); *(LAS bf16*)(Lr + RKA_R + (j + 1) * RKA_RS_K) = (bf16)(tR[j >> 1] >> 16);
            *(LAS bf16*)(Lr + RKA_B + j * RKA_RS_K) = (bf16)(tB[j >> 1] & 0xffffu); *(LAS bf16*)(Lr + RKA_B + (j + 1) * RKA_RS_K) = (bf16)(tB[j >> 1] >> 16);
            *(LAS bf16*)(Lr + RKA_K + j * RKA_RS_K) = (bf16)(tK[j >> 1] & 0xffffu); *(LAS bf16*)(Lr + RKA_K + (j + 1) * RKA_RS_K) = (bf16)(tK[j >> 1] >> 16);
        }
        (void)pA; (void)pB; (void)pK; (void)pV;
        *(LAS v4u*)(Lt + RKA_AT) = (v4u){tA[0], tA[1], tA[2], tA[3]}; *(LAS v4u*)(Lt + RKA_BH) = (v4u){tB[0], tB[1], tB[2], tB[3]}; *(LAS v4u*)(Lt + RKA_KH) = (v4u){tK[0], tK[1], tK[2], tK[3]}; *(LAS v4u*)(Lt + RKA_VT) = (v4u){tV[0], tV[1], tV[2], tV[3]};
        Rc = Rn;
    }
    const float GC = G;
    *(GAS float*)((float*)rk_gc(ws, chunk >> 5) + (size_t)uh * 64 + lane) = GC;
    *(LAS float*)(L + RKA_GC + lane * 4) = GC;
    LDS_WAIT(); asm volatile("" ::: "memory");
    {
        rk_f32x16 aN = {}, aAK = {}, aRB = {}, aRK = {};
#pragma unroll
        for (int s = 0; s < 4; ++s) {
            const rk_bf16x8 fA = rk_frag(L + RKA_A, RKA_RS_K, r32, s, h), fR = rk_frag(L + RKA_R, RKA_RS_K, r32, s, h), fB = rk_frag(L + RKA_B, RKA_RS_K, r32, s, h), fK = rk_frag(L + RKA_K, RKA_RS_K, r32, s, h);
            aN = rk_mfma(fB, fA, aN); aAK = rk_mfma(fK, fA, aAK); aRB = rk_mfma(fB, fR, aRB); aRK = rk_mfma(fK, fR, aRK);
        }
        LDS_WAIT(); asm volatile("" ::: "memory");
#pragma unroll
        for (int i = 0; i < 16; ++i) { const int j = (i & 3) + 8 * (i >> 2) + 4 * h;
            if (!(j < r32)) { aN[i] = 0.f; aAK[i] = 0.f; }
            if (!(j <= r32)) { aRB[i] = 0.f; aRK[i] = 0.f; } }
#pragma unroll
        for (int g = 0; g < 4; ++g) *(LAS f32x4*)(L + RKA_N + r32 * 144 + (8 * g + 4 * h) * 4) = (f32x4){aN[4 * g], aN[4 * g + 1], aN[4 * g + 2], aN[4 * g + 3]};
        rk_store_tile_lds(L + RKA_MAK, RKA_RS_J, r32, 0, h, aAK); rk_store_tile_lds(L + RKA_MRB, RKA_RS_J, r32, 0, h, aRB); rk_store_tile_lds(L + RKA_MRK, RKA_RS_J, r32, 0, h, aRK);
        rk_store_tile_lds(L + RKA_T, RKA_RS_J, r32, 0, h, aN);
    }
    LDS_WAIT(); asm volatile("" ::: "memory");
    {
        const int blk = (r32 >> 4) & 1, cc = r32 & 15;
        const LAS unsigned char* Nb = L + RKA_N + (16 * blk) * 144 + (16 * blk) * 4;
        float T[16];
#pragma unroll
        for (int t = 0; t < 16; ++t) { float ac[4] = {(cc == t) ? 1.0f : 0.0f, 0.f, 0.f, 0.f};
#pragma unroll
            for (int j4 = 0; j4 < (t + 3) / 4; ++j4) { const f32x4 n4 = *(const LAS f32x4*)(Nb + t * 144 + j4 * 16);
#pragma unroll
                for (int e = 0; e < 4; ++e) if (4 * j4 + e < t) ac[e] += n4[e] * T[4 * j4 + e]; }
            T[t] = (ac[0] + ac[1]) + (ac[2] + ac[3]); }
        LDS_WAIT(); asm volatile("" ::: "memory");
#pragma unroll
        for (int t = 0; t < 16; ++t) *(LAS bf16*)(L + RKA_T + (16 * blk + t) * RKA_RS_J + r32 * 2) = (bf16)f2bf(T[t]);
        if (blk == 0) { LAS v4u* p = (LAS v4u*)(L + RKA_N + cc * RKA_RS_J);
            p[0] = (v4u){pk2(T[0], T[1]), pk2(T[2], T[3]), pk2(T[4], T[5]), pk2(T[6], T[7])}; p[1] = (v4u){pk2(T[8], T[9]), pk2(T[10], T[11]), pk2(T[12], T[13]), pk2(T[14], T[15])}; }
        LDS_WAIT(); asm volatile("" ::: "memory");
        rk_f32x16 xa = {};
        xa = rk_mfma(*(const LAS rk_bf16x8*)(L + RKA_T + (16 + r32) * RKA_RS_J + 16 * h), *(const LAS rk_bf16x8*)(L + RKA_N + r32 * RKA_RS_J + 16 * h), xa);
        if (r32 < 16) {
#pragma unroll
            for (int g = 0; g < 2; ++g) { v2u w; w.x = rk_pk(xa[4 * g], xa[4 * g + 1]); w.y = rk_pk(xa[4 * g + 2], xa[4 * g + 3]); *(LAS v2u*)(L + RKA_N + 1280 + r32 * RKA_RS_J + (8 * g + 4 * h) * 2) = w; } }
        LDS_WAIT(); asm volatile("" ::: "memory");
        rk_f32x16 ta = {};
        ta = rk_mfma(*(const LAS rk_bf16x8*)(L + RKA_N + 1280 + r32 * RKA_RS_J + 16 * h), *(const LAS rk_bf16x8*)(L + RKA_T + (16 + r32) * RKA_RS_J + (16 + 8 * h) * 2), ta);
        LDS_WAIT(); asm volatile("" ::: "memory");
        if (r32 < 16) {
#pragma unroll
            for (int g = 0; g < 2; ++g) { v2u w; w.x = rk_pk(ta[4 * g], ta[4 * g + 1]); w.y = rk_pk(ta[4 * g + 2], ta[4 * g + 3]); *(LAS v2u*)(L + RKA_T + (16 + r32) * RKA_RS_J + (8 * g + 4 * h) * 2) = w; } }
    }
    LDS_WAIT(); asm volatile("" ::: "memory");
    rk_bf16x8 fT[2];
#pragma unroll
    for (int s = 0; s < 2; ++s) fT[s] = rk_frag(L + RKA_T, RKA_RS_J, r32, s, h);
    {
        rk_f32x16 x0[2] = {{}, {}}, ap[2] = {{}, {}};
#pragma unroll
        for (int s = 0; s < 2; ++s) { const rk_bf16x8 fM = rk_frag(L + RKA_MAK, RKA_RS_J, r32, s, h);
#pragma unroll
            for (int nt = 0; nt < 2; ++nt) { x0[nt] = rk_mfma(fM, rk_frag(L + RKA_VT, RKA_RS_J, nt * 32 + r32, s, h), x0[nt]); ap[nt] = rk_mfma(fT[s], rk_frag(L + RKA_AT, RKA_RS_J, nt * 32 + r32, s, h), ap[nt]); } }
        LDS_WAIT(); asm volatile("" ::: "memory");
#pragma unroll
        for (int nt = 0; nt < 2; ++nt) { rk_store_tile_lds(L + RKA_X, RKA_RS_J, nt * 32 + r32, 0, h, x0[nt]); rk_store_tile_lds(L + RKA_AT, RKA_RS_J, nt * 32 + r32, 0, h, ap[nt]); }
    }
    LDS_WAIT(); asm volatile("" ::: "memory");
    {
        rk_f32x16 u0[2] = {{}, {}};
#pragma unroll
        for (int s = 0; s < 2; ++s)
#pragma unroll
            for (int nt = 0; nt < 2; ++nt) u0[nt] = rk_mfma(fT[s], rk_frag(L + RKA_X, RKA_RS_J, nt * 32 + r32, s, h), u0[nt]);
        LDS_WAIT(); asm volatile("" ::: "memory");
#pragma unroll
        for (int nt = 0; nt < 2; ++nt) rk_store_tile_lds(L + RKA_X, RKA_RS_J, nt * 32 + r32, 0, h, u0[nt]);
    }
    LDS_WAIT(); asm volatile("" ::: "memory");
    unsigned char* pq = rk_pq(ws, chunk >> 5) + (size_t)uh * 16384; unsigned char* ry = rk_ry(ws, chunk >> 5) + (size_t)uh * 8192;
    rk_bf16x8 fRB[2], fRK[2], fAp[2][2], fBh[2][2], fKh[2][2], fU[2][2], fV[2][2];
#pragma unroll
    for (int s = 0; s < 2; ++s) { fRB[s] = rk_frag(L + RKA_MRB, RKA_RS_J, r32, s, h); fRK[s] = rk_frag(L + RKA_MRK, RKA_RS_J, r32, s, h);
#pragma unroll
        for (int nt = 0; nt < 2; ++nt) { fAp[nt][s] = rk_frag(L + RKA_AT, RKA_RS_J, nt * 32 + r32, s, h); fBh[nt][s] = rk_frag(L + RKA_BH, RKA_RS_J, nt * 32 + r32, s, h);
            fKh[nt][s] = rk_frag(L + RKA_KH, RKA_RS_J, nt * 32 + r32, s, h); fU[nt][s] = rk_frag(L + RKA_X, RKA_RS_J, nt * 32 + r32, s, h); fV[nt][s] = rk_frag(L + RKA_VT, RKA_RS_J, nt * 32 + r32, s, h); } }
#pragma unroll
    for (int kt = 0; kt < 2; ++kt) {
        rk_f32x16 acc;
#pragma unroll
        for (int g = 0; g < 4; ++g) { const v2u w = *(const LAS v2u*)(L + RKA_R + r32 * RKA_RS_K + (kt * 32 + 8 * g + 4 * h) * 2); acc[4 * g] = bflo(w.x); acc[4 * g + 1] = bfhi(w.x); acc[4 * g + 2] = bflo(w.y); acc[4 * g + 3] = bfhi(w.y); }
#pragma unroll
        for (int s = 0; s < 2; ++s) acc = rk_mfma(fAp[kt][s], fRB[s], acc);
        rk_store_tile_frag(ry, 0, r32, kt, h, acc);
    }
#pragma unroll
    for (int kt = 0; kt < 2; ++kt)
#pragma unroll
        for (int kq = 0; kq < 2; ++kq) { rk_f32x16 acc = {};
#pragma unroll
            for (int s = 0; s < 2; ++s) acc = rk_mfma(fAp[kq][s], fBh[kt][s], acc);
            acc = acc * *(const LAS float*)(L + RKA_GC + (kt * 32 + r32) * 4);
            rk_store_tile_frag(pq, kt, r32, kq, h, acc); }
#pragma unroll
    for (int vt = 0; vt < 2; ++vt) {
        rk_f32x16 acc = {};
#pragma unroll
        for (int s = 0; s < 2; ++s) { acc = rk_mfma(fU[vt][s], fRB[s], acc); acc = rk_mfma(fV[vt][s], fRK[s], acc); }
        rk_store_blob((unsigned*)(ry + 4096) + vt * 512, lane, acc);
    }
#pragma unroll
    for (int kt = 0; kt < 2; ++kt)
#pragma unroll
        for (int vt = 0; vt < 2; ++vt) { rk_f32x16 acc = {};
#pragma unroll
            for (int s = 0; s < 2; ++s) { acc = rk_mfma(fBh[kt][s], fU[vt][s], acc); acc = rk_mfma(fKh[kt][s], fV[vt][s], acc); }
#pragma unroll
            for (int g = 0; g < 4; ++g) { const f32x4 gq = *(const LAS f32x4*)(L + RKA_GC + (kt * 32 + 8 * g + 4 * h) * 4); acc[4 * g] *= gq[0]; acc[4 * g + 1] *= gq[1]; acc[4 * g + 2] *= gq[2]; acc[4 * g + 3] *= gq[3]; }
            rk_store_blob((unsigned*)(pq + 8192) + (kt * 2 + vt) * 512, lane, acc); }
    LDS_WAIT(); asm volatile("" ::: "memory");
}
__device__ __forceinline__ void rwkvA_phase(Frame& F, const InTab& A, int half) {
    if (F.wave >= RKA_WAVES) return;
    LAS unsigned char* L = F.lds + RING_OFF + F.wave * RKA_BYTES;
    const int gw = F.bx * RKA_WAVES + F.wave, NGW = F.G * RKA_WAVES;
    for (int u = gw; u < 64 * 32; u += NGW) rwkvA_unit(L, A, F.ws, u >> 5, half * 32 + (u & 31), F.lane);
}
__device__ __forceinline__ void rwkvA_queue(Frame& F, const InTab& A, int half, unsigned* counter) {
    if (F.wave >= RKA_WAVES) return;
    LAS unsigned char* L = F.lds + RING_OFF + F.wave * RKA_BYTES;
    for (;;) {
        unsigned u = 0; if (F.lane == 0) u = __hip_atomic_fetch_add(counter, 1u, __ATOMIC_RELAXED, __HIP_MEMORY_SCOPE_AGENT);
        u = __builtin_amdgcn_readfirstlane(u);
        if (u >= 64u * 32u) break;
        rwkvA_unit(L, A, F.ws, (int)(u >> 5), half * 32 + (int)(u & 31), F.lane);
    }
}
constexpr int RKB_RS = 144, RKB_SBUF = 64 * RKB_RS;
__device__ __forceinline__ void rwkvB_phase(Frame& F, int bh, int half) {
    int lane = F.lane; asm volatile("" : "+v"(lane));
    const int wave = F.wave, r32 = lane & 31, h = lane >> 5;
    LAS unsigned char* SB = F.lds + RING_OFF;
    unsigned char* ws = F.ws;
    const int b = bh >> 3, hd = bh & 7;
    bf16* Y = (bf16*)(ws + WS_Y);
    const int kt = (wave >> 1) & 1, vt = wave & 1;
    float* sst = (float*)(ws + WS_SST) + (size_t)bh * 4096 + (size_t)(wave & 3) * 1024;
    rk_f32x16 st = {};
    if (wave < 4) {
        if (half != 0) {
#pragma unroll
            for (int i = 0; i < 16; ++i) st[i] = *(const GAS float*)(sst + i * 64 + lane);
        }
        rk_store_tile_lds(SB, RKB_RS, vt * 32 + r32, kt * 32, h, st);
    }
    const int uh0 = bh * 32; const bool isS = wave < 4, isY = !isS && wave < 6;
    const unsigned char* fptr = isS ? rk_pq(ws, half) + (size_t)uh0 * 16384 + (kt * 256 + lane) * 16 : rk_ry(ws, half) + (size_t)uh0 * 8192 + lane * 16;
    const unsigned char* bptr = isS ? rk_pq(ws, half) + (size_t)uh0 * 16384 + 8192 + (kt * 2 + vt) * 2048 + lane * 32 : rk_ry(ws, half) + (size_t)uh0 * 8192 + 4096 + vt * 2048 + lane * 32;
    const LAS unsigned char* gl = SB + 2 * RKB_SBUF + (kt * 32 + 4 * h) * 4;
    const int fstride = isS ? 16384 : 8192;
    struct Op { v4u f[4]; v4u b0, b1; };
    { const int tid_ = wave * 64 + lane; *(LAS f32x4*)(SB + 2 * RKB_SBUF + tid_ * 16) = *(const GAS f32x4*)(rk_gc(ws, half) + (size_t)uh0 * 256 + tid_ * 16); }
    Op o0, o1, o2;
#define RKB_LOAD(O_, c) do { const unsigned char* fp_ = fptr + (size_t)(c) * fstride; const unsigned char* bp_ = bptr + (size_t)(c) * fstride; \
        _Pragma("unroll") for (int s = 0; s < 4; ++s) O_.f[s] = *(const GAS v4u*)(fp_ + 1024 * s); \
        O_.b0 = *(const GAS v4u*)bp_; O_.b1 = *(const GAS v4u*)(bp_ + 16); } while (0)
#define RKB_BAR() do { asm volatile("s_waitcnt lgkmcnt(0)" ::: "memory"); __builtin_amdgcn_s_barrier(); asm volatile("" ::: "memory"); } while (0)
#define RKB_NEXT(O_, c, AH_) RKB_LOAD(O_, ((c) + (AH_) < 32 ? (c) + (AH_) : 31))
#define RKB_STEP_S(O_, c) do { \
        const LAS unsigned char* cur = SB + ((c) & 1) * RKB_SBUF; LAS unsigned char* nxt = SB + (((c) & 1) ^ 1) * RKB_SBUF; \
        rk_bf16x8 fS[4]; _Pragma("unroll") for (int s = 0; s < 4; ++s) fS[s] = rk_frag(cur, RKB_RS, vt * 32 + r32, s, h); \
        RkBlob bb_; bb_.w0 = O_.b0; bb_.w1 = O_.b1; const rk_f32x16 q = rk_blob_f32(bb_); \
        _Pragma("unroll") for (int g = 0; g < 4; ++g) { const f32x4 gq = *(const LAS f32x4*)(gl + (c) * 256 + 32 * g); \
            st[4 * g] = st[4 * g] * gq[0] + q[4 * g]; st[4 * g + 1] = st[4 * g + 1] * gq[1] + q[4 * g + 1]; st[4 * g + 2] = st[4 * g + 2] * gq[2] + q[4 * g + 2]; st[4 * g + 3] = st[4 * g + 3] * gq[3] + q[4 * g + 3]; } \
        _Pragma("unroll") for (int s = 0; s < 4; ++s) st = rk_mfma(__builtin_bit_cast(rk_bf16x8, O_.f[s]), fS[s], st); \
        RKB_NEXT(O_, c, 5); \
        rk_store_tile_lds(nxt, RKB_RS, vt * 32 + r32, kt * 32, h, st); \
        RKB_BAR(); } while (0)
#define RKB_STEP_Y(O_, c) do { \
        const LAS unsigned char* cur = SB + ((c) & 1) * RKB_SBUF; \
        rk_bf16x8 fS[4]; _Pragma("unroll") for (int s = 0; s < 4; ++s) fS[s] = rk_frag(cur, RKB_RS, vt * 32 + r32, s, h); \
        RkBlob bb_; bb_.w0 = O_.b0; bb_.w1 = O_.b1; rk_f32x16 acc = rk_blob_f32(bb_); \
        _Pragma("unroll") for (int s = 0; s < 4; ++s) acc = rk_mfma(fS[s], __builtin_bit_cast(rk_bf16x8, O_.f[s]), acc);       \
        RKB_NEXT(O_, c, 3); \
        rk_store_tile_glb(Y + ((size_t)b * SEQ + (size_t)(half * 32 + (c)) * 32) * 512 + hd * 64, 512, r32, vt * 32, h, acc); \
        RKB_BAR(); } while (0)
    if (isY) { RKB_LOAD(o0, 0); RKB_LOAD(o1, 1); RKB_LOAD(o2, 2); }
    __syncthreads();
    if (isS) {
        Op o3, o4; RKB_LOAD(o0, 0); RKB_LOAD(o1, 1); RKB_LOAD(o2, 2); RKB_LOAD(o3, 3); RKB_LOAD(o4, 4);
#define R5S(c) RKB_STEP_S(o0, c); RKB_STEP_S(o1, (c) + 1); RKB_STEP_S(o2, (c) + 2); RKB_STEP_S(o3, (c) + 3); RKB_STEP_S(o4, (c) + 4);
        R5S(0) R5S(5) R5S(10) R5S(15) R5S(20) R5S(25)
        RKB_STEP_S(o0, 30); RKB_STEP_S(o1, 31);
#undef R5S
    } else if (isY) {
#define R3Y(c) RKB_STEP_Y(o0, c); RKB_STEP_Y(o1, (c) + 1); RKB_STEP_Y(o2, (c) + 2);
        R3Y(0) R3Y(3) R3Y(6) R3Y(9) R3Y(12) R3Y(15) R3Y(18) R3Y(21) R3Y(24) R3Y(27)
        RKB_STEP_Y(o0, 30); RKB_STEP_Y(o1, 31);
#undef R3Y
    } else {
#pragma unroll 1
        for (int c = 0; c < 32; ++c) RKB_BAR();
    }
#undef RKB_STEP_S
#undef RKB_STEP_Y
#undef RKB_NEXT
#undef RKB_BAR
#undef RKB_LOAD
    if (wave < 4 && half == 0) {
#pragma unroll
        for (int i = 0; i < 16; ++i) *(GAS float*)(sst + i * 64 + lane) = st[i];
    }
}

constexpr int NPHASE = 9;
template <int PHM> __global__ void __launch_bounds__(NWAVES * 64, 2) fwd_kernel(Args args) {
    extern __shared__ __attribute__((aligned(16))) unsigned char lds[];
    namespace cg = cooperative_groups;
    Frame F;
    F.lds = (LAS unsigned char*)lds;
    F.tid = threadIdx.x; F.lane = F.tid & 63; F.wave = __builtin_amdgcn_readfirstlane(F.tid >> 6);
    F.G = gridDim.x; F.bx = blockIdx.x;
    F.out = args.out; F.ws = args.ws;
#define PH_BEGIN InTab TAB; { ktab_t kp_ = (ktab_t)__builtin_amdgcn_kernarg_segment_ptr(); asm volatile("" : "+s"(kp_)); TAB.p = kp_; } { int t_ = threadIdx.x; asm volatile("" : "+v"(t_)); F.tid = t_; F.lane = t_ & 63; F.wave = __builtin_amdgcn_readfirstlane(t_ >> 6); } GAS unsigned char* wsg_ = (GAS unsigned char*)args.ws; asm volatile("" : "+s"(wsg_)); unsigned char* ws = (unsigned char*)wsg_; F.ws = ws; GAS bf16_t* gtg_ = (GAS bf16_t*)args.out; asm volatile("" : "+s"(gtg_)); bf16_t* GATES = (bf16_t*)gtg_; F.out = (float*)GATES; (void)GATES;
    const int lo = args.ph_lo, hi = args.ph_hi;
    XcdBarrier bar; bar.bar = nullptr; bar.x = 0; bar.st = nullptr;
    if (hi - lo > 1) {
        for (int u = threadIdx.x; u < (LDS_BYTES - 162816) / 4; u += NWAVES * 64) ((LAS unsigned*)(F.lds + 162816))[u] = 0u;
        { GAS v4u* z_ = (GAS v4u*)(args.ws + WS_CTL) + (size_t)blockIdx.x * (CTL_ZERO_BYTES / 16 / 256); for (int u = threadIdx.x; u < (int)(CTL_ZERO_BYTES / 16 / 256); u += NWAVES * 64) z_[u] = (v4u){0u, 0u, 0u, 0u}; }
        asm volatile("s_waitcnt vmcnt(0)" ::: "memory");
        __syncthreads();
        cg::this_grid().sync();
        bar = xcd_barrier_post((unsigned*)(args.ws + WS_CTL) + CW_BAR, (volatile LAS unsigned*)(F.lds + MISC_OFF) + 8);
    }
#define IN(k) (((PHM >> (k)) & 1) && lo <= (k) && (k) < hi)
#ifdef PROBE_DUP
#define REPS(k) (((k) == PROBE_DUP) ? 2 : 1)
#else
#define REPS(k) 1
#endif
#define SEAM(k) do { if (IN(k) && IN((k) + 1)) { xcd_barrier(bar); } } while (0)
    using pg8::Gemm; using pg8::StaticOrder; using pg8::EpiRow8; using pg8::bf16_t;

    if (IN(0)) for (int rep_ = 0; rep_ < REPS(0); ++rep_) { if (rep_) xcd_barrier(bar); PH_BEGIN p0_prologue(F, TAB); } SEAM(0);
    if (IN(1)) for (int rep_ = 0; rep_ < REPS(1); ++rep_) { if (rep_) xcd_barrier(bar); PH_BEGIN
        Gemm g{(const bf16_t*)(ws + WS_XN), (const bf16_t*)(ws + WS_WIN), M, D_IN - 256, D}; StaticOrder S; S.init(M, D_IN - 256, F.G, F.bx);
        EpiRow8<pg8::FProj> E{{ws, GATES}};
        pg8::gemm_phase<EpiRow8<pg8::FProj>, StaticOrder, PG8_ALIGN, PG8_SP2>(F.lds + RING_OFF, g, S, E);
    } SEAM(1);
    if (IN(2)) { PH_BEGIN
        constexpr int NLW = 64;
#ifndef PROBE_ATTN_ONLY
        if (F.bx >= F.G - NLW) {
            const int pm = F.bx - (F.G - NLW);
            prep1_rows(F, TAB, pm * 32, pm * 32 + 32, F.wave, NWAVES);
            asm volatile("s_waitcnt vmcnt(0)" ::: "memory"); __syncthreads();
            if (threadIdx.x == 0) { __builtin_amdgcn_fence(__ATOMIC_ACQUIRE, "agent"); asm volatile("s_waitcnt vmcnt(0)" ::: "memory"); }
            __syncthreads();
            int klora = KLORA; asm volatile("" : "+s"(klora));
            Gemm g{(const bf16_t*)(ws + WS_LIN), (const bf16_t*)(ws + WS_WL) + (size_t)1024 * KLORA, M, 512, klora}; pg8::PanelOrder S{pm, 2};
            EpiRow8<pg8::FLoraG> E{{ws}};
            pg8::gemm_phase<EpiRow8<pg8::FLoraG>, pg8::PanelOrder, PG8_ALIGN, PG8_SP2>(F.lds + RING_OFF, g, S, E);
            __syncthreads();
            {
                Gemm g2{(const bf16_t*)(ws + WS_XN), (const bf16_t*)(ws + WS_WIN) + (size_t)(D_IN - 256) * D, M, 256, D}; pg8::PanelOrder S2{pm, 1};
                EpiRow8<pg8::FProjOff> E2{{{ws, GATES}, (D_IN - 256) / 256}};
                pg8::gemm_phase<EpiRow8<pg8::FProjOff>, pg8::PanelOrder, PG8_ALIGN, PG8_SP2>(F.lds + RING_OFF, g2, S2, E2);
                __syncthreads();
            }
        }
#endif
        const attn_body::AttnTensors AT{(const attn_body::bf16*)(ws + WS_Q), (const attn_body::bf16*)(ws + WS_K), (const attn_body::bf16*)(ws + WS_V), (attn_body::bf16*)(ws + WS_O)};
        attn_body::attn_phase_queue128<8>((char*)lds + RING_OFF, AT, (unsigned*)(ws + WS_CTL + CTL_ATTQ), (volatile LAS unsigned*)(F.lds + MISC_OFF) + 24);
    } SEAM(2);
    if (IN(3)) { PH_BEGIN
        { GAS unsigned char* w_ = (GAS unsigned char*)args.ws; asm volatile("" : "+s"(w_)); F.ws = (unsigned char*)w_; }
        rwkvA_phase(F, TAB, 0);
        xcd_barrier(bar);
        { GAS unsigned char* w_ = (GAS unsigned char*)args.ws; asm volatile("" : "+s"(w_)); F.ws = (unsigned char*)w_; }
        if (F.bx < 64) rwkvB_phase(F, F.bx, 0); else { late_weights(F, TAB, 0, 2, 64); late_weights(F, TAB, 1, 2, 64); }
        __syncthreads();
        { GAS unsigned char* w_ = (GAS unsigned char*)args.ws; asm volatile("" : "+s"(w_)); F.ws = (unsigned char*)w_; }
        rwkvA_queue(F, TAB, 1, (unsigned*)(F.ws + WS_CTL + CTL_RKAQ));
        xcd_barrier(bar);
        { GAS unsigned char* w_ = (GAS unsigned char*)args.ws; asm volatile("" : "+s"(w_)); F.ws = (unsigned char*)w_; }
        if (F.bx < 64) rwkvB_phase(F, F.bx, 1);
    } SEAM(3);
    if (IN(4)) for (int rep_ = 0; rep_ < REPS(4); ++rep_) { if (rep_) xcd_barrier(bar); PH_BEGIN post_phase(F, TAB); } SEAM(4);
    if (IN(5)) for (int rep_ = 0; rep_ < REPS(5); ++rep_) { if (rep_) xcd_barrier(bar); PH_BEGIN
        Gemm g{(const bf16_t*)(ws + WS_YA), (const bf16_t*)(ws + WS_WA), M, D, 1024}; StaticOrder S; S.init(M, D, F.G, F.bx);
        pg8::EpiMerge E{GATES, (bf16_t*)(ws + WS_MERGED)};
        pg8::gemm_phase<pg8::EpiMerge, StaticOrder, PG8_ALIGN, PG8_SP2>(F.lds + RING_OFF, g, S, E);
    } SEAM(5);
    if (IN(6)) for (int rep_ = 0; rep_ < REPS(6); ++rep_) { if (rep_) xcd_barrier(bar); PH_BEGIN
        Gemm g{(const bf16_t*)(ws + WS_MERGED), (const bf16_t*)(ws + WS_WO), M, D, D}; StaticOrder S; S.init(M, D, F.G, F.bx);
        pg8::EpiResNorm<0> E{TAB[I_X], F.out, (bf16_t*)(ws + WS_XN), TAB[I_NFG], (float*)(ws + WS_CTL + CTL_SS1), (unsigned*)(ws + WS_CTL + CTL_CNT1), NORM_EPS, (bf16_t*)(ws + WS_X1B)};
        pg8::gemm_phase<pg8::EpiResNorm<0>, StaticOrder, PG8_ALIGN, PG8_SP2>(F.lds + RING_OFF, g, S, E);
    } SEAM(6);
    if (IN(7)) for (int rep_ = 0; rep_ < REPS(7); ++rep_) { if (rep_) xcd_barrier(bar); PH_BEGIN
        Gemm g{(const bf16_t*)(ws + WS_XN), (const bf16_t*)(ws + WS_W1), M, FF, D}; StaticOrder S; S.init(M, FF, F.G, F.bx);
        EpiRow8<pg8::FRelu2> E{{(bf16_t*)(ws + WS_H)}};
        pg8::gemm_phase<EpiRow8<pg8::FRelu2>, StaticOrder, PG8_ALIGN, PG8_SP2>(F.lds + RING_OFF, g, S, E);
    } SEAM(7);
    if (IN(8)) for (int rep_ = 0; rep_ < REPS(8); ++rep_) { if (rep_) xcd_barrier(bar); PH_BEGIN
        Gemm g{(const bf16_t*)(ws + WS_H), (const bf16_t*)(ws + WS_W2), M, D, FF}; StaticOrder S; S.init(M, D, F.G, F.bx);
        pg8::EpiResNorm<1> E{nullptr, F.out, nullptr, TAB[I_NFIN], (float*)(ws + WS_CTL + CTL_SS2), (unsigned*)(ws + WS_CTL + CTL_CNT2), NORM_EPS, (bf16_t*)(ws + WS_X1B)};
        pg8::gemm_phase<pg8::EpiResNorm<1>, StaticOrder, PG8_ALIGN, PG8_SP2>(F.lds + RING_OFF, g, S, E);
    }
#undef IN
#undef SEAM
#undef PH_BEGIN
}


#ifdef DBG_DUMP
__global__ void dbg_dump(float* out, const unsigned char* ws) {
    const size_t i = (size_t)blockIdx.x * blockDim.x + threadIdx.x; if (i >= (size_t)M * 1024) return;
    const size_t m = i >> 10; const int c = (int)(i & 1023); float v = 0.f;
#if DBG_DUMP == 1
    v = bf1(((const bf16*)(ws + WS_O))[m * 1024 + c]);
#elif DBG_DUMP == 2
    v = c < 512 ? bf1(((const bf16*)(ws + WS_Y))[m * 512 + c]) : (c < 520 ? ((const float*)(ws + WS_BON))[m * 8 + (c - 512)] : 0.f);
#elif DBG_DUMP == 3
    v = c < 512 ? bf1(((const bf16*)(ws + WS_Q))[m * 512 + c]) : bf1(((const bf16*)(ws + WS_K))[m * 512 + c - 512]);
#elif DBG_DUMP == 4
    v = c < 512 ? ((const float*)(ws + WS_DEC))[m * 512 + c] : bf1(((const bf16*)(ws + WS_AA))[m * 512 + c - 512]);
#elif DBG_DUMP == 6
    v = c < 256 ? bf1(((const bf16*)(ws + WS_WAG))[m * 256 + c]) : (c < 512 ? bf1(((const bf16*)(ws + WS_LIN))[m * 256 + c - 256]) : 0.f);
#elif DBG_DUMP == 7
    { const bf16* wl = (const bf16*)(ws + WS_WL); const size_t j = (m * 1024 + c); v = j < (size_t)NLORA * KLORA ? bf1(wl[j]) : 0.f; }
#elif DBG_DUMP == 8
    v = c < 512 ? bf1(((const bf16*)(ws + WS_GG))[m * 512 + c]) : 0.f;
#elif DBG_DUMP == 5
    v = bf1(((const bf16*)(ws + WS_RKV))[m * 1536 + c]);
#endif
    out[i] = v;
}
#endif

#ifdef DBG_FIXLORA
__global__ void dbg_fixlora(Args A) {
    const size_t i = (size_t)blockIdx.x * blockDim.x + threadIdx.x; if (i >= (size_t)M * 512) return;
    const size_t m = i >> 9; const int c = (int)(i & 511);
    const bf16* LINr = (const bf16*)(A.ws + WS_LIN) + m * 256;
#if DBG_FIXLORA & 1
    { float g = 0.f; for (int k = 0; k < 128; ++k) g += bf1(LINr[128 + k]) * A[I_G2][(size_t)k * 512 + c]; ((bf16*)(A.ws + WS_GG))[m * 512 + c] = (bf16)f2bf(g); }
#endif
#if DBG_FIXLORA & 2
    { float s = A[I_A0][c]; for (int k = 0; k < 64; ++k) s += bf1(LINr[64 + k]) * A[I_A2][(size_t)k * 512 + c]; ((bf16*)(A.ws + WS_AA))[m * 512 + c] = (bf16)f2bf(1.0f / (1.0f + expf(-s))); }
#endif
#if DBG_FIXLORA & 4
    { float s = A[I_W0][c]; for (int k = 0; k < 64; ++k) s += bf1(LINr[k]) * A[I_W2][(size_t)k * 512 + c]; const float w = -log1pf(expf(-s)) - 0.5f; ((float*)(A.ws + WS_DEC))[m * 512 + c] = expf(-expf(w)); }
#endif
}
#endif
#ifndef MK_ONE_LAUNCH
#define MK_ONE_LAUNCH 0
#endif
#ifndef MK_MASK
#define MK_MASK ((1 << NPHASE) - 1)
#endif
typedef void (*kern_t)(Args);
template <int P> struct KTab { static void fill(kern_t* t) { t[P] = fwd_kernel<(1 << P)>; KTab<P - 1>::fill(t); } };
template <> struct KTab<-1> { static void fill(kern_t*) {} };
extern "C" void kernel_launch(void* const* d_in, const int* in_sizes, int n_in, void* d_out, int out_size, void* d_ws, size_t ws_size, hipStream_t stream) {
    static int grid = 0; static kern_t ktab[NPHASE];
    if (grid == 0) {
        if (n_in != 26 || in_sizes[0] != M * D || out_size != M * D || ws_size < WS_END) { fprintf(stderr, "kernel_launch: unexpected shapes (n_in %d, in0 %d, out %d, ws %zu); nothing launched\n", n_in, n_in > 0 ? in_sizes[0] : -1, out_size, ws_size); grid = -1; return; }
        int dev = 0, cus = 0;
        if (hipGetDevice(&dev) != hipSuccess || hipDeviceGetAttribute(&cus, hipDeviceAttributeMultiprocessorCount, dev) != hipSuccess) { grid = -1; return; }
#if MK_ONE_LAUNCH
        int per_cu = 0;
        if (hipFuncSetAttribute((const void*)fwd_kernel<MK_MASK>, hipFuncAttributeMaxDynamicSharedMemorySize, LDS_BYTES) != hipSuccess) { fprintf(stderr, "kernel_launch: hipFuncSetAttribute failed\n"); grid = -1; return; }
        if (hipOccupancyMaxActiveBlocksPerMultiprocessor(&per_cu, (const void*)fwd_kernel<MK_MASK>, NWAVES * 64, LDS_BYTES) != hipSuccess || per_cu < 1) { fprintf(stderr, "kernel_launch: occupancy query says %d blocks per CU\n", per_cu); (void)hipGetLastError(); grid = -1; return; }
#else
        KTab<NPHASE - 1>::fill(ktab);
        for (int p = 0; p < NPHASE; ++p) if (hipFuncSetAttribute((const void*)ktab[p], hipFuncAttributeMaxDynamicSharedMemorySize, LDS_BYTES) != hipSuccess) { fprintf(stderr, "kernel_launch: hipFuncSetAttribute failed\n"); grid = -1; return; }
#endif
        grid = cus;
        if (grid != 256) fprintf(stderr, "kernel_launch: note: %d CUs (built for 256)\n", grid);
    }
    if (grid < 0) return;
    Args a{};
    for (int i = 0; i < 26; ++i) a.in[i] = (const float*)d_in[i];
    a.out = (float*)d_out; a.ws = (unsigned char*)d_ws;
#if MK_ONE_LAUNCH
    a.ph_lo = 0; a.ph_hi = NPHASE;
    void* kargs[] = {&a};
    hipError_t e = hipLaunchCooperativeKernel((const void*)fwd_kernel<MK_MASK>, dim3(grid), dim3(NWAVES * 64), kargs, LDS_BYTES, stream);
    if (e != hipSuccess) fprintf(stderr, "kernel_launch: cooperative launch failed: %s\n", hipGetErrorString(e));
#else
#ifdef DBG_DUMP
    for (int p = 0; p <= DBG_STOP; ++p) { a.ph_lo = p; a.ph_hi = p + 1; hipLaunchKernelGGL(ktab[p], dim3(grid), dim3(NWAVES * 64), LDS_BYTES, stream, a); }
    hipLaunchKernelGGL(dbg_dump, dim3((M * 1024) / 256), dim3(256), 0, stream, (float*)d_out, (const unsigned char*)d_ws);
#else
    for (int p = 0; p < NPHASE; ++p) { a.ph_lo = p; a.ph_hi = p + 1; hipLaunchKernelGGL(ktab[p], dim3(grid), dim3(NWAVES * 64), LDS_BYTES, stream, a);
#ifdef DBG_FIXLORA
        if (p == 3) hipLaunchKernelGGL(dbg_fixlora, dim3((M * 512) / 256), dim3(256), 0, stream, a);
#endif
    }
#endif
#endif
}
```

```cpp
#define MK_ONE_LAUNCH 1
#include <hip/hip_runtime.h>
#include <cstdio>
#include <cstdint>
constexpr int NWAVES = 8;
constexpr int BATCH = 8, SEQ = 2048, D = 1024, M = BATCH * SEQ;
constexpr int D_IN = 5376, FF = 4096, RWW = 512, NLORA = 1536, KLORA = 256;
constexpr float NORM_EPS = 1e-6f, SUBLN_EPS = 1e-5f, GN_EPS = 64e-5f, LAMBDA_INIT = 0.2f;
constexpr size_t MiB = 1u << 20;
constexpr size_t WS_CTL = 0, CTL_ZERO_BYTES = 256 * 1024;
constexpr size_t CTL_SS1 = 65536, CTL_SS2 = 131072, CTL_CNT1 = 196608, CTL_CNT2 = 212992, CTL_ATTQ = 229376, CTL_RKAQ = 229380;
constexpr size_t WS_ROPE_C = 512 * 1024, WS_ROPE_S = 768 * 1024;
constexpr size_t WS_BON = 1 * MiB;
constexpr size_t WS_WIN = 2 * MiB;
constexpr size_t WS_WA = WS_WIN + (size_t)D_IN * D * 2;
constexpr size_t WS_WB = WS_WA + 1 * MiB;
constexpr size_t WS_WO = WS_WB + 1 * MiB;
constexpr size_t WS_W1 = WS_WO + 2 * MiB;
constexpr size_t WS_W2 = WS_W1 + 8 * MiB;
constexpr size_t WS_WL = WS_W2 + 8 * MiB;
static_assert(WS_WL + (size_t)NLORA * KLORA * 2 <= 34 * MiB, "weights");
constexpr size_t WS_XN = 34 * MiB;
constexpr size_t WS_DEC = WS_XN;
constexpr size_t WS_Q = 66 * MiB, WS_K = 82 * MiB, WS_V = 98 * MiB;
constexpr size_t WS_RKV = 114 * MiB;
constexpr size_t WS_WAG = 162 * MiB, WS_LIN = 242 * MiB;
constexpr size_t WS_Y = 162 * MiB;
constexpr size_t WS_AA = 178 * MiB, WS_GG = 194 * MiB;
constexpr size_t WS_O = 210 * MiB;
constexpr size_t WS_YA = 210 * MiB;
constexpr size_t WS_TMP = 114 * MiB;
constexpr size_t WS_MERGED = 114 * MiB;
constexpr size_t WS_X1B = 194 * MiB;
constexpr size_t WS_H = 66 * MiB;
constexpr size_t WS_END = 252 * MiB;
constexpr int RING_OFF = 0, RING_BYTES = 131072;
constexpr int LDS_BYTES = 163840;

#include <hip/hip_runtime.h>
#include <cstdio>
#include <cstdint>
namespace pg8 {
#define PG8_LAS __attribute__((address_space(3)))
typedef unsigned short bf16_t;
typedef short bf16x8 __attribute__((ext_vector_type(8)));
typedef float f32x4 __attribute__((ext_vector_type(4)));
typedef unsigned u32x4 __attribute__((ext_vector_type(4)));
constexpr int BM = 256, BK = 64, HALF = 128, HTB = HALF * BK * 2  , STAGE_BYTES = 8 * HTB, NXCD = 8, WGM = 8;

__host__ __device__ __forceinline__ int lds_byte(int r, int c) { const int st = (r >> 4) * 2 + (c >> 5), rr = r & 15, cc = c & 31, ob = rr * 64 + cc * 2; return st * 1024 + (ob ^ (((ob >> 9) & 1) << 5)); }
__host__ __device__ __forceinline__ void stage_rc(int b, int& R, int& C) { const int st = b / 1024, sb = b % 1024, swz = sb ^ (((sb >> 9) & 1) << 5); R = (st >> 1) * 16 + swz / 64; C = (st & 1) * 32 + (swz % 64) / 2; }
__host__ __device__ __forceinline__ int perm32(int rho) { const int n = rho >> 4, i = rho & 15; return 8 * (i >> 2) + 4 * n + (i & 3); }

struct Unit { int pm, pn; };
struct Gemm { const bf16_t* A; const bf16_t* Bt; int M, N, K; };

struct StaticOrder {
    int nM, nN, nwg, G, c;
    __host__ __device__ void init(int M, int N, int G_, int c_) { nM = M / BM; nN = N / BM; nwg = nM * nN; G = G_; c = c_; }
    __host__ __device__ bool next(int i, Unit& u) const {
        const long L = (long)i * G + c; if (L >= nwg) return false;
        int wgid = (int)L; { const int q = nwg / NXCD, r = nwg % NXCD, xcd = wgid % NXCD, off = wgid / NXCD; wgid = (xcd < r ? xcd * (q + 1) : r * (q + 1) + (xcd - r) * q) + off; }
        const int nig = WGM * nN, gid = wgid / nig, fm = gid * WGM, gsz = (nM - fm) < WGM ? (nM - fm) : WGM;
        u.pm = fm + ((wgid % nig) % gsz); u.pn = (wgid % nig) / gsz; return true;
    }
    __device__ __forceinline__ void a_ready(const Unit&) const {}
    __device__ __forceinline__ void done(const Unit&) const {}
};

typedef float f32x2c_t __attribute__((ext_vector_type(2))); typedef __bf16 bf16x2c_t __attribute__((ext_vector_type(2)));
__device__ __forceinline__ unsigned cvt_pk_bf16(float lo, float hi) { f32x2c_t v = {lo, hi}; bf16x2c_t b = __builtin_convertvector(v, bf16x2c_t); return __builtin_bit_cast(unsigned, b); }
typedef float f32x2 __attribute__((ext_vector_type(2)));
__device__ __forceinline__ f32x2 gelu_pk(f32x2 v) {
    const f32x2 av = __builtin_elementwise_abs(v), d = av * 0.2316418882f + 1.0f;
    f32x2 t; t.x = __builtin_amdgcn_rcpf(d.x); t.y = __builtin_amdgcn_rcpf(d.y);
    f32x2 q = t * 0.5307027145f + (-0.7265760135f); q = q * t + 0.7107068705f; q = q * t + (-0.142248368f); q = q * t + 0.127414796f; q = q * t;
    const f32x2 s = (v * v) * (-0.72134752044f);
    f32x2 e; e.x = __builtin_amdgcn_exp2f(s.x); e.y = __builtin_amdgcn_exp2f(s.y);
    const f32x2 m = v * (q * e), r = v - m;
    f32x2 o; o.x = v.x < 0.f ? m.x : r.x; o.y = v.y < 0.f ? m.y : r.y; return o;
}

template <int ACT  > struct EpiBf16 {
    static constexpr int MIDK = 0; static constexpr bool PERM = true, AFTER_DRAIN = false; static_assert(ACT == 0 || ACT == 1, "EpiBf16: ACT is 0 (none) or 1 (gelu_pk)");
    bf16_t* O; int ldc; const float* bias; int split_cols; size_t split_stride; float scale0;
    __device__ __forceinline__ void operator()(const f32x4 (&acc)[2][2][4][2], const Unit& u, int wr, int wc, int fr, int fq) const {
        const int row0 = u.pm * BM + wr * 64 + fr; int colt = u.pn * BM; bf16_t* base = O;
        float sc = 1.f; if (split_cols) { const int t = colt / split_cols; base += (size_t)t * split_stride; colt -= t * split_cols; if (t == 0) sc = scale0; }
        const int col0 = colt + wc * 32 + 8 * fq, bcol0 = u.pn * BM + wc * 32 + 8 * fq;
        f32x4 bv[2][2];
#pragma unroll
        for (int bj = 0; bj < 2; ++bj)
#pragma unroll
            for (int n = 0; n < 2; ++n) bv[bj][n] = bias ? *(const f32x4*)(bias + bcol0 + bj * HALF + 4 * n) : (f32x4){0.f, 0.f, 0.f, 0.f};
#pragma unroll
        for (int ai = 0; ai < 2; ++ai)
#pragma unroll
            for (int m = 0; m < 4; ++m) { bf16_t* rowp = base + (size_t)(row0 + ai * HALF + m * 16) * ldc + col0;
#pragma unroll
                for (int bj = 0; bj < 2; ++bj) { f32x4 v0 = acc[ai][bj][m][0] + bv[bj][0], v1 = acc[ai][bj][m][1] + bv[bj][1];
                    if (ACT == 1) { f32x2 a = gelu_pk((f32x2){v0[0], v0[1]}), b = gelu_pk((f32x2){v0[2], v0[3]}), c = gelu_pk((f32x2){v1[0], v1[1]}), d = gelu_pk((f32x2){v1[2], v1[3]});
                        v0 = (f32x4){a.x, a.y, b.x, b.y}; v1 = (f32x4){c.x, c.y, d.x, d.y}; }
                    v0 = v0 * sc; v1 = v1 * sc; u32x4 w; w.x = cvt_pk_bf16(v0[0], v0[1]); w.y = cvt_pk_bf16(v0[2], v0[3]); w.z = cvt_pk_bf16(v1[0], v1[1]); w.w = cvt_pk_bf16(v1[2], v1[3]);
                    *(u32x4*)(rowp + bj * HALF) = w; } }
    }
};
typedef unsigned u32x2 __attribute__((ext_vector_type(2)));
__device__ __forceinline__ float bf_lo(unsigned w) { return __builtin_bit_cast(float, w << 16); }
__device__ __forceinline__ float bf_hi(unsigned w) { return __builtin_bit_cast(float, w & 0xffff0000u); }
__device__ __forceinline__ u32x4 pack8(f32x4 v0, f32x4 v1) { u32x4 w; w.x = cvt_pk_bf16(v0[0], v0[1]); w.y = cvt_pk_bf16(v0[2], v0[3]); w.z = cvt_pk_bf16(v1[0], v1[1]); w.w = cvt_pk_bf16(v1[2], v1[3]); return w; }
__device__ __forceinline__ float sigmoidf_(float x) { return __builtin_amdgcn_rcpf(1.0f + __expf(-x)); }
template <class F> struct EpiRow8 {
    static constexpr int MIDK = 0; static constexpr bool PERM = true, AFTER_DRAIN = false;
    F f;
    __device__ __forceinline__ void operator()(const f32x4 (&acc)[2][2][4][2], const Unit& u, int wr, int wc, int fr, int fq) const {
        const int row0 = u.pm * BM + wr * 64 + fr, c0 = wc * 32 + 8 * fq;
#pragma unroll
        for (int ai = 0; ai < 2; ++ai)
#pragma unroll
            for (int m = 0; m < 4; ++m) { const int row = row0 + ai * HALF + m * 16;
#pragma unroll
                for (int bj = 0; bj < 2; ++bj) { f(u.pn, row, c0 + bj * HALF, acc[ai][bj][m][0], acc[ai][bj][m][1]); if (F::FENCE) asm volatile("" ::: "memory"); } }
    }
};
constexpr float ATT_C2 = 0.125f * 1.4426950408889634f;
struct FProj {
    static constexpr bool FENCE = false;
    unsigned char* ws; bf16_t* GATES;
    __device__ __forceinline__ void operator()(int pn, int row, int cu, f32x4 v0, f32x4 v1) const {
        if (pn < 4) {
            const int sh = cu >> 6, j = (cu & 63) >> 3, pos = row & 2047;
            const f32x4 c = *(const f32x4*)((const float*)(ws + WS_ROPE_C) + pos * 32 + 4 * j), s = *(const f32x4*)((const float*)(ws + WS_ROPE_S) + pos * 32 + 4 * j);
            const float sc = pn < 2 ? ATT_C2 : 1.0f;
            const f32x4 o1 = (v0 * c - v1 * s) * sc, o2 = (v1 * c + v0 * s) * sc;
            bf16_t* dst = (bf16_t*)(ws + (pn < 2 ? WS_Q : WS_K)) + (size_t)row * 512 + (pn & 1) * 256 + sh * 64 + 4 * j;
            u32x2 w1, w2; w1.x = cvt_pk_bf16(o1[0], o1[1]); w1.y = cvt_pk_bf16(o1[2], o1[3]); w2.x = cvt_pk_bf16(o2[0], o2[1]); w2.y = cvt_pk_bf16(o2[2], o2[3]);
            *(u32x2*)dst = w1; *(u32x2*)(dst + 32) = w2;
        } else if (pn < 13) {
            size_t off; int pitch, col;
            if (pn < 6) { off = WS_V; pitch = 512; col = (pn - 4) * 256; }
            else if (pn < 12) { off = WS_RKV; pitch = 1536; col = (pn - 6) * 256; }
            else { off = WS_WAG; pitch = 256; col = 0; }
            *(u32x4*)((bf16_t*)(ws + off) + (size_t)row * pitch + col + cu) = pack8(v0, v1);
        } else *(u32x4*)(GATES + (size_t)row * 2048 + (pn - 13) * 256 + cu) = pack8(v0, v1);
    }
};
struct FLora {
    static constexpr bool FENCE = false;
    unsigned char* ws; const float *w0, *a0;
    __device__ __forceinline__ void operator()(int pn, int row, int cu, f32x4 v0, f32x4 v1) const {
        const int c = (pn & 1) * 256 + cu;
        if (pn < 2) {
            const f32x4 b0 = *(const f32x4*)(w0 + c), b1 = *(const f32x4*)(w0 + c + 4);
            float* dst = (float*)(ws + WS_DEC) + (size_t)row * 512 + c; *(f32x4*)dst = v0 + b0; *(f32x4*)(dst + 4) = v1 + b1;
        } else if (pn < 4) {
            const f32x4 b0 = *(const f32x4*)(a0 + c), b1 = *(const f32x4*)(a0 + c + 4);
            *(u32x4*)((bf16_t*)(ws + WS_AA) + (size_t)row * 512 + c) = pack8(v0 + b0, v1 + b1);
        } else *(u32x4*)((bf16_t*)(ws + WS_GG) + (size_t)row * 512 + c) = pack8(v0, v1);
    }
};
struct FProjOff {
    static constexpr bool FENCE = false;
    FProj f; int off;
    __device__ __forceinline__ void operator()(int pn, int row, int cu, f32x4 v0, f32x4 v1) const { f(pn + off, row, cu, v0, v1); }
};
struct FLoraG {
    static constexpr bool FENCE = false;
    unsigned char* ws;
    __device__ __forceinline__ void operator()(int pn, int row, int cu, f32x4 v0, f32x4 v1) const { *(u32x4*)((bf16_t*)(ws + WS_GG) + (size_t)row * 512 + pn * 256 + cu) = pack8(v0, v1); }
};
struct EpiMerge {
    static constexpr int MIDK = 8; static constexpr bool PERM = true, AFTER_DRAIN = false;
    const bf16_t* GATES; bf16_t* MERGED;
    static __device__ __forceinline__ float ratio_(float ga, float gb) { return (1.0f + __expf(-gb)) * __builtin_amdgcn_rcpf(1.0f + __expf(-ga)); }
    __device__ __forceinline__ void mid(f32x4 (&acc)[2][2][4][2], const Unit& u, int wr, int wc, int fr, int fq) const {
        int fr_ = fr; asm volatile("" : "+v"(fr_));
        const bf16_t* gp0 = GATES + (size_t)(u.pm * BM + wr * 64 + fr_) * 2048 + u.pn * BM + wc * 32 + 8 * fq;
#pragma unroll
        for (int ai = 0; ai < 2; ++ai)
#pragma unroll
            for (int m = 0; m < 4; ++m)
#pragma unroll
                for (int bj = 0; bj < 2; ++bj) { const bf16_t* gp = gp0 + (size_t)(ai * HALF + m * 16) * 2048 + bj * HALF;
                    const u32x4 ga = *(const u32x4*)gp, gb = *(const u32x4*)(gp + 1024);
                    f32x4& v0 = acc[ai][bj][m][0]; f32x4& v1 = acc[ai][bj][m][1];
                    v0[0] *= ratio_(bf_lo(ga.x), bf_lo(gb.x)); v0[1] *= ratio_(bf_hi(ga.x), bf_hi(gb.x)); v0[2] *= ratio_(bf_lo(ga.y), bf_lo(gb.y)); v0[3] *= ratio_(bf_hi(ga.y), bf_hi(gb.y));
                    v1[0] *= ratio_(bf_lo(ga.z), bf_lo(gb.z)); v1[1] *= ratio_(bf_hi(ga.z), bf_hi(gb.z)); v1[2] *= ratio_(bf_lo(ga.w), bf_lo(gb.w)); v1[3] *= ratio_(bf_hi(ga.w), bf_hi(gb.w));
                    asm volatile("" ::: "memory"); }
    }
    __device__ __forceinline__ void operator()(const f32x4 (&acc)[2][2][4][2], const Unit& u, int wr, int wc, int fr, int fq) const {
        const int row0 = u.pm * BM + wr * 64 + fr, c0 = u.pn * BM + wc * 32 + 8 * fq;
#pragma unroll
        for (int ai = 0; ai < 2; ++ai)
#pragma unroll
            for (int m = 0; m < 4; ++m) { const int row = row0 + ai * HALF + m * 16;
#pragma unroll
                for (int bj = 0; bj < 2; ++bj) { const u32x4 g = *(const u32x4*)(GATES + (size_t)row * 2048 + 1024 + c0 + bj * HALF);
                    f32x4 v0 = acc[ai][bj][m][0], v1 = acc[ai][bj][m][1];
                    v0[0] *= sigmoidf_(bf_lo(g.x)); v0[1] *= sigmoidf_(bf_hi(g.x)); v0[2] *= sigmoidf_(bf_lo(g.y)); v0[3] *= sigmoidf_(bf_hi(g.y));
                    v1[0] *= sigmoidf_(bf_lo(g.z)); v1[1] *= sigmoidf_(bf_hi(g.z)); v1[2] *= sigmoidf_(bf_lo(g.w)); v1[3] *= sigmoidf_(bf_hi(g.w));
                    *(u32x4*)(MERGED + (size_t)row * 1024 + c0 + bj * HALF) = pack8(v0, v1); } }
    }
};
struct FRes {
    static constexpr bool FENCE = false;
    const float* base; float* out;
    __device__ __forceinline__ void operator()(int pn, int row, int cu, f32x4 v0, f32x4 v1) const {
        const size_t off = (size_t)row * 1024 + pn * 256 + cu; const f32x4 b0 = *(const f32x4*)(base + off), b1 = *(const f32x4*)(base + off + 4);
        *(f32x4*)(out + off) = b0 + v0; *(f32x4*)(out + off + 4) = b1 + v1;
    }
};
struct FRelu2 {
    static constexpr bool FENCE = false;
    bf16_t* H;
    __device__ __forceinline__ void operator()(int pn, int row, int cu, f32x4 v0, f32x4 v1) const {
        f32x4 r0, r1;
#pragma unroll
        for (int e = 0; e < 4; ++e) { const float a = __builtin_fmaxf(v0[e], 0.f), b = __builtin_fmaxf(v1[e], 0.f); r0[e] = a * a; r1[e] = b * b; }
        *(u32x4*)(H + (size_t)row * 4096 + pn * 256 + cu) = pack8(r0, r1);
    }
};

__device__ __forceinline__ float xsum_fq(float x) {
    { auto r = __builtin_amdgcn_permlane16_swap(__builtin_bit_cast(unsigned, x), __builtin_bit_cast(unsigned, x), false, false); const unsigned a = r[0], b = r[1]; x = __builtin_bit_cast(float, a) + __builtin_bit_cast(float, b); }
    { auto r = __builtin_amdgcn_permlane32_swap(__builtin_bit_cast(unsigned, x), __builtin_bit_cast(unsigned, x), false, false); const unsigned a = r[0], b = r[1]; x = __builtin_bit_cast(float, a) + __builtin_bit_cast(float, b); }
    return x;
}
template <int MODE> struct EpiResNorm {
    static constexpr int MIDK = 0; static constexpr bool PERM = true, AFTER_DRAIN = false;
    const float* base; float* out; bf16_t* xn; const float* g; float* ss; unsigned* cnt; float eps; bf16_t* x1b;
    __device__ __forceinline__ void operator()(f32x4 (&acc)[2][2][4][2], const Unit& u, int wr, int wc, int fr, int fq) const {
        const int row0 = u.pm * BM + wr * 64 + fr, c0 = u.pn * BM + wc * 32 + 8 * fq;
#pragma unroll
        for (int ai = 0; ai < 2; ++ai)
#pragma unroll
            for (int m = 0; m < 4; ++m) { const int row = row0 + ai * HALF + m * 16; float s = 0.f;
#pragma unroll
                for (int bj = 0; bj < 2; ++bj) { const size_t off = (size_t)row * 1024 + c0 + bj * HALF; f32x4 b0, b1;
                    if (MODE == 0) { b0 = *(const f32x4*)(base + off); b1 = *(const f32x4*)(base + off + 4); }
                    else { const u32x4 w = *(const u32x4*)(x1b + off); b0 = (f32x4){bf_lo(w.x), bf_hi(w.x), bf_lo(w.y), bf_hi(w.y)}; b1 = (f32x4){bf_lo(w.z), bf_hi(w.z), bf_lo(w.w), bf_hi(w.w)}; }
                    f32x4& v0 = acc[ai][bj][m][0]; f32x4& v1 = acc[ai][bj][m][1]; v0 += b0; v1 += b1;
                    if (MODE == 0) *(u32x4*)(x1b + off) = pack8(v0, v1);
                    s += (v0[0] * v0[0] + v0[1] * v0[1]) + (v0[2] * v0[2] + v0[3] * v0[3]) + (v1[0] * v1[0] + v1[1] * v1[1]) + (v1[2] * v1[2] + v1[3] * v1[3]); }
                s = xsum_fq(s);
                if (fq == 0) __hip_atomic_fetch_add(ss + row, s, __ATOMIC_RELAXED, __HIP_MEMORY_SCOPE_AGENT);
                if (m & 1) asm volatile("" ::: "memory"); }
        asm volatile("s_waitcnt vmcnt(0)" ::: "memory");
        unsigned* c_ = cnt + 64 * u.pm;
        if (fr == 0 && fq == 0) __hip_atomic_fetch_add(c_, 1u, __ATOMIC_RELAXED, __HIP_MEMORY_SCOPE_AGENT);
        { unsigned spins = 0; while ((unsigned)__builtin_amdgcn_readfirstlane(__hip_atomic_load(c_, __ATOMIC_RELAXED, __HIP_MEMORY_SCOPE_AGENT)) < 32u && ++spins < (1u << 22)) __builtin_amdgcn_s_sleep(2); }
        asm volatile("" ::: "memory");
#pragma unroll
        for (int ai = 0; ai < 2; ++ai)
#pragma unroll
            for (int m = 0; m < 4; ++m) { const int row = row0 + ai * HALF + m * 16;
                const float rstd = 1.0f / sqrtf(__hip_atomic_load(ss + row, __ATOMIC_RELAXED, __HIP_MEMORY_SCOPE_AGENT) * (1.0f / 1024.0f) + eps);
#pragma unroll
                for (int bj = 0; bj < 2; ++bj) { const size_t off = (size_t)row * 1024 + c0 + bj * HALF; const f32x4 g0 = *(const f32x4*)(g + c0 + bj * HALF), g1 = *(const f32x4*)(g + c0 + bj * HALF + 4);
                    const f32x4 o0 = acc[ai][bj][m][0] * rstd * g0, o1 = acc[ai][bj][m][1] * rstd * g1;
                    if (MODE == 0) *(u32x4*)(xn + off) = pack8(o0, o1); else { *(f32x4*)(out + off) = o0; *(f32x4*)(out + off + 4) = o1; } }
                if (m & 1) asm volatile("" ::: "memory"); }
    }
};

struct PanelOrder {
    int pm, ntiles;
    __device__ __forceinline__ bool next(int i, Unit& u) const { if (i >= ntiles) return false; int p = pm; asm volatile("" : "+s"(p)); u.pm = p; u.pn = i; return true; }
    __device__ __forceinline__ void a_ready(const Unit&) const {}
    __device__ __forceinline__ void done(const Unit&) const {}
};
template <class Epi, class Sched, bool ALIGN_EPI = false, bool SP2 = false>
__device__ __forceinline__ void gemm_phase(PG8_LAS unsigned char* lds, const Gemm g, const Sched& S, const Epi& E) {
    int tid_ = threadIdx.x; asm volatile("" : "+v"(tid_));
    const int tid = tid_, wid = __builtin_amdgcn_readfirstlane(tid >> 6), lane = tid & 63, wr = wid >> 2, wc = wid & 3, fr = lane & 15, fq = lane >> 4;
    const int K = g.K, nt = K / BK;
    unsigned voffA[2], voffB[2];
#pragma unroll
    for (int i = 0; i < 2; ++i) { int R, C; stage_rc(tid * 16 + i * 8192, R, C); const int Rb = Epi::PERM ? ((R & ~31) + perm32(R & 31)) : R;
        voffA[i] = (unsigned)(R * K + C) * 2u; voffB[i] = (unsigned)(Rb * K + C) * 2u; }
    const size_t kstep = (size_t)(BK * 2);
    const size_t hstep = (size_t)HALF * K * 2;
    const size_t tstep = 2 * hstep;
    const unsigned ldsw = (unsigned)wid * 1024u;
    const int aoff = lds_byte(wr * 64 + fr, fq * 8), boff = lds_byte(wc * 32 + fr, fq * 8);
#define PG8_SA(b, h) (((b) * 2 + (h)) * HTB)
#define PG8_SB(b, h) ((4 + (b) * 2 + (h)) * HTB)
#define PG8_STAGE(bufoff, gbase, voff) do { _Pragma("unroll") for (int _i = 0; _i < 2; ++_i) \
        __builtin_amdgcn_global_load_lds((const unsigned*)((const char*)(gbase) + (voff)[_i]), (PG8_LAS unsigned*)(lds + (bufoff) + ldsw + _i * 8192), 16, 0, 0); } while (0)
#define PG8_LDA(dst, b, h) do { _Pragma("unroll") for (int m = 0; m < 4; ++m) _Pragma("unroll") for (int k = 0; k < 2; ++k) dst[m][k] = *(const PG8_LAS bf16x8*)(lds + PG8_SA(b, h) + aoff + m * 2048 + k * 1024); } while (0)
#define PG8_LDB(dst, b, h) do { _Pragma("unroll") for (int n = 0; n < 2; ++n) _Pragma("unroll") for (int k = 0; k < 2; ++k) dst[n][k] = *(const PG8_LAS bf16x8*)(lds + PG8_SB(b, h) + boff + n * 2048 + k * 1024); } while (0)
#define PG8_MMA(ai, bj, At, Bt) do { __builtin_amdgcn_s_setprio(1); _Pragma("unroll") for (int m = 0; m < 4; ++m) _Pragma("unroll") for (int n = 0; n < 2; ++n) _Pragma("unroll") for (int k = 0; k < 2; ++k) \
        acc[ai][bj][m][n] = __builtin_amdgcn_mfma_f32_16x16x32_bf16(Bt[n][k], At[m][k], acc[ai][bj][m][n], 0, 0, 0); __builtin_amdgcn_s_setprio(0); } while (0)
#define PG8_WAIT_V(n) asm volatile("s_waitcnt vmcnt(" #n ")" ::: "memory")
#define PG8_WAIT_L(n) asm volatile("s_waitcnt lgkmcnt(" #n ")" ::: "memory")
#define PG8_BAR __builtin_amdgcn_s_barrier()
#define PG8_SCHED __builtin_amdgcn_sched_barrier(0)
    Unit cur, nxt; int ui = 0;
    if (!S.next(0, cur)) return;
    f32x4 acc[2][2][4][2];
#pragma unroll
    for (int a = 0; a < 2; ++a)
#pragma unroll
        for (int b = 0; b < 2; ++b)
#pragma unroll
            for (int m = 0; m < 4; ++m)
#pragma unroll
                for (int n = 0; n < 2; ++n) acc[a][b][m][n] = (f32x4){0.f, 0.f, 0.f, 0.f};
    bf16x8 At[4][2], B0[2][2], B1[2][2];
    const char* cA = (const char*)g.A + (size_t)cur.pm * tstep; const char* cB = (const char*)g.Bt + (size_t)cur.pn * tstep;
    S.a_ready(cur);
    if constexpr (SP2) {
        PG8_STAGE(PG8_SB(0, 0), cB, voffB); PG8_STAGE(PG8_SB(0, 1), cB + hstep, voffB); PG8_STAGE(PG8_SA(0, 0), cA, voffA); PG8_STAGE(PG8_SA(0, 1), cA + hstep, voffA);
        if (wr == 1) PG8_BAR;
        PG8_WAIT_V(2); PG8_BAR;
        PG8_STAGE(PG8_SB(1, 0), cB + kstep, voffB); PG8_STAGE(PG8_SA(1, 0), cA + kstep, voffA); PG8_STAGE(PG8_SB(1, 1), cB + hstep + kstep, voffB);
        PG8_WAIT_V(6); PG8_BAR;
    } else {
        PG8_STAGE(PG8_SB(0, 0), cB, voffB); PG8_STAGE(PG8_SA(0, 0), cA, voffA); PG8_STAGE(PG8_SB(0, 1), cB + hstep, voffB); PG8_STAGE(PG8_SA(0, 1), cA + hstep, voffA);
        if (wr == 1) PG8_BAR;
        PG8_WAIT_V(4); PG8_BAR;
        PG8_STAGE(PG8_SB(1, 0), cB + kstep, voffB); PG8_STAGE(PG8_SA(1, 0), cA + kstep, voffA); PG8_STAGE(PG8_SB(1, 1), cB + hstep + kstep, voffB);
        PG8_WAIT_V(6); PG8_BAR;
    }
    for (;;) {
        const bool has_next = S.next(ui + 1, nxt);
        const char* nA = has_next ? (const char*)g.A + (size_t)nxt.pm * tstep : cA; const char* nB = has_next ? (const char*)g.Bt + (size_t)nxt.pn * tstep : cB;
        for (int t = 0; t < nt; t += 2) {
            if constexpr (Epi::MIDK > 0) { if (t == Epi::MIDK) E.mid(acc, cur, wr, wc, fr, fq); }
            const bool last = (t == nt - 2);
            const char* a1 = cA + (size_t)(t + 1) * kstep;
            const char* a2 = last ? nA : cA + (size_t)(t + 2) * kstep; const char* b2 = last ? nB : cB + (size_t)(t + 2) * kstep;
            const char* a3 = a2 + kstep; const char* b3 = b2 + kstep;
            if (last && has_next) S.a_ready(nxt);
            if constexpr (SP2) {
            PG8_LDB(B0, 0, 0); PG8_LDB(B1, 0, 1); PG8_SCHED; PG8_LDA(At, 0, 0); PG8_STAGE(PG8_SA(1, 1), a1 + hstep, voffA);
            PG8_WAIT_V(8); PG8_WAIT_L(0); PG8_BAR; PG8_MMA(0, 0, At, B0); PG8_MMA(0, 1, At, B1); PG8_BAR; PG8_SCHED;
            PG8_LDA(At, 0, 1); PG8_STAGE(PG8_SB(0, 0), b2, voffB); PG8_STAGE(PG8_SB(0, 1), b2 + hstep, voffB); PG8_STAGE(PG8_SA(0, 0), a2, voffA);
            PG8_WAIT_V(8); PG8_WAIT_L(0); PG8_BAR; PG8_MMA(1, 0, At, B0); PG8_MMA(1, 1, At, B1); PG8_BAR; PG8_SCHED;
            PG8_LDB(B0, 1, 0); PG8_LDB(B1, 1, 1); PG8_SCHED; PG8_LDA(At, 1, 0); PG8_STAGE(PG8_SA(0, 1), a2 + hstep, voffA);
            PG8_WAIT_V(8); PG8_WAIT_L(0); PG8_BAR; PG8_MMA(0, 0, At, B0); PG8_MMA(0, 1, At, B1); PG8_BAR; PG8_SCHED;
            PG8_LDA(At, 1, 1); PG8_STAGE(PG8_SB(1, 0), b3, voffB); PG8_STAGE(PG8_SB(1, 1), b3 + hstep, voffB); PG8_STAGE(PG8_SA(1, 0), a3, voffA);
            PG8_WAIT_V(8); PG8_WAIT_L(0); PG8_BAR; PG8_MMA(1, 0, At, B0); PG8_MMA(1, 1, At, B1); PG8_BAR; PG8_SCHED;
            } else {
            PG8_LDB(B0, 0, 0); PG8_SCHED; PG8_LDA(At, 0, 0); PG8_STAGE(PG8_SA(1, 1), a1 + hstep, voffA);
            PG8_WAIT_L(8); PG8_BAR; PG8_WAIT_L(0); PG8_MMA(0, 0, At, B0); PG8_BAR; PG8_SCHED;
            PG8_LDB(B1, 0, 1); PG8_STAGE(PG8_SB(0, 0), b2, voffB);
            PG8_BAR; PG8_WAIT_L(0); PG8_MMA(0, 1, At, B1); PG8_BAR;
            PG8_LDA(At, 0, 1); PG8_STAGE(PG8_SA(0, 0), a2, voffA);
            PG8_BAR; PG8_WAIT_L(0); PG8_MMA(1, 0, At, B0); PG8_BAR; PG8_SCHED;
            PG8_STAGE(PG8_SB(0, 1), b2 + hstep, voffB);
            PG8_WAIT_V(6); PG8_BAR; PG8_MMA(1, 1, At, B1); PG8_BAR;
            PG8_LDB(B0, 1, 0); PG8_SCHED; PG8_LDA(At, 1, 0); PG8_STAGE(PG8_SA(0, 1), a2 + hstep, voffA);
            PG8_WAIT_L(8); PG8_BAR; PG8_WAIT_L(0); PG8_MMA(0, 0, At, B0); PG8_BAR; PG8_SCHED;
            PG8_LDB(B1, 1, 1); PG8_STAGE(PG8_SB(1, 0), b3, voffB);
            PG8_BAR; PG8_WAIT_L(0); PG8_MMA(0, 1, At, B1); PG8_BAR;
            PG8_LDA(At, 1, 1); PG8_STAGE(PG8_SA(1, 0), a3, voffA);
            PG8_BAR; PG8_WAIT_L(0); PG8_MMA(1, 0, At, B0); PG8_BAR; PG8_SCHED;
            PG8_STAGE(PG8_SB(1, 1), b3 + hstep, voffB);
            PG8_WAIT_V(6); PG8_BAR; PG8_MMA(1, 1, At, B1); PG8_BAR;
            }
        }
        if constexpr (ALIGN_EPI) { if (wr == 0) PG8_BAR; }
        if constexpr (!Epi::AFTER_DRAIN) { E(acc, cur, wr, wc, fr, fq); S.done(cur); }
        if (!has_next) break;
#pragma unroll
        for (int a = 0; a < 2; ++a)
#pragma unroll
            for (int b = 0; b < 2; ++b)
#pragma unroll
                for (int m = 0; m < 4; ++m)
#pragma unroll
                    for (int n = 0; n < 2; ++n) acc[a][b][m][n] = (f32x4){0.f, 0.f, 0.f, 0.f};
        cur = nxt; cA = nA; cB = nB; ++ui;
        if constexpr (ALIGN_EPI) { if (wr == 1) PG8_BAR; }
    }
    PG8_WAIT_V(0);
    if constexpr (!ALIGN_EPI) { if (wr == 0) PG8_BAR; }
    PG8_BAR;
    if constexpr (Epi::AFTER_DRAIN) { E.fused(acc, cur, wr, wc, fr, fq, lds, wid, lane); S.done(cur); }
#undef PG8_SA
#undef PG8_SB
#undef PG8_STAGE
#undef PG8_LDA
#undef PG8_LDB
#undef PG8_MMA
#undef PG8_WAIT_V
#undef PG8_WAIT_L
#undef PG8_BAR
#undef PG8_SCHED
}
}

#ifndef PG8_SP2
#define PG8_SP2 true
#endif
#ifndef PG8_ALIGN
#define PG8_ALIGN true
#endif
#include <hip/hip_bf16.h>
#include <cmath>
namespace attn_body {
using bf16=__hip_bfloat16;
using bf16x8=__attribute__((ext_vector_type(8)))short;
using s16x4=__attribute__((ext_vector_type(4)))short;
using f32x16=__attribute__((ext_vector_type(16)))float;
using u32x4=__attribute__((ext_vector_type(4)))unsigned;
constexpr int SEQ=2048,D=64,QP=512,KP=512,VP=512,OP=1024;
constexpr int NW=8,QBLK=32,QB=QBLK*NW,KVBLK=64,NQB=SEQ/QB;
constexpr int ATTN_UNIT_ROWS=QB;
__device__ __forceinline__ int crow(int r,int hi){return (r&3)+8*(r>>2)+4*hi;}
#define SBAR() __builtin_amdgcn_sched_barrier(0)
__device__ __forceinline__ void cmask(f32x16&p0,f32x16&p1,int jb,int wchunk,int){
  if(jb>wchunk){ const float NEG=-INFINITY;
    #pragma unroll
    for(int r=0;r<16;++r){p0[r]=NEG;p1[r]=NEG;} }
}

constexpr int NSLOT=3, SLOTB=8192;
constexpr int LDS_K=0, LDS_V=NSLOT*SLOTB, LDS_WS=2*NSLOT*SLOTB, LDS_OST=LDS_WS+NW*64*4, LDS_BYTES=LDS_OST+NW*4096;
constexpr float C2=0.125f*1.4426950408889634f;
__device__ __forceinline__ void glds16(const void*gsrc,unsigned lds_dst){unsigned keep;
  asm volatile("s_mov_b32 %0, m0\n\ts_mov_b32 m0, %2\n\ts_nop 0\n\tglobal_load_lds_dwordx4 %1, off\n\ts_mov_b32 m0, %0":"=&s"(keep):"v"(gsrc),"s"(lds_dst):"memory");}
__device__ __forceinline__ float max3f(float a,float b,float c){float r;asm("v_max3_f32 %0, %1, %2, %3":"=v"(r):"v"(a),"v"(b),"v"(c));return r;}
__device__ __forceinline__ float max2f(float a,float b){float r;asm("v_max_f32_e32 %0, %1, %2":"=v"(r):"v"(a),"v"(b));return r;}
__device__ __forceinline__ float fadd_s(float a,float b){float r;asm("v_add_f32_e32 %0, %1, %2":"=v"(r):"v"(a),"v"(b));return r;}
__device__ __forceinline__ float fsub_s(float a,float b){float r;asm("v_sub_f32_e32 %0, %1, %2":"=v"(r):"v"(a),"v"(b));return r;}
typedef float f32x2_t __attribute__((ext_vector_type(2))); typedef __bf16 bf16x2_t __attribute__((ext_vector_type(2)));
__device__ __forceinline__ unsigned cvtpk_s(float lo,float hi){f32x2_t v={lo,hi};bf16x2_t b=__builtin_convertvector(v,bf16x2_t);return __builtin_bit_cast(unsigned,b);}
#define WAIT_BAR(N) asm volatile("s_waitcnt vmcnt(" #N ") lgkmcnt(0)\n\ts_barrier":::"memory")

__device__ __forceinline__ void qkt(f32x16&p0,f32x16&p1,const char*Kslot,const bf16x8*qr,const f32x16&negm,int r32,int hi){
  const char*kb=Kslot+hi*1024+r32*16;
  #pragma unroll
  for(int d0=0;d0<4;++d0){
    const bf16x8 b0=*reinterpret_cast<const bf16x8*>(kb+d0*2048);
    const bf16x8 b1=*reinterpret_cast<const bf16x8*>(kb+d0*2048+512);
    if(d0==0){p0=__builtin_amdgcn_mfma_f32_32x32x16_bf16(b0,qr[0],negm,0,0,0);p1=__builtin_amdgcn_mfma_f32_32x32x16_bf16(b1,qr[0],negm,0,0,0);}
    else{p0=__builtin_amdgcn_mfma_f32_32x32x16_bf16(b0,qr[d0],p0,0,0,0);p1=__builtin_amdgcn_mfma_f32_32x32x16_bf16(b1,qr[d0],p1,0,0,0);}}
}
typedef __attribute__((address_space(3))) const char* lds_cptr;
typedef short v4i16_t __attribute__((ext_vector_type(4)));
__device__ __forceinline__ void kload8(bf16x8*kf,lds_cptr kp){
  kf[0]=*(const __attribute__((address_space(3))) bf16x8*)(kp);      kf[1]=*(const __attribute__((address_space(3))) bf16x8*)(kp+512);
  kf[2]=*(const __attribute__((address_space(3))) bf16x8*)(kp+2048); kf[3]=*(const __attribute__((address_space(3))) bf16x8*)(kp+2560);
  kf[4]=*(const __attribute__((address_space(3))) bf16x8*)(kp+4096); kf[5]=*(const __attribute__((address_space(3))) bf16x8*)(kp+4608);
  kf[6]=*(const __attribute__((address_space(3))) bf16x8*)(kp+6144); kf[7]=*(const __attribute__((address_space(3))) bf16x8*)(kp+6656);
}
__device__ __forceinline__ void kload2(bf16x8*kf,lds_cptr kp,int j){ kf[2*j]=*(const __attribute__((address_space(3))) bf16x8*)(kp+j*2048); kf[2*j+1]=*(const __attribute__((address_space(3))) bf16x8*)(kp+j*2048+512); }
__device__ __forceinline__ s16x4 vtr(lds_cptr p){ return __builtin_bit_cast(s16x4,__builtin_amdgcn_ds_read_tr16_b64_v4i16((__attribute__((address_space(3))) v4i16_t*)p)); }
__device__ __forceinline__ float rowmax(const f32x16&p0,const f32x16&p1){
  float a=max3f(p0[0],p0[1],p1[0]),b=max3f(p0[2],p0[3],p1[1]);a=max3f(a,p1[2],p1[3]);
  #pragma unroll
  for(int r=4;r<16;r+=4){a=max3f(a,p0[r],p0[r+1]);b=max3f(b,p0[r+2],p0[r+3]);a=max3f(a,p1[r],p1[r+1]);b=max3f(b,p1[r+2],p1[r+3]);}
  const float m=max2f(a,b);
  auto rr=__builtin_amdgcn_permlane32_swap(__float_as_uint(m),__float_as_uint(m),false,false);
  return max2f(__uint_as_float(rr[0]),__uint_as_float(rr[1]));
}
__device__ __forceinline__ void pv(f32x16*o,int vb,bf16x8 pa0,bf16x8 pa1,bf16x8 pa2,bf16x8 pa3){
  #pragma unroll
  for(int d0=0;d0<2;++d0){s16x4 lo[4],hi[4];
    #pragma unroll
    for(int ks=0;ks<4;++ks){
      asm volatile("ds_read_b64_tr_b16 %0,%1 offset:%c2":"=&v"(lo[ks]):"v"(vb),"i"(d0*4096+ks*1024):"memory");
      asm volatile("ds_read_b64_tr_b16 %0,%1 offset:%c2":"=&v"(hi[ks]):"v"(vb),"i"(d0*4096+ks*1024+512):"memory");}
    asm volatile("s_waitcnt lgkmcnt(0)":::"memory");SBAR();
    #define PK(k) (bf16x8){lo[k][0],lo[k][1],lo[k][2],lo[k][3],hi[k][0],hi[k][1],hi[k][2],hi[k][3]}
    o[d0]=__builtin_amdgcn_mfma_f32_32x32x16_bf16(pa0,PK(0),o[d0],0,0,0);
    o[d0]=__builtin_amdgcn_mfma_f32_32x32x16_bf16(pa1,PK(1),o[d0],0,0,0);
    o[d0]=__builtin_amdgcn_mfma_f32_32x32x16_bf16(pa2,PK(2),o[d0],0,0,0);
    o[d0]=__builtin_amdgcn_mfma_f32_32x32x16_bf16(pa3,PK(3),o[d0],0,0,0);
    #undef PK
  }
}

#ifndef ATTN_STORE16
#define ATTN_STORE16(p,v) (*(u32x4*)(p)=(v))
#endif
template<int THRL> __device__ __forceinline__ void attn_unit(int b,int qcol,int kcol,int vcol,int ocol,int qb,const bf16*Q,const bf16*__restrict__ K,const bf16*__restrict__ V,bf16*O,char*shm){
  int tid_=threadIdx.x; asm volatile("":"+v"(tid_));
  const int tid=tid_,lane=tid&63,r32=lane&31,hi=lane>>5; const int wid=__builtin_amdgcn_readfirstlane(tid>>6);
  const long rowbase=(long)b*SEQ; const int q0=qb*QB;
  const bf16*Qw=Q+(rowbase+q0+wid*QBLK)*QP+qcol;
  const bf16*Kh=K+rowbase*KP+kcol,*Vh=V+rowbase*VP+vcol;
  const unsigned lds0=(unsigned)(uintptr_t)shm;
  float*wsf=(float*)(shm+LDS_WS)+wid*64;
  const bf16*ksrc=Kh+(long)lane*KP+wid*8;
  const bf16*vsrc=Vh+(long)(16*(wid&3)+(lane>>2))*VP+(wid>>2)*32+(lane&3)*8;
  const unsigned kdst=lds0+LDS_K+wid*1024, vdst=lds0+LDS_V+wid*1024;
  #define DMA_K(t,slot) glds16(ksrc+(long)(t)*KVBLK*KP,(unsigned)__builtin_amdgcn_readfirstlane(kdst+(slot)))
  #define DMA_V(t,slot) glds16(vsrc+(long)(t)*KVBLK*VP,(unsigned)__builtin_amdgcn_readfirstlane(vdst+(slot)))
  const int vb0=(int)(lds0+LDS_V)+((lane>>4)&1)*32+(lane&3)*8+(4*hi+((lane&15)>>2))*64;
  const char*Kbase=shm+LDS_K; bf16x8 kf[8];
  const lds_cptr shm3=(lds_cptr)shm; const lds_cptr kp0=shm3+LDS_K+hi*1024+r32*16; const lds_cptr vp0=shm3+LDS_V+((lane>>4)&1)*32+(lane&3)*8+(4*hi+((lane&15)>>2))*64;
  const int NT=(q0+QB)/KVBLK;
  DMA_K(0,0);DMA_V(0,0);DMA_K(1,SLOTB);
  bf16x8 qr[4];
  #pragma unroll
  for(int d0=0;d0<4;++d0)qr[d0]=*reinterpret_cast<const bf16x8*>(&Qw[(long)r32*QP+d0*16+hi*8]);
  float mhat=0.f,l_reg=0.f;f32x16 o[2];o[0]=f32x16{};o[1]=f32x16{};f32x16 negm=f32x16{};asm volatile("":"+v"(negm));
  const int qrel=wid>>1;
  #define CMASK(P0,P1,t) do{int jb_=(t)-(NT-4); if(jb_>=0)cmask(P0,P1,jb_,qrel,hi);}while(0)
  bool resc=false;
  #define START(P0,P1) do{ const float rm=rowmax(P0,P1); resc=false; \
    { const float dl=rm; mhat=fadd_s(mhat,dl); \
      _Pragma("unroll") for(int r=0;r<16;++r){P0[r]=fsub_s(P0[r],dl);P1[r]=fsub_s(P1[r],dl);} \
      _Pragma("unroll") for(int r=0;r<16;++r)negm[r]=-mhat; asm volatile("":"+v"(negm)); } \
    _Pragma("unroll") for(int r=0;r<16;++r)P0[r]=__builtin_amdgcn_exp2f(P0[r]); }while(0)
  #define RESC() do{ if(resc){ asm volatile("s_waitcnt lgkmcnt(0)":::"memory"); \
      _Pragma("unroll") for(int d_=0;d_<2;++d_) _Pragma("unroll") for(int r=0;r<16;++r)o[d_][r]*=wsf[crow(r,hi)]; } }while(0)
  f32x16 pA0,pA1,pB0,pB1;
  int sl_prev=0,sl_cur=0,sl_next=SLOTB;
  #define ROT() do{sl_prev=sl_cur;sl_cur=sl_next;sl_next=(sl_next==(NSLOT-1)*SLOTB)?0:sl_next+SLOTB;}while(0)
  DMA_K(2,2*SLOTB);
  WAIT_BAR(3);
  qkt(pA0,pA1,Kbase,qr,negm,r32,hi);asm volatile("s_nop 15\n\ts_nop 7":"+v"(pA0),"+v"(pA1));CMASK(pA0,pA1,0);
  START(pA0,pA1);
  _Pragma("unroll") for(int r=0;r<16;++r)pA1[r]=__builtin_amdgcn_exp2f(pA1[r]);
  WAIT_BAR(0);
  DMA_K(3,0);DMA_V(1,SLOTB);
  ROT();
  kload8(kf,kp0+sl_cur);
  WAIT_BAR(2);
  s16x4 vlo[8],vhi[8]; u32x4 pw0,pw1,pw2,pw3;
  #define PKW(P,B) cvtpk_s(P[B],P[B+1])
  #define PAF(k) __builtin_bit_cast(bf16x8,pw##k)
  #define VFR(i) (bf16x8){vlo[i][0],vlo[i][1],vlo[i][2],vlo[i][3],vhi[i][0],vhi[i][1],vhi[i][2],vhi[i][3]}
  #define PIN(x) asm volatile("":"+v"(x))
  #define MX3(a,b,c) __builtin_fmaxf(__builtin_fmaxf((a),(b)),(c))
  #define GAPA(MF,A0,A1,A2,A3,W0,W1,PW) do{ MF; sacc+=A0; sacc+=A1; sacc+=A2; sacc+=A3; PIN(sacc); W0; W1; PIN(PW); SBAR(); }while(0)
  #define EX(v) __builtin_amdgcn_exp2f(v)
  #define GAPB(MF,X,B) do{ MF; X[B]=EX(X[B]); X[B+1]=EX(X[B+1]); X[B+2]=EX(X[B+2]); X[B+3]=EX(X[B+3]); PIN(X); SBAR(); }while(0)
  #define VRD(i) do{ vlo[i]=vtr(vp_+(((i)>>2)*4096+((i)&3)*1024)); vhi[i]=vtr(vp_+(((i)>>2)*4096+((i)&3)*1024+512)); }while(0)
  #define KRD(G,j) do{ if(G){ kload2(kf,kp0+sl_next,j); SBAR(); } }while(0)
  #define STEP(C0,C1,P0,P1,t,GK,GV,GL) do{ SBAR(); \
    const lds_cptr vp_=vp0+sl_prev; \
    VRD(0); SBAR(); float sacc=(P0[0]+P0[1]); \
    GAPA(C0=__builtin_amdgcn_mfma_f32_32x32x16_bf16(kf[0],qr[0],negm,0,0,0), P0[2],P0[3],P0[4],P0[5],     pw0[0]=PKW(P0,0), pw0[1]=PKW(P0,2), pw0); \
    VRD(4); SBAR(); GAPA(C1=__builtin_amdgcn_mfma_f32_32x32x16_bf16(kf[1],qr[0],negm,0,0,0), P0[6],P0[7],P0[8],P0[9],     pw0[2]=PKW(P0,4), pw0[3]=PKW(P0,6), pw0); \
    VRD(1); SBAR(); GAPA(C0=__builtin_amdgcn_mfma_f32_32x32x16_bf16(kf[2],qr[1],C0,0,0,0),   P0[10],P0[11],P0[12],P0[13], pw1[0]=PKW(P0,8), pw1[1]=PKW(P0,10), pw1); \
    VRD(5); SBAR(); GAPA(C1=__builtin_amdgcn_mfma_f32_32x32x16_bf16(kf[3],qr[1],C1,0,0,0),   P0[14],P0[15],P1[0],P1[1],   pw1[2]=PKW(P0,12),pw1[3]=PKW(P0,14), pw1); \
    VRD(2); SBAR(); GAPA(C0=__builtin_amdgcn_mfma_f32_32x32x16_bf16(kf[4],qr[2],C0,0,0,0),   P1[2],P1[3],P1[4],P1[5],     pw2[0]=PKW(P1,0), pw2[1]=PKW(P1,2), pw2); \
    VRD(6); SBAR(); GAPA(C1=__builtin_amdgcn_mfma_f32_32x32x16_bf16(kf[5],qr[2],C1,0,0,0),   P1[6],P1[7],P1[8],P1[9],     pw2[2]=PKW(P1,4), pw2[3]=PKW(P1,6), pw2); \
    VRD(3); SBAR(); GAPA(C0=__builtin_amdgcn_mfma_f32_32x32x16_bf16(kf[6],qr[3],C0,0,0,0),   P1[10],P1[11],P1[12],P1[13], pw3[0]=PKW(P1,8), pw3[1]=PKW(P1,10), pw3); \
    VRD(7); SBAR(); GAPA(C1=__builtin_amdgcn_mfma_f32_32x32x16_bf16(kf[7],qr[3],C1,0,0,0),   P1[14],P1[15],0.f,0.f,       pw3[2]=PKW(P1,12),pw3[3]=PKW(P1,14), pw3); \
    l_reg+=sacc; \
    if(GK){DMA_K((t)+3,sl_cur);} if(GV){DMA_V((t)+1,sl_next);} \
    CMASK(C0,C1,t); \
    { float a=MX3(C0[0],C0[1],C1[0]),b=MX3(C0[2],C0[3],C1[1]); a=MX3(a,C1[2],C1[3]); \
      _Pragma("unroll") for(int r=4;r<16;r+=4){a=MX3(a,C0[r],C0[r+1]);b=MX3(b,C0[r+2],C0[r+3]);a=MX3(a,C1[r],C1[r+1]);b=MX3(b,C1[r+2],C1[r+3]);} \
      float rm=__builtin_fmaxf(a,b); { auto rr=__builtin_amdgcn_permlane32_swap(__float_as_uint(rm),__float_as_uint(rm),false,false); rm=__builtin_fmaxf(__uint_as_float(rr[0]),__uint_as_float(rr[1])); } \
      resc=false; \
      if(__builtin_expect(__any(rm>(float)THRL),0)){ const float dl=__builtin_fmaxf(rm,0.f); mhat+=dl; \
        _Pragma("unroll") for(int r=0;r<16;++r){C0[r]-=dl;C1[r]-=dl;} \
        _Pragma("unroll") for(int r=0;r<16;++r)negm[r]=-mhat; asm volatile("":"+v"(negm)); \
        const float f=__builtin_amdgcn_exp2f(-dl); l_reg*=f; if(hi==0)wsf[r32]=f; resc=true; } } \
    SBAR(); \
    GAPB(o[0]=__builtin_amdgcn_mfma_f32_32x32x16_bf16(PAF(0),VFR(0),o[0],0,0,0), C0,0); \
    GAPB(o[1]=__builtin_amdgcn_mfma_f32_32x32x16_bf16(PAF(0),VFR(4),o[1],0,0,0), C0,4); \
    KRD(GL,0); GAPB(o[0]=__builtin_amdgcn_mfma_f32_32x32x16_bf16(PAF(1),VFR(1),o[0],0,0,0), C0,8); \
    KRD(GL,1); GAPB(o[1]=__builtin_amdgcn_mfma_f32_32x32x16_bf16(PAF(1),VFR(5),o[1],0,0,0), C0,12); \
    KRD(GL,2); GAPB(o[0]=__builtin_amdgcn_mfma_f32_32x32x16_bf16(PAF(2),VFR(2),o[0],0,0,0), C1,0); \
    KRD(GL,3); GAPB(o[1]=__builtin_amdgcn_mfma_f32_32x32x16_bf16(PAF(2),VFR(6),o[1],0,0,0), C1,4); \
    GAPB(o[0]=__builtin_amdgcn_mfma_f32_32x32x16_bf16(PAF(3),VFR(3),o[0],0,0,0), C1,8); \
    GAPB(o[1]=__builtin_amdgcn_mfma_f32_32x32x16_bf16(PAF(3),VFR(7),o[1],0,0,0), C1,12); \
    }while(0)
  int t=1;
  #undef CMASK
  #define CMASK(P0,P1,t) do{}while(0)
  for(;t+5<NT;t+=2){
    STEP(pB0,pB1,pA0,pA1,t,true,true,true);     WAIT_BAR(2); RESC(); ROT();
    STEP(pA0,pA1,pB0,pB1,t+1,true,true,true);   WAIT_BAR(2); RESC(); ROT();
  }
  #undef CMASK
  #define CMASK(P0,P1,t) do{int jb_=(t)-(NT-4); if(jb_>=0)cmask(P0,P1,jb_,qrel,hi);}while(0)
  #define ENDW(tt) do{ if((tt)+3<NT){WAIT_BAR(2);} else if((tt)+2<NT){WAIT_BAR(1);} else {WAIT_BAR(0);} }while(0)
  for(;t+1<NT;t+=2){
    STEP(pB0,pB1,pA0,pA1,t,(t+3<NT),(t+1<NT),(t+1<NT));       ENDW(t);   RESC(); ROT();
    STEP(pA0,pA1,pB0,pB1,t+1,(t+4<NT),(t+2<NT),(t+2<NT));     ENDW(t+1); RESC(); ROT();
  }
  STEP(pB0,pB1,pA0,pA1,NT-1,false,false,false); RESC();
  { float sacc=pB0[0]+pB0[1]; _Pragma("unroll") for(int r=2;r<16;++r)sacc+=pB0[r]; _Pragma("unroll") for(int r=0;r<16;++r)sacc+=pB1[r]; l_reg+=sacc;
    pw0=(u32x4){PKW(pB0,0),PKW(pB0,2),PKW(pB0,4),PKW(pB0,6)};pw1=(u32x4){PKW(pB0,8),PKW(pB0,10),PKW(pB0,12),PKW(pB0,14)};pw2=(u32x4){PKW(pB1,0),PKW(pB1,2),PKW(pB1,4),PKW(pB1,6)};pw3=(u32x4){PKW(pB1,8),PKW(pB1,10),PKW(pB1,12),PKW(pB1,14)};
    SBAR(); pv(o,vb0+sl_cur,PAF(0),PAF(1),PAF(2),PAF(3)); }
  #undef PKW
  #undef PAF
  #undef VFR
  #undef PIN
  #undef MX3
  #undef GAPA
  #undef GAPB
  #undef EX
  #undef VRD
  #undef KRD
  #undef STEP
  #undef ENDW
  {auto rr=__builtin_amdgcn_permlane32_swap(__float_as_uint(l_reg),__float_as_uint(l_reg),false,false);l_reg=__uint_as_float(rr[0])+__uint_as_float(rr[1]);}
  if(hi==0)wsf[32+r32]=l_reg;asm volatile("s_waitcnt lgkmcnt(0)":::"memory");
  float rli[16];
  #pragma unroll
  for(int r=0;r<16;++r)rli[r]=__builtin_amdgcn_rcpf(wsf[32+crow(r,hi)]);
  bf16*Ow=O+(rowbase+q0+wid*QBLK)*OP+ocol;
  { bf16*stg=(bf16*)(shm+LDS_OST)+wid*2048;
    #pragma unroll
    for(int r=0;r<16;++r){const int orow=crow(r,hi);
      #pragma unroll
      for(int d0=0;d0<2;++d0)stg[orow*64+d0*32+r32]=__float2bfloat16(o[d0][r]*rli[r]);}
    asm volatile("s_waitcnt lgkmcnt(0)":::"memory");
    #pragma unroll
    for(int i=0;i<4;++i){const int row=i*8+(lane>>3),ch=lane&7; const u32x4 v=*(const u32x4*)(stg+row*64+ch*8); ATTN_STORE16(Ow+(long)row*OP+ch*8,v);} }
  asm volatile("s_waitcnt lgkmcnt(0)\n\ts_barrier":::"memory");
  #undef DMA_K
  #undef DMA_V
  #undef CMASK
  #undef START
  #undef RESC
  #undef ROT
}
constexpr int LDS2_V=NSLOT*SLOTB, LDS2_WS=LDS2_V+NSLOT*2*SLOTB, LDS2_OST=LDS2_WS+NW*64*4, LDS2_BYTES=LDS2_OST+NW*8192;
#ifndef ATTN_STORE16
#define ATTN_STORE16(p,v) (*(u32x4*)(p)=(v))
#endif
template<int THRL> __device__ __forceinline__ void attn_unit128(int b,int qcol,int kcol,int vcol,int ocol,int qb,const bf16*Q,const bf16*__restrict__ K,const bf16*__restrict__ V,bf16*O,char*shm){
  int tid_=threadIdx.x; asm volatile("":"+v"(tid_));
  const int tid=tid_,lane=tid&63,r32=lane&31,hi=lane>>5; const int wid=__builtin_amdgcn_readfirstlane(tid>>6);
  const long rowbase=(long)b*SEQ; const int q0=qb*QB;
  const bf16*Qw=Q+(rowbase+q0+wid*QBLK)*QP+qcol;
  const bf16*Kh=K+rowbase*KP+kcol,*Vh=V+rowbase*VP+vcol;
  const unsigned lds0=(unsigned)(uintptr_t)shm;
  float*wsf=(float*)(shm+LDS2_WS)+wid*64;
  const bf16*ksrc=Kh+(long)lane*KP+wid*8;
  const bf16*vsrc=Vh+(long)(16*(wid&3)+(lane>>2))*VP+(wid>>2)*32+(lane&3)*8;
  const unsigned kdst=lds0+LDS_K+wid*1024, vdst=lds0+LDS2_V+wid*1024;
  #define DMA_K(t,slot) glds16(ksrc+(long)(t)*KVBLK*KP,(unsigned)__builtin_amdgcn_readfirstlane(kdst+(slot)))
  #define DMA_V(t,slot) do{ glds16(vsrc+(long)(t)*KVBLK*VP,(unsigned)__builtin_amdgcn_readfirstlane(vdst+2*(slot))); glds16(vsrc+(long)(t)*KVBLK*VP+64,(unsigned)__builtin_amdgcn_readfirstlane(vdst+2*(slot)+8192)); }while(0)
  const int vb0=(int)(lds0+LDS2_V)+((lane>>4)&1)*32+(lane&3)*8+(4*hi+((lane&15)>>2))*64;
  const char*Kbase=shm+LDS_K; bf16x8 kf[8];
  const lds_cptr shm3=(lds_cptr)shm; const lds_cptr kp0=shm3+LDS_K+hi*1024+r32*16; const lds_cptr vp0=shm3+LDS2_V+((lane>>4)&1)*32+(lane&3)*8+(4*hi+((lane&15)>>2))*64;
  const int NT=(q0+QB)/KVBLK;
  DMA_K(0,0);DMA_V(0,0);DMA_K(1,SLOTB);
  bf16x8 qr[4];
  #pragma unroll
  for(int d0=0;d0<4;++d0)qr[d0]=*reinterpret_cast<const bf16x8*>(&Qw[(long)r32*QP+d0*16+hi*8]);
  float mhat=0.f,l_reg=0.f;f32x16 o[4];o[0]=f32x16{};o[1]=f32x16{};o[2]=f32x16{};o[3]=f32x16{};f32x16 negm=f32x16{};asm volatile("":"+v"(negm));
  const int qrel=wid>>1;
  #define CMASK(P0,P1,t) do{int jb_=(t)-(NT-4); if(jb_>=0)cmask(P0,P1,jb_,qrel,hi);}while(0)
  bool resc=false;
  #define START(P0,P1) do{ const float rm=rowmax(P0,P1); resc=false; \
    { const float dl=rm; mhat=fadd_s(mhat,dl); \
      _Pragma("unroll") for(int r=0;r<16;++r){P0[r]=fsub_s(P0[r],dl);P1[r]=fsub_s(P1[r],dl);} \
      _Pragma("unroll") for(int r=0;r<16;++r)negm[r]=-mhat; asm volatile("":"+v"(negm)); } \
    _Pragma("unroll") for(int r=0;r<16;++r)P0[r]=__builtin_amdgcn_exp2f(P0[r]); }while(0)
  #define RESC() do{ if(resc){ asm volatile("s_waitcnt lgkmcnt(0)":::"memory"); \
      _Pragma("unroll") for(int d_=0;d_<4;++d_) _Pragma("unroll") for(int r=0;r<16;++r)o[d_][r]*=wsf[crow(r,hi)]; } }while(0)
  f32x16 pA0,pA1,pB0,pB1;
  int sl_prev=0,sl_cur=0,sl_next=SLOTB;
  #define ROT() do{sl_prev=sl_cur;sl_cur=sl_next;sl_next=(sl_next==(NSLOT-1)*SLOTB)?0:sl_next+SLOTB;}while(0)
  DMA_K(2,2*SLOTB);
  WAIT_BAR(4);
  qkt(pA0,pA1,Kbase,qr,negm,r32,hi);asm volatile("s_nop 15\n\ts_nop 7":"+v"(pA0),"+v"(pA1));CMASK(pA0,pA1,0);
  START(pA0,pA1);
  _Pragma("unroll") for(int r=0;r<16;++r)pA1[r]=__builtin_amdgcn_exp2f(pA1[r]);
  WAIT_BAR(0);
  DMA_K(3,0);DMA_V(1,SLOTB);
  ROT();
  kload8(kf,kp0+sl_cur);
  WAIT_BAR(3);
  s16x4 vlo[4],vhi[4]; u32x4 pw0,pw1,pw2,pw3;
  #define PKW(P,B) cvtpk_s(P[B],P[B+1])
  #define PAF(k) __builtin_bit_cast(bf16x8,pw##k)
  #define VFR(i) (bf16x8){vlo[i][0],vlo[i][1],vlo[i][2],vlo[i][3],vhi[i][0],vhi[i][1],vhi[i][2],vhi[i][3]}
  #define PIN(x) asm volatile("":"+v"(x))
  #define MX3(a,b,c) __builtin_fmaxf(__builtin_fmaxf((a),(b)),(c))
  #define GAPA(MF,A0,A1,A2,A3,W0,W1,PW) do{ MF; sacc+=A0; sacc+=A1; sacc+=A2; sacc+=A3; PIN(sacc); W0; W1; PIN(PW); SBAR(); }while(0)
  #define EX(v) __builtin_amdgcn_exp2f(v)
  #define GAPB(MF,X,B) do{ MF; X[B]=EX(X[B]); X[B+1]=EX(X[B+1]); PIN(X); SBAR(); }while(0)
  #define VRD(j,d,k) do{ vlo[(j)&3]=vtr(vp_+((d)*4096+(k)*1024)); vhi[(j)&3]=vtr(vp_+((d)*4096+(k)*1024+512)); }while(0)
  #define KRD(G,j) do{ if(G){ kload2(kf,kp0+sl_next,j); SBAR(); } }while(0)
  #define STEP(C0,C1,P0,P1,t,GK,GV,GL) do{ SBAR(); \
    const lds_cptr vp_=vp0+2*sl_prev; \
    float sacc=(P0[0]+P0[1]); \
    GAPA(C0=__builtin_amdgcn_mfma_f32_32x32x16_bf16(kf[0],qr[0],negm,0,0,0), P0[2],P0[3],P0[4],P0[5],     pw0[0]=PKW(P0,0), pw0[1]=PKW(P0,2), pw0); \
    GAPA(C1=__builtin_amdgcn_mfma_f32_32x32x16_bf16(kf[1],qr[0],negm,0,0,0), P0[6],P0[7],P0[8],P0[9],     pw0[2]=PKW(P0,4), pw0[3]=PKW(P0,6), pw0); \
    GAPA(C0=__builtin_amdgcn_mfma_f32_32x32x16_bf16(kf[2],qr[1],C0,0,0,0),   P0[10],P0[11],P0[12],P0[13], pw1[0]=PKW(P0,8), pw1[1]=PKW(P0,10), pw1); \
    GAPA(C1=__builtin_amdgcn_mfma_f32_32x32x16_bf16(kf[3],qr[1],C1,0,0,0),   P0[14],P0[15],P1[0],P1[1],   pw1[2]=PKW(P0,12),pw1[3]=PKW(P0,14), pw1); \
    VRD(0,0,0); SBAR(); GAPA(C0=__builtin_amdgcn_mfma_f32_32x32x16_bf16(kf[4],qr[2],C0,0,0,0),   P1[2],P1[3],P1[4],P1[5],     pw2[0]=PKW(P1,0), pw2[1]=PKW(P1,2), pw2); \
    VRD(1,1,0); SBAR(); GAPA(C1=__builtin_amdgcn_mfma_f32_32x32x16_bf16(kf[5],qr[2],C1,0,0,0),   P1[6],P1[7],P1[8],P1[9],     pw2[2]=PKW(P1,4), pw2[3]=PKW(P1,6), pw2); \
    VRD(2,0,1); SBAR(); GAPA(C0=__builtin_amdgcn_mfma_f32_32x32x16_bf16(kf[6],qr[3],C0,0,0,0),   P1[10],P1[11],P1[12],P1[13], pw3[0]=PKW(P1,8), pw3[1]=PKW(P1,10), pw3); \
    VRD(3,1,1); SBAR(); GAPA(C1=__builtin_amdgcn_mfma_f32_32x32x16_bf16(kf[7],qr[3],C1,0,0,0),   P1[14],P1[15],0.f,0.f,       pw3[2]=PKW(P1,12),pw3[3]=PKW(P1,14), pw3); \
    l_reg+=sacc; \
    if(GK){DMA_K((t)+3,sl_cur);} if(GV){DMA_V((t)+1,sl_next);} \
    CMASK(C0,C1,t); \
    { float a=MX3(C0[0],C0[1],C1[0]),b=MX3(C0[2],C0[3],C1[1]); a=MX3(a,C1[2],C1[3]); \
      _Pragma("unroll") for(int r=4;r<16;r+=4){a=MX3(a,C0[r],C0[r+1]);b=MX3(b,C0[r+2],C0[r+3]);a=MX3(a,C1[r],C1[r+1]);b=MX3(b,C1[r+2],C1[r+3]);} \
      float rm=__builtin_fmaxf(a,b); { auto rr=__builtin_amdgcn_permlane32_swap(__float_as_uint(rm),__float_as_uint(rm),false,false); rm=__builtin_fmaxf(__uint_as_float(rr[0]),__uint_as_float(rr[1])); } \
      resc=false; \
      if(__builtin_expect(__any(rm>(float)THRL),0)){ const float dl=__builtin_fmaxf(rm,0.f); mhat+=dl; \
        _Pragma("unroll") for(int r=0;r<16;++r){C0[r]-=dl;C1[r]-=dl;} \
        _Pragma("unroll") for(int r=0;r<16;++r)negm[r]=-mhat; asm volatile("":"+v"(negm)); \
        const float f=__builtin_amdgcn_exp2f(-dl); l_reg*=f; if(hi==0)wsf[r32]=f; resc=true; } } \
    SBAR(); \
    GAPB(o[0]=__builtin_amdgcn_mfma_f32_32x32x16_bf16(PAF(0),VFR(0),o[0],0,0,0), C0,0); \
    VRD(4,0,2); SBAR(); GAPB(o[1]=__builtin_amdgcn_mfma_f32_32x32x16_bf16(PAF(0),VFR(1),o[1],0,0,0), C0,2); \
    VRD(5,1,2); SBAR(); KRD(GL,0); GAPB(o[0]=__builtin_amdgcn_mfma_f32_32x32x16_bf16(PAF(1),VFR(2),o[0],0,0,0), C0,4); \
    VRD(6,0,3); SBAR(); KRD(GL,1); GAPB(o[1]=__builtin_amdgcn_mfma_f32_32x32x16_bf16(PAF(1),VFR(3),o[1],0,0,0), C0,6); \
    VRD(7,1,3); SBAR(); KRD(GL,2); GAPB(o[0]=__builtin_amdgcn_mfma_f32_32x32x16_bf16(PAF(2),VFR(0),o[0],0,0,0), C0,8); \
    VRD(8,2,0); SBAR(); KRD(GL,3); GAPB(o[1]=__builtin_amdgcn_mfma_f32_32x32x16_bf16(PAF(2),VFR(1),o[1],0,0,0), C0,10); \
    VRD(9,3,0); SBAR(); GAPB(o[0]=__builtin_amdgcn_mfma_f32_32x32x16_bf16(PAF(3),VFR(2),o[0],0,0,0), C0,12); \
    VRD(10,2,1); SBAR(); GAPB(o[1]=__builtin_amdgcn_mfma_f32_32x32x16_bf16(PAF(3),VFR(3),o[1],0,0,0), C0,14); \
    VRD(11,3,1); SBAR(); GAPB(o[2]=__builtin_amdgcn_mfma_f32_32x32x16_bf16(PAF(0),VFR(0),o[2],0,0,0), C1,0); \
    VRD(12,2,2); SBAR(); GAPB(o[3]=__builtin_amdgcn_mfma_f32_32x32x16_bf16(PAF(0),VFR(1),o[3],0,0,0), C1,2); \
    VRD(13,3,2); SBAR(); GAPB(o[2]=__builtin_amdgcn_mfma_f32_32x32x16_bf16(PAF(1),VFR(2),o[2],0,0,0), C1,4); \
    VRD(14,2,3); SBAR(); GAPB(o[3]=__builtin_amdgcn_mfma_f32_32x32x16_bf16(PAF(1),VFR(3),o[3],0,0,0), C1,6); \
    VRD(15,3,3); SBAR(); GAPB(o[2]=__builtin_amdgcn_mfma_f32_32x32x16_bf16(PAF(2),VFR(0),o[2],0,0,0), C1,8); \
    GAPB(o[3]=__builtin_amdgcn_mfma_f32_32x32x16_bf16(PAF(2),VFR(1),o[3],0,0,0), C1,10); \
    GAPB(o[2]=__builtin_amdgcn_mfma_f32_32x32x16_bf16(PAF(3),VFR(2),o[2],0,0,0), C1,12); \
    GAPB(o[3]=__builtin_amdgcn_mfma_f32_32x32x16_bf16(PAF(3),VFR(3),o[3],0,0,0), C1,14); \
    }while(0)
  int t=1;
  #undef CMASK
  #define CMASK(P0,P1,t) do{}while(0)
  for(;t+5<NT;t+=2){
    STEP(pB0,pB1,pA0,pA1,t,true,true,true);     WAIT_BAR(3); RESC(); ROT();
    STEP(pA0,pA1,pB0,pB1,t+1,true,true,true);   WAIT_BAR(3); RESC(); ROT();
  }
  #undef CMASK
  #define CMASK(P0,P1,t) do{int jb_=(t)-(NT-4); if(jb_>=0)cmask(P0,P1,jb_,qrel,hi);}while(0)
  #define ENDW(tt) do{ if((tt)+3<NT){WAIT_BAR(3);} else if((tt)+2<NT){WAIT_BAR(2);} else {WAIT_BAR(0);} }while(0)
  for(;t+1<NT;t+=2){
    STEP(pB0,pB1,pA0,pA1,t,(t+3<NT),(t+1<NT),(t+1<NT));       ENDW(t);   RESC(); ROT();
    STEP(pA0,pA1,pB0,pB1,t+1,(t+4<NT),(t+2<NT),(t+2<NT));     ENDW(t+1); RESC(); ROT();
  }
  STEP(pB0,pB1,pA0,pA1,NT-1,false,false,false); RESC();
  { float sacc=pB0[0]+pB0[1]; _Pragma("unroll") for(int r=2;r<16;++r)sacc+=pB0[r]; _Pragma("unroll") for(int r=0;r<16;++r)sacc+=pB1[r]; l_reg+=sacc;
    pw0=(u32x4){PKW(pB0,0),PKW(pB0,2),PKW(pB0,4),PKW(pB0,6)};pw1=(u32x4){PKW(pB0,8),PKW(pB0,10),PKW(pB0,12),PKW(pB0,14)};pw2=(u32x4){PKW(pB1,0),PKW(pB1,2),PKW(pB1,4),PKW(pB1,6)};pw3=(u32x4){PKW(pB1,8),PKW(pB1,10),PKW(pB1,12),PKW(pB1,14)};
    SBAR(); pv(o,vb0+2*sl_cur,PAF(0),PAF(1),PAF(2),PAF(3)); pv(o+2,vb0+2*sl_cur+8192,PAF(0),PAF(1),PAF(2),PAF(3)); }
  #undef PKW
  #undef PAF
  #undef VFR
  #undef PIN
  #undef MX3
  #undef GAPA
  #undef GAPB
  #undef EX
  #undef VRD
  #undef KRD
  #undef STEP
  #undef ENDW
  {auto rr=__builtin_amdgcn_permlane32_swap(__float_as_uint(l_reg),__float_as_uint(l_reg),false,false);l_reg=__uint_as_float(rr[0])+__uint_as_float(rr[1]);}
  if(hi==0)wsf[32+r32]=l_reg;asm volatile("s_waitcnt lgkmcnt(0)":::"memory");
  float rli[16];
  #pragma unroll
  for(int r=0;r<16;++r)rli[r]=__builtin_amdgcn_rcpf(wsf[32+crow(r,hi)]);
  bf16*Ow=O+(rowbase+q0+wid*QBLK)*OP+ocol;
  { bf16*stg=(bf16*)(shm+LDS2_OST)+wid*4096;
    #pragma unroll
    for(int r=0;r<16;++r){const int orow=crow(r,hi);
      #pragma unroll
      for(int d0=0;d0<4;++d0)stg[orow*128+d0*32+r32]=__float2bfloat16(o[d0][r]*rli[r]);}
    asm volatile("s_waitcnt lgkmcnt(0)":::"memory");
    #pragma unroll
    for(int i=0;i<8;++i){const int row=i*4+(lane>>4),ch=lane&15; const u32x4 v=*(const u32x4*)(stg+row*128+ch*8); ATTN_STORE16(Ow+(long)row*OP+ch*8,v);} }
  asm volatile("s_waitcnt lgkmcnt(0)\n\ts_barrier":::"memory");
  #undef DMA_K
  #undef DMA_V
  #undef CMASK
  #undef START
  #undef RESC
  #undef ROT
}
constexpr int ATTN_LDS_BYTES=LDS_BYTES;
struct AttnTensors { const bf16* Q; const bf16* K; const bf16* V; bf16* O; };
struct AttnUnit { int bvh; int qb; };
struct StaticOrder {
  int ai,nA;
  __device__ __forceinline__ StaticOrder(int ai_,int nA_):ai(ai_),nA(nA_){}
  __device__ __forceinline__ bool next(int i,AttnUnit&u)const{
    if(nA==128){ if(i>=8)return false; u.bvh=ai; u.qb=7-i; return true; }
    if(i>=4)return false; const int s=ai&1; u.bvh=ai>>1; u.qb=(i==0)?7-s:(i==1)?4+s:(i==2)?3-s:s; return true; }
  __device__ __forceinline__ void a_ready(const AttnUnit&)const{}
  __device__ __forceinline__ void done(const AttnUnit&)const{}
};
template<class Sched,int THRL=8> __device__ __forceinline__ void attn_phase(char*lds,const AttnTensors&T,const Sched&S){
  AttnUnit u;
  for(int i=0;S.next(i,u);++i){ S.a_ready(u); const int b=u.bvh>>4,vh=u.bvh&15,s=vh>>1,half=vh&1;
    attn_unit<THRL>(b,s*64,s*64,(s>>1)*128+half*64,s*128+half*64,u.qb,T.Q,T.K,T.V,T.O,lds); S.done(u); }
}
template<int THRL=8> __device__ __forceinline__ void attn_phase_queue(char*lds,const AttnTensors&T,unsigned*counter,volatile __attribute__((address_space(3))) unsigned*slot){
  for(;;){
    if(threadIdx.x==0)*slot=__hip_atomic_fetch_add(counter,1u,__ATOMIC_RELAXED,__HIP_MEMORY_SCOPE_AGENT);
    __syncthreads();
    const unsigned u=__builtin_amdgcn_readfirstlane(*slot);
    __syncthreads();
    if(u>=1024u)break;
    const int qb=7-(int)(u>>7),bvh=(int)(u&127u),b=bvh>>4,vh=bvh&15,s=vh>>1,half=vh&1;
    attn_unit<THRL>(b,s*64,s*64,(s>>1)*128+half*64,s*128+half*64,qb,T.Q,T.K,T.V,T.O,lds);
  }
}
template<int THRL=8> __device__ __forceinline__ void attn_phase_queue128(char*lds,const AttnTensors&T,unsigned*counter,volatile __attribute__((address_space(3))) unsigned*slot){
  for(;;){
    if(threadIdx.x==0)*slot=__hip_atomic_fetch_add(counter,1u,__ATOMIC_RELAXED,__HIP_MEMORY_SCOPE_AGENT);
    __syncthreads();
    const unsigned u=__builtin_amdgcn_readfirstlane(*slot);
    __syncthreads();
    if(u>=512u)break;
    const int qb=7-(int)(u>>6),bs=(int)(u&63u),b=bs>>3,s=bs&7;
    attn_unit128<THRL>(b,s*64,s*64,(s>>1)*128,s*128,qb,T.Q,T.K,T.V,T.O,lds);
  }
}
#undef SBAR
#undef WAIT_BAR
}
#include <hip/hip_cooperative_groups.h>
typedef unsigned short bf16;
#define GAS __attribute__((address_space(1)))
#define LAS __attribute__((address_space(3)))
typedef unsigned v4u __attribute__((ext_vector_type(4)));
typedef unsigned v2u __attribute__((ext_vector_type(2)));
typedef float f32x4 __attribute__((ext_vector_type(4)));
#define LDS_WAIT() asm volatile("s_waitcnt lgkmcnt(0)" ::: "memory")
__device__ __forceinline__ unsigned f2bf(float f) { unsigned u = __builtin_bit_cast(unsigned, f); return (u + 0x7fffu + ((u >> 16) & 1u)) >> 16; }
__device__ __forceinline__ unsigned pk2(float lo, float hi) { return f2bf(lo) | (f2bf(hi) << 16); }
__device__ __forceinline__ float bflo(unsigned w) { return __builtin_bit_cast(float, w << 16); }
__device__ __forceinline__ float bfhi(unsigned w) { return __builtin_bit_cast(float, w & 0xffff0000u); }
__device__ __forceinline__ float bf1(unsigned short h) { return __builtin_bit_cast(float, (unsigned)h << 16); }
template <int CTRL> __device__ __forceinline__ float dppf(float x) { return __builtin_bit_cast(float, __builtin_amdgcn_update_dpp(0, __builtin_bit_cast(int, x), CTRL, 0xf, 0xf, false)); }
__device__ __forceinline__ float row16_allsum(float x) { x += dppf<0x128>(x); x += dppf<0x124>(x); x += dppf<0x122>(x); x += dppf<0x121>(x); return x; }
__device__ __forceinline__ float oct_allsum(float x) { x += dppf<0xB1>(x); x += dppf<0x4E>(x); x += dppf<0x141>(x); return x; }
__device__ __forceinline__ float u2f(unsigned u) { return __builtin_bit_cast(float, u); }
__device__ __forceinline__ unsigned f2u(float f) { return __builtin_bit_cast(unsigned, f); }
__device__ __forceinline__ float sw32(float a, float b) { auto r = __builtin_amdgcn_permlane32_swap(f2u(a), f2u(b), false, false); const unsigned r0 = r[0], r1 = r[1]; return u2f(r0) + u2f(r1); }
__device__ __forceinline__ float sw16(float a, float b) { auto r = __builtin_amdgcn_permlane16_swap(f2u(a), f2u(b), false, false); const unsigned r0 = r[0], r1 = r[1]; return u2f(r0) + u2f(r1); }
__device__ __forceinline__ float wave_allsum(float x) { x = row16_allsum(x); x = sw16(x, x); return sw32(x, x); }
__device__ __forceinline__ float red4(float x0, float x1, float x2, float x3) { return row16_allsum(sw16(sw32(x0, x1), sw32(x2, x3))); }

#define XB_TMO      128
#define XB_XCNT(j)  (256  + 64 * (j))
#define XB_XSUB(j)  (1280 + 64 * (j))
#define XB_XGEN(j)  (2304 + 64 * (j))
#define XB_TOP      3328
#define XB_TOPGEN   3392
#define XCD_BAR_WORDS 3456
#define XB_SPIN_CAP (1u << 18)

__device__ __forceinline__ unsigned xb_ld(unsigned* p)              { return __hip_atomic_load(p, __ATOMIC_RELAXED, __HIP_MEMORY_SCOPE_AGENT); }
__device__ __forceinline__ unsigned xb_add(unsigned* p, unsigned v) { return __hip_atomic_fetch_add(p, v, __ATOMIC_RELAXED, __HIP_MEMORY_SCOPE_AGENT); }
__device__ __forceinline__ unsigned xb_xcc_id() { return (unsigned)__builtin_amdgcn_s_getreg((3 << 11) | 20) & 0xFu; }
#define XB_SPIN(cond, bar) do { unsigned _sp = 0; while (cond) { __builtin_amdgcn_s_sleep(1); \
    if ((++_sp & 255u) == 0u) { if (xb_ld(&(bar)[XB_TMO])) break; if (_sp > XB_SPIN_CAP) { atomicAdd(&(bar)[XB_TMO], 1u); break; } } } } while (0)

struct XcdBarrier {
    unsigned* bar; unsigned x;
    volatile LAS unsigned* st;
};

__device__ __forceinline__ XcdBarrier xcd_barrier_post(unsigned* bar, volatile LAS unsigned* st) {
    XcdBarrier b; b.bar = bar; b.x = xb_xcc_id(); b.st = st;
    if (threadIdx.x == 0) (void)xb_add(&bar[XB_XCNT(b.x)], 1u);
    return b;
}
__device__ __forceinline__ void xcd_barrier_complete(unsigned* bar, unsigned x, unsigned& nloc, unsigned& nx) {
    const unsigned G = gridDim.x * gridDim.y * gridDim.z;
    unsigned sum, cnt, mine, sp = 0u;
    for (;;) {
        sum = 0u; cnt = 0u; mine = 0u;
#pragma unroll
        for (unsigned j = 0; j < 16; ++j) { const unsigned c = xb_ld(&bar[XB_XCNT(j)]); sum += c; cnt += (c > 0u) ? 1u : 0u; }
        mine = xb_ld(&bar[XB_XCNT(x)]);
        if (sum == G) break;
        __builtin_amdgcn_s_sleep(1);
        if ((++sp & 255u) == 0u) { if (xb_ld(&bar[XB_TMO])) break; if (sp > XB_SPIN_CAP) { atomicAdd(&bar[XB_TMO], 1u); break; } }
    }
    nloc = mine > 0u ? mine : 1u; nx = cnt > 0u ? cnt : 1u;
}

__device__ __forceinline__ void xcd_barrier(const XcdBarrier& b) {
    asm volatile("s_waitcnt vmcnt(0)" ::: "memory");
    __syncthreads();
    if (threadIdx.x == 0) {
        unsigned* bar = b.bar;
        __builtin_amdgcn_s_waitcnt(0);
        unsigned nloc = b.st[0], nx = b.st[1];
        if (nloc == 0u) { xcd_barrier_complete(bar, b.x, nloc, nx); b.st[0] = nloc; b.st[1] = nx; }
        const unsigned old = xb_add(&bar[XB_XSUB(b.x)], 1u);
        const unsigned gen = old / nloc;
        if (old + 1u == (gen + 1u) * nloc) {
            __builtin_amdgcn_fence(__ATOMIC_RELEASE, "agent");
            asm volatile("s_waitcnt vmcnt(0)" ::: "memory");
            const unsigned og = xb_add(&bar[XB_TOP], 1u);
            const unsigned tg = og / nx;
            if (og + 1u == (tg + 1u) * nx) xb_add(&bar[XB_TOPGEN], 1u);
            else XB_SPIN(xb_ld(&bar[XB_TOPGEN]) == tg, bar);
            __builtin_amdgcn_fence(__ATOMIC_ACQUIRE, "agent");
            xb_add(&bar[XB_XGEN(b.x)], 1u);
            asm volatile("s_waitcnt vmcnt(0)" ::: "memory");
        } else {
            XB_SPIN(xb_ld(&bar[XB_XGEN(b.x)]) == gen, bar);
            __builtin_amdgcn_fence(__ATOMIC_ACQUIRE, "agent");
            asm volatile("s_waitcnt vmcnt(0)" ::: "memory");
        }
    }
    __syncthreads();
}


constexpr int CW_BAR = 4096;
constexpr int MISC_OFF = 162816 + 320;
struct Frame {
    LAS unsigned char* lds;
    int tid, lane, wave, G, bx;
    float* out; unsigned char* ws;
};
struct Args { const float* in[26]; float* out; unsigned char* ws; int ph_lo, ph_hi; };
typedef const float* cfp_t;
typedef __attribute__((address_space(4))) const cfp_t* ktab_t;
struct InTab { ktab_t p; __device__ __forceinline__ const float* operator[](int i) const { return p[i]; } };
enum { I_X = 0, I_NMG, I_WIN, I_MU, I_W0, I_W2, I_A0, I_A2, I_G2, I_KK, I_KA, I_RK, I_LNG, I_LNB, I_LQ1, I_LK1, I_LQ2, I_LK2, I_SUBG, I_WA, I_WB, I_WO, I_NFG, I_FF1, I_FF2, I_NFIN };

template <bool ROPE> __device__ __forceinline__ void p0_transpose_item(const float* W, int K, int N, bf16* WT, LAS float* scr, int item, int lane, int pitch = 0, int koff = 0) {
    if (pitch == 0) pitch = K;
    const int nblk = N / 32, kb = item / nblk, nb = item % nblk, k0 = 64 * kb, n0 = 32 * nb;
#pragma unroll
    for (int i = 0; i < 8; ++i) { const int kk = 8 * i + (lane >> 3), c4 = 4 * (lane & 7); const f32x4 w4 = *(const GAS f32x4*)(W + (size_t)(k0 + kk) * N + n0 + c4);
        scr[kk * 33 + c4] = w4.x; scr[kk * 33 + c4 + 1] = w4.y; scr[kk * 33 + c4 + 2] = w4.z; scr[kk * 33 + c4 + 3] = w4.w; }
    LDS_WAIT(); asm volatile("" ::: "memory");
    const int c = lane & 7;
#pragma unroll
    for (int j = 0; j < 4; ++j) { const int n = (lane >> 3) + 8 * j; const LAS float* s = scr + (8 * c) * 33 + n;
        v4u o; o.x = pk2(s[0 * 33], s[1 * 33]); o.y = pk2(s[2 * 33], s[3 * 33]); o.z = pk2(s[4 * 33], s[5 * 33]); o.w = pk2(s[6 * 33], s[7 * 33]);
        int col = n0 + n;
        if (ROPE && col < 1024) { const int d = col & 63, dd = d & 31; col = (col & ~63) + 8 * (dd >> 2) + (d >> 5) * 4 + (dd & 3); }
        *(GAS v4u*)(WT + (size_t)col * pitch + koff + k0 + 8 * c) = o; }
    LDS_WAIT(); asm volatile("" ::: "memory");
}
__device__ __forceinline__ void rms_row_to_bf16(const float* xrow, const float* g, bf16* orow, int lane) {
    const GAS f32x4* xr = (const GAS f32x4*)xrow + lane; const f32x4* gr = (const f32x4*)g + lane;
    f32x4 v[4]; float s = 0.f;
#pragma unroll
    for (int j = 0; j < 4; ++j) { v[j] = xr[64 * j]; s += (v[j].x * v[j].x + v[j].y * v[j].y) + (v[j].z * v[j].z + v[j].w * v[j].w); }
    const float rstd = 1.0f / sqrtf(wave_allsum(s) * (1.f / D) + NORM_EPS);
    GAS unsigned long long* o8 = (GAS unsigned long long*)orow + lane;
#pragma unroll
    for (int j = 0; j < 4; ++j) { const f32x4 gg = gr[64 * j];
        o8[64 * j] = (unsigned long long)pk2(v[j].x * rstd * gg.x, v[j].y * rstd * gg.y) | ((unsigned long long)pk2(v[j].z * rstd * gg.z, v[j].w * rstd * gg.w) << 32); }
}
__device__ __forceinline__ void rms_row_to_f32(const float* xrow, const float* g, float* orow, int lane) {
    const GAS f32x4* xr = (const GAS f32x4*)xrow + lane; const f32x4* gr = (const f32x4*)g + lane;
    f32x4 v[4]; float s = 0.f;
#pragma unroll
    for (int j = 0; j < 4; ++j) { v[j] = xr[64 * j]; s += (v[j].x * v[j].x + v[j].y * v[j].y) + (v[j].z * v[j].z + v[j].w * v[j].w); }
    const float rstd = 1.0f / sqrtf(wave_allsum(s) * (1.f / D) + NORM_EPS);
    GAS f32x4* o = (GAS f32x4*)orow + lane;
#pragma unroll
    for (int j = 0; j < 4; ++j) { const f32x4 gg = gr[64 * j]; o[64 * j] = v[j] * rstd * gg; }
}
__device__ __forceinline__ void p0_prologue(Frame& F, const InTab& A) {
    LAS float* scr = (LAS float*)(F.lds + RING_OFF + F.wave * 16384);
    const int gw = F.bx * NWAVES + F.wave, NGW = F.G * NWAVES;
    unsigned char* ws = F.ws;
    constexpr int I_IN = (D / 64) * (D_IN / 32), I_A = (512 / 64) * (D / 32), I_O = (D / 64) * (D / 32), I_1 = (D / 64) * (FF / 32), I_2 = (FF / 64) * (D / 32);
    (void)I_A; (void)I_O; (void)I_1; (void)I_2;
    for (int it = gw; it < I_IN; it += NGW) p0_transpose_item<true>(A[I_WIN], D, D_IN, (bf16*)(ws + WS_WIN), scr, it, F.lane);
    if (false) for (int it = gw; it < 0; it += NGW) {
        int r = it;
        if (r < I_A) { p0_transpose_item<false>(A[I_WA], 512, D, (bf16*)(ws + WS_WA), scr, r, F.lane, 1024, 0); continue; } r -= I_A;
        if (r < I_A) { p0_transpose_item<false>(A[I_WB], 512, D, (bf16*)(ws + WS_WA), scr, r, F.lane, 1024, 512); continue; } r -= I_A;
        if (r < I_O) { p0_transpose_item<false>(A[I_WO], D, D, (bf16*)(ws + WS_WO), scr, r, F.lane); continue; } r -= I_O;
        if (r < I_1) { p0_transpose_item<false>(A[I_FF1], D, FF, (bf16*)(ws + WS_W1), scr, r, F.lane); continue; } r -= I_1;
        p0_transpose_item<false>(A[I_FF2], FF, D, (bf16*)(ws + WS_W2), scr, r, F.lane);
    }
    const int gt = F.bx * (NWAVES * 64) + F.tid, NGT = F.G * NWAVES * 64;
    for (int e = gt; e < NLORA * (KLORA / 8); e += NGT) { const int n = e % NLORA, k8 = (e / NLORA) * 8; float v[8];
#pragma unroll
        for (int i = 0; i < 8; ++i) { const int k = k8 + i; float x = 0.f;
            if (n < 512) { if (k < 64) x = A[I_W2][(size_t)k * 512 + n]; }
            else if (n < 1024) { if (k >= 64 && k < 128) x = A[I_A2][(size_t)(k - 64) * 512 + (n - 512)]; }
            else { if (k >= 128) x = A[I_G2][(size_t)(k - 128) * 512 + (n - 1024)]; }
            v[i] = x; }
        v4u o; o.x = pk2(v[0], v[1]); o.y = pk2(v[2], v[3]); o.z = pk2(v[4], v[5]); o.w = pk2(v[6], v[7]);
        *(GAS v4u*)((bf16*)(ws + WS_WL) + (size_t)n * KLORA + k8) = o; }
    for (int e = gt; e < SEQ * 32; e += NGT) { const int pos = e >> 5, i = e & 31;
        const float inv = exp2f(-(float)i * 0.41524101186092029f);
        const float ang = (float)pos * inv; float s, c; sincosf(ang, &s, &c);
        ((float*)(ws + WS_ROPE_C))[e] = c; ((float*)(ws + WS_ROPE_S))[e] = s; }
    for (int m = gw; m < M; m += 2 * NGW) {
        const int m2 = m + NGW;
        const GAS f32x4* xa = (const GAS f32x4*)(A[I_X] + (size_t)m * D) + F.lane; const GAS f32x4* xb = (const GAS f32x4*)(A[I_X] + (size_t)m2 * D) + F.lane; const f32x4* gr = (const f32x4*)A[I_NMG] + F.lane;
        f32x4 va[4], vb[4]; float sa = 0.f, sb = 0.f;
#pragma unroll
        for (int j = 0; j < 4; ++j) { va[j] = xa[64 * j]; vb[j] = xb[64 * j]; }
#pragma unroll
        for (int j = 0; j < 4; ++j) { sa += (va[j].x * va[j].x + va[j].y * va[j].y) + (va[j].z * va[j].z + va[j].w * va[j].w); sb += (vb[j].x * vb[j].x + vb[j].y * vb[j].y) + (vb[j].z * vb[j].z + vb[j].w * vb[j].w); }
        const float ra = __builtin_amdgcn_rsqf(wave_allsum(sa) * (1.f / D) + NORM_EPS), rb = __builtin_amdgcn_rsqf(wave_allsum(sb) * (1.f / D) + NORM_EPS);
        GAS unsigned long long* oa = (GAS unsigned long long*)((bf16*)(ws + WS_XN) + (size_t)m * D) + F.lane; GAS unsigned long long* ob = (GAS unsigned long long*)((bf16*)(ws + WS_XN) + (size_t)m2 * D) + F.lane;
#pragma unroll
        for (int j = 0; j < 4; ++j) { const f32x4 gg = gr[64 * j];
            oa[64 * j] = (unsigned long long)pk2(va[j].x * ra * gg.x, va[j].y * ra * gg.y) | ((unsigned long long)pk2(va[j].z * ra * gg.z, va[j].w * ra * gg.w) << 32);
            ob[64 * j] = (unsigned long long)pk2(vb[j].x * rb * gg.x, vb[j].y * rb * gg.y) | ((unsigned long long)pk2(vb[j].z * rb * gg.z, vb[j].w * rb * gg.w) << 32); }
    }
}

__device__ __forceinline__ void late_weights(Frame& F, const InTab& A, int part, int nparts, int cu0) {
    int lane_ = F.lane; asm volatile("" : "+v"(lane_));
    LAS float* scr = (LAS float*)(F.lds + RING_OFF + F.wave * 16384);
    unsigned char* ws = F.ws;
    constexpr int I_A = (512 / 64) * (D / 32), I_O = (D / 64) * (D / 32), I_1 = (D / 64) * (FF / 32), I_2 = (FF / 64) * (D / 32), NIT = 2 * I_A + I_O + I_1 + I_2;
    const int per = NIT / nparts, lo = part * per, hi = lo + per;
    const int gw = (F.bx - cu0) * NWAVES + F.wave, NGW = (F.G - cu0) * NWAVES;
    for (int it = lo + gw; it < hi; it += NGW) {
        int r = it;
        if (r < I_A) { p0_transpose_item<false>(A[I_WA], 512, D, (bf16*)(ws + WS_WA), scr, r, lane_, 1024, 0); continue; } r -= I_A;
        if (r < I_A) { p0_transpose_item<false>(A[I_WB], 512, D, (bf16*)(ws + WS_WA), scr, r, lane_, 1024, 512); continue; } r -= I_A;
        if (r < I_O) { p0_transpose_item<false>(A[I_WO], D, D, (bf16*)(ws + WS_WO), scr, r, lane_); continue; } r -= I_O;
        if (r < I_1) { p0_transpose_item<false>(A[I_FF1], D, FF, (bf16*)(ws + WS_W1), scr, r, lane_); continue; } r -= I_1;
        p0_transpose_item<false>(A[I_FF2], FF, D, (bf16*)(ws + WS_W2), scr, r, lane_);
    }
}
__device__ __forceinline__ void prep1_rows(Frame& F, const InTab& A, int g0, int g1, int w, int nw) {
    const int lane = F.lane;
    const bf16* WAG = (const bf16*)(F.ws + WS_WAG); bf16* LIN = (bf16*)(F.ws + WS_LIN);
    const f32x4 mu = *(const f32x4*)(A[I_MU] + 1536 + 4 * lane);
    for (int g = g0 + w; g < g1; g += nw) {
        const int m0 = g * 8; v2u row[9];
        row[0] = (v2u){0u, 0u}; if ((m0 & (SEQ - 1)) != 0) row[0] = *(const GAS v2u*)(WAG + (size_t)(m0 - 1) * 256 + 4 * lane);
#pragma unroll
        for (int j = 0; j < 8; ++j) row[j + 1] = *(const GAS v2u*)(WAG + (size_t)(m0 + j) * 256 + 4 * lane);
#pragma unroll
        for (int j = 0; j < 8; ++j) {
            float z[4] = {bflo(row[j + 1].x), bfhi(row[j + 1].x), bflo(row[j + 1].y), bfhi(row[j + 1].y)}; const float p[4] = {bflo(row[j].x), bfhi(row[j].x), bflo(row[j].y), bfhi(row[j].y)};
#pragma unroll
            for (int e = 0; e < 4; ++e) { float v = z[e] + (p[e] - z[e]) * mu[e];
                if (lane < 16) v = 1.0f - 2.0f * __builtin_amdgcn_rcpf(1.0f + __expf(2.0f * v));
                else if (lane >= 32) v = __builtin_amdgcn_rcpf(1.0f + __expf(-v));
                z[e] = v; }
            v2u o; o.x = pk2(z[0], z[1]); o.y = pk2(z[2], z[3]);
            *(GAS v2u*)(LIN + (size_t)(m0 + j) * 256 + 4 * lane) = o;
        }
    }
}
struct ScanRaw { unsigned short r[9], k[9], v[9], a[8]; float d[8]; };
__device__ __forceinline__ void scan_load(ScanRaw& R, const bf16* RKV, const float* DEC, const bf16* AA, size_t row0, int t0, int c) {
#pragma unroll
    for (int j = 0; j < 9; ++j) { int t = t0 - 1 + j; if (t < 0) t = 0; const bf16* p = RKV + (row0 + t) * 1536 + c;
        R.r[j] = *(const GAS bf16*)p; R.k[j] = *(const GAS bf16*)(p + 512); R.v[j] = *(const GAS bf16*)(p + 1024); }
#pragma unroll
    for (int j = 0; j < 8; ++j) { R.d[j] = *(const GAS float*)(DEC + (row0 + t0 + j) * 512 + c); R.a[j] = *(const GAS bf16*)(AA + (row0 + t0 + j) * 512 + c); }
}
__device__ __forceinline__ void scan_phase(Frame& F, const InTab& A, int si) {
    const int lane = F.lane, wave = F.wave, tid = F.tid;
    const int bh = si >> 1, half = si & 1, b = bh >> 3, h = bh & 7, c = h * 64 + lane;
    LAS float* IN = (LAS float*)(F.lds + RING_OFF);
    LAS float* VV = IN + 5 * 4096;
    LAS float* YBUF = VV + 2048;
    const bf16* RKV = (const bf16*)(F.ws + WS_RKV); const float* DEC = (const float*)(F.ws + WS_DEC); const bf16* AA = (const bf16*)(F.ws + WS_AA);
    bf16* Y = (bf16*)(F.ws + WS_Y); float* BON = (float*)(F.ws + WS_BON);
    const float mu_r = A[I_MU][c], mu_k = A[I_MU][512 + c], mu_v = A[I_MU][1024 + c], kkc = A[I_KK][c], kac = A[I_KA][c], rkc = A[I_RK][c];
    const size_t row0 = (size_t)b * SEQ;
    const int myv = (int)(red4(0.f, 1.f, 2.f, 3.f) * (1.0f / 64.0f) + 0.5f);
    const int L0 = __builtin_ctzll(__ballot(myv == 0)), L1 = __builtin_ctzll(__ballot(myv == 1)), L2 = __builtin_ctzll(__ballot(myv == 2)), L3 = __builtin_ctzll(__ballot(myv == 3));
    float S0 = 0.f, S1 = 0.f, S2 = 0.f, S3 = 0.f;
    ScanRaw R; scan_load(R, RKV, DEC, AA, row0, wave * 8, c);
    for (int blk = 0; blk < SEQ / 64; ++blk) {
        {
            const int t0 = blk * 64 + wave * 8;
            f32x4 qd[2], qa[2], qb[2], qk[2], qr[2], qv[2];
#pragma unroll
            for (int j = 0; j < 8; ++j) {
                const float pz = (t0 + j == 0) ? 0.f : 1.f;
                const float rt_ = bf1(R.r[j + 1]), kt_ = bf1(R.k[j + 1]), vt_ = bf1(R.v[j + 1]);
                const float rs = rt_ + (bf1(R.r[j]) * pz - rt_) * mu_r, ks = kt_ + (bf1(R.k[j]) * pz - kt_) * mu_k, vs = vt_ + (bf1(R.v[j]) * pz - vt_) * mu_v;
                const float kkr = ks * kkc, n2 = wave_allsum(kkr * kkr), kk = kkr / __builtin_fmaxf(sqrtf(n2), 1e-12f);
                const float a = 1.0f / (1.0f + __expf(-bf1(R.a[j]))), kx = ks * (1.0f + (a - 1.0f) * kac);
                const float bon = wave_allsum(rs * kx * rkc);
                if (half == 0 && lane == 0) BON[(row0 + t0 + j) * 8 + h] = bon;
                qd[j >> 2][j & 3] = __expf(-0.6065306597f / (1.0f + __expf(-R.d[j])));     qa[j >> 2][j & 3] = -kk; qb[j >> 2][j & 3] = kk * a; qk[j >> 2][j & 3] = kx; qr[j >> 2][j & 3] = rs; qv[j >> 2][j & 3] = vs;
            }
#pragma unroll
            for (int q = 0; q < 2; ++q) { const int t4 = wave * 2 + q; LAS f32x4* p = (LAS f32x4*)IN + t4 * 64 + lane;
                p[0 * 1024] = qd[q]; p[1 * 1024] = qa[q]; p[2 * 1024] = qb[q]; p[3 * 1024] = qk[q]; p[4 * 1024] = qr[q];
                if ((lane >> 5) == half) ((LAS f32x4*)VV)[t4 * 32 + (lane & 31)] = qv[q]; }
        }
        __syncthreads();
        if (blk + 1 < SEQ / 64) scan_load(R, RKV, DEC, AA, row0, (blk + 1) * 64 + wave * 8, c);
#pragma unroll 1
        for (int t4 = 0; t4 < 16; ++t4) {
            const LAS f32x4* p = (const LAS f32x4*)IN + t4 * 64 + lane;
            const f32x4 W4 = p[0], A4 = p[1024], B4 = p[2048], K4 = p[3072], R4 = p[4096];
            const LAS f32x4* pv = (const LAS f32x4*)VV + t4 * 32 + wave * 4;
            const f32x4 V0 = pv[0], V1 = pv[1], V2 = pv[2], V3 = pv[3];
            f32x4 yq;
#pragma unroll
            for (int ts = 0; ts < 4; ++ts) {
                const float w = W4[ts], a = A4[ts], bb = B4[ts], kx = K4[ts], r = R4[ts];
                const float t = red4(S0 * a, S1 * a, S2 * a, S3 * a);
                const float sa0 = __builtin_bit_cast(float, __builtin_amdgcn_readlane(__builtin_bit_cast(int, t), L0)), sa1 = __builtin_bit_cast(float, __builtin_amdgcn_readlane(__builtin_bit_cast(int, t), L1));
                const float sa2 = __builtin_bit_cast(float, __builtin_amdgcn_readlane(__builtin_bit_cast(int, t), L2)), sa3 = __builtin_bit_cast(float, __builtin_amdgcn_readlane(__builtin_bit_cast(int, t), L3));
                S0 = S0 * w + (sa0 * bb + V0[ts] * kx); S1 = S1 * w + (sa1 * bb + V1[ts] * kx); S2 = S2 * w + (sa2 * bb + V2[ts] * kx); S3 = S3 * w + (sa3 * bb + V3[ts] * kx);
                yq[ts] = red4(S0 * r, S1 * r, S2 * r, S3 * r);
            }
            if ((lane & 15) == 0) *(LAS f32x4*)(YBUF + (wave * 4 + myv) * 68 + t4 * 4) = yq;
        }
        __syncthreads();
        { const int t = tid >> 3, rg = tid & 7; const LAS float* yb = YBUF + (4 * rg) * 68 + t;
          v2u o; o.x = pk2(yb[0], yb[68]); o.y = pk2(yb[136], yb[204]);
          *(GAS v2u*)(Y + (row0 + blk * 64 + t) * 512 + h * 64 + 32 * half + 4 * rg) = o; }
    }
    __syncthreads();
}
__device__ __forceinline__ void post_ya(Frame& F, const InTab& A, int w, int nw) {
    int lane = F.lane; asm volatile("" : "+v"(lane));
    const bf16* O = (const bf16*)(F.ws + WS_O); bf16* YA = (bf16*)(F.ws + WS_YA);
    const float lam = __expf(wave_allsum(A[I_LQ1][lane] * A[I_LK1][lane])) - __expf(wave_allsum(A[I_LQ2][lane] * A[I_LK2][lane])) + LAMBDA_INIT;
    const int ca = 8 * lane, ha = lane >> 4, ea = ca & 127;
    float sg[8];
#pragma unroll
    for (int e = 0; e < 8; ++e) sg[e] = A[I_SUBG][ea + e] * (1.0f - LAMBDA_INIT);
#define UNPK8(w_) {bflo(w_.x), bfhi(w_.x), bflo(w_.y), bfhi(w_.y), bflo(w_.z), bfhi(w_.z), bflo(w_.w), bfhi(w_.w)}
    for (int g = w; g < M / 4; g += nw) {
        const int m0 = g * 4;
        v4u o0[4], o1[4];
#pragma unroll
        for (int j = 0; j < 4; ++j) { const size_t mm = (size_t)(m0 + j);
            o0[j] = *(const GAS v4u*)(O + mm * 1024 + (2 * ha) * 128 + ea); o1[j] = *(const GAS v4u*)(O + mm * 1024 + (2 * ha + 1) * 128 + ea); }
        asm volatile("s_waitcnt vmcnt(0)" ::: "memory");
#pragma unroll
        for (int j = 0; j < 4; ++j) { const size_t mm = (size_t)(m0 + j);
            const float a0[8] = UNPK8(o0[j]), a1[8] = UNPK8(o1[j]); float o[8], ss = 0.f;
#pragma unroll
            for (int e = 0; e < 8; ++e) { o[e] = a0[e] - lam * a1[e]; ss += o[e] * o[e]; }
            const float rstd = __builtin_amdgcn_rsqf(row16_allsum(ss) * (1.0f / 128.0f) + SUBLN_EPS);
            v4u wv; wv.x = pk2(o[0] * rstd * sg[0], o[1] * rstd * sg[1]); wv.y = pk2(o[2] * rstd * sg[2], o[3] * rstd * sg[3]); wv.z = pk2(o[4] * rstd * sg[4], o[5] * rstd * sg[5]); wv.w = pk2(o[6] * rstd * sg[6], o[7] * rstd * sg[7]);
            *(GAS v4u*)(YA + mm * 1024 + ca) = wv;
        }
    }
#undef UNPK8
}

typedef short rk_bf16x8 __attribute__((ext_vector_type(8)));
typedef float rk_f32x16 __attribute__((ext_vector_type(16)));
constexpr int RKA_RS_K = 144, RKA_RS_J = 80;
constexpr int RKA_A = 0, RKA_B = 5120, RKA_K = 10240, RKA_R = 15360, RKA_AT = 19968, RKA_BH = 25088, RKA_KH = 30208, RKA_VT = 35328, RKA_GC = 40448, RKA_BYTES = 40704;
constexpr int RKA_N = 0, RKA_X = 0, RKA_T = 5120, RKA_MAK = 7680, RKA_MRB = 10240, RKA_MRK = 12800;
constexpr int RKA_WAVES = 4;
static_assert(RKA_WAVES * RKA_BYTES <= 162816, "phase A LDS");
constexpr size_t WS_PQ0 = 66 * MiB, WS_PQ1 = 34 * MiB;
constexpr size_t WS_RY0 = 98 * MiB, WS_RY1 = 178 * MiB;
constexpr size_t WS_GC = 250 * MiB;
__device__ __forceinline__ unsigned char* rk_pq(unsigned char* ws, int half) { return ws + (half ? WS_PQ1 : WS_PQ0); }
__device__ __forceinline__ unsigned char* rk_ry(unsigned char* ws, int half) { return ws + (half ? WS_RY1 : WS_RY0); }
__device__ __forceinline__ unsigned char* rk_gc(unsigned char* ws, int half) { return ws + WS_GC + (size_t)half * (2048 * 256); }
constexpr size_t WS_SST = 251 * MiB;

__device__ __forceinline__ rk_bf16x8 rk_frag(const LAS unsigned char* base, int rs, int row, int s, int h) { return *(const LAS rk_bf16x8*)(base + row * rs + (16 * s + 8 * h) * 2); }
__device__ __forceinline__ rk_f32x16 rk_mfma(rk_bf16x8 a, rk_bf16x8 b, rk_f32x16 c) { return __builtin_amdgcn_mfma_f32_32x32x16_bf16(a, b, c, 0, 0, 0); }
__device__ __forceinline__ unsigned rk_pk(float lo, float hi) { typedef float f2_ __attribute__((ext_vector_type(2))); typedef __bf16 b2_ __attribute__((ext_vector_type(2))); f2_ v = {lo, hi}; b2_ b = __builtin_convertvector(v, b2_); return __builtin_bit_cast(unsigned, b); }
__device__ __forceinline__ void rk_store_tile_lds(LAS unsigned char* base, int rs, int nrow, int mbase, int h, const rk_f32x16& acc) {
#pragma unroll
    for (int g = 0; g < 4; ++g) { v2u w; w.x = rk_pk(acc[4 * g], acc[4 * g + 1]); w.y = rk_pk(acc[4 * g + 2], acc[4 * g + 3]); *(LAS v2u*)(base + nrow * rs + (mbase + 8 * g + 4 * h) * 2) = w; }
}
__device__ __forceinline__ void rk_store_tile_glb(bf16* base, int pitch, int nrow, int mbase, int h, const rk_f32x16& acc) {
#pragma unroll
    for (int g = 0; g < 4; ++g) { v2u w; w.x = rk_pk(acc[4 * g], acc[4 * g + 1]); w.y = rk_pk(acc[4 * g + 2], acc[4 * g + 3]); *(GAS v2u*)(base + (size_t)nrow * pitch + mbase + 8 * g + 4 * h) = w; }
}
__device__ __forceinline__ void rk_store_tile_frag(unsigned char* base, int nt, int r32, int mt, int h, const rk_f32x16& acc) {
#pragma unroll
    for (int g = 0; g < 4; ++g) { v2u w; w.x = rk_pk(acc[4 * g], acc[4 * g + 1]); w.y = rk_pk(acc[4 * g + 2], acc[4 * g + 3]);
        *(GAS v2u*)(base + ((size_t)((nt * 4 + 2 * mt + (g >> 1)) * 64 + r32 + 32 * (g & 1))) * 16 + 8 * h) = w; }
}
__device__ __forceinline__ void rk_store_blob(unsigned* blob, int lane, const rk_f32x16& acc) {
    v4u w0, w1; w0.x = rk_pk(acc[0], acc[1]); w0.y = rk_pk(acc[2], acc[3]); w0.z = rk_pk(acc[4], acc[5]); w0.w = rk_pk(acc[6], acc[7]);
    w1.x = rk_pk(acc[8], acc[9]); w1.y = rk_pk(acc[10], acc[11]); w1.z = rk_pk(acc[12], acc[13]); w1.w = rk_pk(acc[14], acc[15]);
    *(GAS v4u*)(blob + lane * 8) = w0; *(GAS v4u*)(blob + lane * 8 + 4) = w1;
}
struct RkBlob { v4u w0, w1; };
__device__ __forceinline__ RkBlob rk_load_blob(const unsigned* blob, int lane) { RkBlob b; b.w0 = *(const GAS v4u*)(blob + lane * 8); b.w1 = *(const GAS v4u*)(blob + lane * 8 + 4); return b; }
__device__ __forceinline__ rk_f32x16 rk_blob_f32(const RkBlob& b) {
    rk_f32x16 a; const unsigned w[8] = {b.w0.x, b.w0.y, b.w0.z, b.w0.w, b.w1.x, b.w1.y, b.w1.z, b.w1.w};
#pragma unroll
    for (int i = 0; i < 8; ++i) { a[2 * i] = bflo(w[i]); a[2 * i + 1] = bfhi(w[i]); }
    return a;
}

struct RkRaw { unsigned short r[8], k[8], v[8]; };
__device__ __forceinline__ void rk_load8(RkRaw& R, const bf16* prkv) {
#pragma unroll
    for (int j = 0; j < 8; ++j) { R.r[j] = *(const GAS bf16*)(prkv + j * 1536); R.k[j] = *(const GAS bf16*)(prkv + j * 1536 + 512); R.v[j] = *(const GAS bf16*)(prkv + j * 1536 + 1024); }
}
__device__ __forceinline__ void rwkvA_unit(LAS unsigned char* L, const InTab& A, unsigned char* ws, int bh, int chunk, int lane_in) {
    int lane = lane_in; asm volatile("" : "+v"(lane));
    const int b = bh >> 3, hd = bh & 7, cg = hd * 64 + lane, r32 = lane & 31, h = lane >> 5;
    const size_t row0 = (size_t)b * SEQ + (size_t)chunk * 32;
    const int uh = bh * 32 + (chunk & 31);
    const bf16* prkv = (const bf16*)(ws + WS_RKV) + row0 * 1536 + cg;
    float* pbon = (float*)(ws + WS_BON) + row0 * 8 + hd;
    const float mu_r = A[I_MU][cg], mu_k = A[I_MU][512 + cg], mu_v = A[I_MU][1024 + cg], kkc = A[I_KK][cg], kac = A[I_KA][cg], rkc = A[I_RK][cg], w0c = A[I_W0][cg], a0c = A[I_A0][cg];
    float dW[32], dA[32];
    {
        rk_f32x16 lw[2] = {{}, {}}, la[2] = {{}, {}};
        const bf16* lp = (const bf16*)(ws + WS_LIN) + (row0 + r32) * 256 + 8 * h;
        const bf16* wp = (const bf16*)(ws + WS_WL) + (size_t)(hd * 64 + r32) * 256 + 8 * h;
#pragma unroll
        for (int s2 = 0; s2 < 4; ++s2) { const rk_bf16x8 fw = __builtin_bit_cast(rk_bf16x8, *(const GAS v4u*)(lp + 16 * s2)), fa = __builtin_bit_cast(rk_bf16x8, *(const GAS v4u*)(lp + 64 + 16 * s2));
#pragma unroll
            for (int ct = 0; ct < 2; ++ct) { lw[ct] = rk_mfma(fw, __builtin_bit_cast(rk_bf16x8, *(const GAS v4u*)(wp + (size_t)ct * 32 * 256 + 16 * s2)), lw[ct]);
                la[ct] = rk_mfma(fa, __builtin_bit_cast(rk_bf16x8, *(const GAS v4u*)(wp + (size_t)(512 + ct * 32) * 256 + 64 + 16 * s2)), la[ct]); } }
#pragma unroll
        for (int i = 0; i < 16; ++i) { const int tb = (i & 3) + 8 * (i >> 2);
            { auto r = __builtin_amdgcn_permlane32_swap(f2u(lw[0][i]), f2u(lw[1][i]), false, false); const unsigned r0 = r[0], r1 = r[1]; dW[tb] = u2f(r0); dW[tb + 4] = u2f(r1); }
            { auto r = __builtin_amdgcn_permlane32_swap(f2u(la[0][i]), f2u(la[1][i]), false, false); const unsigned r0 = r[0], r1 = r[1]; dA[tb] = u2f(r0); dA[tb + 4] = u2f(r1); } }
    }
    const int myv = (int)(red4(0.f, 1.f, 2.f, 3.f) * (1.0f / 64.0f) + 0.5f);
    const int L0 = __builtin_ctzll(__ballot(myv == 0)), L1 = __builtin_ctzll(__ballot(myv == 1)), L2 = __builtin_ctzll(__ballot(myv == 2)), L3 = __builtin_ctzll(__ballot(myv == 3));
    float rp = 0.f, kp = 0.f, vp = 0.f;
    if (chunk != 0) { rp = bf1(*(const GAS bf16*)(prkv - 1536)); kp = bf1(*(const GAS bf16*)(prkv - 1536 + 512)); vp = bf1(*(const GAS bf16*)(prkv - 1536 + 1024)); }
    float G = 1.0f;
    RkRaw Rc, Rn; rk_load8(Rc, prkv);
#pragma unroll
    for (int q = 0; q < 4; ++q) {
        prkv += 8 * 1536;
        if (q < 3) rk_load8(Rn, prkv);
        LAS unsigned char* Lr = L + (8 * q) * RKA_RS_K + lane * 2;
        LAS unsigned char* Lt = L + lane * RKA_RS_J + (8 * q) * 2;
        unsigned tA[4], tB[4], tK[4], tV[4], pA = 0, pB = 0, pK = 0, pV = 0;
        float rs_[8], kx_[8], kkr_[8], a8_[8], w8_[8], vs_[8];
#pragma unroll
        for (int j = 0; j < 8; ++j) {
            const float rc = bf1(Rc.r[j]), kc = bf1(Rc.k[j]), vc = bf1(Rc.v[j]);
            const float ks = kc + (kp - kc) * mu_k; rs_[j] = rc + (rp - rc) * mu_r; vs_[j] = vc + (vp - vc) * mu_v; rp = rc; kp = kc; vp = vc;
            kkr_[j] = ks * kkc; a8_[j] = __builtin_amdgcn_rcpf(1.0f + __expf(-(a0c + dA[8 * q + j]))); kx_[j] = ks * (1.0f + (a8_[j] - 1.0f) * kac);
            w8_[j] = __expf(-0.6065306597f * __builtin_amdgcn_rcpf(1.0f + __expf(-(w0c + dW[8 * q + j]))));
        }
        float n2_[8], bon_[8];
#pragma unroll
        for (int j = 0; j < 8; j += 2) {
            const float t = red4(kkr_[j] * kkr_[j], kkr_[j + 1] * kkr_[j + 1], rs_[j] * kx_[j] * rkc, rs_[j + 1] * kx_[j + 1] * rkc);
            n2_[j] = __builtin_bit_cast(float, __builtin_amdgcn_readlane(__builtin_bit_cast(int, t), L0)); n2_[j + 1] = __builtin_bit_cast(float, __builtin_amdgcn_readlane(__builtin_bit_cast(int, t), L1));
            bon_[j] = __builtin_bit_cast(float, __builtin_amdgcn_readlane(__builtin_bit_cast(int, t), L2)); bon_[j + 1] = __builtin_bit_cast(float, __builtin_amdgcn_readlane(__builtin_bit_cast(int, t), L3));
        }
        if (lane < 8) { float bv = bon_[0];
#pragma unroll
            for (int j = 1; j < 8; ++j) bv = (lane == j) ? bon_[j] : bv;
            *(GAS float*)(pbon + (8 * q + lane) * 8) = bv; }
        unsigned tR[4];
#pragma unroll
        for (int j = 0; j < 8; j += 2) {
            const float kk0 = kkr_[j] * __builtin_amdgcn_rsqf(__builtin_fmaxf(n2_[j], 1e-24f)), kk1 = kkr_[j + 1] * __builtin_amdgcn_rsqf(__builtin_fmaxf(n2_[j + 1], 1e-24f));
            const float G0 = G; const float G1 = G0 * w8_[j]; G = G1 * w8_[j + 1]; const float i1 = __builtin_amdgcn_rcpf(G1), i2 = __builtin_amdgcn_rcpf(G);
            tA[j >> 1] = rk_pk(-kk0 * G0, -kk1 * G1); tR[j >> 1] = rk_pk(rs_[j] * G1, rs_[j + 1] * G); tB[j >> 1] = rk_pk(kk0 * a8_[j] * i1, kk1 * a8_[j + 1] * i2); tK[j >> 1] = rk_pk(kx_[j] * i1, kx_[j + 1] * i2); tV[j >> 1] = rk_pk(vs_[j], vs_[j + 1]);
            *(LAS bf16*)(Lr + RKA_A + j * RKA_RS_K) = (bf16)(tA[j >> 1] & 0xffffu); *(LAS bf16*)(Lr + RKA_A + (j + 1) * RKA_RS_K) = (bf16)(tA[j >> 1] >> 16);
            *(LAS bf16*)(Lr + RKA_R + j * RKA_RS_K) = (bf16)(tR[j >> 1] & 0xffffu); *(LAS bf16*)(Lr + RKA_R + (j + 1) * RKA_RS_K) = (bf16)(tR[j >> 1] >> 16);
            *(LAS bf16*)(Lr + RKA_B + j * RKA_RS_K) = (bf16)(tB[j >> 1] & 0xffffu); *(LAS bf16*)(Lr + RKA_B + (j + 1) * RKA_RS_K) = (bf16)(tB[j >> 1] >> 16);
            *(LAS bf16*)(Lr + RKA_K + j * RKA_RS_K) = (bf16)(tK[j >> 1] & 0xffffu); *(LAS bf16*)(Lr + RKA_K + (j + 1) * RKA_RS_K) = (bf16)(tK[j >> 1] >> 16);
        }
        (void)pA; (void)pB; (void)pK; (void)pV;
        *(LAS v4u*)(Lt + RKA_AT) = (v4u){tA[0], tA[1], tA[2], tA[3]}; *(LAS v4u*)(Lt + RKA_BH) = (v4u){tB[0], tB[1], tB[2], tB[3]}; *(LAS v4u*)(Lt + RKA_KH) = (v4u){tK[0], tK[1], tK[2], tK[3]}; *(LAS v4u*)(Lt + RKA_VT) = (v4u){tV[0], tV[1], tV[2], tV[3]};
        Rc = Rn;
    }
    const float GC = G;
    *(GAS float*)((float*)rk_gc(ws, chunk >> 5) + (size_t)uh * 64 + lane) = GC;
    *(LAS float*)(L + RKA_GC + lane * 4) = GC;
    LDS_WAIT(); asm volatile("" ::: "memory");
    {
        rk_f32x16 aN = {}, aAK = {}, aRB = {}, aRK = {};
#pragma unroll
        for (int s = 0; s < 4; ++s) {
            const rk_bf16x8 fA = rk_frag(L + RKA_A, RKA_RS_K, r32, s, h), fR = rk_frag(L + RKA_R, RKA_RS_K, r32, s, h), fB = rk_frag(L + RKA_B, RKA_RS_K, r32, s, h), fK = rk_frag(L + RKA_K, RKA_RS_K, r32, s, h);
            aN = rk_mfma(fB, fA, aN); aAK = rk_mfma(fK, fA, aAK); aRB = rk_mfma(fB, fR, aRB); aRK = rk_mfma(fK, fR, aRK);
        }
        LDS_WAIT(); asm volatile("" ::: "memory");
#pragma unroll
        for (int i = 0; i < 16; ++i) { const int j = (i & 3) + 8 * (i >> 2) + 4 * h;
            if (!(j < r32)) { aN[i] = 0.f; aAK[i] = 0.f; }
            if (!(j <= r32)) { aRB[i] = 0.f; aRK[i] = 0.f; } }
#pragma unroll
        for (int g = 0; g < 4; ++g) *(LAS f32x4*)(L + RKA_N + r32 * 144 + (8 * g + 4 * h) * 4) = (f32x4){aN[4 * g], aN[4 * g + 1], aN[4 * g + 2], aN[4 * g + 3]};
        rk_store_tile_lds(L + RKA_MAK, RKA_RS_J, r32, 0, h, aAK); rk_store_tile_lds(L + RKA_MRB, RKA_RS_J, r32, 0, h, aRB); rk_store_tile_lds(L + RKA_MRK, RKA_RS_J, r32, 0, h, aRK);
        rk_store_tile_lds(L + RKA_T, RKA_RS_J, r32, 0, h, aN);
    }
    LDS_WAIT(); asm volatile("" ::: "memory");
    {
        const int blk = (r32 >> 4) & 1, cc = r32 & 15;
        const LAS unsigned char* Nb = L + RKA_N + (16 * blk) * 144 + (16 * blk) * 4;
        float T[16];
#pragma unroll
        for (int t = 0; t < 16; ++t) { float ac[4] = {(cc == t) ? 1.0f : 0.0f, 0.f, 0.f, 0.f};
#pragma unroll
            for (int j4 = 0; j4 < (t + 3) / 4; ++j4) { const f32x4 n4 = *(const LAS f32x4*)(Nb + t * 144 + j4 * 16);
#pragma unroll
                for (int e = 0; e < 4; ++e) if (4 * j4 + e < t) ac[e] += n4[e] * T[4 * j4 + e]; }
            T[t] = (ac[0] + ac[1]) + (ac[2] + ac[3]); }
        LDS_WAIT(); asm volatile("" ::: "memory");
#pragma unroll
        for (int t = 0; t < 16; ++t) *(LAS bf16*)(L + RKA_T + (16 * blk + t) * RKA_RS_J + r32 * 2) = (bf16)f2bf(T[t]);
        if (blk == 0) { LAS v4u* p = (LAS v4u*)(L + RKA_N + cc * RKA_RS_J);
            p[0] = (v4u){pk2(T[0], T[1]), pk2(T[2], T[3]), pk2(T[4], T[5]), pk2(T[6], T[7])}; p[1] = (v4u){pk2(T[8], T[9]), pk2(T[10], T[11]), pk2(T[12], T[13]), pk2(T[14], T[15])}; }
        LDS_WAIT(); asm volatile("" ::: "memory");
        rk_f32x16 xa = {};
        xa = rk_mfma(*(const LAS rk_bf16x8*)(L + RKA_T + (16 + r32) * RKA_RS_J + 16 * h), *(const LAS rk_bf16x8*)(L + RKA_N + r32 * RKA_RS_J + 16 * h), xa);
        if (r32 < 16) {
#pragma unroll
            for (int g = 0; g < 2; ++g) { v2u w; w.x = rk_pk(xa[4 * g], xa[4 * g + 1]); w.y = rk_pk(xa[4 * g + 2], xa[4 * g + 3]); *(LAS v2u*)(L + RKA_N + 1280 + r32 * RKA_RS_J + (8 * g + 4 * h) * 2) = w; } }
        LDS_WAIT(); asm volatile("" ::: "memory");
        rk_f32x16 ta = {};
        ta = rk_mfma(*(const LAS rk_bf16x8*)(L + RKA_N + 1280 + r32 * RKA_RS_J + 16 * h), *(const LAS rk_bf16x8*)(L + RKA_T + (16 + r32) * RKA_RS_J + (16 + 8 * h) * 2), ta);
        LDS_WAIT(); asm volatile("" ::: "memory");
        if (r32 < 16) {
#pragma unroll
            for (int g = 0; g < 2; ++g) { v2u w; w.x = rk_pk(ta[4 * g], ta[4 * g + 1]); w.y = rk_pk(ta[4 * g + 2], ta[4 * g + 3]); *(LAS v2u*)(L + RKA_T + (16 + r32) * RKA_RS_J + (8 * g + 4 * h) * 2) = w; } }
    }
    LDS_WAIT(); asm volatile("" ::: "memory");
    rk_bf16x8 fT[2];
#pragma unroll
    for (int s = 0; s < 2; ++s) fT[s] = rk_frag(L + RKA_T, RKA_RS_J, r32, s, h);
    {
        rk_f32x16 x0[2] = {{}, {}}, ap[2] = {{}, {}};
#pragma unroll
        for (int s = 0; s < 2; ++s) { const rk_bf16x8 fM = rk_frag(L + RKA_MAK, RKA_RS_J, r32, s, h);
#pragma unroll
            for (int nt = 0; nt < 2; ++nt) { x0[nt] = rk_mfma(fM, rk_frag(L + RKA_VT, RKA_RS_J, nt * 32 + r32, s, h), x0[nt]); ap[nt] = rk_mfma(fT[s], rk_frag(L + RKA_AT, RKA_RS_J, nt * 32 + r32, s, h), ap[nt]); } }
        LDS_WAIT(); asm volatile("" ::: "memory");
#pragma unroll
        for (int nt = 0; nt < 2; ++nt) { rk_store_tile_lds(L + RKA_X, RKA_RS_J, nt * 32 + r32, 0, h, x0[nt]); rk_store_tile_lds(L + RKA_AT, RKA_RS_J, nt * 32 + r32, 0, h, ap[nt]); }
    }
    LDS_WAIT(); asm volatile("" ::: "memory");
    {
        rk_f32x16 u0[2] = {{}, {}};
#pragma unroll
        for (int s = 0; s < 2; ++s)
#pragma unroll
            for (int nt = 0; nt < 2; ++nt) u0[nt] = rk_mfma(fT[s], rk_frag(L + RKA_X, RKA_RS_J, nt * 32 + r32, s, h), u0[nt]);
        LDS_WAIT(); asm volatile("" ::: "memory");
#pragma unroll
        for (int nt = 0; nt < 2; ++nt) rk_store_tile_lds(L + RKA_X, RKA_RS_J, nt * 32 + r32, 0, h, u0[nt]);
    }
    LDS_WAIT(); asm volatile("" ::: "memory");
    unsigned char* pq = rk_pq(ws, chunk >> 5) + (size_t)uh * 16384; unsigned char* ry = rk_ry(ws, chunk >> 5) + (size_t)uh * 8192;
    rk_bf16x8 fRB[2], fRK[2], fAp[2][2], fBh[2][2], fKh[2][2], fU[2][2], fV[2][2];
#pragma unroll
    for (int s = 0; s < 2; ++s) { fRB[s] = rk_frag(L + RKA_MRB, RKA_RS_J, r32, s, h); fRK[s] = rk_frag(L + RKA_MRK, RKA_RS_J, r32, s, h);
#pragma unroll
        for (int nt = 0; nt < 2; ++nt) { fAp[nt][s] = rk_frag(L + RKA_AT, RKA_RS_J, nt * 32 + r32, s, h); fBh[nt][s] = rk_frag(L + RKA_BH, RKA_RS_J, nt * 32 + r32, s, h);
            fKh[nt][s] = rk_frag(L + RKA_KH, RKA_RS_J, nt * 32 + r32, s, h); fU[nt][s] = rk_frag(L + RKA_X, RKA_RS_J, nt * 32 + r32, s, h); fV[nt][s] = rk_frag(L + RKA_VT, RKA_RS_J, nt * 32 + r32, s, h); } }
#pragma unroll
    for (int kt = 0; kt < 2; ++kt) {
        rk_f32x16 acc;
#pragma unroll
        for (int g = 0; g < 4; ++g) { const v2u w = *(const LAS v2u*)(L + RKA_R + r32 * RKA_RS_K + (kt * 32 + 8 * g + 4 * h) * 2); acc[4 * g] = bflo(w.x); acc[4 * g + 1] = bfhi(w.x); acc[4 * g + 2] = bflo(w.y); acc[4 * g + 3] = bfhi(w.y); }
#pragma unroll
        for (int s = 0; s < 2; ++s) acc = rk_mfma(fAp[kt][s], fRB[s], acc);
        rk_store_tile_frag(ry, 0, r32, kt, h, acc);
    }
#pragma unroll
    for (int kt = 0; kt < 2; ++kt)
#pragma unroll
        for (int kq = 0; kq < 2; ++kq) { rk_f32x16 acc = {};
#pragma unroll
            for (int s = 0; s < 2; ++s) acc = rk_mfma(fAp[kq][s], fBh[kt][s], acc);
            acc = acc * *(const LAS float*)(L + RKA_GC + (kt * 32 + r32) * 4);
            rk_store_tile_frag(pq, kt, r32, kq, h, acc); }
#pragma unroll
    for (int vt = 0; vt < 2; ++vt) {
        rk_f32x16 acc = {};
#pragma unroll
        for (int s = 0; s < 2; ++s) { acc = rk_mfma(fU[vt][s], fRB[s], acc); acc = rk_mfma(fV[vt][s], fRK[s], acc); }
        rk_store_blob((unsigned*)(ry + 4096) + vt * 512, lane, acc);
    }
#pragma unroll
    for (int kt = 0; kt < 2; ++kt)
#pragma unroll
        for (int vt = 0; vt < 2; ++vt) { rk_f32x16 acc = {};
#pragma unroll
            for (int s = 0; s < 2; ++s) { acc = rk_mfma(fBh[kt][s], fU[vt][s], acc); acc = rk_mfma(fKh[kt][s], fV[vt][s], acc); }
#pragma unroll
            for (int g = 0; g < 4; ++g) { const f32x4 gq = *(const LAS f32x4*)(L + RKA_GC + (kt * 32 + 8 * g + 4 * h) * 4); acc[4 * g] *= gq[0]; acc[4 * g + 1] *= gq[1]; acc[4 * g + 2] *= gq[2]; acc[4 * g + 3] *= gq[3]; }
            rk_store_blob((unsigned*)(pq + 8192) + (kt * 2 + vt) * 512, lane, acc); }
    LDS_WAIT(); asm volatile("" ::: "memory");
}
__device__ __forceinline__ void rwkvA_phase(Frame& F, const InTab& A, int half) {
    if (F.wave >= RKA_WAVES) { if (half == 0) post_ya(F, A, F.bx * (NWAVES - RKA_WAVES) + (F.wave - RKA_WAVES), F.G * (NWAVES - RKA_WAVES)); return; }
    LAS unsigned char* L = F.lds + RING_OFF + F.wave * RKA_BYTES;
    const int gw = F.bx * RKA_WAVES + F.wave, NGW = F.G * RKA_WAVES;
    for (int u = gw; u < 64 * 32; u += NGW) rwkvA_unit(L, A, F.ws, u >> 5, half * 32 + (u & 31), F.lane);
}
__device__ __forceinline__ void rwkvA_queue(Frame& F, const InTab& A, int half, unsigned* counter) {
    if (F.wave >= RKA_WAVES) return;
    LAS unsigned char* L = F.lds + RING_OFF + F.wave * RKA_BYTES;
    for (;;) {
        unsigned u = 0; if (F.lane == 0) u = __hip_atomic_fetch_add(counter, 1u, __ATOMIC_RELAXED, __HIP_MEMORY_SCOPE_AGENT);
        u = __builtin_amdgcn_readfirstlane(u);
        if (u >= 64u * 32u) break;
        rwkvA_unit(L, A, F.ws, (int)(u >> 5), half * 32 + (int)(u & 31), F.lane);
    }
}
constexpr int RKB_RS = 144, RKB_SBUF = 64 * RKB_RS;
constexpr int RKB_YOFF = 2 * RKB_SBUF + 8192, RKB_YRS = 68, RKB_YBYTES = 32 * RKB_YRS * 4;
__device__ __forceinline__ void rwkvB_phase(Frame& F, const InTab& A, int bh, int half) {
    int lane = F.lane; asm volatile("" : "+v"(lane));
    const int wave = F.wave, r32 = lane & 31, h = lane >> 5;
    LAS unsigned char* SB = F.lds + RING_OFF;
    unsigned char* ws = F.ws;
    const int b = bh >> 3, hd = bh & 7;
    const int kt = (wave >> 1) & 1, vt = wave & 1;
    float* sst = (float*)(ws + WS_SST) + (size_t)bh * 4096 + (size_t)(wave & 3) * 1024;
    rk_f32x16 st = {};
    if (wave < 4) {
        if (half != 0) {
#pragma unroll
            for (int i = 0; i < 16; ++i) st[i] = *(const GAS float*)(sst + i * 64 + lane);
        }
        rk_store_tile_lds(SB, RKB_RS, vt * 32 + r32, kt * 32, h, st);
    }
    const int uh0 = bh * 32; const bool isS = wave < 4, isY = !isS && wave < 6;
    const unsigned char* fptr = isS ? rk_pq(ws, half) + (size_t)uh0 * 16384 + (kt * 256 + lane) * 16 : rk_ry(ws, half) + (size_t)uh0 * 8192 + lane * 16;
    const unsigned char* bptr = isS ? rk_pq(ws, half) + (size_t)uh0 * 16384 + 8192 + (kt * 2 + vt) * 2048 + lane * 32 : rk_ry(ws, half) + (size_t)uh0 * 8192 + 4096 + vt * 2048 + lane * 32;
    const LAS unsigned char* gl = SB + 2 * RKB_SBUF + (kt * 32 + 4 * h) * 4;
    const int fstride = isS ? 16384 : 8192;
    struct Op { v4u f[4]; v4u b0, b1; };
    { const int tid_ = wave * 64 + lane; *(LAS f32x4*)(SB + 2 * RKB_SBUF + tid_ * 16) = *(const GAS f32x4*)(rk_gc(ws, half) + (size_t)uh0 * 256 + tid_ * 16); }
    { const int tid_ = wave * 64 + lane; if (tid_ < 192) { const int e_ = tid_ & 63; const float* src_ = tid_ < 64 ? A[I_LNG] + hd * 64 : (tid_ < 128 ? A[I_LNB] + hd * 64 : A[I_MU] + 1024 + hd * 64);
        ((LAS float*)(SB + RKB_YOFF + 2 * RKB_YBYTES))[tid_] = src_[e_]; } }
    Op o0, o1, o2;
#define RKB_LOAD(O_, c) do { const unsigned char* fp_ = fptr + (size_t)(c) * fstride; const unsigned char* bp_ = bptr + (size_t)(c) * fstride; \
        _Pragma("unroll") for (int s = 0; s < 4; ++s) O_.f[s] = *(const GAS v4u*)(fp_ + 1024 * s); \
        O_.b0 = *(const GAS v4u*)bp_; O_.b1 = *(const GAS v4u*)(bp_ + 16); } while (0)
#define RKB_BAR() do { asm volatile("s_waitcnt lgkmcnt(0)" ::: "memory"); __builtin_amdgcn_s_barrier(); asm volatile("" ::: "memory"); } while (0)
#define RKB_NEXT(O_, c, AH_) RKB_LOAD(O_, ((c) + (AH_) < 32 ? (c) + (AH_) : 31))
#define RKB_STEP_S(O_, c) do { \
        const LAS unsigned char* cur = SB + ((c) & 1) * RKB_SBUF; LAS unsigned char* nxt = SB + (((c) & 1) ^ 1) * RKB_SBUF; \
        rk_bf16x8 fS[4]; _Pragma("unroll") for (int s = 0; s < 4; ++s) fS[s] = rk_frag(cur, RKB_RS, vt * 32 + r32, s, h); \
        RkBlob bb_; bb_.w0 = O_.b0; bb_.w1 = O_.b1; const rk_f32x16 q = rk_blob_f32(bb_); \
        _Pragma("unroll") for (int g = 0; g < 4; ++g) { const f32x4 gq = *(const LAS f32x4*)(gl + (c) * 256 + 32 * g); \
            st[4 * g] = st[4 * g] * gq[0] + q[4 * g]; st[4 * g + 1] = st[4 * g + 1] * gq[1] + q[4 * g + 1]; st[4 * g + 2] = st[4 * g + 2] * gq[2] + q[4 * g + 2]; st[4 * g + 3] = st[4 * g + 3] * gq[3] + q[4 * g + 3]; } \
        _Pragma("unroll") for (int s = 0; s < 4; ++s) st = rk_mfma(__builtin_bit_cast(rk_bf16x8, O_.f[s]), fS[s], st); \
        RKB_NEXT(O_, c, 5); \
        rk_store_tile_lds(nxt, RKB_RS, vt * 32 + r32, kt * 32, h, st); \
        RKB_BAR(); } while (0)
#define RKB_STEP_Y(O_, c) do { \
        const LAS unsigned char* cur = SB + ((c) & 1) * RKB_SBUF; \
        rk_bf16x8 fS[4]; _Pragma("unroll") for (int s = 0; s < 4; ++s) fS[s] = rk_frag(cur, RKB_RS, vt * 32 + r32, s, h); \
        RkBlob bb_; bb_.w0 = O_.b0; bb_.w1 = O_.b1; rk_f32x16 acc = rk_blob_f32(bb_); \
        _Pragma("unroll") for (int s = 0; s < 4; ++s) acc = rk_mfma(fS[s], __builtin_bit_cast(rk_bf16x8, O_.f[s]), acc);       \
        RKB_NEXT(O_, c, 3); \
        { LAS float* yb_ = (LAS float*)(SB + RKB_YOFF + ((c) & 1) * RKB_YBYTES) + r32 * RKB_YRS + 32 * vt + 4 * h;        \
          _Pragma("unroll") for (int g = 0; g < 4; ++g) *(LAS f32x4*)(yb_ + 8 * g) = (f32x4){acc[4 * g], acc[4 * g + 1], acc[4 * g + 2], acc[4 * g + 3]}; } \
        RKB_BAR(); } while (0)
    __syncthreads();
    if (isS) {
        Op o3, o4; RKB_LOAD(o0, 0); RKB_LOAD(o1, 1); RKB_LOAD(o2, 2); RKB_LOAD(o3, 3); RKB_LOAD(o4, 4);
#define R5S(c) RKB_STEP_S(o0, c); RKB_STEP_S(o1, (c) + 1); RKB_STEP_S(o2, (c) + 2); RKB_STEP_S(o3, (c) + 3); RKB_STEP_S(o4, (c) + 4);
        R5S(0) R5S(5) R5S(10) R5S(15) R5S(20) R5S(25)
        RKB_STEP_S(o0, 30); RKB_STEP_S(o1, 31);
#undef R5S
    } else if (isY) {
        RKB_LOAD(o0, 0); RKB_LOAD(o1, 1); RKB_LOAD(o2, 2);
#define R3Y(c) RKB_STEP_Y(o0, c); RKB_STEP_Y(o1, (c) + 1); RKB_STEP_Y(o2, (c) + 2);
        R3Y(0) R3Y(3) R3Y(6) R3Y(9) R3Y(12) R3Y(15) R3Y(18) R3Y(21) R3Y(24) R3Y(27)
        RKB_STEP_Y(o0, 30); RKB_STEP_Y(o1, 31);
#undef R3Y
    } else {
        const int tl = 16 * (wave - 6) + (lane >> 2), q4 = lane & 3, ch = hd * 64 + 16 * q4;
        const LAS float* ctab = (const LAS float*)(SB + RKB_YOFF + 2 * RKB_YBYTES) + 16 * q4;
        const bf16* RKV = (const bf16*)(ws + WS_RKV); const bf16* GG = (const bf16*)(ws + WS_GG); const float* BON = (const float*)(ws + WS_BON); bf16* YA = (bf16*)(ws + WS_YA);
        const size_t m0 = (size_t)b * SEQ + (size_t)half * 1024 + tl;
        struct Pp { v4u g0, g1, v0, v1, p0, p1; float bon; };
#define RKB_PLOAD(P_, c) do { const size_t mm_ = m0 + 32 * (size_t)(c); const size_t mp_ = mm_ ? mm_ - 1 : 0; \
        P_.g0 = *(const GAS v4u*)(GG + mm_ * 512 + ch); P_.g1 = *(const GAS v4u*)(GG + mm_ * 512 + ch + 8); \
        P_.v0 = *(const GAS v4u*)(RKV + mm_ * 1536 + 1024 + ch); P_.v1 = *(const GAS v4u*)(RKV + mm_ * 1536 + 1024 + ch + 8); \
        P_.p0 = *(const GAS v4u*)(RKV + mp_ * 1536 + 1024 + ch); P_.p1 = *(const GAS v4u*)(RKV + mp_ * 1536 + 1024 + ch + 8); \
        P_.bon = *(const GAS float*)(BON + mm_ * 8 + hd); } while (0)
#define RKB_UNPK8(w_) {bflo(w_.x), bfhi(w_.x), bflo(w_.y), bfhi(w_.y), bflo(w_.z), bfhi(w_.z), bflo(w_.w), bfhi(w_.w)}
#define RKB_STEP_P(P_, c) do { RKB_BAR(); { \
        const size_t mm_ = m0 + 32 * (size_t)(c); \
        const LAS float* yb_ = (const LAS float*)(SB + RKB_YOFF + ((c) & 1) * RKB_YBYTES) + tl * RKB_YRS + 16 * q4; \
        float y[16]; _Pragma("unroll") for (int j = 0; j < 4; ++j) { const f32x4 t_ = *(const LAS f32x4*)(yb_ + 4 * j); y[4 * j] = t_[0]; y[4 * j + 1] = t_[1]; y[4 * j + 2] = t_[2]; y[4 * j + 3] = t_[3]; } \
        float s_ = 0.f; _Pragma("unroll") for (int e = 0; e < 16; ++e) s_ += y[e]; \
        s_ += dppf<0xB1>(s_); s_ += dppf<0x4E>(s_); const float mean = s_ * (1.0f / 64.0f); \
        float q_ = 0.f; _Pragma("unroll") for (int e = 0; e < 16; ++e) { const float d_ = y[e] - mean; q_ += d_ * d_; } \
        q_ += dppf<0xB1>(q_); q_ += dppf<0x4E>(q_); const float rstd = __builtin_amdgcn_rsqf(q_ * (1.0f / 64.0f) + GN_EPS); \
        const float pm_ = ((mm_ & (size_t)(SEQ - 1)) == 0) ? 0.f : 1.f;        \
        const float ga[8] = RKB_UNPK8(P_.g0), gb[8] = RKB_UNPK8(P_.g1), va[8] = RKB_UNPK8(P_.v0), vb[8] = RKB_UNPK8(P_.v1), pa[8] = RKB_UNPK8(P_.p0), pb[8] = RKB_UNPK8(P_.p1); \
        float r[16]; \
        _Pragma("unroll") for (int j = 0; j < 4; ++j) { const f32x4 lg_ = *(const LAS f32x4*)(ctab + 4 * j), lb_ = *(const LAS f32x4*)(ctab + 64 + 4 * j), mu_ = *(const LAS f32x4*)(ctab + 128 + 4 * j); \
            _Pragma("unroll") for (int i = 0; i < 4; ++i) { const int e = 4 * j + i; const float v_ = e < 8 ? va[e & 7] : vb[e & 7], p_ = e < 8 ? pa[e & 7] : pb[e & 7], g_ = e < 8 ? ga[e & 7] : gb[e & 7]; \
                const float vs_ = v_ + (p_ * pm_ - v_) * mu_[i]; r[e] = (((y[e] - mean) * rstd) * lg_[i] + lb_[i] + P_.bon * vs_) * g_; } } \
        v4u w0, w1; w0.x = rk_pk(r[0], r[1]); w0.y = rk_pk(r[2], r[3]); w0.z = rk_pk(r[4], r[5]); w0.w = rk_pk(r[6], r[7]); w1.x = rk_pk(r[8], r[9]); w1.y = rk_pk(r[10], r[11]); w1.z = rk_pk(r[12], r[13]); w1.w = rk_pk(r[14], r[15]); \
        *(GAS v4u*)(YA + mm_ * 1024 + 512 + ch) = w0; *(GAS v4u*)(YA + mm_ * 1024 + 512 + ch + 8) = w1; } \
        RKB_PLOAD(P_, ((c) + 3 < 32 ? (c) + 3 : 31)); } while (0)
        Pp p0, p1, p2; RKB_PLOAD(p0, 0); RKB_PLOAD(p1, 1); RKB_PLOAD(p2, 2);
#define R3P(c) RKB_STEP_P(p0, c); RKB_STEP_P(p1, (c) + 1); RKB_STEP_P(p2, (c) + 2);
        R3P(0) R3P(3) R3P(6) R3P(9) R3P(12) R3P(15) R3P(18) R3P(21) R3P(24) R3P(27)
        RKB_STEP_P(p0, 30); RKB_STEP_P(p1, 31);
#undef R3P
#undef RKB_STEP_P
#undef RKB_UNPK8
#undef RKB_PLOAD
    }
#undef RKB_STEP_S
#undef RKB_STEP_Y
#undef RKB_NEXT
#undef RKB_BAR
#undef RKB_LOAD
    if (wave < 4 && half == 0) {
#pragma unroll
        for (int i = 0; i < 16; ++i) *(GAS float*)(sst + i * 64 + lane) = st[i];
    }
}

constexpr int NPHASE = 9;
template <int PHM> __global__ void __launch_bounds__(NWAVES * 64, 2) fwd_kernel(Args args) {
    extern __shared__ __attribute__((aligned(16))) unsigned char lds[];
    namespace cg = cooperative_groups;
    Frame F;
    F.lds = (LAS unsigned char*)lds;
    F.tid = threadIdx.x; F.lane = F.tid & 63; F.wave = __builtin_amdgcn_readfirstlane(F.tid >> 6);
    F.G = gridDim.x; F.bx = blockIdx.x;
    F.out = args.out; F.ws = args.ws;
#define PH_BEGIN InTab TAB; { ktab_t kp_ = (ktab_t)__builtin_amdgcn_kernarg_segment_ptr(); asm volatile("" : "+s"(kp_)); TAB.p = kp_; } { int t_ = threadIdx.x; asm volatile("" : "+v"(t_)); F.tid = t_; F.lane = t_ & 63; F.wave = __builtin_amdgcn_readfirstlane(t_ >> 6); } GAS unsigned char* wsg_ = (GAS unsigned char*)args.ws; asm volatile("" : "+s"(wsg_)); unsigned char* ws = (unsigned char*)wsg_; F.ws = ws; GAS bf16_t* gtg_ = (GAS bf16_t*)args.out; asm volatile("" : "+s"(gtg_)); bf16_t* GATES = (bf16_t*)gtg_; F.out = (float*)GATES; (void)GATES;
    const int lo = args.ph_lo, hi = args.ph_hi;
    XcdBarrier bar; bar.bar = nullptr; bar.x = 0; bar.st = nullptr;
    if (hi - lo > 1) {
        for (int u = threadIdx.x; u < (LDS_BYTES - 162816) / 4; u += NWAVES * 64) ((LAS unsigned*)(F.lds + 162816))[u] = 0u;
        { GAS v4u* z_ = (GAS v4u*)(args.ws + WS_CTL) + (size_t)blockIdx.x * (CTL_ZERO_BYTES / 16 / 256); for (int u = threadIdx.x; u < (int)(CTL_ZERO_BYTES / 16 / 256); u += NWAVES * 64) z_[u] = (v4u){0u, 0u, 0u, 0u}; }
        asm volatile("s_waitcnt vmcnt(0)" ::: "memory");
        __syncthreads();
        cg::this_grid().sync();
        bar = xcd_barrier_post((unsigned*)(args.ws + WS_CTL) + CW_BAR, (volatile LAS unsigned*)(F.lds + MISC_OFF) + 8);
    }
#define IN(k) (((PHM >> (k)) & 1) && lo <= (k) && (k) < hi)
#ifdef PROBE_DUP
#define REPS(k) (((k) == PROBE_DUP) ? 2 : 1)
#else
#define REPS(k) 1
#endif
#define SEAM(k) do { if (IN(k) && IN((k) + 1)) { xcd_barrier(bar); } } while (0)
    using pg8::Gemm; using pg8::StaticOrder; using pg8::EpiRow8; using pg8::bf16_t;

    if (IN(0)) for (int rep_ = 0; rep_ < REPS(0); ++rep_) { if (rep_) xcd_barrier(bar); PH_BEGIN p0_prologue(F, TAB); } SEAM(0);
    if (IN(1)) for (int rep_ = 0; rep_ < REPS(1); ++rep_) { if (rep_) xcd_barrier(bar); PH_BEGIN
        Gemm g{(const bf16_t*)(ws + WS_XN), (const bf16_t*)(ws + WS_WIN), M, D_IN - 256, D}; StaticOrder S; S.init(M, D_IN - 256, F.G, F.bx);
        EpiRow8<pg8::FProj> E{{ws, GATES}};
        pg8::gemm_phase<EpiRow8<pg8::FProj>, StaticOrder, PG8_ALIGN, PG8_SP2>(F.lds + RING_OFF, g, S, E);
    } SEAM(1);
    if (IN(2)) { PH_BEGIN
        constexpr int NLW = 64;
#ifndef PROBE_ATTN_ONLY
        if (F.bx >= F.G - NLW) {
            const int pm = F.bx - (F.G - NLW);
            prep1_rows(F, TAB, pm * 32, pm * 32 + 32, F.wave, NWAVES);
            asm volatile("s_waitcnt vmcnt(0)" ::: "memory"); __syncthreads();
            if (threadIdx.x == 0) { __builtin_amdgcn_fence(__ATOMIC_ACQUIRE, "agent"); asm volatile("s_waitcnt vmcnt(0)" ::: "memory"); }
            __syncthreads();
            int klora = KLORA; asm volatile("" : "+s"(klora));
            Gemm g{(const bf16_t*)(ws + WS_LIN), (const bf16_t*)(ws + WS_WL) + (size_t)1024 * KLORA, M, 512, klora}; pg8::PanelOrder S{pm, 2};
            EpiRow8<pg8::FLoraG> E{{ws}};
            pg8::gemm_phase<EpiRow8<pg8::FLoraG>, pg8::PanelOrder, PG8_ALIGN, PG8_SP2>(F.lds + RING_OFF, g, S, E);
            __syncthreads();
            {
                Gemm g2{(const bf16_t*)(ws + WS_XN), (const bf16_t*)(ws + WS_WIN) + (size_t)(D_IN - 256) * D, M, 256, D}; pg8::PanelOrder S2{pm, 1};
                EpiRow8<pg8::FProjOff> E2{{{ws, GATES}, (D_IN - 256) / 256}};
                pg8::gemm_phase<EpiRow8<pg8::FProjOff>, pg8::PanelOrder, PG8_ALIGN, PG8_SP2>(F.lds + RING_OFF, g2, S2, E2);
                __syncthreads();
            }
        }
#endif
        const attn_body::AttnTensors AT{(const attn_body::bf16*)(ws + WS_Q), (const attn_body::bf16*)(ws + WS_K), (const attn_body::bf16*)(ws + WS_V), (attn_body::bf16*)(ws + WS_O)};
        attn_body::attn_phase_queue128<8>((char*)lds + RING_OFF, AT, (unsigned*)(ws + WS_CTL + CTL_ATTQ), (volatile LAS unsigned*)(F.lds + MISC_OFF) + 24);
    } SEAM(2);
    if (IN(3)) { PH_BEGIN
        { GAS unsigned char* w_ = (GAS unsigned char*)args.ws; asm volatile("" : "+s"(w_)); F.ws = (unsigned char*)w_; }
        rwkvA_phase(F, TAB, 0);
        xcd_barrier(bar);
        { GAS unsigned char* w_ = (GAS unsigned char*)args.ws; asm volatile("" : "+s"(w_)); F.ws = (unsigned char*)w_; }
        if (F.bx < 64) rwkvB_phase(F, TAB, F.bx, 0); else { late_weights(F, TAB, 0, 2, 64); late_weights(F, TAB, 1, 2, 64); }
        __syncthreads();
        { GAS unsigned char* w_ = (GAS unsigned char*)args.ws; asm volatile("" : "+s"(w_)); F.ws = (unsigned char*)w_; }
        rwkvA_queue(F, TAB, 1, (unsigned*)(F.ws + WS_CTL + CTL_RKAQ));
        xcd_barrier(bar);
        { GAS unsigned char* w_ = (GAS unsigned char*)args.ws; asm volatile("" : "+s"(w_)); F.ws = (unsigned char*)w_; }
        if (F.bx < 64) rwkvB_phase(F, TAB, F.bx, 1);
    } SEAM(3);
    if (IN(5)) for (int rep_ = 0; rep_ < REPS(5); ++rep_) { if (rep_) xcd_barrier(bar); PH_BEGIN
        Gemm g{(const bf16_t*)(ws + WS_YA), (const bf16_t*)(ws + WS_WA), M, D, 1024}; StaticOrder S; S.init(M, D, F.G, F.bx);
        pg8::EpiMerge E{GATES, (bf16_t*)(ws + WS_MERGED)};
        pg8::gemm_phase<pg8::EpiMerge, StaticOrder, PG8_ALIGN, PG8_SP2>(F.lds + RING_OFF, g, S, E);
    } SEAM(5);
    if (IN(6)) for (int rep_ = 0; rep_ < REPS(6); ++rep_) { if (rep_) xcd_barrier(bar); PH_BEGIN
        Gemm g{(const bf16_t*)(ws + WS_MERGED), (const bf16_t*)(ws + WS_WO), M, D, D}; StaticOrder S; S.init(M, D, F.G, F.bx);
        pg8::EpiResNorm<0> E{TAB[I_X], F.out, (bf16_t*)(ws + WS_XN), TAB[I_NFG], (float*)(ws + WS_CTL + CTL_SS1), (unsigned*)(ws + WS_CTL + CTL_CNT1), NORM_EPS, (bf16_t*)(ws + WS_X1B)};
        pg8::gemm_phase<pg8::EpiResNorm<0>, StaticOrder, PG8_ALIGN, PG8_SP2>(F.lds + RING_OFF, g, S, E);
    } SEAM(6);
    if (IN(7)) for (int rep_ = 0; rep_ < REPS(7); ++rep_) { if (rep_) xcd_barrier(bar); PH_BEGIN
        Gemm g{(const bf16_t*)(ws + WS_XN), (const bf16_t*)(ws + WS_W1), M, FF, D}; StaticOrder S; S.init(M, FF, F.G, F.bx);
        EpiRow8<pg8::FRelu2> E{{(bf16_t*)(ws + WS_H)}};
        pg8::gemm_phase<EpiRow8<pg8::FRelu2>, StaticOrder, PG8_ALIGN, PG8_SP2>(F.lds + RING_OFF, g, S, E);
    } SEAM(7);
    if (IN(8)) for (int rep_ = 0; rep_ < REPS(8); ++rep_) { if (rep_) xcd_barrier(bar); PH_BEGIN
        Gemm g{(const bf16_t*)(ws + WS_H), (const bf16_t*)(ws + WS_W2), M, D, FF}; StaticOrder S; S.init(M, D, F.G, F.bx);
        pg8::EpiResNorm<1> E{nullptr, F.out, nullptr, TAB[I_NFIN], (float*)(ws + WS_CTL + CTL_SS2), (unsigned*)(ws + WS_CTL + CTL_CNT2), NORM_EPS, (bf16_t*)(ws + WS_X1B)};
        pg8::gemm_phase<pg8::EpiResNorm<1>, StaticOrder, PG8_ALIGN, PG8_SP2>(F.lds + RING_OFF, g, S, E);
    }
#undef IN
#undef SEAM
#undef PH_BEGIN
}


#ifdef DBG_DUMP
__global__ void dbg_dump(float* out, const unsigned char* ws) {
    const size_t i = (size_t)blockIdx.x * blockDim.x + threadIdx.x; if (i >= (size_t)M * 1024) return;
    const size_t m = i >> 10; const int c = (int)(i & 1023); float v = 0.f;
#if DBG_DUMP == 1
    v = bf1(((const bf16*)(ws + WS_O))[m * 1024 + c]);
#elif DBG_DUMP == 2
    v = c < 512 ? bf1(((const bf16*)(ws + WS_Y))[m * 512 + c]) : (c < 520 ? ((const float*)(ws + WS_BON))[m * 8 + (c - 512)] : 0.f);
#elif DBG_DUMP == 3
    v = c < 512 ? bf1(((const bf16*)(ws + WS_Q))[m * 512 + c]) : bf1(((const bf16*)(ws + WS_K))[m * 512 + c - 512]);
#elif DBG_DUMP == 4
    v = c < 512 ? ((const float*)(ws + WS_DEC))[m * 512 + c] : bf1(((const bf16*)(ws + WS_AA))[m * 512 + c - 512]);
#elif DBG_DUMP == 6
    v = c < 256 ? bf1(((const bf16*)(ws + WS_WAG))[m * 256 + c]) : (c < 512 ? bf1(((const bf16*)(ws + WS_LIN))[m * 256 + c - 256]) : 0.f);
#elif DBG_DUMP == 7
    { const bf16* wl = (const bf16*)(ws + WS_WL); const size_t j = (m * 1024 + c); v = j < (size_t)NLORA * KLORA ? bf1(wl[j]) : 0.f; }
#elif DBG_DUMP == 8
    v = c < 512 ? bf1(((const bf16*)(ws + WS_GG))[m * 512 + c]) : 0.f;
#elif DBG_DUMP == 5
    v = bf1(((const bf16*)(ws + WS_RKV))[m * 1536 + c]);
#endif
    out[i] = v;
}
#endif

#ifdef DBG_FIXLORA
__global__ void dbg_fixlora(Args A) {
    const size_t i = (size_t)blockIdx.x * blockDim.x + threadIdx.x; if (i >= (size_t)M * 512) return;
    const size_t m = i >> 9; const int c = (int)(i & 511);
    const bf16* LINr = (const bf16*)(A.ws + WS_LIN) + m * 256;
#if DBG_FIXLORA & 1
    { float g = 0.f; for (int k = 0; k < 128; ++k) g += bf1(LINr[128 + k]) * A[I_G2][(size_t)k * 512 + c]; ((bf16*)(A.ws + WS_GG))[m * 512 + c] = (bf16)f2bf(g); }
#endif
#if DBG_FIXLORA & 2
    { float s = A[I_A0][c]; for (int k = 0; k < 64; ++k) s += bf1(LINr[64 + k]) * A[I_A2][(size_t)k * 512 + c]; ((bf16*)(A.ws + WS_AA))[m * 512 + c] = (bf16)f2bf(1.0f / (1.0f + expf(-s))); }
#endif
#if DBG_FIXLORA & 4
    { float s = A[I_W0][c]; for (int k = 0; k < 64; ++k) s += bf1(LINr[k]) * A[I_W2][(size_t)k * 512 + c]; const float w = -log1pf(expf(-s)) - 0.5f; ((float*)(A.ws + WS_DEC))[m * 512 + c] = expf(-expf(w)); }
#endif
}
#endif
#ifndef MK_ONE_LAUNCH
#define MK_ONE_LAUNCH 0
#endif
#ifndef MK_MASK
#define MK_MASK ((1 << NPHASE) - 1)
#endif
typedef void (*kern_t)(Args);
template <int P> struct KTab { static void fill(kern_t* t) { t[P] = fwd_kernel<(1 << P)>; KTab<P - 1>::fill(t); } };
template <> struct KTab<-1> { static void fill(kern_t*) {} };
extern "C" void kernel_launch(void* const* d_in, const int* in_sizes, int n_in, void* d_out, int out_size, void* d_ws, size_t ws_size, hipStream_t stream) {
    static int grid = 0; static kern_t ktab[NPHASE];
    if (grid == 0) {
        if (n_in != 26 || in_sizes[0] != M * D || out_size != M * D || ws_size < WS_END) { fprintf(stderr, "kernel_launch: unexpected shapes (n_in %d, in0 %d, out %d, ws %zu); nothing launched\n", n_in, n_in > 0 ? in_sizes[0] : -1, out_size, ws_size); grid = -1; return; }
        int dev = 0, cus = 0;
        if (hipGetDevice(&dev) != hipSuccess || hipDeviceGetAttribute(&cus, hipDeviceAttributeMultiprocessorCount, dev) != hipSuccess) { grid = -1; return; }
#if MK_ONE_LAUNCH
        int per_cu = 0;
        if (hipFuncSetAttribute((const void*)fwd_kernel<MK_MASK>, hipFuncAttributeMaxDynamicSharedMemorySize, LDS_BYTES) != hipSuccess) { fprintf(stderr, "kernel_launch: hipFuncSetAttribute failed\n"); grid = -1; return; }
        if (hipOccupancyMaxActiveBlocksPerMultiprocessor(&per_cu, (const void*)fwd_kernel<MK_MASK>, NWAVES * 64, LDS_BYTES) != hipSuccess || per_cu < 1) { fprintf(stderr, "kernel_launch: occupancy query says %d blocks per CU\n", per_cu); (void)hipGetLastError(); grid = -1; return; }
#else
        KTab<NPHASE - 1>::fill(ktab);
        for (int p = 0; p < NPHASE; ++p) if (hipFuncSetAttribute((const void*)ktab[p], hipFuncAttributeMaxDynamicSharedMemorySize, LDS_BYTES) != hipSuccess) { fprintf(stderr, "kernel_launch: hipFuncSetAttribute failed\n"); grid = -1; return; }
#endif
        grid = cus;
        if (grid != 256) fprintf(stderr, "kernel_launch: note: %d CUs (built for 256)\n", grid);
    }
    if (grid < 0) return;
    Args a{};
    for (int i = 0; i < 26; ++i) a.in[i] = (const float*)d_in[i];
    a.out = (float*)d_out; a.ws = (unsigned char*)d_ws;
#if MK_ONE_LAUNCH
    a.ph_lo = 0; a.ph_hi = NPHASE;
    void* kargs[] = {&a};
    hipError_t e = hipLaunchCooperativeKernel((const void*)fwd_kernel<MK_MASK>, dim3(grid), dim3(NWAVES * 64), kargs, LDS_BYTES, stream);
    if (e != hipSuccess) fprintf(stderr, "kernel_launch: cooperative launch failed: %s\n", hipGetErrorString(e));
#else
#ifdef DBG_DUMP
    for (int p = 0; p <= DBG_STOP; ++p) { a.ph_lo = p; a.ph_hi = p + 1; hipLaunchKernelGGL(ktab[p], dim3(grid), dim3(NWAVES * 64), LDS_BYTES, stream, a); }
    hipLaunchKernelGGL(dbg_dump, dim3((M * 1024) / 256), dim3(256), 0, stream, (float*)d_out, (const unsigned char*)d_ws);
#else
    for (int p = 0; p < NPHASE; ++p) { a.ph_lo = p; a.ph_hi = p + 1; hipLaunchKernelGGL(ktab[p], dim3(grid), dim3(NWAVES * 64), LDS_BYTES, stream, a);
#ifdef DBG_FIXLORA
        if (p == 3) hipLaunchKernelGGL(dbg_fixlora, dim3((M * 512) / 256), dim3(256), 0, stream, a);
#endif
    }
#endif
#endif
}
```

```cpp
#define MK_ONE_LAUNCH 1
#include <hip/hip_runtime.h>
#include <cstdio>
#include <cstdint>
constexpr int NWAVES = 8;
constexpr int BATCH = 8, SEQ = 2048, D = 1024, M = BATCH * SEQ;
constexpr int D_IN = 5376, FF = 4096, RWW = 512, NLORA = 1536, KLORA = 256;
constexpr float NORM_EPS = 1e-6f, SUBLN_EPS = 1e-5f, GN_EPS = 64e-5f, LAMBDA_INIT = 0.2f;
constexpr size_t MiB = 1u << 20;
constexpr size_t WS_CTL = 0, CTL_ZERO_BYTES = 256 * 1024;
constexpr size_t CTL_SS1 = 65536, CTL_SS2 = 131072, CTL_CNT1 = 196608, CTL_CNT2 = 212992, CTL_ATTQ = 229376, CTL_RKAQ = 229380;
constexpr size_t WS_ROPE_C = 512 * 1024, WS_ROPE_S = 768 * 1024;
constexpr size_t WS_BON = 1 * MiB;
constexpr size_t WS_WIN = 2 * MiB;
constexpr size_t WS_WA = WS_WIN + (size_t)D_IN * D * 2;
constexpr size_t WS_WB = WS_WA + 1 * MiB;
constexpr size_t WS_WO = WS_WB + 1 * MiB;
constexpr size_t WS_W1 = WS_WO + 2 * MiB;
constexpr size_t WS_W2 = WS_W1 + 8 * MiB;
constexpr size_t WS_WL = WS_W2 + 8 * MiB;
static_assert(WS_WL + (size_t)NLORA * KLORA * 2 <= 34 * MiB, "weights");
constexpr size_t WS_XN = 34 * MiB;
constexpr size_t WS_DEC = WS_XN;
constexpr size_t WS_Q = 66 * MiB, WS_K = 82 * MiB, WS_V = 98 * MiB;
constexpr size_t WS_RKV = 114 * MiB;
constexpr size_t WS_WAG = 162 * MiB, WS_LIN = 242 * MiB;
constexpr size_t WS_Y = 162 * MiB;
constexpr size_t WS_AA = 178 * MiB, WS_GG = 194 * MiB;
constexpr size_t WS_O = 210 * MiB;
constexpr size_t WS_YA = 210 * MiB;
constexpr size_t WS_TMP = 114 * MiB;
constexpr size_t WS_MERGED = 114 * MiB;
constexpr size_t WS_X1B = 194 * MiB;
constexpr size_t WS_H = 66 * MiB;
constexpr size_t WS_END = 252 * MiB;
constexpr int RING_OFF = 0, RING_BYTES = 131072;
constexpr int LDS_BYTES = 163840;

#include <hip/hip_runtime.h>
#include <cstdio>
#include <cstdint>
namespace pg8 {
#define PG8_LAS __attribute__((address_space(3)))
typedef unsigned short bf16_t;
typedef short bf16x8 __attribute__((ext_vector_type(8)));
typedef float f32x4 __attribute__((ext_vector_type(4)));
typedef unsigned u32x4 __attribute__((ext_vector_type(4)));
constexpr int BM = 256, BK = 64, HALF = 128, HTB = HALF * BK * 2  , STAGE_BYTES = 8 * HTB, NXCD = 8, WGM = 8;

__host__ __device__ __forceinline__ int lds_byte(int r, int c) { const int st = (r >> 4) * 2 + (c >> 5), rr = r & 15, cc = c & 31, ob = rr * 64 + cc * 2; return st * 1024 + (ob ^ (((ob >> 9) & 1) << 5)); }
__host__ __device__ __forceinline__ void stage_rc(int b, int& R, int& C) { const int st = b / 1024, sb = b % 1024, swz = sb ^ (((sb >> 9) & 1) << 5); R = (st >> 1) * 16 + swz / 64; C = (st & 1) * 32 + (swz % 64) / 2; }
__host__ __device__ __forceinline__ int perm32(int rho) { const int n = rho >> 4, i = rho & 15; return 8 * (i >> 2) + 4 * n + (i & 3); }

struct Unit { int pm, pn; };
struct Gemm { const bf16_t* A; const bf16_t* Bt; int M, N, K; };

struct StaticOrder {
    int nM, nN, nwg, G, c;
    __host__ __device__ void init(int M, int N, int G_, int c_) { nM = M / BM; nN = N / BM; nwg = nM * nN; G = G_; c = c_; }
    __host__ __device__ bool next(int i, Unit& u) const {
        const long L = (long)i * G + c; if (L >= nwg) return false;
        int wgid = (int)L; { const int q = nwg / NXCD, r = nwg % NXCD, xcd = wgid % NXCD, off = wgid / NXCD; wgid = (xcd < r ? xcd * (q + 1) : r * (q + 1) + (xcd - r) * q) + off; }
        const int nig = WGM * nN, gid = wgid / nig, fm = gid * WGM, gsz = (nM - fm) < WGM ? (nM - fm) : WGM;
        u.pm = fm + ((wgid % nig) % gsz); u.pn = (wgid % nig) / gsz; return true;
    }
    __device__ __forceinline__ void a_ready(const Unit&) const {}
    __device__ __forceinline__ void done(const Unit&) const {}
};

typedef float f32x2c_t __attribute__((ext_vector_type(2))); typedef __bf16 bf16x2c_t __attribute__((ext_vector_type(2)));
__device__ __forceinline__ unsigned cvt_pk_bf16(float lo, float hi) { f32x2c_t v = {lo, hi}; bf16x2c_t b = __builtin_convertvector(v, bf16x2c_t); return __builtin_bit_cast(unsigned, b); }
typedef float f32x2 __attribute__((ext_vector_type(2)));
__device__ __forceinline__ f32x2 gelu_pk(f32x2 v) {
    const f32x2 av = __builtin_elementwise_abs(v), d = av * 0.2316418882f + 1.0f;
    f32x2 t; t.x = __builtin_amdgcn_rcpf(d.x); t.y = __builtin_amdgcn_rcpf(d.y);
    f32x2 q = t * 0.5307027145f + (-0.7265760135f); q = q * t + 0.7107068705f; q = q * t + (-0.142248368f); q = q * t + 0.127414796f; q = q * t;
    const f32x2 s = (v * v) * (-0.72134752044f);
    f32x2 e; e.x = __builtin_amdgcn_exp2f(s.x); e.y = __builtin_amdgcn_exp2f(s.y);
    const f32x2 m = v * (q * e), r = v - m;
    f32x2 o; o.x = v.x < 0.f ? m.x : r.x; o.y = v.y < 0.f ? m.y : r.y; return o;
}

template <int ACT  > struct EpiBf16 {
    static constexpr int MIDK = 0; static constexpr bool PERM = true, AFTER_DRAIN = false; static_assert(ACT == 0 || ACT == 1, "EpiBf16: ACT is 0 (none) or 1 (gelu_pk)");
    bf16_t* O; int ldc; const float* bias; int split_cols; size_t split_stride; float scale0;
    __device__ __forceinline__ void operator()(const f32x4 (&acc)[2][2][4][2], const Unit& u, int wr, int wc, int fr, int fq) const {
        const int row0 = u.pm * BM + wr * 64 + fr; int colt = u.pn * BM; bf16_t* base = O;
        float sc = 1.f; if (split_cols) { const int t = colt / split_cols; base += (size_t)t * split_stride; colt -= t * split_cols; if (t == 0) sc = scale0; }
        const int col0 = colt + wc * 32 + 8 * fq, bcol0 = u.pn * BM + wc * 32 + 8 * fq;
        f32x4 bv[2][2];
#pragma unroll
        for (int bj = 0; bj < 2; ++bj)
#pragma unroll
            for (int n = 0; n < 2; ++n) bv[bj][n] = bias ? *(const f32x4*)(bias + bcol0 + bj * HALF + 4 * n) : (f32x4){0.f, 0.f, 0.f, 0.f};
#pragma unroll
        for (int ai = 0; ai < 2; ++ai)
#pragma unroll
            for (int m = 0; m < 4; ++m) { bf16_t* rowp = base + (size_t)(row0 + ai * HALF + m * 16) * ldc + col0;
#pragma unroll
                for (int bj = 0; bj < 2; ++bj) { f32x4 v0 = acc[ai][bj][m][0] + bv[bj][0], v1 = acc[ai][bj][m][1] + bv[bj][1];
                    if (ACT == 1) { f32x2 a = gelu_pk((f32x2){v0[0], v0[1]}), b = gelu_pk((f32x2){v0[2], v0[3]}), c = gelu_pk((f32x2){v1[0], v1[1]}), d = gelu_pk((f32x2){v1[2], v1[3]});
                        v0 = (f32x4){a.x, a.y, b.x, b.y}; v1 = (f32x4){c.x, c.y, d.x, d.y}; }
                    v0 = v0 * sc; v1 = v1 * sc; u32x4 w; w.x = cvt_pk_bf16(v0[0], v0[1]); w.y = cvt_pk_bf16(v0[2], v0[3]); w.z = cvt_pk_bf16(v1[0], v1[1]); w.w = cvt_pk_bf16(v1[2], v1[3]);
                    *(u32x4*)(rowp + bj * HALF) = w; } }
    }
};
typedef unsigned u32x2 __attribute__((ext_vector_type(2)));
__device__ __forceinline__ float bf_lo(unsigned w) { return __builtin_bit_cast(float, w << 16); }
__device__ __forceinline__ float bf_hi(unsigned w) { return __builtin_bit_cast(float, w & 0xffff0000u); }
__device__ __forceinline__ u32x4 pack8(f32x4 v0, f32x4 v1) { u32x4 w; w.x = cvt_pk_bf16(v0[0], v0[1]); w.y = cvt_pk_bf16(v0[2], v0[3]); w.z = cvt_pk_bf16(v1[0], v1[1]); w.w = cvt_pk_bf16(v1[2], v1[3]); return w; }
__device__ __forceinline__ float sigmoidf_(float x) { return __builtin_amdgcn_rcpf(1.0f + __expf(-x)); }
template <class F> struct EpiRow8 {
    static constexpr int MIDK = 0; static constexpr bool PERM = true, AFTER_DRAIN = false;
    F f;
    __device__ __forceinline__ void operator()(const f32x4 (&acc)[2][2][4][2], const Unit& u, int wr, int wc, int fr, int fq) const {
        const int row0 = u.pm * BM + wr * 64 + fr, c0 = wc * 32 + 8 * fq;
#pragma unroll
        for (int ai = 0; ai < 2; ++ai)
#pragma unroll
            for (int m = 0; m < 4; ++m) { const int row = row0 + ai * HALF + m * 16;
#pragma unroll
                for (int bj = 0; bj < 2; ++bj) { f(u.pn, row, c0 + bj * HALF, acc[ai][bj][m][0], acc[ai][bj][m][1]); if (F::FENCE) asm volatile("" ::: "memory"); } }
    }
};
constexpr float ATT_C2 = 0.125f * 1.4426950408889634f;
struct FProj {
    static constexpr bool FENCE = false;
    unsigned char* ws; bf16_t* GATES;
    __device__ __forceinline__ void operator()(int pn, int row, int cu, f32x4 v0, f32x4 v1) const {
        if (pn < 4) {
            const int sh = cu >> 6, j = (cu & 63) >> 3, pos = row & 2047;
            const f32x4 c = *(const f32x4*)((const float*)(ws + WS_ROPE_C) + pos * 32 + 4 * j), s = *(const f32x4*)((const float*)(ws + WS_ROPE_S) + pos * 32 + 4 * j);
            const float sc = pn < 2 ? ATT_C2 : 1.0f;
            const f32x4 o1 = (v0 * c - v1 * s) * sc, o2 = (v1 * c + v0 * s) * sc;
            bf16_t* dst = (bf16_t*)(ws + (pn < 2 ? WS_Q : WS_K)) + (size_t)row * 512 + (pn & 1) * 256 + sh * 64 + 4 * j;
            u32x2 w1, w2; w1.x = cvt_pk_bf16(o1[0], o1[1]); w1.y = cvt_pk_bf16(o1[2], o1[3]); w2.x = cvt_pk_bf16(o2[0], o2[1]); w2.y = cvt_pk_bf16(o2[2], o2[3]);
            *(u32x2*)dst = w1; *(u32x2*)(dst + 32) = w2;
        } else if (pn < 13) {
            size_t off; int pitch, col;
            if (pn < 6) { off = WS_V; pitch = 512; col = (pn - 4) * 256; }
            else if (pn < 12) { off = WS_RKV; pitch = 1536; col = (pn - 6) * 256; }
            else { off = WS_WAG; pitch = 256; col = 0; }
            *(u32x4*)((bf16_t*)(ws + off) + (size_t)row * pitch + col + cu) = pack8(v0, v1);
        } else *(u32x4*)(GATES + (size_t)row * 2048 + (pn - 13) * 256 + cu) = pack8(v0, v1);
    }
};
struct FLora {
    static constexpr bool FENCE = false;
    unsigned char* ws; const float *w0, *a0;
    __device__ __forceinline__ void operator()(int pn, int row, int cu, f32x4 v0, f32x4 v1) const {
        const int c = (pn & 1) * 256 + cu;
        if (pn < 2) {
            const f32x4 b0 = *(const f32x4*)(w0 + c), b1 = *(const f32x4*)(w0 + c + 4);
            float* dst = (float*)(ws + WS_DEC) + (size_t)row * 512 + c; *(f32x4*)dst = v0 + b0; *(f32x4*)(dst + 4) = v1 + b1;
        } else if (pn < 4) {
            const f32x4 b0 = *(const f32x4*)(a0 + c), b1 = *(const f32x4*)(a0 + c + 4);
            *(u32x4*)((bf16_t*)(ws + WS_AA) + (size_t)row * 512 + c) = pack8(v0 + b0, v1 + b1);
        } else *(u32x4*)((bf16_t*)(ws + WS_GG) + (size_t)row * 512 + c) = pack8(v0, v1);
    }
};
struct FProjOff {
    static constexpr bool FENCE = false;
    FProj f; int off;
    __device__ __forceinline__ void operator()(int pn, int row, int cu, f32x4 v0, f32x4 v1) const { f(pn + off, row, cu, v0, v1); }
};
struct FLoraG {
    static constexpr bool FENCE = false;
    unsigned char* ws;
    __device__ __forceinline__ void operator()(int pn, int row, int cu, f32x4 v0, f32x4 v1) const { *(u32x4*)((bf16_t*)(ws + WS_GG) + (size_t)row * 512 + pn * 256 + cu) = pack8(v0, v1); }
};
struct EpiMerge {
    static constexpr int MIDK = 8; static constexpr bool PERM = true, AFTER_DRAIN = false;
    const bf16_t* GATES; bf16_t* MERGED;
    static __device__ __forceinline__ float ratio_(float ga, float gb) { return (1.0f + __expf(-gb)) * __builtin_amdgcn_rcpf(1.0f + __expf(-ga)); }
    __device__ __forceinline__ void mid(f32x4 (&acc)[2][2][4][2], const Unit& u, int wr, int wc, int fr, int fq) const {
        int fr_ = fr; asm volatile("" : "+v"(fr_));
        const bf16_t* gp0 = GATES + (size_t)(u.pm * BM + wr * 64 + fr_) * 2048 + u.pn * BM + wc * 32 + 8 * fq;
#pragma unroll
        for (int ai = 0; ai < 2; ++ai)
#pragma unroll
            for (int m = 0; m < 4; ++m)
#pragma unroll
                for (int bj = 0; bj < 2; ++bj) { const bf16_t* gp = gp0 + (size_t)(ai * HALF + m * 16) * 2048 + bj * HALF;
                    const u32x4 ga = *(const u32x4*)gp, gb = *(const u32x4*)(gp + 1024);
                    f32x4& v0 = acc[ai][bj][m][0]; f32x4& v1 = acc[ai][bj][m][1];
                    v0[0] *= ratio_(bf_lo(ga.x), bf_lo(gb.x)); v0[1] *= ratio_(bf_hi(ga.x), bf_hi(gb.x)); v0[2] *= ratio_(bf_lo(ga.y), bf_lo(gb.y)); v0[3] *= ratio_(bf_hi(ga.y), bf_hi(gb.y));
                    v1[0] *= ratio_(bf_lo(ga.z), bf_lo(gb.z)); v1[1] *= ratio_(bf_hi(ga.z), bf_hi(gb.z)); v1[2] *= ratio_(bf_lo(ga.w), bf_lo(gb.w)); v1[3] *= ratio_(bf_hi(ga.w), bf_hi(gb.w));
                    asm volatile("" ::: "memory"); }
    }
    __device__ __forceinline__ void operator()(const f32x4 (&acc)[2][2][4][2], const Unit& u, int wr, int wc, int fr, int fq) const {
        const int row0 = u.pm * BM + wr * 64 + fr, c0 = u.pn * BM + wc * 32 + 8 * fq;
#pragma unroll
        for (int ai = 0; ai < 2; ++ai)
#pragma unroll
            for (int m = 0; m < 4; ++m) { const int row = row0 + ai * HALF + m * 16;
#pragma unroll
                for (int bj = 0; bj < 2; ++bj) { const u32x4 g = *(const u32x4*)(GATES + (size_t)row * 2048 + 1024 + c0 + bj * HALF);
                    f32x4 v0 = acc[ai][bj][m][0], v1 = acc[ai][bj][m][1];
                    v0[0] *= sigmoidf_(bf_lo(g.x)); v0[1] *= sigmoidf_(bf_hi(g.x)); v0[2] *= sigmoidf_(bf_lo(g.y)); v0[3] *= sigmoidf_(bf_hi(g.y));
                    v1[0] *= sigmoidf_(bf_lo(g.z)); v1[1] *= sigmoidf_(bf_hi(g.z)); v1[2] *= sigmoidf_(bf_lo(g.w)); v1[3] *= sigmoidf_(bf_hi(g.w));
                    *(u32x4*)(MERGED + (size_t)row * 1024 + c0 + bj * HALF) = pack8(v0, v1); } }
    }
};
struct FRes {
    static constexpr bool FENCE = false;
    const float* base; float* out;
    __device__ __forceinline__ void operator()(int pn, int row, int cu, f32x4 v0, f32x4 v1) const {
        const size_t off = (size_t)row * 1024 + pn * 256 + cu; const f32x4 b0 = *(const f32x4*)(base + off), b1 = *(const f32x4*)(base + off + 4);
        *(f32x4*)(out + off) = b0 + v0; *(f32x4*)(out + off + 4) = b1 + v1;
    }
};
struct FRelu2 {
    static constexpr bool FENCE = false;
    bf16_t* H;
    __device__ __forceinline__ void operator()(int pn, int row, int cu, f32x4 v0, f32x4 v1) const {
        f32x4 r0, r1;
#pragma unroll
        for (int e = 0; e < 4; ++e) { const float a = __builtin_fmaxf(v0[e], 0.f), b = __builtin_fmaxf(v1[e], 0.f); r0[e] = a * a; r1[e] = b * b; }
        *(u32x4*)(H + (size_t)row * 4096 + pn * 256 + cu) = pack8(r0, r1);
    }
};

__device__ __forceinline__ float xsum_fq(float x) {
    { auto r = __builtin_amdgcn_permlane16_swap(__builtin_bit_cast(unsigned, x), __builtin_bit_cast(unsigned, x), false, false); const unsigned a = r[0], b = r[1]; x = __builtin_bit_cast(float, a) + __builtin_bit_cast(float, b); }
    { auto r = __builtin_amdgcn_permlane32_swap(__builtin_bit_cast(unsigned, x), __builtin_bit_cast(unsigned, x), false, false); const unsigned a = r[0], b = r[1]; x = __builtin_bit_cast(float, a) + __builtin_bit_cast(float, b); }
    return x;
}
template <int MODE> struct EpiResNorm {
    static constexpr int MIDK = 0; static constexpr bool PERM = true, AFTER_DRAIN = false;
    const float* base; float* out; bf16_t* xn; const float* g; float* ss; unsigned* cnt; float eps; bf16_t* x1b;
    __device__ __forceinline__ void operator()(f32x4 (&acc)[2][2][4][2], const Unit& u, int wr, int wc, int fr, int fq) const {
        const int row0 = u.pm * BM + wr * 64 + fr, c0 = u.pn * BM + wc * 32 + 8 * fq;
#pragma unroll
        for (int ai = 0; ai < 2; ++ai)
#pragma unroll
            for (int m = 0; m < 4; ++m) { const int row = row0 + ai * HALF + m * 16; float s = 0.f;
#pragma unroll
                for (int bj = 0; bj < 2; ++bj) { const size_t off = (size_t)row * 1024 + c0 + bj * HALF; f32x4 b0, b1;
                    if (MODE == 0) { b0 = *(const f32x4*)(base + off); b1 = *(const f32x4*)(base + off + 4); }
                    else { const u32x4 w = *(const u32x4*)(x1b + off); b0 = (f32x4){bf_lo(w.x), bf_hi(w.x), bf_lo(w.y), bf_hi(w.y)}; b1 = (f32x4){bf_lo(w.z), bf_hi(w.z), bf_lo(w.w), bf_hi(w.w)}; }
                    f32x4& v0 = acc[ai][bj][m][0]; f32x4& v1 = acc[ai][bj][m][1]; v0 += b0; v1 += b1;
                    if (MODE == 0) *(u32x4*)(x1b + off) = pack8(v0, v1);
                    s += (v0[0] * v0[0] + v0[1] * v0[1]) + (v0[2] * v0[2] + v0[3] * v0[3]) + (v1[0] * v1[0] + v1[1] * v1[1]) + (v1[2] * v1[2] + v1[3] * v1[3]); }
                s = xsum_fq(s);
                if (fq == 0) __hip_atomic_fetch_add(ss + row, s, __ATOMIC_RELAXED, __HIP_MEMORY_SCOPE_AGENT);
                if (m & 1) asm volatile("" ::: "memory"); }
        asm volatile("s_waitcnt vmcnt(0)" ::: "memory");
        unsigned* c_ = cnt + 64 * u.pm;
        if (fr == 0 && fq == 0) __hip_atomic_fetch_add(c_, 1u, __ATOMIC_RELAXED, __HIP_MEMORY_SCOPE_AGENT);
        { unsigned spins = 0; while ((unsigned)__builtin_amdgcn_readfirstlane(__hip_atomic_load(c_, __ATOMIC_RELAXED, __HIP_MEMORY_SCOPE_AGENT)) < 32u && ++spins < (1u << 22)) __builtin_amdgcn_s_sleep(2); }
        asm volatile("" ::: "memory");
#pragma unroll
        for (int ai = 0; ai < 2; ++ai)
#pragma unroll
            for (int m = 0; m < 4; ++m) { const int row = row0 + ai * HALF + m * 16;
                const float rstd = 1.0f / sqrtf(__hip_atomic_load(ss + row, __ATOMIC_RELAXED, __HIP_MEMORY_SCOPE_AGENT) * (1.0f / 1024.0f) + eps);
#pragma unroll
                for (int bj = 0; bj < 2; ++bj) { const size_t off = (size_t)row * 1024 + c0 + bj * HALF; const f32x4 g0 = *(const f32x4*)(g + c0 + bj * HALF), g1 = *(const f32x4*)(g + c0 + bj * HALF + 4);
                    const f32x4 o0 = acc[ai][bj][m][0] * rstd * g0, o1 = acc[ai][bj][m][1] * rstd * g1;
                    if (MODE == 0) *(u32x4*)(xn + off) = pack8(o0, o1); else { *(f32x4*)(out + off) = o0; *(f32x4*)(out + off + 4) = o1; } }
                if (m & 1) asm volatile("" ::: "memory"); }
    }
};

struct PanelOrder {
    int pm, ntiles;
    __device__ __forceinline__ bool next(int i, Unit& u) const { if (i >= ntiles) return false; int p = pm; asm volatile("" : "+s"(p)); u.pm = p; u.pn = i; return true; }
    __device__ __forceinline__ void a_ready(const Unit&) const {}
    __device__ __forceinline__ void done(const Unit&) const {}
};
template <class Epi, class Sched, bool ALIGN_EPI = false, bool SP2 = false>
__device__ __forceinline__ void gemm_phase(PG8_LAS unsigned char* lds, const Gemm g, const Sched& S, const Epi& E) {
    int tid_ = threadIdx.x; asm volatile("" : "+v"(tid_));
    const int tid = tid_, wid = __builtin_amdgcn_readfirstlane(tid >> 6), lane = tid & 63, wr = wid >> 2, wc = wid & 3, fr = lane & 15, fq = lane >> 4;
    const int K = g.K, nt = K / BK;
    unsigned voffA[2], voffB[2];
#pragma unroll
    for (int i = 0; i < 2; ++i) { int R, C; stage_rc(tid * 16 + i * 8192, R, C); const int Rb = Epi::PERM ? ((R & ~31) + perm32(R & 31)) : R;
        voffA[i] = (unsigned)(R * K + C) * 2u; voffB[i] = (unsigned)(Rb * K + C) * 2u; }
    const size_t kstep = (size_t)(BK * 2);
    const size_t hstep = (size_t)HALF * K * 2;
    const size_t tstep = 2 * hstep;
    const unsigned ldsw = (unsigned)wid * 1024u;
    const int aoff = lds_byte(wr * 64 + fr, fq * 8), boff = lds_byte(wc * 32 + fr, fq * 8);
#define PG8_SA(b, h) (((b) * 2 + (h)) * HTB)
#define PG8_SB(b, h) ((4 + (b) * 2 + (h)) * HTB)
#define PG8_STAGE(bufoff, gbase, voff) do { _Pragma("unroll") for (int _i = 0; _i < 2; ++_i) \
        __builtin_amdgcn_global_load_lds((const unsigned*)((const char*)(gbase) + (voff)[_i]), (PG8_LAS unsigned*)(lds + (bufoff) + ldsw + _i * 8192), 16, 0, 0); } while (0)
#define PG8_LDA(dst, b, h) do { _Pragma("unroll") for (int m = 0; m < 4; ++m) _Pragma("unroll") for (int k = 0; k < 2; ++k) dst[m][k] = *(const PG8_LAS bf16x8*)(lds + PG8_SA(b, h) + aoff + m * 2048 + k * 1024); } while (0)
#define PG8_LDB(dst, b, h) do { _Pragma("unroll") for (int n = 0; n < 2; ++n) _Pragma("unroll") for (int k = 0; k < 2; ++k) dst[n][k] = *(const PG8_LAS bf16x8*)(lds + PG8_SB(b, h) + boff + n * 2048 + k * 1024); } while (0)
#define PG8_MMA(ai, bj, At, Bt) do { __builtin_amdgcn_s_setprio(1); _Pragma("unroll") for (int m = 0; m < 4; ++m) _Pragma("unroll") for (int n = 0; n < 2; ++n) _Pragma("unroll") for (int k = 0; k < 2; ++k) \
        acc[ai][bj][m][n] = __builtin_amdgcn_mfma_f32_16x16x32_bf16(Bt[n][k], At[m][k], acc[ai][bj][m][n], 0, 0, 0); __builtin_amdgcn_s_setprio(0); } while (0)
#define PG8_WAIT_V(n) asm volatile("s_waitcnt vmcnt(" #n ")" ::: "memory")
#define PG8_WAIT_L(n) asm volatile("s_waitcnt lgkmcnt(" #n ")" ::: "memory")
#define PG8_BAR __builtin_amdgcn_s_barrier()
#define PG8_SCHED __builtin_amdgcn_sched_barrier(0)
    Unit cur, nxt; int ui = 0;
    if (!S.next(0, cur)) return;
    f32x4 acc[2][2][4][2];
#pragma unroll
    for (int a = 0; a < 2; ++a)
#pragma unroll
        for (int b = 0; b < 2; ++b)
#pragma unroll
            for (int m = 0; m < 4; ++m)
#pragma unroll
                for (int n = 0; n < 2; ++n) acc[a][b][m][n] = (f32x4){0.f, 0.f, 0.f, 0.f};
    bf16x8 At[4][2], B0[2][2], B1[2][2];
    const char* cA = (const char*)g.A + (size_t)cur.pm * tstep; const char* cB = (const char*)g.Bt + (size_t)cur.pn * tstep;
    S.a_ready(cur);
    if constexpr (SP2) {
        PG8_STAGE(PG8_SB(0, 0), cB, voffB); PG8_STAGE(PG8_SB(0, 1), cB + hstep, voffB); PG8_STAGE(PG8_SA(0, 0), cA, voffA); PG8_STAGE(PG8_SA(0, 1), cA + hstep, voffA);
        if (wr == 1) PG8_BAR;
        PG8_WAIT_V(2); PG8_BAR;
        PG8_STAGE(PG8_SB(1, 0), cB + kstep, voffB); PG8_STAGE(PG8_SA(1, 0), cA + kstep, voffA); PG8_STAGE(PG8_SB(1, 1), cB + hstep + kstep, voffB);
        PG8_WAIT_V(6); PG8_BAR;
    } else {
        PG8_STAGE(PG8_SB(0, 0), cB, voffB); PG8_STAGE(PG8_SA(0, 0), cA, voffA); PG8_STAGE(PG8_SB(0, 1), cB + hstep, voffB); PG8_STAGE(PG8_SA(0, 1), cA + hstep, voffA);
        if (wr == 1) PG8_BAR;
        PG8_WAIT_V(4); PG8_BAR;
        PG8_STAGE(PG8_SB(1, 0), cB + kstep, voffB); PG8_STAGE(PG8_SA(1, 0), cA + kstep, voffA); PG8_STAGE(PG8_SB(1, 1), cB + hstep + kstep, voffB);
        PG8_WAIT_V(6); PG8_BAR;
    }
    for (;;) {
        const bool has_next = S.next(ui + 1, nxt);
        const char* nA = has_next ? (const char*)g.A + (size_t)nxt.pm * tstep : cA; const char* nB = has_next ? (const char*)g.Bt + (size_t)nxt.pn * tstep : cB;
        for (int t = 0; t < nt; t += 2) {
            if constexpr (Epi::MIDK > 0) { if (t == Epi::MIDK) E.mid(acc, cur, wr, wc, fr, fq); }
            const bool last = (t == nt - 2);
            const char* a1 = cA + (size_t)(t + 1) * kstep;
            const char* a2 = last ? nA : cA + (size_t)(t + 2) * kstep; const char* b2 = last ? nB : cB + (size_t)(t + 2) * kstep;
            const char* a3 = a2 + kstep; const char* b3 = b2 + kstep;
            if (last && has_next) S.a_ready(nxt);
            if constexpr (SP2) {
            PG8_LDB(B0, 0, 0); PG8_LDB(B1, 0, 1); PG8_SCHED; PG8_LDA(At, 0, 0); PG8_STAGE(PG8_SA(1, 1), a1 + hstep, voffA);
            PG8_WAIT_V(8); PG8_WAIT_L(0); PG8_BAR; PG8_MMA(0, 0, At, B0); PG8_MMA(0, 1, At, B1); PG8_BAR; PG8_SCHED;
            PG8_LDA(At, 0, 1); PG8_STAGE(PG8_SB(0, 0), b2, voffB); PG8_STAGE(PG8_SB(0, 1), b2 + hstep, voffB); PG8_STAGE(PG8_SA(0, 0), a2, voffA);
            PG8_WAIT_V(8); PG8_WAIT_L(0); PG8_BAR; PG8_MMA(1, 0, At, B0); PG8_MMA(1, 1, At, B1); PG8_BAR; PG8_SCHED;
            PG8_LDB(B0, 1, 0); PG8_LDB(B1, 1, 1); PG8_SCHED; PG8_LDA(At, 1, 0); PG8_STAGE(PG8_SA(0, 1), a2 + hstep, voffA);
            PG8_WAIT_V(8); PG8_WAIT_L(0); PG8_BAR; PG8_MMA(0, 0, At, B0); PG8_MMA(0, 1, At, B1); PG8_BAR; PG8_SCHED;
            PG8_LDA(At, 1, 1); PG8_STAGE(PG8_SB(1, 0), b3, voffB); PG8_STAGE(PG8_SB(1, 1), b3 + hstep, voffB); PG8_STAGE(PG8_SA(1, 0), a3, voffA);
            PG8_WAIT_V(8); PG8_WAIT_L(0); PG8_BAR; PG8_MMA(1, 0, At, B0); PG8_MMA(1, 1, At, B1); PG8_BAR; PG8_SCHED;
            } else {
            PG8_LDB(B0, 0, 0); PG8_SCHED; PG8_LDA(At, 0, 0); PG8_STAGE(PG8_SA(1, 1), a1 + hstep, voffA);
            PG8_WAIT_L(8); PG8_BAR; PG8_WAIT_L(0); PG8_MMA(0, 0, At, B0); PG8_BAR; PG8_SCHED;
            PG8_LDB(B1, 0, 1); PG8_STAGE(PG8_SB(0, 0), b2, voffB);
            PG8_BAR; PG8_WAIT_L(0); PG8_MMA(0, 1, At, B1); PG8_BAR;
            PG8_LDA(At, 0, 1); PG8_STAGE(PG8_SA(0, 0), a2, voffA);
            PG8_BAR; PG8_WAIT_L(0); PG8_MMA(1, 0, At, B0); PG8_BAR; PG8_SCHED;
            PG8_STAGE(PG8_SB(0, 1), b2 + hstep, voffB);
            PG8_WAIT_V(6); PG8_BAR; PG8_MMA(1, 1, At, B1); PG8_BAR;
            PG8_LDB(B0, 1, 0); PG8_SCHED; PG8_LDA(At, 1, 0); PG8_STAGE(PG8_SA(0, 1), a2 + hstep, voffA);
            PG8_WAIT_L(8); PG8_BAR; PG8_WAIT_L(0); PG8_MMA(0, 0, At, B0); PG8_BAR; PG8_SCHED;
            PG8_LDB(B1, 1, 1); PG8_STAGE(PG8_SB(1, 0), b3, voffB);
            PG8_BAR; PG8_WAIT_L(0); PG8_MMA(0, 1, At, B1); PG8_BAR;
            PG8_LDA(At, 1, 1); PG8_STAGE(PG8_SA(1, 0), a3, voffA);
            PG8_BAR; PG8_WAIT_L(0); PG8_MMA(1, 0, At, B0); PG8_BAR; PG8_SCHED;
            PG8_STAGE(PG8_SB(1, 1), b3 + hstep, voffB);
            PG8_WAIT_V(6); PG8_BAR; PG8_MMA(1, 1, At, B1); PG8_BAR;
            }
        }
        if constexpr (ALIGN_EPI) { if (wr == 0) PG8_BAR; }
        if constexpr (!Epi::AFTER_DRAIN) { E(acc, cur, wr, wc, fr, fq); S.done(cur); }
        if (!has_next) break;
#pragma unroll
        for (int a = 0; a < 2; ++a)
#pragma unroll
            for (int b = 0; b < 2; ++b)
#pragma unroll
                for (int m = 0; m < 4; ++m)
#pragma unroll
                    for (int n = 0; n < 2; ++n) acc[a][b][m][n] = (f32x4){0.f, 0.f, 0.f, 0.f};
        cur = nxt; cA = nA; cB = nB; ++ui;
        if constexpr (ALIGN_EPI) { if (wr == 1) PG8_BAR; }
    }
    PG8_WAIT_V(0);
    if constexpr (!ALIGN_EPI) { if (wr == 0) PG8_BAR; }
    PG8_BAR;
    if constexpr (Epi::AFTER_DRAIN) { E.fused(acc, cur, wr, wc, fr, fq, lds, wid, lane); S.done(cur); }
#undef PG8_SA
#undef PG8_SB
#undef PG8_STAGE
#undef PG8_LDA
#undef PG8_LDB
#undef PG8_MMA
#undef PG8_WAIT_V
#undef PG8_WAIT_L
#undef PG8_BAR
#undef PG8_SCHED
}
}

#ifndef PG8_SP2
#define PG8_SP2 true
#endif
#ifndef PG8_ALIGN
#define PG8_ALIGN true
#endif
#include <hip/hip_bf16.h>
#include <cmath>
namespace attn_body {
using bf16=__hip_bfloat16;
using bf16x8=__attribute__((ext_vector_type(8)))short;
using s16x4=__attribute__((ext_vector_type(4)))short;
using f32x16=__attribute__((ext_vector_type(16)))float;
using u32x4=__attribute__((ext_vector_type(4)))unsigned;
constexpr int SEQ=2048,D=64,QP=512,KP=512,VP=512,OP=1024;
constexpr int NW=8,QBLK=32,QB=QBLK*NW,KVBLK=64,NQB=SEQ/QB;
constexpr int ATTN_UNIT_ROWS=QB;
__device__ __forceinline__ int crow(int r,int hi){return (r&3)+8*(r>>2)+4*hi;}
#define SBAR() __builtin_amdgcn_sched_barrier(0)
__device__ __forceinline__ void cmask(f32x16&p0,f32x16&p1,int jb,int wchunk,int){
  if(jb>wchunk){ const float NEG=-INFINITY;
    #pragma unroll
    for(int r=0;r<16;++r){p0[r]=NEG;p1[r]=NEG;} }
}

constexpr int NSLOT=3, SLOTB=8192;
constexpr int LDS_K=0, LDS_V=NSLOT*SLOTB, LDS_WS=2*NSLOT*SLOTB, LDS_OST=LDS_WS+NW*64*4, LDS_BYTES=LDS_OST+NW*4096;
constexpr float C2=0.125f*1.4426950408889634f;
__device__ __forceinline__ void glds16(const void*gsrc,unsigned lds_dst){unsigned keep;
  asm volatile("s_mov_b32 %0, m0\n\ts_mov_b32 m0, %2\n\ts_nop 0\n\tglobal_load_lds_dwordx4 %1, off\n\ts_mov_b32 m0, %0":"=&s"(keep):"v"(gsrc),"s"(lds_dst):"memory");}
__device__ __forceinline__ float max3f(float a,float b,float c){float r;asm("v_max3_f32 %0, %1, %2, %3":"=v"(r):"v"(a),"v"(b),"v"(c));return r;}
__device__ __forceinline__ float max2f(float a,float b){float r;asm("v_max_f32_e32 %0, %1, %2":"=v"(r):"v"(a),"v"(b));return r;}
__device__ __forceinline__ float fadd_s(float a,float b){float r;asm("v_add_f32_e32 %0, %1, %2":"=v"(r):"v"(a),"v"(b));return r;}
__device__ __forceinline__ float fsub_s(float a,float b){float r;asm("v_sub_f32_e32 %0, %1, %2":"=v"(r):"v"(a),"v"(b));return r;}
typedef float f32x2_t __attribute__((ext_vector_type(2))); typedef __bf16 bf16x2_t __attribute__((ext_vector_type(2)));
__device__ __forceinline__ unsigned cvtpk_s(float lo,float hi){f32x2_t v={lo,hi};bf16x2_t b=__builtin_convertvector(v,bf16x2_t);return __builtin_bit_cast(unsigned,b);}
#define WAIT_BAR(N) asm volatile("s_waitcnt vmcnt(" #N ") lgkmcnt(0)\n\ts_barrier":::"memory")

__device__ __forceinline__ void qkt(f32x16&p0,f32x16&p1,const char*Kslot,const bf16x8*qr,const f32x16&negm,int r32,int hi){
  const char*kb=Kslot+hi*1024+r32*16;
  #pragma unroll
  for(int d0=0;d0<4;++d0){
    const bf16x8 b0=*reinterpret_cast<const bf16x8*>(kb+d0*2048);
    const bf16x8 b1=*reinterpret_cast<const bf16x8*>(kb+d0*2048+512);
    if(d0==0){p0=__builtin_amdgcn_mfma_f32_32x32x16_bf16(b0,qr[0],negm,0,0,0);p1=__builtin_amdgcn_mfma_f32_32x32x16_bf16(b1,qr[0],negm,0,0,0);}
    else{p0=__builtin_amdgcn_mfma_f32_32x32x16_bf16(b0,qr[d0],p0,0,0,0);p1=__builtin_amdgcn_mfma_f32_32x32x16_bf16(b1,qr[d0],p1,0,0,0);}}
}
typedef __attribute__((address_space(3))) const char* lds_cptr;
typedef short v4i16_t __attribute__((ext_vector_type(4)));
__device__ __forceinline__ void kload8(bf16x8*kf,lds_cptr kp){
  kf[0]=*(const __attribute__((address_space(3))) bf16x8*)(kp);      kf[1]=*(const __attribute__((address_space(3))) bf16x8*)(kp+512);
  kf[2]=*(const __attribute__((address_space(3))) bf16x8*)(kp+2048); kf[3]=*(const __attribute__((address_space(3))) bf16x8*)(kp+2560);
  kf[4]=*(const __attribute__((address_space(3))) bf16x8*)(kp+4096); kf[5]=*(const __attribute__((address_space(3))) bf16x8*)(kp+4608);
  kf[6]=*(const __attribute__((address_space(3))) bf16x8*)(kp+6144); kf[7]=*(const __attribute__((address_space(3))) bf16x8*)(kp+6656);
}
__device__ __forceinline__ void kload2(bf16x8*kf,lds_cptr kp,int j){ kf[2*j]=*(const __attribute__((address_space(3))) bf16x8*)(kp+j*2048); kf[2*j+1]=*(const __attribute__((address_space(3))) bf16x8*)(kp+j*2048+512); }
__device__ __forceinline__ s16x4 vtr(lds_cptr p){ return __builtin_bit_cast(s16x4,__builtin_amdgcn_ds_read_tr16_b64_v4i16((__attribute__((address_space(3))) v4i16_t*)p)); }
__device__ __forceinline__ float rowmax(const f32x16&p0,const f32x16&p1){
  float a=max3f(p0[0],p0[1],p1[0]),b=max3f(p0[2],p0[3],p1[1]);a=max3f(a,p1[2],p1[3]);
  #pragma unroll
  for(int r=4;r<16;r+=4){a=max3f(a,p0[r],p0[r+1]);b=max3f(b,p0[r+2],p0[r+3]);a=max3f(a,p1[r],p1[r+1]);b=max3f(b,p1[r+2],p1[r+3]);}
  const float m=max2f(a,b);
  auto rr=__builtin_amdgcn_permlane32_swap(__float_as_uint(m),__float_as_uint(m),false,false);
  return max2f(__uint_as_float(rr[0]),__uint_as_float(rr[1]));
}
__device__ __forceinline__ void pv(f32x16*o,int vb,bf16x8 pa0,bf16x8 pa1,bf16x8 pa2,bf16x8 pa3){
  #pragma unroll
  for(int d0=0;d0<2;++d0){s16x4 lo[4],hi[4];
    #pragma unroll
    for(int ks=0;ks<4;++ks){
      asm volatile("ds_read_b64_tr_b16 %0,%1 offset:%c2":"=&v"(lo[ks]):"v"(vb),"i"(d0*4096+ks*1024):"memory");
      asm volatile("ds_read_b64_tr_b16 %0,%1 offset:%c2":"=&v"(hi[ks]):"v"(vb),"i"(d0*4096+ks*1024+512):"memory");}
    asm volatile("s_waitcnt lgkmcnt(0)":::"memory");SBAR();
    #define PK(k) (bf16x8){lo[k][0],lo[k][1],lo[k][2],lo[k][3],hi[k][0],hi[k][1],hi[k][2],hi[k][3]}
    o[d0]=__builtin_amdgcn_mfma_f32_32x32x16_bf16(pa0,PK(0),o[d0],0,0,0);
    o[d0]=__builtin_amdgcn_mfma_f32_32x32x16_bf16(pa1,PK(1),o[d0],0,0,0);
    o[d0]=__builtin_amdgcn_mfma_f32_32x32x16_bf16(pa2,PK(2),o[d0],0,0,0);
    o[d0]=__builtin_amdgcn_mfma_f32_32x32x16_bf16(pa3,PK(3),o[d0],0,0,0);
    #undef PK
  }
}

#ifndef ATTN_STORE16
#define ATTN_STORE16(p,v) (*(u32x4*)(p)=(v))
#endif
template<int THRL> __device__ __forceinline__ void attn_unit(int b,int qcol,int kcol,int vcol,int ocol,int qb,const bf16*Q,const bf16*__restrict__ K,const bf16*__restrict__ V,bf16*O,char*shm){
  int tid_=threadIdx.x; asm volatile("":"+v"(tid_));
  const int tid=tid_,lane=tid&63,r32=lane&31,hi=lane>>5; const int wid=__builtin_amdgcn_readfirstlane(tid>>6);
  const long rowbase=(long)b*SEQ; const int q0=qb*QB;
  const bf16*Qw=Q+(rowbase+q0+wid*QBLK)*QP+qcol;
  const bf16*Kh=K+rowbase*KP+kcol,*Vh=V+rowbase*VP+vcol;
  const unsigned lds0=(unsigned)(uintptr_t)shm;
  float*wsf=(float*)(shm+LDS_WS)+wid*64;
  const bf16*ksrc=Kh+(long)lane*KP+wid*8;
  const bf16*vsrc=Vh+(long)(16*(wid&3)+(lane>>2))*VP+(wid>>2)*32+(lane&3)*8;
  const unsigned kdst=lds0+LDS_K+wid*1024, vdst=lds0+LDS_V+wid*1024;
  #define DMA_K(t,slot) glds16(ksrc+(long)(t)*KVBLK*KP,(unsigned)__builtin_amdgcn_readfirstlane(kdst+(slot)))
  #define DMA_V(t,slot) glds16(vsrc+(long)(t)*KVBLK*VP,(unsigned)__builtin_amdgcn_readfirstlane(vdst+(slot)))
  const int vb0=(int)(lds0+LDS_V)+((lane>>4)&1)*32+(lane&3)*8+(4*hi+((lane&15)>>2))*64;
  const char*Kbase=shm+LDS_K; bf16x8 kf[8];
  const lds_cptr shm3=(lds_cptr)shm; const lds_cptr kp0=shm3+LDS_K+hi*1024+r32*16; const lds_cptr vp0=shm3+LDS_V+((lane>>4)&1)*32+(lane&3)*8+(4*hi+((lane&15)>>2))*64;
  const int NT=(q0+QB)/KVBLK;
  DMA_K(0,0);DMA_V(0,0);DMA_K(1,SLOTB);
  bf16x8 qr[4];
  #pragma unroll
  for(int d0=0;d0<4;++d0)qr[d0]=*reinterpret_cast<const bf16x8*>(&Qw[(long)r32*QP+d0*16+hi*8]);
  float mhat=0.f,l_reg=0.f;f32x16 o[2];o[0]=f32x16{};o[1]=f32x16{};f32x16 negm=f32x16{};asm volatile("":"+v"(negm));
  const int qrel=wid>>1;
  #define CMASK(P0,P1,t) do{int jb_=(t)-(NT-4); if(jb_>=0)cmask(P0,P1,jb_,qrel,hi);}while(0)
  bool resc=false;
  #define START(P0,P1) do{ const float rm=rowmax(P0,P1); resc=false; \
    { const float dl=rm; mhat=fadd_s(mhat,dl); \
      _Pragma("unroll") for(int r=0;r<16;++r){P0[r]=fsub_s(P0[r],dl);P1[r]=fsub_s(P1[r],dl);} \
      _Pragma("unroll") for(int r=0;r<16;++r)negm[r]=-mhat; asm volatile("":"+v"(negm)); } \
    _Pragma("unroll") for(int r=0;r<16;++r)P0[r]=__builtin_amdgcn_exp2f(P0[r]); }while(0)
  #define RESC() do{ if(resc){ asm volatile("s_waitcnt lgkmcnt(0)":::"memory"); \
      _Pragma("unroll") for(int d_=0;d_<2;++d_) _Pragma("unroll") for(int r=0;r<16;++r)o[d_][r]*=wsf[crow(r,hi)]; } }while(0)
  f32x16 pA0,pA1,pB0,pB1;
  int sl_prev=0,sl_cur=0,sl_next=SLOTB;
  #define ROT() do{sl_prev=sl_cur;sl_cur=sl_next;sl_next=(sl_next==(NSLOT-1)*SLOTB)?0:sl_next+SLOTB;}while(0)
  DMA_K(2,2*SLOTB);
  WAIT_BAR(3);
  qkt(pA0,pA1,Kbase,qr,negm,r32,hi);asm volatile("s_nop 15\n\ts_nop 7":"+v"(pA0),"+v"(pA1));CMASK(pA0,pA1,0);
  START(pA0,pA1);
  _Pragma("unroll") for(int r=0;r<16;++r)pA1[r]=__builtin_amdgcn_exp2f(pA1[r]);
  WAIT_BAR(0);
  DMA_K(3,0);DMA_V(1,SLOTB);
  ROT();
  kload8(kf,kp0+sl_cur);
  WAIT_BAR(2);
  s16x4 vlo[8],vhi[8]; u32x4 pw0,pw1,pw2,pw3;
  #define PKW(P,B) cvtpk_s(P[B],P[B+1])
  #define PAF(k) __builtin_bit_cast(bf16x8,pw##k)
  #define VFR(i) (bf16x8){vlo[i][0],vlo[i][1],vlo[i][2],vlo[i][3],vhi[i][0],vhi[i][1],vhi[i][2],vhi[i][3]}
  #define PIN(x) asm volatile("":"+v"(x))
  #define MX3(a,b,c) __builtin_fmaxf(__builtin_fmaxf((a),(b)),(c))
  #define GAPA(MF,A0,A1,A2,A3,W0,W1,PW) do{ MF; sacc+=A0; sacc+=A1; sacc+=A2; sacc+=A3; PIN(sacc); W0; W1; PIN(PW); SBAR(); }while(0)
  #define EX(v) __builtin_amdgcn_exp2f(v)
  #define GAPB(MF,X,B) do{ MF; X[B]=EX(X[B]); X[B+1]=EX(X[B+1]); X[B+2]=EX(X[B+2]); X[B+3]=EX(X[B+3]); PIN(X); SBAR(); }while(0)
  #define VRD(i) do{ vlo[i]=vtr(vp_+(((i)>>2)*4096+((i)&3)*1024)); vhi[i]=vtr(vp_+(((i)>>2)*4096+((i)&3)*1024+512)); }while(0)
  #define KRD(G,j) do{ if(G){ kload2(kf,kp0+sl_next,j); SBAR(); } }while(0)
  #define STEP(C0,C1,P0,P1,t,GK,GV,GL) do{ SBAR(); \
    const lds_cptr vp_=vp0+sl_prev; \
    VRD(0); SBAR(); float sacc=(P0[0]+P0[1]); \
    GAPA(C0=__builtin_amdgcn_mfma_f32_32x32x16_bf16(kf[0],qr[0],negm,0,0,0), P0[2],P0[3],P0[4],P0[5],     pw0[0]=PKW(P0,0), pw0[1]=PKW(P0,2), pw0); \
    VRD(4); SBAR(); GAPA(C1=__builtin_amdgcn_mfma_f32_32x32x16_bf16(kf[1],qr[0],negm,0,0,0), P0[6],P0[7],P0[8],P0[9],     pw0[2]=PKW(P0,4), pw0[3]=PKW(P0,6), pw0); \
    VRD(1); SBAR(); GAPA(C0=__builtin_amdgcn_mfma_f32_32x32x16_bf16(kf[2],qr[1],C0,0,0,0),   P0[10],P0[11],P0[12],P0[13], pw1[0]=PKW(P0,8), pw1[1]=PKW(P0,10), pw1); \
    VRD(5); SBAR(); GAPA(C1=__builtin_amdgcn_mfma_f32_32x32x16_bf16(kf[3],qr[1],C1,0,0,0),   P0[14],P0[15],P1[0],P1[1],   pw1[2]=PKW(P0,12),pw1[3]=PKW(P0,14), pw1); \
    VRD(2); SBAR(); GAPA(C0=__builtin_amdgcn_mfma_f32_32x32x16_bf16(kf[4],qr[2],C0,0,0,0),   P1[2],P1[3],P1[4],P1[5],     pw2[0]=PKW(P1,0), pw2[1]=PKW(P1,2), pw2); \
    VRD(6); SBAR(); GAPA(C1=__builtin_amdgcn_mfma_f32_32x32x16_bf16(kf[5],qr[2],C1,0,0,0),   P1[6],P1[7],P1[8],P1[9],     pw2[2]=PKW(P1,4), pw2[3]=PKW(P1,6), pw2); \
    VRD(3); SBAR(); GAPA(C0=__builtin_amdgcn_mfma_f32_32x32x16_bf16(kf[6],qr[3],C0,0,0,0),   P1[10],P1[11],P1[12],P1[13], pw3[0]=PKW(P1,8), pw3[1]=PKW(P1,10), pw3); \
    VRD(7); SBAR(); GAPA(C1=__builtin_amdgcn_mfma_f32_32x32x16_bf16(kf[7],qr[3],C1,0,0,0),   P1[14],P1[15],0.f,0.f,       pw3[2]=PKW(P1,12),pw3[3]=PKW(P1,14), pw3); \
    l_reg+=sacc; \
    if(GK){DMA_K((t)+3,sl_cur);} if(GV){DMA_V((t)+1,sl_next);} \
    CMASK(C0,C1,t); \
    { float a=MX3(C0[0],C0[1],C1[0]),b=MX3(C0[2],C0[3],C1[1]); a=MX3(a,C1[2],C1[3]); \
      _Pragma("unroll") for(int r=4;r<16;r+=4){a=MX3(a,C0[r],C0[r+1]);b=MX3(b,C0[r+2],C0[r+3]);a=MX3(a,C1[r],C1[r+1]);b=MX3(b,C1[r+2],C1[r+3]);} \
      float rm=__builtin_fmaxf(a,b); { auto rr=__builtin_amdgcn_permlane32_swap(__float_as_uint(rm),__float_as_uint(rm),false,false); rm=__builtin_fmaxf(__uint_as_float(rr[0]),__uint_as_float(rr[1])); } \
      resc=false; \
      if(__builtin_expect(__any(rm>(float)THRL),0)){ const float dl=__builtin_fmaxf(rm,0.f); mhat+=dl; \
        _Pragma("unroll") for(int r=0;r<16;++r){C0[r]-=dl;C1[r]-=dl;} \
        _Pragma("unroll") for(int r=0;r<16;++r)negm[r]=-mhat; asm volatile("":"+v"(negm)); \
        const float f=__builtin_amdgcn_exp2f(-dl); l_reg*=f; if(hi==0)wsf[r32]=f; resc=true; } } \
    SBAR(); \
    GAPB(o[0]=__builtin_amdgcn_mfma_f32_32x32x16_bf16(PAF(0),VFR(0),o[0],0,0,0), C0,0); \
    GAPB(o[1]=__builtin_amdgcn_mfma_f32_32x32x16_bf16(PAF(0),VFR(4),o[1],0,0,0), C0,4); \
    KRD(GL,0); GAPB(o[0]=__builtin_amdgcn_mfma_f32_32x32x16_bf16(PAF(1),VFR(1),o[0],0,0,0), C0,8); \
    KRD(GL,1); GAPB(o[1]=__builtin_amdgcn_mfma_f32_32x32x16_bf16(PAF(1),VFR(5),o[1],0,0,0), C0,12); \
    KRD(GL,2); GAPB(o[0]=__builtin_amdgcn_mfma_f32_32x32x16_bf16(PAF(2),VFR(2),o[0],0,0,0), C1,0); \
    KRD(GL,3); GAPB(o[1]=__builtin_amdgcn_mfma_f32_32x32x16_bf16(PAF(2),VFR(6),o[1],0,0,0), C1,4); \
    GAPB(o[0]=__builtin_amdgcn_mfma_f32_32x32x16_bf16(PAF(3),VFR(3),o[0],0,0,0), C1,8); \
    GAPB(o[1]=__builtin_amdgcn_mfma_f32_32x32x16_bf16(PAF(3),VFR(7),o[1],0,0,0), C1,12); \
    }while(0)
  int t=1;
  #undef CMASK
  #define CMASK(P0,P1,t) do{}while(0)
  for(;t+5<NT;t+=2){
    STEP(pB0,pB1,pA0,pA1,t,true,true,true);     WAIT_BAR(2); RESC(); ROT();
    STEP(pA0,pA1,pB0,pB1,t+1,true,true,true);   WAIT_BAR(2); RESC(); ROT();
  }
  #undef CMASK
  #define CMASK(P0,P1,t) do{int jb_=(t)-(NT-4); if(jb_>=0)cmask(P0,P1,jb_,qrel,hi);}while(0)
  #define ENDW(tt) do{ if((tt)+3<NT){WAIT_BAR(2);} else if((tt)+2<NT){WAIT_BAR(1);} else {WAIT_BAR(0);} }while(0)
  for(;t+1<NT;t+=2){
    STEP(pB0,pB1,pA0,pA1,t,(t+3<NT),(t+1<NT),(t+1<NT));       ENDW(t);   RESC(); ROT();
    STEP(pA0,pA1,pB0,pB1,t+1,(t+4<NT),(t+2<NT),(t+2<NT));     ENDW(t+1); RESC(); ROT();
  }
  STEP(pB0,pB1,pA0,pA1,NT-1,false,false,false); RESC();
  { float sacc=pB0[0]+pB0[1]; _Pragma("unroll") for(int r=2;r<16;++r)sacc+=pB0[r]; _Pragma("unroll") for(int r=0;r<16;++r)sacc+=pB1[r]; l_reg+=sacc;
    pw0=(u32x4){PKW(pB0,0),PKW(pB0,2),PKW(pB0,4),PKW(pB0,6)};pw1=(u32x4){PKW(pB0,8),PKW(pB0,10),PKW(pB0,12),PKW(pB0,14)};pw2=(u32x4){PKW(pB1,0),PKW(pB1,2),PKW(pB1,4),PKW(pB1,6)};pw3=(u32x4){PKW(pB1,8),PKW(pB1,10),PKW(pB1,12),PKW(pB1,14)};
    SBAR(); pv(o,vb0+sl_cur,PAF(0),PAF(1),PAF(2),PAF(3)); }
  #undef PKW
  #undef PAF
  #undef VFR
  #undef PIN
  #undef MX3
  #undef GAPA
  #undef GAPB
  #undef EX
  #undef VRD
  #undef KRD
  #undef STEP
  #undef ENDW
  {auto rr=__builtin_amdgcn_permlane32_swap(__float_as_uint(l_reg),__float_as_uint(l_reg),false,false);l_reg=__uint_as_float(rr[0])+__uint_as_float(rr[1]);}
  if(hi==0)wsf[32+r32]=l_reg;asm volatile("s_waitcnt lgkmcnt(0)":::"memory");
  float rli[16];
  #pragma unroll
  for(int r=0;r<16;++r)rli[r]=__builtin_amdgcn_rcpf(wsf[32+crow(r,hi)]);
  bf16*Ow=O+(rowbase+q0+wid*QBLK)*OP+ocol;
  { bf16*stg=(bf16*)(shm+LDS_OST)+wid*2048;
    #pragma unroll
    for(int r=0;r<16;++r){const int orow=crow(r,hi);
      #pragma unroll
      for(int d0=0;d0<2;++d0)stg[orow*64+d0*32+r32]=__float2bfloat16(o[d0][r]*rli[r]);}
    asm volatile("s_waitcnt lgkmcnt(0)":::"memory");
    #pragma unroll
    for(int i=0;i<4;++i){const int row=i*8+(lane>>3),ch=lane&7; const u32x4 v=*(const u32x4*)(stg+row*64+ch*8); ATTN_STORE16(Ow+(long)row*OP+ch*8,v);} }
  asm volatile("s_waitcnt lgkmcnt(0)\n\ts_barrier":::"memory");
  #undef DMA_K
  #undef DMA_V
  #undef CMASK
  #undef START
  #undef RESC
  #undef ROT
}
constexpr int LDS3_V=4*SLOTB, LDS3_WS=LDS3_V+4*2*SLOTB, LDS3_OST=LDS3_WS+NW*64*4, LDS3_BYTES=LDS3_OST+NW*4096;
constexpr int LDS2_V=NSLOT*SLOTB, LDS2_WS=LDS2_V+NSLOT*2*SLOTB, LDS2_OST=LDS2_WS+NW*64*4, LDS2_BYTES=LDS2_OST+NW*8192;
#ifndef ATTN_STORE16
#define ATTN_STORE16(p,v) (*(u32x4*)(p)=(v))
#endif
template<int THRL> __device__ __forceinline__ void attn_unit128(int b,int qcol,int kcol,int vcol,int ocol,int qb,const bf16*Q,const bf16*__restrict__ K,const bf16*__restrict__ V,bf16*O,char*shm){
  int tid_=threadIdx.x; asm volatile("":"+v"(tid_));
  const int tid=tid_,lane=tid&63,r32=lane&31,hi=lane>>5; const int wid=__builtin_amdgcn_readfirstlane(tid>>6);
  const long rowbase=(long)b*SEQ; const int q0=qb*QB;
  const bf16*Qw=Q+(rowbase+q0+wid*QBLK)*QP+qcol;
  const bf16*Kh=K+rowbase*KP+kcol,*Vh=V+rowbase*VP+vcol;
  const unsigned lds0=(unsigned)(uintptr_t)shm;
  float*wsf=(float*)(shm+LDS3_WS)+wid*64;
  const bf16*ksrc=Kh+(long)lane*KP+wid*8;
  const bf16*vsrc=Vh+(long)(16*(wid&3)+(lane>>2))*VP+(wid>>2)*32+(lane&3)*8;
  const unsigned kdst=lds0+LDS_K+wid*1024, vdst=lds0+LDS3_V+wid*1024;
  #define DMA_K(t,slot) glds16(ksrc+(long)(t)*KVBLK*KP,(unsigned)__builtin_amdgcn_readfirstlane(kdst+(slot)))
  #define DMA_V(t,slot) do{ glds16(vsrc+(long)(t)*KVBLK*VP,(unsigned)__builtin_amdgcn_readfirstlane(vdst+2*(slot))); glds16(vsrc+(long)(t)*KVBLK*VP+64,(unsigned)__builtin_amdgcn_readfirstlane(vdst+2*(slot)+8192)); }while(0)
  const int vb0=(int)(lds0+LDS3_V)+((lane>>4)&1)*32+(lane&3)*8+(4*hi+((lane&15)>>2))*64;
  const char*Kbase=shm+LDS_K; bf16x8 kf[8];
  const lds_cptr shm3=(lds_cptr)shm; const lds_cptr kp0=shm3+LDS_K+hi*1024+r32*16; const lds_cptr vp0=shm3+LDS3_V+((lane>>4)&1)*32+(lane&3)*8+(4*hi+((lane&15)>>2))*64;
  const int NT=(q0+QB)/KVBLK;
  DMA_K(0,0);DMA_V(0,0);DMA_K(1,SLOTB);
  bf16x8 qr[4];
  #pragma unroll
  for(int d0=0;d0<4;++d0)qr[d0]=*reinterpret_cast<const bf16x8*>(&Qw[(long)r32*QP+d0*16+hi*8]);
  float mhat=0.f,l_reg=0.f;f32x16 o[4];o[0]=f32x16{};o[1]=f32x16{};o[2]=f32x16{};o[3]=f32x16{};f32x16 negm=f32x16{};asm volatile("":"+v"(negm));
  const int qrel=wid>>1;
  #define CMASK(P0,P1,t) do{int jb_=(t)-(NT-4); if(jb_>=0)cmask(P0,P1,jb_,qrel,hi);}while(0)
  bool resc=false;
  #define START(P0,P1) do{ const float rm=rowmax(P0,P1); resc=false; \
    { const float dl=rm; mhat=fadd_s(mhat,dl); \
      _Pragma("unroll") for(int r=0;r<16;++r){P0[r]=fsub_s(P0[r],dl);P1[r]=fsub_s(P1[r],dl);} \
      _Pragma("unroll") for(int r=0;r<16;++r)negm[r]=-mhat; asm volatile("":"+v"(negm)); } \
    _Pragma("unroll") for(int r=0;r<16;++r)P0[r]=__builtin_amdgcn_exp2f(P0[r]); }while(0)
  #define RESC() do{ if(resc){ asm volatile("s_waitcnt lgkmcnt(0)":::"memory"); \
      _Pragma("unroll") for(int d_=0;d_<4;++d_) _Pragma("unroll") for(int r=0;r<16;++r)o[d_][r]*=wsf[crow(r,hi)]; } }while(0)
  f32x16 pA0,pA1,pB0,pB1;
  int sl_prev=0,sl_cur=SLOTB,sl_next=2*SLOTB,sl_next2=3*SLOTB;
  #define ROT() do{sl_prev=sl_cur;sl_cur=sl_next;sl_next=sl_next2;sl_next2=(sl_next2+SLOTB)&(4*SLOTB-1);}while(0)
  DMA_K(2,2*SLOTB);DMA_V(1,SLOTB);DMA_K(3,3*SLOTB);
  WAIT_BAR(7);
  qkt(pA0,pA1,Kbase,qr,negm,r32,hi);asm volatile("s_nop 15\n\ts_nop 7":"+v"(pA0),"+v"(pA1));CMASK(pA0,pA1,0);
  START(pA0,pA1);
  _Pragma("unroll") for(int r=0;r<16;++r)pA1[r]=__builtin_amdgcn_exp2f(pA1[r]);
  WAIT_BAR(4);
  if(NT>4){DMA_K(4,0);} DMA_V(2,2*SLOTB);
  kload8(kf,kp0+sl_cur);
  if(NT>4){WAIT_BAR(6);}else{WAIT_BAR(5);}
  s16x4 vlo[4],vhi[4]; u32x4 pw0,pw1,pw2,pw3;
  #define PKW(P,B) cvtpk_s(P[B],P[B+1])
  #define PAF(k) __builtin_bit_cast(bf16x8,pw##k)
  #define VFR(i) (bf16x8){vlo[i][0],vlo[i][1],vlo[i][2],vlo[i][3],vhi[i][0],vhi[i][1],vhi[i][2],vhi[i][3]}
  #define PIN(x) asm volatile("":"+v"(x))
  #define MX3(a,b,c) __builtin_fmaxf(__builtin_fmaxf((a),(b)),(c))
  #define GAPA(MF,A0,A1,A2,A3,W0,W1,PW) do{ MF; sacc+=A0; sacc+=A1; sacc+=A2; sacc+=A3; PIN(sacc); W0; W1; PIN(PW); SBAR(); }while(0)
  #define EX(v) __builtin_amdgcn_exp2f(v)
  #define GAPB(MF,X,B) do{ MF; X[B]=EX(X[B]); X[B+1]=EX(X[B+1]); PIN(X); SBAR(); }while(0)
  #define GAPBV(MF,RD,X,B) do{ MF; RD; X[B]=EX(X[B]); X[B+1]=EX(X[B+1]); PIN(X); SBAR(); }while(0)
  #define VRD(j,d,k) do{ vlo[(j)&3]=vtr(vp_+((d)*4096+(k)*1024)); vhi[(j)&3]=vtr(vp_+((d)*4096+(k)*1024+512)); }while(0)
  #define KRD(G,j) do{ if(G){ kload2(kf,kp0+sl_next,j); SBAR(); } }while(0)
  #define STEP(C0,C1,P0,P1,t,GK,GV,GL) do{ SBAR(); \
    const lds_cptr vp_=vp0+2*sl_prev; \
    float sacc=(P0[0]+P0[1]); \
    GAPA(C0=__builtin_amdgcn_mfma_f32_32x32x16_bf16(kf[0],qr[0],negm,0,0,0), P0[2],P0[3],P0[4],P0[5],     pw0[0]=PKW(P0,0), pw0[1]=PKW(P0,2), pw0); \
    GAPA(C1=__builtin_amdgcn_mfma_f32_32x32x16_bf16(kf[1],qr[0],negm,0,0,0), P0[6],P0[7],P0[8],P0[9],     pw0[2]=PKW(P0,4), pw0[3]=PKW(P0,6), pw0); \
    GAPA(C0=__builtin_amdgcn_mfma_f32_32x32x16_bf16(kf[2],qr[1],C0,0,0,0),   P0[10],P0[11],P0[12],P0[13], pw1[0]=PKW(P0,8), pw1[1]=PKW(P0,10), pw1); \
    GAPA(C1=__builtin_amdgcn_mfma_f32_32x32x16_bf16(kf[3],qr[1],C1,0,0,0),   P0[14],P0[15],P1[0],P1[1],   pw1[2]=PKW(P0,12),pw1[3]=PKW(P0,14), pw1); \
    VRD(0,0,0); SBAR(); GAPA(C0=__builtin_amdgcn_mfma_f32_32x32x16_bf16(kf[4],qr[2],C0,0,0,0),   P1[2],P1[3],P1[4],P1[5],     pw2[0]=PKW(P1,0), pw2[1]=PKW(P1,2), pw2); \
    VRD(1,1,0); SBAR(); GAPA(C1=__builtin_amdgcn_mfma_f32_32x32x16_bf16(kf[5],qr[2],C1,0,0,0),   P1[6],P1[7],P1[8],P1[9],     pw2[2]=PKW(P1,4), pw2[3]=PKW(P1,6), pw2); \
    VRD(2,0,1); SBAR(); GAPA(C0=__builtin_amdgcn_mfma_f32_32x32x16_bf16(kf[6],qr[3],C0,0,0,0),   P1[10],P1[11],P1[12],P1[13], pw3[0]=PKW(P1,8), pw3[1]=PKW(P1,10), pw3); \
    VRD(3,1,1); SBAR(); GAPA(C1=__builtin_amdgcn_mfma_f32_32x32x16_bf16(kf[7],qr[3],C1,0,0,0),   P1[14],P1[15],0.f,0.f,       pw3[2]=PKW(P1,12),pw3[3]=PKW(P1,14), pw3); \
    l_reg+=sacc; \
    if(GK){DMA_K((t)+4,sl_cur);} if(GV){DMA_V((t)+2,sl_next2);} \
    CMASK(C0,C1,t); \
    { float a=MX3(C0[0],C0[1],C1[0]),b=MX3(C0[2],C0[3],C1[1]); a=MX3(a,C1[2],C1[3]); \
      _Pragma("unroll") for(int r=4;r<16;r+=4){a=MX3(a,C0[r],C0[r+1]);b=MX3(b,C0[r+2],C0[r+3]);a=MX3(a,C1[r],C1[r+1]);b=MX3(b,C1[r+2],C1[r+3]);} \
      float rm=__builtin_fmaxf(a,b); { auto rr=__builtin_amdgcn_permlane32_swap(__float_as_uint(rm),__float_as_uint(rm),false,false); rm=__builtin_fmaxf(__uint_as_float(rr[0]),__uint_as_float(rr[1])); } \
      resc=false; \
      if(__builtin_expect(__any(rm>(float)THRL),0)){ const float dl=__builtin_fmaxf(rm,0.f); mhat+=dl; \
        _Pragma("unroll") for(int r=0;r<16;++r){C0[r]-=dl;C1[r]-=dl;} \
        _Pragma("unroll") for(int r=0;r<16;++r)negm[r]=-mhat; asm volatile("":"+v"(negm)); \
        const float f=__builtin_amdgcn_exp2f(-dl); l_reg*=f; if(hi==0)wsf[r32]=f; resc=true; } } \
    SBAR(); \
    GAPBV(o[0]=__builtin_amdgcn_mfma_f32_32x32x16_bf16(PAF(0),VFR(0),o[0],0,0,0), VRD(4,0,2), C0,0); \
    GAPBV(o[1]=__builtin_amdgcn_mfma_f32_32x32x16_bf16(PAF(0),VFR(1),o[1],0,0,0), VRD(5,1,2), C0,2); \
    KRD(GL,0); GAPBV(o[0]=__builtin_amdgcn_mfma_f32_32x32x16_bf16(PAF(1),VFR(2),o[0],0,0,0), VRD(6,0,3), C0,4); \
    KRD(GL,1); GAPBV(o[1]=__builtin_amdgcn_mfma_f32_32x32x16_bf16(PAF(1),VFR(3),o[1],0,0,0), VRD(7,1,3), C0,6); \
    KRD(GL,2); GAPBV(o[0]=__builtin_amdgcn_mfma_f32_32x32x16_bf16(PAF(2),VFR(0),o[0],0,0,0), VRD(8,2,0), C0,8); \
    KRD(GL,3); GAPBV(o[1]=__builtin_amdgcn_mfma_f32_32x32x16_bf16(PAF(2),VFR(1),o[1],0,0,0), VRD(9,3,0), C0,10); \
    GAPBV(o[0]=__builtin_amdgcn_mfma_f32_32x32x16_bf16(PAF(3),VFR(2),o[0],0,0,0), VRD(10,2,1), C0,12); \
    GAPBV(o[1]=__builtin_amdgcn_mfma_f32_32x32x16_bf16(PAF(3),VFR(3),o[1],0,0,0), VRD(11,3,1), C0,14); \
    GAPBV(o[2]=__builtin_amdgcn_mfma_f32_32x32x16_bf16(PAF(0),VFR(0),o[2],0,0,0), VRD(12,2,2), C1,0); \
    GAPBV(o[3]=__builtin_amdgcn_mfma_f32_32x32x16_bf16(PAF(0),VFR(1),o[3],0,0,0), VRD(13,3,2), C1,2); \
    GAPBV(o[2]=__builtin_amdgcn_mfma_f32_32x32x16_bf16(PAF(1),VFR(2),o[2],0,0,0), VRD(14,2,3), C1,4); \
    GAPBV(o[3]=__builtin_amdgcn_mfma_f32_32x32x16_bf16(PAF(1),VFR(3),o[3],0,0,0), VRD(15,3,3), C1,6); \
    GAPB(o[2]=__builtin_amdgcn_mfma_f32_32x32x16_bf16(PAF(2),VFR(0),o[2],0,0,0), C1,8); \
    GAPB(o[3]=__builtin_amdgcn_mfma_f32_32x32x16_bf16(PAF(2),VFR(1),o[3],0,0,0), C1,10); \
    GAPB(o[2]=__builtin_amdgcn_mfma_f32_32x32x16_bf16(PAF(3),VFR(2),o[2],0,0,0), C1,12); \
    GAPB(o[3]=__builtin_amdgcn_mfma_f32_32x32x16_bf16(PAF(3),VFR(3),o[3],0,0,0), C1,14); \
    }while(0)
  int t=1;
  #undef CMASK
  #define CMASK(P0,P1,t) do{}while(0)
  for(;t+5<NT;t+=2){
    STEP(pB0,pB1,pA0,pA1,t,true,true,true);     WAIT_BAR(6); RESC(); ROT();
    STEP(pA0,pA1,pB0,pB1,t+1,true,true,true);   WAIT_BAR(6); RESC(); ROT();
  }
  #undef CMASK
  #define CMASK(P0,P1,t) do{int jb_=(t)-(NT-4); if(jb_>=0)cmask(P0,P1,jb_,qrel,hi);}while(0)
  #define ENDW(tt) do{ const int d_=NT-(tt); if(d_>=5){WAIT_BAR(6);} else if(d_==4){WAIT_BAR(5);} else if(d_==3){WAIT_BAR(4);} else {WAIT_BAR(0);} }while(0)
  for(;t+1<NT;t+=2){
    STEP(pB0,pB1,pA0,pA1,t,(t+4<NT),(t+2<NT),(t+1<NT));       ENDW(t);   RESC(); ROT();
    STEP(pA0,pA1,pB0,pB1,t+1,(t+5<NT),(t+3<NT),(t+2<NT));     ENDW(t+1); RESC(); ROT();
  }
  STEP(pB0,pB1,pA0,pA1,NT-1,false,false,false); RESC();
  { float sacc=pB0[0]+pB0[1]; _Pragma("unroll") for(int r=2;r<16;++r)sacc+=pB0[r]; _Pragma("unroll") for(int r=0;r<16;++r)sacc+=pB1[r]; l_reg+=sacc;
    pw0=(u32x4){PKW(pB0,0),PKW(pB0,2),PKW(pB0,4),PKW(pB0,6)};pw1=(u32x4){PKW(pB0,8),PKW(pB0,10),PKW(pB0,12),PKW(pB0,14)};pw2=(u32x4){PKW(pB1,0),PKW(pB1,2),PKW(pB1,4),PKW(pB1,6)};pw3=(u32x4){PKW(pB1,8),PKW(pB1,10),PKW(pB1,12),PKW(pB1,14)};
    SBAR(); pv(o,vb0+2*sl_cur,PAF(0),PAF(1),PAF(2),PAF(3)); pv(o+2,vb0+2*sl_cur+8192,PAF(0),PAF(1),PAF(2),PAF(3)); }
  #undef PKW
  #undef PAF
  #undef VFR
  #undef PIN
  #undef MX3
  #undef GAPA
  #undef GAPB
  #undef GAPBV
  #undef EX
  #undef VRD
  #undef KRD
  #undef STEP
  #undef ENDW
  {auto rr=__builtin_amdgcn_permlane32_swap(__float_as_uint(l_reg),__float_as_uint(l_reg),false,false);l_reg=__uint_as_float(rr[0])+__uint_as_float(rr[1]);}
  if(hi==0)wsf[32+r32]=l_reg;asm volatile("s_waitcnt lgkmcnt(0)":::"memory");
  float rli[16];
  #pragma unroll
  for(int r=0;r<16;++r)rli[r]=__builtin_amdgcn_rcpf(wsf[32+crow(r,hi)]);
  bf16*Ow=O+(rowbase+q0+wid*QBLK)*OP+ocol;
  { bf16*stg=(bf16*)(shm+LDS3_OST)+wid*2048;
    #pragma unroll
    for(int hc=0;hc<2;++hc){
      #pragma unroll
      for(int r=0;r<16;++r){const int orow=crow(r,hi);
        #pragma unroll
        for(int d0=0;d0<2;++d0)stg[orow*64+d0*32+r32]=__float2bfloat16(o[2*hc+d0][r]*rli[r]);}
      asm volatile("s_waitcnt lgkmcnt(0)":::"memory");
      #pragma unroll
      for(int i=0;i<4;++i){const int row=i*8+(lane>>3),ch=lane&7; const u32x4 v=*(const u32x4*)(stg+row*64+ch*8); ATTN_STORE16(Ow+(long)row*OP+hc*64+ch*8,v);}
      asm volatile("s_waitcnt lgkmcnt(0)":::"memory"); } }
  asm volatile("s_waitcnt lgkmcnt(0)\n\ts_barrier":::"memory");
  #undef DMA_K
  #undef DMA_V
  #undef CMASK
  #undef START
  #undef RESC
  #undef ROT
}
constexpr int ATTN_LDS_BYTES=LDS_BYTES;
struct AttnTensors { const bf16* Q; const bf16* K; const bf16* V; bf16* O; };
struct AttnUnit { int bvh; int qb; };
struct StaticOrder {
  int ai,nA;
  __device__ __forceinline__ StaticOrder(int ai_,int nA_):ai(ai_),nA(nA_){}
  __device__ __forceinline__ bool next(int i,AttnUnit&u)const{
    if(nA==128){ if(i>=8)return false; u.bvh=ai; u.qb=7-i; return true; }
    if(i>=4)return false; const int s=ai&1; u.bvh=ai>>1; u.qb=(i==0)?7-s:(i==1)?4+s:(i==2)?3-s:s; return true; }
  __device__ __forceinline__ void a_ready(const AttnUnit&)const{}
  __device__ __forceinline__ void done(const AttnUnit&)const{}
};
template<class Sched,int THRL=8> __device__ __forceinline__ void attn_phase(char*lds,const AttnTensors&T,const Sched&S){
  AttnUnit u;
  for(int i=0;S.next(i,u);++i){ S.a_ready(u); const int b=u.bvh>>4,vh=u.bvh&15,s=vh>>1,half=vh&1;
    attn_unit<THRL>(b,s*64,s*64,(s>>1)*128+half*64,s*128+half*64,u.qb,T.Q,T.K,T.V,T.O,lds); S.done(u); }
}
template<int THRL=8> __device__ __forceinline__ void attn_phase_queue(char*lds,const AttnTensors&T,unsigned*counter,volatile __attribute__((address_space(3))) unsigned*slot){
  for(;;){
    if(threadIdx.x==0)*slot=__hip_atomic_fetch_add(counter,1u,__ATOMIC_RELAXED,__HIP_MEMORY_SCOPE_AGENT);
    __syncthreads();
    const unsigned u=__builtin_amdgcn_readfirstlane(*slot);
    __syncthreads();
    if(u>=1024u)break;
    const int qb=7-(int)(u>>7),bvh=(int)(u&127u),b=bvh>>4,vh=bvh&15,s=vh>>1,half=vh&1;
    attn_unit<THRL>(b,s*64,s*64,(s>>1)*128+half*64,s*128+half*64,qb,T.Q,T.K,T.V,T.O,lds);
  }
}
template<int THRL=8> __device__ __forceinline__ void attn_phase_queue128(char*lds,const AttnTensors&T,unsigned*counter,volatile __attribute__((address_space(3))) unsigned*slot){
  for(;;){
    if(threadIdx.x==0)*slot=__hip_atomic_fetch_add(counter,1u,__ATOMIC_RELAXED,__HIP_MEMORY_SCOPE_AGENT);
    __syncthreads();
    const unsigned u=__builtin_amdgcn_readfirstlane(*slot);
    __syncthreads();
    if(u>=512u)break;
    const int qb=7-(int)(u>>6),bs=(int)(u&63u),b=bs>>3,s=bs&7;
    attn_unit128<THRL>(b,s*64,s*64,(s>>1)*128,s*128,qb,T.Q,T.K,T.V,T.O,lds);
  }
}
template<int THRL=8> __device__ __forceinline__ void attn_phase_hybrid128(char*lds,const AttnTensors&T,unsigned*counter,volatile __attribute__((address_space(3))) unsigned*slot,int c){
  int nst=0,q0=0,q1=0,bs0=0;
  if(c<64){nst=2;q0=7;q1=3;bs0=c;} else if(c<128){nst=2;q0=6;q1=4;bs0=c-64;} else if(c>=192){nst=1;q0=5;bs0=c-192;}
  for(int i=0;;++i){
    int qb,bs;
    if(i<nst){ qb=(i==0)?q0:q1; bs=bs0; }
    else{
      if(threadIdx.x==0)*slot=__hip_atomic_fetch_add(counter,1u,__ATOMIC_RELAXED,__HIP_MEMORY_SCOPE_AGENT);
      __syncthreads();
      const unsigned u=__builtin_amdgcn_readfirstlane(*slot);
      __syncthreads();
      if(u>=192u)break;
      qb=2-(int)(u>>6); bs=(int)(u&63u);
    }
    const int b=bs>>3,sh=bs&7;
    attn_unit128<THRL>(b,sh*64,sh*64,(sh>>1)*128,sh*128,qb,T.Q,T.K,T.V,T.O,lds);
  }
}
#undef SBAR
#undef WAIT_BAR
}
#include <hip/hip_cooperative_groups.h>
typedef unsigned short bf16;
#define GAS __attribute__((address_space(1)))
#define LAS __attribute__((address_space(3)))
typedef unsigned v4u __attribute__((ext_vector_type(4)));
typedef unsigned v2u __attribute__((ext_vector_type(2)));
typedef float f32x4 __attribute__((ext_vector_type(4)));
#define LDS_WAIT() asm volatile("s_waitcnt lgkmcnt(0)" ::: "memory")
__device__ __forceinline__ unsigned f2bf(float f) { unsigned u = __builtin_bit_cast(unsigned, f); return (u + 0x7fffu + ((u >> 16) & 1u)) >> 16; }
__device__ __forceinline__ unsigned pk2(float lo, float hi) { return f2bf(lo) | (f2bf(hi) << 16); }
__device__ __forceinline__ float bflo(unsigned w) { return __builtin_bit_cast(float, w << 16); }
__device__ __forceinline__ float bfhi(unsigned w) { return __builtin_bit_cast(float, w & 0xffff0000u); }
__device__ __forceinline__ float bf1(unsigned short h) { return __builtin_bit_cast(float, (unsigned)h << 16); }
template <int CTRL> __device__ __forceinline__ float dppf(float x) { return __builtin_bit_cast(float, __builtin_amdgcn_update_dpp(0, __builtin_bit_cast(int, x), CTRL, 0xf, 0xf, false)); }
__device__ __forceinline__ float row16_allsum(float x) { x += dppf<0x128>(x); x += dppf<0x124>(x); x += dppf<0x122>(x); x += dppf<0x121>(x); return x; }
__device__ __forceinline__ float oct_allsum(float x) { x += dppf<0xB1>(x); x += dppf<0x4E>(x); x += dppf<0x141>(x); return x; }
__device__ __forceinline__ float u2f(unsigned u) { return __builtin_bit_cast(float, u); }
__device__ __forceinline__ unsigned f2u(float f) { return __builtin_bit_cast(unsigned, f); }
__device__ __forceinline__ float sw32(float a, float b) { auto r = __builtin_amdgcn_permlane32_swap(f2u(a), f2u(b), false, false); const unsigned r0 = r[0], r1 = r[1]; return u2f(r0) + u2f(r1); }
__device__ __forceinline__ float sw16(float a, float b) { auto r = __builtin_amdgcn_permlane16_swap(f2u(a), f2u(b), false, false); const unsigned r0 = r[0], r1 = r[1]; return u2f(r0) + u2f(r1); }
__device__ __forceinline__ float wave_allsum(float x) { x = row16_allsum(x); x = sw16(x, x); return sw32(x, x); }
__device__ __forceinline__ float red4(float x0, float x1, float x2, float x3) { return row16_allsum(sw16(sw32(x0, x1), sw32(x2, x3))); }

#define XB_TMO      128
#define XB_XCNT(j)  (256  + 64 * (j))
#define XB_XSUB(j)  (1280 + 64 * (j))
#define XB_XGEN(j)  (2304 + 64 * (j))
#define XB_TOP      3328
#define XB_TOPGEN   3392
#define XCD_BAR_WORDS 3456
#define XB_SPIN_CAP (1u << 18)

__device__ __forceinline__ unsigned xb_ld(unsigned* p)              { return __hip_atomic_load(p, __ATOMIC_RELAXED, __HIP_MEMORY_SCOPE_AGENT); }
__device__ __forceinline__ unsigned xb_add(unsigned* p, unsigned v) { return __hip_atomic_fetch_add(p, v, __ATOMIC_RELAXED, __HIP_MEMORY_SCOPE_AGENT); }
__device__ __forceinline__ unsigned xb_xcc_id() { return (unsigned)__builtin_amdgcn_s_getreg((3 << 11) | 20) & 0xFu; }
#define XB_SPIN(cond, bar) do { unsigned _sp = 0; while (cond) { __builtin_amdgcn_s_sleep(1); \
    if ((++_sp & 255u) == 0u) { if (xb_ld(&(bar)[XB_TMO])) break; if (_sp > XB_SPIN_CAP) { atomicAdd(&(bar)[XB_TMO], 1u); break; } } } } while (0)

struct XcdBarrier {
    unsigned* bar; unsigned x;
    volatile LAS unsigned* st;
};

__device__ __forceinline__ XcdBarrier xcd_barrier_post(unsigned* bar, volatile LAS unsigned* st) {
    XcdBarrier b; b.bar = bar; b.x = xb_xcc_id(); b.st = st;
    if (threadIdx.x == 0) (void)xb_add(&bar[XB_XCNT(b.x)], 1u);
    return b;
}
__device__ __forceinline__ void xcd_barrier_complete(unsigned* bar, unsigned x, unsigned& nloc, unsigned& nx) {
    const unsigned G = gridDim.x * gridDim.y * gridDim.z;
    unsigned sum, cnt, mine, sp = 0u;
    for (;;) {
        sum = 0u; cnt = 0u; mine = 0u;
#pragma unroll
        for (unsigned j = 0; j < 16; ++j) { const unsigned c = xb_ld(&bar[XB_XCNT(j)]); sum += c; cnt += (c > 0u) ? 1u : 0u; }
        mine = xb_ld(&bar[XB_XCNT(x)]);
        if (sum == G) break;
        __builtin_amdgcn_s_sleep(1);
        if ((++sp & 255u) == 0u) { if (xb_ld(&bar[XB_TMO])) break; if (sp > XB_SPIN_CAP) { atomicAdd(&bar[XB_TMO], 1u); break; } }
    }
    nloc = mine > 0u ? mine : 1u; nx = cnt > 0u ? cnt : 1u;
}

__device__ __forceinline__ void xcd_barrier(const XcdBarrier& b) {
    asm volatile("s_waitcnt vmcnt(0)" ::: "memory");
    __syncthreads();
    if (threadIdx.x == 0) {
        unsigned* bar = b.bar;
        __builtin_amdgcn_s_waitcnt(0);
        unsigned nloc = b.st[0], nx = b.st[1];
        if (nloc == 0u) { xcd_barrier_complete(bar, b.x, nloc, nx); b.st[0] = nloc; b.st[1] = nx; }
        const unsigned old = xb_add(&bar[XB_XSUB(b.x)], 1u);
        const unsigned gen = old / nloc;
        if (old + 1u == (gen + 1u) * nloc) {
            __builtin_amdgcn_fence(__ATOMIC_RELEASE, "agent");
            asm volatile("s_waitcnt vmcnt(0)" ::: "memory");
            const unsigned og = xb_add(&bar[XB_TOP], 1u);
            const unsigned tg = og / nx;
            if (og + 1u == (tg + 1u) * nx) xb_add(&bar[XB_TOPGEN], 1u);
            else XB_SPIN(xb_ld(&bar[XB_TOPGEN]) == tg, bar);
            __builtin_amdgcn_fence(__ATOMIC_ACQUIRE, "agent");
            xb_add(&bar[XB_XGEN(b.x)], 1u);
            asm volatile("s_waitcnt vmcnt(0)" ::: "memory");
        } else {
            XB_SPIN(xb_ld(&bar[XB_XGEN(b.x)]) == gen, bar);
            __builtin_amdgcn_fence(__ATOMIC_ACQUIRE, "agent");
            asm volatile("s_waitcnt vmcnt(0)" ::: "memory");
        }
    }
    __syncthreads();
}


constexpr int CW_BAR = 4096;
constexpr int MISC_OFF = 162816 + 320;
struct Frame {
    LAS unsigned char* lds;
    int tid, lane, wave, G, bx;
    float* out; unsigned char* ws;
};
struct Args { const float* in[26]; float* out; unsigned char* ws; int ph_lo, ph_hi; };
typedef const float* cfp_t;
typedef __attribute__((address_space(4))) const cfp_t* ktab_t;
struct InTab { ktab_t p; __device__ __forceinline__ const float* operator[](int i) const { return p[i]; } };
enum { I_X = 0, I_NMG, I_WIN, I_MU, I_W0, I_W2, I_A0, I_A2, I_G2, I_KK, I_KA, I_RK, I_LNG, I_LNB, I_LQ1, I_LK1, I_LQ2, I_LK2, I_SUBG, I_WA, I_WB, I_WO, I_NFG, I_FF1, I_FF2, I_NFIN };

template <bool ROPE> __device__ __forceinline__ void p0_transpose_item(const float* W, int K, int N, bf16* WT, LAS float* scr, int item, int lane, int pitch = 0, int koff = 0) {
    if (pitch == 0) pitch = K;
    const int nblk = N / 32, kb = item / nblk, nb = item % nblk, k0 = 64 * kb, n0 = 32 * nb;
#pragma unroll
    for (int i = 0; i < 8; ++i) { const int kk = 8 * i + (lane >> 3), c4 = 4 * (lane & 7); const f32x4 w4 = *(const GAS f32x4*)(W + (size_t)(k0 + kk) * N + n0 + c4);
        scr[kk * 33 + c4] = w4.x; scr[kk * 33 + c4 + 1] = w4.y; scr[kk * 33 + c4 + 2] = w4.z; scr[kk * 33 + c4 + 3] = w4.w; }
    LDS_WAIT(); asm volatile("" ::: "memory");
    const int c = lane & 7;
#pragma unroll
    for (int j = 0; j < 4; ++j) { const int n = (lane >> 3) + 8 * j; const LAS float* s = scr + (8 * c) * 33 + n;
        v4u o; o.x = pk2(s[0 * 33], s[1 * 33]); o.y = pk2(s[2 * 33], s[3 * 33]); o.z = pk2(s[4 * 33], s[5 * 33]); o.w = pk2(s[6 * 33], s[7 * 33]);
        int col = n0 + n;
        if (ROPE && col < 1024) { const int d = col & 63, dd = d & 31; col = (col & ~63) + 8 * (dd >> 2) + (d >> 5) * 4 + (dd & 3); }
        *(GAS v4u*)(WT + (size_t)col * pitch + koff + k0 + 8 * c) = o; }
    LDS_WAIT(); asm volatile("" ::: "memory");
}
__device__ __forceinline__ void rms_row_to_bf16(const float* xrow, const float* g, bf16* orow, int lane) {
    const GAS f32x4* xr = (const GAS f32x4*)xrow + lane; const f32x4* gr = (const f32x4*)g + lane;
    f32x4 v[4]; float s = 0.f;
#pragma unroll
    for (int j = 0; j < 4; ++j) { v[j] = xr[64 * j]; s += (v[j].x * v[j].x + v[j].y * v[j].y) + (v[j].z * v[j].z + v[j].w * v[j].w); }
    const float rstd = 1.0f / sqrtf(wave_allsum(s) * (1.f / D) + NORM_EPS);
    GAS unsigned long long* o8 = (GAS unsigned long long*)orow + lane;
#pragma unroll
    for (int j = 0; j < 4; ++j) { const f32x4 gg = gr[64 * j];
        o8[64 * j] = (unsigned long long)pk2(v[j].x * rstd * gg.x, v[j].y * rstd * gg.y) | ((unsigned long long)pk2(v[j].z * rstd * gg.z, v[j].w * rstd * gg.w) << 32); }
}
__device__ __forceinline__ void rms_row_to_f32(const float* xrow, const float* g, float* orow, int lane) {
    const GAS f32x4* xr = (const GAS f32x4*)xrow + lane; const f32x4* gr = (const f32x4*)g + lane;
    f32x4 v[4]; float s = 0.f;
#pragma unroll
    for (int j = 0; j < 4; ++j) { v[j] = xr[64 * j]; s += (v[j].x * v[j].x + v[j].y * v[j].y) + (v[j].z * v[j].z + v[j].w * v[j].w); }
    const float rstd = 1.0f / sqrtf(wave_allsum(s) * (1.f / D) + NORM_EPS);
    GAS f32x4* o = (GAS f32x4*)orow + lane;
#pragma unroll
    for (int j = 0; j < 4; ++j) { const f32x4 gg = gr[64 * j]; o[64 * j] = v[j] * rstd * gg; }
}
__device__ __forceinline__ void p0_prologue(Frame& F, const InTab& A) {
    LAS float* scr = (LAS float*)(F.lds + RING_OFF + F.wave * 16384);
    const int gw = F.bx * NWAVES + F.wave, NGW = F.G * NWAVES;
    unsigned char* ws = F.ws;
    constexpr int I_IN = (D / 64) * (D_IN / 32), I_A = (512 / 64) * (D / 32), I_O = (D / 64) * (D / 32), I_1 = (D / 64) * (FF / 32), I_2 = (FF / 64) * (D / 32);
    (void)I_A; (void)I_O; (void)I_1; (void)I_2;
    for (int it = gw; it < I_IN; it += NGW) p0_transpose_item<true>(A[I_WIN], D, D_IN, (bf16*)(ws + WS_WIN), scr, it, F.lane);
    if (false) for (int it = gw; it < 0; it += NGW) {
        int r = it;
        if (r < I_A) { p0_transpose_item<false>(A[I_WA], 512, D, (bf16*)(ws + WS_WA), scr, r, F.lane, 1024, 0); continue; } r -= I_A;
        if (r < I_A) { p0_transpose_item<false>(A[I_WB], 512, D, (bf16*)(ws + WS_WA), scr, r, F.lane, 1024, 512); continue; } r -= I_A;
        if (r < I_O) { p0_transpose_item<false>(A[I_WO], D, D, (bf16*)(ws + WS_WO), scr, r, F.lane); continue; } r -= I_O;
        if (r < I_1) { p0_transpose_item<false>(A[I_FF1], D, FF, (bf16*)(ws + WS_W1), scr, r, F.lane); continue; } r -= I_1;
        p0_transpose_item<false>(A[I_FF2], FF, D, (bf16*)(ws + WS_W2), scr, r, F.lane);
    }
    const int gt = F.bx * (NWAVES * 64) + F.tid, NGT = F.G * NWAVES * 64;
    for (int e = gt; e < NLORA * (KLORA / 8); e += NGT) { const int n = e % NLORA, k8 = (e / NLORA) * 8; float v[8];
#pragma unroll
        for (int i = 0; i < 8; ++i) { const int k = k8 + i; float x = 0.f;
            if (n < 512) { if (k < 64) x = A[I_W2][(size_t)k * 512 + n]; }
            else if (n < 1024) { if (k >= 64 && k < 128) x = A[I_A2][(size_t)(k - 64) * 512 + (n - 512)]; }
            else { if (k >= 128) x = A[I_G2][(size_t)(k - 128) * 512 + (n - 1024)]; }
            v[i] = x; }
        v4u o; o.x = pk2(v[0], v[1]); o.y = pk2(v[2], v[3]); o.z = pk2(v[4], v[5]); o.w = pk2(v[6], v[7]);
        *(GAS v4u*)((bf16*)(ws + WS_WL) + (size_t)n * KLORA + k8) = o; }
    for (int e = gt; e < SEQ * 32; e += NGT) { const int pos = e >> 5, i = e & 31;
        const float inv = exp2f(-(float)i * 0.41524101186092029f);
        const float ang = (float)pos * inv; float s, c; sincosf(ang, &s, &c);
        ((float*)(ws + WS_ROPE_C))[e] = c; ((float*)(ws + WS_ROPE_S))[e] = s; }
    for (int m = gw; m < M; m += 2 * NGW) {
        const int m2 = m + NGW;
        const GAS f32x4* xa = (const GAS f32x4*)(A[I_X] + (size_t)m * D) + F.lane; const GAS f32x4* xb = (const GAS f32x4*)(A[I_X] + (size_t)m2 * D) + F.lane; const f32x4* gr = (const f32x4*)A[I_NMG] + F.lane;
        f32x4 va[4], vb[4]; float sa = 0.f, sb = 0.f;
#pragma unroll
        for (int j = 0; j < 4; ++j) { va[j] = xa[64 * j]; vb[j] = xb[64 * j]; }
#pragma unroll
        for (int j = 0; j < 4; ++j) { sa += (va[j].x * va[j].x + va[j].y * va[j].y) + (va[j].z * va[j].z + va[j].w * va[j].w); sb += (vb[j].x * vb[j].x + vb[j].y * vb[j].y) + (vb[j].z * vb[j].z + vb[j].w * vb[j].w); }
        const float ra = __builtin_amdgcn_rsqf(wave_allsum(sa) * (1.f / D) + NORM_EPS), rb = __builtin_amdgcn_rsqf(wave_allsum(sb) * (1.f / D) + NORM_EPS);
        GAS unsigned long long* oa = (GAS unsigned long long*)((bf16*)(ws + WS_XN) + (size_t)m * D) + F.lane; GAS unsigned long long* ob = (GAS unsigned long long*)((bf16*)(ws + WS_XN) + (size_t)m2 * D) + F.lane;
#pragma unroll
        for (int j = 0; j < 4; ++j) { const f32x4 gg = gr[64 * j];
            oa[64 * j] = (unsigned long long)pk2(va[j].x * ra * gg.x, va[j].y * ra * gg.y) | ((unsigned long long)pk2(va[j].z * ra * gg.z, va[j].w * ra * gg.w) << 32);
            ob[64 * j] = (unsigned long long)pk2(vb[j].x * rb * gg.x, vb[j].y * rb * gg.y) | ((unsigned long long)pk2(vb[j].z * rb * gg.z, vb[j].w * rb * gg.w) << 32); }
    }
}

__device__ __forceinline__ void late_weights(Frame& F, const InTab& A, int part, int nparts, int cu0) {
    int lane_ = F.lane; asm volatile("" : "+v"(lane_));
    LAS float* scr = (LAS float*)(F.lds + RING_OFF + F.wave * 16384);
    unsigned char* ws = F.ws;
    constexpr int I_A = (512 / 64) * (D / 32), I_O = (D / 64) * (D / 32), I_1 = (D / 64) * (FF / 32), I_2 = (FF / 64) * (D / 32), NIT = 2 * I_A + I_O + I_1 + I_2;
    const int per = NIT / nparts, lo = part * per, hi = lo + per;
    const int gw = (F.bx - cu0) * NWAVES + F.wave, NGW = (F.G - cu0) * NWAVES;
    for (int it = lo + gw; it < hi; it += NGW) {
        int r = it;
        if (r < I_A) { p0_transpose_item<false>(A[I_WA], 512, D, (bf16*)(ws + WS_WA), scr, r, lane_, 1024, 0); continue; } r -= I_A;
        if (r < I_A) { p0_transpose_item<false>(A[I_WB], 512, D, (bf16*)(ws + WS_WA), scr, r, lane_, 1024, 512); continue; } r -= I_A;
        if (r < I_O) { p0_transpose_item<false>(A[I_WO], D, D, (bf16*)(ws + WS_WO), scr, r, lane_); continue; } r -= I_O;
        if (r < I_1) { p0_transpose_item<false>(A[I_FF1], D, FF, (bf16*)(ws + WS_W1), scr, r, lane_); continue; } r -= I_1;
        p0_transpose_item<false>(A[I_FF2], FF, D, (bf16*)(ws + WS_W2), scr, r, lane_);
    }
}
__device__ __forceinline__ void prep1_rows(Frame& F, const InTab& A, int g0, int g1, int w, int nw) {
    const int lane = F.lane;
    const bf16* WAG = (const bf16*)(F.ws + WS_WAG); bf16* LIN = (bf16*)(F.ws + WS_LIN);
    const f32x4 mu = *(const f32x4*)(A[I_MU] + 1536 + 4 * lane);
    for (int g = g0 + w; g < g1; g += nw) {
        const int m0 = g * 8; v2u row[9];
        row[0] = (v2u){0u, 0u}; if ((m0 & (SEQ - 1)) != 0) row[0] = *(const GAS v2u*)(WAG + (size_t)(m0 - 1) * 256 + 4 * lane);
#pragma unroll
        for (int j = 0; j < 8; ++j) row[j + 1] = *(const GAS v2u*)(WAG + (size_t)(m0 + j) * 256 + 4 * lane);
#pragma unroll
        for (int j = 0; j < 8; ++j) {
            float z[4] = {bflo(row[j + 1].x), bfhi(row[j + 1].x), bflo(row[j + 1].y), bfhi(row[j + 1].y)}; const float p[4] = {bflo(row[j].x), bfhi(row[j].x), bflo(row[j].y), bfhi(row[j].y)};
#pragma unroll
            for (int e = 0; e < 4; ++e) { float v = z[e] + (p[e] - z[e]) * mu[e];
                if (lane < 16) v = 1.0f - 2.0f * __builtin_amdgcn_rcpf(1.0f + __expf(2.0f * v));
                else if (lane >= 32) v = __builtin_amdgcn_rcpf(1.0f + __expf(-v));
                z[e] = v; }
            v2u o; o.x = pk2(z[0], z[1]); o.y = pk2(z[2], z[3]);
            *(GAS v2u*)(LIN + (size_t)(m0 + j) * 256 + 4 * lane) = o;
        }
    }
}
struct ScanRaw { unsigned short r[9], k[9], v[9], a[8]; float d[8]; };
__device__ __forceinline__ void scan_load(ScanRaw& R, const bf16* RKV, const float* DEC, const bf16* AA, size_t row0, int t0, int c) {
#pragma unroll
    for (int j = 0; j < 9; ++j) { int t = t0 - 1 + j; if (t < 0) t = 0; const bf16* p = RKV + (row0 + t) * 1536 + c;
        R.r[j] = *(const GAS bf16*)p; R.k[j] = *(const GAS bf16*)(p + 512); R.v[j] = *(const GAS bf16*)(p + 1024); }
#pragma unroll
    for (int j = 0; j < 8; ++j) { R.d[j] = *(const GAS float*)(DEC + (row0 + t0 + j) * 512 + c); R.a[j] = *(const GAS bf16*)(AA + (row0 + t0 + j) * 512 + c); }
}
__device__ __forceinline__ void scan_phase(Frame& F, const InTab& A, int si) {
    const int lane = F.lane, wave = F.wave, tid = F.tid;
    const int bh = si >> 1, half = si & 1, b = bh >> 3, h = bh & 7, c = h * 64 + lane;
    LAS float* IN = (LAS float*)(F.lds + RING_OFF);
    LAS float* VV = IN + 5 * 4096;
    LAS float* YBUF = VV + 2048;
    const bf16* RKV = (const bf16*)(F.ws + WS_RKV); const float* DEC = (const float*)(F.ws + WS_DEC); const bf16* AA = (const bf16*)(F.ws + WS_AA);
    bf16* Y = (bf16*)(F.ws + WS_Y); float* BON = (float*)(F.ws + WS_BON);
    const float mu_r = A[I_MU][c], mu_k = A[I_MU][512 + c], mu_v = A[I_MU][1024 + c], kkc = A[I_KK][c], kac = A[I_KA][c], rkc = A[I_RK][c];
    const size_t row0 = (size_t)b * SEQ;
    const int myv = (int)(red4(0.f, 1.f, 2.f, 3.f) * (1.0f / 64.0f) + 0.5f);
    const int L0 = __builtin_ctzll(__ballot(myv == 0)), L1 = __builtin_ctzll(__ballot(myv == 1)), L2 = __builtin_ctzll(__ballot(myv == 2)), L3 = __builtin_ctzll(__ballot(myv == 3));
    float S0 = 0.f, S1 = 0.f, S2 = 0.f, S3 = 0.f;
    ScanRaw R; scan_load(R, RKV, DEC, AA, row0, wave * 8, c);
    for (int blk = 0; blk < SEQ / 64; ++blk) {
        {
            const int t0 = blk * 64 + wave * 8;
            f32x4 qd[2], qa[2], qb[2], qk[2], qr[2], qv[2];
#pragma unroll
            for (int j = 0; j < 8; ++j) {
                const float pz = (t0 + j == 0) ? 0.f : 1.f;
                const float rt_ = bf1(R.r[j + 1]), kt_ = bf1(R.k[j + 1]), vt_ = bf1(R.v[j + 1]);
                const float rs = rt_ + (bf1(R.r[j]) * pz - rt_) * mu_r, ks = kt_ + (bf1(R.k[j]) * pz - kt_) * mu_k, vs = vt_ + (bf1(R.v[j]) * pz - vt_) * mu_v;
                const float kkr = ks * kkc, n2 = wave_allsum(kkr * kkr), kk = kkr / __builtin_fmaxf(sqrtf(n2), 1e-12f);
                const float a = 1.0f / (1.0f + __expf(-bf1(R.a[j]))), kx = ks * (1.0f + (a - 1.0f) * kac);
                const float bon = wave_allsum(rs * kx * rkc);
                if (half == 0 && lane == 0) BON[(row0 + t0 + j) * 8 + h] = bon;
                qd[j >> 2][j & 3] = __expf(-0.6065306597f / (1.0f + __expf(-R.d[j])));     qa[j >> 2][j & 3] = -kk; qb[j >> 2][j & 3] = kk * a; qk[j >> 2][j & 3] = kx; qr[j >> 2][j & 3] = rs; qv[j >> 2][j & 3] = vs;
            }
#pragma unroll
            for (int q = 0; q < 2; ++q) { const int t4 = wave * 2 + q; LAS f32x4* p = (LAS f32x4*)IN + t4 * 64 + lane;
                p[0 * 1024] = qd[q]; p[1 * 1024] = qa[q]; p[2 * 1024] = qb[q]; p[3 * 1024] = qk[q]; p[4 * 1024] = qr[q];
                if ((lane >> 5) == half) ((LAS f32x4*)VV)[t4 * 32 + (lane & 31)] = qv[q]; }
        }
        __syncthreads();
        if (blk + 1 < SEQ / 64) scan_load(R, RKV, DEC, AA, row0, (blk + 1) * 64 + wave * 8, c);
#pragma unroll 1
        for (int t4 = 0; t4 < 16; ++t4) {
            const LAS f32x4* p = (const LAS f32x4*)IN + t4 * 64 + lane;
            const f32x4 W4 = p[0], A4 = p[1024], B4 = p[2048], K4 = p[3072], R4 = p[4096];
            const LAS f32x4* pv = (const LAS f32x4*)VV + t4 * 32 + wave * 4;
            const f32x4 V0 = pv[0], V1 = pv[1], V2 = pv[2], V3 = pv[3];
            f32x4 yq;
#pragma unroll
            for (int ts = 0; ts < 4; ++ts) {
                const float w = W4[ts], a = A4[ts], bb = B4[ts], kx = K4[ts], r = R4[ts];
                const float t = red4(S0 * a, S1 * a, S2 * a, S3 * a);
                const float sa0 = __builtin_bit_cast(float, __builtin_amdgcn_readlane(__builtin_bit_cast(int, t), L0)), sa1 = __builtin_bit_cast(float, __builtin_amdgcn_readlane(__builtin_bit_cast(int, t), L1));
                const float sa2 = __builtin_bit_cast(float, __builtin_amdgcn_readlane(__builtin_bit_cast(int, t), L2)), sa3 = __builtin_bit_cast(float, __builtin_amdgcn_readlane(__builtin_bit_cast(int, t), L3));
                S0 = S0 * w + (sa0 * bb + V0[ts] * kx); S1 = S1 * w + (sa1 * bb + V1[ts] * kx); S2 = S2 * w + (sa2 * bb + V2[ts] * kx); S3 = S3 * w + (sa3 * bb + V3[ts] * kx);
                yq[ts] = red4(S0 * r, S1 * r, S2 * r, S3 * r);
            }
            if ((lane & 15) == 0) *(LAS f32x4*)(YBUF + (wave * 4 + myv) * 68 + t4 * 4) = yq;
        }
        __syncthreads();
        { const int t = tid >> 3, rg = tid & 7; const LAS float* yb = YBUF + (4 * rg) * 68 + t;
          v2u o; o.x = pk2(yb[0], yb[68]); o.y = pk2(yb[136], yb[204]);
          *(GAS v2u*)(Y + (row0 + blk * 64 + t) * 512 + h * 64 + 32 * half + 4 * rg) = o; }
    }
    __syncthreads();
}
__device__ __forceinline__ void post_ya(Frame& F, const InTab& A, int w, int nw) {
    int lane = F.lane; asm volatile("" : "+v"(lane));
    const bf16* O = (const bf16*)(F.ws + WS_O); bf16* YA = (bf16*)(F.ws + WS_YA);
    const float lam = __expf(wave_allsum(A[I_LQ1][lane] * A[I_LK1][lane])) - __expf(wave_allsum(A[I_LQ2][lane] * A[I_LK2][lane])) + LAMBDA_INIT;
    const int ca = 8 * lane, ha = lane >> 4, ea = ca & 127;
    float sg[8];
#pragma unroll
    for (int e = 0; e < 8; ++e) sg[e] = A[I_SUBG][ea + e] * (1.0f - LAMBDA_INIT);
#define UNPK8(w_) {bflo(w_.x), bfhi(w_.x), bflo(w_.y), bfhi(w_.y), bflo(w_.z), bfhi(w_.z), bflo(w_.w), bfhi(w_.w)}
    for (int g = w; g < M / 4; g += nw) {
        const int m0 = g * 4;
        v4u o0[4], o1[4];
#pragma unroll
        for (int j = 0; j < 4; ++j) { const size_t mm = (size_t)(m0 + j);
            o0[j] = *(const GAS v4u*)(O + mm * 1024 + (2 * ha) * 128 + ea); o1[j] = *(const GAS v4u*)(O + mm * 1024 + (2 * ha + 1) * 128 + ea); }
        asm volatile("s_waitcnt vmcnt(0)" ::: "memory");
#pragma unroll
        for (int j = 0; j < 4; ++j) { const size_t mm = (size_t)(m0 + j);
            const float a0[8] = UNPK8(o0[j]), a1[8] = UNPK8(o1[j]); float o[8], ss = 0.f;
#pragma unroll
            for (int e = 0; e < 8; ++e) { o[e] = a0[e] - lam * a1[e]; ss += o[e] * o[e]; }
            const float rstd = __builtin_amdgcn_rsqf(row16_allsum(ss) * (1.0f / 128.0f) + SUBLN_EPS);
            v4u wv; wv.x = pk2(o[0] * rstd * sg[0], o[1] * rstd * sg[1]); wv.y = pk2(o[2] * rstd * sg[2], o[3] * rstd * sg[3]); wv.z = pk2(o[4] * rstd * sg[4], o[5] * rstd * sg[5]); wv.w = pk2(o[6] * rstd * sg[6], o[7] * rstd * sg[7]);
            *(GAS v4u*)(YA + mm * 1024 + ca) = wv;
        }
    }
#undef UNPK8
}

typedef short rk_bf16x8 __attribute__((ext_vector_type(8)));
typedef float rk_f32x16 __attribute__((ext_vector_type(16)));
constexpr int RKA_RS_K = 144, RKA_RS_J = 80;
constexpr int RKA_A = 0, RKA_B = 5120, RKA_K = 10240, RKA_R = 15360, RKA_AT = 19968, RKA_BH = 25088, RKA_KH = 30208, RKA_VT = 35328, RKA_GC = 40448, RKA_BYTES = 40704;
constexpr int RKA_N = 0, RKA_X = 0, RKA_T = 5120, RKA_MAK = 7680, RKA_MRB = 10240, RKA_MRK = 12800;
constexpr int RKA_WAVES = 4;
static_assert(RKA_WAVES * RKA_BYTES <= 162816, "phase A LDS");
constexpr size_t WS_PQ0 = 66 * MiB, WS_PQ1 = 34 * MiB;
constexpr size_t WS_RY0 = 98 * MiB, WS_RY1 = 178 * MiB;
constexpr size_t WS_GC = 250 * MiB;
__device__ __forceinline__ unsigned char* rk_pq(unsigned char* ws, int half) { return ws + (half ? WS_PQ1 : WS_PQ0); }
__device__ __forceinline__ unsigned char* rk_ry(unsigned char* ws, int half) { return ws + (half ? WS_RY1 : WS_RY0); }
__device__ __forceinline__ unsigned char* rk_gc(unsigned char* ws, int half) { return ws + WS_GC + (size_t)half * (2048 * 256); }
constexpr size_t WS_SST = 251 * MiB;

__device__ __forceinline__ rk_bf16x8 rk_frag(const LAS unsigned char* base, int rs, int row, int s, int h) { return *(const LAS rk_bf16x8*)(base + row * rs + (16 * s + 8 * h) * 2); }
__device__ __forceinline__ rk_f32x16 rk_mfma(rk_bf16x8 a, rk_bf16x8 b, rk_f32x16 c) { return __builtin_amdgcn_mfma_f32_32x32x16_bf16(a, b, c, 0, 0, 0); }
__device__ __forceinline__ unsigned rk_pk(float lo, float hi) { typedef float f2_ __attribute__((ext_vector_type(2))); typedef __bf16 b2_ __attribute__((ext_vector_type(2))); f2_ v = {lo, hi}; b2_ b = __builtin_convertvector(v, b2_); return __builtin_bit_cast(unsigned, b); }
__device__ __forceinline__ void rk_store_tile_lds(LAS unsigned char* base, int rs, int nrow, int mbase, int h, const rk_f32x16& acc) {
#pragma unroll
    for (int g = 0; g < 4; ++g) { v2u w; w.x = rk_pk(acc[4 * g], acc[4 * g + 1]); w.y = rk_pk(acc[4 * g + 2], acc[4 * g + 3]); *(LAS v2u*)(base + nrow * rs + (mbase + 8 * g + 4 * h) * 2) = w; }
}
__device__ __forceinline__ void rk_store_tile_glb(bf16* base, int pitch, int nrow, int mbase, int h, const rk_f32x16& acc) {
#pragma unroll
    for (int g = 0; g < 4; ++g) { v2u w; w.x = rk_pk(acc[4 * g], acc[4 * g + 1]); w.y = rk_pk(acc[4 * g + 2], acc[4 * g + 3]); *(GAS v2u*)(base + (size_t)nrow * pitch + mbase + 8 * g + 4 * h) = w; }
}
__device__ __forceinline__ void rk_store_tile_frag(unsigned char* base, int nt, int r32, int mt, int h, const rk_f32x16& acc) {
#pragma unroll
    for (int g = 0; g < 4; ++g) { v2u w; w.x = rk_pk(acc[4 * g], acc[4 * g + 1]); w.y = rk_pk(acc[4 * g + 2], acc[4 * g + 3]);
        *(GAS v2u*)(base + ((size_t)((nt * 4 + 2 * mt + (g >> 1)) * 64 + r32 + 32 * (g & 1))) * 16 + 8 * h) = w; }
}
__device__ __forceinline__ void rk_store_blob(unsigned* blob, int lane, const rk_f32x16& acc) {
    v4u w0, w1; w0.x = rk_pk(acc[0], acc[1]); w0.y = rk_pk(acc[2], acc[3]); w0.z = rk_pk(acc[4], acc[5]); w0.w = rk_pk(acc[6], acc[7]);
    w1.x = rk_pk(acc[8], acc[9]); w1.y = rk_pk(acc[10], acc[11]); w1.z = rk_pk(acc[12], acc[13]); w1.w = rk_pk(acc[14], acc[15]);
    *(GAS v4u*)(blob + lane * 8) = w0; *(GAS v4u*)(blob + lane * 8 + 4) = w1;
}
struct RkBlob { v4u w0, w1; };
__device__ __forceinline__ RkBlob rk_load_blob(const unsigned* blob, int lane) { RkBlob b; b.w0 = *(const GAS v4u*)(blob + lane * 8); b.w1 = *(const GAS v4u*)(blob + lane * 8 + 4); return b; }
__device__ __forceinline__ rk_f32x16 rk_blob_f32(const RkBlob& b) {
    rk_f32x16 a; const unsigned w[8] = {b.w0.x, b.w0.y, b.w0.z, b.w0.w, b.w1.x, b.w1.y, b.w1.z, b.w1.w};
#pragma unroll
    for (int i = 0; i < 8; ++i) { a[2 * i] = bflo(w[i]); a[2 * i + 1] = bfhi(w[i]); }
    return a;
}

struct RkRaw { unsigned short r[8], k[8], v[8]; };
__device__ __forceinline__ void rk_load8(RkRaw& R, const bf16* prkv) {
#pragma unroll
    for (int j = 0; j < 8; ++j) { R.r[j] = *(const GAS bf16*)(prkv + j * 1536); R.k[j] = *(const GAS bf16*)(prkv + j * 1536 + 512); R.v[j] = *(const GAS bf16*)(prkv + j * 1536 + 1024); }
}
__device__ __forceinline__ void rwkvA_unit(LAS unsigned char* L, const InTab& A, unsigned char* ws, int bh, int chunk, int lane_in) {
    int lane = lane_in; asm volatile("" : "+v"(lane));
    const int b = bh >> 3, hd = bh & 7, cg = hd * 64 + lane, r32 = lane & 31, h = lane >> 5;
    const size_t row0 = (size_t)b * SEQ + (size_t)chunk * 32;
    const int uh = bh * 32 + (chunk & 31);
    const bf16* prkv = (const bf16*)(ws + WS_RKV) + row0 * 1536 + cg;
    float* pbon = (float*)(ws + WS_BON) + row0 * 8 + hd;
    const float mu_r = A[I_MU][cg], mu_k = A[I_MU][512 + cg], mu_v = A[I_MU][1024 + cg], kkc = A[I_KK][cg], kac = A[I_KA][cg], rkc = A[I_RK][cg], w0c = A[I_W0][cg], a0c = A[I_A0][cg];
    float dW[32], dA[32];
    {
        rk_f32x16 lw[2] = {{}, {}}, la[2] = {{}, {}};
        const bf16* lp = (const bf16*)(ws + WS_LIN) + (row0 + r32) * 256 + 8 * h;
        const bf16* wp = (const bf16*)(ws + WS_WL) + (size_t)(hd * 64 + r32) * 256 + 8 * h;
#pragma unroll
        for (int s2 = 0; s2 < 4; ++s2) { const rk_bf16x8 fw = __builtin_bit_cast(rk_bf16x8, *(const GAS v4u*)(lp + 16 * s2)), fa = __builtin_bit_cast(rk_bf16x8, *(const GAS v4u*)(lp + 64 + 16 * s2));
#pragma unroll
            for (int ct = 0; ct < 2; ++ct) { lw[ct] = rk_mfma(fw, __builtin_bit_cast(rk_bf16x8, *(const GAS v4u*)(wp + (size_t)ct * 32 * 256 + 16 * s2)), lw[ct]);
                la[ct] = rk_mfma(fa, __builtin_bit_cast(rk_bf16x8, *(const GAS v4u*)(wp + (size_t)(512 + ct * 32) * 256 + 64 + 16 * s2)), la[ct]); } }
#pragma unroll
        for (int i = 0; i < 16; ++i) { const int tb = (i & 3) + 8 * (i >> 2);
            { auto r = __builtin_amdgcn_permlane32_swap(f2u(lw[0][i]), f2u(lw[1][i]), false, false); const unsigned r0 = r[0], r1 = r[1]; dW[tb] = u2f(r0); dW[tb + 4] = u2f(r1); }
            { auto r = __builtin_amdgcn_permlane32_swap(f2u(la[0][i]), f2u(la[1][i]), false, false); const unsigned r0 = r[0], r1 = r[1]; dA[tb] = u2f(r0); dA[tb + 4] = u2f(r1); } }
    }
    const int myv = (int)(red4(0.f, 1.f, 2.f, 3.f) * (1.0f / 64.0f) + 0.5f);
    const int L0 = __builtin_ctzll(__ballot(myv == 0)), L1 = __builtin_ctzll(__ballot(myv == 1)), L2 = __builtin_ctzll(__ballot(myv == 2)), L3 = __builtin_ctzll(__ballot(myv == 3));
    float rp = 0.f, kp = 0.f, vp = 0.f;
    if (chunk != 0) { rp = bf1(*(const GAS bf16*)(prkv - 1536)); kp = bf1(*(const GAS bf16*)(prkv - 1536 + 512)); vp = bf1(*(const GAS bf16*)(prkv - 1536 + 1024)); }
    float G = 1.0f;
    RkRaw Rc, Rn; rk_load8(Rc, prkv);
#pragma unroll
    for (int q = 0; q < 4; ++q) {
        prkv += 8 * 1536;
        if (q < 3) rk_load8(Rn, prkv);
        LAS unsigned char* Lr = L + (8 * q) * RKA_RS_K + lane * 2;
        LAS unsigned char* Lt = L + lane * RKA_RS_J + (8 * q) * 2;
        unsigned tA[4], tB[4], tK[4], tV[4], pA = 0, pB = 0, pK = 0, pV = 0;
        float rs_[8], kx_[8], kkr_[8], a8_[8], w8_[8], vs_[8];
#pragma unroll
        for (int j = 0; j < 8; ++j) {
            const float rc = bf1(Rc.r[j]), kc = bf1(Rc.k[j]), vc = bf1(Rc.v[j]);
            const float ks = kc + (kp - kc) * mu_k; rs_[j] = rc + (rp - rc) * mu_r; vs_[j] = vc + (vp - vc) * mu_v; rp = rc; kp = kc; vp = vc;
            kkr_[j] = ks * kkc; a8_[j] = __builtin_amdgcn_rcpf(1.0f + __expf(-(a0c + dA[8 * q + j]))); kx_[j] = ks * (1.0f + (a8_[j] - 1.0f) * kac);
            w8_[j] = __expf(-0.6065306597f * __builtin_amdgcn_rcpf(1.0f + __expf(-(w0c + dW[8 * q + j]))));
        }
        float n2_[8], bon_[8];
#pragma unroll
        for (int j = 0; j < 8; j += 2) {
            const float t = red4(kkr_[j] * kkr_[j], kkr_[j + 1] * kkr_[j + 1], rs_[j] * kx_[j] * rkc, rs_[j + 1] * kx_[j + 1] * rkc);
            n2_[j] = __builtin_bit_cast(float, __builtin_amdgcn_readlane(__builtin_bit_cast(int, t), L0)); n2_[j + 1] = __builtin_bit_cast(float, __builtin_amdgcn_readlane(__builtin_bit_cast(int, t), L1));
            bon_[j] = __builtin_bit_cast(float, __builtin_amdgcn_readlane(__builtin_bit_cast(int, t), L2)); bon_[j + 1] = __builtin_bit_cast(float, __builtin_amdgcn_readlane(__builtin_bit_cast(int, t), L3));
        }
        if (lane < 8) { float bv = bon_[0];
#pragma unroll
            for (int j = 1; j < 8; ++j) bv = (lane == j) ? bon_[j] : bv;
            *(GAS float*)(pbon + (8 * q + lane) * 8) = bv; }
        unsigned tR[4];
#pragma unroll
        for (int j = 0; j < 8; j += 2) {
            const float kk0 = kkr_[j] * __builtin_amdgcn_rsqf(__builtin_fmaxf(n2_[j], 1e-24f)), kk1 = kkr_[j + 1] * __builtin_amdgcn_rsqf(__builtin_fmaxf(n2_[j + 1], 1e-24f));
            const float G0 = G; const float G1 = G0 * w8_[j]; G = G1 * w8_[j + 1]; const float i1 = __builtin_amdgcn_rcpf(G1), i2 = __builtin_amdgcn_rcpf(G);
            tA[j >> 1] = rk_pk(-kk0 * G0, -kk1 * G1); tR[j >> 1] = rk_pk(rs_[j] * G1, rs_[j + 1] * G); tB[j >> 1] = rk_pk(kk0 * a8_[j] * i1, kk1 * a8_[j + 1] * i2); tK[j >> 1] = rk_pk(kx_[j] * i1, kx_[j + 1] * i2); tV[j >> 1] = rk_pk(vs_[j], vs_[j + 1]);
            *(LAS bf16*)(Lr + RKA_A + j * RKA_RS_K) = (bf16)(tA[j >> 1] & 0xffffu); *(LAS bf16*)(Lr + RKA_A + (j + 1) * RKA_RS_K) = (bf16)(tA[j >> 1] >> 16);
            *(LAS bf16*)(Lr + RKA_R + j * RKA_RS_K) = (bf16)(tR[j >> 1] & 0xffffu); *(LAS bf16*)(Lr + RKA_R + (j + 1) * RKA_RS_K) = (bf16)(tR[j >> 1] >> 16);
            *(LAS bf16*)(Lr + RKA_B + j * RKA_RS_K) = (bf16)(tB[j >> 1] & 0xffffu); *(LAS bf16*)(Lr + RKA_B + (j + 1) * RKA_RS_K) = (bf16)(tB[j >> 1] >> 16);
            *(LAS bf16*)(Lr + RKA_K + j * RKA_RS_K) = (bf16)(tK[j >> 1] & 0xffffu); *(LAS bf16*)(Lr + RKA_K + (j + 1) * RKA_RS_K) = (bf16)(tK[j >> 1] >> 16);
        }
        (void)pA; (void)pB; (void)pK; (void)pV;
        *(LAS v4u*)(Lt + RKA_AT) = (v4u){tA[0], tA[1], tA[2], tA[3]}; *(LAS v4u*)(Lt + RKA_BH) = (v4u){tB[0], tB[1], tB[2], tB[3]}; *(LAS v4u*)(Lt + RKA_KH) = (v4u){tK[0], tK[1], tK[2], tK[3]}; *(LAS v4u*)(Lt + RKA_VT) = (v4u){tV[0], tV[1], tV[2], tV[3]};
        Rc = Rn;
    }
    const float GC = G;
    *(GAS float*)((float*)rk_gc(ws, chunk >> 5) + (size_t)uh * 64 + lane) = GC;
    *(LAS float*)(L + RKA_GC + lane * 4) = GC;
    LDS_WAIT(); asm volatile("" ::: "memory");
    {
        rk_f32x16 aN = {}, aAK = {}, aRB = {}, aRK = {};
#pragma unroll
        for (int s = 0; s < 4; ++s) {
            const rk_bf16x8 fA = rk_frag(L + RKA_A, RKA_RS_K, r32, s, h), fR = rk_frag(L + RKA_R, RKA_RS_K, r32, s, h), fB = rk_frag(L + RKA_B, RKA_RS_K, r32, s, h), fK = rk_frag(L + RKA_K, RKA_RS_K, r32, s, h);
            aN = rk_mfma(fB, fA, aN); aAK = rk_mfma(fK, fA, aAK); aRB = rk_mfma(fB, fR, aRB); aRK = rk_mfma(fK, fR, aRK);
        }
        LDS_WAIT(); asm volatile("" ::: "memory");
#pragma unroll
        for (int i = 0; i < 16; ++i) { const int j = (i & 3) + 8 * (i >> 2) + 4 * h;
            if (!(j < r32)) { aN[i] = 0.f; aAK[i] = 0.f; }
            if (!(j <= r32)) { aRB[i] = 0.f; aRK[i] = 0.f; } }
#pragma unroll
        for (int g = 0; g < 4; ++g) *(LAS f32x4*)(L + RKA_N + r32 * 144 + (8 * g + 4 * h) * 4) = (f32x4){aN[4 * g], aN[4 * g + 1], aN[4 * g + 2], aN[4 * g + 3]};
        rk_store_tile_lds(L + RKA_MAK, RKA_RS_J, r32, 0, h, aAK); rk_store_tile_lds(L + RKA_MRB, RKA_RS_J, r32, 0, h, aRB); rk_store_tile_lds(L + RKA_MRK, RKA_RS_J, r32, 0, h, aRK);
        rk_store_tile_lds(L + RKA_T, RKA_RS_J, r32, 0, h, aN);
    }
    LDS_WAIT(); asm volatile("" ::: "memory");
    {
        const int blk = (r32 >> 4) & 1, cc = r32 & 15;
        const LAS unsigned char* Nb = L + RKA_N + (16 * blk) * 144 + (16 * blk) * 4;
        float T[16];
#pragma unroll
        for (int t = 0; t < 16; ++t) { float ac[4] = {(cc == t) ? 1.0f : 0.0f, 0.f, 0.f, 0.f};
#pragma unroll
            for (int j4 = 0; j4 < (t + 3) / 4; ++j4) { const f32x4 n4 = *(const LAS f32x4*)(Nb + t * 144 + j4 * 16);
#pragma unroll
                for (int e = 0; e < 4; ++e) if (4 * j4 + e < t) ac[e] += n4[e] * T[4 * j4 + e]; }
            T[t] = (ac[0] + ac[1]) + (ac[2] + ac[3]); }
        LDS_WAIT(); asm volatile("" ::: "memory");
#pragma unroll
        for (int t = 0; t < 16; ++t) *(LAS bf16*)(L + RKA_T + (16 * blk + t) * RKA_RS_J + r32 * 2) = (bf16)f2bf(T[t]);
        if (blk == 0) { LAS v4u* p = (LAS v4u*)(L + RKA_N + cc * RKA_RS_J);
            p[0] = (v4u){pk2(T[0], T[1]), pk2(T[2], T[3]), pk2(T[4], T[5]), pk2(T[6], T[7])}; p[1] = (v4u){pk2(T[8], T[9]), pk2(T[10], T[11]), pk2(T[12], T[13]), pk2(T[14], T[15])}; }
        LDS_WAIT(); asm volatile("" ::: "memory");
        rk_f32x16 xa = {};
        xa = rk_mfma(*(const LAS rk_bf16x8*)(L + RKA_T + (16 + r32) * RKA_RS_J + 16 * h), *(const LAS rk_bf16x8*)(L + RKA_N + r32 * RKA_RS_J + 16 * h), xa);
        if (r32 < 16) {
#pragma unroll
            for (int g = 0; g < 2; ++g) { v2u w; w.x = rk_pk(xa[4 * g], xa[4 * g + 1]); w.y = rk_pk(xa[4 * g + 2], xa[4 * g + 3]); *(LAS v2u*)(L + RKA_N + 1280 + r32 * RKA_RS_J + (8 * g + 4 * h) * 2) = w; } }
        LDS_WAIT(); asm volatile("" ::: "memory");
        rk_f32x16 ta = {};
        ta = rk_mfma(*(const LAS rk_bf16x8*)(L + RKA_N + 1280 + r32 * RKA_RS_J + 16 * h), *(const LAS rk_bf16x8*)(L + RKA_T + (16 + r32) * RKA_RS_J + (16 + 8 * h) * 2), ta);
        LDS_WAIT(); asm volatile("" ::: "memory");
        if (r32 < 16) {
#pragma unroll
            for (int g = 0; g < 2; ++g) { v2u w; w.x = rk_pk(ta[4 * g], ta[4 * g + 1]); w.y = rk_pk(ta[4 * g + 2], ta[4 * g + 3]); *(LAS v2u*)(L + RKA_T + (16 + r32) * RKA_RS_J + (8 * g + 4 * h) * 2) = w; } }
    }
    LDS_WAIT(); asm volatile("" ::: "memory");
    rk_bf16x8 fT[2];
#pragma unroll
    for (int s = 0; s < 2; ++s) fT[s] = rk_frag(L + RKA_T, RKA_RS_J, r32, s, h);
    {
        rk_f32x16 x0[2] = {{}, {}}, ap[2] = {{}, {}};
#pragma unroll
        for (int s = 0; s < 2; ++s) { const rk_bf16x8 fM = rk_frag(L + RKA_MAK, RKA_RS_J, r32, s, h);
#pragma unroll
            for (int nt = 0; nt < 2; ++nt) { x0[nt] = rk_mfma(fM, rk_frag(L + RKA_VT, RKA_RS_J, nt * 32 + r32, s, h), x0[nt]); ap[nt] = rk_mfma(fT[s], rk_frag(L + RKA_AT, RKA_RS_J, nt * 32 + r32, s, h), ap[nt]); } }
        LDS_WAIT(); asm volatile("" ::: "memory");
#pragma unroll
        for (int nt = 0; nt < 2; ++nt) { rk_store_tile_lds(L + RKA_X, RKA_RS_J, nt * 32 + r32, 0, h, x0[nt]); rk_store_tile_lds(L + RKA_AT, RKA_RS_J, nt * 32 + r32, 0, h, ap[nt]); }
    }
    LDS_WAIT(); asm volatile("" ::: "memory");
    {
        rk_f32x16 u0[2] = {{}, {}};
#pragma unroll
        for (int s = 0; s < 2; ++s)
#pragma unroll
            for (int nt = 0; nt < 2; ++nt) u0[nt] = rk_mfma(fT[s], rk_frag(L + RKA_X, RKA_RS_J, nt * 32 + r32, s, h), u0[nt]);
        LDS_WAIT(); asm volatile("" ::: "memory");
#pragma unroll
        for (int nt = 0; nt < 2; ++nt) rk_store_tile_lds(L + RKA_X, RKA_RS_J, nt * 32 + r32, 0, h, u0[nt]);
    }
    LDS_WAIT(); asm volatile("" ::: "memory");
    unsigned char* pq = rk_pq(ws, chunk >> 5) + (size_t)uh * 16384; unsigned char* ry = rk_ry(ws, chunk >> 5) + (size_t)uh * 8192;
    rk_bf16x8 fRB[2], fRK[2], fAp[2][2], fBh[2][2], fKh[2][2], fU[2][2], fV[2][2];
#pragma unroll
    for (int s = 0; s < 2; ++s) { fRB[s] = rk_frag(L + RKA_MRB, RKA_RS_J, r32, s, h); fRK[s] = rk_frag(L + RKA_MRK, RKA_RS_J, r32, s, h);
#pragma unroll
        for (int nt = 0; nt < 2; ++nt) { fAp[nt][s] = rk_frag(L + RKA_AT, RKA_RS_J, nt * 32 + r32, s, h); fBh[nt][s] = rk_frag(L + RKA_BH, RKA_RS_J, nt * 32 + r32, s, h);
            fKh[nt][s] = rk_frag(L + RKA_KH, RKA_RS_J, nt * 32 + r32, s, h); fU[nt][s] = rk_frag(L + RKA_X, RKA_RS_J, nt * 32 + r32, s, h); fV[nt][s] = rk_frag(L + RKA_VT, RKA_RS_J, nt * 32 + r32, s, h); } }
#pragma unroll
    for (int kt = 0; kt < 2; ++kt) {
        rk_f32x16 acc;
#pragma unroll
        for (int g = 0; g < 4; ++g) { const v2u w = *(const LAS v2u*)(L + RKA_R + r32 * RKA_RS_K + (kt * 32 + 8 * g + 4 * h) * 2); acc[4 * g] = bflo(w.x); acc[4 * g + 1] = bfhi(w.x); acc[4 * g + 2] = bflo(w.y); acc[4 * g + 3] = bfhi(w.y); }
#pragma unroll
        for (int s = 0; s < 2; ++s) acc = rk_mfma(fAp[kt][s], fRB[s], acc);
        rk_store_tile_frag(ry, 0, r32, kt, h, acc);
    }
#pragma unroll
    for (int kt = 0; kt < 2; ++kt)
#pragma unroll
        for (int kq = 0; kq < 2; ++kq) { rk_f32x16 acc = {};
#pragma unroll
            for (int s = 0; s < 2; ++s) acc = rk_mfma(fAp[kq][s], fBh[kt][s], acc);
            acc = acc * *(const LAS float*)(L + RKA_GC + (kt * 32 + r32) * 4);
            rk_store_tile_frag(pq, kt, r32, kq, h, acc); }
#pragma unroll
    for (int vt = 0; vt < 2; ++vt) {
        rk_f32x16 acc = {};
#pragma unroll
        for (int s = 0; s < 2; ++s) { acc = rk_mfma(fU[vt][s], fRB[s], acc); acc = rk_mfma(fV[vt][s], fRK[s], acc); }
        rk_store_blob((unsigned*)(ry + 4096) + vt * 512, lane, acc);
    }
#pragma unroll
    for (int kt = 0; kt < 2; ++kt)
#pragma unroll
        for (int vt = 0; vt < 2; ++vt) { rk_f32x16 acc = {};
#pragma unroll
            for (int s = 0; s < 2; ++s) { acc = rk_mfma(fBh[kt][s], fU[vt][s], acc); acc = rk_mfma(fKh[kt][s], fV[vt][s], acc); }
#pragma unroll
            for (int g = 0; g < 4; ++g) { const f32x4 gq = *(const LAS f32x4*)(L + RKA_GC + (kt * 32 + 8 * g + 4 * h) * 4); acc[4 * g] *= gq[0]; acc[4 * g + 1] *= gq[1]; acc[4 * g + 2] *= gq[2]; acc[4 * g + 3] *= gq[3]; }
            rk_store_blob((unsigned*)(pq + 8192) + (kt * 2 + vt) * 512, lane, acc); }
    LDS_WAIT(); asm volatile("" ::: "memory");
}
__device__ __forceinline__ void rwkvA_phase(Frame& F, const InTab& A, int half) {
    if (F.wave >= RKA_WAVES) { if (half == 0) post_ya(F, A, F.bx * (NWAVES - RKA_WAVES) + (F.wave - RKA_WAVES), F.G * (NWAVES - RKA_WAVES)); return; }
    LAS unsigned char* L = F.lds + RING_OFF + F.wave * RKA_BYTES;
    const int gw = F.bx * RKA_WAVES + F.wave, NGW = F.G * RKA_WAVES;
    for (int u = gw; u < 64 * 32; u += NGW) rwkvA_unit(L, A, F.ws, u >> 5, half * 32 + (u & 31), F.lane);
}
__device__ __forceinline__ void rwkvA_queue(Frame& F, const InTab& A, int half, unsigned* counter) {
    if (F.wave >= RKA_WAVES) return;
    LAS unsigned char* L = F.lds + RING_OFF + F.wave * RKA_BYTES;
    for (;;) {
        unsigned u = 0; if (F.lane == 0) u = __hip_atomic_fetch_add(counter, 1u, __ATOMIC_RELAXED, __HIP_MEMORY_SCOPE_AGENT);
        u = __builtin_amdgcn_readfirstlane(u);
        if (u >= 64u * 32u) break;
        rwkvA_unit(L, A, F.ws, (int)(u >> 5), half * 32 + (int)(u & 31), F.lane);
    }
}
constexpr int RKB_RS = 144, RKB_SBUF = 64 * RKB_RS;
constexpr int RKB_YOFF = 2 * RKB_SBUF + 8192, RKB_YRS = 68, RKB_YBYTES = 32 * RKB_YRS * 4;
__device__ __forceinline__ void rwkvB_phase(Frame& F, const InTab& A, int bh, int half) {
    int lane = F.lane; asm volatile("" : "+v"(lane));
    const int wave = F.wave, r32 = lane & 31, h = lane >> 5;
    LAS unsigned char* SB = F.lds + RING_OFF;
    unsigned char* ws = F.ws;
    const int b = bh >> 3, hd = bh & 7;
    const int kt = (wave >> 1) & 1, vt = wave & 1;
    float* sst = (float*)(ws + WS_SST) + (size_t)bh * 4096 + (size_t)(wave & 3) * 1024;
    rk_f32x16 st = {};
    if (wave < 4) {
        if (half != 0) {
#pragma unroll
            for (int i = 0; i < 16; ++i) st[i] = *(const GAS float*)(sst + i * 64 + lane);
        }
        rk_store_tile_lds(SB, RKB_RS, vt * 32 + r32, kt * 32, h, st);
    }
    const int uh0 = bh * 32; const bool isS = wave < 4, isY = !isS && wave < 6;
    const unsigned char* fptr = isS ? rk_pq(ws, half) + (size_t)uh0 * 16384 + (kt * 256 + lane) * 16 : rk_ry(ws, half) + (size_t)uh0 * 8192 + lane * 16;
    const unsigned char* bptr = isS ? rk_pq(ws, half) + (size_t)uh0 * 16384 + 8192 + (kt * 2 + vt) * 2048 + lane * 32 : rk_ry(ws, half) + (size_t)uh0 * 8192 + 4096 + vt * 2048 + lane * 32;
    const LAS unsigned char* gl = SB + 2 * RKB_SBUF + (kt * 32 + 4 * h) * 4;
    const int fstride = isS ? 16384 : 8192;
    struct Op { v4u f[4]; v4u b0, b1; };
    { const int tid_ = wave * 64 + lane; *(LAS f32x4*)(SB + 2 * RKB_SBUF + tid_ * 16) = *(const GAS f32x4*)(rk_gc(ws, half) + (size_t)uh0 * 256 + tid_ * 16); }
    { const int tid_ = wave * 64 + lane; if (tid_ < 192) { const int e_ = tid_ & 63; const float* src_ = tid_ < 64 ? A[I_LNG] + hd * 64 : (tid_ < 128 ? A[I_LNB] + hd * 64 : A[I_MU] + 1024 + hd * 64);
        ((LAS float*)(SB + RKB_YOFF + 2 * RKB_YBYTES))[tid_] = src_[e_]; } }
    Op o0, o1, o2;
#define RKB_LOAD(O_, c) do { const unsigned char* fp_ = fptr + (size_t)(c) * fstride; const unsigned char* bp_ = bptr + (size_t)(c) * fstride; \
        _Pragma("unroll") for (int s = 0; s < 4; ++s) O_.f[s] = *(const GAS v4u*)(fp_ + 1024 * s); \
        O_.b0 = *(const GAS v4u*)bp_; O_.b1 = *(const GAS v4u*)(bp_ + 16); } while (0)
#define RKB_BAR() do { asm volatile("s_waitcnt lgkmcnt(0)" ::: "memory"); __builtin_amdgcn_s_barrier(); asm volatile("" ::: "memory"); } while (0)
#define RKB_NEXT(O_, c, AH_) RKB_LOAD(O_, ((c) + (AH_) < 32 ? (c) + (AH_) : 31))
#define RKB_STEP_S(O_, c) do { \
        const LAS unsigned char* cur = SB + ((c) & 1) * RKB_SBUF; LAS unsigned char* nxt = SB + (((c) & 1) ^ 1) * RKB_SBUF; \
        rk_bf16x8 fS[4]; _Pragma("unroll") for (int s = 0; s < 4; ++s) fS[s] = rk_frag(cur, RKB_RS, vt * 32 + r32, s, h); \
        RkBlob bb_; bb_.w0 = O_.b0; bb_.w1 = O_.b1; const rk_f32x16 q = rk_blob_f32(bb_); \
        _Pragma("unroll") for (int g = 0; g < 4; ++g) { const f32x4 gq = *(const LAS f32x4*)(gl + (c) * 256 + 32 * g); \
            st[4 * g] = st[4 * g] * gq[0] + q[4 * g]; st[4 * g + 1] = st[4 * g + 1] * gq[1] + q[4 * g + 1]; st[4 * g + 2] = st[4 * g + 2] * gq[2] + q[4 * g + 2]; st[4 * g + 3] = st[4 * g + 3] * gq[3] + q[4 * g + 3]; } \
        _Pragma("unroll") for (int s = 0; s < 4; ++s) st = rk_mfma(__builtin_bit_cast(rk_bf16x8, O_.f[s]), fS[s], st); \
        RKB_NEXT(O_, c, 5); \
        rk_store_tile_lds(nxt, RKB_RS, vt * 32 + r32, kt * 32, h, st); \
        RKB_BAR(); } while (0)
#define RKB_Y_BODY(O_, c) do { \
        const LAS unsigned char* cur = SB + ((c) & 1) * RKB_SBUF; \
        rk_bf16x8 fS[4]; _Pragma("unroll") for (int s = 0; s < 4; ++s) fS[s] = rk_frag(cur, RKB_RS, vt * 32 + r32, s, h); \
        RkBlob bb_; bb_.w0 = O_.b0; bb_.w1 = O_.b1; rk_f32x16 acc = rk_blob_f32(bb_); \
        _Pragma("unroll") for (int s = 0; s < 4; ++s) acc = rk_mfma(fS[s], __builtin_bit_cast(rk_bf16x8, O_.f[s]), acc);       \
        RKB_NEXT(O_, c, 3); \
        { LAS float* yb_ = (LAS float*)(SB + RKB_YOFF + ((c) & 1) * RKB_YBYTES) + r32 * RKB_YRS + 32 * vt + 4 * h;        \
          _Pragma("unroll") for (int g = 0; g < 4; ++g) *(LAS f32x4*)(yb_ + 8 * g) = (f32x4){acc[4 * g], acc[4 * g + 1], acc[4 * g + 2], acc[4 * g + 3]}; } \
        } while (0)
    __syncthreads();
    if (isS) {
        Op o3, o4; RKB_LOAD(o0, 0); RKB_LOAD(o1, 1); RKB_LOAD(o2, 2); RKB_LOAD(o3, 3); RKB_LOAD(o4, 4);
#define R5S(c) RKB_STEP_S(o0, c); RKB_STEP_S(o1, (c) + 1); RKB_STEP_S(o2, (c) + 2); RKB_STEP_S(o3, (c) + 3); RKB_STEP_S(o4, (c) + 4);
        R5S(0) R5S(5) R5S(10) R5S(15) R5S(20) R5S(25)
        RKB_STEP_S(o0, 30); RKB_STEP_S(o1, 31);
#undef R5S
    } else {
        const int tl = 8 * (wave - 4) + (lane >> 3), q8 = lane & 7, ch = hd * 64 + 8 * q8;
        float lg[8], lb[8], muv[8];
        { const LAS float* ctab = (const LAS float*)(SB + RKB_YOFF + 2 * RKB_YBYTES) + 8 * q8;
#pragma unroll
          for (int j = 0; j < 2; ++j) { const f32x4 a_ = *(const LAS f32x4*)(ctab + 4 * j), b_ = *(const LAS f32x4*)(ctab + 64 + 4 * j), c_ = *(const LAS f32x4*)(ctab + 128 + 4 * j);
#pragma unroll
            for (int i = 0; i < 4; ++i) { lg[4 * j + i] = a_[i]; lb[4 * j + i] = b_[i]; muv[4 * j + i] = c_[i]; } } }
        const GAS unsigned char* RKVp = (const GAS unsigned char*)(ws + WS_RKV) + 2048; const GAS unsigned char* GGp = (const GAS unsigned char*)(ws + WS_GG); const GAS unsigned char* BONp = (const GAS unsigned char*)(ws + WS_BON); GAS unsigned char* YAp = (GAS unsigned char*)(ws + WS_YA) + 1024;
        const unsigned mlane = (unsigned)(b * SEQ + half * 1024 + tl);
        const unsigned og = (mlane * 512u + (unsigned)ch) * 2u, ov = (mlane * 1536u + (unsigned)ch) * 2u, ob = (mlane * 8u + (unsigned)hd) * 4u, oy = (mlane * 1024u + (unsigned)ch) * 2u;
        struct Pp { v4u g, v, p; float bon; };
#define RKB_PLOAD(P_, c) do { \
        P_.g = *(const GAS v4u*)(GGp + (size_t)(c) * 32768 + og); P_.v = *(const GAS v4u*)(RKVp + (size_t)(c) * 98304 + ov); P_.p = *(const GAS v4u*)(RKVp + ((long)(c) * 98304 - 3072) + ov); \
        P_.bon = *(const GAS float*)(BONp + (size_t)(c) * 1024 + ob); } while (0)
#define RKB_UNPK8(w_) {bflo(w_.x), bfhi(w_.x), bflo(w_.y), bfhi(w_.y), bflo(w_.z), bfhi(w_.z), bflo(w_.w), bfhi(w_.w)}
#define RKB_POST(P_, c) do { asm volatile("" : "+v"(P_.g), "+v"(P_.v), "+v"(P_.p));        \
        const LAS float* yb_ = (const LAS float*)(SB + RKB_YOFF + ((c) & 1) * RKB_YBYTES) + tl * RKB_YRS + 8 * q8; \
        const f32x4 ya_ = *(const LAS f32x4*)yb_, yc_ = *(const LAS f32x4*)(yb_ + 4); const float y[8] = {ya_[0], ya_[1], ya_[2], ya_[3], yc_[0], yc_[1], yc_[2], yc_[3]}; \
        const float mean = oct_allsum(((y[0] + y[1]) + (y[2] + y[3])) + ((y[4] + y[5]) + (y[6] + y[7]))) * (1.0f / 64.0f); \
        float q_ = 0.f; _Pragma("unroll") for (int e = 0; e < 8; ++e) { const float d_ = y[e] - mean; q_ += d_ * d_; } \
        const float rstd = __builtin_amdgcn_rsqf(oct_allsum(q_) * (1.0f / 64.0f) + GN_EPS); \
        const bool first_ = (((mlane + 32u * (unsigned)(c)) & (unsigned)(SEQ - 1)) == 0u);        \
        const float ga[8] = RKB_UNPK8(P_.g), va[8] = RKB_UNPK8(P_.v), pa[8] = RKB_UNPK8(P_.p); float r[8]; \
        _Pragma("unroll") for (int e = 0; e < 8; ++e) { const float pe_ = first_ ? 0.f : pa[e]; const float vs_ = va[e] + (pe_ - va[e]) * muv[e]; r[e] = (((y[e] - mean) * rstd) * lg[e] + lb[e] + P_.bon * vs_) * ga[e]; } \
        v4u w0; w0.x = rk_pk(r[0], r[1]); w0.y = rk_pk(r[2], r[3]); w0.z = rk_pk(r[4], r[5]); w0.w = rk_pk(r[6], r[7]); \
        *(GAS v4u*)(YAp + (size_t)(c) * 65536 + oy) = w0; \
        RKB_PLOAD(P_, ((c) + 3 < 32 ? (c) + 3 : 31)); } while (0)
        Pp p0, p1, p2; RKB_PLOAD(p0, 0); RKB_PLOAD(p1, 1); RKB_PLOAD(p2, 2);
        if (isY) {
            RKB_LOAD(o0, 0); RKB_LOAD(o1, 1); RKB_LOAD(o2, 2);
            RKB_Y_BODY(o0, 0); RKB_BAR();
#define R3YP(c) RKB_Y_BODY(o1, c); RKB_POST(p0, (c) - 1); RKB_BAR(); RKB_Y_BODY(o2, (c) + 1); RKB_POST(p1, c); RKB_BAR(); RKB_Y_BODY(o0, (c) + 2); RKB_POST(p2, (c) + 1); RKB_BAR();
            R3YP(1) R3YP(4) R3YP(7) R3YP(10) R3YP(13) R3YP(16) R3YP(19) R3YP(22) R3YP(25) R3YP(28)
            RKB_Y_BODY(o1, 31); RKB_POST(p0, 30); RKB_BAR();
            RKB_POST(p1, 31);
#undef R3YP
        } else {
            RKB_BAR();
#define R3P(c) RKB_POST(p0, (c) - 1); RKB_BAR(); RKB_POST(p1, c); RKB_BAR(); RKB_POST(p2, (c) + 1); RKB_BAR();
            R3P(1) R3P(4) R3P(7) R3P(10) R3P(13) R3P(16) R3P(19) R3P(22) R3P(25) R3P(28)
            RKB_POST(p0, 30); RKB_BAR();
            RKB_POST(p1, 31);
#undef R3P
        }
#undef RKB_POST
#undef RKB_UNPK8
#undef RKB_PLOAD
    }
#undef RKB_STEP_S
#undef RKB_Y_BODY
#undef RKB_NEXT
#undef RKB_BAR
#undef RKB_LOAD
    if (wave < 4 && half == 0) {
#pragma unroll
        for (int i = 0; i < 16; ++i) *(GAS float*)(sst + i * 64 + lane) = st[i];
    }
}

constexpr int NPHASE = 9;
template <int PHM> __global__ void __launch_bounds__(NWAVES * 64, 2) fwd_kernel(Args args) {
    extern __shared__ __attribute__((aligned(16))) unsigned char lds[];
    namespace cg = cooperative_groups;
    Frame F;
    F.lds = (LAS unsigned char*)lds;
    F.tid = threadIdx.x; F.lane = F.tid & 63; F.wave = __builtin_amdgcn_readfirstlane(F.tid >> 6);
    F.G = gridDim.x; F.bx = blockIdx.x;
    F.out = args.out; F.ws = args.ws;
#define PH_BEGIN InTab TAB; { ktab_t kp_ = (ktab_t)__builtin_amdgcn_kernarg_segment_ptr(); asm volatile("" : "+s"(kp_)); TAB.p = kp_; } { int t_ = threadIdx.x; asm volatile("" : "+v"(t_)); F.tid = t_; F.lane = t_ & 63; F.wave = __builtin_amdgcn_readfirstlane(t_ >> 6); } GAS unsigned char* wsg_ = (GAS unsigned char*)args.ws; asm volatile("" : "+s"(wsg_)); unsigned char* ws = (unsigned char*)wsg_; F.ws = ws; GAS bf16_t* gtg_ = (GAS bf16_t*)args.out; asm volatile("" : "+s"(gtg_)); bf16_t* GATES = (bf16_t*)gtg_; F.out = (float*)GATES; (void)GATES;
    const int lo = args.ph_lo, hi = args.ph_hi;
    XcdBarrier bar; bar.bar = nullptr; bar.x = 0; bar.st = nullptr;
    if (hi - lo > 1) {
        for (int u = threadIdx.x; u < (LDS_BYTES - 162816) / 4; u += NWAVES * 64) ((LAS unsigned*)(F.lds + 162816))[u] = 0u;
        { GAS v4u* z_ = (GAS v4u*)(args.ws + WS_CTL) + (size_t)blockIdx.x * (CTL_ZERO_BYTES / 16 / 256); for (int u = threadIdx.x; u < (int)(CTL_ZERO_BYTES / 16 / 256); u += NWAVES * 64) z_[u] = (v4u){0u, 0u, 0u, 0u}; }
        asm volatile("s_waitcnt vmcnt(0)" ::: "memory");
        __syncthreads();
        cg::this_grid().sync();
        bar = xcd_barrier_post((unsigned*)(args.ws + WS_CTL) + CW_BAR, (volatile LAS unsigned*)(F.lds + MISC_OFF) + 8);
    }
#define IN(k) (((PHM >> (k)) & 1) && lo <= (k) && (k) < hi)
#ifdef PROBE_DUP
#define REPS(k) (((k) == PROBE_DUP) ? 2 : 1)
#else
#define REPS(k) 1
#endif
#define SEAM(k) do { if (IN(k) && IN((k) + 1)) { xcd_barrier(bar); } } while (0)
    using pg8::Gemm; using pg8::StaticOrder; using pg8::EpiRow8; using pg8::bf16_t;

#ifdef PROBE_SEG
#ifndef PROBE_BLK
#define PROBE_BLK 0
#endif
    unsigned long long pr_t0 = 0, pr_acc = 0;
#define PR_BEGIN(k) do { if (PROBE_SEG == (k)) { __syncthreads(); pr_t0 = __builtin_amdgcn_s_memrealtime(); } } while (0)
#define PR_END(k) do { if (PROBE_SEG == (k)) { __syncthreads(); pr_acc += __builtin_amdgcn_s_memrealtime() - pr_t0; } } while (0)
#else
#define PR_BEGIN(k) do {} while (0)
#define PR_END(k) do {} while (0)
#endif
    if (IN(0)) for (int rep_ = 0; rep_ < REPS(0); ++rep_) { if (rep_) xcd_barrier(bar); PH_BEGIN p0_prologue(F, TAB); } SEAM(0);
    PR_BEGIN(11); if (IN(1)) for (int rep_ = 0; rep_ < REPS(1); ++rep_) { if (rep_) xcd_barrier(bar); PH_BEGIN
        Gemm g{(const bf16_t*)(ws + WS_XN), (const bf16_t*)(ws + WS_WIN), M, D_IN - 256, D}; StaticOrder S; S.init(M, D_IN - 256, F.G, F.bx);
        EpiRow8<pg8::FProj> E{{ws, GATES}};
        pg8::gemm_phase<EpiRow8<pg8::FProj>, StaticOrder, PG8_ALIGN, PG8_SP2>(F.lds + RING_OFF, g, S, E);
    } SEAM(1); PR_END(11);
    PR_BEGIN(12); if (IN(2)) { PH_BEGIN
        constexpr int NLW = 64;
#ifndef PROBE_ATTN_ONLY
        PR_BEGIN(21);
        if (F.bx >= F.G - NLW) {
            const int pm = F.bx - (F.G - NLW);
            prep1_rows(F, TAB, pm * 32, pm * 32 + 32, F.wave, NWAVES);
            asm volatile("s_waitcnt vmcnt(0)" ::: "memory"); __syncthreads();
            if (threadIdx.x == 0) { __builtin_amdgcn_fence(__ATOMIC_ACQUIRE, "agent"); asm volatile("s_waitcnt vmcnt(0)" ::: "memory"); }
            __syncthreads();
            int klora = KLORA; asm volatile("" : "+s"(klora));
            Gemm g{(const bf16_t*)(ws + WS_LIN), (const bf16_t*)(ws + WS_WL) + (size_t)1024 * KLORA, M, 512, klora}; pg8::PanelOrder S{pm, 2};
            EpiRow8<pg8::FLoraG> E{{ws}};
            pg8::gemm_phase<EpiRow8<pg8::FLoraG>, pg8::PanelOrder, PG8_ALIGN, PG8_SP2>(F.lds + RING_OFF, g, S, E);
            __syncthreads();
        } else if (F.bx >= F.G - 2 * NLW) {
            const int pm = F.bx - (F.G - 2 * NLW);
            {
                Gemm g2{(const bf16_t*)(ws + WS_XN), (const bf16_t*)(ws + WS_WIN) + (size_t)(D_IN - 256) * D, M, 256, D}; pg8::PanelOrder S2{pm, 1};
                EpiRow8<pg8::FProjOff> E2{{{ws, GATES}, (D_IN - 256) / 256}};
                pg8::gemm_phase<EpiRow8<pg8::FProjOff>, pg8::PanelOrder, PG8_ALIGN, PG8_SP2>(F.lds + RING_OFF, g2, S2, E2);
                __syncthreads();
            }
        }
#endif
        PR_END(21);
        const attn_body::AttnTensors AT{(const attn_body::bf16*)(ws + WS_Q), (const attn_body::bf16*)(ws + WS_K), (const attn_body::bf16*)(ws + WS_V), (attn_body::bf16*)(ws + WS_O)};
        PR_BEGIN(20); attn_body::attn_phase_hybrid128<8>((char*)lds + RING_OFF, AT, (unsigned*)(ws + WS_CTL + CTL_ATTQ), (volatile LAS unsigned*)(F.lds + MISC_OFF) + 24, F.bx); PR_END(20);
    } SEAM(2); PR_END(12);
    if (IN(3)) { PH_BEGIN
        { GAS unsigned char* w_ = (GAS unsigned char*)args.ws; asm volatile("" : "+s"(w_)); F.ws = (unsigned char*)w_; }
        PR_BEGIN(1); rwkvA_phase(F, TAB, 0); PR_END(1);
        xcd_barrier(bar);
        { GAS unsigned char* w_ = (GAS unsigned char*)args.ws; asm volatile("" : "+s"(w_)); F.ws = (unsigned char*)w_; }
        PR_BEGIN(2); PR_BEGIN(4); if (F.bx < 64) rwkvB_phase(F, TAB, F.bx, 0); else { late_weights(F, TAB, 0, 2, 64); late_weights(F, TAB, 1, 2, 64); }
        __syncthreads(); PR_END(4);
        { GAS unsigned char* w_ = (GAS unsigned char*)args.ws; asm volatile("" : "+s"(w_)); F.ws = (unsigned char*)w_; }
        rwkvA_queue(F, TAB, 1, (unsigned*)(F.ws + WS_CTL + CTL_RKAQ)); PR_END(2);
        xcd_barrier(bar);
        { GAS unsigned char* w_ = (GAS unsigned char*)args.ws; asm volatile("" : "+s"(w_)); F.ws = (unsigned char*)w_; }
        PR_BEGIN(3); if (F.bx < 64) rwkvB_phase(F, TAB, F.bx, 1); PR_END(3);
    } SEAM(3);
    PR_BEGIN(15); if (IN(5)) for (int rep_ = 0; rep_ < REPS(5); ++rep_) { if (rep_) xcd_barrier(bar); PH_BEGIN
        Gemm g{(const bf16_t*)(ws + WS_YA), (const bf16_t*)(ws + WS_WA), M, D, 1024}; StaticOrder S; S.init(M, D, F.G, F.bx);
        pg8::EpiMerge E{GATES, (bf16_t*)(ws + WS_MERGED)};
        pg8::gemm_phase<pg8::EpiMerge, StaticOrder, PG8_ALIGN, PG8_SP2>(F.lds + RING_OFF, g, S, E);
    } SEAM(5); PR_END(15);
    PR_BEGIN(16); if (IN(6)) for (int rep_ = 0; rep_ < REPS(6); ++rep_) { if (rep_) xcd_barrier(bar); PH_BEGIN
        Gemm g{(const bf16_t*)(ws + WS_MERGED), (const bf16_t*)(ws + WS_WO), M, D, D}; StaticOrder S; S.init(M, D, F.G, F.bx);
        pg8::EpiResNorm<0> E{TAB[I_X], F.out, (bf16_t*)(ws + WS_XN), TAB[I_NFG], (float*)(ws + WS_CTL + CTL_SS1), (unsigned*)(ws + WS_CTL + CTL_CNT1), NORM_EPS, (bf16_t*)(ws + WS_X1B)};
        pg8::gemm_phase<pg8::EpiResNorm<0>, StaticOrder, PG8_ALIGN, PG8_SP2>(F.lds + RING_OFF, g, S, E);
    } SEAM(6); PR_END(16);
    PR_BEGIN(17); if (IN(7)) for (int rep_ = 0; rep_ < REPS(7); ++rep_) { if (rep_) xcd_barrier(bar); PH_BEGIN
        Gemm g{(const bf16_t*)(ws + WS_XN), (const bf16_t*)(ws + WS_W1), M, FF, D}; StaticOrder S; S.init(M, FF, F.G, F.bx);
        EpiRow8<pg8::FRelu2> E{{(bf16_t*)(ws + WS_H)}};
        pg8::gemm_phase<EpiRow8<pg8::FRelu2>, StaticOrder, PG8_ALIGN, PG8_SP2>(F.lds + RING_OFF, g, S, E);
    } SEAM(7); PR_END(17);
    PR_BEGIN(18); if (IN(8)) for (int rep_ = 0; rep_ < REPS(8); ++rep_) { if (rep_) xcd_barrier(bar); PH_BEGIN
        Gemm g{(const bf16_t*)(ws + WS_H), (const bf16_t*)(ws + WS_W2), M, D, FF}; StaticOrder S; S.init(M, D, F.G, F.bx);
        pg8::EpiResNorm<1> E{nullptr, F.out, nullptr, TAB[I_NFIN], (float*)(ws + WS_CTL + CTL_SS2), (unsigned*)(ws + WS_CTL + CTL_CNT2), NORM_EPS, (bf16_t*)(ws + WS_X1B)};
        pg8::gemm_phase<pg8::EpiResNorm<1>, StaticOrder, PG8_ALIGN, PG8_SP2>(F.lds + RING_OFF, g, S, E);
    } PR_END(18);
#ifdef PROBE_SEG
    if (blockIdx.x == PROBE_BLK) { const unsigned long long t0_ = __builtin_amdgcn_s_memrealtime(); while (__builtin_amdgcn_s_memrealtime() - t0_ < (unsigned long long)PROBE_MUL * pr_acc) __builtin_amdgcn_s_sleep(8); }
#endif
#undef IN
#undef SEAM
#undef PH_BEGIN
}


#ifdef DBG_DUMP
__global__ void dbg_dump(float* out, const unsigned char* ws) {
    const size_t i = (size_t)blockIdx.x * blockDim.x + threadIdx.x; if (i >= (size_t)M * 1024) return;
    const size_t m = i >> 10; const int c = (int)(i & 1023); float v = 0.f;
#if DBG_DUMP == 1
    v = bf1(((const bf16*)(ws + WS_O))[m * 1024 + c]);
#elif DBG_DUMP == 2
    v = c < 512 ? bf1(((const bf16*)(ws + WS_Y))[m * 512 + c]) : (c < 520 ? ((const float*)(ws + WS_BON))[m * 8 + (c - 512)] : 0.f);
#elif DBG_DUMP == 3
    v = c < 512 ? bf1(((const bf16*)(ws + WS_Q))[m * 512 + c]) : bf1(((const bf16*)(ws + WS_K))[m * 512 + c - 512]);
#elif DBG_DUMP == 4
    v = c < 512 ? ((const float*)(ws + WS_DEC))[m * 512 + c] : bf1(((const bf16*)(ws + WS_AA))[m * 512 + c - 512]);
#elif DBG_DUMP == 6
    v = c < 256 ? bf1(((const bf16*)(ws + WS_WAG))[m * 256 + c]) : (c < 512 ? bf1(((const bf16*)(ws + WS_LIN))[m * 256 + c - 256]) : 0.f);
#elif DBG_DUMP == 7
    { const bf16* wl = (const bf16*)(ws + WS_WL); const size_t j = (m * 1024 + c); v = j < (size_t)NLORA * KLORA ? bf1(wl[j]) : 0.f; }
#elif DBG_DUMP == 8
    v = c < 512 ? bf1(((const bf16*)(ws + WS_GG))[m * 512 + c]) : 0.f;
#elif DBG_DUMP == 5
    v = bf1(((const bf16*)(ws + WS_RKV))[m * 1536 + c]);
#endif
    out[i] = v;
}
#endif

#ifdef DBG_FIXLORA
__global__ void dbg_fixlora(Args A) {
    const size_t i = (size_t)blockIdx.x * blockDim.x + threadIdx.x; if (i >= (size_t)M * 512) return;
    const size_t m = i >> 9; const int c = (int)(i & 511);
    const bf16* LINr = (const bf16*)(A.ws + WS_LIN) + m * 256;
#if DBG_FIXLORA & 1
    { float g = 0.f; for (int k = 0; k < 128; ++k) g += bf1(LINr[128 + k]) * A[I_G2][(size_t)k * 512 + c]; ((bf16*)(A.ws + WS_GG))[m * 512 + c] = (bf16)f2bf(g); }
#endif
#if DBG_FIXLORA & 2
    { float s = A[I_A0][c]; for (int k = 0; k < 64; ++k) s += bf1(LINr[64 + k]) * A[I_A2][(size_t)k * 512 + c]; ((bf16*)(A.ws + WS_AA))[m * 512 + c] = (bf16)f2bf(1.0f / (1.0f + expf(-s))); }
#endif
#if DBG_FIXLORA & 4
    { float s = A[I_W0][c]; for (int k = 0; k < 64; ++k) s += bf1(LINr[k]) * A[I_W2][(size_t)k * 512 + c]; const float w = -log1pf(expf(-s)) - 0.5f; ((float*)(A.ws + WS_DEC))[m * 512 + c] = expf(-expf(w)); }
#endif
}
#endif
#ifndef MK_ONE_LAUNCH
#define MK_ONE_LAUNCH 0
#endif
#ifndef MK_MASK
#define MK_MASK ((1 << NPHASE) - 1)
#endif
typedef void (*kern_t)(Args);
template <int P> struct KTab { static void fill(kern_t* t) { t[P] = fwd_kernel<(1 << P)>; KTab<P - 1>::fill(t); } };
template <> struct KTab<-1> { static void fill(kern_t*) {} };
extern "C" void kernel_launch(void* const* d_in, const int* in_sizes, int n_in, void* d_out, int out_size, void* d_ws, size_t ws_size, hipStream_t stream) {
    static int grid = 0; static kern_t ktab[NPHASE];
    if (grid == 0) {
        if (n_in != 26 || in_sizes[0] != M * D || out_size != M * D || ws_size < WS_END) { fprintf(stderr, "kernel_launch: unexpected shapes (n_in %d, in0 %d, out %d, ws %zu); nothing launched\n", n_in, n_in > 0 ? in_sizes[0] : -1, out_size, ws_size); grid = -1; return; }
        int dev = 0, cus = 0;
        if (hipGetDevice(&dev) != hipSuccess || hipDeviceGetAttribute(&cus, hipDeviceAttributeMultiprocessorCount, dev) != hipSuccess) { grid = -1; return; }
#if MK_ONE_LAUNCH
        int per_cu = 0;
        if (hipFuncSetAttribute((const void*)fwd_kernel<MK_MASK>, hipFuncAttributeMaxDynamicSharedMemorySize, LDS_BYTES) != hipSuccess) { fprintf(stderr, "kernel_launch: hipFuncSetAttribute failed\n"); grid = -1; return; }
        if (hipOccupancyMaxActiveBlocksPerMultiprocessor(&per_cu, (const void*)fwd_kernel<MK_MASK>, NWAVES * 64, LDS_BYTES) != hipSuccess || per_cu < 1) { fprintf(stderr, "kernel_launch: occupancy query says %d blocks per CU\n", per_cu); (void)hipGetLastError(); grid = -1; return; }
#else
        KTab<NPHASE - 1>::fill(ktab);
        for (int p = 0; p < NPHASE; ++p) if (hipFuncSetAttribute((const void*)ktab[p], hipFuncAttributeMaxDynamicSharedMemorySize, LDS_BYTES) != hipSuccess) { fprintf(stderr, "kernel_launch: hipFuncSetAttribute failed\n"); grid = -1; return; }
#endif
        grid = cus;
        if (grid != 256) fprintf(stderr, "kernel_launch: note: %d CUs (built for 256)\n", grid);
    }
    if (grid < 0) return;
    Args a{};
    for (int i = 0; i < 26; ++i) a.in[i] = (const float*)d_in[i];
    a.out = (float*)d_out; a.ws = (unsigned char*)d_ws;
#if MK_ONE_LAUNCH
    a.ph_lo = 0; a.ph_hi = NPHASE;
    void* kargs[] = {&a};
    hipError_t e = hipLaunchCooperativeKernel((const void*)fwd_kernel<MK_MASK>, dim3(grid), dim3(NWAVES * 64), kargs, LDS_BYTES, stream);
    if (e != hipSuccess) fprintf(stderr, "kernel_launch: cooperative launch failed: %s\n", hipGetErrorString(e));
#else
#ifdef DBG_DUMP
    for (int p = 0; p <= DBG_STOP; ++p) { a.ph_lo = p; a.ph_hi = p + 1; hipLaunchKernelGGL(ktab[p], dim3(grid), dim3(NWAVES * 64), LDS_BYTES, stream, a); }
    hipLaunchKernelGGL(dbg_dump, dim3((M * 1024) / 256), dim3(256), 0, stream, (float*)d_out, (const unsigned char*)d_ws);
#else
    for (int p = 0; p < NPHASE; ++p) { a.ph_lo = p; a.ph_hi = p + 1; hipLaunchKernelGGL(ktab[p], dim3(grid), dim3(NWAVES * 64), LDS_BYTES, stream, a);
#ifdef DBG_FIXLORA
        if (p == 3) hipLaunchKernelGGL(dbg_fixlora, dim3((M * 512) / 256), dim3(256), 0, stream, a);
#endif
    }
#endif
#endif
}
```

```cpp
#define MK_ONE_LAUNCH 1
#include <hip/hip_runtime.h>
#include <cstdio>
#include <cstdint>
constexpr int NWAVES = 8;
constexpr int BATCH = 8, SEQ = 2048, D = 1024, M = BATCH * SEQ;
constexpr int D_IN = 5376, FF = 4096, RWW = 512, NLORA = 1536, KLORA = 256;
constexpr float NORM_EPS = 1e-6f, SUBLN_EPS = 1e-5f, GN_EPS = 64e-5f, LAMBDA_INIT = 0.2f;
constexpr size_t MiB = 1u << 20;
constexpr size_t WS_CTL = 0, CTL_ZERO_BYTES = 256 * 1024;
constexpr size_t CTL_SS1 = 65536, CTL_SS2 = 131072, CTL_CNT1 = 196608, CTL_CNT2 = 212992, CTL_ATTQ = 229376, CTL_RKAQ = 229380;
constexpr size_t WS_ROPE_C = 512 * 1024, WS_ROPE_S = 768 * 1024;
constexpr size_t WS_BON = 1 * MiB;
constexpr size_t WS_WIN = 2 * MiB;
constexpr size_t WS_WA = WS_WIN + (size_t)D_IN * D * 2;
constexpr size_t WS_WB = WS_WA + 1 * MiB;
constexpr size_t WS_WO = WS_WB + 1 * MiB;
constexpr size_t WS_W1 = WS_WO + 2 * MiB;
constexpr size_t WS_W2 = WS_W1 + 8 * MiB;
constexpr size_t WS_WL = WS_W2 + 8 * MiB;
static_assert(WS_WL + (size_t)NLORA * KLORA * 2 <= 34 * MiB, "weights");
constexpr size_t WS_XN = 34 * MiB;
constexpr size_t WS_DEC = WS_XN;
constexpr size_t WS_Q = 66 * MiB, WS_K = 82 * MiB, WS_V = 98 * MiB;
constexpr size_t WS_RKV = 114 * MiB;
constexpr size_t WS_WAG = 162 * MiB, WS_LIN = 242 * MiB;
constexpr size_t WS_Y = 162 * MiB;
constexpr size_t WS_AA = 178 * MiB, WS_GG = 194 * MiB;
constexpr size_t WS_O = 210 * MiB;
constexpr size_t WS_YA = 210 * MiB;
constexpr size_t WS_TMP = 114 * MiB;
constexpr size_t WS_MERGED = 114 * MiB;
constexpr size_t WS_X1B = 194 * MiB;
constexpr size_t WS_H = 66 * MiB;
constexpr size_t WS_END = 252 * MiB;
constexpr int RING_OFF = 0, RING_BYTES = 131072;
constexpr int LDS_BYTES = 163840;

#include <hip/hip_runtime.h>
#include <cstdio>
#include <cstdint>
namespace pg8 {
#define PG8_LAS __attribute__((address_space(3)))
typedef unsigned short bf16_t;
typedef short bf16x8 __attribute__((ext_vector_type(8)));
typedef float f32x4 __attribute__((ext_vector_type(4)));
typedef unsigned u32x4 __attribute__((ext_vector_type(4)));
constexpr int BM = 256, BK = 64, HALF = 128, HTB = HALF * BK * 2  , STAGE_BYTES = 8 * HTB, NXCD = 8, WGM = 8;

__host__ __device__ __forceinline__ int lds_byte(int r, int c) { const int st = (r >> 4) * 2 + (c >> 5), rr = r & 15, cc = c & 31, ob = rr * 64 + cc * 2; return st * 1024 + (ob ^ (((ob >> 9) & 1) << 5)); }
__host__ __device__ __forceinline__ void stage_rc(int b, int& R, int& C) { const int st = b / 1024, sb = b % 1024, swz = sb ^ (((sb >> 9) & 1) << 5); R = (st >> 1) * 16 + swz / 64; C = (st & 1) * 32 + (swz % 64) / 2; }
__host__ __device__ __forceinline__ int perm32(int rho) { const int n = rho >> 4, i = rho & 15; return 8 * (i >> 2) + 4 * n + (i & 3); }

struct Unit { int pm, pn; };
struct Gemm { const bf16_t* A; const bf16_t* Bt; int M, N, K; };

struct StaticOrder {
    int nM, nN, nwg, G, c;
    __host__ __device__ void init(int M, int N, int G_, int c_) { nM = M / BM; nN = N / BM; nwg = nM * nN; G = G_; c = c_; }
    __host__ __device__ bool next(int i, Unit& u) const {
        const long L = (long)i * G + c; if (L >= nwg) return false;
        int wgid = (int)L; { const int q = nwg / NXCD, r = nwg % NXCD, xcd = wgid % NXCD, off = wgid / NXCD; wgid = (xcd < r ? xcd * (q + 1) : r * (q + 1) + (xcd - r) * q) + off; }
        const int nig = WGM * nN, gid = wgid / nig, fm = gid * WGM, gsz = (nM - fm) < WGM ? (nM - fm) : WGM;
        u.pm = fm + ((wgid % nig) % gsz); u.pn = (wgid % nig) / gsz; return true;
    }
    __device__ __forceinline__ void a_ready(const Unit&) const {}
    __device__ __forceinline__ void done(const Unit&) const {}
};

typedef float f32x2c_t __attribute__((ext_vector_type(2))); typedef __bf16 bf16x2c_t __attribute__((ext_vector_type(2)));
__device__ __forceinline__ unsigned cvt_pk_bf16(float lo, float hi) { f32x2c_t v = {lo, hi}; bf16x2c_t b = __builtin_convertvector(v, bf16x2c_t); return __builtin_bit_cast(unsigned, b); }
typedef float f32x2 __attribute__((ext_vector_type(2)));
__device__ __forceinline__ f32x2 gelu_pk(f32x2 v) {
    const f32x2 av = __builtin_elementwise_abs(v), d = av * 0.2316418882f + 1.0f;
    f32x2 t; t.x = __builtin_amdgcn_rcpf(d.x); t.y = __builtin_amdgcn_rcpf(d.y);
    f32x2 q = t * 0.5307027145f + (-0.7265760135f); q = q * t + 0.7107068705f; q = q * t + (-0.142248368f); q = q * t + 0.127414796f; q = q * t;
    const f32x2 s = (v * v) * (-0.72134752044f);
    f32x2 e; e.x = __builtin_amdgcn_exp2f(s.x); e.y = __builtin_amdgcn_exp2f(s.y);
    const f32x2 m = v * (q * e), r = v - m;
    f32x2 o; o.x = v.x < 0.f ? m.x : r.x; o.y = v.y < 0.f ? m.y : r.y; return o;
}

template <int ACT  > struct EpiBf16 {
    static constexpr int MIDK = 0; static constexpr bool PERM = true, AFTER_DRAIN = false; static_assert(ACT == 0 || ACT == 1, "EpiBf16: ACT is 0 (none) or 1 (gelu_pk)");
    bf16_t* O; int ldc; const float* bias; int split_cols; size_t split_stride; float scale0;
    __device__ __forceinline__ void operator()(const f32x4 (&acc)[2][2][4][2], const Unit& u, int wr, int wc, int fr, int fq) const {
        const int row0 = u.pm * BM + wr * 64 + fr; int colt = u.pn * BM; bf16_t* base = O;
        float sc = 1.f; if (split_cols) { const int t = colt / split_cols; base += (size_t)t * split_stride; colt -= t * split_cols; if (t == 0) sc = scale0; }
        const int col0 = colt + wc * 32 + 8 * fq, bcol0 = u.pn * BM + wc * 32 + 8 * fq;
        f32x4 bv[2][2];
#pragma unroll
        for (int bj = 0; bj < 2; ++bj)
#pragma unroll
            for (int n = 0; n < 2; ++n) bv[bj][n] = bias ? *(const f32x4*)(bias + bcol0 + bj * HALF + 4 * n) : (f32x4){0.f, 0.f, 0.f, 0.f};
#pragma unroll
        for (int ai = 0; ai < 2; ++ai)
#pragma unroll
            for (int m = 0; m < 4; ++m) { bf16_t* rowp = base + (size_t)(row0 + ai * HALF + m * 16) * ldc + col0;
#pragma unroll
                for (int bj = 0; bj < 2; ++bj) { f32x4 v0 = acc[ai][bj][m][0] + bv[bj][0], v1 = acc[ai][bj][m][1] + bv[bj][1];
                    if (ACT == 1) { f32x2 a = gelu_pk((f32x2){v0[0], v0[1]}), b = gelu_pk((f32x2){v0[2], v0[3]}), c = gelu_pk((f32x2){v1[0], v1[1]}), d = gelu_pk((f32x2){v1[2], v1[3]});
                        v0 = (f32x4){a.x, a.y, b.x, b.y}; v1 = (f32x4){c.x, c.y, d.x, d.y}; }
                    v0 = v0 * sc; v1 = v1 * sc; u32x4 w; w.x = cvt_pk_bf16(v0[0], v0[1]); w.y = cvt_pk_bf16(v0[2], v0[3]); w.z = cvt_pk_bf16(v1[0], v1[1]); w.w = cvt_pk_bf16(v1[2], v1[3]);
                    *(u32x4*)(rowp + bj * HALF) = w; } }
    }
};
typedef unsigned u32x2 __attribute__((ext_vector_type(2)));
__device__ __forceinline__ float bf_lo(unsigned w) { return __builtin_bit_cast(float, w << 16); }
__device__ __forceinline__ float bf_hi(unsigned w) { return __builtin_bit_cast(float, w & 0xffff0000u); }
__device__ __forceinline__ u32x4 pack8(f32x4 v0, f32x4 v1) { u32x4 w; w.x = cvt_pk_bf16(v0[0], v0[1]); w.y = cvt_pk_bf16(v0[2], v0[3]); w.z = cvt_pk_bf16(v1[0], v1[1]); w.w = cvt_pk_bf16(v1[2], v1[3]); return w; }
__device__ __forceinline__ float sigmoidf_(float x) { return __builtin_amdgcn_rcpf(1.0f + __expf(-x)); }
template <class F> struct EpiRow8 {
    static constexpr int MIDK = 0; static constexpr bool PERM = true, AFTER_DRAIN = false;
    F f;
    __device__ __forceinline__ void operator()(const f32x4 (&acc)[2][2][4][2], const Unit& u, int wr, int wc, int fr, int fq) const {
        const int row0 = u.pm * BM + wr * 64 + fr, c0 = wc * 32 + 8 * fq;
#pragma unroll
        for (int ai = 0; ai < 2; ++ai)
#pragma unroll
            for (int m = 0; m < 4; ++m) { const int row = row0 + ai * HALF + m * 16;
#pragma unroll
                for (int bj = 0; bj < 2; ++bj) { f(u.pn, row, c0 + bj * HALF, acc[ai][bj][m][0], acc[ai][bj][m][1]); if (F::FENCE) asm volatile("" ::: "memory"); } }
    }
};
constexpr float ATT_C2 = 0.125f * 1.4426950408889634f;
struct FProj {
    static constexpr bool FENCE = false;
    unsigned char* ws; bf16_t* GATES;
    __device__ __forceinline__ void operator()(int pn, int row, int cu, f32x4 v0, f32x4 v1) const {
        if (pn < 4) {
            const int sh = cu >> 6, j = (cu & 63) >> 3, pos = row & 2047;
            const f32x4 c = *(const f32x4*)((const float*)(ws + WS_ROPE_C) + pos * 32 + 4 * j), s = *(const f32x4*)((const float*)(ws + WS_ROPE_S) + pos * 32 + 4 * j);
            const float sc = pn < 2 ? ATT_C2 : 1.0f;
            const f32x4 o1 = (v0 * c - v1 * s) * sc, o2 = (v1 * c + v0 * s) * sc;
            bf16_t* dst = (bf16_t*)(ws + (pn < 2 ? WS_Q : WS_K)) + (size_t)row * 512 + (pn & 1) * 256 + sh * 64 + 4 * j;
            u32x2 w1, w2; w1.x = cvt_pk_bf16(o1[0], o1[1]); w1.y = cvt_pk_bf16(o1[2], o1[3]); w2.x = cvt_pk_bf16(o2[0], o2[1]); w2.y = cvt_pk_bf16(o2[2], o2[3]);
            *(u32x2*)dst = w1; *(u32x2*)(dst + 32) = w2;
        } else if (pn < 13) {
            size_t off; int pitch, col;
            if (pn < 6) { off = WS_V; pitch = 512; col = (pn - 4) * 256; }
            else if (pn < 12) { off = WS_RKV; pitch = 1536; col = (pn - 6) * 256; }
            else { off = WS_WAG; pitch = 256; col = 0; }
            *(u32x4*)((bf16_t*)(ws + off) + (size_t)row * pitch + col + cu) = pack8(v0, v1);
        } else *(u32x4*)(GATES + (size_t)row * 2048 + (pn - 13) * 256 + cu) = pack8(v0, v1);
    }
};
struct FLora {
    static constexpr bool FENCE = false;
    unsigned char* ws; const float *w0, *a0;
    __device__ __forceinline__ void operator()(int pn, int row, int cu, f32x4 v0, f32x4 v1) const {
        const int c = (pn & 1) * 256 + cu;
        if (pn < 2) {
            const f32x4 b0 = *(const f32x4*)(w0 + c), b1 = *(const f32x4*)(w0 + c + 4);
            float* dst = (float*)(ws + WS_DEC) + (size_t)row * 512 + c; *(f32x4*)dst = v0 + b0; *(f32x4*)(dst + 4) = v1 + b1;
        } else if (pn < 4) {
            const f32x4 b0 = *(const f32x4*)(a0 + c), b1 = *(const f32x4*)(a0 + c + 4);
            *(u32x4*)((bf16_t*)(ws + WS_AA) + (size_t)row * 512 + c) = pack8(v0 + b0, v1 + b1);
        } else *(u32x4*)((bf16_t*)(ws + WS_GG) + (size_t)row * 512 + c) = pack8(v0, v1);
    }
};
struct FProjOff {
    static constexpr bool FENCE = false;
    FProj f; int off;
    __device__ __forceinline__ void operator()(int pn, int row, int cu, f32x4 v0, f32x4 v1) const { f(pn + off, row, cu, v0, v1); }
};
struct FLoraG {
    static constexpr bool FENCE = false;
    unsigned char* ws;
    __device__ __forceinline__ void operator()(int pn, int row, int cu, f32x4 v0, f32x4 v1) const { *(u32x4*)((bf16_t*)(ws + WS_GG) + (size_t)row * 512 + pn * 256 + cu) = pack8(v0, v1); }
};
struct EpiMerge {
    static constexpr int MIDK = 8; static constexpr bool PERM = true, AFTER_DRAIN = false;
    const bf16_t* GATES; bf16_t* MERGED;
    static __device__ __forceinline__ float ratio_(float ga, float gb) { return (1.0f + __expf(-gb)) * __builtin_amdgcn_rcpf(1.0f + __expf(-ga)); }
    __device__ __forceinline__ void mid(f32x4 (&acc)[2][2][4][2], const Unit& u, int wr, int wc, int fr, int fq) const {
        int fr_ = fr; asm volatile("" : "+v"(fr_));
        const bf16_t* gp0 = GATES + (size_t)(u.pm * BM + wr * 64 + fr_) * 2048 + u.pn * BM + wc * 32 + 8 * fq;
#pragma unroll
        for (int ai = 0; ai < 2; ++ai)
#pragma unroll
            for (int m = 0; m < 4; ++m)
#pragma unroll
                for (int bj = 0; bj < 2; ++bj) { const bf16_t* gp = gp0 + (size_t)(ai * HALF + m * 16) * 2048 + bj * HALF;
                    const u32x4 ga = *(const u32x4*)gp, gb = *(const u32x4*)(gp + 1024);
                    f32x4& v0 = acc[ai][bj][m][0]; f32x4& v1 = acc[ai][bj][m][1];
                    v0[0] *= ratio_(bf_lo(ga.x), bf_lo(gb.x)); v0[1] *= ratio_(bf_hi(ga.x), bf_hi(gb.x)); v0[2] *= ratio_(bf_lo(ga.y), bf_lo(gb.y)); v0[3] *= ratio_(bf_hi(ga.y), bf_hi(gb.y));
                    v1[0] *= ratio_(bf_lo(ga.z), bf_lo(gb.z)); v1[1] *= ratio_(bf_hi(ga.z), bf_hi(gb.z)); v1[2] *= ratio_(bf_lo(ga.w), bf_lo(gb.w)); v1[3] *= ratio_(bf_hi(ga.w), bf_hi(gb.w));
                    asm volatile("" ::: "memory"); }
    }
    __device__ __forceinline__ void operator()(const f32x4 (&acc)[2][2][4][2], const Unit& u, int wr, int wc, int fr, int fq) const {
        const int row0 = u.pm * BM + wr * 64 + fr, c0 = u.pn * BM + wc * 32 + 8 * fq;
#pragma unroll
        for (int ai = 0; ai < 2; ++ai)
#pragma unroll
            for (int m = 0; m < 4; ++m) { const int row = row0 + ai * HALF + m * 16;
#pragma unroll
                for (int bj = 0; bj < 2; ++bj) { const u32x4 g = *(const u32x4*)(GATES + (size_t)row * 2048 + 1024 + c0 + bj * HALF);
                    f32x4 v0 = acc[ai][bj][m][0], v1 = acc[ai][bj][m][1];
                    v0[0] *= sigmoidf_(bf_lo(g.x)); v0[1] *= sigmoidf_(bf_hi(g.x)); v0[2] *= sigmoidf_(bf_lo(g.y)); v0[3] *= sigmoidf_(bf_hi(g.y));
                    v1[0] *= sigmoidf_(bf_lo(g.z)); v1[1] *= sigmoidf_(bf_hi(g.z)); v1[2] *= sigmoidf_(bf_lo(g.w)); v1[3] *= sigmoidf_(bf_hi(g.w));
                    *(u32x4*)(MERGED + (size_t)row * 1024 + c0 + bj * HALF) = pack8(v0, v1); } }
    }
};
struct FRes {
    static constexpr bool FENCE = false;
    const float* base; float* out;
    __device__ __forceinline__ void operator()(int pn, int row, int cu, f32x4 v0, f32x4 v1) const {
        const size_t off = (size_t)row * 1024 + pn * 256 + cu; const f32x4 b0 = *(const f32x4*)(base + off), b1 = *(const f32x4*)(base + off + 4);
        *(f32x4*)(out + off) = b0 + v0; *(f32x4*)(out + off + 4) = b1 + v1;
    }
};
struct FRelu2 {
    static constexpr bool FENCE = false;
    bf16_t* H;
    __device__ __forceinline__ void operator()(int pn, int row, int cu, f32x4 v0, f32x4 v1) const {
        f32x4 r0, r1;
#pragma unroll
        for (int e = 0; e < 4; ++e) { const float a = __builtin_fmaxf(v0[e], 0.f), b = __builtin_fmaxf(v1[e], 0.f); r0[e] = a * a; r1[e] = b * b; }
        *(u32x4*)(H + (size_t)row * 4096 + pn * 256 + cu) = pack8(r0, r1);
    }
};

__device__ __forceinline__ float xsum_fq(float x) {
    { auto r = __builtin_amdgcn_permlane16_swap(__builtin_bit_cast(unsigned, x), __builtin_bit_cast(unsigned, x), false, false); const unsigned a = r[0], b = r[1]; x = __builtin_bit_cast(float, a) + __builtin_bit_cast(float, b); }
    { auto r = __builtin_amdgcn_permlane32_swap(__builtin_bit_cast(unsigned, x), __builtin_bit_cast(unsigned, x), false, false); const unsigned a = r[0], b = r[1]; x = __builtin_bit_cast(float, a) + __builtin_bit_cast(float, b); }
    return x;
}
template <int MODE> struct EpiResNorm {
    static constexpr int MIDK = 0; static constexpr bool PERM = true, AFTER_DRAIN = false;
    const float* base; float* out; bf16_t* xn; const float* g; float* ss; unsigned* cnt; float eps; bf16_t* x1b;
    __device__ __forceinline__ void operator()(f32x4 (&acc)[2][2][4][2], const Unit& u, int wr, int wc, int fr, int fq) const {
        const int row0 = u.pm * BM + wr * 64 + fr, c0 = u.pn * BM + wc * 32 + 8 * fq;
#pragma unroll
        for (int ai = 0; ai < 2; ++ai)
#pragma unroll
            for (int m = 0; m < 4; ++m) { const int row = row0 + ai * HALF + m * 16; float s = 0.f;
#pragma unroll
                for (int bj = 0; bj < 2; ++bj) { const size_t off = (size_t)row * 1024 + c0 + bj * HALF; f32x4 b0, b1;
                    if (MODE == 0) { b0 = *(const f32x4*)(base + off); b1 = *(const f32x4*)(base + off + 4); }
                    else { const u32x4 w = *(const u32x4*)(x1b + off); b0 = (f32x4){bf_lo(w.x), bf_hi(w.x), bf_lo(w.y), bf_hi(w.y)}; b1 = (f32x4){bf_lo(w.z), bf_hi(w.z), bf_lo(w.w), bf_hi(w.w)}; }
                    f32x4& v0 = acc[ai][bj][m][0]; f32x4& v1 = acc[ai][bj][m][1]; v0 += b0; v1 += b1;
                    if (MODE == 0) *(u32x4*)(x1b + off) = pack8(v0, v1);
                    s += (v0[0] * v0[0] + v0[1] * v0[1]) + (v0[2] * v0[2] + v0[3] * v0[3]) + (v1[0] * v1[0] + v1[1] * v1[1]) + (v1[2] * v1[2] + v1[3] * v1[3]); }
                s = xsum_fq(s);
                if (fq == 0) __hip_atomic_fetch_add(ss + row, s, __ATOMIC_RELAXED, __HIP_MEMORY_SCOPE_AGENT);
                if (m & 1) asm volatile("" ::: "memory"); }
        asm volatile("s_waitcnt vmcnt(0)" ::: "memory");
        unsigned* c_ = cnt + 64 * u.pm;
        if (fr == 0 && fq == 0) __hip_atomic_fetch_add(c_, 1u, __ATOMIC_RELAXED, __HIP_MEMORY_SCOPE_AGENT);
        { unsigned spins = 0; while ((unsigned)__builtin_amdgcn_readfirstlane(__hip_atomic_load(c_, __ATOMIC_RELAXED, __HIP_MEMORY_SCOPE_AGENT)) < 32u && ++spins < (1u << 22)) __builtin_amdgcn_s_sleep(2); }
        asm volatile("" ::: "memory");
#pragma unroll
        for (int ai = 0; ai < 2; ++ai)
#pragma unroll
            for (int m = 0; m < 4; ++m) { const int row = row0 + ai * HALF + m * 16;
                const float rstd = 1.0f / sqrtf(__hip_atomic_load(ss + row, __ATOMIC_RELAXED, __HIP_MEMORY_SCOPE_AGENT) * (1.0f / 1024.0f) + eps);
#pragma unroll
                for (int bj = 0; bj < 2; ++bj) { const size_t off = (size_t)row * 1024 + c0 + bj * HALF; const f32x4 g0 = *(const f32x4*)(g + c0 + bj * HALF), g1 = *(const f32x4*)(g + c0 + bj * HALF + 4);
                    const f32x4 o0 = acc[ai][bj][m][0] * rstd * g0, o1 = acc[ai][bj][m][1] * rstd * g1;
                    if (MODE == 0) *(u32x4*)(xn + off) = pack8(o0, o1); else { *(f32x4*)(out + off) = o0; *(f32x4*)(out + off + 4) = o1; } }
                if (m & 1) asm volatile("" ::: "memory"); }
    }
};

struct PanelOrder {
    int pm, ntiles;
    __device__ __forceinline__ bool next(int i, Unit& u) const { if (i >= ntiles) return false; int p = pm; asm volatile("" : "+s"(p)); u.pm = p; u.pn = i; return true; }
    __device__ __forceinline__ void a_ready(const Unit&) const {}
    __device__ __forceinline__ void done(const Unit&) const {}
};
template <class Epi, class Sched, bool ALIGN_EPI = false, bool SP2 = false>
__device__ __forceinline__ void gemm_phase(PG8_LAS unsigned char* lds, const Gemm g, const Sched& S, const Epi& E) {
    int tid_ = threadIdx.x; asm volatile("" : "+v"(tid_));
    const int tid = tid_, wid = __builtin_amdgcn_readfirstlane(tid >> 6), lane = tid & 63, wr = wid >> 2, wc = wid & 3, fr = lane & 15, fq = lane >> 4;
    const int K = g.K, nt = K / BK;
    unsigned voffA[2], voffB[2];
#pragma unroll
    for (int i = 0; i < 2; ++i) { int R, C; stage_rc(tid * 16 + i * 8192, R, C); const int Rb = Epi::PERM ? ((R & ~31) + perm32(R & 31)) : R;
        voffA[i] = (unsigned)(R * K + C) * 2u; voffB[i] = (unsigned)(Rb * K + C) * 2u; }
    const size_t kstep = (size_t)(BK * 2);
    const size_t hstep = (size_t)HALF * K * 2;
    const size_t tstep = 2 * hstep;
    const unsigned ldsw = (unsigned)wid * 1024u;
    const int aoff = lds_byte(wr * 64 + fr, fq * 8), boff = lds_byte(wc * 32 + fr, fq * 8);
#define PG8_SA(b, h) (((b) * 2 + (h)) * HTB)
#define PG8_SB(b, h) ((4 + (b) * 2 + (h)) * HTB)
#define PG8_STAGE(bufoff, gbase, voff) do { _Pragma("unroll") for (int _i = 0; _i < 2; ++_i) \
        __builtin_amdgcn_global_load_lds((const unsigned*)((const char*)(gbase) + (voff)[_i]), (PG8_LAS unsigned*)(lds + (bufoff) + ldsw + _i * 8192), 16, 0, 0); } while (0)
#define PG8_LDA(dst, b, h) do { _Pragma("unroll") for (int m = 0; m < 4; ++m) _Pragma("unroll") for (int k = 0; k < 2; ++k) dst[m][k] = *(const PG8_LAS bf16x8*)(lds + PG8_SA(b, h) + aoff + m * 2048 + k * 1024); } while (0)
#define PG8_LDB(dst, b, h) do { _Pragma("unroll") for (int n = 0; n < 2; ++n) _Pragma("unroll") for (int k = 0; k < 2; ++k) dst[n][k] = *(const PG8_LAS bf16x8*)(lds + PG8_SB(b, h) + boff + n * 2048 + k * 1024); } while (0)
#define PG8_MMA(ai, bj, At, Bt) do { __builtin_amdgcn_s_setprio(1); _Pragma("unroll") for (int m = 0; m < 4; ++m) _Pragma("unroll") for (int n = 0; n < 2; ++n) _Pragma("unroll") for (int k = 0; k < 2; ++k) \
        acc[ai][bj][m][n] = __builtin_amdgcn_mfma_f32_16x16x32_bf16(Bt[n][k], At[m][k], acc[ai][bj][m][n], 0, 0, 0); __builtin_amdgcn_s_setprio(0); } while (0)
#define PG8_WAIT_V(n) asm volatile("s_waitcnt vmcnt(" #n ")" ::: "memory")
#define PG8_WAIT_L(n) asm volatile("s_waitcnt lgkmcnt(" #n ")" ::: "memory")
#define PG8_BAR __builtin_amdgcn_s_barrier()
#define PG8_SCHED __builtin_amdgcn_sched_barrier(0)
    Unit cur, nxt; int ui = 0;
    if (!S.next(0, cur)) return;
    f32x4 acc[2][2][4][2];
#pragma unroll
    for (int a = 0; a < 2; ++a)
#pragma unroll
        for (int b = 0; b < 2; ++b)
#pragma unroll
            for (int m = 0; m < 4; ++m)
#pragma unroll
                for (int n = 0; n < 2; ++n) acc[a][b][m][n] = (f32x4){0.f, 0.f, 0.f, 0.f};
    bf16x8 At[4][2], B0[2][2], B1[2][2];
    const char* cA = (const char*)g.A + (size_t)cur.pm * tstep; const char* cB = (const char*)g.Bt + (size_t)cur.pn * tstep;
    S.a_ready(cur);
    if constexpr (SP2) {
        PG8_STAGE(PG8_SB(0, 0), cB, voffB); PG8_STAGE(PG8_SB(0, 1), cB + hstep, voffB); PG8_STAGE(PG8_SA(0, 0), cA, voffA); PG8_STAGE(PG8_SA(0, 1), cA + hstep, voffA);
        if (wr == 1) PG8_BAR;
        PG8_WAIT_V(2); PG8_BAR;
        PG8_STAGE(PG8_SB(1, 0), cB + kstep, voffB); PG8_STAGE(PG8_SA(1, 0), cA + kstep, voffA); PG8_STAGE(PG8_SB(1, 1), cB + hstep + kstep, voffB);
        PG8_WAIT_V(6); PG8_BAR;
    } else {
        PG8_STAGE(PG8_SB(0, 0), cB, voffB); PG8_STAGE(PG8_SA(0, 0), cA, voffA); PG8_STAGE(PG8_SB(0, 1), cB + hstep, voffB); PG8_STAGE(PG8_SA(0, 1), cA + hstep, voffA);
        if (wr == 1) PG8_BAR;
        PG8_WAIT_V(4); PG8_BAR;
        PG8_STAGE(PG8_SB(1, 0), cB + kstep, voffB); PG8_STAGE(PG8_SA(1, 0), cA + kstep, voffA); PG8_STAGE(PG8_SB(1, 1), cB + hstep + kstep, voffB);
        PG8_WAIT_V(6); PG8_BAR;
    }
    for (;;) {
        const bool has_next = S.next(ui + 1, nxt);
        const char* nA = has_next ? (const char*)g.A + (size_t)nxt.pm * tstep : cA; const char* nB = has_next ? (const char*)g.Bt + (size_t)nxt.pn * tstep : cB;
        for (int t = 0; t < nt; t += 2) {
            if constexpr (Epi::MIDK > 0) { if (t == Epi::MIDK) E.mid(acc, cur, wr, wc, fr, fq); }
            const bool last = (t == nt - 2);
            const char* a1 = cA + (size_t)(t + 1) * kstep;
            const char* a2 = last ? nA : cA + (size_t)(t + 2) * kstep; const char* b2 = last ? nB : cB + (size_t)(t + 2) * kstep;
            const char* a3 = a2 + kstep; const char* b3 = b2 + kstep;
            if (last && has_next) S.a_ready(nxt);
            if constexpr (SP2) {
            PG8_LDB(B0, 0, 0); PG8_LDB(B1, 0, 1); PG8_SCHED; PG8_LDA(At, 0, 0); PG8_STAGE(PG8_SA(1, 1), a1 + hstep, voffA);
            PG8_WAIT_V(8); PG8_WAIT_L(0); PG8_BAR; PG8_MMA(0, 0, At, B0); PG8_MMA(0, 1, At, B1); PG8_BAR; PG8_SCHED;
            PG8_LDA(At, 0, 1); PG8_STAGE(PG8_SB(0, 0), b2, voffB); PG8_STAGE(PG8_SB(0, 1), b2 + hstep, voffB); PG8_STAGE(PG8_SA(0, 0), a2, voffA);
            PG8_WAIT_V(8); PG8_WAIT_L(0); PG8_BAR; PG8_MMA(1, 0, At, B0); PG8_MMA(1, 1, At, B1); PG8_BAR; PG8_SCHED;
            PG8_LDB(B0, 1, 0); PG8_LDB(B1, 1, 1); PG8_SCHED; PG8_LDA(At, 1, 0); PG8_STAGE(PG8_SA(0, 1), a2 + hstep, voffA);
            PG8_WAIT_V(8); PG8_WAIT_L(0); PG8_BAR; PG8_MMA(0, 0, At, B0); PG8_MMA(0, 1, At, B1); PG8_BAR; PG8_SCHED;
            PG8_LDA(At, 1, 1); PG8_STAGE(PG8_SB(1, 0), b3, voffB); PG8_STAGE(PG8_SB(1, 1), b3 + hstep, voffB); PG8_STAGE(PG8_SA(1, 0), a3, voffA);
            PG8_WAIT_V(8); PG8_WAIT_L(0); PG8_BAR; PG8_MMA(1, 0, At, B0); PG8_MMA(1, 1, At, B1); PG8_BAR; PG8_SCHED;
            } else {
            PG8_LDB(B0, 0, 0); PG8_SCHED; PG8_LDA(At, 0, 0); PG8_STAGE(PG8_SA(1, 1), a1 + hstep, voffA);
            PG8_WAIT_L(8); PG8_BAR; PG8_WAIT_L(0); PG8_MMA(0, 0, At, B0); PG8_BAR; PG8_SCHED;
            PG8_LDB(B1, 0, 1); PG8_STAGE(PG8_SB(0, 0), b2, voffB);
            PG8_BAR; PG8_WAIT_L(0); PG8_MMA(0, 1, At, B1); PG8_BAR;
            PG8_LDA(At, 0, 1); PG8_STAGE(PG8_SA(0, 0), a2, voffA);
            PG8_BAR; PG8_WAIT_L(0); PG8_MMA(1, 0, At, B0); PG8_BAR; PG8_SCHED;
            PG8_STAGE(PG8_SB(0, 1), b2 + hstep, voffB);
            PG8_WAIT_V(6); PG8_BAR; PG8_MMA(1, 1, At, B1); PG8_BAR;
            PG8_LDB(B0, 1, 0); PG8_SCHED; PG8_LDA(At, 1, 0); PG8_STAGE(PG8_SA(0, 1), a2 + hstep, voffA);
            PG8_WAIT_L(8); PG8_BAR; PG8_WAIT_L(0); PG8_MMA(0, 0, At, B0); PG8_BAR; PG8_SCHED;
            PG8_LDB(B1, 1, 1); PG8_STAGE(PG8_SB(1, 0), b3, voffB);
            PG8_BAR; PG8_WAIT_L(0); PG8_MMA(0, 1, At, B1); PG8_BAR;
            PG8_LDA(At, 1, 1); PG8_STAGE(PG8_SA(1, 0), a3, voffA);
            PG8_BAR; PG8_WAIT_L(0); PG8_MMA(1, 0, At, B0); PG8_BAR; PG8_SCHED;
            PG8_STAGE(PG8_SB(1, 1), b3 + hstep, voffB);
            PG8_WAIT_V(6); PG8_BAR; PG8_MMA(1, 1, At, B1); PG8_BAR;
            }
        }
        if constexpr (ALIGN_EPI) { if (wr == 0) PG8_BAR; }
        if constexpr (!Epi::AFTER_DRAIN) { E(acc, cur, wr, wc, fr, fq); S.done(cur); }
        if (!has_next) break;
#pragma unroll
        for (int a = 0; a < 2; ++a)
#pragma unroll
            for (int b = 0; b < 2; ++b)
#pragma unroll
                for (int m = 0; m < 4; ++m)
#pragma unroll
                    for (int n = 0; n < 2; ++n) acc[a][b][m][n] = (f32x4){0.f, 0.f, 0.f, 0.f};
        cur = nxt; cA = nA; cB = nB; ++ui;
        if constexpr (ALIGN_EPI) { if (wr == 1) PG8_BAR; }
    }
    PG8_WAIT_V(0);
    if constexpr (!ALIGN_EPI) { if (wr == 0) PG8_BAR; }
    PG8_BAR;
    if constexpr (Epi::AFTER_DRAIN) { E.fused(acc, cur, wr, wc, fr, fq, lds, wid, lane); S.done(cur); }
#undef PG8_SA
#undef PG8_SB
#undef PG8_STAGE
#undef PG8_LDA
#undef PG8_LDB
#undef PG8_MMA
#undef PG8_WAIT_V
#undef PG8_WAIT_L
#undef PG8_BAR
#undef PG8_SCHED
}
}

#ifndef PG8_SP2
#define PG8_SP2 true
#endif
#ifndef PG8_ALIGN
#define PG8_ALIGN true
#endif
#include <hip/hip_bf16.h>
#include <cmath>
namespace attn_body {
using bf16=__hip_bfloat16;
using bf16x8=__attribute__((ext_vector_type(8)))short;
using s16x4=__attribute__((ext_vector_type(4)))short;
using f32x16=__attribute__((ext_vector_type(16)))float;
using u32x4=__attribute__((ext_vector_type(4)))unsigned;
constexpr int SEQ=2048,D=64,QP=512,KP=512,VP=512,OP=1024;
constexpr int NW=8,QBLK=32,QB=QBLK*NW,KVBLK=64,NQB=SEQ/QB;
constexpr int ATTN_UNIT_ROWS=QB;
__device__ __forceinline__ int crow(int r,int hi){return (r&3)+8*(r>>2)+4*hi;}
#define SBAR() __builtin_amdgcn_sched_barrier(0)
__device__ __forceinline__ void cmask(f32x16&p0,f32x16&p1,int jb,int wchunk,int){
  if(jb>wchunk){ const float NEG=-INFINITY;
    #pragma unroll
    for(int r=0;r<16;++r){p0[r]=NEG;p1[r]=NEG;} }
}

constexpr int NSLOT=3, SLOTB=8192;
constexpr int LDS_K=0, LDS_V=NSLOT*SLOTB, LDS_WS=2*NSLOT*SLOTB, LDS_OST=LDS_WS+NW*64*4, LDS_BYTES=LDS_OST+NW*4096;
constexpr float C2=0.125f*1.4426950408889634f;
__device__ __forceinline__ void glds16(const void*gsrc,unsigned lds_dst){unsigned keep;
  asm volatile("s_mov_b32 %0, m0\n\ts_mov_b32 m0, %2\n\ts_nop 0\n\tglobal_load_lds_dwordx4 %1, off\n\ts_mov_b32 m0, %0":"=&s"(keep):"v"(gsrc),"s"(lds_dst):"memory");}
__device__ __forceinline__ float max3f(float a,float b,float c){float r;asm("v_max3_f32 %0, %1, %2, %3":"=v"(r):"v"(a),"v"(b),"v"(c));return r;}
__device__ __forceinline__ float max2f(float a,float b){float r;asm("v_max_f32_e32 %0, %1, %2":"=v"(r):"v"(a),"v"(b));return r;}
__device__ __forceinline__ float fadd_s(float a,float b){float r;asm("v_add_f32_e32 %0, %1, %2":"=v"(r):"v"(a),"v"(b));return r;}
__device__ __forceinline__ float fsub_s(float a,float b){float r;asm("v_sub_f32_e32 %0, %1, %2":"=v"(r):"v"(a),"v"(b));return r;}
typedef float f32x2_t __attribute__((ext_vector_type(2))); typedef __bf16 bf16x2_t __attribute__((ext_vector_type(2)));
__device__ __forceinline__ unsigned cvtpk_s(float lo,float hi){f32x2_t v={lo,hi};bf16x2_t b=__builtin_convertvector(v,bf16x2_t);return __builtin_bit_cast(unsigned,b);}
#define WAIT_BAR(N) asm volatile("s_waitcnt vmcnt(" #N ") lgkmcnt(0)\n\ts_barrier":::"memory")

__device__ __forceinline__ void qkt(f32x16&p0,f32x16&p1,const char*Kslot,const bf16x8*qr,const f32x16&negm,int r32,int hi){
  const char*kb=Kslot+hi*1024+r32*16;
  #pragma unroll
  for(int d0=0;d0<4;++d0){
    const bf16x8 b0=*reinterpret_cast<const bf16x8*>(kb+d0*2048);
    const bf16x8 b1=*reinterpret_cast<const bf16x8*>(kb+d0*2048+512);
    if(d0==0){p0=__builtin_amdgcn_mfma_f32_32x32x16_bf16(b0,qr[0],negm,0,0,0);p1=__builtin_amdgcn_mfma_f32_32x32x16_bf16(b1,qr[0],negm,0,0,0);}
    else{p0=__builtin_amdgcn_mfma_f32_32x32x16_bf16(b0,qr[d0],p0,0,0,0);p1=__builtin_amdgcn_mfma_f32_32x32x16_bf16(b1,qr[d0],p1,0,0,0);}}
}
typedef __attribute__((address_space(3))) const char* lds_cptr;
typedef short v4i16_t __attribute__((ext_vector_type(4)));
__device__ __forceinline__ void kload8(bf16x8*kf,lds_cptr kp){
  kf[0]=*(const __attribute__((address_space(3))) bf16x8*)(kp);      kf[1]=*(const __attribute__((address_space(3))) bf16x8*)(kp+512);
  kf[2]=*(const __attribute__((address_space(3))) bf16x8*)(kp+2048); kf[3]=*(const __attribute__((address_space(3))) bf16x8*)(kp+2560);
  kf[4]=*(const __attribute__((address_space(3))) bf16x8*)(kp+4096); kf[5]=*(const __attribute__((address_space(3))) bf16x8*)(kp+4608);
  kf[6]=*(const __attribute__((address_space(3))) bf16x8*)(kp+6144); kf[7]=*(const __attribute__((address_space(3))) bf16x8*)(kp+6656);
}
__device__ __forceinline__ void kload2(bf16x8*kf,lds_cptr kp,int j){ kf[2*j]=*(const __attribute__((address_space(3))) bf16x8*)(kp+j*2048); kf[2*j+1]=*(const __attribute__((address_space(3))) bf16x8*)(kp+j*2048+512); }
__device__ __forceinline__ s16x4 vtr(lds_cptr p){ return __builtin_bit_cast(s16x4,__builtin_amdgcn_ds_read_tr16_b64_v4i16((__attribute__((address_space(3))) v4i16_t*)p)); }
__device__ __forceinline__ float rowmax(const f32x16&p0,const f32x16&p1){
  float a=max3f(p0[0],p0[1],p1[0]),b=max3f(p0[2],p0[3],p1[1]);a=max3f(a,p1[2],p1[3]);
  #pragma unroll
  for(int r=4;r<16;r+=4){a=max3f(a,p0[r],p0[r+1]);b=max3f(b,p0[r+2],p0[r+3]);a=max3f(a,p1[r],p1[r+1]);b=max3f(b,p1[r+2],p1[r+3]);}
  const float m=max2f(a,b);
  auto rr=__builtin_amdgcn_permlane32_swap(__float_as_uint(m),__float_as_uint(m),false,false);
  return max2f(__uint_as_float(rr[0]),__uint_as_float(rr[1]));
}
__device__ __forceinline__ void pv(f32x16*o,int vb,bf16x8 pa0,bf16x8 pa1,bf16x8 pa2,bf16x8 pa3){
  #pragma unroll
  for(int d0=0;d0<2;++d0){s16x4 lo[4],hi[4];
    #pragma unroll
    for(int ks=0;ks<4;++ks){
      asm volatile("ds_read_b64_tr_b16 %0,%1 offset:%c2":"=&v"(lo[ks]):"v"(vb),"i"(d0*4096+ks*1024):"memory");
      asm volatile("ds_read_b64_tr_b16 %0,%1 offset:%c2":"=&v"(hi[ks]):"v"(vb),"i"(d0*4096+ks*1024+512):"memory");}
    asm volatile("s_waitcnt lgkmcnt(0)":::"memory");SBAR();
    #define PK(k) (bf16x8){lo[k][0],lo[k][1],lo[k][2],lo[k][3],hi[k][0],hi[k][1],hi[k][2],hi[k][3]}
    o[d0]=__builtin_amdgcn_mfma_f32_32x32x16_bf16(pa0,PK(0),o[d0],0,0,0);
    o[d0]=__builtin_amdgcn_mfma_f32_32x32x16_bf16(pa1,PK(1),o[d0],0,0,0);
    o[d0]=__builtin_amdgcn_mfma_f32_32x32x16_bf16(pa2,PK(2),o[d0],0,0,0);
    o[d0]=__builtin_amdgcn_mfma_f32_32x32x16_bf16(pa3,PK(3),o[d0],0,0,0);
    #undef PK
  }
}

#ifndef ATTN_STORE16
#define ATTN_STORE16(p,v) (*(u32x4*)(p)=(v))
#endif
template<int THRL> __device__ __forceinline__ void attn_unit(int b,int qcol,int kcol,int vcol,int ocol,int qb,const bf16*Q,const bf16*__restrict__ K,const bf16*__restrict__ V,bf16*O,char*shm){
  int tid_=threadIdx.x; asm volatile("":"+v"(tid_));
  const int tid=tid_,lane=tid&63,r32=lane&31,hi=lane>>5; const int wid=__builtin_amdgcn_readfirstlane(tid>>6);
  const long rowbase=(long)b*SEQ; const int q0=qb*QB;
  const bf16*Qw=Q+(rowbase+q0+wid*QBLK)*QP+qcol;
  const bf16*Kh=K+rowbase*KP+kcol,*Vh=V+rowbase*VP+vcol;
  const unsigned lds0=(unsigned)(uintptr_t)shm;
  float*wsf=(float*)(shm+LDS_WS)+wid*64;
  const bf16*ksrc=Kh+(long)lane*KP+wid*8;
  const bf16*vsrc=Vh+(long)(16*(wid&3)+(lane>>2))*VP+(wid>>2)*32+(lane&3)*8;
  const unsigned kdst=lds0+LDS_K+wid*1024, vdst=lds0+LDS_V+wid*1024;
  #define DMA_K(t,slot) glds16(ksrc+(long)(t)*KVBLK*KP,(unsigned)__builtin_amdgcn_readfirstlane(kdst+(slot)))
  #define DMA_V(t,slot) glds16(vsrc+(long)(t)*KVBLK*VP,(unsigned)__builtin_amdgcn_readfirstlane(vdst+(slot)))
  const int vb0=(int)(lds0+LDS_V)+((lane>>4)&1)*32+(lane&3)*8+(4*hi+((lane&15)>>2))*64;
  const char*Kbase=shm+LDS_K; bf16x8 kf[8];
  const lds_cptr shm3=(lds_cptr)shm; const lds_cptr kp0=shm3+LDS_K+hi*1024+r32*16; const lds_cptr vp0=shm3+LDS_V+((lane>>4)&1)*32+(lane&3)*8+(4*hi+((lane&15)>>2))*64;
  const int NT=(q0+QB)/KVBLK;
  DMA_K(0,0);DMA_V(0,0);DMA_K(1,SLOTB);
  bf16x8 qr[4];
  #pragma unroll
  for(int d0=0;d0<4;++d0)qr[d0]=*reinterpret_cast<const bf16x8*>(&Qw[(long)r32*QP+d0*16+hi*8]);
  float mhat=0.f,l_reg=0.f;f32x16 o[2];o[0]=f32x16{};o[1]=f32x16{};f32x16 negm=f32x16{};asm volatile("":"+v"(negm));
  const int qrel=wid>>1;
  #define CMASK(P0,P1,t) do{int jb_=(t)-(NT-4); if(jb_>=0)cmask(P0,P1,jb_,qrel,hi);}while(0)
  bool resc=false;
  #define START(P0,P1) do{ const float rm=rowmax(P0,P1); resc=false; \
    { const float dl=rm; mhat=fadd_s(mhat,dl); \
      _Pragma("unroll") for(int r=0;r<16;++r){P0[r]=fsub_s(P0[r],dl);P1[r]=fsub_s(P1[r],dl);} \
      _Pragma("unroll") for(int r=0;r<16;++r)negm[r]=-mhat; asm volatile("":"+v"(negm)); } \
    _Pragma("unroll") for(int r=0;r<16;++r)P0[r]=__builtin_amdgcn_exp2f(P0[r]); }while(0)
  #define RESC() do{ if(resc){ asm volatile("s_waitcnt lgkmcnt(0)":::"memory"); \
      _Pragma("unroll") for(int d_=0;d_<2;++d_) _Pragma("unroll") for(int r=0;r<16;++r)o[d_][r]*=wsf[crow(r,hi)]; } }while(0)
  f32x16 pA0,pA1,pB0,pB1;
  int sl_prev=0,sl_cur=0,sl_next=SLOTB;
  #define ROT() do{sl_prev=sl_cur;sl_cur=sl_next;sl_next=(sl_next==(NSLOT-1)*SLOTB)?0:sl_next+SLOTB;}while(0)
  DMA_K(2,2*SLOTB);
  WAIT_BAR(3);
  qkt(pA0,pA1,Kbase,qr,negm,r32,hi);asm volatile("s_nop 15\n\ts_nop 7":"+v"(pA0),"+v"(pA1));CMASK(pA0,pA1,0);
  START(pA0,pA1);
  _Pragma("unroll") for(int r=0;r<16;++r)pA1[r]=__builtin_amdgcn_exp2f(pA1[r]);
  WAIT_BAR(0);
  DMA_K(3,0);DMA_V(1,SLOTB);
  ROT();
  kload8(kf,kp0+sl_cur);
  WAIT_BAR(2);
  s16x4 vlo[8],vhi[8]; u32x4 pw0,pw1,pw2,pw3;
  #define PKW(P,B) cvtpk_s(P[B],P[B+1])
  #define PAF(k) __builtin_bit_cast(bf16x8,pw##k)
  #define VFR(i) (bf16x8){vlo[i][0],vlo[i][1],vlo[i][2],vlo[i][3],vhi[i][0],vhi[i][1],vhi[i][2],vhi[i][3]}
  #define PIN(x) asm volatile("":"+v"(x))
  #define MX3(a,b,c) __builtin_fmaxf(__builtin_fmaxf((a),(b)),(c))
  #define GAPA(MF,A0,A1,A2,A3,W0,W1,PW) do{ MF; sacc+=A0; sacc+=A1; sacc+=A2; sacc+=A3; PIN(sacc); W0; W1; PIN(PW); SBAR(); }while(0)
  #define EX(v) __builtin_amdgcn_exp2f(v)
  #define GAPB(MF,X,B) do{ MF; X[B]=EX(X[B]); X[B+1]=EX(X[B+1]); X[B+2]=EX(X[B+2]); X[B+3]=EX(X[B+3]); PIN(X); SBAR(); }while(0)
  #define VRD(i) do{ vlo[i]=vtr(vp_+(((i)>>2)*4096+((i)&3)*1024)); vhi[i]=vtr(vp_+(((i)>>2)*4096+((i)&3)*1024+512)); }while(0)
  #define KRD(G,j) do{ if(G){ kload2(kf,kp0+sl_next,j); SBAR(); } }while(0)
  #define STEP(C0,C1,P0,P1,t,GK,GV,GL) do{ SBAR(); \
    const lds_cptr vp_=vp0+sl_prev; \
    VRD(0); SBAR(); float sacc=(P0[0]+P0[1]); \
    GAPA(C0=__builtin_amdgcn_mfma_f32_32x32x16_bf16(kf[0],qr[0],negm,0,0,0), P0[2],P0[3],P0[4],P0[5],     pw0[0]=PKW(P0,0), pw0[1]=PKW(P0,2), pw0); \
    VRD(4); SBAR(); GAPA(C1=__builtin_amdgcn_mfma_f32_32x32x16_bf16(kf[1],qr[0],negm,0,0,0), P0[6],P0[7],P0[8],P0[9],     pw0[2]=PKW(P0,4), pw0[3]=PKW(P0,6), pw0); \
    VRD(1); SBAR(); GAPA(C0=__builtin_amdgcn_mfma_f32_32x32x16_bf16(kf[2],qr[1],C0,0,0,0),   P0[10],P0[11],P0[12],P0[13], pw1[0]=PKW(P0,8), pw1[1]=PKW(P0,10), pw1); \
    VRD(5); SBAR(); GAPA(C1=__builtin_amdgcn_mfma_f32_32x32x16_bf16(kf[3],qr[1],C1,0,0,0),   P0[14],P0[15],P1[0],P1[1],   pw1[2]=PKW(P0,12),pw1[3]=PKW(P0,14), pw1); \
    VRD(2); SBAR(); GAPA(C0=__builtin_amdgcn_mfma_f32_32x32x16_bf16(kf[4],qr[2],C0,0,0,0),   P1[2],P1[3],P1[4],P1[5],     pw2[0]=PKW(P1,0), pw2[1]=PKW(P1,2), pw2); \
    VRD(6); SBAR(); GAPA(C1=__builtin_amdgcn_mfma_f32_32x32x16_bf16(kf[5],qr[2],C1,0,0,0),   P1[6],P1[7],P1[8],P1[9],     pw2[2]=PKW(P1,4), pw2[3]=PKW(P1,6), pw2); \
    VRD(3); SBAR(); GAPA(C0=__builtin_amdgcn_mfma_f32_32x32x16_bf16(kf[6],qr[3],C0,0,0,0),   P1[10],P1[11],P1[12],P1[13], pw3[0]=PKW(P1,8), pw3[1]=PKW(P1,10), pw3); \
    VRD(7); SBAR(); GAPA(C1=__builtin_amdgcn_mfma_f32_32x32x16_bf16(kf[7],qr[3],C1,0,0,0),   P1[14],P1[15],0.f,0.f,       pw3[2]=PKW(P1,12),pw3[3]=PKW(P1,14), pw3); \
    l_reg+=sacc; \
    if(GK){DMA_K((t)+3,sl_cur);} if(GV){DMA_V((t)+1,sl_next);} \
    CMASK(C0,C1,t); \
    { float a=MX3(C0[0],C0[1],C1[0]),b=MX3(C0[2],C0[3],C1[1]); a=MX3(a,C1[2],C1[3]); \
      _Pragma("unroll") for(int r=4;r<16;r+=4){a=MX3(a,C0[r],C0[r+1]);b=MX3(b,C0[r+2],C0[r+3]);a=MX3(a,C1[r],C1[r+1]);b=MX3(b,C1[r+2],C1[r+3]);} \
      float rm=__builtin_fmaxf(a,b); { auto rr=__builtin_amdgcn_permlane32_swap(__float_as_uint(rm),__float_as_uint(rm),false,false); rm=__builtin_fmaxf(__uint_as_float(rr[0]),__uint_as_float(rr[1])); } \
      resc=false; \
      if(__builtin_expect(__any(rm>(float)THRL),0)){ const float dl=__builtin_fmaxf(rm,0.f); mhat+=dl; \
        _Pragma("unroll") for(int r=0;r<16;++r){C0[r]-=dl;C1[r]-=dl;} \
        _Pragma("unroll") for(int r=0;r<16;++r)negm[r]=-mhat; asm volatile("":"+v"(negm)); \
        const float f=__builtin_amdgcn_exp2f(-dl); l_reg*=f; if(hi==0)wsf[r32]=f; resc=true; } } \
    SBAR(); \
    GAPB(o[0]=__builtin_amdgcn_mfma_f32_32x32x16_bf16(PAF(0),VFR(0),o[0],0,0,0), C0,0); \
    GAPB(o[1]=__builtin_amdgcn_mfma_f32_32x32x16_bf16(PAF(0),VFR(4),o[1],0,0,0), C0,4); \
    KRD(GL,0); GAPB(o[0]=__builtin_amdgcn_mfma_f32_32x32x16_bf16(PAF(1),VFR(1),o[0],0,0,0), C0,8); \
    KRD(GL,1); GAPB(o[1]=__builtin_amdgcn_mfma_f32_32x32x16_bf16(PAF(1),VFR(5),o[1],0,0,0), C0,12); \
    KRD(GL,2); GAPB(o[0]=__builtin_amdgcn_mfma_f32_32x32x16_bf16(PAF(2),VFR(2),o[0],0,0,0), C1,0); \
    KRD(GL,3); GAPB(o[1]=__builtin_amdgcn_mfma_f32_32x32x16_bf16(PAF(2),VFR(6),o[1],0,0,0), C1,4); \
    GAPB(o[0]=__builtin_amdgcn_mfma_f32_32x32x16_bf16(PAF(3),VFR(3),o[0],0,0,0), C1,8); \
    GAPB(o[1]=__builtin_amdgcn_mfma_f32_32x32x16_bf16(PAF(3),VFR(7),o[1],0,0,0), C1,12); \
    }while(0)
  int t=1;
  #undef CMASK
  #define CMASK(P0,P1,t) do{}while(0)
  for(;t+5<NT;t+=2){
    STEP(pB0,pB1,pA0,pA1,t,true,true,true);     WAIT_BAR(2); RESC(); ROT();
    STEP(pA0,pA1,pB0,pB1,t+1,true,true,true);   WAIT_BAR(2); RESC(); ROT();
  }
  #undef CMASK
  #define CMASK(P0,P1,t) do{int jb_=(t)-(NT-4); if(jb_>=0)cmask(P0,P1,jb_,qrel,hi);}while(0)
  #define ENDW(tt) do{ if((tt)+3<NT){WAIT_BAR(2);} else if((tt)+2<NT){WAIT_BAR(1);} else {WAIT_BAR(0);} }while(0)
  for(;t+1<NT;t+=2){
    STEP(pB0,pB1,pA0,pA1,t,(t+3<NT),(t+1<NT),(t+1<NT));       ENDW(t);   RESC(); ROT();
    STEP(pA0,pA1,pB0,pB1,t+1,(t+4<NT),(t+2<NT),(t+2<NT));     ENDW(t+1); RESC(); ROT();
  }
  STEP(pB0,pB1,pA0,pA1,NT-1,false,false,false); RESC();
  { float sacc=pB0[0]+pB0[1]; _Pragma("unroll") for(int r=2;r<16;++r)sacc+=pB0[r]; _Pragma("unroll") for(int r=0;r<16;++r)sacc+=pB1[r]; l_reg+=sacc;
    pw0=(u32x4){PKW(pB0,0),PKW(pB0,2),PKW(pB0,4),PKW(pB0,6)};pw1=(u32x4){PKW(pB0,8),PKW(pB0,10),PKW(pB0,12),PKW(pB0,14)};pw2=(u32x4){PKW(pB1,0),PKW(pB1,2),PKW(pB1,4),PKW(pB1,6)};pw3=(u32x4){PKW(pB1,8),PKW(pB1,10),PKW(pB1,12),PKW(pB1,14)};
    SBAR(); pv(o,vb0+sl_cur,PAF(0),PAF(1),PAF(2),PAF(3)); }
  #undef PKW
  #undef PAF
  #undef VFR
  #undef PIN
  #undef MX3
  #undef GAPA
  #undef GAPB
  #undef EX
  #undef VRD
  #undef KRD
  #undef STEP
  #undef ENDW
  {auto rr=__builtin_amdgcn_permlane32_swap(__float_as_uint(l_reg),__float_as_uint(l_reg),false,false);l_reg=__uint_as_float(rr[0])+__uint_as_float(rr[1]);}
  if(hi==0)wsf[32+r32]=l_reg;asm volatile("s_waitcnt lgkmcnt(0)":::"memory");
  float rli[16];
  #pragma unroll
  for(int r=0;r<16;++r)rli[r]=__builtin_amdgcn_rcpf(wsf[32+crow(r,hi)]);
  bf16*Ow=O+(rowbase+q0+wid*QBLK)*OP+ocol;
  { bf16*stg=(bf16*)(shm+LDS_OST)+wid*2048;
    #pragma unroll
    for(int r=0;r<16;++r){const int orow=crow(r,hi);
      #pragma unroll
      for(int d0=0;d0<2;++d0)stg[orow*64+d0*32+r32]=__float2bfloat16(o[d0][r]*rli[r]);}
    asm volatile("s_waitcnt lgkmcnt(0)":::"memory");
    #pragma unroll
    for(int i=0;i<4;++i){const int row=i*8+(lane>>3),ch=lane&7; const u32x4 v=*(const u32x4*)(stg+row*64+ch*8); ATTN_STORE16(Ow+(long)row*OP+ch*8,v);} }
  asm volatile("s_waitcnt lgkmcnt(0)\n\ts_barrier":::"memory");
  #undef DMA_K
  #undef DMA_V
  #undef CMASK
  #undef START
  #undef RESC
  #undef ROT
}
constexpr int LDS3_V=4*SLOTB, LDS3_WS=LDS3_V+4*2*SLOTB, LDS3_OST=LDS3_WS+NW*64*4, LDS3_BYTES=LDS3_OST+NW*4096;
constexpr int LDS2_V=NSLOT*SLOTB, LDS2_WS=LDS2_V+NSLOT*2*SLOTB, LDS2_OST=LDS2_WS+NW*64*4, LDS2_BYTES=LDS2_OST+NW*8192;
#ifndef ATTN_STORE16
#define ATTN_STORE16(p,v) (*(u32x4*)(p)=(v))
#endif
template<int THRL> __device__ __forceinline__ void attn_unit128(int b,int qcol,int kcol,int vcol,int ocol,int qb,const bf16*Q,const bf16*__restrict__ K,const bf16*__restrict__ V,bf16*O,char*shm){
  int tid_=threadIdx.x; asm volatile("":"+v"(tid_));
  const int tid=tid_,lane=tid&63,r32=lane&31,hi=lane>>5; const int wid=__builtin_amdgcn_readfirstlane(tid>>6);
  const long rowbase=(long)b*SEQ; const int q0=qb*QB;
  const bf16*Qw=Q+(rowbase+q0+wid*QBLK)*QP+qcol;
  const bf16*Kh=K+rowbase*KP+kcol,*Vh=V+rowbase*VP+vcol;
  const unsigned lds0=(unsigned)(uintptr_t)shm;
  float*wsf=(float*)(shm+LDS3_WS)+wid*64;
  const bf16*ksrc=Kh+(long)lane*KP+wid*8;
  const bf16*vsrc=Vh+(long)(16*(wid&3)+(lane>>2))*VP+(wid>>2)*32+(lane&3)*8;
  const unsigned kdst=lds0+LDS_K+wid*1024, vdst=lds0+LDS3_V+wid*1024;
  #define DMA_K(t,slot) glds16(ksrc+(long)(t)*KVBLK*KP,(unsigned)__builtin_amdgcn_readfirstlane(kdst+(slot)))
  #define DMA_V(t,slot) do{ glds16(vsrc+(long)(t)*KVBLK*VP,(unsigned)__builtin_amdgcn_readfirstlane(vdst+2*(slot))); glds16(vsrc+(long)(t)*KVBLK*VP+64,(unsigned)__builtin_amdgcn_readfirstlane(vdst+2*(slot)+8192)); }while(0)
  const int vb0=(int)(lds0+LDS3_V)+((lane>>4)&1)*32+(lane&3)*8+(4*hi+((lane&15)>>2))*64;
  const char*Kbase=shm+LDS_K; bf16x8 kf[8];
  const lds_cptr shm3=(lds_cptr)shm; const lds_cptr kp0=shm3+LDS_K+hi*1024+r32*16; const lds_cptr vp0=shm3+LDS3_V+((lane>>4)&1)*32+(lane&3)*8+(4*hi+((lane&15)>>2))*64;
  const int NT=(q0+QB)/KVBLK;
  DMA_K(0,0);DMA_V(0,0);DMA_K(1,SLOTB);
  bf16x8 qr[4];
  #pragma unroll
  for(int d0=0;d0<4;++d0)qr[d0]=*reinterpret_cast<const bf16x8*>(&Qw[(long)r32*QP+d0*16+hi*8]);
  float mhat=0.f,l_reg=0.f;f32x16 o[4];o[0]=f32x16{};o[1]=f32x16{};o[2]=f32x16{};o[3]=f32x16{};f32x16 negm=f32x16{};asm volatile("":"+v"(negm));
  const int qrel=wid>>1;
  #define CMASK(P0,P1,t) do{int jb_=(t)-(NT-4); if(jb_>=0)cmask(P0,P1,jb_,qrel,hi);}while(0)
  bool resc=false;
  #define START(P0,P1) do{ const float rm=rowmax(P0,P1); resc=false; \
    { const float dl=rm; mhat=fadd_s(mhat,dl); \
      _Pragma("unroll") for(int r=0;r<16;++r){P0[r]=fsub_s(P0[r],dl);P1[r]=fsub_s(P1[r],dl);} \
      _Pragma("unroll") for(int r=0;r<16;++r)negm[r]=-mhat; asm volatile("":"+v"(negm)); } \
    _Pragma("unroll") for(int r=0;r<16;++r)P0[r]=__builtin_amdgcn_exp2f(P0[r]); }while(0)
  #define RESC() do{ if(resc){ asm volatile("s_waitcnt lgkmcnt(0)":::"memory"); \
      _Pragma("unroll") for(int d_=0;d_<4;++d_) _Pragma("unroll") for(int r=0;r<16;++r)o[d_][r]*=wsf[crow(r,hi)]; } }while(0)
  f32x16 pA0,pA1,pB0,pB1;
  int sl_prev=0,sl_cur=SLOTB,sl_next=2*SLOTB,sl_next2=3*SLOTB;
  #define ROT() do{sl_prev=sl_cur;sl_cur=sl_next;sl_next=sl_next2;sl_next2=(sl_next2+SLOTB)&(4*SLOTB-1);}while(0)
  DMA_K(2,2*SLOTB);DMA_V(1,SLOTB);DMA_K(3,3*SLOTB);
  WAIT_BAR(7);
  qkt(pA0,pA1,Kbase,qr,negm,r32,hi);asm volatile("s_nop 15\n\ts_nop 7":"+v"(pA0),"+v"(pA1));CMASK(pA0,pA1,0);
  START(pA0,pA1);
  _Pragma("unroll") for(int r=0;r<16;++r)pA1[r]=__builtin_amdgcn_exp2f(pA1[r]);
  WAIT_BAR(4);
  if(NT>4){DMA_K(4,0);} DMA_V(2,2*SLOTB);
  kload8(kf,kp0+sl_cur);
  if(NT>4){WAIT_BAR(6);}else{WAIT_BAR(5);}
  s16x4 vlo[4],vhi[4]; u32x4 pw0,pw1,pw2,pw3;
  #define PKW(P,B) cvtpk_s(P[B],P[B+1])
  #define PAF(k) __builtin_bit_cast(bf16x8,pw##k)
  #define VFR(i) (bf16x8){vlo[i][0],vlo[i][1],vlo[i][2],vlo[i][3],vhi[i][0],vhi[i][1],vhi[i][2],vhi[i][3]}
  #define PIN(x) asm volatile("":"+v"(x))
  #define MX3(a,b,c) __builtin_fmaxf(__builtin_fmaxf((a),(b)),(c))
  #define GAPA(MF,A0,A1,A2,A3,W0,W1,PW) do{ MF; sacc+=A0; sacc+=A1; sacc+=A2; sacc+=A3; PIN(sacc); W0; W1; PIN(PW); SBAR(); }while(0)
  #define EX(v) __builtin_amdgcn_exp2f(v)
  #define GAPB(MF,X,B) do{ MF; X[B]=EX(X[B]); X[B+1]=EX(X[B+1]); PIN(X); SBAR(); }while(0)
  #define GAPBV(MF,RD,X,B) do{ MF; RD; X[B]=EX(X[B]); X[B+1]=EX(X[B+1]); PIN(X); SBAR(); }while(0)
  #define VRD(j,d,k) do{ vlo[(j)&3]=vtr(vp_+((d)*4096+(k)*1024)); vhi[(j)&3]=vtr(vp_+((d)*4096+(k)*1024+512)); }while(0)
  #define KRD(G,j) do{ if(G){ kload2(kf,kp0+sl_next,j); SBAR(); } }while(0)
  #define STEP(C0,C1,P0,P1,t,GK,GV,GL) do{ SBAR(); \
    const lds_cptr vp_=vp0+2*sl_prev; \
    float sacc=(P0[0]+P0[1]); \
    GAPA(C0=__builtin_amdgcn_mfma_f32_32x32x16_bf16(kf[0],qr[0],negm,0,0,0), P0[2],P0[3],P0[4],P0[5],     pw0[0]=PKW(P0,0), pw0[1]=PKW(P0,2), pw0); \
    GAPA(C1=__builtin_amdgcn_mfma_f32_32x32x16_bf16(kf[1],qr[0],negm,0,0,0), P0[6],P0[7],P0[8],P0[9],     pw0[2]=PKW(P0,4), pw0[3]=PKW(P0,6), pw0); \
    GAPA(C0=__builtin_amdgcn_mfma_f32_32x32x16_bf16(kf[2],qr[1],C0,0,0,0),   P0[10],P0[11],P0[12],P0[13], pw1[0]=PKW(P0,8), pw1[1]=PKW(P0,10), pw1); \
    GAPA(C1=__builtin_amdgcn_mfma_f32_32x32x16_bf16(kf[3],qr[1],C1,0,0,0),   P0[14],P0[15],P1[0],P1[1],   pw1[2]=PKW(P0,12),pw1[3]=PKW(P0,14), pw1); \
    VRD(0,0,0); SBAR(); GAPA(C0=__builtin_amdgcn_mfma_f32_32x32x16_bf16(kf[4],qr[2],C0,0,0,0),   P1[2],P1[3],P1[4],P1[5],     pw2[0]=PKW(P1,0), pw2[1]=PKW(P1,2), pw2); \
    VRD(1,1,0); SBAR(); GAPA(C1=__builtin_amdgcn_mfma_f32_32x32x16_bf16(kf[5],qr[2],C1,0,0,0),   P1[6],P1[7],P1[8],P1[9],     pw2[2]=PKW(P1,4), pw2[3]=PKW(P1,6), pw2); \
    VRD(2,0,1); SBAR(); GAPA(C0=__builtin_amdgcn_mfma_f32_32x32x16_bf16(kf[6],qr[3],C0,0,0,0),   P1[10],P1[11],P1[12],P1[13], pw3[0]=PKW(P1,8), pw3[1]=PKW(P1,10), pw3); \
    VRD(3,1,1); SBAR(); GAPA(C1=__builtin_amdgcn_mfma_f32_32x32x16_bf16(kf[7],qr[3],C1,0,0,0),   P1[14],P1[15],0.f,0.f,       pw3[2]=PKW(P1,12),pw3[3]=PKW(P1,14), pw3); \
    l_reg+=sacc; \
    if(GK){DMA_K((t)+4,sl_cur);} if(GV){DMA_V((t)+2,sl_next2);} \
    CMASK(C0,C1,t); \
    { float a=MX3(C0[0],C0[1],C1[0]),b=MX3(C0[2],C0[3],C1[1]); a=MX3(a,C1[2],C1[3]); \
      _Pragma("unroll") for(int r=4;r<16;r+=4){a=MX3(a,C0[r],C0[r+1]);b=MX3(b,C0[r+2],C0[r+3]);a=MX3(a,C1[r],C1[r+1]);b=MX3(b,C1[r+2],C1[r+3]);} \
      float rm=__builtin_fmaxf(a,b); { auto rr=__builtin_amdgcn_permlane32_swap(__float_as_uint(rm),__float_as_uint(rm),false,false); rm=__builtin_fmaxf(__uint_as_float(rr[0]),__uint_as_float(rr[1])); } \
      resc=false; \
      if(__builtin_expect(__any(rm>(float)THRL),0)){ const float dl=__builtin_fmaxf(rm,0.f); mhat+=dl; \
        _Pragma("unroll") for(int r=0;r<16;++r){C0[r]-=dl;C1[r]-=dl;} \
        _Pragma("unroll") for(int r=0;r<16;++r)negm[r]=-mhat; asm volatile("":"+v"(negm)); \
        const float f=__builtin_amdgcn_exp2f(-dl); l_reg*=f; if(hi==0)wsf[r32]=f; resc=true; } } \
    SBAR(); \
    GAPBV(o[0]=__builtin_amdgcn_mfma_f32_32x32x16_bf16(PAF(0),VFR(0),o[0],0,0,0), VRD(4,0,2), C0,0); \
    GAPBV(o[1]=__builtin_amdgcn_mfma_f32_32x32x16_bf16(PAF(0),VFR(1),o[1],0,0,0), VRD(5,1,2), C0,2); \
    KRD(GL,0); GAPBV(o[0]=__builtin_amdgcn_mfma_f32_32x32x16_bf16(PAF(1),VFR(2),o[0],0,0,0), VRD(6,0,3), C0,4); \
    KRD(GL,1); GAPBV(o[1]=__builtin_amdgcn_mfma_f32_32x32x16_bf16(PAF(1),VFR(3),o[1],0,0,0), VRD(7,1,3), C0,6); \
    KRD(GL,2); GAPBV(o[0]=__builtin_amdgcn_mfma_f32_32x32x16_bf16(PAF(2),VFR(0),o[0],0,0,0), VRD(8,2,0), C0,8); \
    KRD(GL,3); GAPBV(o[1]=__builtin_amdgcn_mfma_f32_32x32x16_bf16(PAF(2),VFR(1),o[1],0,0,0), VRD(9,3,0), C0,10); \
    GAPBV(o[0]=__builtin_amdgcn_mfma_f32_32x32x16_bf16(PAF(3),VFR(2),o[0],0,0,0), VRD(10,2,1), C0,12); \
    GAPBV(o[1]=__builtin_amdgcn_mfma_f32_32x32x16_bf16(PAF(3),VFR(3),o[1],0,0,0), VRD(11,3,1), C0,14); \
    GAPBV(o[2]=__builtin_amdgcn_mfma_f32_32x32x16_bf16(PAF(0),VFR(0),o[2],0,0,0), VRD(12,2,2), C1,0); \
    GAPBV(o[3]=__builtin_amdgcn_mfma_f32_32x32x16_bf16(PAF(0),VFR(1),o[3],0,0,0), VRD(13,3,2), C1,2); \
    GAPBV(o[2]=__builtin_amdgcn_mfma_f32_32x32x16_bf16(PAF(1),VFR(2),o[2],0,0,0), VRD(14,2,3), C1,4); \
    GAPBV(o[3]=__builtin_amdgcn_mfma_f32_32x32x16_bf16(PAF(1),VFR(3),o[3],0,0,0), VRD(15,3,3), C1,6); \
    GAPB(o[2]=__builtin_amdgcn_mfma_f32_32x32x16_bf16(PAF(2),VFR(0),o[2],0,0,0), C1,8); \
    GAPB(o[3]=__builtin_amdgcn_mfma_f32_32x32x16_bf16(PAF(2),VFR(1),o[3],0,0,0), C1,10); \
    GAPB(o[2]=__builtin_amdgcn_mfma_f32_32x32x16_bf16(PAF(3),VFR(2),o[2],0,0,0), C1,12); \
    GAPB(o[3]=__builtin_amdgcn_mfma_f32_32x32x16_bf16(PAF(3),VFR(3),o[3],0,0,0), C1,14); \
    }while(0)
  int t=1;
  #undef CMASK
  #define CMASK(P0,P1,t) do{}while(0)
  for(;t+5<NT;t+=2){
    STEP(pB0,pB1,pA0,pA1,t,true,true,true);     WAIT_BAR(6); RESC(); ROT();
    STEP(pA0,pA1,pB0,pB1,t+1,true,true,true);   WAIT_BAR(6); RESC(); ROT();
  }
  #undef CMASK
  #define CMASK(P0,P1,t) do{int jb_=(t)-(NT-4); if(jb_>=0)cmask(P0,P1,jb_,qrel,hi);}while(0)
  #define ENDW(tt) do{ const int d_=NT-(tt); if(d_>=5){WAIT_BAR(6);} else if(d_==4){WAIT_BAR(5);} else if(d_==3){WAIT_BAR(4);} else {WAIT_BAR(0);} }while(0)
  for(;t+1<NT;t+=2){
    STEP(pB0,pB1,pA0,pA1,t,(t+4<NT),(t+2<NT),(t+1<NT));       ENDW(t);   RESC(); ROT();
    STEP(pA0,pA1,pB0,pB1,t+1,(t+5<NT),(t+3<NT),(t+2<NT));     ENDW(t+1); RESC(); ROT();
  }
  STEP(pB0,pB1,pA0,pA1,NT-1,false,false,false); RESC();
  { float sacc=pB0[0]+pB0[1]; _Pragma("unroll") for(int r=2;r<16;++r)sacc+=pB0[r]; _Pragma("unroll") for(int r=0;r<16;++r)sacc+=pB1[r]; l_reg+=sacc;
    pw0=(u32x4){PKW(pB0,0),PKW(pB0,2),PKW(pB0,4),PKW(pB0,6)};pw1=(u32x4){PKW(pB0,8),PKW(pB0,10),PKW(pB0,12),PKW(pB0,14)};pw2=(u32x4){PKW(pB1,0),PKW(pB1,2),PKW(pB1,4),PKW(pB1,6)};pw3=(u32x4){PKW(pB1,8),PKW(pB1,10),PKW(pB1,12),PKW(pB1,14)};
    SBAR(); pv(o,vb0+2*sl_cur,PAF(0),PAF(1),PAF(2),PAF(3)); pv(o+2,vb0+2*sl_cur+8192,PAF(0),PAF(1),PAF(2),PAF(3)); }
  #undef PKW
  #undef PAF
  #undef VFR
  #undef PIN
  #undef MX3
  #undef GAPA
  #undef GAPB
  #undef GAPBV
  #undef EX
  #undef VRD
  #undef KRD
  #undef STEP
  #undef ENDW
  {auto rr=__builtin_amdgcn_permlane32_swap(__float_as_uint(l_reg),__float_as_uint(l_reg),false,false);l_reg=__uint_as_float(rr[0])+__uint_as_float(rr[1]);}
  if(hi==0)wsf[32+r32]=l_reg;asm volatile("s_waitcnt lgkmcnt(0)":::"memory");
  float rli[16];
  #pragma unroll
  for(int r=0;r<16;++r)rli[r]=__builtin_amdgcn_rcpf(wsf[32+crow(r,hi)]);
  bf16*Ow=O+(rowbase+q0+wid*QBLK)*OP+ocol;
  { bf16*stg=(bf16*)(shm+LDS3_OST)+wid*2048;
    #pragma unroll
    for(int hc=0;hc<2;++hc){
      #pragma unroll
      for(int r=0;r<16;++r){const int orow=crow(r,hi);
        #pragma unroll
        for(int d0=0;d0<2;++d0)stg[orow*64+d0*32+r32]=__float2bfloat16(o[2*hc+d0][r]*rli[r]);}
      asm volatile("s_waitcnt lgkmcnt(0)":::"memory");
      #pragma unroll
      for(int i=0;i<4;++i){const int row=i*8+(lane>>3),ch=lane&7; const u32x4 v=*(const u32x4*)(stg+row*64+ch*8); ATTN_STORE16(Ow+(long)row*OP+hc*64+ch*8,v);}
      asm volatile("s_waitcnt lgkmcnt(0)":::"memory"); } }
  asm volatile("s_waitcnt lgkmcnt(0)\n\ts_barrier":::"memory");
  #undef DMA_K
  #undef DMA_V
  #undef CMASK
  #undef START
  #undef RESC
  #undef ROT
}
constexpr int ATTN_LDS_BYTES=LDS_BYTES;
struct AttnTensors { const bf16* Q; const bf16* K; const bf16* V; bf16* O; };
struct AttnUnit { int bvh; int qb; };
struct StaticOrder {
  int ai,nA;
  __device__ __forceinline__ StaticOrder(int ai_,int nA_):ai(ai_),nA(nA_){}
  __device__ __forceinline__ bool next(int i,AttnUnit&u)const{
    if(nA==128){ if(i>=8)return false; u.bvh=ai; u.qb=7-i; return true; }
    if(i>=4)return false; const int s=ai&1; u.bvh=ai>>1; u.qb=(i==0)?7-s:(i==1)?4+s:(i==2)?3-s:s; return true; }
  __device__ __forceinline__ void a_ready(const AttnUnit&)const{}
  __device__ __forceinline__ void done(const AttnUnit&)const{}
};
template<class Sched,int THRL=8> __device__ __forceinline__ void attn_phase(char*lds,const AttnTensors&T,const Sched&S){
  AttnUnit u;
  for(int i=0;S.next(i,u);++i){ S.a_ready(u); const int b=u.bvh>>4,vh=u.bvh&15,s=vh>>1,half=vh&1;
    attn_unit<THRL>(b,s*64,s*64,(s>>1)*128+half*64,s*128+half*64,u.qb,T.Q,T.K,T.V,T.O,lds); S.done(u); }
}
template<int THRL=8> __device__ __forceinline__ void attn_phase_queue(char*lds,const AttnTensors&T,unsigned*counter,volatile __attribute__((address_space(3))) unsigned*slot){
  for(;;){
    if(threadIdx.x==0)*slot=__hip_atomic_fetch_add(counter,1u,__ATOMIC_RELAXED,__HIP_MEMORY_SCOPE_AGENT);
    __syncthreads();
    const unsigned u=__builtin_amdgcn_readfirstlane(*slot);
    __syncthreads();
    if(u>=1024u)break;
    const int qb=7-(int)(u>>7),bvh=(int)(u&127u),b=bvh>>4,vh=bvh&15,s=vh>>1,half=vh&1;
    attn_unit<THRL>(b,s*64,s*64,(s>>1)*128+half*64,s*128+half*64,qb,T.Q,T.K,T.V,T.O,lds);
  }
}
template<int THRL=8> __device__ __forceinline__ void attn_phase_queue128(char*lds,const AttnTensors&T,unsigned*counter,volatile __attribute__((address_space(3))) unsigned*slot){
  for(;;){
    if(threadIdx.x==0)*slot=__hip_atomic_fetch_add(counter,1u,__ATOMIC_RELAXED,__HIP_MEMORY_SCOPE_AGENT);
    __syncthreads();
    const unsigned u=__builtin_amdgcn_readfirstlane(*slot);
    __syncthreads();
    if(u>=512u)break;
    const int qb=7-(int)(u>>6),bs=(int)(u&63u),b=bs>>3,s=bs&7;
    attn_unit128<THRL>(b,s*64,s*64,(s>>1)*128,s*128,qb,T.Q,T.K,T.V,T.O,lds);
  }
}
template<int THRL=8> __device__ __forceinline__ void attn_phase_hybrid128(char*lds,const AttnTensors&T,unsigned*counter,volatile __attribute__((address_space(3))) unsigned*slot,int c){
  int nst=0,q0=0,q1=0,bs0=0;
  if(c<64){nst=2;q0=7;q1=2;bs0=c;} else if(c<128){nst=2;q0=6;q1=4;bs0=c-64;} else if(c<192){nst=2;q0=3;q1=1;bs0=c-128;} else {nst=1;q0=5;bs0=c-192;}
  for(int i=0;;++i){
    int qb,bs;
    if(i<nst){ qb=(i==0)?q0:q1; bs=bs0; }
    else{
      if(threadIdx.x==0)*slot=__hip_atomic_fetch_add(counter,1u,__ATOMIC_RELAXED,__HIP_MEMORY_SCOPE_AGENT);
      __syncthreads();
      const unsigned u=__builtin_amdgcn_readfirstlane(*slot);
      __syncthreads();
      if(u>=64u)break;
      qb=0; bs=(int)u;
    }
    const int b=bs>>3,sh=bs&7;
    attn_unit128<THRL>(b,sh*64,sh*64,(sh>>1)*128,sh*128,qb,T.Q,T.K,T.V,T.O,lds);
  }
}
#undef SBAR
#undef WAIT_BAR
}
#include <hip/hip_cooperative_groups.h>
typedef unsigned short bf16;
#define GAS __attribute__((address_space(1)))
#define LAS __attribute__((address_space(3)))
typedef unsigned v4u __attribute__((ext_vector_type(4)));
typedef unsigned v2u __attribute__((ext_vector_type(2)));
typedef float f32x4 __attribute__((ext_vector_type(4)));
#define LDS_WAIT() asm volatile("s_waitcnt lgkmcnt(0)" ::: "memory")
__device__ __forceinline__ unsigned f2bf(float f) { unsigned u = __builtin_bit_cast(unsigned, f); return (u + 0x7fffu + ((u >> 16) & 1u)) >> 16; }
__device__ __forceinline__ unsigned pk2(float lo, float hi) { return f2bf(lo) | (f2bf(hi) << 16); }
__device__ __forceinline__ float bflo(unsigned w) { return __builtin_bit_cast(float, w << 16); }
__device__ __forceinline__ float bfhi(unsigned w) { return __builtin_bit_cast(float, w & 0xffff0000u); }
__device__ __forceinline__ float bf1(unsigned short h) { return __builtin_bit_cast(float, (unsigned)h << 16); }
template <int CTRL> __device__ __forceinline__ float dppf(float x) { return __builtin_bit_cast(float, __builtin_amdgcn_update_dpp(0, __builtin_bit_cast(int, x), CTRL, 0xf, 0xf, false)); }
__device__ __forceinline__ float row16_allsum(float x) { x += dppf<0x128>(x); x += dppf<0x124>(x); x += dppf<0x122>(x); x += dppf<0x121>(x); return x; }
__device__ __forceinline__ float oct_allsum(float x) { x += dppf<0xB1>(x); x += dppf<0x4E>(x); x += dppf<0x141>(x); return x; }
__device__ __forceinline__ float u2f(unsigned u) { return __builtin_bit_cast(float, u); }
__device__ __forceinline__ unsigned f2u(float f) { return __builtin_bit_cast(unsigned, f); }
__device__ __forceinline__ float sw32(float a, float b) { auto r = __builtin_amdgcn_permlane32_swap(f2u(a), f2u(b), false, false); const unsigned r0 = r[0], r1 = r[1]; return u2f(r0) + u2f(r1); }
__device__ __forceinline__ float sw16(float a, float b) { auto r = __builtin_amdgcn_permlane16_swap(f2u(a), f2u(b), false, false); const unsigned r0 = r[0], r1 = r[1]; return u2f(r0) + u2f(r1); }
__device__ __forceinline__ float wave_allsum(float x) { x = row16_allsum(x); x = sw16(x, x); return sw32(x, x); }
__device__ __forceinline__ float red4(float x0, float x1, float x2, float x3) { return row16_allsum(sw16(sw32(x0, x1), sw32(x2, x3))); }

#define XB_TMO      128
#define XB_XCNT(j)  (256  + 64 * (j))
#define XB_XSUB(j)  (1280 + 64 * (j))
#define XB_XGEN(j)  (2304 + 64 * (j))
#define XB_TOP      3328
#define XB_TOPGEN   3392
#define XCD_BAR_WORDS 3456
#define XB_SPIN_CAP (1u << 18)

__device__ __forceinline__ unsigned xb_ld(unsigned* p)              { return __hip_atomic_load(p, __ATOMIC_RELAXED, __HIP_MEMORY_SCOPE_AGENT); }
__device__ __forceinline__ unsigned xb_add(unsigned* p, unsigned v) { return __hip_atomic_fetch_add(p, v, __ATOMIC_RELAXED, __HIP_MEMORY_SCOPE_AGENT); }
__device__ __forceinline__ unsigned xb_xcc_id() { return (unsigned)__builtin_amdgcn_s_getreg((3 << 11) | 20) & 0xFu; }
#define XB_SPIN(cond, bar) do { unsigned _sp = 0; while (cond) { __builtin_amdgcn_s_sleep(1); \
    if ((++_sp & 255u) == 0u) { if (xb_ld(&(bar)[XB_TMO])) break; if (_sp > XB_SPIN_CAP) { atomicAdd(&(bar)[XB_TMO], 1u); break; } } } } while (0)

struct XcdBarrier {
    unsigned* bar; unsigned x;
    volatile LAS unsigned* st;
};

__device__ __forceinline__ XcdBarrier xcd_barrier_post(unsigned* bar, volatile LAS unsigned* st) {
    XcdBarrier b; b.bar = bar; b.x = xb_xcc_id(); b.st = st;
    if (threadIdx.x == 0) (void)xb_add(&bar[XB_XCNT(b.x)], 1u);
    return b;
}
__device__ __forceinline__ void xcd_barrier_complete(unsigned* bar, unsigned x, unsigned& nloc, unsigned& nx) {
    const unsigned G = gridDim.x * gridDim.y * gridDim.z;
    unsigned sum, cnt, mine, sp = 0u;
    for (;;) {
        sum = 0u; cnt = 0u; mine = 0u;
#pragma unroll
        for (unsigned j = 0; j < 16; ++j) { const unsigned c = xb_ld(&bar[XB_XCNT(j)]); sum += c; cnt += (c > 0u) ? 1u : 0u; }
        mine = xb_ld(&bar[XB_XCNT(x)]);
        if (sum == G) break;
        __builtin_amdgcn_s_sleep(1);
        if ((++sp & 255u) == 0u) { if (xb_ld(&bar[XB_TMO])) break; if (sp > XB_SPIN_CAP) { atomicAdd(&bar[XB_TMO], 1u); break; } }
    }
    nloc = mine > 0u ? mine : 1u; nx = cnt > 0u ? cnt : 1u;
}

__device__ __forceinline__ void xcd_barrier(const XcdBarrier& b) {
    asm volatile("s_waitcnt vmcnt(0)" ::: "memory");
    __syncthreads();
    if (threadIdx.x == 0) {
        unsigned* bar = b.bar;
        __builtin_amdgcn_s_waitcnt(0);
        unsigned nloc = b.st[0], nx = b.st[1];
        if (nloc == 0u) { xcd_barrier_complete(bar, b.x, nloc, nx); b.st[0] = nloc; b.st[1] = nx; }
        const unsigned old = xb_add(&bar[XB_XSUB(b.x)], 1u);
        const unsigned gen = old / nloc;
        if (old + 1u == (gen + 1u) * nloc) {
            __builtin_amdgcn_fence(__ATOMIC_RELEASE, "agent");
            asm volatile("s_waitcnt vmcnt(0)" ::: "memory");
            const unsigned og = xb_add(&bar[XB_TOP], 1u);
            const unsigned tg = og / nx;
            if (og + 1u == (tg + 1u) * nx) xb_add(&bar[XB_TOPGEN], 1u);
            else XB_SPIN(xb_ld(&bar[XB_TOPGEN]) == tg, bar);
            __builtin_amdgcn_fence(__ATOMIC_ACQUIRE, "agent");
            xb_add(&bar[XB_XGEN(b.x)], 1u);
            asm volatile("s_waitcnt vmcnt(0)" ::: "memory");
        } else {
            XB_SPIN(xb_ld(&bar[XB_XGEN(b.x)]) == gen, bar);
            __builtin_amdgcn_fence(__ATOMIC_ACQUIRE, "agent");
            asm volatile("s_waitcnt vmcnt(0)" ::: "memory");
        }
    }
    __syncthreads();
}


constexpr int CW_BAR = 4096;
constexpr int MISC_OFF = 162816 + 320;
struct Frame {
    LAS unsigned char* lds;
    int tid, lane, wave, G, bx;
    float* out; unsigned char* ws;
};
struct Args { const float* in[26]; float* out; unsigned char* ws; int ph_lo, ph_hi; };
typedef const float* cfp_t;
typedef __attribute__((address_space(4))) const cfp_t* ktab_t;
struct InTab { ktab_t p; __device__ __forceinline__ const float* operator[](int i) const { return p[i]; } };
enum { I_X = 0, I_NMG, I_WIN, I_MU, I_W0, I_W2, I_A0, I_A2, I_G2, I_KK, I_KA, I_RK, I_LNG, I_LNB, I_LQ1, I_LK1, I_LQ2, I_LK2, I_SUBG, I_WA, I_WB, I_WO, I_NFG, I_FF1, I_FF2, I_NFIN };

template <bool ROPE> __device__ __forceinline__ void p0_transpose_item(const float* W, int K, int N, bf16* WT, LAS float* scr, int item, int lane, int pitch = 0, int koff = 0) {
    if (pitch == 0) pitch = K;
    const int nblk = N / 32, kb = item / nblk, nb = item % nblk, k0 = 64 * kb, n0 = 32 * nb;
#pragma unroll
    for (int i = 0; i < 8; ++i) { const int kk = 8 * i + (lane >> 3), c4 = 4 * (lane & 7); const f32x4 w4 = *(const GAS f32x4*)(W + (size_t)(k0 + kk) * N + n0 + c4);
        scr[kk * 33 + c4] = w4.x; scr[kk * 33 + c4 + 1] = w4.y; scr[kk * 33 + c4 + 2] = w4.z; scr[kk * 33 + c4 + 3] = w4.w; }
    LDS_WAIT(); asm volatile("" ::: "memory");
    const int c = lane & 7;
#pragma unroll
    for (int j = 0; j < 4; ++j) { const int n = (lane >> 3) + 8 * j; const LAS float* s = scr + (8 * c) * 33 + n;
        v4u o; o.x = pk2(s[0 * 33], s[1 * 33]); o.y = pk2(s[2 * 33], s[3 * 33]); o.z = pk2(s[4 * 33], s[5 * 33]); o.w = pk2(s[6 * 33], s[7 * 33]);
        int col = n0 + n;
        if (ROPE && col < 1024) { const int d = col & 63, dd = d & 31; col = (col & ~63) + 8 * (dd >> 2) + (d >> 5) * 4 + (dd & 3); }
        *(GAS v4u*)(WT + (size_t)col * pitch + koff + k0 + 8 * c) = o; }
    LDS_WAIT(); asm volatile("" ::: "memory");
}
__device__ __forceinline__ void rms_row_to_bf16(const float* xrow, const float* g, bf16* orow, int lane) {
    const GAS f32x4* xr = (const GAS f32x4*)xrow + lane; const f32x4* gr = (const f32x4*)g + lane;
    f32x4 v[4]; float s = 0.f;
#pragma unroll
    for (int j = 0; j < 4; ++j) { v[j] = xr[64 * j]; s += (v[j].x * v[j].x + v[j].y * v[j].y) + (v[j].z * v[j].z + v[j].w * v[j].w); }
    const float rstd = 1.0f / sqrtf(wave_allsum(s) * (1.f / D) + NORM_EPS);
    GAS unsigned long long* o8 = (GAS unsigned long long*)orow + lane;
#pragma unroll
    for (int j = 0; j < 4; ++j) { const f32x4 gg = gr[64 * j];
        o8[64 * j] = (unsigned long long)pk2(v[j].x * rstd * gg.x, v[j].y * rstd * gg.y) | ((unsigned long long)pk2(v[j].z * rstd * gg.z, v[j].w * rstd * gg.w) << 32); }
}
__device__ __forceinline__ void rms_row_to_f32(const float* xrow, const float* g, float* orow, int lane) {
    const GAS f32x4* xr = (const GAS f32x4*)xrow + lane; const f32x4* gr = (const f32x4*)g + lane;
    f32x4 v[4]; float s = 0.f;
#pragma unroll
    for (int j = 0; j < 4; ++j) { v[j] = xr[64 * j]; s += (v[j].x * v[j].x + v[j].y * v[j].y) + (v[j].z * v[j].z + v[j].w * v[j].w); }
    const float rstd = 1.0f / sqrtf(wave_allsum(s) * (1.f / D) + NORM_EPS);
    GAS f32x4* o = (GAS f32x4*)orow + lane;
#pragma unroll
    for (int j = 0; j < 4; ++j) { const f32x4 gg = gr[64 * j]; o[64 * j] = v[j] * rstd * gg; }
}
__device__ __forceinline__ void p0_prologue(Frame& F, const InTab& A) {
    LAS float* scr = (LAS float*)(F.lds + RING_OFF + F.wave * 16384);
    const int gw = F.bx * NWAVES + F.wave, NGW = F.G * NWAVES;
    unsigned char* ws = F.ws;
    constexpr int I_IN = (D / 64) * (D_IN / 32), I_A = (512 / 64) * (D / 32), I_O = (D / 64) * (D / 32), I_1 = (D / 64) * (FF / 32), I_2 = (FF / 64) * (D / 32);
    (void)I_A; (void)I_O; (void)I_1; (void)I_2;
    for (int it = gw; it < I_IN; it += NGW) p0_transpose_item<true>(A[I_WIN], D, D_IN, (bf16*)(ws + WS_WIN), scr, it, F.lane);
    if (false) for (int it = gw; it < 0; it += NGW) {
        int r = it;
        if (r < I_A) { p0_transpose_item<false>(A[I_WA], 512, D, (bf16*)(ws + WS_WA), scr, r, F.lane, 1024, 0); continue; } r -= I_A;
        if (r < I_A) { p0_transpose_item<false>(A[I_WB], 512, D, (bf16*)(ws + WS_WA), scr, r, F.lane, 1024, 512); continue; } r -= I_A;
        if (r < I_O) { p0_transpose_item<false>(A[I_WO], D, D, (bf16*)(ws + WS_WO), scr, r, F.lane); continue; } r -= I_O;
        if (r < I_1) { p0_transpose_item<false>(A[I_FF1], D, FF, (bf16*)(ws + WS_W1), scr, r, F.lane); continue; } r -= I_1;
        p0_transpose_item<false>(A[I_FF2], FF, D, (bf16*)(ws + WS_W2), scr, r, F.lane);
    }
    const int gt = F.bx * (NWAVES * 64) + F.tid, NGT = F.G * NWAVES * 64;
    for (int e = gt; e < NLORA * (KLORA / 8); e += NGT) { const int n = e % NLORA, k8 = (e / NLORA) * 8; float v[8];
#pragma unroll
        for (int i = 0; i < 8; ++i) { const int k = k8 + i; float x = 0.f;
            if (n < 512) { if (k < 64) x = A[I_W2][(size_t)k * 512 + n]; }
            else if (n < 1024) { if (k >= 64 && k < 128) x = A[I_A2][(size_t)(k - 64) * 512 + (n - 512)]; }
            else { if (k >= 128) x = A[I_G2][(size_t)(k - 128) * 512 + (n - 1024)]; }
            v[i] = x; }
        v4u o; o.x = pk2(v[0], v[1]); o.y = pk2(v[2], v[3]); o.z = pk2(v[4], v[5]); o.w = pk2(v[6], v[7]);
        *(GAS v4u*)((bf16*)(ws + WS_WL) + (size_t)n * KLORA + k8) = o; }
    for (int e = gt; e < SEQ * 32; e += NGT) { const int pos = e >> 5, i = e & 31;
        const float inv = exp2f(-(float)i * 0.41524101186092029f);
        const float ang = (float)pos * inv; float s, c; sincosf(ang, &s, &c);
        ((float*)(ws + WS_ROPE_C))[e] = c; ((float*)(ws + WS_ROPE_S))[e] = s; }
    for (int m = gw; m < M; m += 2 * NGW) {
        const int m2 = m + NGW;
        const GAS f32x4* xa = (const GAS f32x4*)(A[I_X] + (size_t)m * D) + F.lane; const GAS f32x4* xb = (const GAS f32x4*)(A[I_X] + (size_t)m2 * D) + F.lane; const f32x4* gr = (const f32x4*)A[I_NMG] + F.lane;
        f32x4 va[4], vb[4]; float sa = 0.f, sb = 0.f;
#pragma unroll
        for (int j = 0; j < 4; ++j) { va[j] = xa[64 * j]; vb[j] = xb[64 * j]; }
#pragma unroll
        for (int j = 0; j < 4; ++j) { sa += (va[j].x * va[j].x + va[j].y * va[j].y) + (va[j].z * va[j].z + va[j].w * va[j].w); sb += (vb[j].x * vb[j].x + vb[j].y * vb[j].y) + (vb[j].z * vb[j].z + vb[j].w * vb[j].w); }
        const float ra = __builtin_amdgcn_rsqf(wave_allsum(sa) * (1.f / D) + NORM_EPS), rb = __builtin_amdgcn_rsqf(wave_allsum(sb) * (1.f / D) + NORM_EPS);
        GAS unsigned long long* oa = (GAS unsigned long long*)((bf16*)(ws + WS_XN) + (size_t)m * D) + F.lane; GAS unsigned long long* ob = (GAS unsigned long long*)((bf16*)(ws + WS_XN) + (size_t)m2 * D) + F.lane;
#pragma unroll
        for (int j = 0; j < 4; ++j) { const f32x4 gg = gr[64 * j];
            oa[64 * j] = (unsigned long long)pk2(va[j].x * ra * gg.x, va[j].y * ra * gg.y) | ((unsigned long long)pk2(va[j].z * ra * gg.z, va[j].w * ra * gg.w) << 32);
            ob[64 * j] = (unsigned long long)pk2(vb[j].x * rb * gg.x, vb[j].y * rb * gg.y) | ((unsigned long long)pk2(vb[j].z * rb * gg.z, vb[j].w * rb * gg.w) << 32); }
    }
}

__device__ __forceinline__ void late_weights(Frame& F, const InTab& A, int part, int nparts, int cu0) {
    int lane_ = F.lane; asm volatile("" : "+v"(lane_));
    LAS float* scr = (LAS float*)(F.lds + RING_OFF + F.wave * 16384);
    unsigned char* ws = F.ws;
    constexpr int I_A = (512 / 64) * (D / 32), I_O = (D / 64) * (D / 32), I_1 = (D / 64) * (FF / 32), I_2 = (FF / 64) * (D / 32), NIT = 2 * I_A + I_O + I_1 + I_2;
    const int per = NIT / nparts, lo = part * per, hi = lo + per;
    const int gw = (F.bx - cu0) * NWAVES + F.wave, NGW = (F.G - cu0) * NWAVES;
    for (int it = lo + gw; it < hi; it += NGW) {
        int r = it;
        if (r < I_A) { p0_transpose_item<false>(A[I_WA], 512, D, (bf16*)(ws + WS_WA), scr, r, lane_, 1024, 0); continue; } r -= I_A;
        if (r < I_A) { p0_transpose_item<false>(A[I_WB], 512, D, (bf16*)(ws + WS_WA), scr, r, lane_, 1024, 512); continue; } r -= I_A;
        if (r < I_O) { p0_transpose_item<false>(A[I_WO], D, D, (bf16*)(ws + WS_WO), scr, r, lane_); continue; } r -= I_O;
        if (r < I_1) { p0_transpose_item<false>(A[I_FF1], D, FF, (bf16*)(ws + WS_W1), scr, r, lane_); continue; } r -= I_1;
        p0_transpose_item<false>(A[I_FF2], FF, D, (bf16*)(ws + WS_W2), scr, r, lane_);
    }
}
__device__ __forceinline__ void prep1_rows(Frame& F, const InTab& A, int g0, int g1, int w, int nw) {
    const int lane = F.lane;
    const bf16* WAG = (const bf16*)(F.ws + WS_WAG); bf16* LIN = (bf16*)(F.ws + WS_LIN);
    const f32x4 mu = *(const f32x4*)(A[I_MU] + 1536 + 4 * lane);
    for (int g = g0 + w; g < g1; g += nw) {
        const int m0 = g * 8; v2u row[9];
        row[0] = (v2u){0u, 0u}; if ((m0 & (SEQ - 1)) != 0) row[0] = *(const GAS v2u*)(WAG + (size_t)(m0 - 1) * 256 + 4 * lane);
#pragma unroll
        for (int j = 0; j < 8; ++j) row[j + 1] = *(const GAS v2u*)(WAG + (size_t)(m0 + j) * 256 + 4 * lane);
#pragma unroll
        for (int j = 0; j < 8; ++j) {
            float z[4] = {bflo(row[j + 1].x), bfhi(row[j + 1].x), bflo(row[j + 1].y), bfhi(row[j + 1].y)}; const float p[4] = {bflo(row[j].x), bfhi(row[j].x), bflo(row[j].y), bfhi(row[j].y)};
#pragma unroll
            for (int e = 0; e < 4; ++e) { float v = z[e] + (p[e] - z[e]) * mu[e];
                if (lane < 16) v = 1.0f - 2.0f * __builtin_amdgcn_rcpf(1.0f + __expf(2.0f * v));
                else if (lane >= 32) v = __builtin_amdgcn_rcpf(1.0f + __expf(-v));
                z[e] = v; }
            v2u o; o.x = pk2(z[0], z[1]); o.y = pk2(z[2], z[3]);
            *(GAS v2u*)(LIN + (size_t)(m0 + j) * 256 + 4 * lane) = o;
        }
    }
}
struct ScanRaw { unsigned short r[9], k[9], v[9], a[8]; float d[8]; };
__device__ __forceinline__ void scan_load(ScanRaw& R, const bf16* RKV, const float* DEC, const bf16* AA, size_t row0, int t0, int c) {
#pragma unroll
    for (int j = 0; j < 9; ++j) { int t = t0 - 1 + j; if (t < 0) t = 0; const bf16* p = RKV + (row0 + t) * 1536 + c;
        R.r[j] = *(const GAS bf16*)p; R.k[j] = *(const GAS bf16*)(p + 512); R.v[j] = *(const GAS bf16*)(p + 1024); }
#pragma unroll
    for (int j = 0; j < 8; ++j) { R.d[j] = *(const GAS float*)(DEC + (row0 + t0 + j) * 512 + c); R.a[j] = *(const GAS bf16*)(AA + (row0 + t0 + j) * 512 + c); }
}
__device__ __forceinline__ void scan_phase(Frame& F, const InTab& A, int si) {
    const int lane = F.lane, wave = F.wave, tid = F.tid;
    const int bh = si >> 1, half = si & 1, b = bh >> 3, h = bh & 7, c = h * 64 + lane;
    LAS float* IN = (LAS float*)(F.lds + RING_OFF);
    LAS float* VV = IN + 5 * 4096;
    LAS float* YBUF = VV + 2048;
    const bf16* RKV = (const bf16*)(F.ws + WS_RKV); const float* DEC = (const float*)(F.ws + WS_DEC); const bf16* AA = (const bf16*)(F.ws + WS_AA);
    bf16* Y = (bf16*)(F.ws + WS_Y); float* BON = (float*)(F.ws + WS_BON);
    const float mu_r = A[I_MU][c], mu_k = A[I_MU][512 + c], mu_v = A[I_MU][1024 + c], kkc = A[I_KK][c], kac = A[I_KA][c], rkc = A[I_RK][c];
    const size_t row0 = (size_t)b * SEQ;
    const int myv = (int)(red4(0.f, 1.f, 2.f, 3.f) * (1.0f / 64.0f) + 0.5f);
    const int L0 = __builtin_ctzll(__ballot(myv == 0)), L1 = __builtin_ctzll(__ballot(myv == 1)), L2 = __builtin_ctzll(__ballot(myv == 2)), L3 = __builtin_ctzll(__ballot(myv == 3));
    float S0 = 0.f, S1 = 0.f, S2 = 0.f, S3 = 0.f;
    ScanRaw R; scan_load(R, RKV, DEC, AA, row0, wave * 8, c);
    for (int blk = 0; blk < SEQ / 64; ++blk) {
        {
            const int t0 = blk * 64 + wave * 8;
            f32x4 qd[2], qa[2], qb[2], qk[2], qr[2], qv[2];
#pragma unroll
            for (int j = 0; j < 8; ++j) {
                const float pz = (t0 + j == 0) ? 0.f : 1.f;
                const float rt_ = bf1(R.r[j + 1]), kt_ = bf1(R.k[j + 1]), vt_ = bf1(R.v[j + 1]);
                const float rs = rt_ + (bf1(R.r[j]) * pz - rt_) * mu_r, ks = kt_ + (bf1(R.k[j]) * pz - kt_) * mu_k, vs = vt_ + (bf1(R.v[j]) * pz - vt_) * mu_v;
                const float kkr = ks * kkc, n2 = wave_allsum(kkr * kkr), kk = kkr / __builtin_fmaxf(sqrtf(n2), 1e-12f);
                const float a = 1.0f / (1.0f + __expf(-bf1(R.a[j]))), kx = ks * (1.0f + (a - 1.0f) * kac);
                const float bon = wave_allsum(rs * kx * rkc);
                if (half == 0 && lane == 0) BON[(row0 + t0 + j) * 8 + h] = bon;
                qd[j >> 2][j & 3] = __expf(-0.6065306597f / (1.0f + __expf(-R.d[j])));     qa[j >> 2][j & 3] = -kk; qb[j >> 2][j & 3] = kk * a; qk[j >> 2][j & 3] = kx; qr[j >> 2][j & 3] = rs; qv[j >> 2][j & 3] = vs;
            }
#pragma unroll
            for (int q = 0; q < 2; ++q) { const int t4 = wave * 2 + q; LAS f32x4* p = (LAS f32x4*)IN + t4 * 64 + lane;
                p[0 * 1024] = qd[q]; p[1 * 1024] = qa[q]; p[2 * 1024] = qb[q]; p[3 * 1024] = qk[q]; p[4 * 1024] = qr[q];
                if ((lane >> 5) == half) ((LAS f32x4*)VV)[t4 * 32 + (lane & 31)] = qv[q]; }
        }
        __syncthreads();
        if (blk + 1 < SEQ / 64) scan_load(R, RKV, DEC, AA, row0, (blk + 1) * 64 + wave * 8, c);
#pragma unroll 1
        for (int t4 = 0; t4 < 16; ++t4) {
            const LAS f32x4* p = (const LAS f32x4*)IN + t4 * 64 + lane;
            const f32x4 W4 = p[0], A4 = p[1024], B4 = p[2048], K4 = p[3072], R4 = p[4096];
            const LAS f32x4* pv = (const LAS f32x4*)VV + t4 * 32 + wave * 4;
            const f32x4 V0 = pv[0], V1 = pv[1], V2 = pv[2], V3 = pv[3];
            f32x4 yq;
#pragma unroll
            for (int ts = 0; ts < 4; ++ts) {
                const float w = W4[ts], a = A4[ts], bb = B4[ts], kx = K4[ts], r = R4[ts];
                const float t = red4(S0 * a, S1 * a, S2 * a, S3 * a);
                const float sa0 = __builtin_bit_cast(float, __builtin_amdgcn_readlane(__builtin_bit_cast(int, t), L0)), sa1 = __builtin_bit_cast(float, __builtin_amdgcn_readlane(__builtin_bit_cast(int, t), L1));
                const float sa2 = __builtin_bit_cast(float, __builtin_amdgcn_readlane(__builtin_bit_cast(int, t), L2)), sa3 = __builtin_bit_cast(float, __builtin_amdgcn_readlane(__builtin_bit_cast(int, t), L3));
                S0 = S0 * w + (sa0 * bb + V0[ts] * kx); S1 = S1 * w + (sa1 * bb + V1[ts] * kx); S2 = S2 * w + (sa2 * bb + V2[ts] * kx); S3 = S3 * w + (sa3 * bb + V3[ts] * kx);
                yq[ts] = red4(S0 * r, S1 * r, S2 * r, S3 * r);
            }
            if ((lane & 15) == 0) *(LAS f32x4*)(YBUF + (wave * 4 + myv) * 68 + t4 * 4) = yq;
        }
        __syncthreads();
        { const int t = tid >> 3, rg = tid & 7; const LAS float* yb = YBUF + (4 * rg) * 68 + t;
          v2u o; o.x = pk2(yb[0], yb[68]); o.y = pk2(yb[136], yb[204]);
          *(GAS v2u*)(Y + (row0 + blk * 64 + t) * 512 + h * 64 + 32 * half + 4 * rg) = o; }
    }
    __syncthreads();
}
__device__ __forceinline__ void post_ya(Frame& F, const InTab& A, int w, int nw) {
    int lane = F.lane; asm volatile("" : "+v"(lane));
    const bf16* O = (const bf16*)(F.ws + WS_O); bf16* YA = (bf16*)(F.ws + WS_YA);
    const float lam = __expf(wave_allsum(A[I_LQ1][lane] * A[I_LK1][lane])) - __expf(wave_allsum(A[I_LQ2][lane] * A[I_LK2][lane])) + LAMBDA_INIT;
    const int ca = 8 * lane, ha = lane >> 4, ea = ca & 127;
    float sg[8];
#pragma unroll
    for (int e = 0; e < 8; ++e) sg[e] = A[I_SUBG][ea + e] * (1.0f - LAMBDA_INIT);
#define UNPK8(w_) {bflo(w_.x), bfhi(w_.x), bflo(w_.y), bfhi(w_.y), bflo(w_.z), bfhi(w_.z), bflo(w_.w), bfhi(w_.w)}
    for (int g = w; g < M / 4; g += nw) {
        const int m0 = g * 4;
        v4u o0[4], o1[4];
#pragma unroll
        for (int j = 0; j < 4; ++j) { const size_t mm = (size_t)(m0 + j);
            o0[j] = *(const GAS v4u*)(O + mm * 1024 + (2 * ha) * 128 + ea); o1[j] = *(const GAS v4u*)(O + mm * 1024 + (2 * ha + 1) * 128 + ea); }
        asm volatile("s_waitcnt vmcnt(0)" ::: "memory");
#pragma unroll
        for (int j = 0; j < 4; ++j) { const size_t mm = (size_t)(m0 + j);
            const float a0[8] = UNPK8(o0[j]), a1[8] = UNPK8(o1[j]); float o[8], ss = 0.f;
#pragma unroll
            for (int e = 0; e < 8; ++e) { o[e] = a0[e] - lam * a1[e]; ss += o[e] * o[e]; }
            const float rstd = __builtin_amdgcn_rsqf(row16_allsum(ss) * (1.0f / 128.0f) + SUBLN_EPS);
            v4u wv; wv.x = pk2(o[0] * rstd * sg[0], o[1] * rstd * sg[1]); wv.y = pk2(o[2] * rstd * sg[2], o[3] * rstd * sg[3]); wv.z = pk2(o[4] * rstd * sg[4], o[5] * rstd * sg[5]); wv.w = pk2(o[6] * rstd * sg[6], o[7] * rstd * sg[7]);
            *(GAS v4u*)(YA + mm * 1024 + ca) = wv;
        }
    }
#undef UNPK8
}

typedef short rk_bf16x8 __attribute__((ext_vector_type(8)));
typedef float rk_f32x16 __attribute__((ext_vector_type(16)));
constexpr int RKA_RS_K = 144, RKA_RS_J = 80;
constexpr int RKA_A = 0, RKA_B = 5120, RKA_K = 10240, RKA_R = 15360, RKA_AT = 19968, RKA_BH = 25088, RKA_KH = 30208, RKA_VT = 35328, RKA_GC = 40448, RKA_BYTES = 40704;
constexpr int RKA_N = 0, RKA_X = 0, RKA_T = 5120, RKA_MAK = 7680, RKA_MRB = 10240, RKA_MRK = 12800;
constexpr int RKA_WAVES = 4;
static_assert(RKA_WAVES * RKA_BYTES <= 162816, "phase A LDS");
constexpr size_t WS_PQ0 = 66 * MiB, WS_PQ1 = 34 * MiB;
constexpr size_t WS_RY0 = 98 * MiB, WS_RY1 = 178 * MiB;
constexpr size_t WS_GC = 250 * MiB;
__device__ __forceinline__ unsigned char* rk_pq(unsigned char* ws, int half) { return ws + (half ? WS_PQ1 : WS_PQ0); }
__device__ __forceinline__ unsigned char* rk_ry(unsigned char* ws, int half) { return ws + (half ? WS_RY1 : WS_RY0); }
__device__ __forceinline__ unsigned char* rk_gc(unsigned char* ws, int half) { return ws + WS_GC + (size_t)half * (2048 * 256); }
constexpr size_t WS_SST = 251 * MiB;

__device__ __forceinline__ rk_bf16x8 rk_frag(const LAS unsigned char* base, int rs, int row, int s, int h) { return *(const LAS rk_bf16x8*)(base + row * rs + (16 * s + 8 * h) * 2); }
__device__ __forceinline__ rk_f32x16 rk_mfma(rk_bf16x8 a, rk_bf16x8 b, rk_f32x16 c) { return __builtin_amdgcn_mfma_f32_32x32x16_bf16(a, b, c, 0, 0, 0); }
__device__ __forceinline__ unsigned rk_pk(float lo, float hi) { typedef float f2_ __attribute__((ext_vector_type(2))); typedef __bf16 b2_ __attribute__((ext_vector_type(2))); f2_ v = {lo, hi}; b2_ b = __builtin_convertvector(v, b2_); return __builtin_bit_cast(unsigned, b); }
__device__ __forceinline__ void rk_store_tile_lds(LAS unsigned char* base, int rs, int nrow, int mbase, int h, const rk_f32x16& acc) {
#pragma unroll
    for (int g = 0; g < 4; ++g) { v2u w; w.x = rk_pk(acc[4 * g], acc[4 * g + 1]); w.y = rk_pk(acc[4 * g + 2], acc[4 * g + 3]); *(LAS v2u*)(base + nrow * rs + (mbase + 8 * g + 4 * h) * 2) = w; }
}
__device__ __forceinline__ void rk_store_tile_glb(bf16* base, int pitch, int nrow, int mbase, int h, const rk_f32x16& acc) {
#pragma unroll
    for (int g = 0; g < 4; ++g) { v2u w; w.x = rk_pk(acc[4 * g], acc[4 * g + 1]); w.y = rk_pk(acc[4 * g + 2], acc[4 * g + 3]); *(GAS v2u*)(base + (size_t)nrow * pitch + mbase + 8 * g + 4 * h) = w; }
}
__device__ __forceinline__ void rk_store_tile_frag(unsigned char* base, int nt, int r32, int mt, int h, const rk_f32x16& acc) {
#pragma unroll
    for (int g = 0; g < 4; ++g) { v2u w; w.x = rk_pk(acc[4 * g], acc[4 * g + 1]); w.y = rk_pk(acc[4 * g + 2], acc[4 * g + 3]);
        *(GAS v2u*)(base + ((size_t)((nt * 4 + 2 * mt + (g >> 1)) * 64 + r32 + 32 * (g & 1))) * 16 + 8 * h) = w; }
}
__device__ __forceinline__ void rk_store_blob(unsigned* blob, int lane, const rk_f32x16& acc) {
    v4u w0, w1; w0.x = rk_pk(acc[0], acc[1]); w0.y = rk_pk(acc[2], acc[3]); w0.z = rk_pk(acc[4], acc[5]); w0.w = rk_pk(acc[6], acc[7]);
    w1.x = rk_pk(acc[8], acc[9]); w1.y = rk_pk(acc[10], acc[11]); w1.z = rk_pk(acc[12], acc[13]); w1.w = rk_pk(acc[14], acc[15]);
    *(GAS v4u*)(blob + lane * 8) = w0; *(GAS v4u*)(blob + lane * 8 + 4) = w1;
}
struct RkBlob { v4u w0, w1; };
__device__ __forceinline__ RkBlob rk_load_blob(const unsigned* blob, int lane) { RkBlob b; b.w0 = *(const GAS v4u*)(blob + lane * 8); b.w1 = *(const GAS v4u*)(blob + lane * 8 + 4); return b; }
__device__ __forceinline__ rk_f32x16 rk_blob_f32(const RkBlob& b) {
    rk_f32x16 a; const unsigned w[8] = {b.w0.x, b.w0.y, b.w0.z, b.w0.w, b.w1.x, b.w1.y, b.w1.z, b.w1.w};
#pragma unroll
    for (int i = 0; i < 8; ++i) { a[2 * i] = bflo(w[i]); a[2 * i + 1] = bfhi(w[i]); }
    return a;
}

struct RkRaw { unsigned short r[8], k[8], v[8]; };
__device__ __forceinline__ void rk_load8(RkRaw& R, const bf16* prkv) {
#pragma unroll
    for (int j = 0; j < 8; ++j) { R.r[j] = *(const GAS bf16*)(prkv + j * 1536); R.k[j] = *(const GAS bf16*)(prkv + j * 1536 + 512); R.v[j] = *(const GAS bf16*)(prkv + j * 1536 + 1024); }
}
__device__ __forceinline__ void rwkvA_unit(LAS unsigned char* L, const InTab& A, unsigned char* ws, int bh, int chunk, int lane_in) {
    int lane = lane_in; asm volatile("" : "+v"(lane));
    const int b = bh >> 3, hd = bh & 7, cg = hd * 64 + lane, r32 = lane & 31, h = lane >> 5;
    const size_t row0 = (size_t)b * SEQ + (size_t)chunk * 32;
    const int uh = bh * 32 + (chunk & 31);
    const bf16* prkv = (const bf16*)(ws + WS_RKV) + row0 * 1536 + cg;
    float* pbon = (float*)(ws + WS_BON) + row0 * 8 + hd;
    const float mu_r = A[I_MU][cg], mu_k = A[I_MU][512 + cg], mu_v = A[I_MU][1024 + cg], kkc = A[I_KK][cg], kac = A[I_KA][cg], rkc = A[I_RK][cg], w0c = A[I_W0][cg], a0c = A[I_A0][cg];
    float dW[32], dA[32];
    {
        rk_f32x16 lw[2] = {{}, {}}, la[2] = {{}, {}};
        const bf16* lp = (const bf16*)(ws + WS_LIN) + (row0 + r32) * 256 + 8 * h;
        const bf16* wp = (const bf16*)(ws + WS_WL) + (size_t)(hd * 64 + r32) * 256 + 8 * h;
#pragma unroll
        for (int s2 = 0; s2 < 4; ++s2) { const rk_bf16x8 fw = __builtin_bit_cast(rk_bf16x8, *(const GAS v4u*)(lp + 16 * s2)), fa = __builtin_bit_cast(rk_bf16x8, *(const GAS v4u*)(lp + 64 + 16 * s2));
#pragma unroll
            for (int ct = 0; ct < 2; ++ct) { lw[ct] = rk_mfma(fw, __builtin_bit_cast(rk_bf16x8, *(const GAS v4u*)(wp + (size_t)ct * 32 * 256 + 16 * s2)), lw[ct]);
                la[ct] = rk_mfma(fa, __builtin_bit_cast(rk_bf16x8, *(const GAS v4u*)(wp + (size_t)(512 + ct * 32) * 256 + 64 + 16 * s2)), la[ct]); } }
#pragma unroll
        for (int i = 0; i < 16; ++i) { const int tb = (i & 3) + 8 * (i >> 2);
            { auto r = __builtin_amdgcn_permlane32_swap(f2u(lw[0][i]), f2u(lw[1][i]), false, false); const unsigned r0 = r[0], r1 = r[1]; dW[tb] = u2f(r0); dW[tb + 4] = u2f(r1); }
            { auto r = __builtin_amdgcn_permlane32_swap(f2u(la[0][i]), f2u(la[1][i]), false, false); const unsigned r0 = r[0], r1 = r[1]; dA[tb] = u2f(r0); dA[tb + 4] = u2f(r1); } }
    }
    const int myv = (int)(red4(0.f, 1.f, 2.f, 3.f) * (1.0f / 64.0f) + 0.5f);
    const int L0 = __builtin_ctzll(__ballot(myv == 0)), L1 = __builtin_ctzll(__ballot(myv == 1)), L2 = __builtin_ctzll(__ballot(myv == 2)), L3 = __builtin_ctzll(__ballot(myv == 3));
    float rp = 0.f, kp = 0.f, vp = 0.f;
    if (chunk != 0) { rp = bf1(*(const GAS bf16*)(prkv - 1536)); kp = bf1(*(const GAS bf16*)(prkv - 1536 + 512)); vp = bf1(*(const GAS bf16*)(prkv - 1536 + 1024)); }
    float G = 1.0f;
    RkRaw Rc, Rn; rk_load8(Rc, prkv);
#pragma unroll
    for (int q = 0; q < 4; ++q) {
        prkv += 8 * 1536;
        if (q < 3) rk_load8(Rn, prkv);
        LAS unsigned char* Lr = L + (8 * q) * RKA_RS_K + lane * 2;
        LAS unsigned char* Lt = L + lane * RKA_RS_J + (8 * q) * 2;
        unsigned tA[4], tB[4], tK[4], tV[4], pA = 0, pB = 0, pK = 0, pV = 0;
        float rs_[8], kx_[8], kkr_[8], a8_[8], w8_[8], vs_[8];
#pragma unroll
        for (int j = 0; j < 8; ++j) {
            const float rc = bf1(Rc.r[j]), kc = bf1(Rc.k[j]), vc = bf1(Rc.v[j]);
            const float ks = kc + (kp - kc) * mu_k; rs_[j] = rc + (rp - rc) * mu_r; vs_[j] = vc + (vp - vc) * mu_v; rp = rc; kp = kc; vp = vc;
            kkr_[j] = ks * kkc; a8_[j] = __builtin_amdgcn_rcpf(1.0f + __expf(-(a0c + dA[8 * q + j]))); kx_[j] = ks * (1.0f + (a8_[j] - 1.0f) * kac);
            w8_[j] = __expf(-0.6065306597f * __builtin_amdgcn_rcpf(1.0f + __expf(-(w0c + dW[8 * q + j]))));
        }
        float n2_[8], bon_[8];
#pragma unroll
        for (int j = 0; j < 8; j += 2) {
            const float t = red4(kkr_[j] * kkr_[j], kkr_[j + 1] * kkr_[j + 1], rs_[j] * kx_[j] * rkc, rs_[j + 1] * kx_[j + 1] * rkc);
            n2_[j] = __builtin_bit_cast(float, __builtin_amdgcn_readlane(__builtin_bit_cast(int, t), L0)); n2_[j + 1] = __builtin_bit_cast(float, __builtin_amdgcn_readlane(__builtin_bit_cast(int, t), L1));
            bon_[j] = __builtin_bit_cast(float, __builtin_amdgcn_readlane(__builtin_bit_cast(int, t), L2)); bon_[j + 1] = __builtin_bit_cast(float, __builtin_amdgcn_readlane(__builtin_bit_cast(int, t), L3));
        }
        if (lane < 8) { float bv = bon_[0];
#pragma unroll
            for (int j = 1; j < 8; ++j) bv = (lane == j) ? bon_[j] : bv;
            *(GAS float*)(pbon + (8 * q + lane) * 8) = bv; }
        unsigned tR[4];
#pragma unroll
        for (int j = 0; j < 8; j += 2) {
            const float kk0 = kkr_[j] * __builtin_amdgcn_rsqf(__builtin_fmaxf(n2_[j], 1e-24f)), kk1 = kkr_[j + 1] * __builtin_amdgcn_rsqf(__builtin_fmaxf(n2_[j + 1], 1e-24f));
            const float G0 = G; const float G1 = G0 * w8_[j]; G = G1 * w8_[j + 1]; const float i1 = __builtin_amdgcn_rcpf(G1), i2 = __builtin_amdgcn_rcpf(G);
            tA[j >> 1] = rk_pk(-kk0 * G0, -kk1 * G1); tR[j >> 1] = rk_pk(rs_[j] * G1, rs_[j + 1] * G); tB[j >> 1] = rk_pk(kk0 * a8_[j] * i1, kk1 * a8_[j + 1] * i2); tK[j >> 1] = rk_pk(kx_[j] * i1, kx_[j + 1] * i2); tV[j >> 1] = rk_pk(vs_[j], vs_[j + 1]);
            *(LAS bf16*)(Lr + RKA_A + j * RKA_RS_K) = (bf16)(tA[j >> 1] & 0xffffu); *(LAS bf16*)(Lr + RKA_A + (j + 1) * RKA_RS_K) = (bf16)(tA[j >> 1] >> 16);
            *(LAS bf16*)(Lr + RKA_R + j * RKA_RS_K) = (bf16)(tR[j >> 1] & 0xffffu); *(LAS bf16*)(Lr + RKA_R + (j + 1) * RKA_RS_K) = (bf16)(tR[j >> 1] >> 16);
            *(LAS bf16*)(Lr + RKA_B + j * RKA_RS_K) = (bf16)(tB[j >> 1] & 0xffffu); *(LAS bf16*)(Lr + RKA_B + (j + 1) * RKA_RS_K) = (bf16)(tB[j >> 1] >> 16);
            *(LAS bf16*)(Lr + RKA_K + j * RKA_RS_K) = (bf16)(tK[j >> 1] & 0xffffu); *(LAS bf16*)(Lr + RKA_K + (j + 1) * RKA_RS_K) = (bf16)(tK[j >> 1] >> 16);
        }
        (void)pA; (void)pB; (void)pK; (void)pV;
        *(LAS v4u*)(Lt + RKA_AT) = (v4u){tA[0], tA[1], tA[2], tA[3]}; *(LAS v4u*)(Lt + RKA_BH) = (v4u){tB[0], tB[1], tB[2], tB[3]}; *(LAS v4u*)(Lt + RKA_KH) = (v4u){tK[0], tK[1], tK[2], tK[3]}; *(LAS v4u*)(Lt + RKA_VT) = (v4u){tV[0], tV[1], tV[2], tV[3]};
        Rc = Rn;
    }
    const float GC = G;
    *(GAS float*)((float*)rk_gc(ws, chunk >> 5) + (size_t)uh * 64 + lane) = GC;
    *(LAS float*)(L + RKA_GC + lane * 4) = GC;
    LDS_WAIT(); asm volatile("" ::: "memory");
    {
        rk_f32x16 aN = {}, aAK = {}, aRB = {}, aRK = {};
#pragma unroll
        for (int s = 0; s < 4; ++s) {
            const rk_bf16x8 fA = rk_frag(L + RKA_A, RKA_RS_K, r32, s, h), fR = rk_frag(L + RKA_R, RKA_RS_K, r32, s, h), fB = rk_frag(L + RKA_B, RKA_RS_K, r32, s, h), fK = rk_frag(L + RKA_K, RKA_RS_K, r32, s, h);
            aN = rk_mfma(fB, fA, aN); aAK = rk_mfma(fK, fA, aAK); aRB = rk_mfma(fB, fR, aRB); aRK = rk_mfma(fK, fR, aRK);
        }
        LDS_WAIT(); asm volatile("" ::: "memory");
#pragma unroll
        for (int i = 0; i < 16; ++i) { const int j = (i & 3) + 8 * (i >> 2) + 4 * h;
            if (!(j < r32)) { aN[i] = 0.f; aAK[i] = 0.f; }
            if (!(j <= r32)) { aRB[i] = 0.f; aRK[i] = 0.f; } }
#pragma unroll
        for (int g = 0; g < 4; ++g) *(LAS f32x4*)(L + RKA_N + r32 * 144 + (8 * g + 4 * h) * 4) = (f32x4){aN[4 * g], aN[4 * g + 1], aN[4 * g + 2], aN[4 * g + 3]};
        rk_store_tile_lds(L + RKA_MAK, RKA_RS_J, r32, 0, h, aAK); rk_store_tile_lds(L + RKA_MRB, RKA_RS_J, r32, 0, h, aRB); rk_store_tile_lds(L + RKA_MRK, RKA_RS_J, r32, 0, h, aRK);
        rk_store_tile_lds(L + RKA_T, RKA_RS_J, r32, 0, h, aN);
    }
    LDS_WAIT(); asm volatile("" ::: "memory");
    {
        const int blk = (r32 >> 4) & 1, cc = r32 & 15;
        const LAS unsigned char* Nb = L + RKA_N + (16 * blk) * 144 + (16 * blk) * 4;
        float T[16];
#pragma unroll
        for (int t = 0; t < 16; ++t) { float ac[4] = {(cc == t) ? 1.0f : 0.0f, 0.f, 0.f, 0.f};
#pragma unroll
            for (int j4 = 0; j4 < (t + 3) / 4; ++j4) { const f32x4 n4 = *(const LAS f32x4*)(Nb + t * 144 + j4 * 16);
#pragma unroll
                for (int e = 0; e < 4; ++e) if (4 * j4 + e < t) ac[e] += n4[e] * T[4 * j4 + e]; }
            T[t] = (ac[0] + ac[1]) + (ac[2] + ac[3]); }
        LDS_WAIT(); asm volatile("" ::: "memory");
#pragma unroll
        for (int t = 0; t < 16; ++t) *(LAS bf16*)(L + RKA_T + (16 * blk + t) * RKA_RS_J + r32 * 2) = (bf16)f2bf(T[t]);
        if (blk == 0) { LAS v4u* p = (LAS v4u*)(L + RKA_N + cc * RKA_RS_J);
            p[0] = (v4u){pk2(T[0], T[1]), pk2(T[2], T[3]), pk2(T[4], T[5]), pk2(T[6], T[7])}; p[1] = (v4u){pk2(T[8], T[9]), pk2(T[10], T[11]), pk2(T[12], T[13]), pk2(T[14], T[15])}; }
        LDS_WAIT(); asm volatile("" ::: "memory");
        rk_f32x16 xa = {};
        xa = rk_mfma(*(const LAS rk_bf16x8*)(L + RKA_T + (16 + r32) * RKA_RS_J + 16 * h), *(const LAS rk_bf16x8*)(L + RKA_N + r32 * RKA_RS_J + 16 * h), xa);
        if (r32 < 16) {
#pragma unroll
            for (int g = 0; g < 2; ++g) { v2u w; w.x = rk_pk(xa[4 * g], xa[4 * g + 1]); w.y = rk_pk(xa[4 * g + 2], xa[4 * g + 3]); *(LAS v2u*)(L + RKA_N + 1280 + r32 * RKA_RS_J + (8 * g + 4 * h) * 2) = w; } }
        LDS_WAIT(); asm volatile("" ::: "memory");
        rk_f32x16 ta = {};
        ta = rk_mfma(*(const LAS rk_bf16x8*)(L + RKA_N + 1280 + r32 * RKA_RS_J + 16 * h), *(const LAS rk_bf16x8*)(L + RKA_T + (16 + r32) * RKA_RS_J + (16 + 8 * h) * 2), ta);
        LDS_WAIT(); asm volatile("" ::: "memory");
        if (r32 < 16) {
#pragma unroll
            for (int g = 0; g < 2; ++g) { v2u w; w.x = rk_pk(ta[4 * g], ta[4 * g + 1]); w.y = rk_pk(ta[4 * g + 2], ta[4 * g + 3]); *(LAS v2u*)(L + RKA_T + (16 + r32) * RKA_RS_J + (8 * g + 4 * h) * 2) = w; } }
    }
    LDS_WAIT(); asm volatile("" ::: "memory");
    rk_bf16x8 fT[2];
#pragma unroll
    for (int s = 0; s < 2; ++s) fT[s] = rk_frag(L + RKA_T, RKA_RS_J, r32, s, h);
    {
        rk_f32x16 x0[2] = {{}, {}}, ap[2] = {{}, {}};
#pragma unroll
        for (int s = 0; s < 2; ++s) { const rk_bf16x8 fM = rk_frag(L + RKA_MAK, RKA_RS_J, r32, s, h);
#pragma unroll
            for (int nt = 0; nt < 2; ++nt) { x0[nt] = rk_mfma(fM, rk_frag(L + RKA_VT, RKA_RS_J, nt * 32 + r32, s, h), x0[nt]); ap[nt] = rk_mfma(fT[s], rk_frag(L + RKA_AT, RKA_RS_J, nt * 32 + r32, s, h), ap[nt]); } }
        LDS_WAIT(); asm volatile("" ::: "memory");
#pragma unroll
        for (int nt = 0; nt < 2; ++nt) { rk_store_tile_lds(L + RKA_X, RKA_RS_J, nt * 32 + r32, 0, h, x0[nt]); rk_store_tile_lds(L + RKA_AT, RKA_RS_J, nt * 32 + r32, 0, h, ap[nt]); }
    }
    LDS_WAIT(); asm volatile("" ::: "memory");
    {
        rk_f32x16 u0[2] = {{}, {}};
#pragma unroll
        for (int s = 0; s < 2; ++s)
#pragma unroll
            for (int nt = 0; nt < 2; ++nt) u0[nt] = rk_mfma(fT[s], rk_frag(L + RKA_X, RKA_RS_J, nt * 32 + r32, s, h), u0[nt]);
        LDS_WAIT(); asm volatile("" ::: "memory");
#pragma unroll
        for (int nt = 0; nt < 2; ++nt) rk_store_tile_lds(L + RKA_X, RKA_RS_J, nt * 32 + r32, 0, h, u0[nt]);
    }
    LDS_WAIT(); asm volatile("" ::: "memory");
    unsigned char* pq = rk_pq(ws, chunk >> 5) + (size_t)uh * 16384; unsigned char* ry = rk_ry(ws, chunk >> 5) + (size_t)uh * 8192;
    rk_bf16x8 fRB[2], fRK[2], fAp[2][2], fBh[2][2], fKh[2][2], fU[2][2], fV[2][2];
#pragma unroll
    for (int s = 0; s < 2; ++s) { fRB[s] = rk_frag(L + RKA_MRB, RKA_RS_J, r32, s, h); fRK[s] = rk_frag(L + RKA_MRK, RKA_RS_J, r32, s, h);
#pragma unroll
        for (int nt = 0; nt < 2; ++nt) { fAp[nt][s] = rk_frag(L + RKA_AT, RKA_RS_J, nt * 32 + r32, s, h); fBh[nt][s] = rk_frag(L + RKA_BH, RKA_RS_J, nt * 32 + r32, s, h);
            fKh[nt][s] = rk_frag(L + RKA_KH, RKA_RS_J, nt * 32 + r32, s, h); fU[nt][s] = rk_frag(L + RKA_X, RKA_RS_J, nt * 32 + r32, s, h); fV[nt][s] = rk_frag(L + RKA_VT, RKA_RS_J, nt * 32 + r32, s, h); } }
#pragma unroll
    for (int kt = 0; kt < 2; ++kt) {
        rk_f32x16 acc;
#pragma unroll
        for (int g = 0; g < 4; ++g) { const v2u w = *(const LAS v2u*)(L + RKA_R + r32 * RKA_RS_K + (kt * 32 + 8 * g + 4 * h) * 2); acc[4 * g] = bflo(w.x); acc[4 * g + 1] = bfhi(w.x); acc[4 * g + 2] = bflo(w.y); acc[4 * g + 3] = bfhi(w.y); }
#pragma unroll
        for (int s = 0; s < 2; ++s) acc = rk_mfma(fAp[kt][s], fRB[s], acc);
        rk_store_tile_frag(ry, 0, r32, kt, h, acc);
    }
#pragma unroll
    for (int kt = 0; kt < 2; ++kt)
#pragma unroll
        for (int kq = 0; kq < 2; ++kq) { rk_f32x16 acc = {};
#pragma unroll
            for (int s = 0; s < 2; ++s) acc = rk_mfma(fAp[kq][s], fBh[kt][s], acc);
            acc = acc * *(const LAS float*)(L + RKA_GC + (kt * 32 + r32) * 4);
            rk_store_tile_frag(pq, kt, r32, kq, h, acc); }
#pragma unroll
    for (int vt = 0; vt < 2; ++vt) {
        rk_f32x16 acc = {};
#pragma unroll
        for (int s = 0; s < 2; ++s) { acc = rk_mfma(fU[vt][s], fRB[s], acc); acc = rk_mfma(fV[vt][s], fRK[s], acc); }
        rk_store_blob((unsigned*)(ry + 4096) + vt * 512, lane, acc);
    }
#pragma unroll
    for (int kt = 0; kt < 2; ++kt)
#pragma unroll
        for (int vt = 0; vt < 2; ++vt) { rk_f32x16 acc = {};
#pragma unroll
            for (int s = 0; s < 2; ++s) { acc = rk_mfma(fBh[kt][s], fU[vt][s], acc); acc = rk_mfma(fKh[kt][s], fV[vt][s], acc); }
#pragma unroll
            for (int g = 0; g < 4; ++g) { const f32x4 gq = *(const LAS f32x4*)(L + RKA_GC + (kt * 32 + 8 * g + 4 * h) * 4); acc[4 * g] *= gq[0]; acc[4 * g + 1] *= gq[1]; acc[4 * g + 2] *= gq[2]; acc[4 * g + 3] *= gq[3]; }
            rk_store_blob((unsigned*)(pq + 8192) + (kt * 2 + vt) * 512, lane, acc); }
    LDS_WAIT(); asm volatile("" ::: "memory");
}
__device__ __forceinline__ void rwkvA_phase(Frame& F, const InTab& A, int half) {
    if (F.wave >= RKA_WAVES) { if (half == 0) post_ya(F, A, F.bx * (NWAVES - RKA_WAVES) + (F.wave - RKA_WAVES), F.G * (NWAVES - RKA_WAVES)); return; }
    LAS unsigned char* L = F.lds + RING_OFF + F.wave * RKA_BYTES;
    const int gw = F.bx * RKA_WAVES + F.wave, NGW = F.G * RKA_WAVES;
    for (int u = gw; u < 64 * 32; u += NGW) rwkvA_unit(L, A, F.ws, u >> 5, half * 32 + (u & 31), F.lane);
}
__device__ __forceinline__ void rwkvA_queue(Frame& F, const InTab& A, int half, unsigned* counter) {
    if (F.wave >= RKA_WAVES) return;
    LAS unsigned char* L = F.lds + RING_OFF + F.wave * RKA_BYTES;
    for (;;) {
        unsigned u = 0; if (F.lane == 0) u = __hip_atomic_fetch_add(counter, 1u, __ATOMIC_RELAXED, __HIP_MEMORY_SCOPE_AGENT);
        u = __builtin_amdgcn_readfirstlane(u);
        if (u >= 64u * 32u) break;
        rwkvA_unit(L, A, F.ws, (int)(u >> 5), half * 32 + (int)(u & 31), F.lane);
    }
}
constexpr int RKB_RS = 144, RKB_SBUF = 64 * RKB_RS;
constexpr int RKB_YOFF = 2 * RKB_SBUF + 8192, RKB_YRS = 68, RKB_YBYTES = 32 * RKB_YRS * 4;
__device__ __forceinline__ void rwkvB_phase(Frame& F, const InTab& A, int bh, int half) {
    int lane = F.lane; asm volatile("" : "+v"(lane));
    const int wave = F.wave, r32 = lane & 31, h = lane >> 5;
    LAS unsigned char* SB = F.lds + RING_OFF;
    unsigned char* ws = F.ws;
    const int b = bh >> 3, hd = bh & 7;
    const int kt = (wave >> 1) & 1, vt = wave & 1;
    float* sst = (float*)(ws + WS_SST) + (size_t)bh * 4096 + (size_t)(wave & 3) * 1024;
    rk_f32x16 st = {};
    if (wave < 4) {
        if (half != 0) {
#pragma unroll
            for (int i = 0; i < 16; ++i) st[i] = *(const GAS float*)(sst + i * 64 + lane);
        }
        rk_store_tile_lds(SB, RKB_RS, vt * 32 + r32, kt * 32, h, st);
    }
    const int uh0 = bh * 32; const bool isS = wave < 4, isY = !isS && wave < 6;
    const unsigned char* fptr = isS ? rk_pq(ws, half) + (size_t)uh0 * 16384 + (kt * 256 + lane) * 16 : rk_ry(ws, half) + (size_t)uh0 * 8192 + lane * 16;
    const unsigned char* bptr = isS ? rk_pq(ws, half) + (size_t)uh0 * 16384 + 8192 + (kt * 2 + vt) * 2048 + lane * 32 : rk_ry(ws, half) + (size_t)uh0 * 8192 + 4096 + vt * 2048 + lane * 32;
    const LAS unsigned char* gl = SB + 2 * RKB_SBUF + (kt * 32 + 4 * h) * 4;
    const int fstride = isS ? 16384 : 8192;
    struct Op { v4u f[4]; v4u b0, b1; };
    { const int tid_ = wave * 64 + lane; *(LAS f32x4*)(SB + 2 * RKB_SBUF + tid_ * 16) = *(const GAS f32x4*)(rk_gc(ws, half) + (size_t)uh0 * 256 + tid_ * 16); }
    { const int tid_ = wave * 64 + lane; if (tid_ < 192) { const int e_ = tid_ & 63; const float* src_ = tid_ < 64 ? A[I_LNG] + hd * 64 : (tid_ < 128 ? A[I_LNB] + hd * 64 : A[I_MU] + 1024 + hd * 64);
        ((LAS float*)(SB + RKB_YOFF + 2 * RKB_YBYTES))[tid_] = src_[e_]; } }
    Op o0, o1, o2;
#define RKB_LOAD(O_, c) do { const unsigned char* fp_ = fptr + (size_t)(c) * fstride; const unsigned char* bp_ = bptr + (size_t)(c) * fstride; \
        _Pragma("unroll") for (int s = 0; s < 4; ++s) O_.f[s] = *(const GAS v4u*)(fp_ + 1024 * s); \
        O_.b0 = *(const GAS v4u*)bp_; O_.b1 = *(const GAS v4u*)(bp_ + 16); } while (0)
#define RKB_BAR() do { asm volatile("s_waitcnt lgkmcnt(0)" ::: "memory"); __builtin_amdgcn_s_barrier(); asm volatile("" ::: "memory"); } while (0)
#define RKB_NEXT(O_, c, AH_) RKB_LOAD(O_, ((c) + (AH_) < 32 ? (c) + (AH_) : 31))
#define RKB_STEP_S(O_, c) do { \
        const LAS unsigned char* cur = SB + ((c) & 1) * RKB_SBUF; LAS unsigned char* nxt = SB + (((c) & 1) ^ 1) * RKB_SBUF; \
        rk_bf16x8 fS[4]; _Pragma("unroll") for (int s = 0; s < 4; ++s) fS[s] = rk_frag(cur, RKB_RS, vt * 32 + r32, s, h); \
        RkBlob bb_; bb_.w0 = O_.b0; bb_.w1 = O_.b1; const rk_f32x16 q = rk_blob_f32(bb_); \
        _Pragma("unroll") for (int g = 0; g < 4; ++g) { const f32x4 gq = *(const LAS f32x4*)(gl + (c) * 256 + 32 * g); \
            st[4 * g] = st[4 * g] * gq[0] + q[4 * g]; st[4 * g + 1] = st[4 * g + 1] * gq[1] + q[4 * g + 1]; st[4 * g + 2] = st[4 * g + 2] * gq[2] + q[4 * g + 2]; st[4 * g + 3] = st[4 * g + 3] * gq[3] + q[4 * g + 3]; } \
        _Pragma("unroll") for (int s = 0; s < 4; ++s) st = rk_mfma(__builtin_bit_cast(rk_bf16x8, O_.f[s]), fS[s], st); \
        RKB_NEXT(O_, c, 5); \
        rk_store_tile_lds(nxt, RKB_RS, vt * 32 + r32, kt * 32, h, st); \
        RKB_BAR(); } while (0)
#define RKB_Y_BODY(O_, c) do { \
        const LAS unsigned char* cur = SB + ((c) & 1) * RKB_SBUF; \
        rk_bf16x8 fS[4]; _Pragma("unroll") for (int s = 0; s < 4; ++s) fS[s] = rk_frag(cur, RKB_RS, vt * 32 + r32, s, h); \
        RkBlob bb_; bb_.w0 = O_.b0; bb_.w1 = O_.b1; rk_f32x16 acc = rk_blob_f32(bb_); \
        _Pragma("unroll") for (int s = 0; s < 4; ++s) acc = rk_mfma(fS[s], __builtin_bit_cast(rk_bf16x8, O_.f[s]), acc);       \
        RKB_NEXT(O_, c, 3); \
        { LAS float* yb_ = (LAS float*)(SB + RKB_YOFF + ((c) & 1) * RKB_YBYTES) + r32 * RKB_YRS + 32 * vt + 4 * h;        \
          _Pragma("unroll") for (int g = 0; g < 4; ++g) *(LAS f32x4*)(yb_ + 8 * g) = (f32x4){acc[4 * g], acc[4 * g + 1], acc[4 * g + 2], acc[4 * g + 3]}; } \
        } while (0)
    __syncthreads();
    if (isS) {
        Op o3, o4; RKB_LOAD(o0, 0); RKB_LOAD(o1, 1); RKB_LOAD(o2, 2); RKB_LOAD(o3, 3); RKB_LOAD(o4, 4);
#define R5S(c) RKB_STEP_S(o0, c); RKB_STEP_S(o1, (c) + 1); RKB_STEP_S(o2, (c) + 2); RKB_STEP_S(o3, (c) + 3); RKB_STEP_S(o4, (c) + 4);
        R5S(0) R5S(5) R5S(10) R5S(15) R5S(20) R5S(25)
        RKB_STEP_S(o0, 30); RKB_STEP_S(o1, 31);
#undef R5S
    } else {
        const int tl = 8 * (wave - 4) + (lane >> 3), q8 = lane & 7, ch = hd * 64 + 8 * q8;
        float lg[8], lb[8], muv[8];
        { const LAS float* ctab = (const LAS float*)(SB + RKB_YOFF + 2 * RKB_YBYTES) + 8 * q8;
#pragma unroll
          for (int j = 0; j < 2; ++j) { const f32x4 a_ = *(const LAS f32x4*)(ctab + 4 * j), b_ = *(const LAS f32x4*)(ctab + 64 + 4 * j), c_ = *(const LAS f32x4*)(ctab + 128 + 4 * j);
#pragma unroll
            for (int i = 0; i < 4; ++i) { lg[4 * j + i] = a_[i]; lb[4 * j + i] = b_[i]; muv[4 * j + i] = c_[i]; } } }
        const GAS unsigned char* RKVp = (const GAS unsigned char*)(ws + WS_RKV) + 2048; const GAS unsigned char* GGp = (const GAS unsigned char*)(ws + WS_GG); const GAS unsigned char* BONp = (const GAS unsigned char*)(ws + WS_BON); GAS unsigned char* YAp = (GAS unsigned char*)(ws + WS_YA) + 1024;
        const unsigned mlane = (unsigned)(b * SEQ + half * 1024 + tl);
        const unsigned og = (mlane * 512u + (unsigned)ch) * 2u, ov = (mlane * 1536u + (unsigned)ch) * 2u, ob = (mlane * 8u + (unsigned)hd) * 4u, oy = (mlane * 1024u + (unsigned)ch) * 2u;
        struct Pp { v4u g, v, p; float bon; };
#define RKB_PLOAD(P_, c) do { \
        P_.g = *(const GAS v4u*)(GGp + (size_t)(c) * 32768 + og); P_.v = *(const GAS v4u*)(RKVp + (size_t)(c) * 98304 + ov); P_.p = *(const GAS v4u*)(RKVp + ((long)(c) * 98304 - 3072) + ov); \
        P_.bon = *(const GAS float*)(BONp + (size_t)(c) * 1024 + ob); } while (0)
#define RKB_UNPK8(w_) {bflo(w_.x), bfhi(w_.x), bflo(w_.y), bfhi(w_.y), bflo(w_.z), bfhi(w_.z), bflo(w_.w), bfhi(w_.w)}
#define RKB_POST(P_, c) do { asm volatile("" : "+v"(P_.g), "+v"(P_.v), "+v"(P_.p));        \
        const LAS float* yb_ = (const LAS float*)(SB + RKB_YOFF + ((c) & 1) * RKB_YBYTES) + tl * RKB_YRS + 8 * q8; \
        const f32x4 ya_ = *(const LAS f32x4*)yb_, yc_ = *(const LAS f32x4*)(yb_ + 4); const float y[8] = {ya_[0], ya_[1], ya_[2], ya_[3], yc_[0], yc_[1], yc_[2], yc_[3]}; \
        const float mean = oct_allsum(((y[0] + y[1]) + (y[2] + y[3])) + ((y[4] + y[5]) + (y[6] + y[7]))) * (1.0f / 64.0f); \
        float q_ = 0.f; _Pragma("unroll") for (int e = 0; e < 8; ++e) { const float d_ = y[e] - mean; q_ += d_ * d_; } \
        const float rstd = __builtin_amdgcn_rsqf(oct_allsum(q_) * (1.0f / 64.0f) + GN_EPS); \
        const bool first_ = (((mlane + 32u * (unsigned)(c)) & (unsigned)(SEQ - 1)) == 0u);        \
        const float ga[8] = RKB_UNPK8(P_.g), va[8] = RKB_UNPK8(P_.v), pa[8] = RKB_UNPK8(P_.p); float r[8]; \
        _Pragma("unroll") for (int e = 0; e < 8; ++e) { const float pe_ = first_ ? 0.f : pa[e]; const float vs_ = va[e] + (pe_ - va[e]) * muv[e]; r[e] = (((y[e] - mean) * rstd) * lg[e] + lb[e] + P_.bon * vs_) * ga[e]; } \
        v4u w0; w0.x = rk_pk(r[0], r[1]); w0.y = rk_pk(r[2], r[3]); w0.z = rk_pk(r[4], r[5]); w0.w = rk_pk(r[6], r[7]); \
        *(GAS v4u*)(YAp + (size_t)(c) * 65536 + oy) = w0; \
        RKB_PLOAD(P_, ((c) + 3 < 32 ? (c) + 3 : 31)); } while (0)
        Pp p0, p1, p2; RKB_PLOAD(p0, 0); RKB_PLOAD(p1, 1); RKB_PLOAD(p2, 2);
        if (isY) {
            RKB_LOAD(o0, 0); RKB_LOAD(o1, 1); RKB_LOAD(o2, 2);
            RKB_Y_BODY(o0, 0); RKB_BAR();
#define R3YP(c) RKB_Y_BODY(o1, c); RKB_POST(p0, (c) - 1); RKB_BAR(); RKB_Y_BODY(o2, (c) + 1); RKB_POST(p1, c); RKB_BAR(); RKB_Y_BODY(o0, (c) + 2); RKB_POST(p2, (c) + 1); RKB_BAR();
            R3YP(1) R3YP(4) R3YP(7) R3YP(10) R3YP(13) R3YP(16) R3YP(19) R3YP(22) R3YP(25) R3YP(28)
            RKB_Y_BODY(o1, 31); RKB_POST(p0, 30); RKB_BAR();
            RKB_POST(p1, 31);
#undef R3YP
        } else {
            RKB_BAR();
#define R3P(c) RKB_POST(p0, (c) - 1); RKB_BAR(); RKB_POST(p1, c); RKB_BAR(); RKB_POST(p2, (c) + 1); RKB_BAR();
            R3P(1) R3P(4) R3P(7) R3P(10) R3P(13) R3P(16) R3P(19) R3P(22) R3P(25) R3P(28)
            RKB_POST(p0, 30); RKB_BAR();
            RKB_POST(p1, 31);
#undef R3P
        }
#undef RKB_POST
#undef RKB_UNPK8
#undef RKB_PLOAD
    }
#undef RKB_STEP_S
#undef RKB_Y_BODY
#undef RKB_NEXT
#undef RKB_BAR
#undef RKB_LOAD
    if (wave < 4 && half == 0) {
#pragma unroll
        for (int i = 0; i < 16; ++i) *(GAS float*)(sst + i * 64 + lane) = st[i];
    }
}

constexpr int NPHASE = 9;
template <int PHM> __global__ void __launch_bounds__(NWAVES * 64, 2) fwd_kernel(Args args) {
    extern __shared__ __attribute__((aligned(16))) unsigned char lds[];
    namespace cg = cooperative_groups;
    Frame F;
    F.lds = (LAS unsigned char*)lds;
    F.tid = threadIdx.x; F.lane = F.tid & 63; F.wave = __builtin_amdgcn_readfirstlane(F.tid >> 6);
    F.G = gridDim.x; F.bx = blockIdx.x;
    F.out = args.out; F.ws = args.ws;
#define PH_BEGIN InTab TAB; { ktab_t kp_ = (ktab_t)__builtin_amdgcn_kernarg_segment_ptr(); asm volatile("" : "+s"(kp_)); TAB.p = kp_; } { int t_ = threadIdx.x; asm volatile("" : "+v"(t_)); F.tid = t_; F.lane = t_ & 63; F.wave = __builtin_amdgcn_readfirstlane(t_ >> 6); } GAS unsigned char* wsg_ = (GAS unsigned char*)args.ws; asm volatile("" : "+s"(wsg_)); unsigned char* ws = (unsigned char*)wsg_; F.ws = ws; GAS bf16_t* gtg_ = (GAS bf16_t*)args.out; asm volatile("" : "+s"(gtg_)); bf16_t* GATES = (bf16_t*)gtg_; F.out = (float*)GATES; (void)GATES;
    const int lo = args.ph_lo, hi = args.ph_hi;
    XcdBarrier bar; bar.bar = nullptr; bar.x = 0; bar.st = nullptr;
    if (hi - lo > 1) {
        for (int u = threadIdx.x; u < (LDS_BYTES - 162816) / 4; u += NWAVES * 64) ((LAS unsigned*)(F.lds + 162816))[u] = 0u;
        { GAS v4u* z_ = (GAS v4u*)(args.ws + WS_CTL) + (size_t)blockIdx.x * (CTL_ZERO_BYTES / 16 / 256); for (int u = threadIdx.x; u < (int)(CTL_ZERO_BYTES / 16 / 256); u += NWAVES * 64) z_[u] = (v4u){0u, 0u, 0u, 0u}; }
        asm volatile("s_waitcnt vmcnt(0)" ::: "memory");
        __syncthreads();
        cg::this_grid().sync();
        bar = xcd_barrier_post((unsigned*)(args.ws + WS_CTL) + CW_BAR, (volatile LAS unsigned*)(F.lds + MISC_OFF) + 8);
    }
#define IN(k) (((PHM >> (k)) & 1) && lo <= (k) && (k) < hi)
#ifdef PROBE_DUP
#define REPS(k) (((k) == PROBE_DUP) ? 2 : 1)
#else
#define REPS(k) 1
#endif
#define SEAM(k) do { if (IN(k) && IN((k) + 1)) { xcd_barrier(bar); } } while (0)
    using pg8::Gemm; using pg8::StaticOrder; using pg8::EpiRow8; using pg8::bf16_t;

#ifdef PROBE_SEG
#ifndef PROBE_BLK
#define PROBE_BLK 0
#endif
    unsigned long long pr_t0 = 0, pr_acc = 0;
#define PR_BEGIN(k) do { if (PROBE_SEG == (k)) { __syncthreads(); pr_t0 = __builtin_amdgcn_s_memrealtime(); } } while (0)
#define PR_END(k) do { if (PROBE_SEG == (k)) { __syncthreads(); pr_acc += __builtin_amdgcn_s_memrealtime() - pr_t0; } } while (0)
#else
#define PR_BEGIN(k) do {} while (0)
#define PR_END(k) do {} while (0)
#endif
    if (IN(0)) for (int rep_ = 0; rep_ < REPS(0); ++rep_) { if (rep_) xcd_barrier(bar); PH_BEGIN p0_prologue(F, TAB); } SEAM(0);
    PR_BEGIN(11); if (IN(1)) for (int rep_ = 0; rep_ < REPS(1); ++rep_) { if (rep_) xcd_barrier(bar); PH_BEGIN
        Gemm g{(const bf16_t*)(ws + WS_XN), (const bf16_t*)(ws + WS_WIN), M, D_IN - 256, D}; StaticOrder S; S.init(M, D_IN - 256, F.G, F.bx);
        EpiRow8<pg8::FProj> E{{ws, GATES}};
        pg8::gemm_phase<EpiRow8<pg8::FProj>, StaticOrder, PG8_ALIGN, PG8_SP2>(F.lds + RING_OFF, g, S, E);
    } SEAM(1); PR_END(11);
    PR_BEGIN(12); if (IN(2)) { PH_BEGIN
        constexpr int NLW = 64;
#ifndef PROBE_ATTN_ONLY
        PR_BEGIN(21);
        if (F.bx >= F.G - NLW) {
            const int pm = F.bx - (F.G - NLW);
            prep1_rows(F, TAB, pm * 32, pm * 32 + 32, F.wave, NWAVES);
            asm volatile("s_waitcnt vmcnt(0)" ::: "memory"); __syncthreads();
            if (threadIdx.x == 0) { __builtin_amdgcn_fence(__ATOMIC_ACQUIRE, "agent"); asm volatile("s_waitcnt vmcnt(0)" ::: "memory"); }
            __syncthreads();
            int klora = KLORA; asm volatile("" : "+s"(klora));
            Gemm g{(const bf16_t*)(ws + WS_LIN), (const bf16_t*)(ws + WS_WL) + (size_t)1024 * KLORA, M, 512, klora}; pg8::PanelOrder S{pm, 2};
            EpiRow8<pg8::FLoraG> E{{ws}};
            pg8::gemm_phase<EpiRow8<pg8::FLoraG>, pg8::PanelOrder, PG8_ALIGN, PG8_SP2>(F.lds + RING_OFF, g, S, E);
            __syncthreads();
        } else if (F.bx >= F.G - 2 * NLW) {
            const int pm = F.bx - (F.G - 2 * NLW);
            {
                Gemm g2{(const bf16_t*)(ws + WS_XN), (const bf16_t*)(ws + WS_WIN) + (size_t)(D_IN - 256) * D, M, 256, D}; pg8::PanelOrder S2{pm, 1};
                EpiRow8<pg8::FProjOff> E2{{{ws, GATES}, (D_IN - 256) / 256}};
                pg8::gemm_phase<EpiRow8<pg8::FProjOff>, pg8::PanelOrder, PG8_ALIGN, PG8_SP2>(F.lds + RING_OFF, g2, S2, E2);
                __syncthreads();
            }
        }
#endif
        PR_END(21);
        const attn_body::AttnTensors AT{(const attn_body::bf16*)(ws + WS_Q), (const attn_body::bf16*)(ws + WS_K), (const attn_body::bf16*)(ws + WS_V), (attn_body::bf16*)(ws + WS_O)};
        PR_BEGIN(20); attn_body::attn_phase_hybrid128<8>((char*)lds + RING_OFF, AT, (unsigned*)(ws + WS_CTL + CTL_ATTQ), (volatile LAS unsigned*)(F.lds + MISC_OFF) + 24, F.bx); PR_END(20);
    } SEAM(2); PR_END(12);
    if (IN(3)) { PH_BEGIN
        { GAS unsigned char* w_ = (GAS unsigned char*)args.ws; asm volatile("" : "+s"(w_)); F.ws = (unsigned char*)w_; }
        PR_BEGIN(1); rwkvA_phase(F, TAB, 0); PR_END(1);
        xcd_barrier(bar);
        { GAS unsigned char* w_ = (GAS unsigned char*)args.ws; asm volatile("" : "+s"(w_)); F.ws = (unsigned char*)w_; }
        PR_BEGIN(2); PR_BEGIN(4); if (F.bx < 64) rwkvB_phase(F, TAB, F.bx, 0); else { late_weights(F, TAB, 0, 2, 64); late_weights(F, TAB, 1, 2, 64); }
        __syncthreads(); PR_END(4);
        { GAS unsigned char* w_ = (GAS unsigned char*)args.ws; asm volatile("" : "+s"(w_)); F.ws = (unsigned char*)w_; }
        rwkvA_queue(F, TAB, 1, (unsigned*)(F.ws + WS_CTL + CTL_RKAQ)); PR_END(2);
        xcd_barrier(bar);
        { GAS unsigned char* w_ = (GAS unsigned char*)args.ws; asm volatile("" : "+s"(w_)); F.ws = (unsigned char*)w_; }
        PR_BEGIN(3); if (F.bx < 64) rwkvB_phase(F, TAB, F.bx, 1); PR_END(3);
    } SEAM(3);
    PR_BEGIN(15); if (IN(5)) for (int rep_ = 0; rep_ < REPS(5); ++rep_) { if (rep_) xcd_barrier(bar); PH_BEGIN
        Gemm g{(const bf16_t*)(ws + WS_YA), (const bf16_t*)(ws + WS_WA), M, D, 1024}; StaticOrder S; S.init(M, D, F.G, F.bx);
        pg8::EpiMerge E{GATES, (bf16_t*)(ws + WS_MERGED)};
        pg8::gemm_phase<pg8::EpiMerge, StaticOrder, PG8_ALIGN, PG8_SP2>(F.lds + RING_OFF, g, S, E);
    } SEAM(5); PR_END(15);
    PR_BEGIN(16); if (IN(6)) for (int rep_ = 0; rep_ < REPS(6); ++rep_) { if (rep_) xcd_barrier(bar); PH_BEGIN
        Gemm g{(const bf16_t*)(ws + WS_MERGED), (const bf16_t*)(ws + WS_WO), M, D, D}; StaticOrder S; S.init(M, D, F.G, F.bx);
        pg8::EpiResNorm<0> E{TAB[I_X], F.out, (bf16_t*)(ws + WS_XN), TAB[I_NFG], (float*)(ws + WS_CTL + CTL_SS1), (unsigned*)(ws + WS_CTL + CTL_CNT1), NORM_EPS, (bf16_t*)(ws + WS_X1B)};
        pg8::gemm_phase<pg8::EpiResNorm<0>, StaticOrder, PG8_ALIGN, PG8_SP2>(F.lds + RING_OFF, g, S, E);
    } SEAM(6); PR_END(16);
    PR_BEGIN(17); if (IN(7)) for (int rep_ = 0; rep_ < REPS(7); ++rep_) { if (rep_) xcd_barrier(bar); PH_BEGIN
        Gemm g{(const bf16_t*)(ws + WS_XN), (const bf16_t*)(ws + WS_W1), M, FF, D}; StaticOrder S; S.init(M, FF, F.G, F.bx);
        EpiRow8<pg8::FRelu2> E{{(bf16_t*)(ws + WS_H)}};
        pg8::gemm_phase<EpiRow8<pg8::FRelu2>, StaticOrder, PG8_ALIGN, PG8_SP2>(F.lds + RING_OFF, g, S, E);
    } SEAM(7); PR_END(17);
    PR_BEGIN(18); if (IN(8)) for (int rep_ = 0; rep_ < REPS(8); ++rep_) { if (rep_) xcd_barrier(bar); PH_BEGIN
        Gemm g{(const bf16_t*)(ws + WS_H), (const bf16_t*)(ws + WS_W2), M, D, FF}; StaticOrder S; S.init(M, D, F.G, F.bx);
        pg8::EpiResNorm<1> E{nullptr, F.out, nullptr, TAB[I_NFIN], (float*)(ws + WS_CTL + CTL_SS2), (unsigned*)(ws + WS_CTL + CTL_CNT2), NORM_EPS, (bf16_t*)(ws + WS_X1B)};
        pg8::gemm_phase<pg8::EpiResNorm<1>, StaticOrder, PG8_ALIGN, PG8_SP2>(F.lds + RING_OFF, g, S, E);
    } PR_END(18);
#ifdef PROBE_SEG
    if (blockIdx.x == PROBE_BLK) { const unsigned long long t0_ = __builtin_amdgcn_s_memrealtime(); while (__builtin_amdgcn_s_memrealtime() - t0_ < (unsigned long long)PROBE_MUL * pr_acc) __builtin_amdgcn_s_sleep(8); }
#endif
#undef IN
#undef SEAM
#undef PH_BEGIN
}


#ifdef DBG_DUMP
__global__ void dbg_dump(float* out, const unsigned char* ws) {
    const size_t i = (size_t)blockIdx.x * blockDim.x + threadIdx.x; if (i >= (size_t)M * 1024) return;
    const size_t m = i >> 10; const int c = (int)(i & 1023); float v = 0.f;
#if DBG_DUMP == 1
    v = bf1(((const bf16*)(ws + WS_O))[m * 1024 + c]);
#elif DBG_DUMP == 2
    v = c < 512 ? bf1(((const bf16*)(ws + WS_Y))[m * 512 + c]) : (c < 520 ? ((const float*)(ws + WS_BON))[m * 8 + (c - 512)] : 0.f);
#elif DBG_DUMP == 3
    v = c < 512 ? bf1(((const bf16*)(ws + WS_Q))[m * 512 + c]) : bf1(((const bf16*)(ws + WS_K))[m * 512 + c - 512]);
#elif DBG_DUMP == 4
    v = c < 512 ? ((const float*)(ws + WS_DEC))[m * 512 + c] : bf1(((const bf16*)(ws + WS_AA))[m * 512 + c - 512]);
#elif DBG_DUMP == 6
    v = c < 256 ? bf1(((const bf16*)(ws + WS_WAG))[m * 256 + c]) : (c < 512 ? bf1(((const bf16*)(ws + WS_LIN))[m * 256 + c - 256]) : 0.f);
#elif DBG_DUMP == 7
    { const bf16* wl = (const bf16*)(ws + WS_WL); const size_t j = (m * 1024 + c); v = j < (size_t)NLORA * KLORA ? bf1(wl[j]) : 0.f; }
#elif DBG_DUMP == 8
    v = c < 512 ? bf1(((const bf16*)(ws + WS_GG))[m * 512 + c]) : 0.f;
#elif DBG_DUMP == 5
    v = bf1(((const bf16*)(ws + WS_RKV))[m * 1536 + c]);
#endif
    out[i] = v;
}
#endif

#ifdef DBG_FIXLORA
__global__ void dbg_fixlora(Args A) {
    const size_t i = (size_t)blockIdx.x * blockDim.x + threadIdx.x; if (i >= (size_t)M * 512) return;
    const size_t m = i >> 9; const int c = (int)(i & 511);
    const bf16* LINr = (const bf16*)(A.ws + WS_LIN) + m * 256;
#if DBG_FIXLORA & 1
    { float g = 0.f; for (int k = 0; k < 128; ++k) g += bf1(LINr[128 + k]) * A[I_G2][(size_t)k * 512 + c]; ((bf16*)(A.ws + WS_GG))[m * 512 + c] = (bf16)f2bf(g); }
#endif
#if DBG_FIXLORA & 2
    { float s = A[I_A0][c]; for (int k = 0; k < 64; ++k) s += bf1(LINr[64 + k]) * A[I_A2][(size_t)k * 512 + c]; ((bf16*)(A.ws + WS_AA))[m * 512 + c] = (bf16)f2bf(1.0f / (1.0f + expf(-s))); }
#endif
#if DBG_FIXLORA & 4
    { float s = A[I_W0][c]; for (int k = 0; k < 64; ++k) s += bf1(LINr[k]) * A[I_W2][(size_t)k * 512 + c]; const float w = -log1pf(expf(-s)) - 0.5f; ((float*)(A.ws + WS_DEC))[m * 512 + c] = expf(-expf(w)); }
#endif
}
#endif
#ifndef MK_ONE_LAUNCH
#define MK_ONE_LAUNCH 0
#endif
#ifndef MK_MASK
#define MK_MASK ((1 << NPHASE) - 1)
#endif
typedef void (*kern_t)(Args);
template <int P> struct KTab { static void fill(kern_t* t) { t[P] = fwd_kernel<(1 << P)>; KTab<P - 1>::fill(t); } };
template <> struct KTab<-1> { static void fill(kern_t*) {} };
extern "C" void kernel_launch(void* const* d_in, const int* in_sizes, int n_in, void* d_out, int out_size, void* d_ws, size_t ws_size, hipStream_t stream) {
    static int grid = 0; static kern_t ktab[NPHASE];
    if (grid == 0) {
        if (n_in != 26 || in_sizes[0] != M * D || out_size != M * D || ws_size < WS_END) { fprintf(stderr, "kernel_launch: unexpected shapes (n_in %d, in0 %d, out %d, ws %zu); nothing launched\n", n_in, n_in > 0 ? in_sizes[0] : -1, out_size, ws_size); grid = -1; return; }
        int dev = 0, cus = 0;
        if (hipGetDevice(&dev) != hipSuccess || hipDeviceGetAttribute(&cus, hipDeviceAttributeMultiprocessorCount, dev) != hipSuccess) { grid = -1; return; }
#if MK_ONE_LAUNCH
        int per_cu = 0;
        if (hipFuncSetAttribute((const void*)fwd_kernel<MK_MASK>, hipFuncAttributeMaxDynamicSharedMemorySize, LDS_BYTES) != hipSuccess) { fprintf(stderr, "kernel_launch: hipFuncSetAttribute failed\n"); grid = -1; return; }
        if (hipOccupancyMaxActiveBlocksPerMultiprocessor(&per_cu, (const void*)fwd_kernel<MK_MASK>, NWAVES * 64, LDS_BYTES) != hipSuccess || per_cu < 1) { fprintf(stderr, "kernel_launch: occupancy query says %d blocks per CU\n", per_cu); (void)hipGetLastError(); grid = -1; return; }
#else
        KTab<NPHASE - 1>::fill(ktab);
        for (int p = 0; p < NPHASE; ++p) if (hipFuncSetAttribute((const void*)ktab[p], hipFuncAttributeMaxDynamicSharedMemorySize, LDS_BYTES) != hipSuccess) { fprintf(stderr, "kernel_launch: hipFuncSetAttribute failed\n"); grid = -1; return; }
#endif
        grid = cus;
        if (grid != 256) fprintf(stderr, "kernel_launch: note: %d CUs (built for 256)\n", grid);
    }
    if (grid < 0) return;
    Args a{};
    for (int i = 0; i < 26; ++i) a.in[i] = (const float*)d_in[i];
    a.out = (float*)d_out; a.ws = (unsigned char*)d_ws;
#if MK_ONE_LAUNCH
    a.ph_lo = 0; a.ph_hi = NPHASE;
    void* kargs[] = {&a};
    hipError_t e = hipLaunchCooperativeKernel((const void*)fwd_kernel<MK_MASK>, dim3(grid), dim3(NWAVES * 64), kargs, LDS_BYTES, stream);
    if (e != hipSuccess) fprintf(stderr, "kernel_launch: cooperative launch failed: %s\n", hipGetErrorString(e));
#else
#ifdef DBG_DUMP
    for (int p = 0; p <= DBG_STOP; ++p) { a.ph_lo = p; a.ph_hi = p + 1; hipLaunchKernelGGL(ktab[p], dim3(grid), dim3(NWAVES * 64), LDS_BYTES, stream, a); }
    hipLaunchKernelGGL(dbg_dump, dim3((M * 1024) / 256), dim3(256), 0, stream, (float*)d_out, (const unsigned char*)d_ws);
#else
    for (int p = 0; p < NPHASE; ++p) { a.ph_lo = p; a.ph_hi = p + 1; hipLaunchKernelGGL(ktab[p], dim3(grid), dim3(NWAVES * 64), LDS_BYTES, stream, a);
#ifdef DBG_FIXLORA
        if (p == 3) hipLaunchKernelGGL(dbg_fixlora, dim3((M * 512) / 256), dim3(256), 0, stream, a);
#endif
    }
#endif
#endif
}
```

```cpp
#define MK_ONE_LAUNCH 1
#include <hip/hip_runtime.h>
#include <cstdio>
#include <cstdint>
constexpr int NWAVES = 8;
constexpr int BATCH = 8, SEQ = 2048, D = 1024, M = BATCH * SEQ;
constexpr int D_IN = 5376, FF = 4096, RWW = 512, NLORA = 1536, KLORA = 256;
constexpr float NORM_EPS = 1e-6f, SUBLN_EPS = 1e-5f, GN_EPS = 64e-5f, LAMBDA_INIT = 0.2f;
constexpr size_t MiB = 1u << 20;
constexpr size_t WS_CTL = 0, CTL_ZERO_BYTES = 256 * 1024;
constexpr size_t CTL_SS1 = 65536, CTL_SS2 = 131072, CTL_CNT1 = 196608, CTL_CNT2 = 212992, CTL_ATTQ = 229376, CTL_RKAQ = 229380;
constexpr size_t WS_ROPE_C = 512 * 1024, WS_ROPE_S = 768 * 1024;
constexpr size_t WS_BON = 1 * MiB;
constexpr size_t WS_WIN = 2 * MiB;
constexpr size_t WS_WA = WS_WIN + (size_t)D_IN * D * 2;
constexpr size_t WS_WB = WS_WA + 1 * MiB;
constexpr size_t WS_WO = WS_WB + 1 * MiB;
constexpr size_t WS_W1 = WS_WO + 2 * MiB;
constexpr size_t WS_W2 = WS_W1 + 8 * MiB;
constexpr size_t WS_WL = WS_W2 + 8 * MiB;
static_assert(WS_WL + (size_t)NLORA * KLORA * 2 <= 34 * MiB, "weights");
constexpr size_t WS_XN = 34 * MiB;
constexpr size_t WS_DEC = WS_XN;
constexpr size_t WS_Q = 66 * MiB, WS_K = 82 * MiB, WS_V = 98 * MiB;
constexpr size_t WS_RKV = 114 * MiB;
constexpr size_t WS_WAG = 162 * MiB, WS_LIN = 242 * MiB;
constexpr size_t WS_Y = 162 * MiB;
constexpr size_t WS_AA = 178 * MiB, WS_GG = 194 * MiB;
constexpr size_t WS_O = 210 * MiB;
constexpr size_t WS_YA = 210 * MiB;
constexpr size_t WS_TMP = 114 * MiB;
constexpr size_t WS_MERGED = 114 * MiB;
constexpr size_t WS_X1B = 194 * MiB;
constexpr size_t WS_H = 66 * MiB;
constexpr size_t WS_END = 252 * MiB;
constexpr int RING_OFF = 0, RING_BYTES = 131072;
constexpr int LDS_BYTES = 163840;

#include <hip/hip_runtime.h>
#include <cstdio>
#include <cstdint>
namespace pg8 {
#define PG8_LAS __attribute__((address_space(3)))
typedef unsigned short bf16_t;
typedef short bf16x8 __attribute__((ext_vector_type(8)));
typedef float f32x4 __attribute__((ext_vector_type(4)));
typedef unsigned u32x4 __attribute__((ext_vector_type(4)));
constexpr int BM = 256, BK = 64, HALF = 128, HTB = HALF * BK * 2  , STAGE_BYTES = 8 * HTB, NXCD = 8, WGM = 8;

__host__ __device__ __forceinline__ int lds_byte(int r, int c) { const int st = (r >> 4) * 2 + (c >> 5), rr = r & 15, cc = c & 31, ob = rr * 64 + cc * 2; return st * 1024 + (ob ^ (((ob >> 9) & 1) << 5)); }
__host__ __device__ __forceinline__ void stage_rc(int b, int& R, int& C) { const int st = b / 1024, sb = b % 1024, swz = sb ^ (((sb >> 9) & 1) << 5); R = (st >> 1) * 16 + swz / 64; C = (st & 1) * 32 + (swz % 64) / 2; }
__host__ __device__ __forceinline__ int perm32(int rho) { const int n = rho >> 4, i = rho & 15; return 8 * (i >> 2) + 4 * n + (i & 3); }

struct Unit { int pm, pn; };
struct Gemm { const bf16_t* A; const bf16_t* Bt; int M, N, K; };

struct StaticOrder {
    int nM, nN, nwg, G, c;
    __host__ __device__ void init(int M, int N, int G_, int c_) { nM = M / BM; nN = N / BM; nwg = nM * nN; G = G_; c = c_; }
    __host__ __device__ bool next(int i, Unit& u) const {
        const long L = (long)i * G + c; if (L >= nwg) return false;
        int wgid = (int)L; { const int q = nwg / NXCD, r = nwg % NXCD, xcd = wgid % NXCD, off = wgid / NXCD; wgid = (xcd < r ? xcd * (q + 1) : r * (q + 1) + (xcd - r) * q) + off; }
        const int nig = WGM * nN, gid = wgid / nig, fm = gid * WGM, gsz = (nM - fm) < WGM ? (nM - fm) : WGM;
        u.pm = fm + ((wgid % nig) % gsz); u.pn = (wgid % nig) / gsz; return true;
    }
    __device__ __forceinline__ void a_ready(const Unit&) const {}
    __device__ __forceinline__ void done(const Unit&) const {}
};

typedef float f32x2c_t __attribute__((ext_vector_type(2))); typedef __bf16 bf16x2c_t __attribute__((ext_vector_type(2)));
__device__ __forceinline__ unsigned cvt_pk_bf16(float lo, float hi) { f32x2c_t v = {lo, hi}; bf16x2c_t b = __builtin_convertvector(v, bf16x2c_t); return __builtin_bit_cast(unsigned, b); }
typedef float f32x2 __attribute__((ext_vector_type(2)));
__device__ __forceinline__ f32x2 gelu_pk(f32x2 v) {
    const f32x2 av = __builtin_elementwise_abs(v), d = av * 0.2316418882f + 1.0f;
    f32x2 t; t.x = __builtin_amdgcn_rcpf(d.x); t.y = __builtin_amdgcn_rcpf(d.y);
    f32x2 q = t * 0.5307027145f + (-0.7265760135f); q = q * t + 0.7107068705f; q = q * t + (-0.142248368f); q = q * t + 0.127414796f; q = q * t;
    const f32x2 s = (v * v) * (-0.72134752044f);
    f32x2 e; e.x = __builtin_amdgcn_exp2f(s.x); e.y = __builtin_amdgcn_exp2f(s.y);
    const f32x2 m = v * (q * e), r = v - m;
    f32x2 o; o.x = v.x < 0.f ? m.x : r.x; o.y = v.y < 0.f ? m.y : r.y; return o;
}

template <int ACT  > struct EpiBf16 {
    static constexpr int MIDK = 0; static constexpr bool PERM = true, AFTER_DRAIN = false; static_assert(ACT == 0 || ACT == 1, "EpiBf16: ACT is 0 (none) or 1 (gelu_pk)");
    bf16_t* O; int ldc; const float* bias; int split_cols; size_t split_stride; float scale0;
    __device__ __forceinline__ void operator()(const f32x4 (&acc)[2][2][4][2], const Unit& u, int wr, int wc, int fr, int fq) const {
        const int row0 = u.pm * BM + wr * 64 + fr; int colt = u.pn * BM; bf16_t* base = O;
        float sc = 1.f; if (split_cols) { const int t = colt / split_cols; base += (size_t)t * split_stride; colt -= t * split_cols; if (t == 0) sc = scale0; }
        const int col0 = colt + wc * 32 + 8 * fq, bcol0 = u.pn * BM + wc * 32 + 8 * fq;
        f32x4 bv[2][2];
#pragma unroll
        for (int bj = 0; bj < 2; ++bj)
#pragma unroll
            for (int n = 0; n < 2; ++n) bv[bj][n] = bias ? *(const f32x4*)(bias + bcol0 + bj * HALF + 4 * n) : (f32x4){0.f, 0.f, 0.f, 0.f};
#pragma unroll
        for (int ai = 0; ai < 2; ++ai)
#pragma unroll
            for (int m = 0; m < 4; ++m) { bf16_t* rowp = base + (size_t)(row0 + ai * HALF + m * 16) * ldc + col0;
#pragma unroll
                for (int bj = 0; bj < 2; ++bj) { f32x4 v0 = acc[ai][bj][m][0] + bv[bj][0], v1 = acc[ai][bj][m][1] + bv[bj][1];
                    if (ACT == 1) { f32x2 a = gelu_pk((f32x2){v0[0], v0[1]}), b = gelu_pk((f32x2){v0[2], v0[3]}), c = gelu_pk((f32x2){v1[0], v1[1]}), d = gelu_pk((f32x2){v1[2], v1[3]});
                        v0 = (f32x4){a.x, a.y, b.x, b.y}; v1 = (f32x4){c.x, c.y, d.x, d.y}; }
                    v0 = v0 * sc; v1 = v1 * sc; u32x4 w; w.x = cvt_pk_bf16(v0[0], v0[1]); w.y = cvt_pk_bf16(v0[2], v0[3]); w.z = cvt_pk_bf16(v1[0], v1[1]); w.w = cvt_pk_bf16(v1[2], v1[3]);
                    *(u32x4*)(rowp + bj * HALF) = w; } }
    }
};
typedef unsigned u32x2 __attribute__((ext_vector_type(2)));
__device__ __forceinline__ float bf_lo(unsigned w) { return __builtin_bit_cast(float, w << 16); }
__device__ __forceinline__ float bf_hi(unsigned w) { return __builtin_bit_cast(float, w & 0xffff0000u); }
__device__ __forceinline__ u32x4 pack8(f32x4 v0, f32x4 v1) { u32x4 w; w.x = cvt_pk_bf16(v0[0], v0[1]); w.y = cvt_pk_bf16(v0[2], v0[3]); w.z = cvt_pk_bf16(v1[0], v1[1]); w.w = cvt_pk_bf16(v1[2], v1[3]); return w; }
__device__ __forceinline__ float sigmoidf_(float x) { return __builtin_amdgcn_rcpf(1.0f + __expf(-x)); }
template <class F> struct EpiRow8 {
    static constexpr int MIDK = 0; static constexpr bool PERM = true, AFTER_DRAIN = false;
    F f;
    __device__ __forceinline__ void operator()(const f32x4 (&acc)[2][2][4][2], const Unit& u, int wr, int wc, int fr, int fq) const {
        const int row0 = u.pm * BM + wr * 64 + fr, c0 = wc * 32 + 8 * fq;
#pragma unroll
        for (int ai = 0; ai < 2; ++ai)
#pragma unroll
            for (int m = 0; m < 4; ++m) { const int row = row0 + ai * HALF + m * 16;
#pragma unroll
                for (int bj = 0; bj < 2; ++bj) { f(u.pn, row, c0 + bj * HALF, acc[ai][bj][m][0], acc[ai][bj][m][1]); if (F::FENCE) asm volatile("" ::: "memory"); } }
    }
};
constexpr float ATT_C2 = 0.125f * 1.4426950408889634f;
struct FProj {
    static constexpr bool FENCE = false;
    unsigned char* ws; bf16_t* GATES;
    __device__ __forceinline__ void operator()(int pn, int row, int cu, f32x4 v0, f32x4 v1) const {
        if (pn < 4) {
            const int sh = cu >> 6, j = (cu & 63) >> 3, pos = row & 2047;
            const f32x4 c = *(const f32x4*)((const float*)(ws + WS_ROPE_C) + pos * 32 + 4 * j), s = *(const f32x4*)((const float*)(ws + WS_ROPE_S) + pos * 32 + 4 * j);
            const float sc = pn < 2 ? ATT_C2 : 1.0f;
            const f32x4 o1 = (v0 * c - v1 * s) * sc, o2 = (v1 * c + v0 * s) * sc;
            bf16_t* dst = (bf16_t*)(ws + (pn < 2 ? WS_Q : WS_K)) + (size_t)row * 512 + (pn & 1) * 256 + sh * 64 + 4 * j;
            u32x2 w1, w2; w1.x = cvt_pk_bf16(o1[0], o1[1]); w1.y = cvt_pk_bf16(o1[2], o1[3]); w2.x = cvt_pk_bf16(o2[0], o2[1]); w2.y = cvt_pk_bf16(o2[2], o2[3]);
            *(u32x2*)dst = w1; *(u32x2*)(dst + 32) = w2;
        } else if (pn < 13) {
            size_t off; int pitch, col;
            if (pn < 6) { off = WS_V; pitch = 512; col = (pn - 4) * 256; }
            else if (pn < 12) { off = WS_RKV; pitch = 1536; col = (pn - 6) * 256; }
            else { off = WS_WAG; pitch = 256; col = 0; }
            *(u32x4*)((bf16_t*)(ws + off) + (size_t)row * pitch + col + cu) = pack8(v0, v1);
        } else *(u32x4*)(GATES + (size_t)row * 2048 + (pn - 13) * 256 + cu) = pack8(v0, v1);
    }
};
struct FLora {
    static constexpr bool FENCE = false;
    unsigned char* ws; const float *w0, *a0;
    __device__ __forceinline__ void operator()(int pn, int row, int cu, f32x4 v0, f32x4 v1) const {
        const int c = (pn & 1) * 256 + cu;
        if (pn < 2) {
            const f32x4 b0 = *(const f32x4*)(w0 + c), b1 = *(const f32x4*)(w0 + c + 4);
            float* dst = (float*)(ws + WS_DEC) + (size_t)row * 512 + c; *(f32x4*)dst = v0 + b0; *(f32x4*)(dst + 4) = v1 + b1;
        } else if (pn < 4) {
            const f32x4 b0 = *(const f32x4*)(a0 + c), b1 = *(const f32x4*)(a0 + c + 4);
            *(u32x4*)((bf16_t*)(ws + WS_AA) + (size_t)row * 512 + c) = pack8(v0 + b0, v1 + b1);
        } else *(u32x4*)((bf16_t*)(ws + WS_GG) + (size_t)row * 512 + c) = pack8(v0, v1);
    }
};
struct FProjOff {
    static constexpr bool FENCE = false;
    FProj f; int off;
    __device__ __forceinline__ void operator()(int pn, int row, int cu, f32x4 v0, f32x4 v1) const { f(pn + off, row, cu, v0, v1); }
};
struct FLoraG {
    static constexpr bool FENCE = false;
    unsigned char* ws;
    __device__ __forceinline__ void operator()(int pn, int row, int cu, f32x4 v0, f32x4 v1) const { *(u32x4*)((bf16_t*)(ws + WS_GG) + (size_t)row * 512 + pn * 256 + cu) = pack8(v0, v1); }
};
struct EpiMerge {
    static constexpr int MIDK = 8; static constexpr bool PERM = true, AFTER_DRAIN = false;
    const bf16_t* GATES; bf16_t* MERGED;
    static __device__ __forceinline__ float ratio_(float ga, float gb) { return (1.0f + __expf(-gb)) * __builtin_amdgcn_rcpf(1.0f + __expf(-ga)); }
    __device__ __forceinline__ void mid(f32x4 (&acc)[2][2][4][2], const Unit& u, int wr, int wc, int fr, int fq) const {
        int fr_ = fr; asm volatile("" : "+v"(fr_));
        const bf16_t* gp0 = GATES + (size_t)(u.pm * BM + wr * 64 + fr_) * 2048 + u.pn * BM + wc * 32 + 8 * fq;
#pragma unroll
        for (int ai = 0; ai < 2; ++ai)
#pragma unroll
            for (int m = 0; m < 4; ++m)
#pragma unroll
                for (int bj = 0; bj < 2; ++bj) { const bf16_t* gp = gp0 + (size_t)(ai * HALF + m * 16) * 2048 + bj * HALF;
                    const u32x4 ga = *(const u32x4*)gp, gb = *(const u32x4*)(gp + 1024);
                    f32x4& v0 = acc[ai][bj][m][0]; f32x4& v1 = acc[ai][bj][m][1];
                    v0[0] *= ratio_(bf_lo(ga.x), bf_lo(gb.x)); v0[1] *= ratio_(bf_hi(ga.x), bf_hi(gb.x)); v0[2] *= ratio_(bf_lo(ga.y), bf_lo(gb.y)); v0[3] *= ratio_(bf_hi(ga.y), bf_hi(gb.y));
                    v1[0] *= ratio_(bf_lo(ga.z), bf_lo(gb.z)); v1[1] *= ratio_(bf_hi(ga.z), bf_hi(gb.z)); v1[2] *= ratio_(bf_lo(ga.w), bf_lo(gb.w)); v1[3] *= ratio_(bf_hi(ga.w), bf_hi(gb.w));
                    asm volatile("" ::: "memory"); }
    }
    __device__ __forceinline__ void operator()(const f32x4 (&acc)[2][2][4][2], const Unit& u, int wr, int wc, int fr, int fq) const {
        const int row0 = u.pm * BM + wr * 64 + fr, c0 = u.pn * BM + wc * 32 + 8 * fq;
#pragma unroll
        for (int ai = 0; ai < 2; ++ai)
#pragma unroll
            for (int m = 0; m < 4; ++m) { const int row = row0 + ai * HALF + m * 16;
#pragma unroll
                for (int bj = 0; bj < 2; ++bj) { const u32x4 g = *(const u32x4*)(GATES + (size_t)row * 2048 + 1024 + c0 + bj * HALF);
                    f32x4 v0 = acc[ai][bj][m][0], v1 = acc[ai][bj][m][1];
                    v0[0] *= sigmoidf_(bf_lo(g.x)); v0[1] *= sigmoidf_(bf_hi(g.x)); v0[2] *= sigmoidf_(bf_lo(g.y)); v0[3] *= sigmoidf_(bf_hi(g.y));
                    v1[0] *= sigmoidf_(bf_lo(g.z)); v1[1] *= sigmoidf_(bf_hi(g.z)); v1[2] *= sigmoidf_(bf_lo(g.w)); v1[3] *= sigmoidf_(bf_hi(g.w));
                    *(u32x4*)(MERGED + (size_t)row * 1024 + c0 + bj * HALF) = pack8(v0, v1); } }
    }
};
struct FRes {
    static constexpr bool FENCE = false;
    const float* base; float* out;
    __device__ __forceinline__ void operator()(int pn, int row, int cu, f32x4 v0, f32x4 v1) const {
        const size_t off = (size_t)row * 1024 + pn * 256 + cu; const f32x4 b0 = *(const f32x4*)(base + off), b1 = *(const f32x4*)(base + off + 4);
        *(f32x4*)(out + off) = b0 + v0; *(f32x4*)(out + off + 4) = b1 + v1;
    }
};
struct FRelu2 {
    static constexpr bool FENCE = false;
    bf16_t* H;
    __device__ __forceinline__ void operator()(int pn, int row, int cu, f32x4 v0, f32x4 v1) const {
        f32x4 r0, r1;
#pragma unroll
        for (int e = 0; e < 4; ++e) { const float a = __builtin_fmaxf(v0[e], 0.f), b = __builtin_fmaxf(v1[e], 0.f); r0[e] = a * a; r1[e] = b * b; }
        *(u32x4*)(H + (size_t)row * 4096 + pn * 256 + cu) = pack8(r0, r1);
    }
};

__device__ __forceinline__ float xsum_fq(float x) {
    { auto r = __builtin_amdgcn_permlane16_swap(__builtin_bit_cast(unsigned, x), __builtin_bit_cast(unsigned, x), false, false); const unsigned a = r[0], b = r[1]; x = __builtin_bit_cast(float, a) + __builtin_bit_cast(float, b); }
    { auto r = __builtin_amdgcn_permlane32_swap(__builtin_bit_cast(unsigned, x), __builtin_bit_cast(unsigned, x), false, false); const unsigned a = r[0], b = r[1]; x = __builtin_bit_cast(float, a) + __builtin_bit_cast(float, b); }
    return x;
}
template <int MODE> struct EpiResNorm {
    static constexpr int MIDK = 0; static constexpr bool PERM = true, AFTER_DRAIN = false;
    const float* base; float* out; bf16_t* xn; const float* g; float* ss; unsigned* cnt; float eps; bf16_t* x1b;
    __device__ __forceinline__ void operator()(f32x4 (&acc)[2][2][4][2], const Unit& u, int wr, int wc, int fr, int fq) const {
        const int row0 = u.pm * BM + wr * 64 + fr, c0 = u.pn * BM + wc * 32 + 8 * fq;
#pragma unroll
        for (int ai = 0; ai < 2; ++ai)
#pragma unroll
            for (int m = 0; m < 4; ++m) { const int row = row0 + ai * HALF + m * 16; float s = 0.f;
#pragma unroll
                for (int bj = 0; bj < 2; ++bj) { const size_t off = (size_t)row * 1024 + c0 + bj * HALF; f32x4 b0, b1;
                    if (MODE == 0) { b0 = *(const f32x4*)(base + off); b1 = *(const f32x4*)(base + off + 4); }
                    else { const u32x4 w = *(const u32x4*)(x1b + off); b0 = (f32x4){bf_lo(w.x), bf_hi(w.x), bf_lo(w.y), bf_hi(w.y)}; b1 = (f32x4){bf_lo(w.z), bf_hi(w.z), bf_lo(w.w), bf_hi(w.w)}; }
                    f32x4& v0 = acc[ai][bj][m][0]; f32x4& v1 = acc[ai][bj][m][1]; v0 += b0; v1 += b1;
                    if (MODE == 0) *(u32x4*)(x1b + off) = pack8(v0, v1);
                    s += (v0[0] * v0[0] + v0[1] * v0[1]) + (v0[2] * v0[2] + v0[3] * v0[3]) + (v1[0] * v1[0] + v1[1] * v1[1]) + (v1[2] * v1[2] + v1[3] * v1[3]); }
                s = xsum_fq(s);
                if (fq == 0) __hip_atomic_fetch_add(ss + row, s, __ATOMIC_RELAXED, __HIP_MEMORY_SCOPE_AGENT);
                if (m & 1) asm volatile("" ::: "memory"); }
        asm volatile("s_waitcnt vmcnt(0)" ::: "memory");
        unsigned* c_ = cnt + 64 * u.pm;
        if (fr == 0 && fq == 0) __hip_atomic_fetch_add(c_, 1u, __ATOMIC_RELAXED, __HIP_MEMORY_SCOPE_AGENT);
        { unsigned spins = 0; while ((unsigned)__builtin_amdgcn_readfirstlane(__hip_atomic_load(c_, __ATOMIC_RELAXED, __HIP_MEMORY_SCOPE_AGENT)) < 32u && ++spins < (1u << 22)) __builtin_amdgcn_s_sleep(2); }
        asm volatile("" ::: "memory");
#pragma unroll
        for (int ai = 0; ai < 2; ++ai)
#pragma unroll
            for (int m = 0; m < 4; ++m) { const int row = row0 + ai * HALF + m * 16;
                const float rstd = 1.0f / sqrtf(__hip_atomic_load(ss + row, __ATOMIC_RELAXED, __HIP_MEMORY_SCOPE_AGENT) * (1.0f / 1024.0f) + eps);
#pragma unroll
                for (int bj = 0; bj < 2; ++bj) { const size_t off = (size_t)row * 1024 + c0 + bj * HALF; const f32x4 g0 = *(const f32x4*)(g + c0 + bj * HALF), g1 = *(const f32x4*)(g + c0 + bj * HALF + 4);
                    const f32x4 o0 = acc[ai][bj][m][0] * rstd * g0, o1 = acc[ai][bj][m][1] * rstd * g1;
                    if (MODE == 0) *(u32x4*)(xn + off) = pack8(o0, o1); else { *(f32x4*)(out + off) = o0; *(f32x4*)(out + off + 4) = o1; } }
                if (m & 1) asm volatile("" ::: "memory"); }
    }
};

struct PanelOrder {
    int pm, ntiles;
    __device__ __forceinline__ bool next(int i, Unit& u) const { if (i >= ntiles) return false; int p = pm; asm volatile("" : "+s"(p)); u.pm = p; u.pn = i; return true; }
    __device__ __forceinline__ void a_ready(const Unit&) const {}
    __device__ __forceinline__ void done(const Unit&) const {}
};
template <class Epi, class Sched, bool ALIGN_EPI = false, bool SP2 = false>
__device__ __forceinline__ void gemm_phase(PG8_LAS unsigned char* lds, const Gemm g, const Sched& S, const Epi& E) {
    int tid_ = threadIdx.x; asm volatile("" : "+v"(tid_));
    const int tid = tid_, wid = __builtin_amdgcn_readfirstlane(tid >> 6), lane = tid & 63, wr = wid >> 2, wc = wid & 3, fr = lane & 15, fq = lane >> 4;
    const int K = g.K, nt = K / BK;
    unsigned voffA[2], voffB[2];
#pragma unroll
    for (int i = 0; i < 2; ++i) { int R, C; stage_rc(tid * 16 + i * 8192, R, C); const int Rb = Epi::PERM ? ((R & ~31) + perm32(R & 31)) : R;
        voffA[i] = (unsigned)(R * K + C) * 2u; voffB[i] = (unsigned)(Rb * K + C) * 2u; }
    const size_t kstep = (size_t)(BK * 2);
    const size_t hstep = (size_t)HALF * K * 2;
    const size_t tstep = 2 * hstep;
    const unsigned ldsw = (unsigned)wid * 1024u;
    const int aoff = lds_byte(wr * 64 + fr, fq * 8), boff = lds_byte(wc * 32 + fr, fq * 8);
#define PG8_SA(b, h) (((b) * 2 + (h)) * HTB)
#define PG8_SB(b, h) ((4 + (b) * 2 + (h)) * HTB)
#define PG8_STAGE(bufoff, gbase, voff) do { _Pragma("unroll") for (int _i = 0; _i < 2; ++_i) \
        __builtin_amdgcn_global_load_lds((const unsigned*)((const char*)(gbase) + (voff)[_i]), (PG8_LAS unsigned*)(lds + (bufoff) + ldsw + _i * 8192), 16, 0, 0); } while (0)
#define PG8_LDA(dst, b, h) do { _Pragma("unroll") for (int m = 0; m < 4; ++m) _Pragma("unroll") for (int k = 0; k < 2; ++k) dst[m][k] = *(const PG8_LAS bf16x8*)(lds + PG8_SA(b, h) + aoff + m * 2048 + k * 1024); } while (0)
#define PG8_LDB(dst, b, h) do { _Pragma("unroll") for (int n = 0; n < 2; ++n) _Pragma("unroll") for (int k = 0; k < 2; ++k) dst[n][k] = *(const PG8_LAS bf16x8*)(lds + PG8_SB(b, h) + boff + n * 2048 + k * 1024); } while (0)
#define PG8_MMA(ai, bj, At, Bt) do { __builtin_amdgcn_s_setprio(1); _Pragma("unroll") for (int m = 0; m < 4; ++m) _Pragma("unroll") for (int n = 0; n < 2; ++n) _Pragma("unroll") for (int k = 0; k < 2; ++k) \
        acc[ai][bj][m][n] = __builtin_amdgcn_mfma_f32_16x16x32_bf16(Bt[n][k], At[m][k], acc[ai][bj][m][n], 0, 0, 0); __builtin_amdgcn_s_setprio(0); } while (0)
#define PG8_WAIT_V(n) asm volatile("s_waitcnt vmcnt(" #n ")" ::: "memory")
#define PG8_WAIT_L(n) asm volatile("s_waitcnt lgkmcnt(" #n ")" ::: "memory")
#define PG8_BAR __builtin_amdgcn_s_barrier()
#define PG8_SCHED __builtin_amdgcn_sched_barrier(0)
    Unit cur, nxt; int ui = 0;
    if (!S.next(0, cur)) return;
    f32x4 acc[2][2][4][2];
#pragma unroll
    for (int a = 0; a < 2; ++a)
#pragma unroll
        for (int b = 0; b < 2; ++b)
#pragma unroll
            for (int m = 0; m < 4; ++m)
#pragma unroll
                for (int n = 0; n < 2; ++n) acc[a][b][m][n] = (f32x4){0.f, 0.f, 0.f, 0.f};
    bf16x8 At[4][2], B0[2][2], B1[2][2];
    const char* cA = (const char*)g.A + (size_t)cur.pm * tstep; const char* cB = (const char*)g.Bt + (size_t)cur.pn * tstep;
    S.a_ready(cur);
    if constexpr (SP2) {
        PG8_STAGE(PG8_SB(0, 0), cB, voffB); PG8_STAGE(PG8_SB(0, 1), cB + hstep, voffB); PG8_STAGE(PG8_SA(0, 0), cA, voffA); PG8_STAGE(PG8_SA(0, 1), cA + hstep, voffA);
        if (wr == 1) PG8_BAR;
        PG8_WAIT_V(2); PG8_BAR;
        PG8_STAGE(PG8_SB(1, 0), cB + kstep, voffB); PG8_STAGE(PG8_SA(1, 0), cA + kstep, voffA); PG8_STAGE(PG8_SB(1, 1), cB + hstep + kstep, voffB);
        PG8_WAIT_V(6); PG8_BAR;
    } else {
        PG8_STAGE(PG8_SB(0, 0), cB, voffB); PG8_STAGE(PG8_SA(0, 0), cA, voffA); PG8_STAGE(PG8_SB(0, 1), cB + hstep, voffB); PG8_STAGE(PG8_SA(0, 1), cA + hstep, voffA);
        if (wr == 1) PG8_BAR;
        PG8_WAIT_V(4); PG8_BAR;
        PG8_STAGE(PG8_SB(1, 0), cB + kstep, voffB); PG8_STAGE(PG8_SA(1, 0), cA + kstep, voffA); PG8_STAGE(PG8_SB(1, 1), cB + hstep + kstep, voffB);
        PG8_WAIT_V(6); PG8_BAR;
    }
    for (;;) {
        const bool has_next = S.next(ui + 1, nxt);
        const char* nA = has_next ? (const char*)g.A + (size_t)nxt.pm * tstep : cA; const char* nB = has_next ? (const char*)g.Bt + (size_t)nxt.pn * tstep : cB;
        for (int t = 0; t < nt; t += 2) {
            if constexpr (Epi::MIDK > 0) { if (t == Epi::MIDK) E.mid(acc, cur, wr, wc, fr, fq); }
            const bool last = (t == nt - 2);
            const char* a1 = cA + (size_t)(t + 1) * kstep;
            const char* a2 = last ? nA : cA + (size_t)(t + 2) * kstep; const char* b2 = last ? nB : cB + (size_t)(t + 2) * kstep;
            const char* a3 = a2 + kstep; const char* b3 = b2 + kstep;
            if (last && has_next) S.a_ready(nxt);
            if constexpr (SP2) {
            PG8_LDB(B0, 0, 0); PG8_LDB(B1, 0, 1); PG8_SCHED; PG8_LDA(At, 0, 0); PG8_STAGE(PG8_SA(1, 1), a1 + hstep, voffA);
            PG8_WAIT_V(8); PG8_WAIT_L(0); PG8_BAR; PG8_MMA(0, 0, At, B0); PG8_MMA(0, 1, At, B1); PG8_BAR; PG8_SCHED;
            PG8_LDA(At, 0, 1); PG8_STAGE(PG8_SB(0, 0), b2, voffB); PG8_STAGE(PG8_SB(0, 1), b2 + hstep, voffB); PG8_STAGE(PG8_SA(0, 0), a2, voffA);
            PG8_WAIT_V(8); PG8_WAIT_L(0); PG8_BAR; PG8_MMA(1, 0, At, B0); PG8_MMA(1, 1, At, B1); PG8_BAR; PG8_SCHED;
            PG8_LDB(B0, 1, 0); PG8_LDB(B1, 1, 1); PG8_SCHED; PG8_LDA(At, 1, 0); PG8_STAGE(PG8_SA(0, 1), a2 + hstep, voffA);
            PG8_WAIT_V(8); PG8_WAIT_L(0); PG8_BAR; PG8_MMA(0, 0, At, B0); PG8_MMA(0, 1, At, B1); PG8_BAR; PG8_SCHED;
            PG8_LDA(At, 1, 1); PG8_STAGE(PG8_SB(1, 0), b3, voffB); PG8_STAGE(PG8_SB(1, 1), b3 + hstep, voffB); PG8_STAGE(PG8_SA(1, 0), a3, voffA);
            PG8_WAIT_V(8); PG8_WAIT_L(0); PG8_BAR; PG8_MMA(1, 0, At, B0); PG8_MMA(1, 1, At, B1); PG8_BAR; PG8_SCHED;
            } else {
            PG8_LDB(B0, 0, 0); PG8_SCHED; PG8_LDA(At, 0, 0); PG8_STAGE(PG8_SA(1, 1), a1 + hstep, voffA);
            PG8_WAIT_L(8); PG8_BAR; PG8_WAIT_L(0); PG8_MMA(0, 0, At, B0); PG8_BAR; PG8_SCHED;
            PG8_LDB(B1, 0, 1); PG8_STAGE(PG8_SB(0, 0), b2, voffB);
            PG8_BAR; PG8_WAIT_L(0); PG8_MMA(0, 1, At, B1); PG8_BAR;
            PG8_LDA(At, 0, 1); PG8_STAGE(PG8_SA(0, 0), a2, voffA);
            PG8_BAR; PG8_WAIT_L(0); PG8_MMA(1, 0, At, B0); PG8_BAR; PG8_SCHED;
            PG8_STAGE(PG8_SB(0, 1), b2 + hstep, voffB);
            PG8_WAIT_V(6); PG8_BAR; PG8_MMA(1, 1, At, B1); PG8_BAR;
            PG8_LDB(B0, 1, 0); PG8_SCHED; PG8_LDA(At, 1, 0); PG8_STAGE(PG8_SA(0, 1), a2 + hstep, voffA);
            PG8_WAIT_L(8); PG8_BAR; PG8_WAIT_L(0); PG8_MMA(0, 0, At, B0); PG8_BAR; PG8_SCHED;
            PG8_LDB(B1, 1, 1); PG8_STAGE(PG8_SB(1, 0), b3, voffB);
            PG8_BAR; PG8_WAIT_L(0); PG8_MMA(0, 1, At, B1); PG8_BAR;
            PG8_LDA(At, 1, 1); PG8_STAGE(PG8_SA(1, 0), a3, voffA);
            PG8_BAR; PG8_WAIT_L(0); PG8_MMA(1, 0, At, B0); PG8_BAR; PG8_SCHED;
            PG8_STAGE(PG8_SB(1, 1), b3 + hstep, voffB);
            PG8_WAIT_V(6); PG8_BAR; PG8_MMA(1, 1, At, B1); PG8_BAR;
            }
        }
        if constexpr (ALIGN_EPI) { if (wr == 0) PG8_BAR; }
        if constexpr (!Epi::AFTER_DRAIN) { E(acc, cur, wr, wc, fr, fq); S.done(cur); }
        if (!has_next) break;
#pragma unroll
        for (int a = 0; a < 2; ++a)
#pragma unroll
            for (int b = 0; b < 2; ++b)
#pragma unroll
                for (int m = 0; m < 4; ++m)
#pragma unroll
                    for (int n = 0; n < 2; ++n) acc[a][b][m][n] = (f32x4){0.f, 0.f, 0.f, 0.f};
        cur = nxt; cA = nA; cB = nB; ++ui;
        if constexpr (ALIGN_EPI) { if (wr == 1) PG8_BAR; }
    }
    PG8_WAIT_V(0);
    if constexpr (!ALIGN_EPI) { if (wr == 0) PG8_BAR; }
    PG8_BAR;
    if constexpr (Epi::AFTER_DRAIN) { E.fused(acc, cur, wr, wc, fr, fq, lds, wid, lane); S.done(cur); }
#undef PG8_SA
#undef PG8_SB
#undef PG8_STAGE
#undef PG8_LDA
#undef PG8_LDB
#undef PG8_MMA
#undef PG8_WAIT_V
#undef PG8_WAIT_L
#undef PG8_BAR
#undef PG8_SCHED
}
}

#ifndef PG8_SP2
#define PG8_SP2 true
#endif
#ifndef PG8_ALIGN
#define PG8_ALIGN true
#endif
#include <hip/hip_bf16.h>
#include <cmath>
namespace attn_body {
using bf16=__hip_bfloat16;
using bf16x8=__attribute__((ext_vector_type(8)))short;
using s16x4=__attribute__((ext_vector_type(4)))short;
using f32x16=__attribute__((ext_vector_type(16)))float;
using u32x4=__attribute__((ext_vector_type(4)))unsigned;
constexpr int SEQ=2048,D=64,QP=512,KP=512,VP=512,OP=1024;
constexpr int NW=8,QBLK=32,QB=QBLK*NW,KVBLK=64,NQB=SEQ/QB;
constexpr int ATTN_UNIT_ROWS=QB;
__device__ __forceinline__ int crow(int r,int hi){return (r&3)+8*(r>>2)+4*hi;}
#define SBAR() __builtin_amdgcn_sched_barrier(0)
__device__ __forceinline__ void cmask(f32x16&p0,f32x16&p1,int jb,int wchunk,int){
  if(jb>wchunk){ const float NEG=-INFINITY;
    #pragma unroll
    for(int r=0;r<16;++r){p0[r]=NEG;p1[r]=NEG;} }
}

constexpr int NSLOT=3, SLOTB=8192;
constexpr int LDS_K=0, LDS_V=NSLOT*SLOTB, LDS_WS=2*NSLOT*SLOTB, LDS_OST=LDS_WS+NW*64*4, LDS_BYTES=LDS_OST+NW*4096;
constexpr float C2=0.125f*1.4426950408889634f;
__device__ __forceinline__ void glds16(const void*gsrc,unsigned lds_dst){unsigned keep;
  asm volatile("s_mov_b32 %0, m0\n\ts_mov_b32 m0, %2\n\ts_nop 0\n\tglobal_load_lds_dwordx4 %1, off\n\ts_mov_b32 m0, %0":"=&s"(keep):"v"(gsrc),"s"(lds_dst):"memory");}
__device__ __forceinline__ float max3f(float a,float b,float c){float r;asm("v_max3_f32 %0, %1, %2, %3":"=v"(r):"v"(a),"v"(b),"v"(c));return r;}
__device__ __forceinline__ float max2f(float a,float b){float r;asm("v_max_f32_e32 %0, %1, %2":"=v"(r):"v"(a),"v"(b));return r;}
__device__ __forceinline__ float fadd_s(float a,float b){float r;asm("v_add_f32_e32 %0, %1, %2":"=v"(r):"v"(a),"v"(b));return r;}
__device__ __forceinline__ float fsub_s(float a,float b){float r;asm("v_sub_f32_e32 %0, %1, %2":"=v"(r):"v"(a),"v"(b));return r;}
typedef float f32x2_t __attribute__((ext_vector_type(2))); typedef __bf16 bf16x2_t __attribute__((ext_vector_type(2)));
__device__ __forceinline__ unsigned cvtpk_s(float lo,float hi){f32x2_t v={lo,hi};bf16x2_t b=__builtin_convertvector(v,bf16x2_t);return __builtin_bit_cast(unsigned,b);}
#define WAIT_BAR(N) asm volatile("s_waitcnt vmcnt(" #N ") lgkmcnt(0)\n\ts_barrier":::"memory")

__device__ __forceinline__ void qkt(f32x16&p0,f32x16&p1,const char*Kslot,const bf16x8*qr,const f32x16&negm,int r32,int hi){
  const char*kb=Kslot+hi*1024+r32*16;
  #pragma unroll
  for(int d0=0;d0<4;++d0){
    const bf16x8 b0=*reinterpret_cast<const bf16x8*>(kb+d0*2048);
    const bf16x8 b1=*reinterpret_cast<const bf16x8*>(kb+d0*2048+512);
    if(d0==0){p0=__builtin_amdgcn_mfma_f32_32x32x16_bf16(b0,qr[0],negm,0,0,0);p1=__builtin_amdgcn_mfma_f32_32x32x16_bf16(b1,qr[0],negm,0,0,0);}
    else{p0=__builtin_amdgcn_mfma_f32_32x32x16_bf16(b0,qr[d0],p0,0,0,0);p1=__builtin_amdgcn_mfma_f32_32x32x16_bf16(b1,qr[d0],p1,0,0,0);}}
}
typedef __attribute__((address_space(3))) const char* lds_cptr;
typedef short v4i16_t __attribute__((ext_vector_type(4)));
__device__ __forceinline__ void kload8(bf16x8*kf,lds_cptr kp){
  kf[0]=*(const __attribute__((address_space(3))) bf16x8*)(kp);      kf[1]=*(const __attribute__((address_space(3))) bf16x8*)(kp+512);
  kf[2]=*(const __attribute__((address_space(3))) bf16x8*)(kp+2048); kf[3]=*(const __attribute__((address_space(3))) bf16x8*)(kp+2560);
  kf[4]=*(const __attribute__((address_space(3))) bf16x8*)(kp+4096); kf[5]=*(const __attribute__((address_space(3))) bf16x8*)(kp+4608);
  kf[6]=*(const __attribute__((address_space(3))) bf16x8*)(kp+6144); kf[7]=*(const __attribute__((address_space(3))) bf16x8*)(kp+6656);
}
__device__ __forceinline__ void kload2(bf16x8*kf,lds_cptr kp,int j){ kf[2*j]=*(const __attribute__((address_space(3))) bf16x8*)(kp+j*2048); kf[2*j+1]=*(const __attribute__((address_space(3))) bf16x8*)(kp+j*2048+512); }
__device__ __forceinline__ s16x4 vtr(lds_cptr p){ return __builtin_bit_cast(s16x4,__builtin_amdgcn_ds_read_tr16_b64_v4i16((__attribute__((address_space(3))) v4i16_t*)p)); }
__device__ __forceinline__ float rowmax(const f32x16&p0,const f32x16&p1){
  float a=max3f(p0[0],p0[1],p1[0]),b=max3f(p0[2],p0[3],p1[1]);a=max3f(a,p1[2],p1[3]);
  #pragma unroll
  for(int r=4;r<16;r+=4){a=max3f(a,p0[r],p0[r+1]);b=max3f(b,p0[r+2],p0[r+3]);a=max3f(a,p1[r],p1[r+1]);b=max3f(b,p1[r+2],p1[r+3]);}
  const float m=max2f(a,b);
  auto rr=__builtin_amdgcn_permlane32_swap(__float_as_uint(m),__float_as_uint(m),false,false);
  return max2f(__uint_as_float(rr[0]),__uint_as_float(rr[1]));
}
__device__ __forceinline__ void pv(f32x16*o,int vb,bf16x8 pa0,bf16x8 pa1,bf16x8 pa2,bf16x8 pa3){
  #pragma unroll
  for(int d0=0;d0<2;++d0){s16x4 lo[4],hi[4];
    #pragma unroll
    for(int ks=0;ks<4;++ks){
      asm volatile("ds_read_b64_tr_b16 %0,%1 offset:%c2":"=&v"(lo[ks]):"v"(vb),"i"(d0*4096+ks*1024):"memory");
      asm volatile("ds_read_b64_tr_b16 %0,%1 offset:%c2":"=&v"(hi[ks]):"v"(vb),"i"(d0*4096+ks*1024+512):"memory");}
    asm volatile("s_waitcnt lgkmcnt(0)":::"memory");SBAR();
    #define PK(k) (bf16x8){lo[k][0],lo[k][1],lo[k][2],lo[k][3],hi[k][0],hi[k][1],hi[k][2],hi[k][3]}
    o[d0]=__builtin_amdgcn_mfma_f32_32x32x16_bf16(pa0,PK(0),o[d0],0,0,0);
    o[d0]=__builtin_amdgcn_mfma_f32_32x32x16_bf16(pa1,PK(1),o[d0],0,0,0);
    o[d0]=__builtin_amdgcn_mfma_f32_32x32x16_bf16(pa2,PK(2),o[d0],0,0,0);
    o[d0]=__builtin_amdgcn_mfma_f32_32x32x16_bf16(pa3,PK(3),o[d0],0,0,0);
    #undef PK
  }
}

#ifndef ATTN_STORE16
#define ATTN_STORE16(p,v) (*(u32x4*)(p)=(v))
#endif
template<int THRL> __device__ __forceinline__ void attn_unit(int b,int qcol,int kcol,int vcol,int ocol,int qb,const bf16*Q,const bf16*__restrict__ K,const bf16*__restrict__ V,bf16*O,char*shm){
  int tid_=threadIdx.x; asm volatile("":"+v"(tid_));
  const int tid=tid_,lane=tid&63,r32=lane&31,hi=lane>>5; const int wid=__builtin_amdgcn_readfirstlane(tid>>6);
  const long rowbase=(long)b*SEQ; const int q0=qb*QB;
  const bf16*Qw=Q+(rowbase+q0+wid*QBLK)*QP+qcol;
  const bf16*Kh=K+rowbase*KP+kcol,*Vh=V+rowbase*VP+vcol;
  const unsigned lds0=(unsigned)(uintptr_t)shm;
  float*wsf=(float*)(shm+LDS_WS)+wid*64;
  const bf16*ksrc=Kh+(long)lane*KP+wid*8;
  const bf16*vsrc=Vh+(long)(16*(wid&3)+(lane>>2))*VP+(wid>>2)*32+(lane&3)*8;
  const unsigned kdst=lds0+LDS_K+wid*1024, vdst=lds0+LDS_V+wid*1024;
  #define DMA_K(t,slot) glds16(ksrc+(long)(t)*KVBLK*KP,(unsigned)__builtin_amdgcn_readfirstlane(kdst+(slot)))
  #define DMA_V(t,slot) glds16(vsrc+(long)(t)*KVBLK*VP,(unsigned)__builtin_amdgcn_readfirstlane(vdst+(slot)))
  const int vb0=(int)(lds0+LDS_V)+((lane>>4)&1)*32+(lane&3)*8+(4*hi+((lane&15)>>2))*64;
  const char*Kbase=shm+LDS_K; bf16x8 kf[8];
  const lds_cptr shm3=(lds_cptr)shm; const lds_cptr kp0=shm3+LDS_K+hi*1024+r32*16; const lds_cptr vp0=shm3+LDS_V+((lane>>4)&1)*32+(lane&3)*8+(4*hi+((lane&15)>>2))*64;
  const int NT=(q0+QB)/KVBLK;
  DMA_K(0,0);DMA_V(0,0);DMA_K(1,SLOTB);
  bf16x8 qr[4];
  #pragma unroll
  for(int d0=0;d0<4;++d0)qr[d0]=*reinterpret_cast<const bf16x8*>(&Qw[(long)r32*QP+d0*16+hi*8]);
  float mhat=0.f,l_reg=0.f;f32x16 o[2];o[0]=f32x16{};o[1]=f32x16{};f32x16 negm=f32x16{};asm volatile("":"+v"(negm));
  const int qrel=wid>>1;
  #define CMASK(P0,P1,t) do{int jb_=(t)-(NT-4); if(jb_>=0)cmask(P0,P1,jb_,qrel,hi);}while(0)
  bool resc=false;
  #define START(P0,P1) do{ const float rm=rowmax(P0,P1); resc=false; \
    { const float dl=rm; mhat=fadd_s(mhat,dl); \
      _Pragma("unroll") for(int r=0;r<16;++r){P0[r]=fsub_s(P0[r],dl);P1[r]=fsub_s(P1[r],dl);} \
      _Pragma("unroll") for(int r=0;r<16;++r)negm[r]=-mhat; asm volatile("":"+v"(negm)); } \
    _Pragma("unroll") for(int r=0;r<16;++r)P0[r]=__builtin_amdgcn_exp2f(P0[r]); }while(0)
  #define RESC() do{ if(resc){ asm volatile("s_waitcnt lgkmcnt(0)":::"memory"); \
      _Pragma("unroll") for(int d_=0;d_<2;++d_) _Pragma("unroll") for(int r=0;r<16;++r)o[d_][r]*=wsf[crow(r,hi)]; } }while(0)
  f32x16 pA0,pA1,pB0,pB1;
  int sl_prev=0,sl_cur=0,sl_next=SLOTB;
  #define ROT() do{sl_prev=sl_cur;sl_cur=sl_next;sl_next=(sl_next==(NSLOT-1)*SLOTB)?0:sl_next+SLOTB;}while(0)
  DMA_K(2,2*SLOTB);
  WAIT_BAR(3);
  qkt(pA0,pA1,Kbase,qr,negm,r32,hi);asm volatile("s_nop 15\n\ts_nop 7":"+v"(pA0),"+v"(pA1));CMASK(pA0,pA1,0);
  START(pA0,pA1);
  _Pragma("unroll") for(int r=0;r<16;++r)pA1[r]=__builtin_amdgcn_exp2f(pA1[r]);
  WAIT_BAR(0);
  DMA_K(3,0);DMA_V(1,SLOTB);
  ROT();
  kload8(kf,kp0+sl_cur);
  WAIT_BAR(2);
  s16x4 vlo[8],vhi[8]; u32x4 pw0,pw1,pw2,pw3;
  #define PKW(P,B) cvtpk_s(P[B],P[B+1])
  #define PAF(k) __builtin_bit_cast(bf16x8,pw##k)
  #define VFR(i) (bf16x8){vlo[i][0],vlo[i][1],vlo[i][2],vlo[i][3],vhi[i][0],vhi[i][1],vhi[i][2],vhi[i][3]}
  #define PIN(x) asm volatile("":"+v"(x))
  #define MX3(a,b,c) __builtin_fmaxf(__builtin_fmaxf((a),(b)),(c))
  #define GAPA(MF,A0,A1,A2,A3,W0,W1,PW) do{ MF; sacc+=A0; sacc+=A1; sacc+=A2; sacc+=A3; PIN(sacc); W0; W1; PIN(PW); SBAR(); }while(0)
  #define EX(v) __builtin_amdgcn_exp2f(v)
  #define GAPB(MF,X,B) do{ MF; X[B]=EX(X[B]); X[B+1]=EX(X[B+1]); X[B+2]=EX(X[B+2]); X[B+3]=EX(X[B+3]); PIN(X); SBAR(); }while(0)
  #define VRD(i) do{ vlo[i]=vtr(vp_+(((i)>>2)*4096+((i)&3)*1024)); vhi[i]=vtr(vp_+(((i)>>2)*4096+((i)&3)*1024+512)); }while(0)
  #define KRD(G,j) do{ if(G){ kload2(kf,kp0+sl_next,j); SBAR(); } }while(0)
  #define STEP(C0,C1,P0,P1,t,GK,GV,GL) do{ SBAR(); \
    const lds_cptr vp_=vp0+sl_prev; \
    VRD(0); SBAR(); float sacc=(P0[0]+P0[1]); \
    GAPA(C0=__builtin_amdgcn_mfma_f32_32x32x16_bf16(kf[0],qr[0],negm,0,0,0), P0[2],P0[3],P0[4],P0[5],     pw0[0]=PKW(P0,0), pw0[1]=PKW(P0,2), pw0); \
    VRD(4); SBAR(); GAPA(C1=__builtin_amdgcn_mfma_f32_32x32x16_bf16(kf[1],qr[0],negm,0,0,0), P0[6],P0[7],P0[8],P0[9],     pw0[2]=PKW(P0,4), pw0[3]=PKW(P0,6), pw0); \
    VRD(1); SBAR(); GAPA(C0=__builtin_amdgcn_mfma_f32_32x32x16_bf16(kf[2],qr[1],C0,0,0,0),   P0[10],P0[11],P0[12],P0[13], pw1[0]=PKW(P0,8), pw1[1]=PKW(P0,10), pw1); \
    VRD(5); SBAR(); GAPA(C1=__builtin_amdgcn_mfma_f32_32x32x16_bf16(kf[3],qr[1],C1,0,0,0),   P0[14],P0[15],P1[0],P1[1],   pw1[2]=PKW(P0,12),pw1[3]=PKW(P0,14), pw1); \
    VRD(2); SBAR(); GAPA(C0=__builtin_amdgcn_mfma_f32_32x32x16_bf16(kf[4],qr[2],C0,0,0,0),   P1[2],P1[3],P1[4],P1[5],     pw2[0]=PKW(P1,0), pw2[1]=PKW(P1,2), pw2); \
    VRD(6); SBAR(); GAPA(C1=__builtin_amdgcn_mfma_f32_32x32x16_bf16(kf[5],qr[2],C1,0,0,0),   P1[6],P1[7],P1[8],P1[9],     pw2[2]=PKW(P1,4), pw2[3]=PKW(P1,6), pw2); \
    VRD(3); SBAR(); GAPA(C0=__builtin_amdgcn_mfma_f32_32x32x16_bf16(kf[6],qr[3],C0,0,0,0),   P1[10],P1[11],P1[12],P1[13], pw3[0]=PKW(P1,8), pw3[1]=PKW(P1,10), pw3); \
    VRD(7); SBAR(); GAPA(C1=__builtin_amdgcn_mfma_f32_32x32x16_bf16(kf[7],qr[3],C1,0,0,0),   P1[14],P1[15],0.f,0.f,       pw3[2]=PKW(P1,12),pw3[3]=PKW(P1,14), pw3); \
    l_reg+=sacc; \
    if(GK){DMA_K((t)+3,sl_cur);} if(GV){DMA_V((t)+1,sl_next);} \
    CMASK(C0,C1,t); \
    { float a=MX3(C0[0],C0[1],C1[0]),b=MX3(C0[2],C0[3],C1[1]); a=MX3(a,C1[2],C1[3]); \
      _Pragma("unroll") for(int r=4;r<16;r+=4){a=MX3(a,C0[r],C0[r+1]);b=MX3(b,C0[r+2],C0[r+3]);a=MX3(a,C1[r],C1[r+1]);b=MX3(b,C1[r+2],C1[r+3]);} \
      float rm=__builtin_fmaxf(a,b); { auto rr=__builtin_amdgcn_permlane32_swap(__float_as_uint(rm),__float_as_uint(rm),false,false); rm=__builtin_fmaxf(__uint_as_float(rr[0]),__uint_as_float(rr[1])); } \
      resc=false; \
      if(__builtin_expect(__any(rm>(float)THRL),0)){ const float dl=__builtin_fmaxf(rm,0.f); mhat+=dl; \
        _Pragma("unroll") for(int r=0;r<16;++r){C0[r]-=dl;C1[r]-=dl;} \
        _Pragma("unroll") for(int r=0;r<16;++r)negm[r]=-mhat; asm volatile("":"+v"(negm)); \
        const float f=__builtin_amdgcn_exp2f(-dl); l_reg*=f; if(hi==0)wsf[r32]=f; resc=true; } } \
    SBAR(); \
    GAPB(o[0]=__builtin_amdgcn_mfma_f32_32x32x16_bf16(PAF(0),VFR(0),o[0],0,0,0), C0,0); \
    GAPB(o[1]=__builtin_amdgcn_mfma_f32_32x32x16_bf16(PAF(0),VFR(4),o[1],0,0,0), C0,4); \
    KRD(GL,0); GAPB(o[0]=__builtin_amdgcn_mfma_f32_32x32x16_bf16(PAF(1),VFR(1),o[0],0,0,0), C0,8); \
    KRD(GL,1); GAPB(o[1]=__builtin_amdgcn_mfma_f32_32x32x16_bf16(PAF(1),VFR(5),o[1],0,0,0), C0,12); \
    KRD(GL,2); GAPB(o[0]=__builtin_amdgcn_mfma_f32_32x32x16_bf16(PAF(2),VFR(2),o[0],0,0,0), C1,0); \
    KRD(GL,3); GAPB(o[1]=__builtin_amdgcn_mfma_f32_32x32x16_bf16(PAF(2),VFR(6),o[1],0,0,0), C1,4); \
    GAPB(o[0]=__builtin_amdgcn_mfma_f32_32x32x16_bf16(PAF(3),VFR(3),o[0],0,0,0), C1,8); \
    GAPB(o[1]=__builtin_amdgcn_mfma_f32_32x32x16_bf16(PAF(3),VFR(7),o[1],0,0,0), C1,12); \
    }while(0)
  int t=1;
  #undef CMASK
  #define CMASK(P0,P1,t) do{}while(0)
  for(;t+5<NT;t+=2){
    STEP(pB0,pB1,pA0,pA1,t,true,true,true);     WAIT_BAR(2); RESC(); ROT();
    STEP(pA0,pA1,pB0,pB1,t+1,true,true,true);   WAIT_BAR(2); RESC(); ROT();
  }
  #undef CMASK
  #define CMASK(P0,P1,t) do{int jb_=(t)-(NT-4); if(jb_>=0)cmask(P0,P1,jb_,qrel,hi);}while(0)
  #define ENDW(tt) do{ if((tt)+3<NT){WAIT_BAR(2);} else if((tt)+2<NT){WAIT_BAR(1);} else {WAIT_BAR(0);} }while(0)
  for(;t+1<NT;t+=2){
    STEP(pB0,pB1,pA0,pA1,t,(t+3<NT),(t+1<NT),(t+1<NT));       ENDW(t);   RESC(); ROT();
    STEP(pA0,pA1,pB0,pB1,t+1,(t+4<NT),(t+2<NT),(t+2<NT));     ENDW(t+1); RESC(); ROT();
  }
  STEP(pB0,pB1,pA0,pA1,NT-1,false,false,false); RESC();
  { float sacc=pB0[0]+pB0[1]; _Pragma("unroll") for(int r=2;r<16;++r)sacc+=pB0[r]; _Pragma("unroll") for(int r=0;r<16;++r)sacc+=pB1[r]; l_reg+=sacc;
    pw0=(u32x4){PKW(pB0,0),PKW(pB0,2),PKW(pB0,4),PKW(pB0,6)};pw1=(u32x4){PKW(pB0,8),PKW(pB0,10),PKW(pB0,12),PKW(pB0,14)};pw2=(u32x4){PKW(pB1,0),PKW(pB1,2),PKW(pB1,4),PKW(pB1,6)};pw3=(u32x4){PKW(pB1,8),PKW(pB1,10),PKW(pB1,12),PKW(pB1,14)};
    SBAR(); pv(o,vb0+sl_cur,PAF(0),PAF(1),PAF(2),PAF(3)); }
  #undef PKW
  #undef PAF
  #undef VFR
  #undef PIN
  #undef MX3
  #undef GAPA
  #undef GAPB
  #undef EX
  #undef VRD
  #undef KRD
  #undef STEP
  #undef ENDW
  {auto rr=__builtin_amdgcn_permlane32_swap(__float_as_uint(l_reg),__float_as_uint(l_reg),false,false);l_reg=__uint_as_float(rr[0])+__uint_as_float(rr[1]);}
  if(hi==0)wsf[32+r32]=l_reg;asm volatile("s_waitcnt lgkmcnt(0)":::"memory");
  float rli[16];
  #pragma unroll
  for(int r=0;r<16;++r)rli[r]=__builtin_amdgcn_rcpf(wsf[32+crow(r,hi)]);
  bf16*Ow=O+(rowbase+q0+wid*QBLK)*OP+ocol;
  { bf16*stg=(bf16*)(shm+LDS_OST)+wid*2048;
    #pragma unroll
    for(int r=0;r<16;++r){const int orow=crow(r,hi);
      #pragma unroll
      for(int d0=0;d0<2;++d0)stg[orow*64+d0*32+r32]=__float2bfloat16(o[d0][r]*rli[r]);}
    asm volatile("s_waitcnt lgkmcnt(0)":::"memory");
    #pragma unroll
    for(int i=0;i<4;++i){const int row=i*8+(lane>>3),ch=lane&7; const u32x4 v=*(const u32x4*)(stg+row*64+ch*8); ATTN_STORE16(Ow+(long)row*OP+ch*8,v);} }
  asm volatile("s_waitcnt lgkmcnt(0)\n\ts_barrier":::"memory");
  #undef DMA_K
  #undef DMA_V
  #undef CMASK
  #undef START
  #undef RESC
  #undef ROT
}
constexpr int LDS3_V=4*SLOTB, LDS3_WS=LDS3_V+4*2*SLOTB, LDS3_OST=LDS3_WS+NW*64*4, LDS3_BYTES=LDS3_OST+NW*4096;
constexpr int LDS2_V=NSLOT*SLOTB, LDS2_WS=LDS2_V+NSLOT*2*SLOTB, LDS2_OST=LDS2_WS+NW*64*4, LDS2_BYTES=LDS2_OST+NW*8192;
#ifndef ATTN_STORE16
#define ATTN_STORE16(p,v) (*(u32x4*)(p)=(v))
#endif
template<int THRL> __device__ __forceinline__ void attn_unit128(int b,int qcol,int kcol,int vcol,int ocol,int qb,const bf16*Q,const bf16*__restrict__ K,const bf16*__restrict__ V,bf16*O,char*shm){
  int tid_=threadIdx.x; asm volatile("":"+v"(tid_));
  const int tid=tid_,lane=tid&63,r32=lane&31,hi=lane>>5; const int wid=__builtin_amdgcn_readfirstlane(tid>>6);
  const long rowbase=(long)b*SEQ; const int q0=qb*QB;
  const bf16*Qw=Q+(rowbase+q0+wid*QBLK)*QP+qcol;
  const bf16*Kh=K+rowbase*KP+kcol,*Vh=V+rowbase*VP+vcol;
  const unsigned lds0=(unsigned)(uintptr_t)shm;
  float*wsf=(float*)(shm+LDS3_WS)+wid*64;
  const bf16*ksrc=Kh+(long)lane*KP+wid*8;
  const bf16*vsrc=Vh+(long)(16*(wid&3)+(lane>>2))*VP+(wid>>2)*32+(lane&3)*8;
  const unsigned kdst=lds0+LDS_K+wid*1024, vdst=lds0+LDS3_V+wid*1024;
  #define DMA_K(t,slot) glds16(ksrc+(long)(t)*KVBLK*KP,(unsigned)__builtin_amdgcn_readfirstlane(kdst+(slot)))
  #define DMA_V(t,slot) do{ glds16(vsrc+(long)(t)*KVBLK*VP,(unsigned)__builtin_amdgcn_readfirstlane(vdst+2*(slot))); glds16(vsrc+(long)(t)*KVBLK*VP+64,(unsigned)__builtin_amdgcn_readfirstlane(vdst+2*(slot)+8192)); }while(0)
  const int vb0=(int)(lds0+LDS3_V)+((lane>>4)&1)*32+(lane&3)*8+(4*hi+((lane&15)>>2))*64;
  const char*Kbase=shm+LDS_K; bf16x8 kf[8];
  const lds_cptr shm3=(lds_cptr)shm; const lds_cptr kp0=shm3+LDS_K+hi*1024+r32*16; const lds_cptr vp0=shm3+LDS3_V+((lane>>4)&1)*32+(lane&3)*8+(4*hi+((lane&15)>>2))*64;
  const int NT=(q0+QB)/KVBLK;
  DMA_K(0,0);DMA_V(0,0);DMA_K(1,SLOTB);
  bf16x8 qr[4];
  #pragma unroll
  for(int d0=0;d0<4;++d0)qr[d0]=*reinterpret_cast<const bf16x8*>(&Qw[(long)r32*QP+d0*16+hi*8]);
  float mhat=0.f,l_reg=0.f;f32x16 o[4];o[0]=f32x16{};o[1]=f32x16{};o[2]=f32x16{};o[3]=f32x16{};f32x16 negm=f32x16{};asm volatile("":"+v"(negm));
  const int qrel=wid>>1;
  #define CMASK(P0,P1,t) do{int jb_=(t)-(NT-4); if(jb_>=0)cmask(P0,P1,jb_,qrel,hi);}while(0)
  bool resc=false;
  #define START(P0,P1) do{ const float rm=rowmax(P0,P1); resc=false; \
    { const float dl=rm; mhat=fadd_s(mhat,dl); \
      _Pragma("unroll") for(int r=0;r<16;++r){P0[r]=fsub_s(P0[r],dl);P1[r]=fsub_s(P1[r],dl);} \
      _Pragma("unroll") for(int r=0;r<16;++r)negm[r]=-mhat; asm volatile("":"+v"(negm)); } \
    _Pragma("unroll") for(int r=0;r<16;++r)P0[r]=__builtin_amdgcn_exp2f(P0[r]); }while(0)
  #define RESC() do{ if(resc){ asm volatile("s_waitcnt lgkmcnt(0)":::"memory"); \
      _Pragma("unroll") for(int d_=0;d_<4;++d_) _Pragma("unroll") for(int r=0;r<16;++r)o[d_][r]*=wsf[crow(r,hi)]; } }while(0)
  f32x16 pA0,pA1,pB0,pB1;
  int sl_prev=0,sl_cur=SLOTB,sl_next=2*SLOTB,sl_next2=3*SLOTB;
  #define ROT() do{sl_prev=sl_cur;sl_cur=sl_next;sl_next=sl_next2;sl_next2=(sl_next2+SLOTB)&(4*SLOTB-1);}while(0)
  DMA_K(2,2*SLOTB);DMA_V(1,SLOTB);DMA_K(3,3*SLOTB);
  WAIT_BAR(7);
  qkt(pA0,pA1,Kbase,qr,negm,r32,hi);asm volatile("s_nop 15\n\ts_nop 7":"+v"(pA0),"+v"(pA1));CMASK(pA0,pA1,0);
  START(pA0,pA1);
  _Pragma("unroll") for(int r=0;r<16;++r)pA1[r]=__builtin_amdgcn_exp2f(pA1[r]);
  WAIT_BAR(4);
  if(NT>4){DMA_K(4,0);} DMA_V(2,2*SLOTB);
  kload8(kf,kp0+sl_cur);
  if(NT>4){WAIT_BAR(6);}else{WAIT_BAR(5);}
  s16x4 vlo[4],vhi[4]; u32x4 pw0,pw1,pw2,pw3;
  #define PKW(P,B) cvtpk_s(P[B],P[B+1])
  #define PAF(k) __builtin_bit_cast(bf16x8,pw##k)
  #define VFR(i) (bf16x8){vlo[i][0],vlo[i][1],vlo[i][2],vlo[i][3],vhi[i][0],vhi[i][1],vhi[i][2],vhi[i][3]}
  #define PIN(x) asm volatile("":"+v"(x))
  #define MX3(a,b,c) __builtin_fmaxf(__builtin_fmaxf((a),(b)),(c))
  #define GAPA(MF,A0,A1,A2,A3,W0,W1,PW) do{ MF; sacc+=A0; sacc+=A1; sacc+=A2; sacc+=A3; PIN(sacc); W0; W1; PIN(PW); SBAR(); }while(0)
  #define EX(v) __builtin_amdgcn_exp2f(v)
  #define GAPB(MF,X,B) do{ MF; X[B]=EX(X[B]); X[B+1]=EX(X[B+1]); PIN(X); SBAR(); }while(0)
  #define GAPBV(MF,RD,X,B) do{ MF; RD; X[B]=EX(X[B]); X[B+1]=EX(X[B+1]); PIN(X); SBAR(); }while(0)
  #define VRD(j,d,k) do{ vlo[(j)&3]=vtr(vp_+((d)*4096+(k)*1024)); vhi[(j)&3]=vtr(vp_+((d)*4096+(k)*1024+512)); }while(0)
  #define KRD(G,j) do{ if(G){ kload2(kf,kp0+sl_next,j); SBAR(); } }while(0)
  #define STEP(C0,C1,P0,P1,t,GK,GV,GL) do{ SBAR(); \
    const lds_cptr vp_=vp0+2*sl_prev; \
    float sacc=(P0[0]+P0[1]); \
    GAPA(C0=__builtin_amdgcn_mfma_f32_32x32x16_bf16(kf[0],qr[0],negm,0,0,0), P0[2],P0[3],P0[4],P0[5],     pw0[0]=PKW(P0,0), pw0[1]=PKW(P0,2), pw0); \
    GAPA(C1=__builtin_amdgcn_mfma_f32_32x32x16_bf16(kf[1],qr[0],negm,0,0,0), P0[6],P0[7],P0[8],P0[9],     pw0[2]=PKW(P0,4), pw0[3]=PKW(P0,6), pw0); \
    GAPA(C0=__builtin_amdgcn_mfma_f32_32x32x16_bf16(kf[2],qr[1],C0,0,0,0),   P0[10],P0[11],P0[12],P0[13], pw1[0]=PKW(P0,8), pw1[1]=PKW(P0,10), pw1); \
    GAPA(C1=__builtin_amdgcn_mfma_f32_32x32x16_bf16(kf[3],qr[1],C1,0,0,0),   P0[14],P0[15],P1[0],P1[1],   pw1[2]=PKW(P0,12),pw1[3]=PKW(P0,14), pw1); \
    VRD(0,0,0); SBAR(); GAPA(C0=__builtin_amdgcn_mfma_f32_32x32x16_bf16(kf[4],qr[2],C0,0,0,0),   P1[2],P1[3],P1[4],P1[5],     pw2[0]=PKW(P1,0), pw2[1]=PKW(P1,2), pw2); \
    VRD(1,1,0); SBAR(); GAPA(C1=__builtin_amdgcn_mfma_f32_32x32x16_bf16(kf[5],qr[2],C1,0,0,0),   P1[6],P1[7],P1[8],P1[9],     pw2[2]=PKW(P1,4), pw2[3]=PKW(P1,6), pw2); \
    VRD(2,0,1); SBAR(); GAPA(C0=__builtin_amdgcn_mfma_f32_32x32x16_bf16(kf[6],qr[3],C0,0,0,0),   P1[10],P1[11],P1[12],P1[13], pw3[0]=PKW(P1,8), pw3[1]=PKW(P1,10), pw3); \
    VRD(3,1,1); SBAR(); GAPA(C1=__builtin_amdgcn_mfma_f32_32x32x16_bf16(kf[7],qr[3],C1,0,0,0),   P1[14],P1[15],0.f,0.f,       pw3[2]=PKW(P1,12),pw3[3]=PKW(P1,14), pw3); \
    l_reg+=sacc; \
    if(GK){DMA_K((t)+4,sl_cur);} if(GV){DMA_V((t)+2,sl_next2);} \
    CMASK(C0,C1,t); \
    { float a=MX3(C0[0],C0[1],C1[0]),b=MX3(C0[2],C0[3],C1[1]); a=MX3(a,C1[2],C1[3]); \
      _Pragma("unroll") for(int r=4;r<16;r+=4){a=MX3(a,C0[r],C0[r+1]);b=MX3(b,C0[r+2],C0[r+3]);a=MX3(a,C1[r],C1[r+1]);b=MX3(b,C1[r+2],C1[r+3]);} \
      float rm=__builtin_fmaxf(a,b); { auto rr=__builtin_amdgcn_permlane32_swap(__float_as_uint(rm),__float_as_uint(rm),false,false); rm=__builtin_fmaxf(__uint_as_float(rr[0]),__uint_as_float(rr[1])); } \
      resc=false; \
      if(__builtin_expect(__any(rm>(float)THRL),0)){ const float dl=__builtin_fmaxf(rm,0.f); mhat+=dl; \
        _Pragma("unroll") for(int r=0;r<16;++r){C0[r]-=dl;C1[r]-=dl;} \
        _Pragma("unroll") for(int r=0;r<16;++r)negm[r]=-mhat; asm volatile("":"+v"(negm)); \
        const float f=__builtin_amdgcn_exp2f(-dl); l_reg*=f; if(hi==0)wsf[r32]=f; resc=true; } } \
    SBAR(); \
    GAPBV(o[0]=__builtin_amdgcn_mfma_f32_32x32x16_bf16(PAF(0),VFR(0),o[0],0,0,0), VRD(4,0,2), C0,0); \
    GAPBV(o[1]=__builtin_amdgcn_mfma_f32_32x32x16_bf16(PAF(0),VFR(1),o[1],0,0,0), VRD(5,1,2), C0,2); \
    KRD(GL,0); GAPBV(o[0]=__builtin_amdgcn_mfma_f32_32x32x16_bf16(PAF(1),VFR(2),o[0],0,0,0), VRD(6,0,3), C0,4); \
    KRD(GL,1); GAPBV(o[1]=__builtin_amdgcn_mfma_f32_32x32x16_bf16(PAF(1),VFR(3),o[1],0,0,0), VRD(7,1,3), C0,6); \
    KRD(GL,2); GAPBV(o[0]=__builtin_amdgcn_mfma_f32_32x32x16_bf16(PAF(2),VFR(0),o[0],0,0,0), VRD(8,2,0), C0,8); \
    KRD(GL,3); GAPBV(o[1]=__builtin_amdgcn_mfma_f32_32x32x16_bf16(PAF(2),VFR(1),o[1],0,0,0), VRD(9,3,0), C0,10); \
    GAPBV(o[0]=__builtin_amdgcn_mfma_f32_32x32x16_bf16(PAF(3),VFR(2),o[0],0,0,0), VRD(10,2,1), C0,12); \
    GAPBV(o[1]=__builtin_amdgcn_mfma_f32_32x32x16_bf16(PAF(3),VFR(3),o[1],0,0,0), VRD(11,3,1), C0,14); \
    GAPBV(o[2]=__builtin_amdgcn_mfma_f32_32x32x16_bf16(PAF(0),VFR(0),o[2],0,0,0), VRD(12,2,2), C1,0); \
    GAPBV(o[3]=__builtin_amdgcn_mfma_f32_32x32x16_bf16(PAF(0),VFR(1),o[3],0,0,0), VRD(13,3,2), C1,2); \
    GAPBV(o[2]=__builtin_amdgcn_mfma_f32_32x32x16_bf16(PAF(1),VFR(2),o[2],0,0,0), VRD(14,2,3), C1,4); \
    GAPBV(o[3]=__builtin_amdgcn_mfma_f32_32x32x16_bf16(PAF(1),VFR(3),o[3],0,0,0), VRD(15,3,3), C1,6); \
    GAPB(o[2]=__builtin_amdgcn_mfma_f32_32x32x16_bf16(PAF(2),VFR(0),o[2],0,0,0), C1,8); \
    GAPB(o[3]=__builtin_amdgcn_mfma_f32_32x32x16_bf16(PAF(2),VFR(1),o[3],0,0,0), C1,10); \
    GAPB(o[2]=__builtin_amdgcn_mfma_f32_32x32x16_bf16(PAF(3),VFR(2),o[2],0,0,0), C1,12); \
    GAPB(o[3]=__builtin_amdgcn_mfma_f32_32x32x16_bf16(PAF(3),VFR(3),o[3],0,0,0), C1,14); \
    }while(0)
  int t=1;
  #undef CMASK
  #define CMASK(P0,P1,t) do{}while(0)
  for(;t+5<NT;t+=2){
    STEP(pB0,pB1,pA0,pA1,t,true,true,true);     WAIT_BAR(6); RESC(); ROT();
    STEP(pA0,pA1,pB0,pB1,t+1,true,true,true);   WAIT_BAR(6); RESC(); ROT();
  }
  #undef CMASK
  #define CMASK(P0,P1,t) do{int jb_=(t)-(NT-4); if(jb_>=0)cmask(P0,P1,jb_,qrel,hi);}while(0)
  #define ENDW(tt) do{ const int d_=NT-(tt); if(d_>=5){WAIT_BAR(6);} else if(d_==4){WAIT_BAR(5);} else if(d_==3){WAIT_BAR(4);} else {WAIT_BAR(0);} }while(0)
  for(;t+1<NT;t+=2){
    STEP(pB0,pB1,pA0,pA1,t,(t+4<NT),(t+2<NT),(t+1<NT));       ENDW(t);   RESC(); ROT();
    STEP(pA0,pA1,pB0,pB1,t+1,(t+5<NT),(t+3<NT),(t+2<NT));     ENDW(t+1); RESC(); ROT();
  }
  STEP(pB0,pB1,pA0,pA1,NT-1,false,false,false); RESC();
  { float sacc=pB0[0]+pB0[1]; _Pragma("unroll") for(int r=2;r<16;++r)sacc+=pB0[r]; _Pragma("unroll") for(int r=0;r<16;++r)sacc+=pB1[r]; l_reg+=sacc;
    pw0=(u32x4){PKW(pB0,0),PKW(pB0,2),PKW(pB0,4),PKW(pB0,6)};pw1=(u32x4){PKW(pB0,8),PKW(pB0,10),PKW(pB0,12),PKW(pB0,14)};pw2=(u32x4){PKW(pB1,0),PKW(pB1,2),PKW(pB1,4),PKW(pB1,6)};pw3=(u32x4){PKW(pB1,8),PKW(pB1,10),PKW(pB1,12),PKW(pB1,14)};
    SBAR(); pv(o,vb0+2*sl_cur,PAF(0),PAF(1),PAF(2),PAF(3)); pv(o+2,vb0+2*sl_cur+8192,PAF(0),PAF(1),PAF(2),PAF(3)); }
  #undef PKW
  #undef PAF
  #undef VFR
  #undef PIN
  #undef MX3
  #undef GAPA
  #undef GAPB
  #undef GAPBV
  #undef EX
  #undef VRD
  #undef KRD
  #undef STEP
  #undef ENDW
  {auto rr=__builtin_amdgcn_permlane32_swap(__float_as_uint(l_reg),__float_as_uint(l_reg),false,false);l_reg=__uint_as_float(rr[0])+__uint_as_float(rr[1]);}
  if(hi==0)wsf[32+r32]=l_reg;asm volatile("s_waitcnt lgkmcnt(0)":::"memory");
  float rli[16];
  #pragma unroll
  for(int r=0;r<16;++r)rli[r]=__builtin_amdgcn_rcpf(wsf[32+crow(r,hi)]);
  bf16*Ow=O+(rowbase+q0+wid*QBLK)*OP+ocol;
  { bf16*stg=(bf16*)(shm+LDS3_OST)+wid*2048;
    #pragma unroll
    for(int hc=0;hc<2;++hc){
      #pragma unroll
      for(int r=0;r<16;++r){const int orow=crow(r,hi);
        #pragma unroll
        for(int d0=0;d0<2;++d0)stg[orow*64+d0*32+r32]=__float2bfloat16(o[2*hc+d0][r]*rli[r]);}
      asm volatile("s_waitcnt lgkmcnt(0)":::"memory");
      #pragma unroll
      for(int i=0;i<4;++i){const int row=i*8+(lane>>3),ch=lane&7; const u32x4 v=*(const u32x4*)(stg+row*64+ch*8); ATTN_STORE16(Ow+(long)row*OP+hc*64+ch*8,v);}
      asm volatile("s_waitcnt lgkmcnt(0)":::"memory"); } }
  asm volatile("s_waitcnt lgkmcnt(0)\n\ts_barrier":::"memory");
  #undef DMA_K
  #undef DMA_V
  #undef CMASK
  #undef START
  #undef RESC
  #undef ROT
}
constexpr int ATTN_LDS_BYTES=LDS_BYTES;
struct AttnTensors { const bf16* Q; const bf16* K; const bf16* V; bf16* O; };
struct AttnUnit { int bvh; int qb; };
struct StaticOrder {
  int ai,nA;
  __device__ __forceinline__ StaticOrder(int ai_,int nA_):ai(ai_),nA(nA_){}
  __device__ __forceinline__ bool next(int i,AttnUnit&u)const{
    if(nA==128){ if(i>=8)return false; u.bvh=ai; u.qb=7-i; return true; }
    if(i>=4)return false; const int s=ai&1; u.bvh=ai>>1; u.qb=(i==0)?7-s:(i==1)?4+s:(i==2)?3-s:s; return true; }
  __device__ __forceinline__ void a_ready(const AttnUnit&)const{}
  __device__ __forceinline__ void done(const AttnUnit&)const{}
};
template<class Sched,int THRL=8> __device__ __forceinline__ void attn_phase(char*lds,const AttnTensors&T,const Sched&S){
  AttnUnit u;
  for(int i=0;S.next(i,u);++i){ S.a_ready(u); const int b=u.bvh>>4,vh=u.bvh&15,s=vh>>1,half=vh&1;
    attn_unit<THRL>(b,s*64,s*64,(s>>1)*128+half*64,s*128+half*64,u.qb,T.Q,T.K,T.V,T.O,lds); S.done(u); }
}
template<int THRL=8> __device__ __forceinline__ void attn_phase_queue(char*lds,const AttnTensors&T,unsigned*counter,volatile __attribute__((address_space(3))) unsigned*slot){
  for(;;){
    if(threadIdx.x==0)*slot=__hip_atomic_fetch_add(counter,1u,__ATOMIC_RELAXED,__HIP_MEMORY_SCOPE_AGENT);
    __syncthreads();
    const unsigned u=__builtin_amdgcn_readfirstlane(*slot);
    __syncthreads();
    if(u>=1024u)break;
    const int qb=7-(int)(u>>7),bvh=(int)(u&127u),b=bvh>>4,vh=bvh&15,s=vh>>1,half=vh&1;
    attn_unit<THRL>(b,s*64,s*64,(s>>1)*128+half*64,s*128+half*64,qb,T.Q,T.K,T.V,T.O,lds);
  }
}
template<int THRL=8> __device__ __forceinline__ void attn_phase_queue128(char*lds,const AttnTensors&T,unsigned*counter,volatile __attribute__((address_space(3))) unsigned*slot){
  for(;;){
    if(threadIdx.x==0)*slot=__hip_atomic_fetch_add(counter,1u,__ATOMIC_RELAXED,__HIP_MEMORY_SCOPE_AGENT);
    __syncthreads();
    const unsigned u=__builtin_amdgcn_readfirstlane(*slot);
    __syncthreads();
    if(u>=512u)break;
    const int qb=7-(int)(u>>6),bs=(int)(u&63u),b=bs>>3,s=bs&7;
    attn_unit128<THRL>(b,s*64,s*64,(s>>1)*128,s*128,qb,T.Q,T.K,T.V,T.O,lds);
  }
}
template<int THRL=8> __device__ __forceinline__ void attn_phase_hybrid128(char*lds,const AttnTensors&T,unsigned*counter,volatile __attribute__((address_space(3))) unsigned*slot,int c){
  int nst=0,q0=0,q1=0,bs0=0;
  if(c<64){nst=2;q0=7;q1=2;bs0=c;} else if(c<128){nst=2;q0=6;q1=4;bs0=c-64;} else if(c<192){nst=2;q0=3;q1=1;bs0=c-128;} else {nst=1;q0=5;bs0=c-192;}
  for(int i=0;;++i){
    int qb,bs;
    if(i<nst){ qb=(i==0)?q0:q1; bs=bs0; }
    else{
      if(threadIdx.x==0)*slot=__hip_atomic_fetch_add(counter,1u,__ATOMIC_RELAXED,__HIP_MEMORY_SCOPE_AGENT);
      __syncthreads();
      const unsigned u=__builtin_amdgcn_readfirstlane(*slot);
      __syncthreads();
      if(u>=64u)break;
      qb=0; bs=(int)u;
    }
    const int b=bs>>3,sh=bs&7;
    attn_unit128<THRL>(b,sh*64,sh*64,(sh>>1)*128,sh*128,qb,T.Q,T.K,T.V,T.O,lds);
  }
}
#undef SBAR
#undef WAIT_BAR
}
#include <hip/hip_cooperative_groups.h>
typedef unsigned short bf16;
#define GAS __attribute__((address_space(1)))
#define LAS __attribute__((address_space(3)))
typedef unsigned v4u __attribute__((ext_vector_type(4)));
typedef unsigned v2u __attribute__((ext_vector_type(2)));
typedef float f32x4 __attribute__((ext_vector_type(4)));
#define LDS_WAIT() asm volatile("s_waitcnt lgkmcnt(0)" ::: "memory")
__device__ __forceinline__ unsigned f2bf(float f) { unsigned u = __builtin_bit_cast(unsigned, f); return (u + 0x7fffu + ((u >> 16) & 1u)) >> 16; }
__device__ __forceinline__ unsigned pk2(float lo, float hi) { typedef float f2_ __attribute__((ext_vector_type(2))); typedef __bf16 b2_ __attribute__((ext_vector_type(2))); const f2_ v = {lo, hi}; return __builtin_bit_cast(unsigned, __builtin_convertvector(v, b2_)); }
__device__ __forceinline__ float bflo(unsigned w) { return __builtin_bit_cast(float, w << 16); }
__device__ __forceinline__ float bfhi(unsigned w) { return __builtin_bit_cast(float, w & 0xffff0000u); }
__device__ __forceinline__ float bf1(unsigned short h) { return __builtin_bit_cast(float, (unsigned)h << 16); }
template <int CTRL> __device__ __forceinline__ float dppf(float x) { return __builtin_bit_cast(float, __builtin_amdgcn_update_dpp(0, __builtin_bit_cast(int, x), CTRL, 0xf, 0xf, false)); }
__device__ __forceinline__ float row16_allsum(float x) { x += dppf<0x128>(x); x += dppf<0x124>(x); x += dppf<0x122>(x); x += dppf<0x121>(x); return x; }
__device__ __forceinline__ float oct_allsum(float x) { x += dppf<0xB1>(x); x += dppf<0x4E>(x); x += dppf<0x141>(x); return x; }
__device__ __forceinline__ float u2f(unsigned u) { return __builtin_bit_cast(float, u); }
__device__ __forceinline__ unsigned f2u(float f) { return __builtin_bit_cast(unsigned, f); }
__device__ __forceinline__ float sw32(float a, float b) { auto r = __builtin_amdgcn_permlane32_swap(f2u(a), f2u(b), false, false); const unsigned r0 = r[0], r1 = r[1]; return u2f(r0) + u2f(r1); }
__device__ __forceinline__ float sw16(float a, float b) { auto r = __builtin_amdgcn_permlane16_swap(f2u(a), f2u(b), false, false); const unsigned r0 = r[0], r1 = r[1]; return u2f(r0) + u2f(r1); }
__device__ __forceinline__ float wave_allsum(float x) { x = row16_allsum(x); x = sw16(x, x); return sw32(x, x); }
__device__ __forceinline__ float red4(float x0, float x1, float x2, float x3) { return row16_allsum(sw16(sw32(x0, x1), sw32(x2, x3))); }

#define XB_TMO      128
#define XB_XCNT(j)  (256  + 64 * (j))
#define XB_XSUB(j)  (1280 + 64 * (j))
#define XB_XGEN(j)  (2304 + 64 * (j))
#define XB_TOP      3328
#define XB_TOPGEN   3392
#define XCD_BAR_WORDS 3456
#define XB_SPIN_CAP (1u << 18)

__device__ __forceinline__ unsigned xb_ld(unsigned* p)              { return __hip_atomic_load(p, __ATOMIC_RELAXED, __HIP_MEMORY_SCOPE_AGENT); }
__device__ __forceinline__ unsigned xb_add(unsigned* p, unsigned v) { return __hip_atomic_fetch_add(p, v, __ATOMIC_RELAXED, __HIP_MEMORY_SCOPE_AGENT); }
__device__ __forceinline__ unsigned xb_xcc_id() { return (unsigned)__builtin_amdgcn_s_getreg((3 << 11) | 20) & 0xFu; }
#define XB_SPIN(cond, bar) do { unsigned _sp = 0; while (cond) { __builtin_amdgcn_s_sleep(1); \
    if ((++_sp & 255u) == 0u) { if (xb_ld(&(bar)[XB_TMO])) break; if (_sp > XB_SPIN_CAP) { atomicAdd(&(bar)[XB_TMO], 1u); break; } } } } while (0)

struct XcdBarrier {
    unsigned* bar; unsigned x;
    volatile LAS unsigned* st;
};

__device__ __forceinline__ XcdBarrier xcd_barrier_post(unsigned* bar, volatile LAS unsigned* st) {
    XcdBarrier b; b.bar = bar; b.x = xb_xcc_id(); b.st = st;
    if (threadIdx.x == 0) (void)xb_add(&bar[XB_XCNT(b.x)], 1u);
    return b;
}
__device__ __forceinline__ void xcd_barrier_complete(unsigned* bar, unsigned x, unsigned& nloc, unsigned& nx) {
    const unsigned G = gridDim.x * gridDim.y * gridDim.z;
    unsigned sum, cnt, mine, sp = 0u;
    for (;;) {
        sum = 0u; cnt = 0u; mine = 0u;
#pragma unroll
        for (unsigned j = 0; j < 16; ++j) { const unsigned c = xb_ld(&bar[XB_XCNT(j)]); sum += c; cnt += (c > 0u) ? 1u : 0u; }
        mine = xb_ld(&bar[XB_XCNT(x)]);
        if (sum == G) break;
        __builtin_amdgcn_s_sleep(1);
        if ((++sp & 255u) == 0u) { if (xb_ld(&bar[XB_TMO])) break; if (sp > XB_SPIN_CAP) { atomicAdd(&bar[XB_TMO], 1u); break; } }
    }
    nloc = mine > 0u ? mine : 1u; nx = cnt > 0u ? cnt : 1u;
}

__device__ __forceinline__ void xcd_barrier(const XcdBarrier& b) {
    asm volatile("s_waitcnt vmcnt(0)" ::: "memory");
    __syncthreads();
    if (threadIdx.x == 0) {
        unsigned* bar = b.bar;
        __builtin_amdgcn_s_waitcnt(0);
        unsigned nloc = b.st[0], nx = b.st[1];
        if (nloc == 0u) { xcd_barrier_complete(bar, b.x, nloc, nx); b.st[0] = nloc; b.st[1] = nx; }
        const unsigned old = xb_add(&bar[XB_XSUB(b.x)], 1u);
        const unsigned gen = old / nloc;
        if (old + 1u == (gen + 1u) * nloc) {
            __builtin_amdgcn_fence(__ATOMIC_RELEASE, "agent");
            asm volatile("s_waitcnt vmcnt(0)" ::: "memory");
            const unsigned og = xb_add(&bar[XB_TOP], 1u);
            const unsigned tg = og / nx;
            if (og + 1u == (tg + 1u) * nx) xb_add(&bar[XB_TOPGEN], 1u);
            else XB_SPIN(xb_ld(&bar[XB_TOPGEN]) == tg, bar);
            __builtin_amdgcn_fence(__ATOMIC_ACQUIRE, "agent");
            xb_add(&bar[XB_XGEN(b.x)], 1u);
            asm volatile("s_waitcnt vmcnt(0)" ::: "memory");
        } else {
            XB_SPIN(xb_ld(&bar[XB_XGEN(b.x)]) == gen, bar);
            __builtin_amdgcn_fence(__ATOMIC_ACQUIRE, "agent");
            asm volatile("s_waitcnt vmcnt(0)" ::: "memory");
        }
    }
    __syncthreads();
}


constexpr int CW_BAR = 4096;
constexpr int MISC_OFF = 162816 + 320;
struct Frame {
    LAS unsigned char* lds;
    int tid, lane, wave, G, bx;
    float* out; unsigned char* ws;
};
struct Args { const float* in[26]; float* out; unsigned char* ws; int ph_lo, ph_hi; };
typedef const float* cfp_t;
typedef __attribute__((address_space(4))) const cfp_t* ktab_t;
struct InTab { ktab_t p; __device__ __forceinline__ const float* operator[](int i) const { return p[i]; } };
enum { I_X = 0, I_NMG, I_WIN, I_MU, I_W0, I_W2, I_A0, I_A2, I_G2, I_KK, I_KA, I_RK, I_LNG, I_LNB, I_LQ1, I_LK1, I_LQ2, I_LK2, I_SUBG, I_WA, I_WB, I_WO, I_NFG, I_FF1, I_FF2, I_NFIN };

template <bool ROPE> __device__ __forceinline__ void p0_transpose_item(const float* W, int K, int N, bf16* WT, LAS float* scr, int item, int lane, int pitch = 0, int koff = 0) {
    if (pitch == 0) pitch = K;
    const int nblk = N / 32, kb = item / nblk, nb = item % nblk, k0 = 64 * kb, n0 = 32 * nb;
#pragma unroll
    for (int i = 0; i < 8; ++i) { const int kk = 8 * i + (lane >> 3), c4 = 4 * (lane & 7); const f32x4 w4 = *(const GAS f32x4*)(W + (size_t)(k0 + kk) * N + n0 + c4);
        scr[kk * 33 + c4] = w4.x; scr[kk * 33 + c4 + 1] = w4.y; scr[kk * 33 + c4 + 2] = w4.z; scr[kk * 33 + c4 + 3] = w4.w; }
    LDS_WAIT(); asm volatile("" ::: "memory");
    const int c = lane & 7;
#pragma unroll
    for (int j = 0; j < 4; ++j) { const int n = (lane >> 3) + 8 * j; const LAS float* s = scr + (8 * c) * 33 + n;
        v4u o; o.x = pk2(s[0 * 33], s[1 * 33]); o.y = pk2(s[2 * 33], s[3 * 33]); o.z = pk2(s[4 * 33], s[5 * 33]); o.w = pk2(s[6 * 33], s[7 * 33]);
        int col = n0 + n;
        if (ROPE && col < 1024) { const int d = col & 63, dd = d & 31; col = (col & ~63) + 8 * (dd >> 2) + (d >> 5) * 4 + (dd & 3); }
        *(GAS v4u*)(WT + (size_t)col * pitch + koff + k0 + 8 * c) = o; }
    LDS_WAIT(); asm volatile("" ::: "memory");
}
__device__ __forceinline__ void rms_row_to_bf16(const float* xrow, const float* g, bf16* orow, int lane) {
    const GAS f32x4* xr = (const GAS f32x4*)xrow + lane; const f32x4* gr = (const f32x4*)g + lane;
    f32x4 v[4]; float s = 0.f;
#pragma unroll
    for (int j = 0; j < 4; ++j) { v[j] = xr[64 * j]; s += (v[j].x * v[j].x + v[j].y * v[j].y) + (v[j].z * v[j].z + v[j].w * v[j].w); }
    const float rstd = 1.0f / sqrtf(wave_allsum(s) * (1.f / D) + NORM_EPS);
    GAS unsigned long long* o8 = (GAS unsigned long long*)orow + lane;
#pragma unroll
    for (int j = 0; j < 4; ++j) { const f32x4 gg = gr[64 * j];
        o8[64 * j] = (unsigned long long)pk2(v[j].x * rstd * gg.x, v[j].y * rstd * gg.y) | ((unsigned long long)pk2(v[j].z * rstd * gg.z, v[j].w * rstd * gg.w) << 32); }
}
__device__ __forceinline__ void rms_row_to_f32(const float* xrow, const float* g, float* orow, int lane) {
    const GAS f32x4* xr = (const GAS f32x4*)xrow + lane; const f32x4* gr = (const f32x4*)g + lane;
    f32x4 v[4]; float s = 0.f;
#pragma unroll
    for (int j = 0; j < 4; ++j) { v[j] = xr[64 * j]; s += (v[j].x * v[j].x + v[j].y * v[j].y) + (v[j].z * v[j].z + v[j].w * v[j].w); }
    const float rstd = 1.0f / sqrtf(wave_allsum(s) * (1.f / D) + NORM_EPS);
    GAS f32x4* o = (GAS f32x4*)orow + lane;
#pragma unroll
    for (int j = 0; j < 4; ++j) { const f32x4 gg = gr[64 * j]; o[64 * j] = v[j] * rstd * gg; }
}
__device__ __forceinline__ void p0_prologue(Frame& F, const InTab& A) {
    LAS float* scr = (LAS float*)(F.lds + RING_OFF + F.wave * 16384);
    const int gw = F.bx * NWAVES + F.wave, NGW = F.G * NWAVES;
    unsigned char* ws = F.ws;
    constexpr int I_IN = (D / 64) * (D_IN / 32), I_A = (512 / 64) * (D / 32), I_O = (D / 64) * (D / 32), I_1 = (D / 64) * (FF / 32), I_2 = (FF / 64) * (D / 32);
    (void)I_A; (void)I_O; (void)I_1; (void)I_2;
    for (int it = gw; it < I_IN; it += NGW) p0_transpose_item<true>(A[I_WIN], D, D_IN, (bf16*)(ws + WS_WIN), scr, it, F.lane);
    if (false) for (int it = gw; it < 0; it += NGW) {
        int r = it;
        if (r < I_A) { p0_transpose_item<false>(A[I_WA], 512, D, (bf16*)(ws + WS_WA), scr, r, F.lane, 1024, 0); continue; } r -= I_A;
        if (r < I_A) { p0_transpose_item<false>(A[I_WB], 512, D, (bf16*)(ws + WS_WA), scr, r, F.lane, 1024, 512); continue; } r -= I_A;
        if (r < I_O) { p0_transpose_item<false>(A[I_WO], D, D, (bf16*)(ws + WS_WO), scr, r, F.lane); continue; } r -= I_O;
        if (r < I_1) { p0_transpose_item<false>(A[I_FF1], D, FF, (bf16*)(ws + WS_W1), scr, r, F.lane); continue; } r -= I_1;
        p0_transpose_item<false>(A[I_FF2], FF, D, (bf16*)(ws + WS_W2), scr, r, F.lane);
    }
    const int gt = F.bx * (NWAVES * 64) + F.tid, NGT = F.G * NWAVES * 64;
    for (int e = gt; e < NLORA * (KLORA / 8); e += NGT) { const int n = e % NLORA, k8 = (e / NLORA) * 8; float v[8];
#pragma unroll
        for (int i = 0; i < 8; ++i) { const int k = k8 + i; float x = 0.f;
            if (n < 512) { if (k < 64) x = A[I_W2][(size_t)k * 512 + n]; }
            else if (n < 1024) { if (k >= 64 && k < 128) x = A[I_A2][(size_t)(k - 64) * 512 + (n - 512)]; }
            else { if (k >= 128) x = A[I_G2][(size_t)(k - 128) * 512 + (n - 1024)]; }
            v[i] = x; }
        v4u o; o.x = pk2(v[0], v[1]); o.y = pk2(v[2], v[3]); o.z = pk2(v[4], v[5]); o.w = pk2(v[6], v[7]);
        *(GAS v4u*)((bf16*)(ws + WS_WL) + (size_t)n * KLORA + k8) = o; }
    for (int e = gt; e < SEQ * 32; e += NGT) { const int pos = e >> 5, i = e & 31;
        const float inv = exp2f(-(float)i * 0.41524101186092029f);
        const float ang = (float)pos * inv; float s, c; sincosf(ang, &s, &c);
        ((float*)(ws + WS_ROPE_C))[e] = c; ((float*)(ws + WS_ROPE_S))[e] = s; }
    for (int m = gw; m < M; m += 2 * NGW) {
        const int m2 = m + NGW;
        const GAS f32x4* xa = (const GAS f32x4*)(A[I_X] + (size_t)m * D) + F.lane; const GAS f32x4* xb = (const GAS f32x4*)(A[I_X] + (size_t)m2 * D) + F.lane; const f32x4* gr = (const f32x4*)A[I_NMG] + F.lane;
        f32x4 va[4], vb[4]; float sa = 0.f, sb = 0.f;
#pragma unroll
        for (int j = 0; j < 4; ++j) { va[j] = xa[64 * j]; vb[j] = xb[64 * j]; }
#pragma unroll
        for (int j = 0; j < 4; ++j) { sa += (va[j].x * va[j].x + va[j].y * va[j].y) + (va[j].z * va[j].z + va[j].w * va[j].w); sb += (vb[j].x * vb[j].x + vb[j].y * vb[j].y) + (vb[j].z * vb[j].z + vb[j].w * vb[j].w); }
        const float ra = __builtin_amdgcn_rsqf(wave_allsum(sa) * (1.f / D) + NORM_EPS), rb = __builtin_amdgcn_rsqf(wave_allsum(sb) * (1.f / D) + NORM_EPS);
        GAS unsigned long long* oa = (GAS unsigned long long*)((bf16*)(ws + WS_XN) + (size_t)m * D) + F.lane; GAS unsigned long long* ob = (GAS unsigned long long*)((bf16*)(ws + WS_XN) + (size_t)m2 * D) + F.lane;
#pragma unroll
        for (int j = 0; j < 4; ++j) { const f32x4 gg = gr[64 * j];
            oa[64 * j] = (unsigned long long)pk2(va[j].x * ra * gg.x, va[j].y * ra * gg.y) | ((unsigned long long)pk2(va[j].z * ra * gg.z, va[j].w * ra * gg.w) << 32);
            ob[64 * j] = (unsigned long long)pk2(vb[j].x * rb * gg.x, vb[j].y * rb * gg.y) | ((unsigned long long)pk2(vb[j].z * rb * gg.z, vb[j].w * rb * gg.w) << 32); }
    }
}

__device__ __forceinline__ void late_weights(Frame& F, const InTab& A, int part, int nparts, int cu0) {
    int lane_ = F.lane; asm volatile("" : "+v"(lane_));
    LAS float* scr = (LAS float*)(F.lds + RING_OFF + F.wave * 16384);
    unsigned char* ws = F.ws;
    constexpr int I_A = (512 / 64) * (D / 32), I_O = (D / 64) * (D / 32), I_1 = (D / 64) * (FF / 32), I_2 = (FF / 64) * (D / 32), NIT = 2 * I_A + I_O + I_1 + I_2;
    const int per = NIT / nparts, lo = part * per, hi = lo + per;
    const int gw = (F.bx - cu0) * NWAVES + F.wave, NGW = (F.G - cu0) * NWAVES;
    for (int it = lo + gw; it < hi; it += NGW) {
        int r = it;
        if (r < I_A) { p0_transpose_item<false>(A[I_WA], 512, D, (bf16*)(ws + WS_WA), scr, r, lane_, 1024, 0); continue; } r -= I_A;
        if (r < I_A) { p0_transpose_item<false>(A[I_WB], 512, D, (bf16*)(ws + WS_WA), scr, r, lane_, 1024, 512); continue; } r -= I_A;
        if (r < I_O) { p0_transpose_item<false>(A[I_WO], D, D, (bf16*)(ws + WS_WO), scr, r, lane_); continue; } r -= I_O;
        if (r < I_1) { p0_transpose_item<false>(A[I_FF1], D, FF, (bf16*)(ws + WS_W1), scr, r, lane_); continue; } r -= I_1;
        p0_transpose_item<false>(A[I_FF2], FF, D, (bf16*)(ws + WS_W2), scr, r, lane_);
    }
}
__device__ __forceinline__ void prep1_rows(Frame& F, const InTab& A, int g0, int g1, int w, int nw) {
    const int lane = F.lane;
    const bf16* WAG = (const bf16*)(F.ws + WS_WAG); bf16* LIN = (bf16*)(F.ws + WS_LIN);
    const f32x4 mu = *(const f32x4*)(A[I_MU] + 1536 + 4 * lane);
    const bool idl = (lane >= 16) && (lane < 32); const float ce = lane < 16 ? 2.8853900817779268f : -1.4426950408889634f, ca = lane < 16 ? 1.0f : 0.0f, cb = lane < 16 ? -2.0f : 1.0f;
    for (int g = g0 + w; g < g1; g += nw) {
        const int m0 = g * 8; v2u row[9];
        row[0] = (v2u){0u, 0u}; if ((m0 & (SEQ - 1)) != 0) row[0] = *(const GAS v2u*)(WAG + (size_t)(m0 - 1) * 256 + 4 * lane);
#pragma unroll
        for (int j = 0; j < 8; ++j) row[j + 1] = *(const GAS v2u*)(WAG + (size_t)(m0 + j) * 256 + 4 * lane);
#pragma unroll
        for (int j = 0; j < 8; ++j) {
            float z[4] = {bflo(row[j + 1].x), bfhi(row[j + 1].x), bflo(row[j + 1].y), bfhi(row[j + 1].y)}; const float p[4] = {bflo(row[j].x), bfhi(row[j].x), bflo(row[j].y), bfhi(row[j].y)};
#pragma unroll
            for (int e = 0; e < 4; ++e) { const float v = z[e] + (p[e] - z[e]) * mu[e];
                const float t = __builtin_amdgcn_rcpf(1.0f + __builtin_amdgcn_exp2f(ce * v));
                z[e] = idl ? v : ca + cb * t; }
            v2u o; { typedef float f2_ __attribute__((ext_vector_type(2))); typedef __bf16 b2_ __attribute__((ext_vector_type(2)));
                     const f2_ v01 = {z[0], z[1]}, v23 = {z[2], z[3]}; o.x = __builtin_bit_cast(unsigned, __builtin_convertvector(v01, b2_)); o.y = __builtin_bit_cast(unsigned, __builtin_convertvector(v23, b2_)); }
            *(GAS v2u*)(LIN + (size_t)(m0 + j) * 256 + 4 * lane) = o;
        }
    }
}
struct ScanRaw { unsigned short r[9], k[9], v[9], a[8]; float d[8]; };
__device__ __forceinline__ void scan_load(ScanRaw& R, const bf16* RKV, const float* DEC, const bf16* AA, size_t row0, int t0, int c) {
#pragma unroll
    for (int j = 0; j < 9; ++j) { int t = t0 - 1 + j; if (t < 0) t = 0; const bf16* p = RKV + (row0 + t) * 1536 + c;
        R.r[j] = *(const GAS bf16*)p; R.k[j] = *(const GAS bf16*)(p + 512); R.v[j] = *(const GAS bf16*)(p + 1024); }
#pragma unroll
    for (int j = 0; j < 8; ++j) { R.d[j] = *(const GAS float*)(DEC + (row0 + t0 + j) * 512 + c); R.a[j] = *(const GAS bf16*)(AA + (row0 + t0 + j) * 512 + c); }
}
__device__ __forceinline__ void scan_phase(Frame& F, const InTab& A, int si) {
    const int lane = F.lane, wave = F.wave, tid = F.tid;
    const int bh = si >> 1, half = si & 1, b = bh >> 3, h = bh & 7, c = h * 64 + lane;
    LAS float* IN = (LAS float*)(F.lds + RING_OFF);
    LAS float* VV = IN + 5 * 4096;
    LAS float* YBUF = VV + 2048;
    const bf16* RKV = (const bf16*)(F.ws + WS_RKV); const float* DEC = (const float*)(F.ws + WS_DEC); const bf16* AA = (const bf16*)(F.ws + WS_AA);
    bf16* Y = (bf16*)(F.ws + WS_Y); float* BON = (float*)(F.ws + WS_BON);
    const float mu_r = A[I_MU][c], mu_k = A[I_MU][512 + c], mu_v = A[I_MU][1024 + c], kkc = A[I_KK][c], kac = A[I_KA][c], rkc = A[I_RK][c];
    const size_t row0 = (size_t)b * SEQ;
    const int myv = (int)(red4(0.f, 1.f, 2.f, 3.f) * (1.0f / 64.0f) + 0.5f);
    const int L0 = __builtin_ctzll(__ballot(myv == 0)), L1 = __builtin_ctzll(__ballot(myv == 1)), L2 = __builtin_ctzll(__ballot(myv == 2)), L3 = __builtin_ctzll(__ballot(myv == 3));
    float S0 = 0.f, S1 = 0.f, S2 = 0.f, S3 = 0.f;
    ScanRaw R; scan_load(R, RKV, DEC, AA, row0, wave * 8, c);
    for (int blk = 0; blk < SEQ / 64; ++blk) {
        {
            const int t0 = blk * 64 + wave * 8;
            f32x4 qd[2], qa[2], qb[2], qk[2], qr[2], qv[2];
#pragma unroll
            for (int j = 0; j < 8; ++j) {
                const float pz = (t0 + j == 0) ? 0.f : 1.f;
                const float rt_ = bf1(R.r[j + 1]), kt_ = bf1(R.k[j + 1]), vt_ = bf1(R.v[j + 1]);
                const float rs = rt_ + (bf1(R.r[j]) * pz - rt_) * mu_r, ks = kt_ + (bf1(R.k[j]) * pz - kt_) * mu_k, vs = vt_ + (bf1(R.v[j]) * pz - vt_) * mu_v;
                const float kkr = ks * kkc, n2 = wave_allsum(kkr * kkr), kk = kkr / __builtin_fmaxf(sqrtf(n2), 1e-12f);
                const float a = 1.0f / (1.0f + __expf(-bf1(R.a[j]))), kx = ks * (1.0f + (a - 1.0f) * kac);
                const float bon = wave_allsum(rs * kx * rkc);
                if (half == 0 && lane == 0) BON[(row0 + t0 + j) * 8 + h] = bon;
                qd[j >> 2][j & 3] = __expf(-0.6065306597f / (1.0f + __expf(-R.d[j])));     qa[j >> 2][j & 3] = -kk; qb[j >> 2][j & 3] = kk * a; qk[j >> 2][j & 3] = kx; qr[j >> 2][j & 3] = rs; qv[j >> 2][j & 3] = vs;
            }
#pragma unroll
            for (int q = 0; q < 2; ++q) { const int t4 = wave * 2 + q; LAS f32x4* p = (LAS f32x4*)IN + t4 * 64 + lane;
                p[0 * 1024] = qd[q]; p[1 * 1024] = qa[q]; p[2 * 1024] = qb[q]; p[3 * 1024] = qk[q]; p[4 * 1024] = qr[q];
                if ((lane >> 5) == half) ((LAS f32x4*)VV)[t4 * 32 + (lane & 31)] = qv[q]; }
        }
        __syncthreads();
        if (blk + 1 < SEQ / 64) scan_load(R, RKV, DEC, AA, row0, (blk + 1) * 64 + wave * 8, c);
#pragma unroll 1
        for (int t4 = 0; t4 < 16; ++t4) {
            const LAS f32x4* p = (const LAS f32x4*)IN + t4 * 64 + lane;
            const f32x4 W4 = p[0], A4 = p[1024], B4 = p[2048], K4 = p[3072], R4 = p[4096];
            const LAS f32x4* pv = (const LAS f32x4*)VV + t4 * 32 + wave * 4;
            const f32x4 V0 = pv[0], V1 = pv[1], V2 = pv[2], V3 = pv[3];
            f32x4 yq;
#pragma unroll
            for (int ts = 0; ts < 4; ++ts) {
                const float w = W4[ts], a = A4[ts], bb = B4[ts], kx = K4[ts], r = R4[ts];
                const float t = red4(S0 * a, S1 * a, S2 * a, S3 * a);
                const float sa0 = __builtin_bit_cast(float, __builtin_amdgcn_readlane(__builtin_bit_cast(int, t), L0)), sa1 = __builtin_bit_cast(float, __builtin_amdgcn_readlane(__builtin_bit_cast(int, t), L1));
                const float sa2 = __builtin_bit_cast(float, __builtin_amdgcn_readlane(__builtin_bit_cast(int, t), L2)), sa3 = __builtin_bit_cast(float, __builtin_amdgcn_readlane(__builtin_bit_cast(int, t), L3));
                S0 = S0 * w + (sa0 * bb + V0[ts] * kx); S1 = S1 * w + (sa1 * bb + V1[ts] * kx); S2 = S2 * w + (sa2 * bb + V2[ts] * kx); S3 = S3 * w + (sa3 * bb + V3[ts] * kx);
                yq[ts] = red4(S0 * r, S1 * r, S2 * r, S3 * r);
            }
            if ((lane & 15) == 0) *(LAS f32x4*)(YBUF + (wave * 4 + myv) * 68 + t4 * 4) = yq;
        }
        __syncthreads();
        { const int t = tid >> 3, rg = tid & 7; const LAS float* yb = YBUF + (4 * rg) * 68 + t;
          v2u o; o.x = pk2(yb[0], yb[68]); o.y = pk2(yb[136], yb[204]);
          *(GAS v2u*)(Y + (row0 + blk * 64 + t) * 512 + h * 64 + 32 * half + 4 * rg) = o; }
    }
    __syncthreads();
}
__device__ __forceinline__ void post_ya(Frame& F, const InTab& A, int w, int nw) {
    int lane = F.lane; asm volatile("" : "+v"(lane));
    const bf16* O = (const bf16*)(F.ws + WS_O); bf16* YA = (bf16*)(F.ws + WS_YA);
    const float lam = __expf(wave_allsum(A[I_LQ1][lane] * A[I_LK1][lane])) - __expf(wave_allsum(A[I_LQ2][lane] * A[I_LK2][lane])) + LAMBDA_INIT;
    const int ca = 8 * lane, ha = lane >> 4, ea = ca & 127;
    float sg[8];
#pragma unroll
    for (int e = 0; e < 8; ++e) sg[e] = A[I_SUBG][ea + e] * (1.0f - LAMBDA_INIT);
#define UNPK8(w_) {bflo(w_.x), bfhi(w_.x), bflo(w_.y), bfhi(w_.y), bflo(w_.z), bfhi(w_.z), bflo(w_.w), bfhi(w_.w)}
    for (int g = w; g < M / 4; g += nw) {
        const int m0 = g * 4;
        v4u o0[4], o1[4];
#pragma unroll
        for (int j = 0; j < 4; ++j) { const size_t mm = (size_t)(m0 + j);
            o0[j] = *(const GAS v4u*)(O + mm * 1024 + (2 * ha) * 128 + ea); o1[j] = *(const GAS v4u*)(O + mm * 1024 + (2 * ha + 1) * 128 + ea); }
        asm volatile("s_waitcnt vmcnt(0)" ::: "memory");
#pragma unroll
        for (int j = 0; j < 4; ++j) { const size_t mm = (size_t)(m0 + j);
            const float a0[8] = UNPK8(o0[j]), a1[8] = UNPK8(o1[j]); float o[8], ss = 0.f;
#pragma unroll
            for (int e = 0; e < 8; ++e) { o[e] = a0[e] - lam * a1[e]; ss += o[e] * o[e]; }
            const float rstd = __builtin_amdgcn_rsqf(row16_allsum(ss) * (1.0f / 128.0f) + SUBLN_EPS);
            v4u wv; wv.x = pk2(o[0] * rstd * sg[0], o[1] * rstd * sg[1]); wv.y = pk2(o[2] * rstd * sg[2], o[3] * rstd * sg[3]); wv.z = pk2(o[4] * rstd * sg[4], o[5] * rstd * sg[5]); wv.w = pk2(o[6] * rstd * sg[6], o[7] * rstd * sg[7]);
            *(GAS v4u*)(YA + mm * 1024 + ca) = wv;
        }
    }
#undef UNPK8
}

typedef short rk_bf16x8 __attribute__((ext_vector_type(8)));
typedef float rk_f32x16 __attribute__((ext_vector_type(16)));
constexpr int RKA_RS_K = 144, RKA_RS_J = 80;
constexpr int RKA_A = 0, RKA_B = 5120, RKA_K = 10240, RKA_R = 15360, RKA_AT = 19968, RKA_BH = 25088, RKA_KH = 30208, RKA_VT = 35328, RKA_GC = 40448, RKA_BYTES = 40704;
constexpr int RKA_N = 0, RKA_X = 0, RKA_T = 5120, RKA_MAK = 7680, RKA_MRB = 10240, RKA_MRK = 12800;
constexpr int RKA_WAVES = 4;
static_assert(RKA_WAVES * RKA_BYTES <= 162816, "phase A LDS");
constexpr size_t WS_PQ0 = 66 * MiB, WS_PQ1 = 34 * MiB;
constexpr size_t WS_RY0 = 98 * MiB, WS_RY1 = 178 * MiB;
constexpr size_t WS_GC = 250 * MiB;
__device__ __forceinline__ unsigned char* rk_pq(unsigned char* ws, int half) { return ws + (half ? WS_PQ1 : WS_PQ0); }
__device__ __forceinline__ unsigned char* rk_ry(unsigned char* ws, int half) { return ws + (half ? WS_RY1 : WS_RY0); }
__device__ __forceinline__ unsigned char* rk_gc(unsigned char* ws, int half) { return ws + WS_GC + (size_t)half * (2048 * 256); }
constexpr size_t WS_SST = 251 * MiB;

__device__ __forceinline__ rk_bf16x8 rk_frag(const LAS unsigned char* base, int rs, int row, int s, int h) { return *(const LAS rk_bf16x8*)(base + row * rs + (16 * s + 8 * h) * 2); }
__device__ __forceinline__ rk_f32x16 rk_mfma(rk_bf16x8 a, rk_bf16x8 b, rk_f32x16 c) { return __builtin_amdgcn_mfma_f32_32x32x16_bf16(a, b, c, 0, 0, 0); }
__device__ __forceinline__ unsigned rk_pk(float lo, float hi) { typedef float f2_ __attribute__((ext_vector_type(2))); typedef __bf16 b2_ __attribute__((ext_vector_type(2))); f2_ v = {lo, hi}; b2_ b = __builtin_convertvector(v, b2_); return __builtin_bit_cast(unsigned, b); }
__device__ __forceinline__ void rk_store_tile_lds(LAS unsigned char* base, int rs, int nrow, int mbase, int h, const rk_f32x16& acc) {
#pragma unroll
    for (int g = 0; g < 4; ++g) { v2u w; w.x = rk_pk(acc[4 * g], acc[4 * g + 1]); w.y = rk_pk(acc[4 * g + 2], acc[4 * g + 3]); *(LAS v2u*)(base + nrow * rs + (mbase + 8 * g + 4 * h) * 2) = w; }
}
__device__ __forceinline__ void rk_store_tile_glb(bf16* base, int pitch, int nrow, int mbase, int h, const rk_f32x16& acc) {
#pragma unroll
    for (int g = 0; g < 4; ++g) { v2u w; w.x = rk_pk(acc[4 * g], acc[4 * g + 1]); w.y = rk_pk(acc[4 * g + 2], acc[4 * g + 3]); *(GAS v2u*)(base + (size_t)nrow * pitch + mbase + 8 * g + 4 * h) = w; }
}
__device__ __forceinline__ void rk_store_tile_frag(unsigned char* base, int nt, int r32, int mt, int h, const rk_f32x16& acc) {
#pragma unroll
    for (int g = 0; g < 4; ++g) { v2u w; w.x = rk_pk(acc[4 * g], acc[4 * g + 1]); w.y = rk_pk(acc[4 * g + 2], acc[4 * g + 3]);
        *(GAS v2u*)(base + ((size_t)((nt * 4 + 2 * mt + (g >> 1)) * 64 + r32 + 32 * (g & 1))) * 16 + 8 * h) = w; }
}
__device__ __forceinline__ void rk_store_blob(unsigned* blob, int lane, const rk_f32x16& acc) {
    v4u w0, w1; w0.x = rk_pk(acc[0], acc[1]); w0.y = rk_pk(acc[2], acc[3]); w0.z = rk_pk(acc[4], acc[5]); w0.w = rk_pk(acc[6], acc[7]);
    w1.x = rk_pk(acc[8], acc[9]); w1.y = rk_pk(acc[10], acc[11]); w1.z = rk_pk(acc[12], acc[13]); w1.w = rk_pk(acc[14], acc[15]);
    *(GAS v4u*)(blob + lane * 8) = w0; *(GAS v4u*)(blob + lane * 8 + 4) = w1;
}
struct RkBlob { v4u w0, w1; };
__device__ __forceinline__ RkBlob rk_load_blob(const unsigned* blob, int lane) { RkBlob b; b.w0 = *(const GAS v4u*)(blob + lane * 8); b.w1 = *(const GAS v4u*)(blob + lane * 8 + 4); return b; }
__device__ __forceinline__ rk_f32x16 rk_blob_f32(const RkBlob& b) {
    rk_f32x16 a; const unsigned w[8] = {b.w0.x, b.w0.y, b.w0.z, b.w0.w, b.w1.x, b.w1.y, b.w1.z, b.w1.w};
#pragma unroll
    for (int i = 0; i < 8; ++i) { a[2 * i] = bflo(w[i]); a[2 * i + 1] = bfhi(w[i]); }
    return a;
}

struct RkRaw { unsigned short r[8], k[8], v[8]; };
__device__ __forceinline__ void rk_load8(RkRaw& R, const bf16* prkv) {
#pragma unroll
    for (int j = 0; j < 8; ++j) { R.r[j] = *(const GAS bf16*)(prkv + j * 1536); R.k[j] = *(const GAS bf16*)(prkv + j * 1536 + 512); R.v[j] = *(const GAS bf16*)(prkv + j * 1536 + 1024); }
}
__device__ __forceinline__ void rwkvA_unit(LAS unsigned char* L, const InTab& A, unsigned char* ws, int bh, int chunk, int lane_in) {
    int lane = lane_in; asm volatile("" : "+v"(lane));
    const int b = bh >> 3, hd = bh & 7, cg = hd * 64 + lane, r32 = lane & 31, h = lane >> 5;
    const size_t row0 = (size_t)b * SEQ + (size_t)chunk * 32;
    const int uh = bh * 32 + (chunk & 31);
    const bf16* prkv = (const bf16*)(ws + WS_RKV) + row0 * 1536 + cg;
    float* pbon = (float*)(ws + WS_BON) + row0 * 8 + hd;
    const float mu_r = A[I_MU][cg], mu_k = A[I_MU][512 + cg], mu_v = A[I_MU][1024 + cg], kkc = A[I_KK][cg], kac = A[I_KA][cg], rkc = A[I_RK][cg], w0c = A[I_W0][cg], a0c = A[I_A0][cg];
    float dW[32], dA[32];
    {
        rk_f32x16 lw[2] = {{}, {}}, la[2] = {{}, {}};
        const bf16* lp = (const bf16*)(ws + WS_LIN) + (row0 + r32) * 256 + 8 * h;
        const bf16* wp = (const bf16*)(ws + WS_WL) + (size_t)(hd * 64 + r32) * 256 + 8 * h;
#pragma unroll
        for (int s2 = 0; s2 < 4; ++s2) { const rk_bf16x8 fw = __builtin_bit_cast(rk_bf16x8, *(const GAS v4u*)(lp + 16 * s2)), fa = __builtin_bit_cast(rk_bf16x8, *(const GAS v4u*)(lp + 64 + 16 * s2));
#pragma unroll
            for (int ct = 0; ct < 2; ++ct) { lw[ct] = rk_mfma(fw, __builtin_bit_cast(rk_bf16x8, *(const GAS v4u*)(wp + (size_t)ct * 32 * 256 + 16 * s2)), lw[ct]);
                la[ct] = rk_mfma(fa, __builtin_bit_cast(rk_bf16x8, *(const GAS v4u*)(wp + (size_t)(512 + ct * 32) * 256 + 64 + 16 * s2)), la[ct]); } }
#pragma unroll
        for (int i = 0; i < 16; ++i) { const int tb = (i & 3) + 8 * (i >> 2);
            { auto r = __builtin_amdgcn_permlane32_swap(f2u(lw[0][i]), f2u(lw[1][i]), false, false); const unsigned r0 = r[0], r1 = r[1]; dW[tb] = u2f(r0); dW[tb + 4] = u2f(r1); }
            { auto r = __builtin_amdgcn_permlane32_swap(f2u(la[0][i]), f2u(la[1][i]), false, false); const unsigned r0 = r[0], r1 = r[1]; dA[tb] = u2f(r0); dA[tb + 4] = u2f(r1); } }
    }
    const int myv = (int)(red4(0.f, 1.f, 2.f, 3.f) * (1.0f / 64.0f) + 0.5f);
    const int L0 = __builtin_ctzll(__ballot(myv == 0)), L1 = __builtin_ctzll(__ballot(myv == 1)), L2 = __builtin_ctzll(__ballot(myv == 2)), L3 = __builtin_ctzll(__ballot(myv == 3));
    float rp = 0.f, kp = 0.f, vp = 0.f;
    if (chunk != 0) { rp = bf1(*(const GAS bf16*)(prkv - 1536)); kp = bf1(*(const GAS bf16*)(prkv - 1536 + 512)); vp = bf1(*(const GAS bf16*)(prkv - 1536 + 1024)); }
    float G = 1.0f;
    RkRaw Rc, Rn; rk_load8(Rc, prkv);
#pragma unroll
    for (int q = 0; q < 4; ++q) {
        prkv += 8 * 1536;
        if (q < 3) rk_load8(Rn, prkv);
        LAS unsigned char* Lr = L + (8 * q) * RKA_RS_K + lane * 2;
        LAS unsigned char* Lt = L + lane * RKA_RS_J + (8 * q) * 2;
        unsigned tA[4], tB[4], tK[4], tV[4], pA = 0, pB = 0, pK = 0, pV = 0;
        float rs_[8], kx_[8], kkr_[8], a8_[8], w8_[8], vs_[8];
#pragma unroll
        for (int j = 0; j < 8; ++j) {
            const float rc = bf1(Rc.r[j]), kc = bf1(Rc.k[j]), vc = bf1(Rc.v[j]);
            const float ks = kc + (kp - kc) * mu_k; rs_[j] = rc + (rp - rc) * mu_r; vs_[j] = vc + (vp - vc) * mu_v; rp = rc; kp = kc; vp = vc;
            kkr_[j] = ks * kkc; a8_[j] = __builtin_amdgcn_rcpf(1.0f + __expf(-(a0c + dA[8 * q + j]))); kx_[j] = ks * (1.0f + (a8_[j] - 1.0f) * kac);
            w8_[j] = __expf(-0.6065306597f * __builtin_amdgcn_rcpf(1.0f + __expf(-(w0c + dW[8 * q + j]))));
        }
        float n2_[8], bon_[8];
#pragma unroll
        for (int j = 0; j < 8; j += 2) {
            const float t = red4(kkr_[j] * kkr_[j], kkr_[j + 1] * kkr_[j + 1], rs_[j] * kx_[j] * rkc, rs_[j + 1] * kx_[j + 1] * rkc);
            n2_[j] = __builtin_bit_cast(float, __builtin_amdgcn_readlane(__builtin_bit_cast(int, t), L0)); n2_[j + 1] = __builtin_bit_cast(float, __builtin_amdgcn_readlane(__builtin_bit_cast(int, t), L1));
            bon_[j] = __builtin_bit_cast(float, __builtin_amdgcn_readlane(__builtin_bit_cast(int, t), L2)); bon_[j + 1] = __builtin_bit_cast(float, __builtin_amdgcn_readlane(__builtin_bit_cast(int, t), L3));
        }
        if (lane < 8) { float bv = bon_[0];
#pragma unroll
            for (int j = 1; j < 8; ++j) bv = (lane == j) ? bon_[j] : bv;
            *(GAS float*)(pbon + (8 * q + lane) * 8) = bv; }
        unsigned tR[4];
#pragma unroll
        for (int j = 0; j < 8; j += 2) {
            const float kk0 = kkr_[j] * __builtin_amdgcn_rsqf(__builtin_fmaxf(n2_[j], 1e-24f)), kk1 = kkr_[j + 1] * __builtin_amdgcn_rsqf(__builtin_fmaxf(n2_[j + 1], 1e-24f));
            const float G0 = G; const float G1 = G0 * w8_[j]; G = G1 * w8_[j + 1]; const float i1 = __builtin_amdgcn_rcpf(G1), i2 = __builtin_amdgcn_rcpf(G);
            tA[j >> 1] = rk_pk(-kk0 * G0, -kk1 * G1); tR[j >> 1] = rk_pk(rs_[j] * G1, rs_[j + 1] * G); tB[j >> 1] = rk_pk(kk0 * a8_[j] * i1, kk1 * a8_[j + 1] * i2); tK[j >> 1] = rk_pk(kx_[j] * i1, kx_[j + 1] * i2); tV[j >> 1] = rk_pk(vs_[j], vs_[j + 1]);
            *(LAS bf16*)(Lr + RKA_A + j * RKA_RS_K) = (bf16)(tA[j >> 1] & 0xffffu); *(LAS bf16*)(Lr + RKA_A + (j + 1) * RKA_RS_K) = (bf16)(tA[j >> 1] >> 16);
            *(LAS bf16*)(Lr + RKA_R + j * RKA_RS_K) = (bf16)(tR[j >> 1] & 0xffffu); *(LAS bf16*)(Lr + RKA_R + (j + 1) * RKA_RS_K) = (bf16)(tR[j >> 1] >> 16);
            *(LAS bf16*)(Lr + RKA_B + j * RKA_RS_K) = (bf16)(tB[j >> 1] & 0xffffu); *(LAS bf16*)(Lr + RKA_B + (j + 1) * RKA_RS_K) = (bf16)(tB[j >> 1] >> 16);
            *(LAS bf16*)(Lr + RKA_K + j * RKA_RS_K) = (bf16)(tK[j >> 1] & 0xffffu); *(LAS bf16*)(Lr + RKA_K + (j + 1) * RKA_RS_K) = (bf16)(tK[j >> 1] >> 16);
        }
        (void)pA; (void)pB; (void)pK; (void)pV;
        *(LAS v4u*)(Lt + RKA_AT) = (v4u){tA[0], tA[1], tA[2], tA[3]}; *(LAS v4u*)(Lt + RKA_BH) = (v4u){tB[0], tB[1], tB[2], tB[3]}; *(LAS v4u*)(Lt + RKA_KH) = (v4u){tK[0], tK[1], tK[2], tK[3]}; *(LAS v4u*)(Lt + RKA_VT) = (v4u){tV[0], tV[1], tV[2], tV[3]};
        Rc = Rn;
    }
    const float GC = G;
    *(GAS float*)((float*)rk_gc(ws, chunk >> 5) + (size_t)uh * 64 + lane) = GC;
    *(LAS float*)(L + RKA_GC + lane * 4) = GC;
    LDS_WAIT(); asm volatile("" ::: "memory");
    {
        rk_f32x16 aN = {}, aAK = {}, aRB = {}, aRK = {};
#pragma unroll
        for (int s = 0; s < 4; ++s) {
            const rk_bf16x8 fA = rk_frag(L + RKA_A, RKA_RS_K, r32, s, h), fR = rk_frag(L + RKA_R, RKA_RS_K, r32, s, h), fB = rk_frag(L + RKA_B, RKA_RS_K, r32, s, h), fK = rk_frag(L + RKA_K, RKA_RS_K, r32, s, h);
            aN = rk_mfma(fB, fA, aN); aAK = rk_mfma(fK, fA, aAK); aRB = rk_mfma(fB, fR, aRB); aRK = rk_mfma(fK, fR, aRK);
        }
        LDS_WAIT(); asm volatile("" ::: "memory");
#pragma unroll
        for (int i = 0; i < 16; ++i) { const int j = (i & 3) + 8 * (i >> 2) + 4 * h;
            if (!(j < r32)) { aN[i] = 0.f; aAK[i] = 0.f; }
            if (!(j <= r32)) { aRB[i] = 0.f; aRK[i] = 0.f; } }
#pragma unroll
        for (int g = 0; g < 4; ++g) *(LAS f32x4*)(L + RKA_N + r32 * 144 + (8 * g + 4 * h) * 4) = (f32x4){aN[4 * g], aN[4 * g + 1], aN[4 * g + 2], aN[4 * g + 3]};
        rk_store_tile_lds(L + RKA_MAK, RKA_RS_J, r32, 0, h, aAK); rk_store_tile_lds(L + RKA_MRB, RKA_RS_J, r32, 0, h, aRB); rk_store_tile_lds(L + RKA_MRK, RKA_RS_J, r32, 0, h, aRK);
        rk_store_tile_lds(L + RKA_T, RKA_RS_J, r32, 0, h, aN);
    }
    LDS_WAIT(); asm volatile("" ::: "memory");
    {
        const int blk = (r32 >> 4) & 1, cc = r32 & 15;
        const LAS unsigned char* Nb = L + RKA_N + (16 * blk) * 144 + (16 * blk) * 4;
        float T[16];
#pragma unroll
        for (int t = 0; t < 16; ++t) { float ac[4] = {(cc == t) ? 1.0f : 0.0f, 0.f, 0.f, 0.f};
#pragma unroll
            for (int j4 = 0; j4 < (t + 3) / 4; ++j4) { const f32x4 n4 = *(const LAS f32x4*)(Nb + t * 144 + j4 * 16);
#pragma unroll
                for (int e = 0; e < 4; ++e) if (4 * j4 + e < t) ac[e] += n4[e] * T[4 * j4 + e]; }
            T[t] = (ac[0] + ac[1]) + (ac[2] + ac[3]); }
        LDS_WAIT(); asm volatile("" ::: "memory");
#pragma unroll
        for (int t = 0; t < 16; ++t) *(LAS bf16*)(L + RKA_T + (16 * blk + t) * RKA_RS_J + r32 * 2) = (bf16)f2bf(T[t]);
        if (blk == 0) { LAS v4u* p = (LAS v4u*)(L + RKA_N + cc * RKA_RS_J);
            p[0] = (v4u){pk2(T[0], T[1]), pk2(T[2], T[3]), pk2(T[4], T[5]), pk2(T[6], T[7])}; p[1] = (v4u){pk2(T[8], T[9]), pk2(T[10], T[11]), pk2(T[12], T[13]), pk2(T[14], T[15])}; }
        LDS_WAIT(); asm volatile("" ::: "memory");
        rk_f32x16 xa = {};
        xa = rk_mfma(*(const LAS rk_bf16x8*)(L + RKA_T + (16 + r32) * RKA_RS_J + 16 * h), *(const LAS rk_bf16x8*)(L + RKA_N + r32 * RKA_RS_J + 16 * h), xa);
        if (r32 < 16) {
#pragma unroll
            for (int g = 0; g < 2; ++g) { v2u w; w.x = rk_pk(xa[4 * g], xa[4 * g + 1]); w.y = rk_pk(xa[4 * g + 2], xa[4 * g + 3]); *(LAS v2u*)(L + RKA_N + 1280 + r32 * RKA_RS_J + (8 * g + 4 * h) * 2) = w; } }
        LDS_WAIT(); asm volatile("" ::: "memory");
        rk_f32x16 ta = {};
        ta = rk_mfma(*(const LAS rk_bf16x8*)(L + RKA_N + 1280 + r32 * RKA_RS_J + 16 * h), *(const LAS rk_bf16x8*)(L + RKA_T + (16 + r32) * RKA_RS_J + (16 + 8 * h) * 2), ta);
        LDS_WAIT(); asm volatile("" ::: "memory");
        if (r32 < 16) {
#pragma unroll
            for (int g = 0; g < 2; ++g) { v2u w; w.x = rk_pk(ta[4 * g], ta[4 * g + 1]); w.y = rk_pk(ta[4 * g + 2], ta[4 * g + 3]); *(LAS v2u*)(L + RKA_T + (16 + r32) * RKA_RS_J + (8 * g + 4 * h) * 2) = w; } }
    }
    LDS_WAIT(); asm volatile("" ::: "memory");
    rk_bf16x8 fT[2];
#pragma unroll
    for (int s = 0; s < 2; ++s) fT[s] = rk_frag(L + RKA_T, RKA_RS_J, r32, s, h);
    {
        rk_f32x16 x0[2] = {{}, {}}, ap[2] = {{}, {}};
#pragma unroll
        for (int s = 0; s < 2; ++s) { const rk_bf16x8 fM = rk_frag(L + RKA_MAK, RKA_RS_J, r32, s, h);
#pragma unroll
            for (int nt = 0; nt < 2; ++nt) { x0[nt] = rk_mfma(fM, rk_frag(L + RKA_VT, RKA_RS_J, nt * 32 + r32, s, h), x0[nt]); ap[nt] = rk_mfma(fT[s], rk_frag(L + RKA_AT, RKA_RS_J, nt * 32 + r32, s, h), ap[nt]); } }
        LDS_WAIT(); asm volatile("" ::: "memory");
#pragma unroll
        for (int nt = 0; nt < 2; ++nt) { rk_store_tile_lds(L + RKA_X, RKA_RS_J, nt * 32 + r32, 0, h, x0[nt]); rk_store_tile_lds(L + RKA_AT, RKA_RS_J, nt * 32 + r32, 0, h, ap[nt]); }
    }
    LDS_WAIT(); asm volatile("" ::: "memory");
    {
        rk_f32x16 u0[2] = {{}, {}};
#pragma unroll
        for (int s = 0; s < 2; ++s)
#pragma unroll
            for (int nt = 0; nt < 2; ++nt) u0[nt] = rk_mfma(fT[s], rk_frag(L + RKA_X, RKA_RS_J, nt * 32 + r32, s, h), u0[nt]);
        LDS_WAIT(); asm volatile("" ::: "memory");
#pragma unroll
        for (int nt = 0; nt < 2; ++nt) rk_store_tile_lds(L + RKA_X, RKA_RS_J, nt * 32 + r32, 0, h, u0[nt]);
    }
    LDS_WAIT(); asm volatile("" ::: "memory");
    unsigned char* pq = rk_pq(ws, chunk >> 5) + (size_t)uh * 16384; unsigned char* ry = rk_ry(ws, chunk >> 5) + (size_t)uh * 8192;
    rk_bf16x8 fRB[2], fRK[2], fAp[2][2], fBh[2][2], fKh[2][2], fU[2][2], fV[2][2];
#pragma unroll
    for (int s = 0; s < 2; ++s) { fRB[s] = rk_frag(L + RKA_MRB, RKA_RS_J, r32, s, h); fRK[s] = rk_frag(L + RKA_MRK, RKA_RS_J, r32, s, h);
#pragma unroll
        for (int nt = 0; nt < 2; ++nt) { fAp[nt][s] = rk_frag(L + RKA_AT, RKA_RS_J, nt * 32 + r32, s, h); fBh[nt][s] = rk_frag(L + RKA_BH, RKA_RS_J, nt * 32 + r32, s, h);
            fKh[nt][s] = rk_frag(L + RKA_KH, RKA_RS_J, nt * 32 + r32, s, h); fU[nt][s] = rk_frag(L + RKA_X, RKA_RS_J, nt * 32 + r32, s, h); fV[nt][s] = rk_frag(L + RKA_VT, RKA_RS_J, nt * 32 + r32, s, h); } }
#pragma unroll
    for (int kt = 0; kt < 2; ++kt) {
        rk_f32x16 acc;
#pragma unroll
        for (int g = 0; g < 4; ++g) { const v2u w = *(const LAS v2u*)(L + RKA_R + r32 * RKA_RS_K + (kt * 32 + 8 * g + 4 * h) * 2); acc[4 * g] = bflo(w.x); acc[4 * g + 1] = bfhi(w.x); acc[4 * g + 2] = bflo(w.y); acc[4 * g + 3] = bfhi(w.y); }
#pragma unroll
        for (int s = 0; s < 2; ++s) acc = rk_mfma(fAp[kt][s], fRB[s], acc);
        rk_store_tile_frag(ry, 0, r32, kt, h, acc);
    }
#pragma unroll
    for (int kt = 0; kt < 2; ++kt)
#pragma unroll
        for (int kq = 0; kq < 2; ++kq) { rk_f32x16 acc = {};
#pragma unroll
            for (int s = 0; s < 2; ++s) acc = rk_mfma(fAp[kq][s], fBh[kt][s], acc);
            acc = acc * *(const LAS float*)(L + RKA_GC + (kt * 32 + r32) * 4);
            rk_store_tile_frag(pq, kt, r32, kq, h, acc); }
#pragma unroll
    for (int vt = 0; vt < 2; ++vt) {
        rk_f32x16 acc = {};
#pragma unroll
        for (int s = 0; s < 2; ++s) { acc = rk_mfma(fU[vt][s], fRB[s], acc); acc = rk_mfma(fV[vt][s], fRK[s], acc); }
        rk_store_blob((unsigned*)(ry + 4096) + vt * 512, lane, acc);
    }
#pragma unroll
    for (int kt = 0; kt < 2; ++kt)
#pragma unroll
        for (int vt = 0; vt < 2; ++vt) { rk_f32x16 acc = {};
#pragma unroll
            for (int s = 0; s < 2; ++s) { acc = rk_mfma(fBh[kt][s], fU[vt][s], acc); acc = rk_mfma(fKh[kt][s], fV[vt][s], acc); }
#pragma unroll
            for (int g = 0; g < 4; ++g) { const f32x4 gq = *(const LAS f32x4*)(L + RKA_GC + (kt * 32 + 8 * g + 4 * h) * 4); acc[4 * g] *= gq[0]; acc[4 * g + 1] *= gq[1]; acc[4 * g + 2] *= gq[2]; acc[4 * g + 3] *= gq[3]; }
            rk_store_blob((unsigned*)(pq + 8192) + (kt * 2 + vt) * 512, lane, acc); }
    LDS_WAIT(); asm volatile("" ::: "memory");
}
__device__ __forceinline__ void rwkvA_phase(Frame& F, const InTab& A, int half) {
    if (F.wave >= RKA_WAVES) { if (half == 0) post_ya(F, A, F.bx * (NWAVES - RKA_WAVES) + (F.wave - RKA_WAVES), F.G * (NWAVES - RKA_WAVES)); return; }
    LAS unsigned char* L = F.lds + RING_OFF + F.wave * RKA_BYTES;
    const int gw = F.bx * RKA_WAVES + F.wave, NGW = F.G * RKA_WAVES;
    for (int u = gw; u < 64 * 32; u += NGW) rwkvA_unit(L, A, F.ws, u >> 5, half * 32 + (u & 31), F.lane);
}
__device__ __forceinline__ void rwkvA_queue(Frame& F, const InTab& A, int half, unsigned* counter) {
    if (F.wave >= RKA_WAVES) return;
    LAS unsigned char* L = F.lds + RING_OFF + F.wave * RKA_BYTES;
    for (;;) {
        unsigned u = 0; if (F.lane == 0) u = __hip_atomic_fetch_add(counter, 1u, __ATOMIC_RELAXED, __HIP_MEMORY_SCOPE_AGENT);
        u = __builtin_amdgcn_readfirstlane(u);
        if (u >= 64u * 32u) break;
        rwkvA_unit(L, A, F.ws, (int)(u >> 5), half * 32 + (int)(u & 31), F.lane);
    }
}
constexpr int RKB_RS = 144, RKB_SBUF = 64 * RKB_RS;
constexpr int RKB_YOFF = 2 * RKB_SBUF + 8192, RKB_YRS = 68, RKB_YBYTES = 32 * RKB_YRS * 4;
__device__ __forceinline__ void rwkvB_phase(Frame& F, const InTab& A, int bh, int half) {
    int lane = F.lane; asm volatile("" : "+v"(lane));
    const int wave = F.wave, r32 = lane & 31, h = lane >> 5;
    LAS unsigned char* SB = F.lds + RING_OFF;
    unsigned char* ws = F.ws;
    const int b = bh >> 3, hd = bh & 7;
    const int kt = (wave >> 1) & 1, vt = wave & 1;
    float* sst = (float*)(ws + WS_SST) + (size_t)bh * 4096 + (size_t)(wave & 3) * 1024;
    rk_f32x16 st = {};
    if (wave < 4) {
        if (half != 0) {
#pragma unroll
            for (int i = 0; i < 16; ++i) st[i] = *(const GAS float*)(sst + i * 64 + lane);
        }
        rk_store_tile_lds(SB, RKB_RS, vt * 32 + r32, kt * 32, h, st);
    }
    const int uh0 = bh * 32; const bool isS = wave < 4, isY = !isS && wave < 6;
    const unsigned char* fptr = isS ? rk_pq(ws, half) + (size_t)uh0 * 16384 + (kt * 256 + lane) * 16 : rk_ry(ws, half) + (size_t)uh0 * 8192 + lane * 16;
    const unsigned char* bptr = isS ? rk_pq(ws, half) + (size_t)uh0 * 16384 + 8192 + (kt * 2 + vt) * 2048 + lane * 32 : rk_ry(ws, half) + (size_t)uh0 * 8192 + 4096 + vt * 2048 + lane * 32;
    const LAS unsigned char* gl = SB + 2 * RKB_SBUF + (kt * 32 + 4 * h) * 4;
    const int fstride = isS ? 16384 : 8192;
    struct Op { v4u f[4]; v4u b0, b1; };
    { const int tid_ = wave * 64 + lane; *(LAS f32x4*)(SB + 2 * RKB_SBUF + tid_ * 16) = *(const GAS f32x4*)(rk_gc(ws, half) + (size_t)uh0 * 256 + tid_ * 16); }
    { const int tid_ = wave * 64 + lane; if (tid_ < 192) { const int e_ = tid_ & 63; const float* src_ = tid_ < 64 ? A[I_LNG] + hd * 64 : (tid_ < 128 ? A[I_LNB] + hd * 64 : A[I_MU] + 1024 + hd * 64);
        ((LAS float*)(SB + RKB_YOFF + 2 * RKB_YBYTES))[tid_] = src_[e_]; } }
    Op o0, o1, o2;
#define RKB_LOAD(O_, c) do { const unsigned char* fp_ = fptr + (size_t)(c) * fstride; const unsigned char* bp_ = bptr + (size_t)(c) * fstride; \
        _Pragma("unroll") for (int s = 0; s < 4; ++s) O_.f[s] = *(const GAS v4u*)(fp_ + 1024 * s); \
        O_.b0 = *(const GAS v4u*)bp_; O_.b1 = *(const GAS v4u*)(bp_ + 16); } while (0)
#define RKB_BAR() do { asm volatile("s_waitcnt lgkmcnt(0)" ::: "memory"); __builtin_amdgcn_s_barrier(); asm volatile("" ::: "memory"); } while (0)
#define RKB_NEXT(O_, c, AH_) RKB_LOAD(O_, ((c) + (AH_) < 32 ? (c) + (AH_) : 31))
#define RKB_STEP_S(O_, c) do { \
        const LAS unsigned char* cur = SB + ((c) & 1) * RKB_SBUF; LAS unsigned char* nxt = SB + (((c) & 1) ^ 1) * RKB_SBUF; \
        rk_bf16x8 fS[4]; _Pragma("unroll") for (int s = 0; s < 4; ++s) fS[s] = rk_frag(cur, RKB_RS, vt * 32 + r32, s, h); \
        RkBlob bb_; bb_.w0 = O_.b0; bb_.w1 = O_.b1; const rk_f32x16 q = rk_blob_f32(bb_); \
        _Pragma("unroll") for (int g = 0; g < 4; ++g) { const f32x4 gq = *(const LAS f32x4*)(gl + (c) * 256 + 32 * g); \
            st[4 * g] = st[4 * g] * gq[0] + q[4 * g]; st[4 * g + 1] = st[4 * g + 1] * gq[1] + q[4 * g + 1]; st[4 * g + 2] = st[4 * g + 2] * gq[2] + q[4 * g + 2]; st[4 * g + 3] = st[4 * g + 3] * gq[3] + q[4 * g + 3]; } \
        _Pragma("unroll") for (int s = 0; s < 4; ++s) st = rk_mfma(__builtin_bit_cast(rk_bf16x8, O_.f[s]), fS[s], st); \
        RKB_NEXT(O_, c, 5); \
        rk_store_tile_lds(nxt, RKB_RS, vt * 32 + r32, kt * 32, h, st); \
        RKB_BAR(); } while (0)
#define RKB_Y_BODY(O_, c) do { \
        const LAS unsigned char* cur = SB + ((c) & 1) * RKB_SBUF; \
        rk_bf16x8 fS[4]; _Pragma("unroll") for (int s = 0; s < 4; ++s) fS[s] = rk_frag(cur, RKB_RS, vt * 32 + r32, s, h); \
        RkBlob bb_; bb_.w0 = O_.b0; bb_.w1 = O_.b1; rk_f32x16 acc = rk_blob_f32(bb_); \
        _Pragma("unroll") for (int s = 0; s < 4; ++s) acc = rk_mfma(fS[s], __builtin_bit_cast(rk_bf16x8, O_.f[s]), acc);       \
        RKB_NEXT(O_, c, 3); \
        { LAS float* yb_ = (LAS float*)(SB + RKB_YOFF + ((c) & 1) * RKB_YBYTES) + r32 * RKB_YRS + 32 * vt + 4 * h;        \
          _Pragma("unroll") for (int g = 0; g < 4; ++g) *(LAS f32x4*)(yb_ + 8 * g) = (f32x4){acc[4 * g], acc[4 * g + 1], acc[4 * g + 2], acc[4 * g + 3]}; } \
        } while (0)
    __syncthreads();
    if (isS) {
        Op o3, o4; RKB_LOAD(o0, 0); RKB_LOAD(o1, 1); RKB_LOAD(o2, 2); RKB_LOAD(o3, 3); RKB_LOAD(o4, 4);
#define R5S(c) RKB_STEP_S(o0, c); RKB_STEP_S(o1, (c) + 1); RKB_STEP_S(o2, (c) + 2); RKB_STEP_S(o3, (c) + 3); RKB_STEP_S(o4, (c) + 4);
        R5S(0) R5S(5) R5S(10) R5S(15) R5S(20) R5S(25)
        RKB_STEP_S(o0, 30); RKB_STEP_S(o1, 31);
#undef R5S
    } else {
        const int tl = 8 * (wave - 4) + (lane >> 3), q8 = lane & 7, ch = hd * 64 + 8 * q8;
        float lg[8], lb[8], muv[8];
        { const LAS float* ctab = (const LAS float*)(SB + RKB_YOFF + 2 * RKB_YBYTES) + 8 * q8;
#pragma unroll
          for (int j = 0; j < 2; ++j) { const f32x4 a_ = *(const LAS f32x4*)(ctab + 4 * j), b_ = *(const LAS f32x4*)(ctab + 64 + 4 * j), c_ = *(const LAS f32x4*)(ctab + 128 + 4 * j);
#pragma unroll
            for (int i = 0; i < 4; ++i) { lg[4 * j + i] = a_[i]; lb[4 * j + i] = b_[i]; muv[4 * j + i] = c_[i]; } } }
        const GAS unsigned char* RKVp = (const GAS unsigned char*)(ws + WS_RKV) + 2048; const GAS unsigned char* GGp = (const GAS unsigned char*)(ws + WS_GG); const GAS unsigned char* BONp = (const GAS unsigned char*)(ws + WS_BON); GAS unsigned char* YAp = (GAS unsigned char*)(ws + WS_YA) + 1024;
        const unsigned mlane = (unsigned)(b * SEQ + half * 1024 + tl);
        const unsigned og = (mlane * 512u + (unsigned)ch) * 2u, ov = (mlane * 1536u + (unsigned)ch) * 2u, ob = (mlane * 8u + (unsigned)hd) * 4u, oy = (mlane * 1024u + (unsigned)ch) * 2u;
        struct Pp { v4u g, v, p; float bon; };
#define RKB_PLOAD(P_, c) do { \
        P_.g = *(const GAS v4u*)(GGp + (size_t)(c) * 32768 + og); P_.v = *(const GAS v4u*)(RKVp + (size_t)(c) * 98304 + ov); P_.p = *(const GAS v4u*)(RKVp + ((long)(c) * 98304 - 3072) + ov); \
        P_.bon = *(const GAS float*)(BONp + (size_t)(c) * 1024 + ob); } while (0)
#define RKB_UNPK8(w_) {bflo(w_.x), bfhi(w_.x), bflo(w_.y), bfhi(w_.y), bflo(w_.z), bfhi(w_.z), bflo(w_.w), bfhi(w_.w)}
#define RKB_POST(P_, c) do { asm volatile("" : "+v"(P_.g), "+v"(P_.v), "+v"(P_.p));        \
        const LAS float* yb_ = (const LAS float*)(SB + RKB_YOFF + ((c) & 1) * RKB_YBYTES) + tl * RKB_YRS + 8 * q8; \
        const f32x4 ya_ = *(const LAS f32x4*)yb_, yc_ = *(const LAS f32x4*)(yb_ + 4); const float y[8] = {ya_[0], ya_[1], ya_[2], ya_[3], yc_[0], yc_[1], yc_[2], yc_[3]}; \
        const float mean = oct_allsum(((y[0] + y[1]) + (y[2] + y[3])) + ((y[4] + y[5]) + (y[6] + y[7]))) * (1.0f / 64.0f); \
        float q_ = 0.f; _Pragma("unroll") for (int e = 0; e < 8; ++e) { const float d_ = y[e] - mean; q_ += d_ * d_; } \
        const float rstd = __builtin_amdgcn_rsqf(oct_allsum(q_) * (1.0f / 64.0f) + GN_EPS); \
        const bool first_ = (((mlane + 32u * (unsigned)(c)) & (unsigned)(SEQ - 1)) == 0u);        \
        const float ga[8] = RKB_UNPK8(P_.g), va[8] = RKB_UNPK8(P_.v), pa[8] = RKB_UNPK8(P_.p); float r[8]; \
        _Pragma("unroll") for (int e = 0; e < 8; ++e) { const float pe_ = first_ ? 0.f : pa[e]; const float vs_ = va[e] + (pe_ - va[e]) * muv[e]; r[e] = (((y[e] - mean) * rstd) * lg[e] + lb[e] + P_.bon * vs_) * ga[e]; } \
        v4u w0; w0.x = rk_pk(r[0], r[1]); w0.y = rk_pk(r[2], r[3]); w0.z = rk_pk(r[4], r[5]); w0.w = rk_pk(r[6], r[7]); \
        *(GAS v4u*)(YAp + (size_t)(c) * 65536 + oy) = w0; \
        RKB_PLOAD(P_, ((c) + 3 < 32 ? (c) + 3 : 31)); } while (0)
        Pp p0, p1, p2; RKB_PLOAD(p0, 0); RKB_PLOAD(p1, 1); RKB_PLOAD(p2, 2);
        if (isY) {
            RKB_LOAD(o0, 0); RKB_LOAD(o1, 1); RKB_LOAD(o2, 2);
            RKB_Y_BODY(o0, 0); RKB_BAR();
#define R3YP(c) RKB_Y_BODY(o1, c); RKB_POST(p0, (c) - 1); RKB_BAR(); RKB_Y_BODY(o2, (c) + 1); RKB_POST(p1, c); RKB_BAR(); RKB_Y_BODY(o0, (c) + 2); RKB_POST(p2, (c) + 1); RKB_BAR();
            R3YP(1) R3YP(4) R3YP(7) R3YP(10) R3YP(13) R3YP(16) R3YP(19) R3YP(22) R3YP(25) R3YP(28)
            RKB_Y_BODY(o1, 31); RKB_POST(p0, 30); RKB_BAR();
            RKB_POST(p1, 31);
#undef R3YP
        } else {
            RKB_BAR();
#define R3P(c) RKB_POST(p0, (c) - 1); RKB_BAR(); RKB_POST(p1, c); RKB_BAR(); RKB_POST(p2, (c) + 1); RKB_BAR();
            R3P(1) R3P(4) R3P(7) R3P(10) R3P(13) R3P(16) R3P(19) R3P(22) R3P(25) R3P(28)
            RKB_POST(p0, 30); RKB_BAR();
            RKB_POST(p1, 31);
#undef R3P
        }
#undef RKB_POST
#undef RKB_UNPK8
#undef RKB_PLOAD
    }
#undef RKB_STEP_S
#undef RKB_Y_BODY
#undef RKB_NEXT
#undef RKB_BAR
#undef RKB_LOAD
    if (wave < 4 && half == 0) {
#pragma unroll
        for (int i = 0; i < 16; ++i) *(GAS float*)(sst + i * 64 + lane) = st[i];
    }
}

constexpr int NPHASE = 9;
template <int PHM> __global__ void __launch_bounds__(NWAVES * 64, 2) fwd_kernel(Args args) {
    extern __shared__ __attribute__((aligned(16))) unsigned char lds[];
    namespace cg = cooperative_groups;
    Frame F;
    F.lds = (LAS unsigned char*)lds;
    F.tid = threadIdx.x; F.lane = F.tid & 63; F.wave = __builtin_amdgcn_readfirstlane(F.tid >> 6);
    F.G = gridDim.x; F.bx = blockIdx.x;
    F.out = args.out; F.ws = args.ws;
#define PH_BEGIN InTab TAB; { ktab_t kp_ = (ktab_t)__builtin_amdgcn_kernarg_segment_ptr(); asm volatile("" : "+s"(kp_)); TAB.p = kp_; } { int t_ = threadIdx.x; asm volatile("" : "+v"(t_)); F.tid = t_; F.lane = t_ & 63; F.wave = __builtin_amdgcn_readfirstlane(t_ >> 6); } GAS unsigned char* wsg_ = (GAS unsigned char*)args.ws; asm volatile("" : "+s"(wsg_)); unsigned char* ws = (unsigned char*)wsg_; F.ws = ws; GAS bf16_t* gtg_ = (GAS bf16_t*)args.out; asm volatile("" : "+s"(gtg_)); bf16_t* GATES = (bf16_t*)gtg_; F.out = (float*)GATES; (void)GATES;
    const int lo = args.ph_lo, hi = args.ph_hi;
    XcdBarrier bar; bar.bar = nullptr; bar.x = 0; bar.st = nullptr;
    if (hi - lo > 1) {
        for (int u = threadIdx.x; u < (LDS_BYTES - 162816) / 4; u += NWAVES * 64) ((LAS unsigned*)(F.lds + 162816))[u] = 0u;
        { GAS v4u* z_ = (GAS v4u*)(args.ws + WS_CTL) + (size_t)blockIdx.x * (CTL_ZERO_BYTES / 16 / 256); for (int u = threadIdx.x; u < (int)(CTL_ZERO_BYTES / 16 / 256); u += NWAVES * 64) z_[u] = (v4u){0u, 0u, 0u, 0u}; }
        asm volatile("s_waitcnt vmcnt(0)" ::: "memory");
        __syncthreads();
        cg::this_grid().sync();
        bar = xcd_barrier_post((unsigned*)(args.ws + WS_CTL) + CW_BAR, (volatile LAS unsigned*)(F.lds + MISC_OFF) + 8);
    }
#define IN(k) (((PHM >> (k)) & 1) && lo <= (k) && (k) < hi)
#ifdef PROBE_DUP
#define REPS(k) (((k) == PROBE_DUP) ? 2 : 1)
#else
#define REPS(k) 1
#endif
#define SEAM(k) do { if (IN(k) && IN((k) + 1)) { xcd_barrier(bar); } } while (0)
    using pg8::Gemm; using pg8::StaticOrder; using pg8::EpiRow8; using pg8::bf16_t;

#ifdef PROBE_SEG
#ifndef PROBE_BLK
#define PROBE_BLK 0
#endif
    unsigned long long pr_t0 = 0, pr_acc = 0;
#define PR_BEGIN(k) do { if (PROBE_SEG == (k)) { __syncthreads(); pr_t0 = __builtin_amdgcn_s_memrealtime(); } } while (0)
#define PR_END(k) do { if (PROBE_SEG == (k)) { __syncthreads(); pr_acc += __builtin_amdgcn_s_memrealtime() - pr_t0; } } while (0)
#else
#define PR_BEGIN(k) do {} while (0)
#define PR_END(k) do {} while (0)
#endif
    if (IN(0)) for (int rep_ = 0; rep_ < REPS(0); ++rep_) { if (rep_) xcd_barrier(bar); PH_BEGIN p0_prologue(F, TAB); } SEAM(0);
    PR_BEGIN(11); if (IN(1)) for (int rep_ = 0; rep_ < REPS(1); ++rep_) { if (rep_) xcd_barrier(bar); PH_BEGIN
        Gemm g{(const bf16_t*)(ws + WS_XN), (const bf16_t*)(ws + WS_WIN), M, D_IN - 256, D}; StaticOrder S; S.init(M, D_IN - 256, F.G, F.bx);
        EpiRow8<pg8::FProj> E{{ws, GATES}};
        pg8::gemm_phase<EpiRow8<pg8::FProj>, StaticOrder, PG8_ALIGN, PG8_SP2>(F.lds + RING_OFF, g, S, E);
    } SEAM(1); PR_END(11);
    PR_BEGIN(12); if (IN(2)) { PH_BEGIN
        constexpr int NLW = 64;
#ifndef PROBE_ATTN_ONLY
        PR_BEGIN(21);
        if (F.bx >= F.G - NLW) {
            const int pm = F.bx - (F.G - NLW);
            PR_BEGIN(22); prep1_rows(F, TAB, pm * 32, pm * 32 + 32, F.wave, NWAVES); PR_END(22);
            asm volatile("s_waitcnt vmcnt(0)" ::: "memory"); __syncthreads();
            if (threadIdx.x == 0) { __builtin_amdgcn_fence(__ATOMIC_ACQUIRE, "agent"); asm volatile("s_waitcnt vmcnt(0)" ::: "memory"); }
            __syncthreads();
            int klora = KLORA; asm volatile("" : "+s"(klora));
            Gemm g{(const bf16_t*)(ws + WS_LIN), (const bf16_t*)(ws + WS_WL) + (size_t)1024 * KLORA, M, 512, klora}; pg8::PanelOrder S{pm, 2};
            EpiRow8<pg8::FLoraG> E{{ws}};
            pg8::gemm_phase<EpiRow8<pg8::FLoraG>, pg8::PanelOrder, PG8_ALIGN, PG8_SP2>(F.lds + RING_OFF, g, S, E);
            __syncthreads();
        } else if (F.bx >= F.G - 2 * NLW) {
            const int pm = F.bx - (F.G - 2 * NLW);
            {
                Gemm g2{(const bf16_t*)(ws + WS_XN), (const bf16_t*)(ws + WS_WIN) + (size_t)(D_IN - 256) * D, M, 256, D}; pg8::PanelOrder S2{pm, 1};
                EpiRow8<pg8::FProjOff> E2{{{ws, GATES}, (D_IN - 256) / 256}};
                pg8::gemm_phase<EpiRow8<pg8::FProjOff>, pg8::PanelOrder, PG8_ALIGN, PG8_SP2>(F.lds + RING_OFF, g2, S2, E2);
                __syncthreads();
            }
        }
#endif
        PR_END(21);
        const attn_body::AttnTensors AT{(const attn_body::bf16*)(ws + WS_Q), (const attn_body::bf16*)(ws + WS_K), (const attn_body::bf16*)(ws + WS_V), (attn_body::bf16*)(ws + WS_O)};
        PR_BEGIN(20); attn_body::attn_phase_hybrid128<8>((char*)lds + RING_OFF, AT, (unsigned*)(ws + WS_CTL + CTL_ATTQ), (volatile LAS unsigned*)(F.lds + MISC_OFF) + 24, F.bx); PR_END(20);
    } SEAM(2); PR_END(12);
    if (IN(3)) { PH_BEGIN
        { GAS unsigned char* w_ = (GAS unsigned char*)args.ws; asm volatile("" : "+s"(w_)); F.ws = (unsigned char*)w_; }
        PR_BEGIN(1); rwkvA_phase(F, TAB, 0); PR_END(1);
        xcd_barrier(bar);
        { GAS unsigned char* w_ = (GAS unsigned char*)args.ws; asm volatile("" : "+s"(w_)); F.ws = (unsigned char*)w_; }
        PR_BEGIN(2); PR_BEGIN(4); if (F.bx < 64) rwkvB_phase(F, TAB, F.bx, 0); else { late_weights(F, TAB, 0, 2, 64); late_weights(F, TAB, 1, 2, 64); }
        __syncthreads(); PR_END(4);
        { GAS unsigned char* w_ = (GAS unsigned char*)args.ws; asm volatile("" : "+s"(w_)); F.ws = (unsigned char*)w_; }
        rwkvA_queue(F, TAB, 1, (unsigned*)(F.ws + WS_CTL + CTL_RKAQ)); PR_END(2);
        xcd_barrier(bar);
        { GAS unsigned char* w_ = (GAS unsigned char*)args.ws; asm volatile("" : "+s"(w_)); F.ws = (unsigned char*)w_; }
        PR_BEGIN(3); if (F.bx < 64) rwkvB_phase(F, TAB, F.bx, 1); PR_END(3);
    } SEAM(3);
    PR_BEGIN(15); if (IN(5)) for (int rep_ = 0; rep_ < REPS(5); ++rep_) { if (rep_) xcd_barrier(bar); PH_BEGIN
        Gemm g{(const bf16_t*)(ws + WS_YA), (const bf16_t*)(ws + WS_WA), M, D, 1024}; StaticOrder S; S.init(M, D, F.G, F.bx);
        pg8::EpiMerge E{GATES, (bf16_t*)(ws + WS_MERGED)};
        pg8::gemm_phase<pg8::EpiMerge, StaticOrder, PG8_ALIGN, PG8_SP2>(F.lds + RING_OFF, g, S, E);
    } SEAM(5); PR_END(15);
    PR_BEGIN(16); if (IN(6)) for (int rep_ = 0; rep_ < REPS(6); ++rep_) { if (rep_) xcd_barrier(bar); PH_BEGIN
        Gemm g{(const bf16_t*)(ws + WS_MERGED), (const bf16_t*)(ws + WS_WO), M, D, D}; StaticOrder S; S.init(M, D, F.G, F.bx);
        pg8::EpiResNorm<0> E{TAB[I_X], F.out, (bf16_t*)(ws + WS_XN), TAB[I_NFG], (float*)(ws + WS_CTL + CTL_SS1), (unsigned*)(ws + WS_CTL + CTL_CNT1), NORM_EPS, (bf16_t*)(ws + WS_X1B)};
        pg8::gemm_phase<pg8::EpiResNorm<0>, StaticOrder, PG8_ALIGN, PG8_SP2>(F.lds + RING_OFF, g, S, E);
    } SEAM(6); PR_END(16);
    PR_BEGIN(17); if (IN(7)) for (int rep_ = 0; rep_ < REPS(7); ++rep_) { if (rep_) xcd_barrier(bar); PH_BEGIN
        Gemm g{(const bf16_t*)(ws + WS_XN), (const bf16_t*)(ws + WS_W1), M, FF, D}; StaticOrder S; S.init(M, FF, F.G, F.bx);
        EpiRow8<pg8::FRelu2> E{{(bf16_t*)(ws + WS_H)}};
        pg8::gemm_phase<EpiRow8<pg8::FRelu2>, StaticOrder, PG8_ALIGN, PG8_SP2>(F.lds + RING_OFF, g, S, E);
    } SEAM(7); PR_END(17);
    PR_BEGIN(18); if (IN(8)) for (int rep_ = 0; rep_ < REPS(8); ++rep_) { if (rep_) xcd_barrier(bar); PH_BEGIN
        Gemm g{(const bf16_t*)(ws + WS_H), (const bf16_t*)(ws + WS_W2), M, D, FF}; StaticOrder S; S.init(M, D, F.G, F.bx);
        pg8::EpiResNorm<1> E{nullptr, F.out, nullptr, TAB[I_NFIN], (float*)(ws + WS_CTL + CTL_SS2), (unsigned*)(ws + WS_CTL + CTL_CNT2), NORM_EPS, (bf16_t*)(ws + WS_X1B)};
        pg8::gemm_phase<pg8::EpiResNorm<1>, StaticOrder, PG8_ALIGN, PG8_SP2>(F.lds + RING_OFF, g, S, E);
    } PR_END(18);
#ifdef PROBE_SEG
    if (blockIdx.x == PROBE_BLK) { const unsigned long long t0_ = __builtin_amdgcn_s_memrealtime(); while (__builtin_amdgcn_s_memrealtime() - t0_ < (unsigned long long)PROBE_MUL * pr_acc) __builtin_amdgcn_s_sleep(8); }
#endif
#undef IN
#undef SEAM
#undef PH_BEGIN
}


#ifdef DBG_DUMP
__global__ void dbg_dump(float* out, const unsigned char* ws) {
    const size_t i = (size_t)blockIdx.x * blockDim.x + threadIdx.x; if (i >= (size_t)M * 1024) return;
    const size_t m = i >> 10; const int c = (int)(i & 1023); float v = 0.f;
#if DBG_DUMP == 1
    v = bf1(((const bf16*)(ws + WS_O))[m * 1024 + c]);
#elif DBG_DUMP == 2
    v = c < 512 ? bf1(((const bf16*)(ws + WS_Y))[m * 512 + c]) : (c < 520 ? ((const float*)(ws + WS_BON))[m * 8 + (c - 512)] : 0.f);
#elif DBG_DUMP == 3
    v = c < 512 ? bf1(((const bf16*)(ws + WS_Q))[m * 512 + c]) : bf1(((const bf16*)(ws + WS_K))[m * 512 + c - 512]);
#elif DBG_DUMP == 4
    v = c < 512 ? ((const float*)(ws + WS_DEC))[m * 512 + c] : bf1(((const bf16*)(ws + WS_AA))[m * 512 + c - 512]);
#elif DBG_DUMP == 6
    v = c < 256 ? bf1(((const bf16*)(ws + WS_WAG))[m * 256 + c]) : (c < 512 ? bf1(((const bf16*)(ws + WS_LIN))[m * 256 + c - 256]) : 0.f);
#elif DBG_DUMP == 7
    { const bf16* wl = (const bf16*)(ws + WS_WL); const size_t j = (m * 1024 + c); v = j < (size_t)NLORA * KLORA ? bf1(wl[j]) : 0.f; }
#elif DBG_DUMP == 8
    v = c < 512 ? bf1(((const bf16*)(ws + WS_GG))[m * 512 + c]) : 0.f;
#elif DBG_DUMP == 5
    v = bf1(((const bf16*)(ws + WS_RKV))[m * 1536 + c]);
#endif
    out[i] = v;
}
#endif

#ifdef DBG_FIXLORA
__global__ void dbg_fixlora(Args A) {
    const size_t i = (size_t)blockIdx.x * blockDim.x + threadIdx.x; if (i >= (size_t)M * 512) return;
    const size_t m = i >> 9; const int c = (int)(i & 511);
    const bf16* LINr = (const bf16*)(A.ws + WS_LIN) + m * 256;
#if DBG_FIXLORA & 1
    { float g = 0.f; for (int k = 0; k < 128; ++k) g += bf1(LINr[128 + k]) * A[I_G2][(size_t)k * 512 + c]; ((bf16*)(A.ws + WS_GG))[m * 512 + c] = (bf16)f2bf(g); }
#endif
#if DBG_FIXLORA & 2
    { float s = A[I_A0][c]; for (int k = 0; k < 64; ++k) s += bf1(LINr[64 + k]) * A[I_A2][(size_t)k * 512 + c]; ((bf16*)(A.ws + WS_AA))[m * 512 + c] = (bf16)f2bf(1.0f / (1.0f + expf(-s))); }
#endif
#if DBG_FIXLORA & 4
    { float s = A[I_W0][c]; for (int k = 0; k < 64; ++k) s += bf1(LINr[k]) * A[I_W2][(size_t)k * 512 + c]; const float w = -log1pf(expf(-s)) - 0.5f; ((float*)(A.ws + WS_DEC))[m * 512 + c] = expf(-expf(w)); }
#endif
}
#endif
#ifndef MK_ONE_LAUNCH
#define MK_ONE_LAUNCH 0
#endif
#ifndef MK_MASK
#define MK_MASK ((1 << NPHASE) - 1)
#endif
typedef void (*kern_t)(Args);
template <int P> struct KTab { static void fill(kern_t* t) { t[P] = fwd_kernel<(1 << P)>; KTab<P - 1>::fill(t); } };
template <> struct KTab<-1> { static void fill(kern_t*) {} };
extern "C" void kernel_launch(void* const* d_in, const int* in_sizes, int n_in, void* d_out, int out_size, void* d_ws, size_t ws_size, hipStream_t stream) {
    static int grid = 0; static kern_t ktab[NPHASE];
    if (grid == 0) {
        if (n_in != 26 || in_sizes[0] != M * D || out_size != M * D || ws_size < WS_END) { fprintf(stderr, "kernel_launch: unexpected shapes (n_in %d, in0 %d, out %d, ws %zu); nothing launched\n", n_in, n_in > 0 ? in_sizes[0] : -1, out_size, ws_size); grid = -1; return; }
        int dev = 0, cus = 0;
        if (hipGetDevice(&dev) != hipSuccess || hipDeviceGetAttribute(&cus, hipDeviceAttributeMultiprocessorCount, dev) != hipSuccess) { grid = -1; return; }
#if MK_ONE_LAUNCH
        int per_cu = 0;
        if (hipFuncSetAttribute((const void*)fwd_kernel<MK_MASK>, hipFuncAttributeMaxDynamicSharedMemorySize, LDS_BYTES) != hipSuccess) { fprintf(stderr, "kernel_launch: hipFuncSetAttribute failed\n"); grid = -1; return; }
        if (hipOccupancyMaxActiveBlocksPerMultiprocessor(&per_cu, (const void*)fwd_kernel<MK_MASK>, NWAVES * 64, LDS_BYTES) != hipSuccess || per_cu < 1) { fprintf(stderr, "kernel_launch: occupancy query says %d blocks per CU\n", per_cu); (void)hipGetLastError(); grid = -1; return; }
#else
        KTab<NPHASE - 1>::fill(ktab);
        for (int p = 0; p < NPHASE; ++p) if (hipFuncSetAttribute((const void*)ktab[p], hipFuncAttributeMaxDynamicSharedMemorySize, LDS_BYTES) != hipSuccess) { fprintf(stderr, "kernel_launch: hipFuncSetAttribute failed\n"); grid = -1; return; }
#endif
        grid = cus;
        if (grid != 256) fprintf(stderr, "kernel_launch: note: %d CUs (built for 256)\n", grid);
    }
    if (grid < 0) return;
    Args a{};
    for (int i = 0; i < 26; ++i) a.in[i] = (const float*)d_in[i];
    a.out = (float*)d_out; a.ws = (unsigned char*)d_ws;
#if MK_ONE_LAUNCH
    a.ph_lo = 0; a.ph_hi = NPHASE;
    void* kargs[] = {&a};
    hipError_t e = hipLaunchCooperativeKernel((const void*)fwd_kernel<MK_MASK>, dim3(grid), dim3(NWAVES * 64), kargs, LDS_BYTES, stream);
    if (e != hipSuccess) fprintf(stderr, "kernel_launch: cooperative launch failed: %s\n", hipGetErrorString(e));
#else
#ifdef DBG_DUMP
    for (int p = 0; p <= DBG_STOP; ++p) { a.ph_lo = p; a.ph_hi = p + 1; hipLaunchKernelGGL(ktab[p], dim3(grid), dim3(NWAVES * 64), LDS_BYTES, stream, a); }
    hipLaunchKernelGGL(dbg_dump, dim3((M * 1024) / 256), dim3(256), 0, stream, (float*)d_out, (const unsigned char*)d_ws);
#else
    for (int p = 0; p < NPHASE; ++p) { a.ph_lo = p; a.ph_hi = p + 1; hipLaunchKernelGGL(ktab[p], dim3(grid), dim3(NWAVES * 64), LDS_BYTES, stream, a);
#ifdef DBG_FIXLORA
        if (p == 3) hipLaunchKernelGGL(dbg_fixlora, dim3((M * 512) / 256), dim3(256), 0, stream, a);
#endif
    }
#endif
#endif
}
```

```cpp
#define MK_ONE_LAUNCH 1
#include <hip/hip_runtime.h>
#include <cstdio>
#include <cstdint>
constexpr int NWAVES = 8;
constexpr int BATCH = 8, SEQ = 2048, D = 1024, M = BATCH * SEQ;
constexpr int D_IN = 5376, FF = 4096, RWW = 512, NLORA = 1536, KLORA = 256;
constexpr float NORM_EPS = 1e-6f, SUBLN_EPS = 1e-5f, GN_EPS = 64e-5f, LAMBDA_INIT = 0.2f;
constexpr size_t MiB = 1u << 20;
constexpr size_t WS_CTL = 0, CTL_ZERO_BYTES = 256 * 1024;
constexpr size_t CTL_SS1 = 65536, CTL_SS2 = 131072, CTL_CNT1 = 196608, CTL_CNT2 = 212992, CTL_ATTQ = 229376, CTL_RKAQ = 229380;
constexpr size_t WS_ROPE_C = 512 * 1024, WS_ROPE_S = 768 * 1024;
constexpr size_t WS_BON = 1 * MiB;
constexpr size_t WS_WIN = 2 * MiB;
constexpr size_t WS_WA = WS_WIN + (size_t)D_IN * D * 2;
constexpr size_t WS_WB = WS_WA + 1 * MiB;
constexpr size_t WS_WO = WS_WB + 1 * MiB;
constexpr size_t WS_W1 = WS_WO + 2 * MiB;
constexpr size_t WS_W2 = WS_W1 + 8 * MiB;
constexpr size_t WS_WL = WS_W2 + 8 * MiB;
static_assert(WS_WL + (size_t)NLORA * KLORA * 2 <= 34 * MiB, "weights");
constexpr size_t WS_XN = 34 * MiB;
constexpr size_t WS_DEC = WS_XN;
constexpr size_t WS_Q = 66 * MiB, WS_K = 82 * MiB, WS_V = 98 * MiB;
constexpr size_t WS_RKV = 114 * MiB;
constexpr size_t WS_WAG = 162 * MiB, WS_LIN = 242 * MiB;
constexpr size_t WS_Y = 162 * MiB;
constexpr size_t WS_AA = 178 * MiB, WS_GG = 194 * MiB;
constexpr size_t WS_O = 210 * MiB;
constexpr size_t WS_YA = 210 * MiB;
constexpr size_t WS_TMP = 114 * MiB;
constexpr size_t WS_MERGED = 114 * MiB;
constexpr size_t WS_X1B = 194 * MiB;
constexpr size_t WS_H = 66 * MiB;
constexpr size_t WS_END = 252 * MiB;
constexpr int RING_OFF = 0, RING_BYTES = 131072;
constexpr int LDS_BYTES = 163840;

#include <hip/hip_runtime.h>
#include <cstdio>
#include <cstdint>
namespace pg8 {
#define PG8_LAS __attribute__((address_space(3)))
typedef unsigned short bf16_t;
typedef short bf16x8 __attribute__((ext_vector_type(8)));
typedef float f32x4 __attribute__((ext_vector_type(4)));
typedef unsigned u32x4 __attribute__((ext_vector_type(4)));
constexpr int BM = 256, BK = 64, HALF = 128, HTB = HALF * BK * 2  , STAGE_BYTES = 8 * HTB, NXCD = 8, WGM = 8;

__host__ __device__ __forceinline__ int lds_byte(int r, int c) { const int st = (r >> 4) * 2 + (c >> 5), rr = r & 15, cc = c & 31, ob = rr * 64 + cc * 2; return st * 1024 + (ob ^ (((ob >> 9) & 1) << 5)); }
__host__ __device__ __forceinline__ void stage_rc(int b, int& R, int& C) { const int st = b / 1024, sb = b % 1024, swz = sb ^ (((sb >> 9) & 1) << 5); R = (st >> 1) * 16 + swz / 64; C = (st & 1) * 32 + (swz % 64) / 2; }
__host__ __device__ __forceinline__ int perm32(int rho) { const int n = rho >> 4, i = rho & 15; return 8 * (i >> 2) + 4 * n + (i & 3); }

struct Unit { int pm, pn; };
struct Gemm { const bf16_t* A; const bf16_t* Bt; int M, N, K; };

struct StaticOrder {
    int nM, nN, nwg, G, c;
    __host__ __device__ void init(int M, int N, int G_, int c_) { nM = M / BM; nN = N / BM; nwg = nM * nN; G = G_; c = c_; }
    __host__ __device__ bool next(int i, Unit& u) const {
        const long L = (long)i * G + c; if (L >= nwg) return false;
        int wgid = (int)L; { const int q = nwg / NXCD, r = nwg % NXCD, xcd = wgid % NXCD, off = wgid / NXCD; wgid = (xcd < r ? xcd * (q + 1) : r * (q + 1) + (xcd - r) * q) + off; }
        const int nig = WGM * nN, gid = wgid / nig, fm = gid * WGM, gsz = (nM - fm) < WGM ? (nM - fm) : WGM;
        u.pm = fm + ((wgid % nig) % gsz); u.pn = (wgid % nig) / gsz; return true;
    }
    __device__ __forceinline__ void a_ready(const Unit&) const {}
    __device__ __forceinline__ void done(const Unit&) const {}
};

typedef float f32x2c_t __attribute__((ext_vector_type(2))); typedef __bf16 bf16x2c_t __attribute__((ext_vector_type(2)));
__device__ __forceinline__ unsigned cvt_pk_bf16(float lo, float hi) { f32x2c_t v = {lo, hi}; bf16x2c_t b = __builtin_convertvector(v, bf16x2c_t); return __builtin_bit_cast(unsigned, b); }
typedef float f32x2 __attribute__((ext_vector_type(2)));
__device__ __forceinline__ f32x2 gelu_pk(f32x2 v) {
    const f32x2 av = __builtin_elementwise_abs(v), d = av * 0.2316418882f + 1.0f;
    f32x2 t; t.x = __builtin_amdgcn_rcpf(d.x); t.y = __builtin_amdgcn_rcpf(d.y);
    f32x2 q = t * 0.5307027145f + (-0.7265760135f); q = q * t + 0.7107068705f; q = q * t + (-0.142248368f); q = q * t + 0.127414796f; q = q * t;
    const f32x2 s = (v * v) * (-0.72134752044f);
    f32x2 e; e.x = __builtin_amdgcn_exp2f(s.x); e.y = __builtin_amdgcn_exp2f(s.y);
    const f32x2 m = v * (q * e), r = v - m;
    f32x2 o; o.x = v.x < 0.f ? m.x : r.x; o.y = v.y < 0.f ? m.y : r.y; return o;
}

template <int ACT  > struct EpiBf16 {
    static constexpr int MIDK = 0; static constexpr bool PERM = true, AFTER_DRAIN = false; static_assert(ACT == 0 || ACT == 1, "EpiBf16: ACT is 0 (none) or 1 (gelu_pk)");
    bf16_t* O; int ldc; const float* bias; int split_cols; size_t split_stride; float scale0;
    __device__ __forceinline__ void operator()(const f32x4 (&acc)[2][2][4][2], const Unit& u, int wr, int wc, int fr, int fq) const {
        const int row0 = u.pm * BM + wr * 64 + fr; int colt = u.pn * BM; bf16_t* base = O;
        float sc = 1.f; if (split_cols) { const int t = colt / split_cols; base += (size_t)t * split_stride; colt -= t * split_cols; if (t == 0) sc = scale0; }
        const int col0 = colt + wc * 32 + 8 * fq, bcol0 = u.pn * BM + wc * 32 + 8 * fq;
        f32x4 bv[2][2];
#pragma unroll
        for (int bj = 0; bj < 2; ++bj)
#pragma unroll
            for (int n = 0; n < 2; ++n) bv[bj][n] = bias ? *(const f32x4*)(bias + bcol0 + bj * HALF + 4 * n) : (f32x4){0.f, 0.f, 0.f, 0.f};
#pragma unroll
        for (int ai = 0; ai < 2; ++ai)
#pragma unroll
            for (int m = 0; m < 4; ++m) { bf16_t* rowp = base + (size_t)(row0 + ai * HALF + m * 16) * ldc + col0;
#pragma unroll
                for (int bj = 0; bj < 2; ++bj) { f32x4 v0 = acc[ai][bj][m][0] + bv[bj][0], v1 = acc[ai][bj][m][1] + bv[bj][1];
                    if (ACT == 1) { f32x2 a = gelu_pk((f32x2){v0[0], v0[1]}), b = gelu_pk((f32x2){v0[2], v0[3]}), c = gelu_pk((f32x2){v1[0], v1[1]}), d = gelu_pk((f32x2){v1[2], v1[3]});
                        v0 = (f32x4){a.x, a.y, b.x, b.y}; v1 = (f32x4){c.x, c.y, d.x, d.y}; }
                    v0 = v0 * sc; v1 = v1 * sc; u32x4 w; w.x = cvt_pk_bf16(v0[0], v0[1]); w.y = cvt_pk_bf16(v0[2], v0[3]); w.z = cvt_pk_bf16(v1[0], v1[1]); w.w = cvt_pk_bf16(v1[2], v1[3]);
                    *(u32x4*)(rowp + bj * HALF) = w; } }
    }
};
typedef unsigned u32x2 __attribute__((ext_vector_type(2)));
__device__ __forceinline__ float bf_lo(unsigned w) { return __builtin_bit_cast(float, w << 16); }
__device__ __forceinline__ float bf_hi(unsigned w) { return __builtin_bit_cast(float, w & 0xffff0000u); }
__device__ __forceinline__ u32x4 pack8(f32x4 v0, f32x4 v1) { u32x4 w; w.x = cvt_pk_bf16(v0[0], v0[1]); w.y = cvt_pk_bf16(v0[2], v0[3]); w.z = cvt_pk_bf16(v1[0], v1[1]); w.w = cvt_pk_bf16(v1[2], v1[3]); return w; }
__device__ __forceinline__ float sigmoidf_(float x) { return __builtin_amdgcn_rcpf(1.0f + __expf(-x)); }
template <class F> struct EpiRow8 {
    static constexpr int MIDK = 0; static constexpr bool PERM = true, AFTER_DRAIN = false;
    F f;
    __device__ __forceinline__ void operator()(const f32x4 (&acc)[2][2][4][2], const Unit& u, int wr, int wc, int fr, int fq) const {
        const int row0 = u.pm * BM + wr * 64 + fr, c0 = wc * 32 + 8 * fq;
#pragma unroll
        for (int ai = 0; ai < 2; ++ai)
#pragma unroll
            for (int m = 0; m < 4; ++m) { const int row = row0 + ai * HALF + m * 16;
#pragma unroll
                for (int bj = 0; bj < 2; ++bj) { f(u.pn, row, c0 + bj * HALF, acc[ai][bj][m][0], acc[ai][bj][m][1]); if (F::FENCE) asm volatile("" ::: "memory"); } }
    }
};
template <class F> struct EpiRow8S {
    static constexpr int MIDK = 0; static constexpr bool PERM = true, AFTER_DRAIN = false;
    F f; const float* ss; float eps;
    __device__ __forceinline__ void operator()(const f32x4 (&acc)[2][2][4][2], const Unit& u, int wr, int wc, int fr, int fq) const {
        const int row0 = u.pm * BM + wr * 64 + fr, c0 = wc * 32 + 8 * fq;
        float r[2][4];
#pragma unroll
        for (int ai = 0; ai < 2; ++ai)
#pragma unroll
            for (int m = 0; m < 4; ++m) r[ai][m] = ss[row0 + ai * HALF + m * 16];
#pragma unroll
        for (int ai = 0; ai < 2; ++ai)
#pragma unroll
            for (int m = 0; m < 4; ++m) r[ai][m] = __builtin_amdgcn_rsqf(r[ai][m] * (1.0f / 1024.0f) + eps);
#pragma unroll
        for (int ai = 0; ai < 2; ++ai)
#pragma unroll
            for (int m = 0; m < 4; ++m) { const int row = row0 + ai * HALF + m * 16;
#pragma unroll
                for (int bj = 0; bj < 2; ++bj) { f(u.pn, row, c0 + bj * HALF, acc[ai][bj][m][0] * r[ai][m], acc[ai][bj][m][1] * r[ai][m]); if (F::FENCE) asm volatile("" ::: "memory"); } }
    }
};
constexpr float ATT_C2 = 0.125f * 1.4426950408889634f;
struct FProj {
    static constexpr bool FENCE = false;
    unsigned char* ws; bf16_t* GATES;
    __device__ __forceinline__ void rope(int pn, int row, int cu, f32x4 v0, f32x4 v1, f32x4 c, f32x4 s) const {
            const int sh = cu >> 6, j = (cu & 63) >> 3;
            const float sc = pn < 2 ? ATT_C2 : 1.0f;
            const f32x4 o1 = (v0 * c - v1 * s) * sc, o2 = (v1 * c + v0 * s) * sc;
            bf16_t* dst = (bf16_t*)(ws + (pn < 2 ? WS_Q : WS_K)) + (size_t)row * 512 + (pn & 1) * 256 + sh * 64 + 4 * j;
            u32x2 w1, w2; w1.x = cvt_pk_bf16(o1[0], o1[1]); w1.y = cvt_pk_bf16(o1[2], o1[3]); w2.x = cvt_pk_bf16(o2[0], o2[1]); w2.y = cvt_pk_bf16(o2[2], o2[3]);
            *(u32x2*)dst = w1; *(u32x2*)(dst + 32) = w2;
    }
    __device__ __forceinline__ void operator()(int pn, int row, int cu, f32x4 v0, f32x4 v1) const {
        if (pn < 4) {
            const int j = (cu & 63) >> 3, pos = row & 2047;
            const f32x4 c = *(const f32x4*)((const float*)(ws + WS_ROPE_C) + pos * 32 + 4 * j), s = *(const f32x4*)((const float*)(ws + WS_ROPE_S) + pos * 32 + 4 * j);
            rope(pn, row, cu, v0, v1, c, s);
        } else if (pn < 13) {
            size_t off; int pitch, col;
            if (pn < 6) { off = WS_V; pitch = 512; col = (pn - 4) * 256; }
            else if (pn < 12) { off = WS_RKV; pitch = 1536; col = (pn - 6) * 256; }
            else { off = WS_WAG; pitch = 256; col = 0; }
            *(u32x4*)((bf16_t*)(ws + off) + (size_t)row * pitch + col + cu) = pack8(v0, v1);
        } else {
            const int gcol = (pn - 13) * 256 + cu; unsigned q[8];
#pragma unroll
            for (int e = 0; e < 4; ++e) { q[e] = (unsigned)__builtin_fmaxf(__builtin_rintf(255.0f * sigmoidf_(v0[e])), 1.0f); q[4 + e] = (unsigned)__builtin_fmaxf(__builtin_rintf(255.0f * sigmoidf_(v1[e])), 1.0f); }
            u32x2 w; w.x = q[0] | (q[1] << 8) | (q[2] << 16) | (q[3] << 24); w.y = q[4] | (q[5] << 8) | (q[6] << 16) | (q[7] << 24);
            *(u32x2*)((unsigned char*)GATES + (size_t)row * 2048 + gcol) = w;
        }
    }
};
struct FLora {
    static constexpr bool FENCE = false;
    unsigned char* ws; const float *w0, *a0;
    __device__ __forceinline__ void operator()(int pn, int row, int cu, f32x4 v0, f32x4 v1) const {
        const int c = (pn & 1) * 256 + cu;
        if (pn < 2) {
            const f32x4 b0 = *(const f32x4*)(w0 + c), b1 = *(const f32x4*)(w0 + c + 4);
            float* dst = (float*)(ws + WS_DEC) + (size_t)row * 512 + c; *(f32x4*)dst = v0 + b0; *(f32x4*)(dst + 4) = v1 + b1;
        } else if (pn < 4) {
            const f32x4 b0 = *(const f32x4*)(a0 + c), b1 = *(const f32x4*)(a0 + c + 4);
            *(u32x4*)((bf16_t*)(ws + WS_AA) + (size_t)row * 512 + c) = pack8(v0 + b0, v1 + b1);
        } else *(u32x4*)((bf16_t*)(ws + WS_GG) + (size_t)row * 512 + c) = pack8(v0, v1);
    }
};
struct FProjOff {
    static constexpr bool FENCE = false;
    FProj f; int off;
    __device__ __forceinline__ void operator()(int pn, int row, int cu, f32x4 v0, f32x4 v1) const { f(pn + off, row, cu, v0, v1); }
};
struct EpiProj {
    static constexpr int MIDK = 0; static constexpr bool PERM = true, AFTER_DRAIN = false;
    FProj f;
    __device__ __forceinline__ void operator()(const f32x4 (&acc)[2][2][4][2], const Unit& u, int wr, int wc, int fr, int fq) const {
        const int row0 = u.pm * BM + wr * 64 + fr, c0 = wc * 32 + 8 * fq;
        if (u.pn < 4) {
            const int j = (c0 & 63) >> 3;
#pragma unroll
            for (int ai = 0; ai < 2; ++ai) { f32x4 c[4], s[4];
#pragma unroll
                for (int m = 0; m < 4; ++m) { const int pos = (row0 + ai * HALF + m * 16) & 2047; c[m] = *(const f32x4*)((const float*)(f.ws + WS_ROPE_C) + pos * 32 + 4 * j); s[m] = *(const f32x4*)((const float*)(f.ws + WS_ROPE_S) + pos * 32 + 4 * j); }
#pragma unroll
                for (int m = 0; m < 4; ++m)
#pragma unroll
                    for (int bj = 0; bj < 2; ++bj) f.rope(u.pn, row0 + ai * HALF + m * 16, c0 + bj * HALF, acc[ai][bj][m][0], acc[ai][bj][m][1], c[m], s[m]); }
        } else {
#pragma unroll
            for (int ai = 0; ai < 2; ++ai)
#pragma unroll
                for (int m = 0; m < 4; ++m)
#pragma unroll
                    for (int bj = 0; bj < 2; ++bj) f(u.pn, row0 + ai * HALF + m * 16, c0 + bj * HALF, acc[ai][bj][m][0], acc[ai][bj][m][1]);
        }
    }
};
struct FLoraG {
    static constexpr bool FENCE = false;
    unsigned char* ws;
    __device__ __forceinline__ void operator()(int pn, int row, int cu, f32x4 v0, f32x4 v1) const { *(u32x4*)((bf16_t*)(ws + WS_GG) + (size_t)row * 512 + pn * 256 + cu) = pack8(v0, v1); }
};
struct EpiMerge {
    static constexpr int MIDK = 8; static constexpr bool PERM = true, AFTER_DRAIN = false;
    const bf16_t* GATES; bf16_t* MERGED;
    static __device__ __forceinline__ float ub(unsigned w, int i) { return (float)((w >> (8 * i)) & 0xffu); }
    __device__ __forceinline__ void mid(f32x4 (&acc)[2][2][4][2], const Unit& u, int wr, int wc, int fr, int fq) const {
        int fr_ = fr; asm volatile("" : "+v"(fr_));
        const unsigned char* gp0 = (const unsigned char*)GATES + (size_t)(u.pm * BM + wr * 64 + fr_) * 2048 + u.pn * BM + wc * 32 + 8 * fq;
#pragma unroll
        for (int ai = 0; ai < 2; ++ai)
#pragma unroll
            for (int m = 0; m < 4; ++m)
#pragma unroll
                for (int bj = 0; bj < 2; ++bj) { const unsigned char* gp = gp0 + (size_t)(ai * HALF + m * 16) * 2048 + bj * HALF;
                    const u32x2 ga = *(const u32x2*)gp, gb = *(const u32x2*)(gp + 1024);
                    f32x4& v0 = acc[ai][bj][m][0]; f32x4& v1 = acc[ai][bj][m][1];
#pragma unroll
                    for (int e = 0; e < 4; ++e) { v0[e] *= ub(ga.x, e) * __builtin_amdgcn_rcpf(ub(gb.x, e)); v1[e] *= ub(ga.y, e) * __builtin_amdgcn_rcpf(ub(gb.y, e)); }
                    asm volatile("" ::: "memory"); }
    }
    __device__ __forceinline__ void operator()(const f32x4 (&acc)[2][2][4][2], const Unit& u, int wr, int wc, int fr, int fq) const {
        const int row0 = u.pm * BM + wr * 64 + fr, c0 = u.pn * BM + wc * 32 + 8 * fq;
#pragma unroll
        for (int ai = 0; ai < 2; ++ai)
#pragma unroll
            for (int m = 0; m < 4; ++m) { const int row = row0 + ai * HALF + m * 16;
#pragma unroll
                for (int bj = 0; bj < 2; ++bj) { const u32x2 g = *(const u32x2*)((const unsigned char*)GATES + (size_t)row * 2048 + 1024 + c0 + bj * HALF);
                    f32x4 v0 = acc[ai][bj][m][0], v1 = acc[ai][bj][m][1];
#pragma unroll
                    for (int e = 0; e < 4; ++e) { v0[e] *= ub(g.x, e) * (1.0f / 255.0f); v1[e] *= ub(g.y, e) * (1.0f / 255.0f); }
                    *(u32x4*)(MERGED + (size_t)row * 1024 + c0 + bj * HALF) = pack8(v0, v1); } }
    }
};
struct FRes {
    static constexpr bool FENCE = false;
    const float* base; float* out;
    __device__ __forceinline__ void operator()(int pn, int row, int cu, f32x4 v0, f32x4 v1) const {
        const size_t off = (size_t)row * 1024 + pn * 256 + cu; const f32x4 b0 = *(const f32x4*)(base + off), b1 = *(const f32x4*)(base + off + 4);
        *(f32x4*)(out + off) = b0 + v0; *(f32x4*)(out + off + 4) = b1 + v1;
    }
};
struct FRelu2N {
    static constexpr bool FENCE = false;
    bf16_t* H; const float* ss; float eps;
    __device__ __forceinline__ void operator()(int pn, int row, int cu, f32x4 v0, f32x4 v1) const {
        const float rstd = __builtin_amdgcn_rsqf(ss[row] * (1.0f / 1024.0f) + eps);
        f32x4 r0, r1;
#pragma unroll
        for (int e = 0; e < 4; ++e) { const float a = __builtin_fmaxf(v0[e], 0.f) * rstd, b = __builtin_fmaxf(v1[e], 0.f) * rstd; r0[e] = a * a; r1[e] = b * b; }
        *(u32x4*)(H + (size_t)row * 4096 + pn * 256 + cu) = pack8(r0, r1);
    }
};
struct FRelu2 {
    static constexpr bool FENCE = false;
    bf16_t* H;
    __device__ __forceinline__ void operator()(int pn, int row, int cu, f32x4 v0, f32x4 v1) const {
        f32x4 r0, r1;
#pragma unroll
        for (int e = 0; e < 4; ++e) { const float a = __builtin_fmaxf(v0[e], 0.f), b = __builtin_fmaxf(v1[e], 0.f); r0[e] = a * a; r1[e] = b * b; }
        *(u32x4*)(H + (size_t)row * 4096 + pn * 256 + cu) = pack8(r0, r1);
    }
};

__device__ __forceinline__ float xsum_fq(float x) {
    { auto r = __builtin_amdgcn_permlane16_swap(__builtin_bit_cast(unsigned, x), __builtin_bit_cast(unsigned, x), false, false); const unsigned a = r[0], b = r[1]; x = __builtin_bit_cast(float, a) + __builtin_bit_cast(float, b); }
    { auto r = __builtin_amdgcn_permlane32_swap(__builtin_bit_cast(unsigned, x), __builtin_bit_cast(unsigned, x), false, false); const unsigned a = r[0], b = r[1]; x = __builtin_bit_cast(float, a) + __builtin_bit_cast(float, b); }
    return x;
}
struct EpiResSum {
    static constexpr int MIDK = 0; static constexpr bool PERM = true, AFTER_DRAIN = false;
    const float* base; float* ss; bf16_t* x1b;
    __device__ __forceinline__ void operator()(f32x4 (&acc)[2][2][4][2], const Unit& u, int wr, int wc, int fr, int fq) const {
        const int row0 = u.pm * BM + wr * 64 + fr, c0 = u.pn * BM + wc * 32 + 8 * fq;
#pragma unroll
        for (int ai = 0; ai < 2; ++ai)
#pragma unroll
            for (int m = 0; m < 4; ++m) { const int row = row0 + ai * HALF + m * 16; float s = 0.f;
#pragma unroll
                for (int bj = 0; bj < 2; ++bj) { const size_t off = (size_t)row * 1024 + c0 + bj * HALF;
                    const f32x4 b0 = __builtin_nontemporal_load((const f32x4*)(base + off)), b1 = __builtin_nontemporal_load((const f32x4*)(base + off + 4));
                    const f32x4 v0 = acc[ai][bj][m][0] + b0, v1 = acc[ai][bj][m][1] + b1;
                    *(u32x4*)(x1b + off) = pack8(v0, v1);
                    s += (v0[0] * v0[0] + v0[1] * v0[1]) + (v0[2] * v0[2] + v0[3] * v0[3]) + (v1[0] * v1[0] + v1[1] * v1[1]) + (v1[2] * v1[2] + v1[3] * v1[3]); }
                s = xsum_fq(s);
                if (fq == 0) __hip_atomic_fetch_add(ss + row, s, __ATOMIC_RELAXED, __HIP_MEMORY_SCOPE_AGENT);
                if (m & 1) asm volatile("" ::: "memory"); }
    }
};
template <int MODE> struct EpiResNorm {
    static constexpr int MIDK = 0; static constexpr bool PERM = true, AFTER_DRAIN = false;
    const float* base; float* out; bf16_t* xn; const float* g; float* ss; unsigned* cnt; float eps; bf16_t* x1b;
    __device__ __forceinline__ void operator()(f32x4 (&acc)[2][2][4][2], const Unit& u, int wr, int wc, int fr, int fq) const {
        const int row0 = u.pm * BM + wr * 64 + fr, c0 = u.pn * BM + wc * 32 + 8 * fq;
#pragma unroll
        for (int ai = 0; ai < 2; ++ai)
#pragma unroll
            for (int m = 0; m < 4; ++m) { const int row = row0 + ai * HALF + m * 16; float s = 0.f;
#pragma unroll
                for (int bj = 0; bj < 2; ++bj) { const size_t off = (size_t)row * 1024 + c0 + bj * HALF; f32x4 b0, b1;
                    if (MODE == 0) { b0 = *(const f32x4*)(base + off); b1 = *(const f32x4*)(base + off + 4); }
                    else { const u32x4 w = __builtin_nontemporal_load((const u32x4*)(x1b + off)); b0 = (f32x4){bf_lo(w.x), bf_hi(w.x), bf_lo(w.y), bf_hi(w.y)}; b1 = (f32x4){bf_lo(w.z), bf_hi(w.z), bf_lo(w.w), bf_hi(w.w)}; }
                    f32x4& v0 = acc[ai][bj][m][0]; f32x4& v1 = acc[ai][bj][m][1]; v0 += b0; v1 += b1;
                    if (MODE == 0) *(u32x4*)(x1b + off) = pack8(v0, v1);
                    s += (v0[0] * v0[0] + v0[1] * v0[1]) + (v0[2] * v0[2] + v0[3] * v0[3]) + (v1[0] * v1[0] + v1[1] * v1[1]) + (v1[2] * v1[2] + v1[3] * v1[3]); }
                s = xsum_fq(s);
                if (fq == 0) __hip_atomic_fetch_add(ss + row, s, __ATOMIC_RELAXED, __HIP_MEMORY_SCOPE_AGENT);
                if (m & 1) asm volatile("" ::: "memory"); }
        asm volatile("s_waitcnt vmcnt(0)" ::: "memory");
        unsigned* c_ = cnt + 64 * u.pm;
        if (fr == 0 && fq == 0) __hip_atomic_fetch_add(c_, 1u, __ATOMIC_RELAXED, __HIP_MEMORY_SCOPE_AGENT);
        { unsigned spins = 0; while ((unsigned)__builtin_amdgcn_readfirstlane(__hip_atomic_load(c_, __ATOMIC_RELAXED, __HIP_MEMORY_SCOPE_AGENT)) < 32u && ++spins < (1u << 22)) __builtin_amdgcn_s_sleep(2); }
        asm volatile("" ::: "memory");
#pragma unroll
        for (int ai = 0; ai < 2; ++ai)
#pragma unroll
            for (int m = 0; m < 4; ++m) { const int row = row0 + ai * HALF + m * 16;
                const float rstd = __builtin_amdgcn_rsqf(__hip_atomic_load(ss + row, __ATOMIC_RELAXED, __HIP_MEMORY_SCOPE_AGENT) * (1.0f / 1024.0f) + eps);
#pragma unroll
                for (int bj = 0; bj < 2; ++bj) { const size_t off = (size_t)row * 1024 + c0 + bj * HALF; const f32x4 g0 = *(const f32x4*)(g + c0 + bj * HALF), g1 = *(const f32x4*)(g + c0 + bj * HALF + 4);
                    const f32x4 o0 = acc[ai][bj][m][0] * rstd * g0, o1 = acc[ai][bj][m][1] * rstd * g1;
                    if (MODE == 0) *(u32x4*)(xn + off) = pack8(o0, o1); else { __builtin_nontemporal_store(o0, (f32x4*)(out + off)); __builtin_nontemporal_store(o1, (f32x4*)(out + off + 4)); } }
                if (m & 1) asm volatile("" ::: "memory"); }
    }
};

struct PanelOrder {
    int pm, ntiles;
    __device__ __forceinline__ bool next(int i, Unit& u) const { if (i >= ntiles) return false; int p = pm; asm volatile("" : "+s"(p)); u.pm = p; u.pn = i; return true; }
    __device__ __forceinline__ void a_ready(const Unit&) const {}
    __device__ __forceinline__ void done(const Unit&) const {}
};
template <class Epi, class Sched, bool ALIGN_EPI = false, bool SP2 = false>
__device__ __forceinline__ void gemm_phase(PG8_LAS unsigned char* lds, const Gemm g, const Sched& S, const Epi& E) {
    int tid_ = threadIdx.x; asm volatile("" : "+v"(tid_));
    const int tid = tid_, wid = __builtin_amdgcn_readfirstlane(tid >> 6), lane = tid & 63, wr = wid >> 2, wc = wid & 3, fr = lane & 15, fq = lane >> 4;
    const int K = g.K, nt = K / BK;
    unsigned voffA[2], voffB[2];
#pragma unroll
    for (int i = 0; i < 2; ++i) { int R, C; stage_rc(tid * 16 + i * 8192, R, C); const int Rb = Epi::PERM ? ((R & ~31) + perm32(R & 31)) : R;
        voffA[i] = (unsigned)(R * K + C) * 2u; voffB[i] = (unsigned)(Rb * K + C) * 2u; }
    const size_t kstep = (size_t)(BK * 2);
    const size_t hstep = (size_t)HALF * K * 2;
    const size_t tstep = 2 * hstep;
    const unsigned ldsw = (unsigned)wid * 1024u;
    const int aoff = lds_byte(wr * 64 + fr, fq * 8), boff = lds_byte(wc * 32 + fr, fq * 8);
#define PG8_SA(b, h) (((b) * 2 + (h)) * HTB)
#define PG8_SB(b, h) ((4 + (b) * 2 + (h)) * HTB)
#define PG8_STAGE(bufoff, gbase, voff) do { _Pragma("unroll") for (int _i = 0; _i < 2; ++_i) \
        __builtin_amdgcn_global_load_lds((const unsigned*)((const char*)(gbase) + (voff)[_i]), (PG8_LAS unsigned*)(lds + (bufoff) + ldsw + _i * 8192), 16, 0, 0); } while (0)
#define PG8_LDA(dst, b, h) do { _Pragma("unroll") for (int m = 0; m < 4; ++m) _Pragma("unroll") for (int k = 0; k < 2; ++k) dst[m][k] = *(const PG8_LAS bf16x8*)(lds + PG8_SA(b, h) + aoff + m * 2048 + k * 1024); } while (0)
#define PG8_LDB(dst, b, h) do { _Pragma("unroll") for (int n = 0; n < 2; ++n) _Pragma("unroll") for (int k = 0; k < 2; ++k) dst[n][k] = *(const PG8_LAS bf16x8*)(lds + PG8_SB(b, h) + boff + n * 2048 + k * 1024); } while (0)
#define PG8_MMA(ai, bj, At, Bt) do { __builtin_amdgcn_s_setprio(1); _Pragma("unroll") for (int m = 0; m < 4; ++m) _Pragma("unroll") for (int n = 0; n < 2; ++n) _Pragma("unroll") for (int k = 0; k < 2; ++k) \
        acc[ai][bj][m][n] = __builtin_amdgcn_mfma_f32_16x16x32_bf16(Bt[n][k], At[m][k], acc[ai][bj][m][n], 0, 0, 0); __builtin_amdgcn_s_setprio(0); } while (0)
#define PG8_WAIT_V(n) asm volatile("s_waitcnt vmcnt(" #n ")" ::: "memory")
#define PG8_WAIT_L(n) asm volatile("s_waitcnt lgkmcnt(" #n ")" ::: "memory")
#define PG8_BAR __builtin_amdgcn_s_barrier()
#define PG8_SCHED __builtin_amdgcn_sched_barrier(0)
    Unit cur, nxt; int ui = 0;
    if (!S.next(0, cur)) return;
    f32x4 acc[2][2][4][2];
#pragma unroll
    for (int a = 0; a < 2; ++a)
#pragma unroll
        for (int b = 0; b < 2; ++b)
#pragma unroll
            for (int m = 0; m < 4; ++m)
#pragma unroll
                for (int n = 0; n < 2; ++n) acc[a][b][m][n] = (f32x4){0.f, 0.f, 0.f, 0.f};
    bf16x8 At[4][2], B0[2][2], B1[2][2];
    const char* cA = (const char*)g.A + (size_t)cur.pm * tstep; const char* cB = (const char*)g.Bt + (size_t)cur.pn * tstep;
    S.a_ready(cur);
    if constexpr (SP2) {
        PG8_STAGE(PG8_SB(0, 0), cB, voffB); PG8_STAGE(PG8_SB(0, 1), cB + hstep, voffB); PG8_STAGE(PG8_SA(0, 0), cA, voffA); PG8_STAGE(PG8_SA(0, 1), cA + hstep, voffA);
        if (wr == 1) PG8_BAR;
        PG8_WAIT_V(2); PG8_BAR;
        PG8_STAGE(PG8_SB(1, 0), cB + kstep, voffB); PG8_STAGE(PG8_SA(1, 0), cA + kstep, voffA); PG8_STAGE(PG8_SB(1, 1), cB + hstep + kstep, voffB);
        PG8_WAIT_V(6); PG8_BAR;
    } else {
        PG8_STAGE(PG8_SB(0, 0), cB, voffB); PG8_STAGE(PG8_SA(0, 0), cA, voffA); PG8_STAGE(PG8_SB(0, 1), cB + hstep, voffB); PG8_STAGE(PG8_SA(0, 1), cA + hstep, voffA);
        if (wr == 1) PG8_BAR;
        PG8_WAIT_V(4); PG8_BAR;
        PG8_STAGE(PG8_SB(1, 0), cB + kstep, voffB); PG8_STAGE(PG8_SA(1, 0), cA + kstep, voffA); PG8_STAGE(PG8_SB(1, 1), cB + hstep + kstep, voffB);
        PG8_WAIT_V(6); PG8_BAR;
    }
    for (;;) {
        const bool has_next = S.next(ui + 1, nxt);
        const char* nA = has_next ? (const char*)g.A + (size_t)nxt.pm * tstep : cA; const char* nB = has_next ? (const char*)g.Bt + (size_t)nxt.pn * tstep : cB;
        for (int t = 0; t < nt; t += 2) {
            if constexpr (Epi::MIDK > 0) { if (t == Epi::MIDK) E.mid(acc, cur, wr, wc, fr, fq); }
            const bool last = (t == nt - 2);
            const char* a1 = cA + (size_t)(t + 1) * kstep;
            const char* a2 = last ? nA : cA + (size_t)(t + 2) * kstep; const char* b2 = last ? nB : cB + (size_t)(t + 2) * kstep;
            const char* a3 = a2 + kstep; const char* b3 = b2 + kstep;
            if (last && has_next) S.a_ready(nxt);
            if constexpr (SP2) {
            PG8_LDB(B0, 0, 0); PG8_LDB(B1, 0, 1); PG8_SCHED; PG8_LDA(At, 0, 0); PG8_STAGE(PG8_SA(1, 1), a1 + hstep, voffA);
            PG8_WAIT_V(8); PG8_WAIT_L(0); PG8_BAR; PG8_MMA(0, 0, At, B0); PG8_MMA(0, 1, At, B1); PG8_BAR; PG8_SCHED;
            PG8_LDA(At, 0, 1); PG8_STAGE(PG8_SB(0, 0), b2, voffB); PG8_STAGE(PG8_SB(0, 1), b2 + hstep, voffB); PG8_STAGE(PG8_SA(0, 0), a2, voffA);
            PG8_WAIT_V(8); PG8_WAIT_L(0); PG8_BAR; PG8_MMA(1, 0, At, B0); PG8_MMA(1, 1, At, B1); PG8_BAR; PG8_SCHED;
            PG8_LDB(B0, 1, 0); PG8_LDB(B1, 1, 1); PG8_SCHED; PG8_LDA(At, 1, 0); PG8_STAGE(PG8_SA(0, 1), a2 + hstep, voffA);
            PG8_WAIT_V(8); PG8_WAIT_L(0); PG8_BAR; PG8_MMA(0, 0, At, B0); PG8_MMA(0, 1, At, B1); PG8_BAR; PG8_SCHED;
            PG8_LDA(At, 1, 1); PG8_STAGE(PG8_SB(1, 0), b3, voffB); PG8_STAGE(PG8_SB(1, 1), b3 + hstep, voffB); PG8_STAGE(PG8_SA(1, 0), a3, voffA);
            PG8_WAIT_V(8); PG8_WAIT_L(0); PG8_BAR; PG8_MMA(1, 0, At, B0); PG8_MMA(1, 1, At, B1); PG8_BAR; PG8_SCHED;
            } else {
            PG8_LDB(B0, 0, 0); PG8_SCHED; PG8_LDA(At, 0, 0); PG8_STAGE(PG8_SA(1, 1), a1 + hstep, voffA);
            PG8_WAIT_L(8); PG8_BAR; PG8_WAIT_L(0); PG8_MMA(0, 0, At, B0); PG8_BAR; PG8_SCHED;
            PG8_LDB(B1, 0, 1); PG8_STAGE(PG8_SB(0, 0), b2, voffB);
            PG8_BAR; PG8_WAIT_L(0); PG8_MMA(0, 1, At, B1); PG8_BAR;
            PG8_LDA(At, 0, 1); PG8_STAGE(PG8_SA(0, 0), a2, voffA);
            PG8_BAR; PG8_WAIT_L(0); PG8_MMA(1, 0, At, B0); PG8_BAR; PG8_SCHED;
            PG8_STAGE(PG8_SB(0, 1), b2 + hstep, voffB);
            PG8_WAIT_V(6); PG8_BAR; PG8_MMA(1, 1, At, B1); PG8_BAR;
            PG8_LDB(B0, 1, 0); PG8_SCHED; PG8_LDA(At, 1, 0); PG8_STAGE(PG8_SA(0, 1), a2 + hstep, voffA);
            PG8_WAIT_L(8); PG8_BAR; PG8_WAIT_L(0); PG8_MMA(0, 0, At, B0); PG8_BAR; PG8_SCHED;
            PG8_LDB(B1, 1, 1); PG8_STAGE(PG8_SB(1, 0), b3, voffB);
            PG8_BAR; PG8_WAIT_L(0); PG8_MMA(0, 1, At, B1); PG8_BAR;
            PG8_LDA(At, 1, 1); PG8_STAGE(PG8_SA(1, 0), a3, voffA);
            PG8_BAR; PG8_WAIT_L(0); PG8_MMA(1, 0, At, B0); PG8_BAR; PG8_SCHED;
            PG8_STAGE(PG8_SB(1, 1), b3 + hstep, voffB);
            PG8_WAIT_V(6); PG8_BAR; PG8_MMA(1, 1, At, B1); PG8_BAR;
            }
        }
        if constexpr (ALIGN_EPI) { if (wr == 0) PG8_BAR; }
        if constexpr (!Epi::AFTER_DRAIN) { E(acc, cur, wr, wc, fr, fq); S.done(cur); }
        if (!has_next) break;
#pragma unroll
        for (int a = 0; a < 2; ++a)
#pragma unroll
            for (int b = 0; b < 2; ++b)
#pragma unroll
                for (int m = 0; m < 4; ++m)
#pragma unroll
                    for (int n = 0; n < 2; ++n) acc[a][b][m][n] = (f32x4){0.f, 0.f, 0.f, 0.f};
        cur = nxt; cA = nA; cB = nB; ++ui;
        if constexpr (ALIGN_EPI) { if (wr == 1) PG8_BAR; }
    }
    PG8_WAIT_V(0);
    if constexpr (!ALIGN_EPI) { if (wr == 0) PG8_BAR; }
    PG8_BAR;
    if constexpr (Epi::AFTER_DRAIN) { E.fused(acc, cur, wr, wc, fr, fq, lds, wid, lane); S.done(cur); }
#undef PG8_SA
#undef PG8_SB
#undef PG8_STAGE
#undef PG8_LDA
#undef PG8_LDB
#undef PG8_MMA
#undef PG8_WAIT_V
#undef PG8_WAIT_L
#undef PG8_BAR
#undef PG8_SCHED
}
}

#ifndef PG8_SP2
#define PG8_SP2 true
#endif
#ifndef PG8_ALIGN
#define PG8_ALIGN true
#endif
#include <hip/hip_bf16.h>
#include <cmath>
namespace attn_body {
using bf16=__hip_bfloat16;
using bf16x8=__attribute__((ext_vector_type(8)))short;
using s16x4=__attribute__((ext_vector_type(4)))short;
using f32x16=__attribute__((ext_vector_type(16)))float;
using u32x4=__attribute__((ext_vector_type(4)))unsigned;
constexpr int SEQ=2048,D=64,QP=512,KP=512,VP=512,OP=1024;
constexpr int NW=8,QBLK=32,QB=QBLK*NW,KVBLK=64,NQB=SEQ/QB;
constexpr int ATTN_UNIT_ROWS=QB;
__device__ __forceinline__ int crow(int r,int hi){return (r&3)+8*(r>>2)+4*hi;}
#define SBAR() __builtin_amdgcn_sched_barrier(0)
__device__ __forceinline__ void cmask(f32x16&p0,f32x16&p1,int jb,int wchunk,int){
  if(jb>wchunk){ const float NEG=-INFINITY;
    #pragma unroll
    for(int r=0;r<16;++r){p0[r]=NEG;p1[r]=NEG;} }
}

constexpr int NSLOT=3, SLOTB=8192;
constexpr int LDS_K=0, LDS_V=NSLOT*SLOTB, LDS_WS=2*NSLOT*SLOTB, LDS_OST=LDS_WS+NW*64*4, LDS_BYTES=LDS_OST+NW*4096;
constexpr float C2=0.125f*1.4426950408889634f;
__device__ __forceinline__ void glds16(const void*gsrc,unsigned lds_dst){unsigned keep;
  asm volatile("s_mov_b32 %0, m0\n\ts_mov_b32 m0, %2\n\ts_nop 0\n\tglobal_load_lds_dwordx4 %1, off\n\ts_mov_b32 m0, %0":"=&s"(keep):"v"(gsrc),"s"(lds_dst):"memory");}
__device__ __forceinline__ float max3f(float a,float b,float c){float r;asm("v_max3_f32 %0, %1, %2, %3":"=v"(r):"v"(a),"v"(b),"v"(c));return r;}
__device__ __forceinline__ float max2f(float a,float b){float r;asm("v_max_f32_e32 %0, %1, %2":"=v"(r):"v"(a),"v"(b));return r;}
__device__ __forceinline__ float fadd_s(float a,float b){float r;asm("v_add_f32_e32 %0, %1, %2":"=v"(r):"v"(a),"v"(b));return r;}
__device__ __forceinline__ float fsub_s(float a,float b){float r;asm("v_sub_f32_e32 %0, %1, %2":"=v"(r):"v"(a),"v"(b));return r;}
typedef float f32x2_t __attribute__((ext_vector_type(2))); typedef __bf16 bf16x2_t __attribute__((ext_vector_type(2)));
__device__ __forceinline__ unsigned cvtpk_s(float lo,float hi){f32x2_t v={lo,hi};bf16x2_t b=__builtin_convertvector(v,bf16x2_t);return __builtin_bit_cast(unsigned,b);}
#define WAIT_BAR(N) asm volatile("s_waitcnt vmcnt(" #N ") lgkmcnt(0)\n\ts_barrier":::"memory")

__device__ __forceinline__ void qkt(f32x16&p0,f32x16&p1,const char*Kslot,const bf16x8*qr,const f32x16&negm,int r32,int hi){
  const char*kb=Kslot+hi*1024+r32*16;
  #pragma unroll
  for(int d0=0;d0<4;++d0){
    const bf16x8 b0=*reinterpret_cast<const bf16x8*>(kb+d0*2048);
    const bf16x8 b1=*reinterpret_cast<const bf16x8*>(kb+d0*2048+512);
    if(d0==0){p0=__builtin_amdgcn_mfma_f32_32x32x16_bf16(b0,qr[0],negm,0,0,0);p1=__builtin_amdgcn_mfma_f32_32x32x16_bf16(b1,qr[0],negm,0,0,0);}
    else{p0=__builtin_amdgcn_mfma_f32_32x32x16_bf16(b0,qr[d0],p0,0,0,0);p1=__builtin_amdgcn_mfma_f32_32x32x16_bf16(b1,qr[d0],p1,0,0,0);}}
}
typedef __attribute__((address_space(3))) const char* lds_cptr;
typedef short v4i16_t __attribute__((ext_vector_type(4)));
__device__ __forceinline__ void kload8(bf16x8*kf,lds_cptr kp){
  kf[0]=*(const __attribute__((address_space(3))) bf16x8*)(kp);      kf[1]=*(const __attribute__((address_space(3))) bf16x8*)(kp+512);
  kf[2]=*(const __attribute__((address_space(3))) bf16x8*)(kp+2048); kf[3]=*(const __attribute__((address_space(3))) bf16x8*)(kp+2560);
  kf[4]=*(const __attribute__((address_space(3))) bf16x8*)(kp+4096); kf[5]=*(const __attribute__((address_space(3))) bf16x8*)(kp+4608);
  kf[6]=*(const __attribute__((address_space(3))) bf16x8*)(kp+6144); kf[7]=*(const __attribute__((address_space(3))) bf16x8*)(kp+6656);
}
__device__ __forceinline__ void kload2(bf16x8*kf,lds_cptr kp,int j){ kf[2*j]=*(const __attribute__((address_space(3))) bf16x8*)(kp+j*2048); kf[2*j+1]=*(const __attribute__((address_space(3))) bf16x8*)(kp+j*2048+512); }
__device__ __forceinline__ s16x4 vtr(lds_cptr p){ return __builtin_bit_cast(s16x4,__builtin_amdgcn_ds_read_tr16_b64_v4i16((__attribute__((address_space(3))) v4i16_t*)p)); }
__device__ __forceinline__ float rowmax(const f32x16&p0,const f32x16&p1){
  float a=max3f(p0[0],p0[1],p1[0]),b=max3f(p0[2],p0[3],p1[1]);a=max3f(a,p1[2],p1[3]);
  #pragma unroll
  for(int r=4;r<16;r+=4){a=max3f(a,p0[r],p0[r+1]);b=max3f(b,p0[r+2],p0[r+3]);a=max3f(a,p1[r],p1[r+1]);b=max3f(b,p1[r+2],p1[r+3]);}
  const float m=max2f(a,b);
  auto rr=__builtin_amdgcn_permlane32_swap(__float_as_uint(m),__float_as_uint(m),false,false);
  return max2f(__uint_as_float(rr[0]),__uint_as_float(rr[1]));
}
__device__ __forceinline__ void pv(f32x16*o,int vb,bf16x8 pa0,bf16x8 pa1,bf16x8 pa2,bf16x8 pa3){
  #pragma unroll
  for(int d0=0;d0<2;++d0){s16x4 lo[4],hi[4];
    #pragma unroll
    for(int ks=0;ks<4;++ks){
      asm volatile("ds_read_b64_tr_b16 %0,%1 offset:%c2":"=&v"(lo[ks]):"v"(vb),"i"(d0*4096+ks*1024):"memory");
      asm volatile("ds_read_b64_tr_b16 %0,%1 offset:%c2":"=&v"(hi[ks]):"v"(vb),"i"(d0*4096+ks*1024+512):"memory");}
    asm volatile("s_waitcnt lgkmcnt(0)":::"memory");SBAR();
    #define PK(k) (bf16x8){lo[k][0],lo[k][1],lo[k][2],lo[k][3],hi[k][0],hi[k][1],hi[k][2],hi[k][3]}
    o[d0]=__builtin_amdgcn_mfma_f32_32x32x16_bf16(pa0,PK(0),o[d0],0,0,0);
    o[d0]=__builtin_amdgcn_mfma_f32_32x32x16_bf16(pa1,PK(1),o[d0],0,0,0);
    o[d0]=__builtin_amdgcn_mfma_f32_32x32x16_bf16(pa2,PK(2),o[d0],0,0,0);
    o[d0]=__builtin_amdgcn_mfma_f32_32x32x16_bf16(pa3,PK(3),o[d0],0,0,0);
    #undef PK
  }
}

#ifndef ATTN_STORE16
#define ATTN_STORE16(p,v) (*(u32x4*)(p)=(v))
#endif
template<int THRL> __device__ __forceinline__ void attn_unit(int b,int qcol,int kcol,int vcol,int ocol,int qb,const bf16*Q,const bf16*__restrict__ K,const bf16*__restrict__ V,bf16*O,char*shm){
  int tid_=threadIdx.x; asm volatile("":"+v"(tid_));
  const int tid=tid_,lane=tid&63,r32=lane&31,hi=lane>>5; const int wid=__builtin_amdgcn_readfirstlane(tid>>6);
  const long rowbase=(long)b*SEQ; const int q0=qb*QB;
  const bf16*Qw=Q+(rowbase+q0+wid*QBLK)*QP+qcol;
  const bf16*Kh=K+rowbase*KP+kcol,*Vh=V+rowbase*VP+vcol;
  const unsigned lds0=(unsigned)(uintptr_t)shm;
  float*wsf=(float*)(shm+LDS_WS)+wid*64;
  const bf16*ksrc=Kh+(long)lane*KP+wid*8;
  const bf16*vsrc=Vh+(long)(16*(wid&3)+(lane>>2))*VP+(wid>>2)*32+(lane&3)*8;
  const unsigned kdst=lds0+LDS_K+wid*1024, vdst=lds0+LDS_V+wid*1024;
  #define DMA_K(t,slot) glds16(ksrc+(long)(t)*KVBLK*KP,(unsigned)__builtin_amdgcn_readfirstlane(kdst+(slot)))
  #define DMA_V(t,slot) glds16(vsrc+(long)(t)*KVBLK*VP,(unsigned)__builtin_amdgcn_readfirstlane(vdst+(slot)))
  const int vb0=(int)(lds0+LDS_V)+((lane>>4)&1)*32+(lane&3)*8+(4*hi+((lane&15)>>2))*64;
  const char*Kbase=shm+LDS_K; bf16x8 kf[8];
  const lds_cptr shm3=(lds_cptr)shm; const lds_cptr kp0=shm3+LDS_K+hi*1024+r32*16; const lds_cptr vp0=shm3+LDS_V+((lane>>4)&1)*32+(lane&3)*8+(4*hi+((lane&15)>>2))*64;
  const int NT=(q0+QB)/KVBLK;
  DMA_K(0,0);DMA_V(0,0);DMA_K(1,SLOTB);
  bf16x8 qr[4];
  #pragma unroll
  for(int d0=0;d0<4;++d0)qr[d0]=*reinterpret_cast<const bf16x8*>(&Qw[(long)r32*QP+d0*16+hi*8]);
  float mhat=0.f,l_reg=0.f;f32x16 o[2];o[0]=f32x16{};o[1]=f32x16{};f32x16 negm=f32x16{};asm volatile("":"+v"(negm));
  const int qrel=wid>>1;
  #define CMASK(P0,P1,t) do{int jb_=(t)-(NT-4); if(jb_>=0)cmask(P0,P1,jb_,qrel,hi);}while(0)
  bool resc=false;
  #define START(P0,P1) do{ const float rm=rowmax(P0,P1); resc=false; \
    { const float dl=rm; mhat=fadd_s(mhat,dl); \
      _Pragma("unroll") for(int r=0;r<16;++r){P0[r]=fsub_s(P0[r],dl);P1[r]=fsub_s(P1[r],dl);} \
      _Pragma("unroll") for(int r=0;r<16;++r)negm[r]=-mhat; asm volatile("":"+v"(negm)); } \
    _Pragma("unroll") for(int r=0;r<16;++r)P0[r]=__builtin_amdgcn_exp2f(P0[r]); }while(0)
  #define RESC() do{ if(resc){ asm volatile("s_waitcnt lgkmcnt(0)":::"memory"); \
      _Pragma("unroll") for(int d_=0;d_<2;++d_) _Pragma("unroll") for(int r=0;r<16;++r)o[d_][r]*=wsf[crow(r,hi)]; } }while(0)
  f32x16 pA0,pA1,pB0,pB1;
  int sl_prev=0,sl_cur=0,sl_next=SLOTB;
  #define ROT() do{sl_prev=sl_cur;sl_cur=sl_next;sl_next=(sl_next==(NSLOT-1)*SLOTB)?0:sl_next+SLOTB;}while(0)
  DMA_K(2,2*SLOTB);
  WAIT_BAR(3);
  qkt(pA0,pA1,Kbase,qr,negm,r32,hi);asm volatile("s_nop 15\n\ts_nop 7":"+v"(pA0),"+v"(pA1));CMASK(pA0,pA1,0);
  START(pA0,pA1);
  _Pragma("unroll") for(int r=0;r<16;++r)pA1[r]=__builtin_amdgcn_exp2f(pA1[r]);
  WAIT_BAR(0);
  DMA_K(3,0);DMA_V(1,SLOTB);
  ROT();
  kload8(kf,kp0+sl_cur);
  WAIT_BAR(2);
  s16x4 vlo[8],vhi[8]; u32x4 pw0,pw1,pw2,pw3;
  #define PKW(P,B) cvtpk_s(P[B],P[B+1])
  #define PAF(k) __builtin_bit_cast(bf16x8,pw##k)
  #define VFR(i) (bf16x8){vlo[i][0],vlo[i][1],vlo[i][2],vlo[i][3],vhi[i][0],vhi[i][1],vhi[i][2],vhi[i][3]}
  #define PIN(x) asm volatile("":"+v"(x))
  #define MX3(a,b,c) __builtin_fmaxf(__builtin_fmaxf((a),(b)),(c))
  #define GAPA(MF,A0,A1,A2,A3,W0,W1,PW) do{ MF; sacc+=A0; sacc+=A1; sacc+=A2; sacc+=A3; PIN(sacc); W0; W1; PIN(PW); SBAR(); }while(0)
  #define EX(v) __builtin_amdgcn_exp2f(v)
  #define GAPB(MF,X,B) do{ MF; X[B]=EX(X[B]); X[B+1]=EX(X[B+1]); X[B+2]=EX(X[B+2]); X[B+3]=EX(X[B+3]); PIN(X); SBAR(); }while(0)
  #define VRD(i) do{ vlo[i]=vtr(vp_+(((i)>>2)*4096+((i)&3)*1024)); vhi[i]=vtr(vp_+(((i)>>2)*4096+((i)&3)*1024+512)); }while(0)
  #define KRD(G,j) do{ if(G){ kload2(kf,kp0+sl_next,j); SBAR(); } }while(0)
  #define STEP(C0,C1,P0,P1,t,GK,GV,GL) do{ SBAR(); \
    const lds_cptr vp_=vp0+sl_prev; \
    VRD(0); SBAR(); float sacc=(P0[0]+P0[1]); \
    GAPA(C0=__builtin_amdgcn_mfma_f32_32x32x16_bf16(kf[0],qr[0],negm,0,0,0), P0[2],P0[3],P0[4],P0[5],     pw0[0]=PKW(P0,0), pw0[1]=PKW(P0,2), pw0); \
    VRD(4); SBAR(); GAPA(C1=__builtin_amdgcn_mfma_f32_32x32x16_bf16(kf[1],qr[0],negm,0,0,0), P0[6],P0[7],P0[8],P0[9],     pw0[2]=PKW(P0,4), pw0[3]=PKW(P0,6), pw0); \
    VRD(1); SBAR(); GAPA(C0=__builtin_amdgcn_mfma_f32_32x32x16_bf16(kf[2],qr[1],C0,0,0,0),   P0[10],P0[11],P0[12],P0[13], pw1[0]=PKW(P0,8), pw1[1]=PKW(P0,10), pw1); \
    VRD(5); SBAR(); GAPA(C1=__builtin_amdgcn_mfma_f32_32x32x16_bf16(kf[3],qr[1],C1,0,0,0),   P0[14],P0[15],P1[0],P1[1],   pw1[2]=PKW(P0,12),pw1[3]=PKW(P0,14), pw1); \
    VRD(2); SBAR(); GAPA(C0=__builtin_amdgcn_mfma_f32_32x32x16_bf16(kf[4],qr[2],C0,0,0,0),   P1[2],P1[3],P1[4],P1[5],     pw2[0]=PKW(P1,0), pw2[1]=PKW(P1,2), pw2); \
    VRD(6); SBAR(); GAPA(C1=__builtin_amdgcn_mfma_f32_32x32x16_bf16(kf[5],qr[2],C1,0,0,0),   P1[6],P1[7],P1[8],P1[9],     pw2[2]=PKW(P1,4), pw2[3]=PKW(P1,6), pw2); \
    VRD(3); SBAR(); GAPA(C0=__builtin_amdgcn_mfma_f32_32x32x16_bf16(kf[6],qr[3],C0,0,0,0),   P1[10],P1[11],P1[12],P1[13], pw3[0]=PKW(P1,8), pw3[1]=PKW(P1,10), pw3); \
    VRD(7); SBAR(); GAPA(C1=__builtin_amdgcn_mfma_f32_32x32x16_bf16(kf[7],qr[3],C1,0,0,0),   P1[14],P1[15],0.f,0.f,       pw3[2]=PKW(P1,12),pw3[3]=PKW(P1,14), pw3); \
    l_reg+=sacc; \
    if(GK){DMA_K((t)+3,sl_cur);} if(GV){DMA_V((t)+1,sl_next);} \
    CMASK(C0,C1,t); \
    { float a=MX3(C0[0],C0[1],C1[0]),b=MX3(C0[2],C0[3],C1[1]); a=MX3(a,C1[2],C1[3]); \
      _Pragma("unroll") for(int r=4;r<16;r+=4){a=MX3(a,C0[r],C0[r+1]);b=MX3(b,C0[r+2],C0[r+3]);a=MX3(a,C1[r],C1[r+1]);b=MX3(b,C1[r+2],C1[r+3]);} \
      float rm=__builtin_fmaxf(a,b); { auto rr=__builtin_amdgcn_permlane32_swap(__float_as_uint(rm),__float_as_uint(rm),false,false); rm=__builtin_fmaxf(__uint_as_float(rr[0]),__uint_as_float(rr[1])); } \
      resc=false; \
      if(__builtin_expect(__any(rm>(float)THRL),0)){ const float dl=__builtin_fmaxf(rm,0.f); mhat+=dl; \
        _Pragma("unroll") for(int r=0;r<16;++r){C0[r]-=dl;C1[r]-=dl;} \
        _Pragma("unroll") for(int r=0;r<16;++r)negm[r]=-mhat; asm volatile("":"+v"(negm)); \
        const float f=__builtin_amdgcn_exp2f(-dl); l_reg*=f; if(hi==0)wsf[r32]=f; resc=true; } } \
    SBAR(); \
    GAPB(o[0]=__builtin_amdgcn_mfma_f32_32x32x16_bf16(PAF(0),VFR(0),o[0],0,0,0), C0,0); \
    GAPB(o[1]=__builtin_amdgcn_mfma_f32_32x32x16_bf16(PAF(0),VFR(4),o[1],0,0,0), C0,4); \
    KRD(GL,0); GAPB(o[0]=__builtin_amdgcn_mfma_f32_32x32x16_bf16(PAF(1),VFR(1),o[0],0,0,0), C0,8); \
    KRD(GL,1); GAPB(o[1]=__builtin_amdgcn_mfma_f32_32x32x16_bf16(PAF(1),VFR(5),o[1],0,0,0), C0,12); \
    KRD(GL,2); GAPB(o[0]=__builtin_amdgcn_mfma_f32_32x32x16_bf16(PAF(2),VFR(2),o[0],0,0,0), C1,0); \
    KRD(GL,3); GAPB(o[1]=__builtin_amdgcn_mfma_f32_32x32x16_bf16(PAF(2),VFR(6),o[1],0,0,0), C1,4); \
    GAPB(o[0]=__builtin_amdgcn_mfma_f32_32x32x16_bf16(PAF(3),VFR(3),o[0],0,0,0), C1,8); \
    GAPB(o[1]=__builtin_amdgcn_mfma_f32_32x32x16_bf16(PAF(3),VFR(7),o[1],0,0,0), C1,12); \
    }while(0)
  int t=1;
  #undef CMASK
  #define CMASK(P0,P1,t) do{}while(0)
  for(;t+5<NT;t+=2){
    STEP(pB0,pB1,pA0,pA1,t,true,true,true);     WAIT_BAR(2); RESC(); ROT();
    STEP(pA0,pA1,pB0,pB1,t+1,true,true,true);   WAIT_BAR(2); RESC(); ROT();
  }
  #undef CMASK
  #define CMASK(P0,P1,t) do{int jb_=(t)-(NT-4); if(jb_>=0)cmask(P0,P1,jb_,qrel,hi);}while(0)
  #define ENDW(tt) do{ if((tt)+3<NT){WAIT_BAR(2);} else if((tt)+2<NT){WAIT_BAR(1);} else {WAIT_BAR(0);} }while(0)
  for(;t+1<NT;t+=2){
    STEP(pB0,pB1,pA0,pA1,t,(t+3<NT),(t+1<NT),(t+1<NT));       ENDW(t);   RESC(); ROT();
    STEP(pA0,pA1,pB0,pB1,t+1,(t+4<NT),(t+2<NT),(t+2<NT));     ENDW(t+1); RESC(); ROT();
  }
  STEP(pB0,pB1,pA0,pA1,NT-1,false,false,false); RESC();
  { float sacc=pB0[0]+pB0[1]; _Pragma("unroll") for(int r=2;r<16;++r)sacc+=pB0[r]; _Pragma("unroll") for(int r=0;r<16;++r)sacc+=pB1[r]; l_reg+=sacc;
    pw0=(u32x4){PKW(pB0,0),PKW(pB0,2),PKW(pB0,4),PKW(pB0,6)};pw1=(u32x4){PKW(pB0,8),PKW(pB0,10),PKW(pB0,12),PKW(pB0,14)};pw2=(u32x4){PKW(pB1,0),PKW(pB1,2),PKW(pB1,4),PKW(pB1,6)};pw3=(u32x4){PKW(pB1,8),PKW(pB1,10),PKW(pB1,12),PKW(pB1,14)};
    SBAR(); pv(o,vb0+sl_cur,PAF(0),PAF(1),PAF(2),PAF(3)); }
  #undef PKW
  #undef PAF
  #undef VFR
  #undef PIN
  #undef MX3
  #undef GAPA
  #undef GAPB
  #undef EX
  #undef VRD
  #undef KRD
  #undef STEP
  #undef ENDW
  {auto rr=__builtin_amdgcn_permlane32_swap(__float_as_uint(l_reg),__float_as_uint(l_reg),false,false);l_reg=__uint_as_float(rr[0])+__uint_as_float(rr[1]);}
  if(hi==0)wsf[32+r32]=l_reg;asm volatile("s_waitcnt lgkmcnt(0)":::"memory");
  float rli[16];
  #pragma unroll
  for(int r=0;r<16;++r)rli[r]=__builtin_amdgcn_rcpf(wsf[32+crow(r,hi)]);
  bf16*Ow=O+(rowbase+q0+wid*QBLK)*OP+ocol;
  { bf16*stg=(bf16*)(shm+LDS_OST)+wid*2048;
    #pragma unroll
    for(int r=0;r<16;++r){const int orow=crow(r,hi);
      #pragma unroll
      for(int d0=0;d0<2;++d0)stg[orow*64+d0*32+r32]=__float2bfloat16(o[d0][r]*rli[r]);}
    asm volatile("s_waitcnt lgkmcnt(0)":::"memory");
    #pragma unroll
    for(int i=0;i<4;++i){const int row=i*8+(lane>>3),ch=lane&7; const u32x4 v=*(const u32x4*)(stg+row*64+ch*8); ATTN_STORE16(Ow+(long)row*OP+ch*8,v);} }
  asm volatile("s_waitcnt lgkmcnt(0)\n\ts_barrier":::"memory");
  #undef DMA_K
  #undef DMA_V
  #undef CMASK
  #undef START
  #undef RESC
  #undef ROT
}
constexpr int LDS3_V=4*SLOTB, LDS3_WS=LDS3_V+4*2*SLOTB, LDS3_OST=LDS3_WS+NW*64*4, LDS3_BYTES=LDS3_OST+NW*4096;
constexpr int LDS2_V=NSLOT*SLOTB, LDS2_WS=LDS2_V+NSLOT*2*SLOTB, LDS2_OST=LDS2_WS+NW*64*4, LDS2_BYTES=LDS2_OST+NW*8192;
#ifndef ATTN_STORE16
#define ATTN_STORE16(p,v) (*(u32x4*)(p)=(v))
#endif
template<int THRL> __device__ __forceinline__ void attn_unit128(int b,int qcol,int kcol,int vcol,int ocol,int qb,const bf16*Q,const bf16*__restrict__ K,const bf16*__restrict__ V,bf16*O,char*shm){
  int tid_=threadIdx.x; asm volatile("":"+v"(tid_));
  const int tid=tid_,lane=tid&63,r32=lane&31,hi=lane>>5; const int wid=__builtin_amdgcn_readfirstlane(tid>>6);
  const long rowbase=(long)b*SEQ; const int q0=qb*QB;
  const bf16*Qw=Q+(rowbase+q0+wid*QBLK)*QP+qcol;
  const bf16*Kh=K+rowbase*KP+kcol,*Vh=V+rowbase*VP+vcol;
  const unsigned lds0=(unsigned)(uintptr_t)shm;
  float*wsf=(float*)(shm+LDS3_WS)+wid*64;
  const bf16*ksrc=Kh+(long)lane*KP+wid*8;
  const bf16*vsrc=Vh+(long)(16*(wid&3)+(lane>>2))*VP+(wid>>2)*32+(lane&3)*8;
  const unsigned kdst=lds0+LDS_K+wid*1024, vdst=lds0+LDS3_V+wid*1024;
  #define DMA_K(t,slot) glds16(ksrc+(long)(t)*KVBLK*KP,(unsigned)__builtin_amdgcn_readfirstlane(kdst+(slot)))
  #define DMA_V(t,slot) do{ glds16(vsrc+(long)(t)*KVBLK*VP,(unsigned)__builtin_amdgcn_readfirstlane(vdst+2*(slot))); glds16(vsrc+(long)(t)*KVBLK*VP+64,(unsigned)__builtin_amdgcn_readfirstlane(vdst+2*(slot)+8192)); }while(0)
  const int vb0=(int)(lds0+LDS3_V)+((lane>>4)&1)*32+(lane&3)*8+(4*hi+((lane&15)>>2))*64;
  const char*Kbase=shm+LDS_K; bf16x8 kf[8];
  const lds_cptr shm3=(lds_cptr)shm; const lds_cptr kp0=shm3+LDS_K+hi*1024+r32*16; const lds_cptr vp0=shm3+LDS3_V+((lane>>4)&1)*32+(lane&3)*8+(4*hi+((lane&15)>>2))*64;
  const int NT=(q0+QB)/KVBLK;
  DMA_K(0,0);DMA_V(0,0);DMA_K(1,SLOTB);
  bf16x8 qr[4];
  #pragma unroll
  for(int d0=0;d0<4;++d0)qr[d0]=__builtin_nontemporal_load(reinterpret_cast<const bf16x8*>(&Qw[(long)r32*QP+d0*16+hi*8]));
  float mhat=0.f,l_reg=0.f;f32x16 o[4];o[0]=f32x16{};o[1]=f32x16{};o[2]=f32x16{};o[3]=f32x16{};f32x16 negm=f32x16{};asm volatile("":"+v"(negm));
  const int qrel=wid>>1;
  #define CMASK(P0,P1,t) do{int jb_=(t)-(NT-4); if(jb_>=0)cmask(P0,P1,jb_,qrel,hi);}while(0)
  bool resc=false;
  #define START(P0,P1) do{ const float rm=rowmax(P0,P1); resc=false; \
    { const float dl=rm; mhat=fadd_s(mhat,dl); \
      _Pragma("unroll") for(int r=0;r<16;++r){P0[r]=fsub_s(P0[r],dl);P1[r]=fsub_s(P1[r],dl);} \
      _Pragma("unroll") for(int r=0;r<16;++r)negm[r]=-mhat; asm volatile("":"+v"(negm)); } \
    _Pragma("unroll") for(int r=0;r<16;++r)P0[r]=__builtin_amdgcn_exp2f(P0[r]); }while(0)
  #define RESC() do{ if(resc){ asm volatile("s_waitcnt lgkmcnt(0)":::"memory"); \
      _Pragma("unroll") for(int d_=0;d_<4;++d_) _Pragma("unroll") for(int r=0;r<16;++r)o[d_][r]*=wsf[crow(r,hi)]; } }while(0)
  f32x16 pA0,pA1,pB0,pB1;
  int sl_prev=0,sl_cur=SLOTB,sl_next=2*SLOTB,sl_next2=3*SLOTB;
  #define ROT() do{sl_prev=sl_cur;sl_cur=sl_next;sl_next=sl_next2;sl_next2=(sl_next2+SLOTB)&(4*SLOTB-1);}while(0)
  DMA_K(2,2*SLOTB);DMA_V(1,SLOTB);DMA_K(3,3*SLOTB);
  WAIT_BAR(7);
  qkt(pA0,pA1,Kbase,qr,negm,r32,hi);asm volatile("s_nop 15\n\ts_nop 7":"+v"(pA0),"+v"(pA1));CMASK(pA0,pA1,0);
  START(pA0,pA1);
  _Pragma("unroll") for(int r=0;r<16;++r)pA1[r]=__builtin_amdgcn_exp2f(pA1[r]);
  WAIT_BAR(4);
  if(NT>4){DMA_K(4,0);} DMA_V(2,2*SLOTB);
  kload8(kf,kp0+sl_cur);
  if(NT>4){WAIT_BAR(6);}else{WAIT_BAR(5);}
  s16x4 vlo[4],vhi[4]; u32x4 pw0,pw1,pw2,pw3;
  #define PKW(P,B) cvtpk_s(P[B],P[B+1])
  #define PAF(k) __builtin_bit_cast(bf16x8,pw##k)
  #define VFR(i) (bf16x8){vlo[i][0],vlo[i][1],vlo[i][2],vlo[i][3],vhi[i][0],vhi[i][1],vhi[i][2],vhi[i][3]}
  #define PIN(x) asm volatile("":"+v"(x))
  #define MX3(a,b,c) __builtin_fmaxf(__builtin_fmaxf((a),(b)),(c))
  #define GAPA(MF,A0,A1,A2,A3,W0,W1,PW) do{ MF; sacc+=A0; sacc+=A1; sacc+=A2; sacc+=A3; PIN(sacc); W0; W1; PIN(PW); SBAR(); }while(0)
  #define EX(v) __builtin_amdgcn_exp2f(v)
  #define GAPB(MF,X,B) do{ MF; X[B]=EX(X[B]); X[B+1]=EX(X[B+1]); PIN(X); SBAR(); }while(0)
  #define GAPBV(MF,RD,X,B) do{ MF; RD; X[B]=EX(X[B]); X[B+1]=EX(X[B+1]); PIN(X); SBAR(); }while(0)
  #define VRD(j,d,k) do{ vlo[(j)&3]=vtr(vp_+((d)*4096+(k)*1024)); vhi[(j)&3]=vtr(vp_+((d)*4096+(k)*1024+512)); }while(0)
  #define KRD(G,j) do{ if(G){ kload2(kf,kp0+sl_next,j); SBAR(); } }while(0)
  #define STEP(C0,C1,P0,P1,t,GK,GV,GL) do{ SBAR(); \
    const lds_cptr vp_=vp0+2*sl_prev; \
    float sacc=(P0[0]+P0[1]); \
    GAPA(C0=__builtin_amdgcn_mfma_f32_32x32x16_bf16(kf[0],qr[0],negm,0,0,0), P0[2],P0[3],P0[4],P0[5],     pw0[0]=PKW(P0,0), pw0[1]=PKW(P0,2), pw0); \
    GAPA(C1=__builtin_amdgcn_mfma_f32_32x32x16_bf16(kf[1],qr[0],negm,0,0,0), P0[6],P0[7],P0[8],P0[9],     pw0[2]=PKW(P0,4), pw0[3]=PKW(P0,6), pw0); \
    GAPA(C0=__builtin_amdgcn_mfma_f32_32x32x16_bf16(kf[2],qr[1],C0,0,0,0),   P0[10],P0[11],P0[12],P0[13], pw1[0]=PKW(P0,8), pw1[1]=PKW(P0,10), pw1); \
    GAPA(C1=__builtin_amdgcn_mfma_f32_32x32x16_bf16(kf[3],qr[1],C1,0,0,0),   P0[14],P0[15],P1[0],P1[1],   pw1[2]=PKW(P0,12),pw1[3]=PKW(P0,14), pw1); \
    VRD(0,0,0); SBAR(); GAPA(C0=__builtin_amdgcn_mfma_f32_32x32x16_bf16(kf[4],qr[2],C0,0,0,0),   P1[2],P1[3],P1[4],P1[5],     pw2[0]=PKW(P1,0), pw2[1]=PKW(P1,2), pw2); \
    VRD(1,1,0); SBAR(); GAPA(C1=__builtin_amdgcn_mfma_f32_32x32x16_bf16(kf[5],qr[2],C1,0,0,0),   P1[6],P1[7],P1[8],P1[9],     pw2[2]=PKW(P1,4), pw2[3]=PKW(P1,6), pw2); \
    VRD(2,0,1); SBAR(); GAPA(C0=__builtin_amdgcn_mfma_f32_32x32x16_bf16(kf[6],qr[3],C0,0,0,0),   P1[10],P1[11],P1[12],P1[13], pw3[0]=PKW(P1,8), pw3[1]=PKW(P1,10), pw3); \
    VRD(3,1,1); SBAR(); GAPA(C1=__builtin_amdgcn_mfma_f32_32x32x16_bf16(kf[7],qr[3],C1,0,0,0),   P1[14],P1[15],0.f,0.f,       pw3[2]=PKW(P1,12),pw3[3]=PKW(P1,14), pw3); \
    l_reg+=sacc; \
    if(GK){DMA_K((t)+4,sl_cur);} if(GV){DMA_V((t)+2,sl_next2);} \
    CMASK(C0,C1,t); \
    { float a=MX3(C0[0],C0[1],C1[0]),b=MX3(C0[2],C0[3],C1[1]); a=MX3(a,C1[2],C1[3]); \
      _Pragma("unroll") for(int r=4;r<16;r+=4){a=MX3(a,C0[r],C0[r+1]);b=MX3(b,C0[r+2],C0[r+3]);a=MX3(a,C1[r],C1[r+1]);b=MX3(b,C1[r+2],C1[r+3]);} \
      float rm=__builtin_fmaxf(a,b); { auto rr=__builtin_amdgcn_permlane32_swap(__float_as_uint(rm),__float_as_uint(rm),false,false); rm=__builtin_fmaxf(__uint_as_float(rr[0]),__uint_as_float(rr[1])); } \
      resc=false; \
      if(__builtin_expect(__any(rm>(float)THRL),0)){ const float dl=__builtin_fmaxf(rm,0.f); mhat+=dl; \
        _Pragma("unroll") for(int r=0;r<16;++r){C0[r]-=dl;C1[r]-=dl;} \
        _Pragma("unroll") for(int r=0;r<16;++r)negm[r]=-mhat; asm volatile("":"+v"(negm)); \
        const float f=__builtin_amdgcn_exp2f(-dl); l_reg*=f; if(hi==0)wsf[r32]=f; resc=true; } } \
    SBAR(); \
    GAPBV(o[0]=__builtin_amdgcn_mfma_f32_32x32x16_bf16(PAF(0),VFR(0),o[0],0,0,0), VRD(4,0,2), C0,0); \
    GAPBV(o[1]=__builtin_amdgcn_mfma_f32_32x32x16_bf16(PAF(0),VFR(1),o[1],0,0,0), VRD(5,1,2), C0,2); \
    KRD(GL,0); GAPBV(o[0]=__builtin_amdgcn_mfma_f32_32x32x16_bf16(PAF(1),VFR(2),o[0],0,0,0), VRD(6,0,3), C0,4); \
    KRD(GL,1); GAPBV(o[1]=__builtin_amdgcn_mfma_f32_32x32x16_bf16(PAF(1),VFR(3),o[1],0,0,0), VRD(7,1,3), C0,6); \
    KRD(GL,2); GAPBV(o[0]=__builtin_amdgcn_mfma_f32_32x32x16_bf16(PAF(2),VFR(0),o[0],0,0,0), VRD(8,2,0), C0,8); \
    KRD(GL,3); GAPBV(o[1]=__builtin_amdgcn_mfma_f32_32x32x16_bf16(PAF(2),VFR(1),o[1],0,0,0), VRD(9,3,0), C0,10); \
    GAPBV(o[0]=__builtin_amdgcn_mfma_f32_32x32x16_bf16(PAF(3),VFR(2),o[0],0,0,0), VRD(10,2,1), C0,12); \
    GAPBV(o[1]=__builtin_amdgcn_mfma_f32_32x32x16_bf16(PAF(3),VFR(3),o[1],0,0,0), VRD(11,3,1), C0,14); \
    GAPBV(o[2]=__builtin_amdgcn_mfma_f32_32x32x16_bf16(PAF(0),VFR(0),o[2],0,0,0), VRD(12,2,2), C1,0); \
    GAPBV(o[3]=__builtin_amdgcn_mfma_f32_32x32x16_bf16(PAF(0),VFR(1),o[3],0,0,0), VRD(13,3,2), C1,2); \
    GAPBV(o[2]=__builtin_amdgcn_mfma_f32_32x32x16_bf16(PAF(1),VFR(2),o[2],0,0,0), VRD(14,2,3), C1,4); \
    GAPBV(o[3]=__builtin_amdgcn_mfma_f32_32x32x16_bf16(PAF(1),VFR(3),o[3],0,0,0), VRD(15,3,3), C1,6); \
    GAPB(o[2]=__builtin_amdgcn_mfma_f32_32x32x16_bf16(PAF(2),VFR(0),o[2],0,0,0), C1,8); \
    GAPB(o[3]=__builtin_amdgcn_mfma_f32_32x32x16_bf16(PAF(2),VFR(1),o[3],0,0,0), C1,10); \
    GAPB(o[2]=__builtin_amdgcn_mfma_f32_32x32x16_bf16(PAF(3),VFR(2),o[2],0,0,0), C1,12); \
    GAPB(o[3]=__builtin_amdgcn_mfma_f32_32x32x16_bf16(PAF(3),VFR(3),o[3],0,0,0), C1,14); \
    }while(0)
  int t=1;
  #undef CMASK
  #define CMASK(P0,P1,t) do{}while(0)
  for(;t+5<NT;t+=2){
    STEP(pB0,pB1,pA0,pA1,t,true,true,true);     WAIT_BAR(6); RESC(); ROT();
    STEP(pA0,pA1,pB0,pB1,t+1,true,true,true);   WAIT_BAR(6); RESC(); ROT();
  }
  #undef CMASK
  #define CMASK(P0,P1,t) do{int jb_=(t)-(NT-4); if(jb_>=0)cmask(P0,P1,jb_,qrel,hi);}while(0)
  #define ENDW(tt) do{ const int d_=NT-(tt); if(d_>=5){WAIT_BAR(6);} else if(d_==4){WAIT_BAR(5);} else if(d_==3){WAIT_BAR(4);} else {WAIT_BAR(0);} }while(0)
  for(;t+1<NT;t+=2){
    STEP(pB0,pB1,pA0,pA1,t,(t+4<NT),(t+2<NT),(t+1<NT));       ENDW(t);   RESC(); ROT();
    STEP(pA0,pA1,pB0,pB1,t+1,(t+5<NT),(t+3<NT),(t+2<NT));     ENDW(t+1); RESC(); ROT();
  }
  STEP(pB0,pB1,pA0,pA1,NT-1,false,false,false); RESC();
  { float sacc=pB0[0]+pB0[1]; _Pragma("unroll") for(int r=2;r<16;++r)sacc+=pB0[r]; _Pragma("unroll") for(int r=0;r<16;++r)sacc+=pB1[r]; l_reg+=sacc;
    pw0=(u32x4){PKW(pB0,0),PKW(pB0,2),PKW(pB0,4),PKW(pB0,6)};pw1=(u32x4){PKW(pB0,8),PKW(pB0,10),PKW(pB0,12),PKW(pB0,14)};pw2=(u32x4){PKW(pB1,0),PKW(pB1,2),PKW(pB1,4),PKW(pB1,6)};pw3=(u32x4){PKW(pB1,8),PKW(pB1,10),PKW(pB1,12),PKW(pB1,14)};
    SBAR(); pv(o,vb0+2*sl_cur,PAF(0),PAF(1),PAF(2),PAF(3)); pv(o+2,vb0+2*sl_cur+8192,PAF(0),PAF(1),PAF(2),PAF(3)); }
  #undef PKW
  #undef PAF
  #undef VFR
  #undef PIN
  #undef MX3
  #undef GAPA
  #undef GAPB
  #undef GAPBV
  #undef EX
  #undef VRD
  #undef KRD
  #undef STEP
  #undef ENDW
  {auto rr=__builtin_amdgcn_permlane32_swap(__float_as_uint(l_reg),__float_as_uint(l_reg),false,false);l_reg=__uint_as_float(rr[0])+__uint_as_float(rr[1]);}
  if(hi==0)wsf[32+r32]=l_reg;asm volatile("s_waitcnt lgkmcnt(0)":::"memory");
  float rli[16];
  #pragma unroll
  for(int r=0;r<16;++r)rli[r]=__builtin_amdgcn_rcpf(wsf[32+crow(r,hi)]);
  bf16*Ow=O+(rowbase+q0+wid*QBLK)*OP+ocol;
  { bf16*stg=(bf16*)(shm+LDS3_OST)+wid*2048;
    #pragma unroll
    for(int hc=0;hc<2;++hc){
      #pragma unroll
      for(int r=0;r<16;++r){const int orow=crow(r,hi);
        #pragma unroll
        for(int d0=0;d0<2;++d0)stg[orow*64+d0*32+r32]=__float2bfloat16(o[2*hc+d0][r]*rli[r]);}
      asm volatile("s_waitcnt lgkmcnt(0)":::"memory");
      #pragma unroll
      for(int i=0;i<4;++i){const int row=i*8+(lane>>3),ch=lane&7; const u32x4 v=*(const u32x4*)(stg+row*64+ch*8); __builtin_nontemporal_store(v,(u32x4*)(Ow+(long)row*OP+hc*64+ch*8));}
      asm volatile("s_waitcnt lgkmcnt(0)":::"memory"); } }
  asm volatile("s_waitcnt lgkmcnt(0)\n\ts_barrier":::"memory");
  #undef DMA_K
  #undef DMA_V
  #undef CMASK
  #undef START
  #undef RESC
  #undef ROT
}
constexpr int ATTN_LDS_BYTES=LDS_BYTES;
struct AttnTensors { const bf16* Q; const bf16* K; const bf16* V; bf16* O; };
struct AttnUnit { int bvh; int qb; };
struct StaticOrder {
  int ai,nA;
  __device__ __forceinline__ StaticOrder(int ai_,int nA_):ai(ai_),nA(nA_){}
  __device__ __forceinline__ bool next(int i,AttnUnit&u)const{
    if(nA==128){ if(i>=8)return false; u.bvh=ai; u.qb=7-i; return true; }
    if(i>=4)return false; const int s=ai&1; u.bvh=ai>>1; u.qb=(i==0)?7-s:(i==1)?4+s:(i==2)?3-s:s; return true; }
  __device__ __forceinline__ void a_ready(const AttnUnit&)const{}
  __device__ __forceinline__ void done(const AttnUnit&)const{}
};
template<class Sched,int THRL=8> __device__ __forceinline__ void attn_phase(char*lds,const AttnTensors&T,const Sched&S){
  AttnUnit u;
  for(int i=0;S.next(i,u);++i){ S.a_ready(u); const int b=u.bvh>>4,vh=u.bvh&15,s=vh>>1,half=vh&1;
    attn_unit<THRL>(b,s*64,s*64,(s>>1)*128+half*64,s*128+half*64,u.qb,T.Q,T.K,T.V,T.O,lds); S.done(u); }
}
template<int THRL=8> __device__ __forceinline__ void attn_phase_queue(char*lds,const AttnTensors&T,unsigned*counter,volatile __attribute__((address_space(3))) unsigned*slot){
  for(;;){
    if(threadIdx.x==0)*slot=__hip_atomic_fetch_add(counter,1u,__ATOMIC_RELAXED,__HIP_MEMORY_SCOPE_AGENT);
    __syncthreads();
    const unsigned u=__builtin_amdgcn_readfirstlane(*slot);
    __syncthreads();
    if(u>=1024u)break;
    const int qb=7-(int)(u>>7),bvh=(int)(u&127u),b=bvh>>4,vh=bvh&15,s=vh>>1,half=vh&1;
    attn_unit<THRL>(b,s*64,s*64,(s>>1)*128+half*64,s*128+half*64,qb,T.Q,T.K,T.V,T.O,lds);
  }
}
template<int THRL=8> __device__ __forceinline__ void attn_phase_queue128(char*lds,const AttnTensors&T,unsigned*counter,volatile __attribute__((address_space(3))) unsigned*slot){
  for(;;){
    if(threadIdx.x==0)*slot=__hip_atomic_fetch_add(counter,1u,__ATOMIC_RELAXED,__HIP_MEMORY_SCOPE_AGENT);
    __syncthreads();
    const unsigned u=__builtin_amdgcn_readfirstlane(*slot);
    __syncthreads();
    if(u>=512u)break;
    const int qb=7-(int)(u>>6),bs=(int)(u&63u),b=bs>>3,s=bs&7;
    attn_unit128<THRL>(b,s*64,s*64,(s>>1)*128,s*128,qb,T.Q,T.K,T.V,T.O,lds);
  }
}
template<int THRL=8> __device__ __forceinline__ void attn_phase_hybrid128(char*lds,const AttnTensors&T,unsigned*counter,volatile __attribute__((address_space(3))) unsigned*slot,int c){
  int nst=0,q0=0,q1=0,bs0=0;
  if(c<64){nst=2;q0=7;q1=2;bs0=c;} else if(c<128){nst=2;q0=6;q1=4;bs0=c-64;} else if(c<192){nst=2;q0=3;q1=1;bs0=c-128;} else {nst=1;q0=5;bs0=c-192;}
  for(int i=0;;++i){
    int qb,bs;
    if(i<nst){ qb=(i==0)?q0:q1; bs=bs0; }
    else{
      if(threadIdx.x==0)*slot=__hip_atomic_fetch_add(counter,1u,__ATOMIC_RELAXED,__HIP_MEMORY_SCOPE_AGENT);
      __syncthreads();
      const unsigned u=__builtin_amdgcn_readfirstlane(*slot);
      __syncthreads();
      if(u>=64u)break;
      qb=0; bs=(int)u;
    }
    const int b=bs>>3,sh=bs&7;
    attn_unit128<THRL>(b,sh*64,sh*64,(sh>>1)*128,sh*128,qb,T.Q,T.K,T.V,T.O,lds);
  }
}
#undef SBAR
#undef WAIT_BAR
}
#include <hip/hip_cooperative_groups.h>
typedef unsigned short bf16;
#define GAS __attribute__((address_space(1)))
#define LAS __attribute__((address_space(3)))
typedef unsigned v4u __attribute__((ext_vector_type(4)));
typedef unsigned v2u __attribute__((ext_vector_type(2)));
typedef float f32x4 __attribute__((ext_vector_type(4)));
#define LDS_WAIT() asm volatile("s_waitcnt lgkmcnt(0)" ::: "memory")
__device__ __forceinline__ unsigned f2bf(float f) { unsigned u = __builtin_bit_cast(unsigned, f); return (u + 0x7fffu + ((u >> 16) & 1u)) >> 16; }
__device__ __forceinline__ unsigned pk2(float lo, float hi) { typedef float f2_ __attribute__((ext_vector_type(2))); typedef __bf16 b2_ __attribute__((ext_vector_type(2))); const f2_ v = {lo, hi}; return __builtin_bit_cast(unsigned, __builtin_convertvector(v, b2_)); }
__device__ __forceinline__ float bflo(unsigned w) { return __builtin_bit_cast(float, w << 16); }
__device__ __forceinline__ float bfhi(unsigned w) { return __builtin_bit_cast(float, w & 0xffff0000u); }
__device__ __forceinline__ float bf1(unsigned short h) { return __builtin_bit_cast(float, (unsigned)h << 16); }
template <int CTRL> __device__ __forceinline__ float dppf(float x) { return __builtin_bit_cast(float, __builtin_amdgcn_update_dpp(0, __builtin_bit_cast(int, x), CTRL, 0xf, 0xf, false)); }
__device__ __forceinline__ float row16_allsum(float x) { x += dppf<0x128>(x); x += dppf<0x124>(x); x += dppf<0x122>(x); x += dppf<0x121>(x); return x; }
__device__ __forceinline__ float oct_allsum(float x) { x += dppf<0xB1>(x); x += dppf<0x4E>(x); x += dppf<0x141>(x); return x; }
__device__ __forceinline__ float u2f(unsigned u) { return __builtin_bit_cast(float, u); }
__device__ __forceinline__ unsigned f2u(float f) { return __builtin_bit_cast(unsigned, f); }
__device__ __forceinline__ float sw32(float a, float b) { auto r = __builtin_amdgcn_permlane32_swap(f2u(a), f2u(b), false, false); const unsigned r0 = r[0], r1 = r[1]; return u2f(r0) + u2f(r1); }
__device__ __forceinline__ float sw16(float a, float b) { auto r = __builtin_amdgcn_permlane16_swap(f2u(a), f2u(b), false, false); const unsigned r0 = r[0], r1 = r[1]; return u2f(r0) + u2f(r1); }
__device__ __forceinline__ float wave_allsum(float x) { x = row16_allsum(x); x = sw16(x, x); return sw32(x, x); }
__device__ __forceinline__ float red4(float x0, float x1, float x2, float x3) { return row16_allsum(sw16(sw32(x0, x1), sw32(x2, x3))); }

#define XB_TMO      128
#define XB_XCNT(j)  (256  + 64 * (j))
#define XB_XSUB(j)  (1280 + 64 * (j))
#define XB_XGEN(j)  (2304 + 64 * (j))
#define XB_TOP      3328
#define XB_TOPGEN   3392
#define XCD_BAR_WORDS 3456
#define XB_SPIN_CAP (1u << 18)

__device__ __forceinline__ unsigned xb_ld(unsigned* p)              { return __hip_atomic_load(p, __ATOMIC_RELAXED, __HIP_MEMORY_SCOPE_AGENT); }
__device__ __forceinline__ unsigned xb_add(unsigned* p, unsigned v) { return __hip_atomic_fetch_add(p, v, __ATOMIC_RELAXED, __HIP_MEMORY_SCOPE_AGENT); }
__device__ __forceinline__ unsigned xb_xcc_id() { return (unsigned)__builtin_amdgcn_s_getreg((3 << 11) | 20) & 0xFu; }
#define XB_SPIN(cond, bar) do { unsigned _sp = 0; while (cond) { __builtin_amdgcn_s_sleep(1); \
    if ((++_sp & 255u) == 0u) { if (xb_ld(&(bar)[XB_TMO])) break; if (_sp > XB_SPIN_CAP) { atomicAdd(&(bar)[XB_TMO], 1u); break; } } } } while (0)

struct XcdBarrier {
    unsigned* bar; unsigned x;
    volatile LAS unsigned* st;
};

__device__ __forceinline__ XcdBarrier xcd_barrier_post(unsigned* bar, volatile LAS unsigned* st) {
    XcdBarrier b; b.bar = bar; b.x = xb_xcc_id(); b.st = st;
    if (threadIdx.x == 0) (void)xb_add(&bar[XB_XCNT(b.x)], 1u);
    return b;
}
__device__ __forceinline__ void xcd_barrier_complete(unsigned* bar, unsigned x, unsigned& nloc, unsigned& nx) {
    const unsigned G = gridDim.x * gridDim.y * gridDim.z;
    unsigned sum, cnt, mine, sp = 0u;
    for (;;) {
        sum = 0u; cnt = 0u; mine = 0u;
#pragma unroll
        for (unsigned j = 0; j < 16; ++j) { const unsigned c = xb_ld(&bar[XB_XCNT(j)]); sum += c; cnt += (c > 0u) ? 1u : 0u; }
        mine = xb_ld(&bar[XB_XCNT(x)]);
        if (sum == G) break;
        __builtin_amdgcn_s_sleep(1);
        if ((++sp & 255u) == 0u) { if (xb_ld(&bar[XB_TMO])) break; if (sp > XB_SPIN_CAP) { atomicAdd(&bar[XB_TMO], 1u); break; } }
    }
    nloc = mine > 0u ? mine : 1u; nx = cnt > 0u ? cnt : 1u;
}

__device__ __forceinline__ void xcd_barrier(const XcdBarrier& b) {
    asm volatile("s_waitcnt vmcnt(0)" ::: "memory");
    __syncthreads();
    if (threadIdx.x == 0) {
        unsigned* bar = b.bar;
        __builtin_amdgcn_s_waitcnt(0);
        unsigned nloc = b.st[0], nx = b.st[1];
        if (nloc == 0u) { xcd_barrier_complete(bar, b.x, nloc, nx); b.st[0] = nloc; b.st[1] = nx; }
        const unsigned old = xb_add(&bar[XB_XSUB(b.x)], 1u);
        const unsigned gen = old / nloc;
        if (old + 1u == (gen + 1u) * nloc) {
            __builtin_amdgcn_fence(__ATOMIC_RELEASE, "agent");
            asm volatile("s_waitcnt vmcnt(0)" ::: "memory");
            const unsigned og = xb_add(&bar[XB_TOP], 1u);
            const unsigned tg = og / nx;
            if (og + 1u != (tg + 1u) * nx) XB_SPIN(xb_ld(&bar[XB_TOP]) < (tg + 1u) * nx, bar);
            xb_add(&bar[XB_XGEN(b.x)], 1u);
            __builtin_amdgcn_fence(__ATOMIC_ACQUIRE, "agent");
            asm volatile("s_waitcnt vmcnt(0)" ::: "memory");
        } else {
            XB_SPIN(xb_ld(&bar[XB_XGEN(b.x)]) == gen, bar);
            __builtin_amdgcn_fence(__ATOMIC_ACQUIRE, "agent");
            asm volatile("s_waitcnt vmcnt(0)" ::: "memory");
        }
    }
    __syncthreads();
}


constexpr int CW_BAR = 4096;
constexpr int MISC_OFF = 162816 + 320;
struct Frame {
    LAS unsigned char* lds;
    int tid, lane, wave, G, bx;
    float* out; unsigned char* ws;
};
struct Args { const float* in[26]; float* out; unsigned char* ws; int ph_lo, ph_hi; };
typedef const float* cfp_t;
typedef __attribute__((address_space(4))) const cfp_t* ktab_t;
struct InTab { ktab_t p; __device__ __forceinline__ const float* operator[](int i) const { return p[i]; } };
enum { I_X = 0, I_NMG, I_WIN, I_MU, I_W0, I_W2, I_A0, I_A2, I_G2, I_KK, I_KA, I_RK, I_LNG, I_LNB, I_LQ1, I_LK1, I_LQ2, I_LK2, I_SUBG, I_WA, I_WB, I_WO, I_NFG, I_FF1, I_FF2, I_NFIN };

template <bool ROPE> __device__ __forceinline__ void p0_transpose_item(const float* W, int K, int N, bf16* WT, LAS float* scr, int item, int lane, int pitch = 0, int koff = 0, const float* rowscale = nullptr) {
    if (pitch == 0) pitch = K;
    const int nblk = N / 32, kb = item / nblk, nb = item % nblk, k0 = 64 * kb, n0 = 32 * nb;
#pragma unroll
    for (int i = 0; i < 8; ++i) { const int kk = 8 * i + (lane >> 3), c4 = 4 * (lane & 7); f32x4 w4 = __builtin_nontemporal_load((const GAS f32x4*)(W + (size_t)(k0 + kk) * N + n0 + c4));
        if (rowscale) w4 *= rowscale[k0 + kk];
        scr[kk * 33 + c4] = w4.x; scr[kk * 33 + c4 + 1] = w4.y; scr[kk * 33 + c4 + 2] = w4.z; scr[kk * 33 + c4 + 3] = w4.w; }
    LDS_WAIT(); asm volatile("" ::: "memory");
    const int c = lane & 7;
#pragma unroll
    for (int j = 0; j < 4; ++j) { const int n = (lane >> 3) + 8 * j; const LAS float* s = scr + (8 * c) * 33 + n;
        v4u o; o.x = pk2(s[0 * 33], s[1 * 33]); o.y = pk2(s[2 * 33], s[3 * 33]); o.z = pk2(s[4 * 33], s[5 * 33]); o.w = pk2(s[6 * 33], s[7 * 33]);
        int col = n0 + n;
        if (ROPE && col < 1024) { const int d = col & 63, dd = d & 31; col = (col & ~63) + 8 * (dd >> 2) + (d >> 5) * 4 + (dd & 3); }
        *(GAS v4u*)(WT + (size_t)col * pitch + koff + k0 + 8 * c) = o; }
    LDS_WAIT(); asm volatile("" ::: "memory");
}
__device__ __forceinline__ void rms_row_to_bf16(const float* xrow, const float* g, bf16* orow, int lane) {
    const GAS f32x4* xr = (const GAS f32x4*)xrow + lane; const f32x4* gr = (const f32x4*)g + lane;
    f32x4 v[4]; float s = 0.f;
#pragma unroll
    for (int j = 0; j < 4; ++j) { v[j] = xr[64 * j]; s += (v[j].x * v[j].x + v[j].y * v[j].y) + (v[j].z * v[j].z + v[j].w * v[j].w); }
    const float rstd = 1.0f / sqrtf(wave_allsum(s) * (1.f / D) + NORM_EPS);
    GAS unsigned long long* o8 = (GAS unsigned long long*)orow + lane;
#pragma unroll
    for (int j = 0; j < 4; ++j) { const f32x4 gg = gr[64 * j];
        o8[64 * j] = (unsigned long long)pk2(v[j].x * rstd * gg.x, v[j].y * rstd * gg.y) | ((unsigned long long)pk2(v[j].z * rstd * gg.z, v[j].w * rstd * gg.w) << 32); }
}
__device__ __forceinline__ void rms_row_to_f32(const float* xrow, const float* g, float* orow, int lane) {
    const GAS f32x4* xr = (const GAS f32x4*)xrow + lane; const f32x4* gr = (const f32x4*)g + lane;
    f32x4 v[4]; float s = 0.f;
#pragma unroll
    for (int j = 0; j < 4; ++j) { v[j] = xr[64 * j]; s += (v[j].x * v[j].x + v[j].y * v[j].y) + (v[j].z * v[j].z + v[j].w * v[j].w); }
    const float rstd = 1.0f / sqrtf(wave_allsum(s) * (1.f / D) + NORM_EPS);
    GAS f32x4* o = (GAS f32x4*)orow + lane;
#pragma unroll
    for (int j = 0; j < 4; ++j) { const f32x4 gg = gr[64 * j]; o[64 * j] = v[j] * rstd * gg; }
}
__device__ __forceinline__ void p0_prologue(Frame& F, const InTab& A) {
    LAS float* scr = (LAS float*)(F.lds + RING_OFF + F.wave * 16384);
    const int gw = F.bx * NWAVES + F.wave, NGW = F.G * NWAVES;
    unsigned char* ws = F.ws;
    constexpr int I_IN = (D / 64) * (D_IN / 32), I_A = (512 / 64) * (D / 32), I_O = (D / 64) * (D / 32), I_1 = (D / 64) * (FF / 32), I_2 = (FF / 64) * (D / 32);
    (void)I_A; (void)I_O; (void)I_1; (void)I_2;
    for (int it = gw; it < I_IN; it += NGW) p0_transpose_item<true>(A[I_WIN], D, D_IN, (bf16*)(ws + WS_WIN), scr, it, F.lane);
    if (false) for (int it = gw; it < 0; it += NGW) {
        int r = it;
        if (r < I_A) { p0_transpose_item<false>(A[I_WA], 512, D, (bf16*)(ws + WS_WA), scr, r, F.lane, 1024, 0); continue; } r -= I_A;
        if (r < I_A) { p0_transpose_item<false>(A[I_WB], 512, D, (bf16*)(ws + WS_WA), scr, r, F.lane, 1024, 512); continue; } r -= I_A;
        if (r < I_O) { p0_transpose_item<false>(A[I_WO], D, D, (bf16*)(ws + WS_WO), scr, r, F.lane); continue; } r -= I_O;
        if (r < I_1) { p0_transpose_item<false>(A[I_FF1], D, FF, (bf16*)(ws + WS_W1), scr, r, F.lane); continue; } r -= I_1;
        p0_transpose_item<false>(A[I_FF2], FF, D, (bf16*)(ws + WS_W2), scr, r, F.lane);
    }
    const int gt = F.bx * (NWAVES * 64) + F.tid, NGT = F.G * NWAVES * 64;
    for (int e = gt; e < NLORA * (KLORA / 8); e += NGT) { const int n = e % NLORA, k8 = (e / NLORA) * 8; float v[8];
        const float* src; int kk, nn; bool ok;
        if (n < 512) { src = A[I_W2]; kk = k8; nn = n; ok = k8 < 64; }
        else if (n < 1024) { src = A[I_A2]; kk = k8 - 64; nn = n - 512; ok = (k8 >= 64) && (k8 < 128); }
        else { src = A[I_G2]; kk = k8 - 128; nn = n - 1024; ok = k8 >= 128; }
        if (!ok) kk = 0;
#pragma unroll
        for (int i = 0; i < 8; ++i) v[i] = *(const GAS float*)(src + (size_t)(kk + i) * 512 + nn);
#pragma unroll
        for (int i = 0; i < 8; ++i) v[i] = ok ? v[i] : 0.f;
        v4u o; o.x = pk2(v[0], v[1]); o.y = pk2(v[2], v[3]); o.z = pk2(v[4], v[5]); o.w = pk2(v[6], v[7]);
        *(GAS v4u*)((bf16*)(ws + WS_WL) + (size_t)n * KLORA + k8) = o; }
    for (int e = gt; e < SEQ * 32; e += NGT) { const int pos = e >> 5, i = e & 31;
        const float inv = exp2f(-(float)i * 0.41524101186092029f);
        const float ang = (float)pos * inv;
        const float nrev = rintf(ang * 0.15915494309189535f); const float r_ = (float)((double)ang - (double)nrev * 6.283185307179586476925286766559); float s, c; sincosf(r_, &s, &c);
        ((float*)(ws + WS_ROPE_C))[e] = c; ((float*)(ws + WS_ROPE_S))[e] = s; }
    for (int m = gw; m < M; m += 2 * NGW) {
        const int m2 = m + NGW;
        const GAS f32x4* xa = (const GAS f32x4*)(A[I_X] + (size_t)m * D) + F.lane; const GAS f32x4* xb = (const GAS f32x4*)(A[I_X] + (size_t)m2 * D) + F.lane; const f32x4* gr = (const f32x4*)A[I_NMG] + F.lane;
        f32x4 va[4], vb[4]; float sa = 0.f, sb = 0.f;
#pragma unroll
        for (int j = 0; j < 4; ++j) { va[j] = __builtin_nontemporal_load(xa + 64 * j); vb[j] = __builtin_nontemporal_load(xb + 64 * j); }
#pragma unroll
        for (int j = 0; j < 4; ++j) { sa += (va[j].x * va[j].x + va[j].y * va[j].y) + (va[j].z * va[j].z + va[j].w * va[j].w); sb += (vb[j].x * vb[j].x + vb[j].y * vb[j].y) + (vb[j].z * vb[j].z + vb[j].w * vb[j].w); }
        const float ra = __builtin_amdgcn_rsqf(wave_allsum(sa) * (1.f / D) + NORM_EPS), rb = __builtin_amdgcn_rsqf(wave_allsum(sb) * (1.f / D) + NORM_EPS);
        GAS unsigned long long* oa = (GAS unsigned long long*)((bf16*)(ws + WS_XN) + (size_t)m * D) + F.lane; GAS unsigned long long* ob = (GAS unsigned long long*)((bf16*)(ws + WS_XN) + (size_t)m2 * D) + F.lane;
#pragma unroll
        for (int j = 0; j < 4; ++j) { const f32x4 gg = gr[64 * j];
            oa[64 * j] = (unsigned long long)pk2(va[j].x * ra * gg.x, va[j].y * ra * gg.y) | ((unsigned long long)pk2(va[j].z * ra * gg.z, va[j].w * ra * gg.w) << 32);
            ob[64 * j] = (unsigned long long)pk2(vb[j].x * rb * gg.x, vb[j].y * rb * gg.y) | ((unsigned long long)pk2(vb[j].z * rb * gg.z, vb[j].w * rb * gg.w) << 32); }
    }
}

__device__ __forceinline__ void late_weights(Frame& F, const InTab& A, int part, int nparts, int cu0) {
    int lane_ = F.lane; asm volatile("" : "+v"(lane_));
    LAS float* scr = (LAS float*)(F.lds + RING_OFF + F.wave * 16384);
    unsigned char* ws = F.ws;
    constexpr int I_A = (512 / 64) * (D / 32), I_O = (D / 64) * (D / 32), I_1 = (D / 64) * (FF / 32), I_2 = (FF / 64) * (D / 32), NIT = 2 * I_A + I_O + I_1 + I_2;
    const int per = NIT / nparts, lo = part * per, hi = lo + per;
    const int gw = (F.bx - cu0) * NWAVES + F.wave, NGW = (F.G - cu0) * NWAVES;
    for (int it = lo + gw; it < hi; it += NGW) {
        int r = it;
        if (r < I_A) { p0_transpose_item<false>(A[I_WA], 512, D, (bf16*)(ws + WS_WA), scr, r, lane_, 1024, 0); continue; } r -= I_A;
        if (r < I_A) { p0_transpose_item<false>(A[I_WB], 512, D, (bf16*)(ws + WS_WA), scr, r, lane_, 1024, 512); continue; } r -= I_A;
        if (r < I_O) { p0_transpose_item<false>(A[I_WO], D, D, (bf16*)(ws + WS_WO), scr, r, lane_); continue; } r -= I_O;
        if (r < I_1) { p0_transpose_item<false>(A[I_FF1], D, FF, (bf16*)(ws + WS_W1), scr, r, lane_, 0, 0, A[I_NFG]); continue; } r -= I_1;
        p0_transpose_item<false>(A[I_FF2], FF, D, (bf16*)(ws + WS_W2), scr, r, lane_);
    }
}
__device__ __forceinline__ void prep1_rows(Frame& F, const InTab& A, int g0, int g1, int w, int nw) {
    const int lane = F.lane;
    const bf16* WAG = (const bf16*)(F.ws + WS_WAG); bf16* LIN = (bf16*)(F.ws + WS_LIN);
    const f32x4 mu = *(const f32x4*)(A[I_MU] + 1536 + 4 * lane);
    const bool idl = (lane >= 16) && (lane < 32); const float ce = lane < 16 ? 2.8853900817779268f : -1.4426950408889634f, ca = lane < 16 ? 1.0f : 0.0f, cb = lane < 16 ? -2.0f : 1.0f;
    for (int g = g0 + w; g < g1; g += nw) {
        const int m0 = g * 8; v2u row[9];
        row[0] = (v2u){0u, 0u}; if ((m0 & (SEQ - 1)) != 0) row[0] = *(const GAS v2u*)(WAG + (size_t)(m0 - 1) * 256 + 4 * lane);
#pragma unroll
        for (int j = 0; j < 8; ++j) row[j + 1] = __builtin_nontemporal_load((const GAS v2u*)(WAG + (size_t)(m0 + j) * 256 + 4 * lane));
#pragma unroll
        for (int j = 0; j < 8; ++j) {
            float z[4] = {bflo(row[j + 1].x), bfhi(row[j + 1].x), bflo(row[j + 1].y), bfhi(row[j + 1].y)}; const float p[4] = {bflo(row[j].x), bfhi(row[j].x), bflo(row[j].y), bfhi(row[j].y)};
#pragma unroll
            for (int e = 0; e < 4; ++e) { const float v = z[e] + (p[e] - z[e]) * mu[e];
                const float t = __builtin_amdgcn_rcpf(1.0f + __builtin_amdgcn_exp2f(ce * v));
                z[e] = idl ? v : ca + cb * t; }
            v2u o; { typedef float f2_ __attribute__((ext_vector_type(2))); typedef __bf16 b2_ __attribute__((ext_vector_type(2)));
                     const f2_ v01 = {z[0], z[1]}, v23 = {z[2], z[3]}; o.x = __builtin_bit_cast(unsigned, __builtin_convertvector(v01, b2_)); o.y = __builtin_bit_cast(unsigned, __builtin_convertvector(v23, b2_)); }
            *(GAS v2u*)(LIN + (size_t)(m0 + j) * 256 + 4 * lane) = o;
        }
    }
}
struct ScanRaw { unsigned short r[9], k[9], v[9], a[8]; float d[8]; };
__device__ __forceinline__ void scan_load(ScanRaw& R, const bf16* RKV, const float* DEC, const bf16* AA, size_t row0, int t0, int c) {
#pragma unroll
    for (int j = 0; j < 9; ++j) { int t = t0 - 1 + j; if (t < 0) t = 0; const bf16* p = RKV + (row0 + t) * 1536 + c;
        R.r[j] = *(const GAS bf16*)p; R.k[j] = *(const GAS bf16*)(p + 512); R.v[j] = *(const GAS bf16*)(p + 1024); }
#pragma unroll
    for (int j = 0; j < 8; ++j) { R.d[j] = *(const GAS float*)(DEC + (row0 + t0 + j) * 512 + c); R.a[j] = *(const GAS bf16*)(AA + (row0 + t0 + j) * 512 + c); }
}
__device__ __forceinline__ void scan_phase(Frame& F, const InTab& A, int si) {
    const int lane = F.lane, wave = F.wave, tid = F.tid;
    const int bh = si >> 1, half = si & 1, b = bh >> 3, h = bh & 7, c = h * 64 + lane;
    LAS float* IN = (LAS float*)(F.lds + RING_OFF);
    LAS float* VV = IN + 5 * 4096;
    LAS float* YBUF = VV + 2048;
    const bf16* RKV = (const bf16*)(F.ws + WS_RKV); const float* DEC = (const float*)(F.ws + WS_DEC); const bf16* AA = (const bf16*)(F.ws + WS_AA);
    bf16* Y = (bf16*)(F.ws + WS_Y); float* BON = (float*)(F.ws + WS_BON);
    const float mu_r = A[I_MU][c], mu_k = A[I_MU][512 + c], mu_v = A[I_MU][1024 + c], kkc = A[I_KK][c], kac = A[I_KA][c], rkc = A[I_RK][c];
    const size_t row0 = (size_t)b * SEQ;
    const int myv = (int)(red4(0.f, 1.f, 2.f, 3.f) * (1.0f / 64.0f) + 0.5f);
    const int L0 = __builtin_ctzll(__ballot(myv == 0)), L1 = __builtin_ctzll(__ballot(myv == 1)), L2 = __builtin_ctzll(__ballot(myv == 2)), L3 = __builtin_ctzll(__ballot(myv == 3));
    float S0 = 0.f, S1 = 0.f, S2 = 0.f, S3 = 0.f;
    ScanRaw R; scan_load(R, RKV, DEC, AA, row0, wave * 8, c);
    for (int blk = 0; blk < SEQ / 64; ++blk) {
        {
            const int t0 = blk * 64 + wave * 8;
            f32x4 qd[2], qa[2], qb[2], qk[2], qr[2], qv[2];
#pragma unroll
            for (int j = 0; j < 8; ++j) {
                const float pz = (t0 + j == 0) ? 0.f : 1.f;
                const float rt_ = bf1(R.r[j + 1]), kt_ = bf1(R.k[j + 1]), vt_ = bf1(R.v[j + 1]);
                const float rs = rt_ + (bf1(R.r[j]) * pz - rt_) * mu_r, ks = kt_ + (bf1(R.k[j]) * pz - kt_) * mu_k, vs = vt_ + (bf1(R.v[j]) * pz - vt_) * mu_v;
                const float kkr = ks * kkc, n2 = wave_allsum(kkr * kkr), kk = kkr / __builtin_fmaxf(sqrtf(n2), 1e-12f);
                const float a = 1.0f / (1.0f + __expf(-bf1(R.a[j]))), kx = ks * (1.0f + (a - 1.0f) * kac);
                const float bon = wave_allsum(rs * kx * rkc);
                if (half == 0 && lane == 0) BON[(row0 + t0 + j) * 8 + h] = bon;
                qd[j >> 2][j & 3] = __expf(-0.6065306597f / (1.0f + __expf(-R.d[j])));     qa[j >> 2][j & 3] = -kk; qb[j >> 2][j & 3] = kk * a; qk[j >> 2][j & 3] = kx; qr[j >> 2][j & 3] = rs; qv[j >> 2][j & 3] = vs;
            }
#pragma unroll
            for (int q = 0; q < 2; ++q) { const int t4 = wave * 2 + q; LAS f32x4* p = (LAS f32x4*)IN + t4 * 64 + lane;
                p[0 * 1024] = qd[q]; p[1 * 1024] = qa[q]; p[2 * 1024] = qb[q]; p[3 * 1024] = qk[q]; p[4 * 1024] = qr[q];
                if ((lane >> 5) == half) ((LAS f32x4*)VV)[t4 * 32 + (lane & 31)] = qv[q]; }
        }
        __syncthreads();
        if (blk + 1 < SEQ / 64) scan_load(R, RKV, DEC, AA, row0, (blk + 1) * 64 + wave * 8, c);
#pragma unroll 1
        for (int t4 = 0; t4 < 16; ++t4) {
            const LAS f32x4* p = (const LAS f32x4*)IN + t4 * 64 + lane;
            const f32x4 W4 = p[0], A4 = p[1024], B4 = p[2048], K4 = p[3072], R4 = p[4096];
            const LAS f32x4* pv = (const LAS f32x4*)VV + t4 * 32 + wave * 4;
            const f32x4 V0 = pv[0], V1 = pv[1], V2 = pv[2], V3 = pv[3];
            f32x4 yq;
#pragma unroll
            for (int ts = 0; ts < 4; ++ts) {
                const float w = W4[ts], a = A4[ts], bb = B4[ts], kx = K4[ts], r = R4[ts];
                const float t = red4(S0 * a, S1 * a, S2 * a, S3 * a);
                const float sa0 = __builtin_bit_cast(float, __builtin_amdgcn_readlane(__builtin_bit_cast(int, t), L0)), sa1 = __builtin_bit_cast(float, __builtin_amdgcn_readlane(__builtin_bit_cast(int, t), L1));
                const float sa2 = __builtin_bit_cast(float, __builtin_amdgcn_readlane(__builtin_bit_cast(int, t), L2)), sa3 = __builtin_bit_cast(float, __builtin_amdgcn_readlane(__builtin_bit_cast(int, t), L3));
                S0 = S0 * w + (sa0 * bb + V0[ts] * kx); S1 = S1 * w + (sa1 * bb + V1[ts] * kx); S2 = S2 * w + (sa2 * bb + V2[ts] * kx); S3 = S3 * w + (sa3 * bb + V3[ts] * kx);
                yq[ts] = red4(S0 * r, S1 * r, S2 * r, S3 * r);
            }
            if ((lane & 15) == 0) *(LAS f32x4*)(YBUF + (wave * 4 + myv) * 68 + t4 * 4) = yq;
        }
        __syncthreads();
        { const int t = tid >> 3, rg = tid & 7; const LAS float* yb = YBUF + (4 * rg) * 68 + t;
          v2u o; o.x = pk2(yb[0], yb[68]); o.y = pk2(yb[136], yb[204]);
          *(GAS v2u*)(Y + (row0 + blk * 64 + t) * 512 + h * 64 + 32 * half + 4 * rg) = o; }
    }
    __syncthreads();
}
__device__ __forceinline__ void post_ya(Frame& F, const InTab& A, int w, int nw) {
    int lane = F.lane; asm volatile("" : "+v"(lane));
    const bf16* O = (const bf16*)(F.ws + WS_O); bf16* YA = (bf16*)(F.ws + WS_YA);
    const float lam = __expf(wave_allsum(A[I_LQ1][lane] * A[I_LK1][lane])) - __expf(wave_allsum(A[I_LQ2][lane] * A[I_LK2][lane])) + LAMBDA_INIT;
    const int ca = 8 * lane, ha = lane >> 4, ea = ca & 127;
    float sg[8];
#pragma unroll
    for (int e = 0; e < 8; ++e) sg[e] = A[I_SUBG][ea + e] * (1.0f - LAMBDA_INIT);
#define UNPK8(w_) {bflo(w_.x), bfhi(w_.x), bflo(w_.y), bfhi(w_.y), bflo(w_.z), bfhi(w_.z), bflo(w_.w), bfhi(w_.w)}
    for (int g = w; g < M / 4; g += nw) {
        const int m0 = g * 4;
        v4u o0[4], o1[4];
#pragma unroll
        for (int j = 0; j < 4; ++j) { const size_t mm = (size_t)(m0 + j);
            o0[j] = __builtin_nontemporal_load((const GAS v4u*)(O + mm * 1024 + (2 * ha) * 128 + ea)); o1[j] = __builtin_nontemporal_load((const GAS v4u*)(O + mm * 1024 + (2 * ha + 1) * 128 + ea)); }
        asm volatile("s_waitcnt vmcnt(0)" ::: "memory");
#pragma unroll
        for (int j = 0; j < 4; ++j) { const size_t mm = (size_t)(m0 + j);
            const float a0[8] = UNPK8(o0[j]), a1[8] = UNPK8(o1[j]); float o[8], ss = 0.f;
#pragma unroll
            for (int e = 0; e < 8; ++e) { o[e] = a0[e] - lam * a1[e]; ss += o[e] * o[e]; }
            const float rstd = __builtin_amdgcn_rsqf(row16_allsum(ss) * (1.0f / 128.0f) + SUBLN_EPS);
            v4u wv; wv.x = pk2(o[0] * rstd * sg[0], o[1] * rstd * sg[1]); wv.y = pk2(o[2] * rstd * sg[2], o[3] * rstd * sg[3]); wv.z = pk2(o[4] * rstd * sg[4], o[5] * rstd * sg[5]); wv.w = pk2(o[6] * rstd * sg[6], o[7] * rstd * sg[7]);
            *(GAS v4u*)(YA + mm * 1024 + ca) = wv;
        }
    }
#undef UNPK8
}

typedef short rk_bf16x8 __attribute__((ext_vector_type(8)));
typedef float rk_f32x16 __attribute__((ext_vector_type(16)));
constexpr int RKA_RS_K = 144, RKA_RS_J = 80;
constexpr int RKA_A = 0, RKA_B = 5120, RKA_K = 10240, RKA_R = 15360, RKA_AT = 19968, RKA_BH = 25088, RKA_KH = 30208, RKA_VT = 35328, RKA_GC = 40448, RKA_BYTES = 40704;
constexpr int RKA_N = 0, RKA_X = 0, RKA_T = 5120, RKA_MAK = 7680, RKA_MRB = 10240, RKA_MRK = 12800;
constexpr int RKA_WAVES = 4;
static_assert(RKA_WAVES * RKA_BYTES <= 162816, "phase A LDS");
constexpr size_t WS_PQ0 = 66 * MiB, WS_PQ1 = 34 * MiB;
constexpr size_t WS_RY0 = 98 * MiB, WS_RY1 = 178 * MiB;
constexpr size_t WS_GC = 250 * MiB;
__device__ __forceinline__ unsigned char* rk_pq(unsigned char* ws, int half) { return ws + (half ? WS_PQ1 : WS_PQ0); }
__device__ __forceinline__ unsigned char* rk_ry(unsigned char* ws, int half) { return ws + (half ? WS_RY1 : WS_RY0); }
__device__ __forceinline__ unsigned char* rk_gc(unsigned char* ws, int half) { return ws + WS_GC + (size_t)half * (2048 * 256); }
constexpr size_t WS_SST = 251 * MiB;

__device__ __forceinline__ rk_bf16x8 rk_frag(const LAS unsigned char* base, int rs, int row, int s, int h) { return *(const LAS rk_bf16x8*)(base + row * rs + (16 * s + 8 * h) * 2); }
__device__ __forceinline__ rk_f32x16 rk_mfma(rk_bf16x8 a, rk_bf16x8 b, rk_f32x16 c) { return __builtin_amdgcn_mfma_f32_32x32x16_bf16(a, b, c, 0, 0, 0); }
__device__ __forceinline__ unsigned rk_pk(float lo, float hi) { typedef float f2_ __attribute__((ext_vector_type(2))); typedef __bf16 b2_ __attribute__((ext_vector_type(2))); f2_ v = {lo, hi}; b2_ b = __builtin_convertvector(v, b2_); return __builtin_bit_cast(unsigned, b); }
__device__ __forceinline__ void rk_store_tile_lds(LAS unsigned char* base, int rs, int nrow, int mbase, int h, const rk_f32x16& acc) {
#pragma unroll
    for (int g = 0; g < 4; ++g) { v2u w; w.x = rk_pk(acc[4 * g], acc[4 * g + 1]); w.y = rk_pk(acc[4 * g + 2], acc[4 * g + 3]); *(LAS v2u*)(base + nrow * rs + (mbase + 8 * g + 4 * h) * 2) = w; }
}
__device__ __forceinline__ void rk_store_tile_glb(bf16* base, int pitch, int nrow, int mbase, int h, const rk_f32x16& acc) {
#pragma unroll
    for (int g = 0; g < 4; ++g) { v2u w; w.x = rk_pk(acc[4 * g], acc[4 * g + 1]); w.y = rk_pk(acc[4 * g + 2], acc[4 * g + 3]); *(GAS v2u*)(base + (size_t)nrow * pitch + mbase + 8 * g + 4 * h) = w; }
}
__device__ __forceinline__ void rk_store_tile_frag(unsigned char* base, int nt, int r32, int mt, int h, const rk_f32x16& acc) {
#pragma unroll
    for (int g = 0; g < 4; ++g) { v2u w; w.x = rk_pk(acc[4 * g], acc[4 * g + 1]); w.y = rk_pk(acc[4 * g + 2], acc[4 * g + 3]);
        *(GAS v2u*)(base + ((size_t)((nt * 4 + 2 * mt + (g >> 1)) * 64 + r32 + 32 * (g & 1))) * 16 + 8 * h) = w; }
}
__device__ __forceinline__ void rk_store_blob(unsigned* blob, int lane, const rk_f32x16& acc) {
    v4u w0, w1; w0.x = rk_pk(acc[0], acc[1]); w0.y = rk_pk(acc[2], acc[3]); w0.z = rk_pk(acc[4], acc[5]); w0.w = rk_pk(acc[6], acc[7]);
    w1.x = rk_pk(acc[8], acc[9]); w1.y = rk_pk(acc[10], acc[11]); w1.z = rk_pk(acc[12], acc[13]); w1.w = rk_pk(acc[14], acc[15]);
    *(GAS v4u*)(blob + lane * 8) = w0; *(GAS v4u*)(blob + lane * 8 + 4) = w1;
}
struct RkBlob { v4u w0, w1; };
__device__ __forceinline__ RkBlob rk_load_blob(const unsigned* blob, int lane) { RkBlob b; b.w0 = *(const GAS v4u*)(blob + lane * 8); b.w1 = *(const GAS v4u*)(blob + lane * 8 + 4); return b; }
__device__ __forceinline__ rk_f32x16 rk_blob_f32(const RkBlob& b) {
    rk_f32x16 a; const unsigned w[8] = {b.w0.x, b.w0.y, b.w0.z, b.w0.w, b.w1.x, b.w1.y, b.w1.z, b.w1.w};
#pragma unroll
    for (int i = 0; i < 8; ++i) { a[2 * i] = bflo(w[i]); a[2 * i + 1] = bfhi(w[i]); }
    return a;
}

struct RkRaw { unsigned short r[8], k[8], v[8]; };
__device__ __forceinline__ void rk_load8(RkRaw& R, const bf16* prkv) {
#pragma unroll
    for (int j = 0; j < 8; ++j) { R.r[j] = __builtin_nontemporal_load((const GAS bf16*)(prkv + j * 1536)); R.k[j] = __builtin_nontemporal_load((const GAS bf16*)(prkv + j * 1536 + 512)); R.v[j] = *(const GAS bf16*)(prkv + j * 1536 + 1024); }
}
__device__ __forceinline__ void rwkvA_unit(LAS unsigned char* L, const InTab& A, unsigned char* ws, int bh, int chunk, int lane_in) {
    int lane = lane_in; asm volatile("" : "+v"(lane));
    const int b = bh >> 3, hd = bh & 7, cg = hd * 64 + lane, r32 = lane & 31, h = lane >> 5;
    const size_t row0 = (size_t)b * SEQ + (size_t)chunk * 32;
    const int uh = bh * 32 + (chunk & 31);
    const bf16* prkv = (const bf16*)(ws + WS_RKV) + row0 * 1536 + cg;
    float* pbon = (float*)(ws + WS_BON) + row0 * 8 + hd;
    const float mu_r = A[I_MU][cg], mu_k = A[I_MU][512 + cg], mu_v = A[I_MU][1024 + cg], kkc = A[I_KK][cg], kac = A[I_KA][cg], rkc = A[I_RK][cg], w0c = A[I_W0][cg], a0c = A[I_A0][cg];
    float dW[32], dA[32];
    {
        rk_f32x16 lw[2] = {{}, {}}, la[2] = {{}, {}};
        const bf16* lp = (const bf16*)(ws + WS_LIN) + (row0 + r32) * 256 + 8 * h;
        const bf16* wp = (const bf16*)(ws + WS_WL) + (size_t)(hd * 64 + r32) * 256 + 8 * h;
#pragma unroll
        for (int s2 = 0; s2 < 4; ++s2) { const rk_bf16x8 fw = __builtin_bit_cast(rk_bf16x8, *(const GAS v4u*)(lp + 16 * s2)), fa = __builtin_bit_cast(rk_bf16x8, *(const GAS v4u*)(lp + 64 + 16 * s2));
#pragma unroll
            for (int ct = 0; ct < 2; ++ct) { lw[ct] = rk_mfma(fw, __builtin_bit_cast(rk_bf16x8, *(const GAS v4u*)(wp + (size_t)ct * 32 * 256 + 16 * s2)), lw[ct]);
                la[ct] = rk_mfma(fa, __builtin_bit_cast(rk_bf16x8, *(const GAS v4u*)(wp + (size_t)(512 + ct * 32) * 256 + 64 + 16 * s2)), la[ct]); } }
#pragma unroll
        for (int i = 0; i < 16; ++i) { const int tb = (i & 3) + 8 * (i >> 2);
            { auto r = __builtin_amdgcn_permlane32_swap(f2u(lw[0][i]), f2u(lw[1][i]), false, false); const unsigned r0 = r[0], r1 = r[1]; dW[tb] = u2f(r0); dW[tb + 4] = u2f(r1); }
            { auto r = __builtin_amdgcn_permlane32_swap(f2u(la[0][i]), f2u(la[1][i]), false, false); const unsigned r0 = r[0], r1 = r[1]; dA[tb] = u2f(r0); dA[tb + 4] = u2f(r1); } }
    }
    const int myv = (int)(red4(0.f, 1.f, 2.f, 3.f) * (1.0f / 64.0f) + 0.5f);
    const int L0 = __builtin_ctzll(__ballot(myv == 0)), L1 = __builtin_ctzll(__ballot(myv == 1)), L2 = __builtin_ctzll(__ballot(myv == 2)), L3 = __builtin_ctzll(__ballot(myv == 3));
    float rp = 0.f, kp = 0.f, vp = 0.f;
    if (chunk != 0) { rp = bf1(*(const GAS bf16*)(prkv - 1536)); kp = bf1(*(const GAS bf16*)(prkv - 1536 + 512)); vp = bf1(*(const GAS bf16*)(prkv - 1536 + 1024)); }
    float G = 1.0f;
    RkRaw Rc, Rn; rk_load8(Rc, prkv);
#pragma unroll
    for (int q = 0; q < 4; ++q) {
        prkv += 8 * 1536;
        if (q < 3) rk_load8(Rn, prkv);
        LAS unsigned char* Lr = L + (8 * q) * RKA_RS_K + lane * 2;
        LAS unsigned char* Lt = L + lane * RKA_RS_J + (8 * q) * 2;
        unsigned tA[4], tB[4], tK[4], tV[4], pA = 0, pB = 0, pK = 0, pV = 0;
        float rs_[8], kx_[8], kkr_[8], a8_[8], w8_[8], vs_[8];
#pragma unroll
        for (int j = 0; j < 8; ++j) {
            const float rc = bf1(Rc.r[j]), kc = bf1(Rc.k[j]), vc = bf1(Rc.v[j]);
            const float ks = kc + (kp - kc) * mu_k; rs_[j] = rc + (rp - rc) * mu_r; vs_[j] = vc + (vp - vc) * mu_v; rp = rc; kp = kc; vp = vc;
            kkr_[j] = ks * kkc; a8_[j] = __builtin_amdgcn_rcpf(1.0f + __expf(-(a0c + dA[8 * q + j]))); kx_[j] = ks * (1.0f + (a8_[j] - 1.0f) * kac);
            w8_[j] = __expf(-0.6065306597f * __builtin_amdgcn_rcpf(1.0f + __expf(-(w0c + dW[8 * q + j]))));
        }
        float n2_[8], bon_[8];
#pragma unroll
        for (int j = 0; j < 8; j += 2) {
            const float t = red4(kkr_[j] * kkr_[j], kkr_[j + 1] * kkr_[j + 1], rs_[j] * kx_[j] * rkc, rs_[j + 1] * kx_[j + 1] * rkc);
            n2_[j] = __builtin_bit_cast(float, __builtin_amdgcn_readlane(__builtin_bit_cast(int, t), L0)); n2_[j + 1] = __builtin_bit_cast(float, __builtin_amdgcn_readlane(__builtin_bit_cast(int, t), L1));
            bon_[j] = __builtin_bit_cast(float, __builtin_amdgcn_readlane(__builtin_bit_cast(int, t), L2)); bon_[j + 1] = __builtin_bit_cast(float, __builtin_amdgcn_readlane(__builtin_bit_cast(int, t), L3));
        }
        if (lane < 8) { float bv = bon_[0];
#pragma unroll
            for (int j = 1; j < 8; ++j) bv = (lane == j) ? bon_[j] : bv;
            *(GAS float*)(pbon + (8 * q + lane) * 8) = bv; }
        unsigned tR[4];
#pragma unroll
        for (int j = 0; j < 8; j += 2) {
            const float kk0 = kkr_[j] * __builtin_amdgcn_rsqf(__builtin_fmaxf(n2_[j], 1e-24f)), kk1 = kkr_[j + 1] * __builtin_amdgcn_rsqf(__builtin_fmaxf(n2_[j + 1], 1e-24f));
            const float G0 = G; const float G1 = G0 * w8_[j]; G = G1 * w8_[j + 1]; const float i1 = __builtin_amdgcn_rcpf(G1), i2 = __builtin_amdgcn_rcpf(G);
            tA[j >> 1] = rk_pk(-kk0 * G0, -kk1 * G1); tR[j >> 1] = rk_pk(rs_[j] * G1, rs_[j + 1] * G); tB[j >> 1] = rk_pk(kk0 * a8_[j] * i1, kk1 * a8_[j + 1] * i2); tK[j >> 1] = rk_pk(kx_[j] * i1, kx_[j + 1] * i2); tV[j >> 1] = rk_pk(vs_[j], vs_[j + 1]);
            *(LAS bf16*)(Lr + RKA_A + j * RKA_RS_K) = (bf16)(tA[j >> 1] & 0xffffu); *(LAS bf16*)(Lr + RKA_A + (j + 1) * RKA_RS_K) = (bf16)(tA[j >> 1] >> 16);
            *(LAS bf16*)(Lr + RKA_R + j * RKA_RS_K) = (bf16)(tR[j >> 1] & 0xffffu); *(LAS bf16*)(Lr + RKA_R + (j + 1) * RKA_RS_K) = (bf16)(tR[j >> 1] >> 16);
            *(LAS bf16*)(Lr + RKA_B + j * RKA_RS_K) = (bf16)(tB[j >> 1] & 0xffffu); *(LAS bf16*)(Lr + RKA_B + (j + 1) * RKA_RS_K) = (bf16)(tB[j >> 1] >> 16);
            *(LAS bf16*)(Lr + RKA_K + j * RKA_RS_K) = (bf16)(tK[j >> 1] & 0xffffu); *(LAS bf16*)(Lr + RKA_K + (j + 1) * RKA_RS_K) = (bf16)(tK[j >> 1] >> 16);
        }
        (void)pA; (void)pB; (void)pK; (void)pV;
        *(LAS v4u*)(Lt + RKA_AT) = (v4u){tA[0], tA[1], tA[2], tA[3]}; *(LAS v4u*)(Lt + RKA_BH) = (v4u){tB[0], tB[1], tB[2], tB[3]}; *(LAS v4u*)(Lt + RKA_KH) = (v4u){tK[0], tK[1], tK[2], tK[3]}; *(LAS v4u*)(Lt + RKA_VT) = (v4u){tV[0], tV[1], tV[2], tV[3]};
        Rc = Rn;
    }
    const float GC = G;
    *(GAS float*)((float*)rk_gc(ws, chunk >> 5) + (size_t)uh * 64 + lane) = GC;
    *(LAS float*)(L + RKA_GC + lane * 4) = GC;
    LDS_WAIT(); asm volatile("" ::: "memory");
    {
        rk_f32x16 aN = {}, aAK = {}, aRB = {}, aRK = {};
#pragma unroll
        for (int s = 0; s < 4; ++s) {
            const rk_bf16x8 fA = rk_frag(L + RKA_A, RKA_RS_K, r32, s, h), fR = rk_frag(L + RKA_R, RKA_RS_K, r32, s, h), fB = rk_frag(L + RKA_B, RKA_RS_K, r32, s, h), fK = rk_frag(L + RKA_K, RKA_RS_K, r32, s, h);
            aN = rk_mfma(fB, fA, aN); aAK = rk_mfma(fK, fA, aAK); aRB = rk_mfma(fB, fR, aRB); aRK = rk_mfma(fK, fR, aRK);
        }
        LDS_WAIT(); asm volatile("" ::: "memory");
#pragma unroll
        for (int i = 0; i < 16; ++i) { const int j = (i & 3) + 8 * (i >> 2) + 4 * h;
            if (!(j < r32)) { aN[i] = 0.f; aAK[i] = 0.f; }
            if (!(j <= r32)) { aRB[i] = 0.f; aRK[i] = 0.f; } }
#pragma unroll
        for (int g = 0; g < 4; ++g) *(LAS f32x4*)(L + RKA_N + r32 * 144 + (8 * g + 4 * h) * 4) = (f32x4){aN[4 * g], aN[4 * g + 1], aN[4 * g + 2], aN[4 * g + 3]};
        rk_store_tile_lds(L + RKA_MAK, RKA_RS_J, r32, 0, h, aAK); rk_store_tile_lds(L + RKA_MRB, RKA_RS_J, r32, 0, h, aRB); rk_store_tile_lds(L + RKA_MRK, RKA_RS_J, r32, 0, h, aRK);
        rk_store_tile_lds(L + RKA_T, RKA_RS_J, r32, 0, h, aN);
    }
    LDS_WAIT(); asm volatile("" ::: "memory");
    {
        const int blk = (r32 >> 4) & 1, cc = r32 & 15;
        const LAS unsigned char* Nb = L + RKA_N + (16 * blk) * 144 + (16 * blk) * 4;
        float T[16];
#pragma unroll
        for (int t = 0; t < 16; ++t) { float ac[4] = {(cc == t) ? 1.0f : 0.0f, 0.f, 0.f, 0.f};
#pragma unroll
            for (int j4 = 0; j4 < (t + 3) / 4; ++j4) { const f32x4 n4 = *(const LAS f32x4*)(Nb + t * 144 + j4 * 16);
#pragma unroll
                for (int e = 0; e < 4; ++e) if (4 * j4 + e < t) ac[e] += n4[e] * T[4 * j4 + e]; }
            T[t] = (ac[0] + ac[1]) + (ac[2] + ac[3]); }
        LDS_WAIT(); asm volatile("" ::: "memory");
#pragma unroll
        for (int t = 0; t < 16; ++t) *(LAS bf16*)(L + RKA_T + (16 * blk + t) * RKA_RS_J + r32 * 2) = (bf16)f2bf(T[t]);
        if (blk == 0) { LAS v4u* p = (LAS v4u*)(L + RKA_N + cc * RKA_RS_J);
            p[0] = (v4u){pk2(T[0], T[1]), pk2(T[2], T[3]), pk2(T[4], T[5]), pk2(T[6], T[7])}; p[1] = (v4u){pk2(T[8], T[9]), pk2(T[10], T[11]), pk2(T[12], T[13]), pk2(T[14], T[15])}; }
        LDS_WAIT(); asm volatile("" ::: "memory");
        rk_f32x16 xa = {};
        xa = rk_mfma(*(const LAS rk_bf16x8*)(L + RKA_T + (16 + r32) * RKA_RS_J + 16 * h), *(const LAS rk_bf16x8*)(L + RKA_N + r32 * RKA_RS_J + 16 * h), xa);
        if (r32 < 16) {
#pragma unroll
            for (int g = 0; g < 2; ++g) { v2u w; w.x = rk_pk(xa[4 * g], xa[4 * g + 1]); w.y = rk_pk(xa[4 * g + 2], xa[4 * g + 3]); *(LAS v2u*)(L + RKA_N + 1280 + r32 * RKA_RS_J + (8 * g + 4 * h) * 2) = w; } }
        LDS_WAIT(); asm volatile("" ::: "memory");
        rk_f32x16 ta = {};
        ta = rk_mfma(*(const LAS rk_bf16x8*)(L + RKA_N + 1280 + r32 * RKA_RS_J + 16 * h), *(const LAS rk_bf16x8*)(L + RKA_T + (16 + r32) * RKA_RS_J + (16 + 8 * h) * 2), ta);
        LDS_WAIT(); asm volatile("" ::: "memory");
        if (r32 < 16) {
#pragma unroll
            for (int g = 0; g < 2; ++g) { v2u w; w.x = rk_pk(ta[4 * g], ta[4 * g + 1]); w.y = rk_pk(ta[4 * g + 2], ta[4 * g + 3]); *(LAS v2u*)(L + RKA_T + (16 + r32) * RKA_RS_J + (8 * g + 4 * h) * 2) = w; } }
    }
    LDS_WAIT(); asm volatile("" ::: "memory");
    rk_bf16x8 fT[2];
#pragma unroll
    for (int s = 0; s < 2; ++s) fT[s] = rk_frag(L + RKA_T, RKA_RS_J, r32, s, h);
    {
        rk_f32x16 x0[2] = {{}, {}}, ap[2] = {{}, {}};
#pragma unroll
        for (int s = 0; s < 2; ++s) { const rk_bf16x8 fM = rk_frag(L + RKA_MAK, RKA_RS_J, r32, s, h);
#pragma unroll
            for (int nt = 0; nt < 2; ++nt) { x0[nt] = rk_mfma(fM, rk_frag(L + RKA_VT, RKA_RS_J, nt * 32 + r32, s, h), x0[nt]); ap[nt] = rk_mfma(fT[s], rk_frag(L + RKA_AT, RKA_RS_J, nt * 32 + r32, s, h), ap[nt]); } }
        LDS_WAIT(); asm volatile("" ::: "memory");
#pragma unroll
        for (int nt = 0; nt < 2; ++nt) { rk_store_tile_lds(L + RKA_X, RKA_RS_J, nt * 32 + r32, 0, h, x0[nt]); rk_store_tile_lds(L + RKA_AT, RKA_RS_J, nt * 32 + r32, 0, h, ap[nt]); }
    }
    LDS_WAIT(); asm volatile("" ::: "memory");
    {
        rk_f32x16 u0[2] = {{}, {}};
#pragma unroll
        for (int s = 0; s < 2; ++s)
#pragma unroll
            for (int nt = 0; nt < 2; ++nt) u0[nt] = rk_mfma(fT[s], rk_frag(L + RKA_X, RKA_RS_J, nt * 32 + r32, s, h), u0[nt]);
        LDS_WAIT(); asm volatile("" ::: "memory");
#pragma unroll
        for (int nt = 0; nt < 2; ++nt) rk_store_tile_lds(L + RKA_X, RKA_RS_J, nt * 32 + r32, 0, h, u0[nt]);
    }
    LDS_WAIT(); asm volatile("" ::: "memory");
    unsigned char* pq = rk_pq(ws, chunk >> 5) + (size_t)uh * 16384; unsigned char* ry = rk_ry(ws, chunk >> 5) + (size_t)uh * 8192;
    rk_bf16x8 fRB[2], fRK[2], fAp[2][2], fBh[2][2], fKh[2][2], fU[2][2], fV[2][2];
#pragma unroll
    for (int s = 0; s < 2; ++s) { fRB[s] = rk_frag(L + RKA_MRB, RKA_RS_J, r32, s, h); fRK[s] = rk_frag(L + RKA_MRK, RKA_RS_J, r32, s, h);
#pragma unroll
        for (int nt = 0; nt < 2; ++nt) { fAp[nt][s] = rk_frag(L + RKA_AT, RKA_RS_J, nt * 32 + r32, s, h); fBh[nt][s] = rk_frag(L + RKA_BH, RKA_RS_J, nt * 32 + r32, s, h);
            fKh[nt][s] = rk_frag(L + RKA_KH, RKA_RS_J, nt * 32 + r32, s, h); fU[nt][s] = rk_frag(L + RKA_X, RKA_RS_J, nt * 32 + r32, s, h); fV[nt][s] = rk_frag(L + RKA_VT, RKA_RS_J, nt * 32 + r32, s, h); } }
#pragma unroll
    for (int kt = 0; kt < 2; ++kt) {
        rk_f32x16 acc;
#pragma unroll
        for (int g = 0; g < 4; ++g) { const v2u w = *(const LAS v2u*)(L + RKA_R + r32 * RKA_RS_K + (kt * 32 + 8 * g + 4 * h) * 2); acc[4 * g] = bflo(w.x); acc[4 * g + 1] = bfhi(w.x); acc[4 * g + 2] = bflo(w.y); acc[4 * g + 3] = bfhi(w.y); }
#pragma unroll
        for (int s = 0; s < 2; ++s) acc = rk_mfma(fAp[kt][s], fRB[s], acc);
        rk_store_tile_frag(ry, 0, r32, kt, h, acc);
    }
#pragma unroll
    for (int kt = 0; kt < 2; ++kt)
#pragma unroll
        for (int kq = 0; kq < 2; ++kq) { rk_f32x16 acc = {};
#pragma unroll
            for (int s = 0; s < 2; ++s) acc = rk_mfma(fAp[kq][s], fBh[kt][s], acc);
            acc = acc * *(const LAS float*)(L + RKA_GC + (kt * 32 + r32) * 4);
            rk_store_tile_frag(pq, kt, r32, kq, h, acc); }
#pragma unroll
    for (int vt = 0; vt < 2; ++vt) {
        rk_f32x16 acc = {};
#pragma unroll
        for (int s = 0; s < 2; ++s) { acc = rk_mfma(fU[vt][s], fRB[s], acc); acc = rk_mfma(fV[vt][s], fRK[s], acc); }
        rk_store_blob((unsigned*)(ry + 4096) + vt * 512, lane, acc);
    }
#pragma unroll
    for (int kt = 0; kt < 2; ++kt)
#pragma unroll
        for (int vt = 0; vt < 2; ++vt) { rk_f32x16 acc = {};
#pragma unroll
            for (int s = 0; s < 2; ++s) { acc = rk_mfma(fBh[kt][s], fU[vt][s], acc); acc = rk_mfma(fKh[kt][s], fV[vt][s], acc); }
#pragma unroll
            for (int g = 0; g < 4; ++g) { const f32x4 gq = *(const LAS f32x4*)(L + RKA_GC + (kt * 32 + 8 * g + 4 * h) * 4); acc[4 * g] *= gq[0]; acc[4 * g + 1] *= gq[1]; acc[4 * g + 2] *= gq[2]; acc[4 * g + 3] *= gq[3]; }
            rk_store_blob((unsigned*)(pq + 8192) + (kt * 2 + vt) * 512, lane, acc); }
    LDS_WAIT(); asm volatile("" ::: "memory");
}
__device__ __forceinline__ void rwkvA_phase(Frame& F, const InTab& A, int half) {
    if (F.wave >= RKA_WAVES) { if (half == 0) post_ya(F, A, F.bx * (NWAVES - RKA_WAVES) + (F.wave - RKA_WAVES), F.G * (NWAVES - RKA_WAVES)); return; }
    LAS unsigned char* L = F.lds + RING_OFF + F.wave * RKA_BYTES;
    const int gw = F.bx * RKA_WAVES + F.wave, NGW = F.G * RKA_WAVES;
    for (int u = gw; u < 64 * 32; u += NGW) rwkvA_unit(L, A, F.ws, u >> 5, half * 32 + (u & 31), F.lane);
}
__device__ __forceinline__ void rwkvA_queue(Frame& F, const InTab& A, int half, unsigned* counter) {
    if (F.wave >= RKA_WAVES) return;
    LAS unsigned char* L = F.lds + RING_OFF + F.wave * RKA_BYTES;
    for (;;) {
        unsigned u = 0; if (F.lane == 0) u = __hip_atomic_fetch_add(counter, 1u, __ATOMIC_RELAXED, __HIP_MEMORY_SCOPE_AGENT);
        u = __builtin_amdgcn_readfirstlane(u);
        if (u >= 64u * 32u) break;
        rwkvA_unit(L, A, F.ws, (int)(u >> 5), half * 32 + (int)(u & 31), F.lane);
    }
}
constexpr int RKB_RS = 144, RKB_SBUF = 64 * RKB_RS;
constexpr int RKB_YOFF = 2 * RKB_SBUF + 8192, RKB_YRS = 68, RKB_YBYTES = 32 * RKB_YRS * 4;
__device__ __forceinline__ void rwkvB_phase(Frame& F, const InTab& A, int bh, int half) {
    int lane = F.lane; asm volatile("" : "+v"(lane));
    const int wave = F.wave, r32 = lane & 31, h = lane >> 5;
    LAS unsigned char* SB = F.lds + RING_OFF;
    unsigned char* ws = F.ws;
    const int b = bh >> 3, hd = bh & 7;
    const int kt = (wave >> 1) & 1, vt = wave & 1;
    float* sst = (float*)(ws + WS_SST) + (size_t)bh * 4096 + (size_t)(wave & 3) * 1024;
    rk_f32x16 st = {};
    if (wave < 4) {
        if (half != 0) {
#pragma unroll
            for (int i = 0; i < 16; ++i) st[i] = *(const GAS float*)(sst + i * 64 + lane);
        }
        rk_store_tile_lds(SB, RKB_RS, vt * 32 + r32, kt * 32, h, st);
    }
    const int uh0 = bh * 32; const bool isS = wave < 4, isY = !isS && wave < 6;
    const unsigned char* fptr = isS ? rk_pq(ws, half) + (size_t)uh0 * 16384 + (kt * 256 + lane) * 16 : rk_ry(ws, half) + (size_t)uh0 * 8192 + lane * 16;
    const unsigned char* bptr = isS ? rk_pq(ws, half) + (size_t)uh0 * 16384 + 8192 + (kt * 2 + vt) * 2048 + lane * 32 : rk_ry(ws, half) + (size_t)uh0 * 8192 + 4096 + vt * 2048 + lane * 32;
    const LAS unsigned char* gl = SB + 2 * RKB_SBUF + (kt * 32 + 4 * h) * 4;
    const int fstride = isS ? 16384 : 8192;
    struct Op { v4u f[4]; v4u b0, b1; };
    { const int tid_ = wave * 64 + lane; *(LAS f32x4*)(SB + 2 * RKB_SBUF + tid_ * 16) = *(const GAS f32x4*)(rk_gc(ws, half) + (size_t)uh0 * 256 + tid_ * 16); }
    { const int tid_ = wave * 64 + lane; if (tid_ < 192) { const int e_ = tid_ & 63; const float* src_ = tid_ < 64 ? A[I_LNG] + hd * 64 : (tid_ < 128 ? A[I_LNB] + hd * 64 : A[I_MU] + 1024 + hd * 64);
        ((LAS float*)(SB + RKB_YOFF + 2 * RKB_YBYTES))[tid_] = src_[e_]; } }
    Op o0, o1, o2;
#define RKB_LOAD(O_, c) do { const unsigned char* fp_ = fptr + (size_t)(c) * fstride; const unsigned char* bp_ = bptr + (size_t)(c) * fstride; \
        _Pragma("unroll") for (int s = 0; s < 4; ++s) O_.f[s] = __builtin_nontemporal_load((const GAS v4u*)(fp_ + 1024 * s)); \
        O_.b0 = __builtin_nontemporal_load((const GAS v4u*)bp_); O_.b1 = __builtin_nontemporal_load((const GAS v4u*)(bp_ + 16)); } while (0)
#define RKB_BAR() do { asm volatile("s_waitcnt lgkmcnt(0)" ::: "memory"); __builtin_amdgcn_s_barrier(); asm volatile("" ::: "memory"); } while (0)
#define RKB_NEXT(O_, c, AH_) RKB_LOAD(O_, ((c) + (AH_) < 32 ? (c) + (AH_) : 31))
#define RKB_STEP_S(O_, c) do { \
        const LAS unsigned char* cur = SB + ((c) & 1) * RKB_SBUF; LAS unsigned char* nxt = SB + (((c) & 1) ^ 1) * RKB_SBUF; \
        rk_bf16x8 fS[4]; _Pragma("unroll") for (int s = 0; s < 4; ++s) fS[s] = rk_frag(cur, RKB_RS, vt * 32 + r32, s, h); \
        RkBlob bb_; bb_.w0 = O_.b0; bb_.w1 = O_.b1; const rk_f32x16 q = rk_blob_f32(bb_); \
        _Pragma("unroll") for (int g = 0; g < 4; ++g) { const f32x4 gq = *(const LAS f32x4*)(gl + (c) * 256 + 32 * g); \
            st[4 * g] = st[4 * g] * gq[0] + q[4 * g]; st[4 * g + 1] = st[4 * g + 1] * gq[1] + q[4 * g + 1]; st[4 * g + 2] = st[4 * g + 2] * gq[2] + q[4 * g + 2]; st[4 * g + 3] = st[4 * g + 3] * gq[3] + q[4 * g + 3]; } \
        _Pragma("unroll") for (int s = 0; s < 4; ++s) st = rk_mfma(__builtin_bit_cast(rk_bf16x8, O_.f[s]), fS[s], st); \
        RKB_NEXT(O_, c, 5); \
        rk_store_tile_lds(nxt, RKB_RS, vt * 32 + r32, kt * 32, h, st); \
        RKB_BAR(); } while (0)
#define RKB_Y_BODY(O_, c) do { \
        const LAS unsigned char* cur = SB + ((c) & 1) * RKB_SBUF; \
        rk_bf16x8 fS[4]; _Pragma("unroll") for (int s = 0; s < 4; ++s) fS[s] = rk_frag(cur, RKB_RS, vt * 32 + r32, s, h); \
        RkBlob bb_; bb_.w0 = O_.b0; bb_.w1 = O_.b1; rk_f32x16 acc = rk_blob_f32(bb_); \
        _Pragma("unroll") for (int s = 0; s < 4; ++s) acc = rk_mfma(fS[s], __builtin_bit_cast(rk_bf16x8, O_.f[s]), acc);       \
        RKB_NEXT(O_, c, 3); \
        { LAS float* yb_ = (LAS float*)(SB + RKB_YOFF + ((c) & 1) * RKB_YBYTES) + r32 * RKB_YRS + 32 * vt + 4 * h;        \
          _Pragma("unroll") for (int g = 0; g < 4; ++g) *(LAS f32x4*)(yb_ + 8 * g) = (f32x4){acc[4 * g], acc[4 * g + 1], acc[4 * g + 2], acc[4 * g + 3]}; } \
        } while (0)
    __syncthreads();
    if (isS) {
        Op o3, o4; RKB_LOAD(o0, 0); RKB_LOAD(o1, 1); RKB_LOAD(o2, 2); RKB_LOAD(o3, 3); RKB_LOAD(o4, 4);
#define R5S(c) RKB_STEP_S(o0, c); RKB_STEP_S(o1, (c) + 1); RKB_STEP_S(o2, (c) + 2); RKB_STEP_S(o3, (c) + 3); RKB_STEP_S(o4, (c) + 4);
        R5S(0) R5S(5) R5S(10) R5S(15) R5S(20) R5S(25)
        RKB_STEP_S(o0, 30); RKB_STEP_S(o1, 31);
#undef R5S
    } else {
        const int tl = 8 * (wave - 4) + (lane >> 3), q8 = lane & 7, ch = hd * 64 + 8 * q8;
        float lg[8], lb[8], muv[8];
        { const LAS float* ctab = (const LAS float*)(SB + RKB_YOFF + 2 * RKB_YBYTES) + 8 * q8;
#pragma unroll
          for (int j = 0; j < 2; ++j) { const f32x4 a_ = *(const LAS f32x4*)(ctab + 4 * j), b_ = *(const LAS f32x4*)(ctab + 64 + 4 * j), c_ = *(const LAS f32x4*)(ctab + 128 + 4 * j);
#pragma unroll
            for (int i = 0; i < 4; ++i) { lg[4 * j + i] = a_[i]; lb[4 * j + i] = b_[i]; muv[4 * j + i] = c_[i]; } } }
        const GAS unsigned char* RKVp = (const GAS unsigned char*)(ws + WS_RKV) + 2048; const GAS unsigned char* GGp = (const GAS unsigned char*)(ws + WS_GG); const GAS unsigned char* BONp = (const GAS unsigned char*)(ws + WS_BON); GAS unsigned char* YAp = (GAS unsigned char*)(ws + WS_YA) + 1024;
        const unsigned mlane = (unsigned)(b * SEQ + half * 1024 + tl);
        const unsigned og = (mlane * 512u + (unsigned)ch) * 2u, ov = (mlane * 1536u + (unsigned)ch) * 2u, ob = (mlane * 8u + (unsigned)hd) * 4u, oy = (mlane * 1024u + (unsigned)ch) * 2u;
        struct Pp { v4u g, v, p; float bon; };
#define RKB_PLOAD(P_, c) do { \
        P_.g = __builtin_nontemporal_load((const GAS v4u*)(GGp + (size_t)(c) * 32768 + og)); P_.v = __builtin_nontemporal_load((const GAS v4u*)(RKVp + (size_t)(c) * 98304 + ov)); P_.p = __builtin_nontemporal_load((const GAS v4u*)(RKVp + ((long)(c) * 98304 - 3072) + ov)); \
        P_.bon = *(const GAS float*)(BONp + (size_t)(c) * 1024 + ob); } while (0)
#define RKB_UNPK8(w_) {bflo(w_.x), bfhi(w_.x), bflo(w_.y), bfhi(w_.y), bflo(w_.z), bfhi(w_.z), bflo(w_.w), bfhi(w_.w)}
#define RKB_POST(P_, c) do { asm volatile("" : "+v"(P_.g), "+v"(P_.v), "+v"(P_.p));        \
        const LAS float* yb_ = (const LAS float*)(SB + RKB_YOFF + ((c) & 1) * RKB_YBYTES) + tl * RKB_YRS + 8 * q8; \
        const f32x4 ya_ = *(const LAS f32x4*)yb_, yc_ = *(const LAS f32x4*)(yb_ + 4); const float y[8] = {ya_[0], ya_[1], ya_[2], ya_[3], yc_[0], yc_[1], yc_[2], yc_[3]}; \
        const float mean = oct_allsum(((y[0] + y[1]) + (y[2] + y[3])) + ((y[4] + y[5]) + (y[6] + y[7]))) * (1.0f / 64.0f); \
        float q_ = 0.f; _Pragma("unroll") for (int e = 0; e < 8; ++e) { const float d_ = y[e] - mean; q_ += d_ * d_; } \
        const float rstd = __builtin_amdgcn_rsqf(oct_allsum(q_) * (1.0f / 64.0f) + GN_EPS); \
        const bool first_ = (((mlane + 32u * (unsigned)(c)) & (unsigned)(SEQ - 1)) == 0u);        \
        const float ga[8] = RKB_UNPK8(P_.g), va[8] = RKB_UNPK8(P_.v), pa[8] = RKB_UNPK8(P_.p); float r[8]; \
        _Pragma("unroll") for (int e = 0; e < 8; ++e) { const float pe_ = first_ ? 0.f : pa[e]; const float vs_ = va[e] + (pe_ - va[e]) * muv[e]; r[e] = (((y[e] - mean) * rstd) * lg[e] + lb[e] + P_.bon * vs_) * ga[e]; } \
        v4u w0; w0.x = rk_pk(r[0], r[1]); w0.y = rk_pk(r[2], r[3]); w0.z = rk_pk(r[4], r[5]); w0.w = rk_pk(r[6], r[7]); \
        *(GAS v4u*)(YAp + (size_t)(c) * 65536 + oy) = w0; \
        RKB_PLOAD(P_, ((c) + 3 < 32 ? (c) + 3 : 31)); } while (0)
        Pp p0, p1, p2; RKB_PLOAD(p0, 0); RKB_PLOAD(p1, 1); RKB_PLOAD(p2, 2);
        if (isY) {
            RKB_LOAD(o0, 0); RKB_LOAD(o1, 1); RKB_LOAD(o2, 2);
            RKB_Y_BODY(o0, 0); RKB_BAR();
#define R3YP(c) RKB_Y_BODY(o1, c); RKB_POST(p0, (c) - 1); RKB_BAR(); RKB_Y_BODY(o2, (c) + 1); RKB_POST(p1, c); RKB_BAR(); RKB_Y_BODY(o0, (c) + 2); RKB_POST(p2, (c) + 1); RKB_BAR();
            R3YP(1) R3YP(4) R3YP(7) R3YP(10) R3YP(13) R3YP(16) R3YP(19) R3YP(22) R3YP(25) R3YP(28)
            RKB_Y_BODY(o1, 31); RKB_POST(p0, 30); RKB_BAR();
            RKB_POST(p1, 31);
#undef R3YP
        } else {
            RKB_BAR();
#define R3P(c) RKB_POST(p0, (c) - 1); RKB_BAR(); RKB_POST(p1, c); RKB_BAR(); RKB_POST(p2, (c) + 1); RKB_BAR();
            R3P(1) R3P(4) R3P(7) R3P(10) R3P(13) R3P(16) R3P(19) R3P(22) R3P(25) R3P(28)
            RKB_POST(p0, 30); RKB_BAR();
            RKB_POST(p1, 31);
#undef R3P
        }
#undef RKB_POST
#undef RKB_UNPK8
#undef RKB_PLOAD
    }
#undef RKB_STEP_S
#undef RKB_Y_BODY
#undef RKB_NEXT
#undef RKB_BAR
#undef RKB_LOAD
    if (wave < 4 && half == 0) {
#pragma unroll
        for (int i = 0; i < 16; ++i) *(GAS float*)(sst + i * 64 + lane) = st[i];
    }
}

constexpr int NPHASE = 9;
template <int PHM> __global__ void __launch_bounds__(NWAVES * 64, 2) fwd_kernel(Args args) {
    extern __shared__ __attribute__((aligned(16))) unsigned char lds[];
    namespace cg = cooperative_groups;
    Frame F;
    F.lds = (LAS unsigned char*)lds;
    F.tid = threadIdx.x; F.lane = F.tid & 63; F.wave = __builtin_amdgcn_readfirstlane(F.tid >> 6);
    F.G = gridDim.x; F.bx = blockIdx.x;
    F.out = args.out; F.ws = args.ws;
#define PH_BEGIN InTab TAB; { ktab_t kp_ = (ktab_t)__builtin_amdgcn_kernarg_segment_ptr(); asm volatile("" : "+s"(kp_)); TAB.p = kp_; } { int t_ = threadIdx.x; asm volatile("" : "+v"(t_)); F.tid = t_; F.lane = t_ & 63; F.wave = __builtin_amdgcn_readfirstlane(t_ >> 6); } GAS unsigned char* wsg_ = (GAS unsigned char*)args.ws; asm volatile("" : "+s"(wsg_)); unsigned char* ws = (unsigned char*)wsg_; F.ws = ws; GAS bf16_t* gtg_ = (GAS bf16_t*)args.out; asm volatile("" : "+s"(gtg_)); bf16_t* GATES = (bf16_t*)gtg_; F.out = (float*)GATES; (void)GATES;
    const int lo = args.ph_lo, hi = args.ph_hi;
    XcdBarrier bar; bar.bar = nullptr; bar.x = 0; bar.st = nullptr;
    if (hi - lo > 1) {
        for (int u = threadIdx.x; u < (LDS_BYTES - 162816) / 4; u += NWAVES * 64) ((LAS unsigned*)(F.lds + 162816))[u] = 0u;
        { GAS v4u* z_ = (GAS v4u*)(args.ws + WS_CTL) + (size_t)blockIdx.x * (CTL_ZERO_BYTES / 16 / 256); for (int u = threadIdx.x; u < (int)(CTL_ZERO_BYTES / 16 / 256); u += NWAVES * 64) z_[u] = (v4u){0u, 0u, 0u, 0u}; }
        asm volatile("s_waitcnt vmcnt(0)" ::: "memory");
        __syncthreads();
        cg::this_grid().sync();
        bar = xcd_barrier_post((unsigned*)(args.ws + WS_CTL) + CW_BAR, (volatile LAS unsigned*)(F.lds + MISC_OFF) + 8);
    }
#define IN(k) (((PHM >> (k)) & 1) && lo <= (k) && (k) < hi)
#ifdef PROBE_DUP
#define REPS(k) (((k) == PROBE_DUP) ? 2 : 1)
#else
#define REPS(k) 1
#endif
#define SEAM(k) do { if (IN(k) && IN((k) + 1)) { xcd_barrier(bar); } } while (0)
    using pg8::Gemm; using pg8::StaticOrder; using pg8::EpiRow8; using pg8::bf16_t;

#ifdef PROBE_SEG
#define PROBE_SEG_IS40 (PROBE_SEG == 40)
#ifndef PROBE_BLK
#define PROBE_BLK 0
#endif
    unsigned long long pr_t0 = 0, pr_acc = 0;
#define PR_BEGIN(k) do { if (PROBE_SEG == (k)) { __syncthreads(); pr_t0 = __builtin_amdgcn_s_memrealtime(); } } while (0)
#define PR_END(k) do { if (PROBE_SEG == (k)) { __syncthreads(); pr_acc += __builtin_amdgcn_s_memrealtime() - pr_t0; } } while (0)
#else
#define PR_BEGIN(k) do {} while (0)
#define PR_END(k) do {} while (0)
#define PROBE_SEG_IS40 0
#endif
    if (IN(0)) for (int rep_ = 0; rep_ < REPS(0); ++rep_) { if (rep_) xcd_barrier(bar); PH_BEGIN p0_prologue(F, TAB); } SEAM(0);
    PR_BEGIN(11); if (IN(1)) for (int rep_ = 0; rep_ < REPS(1); ++rep_) { if (rep_) xcd_barrier(bar); PH_BEGIN
        Gemm g{(const bf16_t*)(ws + WS_XN), (const bf16_t*)(ws + WS_WIN), M, D_IN - 256, D}; StaticOrder S; S.init(M, D_IN - 256, F.G, F.bx);
        pg8::EpiProj E{{ws, GATES}};
        pg8::gemm_phase<pg8::EpiProj, StaticOrder, PG8_ALIGN, PG8_SP2>(F.lds + RING_OFF, g, S, E);
    } SEAM(1); PR_END(11);
    PR_BEGIN(12); if (IN(2)) { PH_BEGIN
        constexpr int NLW = 64;
#ifndef PROBE_ATTN_ONLY
        PR_BEGIN(21);
        if (F.bx >= F.G - NLW) {
            const int pm = F.bx - (F.G - NLW);
            PR_BEGIN(22); prep1_rows(F, TAB, pm * 32, pm * 32 + 32, F.wave, NWAVES); PR_END(22);
            asm volatile("s_waitcnt vmcnt(0)" ::: "memory"); __syncthreads();
            if (threadIdx.x == 0) { __builtin_amdgcn_fence(__ATOMIC_ACQUIRE, "agent"); asm volatile("s_waitcnt vmcnt(0)" ::: "memory"); }
            __syncthreads();
            int klora = KLORA; asm volatile("" : "+s"(klora));
            Gemm g{(const bf16_t*)(ws + WS_LIN), (const bf16_t*)(ws + WS_WL) + (size_t)1024 * KLORA, M, 512, klora}; pg8::PanelOrder S{pm, 2};
            EpiRow8<pg8::FLoraG> E{{ws}};
            pg8::gemm_phase<EpiRow8<pg8::FLoraG>, pg8::PanelOrder, PG8_ALIGN, PG8_SP2>(F.lds + RING_OFF, g, S, E);
            __syncthreads();
        } else if (F.bx >= F.G - 2 * NLW) {
            const int pm = F.bx - (F.G - 2 * NLW);
            {
                Gemm g2{(const bf16_t*)(ws + WS_XN), (const bf16_t*)(ws + WS_WIN) + (size_t)(D_IN - 256) * D, M, 256, D}; pg8::PanelOrder S2{pm, 1};
                EpiRow8<pg8::FProjOff> E2{{{ws, GATES}, (D_IN - 256) / 256}};
                pg8::gemm_phase<EpiRow8<pg8::FProjOff>, pg8::PanelOrder, PG8_ALIGN, PG8_SP2>(F.lds + RING_OFF, g2, S2, E2);
                __syncthreads();
            }
        }
#endif
        PR_END(21);
        const attn_body::AttnTensors AT{(const attn_body::bf16*)(ws + WS_Q), (const attn_body::bf16*)(ws + WS_K), (const attn_body::bf16*)(ws + WS_V), (attn_body::bf16*)(ws + WS_O)};
        PR_BEGIN(20); attn_body::attn_phase_hybrid128<8>((char*)lds + RING_OFF, AT, (unsigned*)(ws + WS_CTL + CTL_ATTQ), (volatile LAS unsigned*)(F.lds + MISC_OFF) + 24, F.bx); PR_END(20);
    } SEAM(2); PR_END(12);
    if (IN(3)) { PH_BEGIN
        { GAS unsigned char* w_ = (GAS unsigned char*)args.ws; asm volatile("" : "+s"(w_)); F.ws = (unsigned char*)w_; }
        PR_BEGIN(1); rwkvA_phase(F, TAB, 0); PR_END(1);
        xcd_barrier(bar);
        { GAS unsigned char* w_ = (GAS unsigned char*)args.ws; asm volatile("" : "+s"(w_)); F.ws = (unsigned char*)w_; }
        PR_BEGIN(5); PR_BEGIN(2); PR_BEGIN(4); if (F.bx < 64) rwkvB_phase(F, TAB, F.bx, 0); else { late_weights(F, TAB, 0, 2, 64); late_weights(F, TAB, 1, 2, 64); }
        __syncthreads(); PR_END(4);
        { GAS unsigned char* w_ = (GAS unsigned char*)args.ws; asm volatile("" : "+s"(w_)); F.ws = (unsigned char*)w_; }
        rwkvA_queue(F, TAB, 1, (unsigned*)(F.ws + WS_CTL + CTL_RKAQ)); PR_END(2);
        xcd_barrier(bar); PR_END(5);
        { GAS unsigned char* w_ = (GAS unsigned char*)args.ws; asm volatile("" : "+s"(w_)); F.ws = (unsigned char*)w_; }
        PR_BEGIN(3); if (F.bx < 64) rwkvB_phase(F, TAB, F.bx, 1); PR_END(3);
    } SEAM(3);
    PR_BEGIN(15); if (IN(5)) for (int rep_ = 0; rep_ < REPS(5); ++rep_) { if (rep_) xcd_barrier(bar); PH_BEGIN
        Gemm g{(const bf16_t*)(ws + WS_YA), (const bf16_t*)(ws + WS_WA), M, D, 1024}; StaticOrder S; S.init(M, D, F.G, F.bx);
        pg8::EpiMerge E{GATES, (bf16_t*)(ws + WS_MERGED)};
        pg8::gemm_phase<pg8::EpiMerge, StaticOrder, PG8_ALIGN, PG8_SP2>(F.lds + RING_OFF, g, S, E);
    } SEAM(5); PR_END(15);
    PR_BEGIN(16); if (IN(6)) for (int rep_ = 0; rep_ < REPS(6); ++rep_) { if (rep_) xcd_barrier(bar); PH_BEGIN
        Gemm g{(const bf16_t*)(ws + WS_MERGED), (const bf16_t*)(ws + WS_WO), M, D, D}; StaticOrder S; S.init(M, D, F.G, F.bx);
        pg8::EpiResSum E{TAB[I_X], (float*)(ws + WS_CTL + CTL_SS1), (bf16_t*)(ws + WS_X1B)};
        pg8::gemm_phase<pg8::EpiResSum, StaticOrder, PG8_ALIGN, PG8_SP2>(F.lds + RING_OFF, g, S, E);
    } SEAM(6); PR_END(16);
    PR_BEGIN(17); if (IN(7)) for (int rep_ = 0; rep_ < REPS(7); ++rep_) { if (rep_) xcd_barrier(bar); PH_BEGIN
        Gemm g{(const bf16_t*)(ws + WS_X1B), (const bf16_t*)(ws + WS_W1), M, FF, D}; StaticOrder S; S.init(M, FF, F.G, F.bx);
        pg8::EpiRow8S<pg8::FRelu2> E{{(bf16_t*)(ws + WS_H)}, (const float*)(ws + WS_CTL + CTL_SS1), NORM_EPS};
        pg8::gemm_phase<pg8::EpiRow8S<pg8::FRelu2>, StaticOrder, PG8_ALIGN, PG8_SP2>(F.lds + RING_OFF, g, S, E);
    } SEAM(7); PR_END(17); PR_BEGIN(40); if (PROBE_SEG_IS40) { xcd_barrier(bar); xcd_barrier(bar); xcd_barrier(bar); xcd_barrier(bar); } PR_END(40);
    PR_BEGIN(18); if (IN(8)) for (int rep_ = 0; rep_ < REPS(8); ++rep_) { if (rep_) xcd_barrier(bar); PH_BEGIN
        Gemm g{(const bf16_t*)(ws + WS_H), (const bf16_t*)(ws + WS_W2), M, D, FF}; StaticOrder S; S.init(M, D, F.G, F.bx);
        pg8::EpiResNorm<1> E{nullptr, F.out, nullptr, TAB[I_NFIN], (float*)(ws + WS_CTL + CTL_SS2), (unsigned*)(ws + WS_CTL + CTL_CNT2), NORM_EPS, (bf16_t*)(ws + WS_X1B)};
        pg8::gemm_phase<pg8::EpiResNorm<1>, StaticOrder, PG8_ALIGN, PG8_SP2>(F.lds + RING_OFF, g, S, E);
    } PR_END(18);
#ifdef PROBE_SEG
    if (blockIdx.x == PROBE_BLK) { const unsigned long long t0_ = __builtin_amdgcn_s_memrealtime(); while (__builtin_amdgcn_s_memrealtime() - t0_ < (unsigned long long)PROBE_MUL * pr_acc) __builtin_amdgcn_s_sleep(8); }
#endif
#undef IN
#undef SEAM
#undef PH_BEGIN
}


#ifdef DBG_DUMP
__global__ void dbg_dump(float* out, const unsigned char* ws) {
    const size_t i = (size_t)blockIdx.x * blockDim.x + threadIdx.x; if (i >= (size_t)M * 1024) return;
    const size_t m = i >> 10; const int c = (int)(i & 1023); float v = 0.f;
#if DBG_DUMP == 1
    v = bf1(((const bf16*)(ws + WS_O))[m * 1024 + c]);
#elif DBG_DUMP == 2
    v = c < 512 ? bf1(((const bf16*)(ws + WS_Y))[m * 512 + c]) : (c < 520 ? ((const float*)(ws + WS_BON))[m * 8 + (c - 512)] : 0.f);
#elif DBG_DUMP == 3
    v = c < 512 ? bf1(((const bf16*)(ws + WS_Q))[m * 512 + c]) : bf1(((const bf16*)(ws + WS_K))[m * 512 + c - 512]);
#elif DBG_DUMP == 4
    v = c < 512 ? ((const float*)(ws + WS_DEC))[m * 512 + c] : bf1(((const bf16*)(ws + WS_AA))[m * 512 + c - 512]);
#elif DBG_DUMP == 6
    v = c < 256 ? bf1(((const bf16*)(ws + WS_WAG))[m * 256 + c]) : (c < 512 ? bf1(((const bf16*)(ws + WS_LIN))[m * 256 + c - 256]) : 0.f);
#elif DBG_DUMP == 7
    { const bf16* wl = (const bf16*)(ws + WS_WL); const size_t j = (m * 1024 + c); v = j < (size_t)NLORA * KLORA ? bf1(wl[j]) : 0.f; }
#elif DBG_DUMP == 8
    v = c < 512 ? bf1(((const bf16*)(ws + WS_GG))[m * 512 + c]) : 0.f;
#elif DBG_DUMP == 5
    v = bf1(((const bf16*)(ws + WS_RKV))[m * 1536 + c]);
#endif
    out[i] = v;
}
#endif

#ifdef DBG_FIXLORA
__global__ void dbg_fixlora(Args A) {
    const size_t i = (size_t)blockIdx.x * blockDim.x + threadIdx.x; if (i >= (size_t)M * 512) return;
    const size_t m = i >> 9; const int c = (int)(i & 511);
    const bf16* LINr = (const bf16*)(A.ws + WS_LIN) + m * 256;
#if DBG_FIXLORA & 1
    { float g = 0.f; for (int k = 0; k < 128; ++k) g += bf1(LINr[128 + k]) * A[I_G2][(size_t)k * 512 + c]; ((bf16*)(A.ws + WS_GG))[m * 512 + c] = (bf16)f2bf(g); }
#endif
#if DBG_FIXLORA & 2
    { float s = A[I_A0][c]; for (int k = 0; k < 64; ++k) s += bf1(LINr[64 + k]) * A[I_A2][(size_t)k * 512 + c]; ((bf16*)(A.ws + WS_AA))[m * 512 + c] = (bf16)f2bf(1.0f / (1.0f + expf(-s))); }
#endif
#if DBG_FIXLORA & 4
    { float s = A[I_W0][c]; for (int k = 0; k < 64; ++k) s += bf1(LINr[k]) * A[I_W2][(size_t)k * 512 + c]; const float w = -log1pf(expf(-s)) - 0.5f; ((float*)(A.ws + WS_DEC))[m * 512 + c] = expf(-expf(w)); }
#endif
}
#endif
#ifndef MK_ONE_LAUNCH
#define MK_ONE_LAUNCH 0
#endif
#ifndef MK_MASK
#define MK_MASK ((1 << NPHASE) - 1)
#endif
typedef void (*kern_t)(Args);
template <int P> struct KTab { static void fill(kern_t* t) { t[P] = fwd_kernel<(1 << P)>; KTab<P - 1>::fill(t); } };
template <> struct KTab<-1> { static void fill(kern_t*) {} };
extern "C" void kernel_launch(void* const* d_in, const int* in_sizes, int n_in, void* d_out, int out_size, void* d_ws, size_t ws_size, hipStream_t stream) {
    static int grid = 0; static kern_t ktab[NPHASE];
    if (grid == 0) {
        if (n_in != 26 || in_sizes[0] != M * D || out_size != M * D || ws_size < WS_END) { fprintf(stderr, "kernel_launch: unexpected shapes (n_in %d, in0 %d, out %d, ws %zu); nothing launched\n", n_in, n_in > 0 ? in_sizes[0] : -1, out_size, ws_size); grid = -1; return; }
        int dev = 0, cus = 0;
        if (hipGetDevice(&dev) != hipSuccess || hipDeviceGetAttribute(&cus, hipDeviceAttributeMultiprocessorCount, dev) != hipSuccess) { grid = -1; return; }
#if MK_ONE_LAUNCH
        int per_cu = 0;
        if (hipFuncSetAttribute((const void*)fwd_kernel<MK_MASK>, hipFuncAttributeMaxDynamicSharedMemorySize, LDS_BYTES) != hipSuccess) { fprintf(stderr, "kernel_launch: hipFuncSetAttribute failed\n"); grid = -1; return; }
        if (hipOccupancyMaxActiveBlocksPerMultiprocessor(&per_cu, (const void*)fwd_kernel<MK_MASK>, NWAVES * 64, LDS_BYTES) != hipSuccess || per_cu < 1) { fprintf(stderr, "kernel_launch: occupancy query says %d blocks per CU\n", per_cu); (void)hipGetLastError(); grid = -1; return; }
#else
        KTab<NPHASE - 1>::fill(ktab);
        for (int p = 0; p < NPHASE; ++p) if (hipFuncSetAttribute((const void*)ktab[p], hipFuncAttributeMaxDynamicSharedMemorySize, LDS_BYTES) != hipSuccess) { fprintf(stderr, "kernel_launch: hipFuncSetAttribute failed\n"); grid = -1; return; }
#endif
        grid = cus;
        if (grid != 256) fprintf(stderr, "kernel_launch: note: %d CUs (built for 256)\n", grid);
    }
    if (grid < 0) return;
    Args a{};
    for (int i = 0; i < 26; ++i) a.in[i] = (const float*)d_in[i];
    a.out = (float*)d_out; a.ws = (unsigned char*)d_ws;
#if MK_ONE_LAUNCH
    a.ph_lo = 0; a.ph_hi = NPHASE;
    void* kargs[] = {&a};
    hipError_t e = hipLaunchCooperativeKernel((const void*)fwd_kernel<MK_MASK>, dim3(grid), dim3(NWAVES * 64), kargs, LDS_BYTES, stream);
    if (e != hipSuccess) fprintf(stderr, "kernel_launch: cooperative launch failed: %s\n", hipGetErrorString(e));
#else
#ifdef DBG_DUMP
    for (int p = 0; p <= DBG_STOP; ++p) { a.ph_lo = p; a.ph_hi = p + 1; hipLaunchKernelGGL(ktab[p], dim3(grid), dim3(NWAVES * 64), LDS_BYTES, stream, a); }
    hipLaunchKernelGGL(dbg_dump, dim3((M * 1024) / 256), dim3(256), 0, stream, (float*)d_out, (const unsigned char*)d_ws);
#else
    for (int p = 0; p < NPHASE; ++p) { a.ph_lo = p; a.ph_hi = p + 1; hipLaunchKernelGGL(ktab[p], dim3(grid), dim3(NWAVES * 64), LDS_BYTES, stream, a);
#ifdef DBG_FIXLORA
        if (p == 3) hipLaunchKernelGGL(dbg_fixlora, dim3((M * 512) / 256), dim3(256), 0, stream, a);
#endif
    }
#endif
#endif
}
```
